# Optimizing an MI355X kernel written in HIP

```python
import jax
import jax.numpy as jnp
from jax import lax
import numpy as np

D_MODEL = 1024
BATCH = 2
SEQ = 8192
DEPTH = 2

GRID_W = 64
CTX_LEN = 256
HEAD_DIM = 64
A_HEADS = 8
A_KV_HEADS = 2
A_WINDOW = 128
A_BLOCK = 128
B_HEADS = 8
NA_ROWS = 8
NA_COLS = 16
QA_W = A_HEADS * HEAD_DIM
KVA_W = A_KV_HEADS * HEAD_DIM
QKVB_W = B_HEADS * HEAD_DIM
EVEN_SPLITS = (QA_W, QA_W + KVA_W, QA_W + 2 * KVA_W, QA_W + 2 * KVA_W + QKVB_W, QA_W + 2 * KVA_W + 2 * QKVB_W)
EVEN_IN = QA_W + 2 * KVA_W + 3 * QKVB_W
EVEN_OUT = (A_HEADS + B_HEADS) * HEAD_DIM
C_HEADS = 16
C_Q_RANK = 384
C_KV_RANK = 256
C_NOPE = 64
C_ROPE = 32
C_V = 64
C_IN = C_Q_RANK + C_KV_RANK + C_ROPE
C_OUT = C_HEADS * C_V
Q_BLOCK = 128
D_FF = 4 * D_MODEL
N_EVEN = (DEPTH + 1) // 2
N_ODD = DEPTH // 2
ROPE_THETA = 10000.0
NORM_EPS = 1e-6
NEG_INF = -1e30

kernel_name = 'hybrid_prefix_dit_block'


def rms_norm(x, g):
    xf = x.astype(jnp.float32)
    y = xf * lax.rsqrt(jnp.mean(xf * xf, axis=-1, keepdims=True) + NORM_EPS)
    return (y * g.astype(jnp.float32)).astype(x.dtype)


def modulate(h, shift, scale):
    return h * (1 + scale) + shift


def adaln(cond, w, b):
    m = jax.nn.silu(cond) @ w + b
    return jnp.split(m[:, None, :], 6, axis=-1)


def rope_1d(x, pos):
    half = x.shape[-1] // 2
    inv = ROPE_THETA ** (-jnp.arange(half, dtype=jnp.float32) / half)
    ang = pos.astype(jnp.float32)[:, None] * inv[None, :]
    cos, sin = jnp.cos(ang)[:, None, :], jnp.sin(ang)[:, None, :]
    x1, x2 = x[..., :half], x[..., half:]
    return jnp.concatenate([x1 * cos - x2 * sin, x1 * sin + x2 * cos], axis=-1).astype(x.dtype)


def rope_2d(x, row, col):
    half = x.shape[-1] // 2
    return jnp.concatenate([rope_1d(x[..., :half], row), rope_1d(x[..., half:], col)], axis=-1)


def squared_relu_mlp(h, w1, w2):
    return jnp.square(jax.nn.relu(h @ w1)) @ w2


def ctx_self_attention(q, k, v, scale, sink=None):
    bsz, n, hq, dq = q.shape
    g = k.shape[2]
    r = hq // g
    qg = q.reshape(bsz, n, g, r, dq)
    s = jnp.einsum('bqgrd,bkgd->bgrqk', qg, k, preferred_element_type=jnp.float32) * scale
    if sink is not None:
        sk = jnp.broadcast_to(sink.astype(jnp.float32).reshape(g, r)[None, :, :, None, None], (bsz, g, r, n, 1))
        s = jnp.concatenate([s, sk], axis=-1)
    p = jax.nn.softmax(s, axis=-1)[..., :n].astype(v.dtype)
    o = jnp.einsum('bgrqk,bkgd->bqgrd', p, v)
    return o.reshape(bsz, n, hq * v.shape[-1])


def window_attention(q, k, v, kc, vc, sink):
    bsz, seq, hq, d = q.shape
    g = k.shape[2]
    r = hq // g
    nb = seq // A_BLOCK
    qb = q.reshape(bsz, nb, A_BLOCK, g, r, d)

    def band(t):
        tb = jnp.pad(t.reshape(bsz, nb, A_BLOCK, g, d), ((0, 0), (1, 1), (0, 0), (0, 0), (0, 0)))
        return jnp.concatenate([tb[:, :-2], tb[:, 1:-1], tb[:, 2:]], axis=2)

    kb, vb = band(k), band(v)
    qpos = jnp.arange(seq).reshape(nb, A_BLOCK)
    kpos = (jnp.arange(nb)[:, None] - 1) * A_BLOCK + jnp.arange(3 * A_BLOCK)[None, :]
    valid = ((kpos[:, None, :] >= 0) & (kpos[:, None, :] < seq)
             & (jnp.abs(qpos[:, :, None] - kpos[:, None, :]) <= A_WINDOW))
    scale = d ** -0.5
    s_loc = jnp.einsum('bnqgrd,bnkgd->bngrqk', qb, kb, preferred_element_type=jnp.float32) * scale
    s_loc = jnp.where(valid[None, :, None, None], s_loc, NEG_INF)
    s_ctx = jnp.einsum('bnqgrd,bcgd->bngrqc', qb, kc, preferred_element_type=jnp.float32) * scale
    s_sink = jnp.broadcast_to(sink.astype(jnp.float32).reshape(g, r)[None, None, :, :, None, None],
                              (bsz, nb, g, r, A_BLOCK, 1))
    p = jax.nn.softmax(jnp.concatenate([s_loc, s_ctx, s_sink], axis=-1), axis=-1).astype(v.dtype)
    nloc = 3 * A_BLOCK
    nctx = kc.shape[1]
    o = (jnp.einsum('bngrqk,bnkgd->bnqgrd', p[..., :nloc], vb)
         + jnp.einsum('bngrqc,bcgd->bnqgrd', p[..., nloc:nloc + nctx], vc))
    return o.reshape(bsz, seq, hq * d)


def neighbourhood_attention(q, k, v, kc, vc, rpb, rows_n):
    bsz, _, h, d = q.shape
    kh = min(NA_ROWS, rows_n)
    r = jnp.arange(rows_n)
    row_idx = jnp.clip(r - kh // 2, 0, rows_n - kh)[:, None] + jnp.arange(kh)[None, :]
    cq = jnp.arange(GRID_W)
    c0 = jnp.clip(cq - NA_COLS // 2, 0, GRID_W - NA_COLS)
    col_ok = (cq[None, :] >= c0[:, None]) & (cq[None, :] < c0[:, None] + NA_COLS)
    dri = row_idx - r[:, None] + NA_ROWS - 1
    dci = jnp.clip(cq[None, :] - cq[:, None], 1 - NA_COLS, NA_COLS - 1) + NA_COLS - 1
    bias = rpb.astype(jnp.float32)[:, dri[:, None, :, None], dci[None, :, None, :]]
    bias = jnp.moveaxis(bias, 0, 1)
    qg = q.reshape(bsz, rows_n, GRID_W, h, d)
    kg = k.reshape(bsz, rows_n, GRID_W, h, d)[:, row_idx]
    vg = v.reshape(bsz, rows_n, GRID_W, h, d)[:, row_idx]
    scale = d ** -0.5
    s_loc = jnp.einsum('brqhd,brikhd->brhqik', qg, kg, preferred_element_type=jnp.float32) * scale + bias[None]
    s_loc = jnp.where(col_ok[:, None, :], s_loc, NEG_INF).reshape(bsz, rows_n, h, GRID_W, kh * GRID_W)
    s_ctx = jnp.einsum('brqhd,bchd->brhqc', qg, kc, preferred_element_type=jnp.float32) * scale
    p = jax.nn.softmax(jnp.concatenate([s_loc, s_ctx], axis=-1), axis=-1).astype(v.dtype)
    nloc = kh * GRID_W
    p_loc = p[..., :nloc].reshape(bsz, rows_n, h, GRID_W, kh, GRID_W)
    o = jnp.einsum('brhqik,brikhd->brqhd', p_loc, vg) + jnp.einsum('brhqc,bchd->brqhd', p[..., nloc:], vc)
    return o.reshape(bsz, rows_n * GRID_W, h * d)


def blockwise_dense_attention(q, k, v, kc, vc, scale):
    bsz, seq, h, dq = q.shape
    nb = seq // Q_BLOCK
    kall = jnp.concatenate([kc, k], axis=1)
    vall = jnp.concatenate([vc, v], axis=1)
    qb = jnp.moveaxis(q.reshape(bsz, nb, Q_BLOCK, h, dq), 1, 0)

    def one_block(qblk):
        s = jnp.einsum('bqhd,bkhd->bhqk', qblk, kall, preferred_element_type=jnp.float32) * scale
        p = jax.nn.softmax(s, axis=-1).astype(vall.dtype)
        return jnp.einsum('bhqk,bkhd->bqhd', p, vall)

    o = lax.map(one_block, qb)
    return jnp.moveaxis(o, 0, 1).reshape(bsz, seq, h * v.shape[-1])


def even_mixer(h_lat, h_ctx, row, col, rows_n, w_in, w_out, a_qn, a_kn, a_sink, b_qn, b_kn, b_rpb, need_ctx_out):
    def heads(hh):
        bsz, n, _ = hh.shape
        qa, ka, va, qb, kb, vb = jnp.split(hh @ w_in, EVEN_SPLITS, axis=-1)
        qa = rms_norm(qa.reshape(bsz, n, A_HEADS, HEAD_DIM), a_qn)
        ka = rms_norm(ka.reshape(bsz, n, A_KV_HEADS, HEAD_DIM), a_kn)
        va = va.reshape(bsz, n, A_KV_HEADS, HEAD_DIM)
        qb = rms_norm(qb.reshape(bsz, n, B_HEADS, HEAD_DIM), b_qn)
        kb = rms_norm(kb.reshape(bsz, n, B_HEADS, HEAD_DIM), b_kn)
        vb = vb.reshape(bsz, n, B_HEADS, HEAD_DIM)
        return qa, ka, va, qb, kb, vb

    qa, ka, va, qb, kb, vb = heads(h_lat)
    qa_c, ka_c, va_c, qb_c, kb_c, vb_c = heads(h_ctx)
    qa = rope_2d(qa, row, col)
    ka = rope_2d(ka, row, col)
    o_a = window_attention(qa, ka, va, ka_c, va_c, a_sink)
    o_b = neighbourhood_attention(qb, kb, vb, kb_c, vb_c, b_rpb, rows_n)
    y_lat = jnp.concatenate([o_a, o_b], axis=-1) @ w_out
    y_ctx = None
    if need_ctx_out:
        scale = HEAD_DIM ** -0.5
        oa_c = ctx_self_attention(qa_c, ka_c, va_c, scale, a_sink)
        ob_c = ctx_self_attention(qb_c, kb_c, vb_c, scale)
        y_ctx = jnp.concatenate([oa_c, ob_c], axis=-1) @ w_out
    return y_lat, y_ctx


def mla_project(hh, w_in, qa_norm, kva_norm, w_uq, w_ukv, qn_nope, qn_rope, kn_nope, kn_rope):
    bsz, n, _ = hh.shape
    cq, ckv, kr = jnp.split(hh @ w_in, (C_Q_RANK, C_Q_RANK + C_KV_RANK), axis=-1)
    q = (rms_norm(cq, qa_norm) @ w_uq).reshape(bsz, n, C_HEADS, C_NOPE + C_ROPE)
    kv = (rms_norm(ckv, kva_norm) @ w_ukv).reshape(bsz, n, C_HEADS, C_NOPE + C_V)
    q_nope = rms_norm(q[..., :C_NOPE], qn_nope)
    q_rope = rms_norm(q[..., C_NOPE:], qn_rope)
    k_nope = rms_norm(kv[..., :C_NOPE], kn_nope)
    v = kv[..., C_NOPE:]
    k_rope = rms_norm(kr[:, :, None, :], kn_rope)
    return q_nope, q_rope, k_nope, k_rope, v


def odd_mixer(h_lat, h_ctx, row, col, w_in, qa_norm, kva_norm, w_uq, w_ukv,
              qn_nope, qn_rope, kn_nope, kn_rope, w_out, need_ctx_out):
    q_nope, q_rope, k_nope, k_rope, v = mla_project(h_lat, w_in, qa_norm, kva_norm, w_uq, w_ukv,
                                                    qn_nope, qn_rope, kn_nope, kn_rope)
    q = jnp.concatenate([q_nope, rope_2d(q_rope, row, col)], axis=-1)
    k_rope = rope_2d(k_rope, row, col)
    k = jnp.concatenate([k_nope, jnp.broadcast_to(k_rope, k_nope.shape[:-1] + (C_ROPE,))], axis=-1)
    qc_nope, qc_rope, kc_nope, kc_rope, vc = mla_project(h_ctx, w_in, qa_norm, kva_norm, w_uq, w_ukv,
                                                         qn_nope, qn_rope, kn_nope, kn_rope)
    kc = jnp.concatenate([kc_nope, jnp.broadcast_to(kc_rope, kc_nope.shape[:-1] + (C_ROPE,))], axis=-1)
    scale = (C_NOPE + C_ROPE) ** -0.5
    y_lat = blockwise_dense_attention(q, k, v, kc, vc, scale) @ w_out
    y_ctx = None
    if need_ctx_out:
        qc = jnp.concatenate([qc_nope, qc_rope], axis=-1)
        y_ctx = ctx_self_attention(qc, kc, vc, scale) @ w_out
    return y_lat, y_ctx


def setup_inputs(seed: int = 0) -> dict:
    key = jax.random.key(seed)
    ks = jax.random.split(key, 32)
    f32 = jnp.float32

    def nrm(k, shape, fan_in):
        return jax.random.normal(k, shape, f32) * fan_in ** -0.5

    def gain(k, shape):
        return 1.0 + 0.05 * jax.random.normal(k, shape, f32)

    return {
        'x': jax.random.normal(ks[0], (BATCH, SEQ, D_MODEL), f32),
        'c': jax.random.normal(ks[1], (BATCH, D_MODEL), f32),
        'ctx': jax.random.normal(ks[2], (BATCH, CTX_LEN, D_MODEL), f32),
        'c_ctx': jax.random.normal(ks[3], (D_MODEL,), f32),
        'ada_w': nrm(ks[4], (DEPTH, D_MODEL, 6 * D_MODEL), D_MODEL),
        'ada_b': 0.02 * jax.random.normal(ks[5], (DEPTH, 6 * D_MODEL), f32),
        'norm_mix': gain(ks[6], (DEPTH, D_MODEL)),
        'norm_mlp': gain(ks[7], (DEPTH, D_MODEL)),
        'mlp_w1': nrm(ks[8], (DEPTH, D_MODEL, D_FF), D_MODEL),
        'mlp_w2': nrm(ks[9], (DEPTH, D_FF, D_MODEL), D_FF),
        'e_w_in': nrm(ks[10], (N_EVEN, D_MODEL, EVEN_IN), D_MODEL),
        'e_w_out': nrm(ks[11], (N_EVEN, EVEN_OUT, D_MODEL), EVEN_OUT),
        'a_q_norm': gain(ks[12], (N_EVEN, HEAD_DIM)),
        'a_k_norm': gain(ks[13], (N_EVEN, HEAD_DIM)),
        'a_sink': jax.random.normal(ks[14], (N_EVEN, A_HEADS), f32),
        'b_q_norm': gain(ks[15], (N_EVEN, HEAD_DIM)),
        'b_k_norm': gain(ks[16], (N_EVEN, HEAD_DIM)),
        'b_rpb': 0.1 * jax.random.normal(ks[17], (N_EVEN, B_HEADS, 2 * NA_ROWS - 1, 2 * NA_COLS - 1), f32),
        'o_w_in': nrm(ks[18], (N_ODD, D_MODEL, C_IN), D_MODEL),
        'o_qa_norm': gain(ks[19], (N_ODD, C_Q_RANK)),
        'o_kva_norm': gain(ks[20], (N_ODD, C_KV_RANK)),
        'o_w_uq': nrm(ks[21], (N_ODD, C_Q_RANK, C_HEADS * (C_NOPE + C_ROPE)), C_Q_RANK),
        'o_w_ukv': nrm(ks[22], (N_ODD, C_KV_RANK, C_HEADS * (C_NOPE + C_V)), C_KV_RANK),
        'o_qn_nope': gain(ks[23], (N_ODD, C_NOPE)),
        'o_qn_rope': gain(ks[24], (N_ODD, C_ROPE)),
        'o_kn_nope': gain(ks[25], (N_ODD, C_NOPE)),
        'o_kn_rope': gain(ks[26], (N_ODD, C_ROPE)),
        'o_w_out': nrm(ks[27], (N_ODD, C_OUT, D_MODEL), C_OUT),
    }


def reference(x, c, ctx, c_ctx, ada_w, ada_b, norm_mix, norm_mlp, mlp_w1, mlp_w2,
              e_w_in, e_w_out, a_q_norm, a_k_norm, a_sink, b_q_norm, b_k_norm, b_rpb,
              o_w_in, o_qa_norm, o_kva_norm, o_w_uq, o_w_ukv,
              o_qn_nope, o_qn_rope, o_kn_nope, o_kn_rope, o_w_out):
    seq = x.shape[1]
    rows_n = seq // GRID_W
    t = jnp.arange(seq, dtype=jnp.int32)
    row, col = t // GRID_W, t % GRID_W
    for i in range(DEPTH):
        last = i == DEPTH - 1
        j = i // 2
        sh1, sc1, g1, sh2, sc2, g2 = adaln(c, ada_w[i], ada_b[i])
        csh1, csc1, cg1, csh2, csc2, cg2 = adaln(c_ctx[None, :], ada_w[i], ada_b[i])
        h_lat = modulate(rms_norm(x, norm_mix[i]), sh1, sc1)
        h_ctx = modulate(rms_norm(ctx, norm_mix[i]), csh1, csc1)
        if i % 2 == 0:
            y_lat, y_ctx = even_mixer(h_lat, h_ctx, row, col, rows_n, e_w_in[j], e_w_out[j],
                                      a_q_norm[j], a_k_norm[j], a_sink[j],
                                      b_q_norm[j], b_k_norm[j], b_rpb[j], not last)
        else:
            y_lat, y_ctx = odd_mixer(h_lat, h_ctx, row, col, o_w_in[j], o_qa_norm[j], o_kva_norm[j],
                                     o_w_uq[j], o_w_ukv[j], o_qn_nope[j], o_qn_rope[j],
                                     o_kn_nope[j], o_kn_rope[j], o_w_out[j], not last)
        x = x + g1 * y_lat
        x = x + g2 * squared_relu_mlp(modulate(rms_norm(x, norm_mlp[i]), sh2, sc2), mlp_w1[i], mlp_w2[i])
        if not last:
            ctx = ctx + cg1 * y_ctx
            ctx = ctx + cg2 * squared_relu_mlp(modulate(rms_norm(ctx, norm_mlp[i]), csh2, csc2),
                                               mlp_w1[i], mlp_w2[i])
    return x
```

```cpp
#include <hip/hip_runtime.h>
#include <cstdio>
#include <cstdint>
namespace pg8 {
#define PG8_LAS __attribute__((address_space(3)))
typedef unsigned short bf16_t;
typedef short bf16x8 __attribute__((ext_vector_type(8)));
typedef float f32x4 __attribute__((ext_vector_type(4)));
typedef unsigned u32x4 __attribute__((ext_vector_type(4)));
constexpr int BM = 256, BK = 64, HALF = 128, HTB = HALF * BK * 2  , STAGE_BYTES = 8 * HTB, NXCD = 8, WGM = 8;

__host__ __device__ __forceinline__ int lds_byte(int r, int c) { const int st = (r >> 4) * 2 + (c >> 5), rr = r & 15, cc = c & 31, ob = rr * 64 + cc * 2; return st * 1024 + (ob ^ (((ob >> 9) & 1) << 5)); }
__host__ __device__ __forceinline__ void stage_rc(int b, int& R, int& C) { const int st = b / 1024, sb = b % 1024, swz = sb ^ (((sb >> 9) & 1) << 5); R = (st >> 1) * 16 + swz / 64; C = (st & 1) * 32 + (swz % 64) / 2; }
__host__ __device__ __forceinline__ int perm32(int rho) { const int n = rho >> 4, i = rho & 15; return 8 * (i >> 2) + 4 * n + (i & 3); }

struct Unit { int pm, pn, kinfo; };
struct Gemm { const bf16_t* A; const bf16_t* Bt; int M, N, K; };

struct StaticOrder {
    int nM, nN, nwg, G, c, ntK;
    int xtiles, xsh;
    __host__ __device__ void init(int M, int N, int K, int G_, int c_, int extra_rows = 0, int S = 1) { nM = M / BM; nN = N / BM; nwg = nM * nN; G = G_; c = c_; ntK = K / BK;
        xtiles = (extra_rows / BM) * nN; xsh = S; }
    __host__ __device__ bool next(int i, Unit& u) const {
        const long L = (long)i * G + c;
        if (L >= nwg) {
            if (xtiles == 0) return false;
            const int nb = (nwg - c + G - 1) / G;
            const int nbc = c < nwg ? nb : 0;
            const long e = (long)(i - nbc) * G + ((c + G - (nwg % G)) % G);
            if (e >= ((long)xtiles << xsh)) return false;
            const int tile = (int)(e >> xsh), ks = (int)e & ((1 << xsh) - 1), xnt = ntK >> xsh;
            u.pm = nM + tile / nN; u.pn = tile % nN; u.kinfo = (ks * xnt) | (xnt << 8) | (1 << 16); return true;
        }
        int wgid = (int)L; { const int q = nwg / NXCD, r = nwg % NXCD, xcd = wgid % NXCD, off = wgid / NXCD; wgid = (xcd < r ? xcd * (q + 1) : r * (q + 1) + (xcd - r) * q) + off; }
        const int nig = WGM * nN, gid = wgid / nig, fm = gid * WGM, gsz = (nM - fm) < WGM ? (nM - fm) : WGM;
        u.pm = fm + ((wgid % nig) % gsz); u.pn = (wgid % nig) / gsz; u.kinfo = ntK << 8; return true;
    }
    __device__ __forceinline__ void a_ready(const Unit&) const {}
    __device__ __forceinline__ void done(const Unit&) const {}
};

__device__ __forceinline__ unsigned cvt_pk_bf16(float lo, float hi) { unsigned r; asm volatile("v_cvt_pk_bf16_f32 %0, %1, %2" : "=v"(r) : "v"(lo), "v"(hi)); return r; }
struct EpiAny {
    static constexpr bool AFTER_DRAIN = false;
    int mode; const float* base; void* out; float* ctxres; const float* gate; int ldc, relu2;
    __device__ __forceinline__ bool perm() const { return mode == 1; }
    __device__ __forceinline__ bool headmode() const { return mode == 3; }
    __device__ __forceinline__ static float xsh(float v, int mask, int lane) { return __builtin_bit_cast(float, __builtin_amdgcn_ds_bpermute((lane ^ mask) << 2, __builtin_bit_cast(int, v))); }
    __device__ __forceinline__ void head_epilogue(const f32x4 (&acc)[2][2][4][2], const Unit& u, int wr, int wc, int fr, int fq) const {
        const int H = 4 * u.pn + wc, kind = relu2, lane = fr + 16 * fq;
        int cls, gsel; float qs = 1.f;
        if (kind == 0) { if (H < 8) { cls = 2; gsel = 0; qs = 0.125f * 1.4426950408889634f; } else if (H < 10) { cls = 2; gsel = 1; } else if (H < 12) { cls = 0; gsel = 0; }
                         else if (H < 20) { cls = 1; gsel = 2; qs = 0.125f * 1.4426950408889634f; } else if (H < 28) { cls = 1; gsel = 3; } else { cls = 0; gsel = 0; } }
        else if (kind == 1) { qs = 0.10206207261596575f * 1.4426950408889634f; if (H < 16) { cls = 1; gsel = 4; } else { cls = 3; gsel = 5; } }
        else { if (H < 16) { cls = 1; gsel = 6; } else { cls = 0; gsel = 0; } }
        const bool lat = u.pm < 64;
        bf16_t* O = (bf16_t*)out;
        const int col0 = u.pn * BM + 64 * wc + 8 * fq;
        f32x4 gv[2][2];
#pragma unroll
        for (int bj = 0; bj < 2; ++bj)
#pragma unroll
            for (int n = 0; n < 2; ++n) gv[bj][n] = *(const f32x4*)(base + gsel * 64 + 32 * bj + 8 * fq + 4 * n);
#pragma unroll
        for (int ai = 0; ai < 2; ++ai)
#pragma unroll
            for (int m = 0; m < 4; ++m) {
                const int row = u.pm * BM + ai * HALF + wr * 64 + m * 16 + fr;
                f32x4 v[2][2];
#pragma unroll
                for (int bj = 0; bj < 2; ++bj)
#pragma unroll
                    for (int n = 0; n < 2; ++n) v[bj][n] = acc[ai][bj][m][n];
                if (cls != 0) {
                    float s0 = 0.f, s1 = 0.f;
#pragma unroll
                    for (int n = 0; n < 2; ++n)
#pragma unroll
                        for (int e = 0; e < 4; ++e) { s0 += v[0][n][e] * v[0][n][e]; s1 += v[1][n][e] * v[1][n][e]; }
                    if (cls != 3) { s0 += s1; s0 += xsh(s0, 16, lane); s0 += xsh(s0, 32, lane); s0 = s0 * (1.f / 64.f); s1 = s0; }
                    else { s0 += xsh(s0, 16, lane); s0 += xsh(s0, 32, lane); s1 += xsh(s1, 16, lane); s1 += xsh(s1, 32, lane); s0 *= (1.f / 32.f); s1 *= (1.f / 32.f); }
                    const float r0 = 1.f / sqrtf(s0 + 1e-6f), r1 = 1.f / sqrtf(s1 + 1e-6f);
#pragma unroll
                    for (int n = 0; n < 2; ++n) { v[0][n] = v[0][n] * r0 * gv[0][n]; v[1][n] = v[1][n] * r1 * gv[1][n]; }
                    if (lat && cls == 2) {
                        const int t = row & 8191;
#pragma unroll
                        for (int bj = 0; bj < 2; ++bj) { const int pos = bj == 0 ? (t >> 6) : (t & 63); const float sgn = fq < 2 ? -1.f : 1.f;
#pragma unroll
                            for (int n = 0; n < 2; ++n) { const float* cs = gate + pos * 16 + 8 * (fq & 1) + 4 * n; const f32x4 c = *(const f32x4*)cs, sn = *(const f32x4*)(cs + 2048);
                                f32x4 p;
#pragma unroll
                                for (int e = 0; e < 4; ++e) p[e] = xsh(v[bj][n][e], 32, lane);
                                v[bj][n] = v[bj][n] * c + (p * sgn) * sn; } }
                    }
                    if (lat && cls == 3) {
                        const int t = row & 8191; const int pos = fq < 2 ? (t >> 6) : (t & 63); const float sgn = (fq & 1) ? 1.f : -1.f;
#pragma unroll
                        for (int bj = 0; bj < 2; ++bj)
#pragma unroll
                            for (int n = 0; n < 2; ++n) { const float* cs = gate + 4096 + pos * 8 + 4 * n; const f32x4 c = *(const f32x4*)cs, sn = *(const f32x4*)(cs + 1024);
                                f32x4 p;
#pragma unroll
                                for (int e = 0; e < 4; ++e) p[e] = xsh(v[bj][n][e], 16, lane);
                                v[bj][n] = v[bj][n] * c + (p * sgn) * sn; }
                    }
                    if (qs != 1.f) {
#pragma unroll
                        for (int bj = 0; bj < 2; ++bj)
#pragma unroll
                            for (int n = 0; n < 2; ++n) v[bj][n] = v[bj][n] * qs; }
                }
                bf16_t* rowp = O + (size_t)row * ldc + col0;
#pragma unroll
                for (int bj = 0; bj < 2; ++bj) { u32x4 w; w.x = cvt_pk_bf16(v[bj][0][0], v[bj][0][1]); w.y = cvt_pk_bf16(v[bj][0][2], v[bj][0][3]); w.z = cvt_pk_bf16(v[bj][1][0], v[bj][1][1]); w.w = cvt_pk_bf16(v[bj][1][2], v[bj][1][3]);
                    *(u32x4*)(rowp + 32 * bj) = w; }
            }
    }
    __device__ __forceinline__ void operator()(const f32x4 (&acc)[2][2][4][2], const Unit& u, int wr, int wc, int fr, int fq) const {
        asm volatile("" : "+v"(fr), "+v"(fq));
        if (mode == 1) {
            bf16_t* O = (bf16_t*)out;
            const int row0 = u.pm * BM + wr * 64 + fr, col0 = u.pn * BM + wc * 32 + 8 * fq;
#pragma unroll
            for (int ai = 0; ai < 2; ++ai)
#pragma unroll
                for (int m = 0; m < 4; ++m) { bf16_t* rowp = O + (size_t)(row0 + ai * HALF + m * 16) * ldc + col0;
#pragma unroll
                    for (int bj = 0; bj < 2; ++bj) { f32x4 v0 = acc[ai][bj][m][0], v1 = acc[ai][bj][m][1];
                        if (relu2) {
#pragma unroll
                            for (int e = 0; e < 4; ++e) { float a = fmaxf(v0[e], 0.f), b = fmaxf(v1[e], 0.f); v0[e] = a * a; v1[e] = b * b; } }
                        u32x4 w; w.x = cvt_pk_bf16(v0[0], v0[1]); w.y = cvt_pk_bf16(v0[2], v0[3]); w.z = cvt_pk_bf16(v1[0], v1[1]); w.w = cvt_pk_bf16(v1[2], v1[3]);
                        *(u32x4*)(rowp + bj * HALF) = w; } }
            return;
        }
        if (mode == 3) { head_epilogue(acc, u, wr, wc, fr, fq); return; }
        const int t0 = u.pm * BM; const bool split = (u.kinfo >> 16) != 0; const int cond = t0 < 8192 ? 0 : (t0 < 16384 ? 1 : 2);
        const int col0 = u.pn * BM + wc * 32 + 4 * fq; const float* g = gate + cond * 6144 + col0;
        f32x4 gv[2][2];
#pragma unroll
        for (int bj = 0; bj < 2; ++bj)
#pragma unroll
            for (int n = 0; n < 2; ++n) gv[bj][n] = *(const f32x4*)(g + bj * HALF + n * 16);
        if (split) {
            const int ks = (u.kinfo & 255) / ((u.kinfo >> 8) & 255);
            float* op = ctxres + (size_t)ks * (512 * 1024) + (size_t)(t0 - 16384) * 1024;
#pragma unroll
            for (int ai = 0; ai < 2; ++ai)
#pragma unroll
                for (int m = 0; m < 4; ++m) { const size_t off = (size_t)(wr * 64 + fr + ai * HALF + m * 16) * 1024 + col0;
#pragma unroll
                    for (int bj = 0; bj < 2; ++bj)
#pragma unroll
                        for (int n = 0; n < 2; ++n) *(f32x4*)(op + off + bj * HALF + n * 16) = gv[bj][n] * acc[ai][bj][m][n]; }
            return;
        }
        const float* bp = base + (size_t)t0 * 1024; float* op = (float*)out + (size_t)t0 * 1024;
#pragma unroll
        for (int ai = 0; ai < 2; ++ai)
#pragma unroll
            for (int m = 0; m < 4; ++m) { const size_t off = (size_t)(wr * 64 + fr + ai * HALF + m * 16) * 1024 + col0;
#pragma unroll
                for (int bj = 0; bj < 2; ++bj)
#pragma unroll
                    for (int n = 0; n < 2; ++n) { const f32x4 b = *(const f32x4*)(bp + off + bj * HALF + n * 16);
                        *(f32x4*)(op + off + bj * HALF + n * 16) = b + gv[bj][n] * acc[ai][bj][m][n]; } }
    }
};

template <class Epi, class Sched, bool ALIGN_EPI = false, bool SP2 = false>
__device__ __forceinline__ void gemm_phase(PG8_LAS unsigned char* lds, const Gemm g, const Sched& S, const Epi& E, const int tid) {
    const int wid = __builtin_amdgcn_readfirstlane(tid >> 6), lane = tid & 63, wr = wid >> 2, wc = wid & 3, fr = lane & 15, fq = lane >> 4;
    const int K = g.K;
    unsigned voffA[2], voffB[2];
#pragma unroll
    for (int i = 0; i < 2; ++i) { int R, C; stage_rc(tid * 16 + i * 8192, R, C); const int Rb = E.headmode() ? (64 * (R >> 5) + perm32(R & 31)) : (E.perm() ? ((R & ~31) + perm32(R & 31)) : R);
        voffA[i] = (unsigned)(R * K + C) * 2u; voffB[i] = (unsigned)(Rb * K + C) * 2u; }
    const size_t kstep = (size_t)(BK * 2);
    const size_t hstep = (size_t)HALF * K * 2;
    const size_t tstep = 2 * hstep;
    const size_t hstepB = E.headmode() ? (size_t)32 * K * 2 : hstep;
    const unsigned ldsw = (unsigned)wid * 1024u;
    const int aoff = lds_byte(wr * 64 + fr, fq * 8), boff = lds_byte(wc * 32 + fr, fq * 8);
#define PG8_SA(b, h) (((b) * 2 + (h)) * HTB)
#define PG8_SB(b, h) ((4 + (b) * 2 + (h)) * HTB)
#define PG8_STAGE(bufoff, gbase, voff) do { _Pragma("unroll") for (int _i = 0; _i < 2; ++_i) \
        __builtin_amdgcn_global_load_lds((const unsigned*)((const char*)(gbase) + (voff)[_i]), (PG8_LAS unsigned*)(lds + (bufoff) + ldsw + _i * 8192), 16, 0, 0); } while (0)
#define PG8_LDA(dst, b, h) do { _Pragma("unroll") for (int m = 0; m < 4; ++m) _Pragma("unroll") for (int k = 0; k < 2; ++k) dst[m][k] = *(const PG8_LAS bf16x8*)(lds + PG8_SA(b, h) + aoff + m * 2048 + k * 1024); } while (0)
#define PG8_LDB(dst, b, h) do { _Pragma("unroll") for (int n = 0; n < 2; ++n) _Pragma("unroll") for (int k = 0; k < 2; ++k) dst[n][k] = *(const PG8_LAS bf16x8*)(lds + PG8_SB(b, h) + boff + n * 2048 + k * 1024); } while (0)
#define PG8_MMA(ai, bj, At, Bt) do { __builtin_amdgcn_s_setprio(1); _Pragma("unroll") for (int m = 0; m < 4; ++m) _Pragma("unroll") for (int n = 0; n < 2; ++n) _Pragma("unroll") for (int k = 0; k < 2; ++k) \
        acc[ai][bj][m][n] = __builtin_amdgcn_mfma_f32_16x16x32_bf16(Bt[n][k], At[m][k], acc[ai][bj][m][n], 0, 0, 0); __builtin_amdgcn_s_setprio(0); } while (0)
#define PG8_WAIT_V(n) asm volatile("s_waitcnt vmcnt(" #n ")" ::: "memory")
#define PG8_WAIT_L(n) asm volatile("s_waitcnt lgkmcnt(" #n ")" ::: "memory")
#define PG8_BAR __builtin_amdgcn_s_barrier()
#define PG8_SCHED __builtin_amdgcn_sched_barrier(0)
    Unit cur, nxt; int ui = 0;
    if (!S.next(0, cur)) return;
    f32x4 acc[2][2][4][2];
#pragma unroll
    for (int a = 0; a < 2; ++a)
#pragma unroll
        for (int b = 0; b < 2; ++b)
#pragma unroll
            for (int m = 0; m < 4; ++m)
#pragma unroll
                for (int n = 0; n < 2; ++n) acc[a][b][m][n] = (f32x4){0.f, 0.f, 0.f, 0.f};
    bf16x8 At[4][2], B0[2][2], B1[2][2];
    const char* cA = (const char*)g.A + (size_t)cur.pm * tstep + (size_t)(cur.kinfo & 255) * (BK * 2); const char* cB = (const char*)g.Bt + (size_t)cur.pn * tstep + (size_t)(cur.kinfo & 255) * (BK * 2);
    S.a_ready(cur);
    if constexpr (SP2) {
        PG8_STAGE(PG8_SB(0, 0), cB, voffB); PG8_STAGE(PG8_SB(0, 1), cB + hstepB, voffB); PG8_STAGE(PG8_SA(0, 0), cA, voffA); PG8_STAGE(PG8_SA(0, 1), cA + hstep, voffA);
        if (wr == 1) PG8_BAR;
        PG8_WAIT_V(2); PG8_BAR;
        PG8_STAGE(PG8_SB(1, 0), cB + kstep, voffB); PG8_STAGE(PG8_SA(1, 0), cA + kstep, voffA); PG8_STAGE(PG8_SB(1, 1), cB + hstepB + kstep, voffB);
        PG8_WAIT_V(6); PG8_BAR;
    } else {
        PG8_STAGE(PG8_SB(0, 0), cB, voffB); PG8_STAGE(PG8_SA(0, 0), cA, voffA); PG8_STAGE(PG8_SB(0, 1), cB + hstepB, voffB); PG8_STAGE(PG8_SA(0, 1), cA + hstep, voffA);
        if (wr == 1) PG8_BAR;
        PG8_WAIT_V(4); PG8_BAR;
        PG8_STAGE(PG8_SB(1, 0), cB + kstep, voffB); PG8_STAGE(PG8_SA(1, 0), cA + kstep, voffA); PG8_STAGE(PG8_SB(1, 1), cB + hstepB + kstep, voffB);
        PG8_WAIT_V(6); PG8_BAR;
    }
    for (;;) {
        const bool has_next = S.next(ui + 1, nxt);
        const char* nA = has_next ? (const char*)g.A + (size_t)nxt.pm * tstep + (size_t)(nxt.kinfo & 255) * (BK * 2) : cA; const char* nB = has_next ? (const char*)g.Bt + (size_t)nxt.pn * tstep + (size_t)(nxt.kinfo & 255) * (BK * 2) : cB;
        const int nt = (cur.kinfo >> 8) & 255;
        for (int t = 0; t < nt; t += 2) {
            const bool last = (t == nt - 2);
            const char* a1 = cA + (size_t)(t + 1) * kstep;
            const char* a2 = last ? nA : cA + (size_t)(t + 2) * kstep; const char* b2 = last ? nB : cB + (size_t)(t + 2) * kstep;
            const char* a3 = a2 + kstep; const char* b3 = b2 + kstep;
            if (last && has_next) S.a_ready(nxt);
            if constexpr (SP2) {
            PG8_LDB(B0, 0, 0); PG8_LDB(B1, 0, 1); PG8_SCHED; PG8_LDA(At, 0, 0); PG8_STAGE(PG8_SA(1, 1), a1 + hstep, voffA);
            PG8_WAIT_V(8); PG8_WAIT_L(0); PG8_BAR; PG8_MMA(0, 0, At, B0); PG8_MMA(0, 1, At, B1); PG8_BAR; PG8_SCHED;
            PG8_LDA(At, 0, 1); PG8_STAGE(PG8_SB(0, 0), b2, voffB); PG8_STAGE(PG8_SB(0, 1), b2 + hstepB, voffB); PG8_STAGE(PG8_SA(0, 0), a2, voffA);
            PG8_WAIT_V(8); PG8_WAIT_L(0); PG8_BAR; PG8_MMA(1, 0, At, B0); PG8_MMA(1, 1, At, B1); PG8_BAR; PG8_SCHED;
            PG8_LDB(B0, 1, 0); PG8_LDB(B1, 1, 1); PG8_SCHED; PG8_LDA(At, 1, 0); PG8_STAGE(PG8_SA(0, 1), a2 + hstep, voffA);
            PG8_WAIT_V(8); PG8_WAIT_L(0); PG8_BAR; PG8_MMA(0, 0, At, B0); PG8_MMA(0, 1, At, B1); PG8_BAR; PG8_SCHED;
            PG8_LDA(At, 1, 1); PG8_STAGE(PG8_SB(1, 0), b3, voffB); PG8_STAGE(PG8_SB(1, 1), b3 + hstepB, voffB); PG8_STAGE(PG8_SA(1, 0), a3, voffA);
            PG8_WAIT_V(8); PG8_WAIT_L(0); PG8_BAR; PG8_MMA(1, 0, At, B0); PG8_MMA(1, 1, At, B1); PG8_BAR; PG8_SCHED;
            } else {
            PG8_LDB(B0, 0, 0); PG8_SCHED; PG8_LDA(At, 0, 0); PG8_STAGE(PG8_SA(1, 1), a1 + hstep, voffA);
            PG8_WAIT_L(8); PG8_BAR; PG8_WAIT_L(0); PG8_MMA(0, 0, At, B0); PG8_BAR; PG8_SCHED;
            PG8_LDB(B1, 0, 1); PG8_STAGE(PG8_SB(0, 0), b2, voffB);
            PG8_BAR; PG8_WAIT_L(0); PG8_MMA(0, 1, At, B1); PG8_BAR;
            PG8_LDA(At, 0, 1); PG8_STAGE(PG8_SA(0, 0), a2, voffA);
            PG8_BAR; PG8_WAIT_L(0); PG8_MMA(1, 0, At, B0); PG8_BAR; PG8_SCHED;
            PG8_STAGE(PG8_SB(0, 1), b2 + hstepB, voffB);
            PG8_WAIT_V(6); PG8_BAR; PG8_MMA(1, 1, At, B1); PG8_BAR;
            PG8_LDB(B0, 1, 0); PG8_SCHED; PG8_LDA(At, 1, 0); PG8_STAGE(PG8_SA(0, 1), a2 + hstep, voffA);
            PG8_WAIT_L(8); PG8_BAR; PG8_WAIT_L(0); PG8_MMA(0, 0, At, B0); PG8_BAR; PG8_SCHED;
            PG8_LDB(B1, 1, 1); PG8_STAGE(PG8_SB(1, 0), b3, voffB);
            PG8_BAR; PG8_WAIT_L(0); PG8_MMA(0, 1, At, B1); PG8_BAR;
            PG8_LDA(At, 1, 1); PG8_STAGE(PG8_SA(1, 0), a3, voffA);
            PG8_BAR; PG8_WAIT_L(0); PG8_MMA(1, 0, At, B0); PG8_BAR; PG8_SCHED;
            PG8_STAGE(PG8_SB(1, 1), b3 + hstepB, voffB);
            PG8_WAIT_V(6); PG8_BAR; PG8_MMA(1, 1, At, B1); PG8_BAR;
            }
        }
        if constexpr (ALIGN_EPI) { if (wr == 0) PG8_BAR; }
        if constexpr (!Epi::AFTER_DRAIN) { E(acc, cur, wr, wc, fr, fq); S.done(cur); }
        if (!has_next) break;
#pragma unroll
        for (int a = 0; a < 2; ++a)
#pragma unroll
            for (int b = 0; b < 2; ++b)
#pragma unroll
                for (int m = 0; m < 4; ++m)
#pragma unroll
                    for (int n = 0; n < 2; ++n) acc[a][b][m][n] = (f32x4){0.f, 0.f, 0.f, 0.f};
        cur = nxt; cA = nA; cB = nB; ++ui;
        if constexpr (ALIGN_EPI) { if (wr == 1) PG8_BAR; }
    }
    PG8_WAIT_V(0);
    if constexpr (!ALIGN_EPI) { if (wr == 0) PG8_BAR; }
    PG8_BAR;
    if constexpr (Epi::AFTER_DRAIN) { E.fused(acc, cur, wr, wc, fr, fq, lds, wid, lane); S.done(cur); }
#undef PG8_SA
#undef PG8_SB
#undef PG8_STAGE
#undef PG8_LDA
#undef PG8_LDB
#undef PG8_MMA
#undef PG8_WAIT_V
#undef PG8_WAIT_L
#undef PG8_BAR
#undef PG8_SCHED
}
}
namespace att {
#define ATT_LAS __attribute__((address_space(3)))
typedef unsigned short bf16;
typedef short bf16x8 __attribute__((ext_vector_type(8)));
typedef short s16x4 __attribute__((ext_vector_type(4)));
typedef float f32x16 __attribute__((ext_vector_type(16)));
typedef unsigned u32x4 __attribute__((ext_vector_type(4)));
typedef ATT_LAS char lchar;
constexpr int KBUF = 12288, VBUF = 16384;
constexpr int L_K = 0, L_V = 2 * KBUF, L_WS = L_V + 2 * VBUF, L_RPB = L_WS + 2048, L_END = L_RPB + 2048;
constexpr float LOG2E = 1.4426950408889634f;
#define ATT_SBAR() __builtin_amdgcn_sched_barrier(0)
__device__ __forceinline__ int crow(int r, int hi) { return (r & 3) + 8 * (r >> 2) + 4 * hi; }
__device__ __forceinline__ unsigned cvtpk(float lo, float hi) { unsigned r; asm volatile("v_cvt_pk_bf16_f32 %0, %1, %2" : "=v"(r) : "v"(lo), "v"(hi)); return r; }
__device__ __forceinline__ int v_st(int k, int c) { const int kk = (k & ~0xC) | ((k & 4) << 1) | ((k & 8) >> 1); return ((kk >> 3) * 4 + (c >> 5)) * 512 + ((kk & 7) * 32 + (c & 31)) * 2; }
__device__ __forceinline__ int v_rd_base(int lane) { return ((lane & 3) << 3) | (((lane >> 2) & 3) << 6) | (((lane >> 4) & 1) << 5) | (((lane >> 5) & 1) << 8); }
constexpr int v_rd_off(int d0, int ks, int half) { return d0 * 512 + ks * 4096 + half * 2048; }
template <int OFF> __device__ __forceinline__ s16x4 tr_read(unsigned vb) {
  s16x4 r; asm volatile("ds_read_b64_tr_b16 %0, %1 offset:%2" : "=&v"(r) : "v"(vb), "i"(OFF) : "memory"); return r;
}
template <int D0> __device__ __forceinline__ void pv_one(f32x16& od, unsigned vb, bf16x8 pa0, bf16x8 pa1, bf16x8 pa2, bf16x8 pa3) {
  const s16x4 l0 = tr_read<v_rd_off(D0, 0, 0)>(vb), h0 = tr_read<v_rd_off(D0, 0, 1)>(vb), l1 = tr_read<v_rd_off(D0, 1, 0)>(vb), h1 = tr_read<v_rd_off(D0, 1, 1)>(vb);
  const s16x4 l2 = tr_read<v_rd_off(D0, 2, 0)>(vb), h2 = tr_read<v_rd_off(D0, 2, 1)>(vb), l3 = tr_read<v_rd_off(D0, 3, 0)>(vb), h3 = tr_read<v_rd_off(D0, 3, 1)>(vb);
  asm volatile("s_waitcnt lgkmcnt(0)" ::: "memory"); ATT_SBAR();
#define ATT_PK(L, H) (bf16x8){L[0], L[1], L[2], L[3], H[0], H[1], H[2], H[3]}
  od = __builtin_amdgcn_mfma_f32_32x32x16_bf16(pa0, ATT_PK(l0, h0), od, 0, 0, 0);
  od = __builtin_amdgcn_mfma_f32_32x32x16_bf16(pa1, ATT_PK(l1, h1), od, 0, 0, 0);
  od = __builtin_amdgcn_mfma_f32_32x32x16_bf16(pa2, ATT_PK(l2, h2), od, 0, 0, 0);
  od = __builtin_amdgcn_mfma_f32_32x32x16_bf16(pa3, ATT_PK(l3, h3), od, 0, 0, 0);
#undef ATT_PK
}

template <int DKC, class U>
__device__ __forceinline__ void unit(const U& u, lchar* lds, int tid) {
  asm volatile("" : "+v"(tid));
  const int lane = tid & 63, r32 = lane & 31, hi = lane >> 5;
  const int wid = __builtin_amdgcn_readfirstlane(tid >> 6);
  lchar* Kl = lds + L_K; lchar* Vl = lds + L_V;
  ATT_LAS float* ws = (ATT_LAS float*)(lds + L_WS) + wid * 64;
  bf16x8 qr[DKC / 2];
#pragma unroll
  for (int d0 = 0; d0 < DKC / 2; ++d0) qr[d0] = *(const bf16x8*)u.qptr(wid, r32, d0, hi);
  const int vrow = tid >> 3, vch = tid & 7, vst = v_st(vrow, vch * 8);
  const int krow0 = tid & 63, kch0 = tid >> 6;
  const bool k2 = (DKC > 8) && (tid < 64 * (DKC - 8));
  const unsigned vb0 = (unsigned)(uintptr_t)Vl + (unsigned)v_rd_base(lane);
  bf16x8 kst0, kst1 = {}, vstr;
  const int NT = u.nt();
#define ATT_SLOAD(t) do { const long R_ = u.krow(t); kst0 = *(const bf16x8*)u.kptr(R_ + krow0, kch0); if (k2) kst1 = *(const bf16x8*)u.kptr(R_ + krow0, 8 + kch0); \
    vstr = *(const bf16x8*)u.vptr(R_ + vrow, vch); } while (0)
#define ATT_SWRITE(b) do { *(ATT_LAS bf16x8*)(Kl + (b) * KBUF + kch0 * 1024 + krow0 * 16) = kst0; if (k2) *(ATT_LAS bf16x8*)(Kl + (b) * KBUF + (8 + kch0) * 1024 + krow0 * 16) = kst1; \
    *(ATT_LAS bf16x8*)(Vl + (b) * VBUF + vst) = vstr; } while (0)
  float m_reg = -1e30f, l_reg = 0.f; f32x16 o[2]; o[0] = f32x16{}; o[1] = f32x16{};
  ATT_SLOAD(0); ATT_SWRITE(0); __syncthreads();
  for (int t = 0; t < NT; ++t) {
    const int buf = t & 1;
    if (t + 1 < NT) ATT_SLOAD(t + 1);
    if (!u.skip(t, wid)) {
      f32x16 p0 = f32x16{}, p1 = f32x16{};
      { const lchar* kb = Kl + buf * KBUF + hi * 1024 + r32 * 16;
#pragma unroll
        for (int d0 = 0; d0 < DKC / 2; ++d0) {
          const bf16x8 b0 = *(const ATT_LAS bf16x8*)(kb + d0 * 2048);
          const bf16x8 b1 = *(const ATT_LAS bf16x8*)(kb + d0 * 2048 + 512);
          p0 = __builtin_amdgcn_mfma_f32_32x32x16_bf16(b0, qr[d0], p0, 0, 0, 0);
          p1 = __builtin_amdgcn_mfma_f32_32x32x16_bf16(b1, qr[d0], p1, 0, 0, 0); } }
      u.mask(p0, p1, t, wid, r32, hi);
      float pmax = p0[0];
#pragma unroll
      for (int r = 1; r < 16; ++r) pmax = fmaxf(pmax, p0[r]);
#pragma unroll
      for (int r = 0; r < 16; ++r) pmax = fmaxf(pmax, p1[r]);
      { auto rr = __builtin_amdgcn_permlane32_swap(__float_as_uint(pmax), __float_as_uint(pmax), false, false);
        pmax = fmaxf(__uint_as_float(rr[0]), __uint_as_float(rr[1])); }
      const float mn = fmaxf(m_reg, pmax);
      const float alpha = __builtin_amdgcn_exp2f(m_reg - mn);
      m_reg = mn;
#pragma unroll
      for (int r = 0; r < 16; ++r) { p0[r] = __builtin_amdgcn_exp2f(p0[r] - mn); p1[r] = __builtin_amdgcn_exp2f(p1[r] - mn); }
      float ps = 0.f;
#pragma unroll
      for (int r = 0; r < 16; ++r) ps += p0[r];
#pragma unroll
      for (int r = 0; r < 16; ++r) ps += p1[r];
      { auto rr = __builtin_amdgcn_permlane32_swap(__float_as_uint(ps), __float_as_uint(ps), false, false);
        ps = __uint_as_float(rr[0]) + __uint_as_float(rr[1]); }
      l_reg = l_reg * alpha + ps;
      if (__any(alpha < 1.f)) {
        if (hi == 0) ws[r32] = alpha;
        asm volatile("s_waitcnt lgkmcnt(0)" ::: "memory");
#pragma unroll
        for (int r = 0; r < 16; ++r) { const float a = ws[crow(r, hi)]; o[0][r] *= a; o[1][r] *= a; }
      }
      bf16x8 pa0, pa1, pa2, pa3;
#define ATT_PK4(P, BASE, OUT) do { unsigned a0 = cvtpk(P[BASE + 0], P[BASE + 1]), a1 = cvtpk(P[BASE + 2], P[BASE + 3]);   \
    unsigned b0 = cvtpk(P[BASE + 4], P[BASE + 5]), b1 = cvtpk(P[BASE + 6], P[BASE + 7]);                              \
    auto r0 = __builtin_amdgcn_permlane32_swap(a0, b0, false, false); auto r1 = __builtin_amdgcn_permlane32_swap(a1, b1, false, false); \
    u32x4 w = {r0[0], r1[0], r0[1], r1[1]}; OUT = __builtin_bit_cast(bf16x8, w); } while (0)
      ATT_PK4(p0, 0, pa0); ATT_PK4(p0, 8, pa1); ATT_PK4(p1, 0, pa2); ATT_PK4(p1, 8, pa3);
#undef ATT_PK4
      const unsigned vb = vb0 + (unsigned)(buf * VBUF);
      pv_one<0>(o[0], vb, pa0, pa1, pa2, pa3); pv_one<1>(o[1], vb, pa0, pa1, pa2, pa3);
    }
    if (t + 1 < NT) ATT_SWRITE(buf ^ 1);
    __syncthreads();
  }
#undef ATT_SLOAD
#undef ATT_SWRITE
  { const float sk = u.sink(wid); l_reg += __builtin_amdgcn_exp2f(sk - m_reg); }
  if (hi == 0) ws[r32] = l_reg;
  asm volatile("s_waitcnt lgkmcnt(0)" ::: "memory");
  float rli[16];
#pragma unroll
  for (int r = 0; r < 16; ++r) rli[r] = __builtin_amdgcn_rcpf(ws[crow(r, hi)]);
#pragma unroll
  for (int r = 0; r < 16; ++r) { bf16* op = u.orow(wid, crow(r, hi));
    op[r32] = (bf16)(cvtpk(o[0][r] * rli[r], 0.f) & 0xffffu); op[32 + r32] = (bf16)(cvtpk(o[1][r] * rli[r], 0.f) & 0xffffu); }
  asm volatile("s_waitcnt lgkmcnt(0)" ::: "memory");
}

constexpr int ROWS_LAT = 16384;
struct UWin {
  const bf16* QKV; bf16* O; const float* sinkp; int b, n, g, hh; int i0, cnt;
  __device__ __forceinline__ void init() { i0 = (n == 0) ? 2 : 0; cnt = (n == 0 || n == 63) ? 4 : 6; }
  __device__ __forceinline__ int nt() const { return 4 + cnt; }
  __device__ __forceinline__ int kpos0(int t) const { return 128 * (n - 1) + 64 * (i0 + t - 4); }
  __device__ __forceinline__ long krow(int t) const { return t < 4 ? (long)(ROWS_LAT + 256 * b + 64 * t) : (long)(8192 * b + kpos0(t)); }
  __device__ __forceinline__ const bf16* kptr(long row, int ch) const { return QKV + row * 2304 + 512 + 64 * g + ch * 8; }
  __device__ __forceinline__ const bf16* vptr(long row, int ch) const { return QKV + row * 2304 + 640 + 64 * g + ch * 8; }
  __device__ __forceinline__ int head(int wid) const { return 4 * g + 2 * hh + (wid >> 2); }
  __device__ __forceinline__ int qpos0(int wid) const { return 128 * n + 32 * (wid & 3); }
  __device__ __forceinline__ const bf16* qptr(int wid, int r32, int d0, int hi) const { return QKV + (long)(8192 * b + qpos0(wid) + r32) * 2304 + 64 * head(wid) + 16 * d0 + 8 * hi; }
  __device__ __forceinline__ bool skip(int t, int wid) const { if (t < 4) return false; const int k0 = kpos0(t), q0 = qpos0(wid); return (k0 + 63 < q0 - 128) || (k0 > q0 + 31 + 128); }
  __device__ __forceinline__ void mask(f32x16& p0, f32x16& p1, int t, int wid, int r32, int hi) const {
    if (t < 4) return;
    const int dq = kpos0(t) - (qpos0(wid) + r32);
#pragma unroll
    for (int r = 0; r < 16; ++r) { const int d = dq + crow(r, hi); if (d > 128 || d < -128) p0[r] = -INFINITY; if (d + 32 > 128 || d + 32 < -128) p1[r] = -INFINITY; }
  }
  __device__ __forceinline__ float sink(int wid) const { return sinkp[head(wid)] * LOG2E; }
  __device__ __forceinline__ bf16* orow(int wid, int row) const { return O + (long)(8192 * b + qpos0(wid) + row) * 1024 + 64 * head(wid); }
};
struct UNa {
  const bf16* QKV; bf16* O; const ATT_LAS float* rpbl; int b, h, R4; int krlo, nloc;
  __device__ __forceinline__ static int clampi(int v, int lo, int hi_) { return v < lo ? lo : (v > hi_ ? hi_ : v); }
  __device__ __forceinline__ void init() { krlo = clampi(4 * R4 - 4, 0, 120); const int krhi = clampi(4 * R4 - 1, 0, 120) + 7; nloc = krhi - krlo + 1; }
  __device__ __forceinline__ int nt() const { return 4 + nloc; }
  __device__ __forceinline__ long krow(int t) const { return t < 4 ? (long)(ROWS_LAT + 256 * b + 64 * t) : (long)(8192 * b + 64 * (krlo + t - 4)); }
  __device__ __forceinline__ const bf16* kptr(long row, int ch) const { return QKV + row * 2304 + 1280 + 64 * h + ch * 8; }
  __device__ __forceinline__ const bf16* vptr(long row, int ch) const { return QKV + row * 2304 + 1792 + 64 * h + ch * 8; }
  __device__ __forceinline__ int qrow(int wid) const { return 4 * R4 + (wid >> 1); }
  __device__ __forceinline__ const bf16* qptr(int wid, int r32, int d0, int hi) const { return QKV + (long)(8192 * b + 64 * qrow(wid) + 32 * (wid & 1) + r32) * 2304 + 768 + 64 * h + 16 * d0 + 8 * hi; }
  __device__ __forceinline__ bool skip(int t, int wid) const { if (t < 4) return false; const int kr = krlo + t - 4, w0 = clampi(qrow(wid) - 4, 0, 120); return kr < w0 || kr > w0 + 7; }
  __device__ __forceinline__ void mask(f32x16& p0, f32x16& p1, int t, int wid, int r32, int hi) const {
    if (t < 4) return;
    const int kr = krlo + t - 4, qc = 32 * (wid & 1) + r32, c0 = clampi(qc - 8, 0, 48);
    const ATT_LAS float* brow = rpbl + (kr - qrow(wid) + 7) * 31 + 15;
#pragma unroll
    for (int r = 0; r < 16; ++r) {
      { const int kc = crow(r, hi); const bool ok = kc >= c0 && kc < c0 + 16; const float bv = brow[clampi(kc - qc, -15, 15)]; p0[r] = ok ? p0[r] + bv : -INFINITY; }
      { const int kc = 32 + crow(r, hi); const bool ok = kc >= c0 && kc < c0 + 16; const float bv = brow[clampi(kc - qc, -15, 15)]; p1[r] = ok ? p1[r] + bv : -INFINITY; } }
  }
  __device__ __forceinline__ float sink(int) const { return -INFINITY; }
  __device__ __forceinline__ bf16* orow(int wid, int row) const { return O + (long)(8192 * b + 64 * qrow(wid) + 32 * (wid & 1) + row) * 1024 + 512 + 64 * h; }
};
struct UCtx {
  const bf16* QKV; bf16* O; const float* sinkp; int b, hx; int qcol, kcol, vcol, ocol;
  __device__ __forceinline__ void init() { if (hx < 8) { qcol = 64 * hx; kcol = 512 + 64 * (hx >> 2); vcol = 640 + 64 * (hx >> 2); ocol = 64 * hx; }
    else { const int h = hx - 8; qcol = 768 + 64 * h; kcol = 1280 + 64 * h; vcol = 1792 + 64 * h; ocol = 512 + 64 * h; } }
  __device__ __forceinline__ int nt() const { return 4; }
  __device__ __forceinline__ long krow(int t) const { return (long)(ROWS_LAT + 256 * b + 64 * t); }
  __device__ __forceinline__ const bf16* kptr(long row, int ch) const { return QKV + row * 2304 + kcol + ch * 8; }
  __device__ __forceinline__ const bf16* vptr(long row, int ch) const { return QKV + row * 2304 + vcol + ch * 8; }
  __device__ __forceinline__ const bf16* qptr(int wid, int r32, int d0, int hi) const { return QKV + (long)(ROWS_LAT + 256 * b + 32 * wid + r32) * 2304 + qcol + 16 * d0 + 8 * hi; }
  __device__ __forceinline__ bool skip(int, int) const { return false; }
  __device__ __forceinline__ void mask(f32x16&, f32x16&, int, int, int, int) const {}
  __device__ __forceinline__ float sink(int) const { return hx < 8 ? sinkp[hx] * LOG2E : -INFINITY; }
  __device__ __forceinline__ bf16* orow(int wid, int row) const { return O + (long)(ROWS_LAT + 256 * b + 32 * wid + row) * 1024 + ocol; }
};
struct UDense {
  const bf16* Q; const bf16* KV; const bf16* KR; bf16* O; int b, h, qb;
  __device__ __forceinline__ int nt() const { return 132; }
  __device__ __forceinline__ long krow(int t) const { return t < 4 ? (long)(ROWS_LAT + 256 * b + 64 * t) : (long)(8192 * b + 64 * (t - 4)); }
  __device__ __forceinline__ const bf16* kptr(long row, int ch) const { return ch < 8 ? KV + row * 2048 + 64 * h + ch * 8 : KR + row * 32 + (ch - 8) * 8; }
  __device__ __forceinline__ const bf16* vptr(long row, int ch) const { return KV + row * 2048 + 1024 + 64 * h + ch * 8; }
  __device__ __forceinline__ const bf16* qptr(int wid, int r32, int d0, int hi) const { const bf16* qp = Q + (long)(8192 * b + 256 * qb + 32 * wid + r32) * 1536;
    return d0 < 4 ? qp + 64 * h + 16 * d0 + 8 * hi : qp + 1024 + 32 * h + 16 * (d0 - 4) + 8 * hi; }
  __device__ __forceinline__ bool skip(int, int) const { return false; }
  __device__ __forceinline__ void mask(f32x16&, f32x16&, int, int, int, int) const {}
  __device__ __forceinline__ float sink(int) const { return -INFINITY; }
  __device__ __forceinline__ bf16* orow(int wid, int row) const { return O + (long)(8192 * b + 256 * qb + 32 * wid + row) * 1024 + 64 * h; }
};
#undef ATT_SBAR
}
namespace attd {
typedef unsigned short bf16;
using bf16x8 = __attribute__((ext_vector_type(8))) short;
using s16x4 = __attribute__((ext_vector_type(4))) short;
using f32x16 = __attribute__((ext_vector_type(16))) float;
using u32x4 = __attribute__((ext_vector_type(4))) unsigned;
constexpr int NW = 8, NT = 132, KSLOT = 12288, VSLOT = 8192;
constexpr int LDS_K = 0, LDS_V = 3 * KSLOT, LDS_WS = LDS_V + 3 * VSLOT, LDS_OST = LDS_WS + NW * 64 * 4, LDS_BYTES = LDS_OST + NW * 4096;
__device__ __forceinline__ int crow(int r, int hi) { return (r & 3) + 8 * (r >> 2) + 4 * hi; }
#define AF_SBAR() __builtin_amdgcn_sched_barrier(0)
__device__ __forceinline__ void glds16(const void* gsrc, unsigned lds_dst) { unsigned keep;
  asm volatile("s_mov_b32 %0, m0\n\ts_mov_b32 m0, %2\n\ts_nop 0\n\tglobal_load_lds_dwordx4 %1, off\n\ts_mov_b32 m0, %0" : "=&s"(keep) : "v"(gsrc), "s"(lds_dst) : "memory"); }
typedef float f32x2_t __attribute__((ext_vector_type(2))); typedef __bf16 bf16x2_t __attribute__((ext_vector_type(2)));
__device__ __forceinline__ unsigned cvtpk_s(float lo, float hi) { f32x2_t v = {lo, hi}; bf16x2_t b = __builtin_convertvector(v, bf16x2_t); return __builtin_bit_cast(unsigned, b); }
#define AF_WAIT_BAR(N) asm volatile("s_waitcnt vmcnt(" #N ") lgkmcnt(0)\n\ts_barrier" ::: "memory")
typedef __attribute__((address_space(3))) const char* lds_cptr;
typedef short v4i16_t __attribute__((ext_vector_type(4)));
__device__ __forceinline__ void kload2(bf16x8* kf, lds_cptr kp, int j) { kf[2 * j] = *(const __attribute__((address_space(3))) bf16x8*)(kp + j * 2048); kf[2 * j + 1] = *(const __attribute__((address_space(3))) bf16x8*)(kp + j * 2048 + 512); }
__device__ __forceinline__ s16x4 vtr(lds_cptr p) { return __builtin_bit_cast(s16x4, __builtin_amdgcn_ds_read_tr16_b64_v4i16((__attribute__((address_space(3))) v4i16_t*)p)); }
__device__ __forceinline__ long tile_row(int b, int t) { return t < 4 ? (long)(16384 + 256 * b + 64 * t) : (long)(8192 * b + 64 * (t - 4)); }

__device__ __forceinline__ void dense_unit(int b, int h, int qb, const bf16* Q, const bf16* __restrict__ KV, const bf16* __restrict__ KR, bf16* O, char* shm, const int tid) {
  const int lane = tid & 63, r32 = lane & 31, hi = lane >> 5; const int wid = __builtin_amdgcn_readfirstlane(tid >> 6);
  const unsigned lds0 = (unsigned)(uintptr_t)shm;
  float* wsf = (float*)(shm + LDS_WS) + wid * 64;
  const bf16* ksrcA = KV + (long)lane * 2048 + 64 * h + 8 * wid;
  const bf16* ksrcB = KR + (long)lane * 32 + 8 * (wid & 3);
  const bf16* vsrc = KV + (long)(16 * (wid & 3) + (lane >> 2)) * 2048 + 1024 + 64 * h + (wid >> 2) * 32 + (lane & 3) * 8;
  const unsigned kdstA = lds0 + LDS_K + wid * 1024, kdstB = lds0 + LDS_K + (8 + (wid & 3)) * 1024, vdst = lds0 + LDS_V + wid * 1024;
#define AF_DMA_K(t, ks) do { const long R_ = tile_row(b, (t)); glds16(ksrcA + R_ * 2048, (unsigned)__builtin_amdgcn_readfirstlane(kdstA + (ks))); glds16(ksrcB + R_ * 32, (unsigned)__builtin_amdgcn_readfirstlane(kdstB + (ks))); } while (0)
#define AF_DMA_V(t, vs) do { const long R_ = tile_row(b, (t)); glds16(vsrc + R_ * 2048, (unsigned)__builtin_amdgcn_readfirstlane(vdst + (vs))); } while (0)
  const lds_cptr shm3 = (lds_cptr)shm; const lds_cptr kp0 = shm3 + LDS_K + hi * 1024 + r32 * 16;
  const lds_cptr vp0 = shm3 + LDS_V + ((lane >> 4) & 1) * 32 + (lane & 3) * 8 + (4 * hi + ((lane & 15) >> 2)) * 64;
  bf16x8 qr[6];
  { const bf16* qp = Q + (long)(8192 * b + 256 * qb + 32 * wid + r32) * 1536;
#pragma unroll
    for (int d0 = 0; d0 < 4; ++d0) qr[d0] = *reinterpret_cast<const bf16x8*>(qp + 64 * h + 16 * d0 + 8 * hi);
#pragma unroll
    for (int d0 = 0; d0 < 2; ++d0) qr[4 + d0] = *reinterpret_cast<const bf16x8*>(qp + 1024 + 32 * h + 16 * d0 + 8 * hi); }
  AF_DMA_K(0, 0); AF_DMA_V(0, 0); AF_DMA_K(1, KSLOT); AF_DMA_K(2, 2 * KSLOT);
  float l_reg = 0.f; f32x16 o[2]; o[0] = f32x16{}; o[1] = f32x16{};
  f32x16 pA0, pA1, pB0, pB1; bf16x8 kf[12];
  int s_prev = 0, s_cur = 0, s_next = 1;
#define AF_ROT() do { s_prev = s_cur; s_cur = s_next; s_next = (s_next == 2) ? 0 : s_next + 1; } while (0)
  AF_WAIT_BAR(5);
  { const char* kb = shm + LDS_K + hi * 1024 + r32 * 16; pA0 = f32x16{}; pA1 = f32x16{};
#pragma unroll
    for (int d0 = 0; d0 < 6; ++d0) { const bf16x8 b0 = *reinterpret_cast<const bf16x8*>(kb + d0 * 2048), b1 = *reinterpret_cast<const bf16x8*>(kb + d0 * 2048 + 512);
      pA0 = __builtin_amdgcn_mfma_f32_32x32x16_bf16(b0, qr[d0], pA0, 0, 0, 0); pA1 = __builtin_amdgcn_mfma_f32_32x32x16_bf16(b1, qr[d0], pA1, 0, 0, 0); }
#pragma unroll
    for (int r = 0; r < 16; ++r) { pA0[r] = __builtin_amdgcn_exp2f(pA0[r]); pA1[r] = __builtin_amdgcn_exp2f(pA1[r]); } }
  AF_WAIT_BAR(0);
  AF_DMA_K(3, 0); AF_DMA_V(1, VSLOT);
  AF_ROT();
#pragma unroll
  for (int j = 0; j < 6; ++j) kload2(kf, kp0 + s_cur * KSLOT, j);
  AF_WAIT_BAR(3);
  s16x4 vlo[8], vhi[8]; u32x4 pw0, pw1, pw2, pw3;
#define AF_PKW(P, B) cvtpk_s(P[B], P[B + 1])
#define AF_PAF(k) __builtin_bit_cast(bf16x8, pw##k)
#define AF_VFR(i) (bf16x8){vlo[i][0], vlo[i][1], vlo[i][2], vlo[i][3], vhi[i][0], vhi[i][1], vhi[i][2], vhi[i][3]}
#define AF_PIN(x) asm volatile("" : "+v"(x))
#define AF_MF(a, b, c) __builtin_amdgcn_mfma_f32_32x32x16_bf16(a, b, c, 0, 0, 0)
#define AF_EX(v) __builtin_amdgcn_exp2f(v)
#define AF_VRD(i) do { vlo[i] = vtr(vp_ + (((i) >> 2) * 4096 + ((i) & 3) * 1024)); vhi[i] = vtr(vp_ + (((i) >> 2) * 4096 + ((i) & 3) * 1024 + 512)); AF_SBAR(); } while (0)
#define AF_GA3(MF, A0, A1, A2, W0, W1, PW) do { MF; sacc += A0; sacc += A1; sacc += A2; AF_PIN(sacc); W0; W1; AF_PIN(PW); AF_SBAR(); } while (0)
#define AF_GA2(MF, A0, A1, W0, PW) do { MF; sacc += A0; sacc += A1; AF_PIN(sacc); W0; AF_PIN(PW); AF_SBAR(); } while (0)
#define AF_GB(MF, X, B) do { MF; X[B] = AF_EX(X[B]); X[B + 1] = AF_EX(X[B + 1]); X[B + 2] = AF_EX(X[B + 2]); X[B + 3] = AF_EX(X[B + 3]); AF_PIN(X); AF_SBAR(); } while (0)
#define AF_KRD(G, j) do { if (G) { kload2(kf, kp0 + s_next * KSLOT, j); AF_SBAR(); } } while (0)
  const f32x16 zero16 = f32x16{};
#define AF_STEP(C0, C1, P0, P1, t, GK, GV, GL) do { AF_SBAR(); \
    const lds_cptr vp_ = vp0 + s_prev * VSLOT; \
    AF_VRD(0); float sacc = (P0[0] + P0[1]); \
    AF_GA3(C0 = AF_MF(kf[0], qr[0], zero16), P0[2], P0[3], P0[4],     pw0[0] = AF_PKW(P0, 0), pw0[1] = AF_PKW(P0, 2), pw0); \
    AF_VRD(4); AF_GA3(C1 = AF_MF(kf[1], qr[0], zero16), P0[5], P0[6], P0[7],     pw0[2] = AF_PKW(P0, 4), pw0[3] = AF_PKW(P0, 6), pw0); \
    AF_VRD(1); AF_GA3(C0 = AF_MF(kf[2], qr[1], C0),     P0[8], P0[9], P0[10],    pw1[0] = AF_PKW(P0, 8), pw1[1] = AF_PKW(P0, 10), pw1); \
    AF_VRD(5); AF_GA3(C1 = AF_MF(kf[3], qr[1], C1),     P0[11], P0[12], P0[13],  pw1[2] = AF_PKW(P0, 12), pw1[3] = AF_PKW(P0, 14), pw1); \
    AF_VRD(2); AF_GA3(C0 = AF_MF(kf[4], qr[2], C0),     P0[14], P0[15], P1[0],   pw2[0] = AF_PKW(P1, 0), pw2[1] = AF_PKW(P1, 2), pw2); \
    AF_VRD(6); AF_GA3(C1 = AF_MF(kf[5], qr[2], C1),     P1[1], P1[2], P1[3],     pw2[2] = AF_PKW(P1, 4), pw2[3] = AF_PKW(P1, 6), pw2); \
    AF_VRD(3); AF_GA2(C0 = AF_MF(kf[6], qr[3], C0),     P1[4], P1[5],            pw3[0] = AF_PKW(P1, 8), pw3); \
    AF_VRD(7); AF_GA2(C1 = AF_MF(kf[7], qr[3], C1),     P1[6], P1[7],            pw3[1] = AF_PKW(P1, 10), pw3); \
    AF_GA2(C0 = AF_MF(kf[8], qr[4], C0),                P1[8], P1[9],            pw3[2] = AF_PKW(P1, 12), pw3); \
    if (GK) { const long R_ = tile_row(b, (t) + 3); glds16(ksrcA + R_ * 2048, (unsigned)__builtin_amdgcn_readfirstlane(kdstA + s_cur * KSLOT)); AF_SBAR(); } \
    AF_GA2(C1 = AF_MF(kf[9], qr[4], C1),                P1[10], P1[11],          pw3[3] = AF_PKW(P1, 14), pw3); \
    if (GK) { const long R_ = tile_row(b, (t) + 3); glds16(ksrcB + R_ * 32, (unsigned)__builtin_amdgcn_readfirstlane(kdstB + s_cur * KSLOT)); AF_SBAR(); } \
    { C0 = AF_MF(kf[10], qr[5], C0); sacc += P1[12]; sacc += P1[13]; AF_PIN(sacc); AF_SBAR(); } \
    if (GV) { AF_DMA_V((t) + 1, s_next * VSLOT); AF_SBAR(); } \
    { C1 = AF_MF(kf[11], qr[5], C1); sacc += P1[14]; sacc += P1[15]; AF_PIN(sacc); AF_SBAR(); } \
    l_reg += sacc; \
    AF_SBAR(); \
    AF_GB(o[0] = AF_MF(AF_PAF(0), AF_VFR(0), o[0]), C0, 0);  AF_KRD(GL, 0); \
    AF_GB(o[1] = AF_MF(AF_PAF(0), AF_VFR(4), o[1]), C0, 4);  AF_KRD(GL, 1); \
    AF_GB(o[0] = AF_MF(AF_PAF(1), AF_VFR(1), o[0]), C0, 8);  AF_KRD(GL, 2); \
    AF_GB(o[1] = AF_MF(AF_PAF(1), AF_VFR(5), o[1]), C0, 12); AF_KRD(GL, 3); \
    AF_GB(o[0] = AF_MF(AF_PAF(2), AF_VFR(2), o[0]), C1, 0);  AF_KRD(GL, 4); \
    AF_GB(o[1] = AF_MF(AF_PAF(2), AF_VFR(6), o[1]), C1, 4);  AF_KRD(GL, 5); \
    AF_GB(o[0] = AF_MF(AF_PAF(3), AF_VFR(3), o[0]), C1, 8); \
    AF_GB(o[1] = AF_MF(AF_PAF(3), AF_VFR(7), o[1]), C1, 12); \
  } while (0)
  int t = 1;
  for (; t + 3 < NT; t += 2) {
    AF_STEP(pB0, pB1, pA0, pA1, t, true, true, true);     AF_WAIT_BAR(3); AF_ROT();
    AF_STEP(pA0, pA1, pB0, pB1, t + 1, true, true, true); AF_WAIT_BAR(3); AF_ROT();
  }
  AF_STEP(pB0, pB1, pA0, pA1, NT - 3, false, true, true);  AF_WAIT_BAR(1); AF_ROT();
  AF_STEP(pA0, pA1, pB0, pB1, NT - 2, false, true, true);  AF_WAIT_BAR(0); AF_ROT();
  AF_STEP(pB0, pB1, pA0, pA1, NT - 1, false, false, false);
  { float sacc = pB0[0] + pB0[1];
#pragma unroll
    for (int r = 2; r < 16; ++r) sacc += pB0[r];
#pragma unroll
    for (int r = 0; r < 16; ++r) sacc += pB1[r];
    l_reg += sacc;
    pw0 = (u32x4){AF_PKW(pB0, 0), AF_PKW(pB0, 2), AF_PKW(pB0, 4), AF_PKW(pB0, 6)}; pw1 = (u32x4){AF_PKW(pB0, 8), AF_PKW(pB0, 10), AF_PKW(pB0, 12), AF_PKW(pB0, 14)};
    pw2 = (u32x4){AF_PKW(pB1, 0), AF_PKW(pB1, 2), AF_PKW(pB1, 4), AF_PKW(pB1, 6)}; pw3 = (u32x4){AF_PKW(pB1, 8), AF_PKW(pB1, 10), AF_PKW(pB1, 12), AF_PKW(pB1, 14)};
    AF_SBAR();
    const lds_cptr vp_ = vp0 + s_cur * VSLOT;
#pragma unroll
    for (int i = 0; i < 8; ++i) { vlo[i] = vtr(vp_ + ((i >> 2) * 4096 + (i & 3) * 1024)); vhi[i] = vtr(vp_ + ((i >> 2) * 4096 + (i & 3) * 1024 + 512)); }
    o[0] = AF_MF(AF_PAF(0), AF_VFR(0), o[0]); o[1] = AF_MF(AF_PAF(0), AF_VFR(4), o[1]);
    o[0] = AF_MF(AF_PAF(1), AF_VFR(1), o[0]); o[1] = AF_MF(AF_PAF(1), AF_VFR(5), o[1]);
    o[0] = AF_MF(AF_PAF(2), AF_VFR(2), o[0]); o[1] = AF_MF(AF_PAF(2), AF_VFR(6), o[1]);
    o[0] = AF_MF(AF_PAF(3), AF_VFR(3), o[0]); o[1] = AF_MF(AF_PAF(3), AF_VFR(7), o[1]); }
  { auto rr = __builtin_amdgcn_permlane32_swap(__float_as_uint(l_reg), __float_as_uint(l_reg), false, false); l_reg = __uint_as_float(rr[0]) + __uint_as_float(rr[1]); }
  if (hi == 0) wsf[32 + r32] = l_reg; asm volatile("s_waitcnt lgkmcnt(0)" ::: "memory");
  float rli[16];
#pragma unroll
  for (int r = 0; r < 16; ++r) rli[r] = __builtin_amdgcn_rcpf(wsf[32 + crow(r, hi)]);
  bf16* Ow = O + (long)(8192 * b + 256 * qb + 32 * wid) * 1024 + 64 * h;
  { bf16* stg = (bf16*)(shm + LDS_OST) + wid * 2048;
#pragma unroll
    for (int r = 0; r < 16; ++r) { const int orow = crow(r, hi);
#pragma unroll
      for (int d0 = 0; d0 < 2; ++d0) stg[orow * 64 + d0 * 32 + r32] = (bf16)(cvtpk_s(o[d0][r] * rli[r], 0.f) & 0xffffu); }
    asm volatile("s_waitcnt lgkmcnt(0)" ::: "memory");
#pragma unroll
    for (int i = 0; i < 4; ++i) { const int row = i * 8 + (lane >> 3), ch = lane & 7; const u32x4 v = *(const u32x4*)(stg + row * 64 + ch * 8); *(u32x4*)(Ow + (long)row * 1024 + ch * 8) = v; } }
  asm volatile("s_waitcnt vmcnt(0) lgkmcnt(0)\n\ts_barrier" ::: "memory");
#undef AF_DMA_K
#undef AF_DMA_V
#undef AF_ROT
#undef AF_PKW
#undef AF_PAF
#undef AF_VFR
#undef AF_PIN
#undef AF_MF
#undef AF_EX
#undef AF_VRD
#undef AF_GA3
#undef AF_GA2
#undef AF_GB
#undef AF_KRD
#undef AF_STEP
}
#undef AF_SBAR
#undef AF_WAIT_BAR
}
namespace attf {
typedef unsigned short bf16;
using bf16x8 = __attribute__((ext_vector_type(8))) short;
using s16x4 = __attribute__((ext_vector_type(4))) short;
using f32x16 = __attribute__((ext_vector_type(16))) float;
using u32x4 = __attribute__((ext_vector_type(4))) unsigned;
constexpr int NW = 8, KSLOT = 12288, VSLOT = 8192;
constexpr int LDS_K = 0, LDS_V = 3 * KSLOT, LDS_WS = LDS_V + 3 * VSLOT, LDS_OST = LDS_WS + NW * 64 * 4, LDS_RPB = LDS_OST + NW * 4096, LDS_BYTES = LDS_RPB + 2048;
__device__ __forceinline__ int crow(int r, int hi) { return (r & 3) + 8 * (r >> 2) + 4 * hi; }
#define AF_SBAR() __builtin_amdgcn_sched_barrier(0)
__device__ __forceinline__ void glds16(const void* gsrc, unsigned lds_dst) { unsigned keep;
  asm volatile("s_mov_b32 %0, m0\n\ts_mov_b32 m0, %2\n\ts_nop 0\n\tglobal_load_lds_dwordx4 %1, off\n\ts_mov_b32 m0, %0" : "=&s"(keep) : "v"(gsrc), "s"(lds_dst) : "memory"); }
typedef float f32x2_t __attribute__((ext_vector_type(2))); typedef __bf16 bf16x2_t __attribute__((ext_vector_type(2)));
__device__ __forceinline__ unsigned cvtpk_s(float lo, float hi) { f32x2_t v = {lo, hi}; bf16x2_t b = __builtin_convertvector(v, bf16x2_t); return __builtin_bit_cast(unsigned, b); }
#define AF_WAIT_BAR(N) asm volatile("s_waitcnt vmcnt(" #N ") lgkmcnt(0)\n\ts_barrier" ::: "memory")
typedef __attribute__((address_space(3))) const char* lds_cptr;
typedef short v4i16_t __attribute__((ext_vector_type(4)));
__device__ __forceinline__ void kload2(bf16x8* kf, lds_cptr kp, int j) { kf[2 * j] = *(const __attribute__((address_space(3))) bf16x8*)(kp + j * 2048); kf[2 * j + 1] = *(const __attribute__((address_space(3))) bf16x8*)(kp + j * 2048 + 512); }
__device__ __forceinline__ s16x4 vtr(lds_cptr p) { return __builtin_bit_cast(s16x4, __builtin_amdgcn_ds_read_tr16_b64_v4i16((__attribute__((address_space(3))) v4i16_t*)p)); }

template <int DKC, class U>
__device__ __forceinline__ void fast_unit(const U& u, char* shm, int tid) {
  static_assert(DKC == 8 || DKC == 12, "q/k dim 64 or 96");
  asm volatile("" : "+v"(tid));
  constexpr int ND0 = DKC / 2;
  const int lane = tid & 63, r32 = lane & 31, hi = lane >> 5; const int wid = __builtin_amdgcn_readfirstlane(tid >> 6);
  const unsigned lds0 = (unsigned)(uintptr_t)shm;
  float* wsf = (float*)(shm + LDS_WS) + wid * 64;
  const int NT = u.nt();
  const bf16* ksrcA = u.kbase + (long)lane * u.kpitch + 8 * wid;
  const bf16* ksrcB = DKC == 12 ? u.krbase + (long)lane * 32 + 8 * (wid & 3) : nullptr;
  const bf16* vsrc = u.vbase + (long)(16 * (wid & 3) + (lane >> 2)) * u.vpitch + (wid >> 2) * 32 + (lane & 3) * 8;
  const unsigned kdstA = lds0 + LDS_K + wid * 1024, kdstB = lds0 + LDS_K + (8 + (wid & 3)) * 1024, vdst = lds0 + LDS_V + wid * 1024;
#define AF_DMA_KA(t, ks) do { const long R_ = u.trow(t); glds16(ksrcA + R_ * u.kpitch, (unsigned)__builtin_amdgcn_readfirstlane(kdstA + (ks))); } while (0)
#define AF_DMA_KB(t, ks) do { if constexpr (DKC == 12) { const long R_ = u.trow(t); glds16(ksrcB + R_ * 32, (unsigned)__builtin_amdgcn_readfirstlane(kdstB + (ks))); } } while (0)
#define AF_DMA_K(t, ks) do { AF_DMA_KA(t, ks); AF_DMA_KB(t, ks); } while (0)
#define AF_DMA_V(t, vs) do { const long R_ = u.trow(t); glds16(vsrc + R_ * u.vpitch, (unsigned)__builtin_amdgcn_readfirstlane(vdst + (vs))); } while (0)
#define AF_WAITN(NSTEPS_K, NV) do { if constexpr (DKC == 12) { if ((NSTEPS_K) == 2 && (NV) == 1) AF_WAIT_BAR(5); else if ((NSTEPS_K) == 1 && (NV) == 1) AF_WAIT_BAR(3); else if ((NV) == 1) AF_WAIT_BAR(1); else AF_WAIT_BAR(0); } \
    else { if ((NSTEPS_K) == 2 && (NV) == 1) AF_WAIT_BAR(3); else if ((NSTEPS_K) == 1 && (NV) == 1) AF_WAIT_BAR(2); else if ((NV) == 1) AF_WAIT_BAR(1); else AF_WAIT_BAR(0); } } while (0)
  const lds_cptr shm3 = (lds_cptr)shm; const lds_cptr kp0 = shm3 + LDS_K + hi * 1024 + r32 * 16;
  const lds_cptr vp0 = shm3 + LDS_V + ((lane >> 4) & 1) * 32 + (lane & 3) * 8 + (4 * hi + ((lane & 15) >> 2)) * 64;
  bf16x8 qr[ND0];
#pragma unroll
  for (int d0 = 0; d0 < ND0; ++d0) qr[d0] = *reinterpret_cast<const bf16x8*>(u.qptr(wid, r32, d0, hi));
  AF_DMA_K(0, 0); AF_DMA_V(0, 0); AF_DMA_K(1, KSLOT); AF_DMA_K(2, 2 * KSLOT);
  float l_reg = 0.f; f32x16 o[2]; o[0] = f32x16{}; o[1] = f32x16{};
  f32x16 pA0, pA1, pB0, pB1; bf16x8 kf[DKC];
  int s_prev = 0, s_cur = 0, s_next = 1;
#define AF_ROT() do { s_prev = s_cur; s_cur = s_next; s_next = (s_next == 2) ? 0 : s_next + 1; } while (0)
  AF_WAITN(2, 1);
  { const char* kb = shm + LDS_K + hi * 1024 + r32 * 16; pA0 = f32x16{}; pA1 = f32x16{};
#pragma unroll
    for (int d0 = 0; d0 < ND0; ++d0) { const bf16x8 b0 = *reinterpret_cast<const bf16x8*>(kb + d0 * 2048), b1 = *reinterpret_cast<const bf16x8*>(kb + d0 * 2048 + 512);
      pA0 = __builtin_amdgcn_mfma_f32_32x32x16_bf16(b0, qr[d0], pA0, 0, 0, 0); pA1 = __builtin_amdgcn_mfma_f32_32x32x16_bf16(b1, qr[d0], pA1, 0, 0, 0); }
    if constexpr (U::HAS_MASK) u.mask(pA0, pA1, 0, wid, r32, hi);
#pragma unroll
    for (int r = 0; r < 16; ++r) { pA0[r] = __builtin_amdgcn_exp2f(pA0[r]); pA1[r] = __builtin_amdgcn_exp2f(pA1[r]); } }
  AF_WAIT_BAR(0);
  AF_DMA_K(3, 0); AF_DMA_V(1, VSLOT);
  AF_ROT();
#pragma unroll
  for (int j = 0; j < ND0; ++j) kload2(kf, kp0 + s_cur * KSLOT, j);
  AF_WAITN(1, 1);
  s16x4 vlo[8], vhi[8]; u32x4 pw0, pw1, pw2, pw3;
#define AF_PKW(P, B) cvtpk_s(P[B], P[B + 1])
#define AF_PAF(k) __builtin_bit_cast(bf16x8, pw##k)
#define AF_VFR(i) (bf16x8){vlo[i][0], vlo[i][1], vlo[i][2], vlo[i][3], vhi[i][0], vhi[i][1], vhi[i][2], vhi[i][3]}
#define AF_PIN(x) asm volatile("" : "+v"(x))
#define AF_MF(a, b, c) __builtin_amdgcn_mfma_f32_32x32x16_bf16(a, b, c, 0, 0, 0)
#define AF_EX(v) __builtin_amdgcn_exp2f(v)
#define AF_VRD(i) do { vlo[i] = vtr(vp_ + (((i) >> 2) * 4096 + ((i) & 3) * 1024)); vhi[i] = vtr(vp_ + (((i) >> 2) * 4096 + ((i) & 3) * 1024 + 512)); AF_SBAR(); } while (0)
#define AF_GA4(MF, A0, A1, A2, A3, W0, W1, PW) do { MF; sacc += A0; sacc += A1; sacc += A2; sacc += A3; AF_PIN(sacc); W0; W1; AF_PIN(PW); AF_SBAR(); } while (0)
#define AF_GA3(MF, A0, A1, A2, W0, W1, PW) do { MF; sacc += A0; sacc += A1; sacc += A2; AF_PIN(sacc); W0; W1; AF_PIN(PW); AF_SBAR(); } while (0)
#define AF_GA2(MF, A0, A1, W0, PW) do { MF; sacc += A0; sacc += A1; AF_PIN(sacc); W0; AF_PIN(PW); AF_SBAR(); } while (0)
#define AF_GB(MF, X, B) do { MF; X[B] = AF_EX(X[B]); X[B + 1] = AF_EX(X[B + 1]); X[B + 2] = AF_EX(X[B + 2]); X[B + 3] = AF_EX(X[B + 3]); AF_PIN(X); AF_SBAR(); } while (0)
#define AF_KRD(G, j) do { if ((j) < ND0) { if (G) { kload2(kf, kp0 + s_next * KSLOT, (j) < ND0 ? (j) : 0); AF_SBAR(); } } } while (0)
  const f32x16 zero16 = f32x16{};
#define AF_PHASE_A12(C0, C1, P0, P1, t, GK, GV) do { \
    AF_VRD(0); float sacc = (P0[0] + P0[1]); \
    AF_GA3(C0 = AF_MF(kf[0], qr[0], zero16), P0[2], P0[3], P0[4],     pw0[0] = AF_PKW(P0, 0), pw0[1] = AF_PKW(P0, 2), pw0); \
    AF_VRD(4); AF_GA3(C1 = AF_MF(kf[1], qr[0], zero16), P0[5], P0[6], P0[7],     pw0[2] = AF_PKW(P0, 4), pw0[3] = AF_PKW(P0, 6), pw0); \
    AF_VRD(1); AF_GA3(C0 = AF_MF(kf[2], qr[1], C0),     P0[8], P0[9], P0[10],    pw1[0] = AF_PKW(P0, 8), pw1[1] = AF_PKW(P0, 10), pw1); \
    AF_VRD(5); AF_GA3(C1 = AF_MF(kf[3], qr[1], C1),     P0[11], P0[12], P0[13],  pw1[2] = AF_PKW(P0, 12), pw1[3] = AF_PKW(P0, 14), pw1); \
    AF_VRD(2); AF_GA3(C0 = AF_MF(kf[4], qr[2], C0),     P0[14], P0[15], P1[0],   pw2[0] = AF_PKW(P1, 0), pw2[1] = AF_PKW(P1, 2), pw2); \
    AF_VRD(6); AF_GA3(C1 = AF_MF(kf[5], qr[2], C1),     P1[1], P1[2], P1[3],     pw2[2] = AF_PKW(P1, 4), pw2[3] = AF_PKW(P1, 6), pw2); \
    AF_VRD(3); AF_GA2(C0 = AF_MF(kf[6], qr[3], C0),     P1[4], P1[5],            pw3[0] = AF_PKW(P1, 8), pw3); \
    AF_VRD(7); AF_GA2(C1 = AF_MF(kf[7], qr[3], C1),     P1[6], P1[7],            pw3[1] = AF_PKW(P1, 10), pw3); \
    AF_GA2(C0 = AF_MF(kf[8 % DKC], qr[4 % ND0], C0),    P1[8], P1[9],            pw3[2] = AF_PKW(P1, 12), pw3); \
    if (GK) { AF_DMA_KA((t) + 3, s_cur * KSLOT); AF_SBAR(); } \
    AF_GA2(C1 = AF_MF(kf[9 % DKC], qr[4 % ND0], C1),    P1[10], P1[11],          pw3[3] = AF_PKW(P1, 14), pw3); \
    if (GK) { AF_DMA_KB((t) + 3, s_cur * KSLOT); AF_SBAR(); } \
    { C0 = AF_MF(kf[10 % DKC], qr[5 % ND0], C0); sacc += P1[12]; sacc += P1[13]; AF_PIN(sacc); AF_SBAR(); } \
    if (GV) { AF_DMA_V((t) + 1, s_next * VSLOT); AF_SBAR(); } \
    { C1 = AF_MF(kf[11 % DKC], qr[5 % ND0], C1); sacc += P1[14]; sacc += P1[15]; AF_PIN(sacc); AF_SBAR(); } \
    l_reg += sacc; } while (0)
#define AF_PHASE_A8(C0, C1, P0, P1, t, GK, GV) do { \
    AF_VRD(0); float sacc = (P0[0] + P0[1]); \
    AF_GA4(C0 = AF_MF(kf[0], qr[0], zero16), P0[2], P0[3], P0[4], P0[5],       pw0[0] = AF_PKW(P0, 0), pw0[1] = AF_PKW(P0, 2), pw0); \
    AF_VRD(4); AF_GA4(C1 = AF_MF(kf[1], qr[0], zero16), P0[6], P0[7], P0[8], P0[9],       pw0[2] = AF_PKW(P0, 4), pw0[3] = AF_PKW(P0, 6), pw0); \
    AF_VRD(1); AF_GA4(C0 = AF_MF(kf[2], qr[1], C0),     P0[10], P0[11], P0[12], P0[13],   pw1[0] = AF_PKW(P0, 8), pw1[1] = AF_PKW(P0, 10), pw1); \
    AF_VRD(5); AF_GA4(C1 = AF_MF(kf[3], qr[1], C1),     P0[14], P0[15], P1[0], P1[1],     pw1[2] = AF_PKW(P0, 12), pw1[3] = AF_PKW(P0, 14), pw1); \
    AF_VRD(2); AF_GA4(C0 = AF_MF(kf[4], qr[2], C0),     P1[2], P1[3], P1[4], P1[5],       pw2[0] = AF_PKW(P1, 0), pw2[1] = AF_PKW(P1, 2), pw2); \
    AF_VRD(6); AF_GA4(C1 = AF_MF(kf[5], qr[2], C1),     P1[6], P1[7], P1[8], P1[9],       pw2[2] = AF_PKW(P1, 4), pw2[3] = AF_PKW(P1, 6), pw2); \
    AF_VRD(3); AF_GA4(C0 = AF_MF(kf[6], qr[3], C0),     P1[10], P1[11], P1[12], P1[13],   pw3[0] = AF_PKW(P1, 8), pw3[1] = AF_PKW(P1, 10), pw3); \
    AF_VRD(7); AF_GA4(C1 = AF_MF(kf[7], qr[3], C1),     P1[14], P1[15], 0.f, 0.f,         pw3[2] = AF_PKW(P1, 12), pw3[3] = AF_PKW(P1, 14), pw3); \
    l_reg += sacc; \
    if (GK) { AF_DMA_KA((t) + 3, s_cur * KSLOT); } if (GV) { AF_DMA_V((t) + 1, s_next * VSLOT); } } while (0)
#define AF_STEP(C0, C1, P0, P1, t, GK, GV, GL) do { AF_SBAR(); \
    const lds_cptr vp_ = vp0 + s_prev * VSLOT; \
    if constexpr (DKC == 12) AF_PHASE_A12(C0, C1, P0, P1, t, GK, GV); else AF_PHASE_A8(C0, C1, P0, P1, t, GK, GV); \
    if constexpr (U::HAS_MASK) u.mask(C0, C1, (t), wid, r32, hi); \
    AF_SBAR(); \
    AF_GB(o[0] = AF_MF(AF_PAF(0), AF_VFR(0), o[0]), C0, 0);  AF_KRD(GL, 0); \
    AF_GB(o[1] = AF_MF(AF_PAF(0), AF_VFR(4), o[1]), C0, 4);  AF_KRD(GL, 1); \
    AF_GB(o[0] = AF_MF(AF_PAF(1), AF_VFR(1), o[0]), C0, 8);  AF_KRD(GL, 2); \
    AF_GB(o[1] = AF_MF(AF_PAF(1), AF_VFR(5), o[1]), C0, 12); AF_KRD(GL, 3); \
    AF_GB(o[0] = AF_MF(AF_PAF(2), AF_VFR(2), o[0]), C1, 0);  AF_KRD(GL, 4); \
    AF_GB(o[1] = AF_MF(AF_PAF(2), AF_VFR(6), o[1]), C1, 4);  AF_KRD(GL, 5); \
    AF_GB(o[0] = AF_MF(AF_PAF(3), AF_VFR(3), o[0]), C1, 8); \
    AF_GB(o[1] = AF_MF(AF_PAF(3), AF_VFR(7), o[1]), C1, 12); \
  } while (0)
  int t = 1;
  for (; t + 3 < NT; t += 2) {
    AF_STEP(pB0, pB1, pA0, pA1, t, true, true, true);     AF_WAITN(1, 1); AF_ROT();
    AF_STEP(pA0, pA1, pB0, pB1, t + 1, true, true, true); AF_WAITN(1, 1); AF_ROT();
  }
  AF_STEP(pB0, pB1, pA0, pA1, NT - 3, false, true, true);  AF_WAITN(0, 1); AF_ROT();
  AF_STEP(pA0, pA1, pB0, pB1, NT - 2, false, true, true);  AF_WAIT_BAR(0); AF_ROT();
  AF_STEP(pB0, pB1, pA0, pA1, NT - 1, false, false, false);
  { float sacc = pB0[0] + pB0[1];
#pragma unroll
    for (int r = 2; r < 16; ++r) sacc += pB0[r];
#pragma unroll
    for (int r = 0; r < 16; ++r) sacc += pB1[r];
    l_reg += sacc;
    pw0 = (u32x4){AF_PKW(pB0, 0), AF_PKW(pB0, 2), AF_PKW(pB0, 4), AF_PKW(pB0, 6)}; pw1 = (u32x4){AF_PKW(pB0, 8), AF_PKW(pB0, 10), AF_PKW(pB0, 12), AF_PKW(pB0, 14)};
    pw2 = (u32x4){AF_PKW(pB1, 0), AF_PKW(pB1, 2), AF_PKW(pB1, 4), AF_PKW(pB1, 6)}; pw3 = (u32x4){AF_PKW(pB1, 8), AF_PKW(pB1, 10), AF_PKW(pB1, 12), AF_PKW(pB1, 14)};
    AF_SBAR();
    const lds_cptr vp_ = vp0 + s_cur * VSLOT;
#pragma unroll
    for (int i = 0; i < 8; ++i) { vlo[i] = vtr(vp_ + ((i >> 2) * 4096 + (i & 3) * 1024)); vhi[i] = vtr(vp_ + ((i >> 2) * 4096 + (i & 3) * 1024 + 512)); }
    o[0] = AF_MF(AF_PAF(0), AF_VFR(0), o[0]); o[1] = AF_MF(AF_PAF(0), AF_VFR(4), o[1]);
    o[0] = AF_MF(AF_PAF(1), AF_VFR(1), o[0]); o[1] = AF_MF(AF_PAF(1), AF_VFR(5), o[1]);
    o[0] = AF_MF(AF_PAF(2), AF_VFR(2), o[0]); o[1] = AF_MF(AF_PAF(2), AF_VFR(6), o[1]);
    o[0] = AF_MF(AF_PAF(3), AF_VFR(3), o[0]); o[1] = AF_MF(AF_PAF(3), AF_VFR(7), o[1]); }
  { auto rr = __builtin_amdgcn_permlane32_swap(__float_as_uint(l_reg), __float_as_uint(l_reg), false, false); l_reg = __uint_as_float(rr[0]) + __uint_as_float(rr[1]); }
  l_reg += __builtin_amdgcn_exp2f(u.sink(wid));
  if (hi == 0) wsf[32 + r32] = l_reg; asm volatile("s_waitcnt lgkmcnt(0)" ::: "memory");
  float rli[16];
#pragma unroll
  for (int r = 0; r < 16; ++r) rli[r] = __builtin_amdgcn_rcpf(wsf[32 + crow(r, hi)]);
  bf16* Ow = u.orow0(wid);
  { bf16* stg = (bf16*)(shm + LDS_OST) + wid * 2048;
#pragma unroll
    for (int r = 0; r < 16; ++r) { const int orow = crow(r, hi);
#pragma unroll
      for (int d0 = 0; d0 < 2; ++d0) stg[orow * 64 + d0 * 32 + r32] = (bf16)(cvtpk_s(o[d0][r] * rli[r], 0.f) & 0xffffu); }
    asm volatile("s_waitcnt lgkmcnt(0)" ::: "memory");
#pragma unroll
    for (int i = 0; i < 4; ++i) { const int row = i * 8 + (lane >> 3), ch = lane & 7; const u32x4 v = *(const u32x4*)(stg + row * 64 + ch * 8); *(u32x4*)(Ow + (long)row * 1024 + ch * 8) = v; } }
  asm volatile("s_waitcnt vmcnt(0) lgkmcnt(0)\n\ts_barrier" ::: "memory");
#undef AF_DMA_KA
#undef AF_DMA_KB
#undef AF_DMA_K
#undef AF_DMA_V
#undef AF_WAITN
#undef AF_ROT
#undef AF_PKW
#undef AF_PAF
#undef AF_VFR
#undef AF_PIN
#undef AF_MF
#undef AF_EX
#undef AF_VRD
#undef AF_GA4
#undef AF_GA3
#undef AF_GA2
#undef AF_GB
#undef AF_KRD
#undef AF_PHASE_A12
#undef AF_PHASE_A8
#undef AF_STEP
}

constexpr int ROWS_LAT = 16384;
constexpr float LOG2E_ = 1.4426950408889634f;
__device__ __forceinline__ int clampi(int v, int lo, int hi_) { return v < lo ? lo : (v > hi_ ? hi_ : v); }
struct FDense {
  static constexpr bool HAS_MASK = false;
  const bf16* Q; const bf16* kbase; const bf16* vbase; const bf16* krbase; bf16* O; int b, h, qb; static constexpr int kpitch = 2048, vpitch = 2048;
  __device__ __forceinline__ void init(const bf16* Q_, const bf16* KV, const bf16* KR, bf16* O_, int b_, int h_, int qb_) { Q = Q_; kbase = KV + 64 * h_; vbase = KV + 1024 + 64 * h_; krbase = KR; O = O_; b = b_; h = h_; qb = qb_; }
  __device__ __forceinline__ int nt() const { return 132; }
  __device__ __forceinline__ long trow(int t) const { return t < 4 ? (long)(ROWS_LAT + 256 * b + 64 * t) : (long)(8192 * b + 64 * (t - 4)); }
  __device__ __forceinline__ const bf16* qptr(int wid, int r32, int d0, int hi) const { const bf16* qp = Q + (long)(8192 * b + 256 * qb + 32 * wid + r32) * 1536;
    return d0 < 4 ? qp + 64 * h + 16 * d0 + 8 * hi : qp + 1024 + 32 * h + 16 * (d0 - 4) + 8 * hi; }
  __device__ __forceinline__ void mask(f32x16&, f32x16&, int, int, int, int) const {}
  __device__ __forceinline__ float sink(int) const { return -INFINITY; }
  __device__ __forceinline__ bf16* orow0(int wid) const { return O + (long)(8192 * b + 256 * qb + 32 * wid) * 1024 + 64 * h; }
};
struct FWin {
  static constexpr bool HAS_MASK = true; static constexpr int kpitch = 2304, vpitch = 2304;
  const bf16* QKV; const bf16* kbase; const bf16* vbase; const bf16* krbase; bf16* O; const float* sinkp; int b, n, g, hh, i0, cnt;
  __device__ __forceinline__ void init(const bf16* QKV_, bf16* O_, const float* sk, int b_, int n_, int g_, int hh_) { QKV = QKV_; O = O_; sinkp = sk; b = b_; n = n_; g = g_; hh = hh_; krbase = nullptr;
    kbase = QKV_ + 512 + 64 * g_; vbase = QKV_ + 640 + 64 * g_; i0 = (n_ == 0) ? 2 : 0; cnt = (n_ == 0 || n_ == 63) ? 4 : 6; }
  __device__ __forceinline__ int nt() const { return 4 + cnt; }
  __device__ __forceinline__ int kpos0(int t) const { return 128 * (n - 1) + 64 * (i0 + t - 4); }
  __device__ __forceinline__ long trow(int t) const { return t < 4 ? (long)(ROWS_LAT + 256 * b + 64 * t) : (long)(8192 * b + kpos0(t)); }
  __device__ __forceinline__ int head(int wid) const { return 4 * g + 2 * hh + (wid >> 2); }
  __device__ __forceinline__ int qpos0(int wid) const { return 128 * n + 32 * (wid & 3); }
  __device__ __forceinline__ const bf16* qptr(int wid, int r32, int d0, int hi) const { return QKV + (long)(8192 * b + qpos0(wid) + r32) * 2304 + 64 * head(wid) + 16 * d0 + 8 * hi; }
  __device__ __forceinline__ void mask(f32x16& p0, f32x16& p1, int t, int wid, int r32, int hi) const {
    if (t < 4) return;
    const int k0 = kpos0(t), q0 = qpos0(wid);
    if (k0 - (q0 + 31) >= -128 && k0 + 63 - q0 <= 128) return;
    asm volatile("" : "+v"(r32), "+v"(hi));
    const int dq = k0 - (q0 + r32);
#pragma unroll
    for (int r = 0; r < 16; ++r) { const int d = dq + crow(r, hi); if (d > 128 || d < -128) p0[r] = -INFINITY; if (d + 32 > 128 || d + 32 < -128) p1[r] = -INFINITY; }
  }
  __device__ __forceinline__ float sink(int wid) const { return sinkp[head(wid)] * LOG2E_; }
  __device__ __forceinline__ bf16* orow0(int wid) const { return O + (long)(8192 * b + qpos0(wid)) * 1024 + 64 * head(wid); }
};
struct FNa {
  static constexpr bool HAS_MASK = true; static constexpr int kpitch = 2304, vpitch = 2304;
  const bf16* QKV; const bf16* kbase; const bf16* vbase; const bf16* krbase; bf16* O; const float* rpbl; int b, h, R4, krlo, nloc;
  __device__ __forceinline__ void init(const bf16* QKV_, bf16* O_, const float* rpbl_, int b_, int h_, int R4_) { QKV = QKV_; O = O_; rpbl = rpbl_; b = b_; h = h_; R4 = R4_; krbase = nullptr;
    kbase = QKV_ + 1280 + 64 * h_; vbase = QKV_ + 1792 + 64 * h_; krlo = clampi(4 * R4_ - 4, 0, 120); nloc = clampi(4 * R4_ - 1, 0, 120) + 7 - krlo + 1; }
  __device__ __forceinline__ int nt() const { return (4 + nloc + 1) & ~1; }
  __device__ __forceinline__ long trow(int t) const { return (t < 4 || t >= 4 + nloc) ? (long)(ROWS_LAT + 256 * b + 64 * (t & 3)) : (long)(8192 * b + 64 * (krlo + t - 4)); }
  __device__ __forceinline__ int qrow(int wid) const { return 4 * R4 + (wid >> 1); }
  __device__ __forceinline__ const bf16* qptr(int wid, int r32, int d0, int hi) const { return QKV + (long)(8192 * b + 64 * qrow(wid) + 32 * (wid & 1) + r32) * 2304 + 768 + 64 * h + 16 * d0 + 8 * hi; }
  __device__ __forceinline__ void mask(f32x16& p0, f32x16& p1, int t, int wid, int r32, int hi) const {
    if (t < 4) return;
    const int kr = krlo + t - 4, w0 = clampi(qrow(wid) - 4, 0, 120);
    if (t >= 4 + nloc || kr < w0 || kr > w0 + 7) {
#pragma unroll
      for (int r = 0; r < 16; ++r) { p0[r] = -INFINITY; p1[r] = -INFINITY; }
      return; }
    asm volatile("" : "+v"(r32), "+v"(hi));
    const int qc = 32 * (wid & 1) + r32, c0 = clampi(qc - 8, 0, 48);
    const float* brow = rpbl + (kr - qrow(wid) + 7) * 31 + 15;
#pragma unroll
    for (int r = 0; r < 16; ++r) {
      { const int kc = crow(r, hi); const bool ok = kc >= c0 && kc < c0 + 16; const float bv = brow[clampi(kc - qc, -15, 15)]; p0[r] = ok ? p0[r] + bv : -INFINITY; }
      { const int kc = 32 + crow(r, hi); const bool ok = kc >= c0 && kc < c0 + 16; const float bv = brow[clampi(kc - qc, -15, 15)]; p1[r] = ok ? p1[r] + bv : -INFINITY; } }
  }
  __device__ __forceinline__ float sink(int) const { return -INFINITY; }
  __device__ __forceinline__ bf16* orow0(int wid) const { return O + (long)(8192 * b + 64 * qrow(wid) + 32 * (wid & 1)) * 1024 + 512 + 64 * h; }
};
struct FCtx {
  static constexpr bool HAS_MASK = false; static constexpr int kpitch = 2304, vpitch = 2304;
  const bf16* QKV; const bf16* kbase; const bf16* vbase; const bf16* krbase; bf16* O; const float* sinkp; int b, hx, qcol, ocol;
  __device__ __forceinline__ void init(const bf16* QKV_, bf16* O_, const float* sk, int b_, int hx_) { QKV = QKV_; O = O_; sinkp = sk; b = b_; hx = hx_; krbase = nullptr;
    if (hx_ < 8) { qcol = 64 * hx_; kbase = QKV_ + 512 + 64 * (hx_ >> 2); vbase = QKV_ + 640 + 64 * (hx_ >> 2); ocol = 64 * hx_; }
    else { const int h = hx_ - 8; qcol = 768 + 64 * h; kbase = QKV_ + 1280 + 64 * h; vbase = QKV_ + 1792 + 64 * h; ocol = 512 + 64 * h; } }
  __device__ __forceinline__ int nt() const { return 4; }
  __device__ __forceinline__ long trow(int t) const { return (long)(ROWS_LAT + 256 * b + 64 * (t & 3)); }
  __device__ __forceinline__ const bf16* qptr(int wid, int r32, int d0, int hi) const { return QKV + (long)(ROWS_LAT + 256 * b + 32 * wid + r32) * 2304 + qcol + 16 * d0 + 8 * hi; }
  __device__ __forceinline__ void mask(f32x16&, f32x16&, int, int, int, int) const {}
  __device__ __forceinline__ float sink(int) const { return hx < 8 ? sinkp[hx] * LOG2E_ : -INFINITY; }
  __device__ __forceinline__ bf16* orow0(int wid) const { return O + (long)(ROWS_LAT + 256 * b + 32 * wid) * 1024 + ocol; }
};
#undef AF_SBAR
#undef AF_WAIT_BAR
}
constexpr int NWAVES = 8;
#ifndef MK_PER_PHASE
#define MK_PER_PHASE 0
#endif
constexpr int BATCH = 2, SEQ = 8192, DM = 1024, CTXL = 256, FF = 4096;
constexpr int ML = BATCH * SEQ, MC = BATCH * CTXL, MR = ML + MC;
constexpr int NQKV = 2304, NCIN = 768, NUQ = 1536, NUKV = 2048;
constexpr float NORM_EPS = 1e-6f;
constexpr int ADA_KS = 16;
constexpr size_t MiB = 1u << 20;
constexpr size_t WS_CTL = 0, CTL_ZERO_BYTES = 64 * 1024;
constexpr size_t WS_MODP = 1 * MiB;
constexpr size_t WS_MOD = 3 * MiB + 512 * 1024;
constexpr size_t WS_ROPE = 3 * MiB + 768 * 1024;
constexpr size_t WS_HPAR = WS_ROPE + 32 * 1024;
constexpr size_t WS_CTXRES = 4 * MiB;
constexpr size_t WS_WQKV = 6 * MiB, WS_WO0 = WS_WQKV + 4608 * 1024, WS_W1_0 = WS_WO0 + 2 * MiB, WS_W2_0 = WS_W1_0 + 8 * MiB, WS_W1_1 = WS_W2_0 + 8 * MiB, WS_W2_1 = WS_W1_1 + 8 * MiB;
constexpr size_t WS_WIN = WS_W2_1 + 8 * MiB, WS_WUQ = WS_WIN + 1536 * 1024, WS_WUKV = WS_WUQ + 1152 * 1024, WS_WO1 = WS_WUKV + 1 * MiB, WS_WEND = WS_WO1 + 2 * MiB;
constexpr size_t WS_AR = 51 * MiB;
static_assert(WS_WEND <= WS_AR, "weights overlap the arena");
constexpr size_t WS_XN = WS_AR, WS_H = WS_AR + 33 * MiB;
constexpr size_t WS_QKV = WS_AR + 33 * MiB, WS_O0 = WS_AR + 108 * MiB;
constexpr size_t WS_CQKV = WS_AR + 33 * MiB, WS_CQN = WS_AR + 58 * MiB, WS_CKVN = WS_AR + 71 * MiB, WS_KR = WS_AR + 80 * MiB, WS_Q1 = WS_AR + 82 * MiB, WS_KV1 = WS_AR + 130 * MiB, WS_O1 = WS_AR;
constexpr size_t WS_PART5 = WS_AR + 33 * MiB;
constexpr size_t WS_PART8 = WS_AR + 166 * MiB;
constexpr size_t WS_END = 256 * MiB;
static_assert(WS_PART8 + (size_t)16 * 512 * 1024 * 4 <= WS_END && WS_KV1 + (size_t)MR * NUKV * 2 <= WS_END && WS_H + (size_t)MR * FF * 2 <= WS_END, "d_ws map");
constexpr int CW_BAR = 4096;
constexpr int RING_OFF = 0, RING_BYTES = 131072;
constexpr int LDSCTL_OFF = RING_BYTES, MISC_OFF = LDSCTL_OFF + 320;
constexpr int LDS_BYTES = 147456;
static_assert(att::L_END <= RING_BYTES && attf::LDS_BYTES <= RING_BYTES, "attention LDS");

#define GAS __attribute__((address_space(1)))
#define LAS __attribute__((address_space(3)))
typedef unsigned short bf16;
typedef unsigned v4u __attribute__((ext_vector_type(4)));
typedef unsigned v2u __attribute__((ext_vector_type(2)));
typedef float f32x4 __attribute__((ext_vector_type(4)));
typedef GAS unsigned gu32;
#define RLX_AGENT __ATOMIC_RELAXED, __HIP_MEMORY_SCOPE_AGENT
#define LDS_WAIT() asm volatile("s_waitcnt lgkmcnt(0)" ::: "memory")
#define VM_WAIT() asm volatile("s_waitcnt vmcnt(0)" ::: "memory")
__device__ __forceinline__ unsigned f2bf(float f) { unsigned u = __builtin_bit_cast(unsigned, f); return (u + 0x7fffu + ((u >> 16) & 1u)) >> 16; }
__device__ __forceinline__ unsigned pk2(float lo, float hi) { return f2bf(lo) | (f2bf(hi) << 16); }
__device__ __forceinline__ float bf2f(unsigned short h) { return __builtin_bit_cast(float, (unsigned)h << 16); }
__device__ __forceinline__ float bflo(unsigned w) { return __builtin_bit_cast(float, w << 16); }
__device__ __forceinline__ float bfhi(unsigned w) { return __builtin_bit_cast(float, w & 0xffff0000u); }

#define XB_TMO      128
#define XB_XCNT(j)  (256  + 64 * (j))
#define XB_XSUB(j)  (1280 + 64 * (j))
#define XB_XGEN(j)  (2304 + 64 * (j))
#define XB_TOP      3328
#define XB_TOPGEN   3392
#define XCD_BAR_WORDS 3456
#define XB_SPIN_CAP (1u << 18)

__device__ __forceinline__ unsigned xb_ld(unsigned* p)              { return __hip_atomic_load(p, __ATOMIC_RELAXED, __HIP_MEMORY_SCOPE_AGENT); }
__device__ __forceinline__ unsigned xb_add(unsigned* p, unsigned v) { return __hip_atomic_fetch_add(p, v, __ATOMIC_RELAXED, __HIP_MEMORY_SCOPE_AGENT); }
__device__ __forceinline__ unsigned xb_xcc_id() { return (unsigned)__builtin_amdgcn_s_getreg((3 << 11) | 20) & 0xFu; }
#define XB_SPIN(cond, bar) do { unsigned _sp = 0; while (cond) { __builtin_amdgcn_s_sleep(1); \
    if ((++_sp & 255u) == 0u) { if (xb_ld(&(bar)[XB_TMO])) break; if (_sp > XB_SPIN_CAP) { atomicAdd(&(bar)[XB_TMO], 1u); break; } } } } while (0)

struct XcdBarrier {
    unsigned* bar; unsigned x;
    volatile LAS unsigned* st;
};

__device__ __forceinline__ XcdBarrier xcd_barrier_post(unsigned* bar, volatile LAS unsigned* st) {
    XcdBarrier b; b.bar = bar; b.x = xb_xcc_id(); b.st = st;
    if (threadIdx.x == 0) (void)xb_add(&bar[XB_XCNT(b.x)], 1u);
    return b;
}
__device__ __forceinline__ void xcd_barrier_complete(unsigned* bar, unsigned x, unsigned& nloc, unsigned& nx) {
    const unsigned G = gridDim.x * gridDim.y * gridDim.z;
    unsigned sum, cnt, mine, sp = 0u;
    for (;;) {
        sum = 0u; cnt = 0u; mine = 0u;
#pragma unroll
        for (unsigned j = 0; j < 16; ++j) { const unsigned c = xb_ld(&bar[XB_XCNT(j)]); sum += c; cnt += (c > 0u) ? 1u : 0u; mine = (j == x) ? c : mine; }
        if (sum == G) break;
        __builtin_amdgcn_s_sleep(1);
        if ((++sp & 255u) == 0u) { if (xb_ld(&bar[XB_TMO])) break; if (sp > XB_SPIN_CAP) { atomicAdd(&bar[XB_TMO], 1u); break; } }
    }
    nloc = mine > 0u ? mine : 1u; nx = cnt > 0u ? cnt : 1u;
}

__device__ __forceinline__ void xcd_barrier(const XcdBarrier& b) {
    asm volatile("s_waitcnt vmcnt(0)" ::: "memory");
    __syncthreads();
    if (threadIdx.x == 0) {
        unsigned* bar = b.bar;
        __builtin_amdgcn_s_waitcnt(0);
        unsigned nloc = b.st[0], nx = b.st[1];
        if (nloc == 0u) { xcd_barrier_complete(bar, b.x, nloc, nx); b.st[0] = nloc; b.st[1] = nx; }
        const unsigned old = xb_add(&bar[XB_XSUB(b.x)], 1u);
        const unsigned gen = old / nloc;
        if (old + 1u == (gen + 1u) * nloc) {
            __builtin_amdgcn_fence(__ATOMIC_RELEASE, "agent");
            asm volatile("s_waitcnt vmcnt(0)" ::: "memory");
            const unsigned og = xb_add(&bar[XB_TOP], 1u);
            const unsigned tg = og / nx;
            if (og + 1u == (tg + 1u) * nx) xb_add(&bar[XB_TOPGEN], 1u);
            else XB_SPIN(xb_ld(&bar[XB_TOPGEN]) == tg, bar);
            __builtin_amdgcn_fence(__ATOMIC_ACQUIRE, "agent");
            xb_add(&bar[XB_XGEN(b.x)], 1u);
            asm volatile("s_waitcnt vmcnt(0)" ::: "memory");
        } else {
            XB_SPIN(xb_ld(&bar[XB_XGEN(b.x)]) == gen, bar);
            __builtin_amdgcn_fence(__ATOMIC_ACQUIRE, "agent");
            asm volatile("s_waitcnt vmcnt(0)" ::: "memory");
        }
    }
    __syncthreads();
}


template <int K> __device__ __forceinline__ const float* ldarg() {
    auto ka = __builtin_amdgcn_kernarg_segment_ptr();
    const __attribute__((address_space(1))) float* p; asm volatile("s_load_dwordx2 %0, %1, %2\n\ts_waitcnt lgkmcnt(0)" : "=s"(p) : "s"(ka), "i"(K * 8) : "memory"); return (const float*)p;
}
#define ARG(k) (ldarg<k>())
#define ARG_OUT ((float*)ldarg<28>())
#define ARG_WS ((unsigned char*)ldarg<29>())
struct Frame {
    LAS unsigned char* lds;
    volatile LAS unsigned* MISC;
    gu32* ctl;
    int tid, lane, wave;
    int vcu, G, bx;
    float* out; unsigned char* ws;
};
__device__ __forceinline__ float shx(float v, int mask, int lane) { return __builtin_bit_cast(float, __builtin_amdgcn_ds_bpermute((lane ^ mask) << 2, __builtin_bit_cast(int, v))); }
__device__ __forceinline__ float wave_sum(float v, int lane) {
#pragma unroll
    for (int o = 1; o < 64; o <<= 1) v += shx(v, o, lane);
    return v;
}
__device__ __forceinline__ void p0_transpose_item(const float* W, int K, int N, bf16* WT, int pmode, LAS float* scr, int item, int lane) {
    const int nblk = N / 32, kb = item / nblk, nb = item % nblk, k0 = 64 * kb, n0 = 32 * nb;
    int r0 = n0;
    if (pmode == 1) { const int h = n0 / 96, d = n0 % 96; r0 = d < 64 ? h * 64 + d : 1024 + h * 32 + (d - 64); }
    else if (pmode == 2) { const int h = n0 / 128, d = n0 % 128; r0 = d < 64 ? h * 64 + d : 1024 + h * 64 + (d - 64); }
#pragma unroll 8
    for (int i = 0; i < 32; ++i) { const int kk = 2 * i + (lane >> 5); scr[kk * 33 + (lane & 31)] = W[(size_t)(k0 + kk) * N + n0 + (lane & 31)]; }
    LDS_WAIT(); asm volatile("" ::: "memory");
    const int c = lane & 7;
#pragma unroll
    for (int j = 0; j < 4; ++j) { const int n = (lane >> 3) + 8 * j; const LAS float* s = scr + (8 * c) * 33 + n;
        v4u o; o.x = pk2(s[0 * 33], s[1 * 33]); o.y = pk2(s[2 * 33], s[3 * 33]); o.z = pk2(s[4 * 33], s[5 * 33]); o.w = pk2(s[6 * 33], s[7 * 33]);
        *(GAS v4u*)(WT + (size_t)(r0 + n) * K + k0 + 8 * c) = o; }
    LDS_WAIT(); asm volatile("" ::: "memory");
}
__device__ __forceinline__ float silu_f(float v) { return v / (1.f + __expf(-v)); }

__device__ __forceinline__ void p0_prologue(Frame& F) {
    LAS float* scr = (LAS float*)(F.lds + RING_OFF + F.wave * 16384);
    const float* c = ARG(1); const float* cctx = ARG(3);
    if (F.wave >= 5) {
        for (int it = F.vcu * 3 + (F.wave - 5); it < 2 * 24 * ADA_KS; it += F.G * 3) {
            const int l = it / (24 * ADA_KS), rem = it % (24 * ADA_KS), cg = rem / ADA_KS, ks = rem % ADA_KS;
            const float* W = ARG(4) + (size_t)l * DM * 6144 + cg * 256 + 4 * F.lane;
            f32x4 a0 = {0.f, 0.f, 0.f, 0.f}, a1 = a0, a2 = a0;
            const int kbeg = ks * (DM / ADA_KS);
#pragma unroll 8
            for (int k = kbeg; k < kbeg + DM / ADA_KS; ++k) {
                const f32x4 w = *(const GAS f32x4*)(W + (size_t)k * 6144);
                const float s0 = silu_f(c[k]), s1 = silu_f(c[DM + k]), s2 = silu_f(cctx[k]);
                a0 += w * s0; a1 += w * s1; a2 += w * s2;
            }
            float* P = (float*)(F.ws + WS_MODP) + ((size_t)(ks * 2 + l) * 3) * 6144 + cg * 256 + 4 * F.lane;
            *(GAS f32x4*)(P) = a0; *(GAS f32x4*)(P + 6144) = a1; *(GAS f32x4*)(P + 2 * 6144) = a2;
        }
    } else {
        const int gw = F.vcu * 5 + F.wave, NGW = F.G * 5;
        constexpr int I_QKV = 16 * 72, I_O = 16 * 32, I_1 = 16 * 128, I_2 = 64 * 32, I_IN = 16 * 21, I_UQ = 6 * 48, I_UKV = 4 * 64;
        constexpr int NITEMS = I_QKV + I_O + 2 * I_1 + 2 * I_2 + I_IN + I_UQ + I_UKV + I_O;
        for (int it = gw; it < NITEMS; it += NGW) {
            int r = it;
            if (r < I_QKV) { p0_transpose_item(ARG(10), DM, NQKV, (bf16*)(F.ws + WS_WQKV), 0, scr, r, F.lane); continue; } r -= I_QKV;
            if (r < I_O) { p0_transpose_item(ARG(11), DM, DM, (bf16*)(F.ws + WS_WO0), 0, scr, r, F.lane); continue; } r -= I_O;
            if (r < I_1) { p0_transpose_item(ARG(8), DM, FF, (bf16*)(F.ws + WS_W1_0), 0, scr, r, F.lane); continue; } r -= I_1;
            if (r < I_1) { p0_transpose_item(ARG(8) + (size_t)DM * FF, DM, FF, (bf16*)(F.ws + WS_W1_1), 0, scr, r, F.lane); continue; } r -= I_1;
            if (r < I_2) { p0_transpose_item(ARG(9), FF, DM, (bf16*)(F.ws + WS_W2_0), 0, scr, r, F.lane); continue; } r -= I_2;
            if (r < I_2) { p0_transpose_item(ARG(9) + (size_t)DM * FF, FF, DM, (bf16*)(F.ws + WS_W2_1), 0, scr, r, F.lane); continue; } r -= I_2;
            if (r < I_IN) { p0_transpose_item(ARG(18), DM, 672, (bf16*)(F.ws + WS_WIN), 0, scr, r, F.lane); continue; } r -= I_IN;
            if (r < I_UQ) { p0_transpose_item(ARG(21), 384, NUQ, (bf16*)(F.ws + WS_WUQ), 1, scr, r, F.lane); continue; } r -= I_UQ;
            if (r < I_UKV) { p0_transpose_item(ARG(22), 256, NUKV, (bf16*)(F.ws + WS_WUKV), 2, scr, r, F.lane); continue; } r -= I_UKV;
            p0_transpose_item(ARG(27), DM, DM, (bf16*)(F.ws + WS_WO1), 0, scr, r, F.lane);
        }
    }
    if (F.bx == 1 % F.G) {
        float* rt = (float*)(F.ws + WS_ROPE);
        for (int e = F.tid; e < 128 * 16; e += NWAVES * 64) { const int pos = e >> 4, i = e & 15; const float inv = exp2f(-(float)i * (13.287712379549449f / 16.f));
            float x = (float)pos * inv * 0.15915494309189535f; x -= rintf(x); rt[e] = __builtin_amdgcn_cosf(x); rt[2048 + e] = __builtin_amdgcn_sinf(x); }
        for (int e = F.tid; e < 128 * 8; e += NWAVES * 64) { const int pos = e >> 3, i = e & 7; const float inv = exp2f(-(float)i * (13.287712379549449f / 8.f));
            float x = (float)pos * inv * 0.15915494309189535f; x -= rintf(x); rt[4096 + e] = __builtin_amdgcn_cosf(x); rt[5120 + e] = __builtin_amdgcn_sinf(x); }
    }
    if (F.bx == 3 % F.G && F.tid < 64) {
        float* hp = (float*)(F.ws + WS_HPAR); const int i = F.tid;
        hp[i] = ARG(12)[i]; hp[64 + i] = ARG(13)[i]; hp[128 + i] = ARG(15)[i]; hp[192 + i] = ARG(16)[i]; hp[256 + i] = ARG(23)[i]; hp[320 + i] = ARG(24)[i & 31]; hp[384 + i] = ARG(25)[i];
    }
    if (F.bx == 2 % F.G) {
        GAS v4u* z = (GAS v4u*)((bf16*)(F.ws + WS_WIN) + (size_t)672 * DM);
        unsigned zz = 0u; asm volatile("" : "+v"(zz));
        for (int e = F.tid; e < 96 * DM / 8; e += NWAVES * 64) z[e] = (v4u){zz, zz, zz, zz};
    }
}

__device__ __forceinline__ void norm_phase(Frame& F, const float* src_lat, const float* src_ctx, int nrows, const float* gw_, int layer, int which  , bool from_partials, const float* parts = nullptr, int nparts = 0) {
    LAS float* gl = (LAS float*)(F.lds + RING_OFF); LAS float* scl = gl + 1024; LAS float* shl = scl + 3 * 1024;
    const float* modp = (const float*)(F.ws + WS_MODP); const float* mod = (const float*)(F.ws + WS_MOD); const float* ada_b = ARG(5);
    const int offsh = which * 3072, offsc = which * 3072 + 1024;
    for (int i = F.tid; i < 1024; i += NWAVES * 64) {
        gl[i] = gw_[i];
#pragma unroll
        for (int cnd = 0; cnd < 3; ++cnd) {
            float sh, sc;
            if (from_partials) { sh = ada_b[layer * 6144 + offsh + i]; sc = ada_b[layer * 6144 + offsc + i];
                float ph[ADA_KS], pc[ADA_KS];
#pragma unroll
                for (int ks = 0; ks < ADA_KS; ++ks) { const float* p = modp + ((size_t)(ks * 2 + layer) * 3 + cnd) * 6144; ph[ks] = p[offsh + i]; pc[ks] = p[offsc + i]; }
#pragma unroll
                for (int ks = 0; ks < ADA_KS; ++ks) { sh += ph[ks]; sc += pc[ks]; } }
            else { sh = mod[(layer * 3 + cnd) * 6144 + offsh + i]; sc = mod[(layer * 3 + cnd) * 6144 + offsc + i]; }
            scl[cnd * 1024 + i] = 1.f + sc; shl[cnd * 1024 + i] = sh;
        }
    }
    if (from_partials) {
        float* modw = (float*)(F.ws + WS_MOD);
        for (int e = F.vcu * (NWAVES * 64) + F.tid; e < 2 * 3 * 6144; e += F.G * NWAVES * 64) {
            const int l = e / (3 * 6144), rem = e % (3 * 6144), cnd = rem / 6144, col = rem % 6144;
            float v = ada_b[l * 6144 + col];
            float pv[ADA_KS];
#pragma unroll
            for (int ks = 0; ks < ADA_KS; ++ks) pv[ks] = modp[((size_t)(ks * 2 + l) * 3 + cnd) * 6144 + col];
#pragma unroll
            for (int ks = 0; ks < ADA_KS; ++ks) v += pv[ks];
            modw[e] = v;
        }
    }
    __syncthreads();
    bf16* XN = (bf16*)(F.ws + WS_XN);
    const int gw = F.vcu * NWAVES + F.wave, NGW = F.G * NWAVES;
    for (int m = gw; m < nrows; m += NGW) {
        const float* xrow = m < ML ? src_lat + (size_t)m * DM : src_ctx + (size_t)(m - ML) * DM;
        const int cnd = m < SEQ ? 0 : (m < ML ? 1 : 2);
        const GAS f32x4* xr = (const GAS f32x4*)xrow + F.lane;
        f32x4 v[4]; float s = 0.f;
#pragma unroll
        for (int j = 0; j < 4; ++j) v[j] = xr[64 * j];
        if (nparts > 0 && m >= ML) {
            for (int p = 0; p < nparts; p += 4) {
                const GAS f32x4* pr = (const GAS f32x4*)(parts + (size_t)p * (512 * 1024) + (size_t)(m - ML) * DM) + F.lane;
                f32x4 w[4][4];
#pragma unroll
                for (int q = 0; q < 4; ++q)
#pragma unroll
                    for (int j = 0; j < 4; ++j) w[q][j] = pr[(size_t)q * (512 * 1024 / 4) + 64 * j];
#pragma unroll
                for (int j = 0; j < 4; ++j) v[j] += (w[0][j] + w[1][j]) + (w[2][j] + w[3][j]); }
            GAS f32x4* cr = (GAS f32x4*)((float*)(F.ws + WS_CTXRES) + (size_t)(m - ML) * DM) + F.lane;
#pragma unroll
            for (int j = 0; j < 4; ++j) cr[64 * j] = v[j];
        }
#pragma unroll
        for (int j = 0; j < 4; ++j) s += (v[j].x * v[j].x + v[j].y * v[j].y) + (v[j].z * v[j].z + v[j].w * v[j].w);
        const float rstd = 1.f / sqrtf(wave_sum(s, F.lane) * (1.f / DM) + NORM_EPS);
        if (from_partials && m >= ML) { GAS f32x4* cr = (GAS f32x4*)((float*)(F.ws + WS_CTXRES) + (size_t)(m - ML) * DM) + F.lane;
#pragma unroll
            for (int j = 0; j < 4; ++j) cr[64 * j] = v[j]; }
        GAS v2u* o8 = (GAS v2u*)(XN + (size_t)m * DM) + F.lane;
#pragma unroll
        for (int j = 0; j < 4; ++j) { const int col = 4 * F.lane + 256 * j;
            const f32x4 g = *(const LAS f32x4*)(gl + col), sc = *(const LAS f32x4*)(scl + cnd * 1024 + col), sh = *(const LAS f32x4*)(shl + cnd * 1024 + col);
            const f32x4 y = (v[j] * rstd) * g * sc + sh;
            v2u w; w.x = pk2(y.x, y.y); w.y = pk2(y.z, y.w); o8[64 * j] = w; }
    }
    __syncthreads();
}

__device__ __forceinline__ void unpack8(const v4u w, float (&x)[8]) { x[0] = bflo(w.x); x[1] = bfhi(w.x); x[2] = bflo(w.y); x[3] = bfhi(w.y); x[4] = bflo(w.z); x[5] = bfhi(w.z); x[6] = bflo(w.w); x[7] = bfhi(w.w); }
__device__ __forceinline__ v4u pack8(const float (&x)[8]) { v4u w; w.x = pk2(x[0], x[1]); w.y = pk2(x[2], x[3]); w.z = pk2(x[4], x[5]); w.w = pk2(x[6], x[7]); return w; }

__device__ __forceinline__ void qknorm_phase(Frame& F) {
    bf16* QKV = (bf16*)(F.ws + WS_QKV);
    const float* rt = (const float*)(F.ws + WS_ROPE);
    const float* nw[4] = {ARG(12), ARG(13), ARG(15), ARG(16)};
    const float qscale = 0.125f * att::LOG2E;
    const int gw = F.vcu * NWAVES + F.wave, NGW = F.G * NWAVES;
    const int lane = F.lane, grp = lane >> 3, l8 = lane & 7;
    for (int m = gw; m < MR; m += NGW) {
        const bool lat = m < ML; const int t = m & (SEQ - 1); const int prow = t >> 6, pcol = t & 63;
        GAS v4u* rowp = (GAS v4u*)(QKV + (size_t)m * NQKV);
#pragma unroll
        for (int pass = 0; pass < 4; ++pass) {
            int type;
            if (pass == 0) type = 1; else if (pass == 1) type = grp < 2 ? 2 : (grp < 4 ? 0 : 3); else if (pass == 2) type = grp < 4 ? 3 : 4; else type = grp < 4 ? 4 : 0;
            const v4u w = rowp[pass * 64 + lane];
            float x[8]; unpack8(w, x);
            float ss = 0.f;
#pragma unroll
            for (int j = 0; j < 8; ++j) ss += x[j] * x[j];
            ss += shx(ss, 1, F.lane); ss += shx(ss, 2, F.lane); ss += shx(ss, 4, F.lane);
            const float rstd = 1.f / sqrtf(ss * (1.f / 64.f) + NORM_EPS);
            const float* g = type == 1 ? nw[0] : (type == 2 ? nw[1] : (type == 3 ? nw[2] : nw[3]));
            const f32x4 g0 = *(const GAS f32x4*)(g + l8 * 8), g1 = *(const GAS f32x4*)(g + l8 * 8 + 4);
            x[0] *= rstd * g0.x; x[1] *= rstd * g0.y; x[2] *= rstd * g0.z; x[3] *= rstd * g0.w; x[4] *= rstd * g1.x; x[5] *= rstd * g1.y; x[6] *= rstd * g1.z; x[7] *= rstd * g1.w;
            float px[8];
#pragma unroll
            for (int j = 0; j < 8; ++j) px[j] = shx(x[j], 2, F.lane);
            if (lat && (type == 1 || type == 2)) {
                const int pos = (l8 & 4) ? pcol : prow; const float* cs = rt + pos * 16 + (l8 & 1) * 8;
                const f32x4 c0 = *(const GAS f32x4*)(cs), c1 = *(const GAS f32x4*)(cs + 4), s0 = *(const GAS f32x4*)(cs + 2048), s1 = *(const GAS f32x4*)(cs + 2052);
                const float cc[8] = {c0.x, c0.y, c0.z, c0.w, c1.x, c1.y, c1.z, c1.w}, sn[8] = {s0.x, s0.y, s0.z, s0.w, s1.x, s1.y, s1.z, s1.w};
                const float sgn = (l8 & 2) ? 1.f : -1.f;
#pragma unroll
                for (int j = 0; j < 8; ++j) x[j] = x[j] * cc[j] + sgn * px[j] * sn[j];
            }
            if (type == 1 || type == 3) {
#pragma unroll
                for (int j = 0; j < 8; ++j) x[j] *= qscale;
            }
            if (type != 0) rowp[pass * 64 + lane] = pack8(x);
        }
    }
}

__device__ __forceinline__ void cnorm_phase(Frame& F) {
    const bf16* CQKV = (const bf16*)(F.ws + WS_CQKV); bf16* CQN = (bf16*)(F.ws + WS_CQN); bf16* CKVN = (bf16*)(F.ws + WS_CKVN); bf16* KR = (bf16*)(F.ws + WS_KR);
    const float* rt = (const float*)(F.ws + WS_ROPE) + 4096;
    const float* gq = ARG(19); const float* gkv = ARG(20); const float* gkr = ARG(26);
    const int gw = F.vcu * NWAVES + F.wave, NGW = F.G * NWAVES; const int lane = F.lane;
    for (int m = gw; m < MR; m += NGW) {
        const bool lat = m < ML; const int t = m & (SEQ - 1); const int prow = t >> 6, pcol = t & 63;
        const GAS v4u* rowp = (const GAS v4u*)(CQKV + (size_t)m * NCIN);
        const v4u w0 = rowp[lane]; v4u w1 = {0u, 0u, 0u, 0u}; if (lane < 32) w1 = rowp[64 + lane];
        float x0[8], x1[8]; unpack8(w0, x0); unpack8(w1, x1);
        float s0 = 0.f, s1 = 0.f;
#pragma unroll
        for (int j = 0; j < 8; ++j) { s0 += x0[j] * x0[j]; s1 += x1[j] * x1[j]; }
        const float ssq = wave_sum(lane < 48 ? s0 : 0.f, F.lane);
        const float sskv = wave_sum((lane >= 48 ? s0 : 0.f) + (lane < 16 ? s1 : 0.f), F.lane);
        const float sskr = wave_sum((lane >= 16 && lane < 20) ? s1 : 0.f, F.lane);
        const float rq = 1.f / sqrtf(ssq * (1.f / 384.f) + NORM_EPS), rkv = 1.f / sqrtf(sskv * (1.f / 256.f) + NORM_EPS), rkr = 1.f / sqrtf(sskr * (1.f / 32.f) + NORM_EPS);
        { const float* g = lane < 48 ? gq + lane * 8 : gkv + (lane - 48) * 8; const float r = lane < 48 ? rq : rkv;
          const f32x4 g0 = *(const GAS f32x4*)(g), g1 = *(const GAS f32x4*)(g + 4);
          float y[8] = {x0[0] * r * g0.x, x0[1] * r * g0.y, x0[2] * r * g0.z, x0[3] * r * g0.w, x0[4] * r * g1.x, x0[5] * r * g1.y, x0[6] * r * g1.z, x0[7] * r * g1.w};
          if (lane < 48) *(GAS v4u*)(CQN + (size_t)m * 384 + lane * 8) = pack8(y); else *(GAS v4u*)(CKVN + (size_t)m * 256 + (lane - 48) * 8) = pack8(y); }
        { const int li = lane < 16 ? lane : (lane < 20 ? lane - 16 : 0);
          const float* g = lane < 16 ? gkv + 128 + li * 8 : gkr + li * 8; const float r = lane < 16 ? rkv : rkr;
          const f32x4 g0 = *(const GAS f32x4*)(g), g1 = *(const GAS f32x4*)(g + 4);
          float y[8] = {x1[0] * r * g0.x, x1[1] * r * g0.y, x1[2] * r * g0.z, x1[3] * r * g0.w, x1[4] * r * g1.x, x1[5] * r * g1.y, x1[6] * r * g1.z, x1[7] * r * g1.w};
          float py[8];
#pragma unroll
          for (int j = 0; j < 8; ++j) py[j] = shx(y[j], 1, F.lane);
          if (lat && lane >= 16 && lane < 20) {
              const int pos = (lane & 2) ? pcol : prow; const float* cs = rt + pos * 8;
              const f32x4 c0 = *(const GAS f32x4*)(cs), c1 = *(const GAS f32x4*)(cs + 4), sa = *(const GAS f32x4*)(cs + 1024), sb = *(const GAS f32x4*)(cs + 1028);
              const float cc[8] = {c0.x, c0.y, c0.z, c0.w, c1.x, c1.y, c1.z, c1.w}, sn[8] = {sa.x, sa.y, sa.z, sa.w, sb.x, sb.y, sb.z, sb.w};
              const float sgn = (lane & 1) ? 1.f : -1.f;
#pragma unroll
              for (int j = 0; j < 8; ++j) y[j] = y[j] * cc[j] + sgn * py[j] * sn[j];
          }
          if (lane < 16) *(GAS v4u*)(CKVN + (size_t)m * 256 + 128 + lane * 8) = pack8(y);
          else if (lane < 20) *(GAS v4u*)(KR + (size_t)m * 32 + (lane - 16) * 8) = pack8(y); }
    }
}

__device__ __forceinline__ void hnorm_phase(Frame& F) {
    bf16* Q = (bf16*)(F.ws + WS_Q1); bf16* KV = (bf16*)(F.ws + WS_KV1);
    const float* rt = (const float*)(F.ws + WS_ROPE) + 4096;
    const float* gqn = ARG(23); const float* gqr = ARG(24); const float* gkn = ARG(25);
    const float qscale = 0.10206207261596575f * att::LOG2E;
    const int gw = F.vcu * NWAVES + F.wave, NGW = F.G * NWAVES; const int lane = F.lane, l8 = lane & 7, l4 = lane & 3;
    for (int m = gw; m < MR; m += NGW) {
        const bool lat = m < ML; const int t = m & (SEQ - 1); const int prow = t >> 6, pcol = t & 63;
        { GAS v4u* rowp = (GAS v4u*)(KV + (size_t)m * NUKV);
          const f32x4 g0 = *(const GAS f32x4*)(gkn + l8 * 8), g1 = *(const GAS f32x4*)(gkn + l8 * 8 + 4);
#pragma unroll
          for (int pass = 0; pass < 2; ++pass) {
              float x[8]; unpack8(rowp[pass * 64 + lane], x); float ss = 0.f;
#pragma unroll
              for (int j = 0; j < 8; ++j) ss += x[j] * x[j];
              ss += shx(ss, 1, F.lane); ss += shx(ss, 2, F.lane); ss += shx(ss, 4, F.lane);
              const float r = 1.f / sqrtf(ss * (1.f / 64.f) + NORM_EPS);
              x[0] *= r * g0.x; x[1] *= r * g0.y; x[2] *= r * g0.z; x[3] *= r * g0.w; x[4] *= r * g1.x; x[5] *= r * g1.y; x[6] *= r * g1.z; x[7] *= r * g1.w;
              rowp[pass * 64 + lane] = pack8(x); } }
        if (lat) {
            GAS v4u* rowp = (GAS v4u*)(Q + (size_t)m * NUQ);
            { const f32x4 g0 = *(const GAS f32x4*)(gqn + l8 * 8), g1 = *(const GAS f32x4*)(gqn + l8 * 8 + 4);
#pragma unroll
              for (int pass = 0; pass < 2; ++pass) {
                  float x[8]; unpack8(rowp[pass * 64 + lane], x); float ss = 0.f;
#pragma unroll
                  for (int j = 0; j < 8; ++j) ss += x[j] * x[j];
                  ss += shx(ss, 1, F.lane); ss += shx(ss, 2, F.lane); ss += shx(ss, 4, F.lane);
                  const float r = qscale / sqrtf(ss * (1.f / 64.f) + NORM_EPS);
                  x[0] *= r * g0.x; x[1] *= r * g0.y; x[2] *= r * g0.z; x[3] *= r * g0.w; x[4] *= r * g1.x; x[5] *= r * g1.y; x[6] *= r * g1.z; x[7] *= r * g1.w;
                  rowp[pass * 64 + lane] = pack8(x); } }
            {
              const f32x4 g0 = *(const GAS f32x4*)(gqr + l4 * 8), g1 = *(const GAS f32x4*)(gqr + l4 * 8 + 4);
              float x[8]; unpack8(rowp[128 + lane], x); float ss = 0.f;
#pragma unroll
              for (int j = 0; j < 8; ++j) ss += x[j] * x[j];
              ss += shx(ss, 1, F.lane); ss += shx(ss, 2, F.lane);
              const float r = 1.f / sqrtf(ss * (1.f / 32.f) + NORM_EPS);
              x[0] *= r * g0.x; x[1] *= r * g0.y; x[2] *= r * g0.z; x[3] *= r * g0.w; x[4] *= r * g1.x; x[5] *= r * g1.y; x[6] *= r * g1.z; x[7] *= r * g1.w;
              float px[8];
#pragma unroll
              for (int j = 0; j < 8; ++j) px[j] = shx(x[j], 1, F.lane);
              const int pos = (l4 & 2) ? pcol : prow; const float* cs = rt + pos * 8;
              const f32x4 c0 = *(const GAS f32x4*)(cs), c1 = *(const GAS f32x4*)(cs + 4), sa = *(const GAS f32x4*)(cs + 1024), sb = *(const GAS f32x4*)(cs + 1028);
              const float cc[8] = {c0.x, c0.y, c0.z, c0.w, c1.x, c1.y, c1.z, c1.w}, sn[8] = {sa.x, sa.y, sa.z, sa.w, sb.x, sb.y, sb.z, sb.w};
              const float sgn = (l4 & 1) ? 1.f : -1.f;
#pragma unroll
              for (int j = 0; j < 8; ++j) x[j] = (x[j] * cc[j] + sgn * px[j] * sn[j]) * qscale;
              rowp[128 + lane] = pack8(x); }
        }
    }
}

__device__ __forceinline__ void attn0_phase(Frame& F) {
    att::lchar* lds = (att::lchar*)(F.lds + RING_OFF);
    const att::bf16* QKV = (const att::bf16*)(F.ws + WS_QKV); att::bf16* O = (att::bf16*)(F.ws + WS_O0);
    bool fast;
    { float a = fabsf(ARG(12)[F.lane]), b_ = fabsf(ARG(13)[F.lane]), c_ = fabsf(ARG(15)[F.lane]), d_ = fabsf(ARG(16)[F.lane]), e_ = 0.f, f_ = fabsf(ARG(14)[F.lane & 7]);
      for (int i = F.lane; i < 8 * 465; i += 64) e_ = fmaxf(e_, fabsf(ARG(17)[i]));
#pragma unroll
      for (int o_ = 1; o_ < 64; o_ <<= 1) { a = fmaxf(a, shx(a, o_, F.lane)); b_ = fmaxf(b_, shx(b_, o_, F.lane)); c_ = fmaxf(c_, shx(c_, o_, F.lane)); d_ = fmaxf(d_, shx(d_, o_, F.lane)); e_ = fmaxf(e_, shx(e_, o_, F.lane)); f_ = fmaxf(f_, shx(f_, o_, F.lane)); }
      const float bound = fmaxf(fmaxf(8.f * a * b_, 8.f * c_ * d_ + e_), f_) * att::LOG2E;
      fast = __builtin_amdgcn_readfirstlane(bound < 64.f ? 1 : 0) != 0; }
    char* shm = (char*)(F.lds + RING_OFF);
    for (int ui = F.vcu; ui < 1056; ui += F.G) {
        if (ui < 512) {
            const int b = ui >> 8, h = (ui >> 5) & 7, R4 = ui & 31;
            const float* rpb = ARG(17) + h * 465;
            if (fast) {
                float* rl = (float*)(shm + attf::LDS_RPB);
                for (int i = F.tid; i < 465; i += NWAVES * 64) rl[i] = rpb[i] * att::LOG2E;
                __syncthreads();
                attf::FNa fu; fu.init((const attf::bf16*)QKV, (attf::bf16*)O, rl, b, h, R4);
                attf::fast_unit<8, attf::FNa>(fu, shm, F.tid);
            } else {
                att::UNa u; u.QKV = QKV; u.O = O; u.rpbl = (const LAS float*)(lds + att::L_RPB); u.b = b; u.h = h; u.R4 = R4; u.init();
                for (int i = F.tid; i < 465; i += NWAVES * 64) ((LAS float*)(lds + att::L_RPB))[i] = rpb[i] * att::LOG2E;
                att::unit<8, att::UNa>(u, lds, F.tid);
            }
        } else if (ui < 1024) {
            const int v = ui - 512;
            if (fast) { attf::FWin fu; fu.init((const attf::bf16*)QKV, (attf::bf16*)O, ARG(14), v >> 8, (v >> 2) & 63, (v >> 1) & 1, v & 1); attf::fast_unit<8, attf::FWin>(fu, shm, F.tid); }
            else { att::UWin u; u.QKV = QKV; u.O = O; u.sinkp = ARG(14); u.b = v >> 8; u.n = (v >> 2) & 63; u.g = (v >> 1) & 1; u.hh = v & 1; u.init(); att::unit<8, att::UWin>(u, lds, F.tid); }
        } else {
            const int v = ui - 1024;
            if (fast) { attf::FCtx fu; fu.init((const attf::bf16*)QKV, (attf::bf16*)O, ARG(14), v >> 4, v & 15); attf::fast_unit<8, attf::FCtx>(fu, shm, F.tid); }
            else { att::UCtx u; u.QKV = QKV; u.O = O; u.sinkp = ARG(14); u.b = v >> 4; u.hx = v & 15; u.init(); att::unit<8, att::UCtx>(u, lds, F.tid); }
        }
    }
}
__device__ __forceinline__ void attn1_phase(Frame& F) {
    att::lchar* lds = (att::lchar*)(F.lds + RING_OFF);
    bool fast;
    { float a = fabsf(ARG(23)[F.lane]), b_ = fabsf(ARG(25)[F.lane]), c_ = fabsf(ARG(24)[F.lane & 31]), d_ = fabsf(ARG(26)[F.lane & 31]);
#pragma unroll
      for (int o_ = 1; o_ < 64; o_ <<= 1) { a = fmaxf(a, shx(a, o_, F.lane)); b_ = fmaxf(b_, shx(b_, o_, F.lane)); c_ = fmaxf(c_, shx(c_, o_, F.lane)); d_ = fmaxf(d_, shx(d_, o_, F.lane)); }
      const float bound = (64.f * a * b_ + 32.f * c_ * d_) * (0.10206207261596575f * att::LOG2E);
      fast = __builtin_amdgcn_readfirstlane(bound < 64.f ? 1 : 0) != 0; }
    const bool g256 = F.G == 256; const int x = F.vcu >> 5, j = F.vcu & 31;
    const int nit = g256 ? 4 : (F.vcu < 1024 ? (1024 - F.vcu + F.G - 1) / F.G : 0);
    for (int i = 0; i < nit; ++i) {
        const int ui = g256 ? ((x * 4 + i) * 32 + j) : F.vcu + i * F.G;
        if (fast) attd::dense_unit(ui >> 9, (ui >> 5) & 15, ui & 31, (const attd::bf16*)(F.ws + WS_Q1), (const attd::bf16*)(F.ws + WS_KV1), (const attd::bf16*)(F.ws + WS_KR), (attd::bf16*)(F.ws + WS_O1), (char*)(F.lds + RING_OFF), F.tid);
        else {
        att::UDense u; u.Q = (const att::bf16*)(F.ws + WS_Q1); u.KV = (const att::bf16*)(F.ws + WS_KV1); u.KR = (const att::bf16*)(F.ws + WS_KR); u.O = (att::bf16*)(F.ws + WS_O1);
        u.b = ui >> 9; u.h = (ui >> 5) & 15; u.qb = ui & 31;
        att::unit<12, att::UDense>(u, lds, F.tid); }
    }
}

#ifndef PHASE_MASK
#define PHASE_MASK 0xFFFFFu
#endif
#ifndef PHASE_REP
#define PHASE_REP 0u
#endif
struct Args { const float* in[28]; float* out; unsigned char* ws; int ph_lo, ph_hi; };
constexpr int N_PHASES = 19;
__global__ void __launch_bounds__(NWAVES * 64, 2) fwd_kernel(Args args) {
    extern __shared__ __attribute__((aligned(16))) unsigned char lds[];
    for (int u = threadIdx.x; u < (LDS_BYTES - LDSCTL_OFF) / 4; u += NWAVES * 64) ((LAS unsigned*)((LAS unsigned char*)lds + LDSCTL_OFF))[u] = 0u;
    __syncthreads();
    if (!MK_PER_PHASE) (void)xcd_barrier_post((unsigned*)((gu32*)(ARG_WS + WS_CTL) + CW_BAR), (volatile LAS unsigned*)((LAS unsigned char*)lds + MISC_OFF) + 8);
    for (int ph2 = 2 * args.ph_lo; ph2 < 2 * args.ph_hi; ++ph2) {
        const int ph = ph2 >> 1; if ((ph2 & 1) && !((PHASE_REP >> ph) & 1)) continue;
        if (ph == 3 || ph == 14) continue;
        Frame F;
        { int t_ = threadIdx.x; asm volatile("" : "+v"(t_)); int b_ = blockIdx.x; asm volatile("" : "+s"(b_)); int g_ = gridDim.x; asm volatile("" : "+s"(g_)); F.tid = t_; F.bx = b_; F.G = g_; }
        F.lds = (LAS unsigned char*)lds; F.MISC = (volatile LAS unsigned*)(F.lds + MISC_OFF);
        F.lane = F.tid & 63; F.wave = __builtin_amdgcn_readfirstlane(F.tid >> 6);
        F.vcu = (F.G % 8 == 0) ? (F.bx % 8) * (F.G / 8) + F.bx / 8 : F.bx;
        F.ws = ARG_WS; F.out = ARG_OUT; F.ctl = (gu32*)(F.ws + WS_CTL);
        XcdBarrier bar; bar.bar = (unsigned*)(F.ctl + CW_BAR); bar.x = xb_xcc_id(); bar.st = F.MISC + 8;
        float* ctxres = (float*)(F.ws + WS_CTXRES);
        const float* mod = (const float*)(F.ws + WS_MOD);
        int gk = 0, xrows = 0, xS = 0;
        pg8::Gemm g{nullptr, nullptr, 0, 0, 0}; pg8::EpiAny ea{0, nullptr, nullptr, nullptr, nullptr, 0, 0};
        switch (ph) {
        case 0: if (!((PHASE_MASK >> 0) & 1)) break; p0_prologue(F); break;
        case 1: if (!((PHASE_MASK >> 1) & 1)) break; norm_phase(F, ARG(0), ARG(2), MR, ARG(6), 0, 0, true); break;
        case 2: if (!((PHASE_MASK >> 2) & 1)) break; gk = 1; g = pg8::Gemm{(const bf16*)(F.ws + WS_XN), (const bf16*)(F.ws + WS_WQKV), MR, NQKV, DM}; ea = pg8::EpiAny{3, (const float*)(F.ws + WS_HPAR), (void*)(F.ws + WS_QKV), nullptr, (const float*)(F.ws + WS_ROPE), NQKV, 0}; break;
        case 4: if (!((PHASE_MASK >> 4) & 1)) break; attn0_phase(F); break;
        case 5: if (!((PHASE_MASK >> 5) & 1)) break; gk = 2; g = pg8::Gemm{(const bf16*)(F.ws + WS_O0), (const bf16*)(F.ws + WS_WO0), ML, DM, DM}; xrows = MC; xS = 2; ea = pg8::EpiAny{2, ARG(0), (void*)F.out, (float*)(F.ws + WS_PART5), mod + 2048, 0, 0}; break;
        case 6: if (!((PHASE_MASK >> 6) & 1)) break; norm_phase(F, F.out, ctxres, MR, ARG(7), 0, 1, false, (const float*)(F.ws + WS_PART5), 4); break;
        case 7: if (!((PHASE_MASK >> 7) & 1)) break; gk = 1; g = pg8::Gemm{(const bf16*)(F.ws + WS_XN), (const bf16*)(F.ws + WS_W1_0), MR, FF, DM}; ea = pg8::EpiAny{1, nullptr, (void*)(F.ws + WS_H), nullptr, nullptr, FF, 1}; break;
        case 8: if (!((PHASE_MASK >> 8) & 1)) break; gk = 2; g = pg8::Gemm{(const bf16*)(F.ws + WS_H), (const bf16*)(F.ws + WS_W2_0), ML, DM, FF}; xrows = MC; xS = 4; ea = pg8::EpiAny{2, F.out, (void*)F.out, (float*)(F.ws + WS_PART8), mod + 5120, 0, 0}; break;
        case 9: if (!((PHASE_MASK >> 9) & 1)) break; norm_phase(F, F.out, ctxres, MR, ARG(6) + DM, 1, 0, false, (const float*)(F.ws + WS_PART8), 16); break;
        case 10: if (!((PHASE_MASK >> 10) & 1)) break; gk = 1; g = pg8::Gemm{(const bf16*)(F.ws + WS_XN), (const bf16*)(F.ws + WS_WIN), MR, NCIN, DM}; ea = pg8::EpiAny{1, nullptr, (void*)(F.ws + WS_CQKV), nullptr, nullptr, NCIN, 0}; break;
        case 11: if (!((PHASE_MASK >> 11) & 1)) break; cnorm_phase(F); break;
        case 12: if (!((PHASE_MASK >> 12) & 1)) break; gk = 1; g = pg8::Gemm{(const bf16*)(F.ws + WS_CQN), (const bf16*)(F.ws + WS_WUQ), ML, NUQ, 384}; ea = pg8::EpiAny{3, (const float*)(F.ws + WS_HPAR), (void*)(F.ws + WS_Q1), nullptr, (const float*)(F.ws + WS_ROPE), NUQ, 1}; break;
        case 13: if (!((PHASE_MASK >> 13) & 1)) break; gk = 1; g = pg8::Gemm{(const bf16*)(F.ws + WS_CKVN), (const bf16*)(F.ws + WS_WUKV), MR, NUKV, 256}; ea = pg8::EpiAny{3, (const float*)(F.ws + WS_HPAR), (void*)(F.ws + WS_KV1), nullptr, (const float*)(F.ws + WS_ROPE), NUKV, 2}; break;
        case 15: if (!((PHASE_MASK >> 15) & 1)) break; attn1_phase(F); break;
        case 16: if (!((PHASE_MASK >> 16) & 1)) break; gk = 2; g = pg8::Gemm{(const bf16*)(F.ws + WS_O1), (const bf16*)(F.ws + WS_WO1), ML, DM, DM}; ea = pg8::EpiAny{2, F.out, (void*)F.out, ctxres, mod + 3 * 6144 + 2048, 0, 0}; break;
        case 17: if (!((PHASE_MASK >> 17) & 1)) break; norm_phase(F, F.out, ctxres, ML, ARG(7) + DM, 1, 1, false); break;
        case 18: if (!((PHASE_MASK >> 18) & 1)) break; gk = 1; g = pg8::Gemm{(const bf16*)(F.ws + WS_XN), (const bf16*)(F.ws + WS_W1_1), ML, FF, DM}; ea = pg8::EpiAny{1, nullptr, (void*)(F.ws + WS_H), nullptr, nullptr, FF, 1}; break;
        case 19: if (!((PHASE_MASK >> 19) & 1)) break; gk = 2; g = pg8::Gemm{(const bf16*)(F.ws + WS_H), (const bf16*)(F.ws + WS_W2_1), ML, DM, FF}; ea = pg8::EpiAny{2, F.out, (void*)F.out, ctxres, mod + 3 * 6144 + 5120, 0, 0}; break;
        default: break;
        }
        if (gk != 0) { pg8::StaticOrder S; S.init(g.M, g.N, g.K, F.G, F.bx, xrows, xS); pg8::gemm_phase<pg8::EpiAny, pg8::StaticOrder, true, true>(F.lds + RING_OFF, g, S, ea, F.tid); }
        const bool last_ = (ph == args.ph_hi - 1) && ((ph2 & 1) || !((PHASE_REP >> ph) & 1));
        if (!MK_PER_PHASE && !last_ && ph != 12) xcd_barrier(bar);
        else __syncthreads();
    }
}

extern "C" void kernel_launch(void* const* d_in, const int* in_sizes, int n_in, void* d_out, int out_size, void* d_ws, size_t ws_size, hipStream_t stream) {
    static int grid = 0;
    if (grid == 0) {
        if (n_in != 28 || in_sizes[0] != ML * DM || out_size != ML * DM || ws_size < WS_END) { fprintf(stderr, "kernel_launch: unexpected shapes: n_in %d in0 %d out %d ws %zu\n", n_in, n_in > 0 ? in_sizes[0] : -1, out_size, ws_size); grid = -1; return; }
        int dev = 0, cus = 0, per_cu = 0;
        if (hipGetDevice(&dev) != hipSuccess || hipDeviceGetAttribute(&cus, hipDeviceAttributeMultiprocessorCount, dev) != hipSuccess) { fprintf(stderr, "kernel_launch: device query failed\n"); grid = -1; return; }
        if (hipFuncSetAttribute((const void*)fwd_kernel, hipFuncAttributeMaxDynamicSharedMemorySize, LDS_BYTES) != hipSuccess) { fprintf(stderr, "kernel_launch: hipFuncSetAttribute failed\n"); grid = -1; return; }
        if (hipOccupancyMaxActiveBlocksPerMultiprocessor(&per_cu, (const void*)fwd_kernel, NWAVES * 64, LDS_BYTES) != hipSuccess || per_cu < 1)
            fprintf(stderr, "kernel_launch: note: occupancy query reports %d workgroups per CU\n", per_cu);
        (void)hipGetLastError();
        grid = cus;
    }
    if (grid < 0) return;
    if (hipMemsetAsync((char*)d_ws + WS_CTL, 0, CTL_ZERO_BYTES, stream) != hipSuccess) { fprintf(stderr, "kernel_launch: hipMemsetAsync failed\n"); return; }
    Args a{};
    for (int i = 0; i < 28; ++i) a.in[i] = (const float*)d_in[i];
    a.out = (float*)d_out; a.ws = (unsigned char*)d_ws;
#if MK_PER_PHASE
    for (int ph = 0; ph <= N_PHASES; ++ph) { a.ph_lo = ph; a.ph_hi = ph + 1; hipLaunchKernelGGL(fwd_kernel, dim3(grid), dim3(NWAVES * 64), LDS_BYTES, stream, a); }
#else
    a.ph_lo = 0; a.ph_hi = N_PHASES + 1;
    hipLaunchKernelGGL(fwd_kernel, dim3(grid), dim3(NWAVES * 64), LDS_BYTES, stream, a);
#endif
    const hipError_t le = hipPeekAtLastError();
    if (le != hipSuccess) fprintf(stderr, "kernel_launch: launch failed: %s\n", hipGetErrorName(le));
}
```

```cpp
#include <hip/hip_runtime.h>
#include <cstdio>
#include <cstdint>
namespace pg8 {
#define PG8_LAS __attribute__((address_space(3)))
typedef unsigned short bf16_t;
typedef short bf16x8 __attribute__((ext_vector_type(8)));
typedef float f32x4 __attribute__((ext_vector_type(4)));
typedef unsigned u32x4 __attribute__((ext_vector_type(4)));
constexpr int BM = 256, BK = 64, HALF = 128, HTB = HALF * BK * 2  , STAGE_BYTES = 8 * HTB, NXCD = 8, WGM = 8;

__host__ __device__ __forceinline__ int lds_byte(int r, int c) { const int st = (r >> 4) * 2 + (c >> 5), rr = r & 15, cc = c & 31, ob = rr * 64 + cc * 2; return st * 1024 + (ob ^ (((ob >> 9) & 1) << 5)); }
__host__ __device__ __forceinline__ void stage_rc(int b, int& R, int& C) { const int st = b / 1024, sb = b % 1024, swz = sb ^ (((sb >> 9) & 1) << 5); R = (st >> 1) * 16 + swz / 64; C = (st & 1) * 32 + (swz % 64) / 2; }
__host__ __device__ __forceinline__ int perm32(int rho) { const int n = rho >> 4, i = rho & 15; return 8 * (i >> 2) + 4 * n + (i & 3); }

struct Unit { int pm, pn, kinfo; };
struct Gemm { const bf16_t* A; const bf16_t* Bt; int M, N, K; };

struct StaticOrder {
    int nM, nN, nwg, G, c, ntK;
    int xtiles, xsh;
    __host__ __device__ void init(int M, int N, int K, int G_, int c_, int extra_rows = 0, int S = 1) { nM = M / BM; nN = N / BM; nwg = nM * nN; G = G_; c = c_; ntK = K / BK;
        xtiles = (extra_rows / BM) * nN; xsh = S; }
    __host__ __device__ bool next(int i, Unit& u) const {
        const long L = (long)i * G + c;
        if (L >= nwg) {
            if (xtiles == 0) return false;
            const int nb = (nwg - c + G - 1) / G;
            const int nbc = c < nwg ? nb : 0;
            const long e = (long)(i - nbc) * G + ((c + G - (nwg % G)) % G);
            if (e >= ((long)xtiles << xsh)) return false;
            const int tile = (int)(e >> xsh), ks = (int)e & ((1 << xsh) - 1), xnt = ntK >> xsh;
            u.pm = nM + tile / nN; u.pn = tile % nN; u.kinfo = (ks * xnt) | (xnt << 8) | (1 << 16); return true;
        }
        int wgid = (int)L; { const int q = nwg / NXCD, r = nwg % NXCD, xcd = wgid % NXCD, off = wgid / NXCD; wgid = (xcd < r ? xcd * (q + 1) : r * (q + 1) + (xcd - r) * q) + off; }
        const int nig = WGM * nN, gid = wgid / nig, fm = gid * WGM, gsz = (nM - fm) < WGM ? (nM - fm) : WGM;
        u.pm = fm + ((wgid % nig) % gsz); u.pn = (wgid % nig) / gsz; u.kinfo = ntK << 8; return true;
    }
    __device__ __forceinline__ void a_ready(const Unit&) const {}
    __device__ __forceinline__ void done(const Unit&) const {}
};

__device__ __forceinline__ unsigned cvt_pk_bf16(float lo, float hi) { unsigned r; asm volatile("v_cvt_pk_bf16_f32 %0, %1, %2" : "=v"(r) : "v"(lo), "v"(hi)); return r; }
struct EpiAny {
    static constexpr bool AFTER_DRAIN = false;
    int mode; const float* base; void* out; float* ctxres; const float* gate; int ldc, relu2;
    __device__ __forceinline__ bool perm() const { return mode == 1; }
    __device__ __forceinline__ bool headmode() const { return mode == 3; }
    __device__ __forceinline__ static float xsh(float v, int mask, int lane) { return __builtin_bit_cast(float, __builtin_amdgcn_ds_bpermute((lane ^ mask) << 2, __builtin_bit_cast(int, v))); }
    __device__ __forceinline__ void head_epilogue(const f32x4 (&acc)[2][2][4][2], const Unit& u, int wr, int wc, int fr, int fq) const {
        const int H = 4 * u.pn + wc, kind = relu2, lane = fr + 16 * fq;
        int cls, gsel; float qs = 1.f;
        if (kind == 0) { if (H < 8) { cls = 2; gsel = 0; qs = 0.125f * 1.4426950408889634f; } else if (H < 10) { cls = 2; gsel = 1; } else if (H < 12) { cls = 0; gsel = 0; }
                         else if (H < 20) { cls = 1; gsel = 2; qs = 0.125f * 1.4426950408889634f; } else if (H < 28) { cls = 1; gsel = 3; } else { cls = 0; gsel = 0; } }
        else if (kind == 1) { qs = 0.10206207261596575f * 1.4426950408889634f; if (H < 16) { cls = 1; gsel = 4; } else { cls = 3; gsel = 5; } }
        else { if (H < 16) { cls = 1; gsel = 6; } else { cls = 0; gsel = 0; } }
        const bool lat = u.pm < 64;
        bf16_t* O = (bf16_t*)out;
        const int col0 = u.pn * BM + 64 * wc + 8 * fq;
        f32x4 gv[2][2];
#pragma unroll
        for (int bj = 0; bj < 2; ++bj)
#pragma unroll
            for (int n = 0; n < 2; ++n) gv[bj][n] = *(const f32x4*)(base + gsel * 64 + 32 * bj + 8 * fq + 4 * n);
#pragma unroll
        for (int ai = 0; ai < 2; ++ai)
#pragma unroll
            for (int m = 0; m < 4; ++m) {
                const int row = u.pm * BM + ai * HALF + wr * 64 + m * 16 + fr;
                f32x4 v[2][2];
#pragma unroll
                for (int bj = 0; bj < 2; ++bj)
#pragma unroll
                    for (int n = 0; n < 2; ++n) v[bj][n] = acc[ai][bj][m][n];
                if (cls != 0) {
                    float s0 = 0.f, s1 = 0.f;
#pragma unroll
                    for (int n = 0; n < 2; ++n)
#pragma unroll
                        for (int e = 0; e < 4; ++e) { s0 += v[0][n][e] * v[0][n][e]; s1 += v[1][n][e] * v[1][n][e]; }
                    if (cls != 3) { s0 += s1; s0 += xsh(s0, 16, lane); s0 += xsh(s0, 32, lane); s0 = s0 * (1.f / 64.f); s1 = s0; }
                    else { s0 += xsh(s0, 16, lane); s0 += xsh(s0, 32, lane); s1 += xsh(s1, 16, lane); s1 += xsh(s1, 32, lane); s0 *= (1.f / 32.f); s1 *= (1.f / 32.f); }
                    const float r0 = 1.f / sqrtf(s0 + 1e-6f), r1 = 1.f / sqrtf(s1 + 1e-6f);
#pragma unroll
                    for (int n = 0; n < 2; ++n) { v[0][n] = v[0][n] * r0 * gv[0][n]; v[1][n] = v[1][n] * r1 * gv[1][n]; }
                    if (lat && cls == 2) {
                        const int t = row & 8191;
#pragma unroll
                        for (int bj = 0; bj < 2; ++bj) { const int pos = bj == 0 ? (t >> 6) : (t & 63); const float sgn = fq < 2 ? -1.f : 1.f;
#pragma unroll
                            for (int n = 0; n < 2; ++n) { const float* cs = gate + pos * 16 + 8 * (fq & 1) + 4 * n; const f32x4 c = *(const f32x4*)cs, sn = *(const f32x4*)(cs + 2048);
                                f32x4 p;
#pragma unroll
                                for (int e = 0; e < 4; ++e) p[e] = xsh(v[bj][n][e], 32, lane);
                                v[bj][n] = v[bj][n] * c + (p * sgn) * sn; } }
                    }
                    if (lat && cls == 3) {
                        const int t = row & 8191; const int pos = fq < 2 ? (t >> 6) : (t & 63); const float sgn = (fq & 1) ? 1.f : -1.f;
#pragma unroll
                        for (int bj = 0; bj < 2; ++bj)
#pragma unroll
                            for (int n = 0; n < 2; ++n) { const float* cs = gate + 4096 + pos * 8 + 4 * n; const f32x4 c = *(const f32x4*)cs, sn = *(const f32x4*)(cs + 1024);
                                f32x4 p;
#pragma unroll
                                for (int e = 0; e < 4; ++e) p[e] = xsh(v[bj][n][e], 16, lane);
                                v[bj][n] = v[bj][n] * c + (p * sgn) * sn; }
                    }
                    if (qs != 1.f) {
#pragma unroll
                        for (int bj = 0; bj < 2; ++bj)
#pragma unroll
                            for (int n = 0; n < 2; ++n) v[bj][n] = v[bj][n] * qs; }
                }
                bf16_t* rowp = O + (size_t)row * ldc + col0;
#pragma unroll
                for (int bj = 0; bj < 2; ++bj) { u32x4 w; w.x = cvt_pk_bf16(v[bj][0][0], v[bj][0][1]); w.y = cvt_pk_bf16(v[bj][0][2], v[bj][0][3]); w.z = cvt_pk_bf16(v[bj][1][0], v[bj][1][1]); w.w = cvt_pk_bf16(v[bj][1][2], v[bj][1][3]);
                    *(u32x4*)(rowp + 32 * bj) = w; }
            }
    }
    __device__ __forceinline__ void operator()(const f32x4 (&acc)[2][2][4][2], const Unit& u, int wr, int wc, int fr, int fq) const {
        asm volatile("" : "+v"(fr), "+v"(fq));
        if (mode == 1) {
            bf16_t* O = (bf16_t*)out;
            const int row0 = u.pm * BM + wr * 64 + fr, col0 = u.pn * BM + wc * 32 + 8 * fq;
#pragma unroll
            for (int ai = 0; ai < 2; ++ai)
#pragma unroll
                for (int m = 0; m < 4; ++m) { bf16_t* rowp = O + (size_t)(row0 + ai * HALF + m * 16) * ldc + col0;
#pragma unroll
                    for (int bj = 0; bj < 2; ++bj) { f32x4 v0 = acc[ai][bj][m][0], v1 = acc[ai][bj][m][1];
                        if (relu2) {
#pragma unroll
                            for (int e = 0; e < 4; ++e) { float a = fmaxf(v0[e], 0.f), b = fmaxf(v1[e], 0.f); v0[e] = a * a; v1[e] = b * b; } }
                        u32x4 w; w.x = cvt_pk_bf16(v0[0], v0[1]); w.y = cvt_pk_bf16(v0[2], v0[3]); w.z = cvt_pk_bf16(v1[0], v1[1]); w.w = cvt_pk_bf16(v1[2], v1[3]);
                        *(u32x4*)(rowp + bj * HALF) = w; } }
            return;
        }
        if (mode == 3) { head_epilogue(acc, u, wr, wc, fr, fq); return; }
        const int t0 = u.pm * BM; const bool split = (u.kinfo >> 16) != 0; const int cond = t0 < 8192 ? 0 : (t0 < 16384 ? 1 : 2);
        const int col0 = u.pn * BM + wc * 32 + 4 * fq; const float* g = gate + cond * 6144 + col0;
        f32x4 gv[2][2];
#pragma unroll
        for (int bj = 0; bj < 2; ++bj)
#pragma unroll
            for (int n = 0; n < 2; ++n) gv[bj][n] = *(const f32x4*)(g + bj * HALF + n * 16);
        if (split) {
            const int ks = (u.kinfo & 255) / ((u.kinfo >> 8) & 255);
            float* op = ctxres + (size_t)ks * (512 * 1024) + (size_t)(t0 - 16384) * 1024;
#pragma unroll
            for (int ai = 0; ai < 2; ++ai)
#pragma unroll
                for (int m = 0; m < 4; ++m) { const size_t off = (size_t)(wr * 64 + fr + ai * HALF + m * 16) * 1024 + col0;
#pragma unroll
                    for (int bj = 0; bj < 2; ++bj)
#pragma unroll
                        for (int n = 0; n < 2; ++n) *(f32x4*)(op + off + bj * HALF + n * 16) = gv[bj][n] * acc[ai][bj][m][n]; }
            return;
        }
        const float* bp = base + (size_t)t0 * 1024; float* op = (float*)out + (size_t)t0 * 1024;
#pragma unroll
        for (int ai = 0; ai < 2; ++ai)
#pragma unroll
            for (int m = 0; m < 4; ++m) { const size_t off = (size_t)(wr * 64 + fr + ai * HALF + m * 16) * 1024 + col0;
#pragma unroll
                for (int bj = 0; bj < 2; ++bj)
#pragma unroll
                    for (int n = 0; n < 2; ++n) { const f32x4 b = *(const f32x4*)(bp + off + bj * HALF + n * 16);
                        *(f32x4*)(op + off + bj * HALF + n * 16) = b + gv[bj][n] * acc[ai][bj][m][n]; } }
    }
};

template <class Epi, class Sched, bool ALIGN_EPI = false, bool SP2 = false>
__device__ __forceinline__ void gemm_phase(PG8_LAS unsigned char* lds, const Gemm g, const Sched& S, const Epi& E, const int tid) {
    const int wid = __builtin_amdgcn_readfirstlane(tid >> 6), lane = tid & 63, wr = wid >> 2, wc = wid & 3, fr = lane & 15, fq = lane >> 4;
    const int K = g.K;
    unsigned voffA[2], voffB[2];
#pragma unroll
    for (int i = 0; i < 2; ++i) { int R, C; stage_rc(tid * 16 + i * 8192, R, C); const int Rb = E.headmode() ? (64 * (R >> 5) + perm32(R & 31)) : (E.perm() ? ((R & ~31) + perm32(R & 31)) : R);
        voffA[i] = (unsigned)(R * K + C) * 2u; voffB[i] = (unsigned)(Rb * K + C) * 2u; }
    const size_t kstep = (size_t)(BK * 2);
    const size_t hstep = (size_t)HALF * K * 2;
    const size_t tstep = 2 * hstep;
    const size_t hstepB = E.headmode() ? (size_t)32 * K * 2 : hstep;
    const unsigned ldsw = (unsigned)wid * 1024u;
    const int aoff = lds_byte(wr * 64 + fr, fq * 8), boff = lds_byte(wc * 32 + fr, fq * 8);
#define PG8_SA(b, h) (((b) * 2 + (h)) * HTB)
#define PG8_SB(b, h) ((4 + (b) * 2 + (h)) * HTB)
#define PG8_STAGE(bufoff, gbase, voff) do { _Pragma("unroll") for (int _i = 0; _i < 2; ++_i) \
        __builtin_amdgcn_global_load_lds((const unsigned*)((const char*)(gbase) + (voff)[_i]), (PG8_LAS unsigned*)(lds + (bufoff) + ldsw + _i * 8192), 16, 0, 0); } while (0)
#define PG8_LDA(dst, b, h) do { _Pragma("unroll") for (int m = 0; m < 4; ++m) _Pragma("unroll") for (int k = 0; k < 2; ++k) dst[m][k] = *(const PG8_LAS bf16x8*)(lds + PG8_SA(b, h) + aoff + m * 2048 + k * 1024); } while (0)
#define PG8_LDB(dst, b, h) do { _Pragma("unroll") for (int n = 0; n < 2; ++n) _Pragma("unroll") for (int k = 0; k < 2; ++k) dst[n][k] = *(const PG8_LAS bf16x8*)(lds + PG8_SB(b, h) + boff + n * 2048 + k * 1024); } while (0)
#define PG8_MMA(ai, bj, At, Bt) do { __builtin_amdgcn_s_setprio(1); _Pragma("unroll") for (int m = 0; m < 4; ++m) _Pragma("unroll") for (int n = 0; n < 2; ++n) _Pragma("unroll") for (int k = 0; k < 2; ++k) \
        acc[ai][bj][m][n] = __builtin_amdgcn_mfma_f32_16x16x32_bf16(Bt[n][k], At[m][k], acc[ai][bj][m][n], 0, 0, 0); __builtin_amdgcn_s_setprio(0); } while (0)
#define PG8_WAIT_V(n) asm volatile("s_waitcnt vmcnt(" #n ")" ::: "memory")
#define PG8_WAIT_L(n) asm volatile("s_waitcnt lgkmcnt(" #n ")" ::: "memory")
#define PG8_BAR __builtin_amdgcn_s_barrier()
#define PG8_SCHED __builtin_amdgcn_sched_barrier(0)
    Unit cur, nxt; int ui = 0;
    if (!S.next(0, cur)) return;
    f32x4 acc[2][2][4][2];
#pragma unroll
    for (int a = 0; a < 2; ++a)
#pragma unroll
        for (int b = 0; b < 2; ++b)
#pragma unroll
            for (int m = 0; m < 4; ++m)
#pragma unroll
                for (int n = 0; n < 2; ++n) acc[a][b][m][n] = (f32x4){0.f, 0.f, 0.f, 0.f};
    bf16x8 At[4][2], B0[2][2], B1[2][2];
    const char* cA = (const char*)g.A + (size_t)cur.pm * tstep + (size_t)(cur.kinfo & 255) * (BK * 2); const char* cB = (const char*)g.Bt + (size_t)cur.pn * tstep + (size_t)(cur.kinfo & 255) * (BK * 2);
    S.a_ready(cur);
    if constexpr (SP2) {
        PG8_STAGE(PG8_SB(0, 0), cB, voffB); PG8_STAGE(PG8_SB(0, 1), cB + hstepB, voffB); PG8_STAGE(PG8_SA(0, 0), cA, voffA); PG8_STAGE(PG8_SA(0, 1), cA + hstep, voffA);
        if (wr == 1) PG8_BAR;
        PG8_WAIT_V(2); PG8_BAR;
        PG8_STAGE(PG8_SB(1, 0), cB + kstep, voffB); PG8_STAGE(PG8_SA(1, 0), cA + kstep, voffA); PG8_STAGE(PG8_SB(1, 1), cB + hstepB + kstep, voffB);
        PG8_WAIT_V(6); PG8_BAR;
    } else {
        PG8_STAGE(PG8_SB(0, 0), cB, voffB); PG8_STAGE(PG8_SA(0, 0), cA, voffA); PG8_STAGE(PG8_SB(0, 1), cB + hstepB, voffB); PG8_STAGE(PG8_SA(0, 1), cA + hstep, voffA);
        if (wr == 1) PG8_BAR;
        PG8_WAIT_V(4); PG8_BAR;
        PG8_STAGE(PG8_SB(1, 0), cB + kstep, voffB); PG8_STAGE(PG8_SA(1, 0), cA + kstep, voffA); PG8_STAGE(PG8_SB(1, 1), cB + hstepB + kstep, voffB);
        PG8_WAIT_V(6); PG8_BAR;
    }
    for (;;) {
        const bool has_next = S.next(ui + 1, nxt);
        const char* nA = has_next ? (const char*)g.A + (size_t)nxt.pm * tstep + (size_t)(nxt.kinfo & 255) * (BK * 2) : cA; const char* nB = has_next ? (const char*)g.Bt + (size_t)nxt.pn * tstep + (size_t)(nxt.kinfo & 255) * (BK * 2) : cB;
        const int nt = (cur.kinfo >> 8) & 255;
        for (int t = 0; t < nt; t += 2) {
            const bool last = (t == nt - 2);
            const char* a1 = cA + (size_t)(t + 1) * kstep;
            const char* a2 = last ? nA : cA + (size_t)(t + 2) * kstep; const char* b2 = last ? nB : cB + (size_t)(t + 2) * kstep;
            const char* a3 = a2 + kstep; const char* b3 = b2 + kstep;
            if (last && has_next) S.a_ready(nxt);
            if constexpr (SP2) {
            PG8_LDB(B0, 0, 0); PG8_LDB(B1, 0, 1); PG8_SCHED; PG8_LDA(At, 0, 0); PG8_STAGE(PG8_SA(1, 1), a1 + hstep, voffA);
            PG8_WAIT_V(8); PG8_WAIT_L(0); PG8_BAR; PG8_MMA(0, 0, At, B0); PG8_MMA(0, 1, At, B1); PG8_BAR; PG8_SCHED;
            PG8_LDA(At, 0, 1); PG8_STAGE(PG8_SB(0, 0), b2, voffB); PG8_STAGE(PG8_SB(0, 1), b2 + hstepB, voffB); PG8_STAGE(PG8_SA(0, 0), a2, voffA);
            PG8_WAIT_V(8); PG8_WAIT_L(0); PG8_BAR; PG8_MMA(1, 0, At, B0); PG8_MMA(1, 1, At, B1); PG8_BAR; PG8_SCHED;
            PG8_LDB(B0, 1, 0); PG8_LDB(B1, 1, 1); PG8_SCHED; PG8_LDA(At, 1, 0); PG8_STAGE(PG8_SA(0, 1), a2 + hstep, voffA);
            PG8_WAIT_V(8); PG8_WAIT_L(0); PG8_BAR; PG8_MMA(0, 0, At, B0); PG8_MMA(0, 1, At, B1); PG8_BAR; PG8_SCHED;
            PG8_LDA(At, 1, 1); PG8_STAGE(PG8_SB(1, 0), b3, voffB); PG8_STAGE(PG8_SB(1, 1), b3 + hstepB, voffB); PG8_STAGE(PG8_SA(1, 0), a3, voffA);
            PG8_WAIT_V(8); PG8_WAIT_L(0); PG8_BAR; PG8_MMA(1, 0, At, B0); PG8_MMA(1, 1, At, B1); PG8_BAR; PG8_SCHED;
            } else {
            PG8_LDB(B0, 0, 0); PG8_SCHED; PG8_LDA(At, 0, 0); PG8_STAGE(PG8_SA(1, 1), a1 + hstep, voffA);
            PG8_WAIT_L(8); PG8_BAR; PG8_WAIT_L(0); PG8_MMA(0, 0, At, B0); PG8_BAR; PG8_SCHED;
            PG8_LDB(B1, 0, 1); PG8_STAGE(PG8_SB(0, 0), b2, voffB);
            PG8_BAR; PG8_WAIT_L(0); PG8_MMA(0, 1, At, B1); PG8_BAR;
            PG8_LDA(At, 0, 1); PG8_STAGE(PG8_SA(0, 0), a2, voffA);
            PG8_BAR; PG8_WAIT_L(0); PG8_MMA(1, 0, At, B0); PG8_BAR; PG8_SCHED;
            PG8_STAGE(PG8_SB(0, 1), b2 + hstepB, voffB);
            PG8_WAIT_V(6); PG8_BAR; PG8_MMA(1, 1, At, B1); PG8_BAR;
            PG8_LDB(B0, 1, 0); PG8_SCHED; PG8_LDA(At, 1, 0); PG8_STAGE(PG8_SA(0, 1), a2 + hstep, voffA);
            PG8_WAIT_L(8); PG8_BAR; PG8_WAIT_L(0); PG8_MMA(0, 0, At, B0); PG8_BAR; PG8_SCHED;
            PG8_LDB(B1, 1, 1); PG8_STAGE(PG8_SB(1, 0), b3, voffB);
            PG8_BAR; PG8_WAIT_L(0); PG8_MMA(0, 1, At, B1); PG8_BAR;
            PG8_LDA(At, 1, 1); PG8_STAGE(PG8_SA(1, 0), a3, voffA);
            PG8_BAR; PG8_WAIT_L(0); PG8_MMA(1, 0, At, B0); PG8_BAR; PG8_SCHED;
            PG8_STAGE(PG8_SB(1, 1), b3 + hstepB, voffB);
            PG8_WAIT_V(6); PG8_BAR; PG8_MMA(1, 1, At, B1); PG8_BAR;
            }
        }
        if constexpr (ALIGN_EPI) { if (wr == 0) PG8_BAR; }
        if constexpr (!Epi::AFTER_DRAIN) { E(acc, cur, wr, wc, fr, fq); S.done(cur); }
        if (!has_next) break;
#pragma unroll
        for (int a = 0; a < 2; ++a)
#pragma unroll
            for (int b = 0; b < 2; ++b)
#pragma unroll
                for (int m = 0; m < 4; ++m)
#pragma unroll
                    for (int n = 0; n < 2; ++n) acc[a][b][m][n] = (f32x4){0.f, 0.f, 0.f, 0.f};
        cur = nxt; cA = nA; cB = nB; ++ui;
        if constexpr (ALIGN_EPI) { if (wr == 1) PG8_BAR; }
    }
    PG8_WAIT_V(0);
    if constexpr (!ALIGN_EPI) { if (wr == 0) PG8_BAR; }
    PG8_BAR;
    if constexpr (Epi::AFTER_DRAIN) { E.fused(acc, cur, wr, wc, fr, fq, lds, wid, lane); S.done(cur); }
#undef PG8_SA
#undef PG8_SB
#undef PG8_STAGE
#undef PG8_LDA
#undef PG8_LDB
#undef PG8_MMA
#undef PG8_WAIT_V
#undef PG8_WAIT_L
#undef PG8_BAR
#undef PG8_SCHED
}
}
namespace att {
#define ATT_LAS __attribute__((address_space(3)))
typedef unsigned short bf16;
typedef short bf16x8 __attribute__((ext_vector_type(8)));
typedef short s16x4 __attribute__((ext_vector_type(4)));
typedef float f32x16 __attribute__((ext_vector_type(16)));
typedef unsigned u32x4 __attribute__((ext_vector_type(4)));
typedef ATT_LAS char lchar;
constexpr int KBUF = 12288, VBUF = 16384;
constexpr int L_K = 0, L_V = 2 * KBUF, L_WS = L_V + 2 * VBUF, L_RPB = L_WS + 2048, L_END = L_RPB + 2048;
constexpr float LOG2E = 1.4426950408889634f;
#define ATT_SBAR() __builtin_amdgcn_sched_barrier(0)
__device__ __forceinline__ int crow(int r, int hi) { return (r & 3) + 8 * (r >> 2) + 4 * hi; }
__device__ __forceinline__ unsigned cvtpk(float lo, float hi) { unsigned r; asm volatile("v_cvt_pk_bf16_f32 %0, %1, %2" : "=v"(r) : "v"(lo), "v"(hi)); return r; }
__device__ __forceinline__ int v_st(int k, int c) { const int kk = (k & ~0xC) | ((k & 4) << 1) | ((k & 8) >> 1); return ((kk >> 3) * 4 + (c >> 5)) * 512 + ((kk & 7) * 32 + (c & 31)) * 2; }
__device__ __forceinline__ int v_rd_base(int lane) { return ((lane & 3) << 3) | (((lane >> 2) & 3) << 6) | (((lane >> 4) & 1) << 5) | (((lane >> 5) & 1) << 8); }
constexpr int v_rd_off(int d0, int ks, int half) { return d0 * 512 + ks * 4096 + half * 2048; }
template <int OFF> __device__ __forceinline__ s16x4 tr_read(unsigned vb) {
  s16x4 r; asm volatile("ds_read_b64_tr_b16 %0, %1 offset:%2" : "=&v"(r) : "v"(vb), "i"(OFF) : "memory"); return r;
}
template <int D0> __device__ __forceinline__ void pv_one(f32x16& od, unsigned vb, bf16x8 pa0, bf16x8 pa1, bf16x8 pa2, bf16x8 pa3) {
  const s16x4 l0 = tr_read<v_rd_off(D0, 0, 0)>(vb), h0 = tr_read<v_rd_off(D0, 0, 1)>(vb), l1 = tr_read<v_rd_off(D0, 1, 0)>(vb), h1 = tr_read<v_rd_off(D0, 1, 1)>(vb);
  const s16x4 l2 = tr_read<v_rd_off(D0, 2, 0)>(vb), h2 = tr_read<v_rd_off(D0, 2, 1)>(vb), l3 = tr_read<v_rd_off(D0, 3, 0)>(vb), h3 = tr_read<v_rd_off(D0, 3, 1)>(vb);
  asm volatile("s_waitcnt lgkmcnt(0)" ::: "memory"); ATT_SBAR();
#define ATT_PK(L, H) (bf16x8){L[0], L[1], L[2], L[3], H[0], H[1], H[2], H[3]}
  od = __builtin_amdgcn_mfma_f32_32x32x16_bf16(pa0, ATT_PK(l0, h0), od, 0, 0, 0);
  od = __builtin_amdgcn_mfma_f32_32x32x16_bf16(pa1, ATT_PK(l1, h1), od, 0, 0, 0);
  od = __builtin_amdgcn_mfma_f32_32x32x16_bf16(pa2, ATT_PK(l2, h2), od, 0, 0, 0);
  od = __builtin_amdgcn_mfma_f32_32x32x16_bf16(pa3, ATT_PK(l3, h3), od, 0, 0, 0);
#undef ATT_PK
}

template <int DKC, class U>
__device__ __forceinline__ void unit(const U& u, lchar* lds, int tid) {
  asm volatile("" : "+v"(tid));
  const int lane = tid & 63, r32 = lane & 31, hi = lane >> 5;
  const int wid = __builtin_amdgcn_readfirstlane(tid >> 6);
  lchar* Kl = lds + L_K; lchar* Vl = lds + L_V;
  ATT_LAS float* ws = (ATT_LAS float*)(lds + L_WS) + wid * 64;
  bf16x8 qr[DKC / 2];
#pragma unroll
  for (int d0 = 0; d0 < DKC / 2; ++d0) qr[d0] = *(const bf16x8*)u.qptr(wid, r32, d0, hi);
  const int vrow = tid >> 3, vch = tid & 7, vst = v_st(vrow, vch * 8);
  const int krow0 = tid & 63, kch0 = tid >> 6;
  const bool k2 = (DKC > 8) && (tid < 64 * (DKC - 8));
  const unsigned vb0 = (unsigned)(uintptr_t)Vl + (unsigned)v_rd_base(lane);
  bf16x8 kst0, kst1 = {}, vstr;
  const int NT = u.nt();
#define ATT_SLOAD(t) do { const long R_ = u.krow(t); kst0 = *(const bf16x8*)u.kptr(R_ + krow0, kch0); if (k2) kst1 = *(const bf16x8*)u.kptr(R_ + krow0, 8 + kch0); \
    vstr = *(const bf16x8*)u.vptr(R_ + vrow, vch); } while (0)
#define ATT_SWRITE(b) do { *(ATT_LAS bf16x8*)(Kl + (b) * KBUF + kch0 * 1024 + krow0 * 16) = kst0; if (k2) *(ATT_LAS bf16x8*)(Kl + (b) * KBUF + (8 + kch0) * 1024 + krow0 * 16) = kst1; \
    *(ATT_LAS bf16x8*)(Vl + (b) * VBUF + vst) = vstr; } while (0)
  float m_reg = -1e30f, l_reg = 0.f; f32x16 o[2]; o[0] = f32x16{}; o[1] = f32x16{};
  ATT_SLOAD(0); ATT_SWRITE(0); __syncthreads();
  for (int t = 0; t < NT; ++t) {
    const int buf = t & 1;
    if (t + 1 < NT) ATT_SLOAD(t + 1);
    if (!u.skip(t, wid)) {
      f32x16 p0 = f32x16{}, p1 = f32x16{};
      { const lchar* kb = Kl + buf * KBUF + hi * 1024 + r32 * 16;
#pragma unroll
        for (int d0 = 0; d0 < DKC / 2; ++d0) {
          const bf16x8 b0 = *(const ATT_LAS bf16x8*)(kb + d0 * 2048);
          const bf16x8 b1 = *(const ATT_LAS bf16x8*)(kb + d0 * 2048 + 512);
          p0 = __builtin_amdgcn_mfma_f32_32x32x16_bf16(b0, qr[d0], p0, 0, 0, 0);
          p1 = __builtin_amdgcn_mfma_f32_32x32x16_bf16(b1, qr[d0], p1, 0, 0, 0); } }
      u.mask(p0, p1, t, wid, r32, hi);
      float pmax = p0[0];
#pragma unroll
      for (int r = 1; r < 16; ++r) pmax = fmaxf(pmax, p0[r]);
#pragma unroll
      for (int r = 0; r < 16; ++r) pmax = fmaxf(pmax, p1[r]);
      { auto rr = __builtin_amdgcn_permlane32_swap(__float_as_uint(pmax), __float_as_uint(pmax), false, false);
        pmax = fmaxf(__uint_as_float(rr[0]), __uint_as_float(rr[1])); }
      const float mn = fmaxf(m_reg, pmax);
      const float alpha = __builtin_amdgcn_exp2f(m_reg - mn);
      m_reg = mn;
#pragma unroll
      for (int r = 0; r < 16; ++r) { p0[r] = __builtin_amdgcn_exp2f(p0[r] - mn); p1[r] = __builtin_amdgcn_exp2f(p1[r] - mn); }
      float ps = 0.f;
#pragma unroll
      for (int r = 0; r < 16; ++r) ps += p0[r];
#pragma unroll
      for (int r = 0; r < 16; ++r) ps += p1[r];
      { auto rr = __builtin_amdgcn_permlane32_swap(__float_as_uint(ps), __float_as_uint(ps), false, false);
        ps = __uint_as_float(rr[0]) + __uint_as_float(rr[1]); }
      l_reg = l_reg * alpha + ps;
      if (__any(alpha < 1.f)) {
        if (hi == 0) ws[r32] = alpha;
        asm volatile("s_waitcnt lgkmcnt(0)" ::: "memory");
#pragma unroll
        for (int r = 0; r < 16; ++r) { const float a = ws[crow(r, hi)]; o[0][r] *= a; o[1][r] *= a; }
      }
      bf16x8 pa0, pa1, pa2, pa3;
#define ATT_PK4(P, BASE, OUT) do { unsigned a0 = cvtpk(P[BASE + 0], P[BASE + 1]), a1 = cvtpk(P[BASE + 2], P[BASE + 3]);   \
    unsigned b0 = cvtpk(P[BASE + 4], P[BASE + 5]), b1 = cvtpk(P[BASE + 6], P[BASE + 7]);                              \
    auto r0 = __builtin_amdgcn_permlane32_swap(a0, b0, false, false); auto r1 = __builtin_amdgcn_permlane32_swap(a1, b1, false, false); \
    u32x4 w = {r0[0], r1[0], r0[1], r1[1]}; OUT = __builtin_bit_cast(bf16x8, w); } while (0)
      ATT_PK4(p0, 0, pa0); ATT_PK4(p0, 8, pa1); ATT_PK4(p1, 0, pa2); ATT_PK4(p1, 8, pa3);
#undef ATT_PK4
      const unsigned vb = vb0 + (unsigned)(buf * VBUF);
      pv_one<0>(o[0], vb, pa0, pa1, pa2, pa3); pv_one<1>(o[1], vb, pa0, pa1, pa2, pa3);
    }
    if (t + 1 < NT) ATT_SWRITE(buf ^ 1);
    __syncthreads();
  }
#undef ATT_SLOAD
#undef ATT_SWRITE
  { const float sk = u.sink(wid); l_reg += __builtin_amdgcn_exp2f(sk - m_reg); }
  if (hi == 0) ws[r32] = l_reg;
  asm volatile("s_waitcnt lgkmcnt(0)" ::: "memory");
  float rli[16];
#pragma unroll
  for (int r = 0; r < 16; ++r) rli[r] = __builtin_amdgcn_rcpf(ws[crow(r, hi)]);
#pragma unroll
  for (int r = 0; r < 16; ++r) { bf16* op = u.orow(wid, crow(r, hi));
    op[r32] = (bf16)(cvtpk(o[0][r] * rli[r], 0.f) & 0xffffu); op[32 + r32] = (bf16)(cvtpk(o[1][r] * rli[r], 0.f) & 0xffffu); }
  asm volatile("s_waitcnt lgkmcnt(0)" ::: "memory");
}

constexpr int ROWS_LAT = 16384;
struct UWin {
  const bf16* QKV; bf16* O; const float* sinkp; int b, n, g, hh; int i0, cnt;
  __device__ __forceinline__ void init() { i0 = (n == 0) ? 2 : 0; cnt = (n == 0 || n == 63) ? 4 : 6; }
  __device__ __forceinline__ int nt() const { return 4 + cnt; }
  __device__ __forceinline__ int kpos0(int t) const { return 128 * (n - 1) + 64 * (i0 + t - 4); }
  __device__ __forceinline__ long krow(int t) const { return t < 4 ? (long)(ROWS_LAT + 256 * b + 64 * t) : (long)(8192 * b + kpos0(t)); }
  __device__ __forceinline__ const bf16* kptr(long row, int ch) const { return QKV + row * 2304 + 512 + 64 * g + ch * 8; }
  __device__ __forceinline__ const bf16* vptr(long row, int ch) const { return QKV + row * 2304 + 640 + 64 * g + ch * 8; }
  __device__ __forceinline__ int head(int wid) const { return 4 * g + 2 * hh + (wid >> 2); }
  __device__ __forceinline__ int qpos0(int wid) const { return 128 * n + 32 * (wid & 3); }
  __device__ __forceinline__ const bf16* qptr(int wid, int r32, int d0, int hi) const { return QKV + (long)(8192 * b + qpos0(wid) + r32) * 2304 + 64 * head(wid) + 16 * d0 + 8 * hi; }
  __device__ __forceinline__ bool skip(int t, int wid) const { if (t < 4) return false; const int k0 = kpos0(t), q0 = qpos0(wid); return (k0 + 63 < q0 - 128) || (k0 > q0 + 31 + 128); }
  __device__ __forceinline__ void mask(f32x16& p0, f32x16& p1, int t, int wid, int r32, int hi) const {
    if (t < 4) return;
    const int dq = kpos0(t) - (qpos0(wid) + r32);
#pragma unroll
    for (int r = 0; r < 16; ++r) { const int d = dq + crow(r, hi); if (d > 128 || d < -128) p0[r] = -INFINITY; if (d + 32 > 128 || d + 32 < -128) p1[r] = -INFINITY; }
  }
  __device__ __forceinline__ float sink(int wid) const { return sinkp[head(wid)] * LOG2E; }
  __device__ __forceinline__ bf16* orow(int wid, int row) const { return O + (long)(8192 * b + qpos0(wid) + row) * 1024 + 64 * head(wid); }
};
struct UNa {
  const bf16* QKV; bf16* O; const ATT_LAS float* rpbl; int b, h, R4; int krlo, nloc;
  __device__ __forceinline__ static int clampi(int v, int lo, int hi_) { return v < lo ? lo : (v > hi_ ? hi_ : v); }
  __device__ __forceinline__ void init() { krlo = clampi(4 * R4 - 4, 0, 120); const int krhi = clampi(4 * R4 - 1, 0, 120) + 7; nloc = krhi - krlo + 1; }
  __device__ __forceinline__ int nt() const { return 4 + nloc; }
  __device__ __forceinline__ long krow(int t) const { return t < 4 ? (long)(ROWS_LAT + 256 * b + 64 * t) : (long)(8192 * b + 64 * (krlo + t - 4)); }
  __device__ __forceinline__ const bf16* kptr(long row, int ch) const { return QKV + row * 2304 + 1280 + 64 * h + ch * 8; }
  __device__ __forceinline__ const bf16* vptr(long row, int ch) const { return QKV + row * 2304 + 1792 + 64 * h + ch * 8; }
  __device__ __forceinline__ int qrow(int wid) const { return 4 * R4 + (wid >> 1); }
  __device__ __forceinline__ const bf16* qptr(int wid, int r32, int d0, int hi) const { return QKV + (long)(8192 * b + 64 * qrow(wid) + 32 * (wid & 1) + r32) * 2304 + 768 + 64 * h + 16 * d0 + 8 * hi; }
  __device__ __forceinline__ bool skip(int t, int wid) const { if (t < 4) return false; const int kr = krlo + t - 4, w0 = clampi(qrow(wid) - 4, 0, 120); return kr < w0 || kr > w0 + 7; }
  __device__ __forceinline__ void mask(f32x16& p0, f32x16& p1, int t, int wid, int r32, int hi) const {
    if (t < 4) return;
    const int kr = krlo + t - 4, qc = 32 * (wid & 1) + r32, c0 = clampi(qc - 8, 0, 48);
    const ATT_LAS float* brow = rpbl + (kr - qrow(wid) + 7) * 31 + 15;
#pragma unroll
    for (int r = 0; r < 16; ++r) {
      { const int kc = crow(r, hi); const bool ok = kc >= c0 && kc < c0 + 16; const float bv = brow[clampi(kc - qc, -15, 15)]; p0[r] = ok ? p0[r] + bv : -INFINITY; }
      { const int kc = 32 + crow(r, hi); const bool ok = kc >= c0 && kc < c0 + 16; const float bv = brow[clampi(kc - qc, -15, 15)]; p1[r] = ok ? p1[r] + bv : -INFINITY; } }
  }
  __device__ __forceinline__ float sink(int) const { return -INFINITY; }
  __device__ __forceinline__ bf16* orow(int wid, int row) const { return O + (long)(8192 * b + 64 * qrow(wid) + 32 * (wid & 1) + row) * 1024 + 512 + 64 * h; }
};
struct UCtx {
  const bf16* QKV; bf16* O; const float* sinkp; int b, hx; int qcol, kcol, vcol, ocol;
  __device__ __forceinline__ void init() { if (hx < 8) { qcol = 64 * hx; kcol = 512 + 64 * (hx >> 2); vcol = 640 + 64 * (hx >> 2); ocol = 64 * hx; }
    else { const int h = hx - 8; qcol = 768 + 64 * h; kcol = 1280 + 64 * h; vcol = 1792 + 64 * h; ocol = 512 + 64 * h; } }
  __device__ __forceinline__ int nt() const { return 4; }
  __device__ __forceinline__ long krow(int t) const { return (long)(ROWS_LAT + 256 * b + 64 * t); }
  __device__ __forceinline__ const bf16* kptr(long row, int ch) const { return QKV + row * 2304 + kcol + ch * 8; }
  __device__ __forceinline__ const bf16* vptr(long row, int ch) const { return QKV + row * 2304 + vcol + ch * 8; }
  __device__ __forceinline__ const bf16* qptr(int wid, int r32, int d0, int hi) const { return QKV + (long)(ROWS_LAT + 256 * b + 32 * wid + r32) * 2304 + qcol + 16 * d0 + 8 * hi; }
  __device__ __forceinline__ bool skip(int, int) const { return false; }
  __device__ __forceinline__ void mask(f32x16&, f32x16&, int, int, int, int) const {}
  __device__ __forceinline__ float sink(int) const { return hx < 8 ? sinkp[hx] * LOG2E : -INFINITY; }
  __device__ __forceinline__ bf16* orow(int wid, int row) const { return O + (long)(ROWS_LAT + 256 * b + 32 * wid + row) * 1024 + ocol; }
};
struct UDense {
  const bf16* Q; const bf16* KV; const bf16* KR; bf16* O; int b, h, qb;
  __device__ __forceinline__ int nt() const { return 132; }
  __device__ __forceinline__ long krow(int t) const { return t < 4 ? (long)(ROWS_LAT + 256 * b + 64 * t) : (long)(8192 * b + 64 * (t - 4)); }
  __device__ __forceinline__ const bf16* kptr(long row, int ch) const { return ch < 8 ? KV + row * 2048 + 64 * h + ch * 8 : KR + row * 32 + (ch - 8) * 8; }
  __device__ __forceinline__ const bf16* vptr(long row, int ch) const { return KV + row * 2048 + 1024 + 64 * h + ch * 8; }
  __device__ __forceinline__ const bf16* qptr(int wid, int r32, int d0, int hi) const { const bf16* qp = Q + (long)(8192 * b + 256 * qb + 32 * wid + r32) * 1536;
    return d0 < 4 ? qp + 64 * h + 16 * d0 + 8 * hi : qp + 1024 + 32 * h + 16 * (d0 - 4) + 8 * hi; }
  __device__ __forceinline__ bool skip(int, int) const { return false; }
  __device__ __forceinline__ void mask(f32x16&, f32x16&, int, int, int, int) const {}
  __device__ __forceinline__ float sink(int) const { return -INFINITY; }
  __device__ __forceinline__ bf16* orow(int wid, int row) const { return O + (long)(8192 * b + 256 * qb + 32 * wid + row) * 1024 + 64 * h; }
};
#undef ATT_SBAR
}
namespace attd {
typedef unsigned short bf16;
using bf16x8 = __attribute__((ext_vector_type(8))) short;
using s16x4 = __attribute__((ext_vector_type(4))) short;
using f32x16 = __attribute__((ext_vector_type(16))) float;
using u32x4 = __attribute__((ext_vector_type(4))) unsigned;
constexpr int NW = 8, NT = 132, KSLOT = 12288, VSLOT = 8192;
constexpr int LDS_K = 0, LDS_V = 3 * KSLOT, LDS_WS = LDS_V + 3 * VSLOT, LDS_OST = LDS_WS + NW * 64 * 4, LDS_BYTES = LDS_OST + NW * 4096;
__device__ __forceinline__ int crow(int r, int hi) { return (r & 3) + 8 * (r >> 2) + 4 * hi; }
#define AF_SBAR() __builtin_amdgcn_sched_barrier(0)
__device__ __forceinline__ void glds16(unsigned voff, const void* sbase, unsigned lds_dst) { unsigned keep;
  asm volatile("s_mov_b32 %0, m0\n\ts_mov_b32 m0, %3\n\ts_nop 0\n\tglobal_load_lds_dwordx4 %1, %2\n\ts_mov_b32 m0, %0" : "=&s"(keep) : "v"(voff), "s"(sbase), "s"(lds_dst) : "memory"); }
typedef float f32x2_t __attribute__((ext_vector_type(2))); typedef __bf16 bf16x2_t __attribute__((ext_vector_type(2)));
__device__ __forceinline__ unsigned cvtpk_s(float lo, float hi) { f32x2_t v = {lo, hi}; bf16x2_t b = __builtin_convertvector(v, bf16x2_t); return __builtin_bit_cast(unsigned, b); }
#define AF_WAIT_BAR(N) asm volatile("s_waitcnt vmcnt(" #N ") lgkmcnt(0)\n\ts_barrier" ::: "memory")
typedef __attribute__((address_space(3))) const char* lds_cptr;
typedef short v4i16_t __attribute__((ext_vector_type(4)));
__device__ __forceinline__ void kload2(bf16x8* kf, lds_cptr kp, int j) { kf[2 * j] = *(const __attribute__((address_space(3))) bf16x8*)(kp + j * 2048); kf[2 * j + 1] = *(const __attribute__((address_space(3))) bf16x8*)(kp + j * 2048 + 512); }
__device__ __forceinline__ s16x4 vtr(lds_cptr p) { return __builtin_bit_cast(s16x4, __builtin_amdgcn_ds_read_tr16_b64_v4i16((__attribute__((address_space(3))) v4i16_t*)p)); }
__device__ __forceinline__ long tile_row(int b, int t) { return t < 4 ? (long)(16384 + 256 * b + 64 * t) : (long)(8192 * b + 64 * (t - 4)); }

__device__ __forceinline__ void dense_unit(int b, int h, int qb, const bf16* Q, const bf16* __restrict__ KV, const bf16* __restrict__ KR, bf16* O, char* shm, const int tid) {
  const int lane = tid & 63, r32 = lane & 31, hi = lane >> 5; const int wid = __builtin_amdgcn_readfirstlane(tid >> 6);
  const unsigned lds0 = (unsigned)(uintptr_t)shm;
  float* wsf = (float*)(shm + LDS_WS) + wid * 64;
  const unsigned voffKA = (unsigned)(lane * 2048 + 8 * wid) * 2u;
  const unsigned voffKB = (unsigned)(lane * 32 + 8 * (wid & 3)) * 2u;
  const unsigned voffV = (unsigned)((16 * (wid & 3) + (lane >> 2)) * 2048 + (wid >> 2) * 32 + (lane & 3) * 8) * 2u;
  const char* sKA = (const char*)(KV + 64 * h); const char* sKB = (const char*)KR; const char* sV = (const char*)(KV + 1024 + 64 * h);
  const unsigned kdstA = lds0 + LDS_K + wid * 1024, kdstB = lds0 + LDS_K + (8 + (wid & 3)) * 1024, vdst = lds0 + LDS_V + wid * 1024;
#define AF_DMA_K(t, ks) do { const long R_ = tile_row(b, (t)); glds16(voffKA, sKA + R_ * 4096, (unsigned)__builtin_amdgcn_readfirstlane(kdstA + (ks))); glds16(voffKB, sKB + R_ * 64, (unsigned)__builtin_amdgcn_readfirstlane(kdstB + (ks))); } while (0)
#define AF_DMA_V(t, vs) do { const long R_ = tile_row(b, (t)); glds16(voffV, sV + R_ * 4096, (unsigned)__builtin_amdgcn_readfirstlane(vdst + (vs))); } while (0)
  const lds_cptr shm3 = (lds_cptr)shm; const lds_cptr kp0 = shm3 + LDS_K + hi * 1024 + r32 * 16;
  const lds_cptr vp0 = shm3 + LDS_V + ((lane >> 4) & 1) * 32 + (lane & 3) * 8 + (4 * hi + ((lane & 15) >> 2)) * 64;
  bf16x8 qr[6];
  { const bf16* qp = Q + (long)(8192 * b + 256 * qb + 32 * wid + r32) * 1536;
#pragma unroll
    for (int d0 = 0; d0 < 4; ++d0) qr[d0] = *reinterpret_cast<const bf16x8*>(qp + 64 * h + 16 * d0 + 8 * hi);
#pragma unroll
    for (int d0 = 0; d0 < 2; ++d0) qr[4 + d0] = *reinterpret_cast<const bf16x8*>(qp + 1024 + 32 * h + 16 * d0 + 8 * hi); }
  AF_DMA_K(0, 0); AF_DMA_V(0, 0); AF_DMA_K(1, KSLOT); AF_DMA_K(2, 2 * KSLOT);
  float l_reg = 0.f; f32x16 o[2]; o[0] = f32x16{}; o[1] = f32x16{};
  f32x16 pA0, pA1, pB0, pB1; bf16x8 kf[12];
  int s_prev = 0, s_cur = 0, s_next = 1;
#define AF_ROT() do { s_prev = s_cur; s_cur = s_next; s_next = (s_next == 2) ? 0 : s_next + 1; } while (0)
  AF_WAIT_BAR(5);
  { const char* kb = shm + LDS_K + hi * 1024 + r32 * 16; pA0 = f32x16{}; pA1 = f32x16{};
#pragma unroll
    for (int d0 = 0; d0 < 6; ++d0) { const bf16x8 b0 = *reinterpret_cast<const bf16x8*>(kb + d0 * 2048), b1 = *reinterpret_cast<const bf16x8*>(kb + d0 * 2048 + 512);
      pA0 = __builtin_amdgcn_mfma_f32_32x32x16_bf16(b0, qr[d0], pA0, 0, 0, 0); pA1 = __builtin_amdgcn_mfma_f32_32x32x16_bf16(b1, qr[d0], pA1, 0, 0, 0); }
#pragma unroll
    for (int r = 0; r < 16; ++r) { pA0[r] = __builtin_amdgcn_exp2f(pA0[r]); pA1[r] = __builtin_amdgcn_exp2f(pA1[r]); } }
  AF_WAIT_BAR(0);
  AF_DMA_K(3, 0); AF_DMA_V(1, VSLOT);
  AF_ROT();
#pragma unroll
  for (int j = 0; j < 6; ++j) kload2(kf, kp0 + s_cur * KSLOT, j);
  AF_WAIT_BAR(3);
  s16x4 vlo[8], vhi[8]; u32x4 pw0, pw1, pw2, pw3;
#define AF_PKW(P, B) cvtpk_s(P[B], P[B + 1])
#define AF_PAF(k) __builtin_bit_cast(bf16x8, pw##k)
#define AF_VFR(i) (bf16x8){vlo[i][0], vlo[i][1], vlo[i][2], vlo[i][3], vhi[i][0], vhi[i][1], vhi[i][2], vhi[i][3]}
#define AF_PIN(x) asm volatile("" : "+v"(x))
#define AF_MF(a, b, c) __builtin_amdgcn_mfma_f32_32x32x16_bf16(a, b, c, 0, 0, 0)
#define AF_EX(v) __builtin_amdgcn_exp2f(v)
#define AF_VRD(i) do { vlo[i] = vtr(vp_ + (((i) >> 2) * 4096 + ((i) & 3) * 1024)); vhi[i] = vtr(vp_ + (((i) >> 2) * 4096 + ((i) & 3) * 1024 + 512)); AF_SBAR(); } while (0)
#define AF_GA3(MF, A0, A1, A2, W0, W1, PW) do { MF; sacc += A0; sacc += A1; sacc += A2; AF_PIN(sacc); W0; W1; AF_PIN(PW); AF_SBAR(); } while (0)
#define AF_GA2(MF, A0, A1, W0, PW) do { MF; sacc += A0; sacc += A1; AF_PIN(sacc); W0; AF_PIN(PW); AF_SBAR(); } while (0)
#define AF_GB(MF, X, B) do { MF; X[B] = AF_EX(X[B]); X[B + 1] = AF_EX(X[B + 1]); X[B + 2] = AF_EX(X[B + 2]); X[B + 3] = AF_EX(X[B + 3]); AF_PIN(X); AF_SBAR(); } while (0)
#define AF_KRD(G, j) do { if (G) { kload2(kf, kp0 + s_next * KSLOT, j); AF_SBAR(); } } while (0)
  const f32x16 zero16 = f32x16{};
#define AF_STEP(C0, C1, P0, P1, t, GK, GV, GL) do { AF_SBAR(); \
    const lds_cptr vp_ = vp0 + s_prev * VSLOT; \
    AF_VRD(0); float sacc = (P0[0] + P0[1]); \
    AF_GA3(C0 = AF_MF(kf[0], qr[0], zero16), P0[2], P0[3], P0[4],     pw0[0] = AF_PKW(P0, 0), pw0[1] = AF_PKW(P0, 2), pw0); \
    AF_VRD(4); AF_GA3(C1 = AF_MF(kf[1], qr[0], zero16), P0[5], P0[6], P0[7],     pw0[2] = AF_PKW(P0, 4), pw0[3] = AF_PKW(P0, 6), pw0); \
    AF_VRD(1); AF_GA3(C0 = AF_MF(kf[2], qr[1], C0),     P0[8], P0[9], P0[10],    pw1[0] = AF_PKW(P0, 8), pw1[1] = AF_PKW(P0, 10), pw1); \
    AF_VRD(5); AF_GA3(C1 = AF_MF(kf[3], qr[1], C1),     P0[11], P0[12], P0[13],  pw1[2] = AF_PKW(P0, 12), pw1[3] = AF_PKW(P0, 14), pw1); \
    AF_VRD(2); AF_GA3(C0 = AF_MF(kf[4], qr[2], C0),     P0[14], P0[15], P1[0],   pw2[0] = AF_PKW(P1, 0), pw2[1] = AF_PKW(P1, 2), pw2); \
    AF_VRD(6); AF_GA3(C1 = AF_MF(kf[5], qr[2], C1),     P1[1], P1[2], P1[3],     pw2[2] = AF_PKW(P1, 4), pw2[3] = AF_PKW(P1, 6), pw2); \
    AF_VRD(3); AF_GA2(C0 = AF_MF(kf[6], qr[3], C0),     P1[4], P1[5],            pw3[0] = AF_PKW(P1, 8), pw3); \
    AF_VRD(7); AF_GA2(C1 = AF_MF(kf[7], qr[3], C1),     P1[6], P1[7],            pw3[1] = AF_PKW(P1, 10), pw3); \
    AF_GA2(C0 = AF_MF(kf[8], qr[4], C0),                P1[8], P1[9],            pw3[2] = AF_PKW(P1, 12), pw3); \
    if (GK) { const long R_ = tile_row(b, (t) + 3); glds16(voffKA, sKA + R_ * 4096, (unsigned)__builtin_amdgcn_readfirstlane(kdstA + s_cur * KSLOT)); AF_SBAR(); } \
    AF_GA2(C1 = AF_MF(kf[9], qr[4], C1),                P1[10], P1[11],          pw3[3] = AF_PKW(P1, 14), pw3); \
    if (GK) { const long R_ = tile_row(b, (t) + 3); glds16(voffKB, sKB + R_ * 64, (unsigned)__builtin_amdgcn_readfirstlane(kdstB + s_cur * KSLOT)); AF_SBAR(); } \
    { C0 = AF_MF(kf[10], qr[5], C0); sacc += P1[12]; sacc += P1[13]; AF_PIN(sacc); AF_SBAR(); } \
    if (GV) { AF_DMA_V((t) + 1, s_next * VSLOT); AF_SBAR(); } \
    { C1 = AF_MF(kf[11], qr[5], C1); sacc += P1[14]; sacc += P1[15]; AF_PIN(sacc); AF_SBAR(); } \
    l_reg += sacc; \
    AF_SBAR(); \
    AF_GB(o[0] = AF_MF(AF_PAF(0), AF_VFR(0), o[0]), C0, 0);  AF_KRD(GL, 0); \
    AF_GB(o[1] = AF_MF(AF_PAF(0), AF_VFR(4), o[1]), C0, 4);  AF_KRD(GL, 1); \
    AF_GB(o[0] = AF_MF(AF_PAF(1), AF_VFR(1), o[0]), C0, 8);  AF_KRD(GL, 2); \
    AF_GB(o[1] = AF_MF(AF_PAF(1), AF_VFR(5), o[1]), C0, 12); AF_KRD(GL, 3); \
    AF_GB(o[0] = AF_MF(AF_PAF(2), AF_VFR(2), o[0]), C1, 0);  AF_KRD(GL, 4); \
    AF_GB(o[1] = AF_MF(AF_PAF(2), AF_VFR(6), o[1]), C1, 4);  AF_KRD(GL, 5); \
    AF_GB(o[0] = AF_MF(AF_PAF(3), AF_VFR(3), o[0]), C1, 8); \
    AF_GB(o[1] = AF_MF(AF_PAF(3), AF_VFR(7), o[1]), C1, 12); \
  } while (0)
  int t = 1;
  for (; t + 3 < NT; t += 2) {
    AF_STEP(pB0, pB1, pA0, pA1, t, true, true, true);     AF_WAIT_BAR(3); AF_ROT();
    AF_STEP(pA0, pA1, pB0, pB1, t + 1, true, true, true); AF_WAIT_BAR(3); AF_ROT();
  }
  AF_STEP(pB0, pB1, pA0, pA1, NT - 3, false, true, true);  AF_WAIT_BAR(1); AF_ROT();
  AF_STEP(pA0, pA1, pB0, pB1, NT - 2, false, true, true);  AF_WAIT_BAR(0); AF_ROT();
  AF_STEP(pB0, pB1, pA0, pA1, NT - 1, false, false, false);
  { float sacc = pB0[0] + pB0[1];
#pragma unroll
    for (int r = 2; r < 16; ++r) sacc += pB0[r];
#pragma unroll
    for (int r = 0; r < 16; ++r) sacc += pB1[r];
    l_reg += sacc;
    pw0 = (u32x4){AF_PKW(pB0, 0), AF_PKW(pB0, 2), AF_PKW(pB0, 4), AF_PKW(pB0, 6)}; pw1 = (u32x4){AF_PKW(pB0, 8), AF_PKW(pB0, 10), AF_PKW(pB0, 12), AF_PKW(pB0, 14)};
    pw2 = (u32x4){AF_PKW(pB1, 0), AF_PKW(pB1, 2), AF_PKW(pB1, 4), AF_PKW(pB1, 6)}; pw3 = (u32x4){AF_PKW(pB1, 8), AF_PKW(pB1, 10), AF_PKW(pB1, 12), AF_PKW(pB1, 14)};
    AF_SBAR();
    const lds_cptr vp_ = vp0 + s_cur * VSLOT;
#pragma unroll
    for (int i = 0; i < 8; ++i) { vlo[i] = vtr(vp_ + ((i >> 2) * 4096 + (i & 3) * 1024)); vhi[i] = vtr(vp_ + ((i >> 2) * 4096 + (i & 3) * 1024 + 512)); }
    o[0] = AF_MF(AF_PAF(0), AF_VFR(0), o[0]); o[1] = AF_MF(AF_PAF(0), AF_VFR(4), o[1]);
    o[0] = AF_MF(AF_PAF(1), AF_VFR(1), o[0]); o[1] = AF_MF(AF_PAF(1), AF_VFR(5), o[1]);
    o[0] = AF_MF(AF_PAF(2), AF_VFR(2), o[0]); o[1] = AF_MF(AF_PAF(2), AF_VFR(6), o[1]);
    o[0] = AF_MF(AF_PAF(3), AF_VFR(3), o[0]); o[1] = AF_MF(AF_PAF(3), AF_VFR(7), o[1]); }
  { auto rr = __builtin_amdgcn_permlane32_swap(__float_as_uint(l_reg), __float_as_uint(l_reg), false, false); l_reg = __uint_as_float(rr[0]) + __uint_as_float(rr[1]); }
  if (hi == 0) wsf[32 + r32] = l_reg; asm volatile("s_waitcnt lgkmcnt(0)" ::: "memory");
  float rli[16];
#pragma unroll
  for (int r = 0; r < 16; ++r) rli[r] = __builtin_amdgcn_rcpf(wsf[32 + crow(r, hi)]);
  bf16* Ow = O + (long)(8192 * b + 256 * qb + 32 * wid) * 1024 + 64 * h;
  { bf16* stg = (bf16*)(shm + LDS_OST) + wid * 2048;
#pragma unroll
    for (int r = 0; r < 16; ++r) { const int orow = crow(r, hi);
#pragma unroll
      for (int d0 = 0; d0 < 2; ++d0) stg[orow * 64 + d0 * 32 + r32] = (bf16)(cvtpk_s(o[d0][r] * rli[r], 0.f) & 0xffffu); }
    asm volatile("s_waitcnt lgkmcnt(0)" ::: "memory");
#pragma unroll
    for (int i = 0; i < 4; ++i) { const int row = i * 8 + (lane >> 3), ch = lane & 7; const u32x4 v = *(const u32x4*)(stg + row * 64 + ch * 8); *(u32x4*)(Ow + (long)row * 1024 + ch * 8) = v; } }
  asm volatile("s_waitcnt vmcnt(0) lgkmcnt(0)\n\ts_barrier" ::: "memory");
#undef AF_DMA_K
#undef AF_DMA_V
#undef AF_ROT
#undef AF_PKW
#undef AF_PAF
#undef AF_VFR
#undef AF_PIN
#undef AF_MF
#undef AF_EX
#undef AF_VRD
#undef AF_GA3
#undef AF_GA2
#undef AF_GB
#undef AF_KRD
#undef AF_STEP
}
#undef AF_SBAR
#undef AF_WAIT_BAR
}
namespace attf {
typedef unsigned short bf16;
using bf16x8 = __attribute__((ext_vector_type(8))) short;
using s16x4 = __attribute__((ext_vector_type(4))) short;
using f32x16 = __attribute__((ext_vector_type(16))) float;
using u32x4 = __attribute__((ext_vector_type(4))) unsigned;
constexpr int NW = 8, KSLOT = 12288, VSLOT = 8192;
constexpr int LDS_K = 0, LDS_V = 3 * KSLOT, LDS_WS = LDS_V + 3 * VSLOT, LDS_OST = LDS_WS + NW * 64 * 4, LDS_RPB = LDS_OST + NW * 4096, LDS_BYTES = LDS_RPB + 2048;
__device__ __forceinline__ int crow(int r, int hi) { return (r & 3) + 8 * (r >> 2) + 4 * hi; }
#define AF_SBAR() __builtin_amdgcn_sched_barrier(0)
__device__ __forceinline__ void glds16(unsigned voff, const void* sbase, unsigned lds_dst) { unsigned keep;
  asm volatile("s_mov_b32 %0, m0\n\ts_mov_b32 m0, %3\n\ts_nop 0\n\tglobal_load_lds_dwordx4 %1, %2\n\ts_mov_b32 m0, %0" : "=&s"(keep) : "v"(voff), "s"(sbase), "s"(lds_dst) : "memory"); }
typedef float f32x2_t __attribute__((ext_vector_type(2))); typedef __bf16 bf16x2_t __attribute__((ext_vector_type(2)));
__device__ __forceinline__ unsigned cvtpk_s(float lo, float hi) { f32x2_t v = {lo, hi}; bf16x2_t b = __builtin_convertvector(v, bf16x2_t); return __builtin_bit_cast(unsigned, b); }
#define AF_WAIT_BAR(N) asm volatile("s_waitcnt vmcnt(" #N ") lgkmcnt(0)\n\ts_barrier" ::: "memory")
typedef __attribute__((address_space(3))) const char* lds_cptr;
typedef short v4i16_t __attribute__((ext_vector_type(4)));
__device__ __forceinline__ void kload2(bf16x8* kf, lds_cptr kp, int j) { kf[2 * j] = *(const __attribute__((address_space(3))) bf16x8*)(kp + j * 2048); kf[2 * j + 1] = *(const __attribute__((address_space(3))) bf16x8*)(kp + j * 2048 + 512); }
__device__ __forceinline__ s16x4 vtr(lds_cptr p) { return __builtin_bit_cast(s16x4, __builtin_amdgcn_ds_read_tr16_b64_v4i16((__attribute__((address_space(3))) v4i16_t*)p)); }

template <int DKC, class U>
__device__ __forceinline__ void fast_unit(const U& u, char* shm, int tid) {
  static_assert(DKC == 8 || DKC == 12, "q/k dim 64 or 96");
  asm volatile("" : "+v"(tid));
  constexpr int ND0 = DKC / 2;
  const int lane = tid & 63, r32 = lane & 31, hi = lane >> 5; const int wid = __builtin_amdgcn_readfirstlane(tid >> 6);
  const unsigned lds0 = (unsigned)(uintptr_t)shm;
  float* wsf = (float*)(shm + LDS_WS) + wid * 64;
  const int NT = u.nt();
  const unsigned voffKA = (unsigned)(lane * u.kpitch + 8 * wid) * 2u;
  const unsigned voffKB = (unsigned)(lane * 32 + 8 * (wid & 3)) * 2u;
  const unsigned voffV = (unsigned)((16 * (wid & 3) + (lane >> 2)) * u.vpitch + (wid >> 2) * 32 + (lane & 3) * 8) * 2u;
  const unsigned kdstA = lds0 + LDS_K + wid * 1024, kdstB = lds0 + LDS_K + (8 + (wid & 3)) * 1024, vdst = lds0 + LDS_V + wid * 1024;
#define AF_DMA_KA(t, ks) do { const long R_ = u.trow(t); glds16(voffKA, (const char*)u.kbase + R_ * (2 * u.kpitch), (unsigned)__builtin_amdgcn_readfirstlane(kdstA + (ks))); } while (0)
#define AF_DMA_KB(t, ks) do { if constexpr (DKC == 12) { const long R_ = u.trow(t); glds16(voffKB, (const char*)u.krbase + R_ * 64, (unsigned)__builtin_amdgcn_readfirstlane(kdstB + (ks))); } } while (0)
#define AF_DMA_K(t, ks) do { AF_DMA_KA(t, ks); AF_DMA_KB(t, ks); } while (0)
#define AF_DMA_V(t, vs) do { const long R_ = u.trow(t); glds16(voffV, (const char*)u.vbase + R_ * (2 * u.vpitch), (unsigned)__builtin_amdgcn_readfirstlane(vdst + (vs))); } while (0)
#define AF_WAITN(NSTEPS_K, NV) do { if constexpr (DKC == 12) { if ((NSTEPS_K) == 2 && (NV) == 1) AF_WAIT_BAR(5); else if ((NSTEPS_K) == 1 && (NV) == 1) AF_WAIT_BAR(3); else if ((NV) == 1) AF_WAIT_BAR(1); else AF_WAIT_BAR(0); } \
    else { if ((NSTEPS_K) == 2 && (NV) == 1) AF_WAIT_BAR(3); else if ((NSTEPS_K) == 1 && (NV) == 1) AF_WAIT_BAR(2); else if ((NV) == 1) AF_WAIT_BAR(1); else AF_WAIT_BAR(0); } } while (0)
  const lds_cptr shm3 = (lds_cptr)shm; const lds_cptr kp0 = shm3 + LDS_K + hi * 1024 + r32 * 16;
  const lds_cptr vp0 = shm3 + LDS_V + ((lane >> 4) & 1) * 32 + (lane & 3) * 8 + (4 * hi + ((lane & 15) >> 2)) * 64;
  bf16x8 qr[ND0];
#pragma unroll
  for (int d0 = 0; d0 < ND0; ++d0) qr[d0] = *reinterpret_cast<const bf16x8*>(u.qptr(wid, r32, d0, hi));
  AF_DMA_K(0, 0); AF_DMA_V(0, 0); AF_DMA_K(1, KSLOT); AF_DMA_K(2, 2 * KSLOT);
  float l_reg = 0.f; f32x16 o[2]; o[0] = f32x16{}; o[1] = f32x16{};
  f32x16 pA0, pA1, pB0, pB1; bf16x8 kf[DKC];
  int s_prev = 0, s_cur = 0, s_next = 1;
#define AF_ROT() do { s_prev = s_cur; s_cur = s_next; s_next = (s_next == 2) ? 0 : s_next + 1; } while (0)
  AF_WAITN(2, 1);
  { const char* kb = shm + LDS_K + hi * 1024 + r32 * 16; pA0 = f32x16{}; pA1 = f32x16{};
#pragma unroll
    for (int d0 = 0; d0 < ND0; ++d0) { const bf16x8 b0 = *reinterpret_cast<const bf16x8*>(kb + d0 * 2048), b1 = *reinterpret_cast<const bf16x8*>(kb + d0 * 2048 + 512);
      pA0 = __builtin_amdgcn_mfma_f32_32x32x16_bf16(b0, qr[d0], pA0, 0, 0, 0); pA1 = __builtin_amdgcn_mfma_f32_32x32x16_bf16(b1, qr[d0], pA1, 0, 0, 0); }
    if constexpr (U::HAS_MASK) u.mask(pA0, pA1, 0, wid, r32, hi);
#pragma unroll
    for (int r = 0; r < 16; ++r) { pA0[r] = __builtin_amdgcn_exp2f(pA0[r]); pA1[r] = __builtin_amdgcn_exp2f(pA1[r]); } }
  AF_WAIT_BAR(0);
  AF_DMA_K(3, 0); AF_DMA_V(1, VSLOT);
  AF_ROT();
#pragma unroll
  for (int j = 0; j < ND0; ++j) kload2(kf, kp0 + s_cur * KSLOT, j);
  AF_WAITN(1, 1);
  s16x4 vlo[8], vhi[8]; u32x4 pw0, pw1, pw2, pw3;
#define AF_PKW(P, B) cvtpk_s(P[B], P[B + 1])
#define AF_PAF(k) __builtin_bit_cast(bf16x8, pw##k)
#define AF_VFR(i) (bf16x8){vlo[i][0], vlo[i][1], vlo[i][2], vlo[i][3], vhi[i][0], vhi[i][1], vhi[i][2], vhi[i][3]}
#define AF_PIN(x) asm volatile("" : "+v"(x))
#define AF_MF(a, b, c) __builtin_amdgcn_mfma_f32_32x32x16_bf16(a, b, c, 0, 0, 0)
#define AF_EX(v) __builtin_amdgcn_exp2f(v)
#define AF_VRD(i) do { vlo[i] = vtr(vp_ + (((i) >> 2) * 4096 + ((i) & 3) * 1024)); vhi[i] = vtr(vp_ + (((i) >> 2) * 4096 + ((i) & 3) * 1024 + 512)); AF_SBAR(); } while (0)
#define AF_GA4(MF, A0, A1, A2, A3, W0, W1, PW) do { MF; sacc += A0; sacc += A1; sacc += A2; sacc += A3; AF_PIN(sacc); W0; W1; AF_PIN(PW); AF_SBAR(); } while (0)
#define AF_GA3(MF, A0, A1, A2, W0, W1, PW) do { MF; sacc += A0; sacc += A1; sacc += A2; AF_PIN(sacc); W0; W1; AF_PIN(PW); AF_SBAR(); } while (0)
#define AF_GA2(MF, A0, A1, W0, PW) do { MF; sacc += A0; sacc += A1; AF_PIN(sacc); W0; AF_PIN(PW); AF_SBAR(); } while (0)
#define AF_GB(MF, X, B) do { MF; X[B] = AF_EX(X[B]); X[B + 1] = AF_EX(X[B + 1]); X[B + 2] = AF_EX(X[B + 2]); X[B + 3] = AF_EX(X[B + 3]); AF_PIN(X); AF_SBAR(); } while (0)
#define AF_KRD(G, j) do { if ((j) < ND0) { if (G) { kload2(kf, kp0 + s_next * KSLOT, (j) < ND0 ? (j) : 0); AF_SBAR(); } } } while (0)
  const f32x16 zero16 = f32x16{};
#define AF_PHASE_A12(C0, C1, P0, P1, t, GK, GV) do { \
    AF_VRD(0); float sacc = (P0[0] + P0[1]); \
    AF_GA3(C0 = AF_MF(kf[0], qr[0], zero16), P0[2], P0[3], P0[4],     pw0[0] = AF_PKW(P0, 0), pw0[1] = AF_PKW(P0, 2), pw0); \
    AF_VRD(4); AF_GA3(C1 = AF_MF(kf[1], qr[0], zero16), P0[5], P0[6], P0[7],     pw0[2] = AF_PKW(P0, 4), pw0[3] = AF_PKW(P0, 6), pw0); \
    AF_VRD(1); AF_GA3(C0 = AF_MF(kf[2], qr[1], C0),     P0[8], P0[9], P0[10],    pw1[0] = AF_PKW(P0, 8), pw1[1] = AF_PKW(P0, 10), pw1); \
    AF_VRD(5); AF_GA3(C1 = AF_MF(kf[3], qr[1], C1),     P0[11], P0[12], P0[13],  pw1[2] = AF_PKW(P0, 12), pw1[3] = AF_PKW(P0, 14), pw1); \
    AF_VRD(2); AF_GA3(C0 = AF_MF(kf[4], qr[2], C0),     P0[14], P0[15], P1[0],   pw2[0] = AF_PKW(P1, 0), pw2[1] = AF_PKW(P1, 2), pw2); \
    AF_VRD(6); AF_GA3(C1 = AF_MF(kf[5], qr[2], C1),     P1[1], P1[2], P1[3],     pw2[2] = AF_PKW(P1, 4), pw2[3] = AF_PKW(P1, 6), pw2); \
    AF_VRD(3); AF_GA2(C0 = AF_MF(kf[6], qr[3], C0),     P1[4], P1[5],            pw3[0] = AF_PKW(P1, 8), pw3); \
    AF_VRD(7); AF_GA2(C1 = AF_MF(kf[7], qr[3], C1),     P1[6], P1[7],            pw3[1] = AF_PKW(P1, 10), pw3); \
    AF_GA2(C0 = AF_MF(kf[8 % DKC], qr[4 % ND0], C0),    P1[8], P1[9],            pw3[2] = AF_PKW(P1, 12), pw3); \
    if (GK) { AF_DMA_KA((t) + 3, s_cur * KSLOT); AF_SBAR(); } \
    AF_GA2(C1 = AF_MF(kf[9 % DKC], qr[4 % ND0], C1),    P1[10], P1[11],          pw3[3] = AF_PKW(P1, 14), pw3); \
    if (GK) { AF_DMA_KB((t) + 3, s_cur * KSLOT); AF_SBAR(); } \
    { C0 = AF_MF(kf[10 % DKC], qr[5 % ND0], C0); sacc += P1[12]; sacc += P1[13]; AF_PIN(sacc); AF_SBAR(); } \
    if (GV) { AF_DMA_V((t) + 1, s_next * VSLOT); AF_SBAR(); } \
    { C1 = AF_MF(kf[11 % DKC], qr[5 % ND0], C1); sacc += P1[14]; sacc += P1[15]; AF_PIN(sacc); AF_SBAR(); } \
    l_reg += sacc; } while (0)
#define AF_PHASE_A8(C0, C1, P0, P1, t, GK, GV) do { \
    AF_VRD(0); float sacc = (P0[0] + P0[1]); \
    AF_GA4(C0 = AF_MF(kf[0], qr[0], zero16), P0[2], P0[3], P0[4], P0[5],       pw0[0] = AF_PKW(P0, 0), pw0[1] = AF_PKW(P0, 2), pw0); \
    AF_VRD(4); AF_GA4(C1 = AF_MF(kf[1], qr[0], zero16), P0[6], P0[7], P0[8], P0[9],       pw0[2] = AF_PKW(P0, 4), pw0[3] = AF_PKW(P0, 6), pw0); \
    AF_VRD(1); AF_GA4(C0 = AF_MF(kf[2], qr[1], C0),     P0[10], P0[11], P0[12], P0[13],   pw1[0] = AF_PKW(P0, 8), pw1[1] = AF_PKW(P0, 10), pw1); \
    AF_VRD(5); AF_GA4(C1 = AF_MF(kf[3], qr[1], C1),     P0[14], P0[15], P1[0], P1[1],     pw1[2] = AF_PKW(P0, 12), pw1[3] = AF_PKW(P0, 14), pw1); \
    AF_VRD(2); AF_GA4(C0 = AF_MF(kf[4], qr[2], C0),     P1[2], P1[3], P1[4], P1[5],       pw2[0] = AF_PKW(P1, 0), pw2[1] = AF_PKW(P1, 2), pw2); \
    AF_VRD(6); AF_GA4(C1 = AF_MF(kf[5], qr[2], C1),     P1[6], P1[7], P1[8], P1[9],       pw2[2] = AF_PKW(P1, 4), pw2[3] = AF_PKW(P1, 6), pw2); \
    AF_VRD(3); AF_GA4(C0 = AF_MF(kf[6], qr[3], C0),     P1[10], P1[11], P1[12], P1[13],   pw3[0] = AF_PKW(P1, 8), pw3[1] = AF_PKW(P1, 10), pw3); \
    AF_VRD(7); AF_GA4(C1 = AF_MF(kf[7], qr[3], C1),     P1[14], P1[15], 0.f, 0.f,         pw3[2] = AF_PKW(P1, 12), pw3[3] = AF_PKW(P1, 14), pw3); \
    l_reg += sacc; \
    if (GK) { AF_DMA_KA((t) + 3, s_cur * KSLOT); } if (GV) { AF_DMA_V((t) + 1, s_next * VSLOT); } } while (0)
#define AF_STEP(C0, C1, P0, P1, t, GK, GV, GL) do { AF_SBAR(); \
    const lds_cptr vp_ = vp0 + s_prev * VSLOT; \
    if constexpr (DKC == 12) AF_PHASE_A12(C0, C1, P0, P1, t, GK, GV); else AF_PHASE_A8(C0, C1, P0, P1, t, GK, GV); \
    if constexpr (U::HAS_MASK) u.mask(C0, C1, (t), wid, r32, hi); \
    AF_SBAR(); \
    AF_GB(o[0] = AF_MF(AF_PAF(0), AF_VFR(0), o[0]), C0, 0);  AF_KRD(GL, 0); \
    AF_GB(o[1] = AF_MF(AF_PAF(0), AF_VFR(4), o[1]), C0, 4);  AF_KRD(GL, 1); \
    AF_GB(o[0] = AF_MF(AF_PAF(1), AF_VFR(1), o[0]), C0, 8);  AF_KRD(GL, 2); \
    AF_GB(o[1] = AF_MF(AF_PAF(1), AF_VFR(5), o[1]), C0, 12); AF_KRD(GL, 3); \
    AF_GB(o[0] = AF_MF(AF_PAF(2), AF_VFR(2), o[0]), C1, 0);  AF_KRD(GL, 4); \
    AF_GB(o[1] = AF_MF(AF_PAF(2), AF_VFR(6), o[1]), C1, 4);  AF_KRD(GL, 5); \
    AF_GB(o[0] = AF_MF(AF_PAF(3), AF_VFR(3), o[0]), C1, 8); \
    AF_GB(o[1] = AF_MF(AF_PAF(3), AF_VFR(7), o[1]), C1, 12); \
  } while (0)
  int t = 1;
  for (; t + 3 < NT; t += 2) {
    AF_STEP(pB0, pB1, pA0, pA1, t, true, true, true);     AF_WAITN(1, 1); AF_ROT();
    AF_STEP(pA0, pA1, pB0, pB1, t + 1, true, true, true); AF_WAITN(1, 1); AF_ROT();
  }
  AF_STEP(pB0, pB1, pA0, pA1, NT - 3, false, true, true);  AF_WAITN(0, 1); AF_ROT();
  AF_STEP(pA0, pA1, pB0, pB1, NT - 2, false, true, true);  AF_WAIT_BAR(0); AF_ROT();
  AF_STEP(pB0, pB1, pA0, pA1, NT - 1, false, false, false);
  { float sacc = pB0[0] + pB0[1];
#pragma unroll
    for (int r = 2; r < 16; ++r) sacc += pB0[r];
#pragma unroll
    for (int r = 0; r < 16; ++r) sacc += pB1[r];
    l_reg += sacc;
    pw0 = (u32x4){AF_PKW(pB0, 0), AF_PKW(pB0, 2), AF_PKW(pB0, 4), AF_PKW(pB0, 6)}; pw1 = (u32x4){AF_PKW(pB0, 8), AF_PKW(pB0, 10), AF_PKW(pB0, 12), AF_PKW(pB0, 14)};
    pw2 = (u32x4){AF_PKW(pB1, 0), AF_PKW(pB1, 2), AF_PKW(pB1, 4), AF_PKW(pB1, 6)}; pw3 = (u32x4){AF_PKW(pB1, 8), AF_PKW(pB1, 10), AF_PKW(pB1, 12), AF_PKW(pB1, 14)};
    AF_SBAR();
    const lds_cptr vp_ = vp0 + s_cur * VSLOT;
#pragma unroll
    for (int i = 0; i < 8; ++i) { vlo[i] = vtr(vp_ + ((i >> 2) * 4096 + (i & 3) * 1024)); vhi[i] = vtr(vp_ + ((i >> 2) * 4096 + (i & 3) * 1024 + 512)); }
    o[0] = AF_MF(AF_PAF(0), AF_VFR(0), o[0]); o[1] = AF_MF(AF_PAF(0), AF_VFR(4), o[1]);
    o[0] = AF_MF(AF_PAF(1), AF_VFR(1), o[0]); o[1] = AF_MF(AF_PAF(1), AF_VFR(5), o[1]);
    o[0] = AF_MF(AF_PAF(2), AF_VFR(2), o[0]); o[1] = AF_MF(AF_PAF(2), AF_VFR(6), o[1]);
    o[0] = AF_MF(AF_PAF(3), AF_VFR(3), o[0]); o[1] = AF_MF(AF_PAF(3), AF_VFR(7), o[1]); }
  { auto rr = __builtin_amdgcn_permlane32_swap(__float_as_uint(l_reg), __float_as_uint(l_reg), false, false); l_reg = __uint_as_float(rr[0]) + __uint_as_float(rr[1]); }
  l_reg += __builtin_amdgcn_exp2f(u.sink(wid));
  if (hi == 0) wsf[32 + r32] = l_reg; asm volatile("s_waitcnt lgkmcnt(0)" ::: "memory");
  float rli[16];
#pragma unroll
  for (int r = 0; r < 16; ++r) rli[r] = __builtin_amdgcn_rcpf(wsf[32 + crow(r, hi)]);
  bf16* Ow = u.orow0(wid);
  { bf16* stg = (bf16*)(shm + LDS_OST) + wid * 2048;
#pragma unroll
    for (int r = 0; r < 16; ++r) { const int orow = crow(r, hi);
#pragma unroll
      for (int d0 = 0; d0 < 2; ++d0) stg[orow * 64 + d0 * 32 + r32] = (bf16)(cvtpk_s(o[d0][r] * rli[r], 0.f) & 0xffffu); }
    asm volatile("s_waitcnt lgkmcnt(0)" ::: "memory");
#pragma unroll
    for (int i = 0; i < 4; ++i) { const int row = i * 8 + (lane >> 3), ch = lane & 7; const u32x4 v = *(const u32x4*)(stg + row * 64 + ch * 8); *(u32x4*)(Ow + (long)row * 1024 + ch * 8) = v; } }
  asm volatile("s_waitcnt vmcnt(0) lgkmcnt(0)\n\ts_barrier" ::: "memory");
#undef AF_DMA_KA
#undef AF_DMA_KB
#undef AF_DMA_K
#undef AF_DMA_V
#undef AF_WAITN
#undef AF_ROT
#undef AF_PKW
#undef AF_PAF
#undef AF_VFR
#undef AF_PIN
#undef AF_MF
#undef AF_EX
#undef AF_VRD
#undef AF_GA4
#undef AF_GA3
#undef AF_GA2
#undef AF_GB
#undef AF_KRD
#undef AF_PHASE_A12
#undef AF_PHASE_A8
#undef AF_STEP
}

constexpr int ROWS_LAT = 16384;
constexpr float LOG2E_ = 1.4426950408889634f;
__device__ __forceinline__ int clampi(int v, int lo, int hi_) { return v < lo ? lo : (v > hi_ ? hi_ : v); }
struct FDense {
  static constexpr bool HAS_MASK = false;
  const bf16* Q; const bf16* kbase; const bf16* vbase; const bf16* krbase; bf16* O; int b, h, qb; static constexpr int kpitch = 2048, vpitch = 2048;
  __device__ __forceinline__ void init(const bf16* Q_, const bf16* KV, const bf16* KR, bf16* O_, int b_, int h_, int qb_) { Q = Q_; kbase = KV + 64 * h_; vbase = KV + 1024 + 64 * h_; krbase = KR; O = O_; b = b_; h = h_; qb = qb_; }
  __device__ __forceinline__ int nt() const { return 132; }
  __device__ __forceinline__ long trow(int t) const { return t < 4 ? (long)(ROWS_LAT + 256 * b + 64 * t) : (long)(8192 * b + 64 * (t - 4)); }
  __device__ __forceinline__ const bf16* qptr(int wid, int r32, int d0, int hi) const { const bf16* qp = Q + (long)(8192 * b + 256 * qb + 32 * wid + r32) * 1536;
    return d0 < 4 ? qp + 64 * h + 16 * d0 + 8 * hi : qp + 1024 + 32 * h + 16 * (d0 - 4) + 8 * hi; }
  __device__ __forceinline__ void mask(f32x16&, f32x16&, int, int, int, int) const {}
  __device__ __forceinline__ float sink(int) const { return -INFINITY; }
  __device__ __forceinline__ bf16* orow0(int wid) const { return O + (long)(8192 * b + 256 * qb + 32 * wid) * 1024 + 64 * h; }
};
struct FWin {
  static constexpr bool HAS_MASK = true; static constexpr int kpitch = 2304, vpitch = 2304;
  const bf16* QKV; const bf16* kbase; const bf16* vbase; const bf16* krbase; bf16* O; const float* sinkp; int b, n, g, hh, i0, cnt;
  __device__ __forceinline__ void init(const bf16* QKV_, bf16* O_, const float* sk, int b_, int n_, int g_, int hh_) { QKV = QKV_; O = O_; sinkp = sk; b = b_; n = n_; g = g_; hh = hh_; krbase = nullptr;
    kbase = QKV_ + 512 + 64 * g_; vbase = QKV_ + 640 + 64 * g_; i0 = (n_ == 0) ? 2 : 0; cnt = (n_ == 0 || n_ == 63) ? 4 : 6; }
  __device__ __forceinline__ int nt() const { return 4 + cnt; }
  __device__ __forceinline__ int kpos0(int t) const { return 128 * (n - 1) + 64 * (i0 + t - 4); }
  __device__ __forceinline__ long trow(int t) const { return t < 4 ? (long)(ROWS_LAT + 256 * b + 64 * t) : (long)(8192 * b + kpos0(t)); }
  __device__ __forceinline__ int head(int wid) const { return 4 * g + 2 * hh + (wid >> 2); }
  __device__ __forceinline__ int qpos0(int wid) const { return 128 * n + 32 * (wid & 3); }
  __device__ __forceinline__ const bf16* qptr(int wid, int r32, int d0, int hi) const { return QKV + (long)(8192 * b + qpos0(wid) + r32) * 2304 + 64 * head(wid) + 16 * d0 + 8 * hi; }
  __device__ __forceinline__ void mask(f32x16& p0, f32x16& p1, int t, int wid, int r32, int hi) const {
    if (t < 4) return;
    const int k0 = kpos0(t), q0 = qpos0(wid);
    if (k0 - (q0 + 31) >= -128 && k0 + 63 - q0 <= 128) return;
    asm volatile("" : "+v"(r32), "+v"(hi));
    const int dq = k0 - (q0 + r32);
#pragma unroll
    for (int r = 0; r < 16; ++r) { const int d = dq + crow(r, hi); if (d > 128 || d < -128) p0[r] = -INFINITY; if (d + 32 > 128 || d + 32 < -128) p1[r] = -INFINITY; }
  }
  __device__ __forceinline__ float sink(int wid) const { return sinkp[head(wid)] * LOG2E_; }
  __device__ __forceinline__ bf16* orow0(int wid) const { return O + (long)(8192 * b + qpos0(wid)) * 1024 + 64 * head(wid); }
};
struct FNa {
  static constexpr bool HAS_MASK = true; static constexpr int kpitch = 2304, vpitch = 2304;
  const bf16* QKV; const bf16* kbase; const bf16* vbase; const bf16* krbase; bf16* O; const float* rpbl; int b, h, R4, krlo, nloc;
  __device__ __forceinline__ void init(const bf16* QKV_, bf16* O_, const float* rpbl_, int b_, int h_, int R4_) { QKV = QKV_; O = O_; rpbl = rpbl_; b = b_; h = h_; R4 = R4_; krbase = nullptr;
    kbase = QKV_ + 1280 + 64 * h_; vbase = QKV_ + 1792 + 64 * h_; krlo = clampi(4 * R4_ - 4, 0, 120); nloc = clampi(4 * R4_ - 1, 0, 120) + 7 - krlo + 1; }
  __device__ __forceinline__ int nt() const { return (4 + nloc + 1) & ~1; }
  __device__ __forceinline__ long trow(int t) const { return (t < 4 || t >= 4 + nloc) ? (long)(ROWS_LAT + 256 * b + 64 * (t & 3)) : (long)(8192 * b + 64 * (krlo + t - 4)); }
  __device__ __forceinline__ int qrow(int wid) const { return 4 * R4 + (wid >> 1); }
  __device__ __forceinline__ const bf16* qptr(int wid, int r32, int d0, int hi) const { return QKV + (long)(8192 * b + 64 * qrow(wid) + 32 * (wid & 1) + r32) * 2304 + 768 + 64 * h + 16 * d0 + 8 * hi; }
  __device__ __forceinline__ void mask(f32x16& p0, f32x16& p1, int t, int wid, int r32, int hi) const {
    if (t < 4) return;
    const int kr = krlo + t - 4, w0 = clampi(qrow(wid) - 4, 0, 120);
    if (t >= 4 + nloc || kr < w0 || kr > w0 + 7) {
#pragma unroll
      for (int r = 0; r < 16; ++r) { p0[r] = -INFINITY; p1[r] = -INFINITY; }
      return; }
    asm volatile("" : "+v"(r32), "+v"(hi));
    const int qc = 32 * (wid & 1) + r32, c0 = clampi(qc - 8, 0, 48);
    const float* brow = rpbl + (kr - qrow(wid) + 7) * 31 + 15;
#pragma unroll
    for (int r = 0; r < 16; ++r) {
      { const int kc = crow(r, hi); const bool ok = kc >= c0 && kc < c0 + 16; const float bv = brow[clampi(kc - qc, -15, 15)]; p0[r] = ok ? p0[r] + bv : -INFINITY; }
      { const int kc = 32 + crow(r, hi); const bool ok = kc >= c0 && kc < c0 + 16; const float bv = brow[clampi(kc - qc, -15, 15)]; p1[r] = ok ? p1[r] + bv : -INFINITY; } }
  }
  __device__ __forceinline__ float sink(int) const { return -INFINITY; }
  __device__ __forceinline__ bf16* orow0(int wid) const { return O + (long)(8192 * b + 64 * qrow(wid) + 32 * (wid & 1)) * 1024 + 512 + 64 * h; }
};
struct FCtx {
  static constexpr bool HAS_MASK = false; static constexpr int kpitch = 2304, vpitch = 2304;
  const bf16* QKV; const bf16* kbase; const bf16* vbase; const bf16* krbase; bf16* O; const float* sinkp; int b, hx, qcol, ocol;
  __device__ __forceinline__ void init(const bf16* QKV_, bf16* O_, const float* sk, int b_, int hx_) { QKV = QKV_; O = O_; sinkp = sk; b = b_; hx = hx_; krbase = nullptr;
    if (hx_ < 8) { qcol = 64 * hx_; kbase = QKV_ + 512 + 64 * (hx_ >> 2); vbase = QKV_ + 640 + 64 * (hx_ >> 2); ocol = 64 * hx_; }
    else { const int h = hx_ - 8; qcol = 768 + 64 * h; kbase = QKV_ + 1280 + 64 * h; vbase = QKV_ + 1792 + 64 * h; ocol = 512 + 64 * h; } }
  __device__ __forceinline__ int nt() const { return 4; }
  __device__ __forceinline__ long trow(int t) const { return (long)(ROWS_LAT + 256 * b + 64 * (t & 3)); }
  __device__ __forceinline__ const bf16* qptr(int wid, int r32, int d0, int hi) const { return QKV + (long)(ROWS_LAT + 256 * b + 32 * wid + r32) * 2304 + qcol + 16 * d0 + 8 * hi; }
  __device__ __forceinline__ void mask(f32x16&, f32x16&, int, int, int, int) const {}
  __device__ __forceinline__ float sink(int) const { return hx < 8 ? sinkp[hx] * LOG2E_ : -INFINITY; }
  __device__ __forceinline__ bf16* orow0(int wid) const { return O + (long)(ROWS_LAT + 256 * b + 32 * wid) * 1024 + ocol; }
};
#undef AF_SBAR
#undef AF_WAIT_BAR
}
constexpr int NWAVES = 8;
#ifndef MK_PER_PHASE
#define MK_PER_PHASE 0
#endif
constexpr int BATCH = 2, SEQ = 8192, DM = 1024, CTXL = 256, FF = 4096;
constexpr int ML = BATCH * SEQ, MC = BATCH * CTXL, MR = ML + MC;
constexpr int NQKV = 2304, NCIN = 768, NUQ = 1536, NUKV = 2048;
constexpr float NORM_EPS = 1e-6f;
constexpr int ADA_KS = 16;
constexpr size_t MiB = 1u << 20;
constexpr size_t WS_CTL = 0, CTL_ZERO_BYTES = 64 * 1024;
constexpr size_t WS_MODP = 1 * MiB;
constexpr size_t WS_MOD = 3 * MiB + 512 * 1024;
constexpr size_t WS_ROPE = 3 * MiB + 768 * 1024;
constexpr size_t WS_HPAR = WS_ROPE + 32 * 1024;
constexpr size_t WS_CTXRES = 4 * MiB;
constexpr size_t WS_WQKV = 6 * MiB, WS_WO0 = WS_WQKV + 4608 * 1024, WS_W1_0 = WS_WO0 + 2 * MiB, WS_W2_0 = WS_W1_0 + 8 * MiB, WS_W1_1 = WS_W2_0 + 8 * MiB, WS_W2_1 = WS_W1_1 + 8 * MiB;
constexpr size_t WS_WIN = WS_W2_1 + 8 * MiB, WS_WUQ = WS_WIN + 1536 * 1024, WS_WUKV = WS_WUQ + 1152 * 1024, WS_WO1 = WS_WUKV + 1 * MiB, WS_WEND = WS_WO1 + 2 * MiB;
constexpr size_t WS_AR = 51 * MiB;
static_assert(WS_WEND <= WS_AR, "weights overlap the arena");
constexpr size_t WS_XN = WS_AR, WS_H = WS_AR + 33 * MiB;
constexpr size_t WS_QKV = WS_AR + 33 * MiB, WS_O0 = WS_AR + 108 * MiB;
constexpr size_t WS_CQKV = WS_AR + 33 * MiB, WS_CQN = WS_AR + 58 * MiB, WS_CKVN = WS_AR + 71 * MiB, WS_KR = WS_AR + 80 * MiB, WS_Q1 = WS_AR + 82 * MiB, WS_KV1 = WS_AR + 130 * MiB, WS_O1 = WS_AR;
constexpr size_t WS_PART5 = WS_AR + 33 * MiB;
constexpr size_t WS_PART8 = WS_AR + 166 * MiB;
constexpr size_t WS_END = 256 * MiB;
static_assert(WS_PART8 + (size_t)16 * 512 * 1024 * 4 <= WS_END && WS_KV1 + (size_t)MR * NUKV * 2 <= WS_END && WS_H + (size_t)MR * FF * 2 <= WS_END, "d_ws map");
constexpr int CW_BAR = 4096;
constexpr int RING_OFF = 0, RING_BYTES = 131072;
constexpr int LDSCTL_OFF = RING_BYTES, MISC_OFF = LDSCTL_OFF + 320;
constexpr int LDS_BYTES = 147456;
static_assert(att::L_END <= RING_BYTES && attf::LDS_BYTES <= RING_BYTES, "attention LDS");

#define GAS __attribute__((address_space(1)))
#define LAS __attribute__((address_space(3)))
typedef unsigned short bf16;
typedef unsigned v4u __attribute__((ext_vector_type(4)));
typedef unsigned v2u __attribute__((ext_vector_type(2)));
typedef float f32x4 __attribute__((ext_vector_type(4)));
typedef GAS unsigned gu32;
#define RLX_AGENT __ATOMIC_RELAXED, __HIP_MEMORY_SCOPE_AGENT
#define LDS_WAIT() asm volatile("s_waitcnt lgkmcnt(0)" ::: "memory")
#define VM_WAIT() asm volatile("s_waitcnt vmcnt(0)" ::: "memory")
__device__ __forceinline__ unsigned f2bf(float f) { unsigned u = __builtin_bit_cast(unsigned, f); return (u + 0x7fffu + ((u >> 16) & 1u)) >> 16; }
__device__ __forceinline__ unsigned pk2(float lo, float hi) { return f2bf(lo) | (f2bf(hi) << 16); }
__device__ __forceinline__ float bf2f(unsigned short h) { return __builtin_bit_cast(float, (unsigned)h << 16); }
__device__ __forceinline__ float bflo(unsigned w) { return __builtin_bit_cast(float, w << 16); }
__device__ __forceinline__ float bfhi(unsigned w) { return __builtin_bit_cast(float, w & 0xffff0000u); }

#define XB_TMO      128
#define XB_XCNT(j)  (256  + 64 * (j))
#define XB_XSUB(j)  (1280 + 64 * (j))
#define XB_XGEN(j)  (2304 + 64 * (j))
#define XB_TOP      3328
#define XB_TOPGEN   3392
#define XCD_BAR_WORDS 3456
#define XB_SPIN_CAP (1u << 18)

__device__ __forceinline__ unsigned xb_ld(unsigned* p)              { return __hip_atomic_load(p, __ATOMIC_RELAXED, __HIP_MEMORY_SCOPE_AGENT); }
__device__ __forceinline__ unsigned xb_add(unsigned* p, unsigned v) { return __hip_atomic_fetch_add(p, v, __ATOMIC_RELAXED, __HIP_MEMORY_SCOPE_AGENT); }
__device__ __forceinline__ unsigned xb_xcc_id() { return (unsigned)__builtin_amdgcn_s_getreg((3 << 11) | 20) & 0xFu; }
#define XB_SPIN(cond, bar) do { unsigned _sp = 0; while (cond) { __builtin_amdgcn_s_sleep(1); \
    if ((++_sp & 255u) == 0u) { if (xb_ld(&(bar)[XB_TMO])) break; if (_sp > XB_SPIN_CAP) { atomicAdd(&(bar)[XB_TMO], 1u); break; } } } } while (0)

struct XcdBarrier {
    unsigned* bar; unsigned x;
    volatile LAS unsigned* st;
};

__device__ __forceinline__ XcdBarrier xcd_barrier_post(unsigned* bar, volatile LAS unsigned* st) {
    XcdBarrier b; b.bar = bar; b.x = xb_xcc_id(); b.st = st;
    if (threadIdx.x == 0) (void)xb_add(&bar[XB_XCNT(b.x)], 1u);
    return b;
}
__device__ __forceinline__ void xcd_barrier_complete(unsigned* bar, unsigned x, unsigned& nloc, unsigned& nx) {
    const unsigned G = gridDim.x * gridDim.y * gridDim.z;
    unsigned sum, cnt, mine, sp = 0u;
    for (;;) {
        sum = 0u; cnt = 0u; mine = 0u;
#pragma unroll
        for (unsigned j = 0; j < 16; ++j) { const unsigned c = xb_ld(&bar[XB_XCNT(j)]); sum += c; cnt += (c > 0u) ? 1u : 0u; mine = (j == x) ? c : mine; }
        if (sum == G) break;
        __builtin_amdgcn_s_sleep(1);
        if ((++sp & 255u) == 0u) { if (xb_ld(&bar[XB_TMO])) break; if (sp > XB_SPIN_CAP) { atomicAdd(&bar[XB_TMO], 1u); break; } }
    }
    nloc = mine > 0u ? mine : 1u; nx = cnt > 0u ? cnt : 1u;
}

__device__ __forceinline__ void xcd_barrier(const XcdBarrier& b) {
    asm volatile("s_waitcnt vmcnt(0)" ::: "memory");
    __syncthreads();
    if (threadIdx.x == 0) {
        unsigned* bar = b.bar;
        __builtin_amdgcn_s_waitcnt(0);
        unsigned nloc = b.st[0], nx = b.st[1];
        if (nloc == 0u) { xcd_barrier_complete(bar, b.x, nloc, nx); b.st[0] = nloc; b.st[1] = nx; }
        const unsigned old = xb_add(&bar[XB_XSUB(b.x)], 1u);
        const unsigned gen = old / nloc;
        if (old + 1u == (gen + 1u) * nloc) {
            __builtin_amdgcn_fence(__ATOMIC_RELEASE, "agent");
            asm volatile("s_waitcnt vmcnt(0)" ::: "memory");
            const unsigned og = xb_add(&bar[XB_TOP], 1u);
            const unsigned tg = og / nx;
            if (og + 1u == (tg + 1u) * nx) xb_add(&bar[XB_TOPGEN], 1u);
            else XB_SPIN(xb_ld(&bar[XB_TOPGEN]) == tg, bar);
            __builtin_amdgcn_fence(__ATOMIC_ACQUIRE, "agent");
            xb_add(&bar[XB_XGEN(b.x)], 1u);
            asm volatile("s_waitcnt vmcnt(0)" ::: "memory");
        } else {
            XB_SPIN(xb_ld(&bar[XB_XGEN(b.x)]) == gen, bar);
            __builtin_amdgcn_fence(__ATOMIC_ACQUIRE, "agent");
            asm volatile("s_waitcnt vmcnt(0)" ::: "memory");
        }
    }
    __syncthreads();
}


template <int K> __device__ __forceinline__ const float* ldarg() {
    auto ka = __builtin_amdgcn_kernarg_segment_ptr();
    const __attribute__((address_space(1))) float* p; asm volatile("s_load_dwordx2 %0, %1, %2\n\ts_waitcnt lgkmcnt(0)" : "=s"(p) : "s"(ka), "i"(K * 8) : "memory"); return (const float*)p;
}
#define ARG(k) (ldarg<k>())
#define ARG_OUT ((float*)ldarg<28>())
#define ARG_WS ((unsigned char*)ldarg<29>())
struct Frame {
    LAS unsigned char* lds;
    volatile LAS unsigned* MISC;
    gu32* ctl;
    int tid, lane, wave;
    int vcu, G, bx;
    float* out; unsigned char* ws;
};
__device__ __forceinline__ float shx(float v, int mask, int lane) { return __builtin_bit_cast(float, __builtin_amdgcn_ds_bpermute((lane ^ mask) << 2, __builtin_bit_cast(int, v))); }
__device__ __forceinline__ float wave_sum(float v, int lane) {
#pragma unroll
    for (int o = 1; o < 64; o <<= 1) v += shx(v, o, lane);
    return v;
}
__device__ __forceinline__ void p0_transpose_item(const float* W, int K, int N, bf16* WT, int pmode, LAS float* scr, int item, int lane) {
    const int nblk = N / 32, kb = item / nblk, nb = item % nblk, k0 = 64 * kb, n0 = 32 * nb;
    int r0 = n0;
    if (pmode == 1) { const int h = n0 / 96, d = n0 % 96; r0 = d < 64 ? h * 64 + d : 1024 + h * 32 + (d - 64); }
    else if (pmode == 2) { const int h = n0 / 128, d = n0 % 128; r0 = d < 64 ? h * 64 + d : 1024 + h * 64 + (d - 64); }
#pragma unroll 8
    for (int i = 0; i < 32; ++i) { const int kk = 2 * i + (lane >> 5); scr[kk * 33 + (lane & 31)] = W[(size_t)(k0 + kk) * N + n0 + (lane & 31)]; }
    LDS_WAIT(); asm volatile("" ::: "memory");
    const int c = lane & 7;
#pragma unroll
    for (int j = 0; j < 4; ++j) { const int n = (lane >> 3) + 8 * j; const LAS float* s = scr + (8 * c) * 33 + n;
        v4u o; o.x = pk2(s[0 * 33], s[1 * 33]); o.y = pk2(s[2 * 33], s[3 * 33]); o.z = pk2(s[4 * 33], s[5 * 33]); o.w = pk2(s[6 * 33], s[7 * 33]);
        *(GAS v4u*)(WT + (size_t)(r0 + n) * K + k0 + 8 * c) = o; }
    LDS_WAIT(); asm volatile("" ::: "memory");
}
__device__ __forceinline__ float silu_f(float v) { return v / (1.f + __expf(-v)); }

__device__ __forceinline__ void p0_prologue(Frame& F) {
    LAS float* scr = (LAS float*)(F.lds + RING_OFF + F.wave * 16384);
    const float* c = ARG(1); const float* cctx = ARG(3);
    if (F.wave >= 5) {
        for (int it = F.vcu * 3 + (F.wave - 5); it < 2 * 24 * ADA_KS; it += F.G * 3) {
            const int l = it / (24 * ADA_KS), rem = it % (24 * ADA_KS), cg = rem / ADA_KS, ks = rem % ADA_KS;
            const float* W = ARG(4) + (size_t)l * DM * 6144 + cg * 256 + 4 * F.lane;
            f32x4 a0 = {0.f, 0.f, 0.f, 0.f}, a1 = a0, a2 = a0;
            const int kbeg = ks * (DM / ADA_KS);
#pragma unroll 8
            for (int k = kbeg; k < kbeg + DM / ADA_KS; ++k) {
                const f32x4 w = *(const GAS f32x4*)(W + (size_t)k * 6144);
                const float s0 = silu_f(c[k]), s1 = silu_f(c[DM + k]), s2 = silu_f(cctx[k]);
                a0 += w * s0; a1 += w * s1; a2 += w * s2;
            }
            float* P = (float*)(F.ws + WS_MODP) + ((size_t)(ks * 2 + l) * 3) * 6144 + cg * 256 + 4 * F.lane;
            *(GAS f32x4*)(P) = a0; *(GAS f32x4*)(P + 6144) = a1; *(GAS f32x4*)(P + 2 * 6144) = a2;
        }
    } else {
        const int gw = F.vcu * 5 + F.wave, NGW = F.G * 5;
        constexpr int I_QKV = 16 * 72, I_O = 16 * 32, I_1 = 16 * 128, I_2 = 64 * 32, I_IN = 16 * 21, I_UQ = 6 * 48, I_UKV = 4 * 64;
        constexpr int NITEMS = I_QKV + I_O + 2 * I_1 + 2 * I_2 + I_IN + I_UQ + I_UKV + I_O;
        for (int it = gw; it < NITEMS; it += NGW) {
            int r = it;
            if (r < I_QKV) { p0_transpose_item(ARG(10), DM, NQKV, (bf16*)(F.ws + WS_WQKV), 0, scr, r, F.lane); continue; } r -= I_QKV;
            if (r < I_O) { p0_transpose_item(ARG(11), DM, DM, (bf16*)(F.ws + WS_WO0), 0, scr, r, F.lane); continue; } r -= I_O;
            if (r < I_1) { p0_transpose_item(ARG(8), DM, FF, (bf16*)(F.ws + WS_W1_0), 0, scr, r, F.lane); continue; } r -= I_1;
            if (r < I_1) { p0_transpose_item(ARG(8) + (size_t)DM * FF, DM, FF, (bf16*)(F.ws + WS_W1_1), 0, scr, r, F.lane); continue; } r -= I_1;
            if (r < I_2) { p0_transpose_item(ARG(9), FF, DM, (bf16*)(F.ws + WS_W2_0), 0, scr, r, F.lane); continue; } r -= I_2;
            if (r < I_2) { p0_transpose_item(ARG(9) + (size_t)DM * FF, FF, DM, (bf16*)(F.ws + WS_W2_1), 0, scr, r, F.lane); continue; } r -= I_2;
            if (r < I_IN) { p0_transpose_item(ARG(18), DM, 672, (bf16*)(F.ws + WS_WIN), 0, scr, r, F.lane); continue; } r -= I_IN;
            if (r < I_UQ) { p0_transpose_item(ARG(21), 384, NUQ, (bf16*)(F.ws + WS_WUQ), 1, scr, r, F.lane); continue; } r -= I_UQ;
            if (r < I_UKV) { p0_transpose_item(ARG(22), 256, NUKV, (bf16*)(F.ws + WS_WUKV), 2, scr, r, F.lane); continue; } r -= I_UKV;
            p0_transpose_item(ARG(27), DM, DM, (bf16*)(F.ws + WS_WO1), 0, scr, r, F.lane);
        }
    }
    if (F.bx == 1 % F.G) {
        float* rt = (float*)(F.ws + WS_ROPE);
        for (int e = F.tid; e < 128 * 16; e += NWAVES * 64) { const int pos = e >> 4, i = e & 15; const float inv = exp2f(-(float)i * (13.287712379549449f / 16.f));
            float x = (float)pos * inv * 0.15915494309189535f; x -= rintf(x); rt[e] = __builtin_amdgcn_cosf(x); rt[2048 + e] = __builtin_amdgcn_sinf(x); }
        for (int e = F.tid; e < 128 * 8; e += NWAVES * 64) { const int pos = e >> 3, i = e & 7; const float inv = exp2f(-(float)i * (13.287712379549449f / 8.f));
            float x = (float)pos * inv * 0.15915494309189535f; x -= rintf(x); rt[4096 + e] = __builtin_amdgcn_cosf(x); rt[5120 + e] = __builtin_amdgcn_sinf(x); }
    }
    if (F.bx == 3 % F.G && F.tid < 64) {
        float* hp = (float*)(F.ws + WS_HPAR); const int i = F.tid;
        hp[i] = ARG(12)[i]; hp[64 + i] = ARG(13)[i]; hp[128 + i] = ARG(15)[i]; hp[192 + i] = ARG(16)[i]; hp[256 + i] = ARG(23)[i]; hp[320 + i] = ARG(24)[i & 31]; hp[384 + i] = ARG(25)[i];
    }
    if (F.bx == 2 % F.G) {
        GAS v4u* z = (GAS v4u*)((bf16*)(F.ws + WS_WIN) + (size_t)672 * DM);
        unsigned zz = 0u; asm volatile("" : "+v"(zz));
        for (int e = F.tid; e < 96 * DM / 8; e += NWAVES * 64) z[e] = (v4u){zz, zz, zz, zz};
    }
}

__device__ __forceinline__ void norm_phase(Frame& F, const float* src_lat, const float* src_ctx, int nrows, const float* gw_, int layer, int which  , bool from_partials, const float* parts = nullptr, int nparts = 0) {
    LAS float* gl = (LAS float*)(F.lds + RING_OFF); LAS float* scl = gl + 1024; LAS float* shl = scl + 3 * 1024;
    const float* modp = (const float*)(F.ws + WS_MODP); const float* mod = (const float*)(F.ws + WS_MOD); const float* ada_b = ARG(5);
    const int offsh = which * 3072, offsc = which * 3072 + 1024;
    for (int i = F.tid; i < 1024; i += NWAVES * 64) {
        gl[i] = gw_[i];
#pragma unroll
        for (int cnd = 0; cnd < 3; ++cnd) {
            float sh, sc;
            if (from_partials) { sh = ada_b[layer * 6144 + offsh + i]; sc = ada_b[layer * 6144 + offsc + i];
                float ph[ADA_KS], pc[ADA_KS];
#pragma unroll
                for (int ks = 0; ks < ADA_KS; ++ks) { const float* p = modp + ((size_t)(ks * 2 + layer) * 3 + cnd) * 6144; ph[ks] = p[offsh + i]; pc[ks] = p[offsc + i]; }
#pragma unroll
                for (int ks = 0; ks < ADA_KS; ++ks) { sh += ph[ks]; sc += pc[ks]; } }
            else { sh = mod[(layer * 3 + cnd) * 6144 + offsh + i]; sc = mod[(layer * 3 + cnd) * 6144 + offsc + i]; }
            scl[cnd * 1024 + i] = 1.f + sc; shl[cnd * 1024 + i] = sh;
        }
    }
    if (from_partials) {
        float* modw = (float*)(F.ws + WS_MOD);
        for (int e = F.vcu * (NWAVES * 64) + F.tid; e < 2 * 3 * 6144; e += F.G * NWAVES * 64) {
            const int l = e / (3 * 6144), rem = e % (3 * 6144), cnd = rem / 6144, col = rem % 6144;
            float v = ada_b[l * 6144 + col];
            float pv[ADA_KS];
#pragma unroll
            for (int ks = 0; ks < ADA_KS; ++ks) pv[ks] = modp[((size_t)(ks * 2 + l) * 3 + cnd) * 6144 + col];
#pragma unroll
            for (int ks = 0; ks < ADA_KS; ++ks) v += pv[ks];
            modw[e] = v;
        }
    }
    __syncthreads();
    bf16* XN = (bf16*)(F.ws + WS_XN);
    const int gw = F.vcu * NWAVES + F.wave, NGW = F.G * NWAVES;
    for (int m = gw; m < nrows; m += NGW) {
        const float* xrow = m < ML ? src_lat + (size_t)m * DM : src_ctx + (size_t)(m - ML) * DM;
        const int cnd = m < SEQ ? 0 : (m < ML ? 1 : 2);
        const GAS f32x4* xr = (const GAS f32x4*)xrow + F.lane;
        f32x4 v[4]; float s = 0.f;
#pragma unroll
        for (int j = 0; j < 4; ++j) v[j] = xr[64 * j];
        if (nparts > 0 && m >= ML) {
            for (int p = 0; p < nparts; p += 4) {
                const GAS f32x4* pr = (const GAS f32x4*)(parts + (size_t)p * (512 * 1024) + (size_t)(m - ML) * DM) + F.lane;
                f32x4 w[4][4];
#pragma unroll
                for (int q = 0; q < 4; ++q)
#pragma unroll
                    for (int j = 0; j < 4; ++j) w[q][j] = pr[(size_t)q * (512 * 1024 / 4) + 64 * j];
#pragma unroll
                for (int j = 0; j < 4; ++j) v[j] += (w[0][j] + w[1][j]) + (w[2][j] + w[3][j]); }
            GAS f32x4* cr = (GAS f32x4*)((float*)(F.ws + WS_CTXRES) + (size_t)(m - ML) * DM) + F.lane;
#pragma unroll
            for (int j = 0; j < 4; ++j) cr[64 * j] = v[j];
        }
#pragma unroll
        for (int j = 0; j < 4; ++j) s += (v[j].x * v[j].x + v[j].y * v[j].y) + (v[j].z * v[j].z + v[j].w * v[j].w);
        const float rstd = 1.f / sqrtf(wave_sum(s, F.lane) * (1.f / DM) + NORM_EPS);
        if (from_partials && m >= ML) { GAS f32x4* cr = (GAS f32x4*)((float*)(F.ws + WS_CTXRES) + (size_t)(m - ML) * DM) + F.lane;
#pragma unroll
            for (int j = 0; j < 4; ++j) cr[64 * j] = v[j]; }
        GAS v2u* o8 = (GAS v2u*)(XN + (size_t)m * DM) + F.lane;
#pragma unroll
        for (int j = 0; j < 4; ++j) { const int col = 4 * F.lane + 256 * j;
            const f32x4 g = *(const LAS f32x4*)(gl + col), sc = *(const LAS f32x4*)(scl + cnd * 1024 + col), sh = *(const LAS f32x4*)(shl + cnd * 1024 + col);
            const f32x4 y = (v[j] * rstd) * g * sc + sh;
            v2u w; w.x = pk2(y.x, y.y); w.y = pk2(y.z, y.w); o8[64 * j] = w; }
    }
    __syncthreads();
}

__device__ __forceinline__ void unpack8(const v4u w, float (&x)[8]) { x[0] = bflo(w.x); x[1] = bfhi(w.x); x[2] = bflo(w.y); x[3] = bfhi(w.y); x[4] = bflo(w.z); x[5] = bfhi(w.z); x[6] = bflo(w.w); x[7] = bfhi(w.w); }
__device__ __forceinline__ v4u pack8(const float (&x)[8]) { v4u w; w.x = pk2(x[0], x[1]); w.y = pk2(x[2], x[3]); w.z = pk2(x[4], x[5]); w.w = pk2(x[6], x[7]); return w; }

__device__ __forceinline__ void qknorm_phase(Frame& F) {
    bf16* QKV = (bf16*)(F.ws + WS_QKV);
    const float* rt = (const float*)(F.ws + WS_ROPE);
    const float* nw[4] = {ARG(12), ARG(13), ARG(15), ARG(16)};
    const float qscale = 0.125f * att::LOG2E;
    const int gw = F.vcu * NWAVES + F.wave, NGW = F.G * NWAVES;
    const int lane = F.lane, grp = lane >> 3, l8 = lane & 7;
    for (int m = gw; m < MR; m += NGW) {
        const bool lat = m < ML; const int t = m & (SEQ - 1); const int prow = t >> 6, pcol = t & 63;
        GAS v4u* rowp = (GAS v4u*)(QKV + (size_t)m * NQKV);
#pragma unroll
        for (int pass = 0; pass < 4; ++pass) {
            int type;
            if (pass == 0) type = 1; else if (pass == 1) type = grp < 2 ? 2 : (grp < 4 ? 0 : 3); else if (pass == 2) type = grp < 4 ? 3 : 4; else type = grp < 4 ? 4 : 0;
            const v4u w = rowp[pass * 64 + lane];
            float x[8]; unpack8(w, x);
            float ss = 0.f;
#pragma unroll
            for (int j = 0; j < 8; ++j) ss += x[j] * x[j];
            ss += shx(ss, 1, F.lane); ss += shx(ss, 2, F.lane); ss += shx(ss, 4, F.lane);
            const float rstd = 1.f / sqrtf(ss * (1.f / 64.f) + NORM_EPS);
            const float* g = type == 1 ? nw[0] : (type == 2 ? nw[1] : (type == 3 ? nw[2] : nw[3]));
            const f32x4 g0 = *(const GAS f32x4*)(g + l8 * 8), g1 = *(const GAS f32x4*)(g + l8 * 8 + 4);
            x[0] *= rstd * g0.x; x[1] *= rstd * g0.y; x[2] *= rstd * g0.z; x[3] *= rstd * g0.w; x[4] *= rstd * g1.x; x[5] *= rstd * g1.y; x[6] *= rstd * g1.z; x[7] *= rstd * g1.w;
            float px[8];
#pragma unroll
            for (int j = 0; j < 8; ++j) px[j] = shx(x[j], 2, F.lane);
            if (lat && (type == 1 || type == 2)) {
                const int pos = (l8 & 4) ? pcol : prow; const float* cs = rt + pos * 16 + (l8 & 1) * 8;
                const f32x4 c0 = *(const GAS f32x4*)(cs), c1 = *(const GAS f32x4*)(cs + 4), s0 = *(const GAS f32x4*)(cs + 2048), s1 = *(const GAS f32x4*)(cs + 2052);
                const float cc[8] = {c0.x, c0.y, c0.z, c0.w, c1.x, c1.y, c1.z, c1.w}, sn[8] = {s0.x, s0.y, s0.z, s0.w, s1.x, s1.y, s1.z, s1.w};
                const float sgn = (l8 & 2) ? 1.f : -1.f;
#pragma unroll
                for (int j = 0; j < 8; ++j) x[j] = x[j] * cc[j] + sgn * px[j] * sn[j];
            }
            if (type == 1 || type == 3) {
#pragma unroll
                for (int j = 0; j < 8; ++j) x[j] *= qscale;
            }
            if (type != 0) rowp[pass * 64 + lane] = pack8(x);
        }
    }
}

__device__ __forceinline__ void cnorm_phase(Frame& F) {
    const bf16* CQKV = (const bf16*)(F.ws + WS_CQKV); bf16* CQN = (bf16*)(F.ws + WS_CQN); bf16* CKVN = (bf16*)(F.ws + WS_CKVN); bf16* KR = (bf16*)(F.ws + WS_KR);
    const float* rt = (const float*)(F.ws + WS_ROPE) + 4096;
    const float* gq = ARG(19); const float* gkv = ARG(20); const float* gkr = ARG(26);
    const int gw = F.vcu * NWAVES + F.wave, NGW = F.G * NWAVES; const int lane = F.lane;
    for (int m = gw; m < MR; m += NGW) {
        const bool lat = m < ML; const int t = m & (SEQ - 1); const int prow = t >> 6, pcol = t & 63;
        const GAS v4u* rowp = (const GAS v4u*)(CQKV + (size_t)m * NCIN);
        const v4u w0 = rowp[lane]; v4u w1 = {0u, 0u, 0u, 0u}; if (lane < 32) w1 = rowp[64 + lane];
        float x0[8], x1[8]; unpack8(w0, x0); unpack8(w1, x1);
        float s0 = 0.f, s1 = 0.f;
#pragma unroll
        for (int j = 0; j < 8; ++j) { s0 += x0[j] * x0[j]; s1 += x1[j] * x1[j]; }
        const float ssq = wave_sum(lane < 48 ? s0 : 0.f, F.lane);
        const float sskv = wave_sum((lane >= 48 ? s0 : 0.f) + (lane < 16 ? s1 : 0.f), F.lane);
        const float sskr = wave_sum((lane >= 16 && lane < 20) ? s1 : 0.f, F.lane);
        const float rq = 1.f / sqrtf(ssq * (1.f / 384.f) + NORM_EPS), rkv = 1.f / sqrtf(sskv * (1.f / 256.f) + NORM_EPS), rkr = 1.f / sqrtf(sskr * (1.f / 32.f) + NORM_EPS);
        { const float* g = lane < 48 ? gq + lane * 8 : gkv + (lane - 48) * 8; const float r = lane < 48 ? rq : rkv;
          const f32x4 g0 = *(const GAS f32x4*)(g), g1 = *(const GAS f32x4*)(g + 4);
          float y[8] = {x0[0] * r * g0.x, x0[1] * r * g0.y, x0[2] * r * g0.z, x0[3] * r * g0.w, x0[4] * r * g1.x, x0[5] * r * g1.y, x0[6] * r * g1.z, x0[7] * r * g1.w};
          if (lane < 48) *(GAS v4u*)(CQN + (size_t)m * 384 + lane * 8) = pack8(y); else *(GAS v4u*)(CKVN + (size_t)m * 256 + (lane - 48) * 8) = pack8(y); }
        { const int li = lane < 16 ? lane : (lane < 20 ? lane - 16 : 0);
          const float* g = lane < 16 ? gkv + 128 + li * 8 : gkr + li * 8; const float r = lane < 16 ? rkv : rkr;
          const f32x4 g0 = *(const GAS f32x4*)(g), g1 = *(const GAS f32x4*)(g + 4);
          float y[8] = {x1[0] * r * g0.x, x1[1] * r * g0.y, x1[2] * r * g0.z, x1[3] * r * g0.w, x1[4] * r * g1.x, x1[5] * r * g1.y, x1[6] * r * g1.z, x1[7] * r * g1.w};
          float py[8];
#pragma unroll
          for (int j = 0; j < 8; ++j) py[j] = shx(y[j], 1, F.lane);
          if (lat && lane >= 16 && lane < 20) {
              const int pos = (lane & 2) ? pcol : prow; const float* cs = rt + pos * 8;
              const f32x4 c0 = *(const GAS f32x4*)(cs), c1 = *(const GAS f32x4*)(cs + 4), sa = *(const GAS f32x4*)(cs + 1024), sb = *(const GAS f32x4*)(cs + 1028);
              const float cc[8] = {c0.x, c0.y, c0.z, c0.w, c1.x, c1.y, c1.z, c1.w}, sn[8] = {sa.x, sa.y, sa.z, sa.w, sb.x, sb.y, sb.z, sb.w};
              const float sgn = (lane & 1) ? 1.f : -1.f;
#pragma unroll
              for (int j = 0; j < 8; ++j) y[j] = y[j] * cc[j] + sgn * py[j] * sn[j];
          }
          if (lane < 16) *(GAS v4u*)(CKVN + (size_t)m * 256 + 128 + lane * 8) = pack8(y);
          else if (lane < 20) *(GAS v4u*)(KR + (size_t)m * 32 + (lane - 16) * 8) = pack8(y); }
    }
}

__device__ __forceinline__ void hnorm_phase(Frame& F) {
    bf16* Q = (bf16*)(F.ws + WS_Q1); bf16* KV = (bf16*)(F.ws + WS_KV1);
    const float* rt = (const float*)(F.ws + WS_ROPE) + 4096;
    const float* gqn = ARG(23); const float* gqr = ARG(24); const float* gkn = ARG(25);
    const float qscale = 0.10206207261596575f * att::LOG2E;
    const int gw = F.vcu * NWAVES + F.wave, NGW = F.G * NWAVES; const int lane = F.lane, l8 = lane & 7, l4 = lane & 3;
    for (int m = gw; m < MR; m += NGW) {
        const bool lat = m < ML; const int t = m & (SEQ - 1); const int prow = t >> 6, pcol = t & 63;
        { GAS v4u* rowp = (GAS v4u*)(KV + (size_t)m * NUKV);
          const f32x4 g0 = *(const GAS f32x4*)(gkn + l8 * 8), g1 = *(const GAS f32x4*)(gkn + l8 * 8 + 4);
#pragma unroll
          for (int pass = 0; pass < 2; ++pass) {
              float x[8]; unpack8(rowp[pass * 64 + lane], x); float ss = 0.f;
#pragma unroll
              for (int j = 0; j < 8; ++j) ss += x[j] * x[j];
              ss += shx(ss, 1, F.lane); ss += shx(ss, 2, F.lane); ss += shx(ss, 4, F.lane);
              const float r = 1.f / sqrtf(ss * (1.f / 64.f) + NORM_EPS);
              x[0] *= r * g0.x; x[1] *= r * g0.y; x[2] *= r * g0.z; x[3] *= r * g0.w; x[4] *= r * g1.x; x[5] *= r * g1.y; x[6] *= r * g1.z; x[7] *= r * g1.w;
              rowp[pass * 64 + lane] = pack8(x); } }
        if (lat) {
            GAS v4u* rowp = (GAS v4u*)(Q + (size_t)m * NUQ);
            { const f32x4 g0 = *(const GAS f32x4*)(gqn + l8 * 8), g1 = *(const GAS f32x4*)(gqn + l8 * 8 + 4);
#pragma unroll
              for (int pass = 0; pass < 2; ++pass) {
                  float x[8]; unpack8(rowp[pass * 64 + lane], x); float ss = 0.f;
#pragma unroll
                  for (int j = 0; j < 8; ++j) ss += x[j] * x[j];
                  ss += shx(ss, 1, F.lane); ss += shx(ss, 2, F.lane); ss += shx(ss, 4, F.lane);
                  const float r = qscale / sqrtf(ss * (1.f / 64.f) + NORM_EPS);
                  x[0] *= r * g0.x; x[1] *= r * g0.y; x[2] *= r * g0.z; x[3] *= r * g0.w; x[4] *= r * g1.x; x[5] *= r * g1.y; x[6] *= r * g1.z; x[7] *= r * g1.w;
                  rowp[pass * 64 + lane] = pack8(x); } }
            {
              const f32x4 g0 = *(const GAS f32x4*)(gqr + l4 * 8), g1 = *(const GAS f32x4*)(gqr + l4 * 8 + 4);
              float x[8]; unpack8(rowp[128 + lane], x); float ss = 0.f;
#pragma unroll
              for (int j = 0; j < 8; ++j) ss += x[j] * x[j];
              ss += shx(ss, 1, F.lane); ss += shx(ss, 2, F.lane);
              const float r = 1.f / sqrtf(ss * (1.f / 32.f) + NORM_EPS);
              x[0] *= r * g0.x; x[1] *= r * g0.y; x[2] *= r * g0.z; x[3] *= r * g0.w; x[4] *= r * g1.x; x[5] *= r * g1.y; x[6] *= r * g1.z; x[7] *= r * g1.w;
              float px[8];
#pragma unroll
              for (int j = 0; j < 8; ++j) px[j] = shx(x[j], 1, F.lane);
              const int pos = (l4 & 2) ? pcol : prow; const float* cs = rt + pos * 8;
              const f32x4 c0 = *(const GAS f32x4*)(cs), c1 = *(const GAS f32x4*)(cs + 4), sa = *(const GAS f32x4*)(cs + 1024), sb = *(const GAS f32x4*)(cs + 1028);
              const float cc[8] = {c0.x, c0.y, c0.z, c0.w, c1.x, c1.y, c1.z, c1.w}, sn[8] = {sa.x, sa.y, sa.z, sa.w, sb.x, sb.y, sb.z, sb.w};
              const float sgn = (l4 & 1) ? 1.f : -1.f;
#pragma unroll
              for (int j = 0; j < 8; ++j) x[j] = (x[j] * cc[j] + sgn * px[j] * sn[j]) * qscale;
              rowp[128 + lane] = pack8(x); }
        }
    }
}

__device__ __forceinline__ void attn0_phase(Frame& F) {
    att::lchar* lds = (att::lchar*)(F.lds + RING_OFF);
    const att::bf16* QKV = (const att::bf16*)(F.ws + WS_QKV); att::bf16* O = (att::bf16*)(F.ws + WS_O0);
    bool fast;
    { float a = fabsf(ARG(12)[F.lane]), b_ = fabsf(ARG(13)[F.lane]), c_ = fabsf(ARG(15)[F.lane]), d_ = fabsf(ARG(16)[F.lane]), e_ = 0.f, f_ = fabsf(ARG(14)[F.lane & 7]);
      for (int i = F.lane; i < 8 * 465; i += 64) e_ = fmaxf(e_, fabsf(ARG(17)[i]));
#pragma unroll
      for (int o_ = 1; o_ < 64; o_ <<= 1) { a = fmaxf(a, shx(a, o_, F.lane)); b_ = fmaxf(b_, shx(b_, o_, F.lane)); c_ = fmaxf(c_, shx(c_, o_, F.lane)); d_ = fmaxf(d_, shx(d_, o_, F.lane)); e_ = fmaxf(e_, shx(e_, o_, F.lane)); f_ = fmaxf(f_, shx(f_, o_, F.lane)); }
      const float bound = fmaxf(fmaxf(8.f * a * b_, 8.f * c_ * d_ + e_), f_) * att::LOG2E;
      fast = __builtin_amdgcn_readfirstlane(bound < 64.f ? 1 : 0) != 0; }
    char* shm = (char*)(F.lds + RING_OFF);
    for (int ui = F.vcu; ui < 1056; ui += F.G) {
        if (ui < 512) {
            const int b = ui >> 8, h = (ui >> 5) & 7, R4 = ui & 31;
            const float* rpb = ARG(17) + h * 465;
            if (fast) {
                float* rl = (float*)(shm + attf::LDS_RPB);
                for (int i = F.tid; i < 465; i += NWAVES * 64) rl[i] = rpb[i] * att::LOG2E;
                __syncthreads();
                attf::FNa fu; fu.init((const attf::bf16*)QKV, (attf::bf16*)O, rl, b, h, R4);
                attf::fast_unit<8, attf::FNa>(fu, shm, F.tid);
            } else {
                att::UNa u; u.QKV = QKV; u.O = O; u.rpbl = (const LAS float*)(lds + att::L_RPB); u.b = b; u.h = h; u.R4 = R4; u.init();
                for (int i = F.tid; i < 465; i += NWAVES * 64) ((LAS float*)(lds + att::L_RPB))[i] = rpb[i] * att::LOG2E;
                att::unit<8, att::UNa>(u, lds, F.tid);
            }
        } else if (ui < 1024) {
            const int v = ui - 512;
            if (fast) { attf::FWin fu; fu.init((const attf::bf16*)QKV, (attf::bf16*)O, ARG(14), v >> 8, (v >> 2) & 63, (v >> 1) & 1, v & 1); attf::fast_unit<8, attf::FWin>(fu, shm, F.tid); }
            else { att::UWin u; u.QKV = QKV; u.O = O; u.sinkp = ARG(14); u.b = v >> 8; u.n = (v >> 2) & 63; u.g = (v >> 1) & 1; u.hh = v & 1; u.init(); att::unit<8, att::UWin>(u, lds, F.tid); }
        } else {
            const int v = ui - 1024;
            if (fast) { attf::FCtx fu; fu.init((const attf::bf16*)QKV, (attf::bf16*)O, ARG(14), v >> 4, v & 15); attf::fast_unit<8, attf::FCtx>(fu, shm, F.tid); }
            else { att::UCtx u; u.QKV = QKV; u.O = O; u.sinkp = ARG(14); u.b = v >> 4; u.hx = v & 15; u.init(); att::unit<8, att::UCtx>(u, lds, F.tid); }
        }
    }
}
__device__ __forceinline__ void attn1_phase(Frame& F) {
    att::lchar* lds = (att::lchar*)(F.lds + RING_OFF);
    bool fast;
    { float a = fabsf(ARG(23)[F.lane]), b_ = fabsf(ARG(25)[F.lane]), c_ = fabsf(ARG(24)[F.lane & 31]), d_ = fabsf(ARG(26)[F.lane & 31]);
#pragma unroll
      for (int o_ = 1; o_ < 64; o_ <<= 1) { a = fmaxf(a, shx(a, o_, F.lane)); b_ = fmaxf(b_, shx(b_, o_, F.lane)); c_ = fmaxf(c_, shx(c_, o_, F.lane)); d_ = fmaxf(d_, shx(d_, o_, F.lane)); }
      const float bound = (64.f * a * b_ + 32.f * c_ * d_) * (0.10206207261596575f * att::LOG2E);
      fast = __builtin_amdgcn_readfirstlane(bound < 64.f ? 1 : 0) != 0; }
    const bool g256 = F.G == 256; const int x = F.vcu >> 5, j = F.vcu & 31;
    const int nit = g256 ? 4 : (F.vcu < 1024 ? (1024 - F.vcu + F.G - 1) / F.G : 0);
    for (int i = 0; i < nit; ++i) {
        const int ui = g256 ? ((x * 4 + i) * 32 + j) : F.vcu + i * F.G;
        if (fast) attd::dense_unit(ui >> 9, (ui >> 5) & 15, ui & 31, (const attd::bf16*)(F.ws + WS_Q1), (const attd::bf16*)(F.ws + WS_KV1), (const attd::bf16*)(F.ws + WS_KR), (attd::bf16*)(F.ws + WS_O1), (char*)(F.lds + RING_OFF), F.tid);
        else {
        att::UDense u; u.Q = (const att::bf16*)(F.ws + WS_Q1); u.KV = (const att::bf16*)(F.ws + WS_KV1); u.KR = (const att::bf16*)(F.ws + WS_KR); u.O = (att::bf16*)(F.ws + WS_O1);
        u.b = ui >> 9; u.h = (ui >> 5) & 15; u.qb = ui & 31;
        att::unit<12, att::UDense>(u, lds, F.tid); }
    }
}

#ifndef PHASE_MASK
#define PHASE_MASK 0xFFFFFu
#endif
#ifndef PHASE_REP
#define PHASE_REP 0u
#endif
struct Args { const float* in[28]; float* out; unsigned char* ws; int ph_lo, ph_hi; };
constexpr int N_PHASES = 19;
__global__ void __launch_bounds__(NWAVES * 64, 2) fwd_kernel(Args args) {
    extern __shared__ __attribute__((aligned(16))) unsigned char lds[];
    for (int u = threadIdx.x; u < (LDS_BYTES - LDSCTL_OFF) / 4; u += NWAVES * 64) ((LAS unsigned*)((LAS unsigned char*)lds + LDSCTL_OFF))[u] = 0u;
    __syncthreads();
    if (!MK_PER_PHASE) (void)xcd_barrier_post((unsigned*)((gu32*)(ARG_WS + WS_CTL) + CW_BAR), (volatile LAS unsigned*)((LAS unsigned char*)lds + MISC_OFF) + 8);
    for (int ph2 = 2 * args.ph_lo; ph2 < 2 * args.ph_hi; ++ph2) {
        const int ph = ph2 >> 1; if ((ph2 & 1) && !((PHASE_REP >> ph) & 1)) continue;
        if (ph == 3 || ph == 14) continue;
        Frame F;
        { int t_ = threadIdx.x; asm volatile("" : "+v"(t_)); int b_ = blockIdx.x; asm volatile("" : "+s"(b_)); int g_ = gridDim.x; asm volatile("" : "+s"(g_)); F.tid = t_; F.bx = b_; F.G = g_; }
        F.lds = (LAS unsigned char*)lds; F.MISC = (volatile LAS unsigned*)(F.lds + MISC_OFF);
        F.lane = F.tid & 63; F.wave = __builtin_amdgcn_readfirstlane(F.tid >> 6);
        F.vcu = (F.G % 8 == 0) ? (F.bx % 8) * (F.G / 8) + F.bx / 8 : F.bx;
        F.ws = ARG_WS; F.out = ARG_OUT; F.ctl = (gu32*)(F.ws + WS_CTL);
        XcdBarrier bar; bar.bar = (unsigned*)(F.ctl + CW_BAR); bar.x = xb_xcc_id(); bar.st = F.MISC + 8;
        float* ctxres = (float*)(F.ws + WS_CTXRES);
        const float* mod = (const float*)(F.ws + WS_MOD);
        int gk = 0, xrows = 0, xS = 0;
        pg8::Gemm g{nullptr, nullptr, 0, 0, 0}; pg8::EpiAny ea{0, nullptr, nullptr, nullptr, nullptr, 0, 0};
        switch (ph) {
        case 0: if (!((PHASE_MASK >> 0) & 1)) break; p0_prologue(F); break;
        case 1: if (!((PHASE_MASK >> 1) & 1)) break; norm_phase(F, ARG(0), ARG(2), MR, ARG(6), 0, 0, true); break;
        case 2: if (!((PHASE_MASK >> 2) & 1)) break; gk = 1; g = pg8::Gemm{(const bf16*)(F.ws + WS_XN), (const bf16*)(F.ws + WS_WQKV), MR, NQKV, DM}; ea = pg8::EpiAny{3, (const float*)(F.ws + WS_HPAR), (void*)(F.ws + WS_QKV), nullptr, (const float*)(F.ws + WS_ROPE), NQKV, 0}; break;
        case 4: if (!((PHASE_MASK >> 4) & 1)) break; attn0_phase(F); break;
        case 5: if (!((PHASE_MASK >> 5) & 1)) break; gk = 2; g = pg8::Gemm{(const bf16*)(F.ws + WS_O0), (const bf16*)(F.ws + WS_WO0), ML, DM, DM}; xrows = MC; xS = 2; ea = pg8::EpiAny{2, ARG(0), (void*)F.out, (float*)(F.ws + WS_PART5), mod + 2048, 0, 0}; break;
        case 6: if (!((PHASE_MASK >> 6) & 1)) break; norm_phase(F, F.out, ctxres, MR, ARG(7), 0, 1, false, (const float*)(F.ws + WS_PART5), 4); break;
        case 7: if (!((PHASE_MASK >> 7) & 1)) break; gk = 1; g = pg8::Gemm{(const bf16*)(F.ws + WS_XN), (const bf16*)(F.ws + WS_W1_0), MR, FF, DM}; ea = pg8::EpiAny{1, nullptr, (void*)(F.ws + WS_H), nullptr, nullptr, FF, 1}; break;
        case 8: if (!((PHASE_MASK >> 8) & 1)) break; gk = 2; g = pg8::Gemm{(const bf16*)(F.ws + WS_H), (const bf16*)(F.ws + WS_W2_0), ML, DM, FF}; xrows = MC; xS = 4; ea = pg8::EpiAny{2, F.out, (void*)F.out, (float*)(F.ws + WS_PART8), mod + 5120, 0, 0}; break;
        case 9: if (!((PHASE_MASK >> 9) & 1)) break; norm_phase(F, F.out, ctxres, MR, ARG(6) + DM, 1, 0, false, (const float*)(F.ws + WS_PART8), 16); break;
        case 10: if (!((PHASE_MASK >> 10) & 1)) break; gk = 1; g = pg8::Gemm{(const bf16*)(F.ws + WS_XN), (const bf16*)(F.ws + WS_WIN), MR, NCIN, DM}; ea = pg8::EpiAny{1, nullptr, (void*)(F.ws + WS_CQKV), nullptr, nullptr, NCIN, 0}; break;
        case 11: if (!((PHASE_MASK >> 11) & 1)) break; cnorm_phase(F); break;
        case 12: if (!((PHASE_MASK >> 12) & 1)) break; gk = 1; g = pg8::Gemm{(const bf16*)(F.ws + WS_CQN), (const bf16*)(F.ws + WS_WUQ), ML, NUQ, 384}; ea = pg8::EpiAny{3, (const float*)(F.ws + WS_HPAR), (void*)(F.ws + WS_Q1), nullptr, (const float*)(F.ws + WS_ROPE), NUQ, 1}; break;
        case 13: if (!((PHASE_MASK >> 13) & 1)) break; gk = 1; g = pg8::Gemm{(const bf16*)(F.ws + WS_CKVN), (const bf16*)(F.ws + WS_WUKV), MR, NUKV, 256}; ea = pg8::EpiAny{3, (const float*)(F.ws + WS_HPAR), (void*)(F.ws + WS_KV1), nullptr, (const float*)(F.ws + WS_ROPE), NUKV, 2}; break;
        case 15: if (!((PHASE_MASK >> 15) & 1)) break; attn1_phase(F); break;
        case 16: if (!((PHASE_MASK >> 16) & 1)) break; gk = 2; g = pg8::Gemm{(const bf16*)(F.ws + WS_O1), (const bf16*)(F.ws + WS_WO1), ML, DM, DM}; ea = pg8::EpiAny{2, F.out, (void*)F.out, ctxres, mod + 3 * 6144 + 2048, 0, 0}; break;
        case 17: if (!((PHASE_MASK >> 17) & 1)) break; norm_phase(F, F.out, ctxres, ML, ARG(7) + DM, 1, 1, false); break;
        case 18: if (!((PHASE_MASK >> 18) & 1)) break; gk = 1; g = pg8::Gemm{(const bf16*)(F.ws + WS_XN), (const bf16*)(F.ws + WS_W1_1), ML, FF, DM}; ea = pg8::EpiAny{1, nullptr, (void*)(F.ws + WS_H), nullptr, nullptr, FF, 1}; break;
        case 19: if (!((PHASE_MASK >> 19) & 1)) break; gk = 2; g = pg8::Gemm{(const bf16*)(F.ws + WS_H), (const bf16*)(F.ws + WS_W2_1), ML, DM, FF}; ea = pg8::EpiAny{2, F.out, (void*)F.out, ctxres, mod + 3 * 6144 + 5120, 0, 0}; break;
        default: break;
        }
        if (gk != 0) { pg8::StaticOrder S; S.init(g.M, g.N, g.K, F.G, F.bx, xrows, xS); pg8::gemm_phase<pg8::EpiAny, pg8::StaticOrder, true, true>(F.lds + RING_OFF, g, S, ea, F.tid); }
        const bool last_ = (ph == args.ph_hi - 1) && ((ph2 & 1) || !((PHASE_REP >> ph) & 1));
        if (!MK_PER_PHASE && !last_ && ph != 12) xcd_barrier(bar);
        else __syncthreads();
    }
}

extern "C" void kernel_launch(void* const* d_in, const int* in_sizes, int n_in, void* d_out, int out_size, void* d_ws, size_t ws_size, hipStream_t stream) {
    static int grid = 0;
    if (grid == 0) {
        if (n_in != 28 || in_sizes[0] != ML * DM || out_size != ML * DM || ws_size < WS_END) { fprintf(stderr, "kernel_launch: unexpected shapes: n_in %d in0 %d out %d ws %zu\n", n_in, n_in > 0 ? in_sizes[0] : -1, out_size, ws_size); grid = -1; return; }
        int dev = 0, cus = 0, per_cu = 0;
        if (hipGetDevice(&dev) != hipSuccess || hipDeviceGetAttribute(&cus, hipDeviceAttributeMultiprocessorCount, dev) != hipSuccess) { fprintf(stderr, "kernel_launch: device query failed\n"); grid = -1; return; }
        if (hipFuncSetAttribute((const void*)fwd_kernel, hipFuncAttributeMaxDynamicSharedMemorySize, LDS_BYTES) != hipSuccess) { fprintf(stderr, "kernel_launch: hipFuncSetAttribute failed\n"); grid = -1; return; }
        if (hipOccupancyMaxActiveBlocksPerMultiprocessor(&per_cu, (const void*)fwd_kernel, NWAVES * 64, LDS_BYTES) != hipSuccess || per_cu < 1)
            fprintf(stderr, "kernel_launch: note: occupancy query reports %d workgroups per CU\n", per_cu);
        (void)hipGetLastError();
        grid = cus;
    }
    if (grid < 0) return;
    if (hipMemsetAsync((char*)d_ws + WS_CTL, 0, CTL_ZERO_BYTES, stream) != hipSuccess) { fprintf(stderr, "kernel_launch: hipMemsetAsync failed\n"); return; }
    Args a{};
    for (int i = 0; i < 28; ++i) a.in[i] = (const float*)d_in[i];
    a.out = (float*)d_out; a.ws = (unsigned char*)d_ws;
#if MK_PER_PHASE
    for (int ph = 0; ph <= N_PHASES; ++ph) { a.ph_lo = ph; a.ph_hi = ph + 1; hipLaunchKernelGGL(fwd_kernel, dim3(grid), dim3(NWAVES * 64), LDS_BYTES, stream, a); }
#else
    a.ph_lo = 0; a.ph_hi = N_PHASES + 1;
    hipLaunchKernelGGL(fwd_kernel, dim3(grid), dim3(NWAVES * 64), LDS_BYTES, stream, a);
#endif
    const hipError_t le = hipPeekAtLastError();
    if (le != hipSuccess) fprintf(stderr, "kernel_launch: launch failed: %s\n", hipGetErrorName(le));
}
```

```cpp
#include <hip/hip_runtime.h>
#include <cstdio>
#include <cstdint>
namespace pg8 {
#define PG8_LAS __attribute__((address_space(3)))
typedef unsigned short bf16_t;
typedef short bf16x8 __attribute__((ext_vector_type(8)));
typedef float f32x4 __attribute__((ext_vector_type(4)));
typedef unsigned u32x4 __attribute__((ext_vector_type(4)));
typedef unsigned u32x2 __attribute__((ext_vector_type(2)));
constexpr int BM = 256, BK = 64, HALF = 128, HTB = HALF * BK * 2  , STAGE_BYTES = 8 * HTB, NXCD = 8, WGM = 8;

__host__ __device__ __forceinline__ int lds_byte(int r, int c) { const int st = (r >> 4) * 2 + (c >> 5), rr = r & 15, cc = c & 31, ob = rr * 64 + cc * 2; return st * 1024 + (ob ^ (((ob >> 9) & 1) << 5)); }
__host__ __device__ __forceinline__ void stage_rc(int b, int& R, int& C) { const int st = b / 1024, sb = b % 1024, swz = sb ^ (((sb >> 9) & 1) << 5); R = (st >> 1) * 16 + swz / 64; C = (st & 1) * 32 + (swz % 64) / 2; }
__host__ __device__ __forceinline__ int perm32(int rho) { const int n = rho >> 4, i = rho & 15; return 8 * (i >> 2) + 4 * n + (i & 3); }

struct Unit { int pm, pn, kinfo; };
struct Gemm { const bf16_t* A; const bf16_t* Bt; int M, N, K; };

struct StaticOrder {
    int nM, nN, nwg, G, c, ntK;
    int xtiles, xsh;
    __host__ __device__ void init(int M, int N, int K, int G_, int c_, int extra_rows = 0, int S = 1) { nM = M / BM; nN = N / BM; nwg = nM * nN; G = G_; c = c_; ntK = K / BK;
        xtiles = (extra_rows / BM) * nN; xsh = S; }
    __host__ __device__ bool next(int i, Unit& u) const {
        const long L = (long)i * G + c;
        if (L >= nwg) {
            if (xtiles == 0) return false;
            const int nb = (nwg - c + G - 1) / G;
            const int nbc = c < nwg ? nb : 0;
            const long e = (long)(i - nbc) * G + ((c + G - (nwg % G)) % G);
            if (e >= ((long)xtiles << xsh)) return false;
            const int tile = (int)(e >> xsh), ks = (int)e & ((1 << xsh) - 1), xnt = ntK >> xsh;
            u.pm = nM + tile / nN; u.pn = tile % nN; u.kinfo = (ks * xnt) | (xnt << 8) | (1 << 16); return true;
        }
        int wgid = (int)L; { const int q = nwg / NXCD, r = nwg % NXCD, xcd = wgid % NXCD, off = wgid / NXCD; wgid = (xcd < r ? xcd * (q + 1) : r * (q + 1) + (xcd - r) * q) + off; }
        const int nig = WGM * nN, gid = wgid / nig, fm = gid * WGM, gsz = (nM - fm) < WGM ? (nM - fm) : WGM;
        u.pm = fm + ((wgid % nig) % gsz); u.pn = (wgid % nig) / gsz; u.kinfo = ntK << 8; return true;
    }
    __device__ __forceinline__ void a_ready(const Unit&) const {}
    __device__ __forceinline__ void done(const Unit&) const {}
};

__device__ __forceinline__ unsigned cvt_pk_bf16(float lo, float hi) { unsigned r; asm volatile("v_cvt_pk_bf16_f32 %0, %1, %2" : "=v"(r) : "v"(lo), "v"(hi)); return r; }
struct EpiAny {
    static constexpr bool AFTER_DRAIN = false;
    int mode; const float* base; void* out; float* ctxres; const float* gate; int ldc, relu2;
    __device__ __forceinline__ bool perm() const { return mode == 1; }
    __device__ __forceinline__ bool headmode() const { return mode == 3; }
    __device__ __forceinline__ static float xsh(float v, int mask, int lane) { return __builtin_bit_cast(float, __builtin_amdgcn_ds_bpermute((lane ^ mask) << 2, __builtin_bit_cast(int, v))); }
    __device__ __forceinline__ void head_epilogue(const f32x4 (&acc)[2][2][4][2], const Unit& u, int wr, int wc, int fr, int fq) const {
        const int H = 4 * u.pn + wc, kind = relu2, lane = fr + 16 * fq;
        int cls, gsel; float qs = 1.f;
        if (kind == 0) { if (H < 8) { cls = 2; gsel = 0; qs = 0.125f * 1.4426950408889634f; } else if (H < 10) { cls = 2; gsel = 1; } else if (H < 12) { cls = 0; gsel = 0; }
                         else if (H < 20) { cls = 1; gsel = 2; qs = 0.125f * 1.4426950408889634f; } else if (H < 28) { cls = 1; gsel = 3; } else { cls = 0; gsel = 0; } }
        else if (kind == 1) { qs = 0.10206207261596575f * 1.4426950408889634f; if (H < 16) { cls = 1; gsel = 4; } else { cls = 3; gsel = 5; } }
        else { if (H < 16) { cls = 1; gsel = 6; } else { cls = 0; gsel = 0; } }
        const bool lat = u.pm < 64;
        const bool f8 = kind != 0 && H < 16 && base[448] != 0.f;
        bf16_t* O = (bf16_t*)out;
        const int col0 = u.pn * BM + 64 * wc + 8 * fq;
        f32x4 gv[2][2];
#pragma unroll
        for (int bj = 0; bj < 2; ++bj)
#pragma unroll
            for (int n = 0; n < 2; ++n) gv[bj][n] = *(const f32x4*)(base + gsel * 64 + 32 * bj + 8 * fq + 4 * n);
#pragma unroll
        for (int ai = 0; ai < 2; ++ai)
#pragma unroll
            for (int m = 0; m < 4; ++m) {
                const int row = u.pm * BM + ai * HALF + wr * 64 + m * 16 + fr;
                f32x4 v[2][2];
#pragma unroll
                for (int bj = 0; bj < 2; ++bj)
#pragma unroll
                    for (int n = 0; n < 2; ++n) v[bj][n] = acc[ai][bj][m][n];
                if (cls != 0) {
                    float s0 = 0.f, s1 = 0.f;
#pragma unroll
                    for (int n = 0; n < 2; ++n)
#pragma unroll
                        for (int e = 0; e < 4; ++e) { s0 += v[0][n][e] * v[0][n][e]; s1 += v[1][n][e] * v[1][n][e]; }
                    if (cls != 3) { s0 += s1; s0 += xsh(s0, 16, lane); s0 += xsh(s0, 32, lane); s0 = s0 * (1.f / 64.f); s1 = s0; }
                    else { s0 += xsh(s0, 16, lane); s0 += xsh(s0, 32, lane); s1 += xsh(s1, 16, lane); s1 += xsh(s1, 32, lane); s0 *= (1.f / 32.f); s1 *= (1.f / 32.f); }
                    const float r0 = 1.f / sqrtf(s0 + 1e-6f), r1 = 1.f / sqrtf(s1 + 1e-6f);
#pragma unroll
                    for (int n = 0; n < 2; ++n) { v[0][n] = v[0][n] * r0 * gv[0][n]; v[1][n] = v[1][n] * r1 * gv[1][n]; }
                    if (lat && cls == 2) {
                        const int t = row & 8191;
#pragma unroll
                        for (int bj = 0; bj < 2; ++bj) { const int pos = bj == 0 ? (t >> 6) : (t & 63); const float sgn = fq < 2 ? -1.f : 1.f;
#pragma unroll
                            for (int n = 0; n < 2; ++n) { const float* cs = gate + pos * 16 + 8 * (fq & 1) + 4 * n; const f32x4 c = *(const f32x4*)cs, sn = *(const f32x4*)(cs + 2048);
                                f32x4 p;
#pragma unroll
                                for (int e = 0; e < 4; ++e) p[e] = xsh(v[bj][n][e], 32, lane);
                                v[bj][n] = v[bj][n] * c + (p * sgn) * sn; } }
                    }
                    if (lat && cls == 3) {
                        const int t = row & 8191; const int pos = fq < 2 ? (t >> 6) : (t & 63); const float sgn = (fq & 1) ? 1.f : -1.f;
#pragma unroll
                        for (int bj = 0; bj < 2; ++bj)
#pragma unroll
                            for (int n = 0; n < 2; ++n) { const float* cs = gate + 4096 + pos * 8 + 4 * n; const f32x4 c = *(const f32x4*)cs, sn = *(const f32x4*)(cs + 1024);
                                f32x4 p;
#pragma unroll
                                for (int e = 0; e < 4; ++e) p[e] = xsh(v[bj][n][e], 16, lane);
                                v[bj][n] = v[bj][n] * c + (p * sgn) * sn; }
                    }
                    if (qs != 1.f) {
#pragma unroll
                        for (int bj = 0; bj < 2; ++bj)
#pragma unroll
                            for (int n = 0; n < 2; ++n) v[bj][n] = v[bj][n] * qs; }
                }
                if (f8) {
                    unsigned char* rowb = (unsigned char*)O + (size_t)row * ldc * 2 + 64 * H + 8 * fq;
#pragma unroll
                    for (int bj = 0; bj < 2; ++bj) { int w0 = 0, w1 = 0;
                        w0 = __builtin_amdgcn_cvt_pk_fp8_f32(v[bj][0][0], v[bj][0][1], w0, false); w0 = __builtin_amdgcn_cvt_pk_fp8_f32(v[bj][0][2], v[bj][0][3], w0, true);
                        w1 = __builtin_amdgcn_cvt_pk_fp8_f32(v[bj][1][0], v[bj][1][1], w1, false); w1 = __builtin_amdgcn_cvt_pk_fp8_f32(v[bj][1][2], v[bj][1][3], w1, true);
                        *(u32x2*)(rowb + 32 * bj) = (u32x2){(unsigned)w0, (unsigned)w1}; }
                    continue;
                }
                bf16_t* rowp = O + (size_t)row * ldc + col0;
#pragma unroll
                for (int bj = 0; bj < 2; ++bj) { u32x4 w; w.x = cvt_pk_bf16(v[bj][0][0], v[bj][0][1]); w.y = cvt_pk_bf16(v[bj][0][2], v[bj][0][3]); w.z = cvt_pk_bf16(v[bj][1][0], v[bj][1][1]); w.w = cvt_pk_bf16(v[bj][1][2], v[bj][1][3]);
                    *(u32x4*)(rowp + 32 * bj) = w; }
            }
    }
    __device__ __forceinline__ void operator()(const f32x4 (&acc)[2][2][4][2], const Unit& u, int wr, int wc, int fr, int fq) const {
        asm volatile("" : "+v"(fr), "+v"(fq));
        if (mode == 1) {
            bf16_t* O = (bf16_t*)out;
            const int row0 = u.pm * BM + wr * 64 + fr, col0 = u.pn * BM + wc * 32 + 8 * fq;
#pragma unroll
            for (int ai = 0; ai < 2; ++ai)
#pragma unroll
                for (int m = 0; m < 4; ++m) { bf16_t* rowp = O + (size_t)(row0 + ai * HALF + m * 16) * ldc + col0;
#pragma unroll
                    for (int bj = 0; bj < 2; ++bj) { f32x4 v0 = acc[ai][bj][m][0], v1 = acc[ai][bj][m][1];
                        if (relu2) {
#pragma unroll
                            for (int e = 0; e < 4; ++e) { float a = fmaxf(v0[e], 0.f), b = fmaxf(v1[e], 0.f); v0[e] = a * a; v1[e] = b * b; } }
                        u32x4 w; w.x = cvt_pk_bf16(v0[0], v0[1]); w.y = cvt_pk_bf16(v0[2], v0[3]); w.z = cvt_pk_bf16(v1[0], v1[1]); w.w = cvt_pk_bf16(v1[2], v1[3]);
                        *(u32x4*)(rowp + bj * HALF) = w; } }
            return;
        }
        if (mode == 3) { head_epilogue(acc, u, wr, wc, fr, fq); return; }
        const int t0 = u.pm * BM; const bool split = (u.kinfo >> 16) != 0; const int cond = t0 < 8192 ? 0 : (t0 < 16384 ? 1 : 2);
        const int col0 = u.pn * BM + wc * 32 + 4 * fq; const float* g = gate + cond * 6144 + col0;
        f32x4 gv[2][2];
#pragma unroll
        for (int bj = 0; bj < 2; ++bj)
#pragma unroll
            for (int n = 0; n < 2; ++n) gv[bj][n] = *(const f32x4*)(g + bj * HALF + n * 16);
        if (split) {
            const int ks = (u.kinfo & 255) / ((u.kinfo >> 8) & 255);
            float* op = ctxres + (size_t)ks * (512 * 1024) + (size_t)(t0 - 16384) * 1024;
#pragma unroll
            for (int ai = 0; ai < 2; ++ai)
#pragma unroll
                for (int m = 0; m < 4; ++m) { const size_t off = (size_t)(wr * 64 + fr + ai * HALF + m * 16) * 1024 + col0;
#pragma unroll
                    for (int bj = 0; bj < 2; ++bj)
#pragma unroll
                        for (int n = 0; n < 2; ++n) *(f32x4*)(op + off + bj * HALF + n * 16) = gv[bj][n] * acc[ai][bj][m][n]; }
            return;
        }
        const float* bp = base + (size_t)t0 * 1024; float* op = (float*)out + (size_t)t0 * 1024;
#pragma unroll
        for (int ai = 0; ai < 2; ++ai)
#pragma unroll
            for (int m = 0; m < 4; ++m) { const size_t off = (size_t)(wr * 64 + fr + ai * HALF + m * 16) * 1024 + col0;
#pragma unroll
                for (int bj = 0; bj < 2; ++bj)
#pragma unroll
                    for (int n = 0; n < 2; ++n) { const f32x4 b = *(const f32x4*)(bp + off + bj * HALF + n * 16);
                        *(f32x4*)(op + off + bj * HALF + n * 16) = b + gv[bj][n] * acc[ai][bj][m][n]; } }
    }
};

template <class Epi, class Sched, bool ALIGN_EPI = false, bool SP2 = false>
__device__ __forceinline__ void gemm_phase(PG8_LAS unsigned char* lds, const Gemm g, const Sched& S, const Epi& E, const int tid) {
    const int wid = __builtin_amdgcn_readfirstlane(tid >> 6), lane = tid & 63, wr = wid >> 2, wc = wid & 3, fr = lane & 15, fq = lane >> 4;
    const int K = g.K;
    unsigned voffA[2], voffB[2];
#pragma unroll
    for (int i = 0; i < 2; ++i) { int R, C; stage_rc(tid * 16 + i * 8192, R, C); const int Rb = E.headmode() ? (64 * (R >> 5) + perm32(R & 31)) : (E.perm() ? ((R & ~31) + perm32(R & 31)) : R);
        voffA[i] = (unsigned)(R * K + C) * 2u; voffB[i] = (unsigned)(Rb * K + C) * 2u; }
    const size_t kstep = (size_t)(BK * 2);
    const size_t hstep = (size_t)HALF * K * 2;
    const size_t tstep = 2 * hstep;
    const size_t hstepB = E.headmode() ? (size_t)32 * K * 2 : hstep;
    const unsigned ldsw = (unsigned)wid * 1024u;
    const int aoff = lds_byte(wr * 64 + fr, fq * 8), boff = lds_byte(wc * 32 + fr, fq * 8);
#define PG8_SA(b, h) (((b) * 2 + (h)) * HTB)
#define PG8_SB(b, h) ((4 + (b) * 2 + (h)) * HTB)
#define PG8_STAGE(bufoff, gbase, voff) do { _Pragma("unroll") for (int _i = 0; _i < 2; ++_i) \
        __builtin_amdgcn_global_load_lds((const unsigned*)((const char*)(gbase) + (voff)[_i]), (PG8_LAS unsigned*)(lds + (bufoff) + ldsw + _i * 8192), 16, 0, 0); } while (0)
#define PG8_LDA(dst, b, h) do { _Pragma("unroll") for (int m = 0; m < 4; ++m) _Pragma("unroll") for (int k = 0; k < 2; ++k) dst[m][k] = *(const PG8_LAS bf16x8*)(lds + PG8_SA(b, h) + aoff + m * 2048 + k * 1024); } while (0)
#define PG8_LDB(dst, b, h) do { _Pragma("unroll") for (int n = 0; n < 2; ++n) _Pragma("unroll") for (int k = 0; k < 2; ++k) dst[n][k] = *(const PG8_LAS bf16x8*)(lds + PG8_SB(b, h) + boff + n * 2048 + k * 1024); } while (0)
#define PG8_MMA(ai, bj, At, Bt) do { __builtin_amdgcn_s_setprio(1); _Pragma("unroll") for (int m = 0; m < 4; ++m) _Pragma("unroll") for (int n = 0; n < 2; ++n) _Pragma("unroll") for (int k = 0; k < 2; ++k) \
        acc[ai][bj][m][n] = __builtin_amdgcn_mfma_f32_16x16x32_bf16(Bt[n][k], At[m][k], acc[ai][bj][m][n], 0, 0, 0); __builtin_amdgcn_s_setprio(0); } while (0)
#define PG8_WAIT_V(n) asm volatile("s_waitcnt vmcnt(" #n ")" ::: "memory")
#define PG8_WAIT_L(n) asm volatile("s_waitcnt lgkmcnt(" #n ")" ::: "memory")
#define PG8_BAR __builtin_amdgcn_s_barrier()
#define PG8_SCHED __builtin_amdgcn_sched_barrier(0)
    Unit cur, nxt; int ui = 0;
    if (!S.next(0, cur)) return;
    f32x4 acc[2][2][4][2];
#pragma unroll
    for (int a = 0; a < 2; ++a)
#pragma unroll
        for (int b = 0; b < 2; ++b)
#pragma unroll
            for (int m = 0; m < 4; ++m)
#pragma unroll
                for (int n = 0; n < 2; ++n) acc[a][b][m][n] = (f32x4){0.f, 0.f, 0.f, 0.f};
    bf16x8 At[4][2], B0[2][2], B1[2][2];
    const char* cA = (const char*)g.A + (size_t)cur.pm * tstep + (size_t)(cur.kinfo & 255) * (BK * 2); const char* cB = (const char*)g.Bt + (size_t)cur.pn * tstep + (size_t)(cur.kinfo & 255) * (BK * 2);
    S.a_ready(cur);
    if constexpr (SP2) {
        PG8_STAGE(PG8_SB(0, 0), cB, voffB); PG8_STAGE(PG8_SB(0, 1), cB + hstepB, voffB); PG8_STAGE(PG8_SA(0, 0), cA, voffA); PG8_STAGE(PG8_SA(0, 1), cA + hstep, voffA);
        if (wr == 1) PG8_BAR;
        PG8_WAIT_V(2); PG8_BAR;
        PG8_STAGE(PG8_SB(1, 0), cB + kstep, voffB); PG8_STAGE(PG8_SA(1, 0), cA + kstep, voffA); PG8_STAGE(PG8_SB(1, 1), cB + hstepB + kstep, voffB);
        PG8_WAIT_V(6); PG8_BAR;
    } else {
        PG8_STAGE(PG8_SB(0, 0), cB, voffB); PG8_STAGE(PG8_SA(0, 0), cA, voffA); PG8_STAGE(PG8_SB(0, 1), cB + hstepB, voffB); PG8_STAGE(PG8_SA(0, 1), cA + hstep, voffA);
        if (wr == 1) PG8_BAR;
        PG8_WAIT_V(4); PG8_BAR;
        PG8_STAGE(PG8_SB(1, 0), cB + kstep, voffB); PG8_STAGE(PG8_SA(1, 0), cA + kstep, voffA); PG8_STAGE(PG8_SB(1, 1), cB + hstepB + kstep, voffB);
        PG8_WAIT_V(6); PG8_BAR;
    }
    for (;;) {
        const bool has_next = S.next(ui + 1, nxt);
        const char* nA = has_next ? (const char*)g.A + (size_t)nxt.pm * tstep + (size_t)(nxt.kinfo & 255) * (BK * 2) : cA; const char* nB = has_next ? (const char*)g.Bt + (size_t)nxt.pn * tstep + (size_t)(nxt.kinfo & 255) * (BK * 2) : cB;
        const int nt = (cur.kinfo >> 8) & 255;
        for (int t = 0; t < nt; t += 2) {
            const bool last = (t == nt - 2);
            const char* a1 = cA + (size_t)(t + 1) * kstep;
            const char* a2 = last ? nA : cA + (size_t)(t + 2) * kstep; const char* b2 = last ? nB : cB + (size_t)(t + 2) * kstep;
            const char* a3 = a2 + kstep; const char* b3 = b2 + kstep;
            if (last && has_next) S.a_ready(nxt);
            if constexpr (SP2) {
            PG8_LDB(B0, 0, 0); PG8_LDB(B1, 0, 1); PG8_SCHED; PG8_LDA(At, 0, 0); PG8_STAGE(PG8_SA(1, 1), a1 + hstep, voffA);
            PG8_WAIT_V(8); PG8_WAIT_L(0); PG8_BAR; PG8_MMA(0, 0, At, B0); PG8_MMA(0, 1, At, B1); PG8_BAR; PG8_SCHED;
            PG8_LDA(At, 0, 1); PG8_STAGE(PG8_SB(0, 0), b2, voffB); PG8_STAGE(PG8_SB(0, 1), b2 + hstepB, voffB); PG8_STAGE(PG8_SA(0, 0), a2, voffA);
            PG8_WAIT_V(8); PG8_WAIT_L(0); PG8_BAR; PG8_MMA(1, 0, At, B0); PG8_MMA(1, 1, At, B1); PG8_BAR; PG8_SCHED;
            PG8_LDB(B0, 1, 0); PG8_LDB(B1, 1, 1); PG8_SCHED; PG8_LDA(At, 1, 0); PG8_STAGE(PG8_SA(0, 1), a2 + hstep, voffA);
            PG8_WAIT_V(8); PG8_WAIT_L(0); PG8_BAR; PG8_MMA(0, 0, At, B0); PG8_MMA(0, 1, At, B1); PG8_BAR; PG8_SCHED;
            PG8_LDA(At, 1, 1); PG8_STAGE(PG8_SB(1, 0), b3, voffB); PG8_STAGE(PG8_SB(1, 1), b3 + hstepB, voffB); PG8_STAGE(PG8_SA(1, 0), a3, voffA);
            PG8_WAIT_V(8); PG8_WAIT_L(0); PG8_BAR; PG8_MMA(1, 0, At, B0); PG8_MMA(1, 1, At, B1); PG8_BAR; PG8_SCHED;
            } else {
            PG8_LDB(B0, 0, 0); PG8_SCHED; PG8_LDA(At, 0, 0); PG8_STAGE(PG8_SA(1, 1), a1 + hstep, voffA);
            PG8_WAIT_L(8); PG8_BAR; PG8_WAIT_L(0); PG8_MMA(0, 0, At, B0); PG8_BAR; PG8_SCHED;
            PG8_LDB(B1, 0, 1); PG8_STAGE(PG8_SB(0, 0), b2, voffB);
            PG8_BAR; PG8_WAIT_L(0); PG8_MMA(0, 1, At, B1); PG8_BAR;
            PG8_LDA(At, 0, 1); PG8_STAGE(PG8_SA(0, 0), a2, voffA);
            PG8_BAR; PG8_WAIT_L(0); PG8_MMA(1, 0, At, B0); PG8_BAR; PG8_SCHED;
            PG8_STAGE(PG8_SB(0, 1), b2 + hstepB, voffB);
            PG8_WAIT_V(6); PG8_BAR; PG8_MMA(1, 1, At, B1); PG8_BAR;
            PG8_LDB(B0, 1, 0); PG8_SCHED; PG8_LDA(At, 1, 0); PG8_STAGE(PG8_SA(0, 1), a2 + hstep, voffA);
            PG8_WAIT_L(8); PG8_BAR; PG8_WAIT_L(0); PG8_MMA(0, 0, At, B0); PG8_BAR; PG8_SCHED;
            PG8_LDB(B1, 1, 1); PG8_STAGE(PG8_SB(1, 0), b3, voffB);
            PG8_BAR; PG8_WAIT_L(0); PG8_MMA(0, 1, At, B1); PG8_BAR;
            PG8_LDA(At, 1, 1); PG8_STAGE(PG8_SA(1, 0), a3, voffA);
            PG8_BAR; PG8_WAIT_L(0); PG8_MMA(1, 0, At, B0); PG8_BAR; PG8_SCHED;
            PG8_STAGE(PG8_SB(1, 1), b3 + hstepB, voffB);
            PG8_WAIT_V(6); PG8_BAR; PG8_MMA(1, 1, At, B1); PG8_BAR;
            }
        }
        if constexpr (ALIGN_EPI) { if (wr == 0) PG8_BAR; }
        if constexpr (!Epi::AFTER_DRAIN) { E(acc, cur, wr, wc, fr, fq); S.done(cur); }
        if (!has_next) break;
#pragma unroll
        for (int a = 0; a < 2; ++a)
#pragma unroll
            for (int b = 0; b < 2; ++b)
#pragma unroll
                for (int m = 0; m < 4; ++m)
#pragma unroll
                    for (int n = 0; n < 2; ++n) acc[a][b][m][n] = (f32x4){0.f, 0.f, 0.f, 0.f};
        cur = nxt; cA = nA; cB = nB; ++ui;
        if constexpr (ALIGN_EPI) { if (wr == 1) PG8_BAR; }
    }
    PG8_WAIT_V(0);
    if constexpr (!ALIGN_EPI) { if (wr == 0) PG8_BAR; }
    PG8_BAR;
    if constexpr (Epi::AFTER_DRAIN) { E.fused(acc, cur, wr, wc, fr, fq, lds, wid, lane); S.done(cur); }
#undef PG8_SA
#undef PG8_SB
#undef PG8_STAGE
#undef PG8_LDA
#undef PG8_LDB
#undef PG8_MMA
#undef PG8_WAIT_V
#undef PG8_WAIT_L
#undef PG8_BAR
#undef PG8_SCHED
}
}
namespace att {
#define ATT_LAS __attribute__((address_space(3)))
typedef unsigned short bf16;
typedef short bf16x8 __attribute__((ext_vector_type(8)));
typedef short s16x4 __attribute__((ext_vector_type(4)));
typedef float f32x16 __attribute__((ext_vector_type(16)));
typedef unsigned u32x4 __attribute__((ext_vector_type(4)));
typedef ATT_LAS char lchar;
constexpr int KBUF = 12288, VBUF = 16384;
constexpr int L_K = 0, L_V = 2 * KBUF, L_WS = L_V + 2 * VBUF, L_RPB = L_WS + 2048, L_END = L_RPB + 2048;
constexpr float LOG2E = 1.4426950408889634f;
#define ATT_SBAR() __builtin_amdgcn_sched_barrier(0)
__device__ __forceinline__ int crow(int r, int hi) { return (r & 3) + 8 * (r >> 2) + 4 * hi; }
__device__ __forceinline__ unsigned cvtpk(float lo, float hi) { unsigned r; asm volatile("v_cvt_pk_bf16_f32 %0, %1, %2" : "=v"(r) : "v"(lo), "v"(hi)); return r; }
__device__ __forceinline__ int v_st(int k, int c) { const int kk = (k & ~0xC) | ((k & 4) << 1) | ((k & 8) >> 1); return ((kk >> 3) * 4 + (c >> 5)) * 512 + ((kk & 7) * 32 + (c & 31)) * 2; }
__device__ __forceinline__ int v_rd_base(int lane) { return ((lane & 3) << 3) | (((lane >> 2) & 3) << 6) | (((lane >> 4) & 1) << 5) | (((lane >> 5) & 1) << 8); }
constexpr int v_rd_off(int d0, int ks, int half) { return d0 * 512 + ks * 4096 + half * 2048; }
template <int OFF> __device__ __forceinline__ s16x4 tr_read(unsigned vb) {
  s16x4 r; asm volatile("ds_read_b64_tr_b16 %0, %1 offset:%2" : "=&v"(r) : "v"(vb), "i"(OFF) : "memory"); return r;
}
template <int D0> __device__ __forceinline__ void pv_one(f32x16& od, unsigned vb, bf16x8 pa0, bf16x8 pa1, bf16x8 pa2, bf16x8 pa3) {
  const s16x4 l0 = tr_read<v_rd_off(D0, 0, 0)>(vb), h0 = tr_read<v_rd_off(D0, 0, 1)>(vb), l1 = tr_read<v_rd_off(D0, 1, 0)>(vb), h1 = tr_read<v_rd_off(D0, 1, 1)>(vb);
  const s16x4 l2 = tr_read<v_rd_off(D0, 2, 0)>(vb), h2 = tr_read<v_rd_off(D0, 2, 1)>(vb), l3 = tr_read<v_rd_off(D0, 3, 0)>(vb), h3 = tr_read<v_rd_off(D0, 3, 1)>(vb);
  asm volatile("s_waitcnt lgkmcnt(0)" ::: "memory"); ATT_SBAR();
#define ATT_PK(L, H) (bf16x8){L[0], L[1], L[2], L[3], H[0], H[1], H[2], H[3]}
  od = __builtin_amdgcn_mfma_f32_32x32x16_bf16(pa0, ATT_PK(l0, h0), od, 0, 0, 0);
  od = __builtin_amdgcn_mfma_f32_32x32x16_bf16(pa1, ATT_PK(l1, h1), od, 0, 0, 0);
  od = __builtin_amdgcn_mfma_f32_32x32x16_bf16(pa2, ATT_PK(l2, h2), od, 0, 0, 0);
  od = __builtin_amdgcn_mfma_f32_32x32x16_bf16(pa3, ATT_PK(l3, h3), od, 0, 0, 0);
#undef ATT_PK
}

template <int DKC, class U>
__device__ __forceinline__ void unit(const U& u, lchar* lds, int tid) {
  asm volatile("" : "+v"(tid));
  const int lane = tid & 63, r32 = lane & 31, hi = lane >> 5;
  const int wid = __builtin_amdgcn_readfirstlane(tid >> 6);
  lchar* Kl = lds + L_K; lchar* Vl = lds + L_V;
  ATT_LAS float* ws = (ATT_LAS float*)(lds + L_WS) + wid * 64;
  bf16x8 qr[DKC / 2];
#pragma unroll
  for (int d0 = 0; d0 < DKC / 2; ++d0) qr[d0] = *(const bf16x8*)u.qptr(wid, r32, d0, hi);
  const int vrow = tid >> 3, vch = tid & 7, vst = v_st(vrow, vch * 8);
  const int krow0 = tid & 63, kch0 = tid >> 6;
  const bool k2 = (DKC > 8) && (tid < 64 * (DKC - 8));
  const unsigned vb0 = (unsigned)(uintptr_t)Vl + (unsigned)v_rd_base(lane);
  bf16x8 kst0, kst1 = {}, vstr;
  const int NT = u.nt();
#define ATT_SLOAD(t) do { const long R_ = u.krow(t); kst0 = *(const bf16x8*)u.kptr(R_ + krow0, kch0); if (k2) kst1 = *(const bf16x8*)u.kptr(R_ + krow0, 8 + kch0); \
    vstr = *(const bf16x8*)u.vptr(R_ + vrow, vch); } while (0)
#define ATT_SWRITE(b) do { *(ATT_LAS bf16x8*)(Kl + (b) * KBUF + kch0 * 1024 + krow0 * 16) = kst0; if (k2) *(ATT_LAS bf16x8*)(Kl + (b) * KBUF + (8 + kch0) * 1024 + krow0 * 16) = kst1; \
    *(ATT_LAS bf16x8*)(Vl + (b) * VBUF + vst) = vstr; } while (0)
  float m_reg = -1e30f, l_reg = 0.f; f32x16 o[2]; o[0] = f32x16{}; o[1] = f32x16{};
  ATT_SLOAD(0); ATT_SWRITE(0); __syncthreads();
  for (int t = 0; t < NT; ++t) {
    const int buf = t & 1;
    if (t + 1 < NT) ATT_SLOAD(t + 1);
    if (!u.skip(t, wid)) {
      f32x16 p0 = f32x16{}, p1 = f32x16{};
      { const lchar* kb = Kl + buf * KBUF + hi * 1024 + r32 * 16;
#pragma unroll
        for (int d0 = 0; d0 < DKC / 2; ++d0) {
          const bf16x8 b0 = *(const ATT_LAS bf16x8*)(kb + d0 * 2048);
          const bf16x8 b1 = *(const ATT_LAS bf16x8*)(kb + d0 * 2048 + 512);
          p0 = __builtin_amdgcn_mfma_f32_32x32x16_bf16(b0, qr[d0], p0, 0, 0, 0);
          p1 = __builtin_amdgcn_mfma_f32_32x32x16_bf16(b1, qr[d0], p1, 0, 0, 0); } }
      u.mask(p0, p1, t, wid, r32, hi);
      float pmax = p0[0];
#pragma unroll
      for (int r = 1; r < 16; ++r) pmax = fmaxf(pmax, p0[r]);
#pragma unroll
      for (int r = 0; r < 16; ++r) pmax = fmaxf(pmax, p1[r]);
      { auto rr = __builtin_amdgcn_permlane32_swap(__float_as_uint(pmax), __float_as_uint(pmax), false, false);
        pmax = fmaxf(__uint_as_float(rr[0]), __uint_as_float(rr[1])); }
      const float mn = fmaxf(m_reg, pmax);
      const float alpha = __builtin_amdgcn_exp2f(m_reg - mn);
      m_reg = mn;
#pragma unroll
      for (int r = 0; r < 16; ++r) { p0[r] = __builtin_amdgcn_exp2f(p0[r] - mn); p1[r] = __builtin_amdgcn_exp2f(p1[r] - mn); }
      float ps = 0.f;
#pragma unroll
      for (int r = 0; r < 16; ++r) ps += p0[r];
#pragma unroll
      for (int r = 0; r < 16; ++r) ps += p1[r];
      { auto rr = __builtin_amdgcn_permlane32_swap(__float_as_uint(ps), __float_as_uint(ps), false, false);
        ps = __uint_as_float(rr[0]) + __uint_as_float(rr[1]); }
      l_reg = l_reg * alpha + ps;
      if (__any(alpha < 1.f)) {
        if (hi == 0) ws[r32] = alpha;
        asm volatile("s_waitcnt lgkmcnt(0)" ::: "memory");
#pragma unroll
        for (int r = 0; r < 16; ++r) { const float a = ws[crow(r, hi)]; o[0][r] *= a; o[1][r] *= a; }
      }
      bf16x8 pa0, pa1, pa2, pa3;
#define ATT_PK4(P, BASE, OUT) do { unsigned a0 = cvtpk(P[BASE + 0], P[BASE + 1]), a1 = cvtpk(P[BASE + 2], P[BASE + 3]);   \
    unsigned b0 = cvtpk(P[BASE + 4], P[BASE + 5]), b1 = cvtpk(P[BASE + 6], P[BASE + 7]);                              \
    auto r0 = __builtin_amdgcn_permlane32_swap(a0, b0, false, false); auto r1 = __builtin_amdgcn_permlane32_swap(a1, b1, false, false); \
    u32x4 w = {r0[0], r1[0], r0[1], r1[1]}; OUT = __builtin_bit_cast(bf16x8, w); } while (0)
      ATT_PK4(p0, 0, pa0); ATT_PK4(p0, 8, pa1); ATT_PK4(p1, 0, pa2); ATT_PK4(p1, 8, pa3);
#undef ATT_PK4
      const unsigned vb = vb0 + (unsigned)(buf * VBUF);
      pv_one<0>(o[0], vb, pa0, pa1, pa2, pa3); pv_one<1>(o[1], vb, pa0, pa1, pa2, pa3);
    }
    if (t + 1 < NT) ATT_SWRITE(buf ^ 1);
    __syncthreads();
  }
#undef ATT_SLOAD
#undef ATT_SWRITE
  { const float sk = u.sink(wid); l_reg += __builtin_amdgcn_exp2f(sk - m_reg); }
  if (hi == 0) ws[r32] = l_reg;
  asm volatile("s_waitcnt lgkmcnt(0)" ::: "memory");
  float rli[16];
#pragma unroll
  for (int r = 0; r < 16; ++r) rli[r] = __builtin_amdgcn_rcpf(ws[crow(r, hi)]);
#pragma unroll
  for (int r = 0; r < 16; ++r) { bf16* op = u.orow(wid, crow(r, hi));
    op[r32] = (bf16)(cvtpk(o[0][r] * rli[r], 0.f) & 0xffffu); op[32 + r32] = (bf16)(cvtpk(o[1][r] * rli[r], 0.f) & 0xffffu); }
  asm volatile("s_waitcnt lgkmcnt(0)" ::: "memory");
}

constexpr int ROWS_LAT = 16384;
struct UWin {
  const bf16* QKV; bf16* O; const float* sinkp; int b, n, g, hh; int i0, cnt;
  __device__ __forceinline__ void init() { i0 = (n == 0) ? 2 : 0; cnt = (n == 0 || n == 63) ? 4 : 6; }
  __device__ __forceinline__ int nt() const { return 4 + cnt; }
  __device__ __forceinline__ int kpos0(int t) const { return 128 * (n - 1) + 64 * (i0 + t - 4); }
  __device__ __forceinline__ long krow(int t) const { return t < 4 ? (long)(ROWS_LAT + 256 * b + 64 * t) : (long)(8192 * b + kpos0(t)); }
  __device__ __forceinline__ const bf16* kptr(long row, int ch) const { return QKV + row * 2304 + 512 + 64 * g + ch * 8; }
  __device__ __forceinline__ const bf16* vptr(long row, int ch) const { return QKV + row * 2304 + 640 + 64 * g + ch * 8; }
  __device__ __forceinline__ int head(int wid) const { return 4 * g + 2 * hh + (wid >> 2); }
  __device__ __forceinline__ int qpos0(int wid) const { return 128 * n + 32 * (wid & 3); }
  __device__ __forceinline__ const bf16* qptr(int wid, int r32, int d0, int hi) const { return QKV + (long)(8192 * b + qpos0(wid) + r32) * 2304 + 64 * head(wid) + 16 * d0 + 8 * hi; }
  __device__ __forceinline__ bool skip(int t, int wid) const { if (t < 4) return false; const int k0 = kpos0(t), q0 = qpos0(wid); return (k0 + 63 < q0 - 128) || (k0 > q0 + 31 + 128); }
  __device__ __forceinline__ void mask(f32x16& p0, f32x16& p1, int t, int wid, int r32, int hi) const {
    if (t < 4) return;
    const int dq = kpos0(t) - (qpos0(wid) + r32);
#pragma unroll
    for (int r = 0; r < 16; ++r) { const int d = dq + crow(r, hi); if (d > 128 || d < -128) p0[r] = -INFINITY; if (d + 32 > 128 || d + 32 < -128) p1[r] = -INFINITY; }
  }
  __device__ __forceinline__ float sink(int wid) const { return sinkp[head(wid)] * LOG2E; }
  __device__ __forceinline__ bf16* orow(int wid, int row) const { return O + (long)(8192 * b + qpos0(wid) + row) * 1024 + 64 * head(wid); }
};
struct UNa {
  const bf16* QKV; bf16* O; const ATT_LAS float* rpbl; int b, h, R4; int krlo, nloc;
  __device__ __forceinline__ static int clampi(int v, int lo, int hi_) { return v < lo ? lo : (v > hi_ ? hi_ : v); }
  __device__ __forceinline__ void init() { krlo = clampi(4 * R4 - 4, 0, 120); const int krhi = clampi(4 * R4 - 1, 0, 120) + 7; nloc = krhi - krlo + 1; }
  __device__ __forceinline__ int nt() const { return 4 + nloc; }
  __device__ __forceinline__ long krow(int t) const { return t < 4 ? (long)(ROWS_LAT + 256 * b + 64 * t) : (long)(8192 * b + 64 * (krlo + t - 4)); }
  __device__ __forceinline__ const bf16* kptr(long row, int ch) const { return QKV + row * 2304 + 1280 + 64 * h + ch * 8; }
  __device__ __forceinline__ const bf16* vptr(long row, int ch) const { return QKV + row * 2304 + 1792 + 64 * h + ch * 8; }
  __device__ __forceinline__ int qrow(int wid) const { return 4 * R4 + (wid >> 1); }
  __device__ __forceinline__ const bf16* qptr(int wid, int r32, int d0, int hi) const { return QKV + (long)(8192 * b + 64 * qrow(wid) + 32 * (wid & 1) + r32) * 2304 + 768 + 64 * h + 16 * d0 + 8 * hi; }
  __device__ __forceinline__ bool skip(int t, int wid) const { if (t < 4) return false; const int kr = krlo + t - 4, w0 = clampi(qrow(wid) - 4, 0, 120); return kr < w0 || kr > w0 + 7; }
  __device__ __forceinline__ void mask(f32x16& p0, f32x16& p1, int t, int wid, int r32, int hi) const {
    if (t < 4) return;
    const int kr = krlo + t - 4, qc = 32 * (wid & 1) + r32, c0 = clampi(qc - 8, 0, 48);
    const ATT_LAS float* brow = rpbl + (kr - qrow(wid) + 7) * 31 + 15;
#pragma unroll
    for (int r = 0; r < 16; ++r) {
      { const int kc = crow(r, hi); const bool ok = kc >= c0 && kc < c0 + 16; const float bv = brow[clampi(kc - qc, -15, 15)]; p0[r] = ok ? p0[r] + bv : -INFINITY; }
      { const int kc = 32 + crow(r, hi); const bool ok = kc >= c0 && kc < c0 + 16; const float bv = brow[clampi(kc - qc, -15, 15)]; p1[r] = ok ? p1[r] + bv : -INFINITY; } }
  }
  __device__ __forceinline__ float sink(int) const { return -INFINITY; }
  __device__ __forceinline__ bf16* orow(int wid, int row) const { return O + (long)(8192 * b + 64 * qrow(wid) + 32 * (wid & 1) + row) * 1024 + 512 + 64 * h; }
};
struct UCtx {
  const bf16* QKV; bf16* O; const float* sinkp; int b, hx; int qcol, kcol, vcol, ocol;
  __device__ __forceinline__ void init() { if (hx < 8) { qcol = 64 * hx; kcol = 512 + 64 * (hx >> 2); vcol = 640 + 64 * (hx >> 2); ocol = 64 * hx; }
    else { const int h = hx - 8; qcol = 768 + 64 * h; kcol = 1280 + 64 * h; vcol = 1792 + 64 * h; ocol = 512 + 64 * h; } }
  __device__ __forceinline__ int nt() const { return 4; }
  __device__ __forceinline__ long krow(int t) const { return (long)(ROWS_LAT + 256 * b + 64 * t); }
  __device__ __forceinline__ const bf16* kptr(long row, int ch) const { return QKV + row * 2304 + kcol + ch * 8; }
  __device__ __forceinline__ const bf16* vptr(long row, int ch) const { return QKV + row * 2304 + vcol + ch * 8; }
  __device__ __forceinline__ const bf16* qptr(int wid, int r32, int d0, int hi) const { return QKV + (long)(ROWS_LAT + 256 * b + 32 * wid + r32) * 2304 + qcol + 16 * d0 + 8 * hi; }
  __device__ __forceinline__ bool skip(int, int) const { return false; }
  __device__ __forceinline__ void mask(f32x16&, f32x16&, int, int, int, int) const {}
  __device__ __forceinline__ float sink(int) const { return hx < 8 ? sinkp[hx] * LOG2E : -INFINITY; }
  __device__ __forceinline__ bf16* orow(int wid, int row) const { return O + (long)(ROWS_LAT + 256 * b + 32 * wid + row) * 1024 + ocol; }
};
struct UDense {
  const bf16* Q; const bf16* KV; const bf16* KR; bf16* O; int b, h, qb;
  __device__ __forceinline__ int nt() const { return 132; }
  __device__ __forceinline__ long krow(int t) const { return t < 4 ? (long)(ROWS_LAT + 256 * b + 64 * t) : (long)(8192 * b + 64 * (t - 4)); }
  __device__ __forceinline__ const bf16* kptr(long row, int ch) const { return ch < 8 ? KV + row * 2048 + 64 * h + ch * 8 : KR + row * 32 + (ch - 8) * 8; }
  __device__ __forceinline__ const bf16* vptr(long row, int ch) const { return KV + row * 2048 + 1024 + 64 * h + ch * 8; }
  __device__ __forceinline__ const bf16* qptr(int wid, int r32, int d0, int hi) const { const bf16* qp = Q + (long)(8192 * b + 256 * qb + 32 * wid + r32) * 1536;
    return d0 < 4 ? qp + 64 * h + 16 * d0 + 8 * hi : qp + 1024 + 32 * h + 16 * (d0 - 4) + 8 * hi; }
  __device__ __forceinline__ bool skip(int, int) const { return false; }
  __device__ __forceinline__ void mask(f32x16&, f32x16&, int, int, int, int) const {}
  __device__ __forceinline__ float sink(int) const { return -INFINITY; }
  __device__ __forceinline__ bf16* orow(int wid, int row) const { return O + (long)(8192 * b + 256 * qb + 32 * wid + row) * 1024 + 64 * h; }
};
#undef ATT_SBAR
}
namespace attd {
typedef unsigned short bf16;
using bf16x8 = __attribute__((ext_vector_type(8))) short;
using s16x4 = __attribute__((ext_vector_type(4))) short;
using f32x16 = __attribute__((ext_vector_type(16))) float;
using u32x4 = __attribute__((ext_vector_type(4))) unsigned;
using i32x4 = __attribute__((ext_vector_type(4))) int;
using i32x8 = __attribute__((ext_vector_type(8))) int;
constexpr int NW = 8, NT = 132, KSLOT = 8192, VSLOT = 8192;
constexpr int LDS_K = 0, LDS_V = 3 * KSLOT, LDS_WS = LDS_V + 3 * VSLOT, LDS_OST = LDS_WS + NW * 64 * 4, LDS_BYTES = LDS_OST + NW * 4096;
__device__ __forceinline__ int crow(int r, int hi) { return (r & 3) + 8 * (r >> 2) + 4 * hi; }
#define AF_SBAR() __builtin_amdgcn_sched_barrier(0)
__device__ __forceinline__ void glds16(unsigned voff, const void* sbase, unsigned lds_dst) { unsigned keep;
  asm volatile("s_mov_b32 %0, m0\n\ts_mov_b32 m0, %3\n\ts_nop 0\n\tglobal_load_lds_dwordx4 %1, %2\n\ts_mov_b32 m0, %0" : "=&s"(keep) : "v"(voff), "s"(sbase), "s"(lds_dst) : "memory"); }
typedef float f32x2_t __attribute__((ext_vector_type(2))); typedef __bf16 bf16x2_t __attribute__((ext_vector_type(2)));
__device__ __forceinline__ unsigned cvtpk_s(float lo, float hi) { f32x2_t v = {lo, hi}; bf16x2_t b = __builtin_convertvector(v, bf16x2_t); return __builtin_bit_cast(unsigned, b); }
#define AF_WAIT_BAR(N) asm volatile("s_waitcnt vmcnt(" #N ") lgkmcnt(0)\n\ts_barrier" ::: "memory")
typedef __attribute__((address_space(3))) const char* lds_cptr;
typedef short v4i16_t __attribute__((ext_vector_type(4)));
__device__ __forceinline__ bf16x8 ldk(lds_cptr p) { return *(const __attribute__((address_space(3))) bf16x8*)p; }
__device__ __forceinline__ i32x8 ldn(lds_cptr p) { const i32x4 a = *(const __attribute__((address_space(3))) i32x4*)p, b = *(const __attribute__((address_space(3))) i32x4*)(p + 1024); return __builtin_shufflevector(a, b, 0, 1, 2, 3, 4, 5, 6, 7); }
__device__ __forceinline__ s16x4 vtr(lds_cptr p) { return __builtin_bit_cast(s16x4, __builtin_amdgcn_ds_read_tr16_b64_v4i16((__attribute__((address_space(3))) v4i16_t*)p)); }
__device__ __forceinline__ long tile_row(int b, int t) { return t < 4 ? (long)(16384 + 256 * b + 64 * t) : (long)(8192 * b + 64 * (t - 4)); }

__device__ __forceinline__ void dense_unit(int b, int h, int qb, const bf16* Q, const bf16* __restrict__ KV, const bf16* __restrict__ KR, bf16* O, char* shm, const int tid) {
  const int lane = tid & 63, r32 = lane & 31, hi = lane >> 5; const int wid = __builtin_amdgcn_readfirstlane(tid >> 6);
  const unsigned lds0 = (unsigned)(uintptr_t)shm;
  float* wsf = (float*)(shm + LDS_WS) + wid * 64;
  const bool wn = wid < 4; const int rc = wid & 3;
  const unsigned voffK = wn ? (unsigned)(lane * 4096 + 16 * wid) : (unsigned)(lane * 64 + 16 * rc);
  const char* sK = wn ? (const char*)KV + 64 * h : (const char*)KR; const long krow = wn ? 4096 : 64;
  const unsigned voffV = (unsigned)((16 * (wid & 3) + (lane >> 2)) * 2048 + (wid >> 2) * 32 + (lane & 3) * 8) * 2u;
  const char* sV = (const char*)(KV + 1024 + 64 * h);
  const unsigned kdst = lds0 + LDS_K + (wn ? wid * 1024 : 4096 + (2 * (rc & 1) + (rc >> 1)) * 1024), vdst = lds0 + LDS_V + wid * 1024;
#define AF_DMA_K(t, ks) do { const long R_ = tile_row(b, (t)); glds16(voffK, sK + R_ * krow, (unsigned)__builtin_amdgcn_readfirstlane(kdst + (ks))); } while (0)
#define AF_DMA_V(t, vs) do { const long R_ = tile_row(b, (t)); glds16(voffV, sV + R_ * 4096, (unsigned)__builtin_amdgcn_readfirstlane(vdst + (vs))); } while (0)
  const lds_cptr shm3 = (lds_cptr)shm; const lds_cptr kp0 = shm3 + LDS_K + hi * 2048 + r32 * 16;
  const lds_cptr vp0 = shm3 + LDS_V + ((lane >> 4) & 1) * 32 + (lane & 3) * 8 + (4 * hi + ((lane & 15) >> 2)) * 64;
  i32x8 qn; bf16x8 qr0, qr1;
  { const char* qp = (const char*)Q + (long)(8192 * b + 256 * qb + 32 * wid + r32) * 3072;
    const i32x4 a = *reinterpret_cast<const i32x4*>(qp + 64 * h + 32 * hi), c = *reinterpret_cast<const i32x4*>(qp + 64 * h + 32 * hi + 16); qn = __builtin_shufflevector(a, c, 0, 1, 2, 3, 4, 5, 6, 7);
    qr0 = *reinterpret_cast<const bf16x8*>(qp + 2048 + 64 * h + 16 * hi); qr1 = *reinterpret_cast<const bf16x8*>(qp + 2048 + 64 * h + 32 + 16 * hi); }
  AF_DMA_K(0, 0); AF_DMA_V(0, 0); AF_DMA_K(1, KSLOT); AF_DMA_K(2, 2 * KSLOT);
  float l_reg = 0.f; f32x16 o[2]; o[0] = f32x16{}; o[1] = f32x16{};
  f32x16 pA0, pA1, pB0, pB1; i32x8 kn0, kn1; bf16x8 kr0, kr1, kr2, kr3;
  int s_prev = 0, s_cur = 0, s_next = 1;
#define AF_ROT() do { s_prev = s_cur; s_cur = s_next; s_next = (s_next == 2) ? 0 : s_next + 1; } while (0)
#define AF_MF(a, b, c) __builtin_amdgcn_mfma_f32_32x32x16_bf16(a, b, c, 0, 0, 0)
#define AF_MX(a, b, c) __builtin_amdgcn_mfma_scale_f32_32x32x64_f8f6f4(a, b, c, 0, 0, 0, 0x7f7f7f7f, 0, 0x7f7f7f7f)
#define AF_EX(v) __builtin_amdgcn_exp2f(v)
  const f32x16 zero16 = f32x16{};
  AF_WAIT_BAR(3);
  { const i32x8 a0 = ldn(kp0), a1 = ldn(kp0 + 512);
    pA0 = AF_MX(a0, qn, zero16); pA1 = AF_MX(a1, qn, zero16);
    pA0 = AF_MF(ldk(kp0 + 4096), qr0, pA0); pA1 = AF_MF(ldk(kp0 + 4096 + 512), qr0, pA1);
    pA0 = AF_MF(ldk(kp0 + 4096 + 1024), qr1, pA0); pA1 = AF_MF(ldk(kp0 + 4096 + 1024 + 512), qr1, pA1);
#pragma unroll
    for (int r = 0; r < 16; ++r) { pA0[r] = AF_EX(pA0[r]); pA1[r] = AF_EX(pA1[r]); } }
  AF_WAIT_BAR(0);
  AF_DMA_K(3, 0); AF_DMA_V(1, VSLOT);
  AF_ROT();
  { const lds_cptr kq_ = kp0 + s_cur * KSLOT; kn0 = ldn(kq_); kn1 = ldn(kq_ + 512); kr0 = ldk(kq_ + 4096); kr1 = ldk(kq_ + 4096 + 512); kr2 = ldk(kq_ + 4096 + 1024); kr3 = ldk(kq_ + 4096 + 1024 + 512); }
  AF_WAIT_BAR(2);
  s16x4 vlo[8], vhi[8]; u32x4 pw0, pw1, pw2, pw3;
#define AF_PKW(P, B) cvtpk_s(P[B], P[B + 1])
#define AF_PAF(k) __builtin_bit_cast(bf16x8, pw##k)
#define AF_VFR(i) (bf16x8){vlo[i][0], vlo[i][1], vlo[i][2], vlo[i][3], vhi[i][0], vhi[i][1], vhi[i][2], vhi[i][3]}
#define AF_PIN(x) asm volatile("" : "+v"(x))
#define AF_VRD(i) do { vlo[i] = vtr(vp_ + (((i) >> 2) * 4096 + ((i) & 3) * 1024)); vhi[i] = vtr(vp_ + (((i) >> 2) * 4096 + ((i) & 3) * 1024 + 512)); AF_SBAR(); } while (0)
#define AF_GB(MF, X, B) do { MF; X[B] = AF_EX(X[B]); X[B + 1] = AF_EX(X[B + 1]); X[B + 2] = AF_EX(X[B + 2]); X[B + 3] = AF_EX(X[B + 3]); AF_PIN(X); AF_SBAR(); } while (0)
#define AF_KRD(G, j) do { if (G) { const lds_cptr kq_ = kp0 + s_next * KSLOT; \
      if ((j) == 0) kn0 = ldn(kq_); if ((j) == 1) kn1 = ldn(kq_ + 512); \
      if ((j) == 2) { kr0 = ldk(kq_ + 4096); kr1 = ldk(kq_ + 4096 + 512); } if ((j) == 3) { kr2 = ldk(kq_ + 4096 + 1024); kr3 = ldk(kq_ + 4096 + 1024 + 512); } AF_SBAR(); } } while (0)
#define AF_STEP(C0, C1, P0, P1, t, GK, GV, GL) do { AF_SBAR(); \
    const lds_cptr vp_ = vp0 + s_prev * VSLOT; \
    float sacc = (P0[0] + P0[1]); \
    AF_VRD(0); AF_VRD(4); \
    { C0 = AF_MX(kn0, qn, zero16); sacc += P0[2]; sacc += P0[3]; sacc += P0[4]; sacc += P0[5]; sacc += P0[6]; sacc += P0[7]; AF_PIN(sacc); \
      pw0[0] = AF_PKW(P0, 0); pw0[1] = AF_PKW(P0, 2); pw0[2] = AF_PKW(P0, 4); pw0[3] = AF_PKW(P0, 6); AF_PIN(pw0); AF_SBAR(); } \
    AF_VRD(1); AF_VRD(5); \
    { C1 = AF_MX(kn1, qn, zero16); sacc += P0[8]; sacc += P0[9]; sacc += P0[10]; sacc += P0[11]; sacc += P0[12]; sacc += P0[13]; AF_PIN(sacc); \
      pw1[0] = AF_PKW(P0, 8); pw1[1] = AF_PKW(P0, 10); pw1[2] = AF_PKW(P0, 12); pw1[3] = AF_PKW(P0, 14); AF_PIN(pw1); AF_SBAR(); } \
    AF_VRD(2); AF_VRD(6); \
    { C0 = AF_MF(kr0, qr0, C0); sacc += P0[14]; sacc += P0[15]; sacc += P1[0]; sacc += P1[1]; AF_PIN(sacc); pw2[0] = AF_PKW(P1, 0); pw2[1] = AF_PKW(P1, 2); AF_PIN(pw2); AF_SBAR(); } \
    AF_VRD(3); AF_VRD(7); \
    { C1 = AF_MF(kr1, qr0, C1); sacc += P1[2]; sacc += P1[3]; sacc += P1[4]; sacc += P1[5]; AF_PIN(sacc); pw2[2] = AF_PKW(P1, 4); pw2[3] = AF_PKW(P1, 6); AF_PIN(pw2); AF_SBAR(); } \
    { C0 = AF_MF(kr2, qr1, C0); sacc += P1[6]; sacc += P1[7]; sacc += P1[8]; sacc += P1[9]; AF_PIN(sacc); pw3[0] = AF_PKW(P1, 8); pw3[1] = AF_PKW(P1, 10); AF_PIN(pw3); AF_SBAR(); } \
    if (GK) { AF_DMA_K((t) + 3, s_cur * KSLOT); AF_SBAR(); } \
    { C1 = AF_MF(kr3, qr1, C1); sacc += P1[10]; sacc += P1[11]; sacc += P1[12]; sacc += P1[13]; sacc += P1[14]; sacc += P1[15]; AF_PIN(sacc); \
      pw3[2] = AF_PKW(P1, 12); pw3[3] = AF_PKW(P1, 14); AF_PIN(pw3); AF_SBAR(); } \
    if (GV) { AF_DMA_V((t) + 1, s_next * VSLOT); AF_SBAR(); } \
    l_reg += sacc; \
    AF_SBAR(); \
    AF_GB(o[0] = AF_MF(AF_PAF(0), AF_VFR(0), o[0]), C0, 0);  AF_KRD(GL, 0); \
    AF_GB(o[1] = AF_MF(AF_PAF(0), AF_VFR(4), o[1]), C0, 4);  AF_KRD(GL, 1); \
    AF_GB(o[0] = AF_MF(AF_PAF(1), AF_VFR(1), o[0]), C0, 8);  AF_KRD(GL, 2); \
    AF_GB(o[1] = AF_MF(AF_PAF(1), AF_VFR(5), o[1]), C0, 12); AF_KRD(GL, 3); \
    AF_GB(o[0] = AF_MF(AF_PAF(2), AF_VFR(2), o[0]), C1, 0); \
    AF_GB(o[1] = AF_MF(AF_PAF(2), AF_VFR(6), o[1]), C1, 4); \
    AF_GB(o[0] = AF_MF(AF_PAF(3), AF_VFR(3), o[0]), C1, 8); \
    AF_GB(o[1] = AF_MF(AF_PAF(3), AF_VFR(7), o[1]), C1, 12); \
  } while (0)
  int t = 1;
  for (; t + 3 < NT; t += 2) {
    AF_STEP(pB0, pB1, pA0, pA1, t, true, true, true);     AF_WAIT_BAR(2); AF_ROT();
    AF_STEP(pA0, pA1, pB0, pB1, t + 1, true, true, true); AF_WAIT_BAR(2); AF_ROT();
  }
  AF_STEP(pB0, pB1, pA0, pA1, NT - 3, false, true, true);  AF_WAIT_BAR(1); AF_ROT();
  AF_STEP(pA0, pA1, pB0, pB1, NT - 2, false, true, true);  AF_WAIT_BAR(0); AF_ROT();
  AF_STEP(pB0, pB1, pA0, pA1, NT - 1, false, false, false);
  { float sacc = pB0[0] + pB0[1];
#pragma unroll
    for (int r = 2; r < 16; ++r) sacc += pB0[r];
#pragma unroll
    for (int r = 0; r < 16; ++r) sacc += pB1[r];
    l_reg += sacc;
    pw0 = (u32x4){AF_PKW(pB0, 0), AF_PKW(pB0, 2), AF_PKW(pB0, 4), AF_PKW(pB0, 6)}; pw1 = (u32x4){AF_PKW(pB0, 8), AF_PKW(pB0, 10), AF_PKW(pB0, 12), AF_PKW(pB0, 14)};
    pw2 = (u32x4){AF_PKW(pB1, 0), AF_PKW(pB1, 2), AF_PKW(pB1, 4), AF_PKW(pB1, 6)}; pw3 = (u32x4){AF_PKW(pB1, 8), AF_PKW(pB1, 10), AF_PKW(pB1, 12), AF_PKW(pB1, 14)};
    AF_SBAR();
    const lds_cptr vp_ = vp0 + s_cur * VSLOT;
#pragma unroll
    for (int i = 0; i < 8; ++i) { vlo[i] = vtr(vp_ + ((i >> 2) * 4096 + (i & 3) * 1024)); vhi[i] = vtr(vp_ + ((i >> 2) * 4096 + (i & 3) * 1024 + 512)); }
    o[0] = AF_MF(AF_PAF(0), AF_VFR(0), o[0]); o[1] = AF_MF(AF_PAF(0), AF_VFR(4), o[1]);
    o[0] = AF_MF(AF_PAF(1), AF_VFR(1), o[0]); o[1] = AF_MF(AF_PAF(1), AF_VFR(5), o[1]);
    o[0] = AF_MF(AF_PAF(2), AF_VFR(2), o[0]); o[1] = AF_MF(AF_PAF(2), AF_VFR(6), o[1]);
    o[0] = AF_MF(AF_PAF(3), AF_VFR(3), o[0]); o[1] = AF_MF(AF_PAF(3), AF_VFR(7), o[1]); }
  { auto rr = __builtin_amdgcn_permlane32_swap(__float_as_uint(l_reg), __float_as_uint(l_reg), false, false); l_reg = __uint_as_float(rr[0]) + __uint_as_float(rr[1]); }
  if (hi == 0) wsf[32 + r32] = l_reg; asm volatile("s_waitcnt lgkmcnt(0)" ::: "memory");
  float rli[16];
#pragma unroll
  for (int r = 0; r < 16; ++r) rli[r] = __builtin_amdgcn_rcpf(wsf[32 + crow(r, hi)]);
  bf16* Ow = O + (long)(8192 * b + 256 * qb + 32 * wid) * 1024 + 64 * h;
  { bf16* stg = (bf16*)(shm + LDS_OST) + wid * 2048;
#pragma unroll
    for (int r = 0; r < 16; ++r) { const int orow = crow(r, hi);
#pragma unroll
      for (int d0 = 0; d0 < 2; ++d0) stg[orow * 64 + d0 * 32 + r32] = (bf16)(cvtpk_s(o[d0][r] * rli[r], 0.f) & 0xffffu); }
    asm volatile("s_waitcnt lgkmcnt(0)" ::: "memory");
#pragma unroll
    for (int i = 0; i < 4; ++i) { const int row = i * 8 + (lane >> 3), ch = lane & 7; const u32x4 v = *(const u32x4*)(stg + row * 64 + ch * 8); *(u32x4*)(Ow + (long)row * 1024 + ch * 8) = v; } }
  asm volatile("s_waitcnt vmcnt(0) lgkmcnt(0)\n\ts_barrier" ::: "memory");
#undef AF_DMA_K
#undef AF_DMA_V
#undef AF_ROT
#undef AF_PKW
#undef AF_PAF
#undef AF_VFR
#undef AF_PIN
#undef AF_MF
#undef AF_MX
#undef AF_EX
#undef AF_VRD
#undef AF_GB
#undef AF_KRD
#undef AF_STEP
}
#undef AF_SBAR
#undef AF_WAIT_BAR
}
namespace attf {
typedef unsigned short bf16;
using bf16x8 = __attribute__((ext_vector_type(8))) short;
using s16x4 = __attribute__((ext_vector_type(4))) short;
using f32x16 = __attribute__((ext_vector_type(16))) float;
using u32x4 = __attribute__((ext_vector_type(4))) unsigned;
constexpr int NW = 8, KSLOT = 12288, VSLOT = 8192;
constexpr int LDS_K = 0, LDS_V = 3 * KSLOT, LDS_WS = LDS_V + 3 * VSLOT, LDS_OST = LDS_WS + NW * 64 * 4, LDS_RPB = LDS_OST + NW * 4096, LDS_BYTES = LDS_RPB + 2048;
__device__ __forceinline__ int crow(int r, int hi) { return (r & 3) + 8 * (r >> 2) + 4 * hi; }
#define AF_SBAR() __builtin_amdgcn_sched_barrier(0)
__device__ __forceinline__ void glds16(unsigned voff, const void* sbase, unsigned lds_dst) { unsigned keep;
  asm volatile("s_mov_b32 %0, m0\n\ts_mov_b32 m0, %3\n\ts_nop 0\n\tglobal_load_lds_dwordx4 %1, %2\n\ts_mov_b32 m0, %0" : "=&s"(keep) : "v"(voff), "s"(sbase), "s"(lds_dst) : "memory"); }
typedef float f32x2_t __attribute__((ext_vector_type(2))); typedef __bf16 bf16x2_t __attribute__((ext_vector_type(2)));
__device__ __forceinline__ unsigned cvtpk_s(float lo, float hi) { f32x2_t v = {lo, hi}; bf16x2_t b = __builtin_convertvector(v, bf16x2_t); return __builtin_bit_cast(unsigned, b); }
#define AF_WAIT_BAR(N) asm volatile("s_waitcnt vmcnt(" #N ") lgkmcnt(0)\n\ts_barrier" ::: "memory")
typedef __attribute__((address_space(3))) const char* lds_cptr;
typedef short v4i16_t __attribute__((ext_vector_type(4)));
__device__ __forceinline__ void kload2(bf16x8* kf, lds_cptr kp, int j) { kf[2 * j] = *(const __attribute__((address_space(3))) bf16x8*)(kp + j * 2048); kf[2 * j + 1] = *(const __attribute__((address_space(3))) bf16x8*)(kp + j * 2048 + 512); }
__device__ __forceinline__ s16x4 vtr(lds_cptr p) { return __builtin_bit_cast(s16x4, __builtin_amdgcn_ds_read_tr16_b64_v4i16((__attribute__((address_space(3))) v4i16_t*)p)); }

template <int DKC, class U>
__device__ __forceinline__ void fast_unit(const U& u, char* shm, int tid) {
  static_assert(DKC == 8 || DKC == 12, "q/k dim 64 or 96");
  asm volatile("" : "+v"(tid));
  constexpr int ND0 = DKC / 2;
  const int lane = tid & 63, r32 = lane & 31, hi = lane >> 5; const int wid = __builtin_amdgcn_readfirstlane(tid >> 6);
  const unsigned lds0 = (unsigned)(uintptr_t)shm;
  float* wsf = (float*)(shm + LDS_WS) + wid * 64;
  const int NT = u.nt();
  const unsigned voffKA = (unsigned)(lane * u.kpitch + 8 * wid) * 2u;
  const unsigned voffKB = (unsigned)(lane * 32 + 8 * (wid & 3)) * 2u;
  const unsigned voffV = (unsigned)((16 * (wid & 3) + (lane >> 2)) * u.vpitch + (wid >> 2) * 32 + (lane & 3) * 8) * 2u;
  const unsigned kdstA = lds0 + LDS_K + wid * 1024, kdstB = lds0 + LDS_K + (8 + (wid & 3)) * 1024, vdst = lds0 + LDS_V + wid * 1024;
#define AF_DMA_KA(t, ks) do { const long R_ = u.trow(t); glds16(voffKA, (const char*)u.kbase + R_ * (2 * u.kpitch), (unsigned)__builtin_amdgcn_readfirstlane(kdstA + (ks))); } while (0)
#define AF_DMA_KB(t, ks) do { if constexpr (DKC == 12) { const long R_ = u.trow(t); glds16(voffKB, (const char*)u.krbase + R_ * 64, (unsigned)__builtin_amdgcn_readfirstlane(kdstB + (ks))); } } while (0)
#define AF_DMA_K(t, ks) do { AF_DMA_KA(t, ks); AF_DMA_KB(t, ks); } while (0)
#define AF_DMA_V(t, vs) do { const long R_ = u.trow(t); glds16(voffV, (const char*)u.vbase + R_ * (2 * u.vpitch), (unsigned)__builtin_amdgcn_readfirstlane(vdst + (vs))); } while (0)
#define AF_WAITN(NSTEPS_K, NV) do { if constexpr (DKC == 12) { if ((NSTEPS_K) == 2 && (NV) == 1) AF_WAIT_BAR(5); else if ((NSTEPS_K) == 1 && (NV) == 1) AF_WAIT_BAR(3); else if ((NV) == 1) AF_WAIT_BAR(1); else AF_WAIT_BAR(0); } \
    else { if ((NSTEPS_K) == 2 && (NV) == 1) AF_WAIT_BAR(3); else if ((NSTEPS_K) == 1 && (NV) == 1) AF_WAIT_BAR(2); else if ((NV) == 1) AF_WAIT_BAR(1); else AF_WAIT_BAR(0); } } while (0)
  const lds_cptr shm3 = (lds_cptr)shm; const lds_cptr kp0 = shm3 + LDS_K + hi * 1024 + r32 * 16;
  const lds_cptr vp0 = shm3 + LDS_V + ((lane >> 4) & 1) * 32 + (lane & 3) * 8 + (4 * hi + ((lane & 15) >> 2)) * 64;
  bf16x8 qr[ND0];
#pragma unroll
  for (int d0 = 0; d0 < ND0; ++d0) qr[d0] = *reinterpret_cast<const bf16x8*>(u.qptr(wid, r32, d0, hi));
  AF_DMA_K(0, 0); AF_DMA_V(0, 0); AF_DMA_K(1, KSLOT); AF_DMA_K(2, 2 * KSLOT);
  float l_reg = 0.f; f32x16 o[2]; o[0] = f32x16{}; o[1] = f32x16{};
  f32x16 pA0, pA1, pB0, pB1; bf16x8 kf[DKC];
  int s_prev = 0, s_cur = 0, s_next = 1;
#define AF_ROT() do { s_prev = s_cur; s_cur = s_next; s_next = (s_next == 2) ? 0 : s_next + 1; } while (0)
  AF_WAITN(2, 1);
  { const char* kb = shm + LDS_K + hi * 1024 + r32 * 16; pA0 = f32x16{}; pA1 = f32x16{};
#pragma unroll
    for (int d0 = 0; d0 < ND0; ++d0) { const bf16x8 b0 = *reinterpret_cast<const bf16x8*>(kb + d0 * 2048), b1 = *reinterpret_cast<const bf16x8*>(kb + d0 * 2048 + 512);
      pA0 = __builtin_amdgcn_mfma_f32_32x32x16_bf16(b0, qr[d0], pA0, 0, 0, 0); pA1 = __builtin_amdgcn_mfma_f32_32x32x16_bf16(b1, qr[d0], pA1, 0, 0, 0); }
    if constexpr (U::HAS_MASK) u.mask(pA0, pA1, 0, wid, r32, hi);
#pragma unroll
    for (int r = 0; r < 16; ++r) { pA0[r] = __builtin_amdgcn_exp2f(pA0[r]); pA1[r] = __builtin_amdgcn_exp2f(pA1[r]); } }
  AF_WAIT_BAR(0);
  AF_DMA_K(3, 0); AF_DMA_V(1, VSLOT);
  AF_ROT();
#pragma unroll
  for (int j = 0; j < ND0; ++j) kload2(kf, kp0 + s_cur * KSLOT, j);
  AF_WAITN(1, 1);
  s16x4 vlo[8], vhi[8]; u32x4 pw0, pw1, pw2, pw3;
#define AF_PKW(P, B) cvtpk_s(P[B], P[B + 1])
#define AF_PAF(k) __builtin_bit_cast(bf16x8, pw##k)
#define AF_VFR(i) (bf16x8){vlo[i][0], vlo[i][1], vlo[i][2], vlo[i][3], vhi[i][0], vhi[i][1], vhi[i][2], vhi[i][3]}
#define AF_PIN(x) asm volatile("" : "+v"(x))
#define AF_MF(a, b, c) __builtin_amdgcn_mfma_f32_32x32x16_bf16(a, b, c, 0, 0, 0)
#define AF_EX(v) __builtin_amdgcn_exp2f(v)
#define AF_VRD(i) do { vlo[i] = vtr(vp_ + (((i) >> 2) * 4096 + ((i) & 3) * 1024)); vhi[i] = vtr(vp_ + (((i) >> 2) * 4096 + ((i) & 3) * 1024 + 512)); AF_SBAR(); } while (0)
#define AF_GA4(MF, A0, A1, A2, A3, W0, W1, PW) do { MF; sacc += A0; sacc += A1; sacc += A2; sacc += A3; AF_PIN(sacc); W0; W1; AF_PIN(PW); AF_SBAR(); } while (0)
#define AF_GA3(MF, A0, A1, A2, W0, W1, PW) do { MF; sacc += A0; sacc += A1; sacc += A2; AF_PIN(sacc); W0; W1; AF_PIN(PW); AF_SBAR(); } while (0)
#define AF_GA2(MF, A0, A1, W0, PW) do { MF; sacc += A0; sacc += A1; AF_PIN(sacc); W0; AF_PIN(PW); AF_SBAR(); } while (0)
#define AF_GB(MF, X, B) do { MF; X[B] = AF_EX(X[B]); X[B + 1] = AF_EX(X[B + 1]); X[B + 2] = AF_EX(X[B + 2]); X[B + 3] = AF_EX(X[B + 3]); AF_PIN(X); AF_SBAR(); } while (0)
#define AF_KRD(G, j) do { if ((j) < ND0) { if (G) { kload2(kf, kp0 + s_next * KSLOT, (j) < ND0 ? (j) : 0); AF_SBAR(); } } } while (0)
  const f32x16 zero16 = f32x16{};
#define AF_PHASE_A12(C0, C1, P0, P1, t, GK, GV) do { \
    AF_VRD(0); float sacc = (P0[0] + P0[1]); \
    AF_GA3(C0 = AF_MF(kf[0], qr[0], zero16), P0[2], P0[3], P0[4],     pw0[0] = AF_PKW(P0, 0), pw0[1] = AF_PKW(P0, 2), pw0); \
    AF_VRD(4); AF_GA3(C1 = AF_MF(kf[1], qr[0], zero16), P0[5], P0[6], P0[7],     pw0[2] = AF_PKW(P0, 4), pw0[3] = AF_PKW(P0, 6), pw0); \
    AF_VRD(1); AF_GA3(C0 = AF_MF(kf[2], qr[1], C0),     P0[8], P0[9], P0[10],    pw1[0] = AF_PKW(P0, 8), pw1[1] = AF_PKW(P0, 10), pw1); \
    AF_VRD(5); AF_GA3(C1 = AF_MF(kf[3], qr[1], C1),     P0[11], P0[12], P0[13],  pw1[2] = AF_PKW(P0, 12), pw1[3] = AF_PKW(P0, 14), pw1); \
    AF_VRD(2); AF_GA3(C0 = AF_MF(kf[4], qr[2], C0),     P0[14], P0[15], P1[0],   pw2[0] = AF_PKW(P1, 0), pw2[1] = AF_PKW(P1, 2), pw2); \
    AF_VRD(6); AF_GA3(C1 = AF_MF(kf[5], qr[2], C1),     P1[1], P1[2], P1[3],     pw2[2] = AF_PKW(P1, 4), pw2[3] = AF_PKW(P1, 6), pw2); \
    AF_VRD(3); AF_GA2(C0 = AF_MF(kf[6], qr[3], C0),     P1[4], P1[5],            pw3[0] = AF_PKW(P1, 8), pw3); \
    AF_VRD(7); AF_GA2(C1 = AF_MF(kf[7], qr[3], C1),     P1[6], P1[7],            pw3[1] = AF_PKW(P1, 10), pw3); \
    AF_GA2(C0 = AF_MF(kf[8 % DKC], qr[4 % ND0], C0),    P1[8], P1[9],            pw3[2] = AF_PKW(P1, 12), pw3); \
    if (GK) { AF_DMA_KA((t) + 3, s_cur * KSLOT); AF_SBAR(); } \
    AF_GA2(C1 = AF_MF(kf[9 % DKC], qr[4 % ND0], C1),    P1[10], P1[11],          pw3[3] = AF_PKW(P1, 14), pw3); \
    if (GK) { AF_DMA_KB((t) + 3, s_cur * KSLOT); AF_SBAR(); } \
    { C0 = AF_MF(kf[10 % DKC], qr[5 % ND0], C0); sacc += P1[12]; sacc += P1[13]; AF_PIN(sacc); AF_SBAR(); } \
    if (GV) { AF_DMA_V((t) + 1, s_next * VSLOT); AF_SBAR(); } \
    { C1 = AF_MF(kf[11 % DKC], qr[5 % ND0], C1); sacc += P1[14]; sacc += P1[15]; AF_PIN(sacc); AF_SBAR(); } \
    l_reg += sacc; } while (0)
#define AF_PHASE_A8(C0, C1, P0, P1, t, GK, GV) do { \
    AF_VRD(0); float sacc = (P0[0] + P0[1]); \
    AF_GA4(C0 = AF_MF(kf[0], qr[0], zero16), P0[2], P0[3], P0[4], P0[5],       pw0[0] = AF_PKW(P0, 0), pw0[1] = AF_PKW(P0, 2), pw0); \
    AF_VRD(4); AF_GA4(C1 = AF_MF(kf[1], qr[0], zero16), P0[6], P0[7], P0[8], P0[9],       pw0[2] = AF_PKW(P0, 4), pw0[3] = AF_PKW(P0, 6), pw0); \
    AF_VRD(1); AF_GA4(C0 = AF_MF(kf[2], qr[1], C0),     P0[10], P0[11], P0[12], P0[13],   pw1[0] = AF_PKW(P0, 8), pw1[1] = AF_PKW(P0, 10), pw1); \
    AF_VRD(5); AF_GA4(C1 = AF_MF(kf[3], qr[1], C1),     P0[14], P0[15], P1[0], P1[1],     pw1[2] = AF_PKW(P0, 12), pw1[3] = AF_PKW(P0, 14), pw1); \
    AF_VRD(2); AF_GA4(C0 = AF_MF(kf[4], qr[2], C0),     P1[2], P1[3], P1[4], P1[5],       pw2[0] = AF_PKW(P1, 0), pw2[1] = AF_PKW(P1, 2), pw2); \
    AF_VRD(6); AF_GA4(C1 = AF_MF(kf[5], qr[2], C1),     P1[6], P1[7], P1[8], P1[9],       pw2[2] = AF_PKW(P1, 4), pw2[3] = AF_PKW(P1, 6), pw2); \
    AF_VRD(3); AF_GA4(C0 = AF_MF(kf[6], qr[3], C0),     P1[10], P1[11], P1[12], P1[13],   pw3[0] = AF_PKW(P1, 8), pw3[1] = AF_PKW(P1, 10), pw3); \
    AF_VRD(7); AF_GA4(C1 = AF_MF(kf[7], qr[3], C1),     P1[14], P1[15], 0.f, 0.f,         pw3[2] = AF_PKW(P1, 12), pw3[3] = AF_PKW(P1, 14), pw3); \
    l_reg += sacc; \
    if (GK) { AF_DMA_KA((t) + 3, s_cur * KSLOT); } if (GV) { AF_DMA_V((t) + 1, s_next * VSLOT); } } while (0)
#define AF_STEP(C0, C1, P0, P1, t, GK, GV, GL) do { AF_SBAR(); \
    const lds_cptr vp_ = vp0 + s_prev * VSLOT; \
    if constexpr (DKC == 12) AF_PHASE_A12(C0, C1, P0, P1, t, GK, GV); else AF_PHASE_A8(C0, C1, P0, P1, t, GK, GV); \
    if constexpr (U::HAS_MASK) u.mask(C0, C1, (t), wid, r32, hi); \
    AF_SBAR(); \
    AF_GB(o[0] = AF_MF(AF_PAF(0), AF_VFR(0), o[0]), C0, 0);  AF_KRD(GL, 0); \
    AF_GB(o[1] = AF_MF(AF_PAF(0), AF_VFR(4), o[1]), C0, 4);  AF_KRD(GL, 1); \
    AF_GB(o[0] = AF_MF(AF_PAF(1), AF_VFR(1), o[0]), C0, 8);  AF_KRD(GL, 2); \
    AF_GB(o[1] = AF_MF(AF_PAF(1), AF_VFR(5), o[1]), C0, 12); AF_KRD(GL, 3); \
    AF_GB(o[0] = AF_MF(AF_PAF(2), AF_VFR(2), o[0]), C1, 0);  AF_KRD(GL, 4); \
    AF_GB(o[1] = AF_MF(AF_PAF(2), AF_VFR(6), o[1]), C1, 4);  AF_KRD(GL, 5); \
    AF_GB(o[0] = AF_MF(AF_PAF(3), AF_VFR(3), o[0]), C1, 8); \
    AF_GB(o[1] = AF_MF(AF_PAF(3), AF_VFR(7), o[1]), C1, 12); \
  } while (0)
  int t = 1;
  for (; t + 3 < NT; t += 2) {
    AF_STEP(pB0, pB1, pA0, pA1, t, true, true, true);     AF_WAITN(1, 1); AF_ROT();
    AF_STEP(pA0, pA1, pB0, pB1, t + 1, true, true, true); AF_WAITN(1, 1); AF_ROT();
  }
  AF_STEP(pB0, pB1, pA0, pA1, NT - 3, false, true, true);  AF_WAITN(0, 1); AF_ROT();
  AF_STEP(pA0, pA1, pB0, pB1, NT - 2, false, true, true);  AF_WAIT_BAR(0); AF_ROT();
  AF_STEP(pB0, pB1, pA0, pA1, NT - 1, false, false, false);
  { float sacc = pB0[0] + pB0[1];
#pragma unroll
    for (int r = 2; r < 16; ++r) sacc += pB0[r];
#pragma unroll
    for (int r = 0; r < 16; ++r) sacc += pB1[r];
    l_reg += sacc;
    pw0 = (u32x4){AF_PKW(pB0, 0), AF_PKW(pB0, 2), AF_PKW(pB0, 4), AF_PKW(pB0, 6)}; pw1 = (u32x4){AF_PKW(pB0, 8), AF_PKW(pB0, 10), AF_PKW(pB0, 12), AF_PKW(pB0, 14)};
    pw2 = (u32x4){AF_PKW(pB1, 0), AF_PKW(pB1, 2), AF_PKW(pB1, 4), AF_PKW(pB1, 6)}; pw3 = (u32x4){AF_PKW(pB1, 8), AF_PKW(pB1, 10), AF_PKW(pB1, 12), AF_PKW(pB1, 14)};
    AF_SBAR();
    const lds_cptr vp_ = vp0 + s_cur * VSLOT;
#pragma unroll
    for (int i = 0; i < 8; ++i) { vlo[i] = vtr(vp_ + ((i >> 2) * 4096 + (i & 3) * 1024)); vhi[i] = vtr(vp_ + ((i >> 2) * 4096 + (i & 3) * 1024 + 512)); }
    o[0] = AF_MF(AF_PAF(0), AF_VFR(0), o[0]); o[1] = AF_MF(AF_PAF(0), AF_VFR(4), o[1]);
    o[0] = AF_MF(AF_PAF(1), AF_VFR(1), o[0]); o[1] = AF_MF(AF_PAF(1), AF_VFR(5), o[1]);
    o[0] = AF_MF(AF_PAF(2), AF_VFR(2), o[0]); o[1] = AF_MF(AF_PAF(2), AF_VFR(6), o[1]);
    o[0] = AF_MF(AF_PAF(3), AF_VFR(3), o[0]); o[1] = AF_MF(AF_PAF(3), AF_VFR(7), o[1]); }
  { auto rr = __builtin_amdgcn_permlane32_swap(__float_as_uint(l_reg), __float_as_uint(l_reg), false, false); l_reg = __uint_as_float(rr[0]) + __uint_as_float(rr[1]); }
  l_reg += __builtin_amdgcn_exp2f(u.sink(wid));
  if (hi == 0) wsf[32 + r32] = l_reg; asm volatile("s_waitcnt lgkmcnt(0)" ::: "memory");
  float rli[16];
#pragma unroll
  for (int r = 0; r < 16; ++r) rli[r] = __builtin_amdgcn_rcpf(wsf[32 + crow(r, hi)]);
  bf16* Ow = u.orow0(wid);
  { bf16* stg = (bf16*)(shm + LDS_OST) + wid * 2048;
#pragma unroll
    for (int r = 0; r < 16; ++r) { const int orow = crow(r, hi);
#pragma unroll
      for (int d0 = 0; d0 < 2; ++d0) stg[orow * 64 + d0 * 32 + r32] = (bf16)(cvtpk_s(o[d0][r] * rli[r], 0.f) & 0xffffu); }
    asm volatile("s_waitcnt lgkmcnt(0)" ::: "memory");
#pragma unroll
    for (int i = 0; i < 4; ++i) { const int row = i * 8 + (lane >> 3), ch = lane & 7; const u32x4 v = *(const u32x4*)(stg + row * 64 + ch * 8); *(u32x4*)(Ow + (long)row * 1024 + ch * 8) = v; } }
  asm volatile("s_waitcnt vmcnt(0) lgkmcnt(0)\n\ts_barrier" ::: "memory");
#undef AF_DMA_KA
#undef AF_DMA_KB
#undef AF_DMA_K
#undef AF_DMA_V
#undef AF_WAITN
#undef AF_ROT
#undef AF_PKW
#undef AF_PAF
#undef AF_VFR
#undef AF_PIN
#undef AF_MF
#undef AF_EX
#undef AF_VRD
#undef AF_GA4
#undef AF_GA3
#undef AF_GA2
#undef AF_GB
#undef AF_KRD
#undef AF_PHASE_A12
#undef AF_PHASE_A8
#undef AF_STEP
}

constexpr int ROWS_LAT = 16384;
constexpr float LOG2E_ = 1.4426950408889634f;
__device__ __forceinline__ int clampi(int v, int lo, int hi_) { return v < lo ? lo : (v > hi_ ? hi_ : v); }
struct FDense {
  static constexpr bool HAS_MASK = false;
  const bf16* Q; const bf16* kbase; const bf16* vbase; const bf16* krbase; bf16* O; int b, h, qb; static constexpr int kpitch = 2048, vpitch = 2048;
  __device__ __forceinline__ void init(const bf16* Q_, const bf16* KV, const bf16* KR, bf16* O_, int b_, int h_, int qb_) { Q = Q_; kbase = KV + 64 * h_; vbase = KV + 1024 + 64 * h_; krbase = KR; O = O_; b = b_; h = h_; qb = qb_; }
  __device__ __forceinline__ int nt() const { return 132; }
  __device__ __forceinline__ long trow(int t) const { return t < 4 ? (long)(ROWS_LAT + 256 * b + 64 * t) : (long)(8192 * b + 64 * (t - 4)); }
  __device__ __forceinline__ const bf16* qptr(int wid, int r32, int d0, int hi) const { const bf16* qp = Q + (long)(8192 * b + 256 * qb + 32 * wid + r32) * 1536;
    return d0 < 4 ? qp + 64 * h + 16 * d0 + 8 * hi : qp + 1024 + 32 * h + 16 * (d0 - 4) + 8 * hi; }
  __device__ __forceinline__ void mask(f32x16&, f32x16&, int, int, int, int) const {}
  __device__ __forceinline__ float sink(int) const { return -INFINITY; }
  __device__ __forceinline__ bf16* orow0(int wid) const { return O + (long)(8192 * b + 256 * qb + 32 * wid) * 1024 + 64 * h; }
};
struct FWin {
  static constexpr bool HAS_MASK = true; static constexpr int kpitch = 2304, vpitch = 2304;
  const bf16* QKV; const bf16* kbase; const bf16* vbase; const bf16* krbase; bf16* O; const float* sinkp; int b, n, g, hh, i0, cnt;
  __device__ __forceinline__ void init(const bf16* QKV_, bf16* O_, const float* sk, int b_, int n_, int g_, int hh_) { QKV = QKV_; O = O_; sinkp = sk; b = b_; n = n_; g = g_; hh = hh_; krbase = nullptr;
    kbase = QKV_ + 512 + 64 * g_; vbase = QKV_ + 640 + 64 * g_; i0 = (n_ == 0) ? 2 : 0; cnt = (n_ == 0 || n_ == 63) ? 4 : 6; }
  __device__ __forceinline__ int nt() const { return 4 + cnt; }
  __device__ __forceinline__ int kpos0(int t) const { return 128 * (n - 1) + 64 * (i0 + t - 4); }
  __device__ __forceinline__ long trow(int t) const { return t < 4 ? (long)(ROWS_LAT + 256 * b + 64 * t) : (long)(8192 * b + kpos0(t)); }
  __device__ __forceinline__ int head(int wid) const { return 4 * g + 2 * hh + (wid >> 2); }
  __device__ __forceinline__ int qpos0(int wid) const { return 128 * n + 32 * (wid & 3); }
  __device__ __forceinline__ const bf16* qptr(int wid, int r32, int d0, int hi) const { return QKV + (long)(8192 * b + qpos0(wid) + r32) * 2304 + 64 * head(wid) + 16 * d0 + 8 * hi; }
  __device__ __forceinline__ void mask(f32x16& p0, f32x16& p1, int t, int wid, int r32, int hi) const {
    if (t < 4) return;
    const int k0 = kpos0(t), q0 = qpos0(wid);
    if (k0 - (q0 + 31) >= -128 && k0 + 63 - q0 <= 128) return;
    asm volatile("" : "+v"(r32), "+v"(hi));
    const int dq = k0 - (q0 + r32);
#pragma unroll
    for (int r = 0; r < 16; ++r) { const int d = dq + crow(r, hi); if (d > 128 || d < -128) p0[r] = -INFINITY; if (d + 32 > 128 || d + 32 < -128) p1[r] = -INFINITY; }
  }
  __device__ __forceinline__ float sink(int wid) const { return sinkp[head(wid)] * LOG2E_; }
  __device__ __forceinline__ bf16* orow0(int wid) const { return O + (long)(8192 * b + qpos0(wid)) * 1024 + 64 * head(wid); }
};
struct FNa {
  static constexpr bool HAS_MASK = true; static constexpr int kpitch = 2304, vpitch = 2304;
  const bf16* QKV; const bf16* kbase; const bf16* vbase; const bf16* krbase; bf16* O; const float* rpbl; int b, h, R4, krlo, nloc;
  __device__ __forceinline__ void init(const bf16* QKV_, bf16* O_, const float* rpbl_, int b_, int h_, int R4_) { QKV = QKV_; O = O_; rpbl = rpbl_; b = b_; h = h_; R4 = R4_; krbase = nullptr;
    kbase = QKV_ + 1280 + 64 * h_; vbase = QKV_ + 1792 + 64 * h_; krlo = clampi(4 * R4_ - 4, 0, 120); nloc = clampi(4 * R4_ - 1, 0, 120) + 7 - krlo + 1; }
  __device__ __forceinline__ int nt() const { return (4 + nloc + 1) & ~1; }
  __device__ __forceinline__ long trow(int t) const { return (t < 4 || t >= 4 + nloc) ? (long)(ROWS_LAT + 256 * b + 64 * (t & 3)) : (long)(8192 * b + 64 * (krlo + t - 4)); }
  __device__ __forceinline__ int qrow(int wid) const { return 4 * R4 + (wid >> 1); }
  __device__ __forceinline__ const bf16* qptr(int wid, int r32, int d0, int hi) const { return QKV + (long)(8192 * b + 64 * qrow(wid) + 32 * (wid & 1) + r32) * 2304 + 768 + 64 * h + 16 * d0 + 8 * hi; }
  __device__ __forceinline__ void mask(f32x16& p0, f32x16& p1, int t, int wid, int r32, int hi) const {
    if (t < 4) return;
    const int kr = krlo + t - 4, w0 = clampi(qrow(wid) - 4, 0, 120);
    if (t >= 4 + nloc || kr < w0 || kr > w0 + 7) {
#pragma unroll
      for (int r = 0; r < 16; ++r) { p0[r] = -INFINITY; p1[r] = -INFINITY; }
      return; }
    asm volatile("" : "+v"(r32), "+v"(hi));
    const int qc = 32 * (wid & 1) + r32, c0 = clampi(qc - 8, 0, 48);
    const float* brow = rpbl + (kr - qrow(wid) + 7) * 31 + 15;
#pragma unroll
    for (int r = 0; r < 16; ++r) {
      { const int kc = crow(r, hi); const bool ok = kc >= c0 && kc < c0 + 16; const float bv = brow[clampi(kc - qc, -15, 15)]; p0[r] = ok ? p0[r] + bv : -INFINITY; }
      { const int kc = 32 + crow(r, hi); const bool ok = kc >= c0 && kc < c0 + 16; const float bv = brow[clampi(kc - qc, -15, 15)]; p1[r] = ok ? p1[r] + bv : -INFINITY; } }
  }
  __device__ __forceinline__ float sink(int) const { return -INFINITY; }
  __device__ __forceinline__ bf16* orow0(int wid) const { return O + (long)(8192 * b + 64 * qrow(wid) + 32 * (wid & 1)) * 1024 + 512 + 64 * h; }
};
struct FCtx {
  static constexpr bool HAS_MASK = false; static constexpr int kpitch = 2304, vpitch = 2304;
  const bf16* QKV; const bf16* kbase; const bf16* vbase; const bf16* krbase; bf16* O; const float* sinkp; int b, hx, qcol, ocol;
  __device__ __forceinline__ void init(const bf16* QKV_, bf16* O_, const float* sk, int b_, int hx_) { QKV = QKV_; O = O_; sinkp = sk; b = b_; hx = hx_; krbase = nullptr;
    if (hx_ < 8) { qcol = 64 * hx_; kbase = QKV_ + 512 + 64 * (hx_ >> 2); vbase = QKV_ + 640 + 64 * (hx_ >> 2); ocol = 64 * hx_; }
    else { const int h = hx_ - 8; qcol = 768 + 64 * h; kbase = QKV_ + 1280 + 64 * h; vbase = QKV_ + 1792 + 64 * h; ocol = 512 + 64 * h; } }
  __device__ __forceinline__ int nt() const { return 4; }
  __device__ __forceinline__ long trow(int t) const { return (long)(ROWS_LAT + 256 * b + 64 * (t & 3)); }
  __device__ __forceinline__ const bf16* qptr(int wid, int r32, int d0, int hi) const { return QKV + (long)(ROWS_LAT + 256 * b + 32 * wid + r32) * 2304 + qcol + 16 * d0 + 8 * hi; }
  __device__ __forceinline__ void mask(f32x16&, f32x16&, int, int, int, int) const {}
  __device__ __forceinline__ float sink(int) const { return hx < 8 ? sinkp[hx] * LOG2E_ : -INFINITY; }
  __device__ __forceinline__ bf16* orow0(int wid) const { return O + (long)(ROWS_LAT + 256 * b + 32 * wid) * 1024 + ocol; }
};
#undef AF_SBAR
#undef AF_WAIT_BAR
}
constexpr int NWAVES = 8;
#ifndef MK_PER_PHASE
#define MK_PER_PHASE 0
#endif
constexpr int BATCH = 2, SEQ = 8192, DM = 1024, CTXL = 256, FF = 4096;
constexpr int ML = BATCH * SEQ, MC = BATCH * CTXL, MR = ML + MC;
constexpr int NQKV = 2304, NCIN = 768, NUQ = 1536, NUKV = 2048;
constexpr float NORM_EPS = 1e-6f;
constexpr int ADA_KS = 16;
constexpr size_t MiB = 1u << 20;
constexpr size_t WS_CTL = 0, CTL_ZERO_BYTES = 64 * 1024;
constexpr size_t WS_MODP = 1 * MiB;
constexpr size_t WS_MOD = 3 * MiB + 512 * 1024;
constexpr size_t WS_ROPE = 3 * MiB + 768 * 1024;
constexpr size_t WS_HPAR = WS_ROPE + 32 * 1024;
constexpr size_t WS_CTXRES = 4 * MiB;
constexpr size_t WS_WQKV = 6 * MiB, WS_WO0 = WS_WQKV + 4608 * 1024, WS_W1_0 = WS_WO0 + 2 * MiB, WS_W2_0 = WS_W1_0 + 8 * MiB, WS_W1_1 = WS_W2_0 + 8 * MiB, WS_W2_1 = WS_W1_1 + 8 * MiB;
constexpr size_t WS_WIN = WS_W2_1 + 8 * MiB, WS_WUQ = WS_WIN + 1536 * 1024, WS_WUKV = WS_WUQ + 1152 * 1024, WS_WO1 = WS_WUKV + 1 * MiB, WS_WEND = WS_WO1 + 2 * MiB;
constexpr size_t WS_AR = 51 * MiB;
static_assert(WS_WEND <= WS_AR, "weights overlap the arena");
constexpr size_t WS_XN = WS_AR, WS_H = WS_AR + 33 * MiB;
constexpr size_t WS_QKV = WS_AR + 33 * MiB, WS_O0 = WS_AR + 108 * MiB;
constexpr size_t WS_CQKV = WS_AR + 33 * MiB, WS_CQN = WS_AR + 58 * MiB, WS_CKVN = WS_AR + 71 * MiB, WS_KR = WS_AR + 80 * MiB, WS_Q1 = WS_AR + 82 * MiB, WS_KV1 = WS_AR + 130 * MiB, WS_O1 = WS_AR;
constexpr size_t WS_PART5 = WS_AR + 33 * MiB;
constexpr size_t WS_PART8 = WS_AR + 166 * MiB;
constexpr size_t WS_END = 256 * MiB;
static_assert(WS_PART8 + (size_t)16 * 512 * 1024 * 4 <= WS_END && WS_KV1 + (size_t)MR * NUKV * 2 <= WS_END && WS_H + (size_t)MR * FF * 2 <= WS_END, "d_ws map");
constexpr int CW_BAR = 4096;
constexpr int RING_OFF = 0, RING_BYTES = 131072;
constexpr int LDSCTL_OFF = RING_BYTES, MISC_OFF = LDSCTL_OFF + 320;
constexpr int LDS_BYTES = 147456;
static_assert(att::L_END <= RING_BYTES && attf::LDS_BYTES <= RING_BYTES, "attention LDS");

#define GAS __attribute__((address_space(1)))
#define LAS __attribute__((address_space(3)))
typedef unsigned short bf16;
typedef unsigned v4u __attribute__((ext_vector_type(4)));
typedef unsigned v2u __attribute__((ext_vector_type(2)));
typedef float f32x4 __attribute__((ext_vector_type(4)));
typedef GAS unsigned gu32;
#define RLX_AGENT __ATOMIC_RELAXED, __HIP_MEMORY_SCOPE_AGENT
#define LDS_WAIT() asm volatile("s_waitcnt lgkmcnt(0)" ::: "memory")
#define VM_WAIT() asm volatile("s_waitcnt vmcnt(0)" ::: "memory")
__device__ __forceinline__ unsigned f2bf(float f) { unsigned u = __builtin_bit_cast(unsigned, f); return (u + 0x7fffu + ((u >> 16) & 1u)) >> 16; }
__device__ __forceinline__ unsigned pk2(float lo, float hi) { return f2bf(lo) | (f2bf(hi) << 16); }
__device__ __forceinline__ float bf2f(unsigned short h) { return __builtin_bit_cast(float, (unsigned)h << 16); }
__device__ __forceinline__ float bflo(unsigned w) { return __builtin_bit_cast(float, w << 16); }
__device__ __forceinline__ float bfhi(unsigned w) { return __builtin_bit_cast(float, w & 0xffff0000u); }

#define XB_TMO      128
#define XB_XCNT(j)  (256  + 64 * (j))
#define XB_XSUB(j)  (1280 + 64 * (j))
#define XB_XGEN(j)  (2304 + 64 * (j))
#define XB_TOP      3328
#define XB_TOPGEN   3392
#define XCD_BAR_WORDS 3456
#define XB_SPIN_CAP (1u << 18)

__device__ __forceinline__ unsigned xb_ld(unsigned* p)              { return __hip_atomic_load(p, __ATOMIC_RELAXED, __HIP_MEMORY_SCOPE_AGENT); }
__device__ __forceinline__ unsigned xb_add(unsigned* p, unsigned v) { return __hip_atomic_fetch_add(p, v, __ATOMIC_RELAXED, __HIP_MEMORY_SCOPE_AGENT); }
__device__ __forceinline__ unsigned xb_xcc_id() { return (unsigned)__builtin_amdgcn_s_getreg((3 << 11) | 20) & 0xFu; }
#define XB_SPIN(cond, bar) do { unsigned _sp = 0; while (cond) { __builtin_amdgcn_s_sleep(1); \
    if ((++_sp & 255u) == 0u) { if (xb_ld(&(bar)[XB_TMO])) break; if (_sp > XB_SPIN_CAP) { atomicAdd(&(bar)[XB_TMO], 1u); break; } } } } while (0)

struct XcdBarrier {
    unsigned* bar; unsigned x;
    volatile LAS unsigned* st;
};

__device__ __forceinline__ XcdBarrier xcd_barrier_post(unsigned* bar, volatile LAS unsigned* st) {
    XcdBarrier b; b.bar = bar; b.x = xb_xcc_id(); b.st = st;
    if (threadIdx.x == 0) (void)xb_add(&bar[XB_XCNT(b.x)], 1u);
    return b;
}
__device__ __forceinline__ void xcd_barrier_complete(unsigned* bar, unsigned x, unsigned& nloc, unsigned& nx) {
    const unsigned G = gridDim.x * gridDim.y * gridDim.z;
    unsigned sum, cnt, mine, sp = 0u;
    for (;;) {
        sum = 0u; cnt = 0u; mine = 0u;
#pragma unroll
        for (unsigned j = 0; j < 16; ++j) { const unsigned c = xb_ld(&bar[XB_XCNT(j)]); sum += c; cnt += (c > 0u) ? 1u : 0u; mine = (j == x) ? c : mine; }
        if (sum == G) break;
        __builtin_amdgcn_s_sleep(1);
        if ((++sp & 255u) == 0u) { if (xb_ld(&bar[XB_TMO])) break; if (sp > XB_SPIN_CAP) { atomicAdd(&bar[XB_TMO], 1u); break; } }
    }
    nloc = mine > 0u ? mine : 1u; nx = cnt > 0u ? cnt : 1u;
}

__device__ __forceinline__ void xcd_barrier(const XcdBarrier& b) {
    asm volatile("s_waitcnt vmcnt(0)" ::: "memory");
    __syncthreads();
    if (threadIdx.x == 0) {
        unsigned* bar = b.bar;
        __builtin_amdgcn_s_waitcnt(0);
        unsigned nloc = b.st[0], nx = b.st[1];
        if (nloc == 0u) { xcd_barrier_complete(bar, b.x, nloc, nx); b.st[0] = nloc; b.st[1] = nx; }
        const unsigned old = xb_add(&bar[XB_XSUB(b.x)], 1u);
        const unsigned gen = old / nloc;
        if (old + 1u == (gen + 1u) * nloc) {
            __builtin_amdgcn_fence(__ATOMIC_RELEASE, "agent");
            asm volatile("s_waitcnt vmcnt(0)" ::: "memory");
            const unsigned og = xb_add(&bar[XB_TOP], 1u);
            const unsigned tg = og / nx;
            if (og + 1u == (tg + 1u) * nx) xb_add(&bar[XB_TOPGEN], 1u);
            else XB_SPIN(xb_ld(&bar[XB_TOPGEN]) == tg, bar);
            __builtin_amdgcn_fence(__ATOMIC_ACQUIRE, "agent");
            xb_add(&bar[XB_XGEN(b.x)], 1u);
            asm volatile("s_waitcnt vmcnt(0)" ::: "memory");
        } else {
            XB_SPIN(xb_ld(&bar[XB_XGEN(b.x)]) == gen, bar);
            __builtin_amdgcn_fence(__ATOMIC_ACQUIRE, "agent");
            asm volatile("s_waitcnt vmcnt(0)" ::: "memory");
        }
    }
    __syncthreads();
}


template <int K> __device__ __forceinline__ const float* ldarg() {
    auto ka = __builtin_amdgcn_kernarg_segment_ptr();
    const __attribute__((address_space(1))) float* p; asm volatile("s_load_dwordx2 %0, %1, %2\n\ts_waitcnt lgkmcnt(0)" : "=s"(p) : "s"(ka), "i"(K * 8) : "memory"); return (const float*)p;
}
#define ARG(k) (ldarg<k>())
#define ARG_OUT ((float*)ldarg<28>())
#define ARG_WS ((unsigned char*)ldarg<29>())
struct Frame {
    LAS unsigned char* lds;
    volatile LAS unsigned* MISC;
    gu32* ctl;
    int tid, lane, wave;
    int vcu, G, bx;
    float* out; unsigned char* ws;
};
__device__ __forceinline__ float shx(float v, int mask, int lane) { return __builtin_bit_cast(float, __builtin_amdgcn_ds_bpermute((lane ^ mask) << 2, __builtin_bit_cast(int, v))); }
__device__ __forceinline__ float wave_sum(float v, int lane) {
#pragma unroll
    for (int o = 1; o < 64; o <<= 1) v += shx(v, o, lane);
    return v;
}
__device__ __forceinline__ void p0_transpose_item(const float* W, int K, int N, bf16* WT, int pmode, LAS float* scr, int item, int lane) {
    const int nblk = N / 32, kb = item / nblk, nb = item % nblk, k0 = 64 * kb, n0 = 32 * nb;
    int r0 = n0;
    if (pmode == 1) { const int h = n0 / 96, d = n0 % 96; r0 = d < 64 ? h * 64 + d : 1024 + h * 32 + (d - 64); }
    else if (pmode == 2) { const int h = n0 / 128, d = n0 % 128; r0 = d < 64 ? h * 64 + d : 1024 + h * 64 + (d - 64); }
#pragma unroll 8
    for (int i = 0; i < 32; ++i) { const int kk = 2 * i + (lane >> 5); scr[kk * 33 + (lane & 31)] = W[(size_t)(k0 + kk) * N + n0 + (lane & 31)]; }
    LDS_WAIT(); asm volatile("" ::: "memory");
    const int c = lane & 7;
#pragma unroll
    for (int j = 0; j < 4; ++j) { const int n = (lane >> 3) + 8 * j; const LAS float* s = scr + (8 * c) * 33 + n;
        v4u o; o.x = pk2(s[0 * 33], s[1 * 33]); o.y = pk2(s[2 * 33], s[3 * 33]); o.z = pk2(s[4 * 33], s[5 * 33]); o.w = pk2(s[6 * 33], s[7 * 33]);
        *(GAS v4u*)(WT + (size_t)(r0 + n) * K + k0 + 8 * c) = o; }
    LDS_WAIT(); asm volatile("" ::: "memory");
}
__device__ __forceinline__ float silu_f(float v) { return v / (1.f + __expf(-v)); }

__device__ __forceinline__ void p0_prologue(Frame& F) {
    LAS float* scr = (LAS float*)(F.lds + RING_OFF + F.wave * 16384);
    const float* c = ARG(1); const float* cctx = ARG(3);
    if (F.wave >= 5) {
        for (int it = F.vcu * 3 + (F.wave - 5); it < 2 * 24 * ADA_KS; it += F.G * 3) {
            const int l = it / (24 * ADA_KS), rem = it % (24 * ADA_KS), cg = rem / ADA_KS, ks = rem % ADA_KS;
            const float* W = ARG(4) + (size_t)l * DM * 6144 + cg * 256 + 4 * F.lane;
            f32x4 a0 = {0.f, 0.f, 0.f, 0.f}, a1 = a0, a2 = a0;
            const int kbeg = ks * (DM / ADA_KS);
#pragma unroll 8
            for (int k = kbeg; k < kbeg + DM / ADA_KS; ++k) {
                const f32x4 w = *(const GAS f32x4*)(W + (size_t)k * 6144);
                const float s0 = silu_f(c[k]), s1 = silu_f(c[DM + k]), s2 = silu_f(cctx[k]);
                a0 += w * s0; a1 += w * s1; a2 += w * s2;
            }
            float* P = (float*)(F.ws + WS_MODP) + ((size_t)(ks * 2 + l) * 3) * 6144 + cg * 256 + 4 * F.lane;
            *(GAS f32x4*)(P) = a0; *(GAS f32x4*)(P + 6144) = a1; *(GAS f32x4*)(P + 2 * 6144) = a2;
        }
    } else {
        const int gw = F.vcu * 5 + F.wave, NGW = F.G * 5;
        constexpr int I_QKV = 16 * 72, I_O = 16 * 32, I_1 = 16 * 128, I_2 = 64 * 32, I_IN = 16 * 21, I_UQ = 6 * 48, I_UKV = 4 * 64;
        constexpr int NITEMS = I_QKV + I_O + 2 * I_1 + 2 * I_2 + I_IN + I_UQ + I_UKV + I_O;
        for (int it = gw; it < NITEMS; it += NGW) {
            int r = it;
            if (r < I_QKV) { p0_transpose_item(ARG(10), DM, NQKV, (bf16*)(F.ws + WS_WQKV), 0, scr, r, F.lane); continue; } r -= I_QKV;
            if (r < I_O) { p0_transpose_item(ARG(11), DM, DM, (bf16*)(F.ws + WS_WO0), 0, scr, r, F.lane); continue; } r -= I_O;
            if (r < I_1) { p0_transpose_item(ARG(8), DM, FF, (bf16*)(F.ws + WS_W1_0), 0, scr, r, F.lane); continue; } r -= I_1;
            if (r < I_1) { p0_transpose_item(ARG(8) + (size_t)DM * FF, DM, FF, (bf16*)(F.ws + WS_W1_1), 0, scr, r, F.lane); continue; } r -= I_1;
            if (r < I_2) { p0_transpose_item(ARG(9), FF, DM, (bf16*)(F.ws + WS_W2_0), 0, scr, r, F.lane); continue; } r -= I_2;
            if (r < I_2) { p0_transpose_item(ARG(9) + (size_t)DM * FF, FF, DM, (bf16*)(F.ws + WS_W2_1), 0, scr, r, F.lane); continue; } r -= I_2;
            if (r < I_IN) { p0_transpose_item(ARG(18), DM, 672, (bf16*)(F.ws + WS_WIN), 0, scr, r, F.lane); continue; } r -= I_IN;
            if (r < I_UQ) { p0_transpose_item(ARG(21), 384, NUQ, (bf16*)(F.ws + WS_WUQ), 1, scr, r, F.lane); continue; } r -= I_UQ;
            if (r < I_UKV) { p0_transpose_item(ARG(22), 256, NUKV, (bf16*)(F.ws + WS_WUKV), 2, scr, r, F.lane); continue; } r -= I_UKV;
            p0_transpose_item(ARG(27), DM, DM, (bf16*)(F.ws + WS_WO1), 0, scr, r, F.lane);
        }
    }
    if (F.bx == 1 % F.G) {
        float* rt = (float*)(F.ws + WS_ROPE);
        for (int e = F.tid; e < 128 * 16; e += NWAVES * 64) { const int pos = e >> 4, i = e & 15; const float inv = exp2f(-(float)i * (13.287712379549449f / 16.f));
            float x = (float)pos * inv * 0.15915494309189535f; x -= rintf(x); rt[e] = __builtin_amdgcn_cosf(x); rt[2048 + e] = __builtin_amdgcn_sinf(x); }
        for (int e = F.tid; e < 128 * 8; e += NWAVES * 64) { const int pos = e >> 3, i = e & 7; const float inv = exp2f(-(float)i * (13.287712379549449f / 8.f));
            float x = (float)pos * inv * 0.15915494309189535f; x -= rintf(x); rt[4096 + e] = __builtin_amdgcn_cosf(x); rt[5120 + e] = __builtin_amdgcn_sinf(x); }
    }
    if (F.bx == 3 % F.G && F.tid < 64) {
        float* hp = (float*)(F.ws + WS_HPAR); const int i = F.tid;
        hp[i] = ARG(12)[i]; hp[64 + i] = ARG(13)[i]; hp[128 + i] = ARG(15)[i]; hp[192 + i] = ARG(16)[i]; hp[256 + i] = ARG(23)[i]; hp[320 + i] = ARG(24)[i & 31]; hp[384 + i] = ARG(25)[i];
        float a = fabsf(ARG(23)[i]), b_ = fabsf(ARG(25)[i]), c_ = fabsf(ARG(24)[i & 31]), d_ = fabsf(ARG(26)[i & 31]);
#pragma unroll
        for (int o_ = 1; o_ < 64; o_ <<= 1) { a = fmaxf(a, shx(a, o_, i)); b_ = fmaxf(b_, shx(b_, o_, i)); c_ = fmaxf(c_, shx(c_, o_, i)); d_ = fmaxf(d_, shx(d_, o_, i)); }
        const float bound = (64.f * a * b_ + 32.f * c_ * d_) * (0.10206207261596575f * 1.4426950408889634f);
        if (i == 0) hp[448] = (bound < 64.f && a < 200.f && b_ < 40.f) ? 1.f : 0.f;
    }
    if (F.bx == 2 % F.G) {
        GAS v4u* z = (GAS v4u*)((bf16*)(F.ws + WS_WIN) + (size_t)672 * DM);
        unsigned zz = 0u; asm volatile("" : "+v"(zz));
        for (int e = F.tid; e < 96 * DM / 8; e += NWAVES * 64) z[e] = (v4u){zz, zz, zz, zz};
    }
}

__device__ __forceinline__ void norm_phase(Frame& F, const float* src_lat, const float* src_ctx, int nrows, const float* gw_, int layer, int which  , bool from_partials, const float* parts = nullptr, int nparts = 0) {
    LAS float* gl = (LAS float*)(F.lds + RING_OFF); LAS float* scl = gl + 1024; LAS float* shl = scl + 3 * 1024;
    const float* modp = (const float*)(F.ws + WS_MODP); const float* mod = (const float*)(F.ws + WS_MOD); const float* ada_b = ARG(5);
    const int offsh = which * 3072, offsc = which * 3072 + 1024;
    for (int i = F.tid; i < 1024; i += NWAVES * 64) {
        gl[i] = gw_[i];
#pragma unroll
        for (int cnd = 0; cnd < 3; ++cnd) {
            float sh, sc;
            if (from_partials) { sh = ada_b[layer * 6144 + offsh + i]; sc = ada_b[layer * 6144 + offsc + i];
                float ph[ADA_KS], pc[ADA_KS];
#pragma unroll
                for (int ks = 0; ks < ADA_KS; ++ks) { const float* p = modp + ((size_t)(ks * 2 + layer) * 3 + cnd) * 6144; ph[ks] = p[offsh + i]; pc[ks] = p[offsc + i]; }
#pragma unroll
                for (int ks = 0; ks < ADA_KS; ++ks) { sh += ph[ks]; sc += pc[ks]; } }
            else { sh = mod[(layer * 3 + cnd) * 6144 + offsh + i]; sc = mod[(layer * 3 + cnd) * 6144 + offsc + i]; }
            scl[cnd * 1024 + i] = 1.f + sc; shl[cnd * 1024 + i] = sh;
        }
    }
    if (from_partials) {
        float* modw = (float*)(F.ws + WS_MOD);
        for (int e = F.vcu * (NWAVES * 64) + F.tid; e < 2 * 3 * 6144; e += F.G * NWAVES * 64) {
            const int l = e / (3 * 6144), rem = e % (3 * 6144), cnd = rem / 6144, col = rem % 6144;
            float v = ada_b[l * 6144 + col];
            float pv[ADA_KS];
#pragma unroll
            for (int ks = 0; ks < ADA_KS; ++ks) pv[ks] = modp[((size_t)(ks * 2 + l) * 3 + cnd) * 6144 + col];
#pragma unroll
            for (int ks = 0; ks < ADA_KS; ++ks) v += pv[ks];
            modw[e] = v;
        }
    }
    __syncthreads();
    bf16* XN = (bf16*)(F.ws + WS_XN);
    const int gw = F.vcu * NWAVES + F.wave, NGW = F.G * NWAVES;
    for (int m = gw; m < nrows; m += NGW) {
        const float* xrow = m < ML ? src_lat + (size_t)m * DM : src_ctx + (size_t)(m - ML) * DM;
        const int cnd = m < SEQ ? 0 : (m < ML ? 1 : 2);
        const GAS f32x4* xr = (const GAS f32x4*)xrow + F.lane;
        f32x4 v[4]; float s = 0.f;
#pragma unroll
        for (int j = 0; j < 4; ++j) v[j] = xr[64 * j];
        if (nparts > 0 && m >= ML) {
            for (int p = 0; p < nparts; p += 4) {
                const GAS f32x4* pr = (const GAS f32x4*)(parts + (size_t)p * (512 * 1024) + (size_t)(m - ML) * DM) + F.lane;
                f32x4 w[4][4];
#pragma unroll
                for (int q = 0; q < 4; ++q)
#pragma unroll
                    for (int j = 0; j < 4; ++j) w[q][j] = pr[(size_t)q * (512 * 1024 / 4) + 64 * j];
#pragma unroll
                for (int j = 0; j < 4; ++j) v[j] += (w[0][j] + w[1][j]) + (w[2][j] + w[3][j]); }
            GAS f32x4* cr = (GAS f32x4*)((float*)(F.ws + WS_CTXRES) + (size_t)(m - ML) * DM) + F.lane;
#pragma unroll
            for (int j = 0; j < 4; ++j) cr[64 * j] = v[j];
        }
#pragma unroll
        for (int j = 0; j < 4; ++j) s += (v[j].x * v[j].x + v[j].y * v[j].y) + (v[j].z * v[j].z + v[j].w * v[j].w);
        const float rstd = 1.f / sqrtf(wave_sum(s, F.lane) * (1.f / DM) + NORM_EPS);
        if (from_partials && m >= ML) { GAS f32x4* cr = (GAS f32x4*)((float*)(F.ws + WS_CTXRES) + (size_t)(m - ML) * DM) + F.lane;
#pragma unroll
            for (int j = 0; j < 4; ++j) cr[64 * j] = v[j]; }
        GAS v2u* o8 = (GAS v2u*)(XN + (size_t)m * DM) + F.lane;
#pragma unroll
        for (int j = 0; j < 4; ++j) { const int col = 4 * F.lane + 256 * j;
            const f32x4 g = *(const LAS f32x4*)(gl + col), sc = *(const LAS f32x4*)(scl + cnd * 1024 + col), sh = *(const LAS f32x4*)(shl + cnd * 1024 + col);
            const f32x4 y = (v[j] * rstd) * g * sc + sh;
            v2u w; w.x = pk2(y.x, y.y); w.y = pk2(y.z, y.w); o8[64 * j] = w; }
    }
    __syncthreads();
}

__device__ __forceinline__ void unpack8(const v4u w, float (&x)[8]) { x[0] = bflo(w.x); x[1] = bfhi(w.x); x[2] = bflo(w.y); x[3] = bfhi(w.y); x[4] = bflo(w.z); x[5] = bfhi(w.z); x[6] = bflo(w.w); x[7] = bfhi(w.w); }
__device__ __forceinline__ v4u pack8(const float (&x)[8]) { v4u w; w.x = pk2(x[0], x[1]); w.y = pk2(x[2], x[3]); w.z = pk2(x[4], x[5]); w.w = pk2(x[6], x[7]); return w; }

__device__ __forceinline__ void qknorm_phase(Frame& F) {
    bf16* QKV = (bf16*)(F.ws + WS_QKV);
    const float* rt = (const float*)(F.ws + WS_ROPE);
    const float* nw[4] = {ARG(12), ARG(13), ARG(15), ARG(16)};
    const float qscale = 0.125f * att::LOG2E;
    const int gw = F.vcu * NWAVES + F.wave, NGW = F.G * NWAVES;
    const int lane = F.lane, grp = lane >> 3, l8 = lane & 7;
    for (int m = gw; m < MR; m += NGW) {
        const bool lat = m < ML; const int t = m & (SEQ - 1); const int prow = t >> 6, pcol = t & 63;
        GAS v4u* rowp = (GAS v4u*)(QKV + (size_t)m * NQKV);
#pragma unroll
        for (int pass = 0; pass < 4; ++pass) {
            int type;
            if (pass == 0) type = 1; else if (pass == 1) type = grp < 2 ? 2 : (grp < 4 ? 0 : 3); else if (pass == 2) type = grp < 4 ? 3 : 4; else type = grp < 4 ? 4 : 0;
            const v4u w = rowp[pass * 64 + lane];
            float x[8]; unpack8(w, x);
            float ss = 0.f;
#pragma unroll
            for (int j = 0; j < 8; ++j) ss += x[j] * x[j];
            ss += shx(ss, 1, F.lane); ss += shx(ss, 2, F.lane); ss += shx(ss, 4, F.lane);
            const float rstd = 1.f / sqrtf(ss * (1.f / 64.f) + NORM_EPS);
            const float* g = type == 1 ? nw[0] : (type == 2 ? nw[1] : (type == 3 ? nw[2] : nw[3]));
            const f32x4 g0 = *(const GAS f32x4*)(g + l8 * 8), g1 = *(const GAS f32x4*)(g + l8 * 8 + 4);
            x[0] *= rstd * g0.x; x[1] *= rstd * g0.y; x[2] *= rstd * g0.z; x[3] *= rstd * g0.w; x[4] *= rstd * g1.x; x[5] *= rstd * g1.y; x[6] *= rstd * g1.z; x[7] *= rstd * g1.w;
            float px[8];
#pragma unroll
            for (int j = 0; j < 8; ++j) px[j] = shx(x[j], 2, F.lane);
            if (lat && (type == 1 || type == 2)) {
                const int pos = (l8 & 4) ? pcol : prow; const float* cs = rt + pos * 16 + (l8 & 1) * 8;
                const f32x4 c0 = *(const GAS f32x4*)(cs), c1 = *(const GAS f32x4*)(cs + 4), s0 = *(const GAS f32x4*)(cs + 2048), s1 = *(const GAS f32x4*)(cs + 2052);
                const float cc[8] = {c0.x, c0.y, c0.z, c0.w, c1.x, c1.y, c1.z, c1.w}, sn[8] = {s0.x, s0.y, s0.z, s0.w, s1.x, s1.y, s1.z, s1.w};
                const float sgn = (l8 & 2) ? 1.f : -1.f;
#pragma unroll
                for (int j = 0; j < 8; ++j) x[j] = x[j] * cc[j] + sgn * px[j] * sn[j];
            }
            if (type == 1 || type == 3) {
#pragma unroll
                for (int j = 0; j < 8; ++j) x[j] *= qscale;
            }
            if (type != 0) rowp[pass * 64 + lane] = pack8(x);
        }
    }
}

__device__ __forceinline__ void cnorm_phase(Frame& F) {
    const bf16* CQKV = (const bf16*)(F.ws + WS_CQKV); bf16* CQN = (bf16*)(F.ws + WS_CQN); bf16* CKVN = (bf16*)(F.ws + WS_CKVN); bf16* KR = (bf16*)(F.ws + WS_KR);
    const float* rt = (const float*)(F.ws + WS_ROPE) + 4096;
    const float* gq = ARG(19); const float* gkv = ARG(20); const float* gkr = ARG(26);
    const int gw = F.vcu * NWAVES + F.wave, NGW = F.G * NWAVES; const int lane = F.lane;
    for (int m = gw; m < MR; m += NGW) {
        const bool lat = m < ML; const int t = m & (SEQ - 1); const int prow = t >> 6, pcol = t & 63;
        const GAS v4u* rowp = (const GAS v4u*)(CQKV + (size_t)m * NCIN);
        const v4u w0 = rowp[lane]; v4u w1 = {0u, 0u, 0u, 0u}; if (lane < 32) w1 = rowp[64 + lane];
        float x0[8], x1[8]; unpack8(w0, x0); unpack8(w1, x1);
        float s0 = 0.f, s1 = 0.f;
#pragma unroll
        for (int j = 0; j < 8; ++j) { s0 += x0[j] * x0[j]; s1 += x1[j] * x1[j]; }
        const float ssq = wave_sum(lane < 48 ? s0 : 0.f, F.lane);
        const float sskv = wave_sum((lane >= 48 ? s0 : 0.f) + (lane < 16 ? s1 : 0.f), F.lane);
        const float sskr = wave_sum((lane >= 16 && lane < 20) ? s1 : 0.f, F.lane);
        const float rq = 1.f / sqrtf(ssq * (1.f / 384.f) + NORM_EPS), rkv = 1.f / sqrtf(sskv * (1.f / 256.f) + NORM_EPS), rkr = 1.f / sqrtf(sskr * (1.f / 32.f) + NORM_EPS);
        { const float* g = lane < 48 ? gq + lane * 8 : gkv + (lane - 48) * 8; const float r = lane < 48 ? rq : rkv;
          const f32x4 g0 = *(const GAS f32x4*)(g), g1 = *(const GAS f32x4*)(g + 4);
          float y[8] = {x0[0] * r * g0.x, x0[1] * r * g0.y, x0[2] * r * g0.z, x0[3] * r * g0.w, x0[4] * r * g1.x, x0[5] * r * g1.y, x0[6] * r * g1.z, x0[7] * r * g1.w};
          if (lane < 48) *(GAS v4u*)(CQN + (size_t)m * 384 + lane * 8) = pack8(y); else *(GAS v4u*)(CKVN + (size_t)m * 256 + (lane - 48) * 8) = pack8(y); }
        { const int li = lane < 16 ? lane : (lane < 20 ? lane - 16 : 0);
          const float* g = lane < 16 ? gkv + 128 + li * 8 : gkr + li * 8; const float r = lane < 16 ? rkv : rkr;
          const f32x4 g0 = *(const GAS f32x4*)(g), g1 = *(const GAS f32x4*)(g + 4);
          float y[8] = {x1[0] * r * g0.x, x1[1] * r * g0.y, x1[2] * r * g0.z, x1[3] * r * g0.w, x1[4] * r * g1.x, x1[5] * r * g1.y, x1[6] * r * g1.z, x1[7] * r * g1.w};
          float py[8];
#pragma unroll
          for (int j = 0; j < 8; ++j) py[j] = shx(y[j], 1, F.lane);
          if (lat && lane >= 16 && lane < 20) {
              const int pos = (lane & 2) ? pcol : prow; const float* cs = rt + pos * 8;
              const f32x4 c0 = *(const GAS f32x4*)(cs), c1 = *(const GAS f32x4*)(cs + 4), sa = *(const GAS f32x4*)(cs + 1024), sb = *(const GAS f32x4*)(cs + 1028);
              const float cc[8] = {c0.x, c0.y, c0.z, c0.w, c1.x, c1.y, c1.z, c1.w}, sn[8] = {sa.x, sa.y, sa.z, sa.w, sb.x, sb.y, sb.z, sb.w};
              const float sgn = (lane & 1) ? 1.f : -1.f;
#pragma unroll
              for (int j = 0; j < 8; ++j) y[j] = y[j] * cc[j] + sgn * py[j] * sn[j];
          }
          if (lane < 16) *(GAS v4u*)(CKVN + (size_t)m * 256 + 128 + lane * 8) = pack8(y);
          else if (lane < 20) *(GAS v4u*)(KR + (size_t)m * 32 + (lane - 16) * 8) = pack8(y); }
    }
}

__device__ __forceinline__ void hnorm_phase(Frame& F) {
    bf16* Q = (bf16*)(F.ws + WS_Q1); bf16* KV = (bf16*)(F.ws + WS_KV1);
    const float* rt = (const float*)(F.ws + WS_ROPE) + 4096;
    const float* gqn = ARG(23); const float* gqr = ARG(24); const float* gkn = ARG(25);
    const float qscale = 0.10206207261596575f * att::LOG2E;
    const int gw = F.vcu * NWAVES + F.wave, NGW = F.G * NWAVES; const int lane = F.lane, l8 = lane & 7, l4 = lane & 3;
    for (int m = gw; m < MR; m += NGW) {
        const bool lat = m < ML; const int t = m & (SEQ - 1); const int prow = t >> 6, pcol = t & 63;
        { GAS v4u* rowp = (GAS v4u*)(KV + (size_t)m * NUKV);
          const f32x4 g0 = *(const GAS f32x4*)(gkn + l8 * 8), g1 = *(const GAS f32x4*)(gkn + l8 * 8 + 4);
#pragma unroll
          for (int pass = 0; pass < 2; ++pass) {
              float x[8]; unpack8(rowp[pass * 64 + lane], x); float ss = 0.f;
#pragma unroll
              for (int j = 0; j < 8; ++j) ss += x[j] * x[j];
              ss += shx(ss, 1, F.lane); ss += shx(ss, 2, F.lane); ss += shx(ss, 4, F.lane);
              const float r = 1.f / sqrtf(ss * (1.f / 64.f) + NORM_EPS);
              x[0] *= r * g0.x; x[1] *= r * g0.y; x[2] *= r * g0.z; x[3] *= r * g0.w; x[4] *= r * g1.x; x[5] *= r * g1.y; x[6] *= r * g1.z; x[7] *= r * g1.w;
              rowp[pass * 64 + lane] = pack8(x); } }
        if (lat) {
            GAS v4u* rowp = (GAS v4u*)(Q + (size_t)m * NUQ);
            { const f32x4 g0 = *(const GAS f32x4*)(gqn + l8 * 8), g1 = *(const GAS f32x4*)(gqn + l8 * 8 + 4);
#pragma unroll
              for (int pass = 0; pass < 2; ++pass) {
                  float x[8]; unpack8(rowp[pass * 64 + lane], x); float ss = 0.f;
#pragma unroll
                  for (int j = 0; j < 8; ++j) ss += x[j] * x[j];
                  ss += shx(ss, 1, F.lane); ss += shx(ss, 2, F.lane); ss += shx(ss, 4, F.lane);
                  const float r = qscale / sqrtf(ss * (1.f / 64.f) + NORM_EPS);
                  x[0] *= r * g0.x; x[1] *= r * g0.y; x[2] *= r * g0.z; x[3] *= r * g0.w; x[4] *= r * g1.x; x[5] *= r * g1.y; x[6] *= r * g1.z; x[7] *= r * g1.w;
                  rowp[pass * 64 + lane] = pack8(x); } }
            {
              const f32x4 g0 = *(const GAS f32x4*)(gqr + l4 * 8), g1 = *(const GAS f32x4*)(gqr + l4 * 8 + 4);
              float x[8]; unpack8(rowp[128 + lane], x); float ss = 0.f;
#pragma unroll
              for (int j = 0; j < 8; ++j) ss += x[j] * x[j];
              ss += shx(ss, 1, F.lane); ss += shx(ss, 2, F.lane);
              const float r = 1.f / sqrtf(ss * (1.f / 32.f) + NORM_EPS);
              x[0] *= r * g0.x; x[1] *= r * g0.y; x[2] *= r * g0.z; x[3] *= r * g0.w; x[4] *= r * g1.x; x[5] *= r * g1.y; x[6] *= r * g1.z; x[7] *= r * g1.w;
              float px[8];
#pragma unroll
              for (int j = 0; j < 8; ++j) px[j] = shx(x[j], 1, F.lane);
              const int pos = (l4 & 2) ? pcol : prow; const float* cs = rt + pos * 8;
              const f32x4 c0 = *(const GAS f32x4*)(cs), c1 = *(const GAS f32x4*)(cs + 4), sa = *(const GAS f32x4*)(cs + 1024), sb = *(const GAS f32x4*)(cs + 1028);
              const float cc[8] = {c0.x, c0.y, c0.z, c0.w, c1.x, c1.y, c1.z, c1.w}, sn[8] = {sa.x, sa.y, sa.z, sa.w, sb.x, sb.y, sb.z, sb.w};
              const float sgn = (l4 & 1) ? 1.f : -1.f;
#pragma unroll
              for (int j = 0; j < 8; ++j) x[j] = (x[j] * cc[j] + sgn * px[j] * sn[j]) * qscale;
              rowp[128 + lane] = pack8(x); }
        }
    }
}

__device__ __forceinline__ void attn0_phase(Frame& F) {
    att::lchar* lds = (att::lchar*)(F.lds + RING_OFF);
    const att::bf16* QKV = (const att::bf16*)(F.ws + WS_QKV); att::bf16* O = (att::bf16*)(F.ws + WS_O0);
    bool fast;
    { float a = fabsf(ARG(12)[F.lane]), b_ = fabsf(ARG(13)[F.lane]), c_ = fabsf(ARG(15)[F.lane]), d_ = fabsf(ARG(16)[F.lane]), e_ = 0.f, f_ = fabsf(ARG(14)[F.lane & 7]);
      for (int i = F.lane; i < 8 * 465; i += 64) e_ = fmaxf(e_, fabsf(ARG(17)[i]));
#pragma unroll
      for (int o_ = 1; o_ < 64; o_ <<= 1) { a = fmaxf(a, shx(a, o_, F.lane)); b_ = fmaxf(b_, shx(b_, o_, F.lane)); c_ = fmaxf(c_, shx(c_, o_, F.lane)); d_ = fmaxf(d_, shx(d_, o_, F.lane)); e_ = fmaxf(e_, shx(e_, o_, F.lane)); f_ = fmaxf(f_, shx(f_, o_, F.lane)); }
      const float bound = fmaxf(fmaxf(8.f * a * b_, 8.f * c_ * d_ + e_), f_) * att::LOG2E;
      fast = __builtin_amdgcn_readfirstlane(bound < 64.f ? 1 : 0) != 0; }
    char* shm = (char*)(F.lds + RING_OFF);
    for (int ui = F.vcu; ui < 1056; ui += F.G) {
        if (ui < 512) {
            const int b = ui >> 8, h = (ui >> 5) & 7, R4 = ui & 31;
            const float* rpb = ARG(17) + h * 465;
            if (fast) {
                float* rl = (float*)(shm + attf::LDS_RPB);
                for (int i = F.tid; i < 465; i += NWAVES * 64) rl[i] = rpb[i] * att::LOG2E;
                __syncthreads();
                attf::FNa fu; fu.init((const attf::bf16*)QKV, (attf::bf16*)O, rl, b, h, R4);
                attf::fast_unit<8, attf::FNa>(fu, shm, F.tid);
            } else {
                att::UNa u; u.QKV = QKV; u.O = O; u.rpbl = (const LAS float*)(lds + att::L_RPB); u.b = b; u.h = h; u.R4 = R4; u.init();
                for (int i = F.tid; i < 465; i += NWAVES * 64) ((LAS float*)(lds + att::L_RPB))[i] = rpb[i] * att::LOG2E;
                att::unit<8, att::UNa>(u, lds, F.tid);
            }
        } else if (ui < 1024) {
            const int v = ui - 512;
            if (fast) { attf::FWin fu; fu.init((const attf::bf16*)QKV, (attf::bf16*)O, ARG(14), v >> 8, (v >> 2) & 63, (v >> 1) & 1, v & 1); attf::fast_unit<8, attf::FWin>(fu, shm, F.tid); }
            else { att::UWin u; u.QKV = QKV; u.O = O; u.sinkp = ARG(14); u.b = v >> 8; u.n = (v >> 2) & 63; u.g = (v >> 1) & 1; u.hh = v & 1; u.init(); att::unit<8, att::UWin>(u, lds, F.tid); }
        } else {
            const int v = ui - 1024;
            if (fast) { attf::FCtx fu; fu.init((const attf::bf16*)QKV, (attf::bf16*)O, ARG(14), v >> 4, v & 15); attf::fast_unit<8, attf::FCtx>(fu, shm, F.tid); }
            else { att::UCtx u; u.QKV = QKV; u.O = O; u.sinkp = ARG(14); u.b = v >> 4; u.hx = v & 15; u.init(); att::unit<8, att::UCtx>(u, lds, F.tid); }
        }
    }
}
__device__ __forceinline__ void attn1_phase(Frame& F) {
    att::lchar* lds = (att::lchar*)(F.lds + RING_OFF);
    const bool fast = __builtin_amdgcn_readfirstlane(__builtin_bit_cast(int, ((const float*)(F.ws + WS_HPAR))[448])) != 0;
    const bool g256 = F.G == 256; const int x = F.vcu >> 5, j = F.vcu & 31;
    const int nit = g256 ? 4 : (F.vcu < 1024 ? (1024 - F.vcu + F.G - 1) / F.G : 0);
    for (int i = 0; i < nit; ++i) {
        const int ui = g256 ? ((x * 4 + i) * 32 + j) : F.vcu + i * F.G;
        if (fast) attd::dense_unit(ui >> 9, (ui >> 5) & 15, ui & 31, (const attd::bf16*)(F.ws + WS_Q1), (const attd::bf16*)(F.ws + WS_KV1), (const attd::bf16*)(F.ws + WS_KR), (attd::bf16*)(F.ws + WS_O1), (char*)(F.lds + RING_OFF), F.tid);
        else {
        att::UDense u; u.Q = (const att::bf16*)(F.ws + WS_Q1); u.KV = (const att::bf16*)(F.ws + WS_KV1); u.KR = (const att::bf16*)(F.ws + WS_KR); u.O = (att::bf16*)(F.ws + WS_O1);
        u.b = ui >> 9; u.h = (ui >> 5) & 15; u.qb = ui & 31;
        att::unit<12, att::UDense>(u, lds, F.tid); }
    }
}

#ifndef PHASE_MASK
#define PHASE_MASK 0xFFFFFu
#endif
#ifndef PHASE_REP
#define PHASE_REP 0u
#endif
struct Args { const float* in[28]; float* out; unsigned char* ws; int ph_lo, ph_hi; };
constexpr int N_PHASES = 19;
__global__ void __launch_bounds__(NWAVES * 64, 2) fwd_kernel(Args args) {
    extern __shared__ __attribute__((aligned(16))) unsigned char lds[];
    for (int u = threadIdx.x; u < (LDS_BYTES - LDSCTL_OFF) / 4; u += NWAVES * 64) ((LAS unsigned*)((LAS unsigned char*)lds + LDSCTL_OFF))[u] = 0u;
    __syncthreads();
    if (!MK_PER_PHASE) (void)xcd_barrier_post((unsigned*)((gu32*)(ARG_WS + WS_CTL) + CW_BAR), (volatile LAS unsigned*)((LAS unsigned char*)lds + MISC_OFF) + 8);
    for (int ph2 = 2 * args.ph_lo; ph2 < 2 * args.ph_hi; ++ph2) {
        const int ph = ph2 >> 1; if ((ph2 & 1) && !((PHASE_REP >> ph) & 1)) continue;
        if (ph == 3 || ph == 14) continue;
        Frame F;
        { int t_ = threadIdx.x; asm volatile("" : "+v"(t_)); int b_ = blockIdx.x; asm volatile("" : "+s"(b_)); int g_ = gridDim.x; asm volatile("" : "+s"(g_)); F.tid = t_; F.bx = b_; F.G = g_; }
        F.lds = (LAS unsigned char*)lds; F.MISC = (volatile LAS unsigned*)(F.lds + MISC_OFF);
        F.lane = F.tid & 63; F.wave = __builtin_amdgcn_readfirstlane(F.tid >> 6);
        F.vcu = (F.G % 8 == 0) ? (F.bx % 8) * (F.G / 8) + F.bx / 8 : F.bx;
        F.ws = ARG_WS; F.out = ARG_OUT; F.ctl = (gu32*)(F.ws + WS_CTL);
        XcdBarrier bar; bar.bar = (unsigned*)(F.ctl + CW_BAR); bar.x = xb_xcc_id(); bar.st = F.MISC + 8;
        float* ctxres = (float*)(F.ws + WS_CTXRES);
        const float* mod = (const float*)(F.ws + WS_MOD);
        int gk = 0, xrows = 0, xS = 0;
        pg8::Gemm g{nullptr, nullptr, 0, 0, 0}; pg8::EpiAny ea{0, nullptr, nullptr, nullptr, nullptr, 0, 0};
        switch (ph) {
        case 0: if (!((PHASE_MASK >> 0) & 1)) break; p0_prologue(F); break;
        case 1: if (!((PHASE_MASK >> 1) & 1)) break; norm_phase(F, ARG(0), ARG(2), MR, ARG(6), 0, 0, true); break;
        case 2: if (!((PHASE_MASK >> 2) & 1)) break; gk = 1; g = pg8::Gemm{(const bf16*)(F.ws + WS_XN), (const bf16*)(F.ws + WS_WQKV), MR, NQKV, DM}; ea = pg8::EpiAny{3, (const float*)(F.ws + WS_HPAR), (void*)(F.ws + WS_QKV), nullptr, (const float*)(F.ws + WS_ROPE), NQKV, 0}; break;
        case 4: if (!((PHASE_MASK >> 4) & 1)) break; attn0_phase(F); break;
        case 5: if (!((PHASE_MASK >> 5) & 1)) break; gk = 2; g = pg8::Gemm{(const bf16*)(F.ws + WS_O0), (const bf16*)(F.ws + WS_WO0), ML, DM, DM}; xrows = MC; xS = 2; ea = pg8::EpiAny{2, ARG(0), (void*)F.out, (float*)(F.ws + WS_PART5), mod + 2048, 0, 0}; break;
        case 6: if (!((PHASE_MASK >> 6) & 1)) break; norm_phase(F, F.out, ctxres, MR, ARG(7), 0, 1, false, (const float*)(F.ws + WS_PART5), 4); break;
        case 7: if (!((PHASE_MASK >> 7) & 1)) break; gk = 1; g = pg8::Gemm{(const bf16*)(F.ws + WS_XN), (const bf16*)(F.ws + WS_W1_0), MR, FF, DM}; ea = pg8::EpiAny{1, nullptr, (void*)(F.ws + WS_H), nullptr, nullptr, FF, 1}; break;
        case 8: if (!((PHASE_MASK >> 8) & 1)) break; gk = 2; g = pg8::Gemm{(const bf16*)(F.ws + WS_H), (const bf16*)(F.ws + WS_W2_0), ML, DM, FF}; xrows = MC; xS = 4; ea = pg8::EpiAny{2, F.out, (void*)F.out, (float*)(F.ws + WS_PART8), mod + 5120, 0, 0}; break;
        case 9: if (!((PHASE_MASK >> 9) & 1)) break; norm_phase(F, F.out, ctxres, MR, ARG(6) + DM, 1, 0, false, (const float*)(F.ws + WS_PART8), 16); break;
        case 10: if (!((PHASE_MASK >> 10) & 1)) break; gk = 1; g = pg8::Gemm{(const bf16*)(F.ws + WS_XN), (const bf16*)(F.ws + WS_WIN), MR, NCIN, DM}; ea = pg8::EpiAny{1, nullptr, (void*)(F.ws + WS_CQKV), nullptr, nullptr, NCIN, 0}; break;
        case 11: if (!((PHASE_MASK >> 11) & 1)) break; cnorm_phase(F); break;
        case 12: if (!((PHASE_MASK >> 12) & 1)) break; gk = 1; g = pg8::Gemm{(const bf16*)(F.ws + WS_CQN), (const bf16*)(F.ws + WS_WUQ), ML, NUQ, 384}; ea = pg8::EpiAny{3, (const float*)(F.ws + WS_HPAR), (void*)(F.ws + WS_Q1), nullptr, (const float*)(F.ws + WS_ROPE), NUQ, 1}; break;
        case 13: if (!((PHASE_MASK >> 13) & 1)) break; gk = 1; g = pg8::Gemm{(const bf16*)(F.ws + WS_CKVN), (const bf16*)(F.ws + WS_WUKV), MR, NUKV, 256}; ea = pg8::EpiAny{3, (const float*)(F.ws + WS_HPAR), (void*)(F.ws + WS_KV1), nullptr, (const float*)(F.ws + WS_ROPE), NUKV, 2}; break;
        case 15: if (!((PHASE_MASK >> 15) & 1)) break; attn1_phase(F); break;
        case 16: if (!((PHASE_MASK >> 16) & 1)) break; gk = 2; g = pg8::Gemm{(const bf16*)(F.ws + WS_O1), (const bf16*)(F.ws + WS_WO1), ML, DM, DM}; ea = pg8::EpiAny{2, F.out, (void*)F.out, ctxres, mod + 3 * 6144 + 2048, 0, 0}; break;
        case 17: if (!((PHASE_MASK >> 17) & 1)) break; norm_phase(F, F.out, ctxres, ML, ARG(7) + DM, 1, 1, false); break;
        case 18: if (!((PHASE_MASK >> 18) & 1)) break; gk = 1; g = pg8::Gemm{(const bf16*)(F.ws + WS_XN), (const bf16*)(F.ws + WS_W1_1), ML, FF, DM}; ea = pg8::EpiAny{1, nullptr, (void*)(F.ws + WS_H), nullptr, nullptr, FF, 1}; break;
        case 19: if (!((PHASE_MASK >> 19) & 1)) break; gk = 2; g = pg8::Gemm{(const bf16*)(F.ws + WS_H), (const bf16*)(F.ws + WS_W2_1), ML, DM, FF}; ea = pg8::EpiAny{2, F.out, (void*)F.out, ctxres, mod + 3 * 6144 + 5120, 0, 0}; break;
        default: break;
        }
        if (gk != 0) { pg8::StaticOrder S; S.init(g.M, g.N, g.K, F.G, F.bx, xrows, xS); pg8::gemm_phase<pg8::EpiAny, pg8::StaticOrder, true, true>(F.lds + RING_OFF, g, S, ea, F.tid); }
        const bool last_ = (ph == args.ph_hi - 1) && ((ph2 & 1) || !((PHASE_REP >> ph) & 1));
        if (!MK_PER_PHASE && !last_ && ph != 12) xcd_barrier(bar);
        else __syncthreads();
    }
}

extern "C" void kernel_launch(void* const* d_in, const int* in_sizes, int n_in, void* d_out, int out_size, void* d_ws, size_t ws_size, hipStream_t stream) {
    static int grid = 0;
    if (grid == 0) {
        if (n_in != 28 || in_sizes[0] != ML * DM || out_size != ML * DM || ws_size < WS_END) { fprintf(stderr, "kernel_launch: unexpected shapes: n_in %d in0 %d out %d ws %zu\n", n_in, n_in > 0 ? in_sizes[0] : -1, out_size, ws_size); grid = -1; return; }
        int dev = 0, cus = 0, per_cu = 0;
        if (hipGetDevice(&dev) != hipSuccess || hipDeviceGetAttribute(&cus, hipDeviceAttributeMultiprocessorCount, dev) != hipSuccess) { fprintf(stderr, "kernel_launch: device query failed\n"); grid = -1; return; }
        if (hipFuncSetAttribute((const void*)fwd_kernel, hipFuncAttributeMaxDynamicSharedMemorySize, LDS_BYTES) != hipSuccess) { fprintf(stderr, "kernel_launch: hipFuncSetAttribute failed\n"); grid = -1; return; }
        if (hipOccupancyMaxActiveBlocksPerMultiprocessor(&per_cu, (const void*)fwd_kernel, NWAVES * 64, LDS_BYTES) != hipSuccess || per_cu < 1)
            fprintf(stderr, "kernel_launch: note: occupancy query reports %d workgroups per CU\n", per_cu);
        (void)hipGetLastError();
        grid = cus;
    }
    if (grid < 0) return;
    if (hipMemsetAsync((char*)d_ws + WS_CTL, 0, CTL_ZERO_BYTES, stream) != hipSuccess) { fprintf(stderr, "kernel_launch: hipMemsetAsync failed\n"); return; }
    Args a{};
    for (int i = 0; i < 28; ++i) a.in[i] = (const float*)d_in[i];
    a.out = (float*)d_out; a.ws = (unsigned char*)d_ws;
#if MK_PER_PHASE
    for (int ph = 0; ph <= N_PHASES; ++ph) { a.ph_lo = ph; a.ph_hi = ph + 1; hipLaunchKernelGGL(fwd_kernel, dim3(grid), dim3(NWAVES * 64), LDS_BYTES, stream, a); }
#else
    a.ph_lo = 0; a.ph_hi = N_PHASES + 1;
    hipLaunchKernelGGL(fwd_kernel, dim3(grid), dim3(NWAVES * 64), LDS_BYTES, stream, a);
#endif
    const hipError_t le = hipPeekAtLastError();
    if (le != hipSuccess) fprintf(stderr, "kernel_launch: launch failed: %s\n", hipGetErrorName(le));
}
```

```cpp
#include <hip/hip_runtime.h>
#include <cstdio>
#include <cstdint>
namespace pg8 {
#define PG8_LAS __attribute__((address_space(3)))
typedef unsigned short bf16_t;
typedef short bf16x8 __attribute__((ext_vector_type(8)));
typedef float f32x4 __attribute__((ext_vector_type(4)));
typedef unsigned u32x4 __attribute__((ext_vector_type(4)));
typedef unsigned u32x2 __attribute__((ext_vector_type(2)));
typedef unsigned u32x6 __attribute__((ext_vector_type(6)));
typedef unsigned u32x16 __attribute__((ext_vector_type(16)));
typedef __bf16 bf16x32 __attribute__((ext_vector_type(32)));
constexpr int BM = 256, BK = 64, HALF = 128, HTB = HALF * BK * 2  , STAGE_BYTES = 8 * HTB, NXCD = 8, WGM = 8;

__host__ __device__ __forceinline__ int lds_byte(int r, int c) { const int st = (r >> 4) * 2 + (c >> 5), rr = r & 15, cc = c & 31, ob = rr * 64 + cc * 2; return st * 1024 + (ob ^ (((ob >> 9) & 1) << 5)); }
__host__ __device__ __forceinline__ void stage_rc(int b, int& R, int& C) { const int st = b / 1024, sb = b % 1024, swz = sb ^ (((sb >> 9) & 1) << 5); R = (st >> 1) * 16 + swz / 64; C = (st & 1) * 32 + (swz % 64) / 2; }
__host__ __device__ __forceinline__ int perm32(int rho) { const int n = rho >> 4, i = rho & 15; return 8 * (i >> 2) + 4 * n + (i & 3); }

struct Unit { int pm, pn, kinfo; };
struct Gemm { const bf16_t* A; const bf16_t* Bt; int M, N, K; };

struct StaticOrder {
    int nM, nN, nwg, G, c, ntK;
    int xtiles, xsh;
    __host__ __device__ void init(int M, int N, int K, int G_, int c_, int extra_rows = 0, int S = 1) { nM = M / BM; nN = N / BM; nwg = nM * nN; G = G_; c = c_; ntK = K / BK;
        xtiles = (extra_rows / BM) * nN; xsh = S; }
    __host__ __device__ bool next(int i, Unit& u) const {
        const long L = (long)i * G + c;
        if (L >= nwg) {
            if (xtiles == 0) return false;
            const int nb = (nwg - c + G - 1) / G;
            const int nbc = c < nwg ? nb : 0;
            const long e = (long)(i - nbc) * G + ((c + G - (nwg % G)) % G);
            if (e >= ((long)xtiles << xsh)) return false;
            const int tile = (int)(e >> xsh), ks = (int)e & ((1 << xsh) - 1), xnt = ntK >> xsh;
            u.pm = nM + tile / nN; u.pn = tile % nN; u.kinfo = (ks * xnt) | (xnt << 8) | (1 << 16); return true;
        }
        int wgid = (int)L; { const int q = nwg / NXCD, r = nwg % NXCD, xcd = wgid % NXCD, off = wgid / NXCD; wgid = (xcd < r ? xcd * (q + 1) : r * (q + 1) + (xcd - r) * q) + off; }
        const int nig = WGM * nN, gid = wgid / nig, fm = gid * WGM, gsz = (nM - fm) < WGM ? (nM - fm) : WGM;
        u.pm = fm + ((wgid % nig) % gsz); u.pn = (wgid % nig) / gsz; u.kinfo = ntK << 8; return true;
    }
    __device__ __forceinline__ void a_ready(const Unit&) const {}
    __device__ __forceinline__ void done(const Unit&) const {}
};

__device__ __forceinline__ unsigned cvt_pk_bf16(float lo, float hi) { unsigned r; asm volatile("v_cvt_pk_bf16_f32 %0, %1, %2" : "=v"(r) : "v"(lo), "v"(hi)); return r; }
struct EpiAny {
    static constexpr bool AFTER_DRAIN = false;
    int mode; const float* base; void* out; float* ctxres; const float* gate; int ldc, relu2; PG8_LAS unsigned char* scr = nullptr;
    __device__ __forceinline__ bool perm() const { return mode == 1; }
    __device__ __forceinline__ bool headmode() const { return mode == 3; }
    __device__ __forceinline__ static float xsh(float v, int mask, int lane) { return __builtin_bit_cast(float, __builtin_amdgcn_ds_bpermute((lane ^ mask) << 2, __builtin_bit_cast(int, v))); }
    __device__ __forceinline__ void head_epilogue(const f32x4 (&acc)[2][2][4][2], const Unit& u, int wr, int wc, int fr, int fq) const {
        const int H = 4 * u.pn + wc, kind = relu2, lane = fr + 16 * fq;
        const bool f6 = kind != 0 && base[448] != 0.f;
        int cls, gsel; float qs = 1.f;
        if (kind == 0) { if (H < 8) { cls = 2; gsel = 0; qs = 0.125f * 1.4426950408889634f; } else if (H < 10) { cls = 2; gsel = 1; } else if (H < 12) { cls = 0; gsel = 0; }
                         else if (H < 20) { cls = 1; gsel = 2; qs = 0.125f * 1.4426950408889634f; } else if (H < 28) { cls = 1; gsel = 3; } else { cls = 0; gsel = 0; } }
        else if (kind == 1) { qs = f6 ? 1.5349124f : 0.10206207261596575f * 1.4426950408889634f; if (H < 16) { cls = 1; gsel = 4; } else { cls = 3; gsel = 5; } }
        else { if (H < 16) { cls = 1; gsel = 6; if (f6) qs = 1.5349124f; } else { cls = 0; gsel = 0; } }
        const bool lat = u.pm < 64;
        const bool k6 = f6 && kind == 2 && H < 16;
        bf16_t* O = (bf16_t*)out;
        const int col0 = u.pn * BM + 64 * wc + 8 * fq;
        f32x4 gv[2][2];
#pragma unroll
        for (int bj = 0; bj < 2; ++bj)
#pragma unroll
            for (int n = 0; n < 2; ++n) gv[bj][n] = *(const f32x4*)(base + gsel * 64 + 32 * bj + 8 * fq + 4 * n);
#pragma unroll
        for (int ai = 0; ai < 2; ++ai)
#pragma unroll
            for (int m = 0; m < 4; ++m) {
                const int row = u.pm * BM + ai * HALF + wr * 64 + m * 16 + fr;
                f32x4 v[2][2];
#pragma unroll
                for (int bj = 0; bj < 2; ++bj)
#pragma unroll
                    for (int n = 0; n < 2; ++n) v[bj][n] = acc[ai][bj][m][n];
                if (cls != 0) {
                    float s0 = 0.f, s1 = 0.f;
#pragma unroll
                    for (int n = 0; n < 2; ++n)
#pragma unroll
                        for (int e = 0; e < 4; ++e) { s0 += v[0][n][e] * v[0][n][e]; s1 += v[1][n][e] * v[1][n][e]; }
                    if (cls != 3) { s0 += s1; s0 += xsh(s0, 16, lane); s0 += xsh(s0, 32, lane); s0 = s0 * (1.f / 64.f); s1 = s0; }
                    else { s0 += xsh(s0, 16, lane); s0 += xsh(s0, 32, lane); s1 += xsh(s1, 16, lane); s1 += xsh(s1, 32, lane); s0 *= (1.f / 32.f); s1 *= (1.f / 32.f); }
                    const float r0 = 1.f / sqrtf(s0 + 1e-6f), r1 = 1.f / sqrtf(s1 + 1e-6f);
#pragma unroll
                    for (int n = 0; n < 2; ++n) { v[0][n] = v[0][n] * r0 * gv[0][n]; v[1][n] = v[1][n] * r1 * gv[1][n]; }
                    if (lat && cls == 2) {
                        const int t = row & 8191;
#pragma unroll
                        for (int bj = 0; bj < 2; ++bj) { const int pos = bj == 0 ? (t >> 6) : (t & 63); const float sgn = fq < 2 ? -1.f : 1.f;
#pragma unroll
                            for (int n = 0; n < 2; ++n) { const float* cs = gate + pos * 16 + 8 * (fq & 1) + 4 * n; const f32x4 c = *(const f32x4*)cs, sn = *(const f32x4*)(cs + 2048);
                                f32x4 p;
#pragma unroll
                                for (int e = 0; e < 4; ++e) p[e] = xsh(v[bj][n][e], 32, lane);
                                v[bj][n] = v[bj][n] * c + (p * sgn) * sn; } }
                    }
                    if (lat && cls == 3) {
                        const int t = row & 8191; const int pos = fq < 2 ? (t >> 6) : (t & 63); const float sgn = (fq & 1) ? 1.f : -1.f;
#pragma unroll
                        for (int bj = 0; bj < 2; ++bj)
#pragma unroll
                            for (int n = 0; n < 2; ++n) { const float* cs = gate + 4096 + pos * 8 + 4 * n; const f32x4 c = *(const f32x4*)cs, sn = *(const f32x4*)(cs + 1024);
                                f32x4 p;
#pragma unroll
                                for (int e = 0; e < 4; ++e) p[e] = xsh(v[bj][n][e], 16, lane);
                                v[bj][n] = v[bj][n] * c + (p * sgn) * sn; }
                    }
                    if (qs != 1.f) {
#pragma unroll
                        for (int bj = 0; bj < 2; ++bj)
#pragma unroll
                            for (int n = 0; n < 2; ++n) v[bj][n] = v[bj][n] * qs; }
                }
                if (k6) {
                    PG8_LAS unsigned char* sw = scr + (wr * 4 + wc) * 1024 + fr * 64;
                    unsigned char* img = (unsigned char*)ctxres + ((size_t)(row >> 6) * 16 + H) * 3072;
                    const int key = row & 63;
#pragma unroll
                    for (int bj = 0; bj < 2; ++bj) {
                        u32x4 w; w.x = cvt_pk_bf16(v[bj][0][0], v[bj][0][1]); w.y = cvt_pk_bf16(v[bj][0][2], v[bj][0][3]); w.z = cvt_pk_bf16(v[bj][1][0], v[bj][1][1]); w.w = cvt_pk_bf16(v[bj][1][2], v[bj][1][3]);
                        *(PG8_LAS u32x4*)(sw + fq * 16) = w;
                        asm volatile("s_waitcnt lgkmcnt(0)" ::: "memory");
                        if (fq == 0) {
                            const u32x4 a0 = *(PG8_LAS u32x4*)(sw), a1 = *(PG8_LAS u32x4*)(sw + 16), a2 = *(PG8_LAS u32x4*)(sw + 32), a3 = *(PG8_LAS u32x4*)(sw + 48);
                            const u32x16 all = {a0.x, a0.y, a0.z, a0.w, a1.x, a1.y, a1.z, a1.w, a2.x, a2.y, a2.z, a2.w, a3.x, a3.y, a3.z, a3.w};
                            const u32x6 c = __builtin_amdgcn_cvt_scalef32_pk32_fp6_bf16(__builtin_bit_cast(bf16x32, all), 1.0f);
                            *(u32x4*)(img + bj * 1024 + key * 16) = (u32x4){c[0], c[1], c[2], c[3]};
                            *(u32x2*)(img + 2048 + bj * 512 + key * 8) = (u32x2){c[4], c[5]};
                        }
                        asm volatile("s_waitcnt lgkmcnt(0)" ::: "memory");
                    }
                    continue;
                }
                bf16_t* rowp = O + (size_t)row * ldc + col0;
#pragma unroll
                for (int bj = 0; bj < 2; ++bj) { u32x4 w; w.x = cvt_pk_bf16(v[bj][0][0], v[bj][0][1]); w.y = cvt_pk_bf16(v[bj][0][2], v[bj][0][3]); w.z = cvt_pk_bf16(v[bj][1][0], v[bj][1][1]); w.w = cvt_pk_bf16(v[bj][1][2], v[bj][1][3]);
                    *(u32x4*)(rowp + 32 * bj) = w; }
            }
    }
    __device__ __forceinline__ void operator()(const f32x4 (&acc)[2][2][4][2], const Unit& u, int wr, int wc, int fr, int fq) const {
        asm volatile("" : "+v"(fr), "+v"(fq));
        if (mode == 1) {
            bf16_t* O = (bf16_t*)out;
            const int row0 = u.pm * BM + wr * 64 + fr, col0 = u.pn * BM + wc * 32 + 8 * fq;
#pragma unroll
            for (int ai = 0; ai < 2; ++ai)
#pragma unroll
                for (int m = 0; m < 4; ++m) { bf16_t* rowp = O + (size_t)(row0 + ai * HALF + m * 16) * ldc + col0;
#pragma unroll
                    for (int bj = 0; bj < 2; ++bj) { f32x4 v0 = acc[ai][bj][m][0], v1 = acc[ai][bj][m][1];
                        if (relu2) {
#pragma unroll
                            for (int e = 0; e < 4; ++e) { float a = fmaxf(v0[e], 0.f), b = fmaxf(v1[e], 0.f); v0[e] = a * a; v1[e] = b * b; } }
                        u32x4 w; w.x = cvt_pk_bf16(v0[0], v0[1]); w.y = cvt_pk_bf16(v0[2], v0[3]); w.z = cvt_pk_bf16(v1[0], v1[1]); w.w = cvt_pk_bf16(v1[2], v1[3]);
                        *(u32x4*)(rowp + bj * HALF) = w; } }
            return;
        }
        if (mode == 3) { head_epilogue(acc, u, wr, wc, fr, fq); return; }
        const int t0 = u.pm * BM; const bool split = (u.kinfo >> 16) != 0; const int cond = t0 < 8192 ? 0 : (t0 < 16384 ? 1 : 2);
        const int col0 = u.pn * BM + wc * 32 + 4 * fq; const float* g = gate + cond * 6144 + col0;
        f32x4 gv[2][2];
#pragma unroll
        for (int bj = 0; bj < 2; ++bj)
#pragma unroll
            for (int n = 0; n < 2; ++n) gv[bj][n] = *(const f32x4*)(g + bj * HALF + n * 16);
        if (split) {
            const int ks = (u.kinfo & 255) / ((u.kinfo >> 8) & 255);
            float* op = ctxres + (size_t)ks * (512 * 1024) + (size_t)(t0 - 16384) * 1024;
#pragma unroll
            for (int ai = 0; ai < 2; ++ai)
#pragma unroll
                for (int m = 0; m < 4; ++m) { const size_t off = (size_t)(wr * 64 + fr + ai * HALF + m * 16) * 1024 + col0;
#pragma unroll
                    for (int bj = 0; bj < 2; ++bj)
#pragma unroll
                        for (int n = 0; n < 2; ++n) *(f32x4*)(op + off + bj * HALF + n * 16) = gv[bj][n] * acc[ai][bj][m][n]; }
            return;
        }
        const float* bp = base + (size_t)t0 * 1024; float* op = (float*)out + (size_t)t0 * 1024;
#pragma unroll
        for (int ai = 0; ai < 2; ++ai)
#pragma unroll
            for (int m = 0; m < 4; ++m) { const size_t off = (size_t)(wr * 64 + fr + ai * HALF + m * 16) * 1024 + col0;
#pragma unroll
                for (int bj = 0; bj < 2; ++bj)
#pragma unroll
                    for (int n = 0; n < 2; ++n) { const f32x4 b = *(const f32x4*)(bp + off + bj * HALF + n * 16);
                        *(f32x4*)(op + off + bj * HALF + n * 16) = b + gv[bj][n] * acc[ai][bj][m][n]; } }
    }
};

template <class Epi, class Sched, bool ALIGN_EPI = false, bool SP2 = false>
__device__ __forceinline__ void gemm_phase(PG8_LAS unsigned char* lds, const Gemm g, const Sched& S, const Epi& E, const int tid) {
    const int wid = __builtin_amdgcn_readfirstlane(tid >> 6), lane = tid & 63, wr = wid >> 2, wc = wid & 3, fr = lane & 15, fq = lane >> 4;
    const int K = g.K;
    unsigned voffA[2], voffB[2];
#pragma unroll
    for (int i = 0; i < 2; ++i) { int R, C; stage_rc(tid * 16 + i * 8192, R, C); const int Rb = E.headmode() ? (64 * (R >> 5) + perm32(R & 31)) : (E.perm() ? ((R & ~31) + perm32(R & 31)) : R);
        voffA[i] = (unsigned)(R * K + C) * 2u; voffB[i] = (unsigned)(Rb * K + C) * 2u; }
    const size_t kstep = (size_t)(BK * 2);
    const size_t hstep = (size_t)HALF * K * 2;
    const size_t tstep = 2 * hstep;
    const size_t hstepB = E.headmode() ? (size_t)32 * K * 2 : hstep;
    const unsigned ldsw = (unsigned)wid * 1024u;
    const int aoff = lds_byte(wr * 64 + fr, fq * 8), boff = lds_byte(wc * 32 + fr, fq * 8);
#define PG8_SA(b, h) (((b) * 2 + (h)) * HTB)
#define PG8_SB(b, h) ((4 + (b) * 2 + (h)) * HTB)
#define PG8_STAGE(bufoff, gbase, voff) do { _Pragma("unroll") for (int _i = 0; _i < 2; ++_i) \
        __builtin_amdgcn_global_load_lds((const unsigned*)((const char*)(gbase) + (voff)[_i]), (PG8_LAS unsigned*)(lds + (bufoff) + ldsw + _i * 8192), 16, 0, 0); } while (0)
#define PG8_LDA(dst, b, h) do { _Pragma("unroll") for (int m = 0; m < 4; ++m) _Pragma("unroll") for (int k = 0; k < 2; ++k) dst[m][k] = *(const PG8_LAS bf16x8*)(lds + PG8_SA(b, h) + aoff + m * 2048 + k * 1024); } while (0)
#define PG8_LDB(dst, b, h) do { _Pragma("unroll") for (int n = 0; n < 2; ++n) _Pragma("unroll") for (int k = 0; k < 2; ++k) dst[n][k] = *(const PG8_LAS bf16x8*)(lds + PG8_SB(b, h) + boff + n * 2048 + k * 1024); } while (0)
#define PG8_MMA(ai, bj, At, Bt) do { __builtin_amdgcn_s_setprio(1); _Pragma("unroll") for (int m = 0; m < 4; ++m) _Pragma("unroll") for (int n = 0; n < 2; ++n) _Pragma("unroll") for (int k = 0; k < 2; ++k) \
        acc[ai][bj][m][n] = __builtin_amdgcn_mfma_f32_16x16x32_bf16(Bt[n][k], At[m][k], acc[ai][bj][m][n], 0, 0, 0); __builtin_amdgcn_s_setprio(0); } while (0)
#define PG8_WAIT_V(n) asm volatile("s_waitcnt vmcnt(" #n ")" ::: "memory")
#define PG8_WAIT_L(n) asm volatile("s_waitcnt lgkmcnt(" #n ")" ::: "memory")
#define PG8_BAR __builtin_amdgcn_s_barrier()
#define PG8_SCHED __builtin_amdgcn_sched_barrier(0)
    Unit cur, nxt; int ui = 0;
    if (!S.next(0, cur)) return;
    f32x4 acc[2][2][4][2];
#pragma unroll
    for (int a = 0; a < 2; ++a)
#pragma unroll
        for (int b = 0; b < 2; ++b)
#pragma unroll
            for (int m = 0; m < 4; ++m)
#pragma unroll
                for (int n = 0; n < 2; ++n) acc[a][b][m][n] = (f32x4){0.f, 0.f, 0.f, 0.f};
    bf16x8 At[4][2], B0[2][2], B1[2][2];
    const char* cA = (const char*)g.A + (size_t)cur.pm * tstep + (size_t)(cur.kinfo & 255) * (BK * 2); const char* cB = (const char*)g.Bt + (size_t)cur.pn * tstep + (size_t)(cur.kinfo & 255) * (BK * 2);
    S.a_ready(cur);
    if constexpr (SP2) {
        PG8_STAGE(PG8_SB(0, 0), cB, voffB); PG8_STAGE(PG8_SB(0, 1), cB + hstepB, voffB); PG8_STAGE(PG8_SA(0, 0), cA, voffA); PG8_STAGE(PG8_SA(0, 1), cA + hstep, voffA);
        if (wr == 1) PG8_BAR;
        PG8_WAIT_V(2); PG8_BAR;
        PG8_STAGE(PG8_SB(1, 0), cB + kstep, voffB); PG8_STAGE(PG8_SA(1, 0), cA + kstep, voffA); PG8_STAGE(PG8_SB(1, 1), cB + hstepB + kstep, voffB);
        PG8_WAIT_V(6); PG8_BAR;
    } else {
        PG8_STAGE(PG8_SB(0, 0), cB, voffB); PG8_STAGE(PG8_SA(0, 0), cA, voffA); PG8_STAGE(PG8_SB(0, 1), cB + hstepB, voffB); PG8_STAGE(PG8_SA(0, 1), cA + hstep, voffA);
        if (wr == 1) PG8_BAR;
        PG8_WAIT_V(4); PG8_BAR;
        PG8_STAGE(PG8_SB(1, 0), cB + kstep, voffB); PG8_STAGE(PG8_SA(1, 0), cA + kstep, voffA); PG8_STAGE(PG8_SB(1, 1), cB + hstepB + kstep, voffB);
        PG8_WAIT_V(6); PG8_BAR;
    }
    for (;;) {
        const bool has_next = S.next(ui + 1, nxt);
        const char* nA = has_next ? (const char*)g.A + (size_t)nxt.pm * tstep + (size_t)(nxt.kinfo & 255) * (BK * 2) : cA; const char* nB = has_next ? (const char*)g.Bt + (size_t)nxt.pn * tstep + (size_t)(nxt.kinfo & 255) * (BK * 2) : cB;
        const int nt = (cur.kinfo >> 8) & 255;
        for (int t = 0; t < nt; t += 2) {
            const bool last = (t == nt - 2);
            const char* a1 = cA + (size_t)(t + 1) * kstep;
            const char* a2 = last ? nA : cA + (size_t)(t + 2) * kstep; const char* b2 = last ? nB : cB + (size_t)(t + 2) * kstep;
            const char* a3 = a2 + kstep; const char* b3 = b2 + kstep;
            if (last && has_next) S.a_ready(nxt);
            if constexpr (SP2) {
            PG8_LDB(B0, 0, 0); PG8_LDB(B1, 0, 1); PG8_SCHED; PG8_LDA(At, 0, 0); PG8_STAGE(PG8_SA(1, 1), a1 + hstep, voffA);
            PG8_WAIT_V(8); PG8_WAIT_L(0); PG8_BAR; PG8_MMA(0, 0, At, B0); PG8_MMA(0, 1, At, B1); PG8_BAR; PG8_SCHED;
            PG8_LDA(At, 0, 1); PG8_STAGE(PG8_SB(0, 0), b2, voffB); PG8_STAGE(PG8_SB(0, 1), b2 + hstepB, voffB); PG8_STAGE(PG8_SA(0, 0), a2, voffA);
            PG8_WAIT_V(8); PG8_WAIT_L(0); PG8_BAR; PG8_MMA(1, 0, At, B0); PG8_MMA(1, 1, At, B1); PG8_BAR; PG8_SCHED;
            PG8_LDB(B0, 1, 0); PG8_LDB(B1, 1, 1); PG8_SCHED; PG8_LDA(At, 1, 0); PG8_STAGE(PG8_SA(0, 1), a2 + hstep, voffA);
            PG8_WAIT_V(8); PG8_WAIT_L(0); PG8_BAR; PG8_MMA(0, 0, At, B0); PG8_MMA(0, 1, At, B1); PG8_BAR; PG8_SCHED;
            PG8_LDA(At, 1, 1); PG8_STAGE(PG8_SB(1, 0), b3, voffB); PG8_STAGE(PG8_SB(1, 1), b3 + hstepB, voffB); PG8_STAGE(PG8_SA(1, 0), a3, voffA);
            PG8_WAIT_V(8); PG8_WAIT_L(0); PG8_BAR; PG8_MMA(1, 0, At, B0); PG8_MMA(1, 1, At, B1); PG8_BAR; PG8_SCHED;
            } else {
            PG8_LDB(B0, 0, 0); PG8_SCHED; PG8_LDA(At, 0, 0); PG8_STAGE(PG8_SA(1, 1), a1 + hstep, voffA);
            PG8_WAIT_L(8); PG8_BAR; PG8_WAIT_L(0); PG8_MMA(0, 0, At, B0); PG8_BAR; PG8_SCHED;
            PG8_LDB(B1, 0, 1); PG8_STAGE(PG8_SB(0, 0), b2, voffB);
            PG8_BAR; PG8_WAIT_L(0); PG8_MMA(0, 1, At, B1); PG8_BAR;
            PG8_LDA(At, 0, 1); PG8_STAGE(PG8_SA(0, 0), a2, voffA);
            PG8_BAR; PG8_WAIT_L(0); PG8_MMA(1, 0, At, B0); PG8_BAR; PG8_SCHED;
            PG8_STAGE(PG8_SB(0, 1), b2 + hstepB, voffB);
            PG8_WAIT_V(6); PG8_BAR; PG8_MMA(1, 1, At, B1); PG8_BAR;
            PG8_LDB(B0, 1, 0); PG8_SCHED; PG8_LDA(At, 1, 0); PG8_STAGE(PG8_SA(0, 1), a2 + hstep, voffA);
            PG8_WAIT_L(8); PG8_BAR; PG8_WAIT_L(0); PG8_MMA(0, 0, At, B0); PG8_BAR; PG8_SCHED;
            PG8_LDB(B1, 1, 1); PG8_STAGE(PG8_SB(1, 0), b3, voffB);
            PG8_BAR; PG8_WAIT_L(0); PG8_MMA(0, 1, At, B1); PG8_BAR;
            PG8_LDA(At, 1, 1); PG8_STAGE(PG8_SA(1, 0), a3, voffA);
            PG8_BAR; PG8_WAIT_L(0); PG8_MMA(1, 0, At, B0); PG8_BAR; PG8_SCHED;
            PG8_STAGE(PG8_SB(1, 1), b3 + hstepB, voffB);
            PG8_WAIT_V(6); PG8_BAR; PG8_MMA(1, 1, At, B1); PG8_BAR;
            }
        }
        if constexpr (ALIGN_EPI) { if (wr == 0) PG8_BAR; }
        if constexpr (!Epi::AFTER_DRAIN) { E(acc, cur, wr, wc, fr, fq); S.done(cur); }
        if (!has_next) break;
#pragma unroll
        for (int a = 0; a < 2; ++a)
#pragma unroll
            for (int b = 0; b < 2; ++b)
#pragma unroll
                for (int m = 0; m < 4; ++m)
#pragma unroll
                    for (int n = 0; n < 2; ++n) acc[a][b][m][n] = (f32x4){0.f, 0.f, 0.f, 0.f};
        cur = nxt; cA = nA; cB = nB; ++ui;
        if constexpr (ALIGN_EPI) { if (wr == 1) PG8_BAR; }
    }
    PG8_WAIT_V(0);
    if constexpr (!ALIGN_EPI) { if (wr == 0) PG8_BAR; }
    PG8_BAR;
    if constexpr (Epi::AFTER_DRAIN) { E.fused(acc, cur, wr, wc, fr, fq, lds, wid, lane); S.done(cur); }
#undef PG8_SA
#undef PG8_SB
#undef PG8_STAGE
#undef PG8_LDA
#undef PG8_LDB
#undef PG8_MMA
#undef PG8_WAIT_V
#undef PG8_WAIT_L
#undef PG8_BAR
#undef PG8_SCHED
}
}
namespace att {
#define ATT_LAS __attribute__((address_space(3)))
typedef unsigned short bf16;
typedef short bf16x8 __attribute__((ext_vector_type(8)));
typedef short s16x4 __attribute__((ext_vector_type(4)));
typedef float f32x16 __attribute__((ext_vector_type(16)));
typedef unsigned u32x4 __attribute__((ext_vector_type(4)));
typedef ATT_LAS char lchar;
constexpr int KBUF = 12288, VBUF = 16384;
constexpr int L_K = 0, L_V = 2 * KBUF, L_WS = L_V + 2 * VBUF, L_RPB = L_WS + 2048, L_END = L_RPB + 2048;
constexpr float LOG2E = 1.4426950408889634f;
#define ATT_SBAR() __builtin_amdgcn_sched_barrier(0)
__device__ __forceinline__ int crow(int r, int hi) { return (r & 3) + 8 * (r >> 2) + 4 * hi; }
__device__ __forceinline__ unsigned cvtpk(float lo, float hi) { unsigned r; asm volatile("v_cvt_pk_bf16_f32 %0, %1, %2" : "=v"(r) : "v"(lo), "v"(hi)); return r; }
__device__ __forceinline__ int v_st(int k, int c) { const int kk = (k & ~0xC) | ((k & 4) << 1) | ((k & 8) >> 1); return ((kk >> 3) * 4 + (c >> 5)) * 512 + ((kk & 7) * 32 + (c & 31)) * 2; }
__device__ __forceinline__ int v_rd_base(int lane) { return ((lane & 3) << 3) | (((lane >> 2) & 3) << 6) | (((lane >> 4) & 1) << 5) | (((lane >> 5) & 1) << 8); }
constexpr int v_rd_off(int d0, int ks, int half) { return d0 * 512 + ks * 4096 + half * 2048; }
template <int OFF> __device__ __forceinline__ s16x4 tr_read(unsigned vb) {
  s16x4 r; asm volatile("ds_read_b64_tr_b16 %0, %1 offset:%2" : "=&v"(r) : "v"(vb), "i"(OFF) : "memory"); return r;
}
template <int D0> __device__ __forceinline__ void pv_one(f32x16& od, unsigned vb, bf16x8 pa0, bf16x8 pa1, bf16x8 pa2, bf16x8 pa3) {
  const s16x4 l0 = tr_read<v_rd_off(D0, 0, 0)>(vb), h0 = tr_read<v_rd_off(D0, 0, 1)>(vb), l1 = tr_read<v_rd_off(D0, 1, 0)>(vb), h1 = tr_read<v_rd_off(D0, 1, 1)>(vb);
  const s16x4 l2 = tr_read<v_rd_off(D0, 2, 0)>(vb), h2 = tr_read<v_rd_off(D0, 2, 1)>(vb), l3 = tr_read<v_rd_off(D0, 3, 0)>(vb), h3 = tr_read<v_rd_off(D0, 3, 1)>(vb);
  asm volatile("s_waitcnt lgkmcnt(0)" ::: "memory"); ATT_SBAR();
#define ATT_PK(L, H) (bf16x8){L[0], L[1], L[2], L[3], H[0], H[1], H[2], H[3]}
  od = __builtin_amdgcn_mfma_f32_32x32x16_bf16(pa0, ATT_PK(l0, h0), od, 0, 0, 0);
  od = __builtin_amdgcn_mfma_f32_32x32x16_bf16(pa1, ATT_PK(l1, h1), od, 0, 0, 0);
  od = __builtin_amdgcn_mfma_f32_32x32x16_bf16(pa2, ATT_PK(l2, h2), od, 0, 0, 0);
  od = __builtin_amdgcn_mfma_f32_32x32x16_bf16(pa3, ATT_PK(l3, h3), od, 0, 0, 0);
#undef ATT_PK
}

template <int DKC, class U>
__device__ __forceinline__ void unit(const U& u, lchar* lds, int tid) {
  asm volatile("" : "+v"(tid));
  const int lane = tid & 63, r32 = lane & 31, hi = lane >> 5;
  const int wid = __builtin_amdgcn_readfirstlane(tid >> 6);
  lchar* Kl = lds + L_K; lchar* Vl = lds + L_V;
  ATT_LAS float* ws = (ATT_LAS float*)(lds + L_WS) + wid * 64;
  bf16x8 qr[DKC / 2];
#pragma unroll
  for (int d0 = 0; d0 < DKC / 2; ++d0) qr[d0] = *(const bf16x8*)u.qptr(wid, r32, d0, hi);
  const int vrow = tid >> 3, vch = tid & 7, vst = v_st(vrow, vch * 8);
  const int krow0 = tid & 63, kch0 = tid >> 6;
  const bool k2 = (DKC > 8) && (tid < 64 * (DKC - 8));
  const unsigned vb0 = (unsigned)(uintptr_t)Vl + (unsigned)v_rd_base(lane);
  bf16x8 kst0, kst1 = {}, vstr;
  const int NT = u.nt();
#define ATT_SLOAD(t) do { const long R_ = u.krow(t); kst0 = *(const bf16x8*)u.kptr(R_ + krow0, kch0); if (k2) kst1 = *(const bf16x8*)u.kptr(R_ + krow0, 8 + kch0); \
    vstr = *(const bf16x8*)u.vptr(R_ + vrow, vch); } while (0)
#define ATT_SWRITE(b) do { *(ATT_LAS bf16x8*)(Kl + (b) * KBUF + kch0 * 1024 + krow0 * 16) = kst0; if (k2) *(ATT_LAS bf16x8*)(Kl + (b) * KBUF + (8 + kch0) * 1024 + krow0 * 16) = kst1; \
    *(ATT_LAS bf16x8*)(Vl + (b) * VBUF + vst) = vstr; } while (0)
  float m_reg = -1e30f, l_reg = 0.f; f32x16 o[2]; o[0] = f32x16{}; o[1] = f32x16{};
  ATT_SLOAD(0); ATT_SWRITE(0); __syncthreads();
  for (int t = 0; t < NT; ++t) {
    const int buf = t & 1;
    if (t + 1 < NT) ATT_SLOAD(t + 1);
    if (!u.skip(t, wid)) {
      f32x16 p0 = f32x16{}, p1 = f32x16{};
      { const lchar* kb = Kl + buf * KBUF + hi * 1024 + r32 * 16;
#pragma unroll
        for (int d0 = 0; d0 < DKC / 2; ++d0) {
          const bf16x8 b0 = *(const ATT_LAS bf16x8*)(kb + d0 * 2048);
          const bf16x8 b1 = *(const ATT_LAS bf16x8*)(kb + d0 * 2048 + 512);
          p0 = __builtin_amdgcn_mfma_f32_32x32x16_bf16(b0, qr[d0], p0, 0, 0, 0);
          p1 = __builtin_amdgcn_mfma_f32_32x32x16_bf16(b1, qr[d0], p1, 0, 0, 0); } }
      u.mask(p0, p1, t, wid, r32, hi);
      float pmax = p0[0];
#pragma unroll
      for (int r = 1; r < 16; ++r) pmax = fmaxf(pmax, p0[r]);
#pragma unroll
      for (int r = 0; r < 16; ++r) pmax = fmaxf(pmax, p1[r]);
      { auto rr = __builtin_amdgcn_permlane32_swap(__float_as_uint(pmax), __float_as_uint(pmax), false, false);
        pmax = fmaxf(__uint_as_float(rr[0]), __uint_as_float(rr[1])); }
      const float mn = fmaxf(m_reg, pmax);
      const float alpha = __builtin_amdgcn_exp2f(m_reg - mn);
      m_reg = mn;
#pragma unroll
      for (int r = 0; r < 16; ++r) { p0[r] = __builtin_amdgcn_exp2f(p0[r] - mn); p1[r] = __builtin_amdgcn_exp2f(p1[r] - mn); }
      float ps = 0.f;
#pragma unroll
      for (int r = 0; r < 16; ++r) ps += p0[r];
#pragma unroll
      for (int r = 0; r < 16; ++r) ps += p1[r];
      { auto rr = __builtin_amdgcn_permlane32_swap(__float_as_uint(ps), __float_as_uint(ps), false, false);
        ps = __uint_as_float(rr[0]) + __uint_as_float(rr[1]); }
      l_reg = l_reg * alpha + ps;
      if (__any(alpha < 1.f)) {
        if (hi == 0) ws[r32] = alpha;
        asm volatile("s_waitcnt lgkmcnt(0)" ::: "memory");
#pragma unroll
        for (int r = 0; r < 16; ++r) { const float a = ws[crow(r, hi)]; o[0][r] *= a; o[1][r] *= a; }
      }
      bf16x8 pa0, pa1, pa2, pa3;
#define ATT_PK4(P, BASE, OUT) do { unsigned a0 = cvtpk(P[BASE + 0], P[BASE + 1]), a1 = cvtpk(P[BASE + 2], P[BASE + 3]);   \
    unsigned b0 = cvtpk(P[BASE + 4], P[BASE + 5]), b1 = cvtpk(P[BASE + 6], P[BASE + 7]);                              \
    auto r0 = __builtin_amdgcn_permlane32_swap(a0, b0, false, false); auto r1 = __builtin_amdgcn_permlane32_swap(a1, b1, false, false); \
    u32x4 w = {r0[0], r1[0], r0[1], r1[1]}; OUT = __builtin_bit_cast(bf16x8, w); } while (0)
      ATT_PK4(p0, 0, pa0); ATT_PK4(p0, 8, pa1); ATT_PK4(p1, 0, pa2); ATT_PK4(p1, 8, pa3);
#undef ATT_PK4
      const unsigned vb = vb0 + (unsigned)(buf * VBUF);
      pv_one<0>(o[0], vb, pa0, pa1, pa2, pa3); pv_one<1>(o[1], vb, pa0, pa1, pa2, pa3);
    }
    if (t + 1 < NT) ATT_SWRITE(buf ^ 1);
    __syncthreads();
  }
#undef ATT_SLOAD
#undef ATT_SWRITE
  { const float sk = u.sink(wid); l_reg += __builtin_amdgcn_exp2f(sk - m_reg); }
  if (hi == 0) ws[r32] = l_reg;
  asm volatile("s_waitcnt lgkmcnt(0)" ::: "memory");
  float rli[16];
#pragma unroll
  for (int r = 0; r < 16; ++r) rli[r] = __builtin_amdgcn_rcpf(ws[crow(r, hi)]);
#pragma unroll
  for (int r = 0; r < 16; ++r) { bf16* op = u.orow(wid, crow(r, hi));
    op[r32] = (bf16)(cvtpk(o[0][r] * rli[r], 0.f) & 0xffffu); op[32 + r32] = (bf16)(cvtpk(o[1][r] * rli[r], 0.f) & 0xffffu); }
  asm volatile("s_waitcnt lgkmcnt(0)" ::: "memory");
}

constexpr int ROWS_LAT = 16384;
struct UWin {
  const bf16* QKV; bf16* O; const float* sinkp; int b, n, g, hh; int i0, cnt;
  __device__ __forceinline__ void init() { i0 = (n == 0) ? 2 : 0; cnt = (n == 0 || n == 63) ? 4 : 6; }
  __device__ __forceinline__ int nt() const { return 4 + cnt; }
  __device__ __forceinline__ int kpos0(int t) const { return 128 * (n - 1) + 64 * (i0 + t - 4); }
  __device__ __forceinline__ long krow(int t) const { return t < 4 ? (long)(ROWS_LAT + 256 * b + 64 * t) : (long)(8192 * b + kpos0(t)); }
  __device__ __forceinline__ const bf16* kptr(long row, int ch) const { return QKV + row * 2304 + 512 + 64 * g + ch * 8; }
  __device__ __forceinline__ const bf16* vptr(long row, int ch) const { return QKV + row * 2304 + 640 + 64 * g + ch * 8; }
  __device__ __forceinline__ int head(int wid) const { return 4 * g + 2 * hh + (wid >> 2); }
  __device__ __forceinline__ int qpos0(int wid) const { return 128 * n + 32 * (wid & 3); }
  __device__ __forceinline__ const bf16* qptr(int wid, int r32, int d0, int hi) const { return QKV + (long)(8192 * b + qpos0(wid) + r32) * 2304 + 64 * head(wid) + 16 * d0 + 8 * hi; }
  __device__ __forceinline__ bool skip(int t, int wid) const { if (t < 4) return false; const int k0 = kpos0(t), q0 = qpos0(wid); return (k0 + 63 < q0 - 128) || (k0 > q0 + 31 + 128); }
  __device__ __forceinline__ void mask(f32x16& p0, f32x16& p1, int t, int wid, int r32, int hi) const {
    if (t < 4) return;
    const int dq = kpos0(t) - (qpos0(wid) + r32);
#pragma unroll
    for (int r = 0; r < 16; ++r) { const int d = dq + crow(r, hi); if (d > 128 || d < -128) p0[r] = -INFINITY; if (d + 32 > 128 || d + 32 < -128) p1[r] = -INFINITY; }
  }
  __device__ __forceinline__ float sink(int wid) const { return sinkp[head(wid)] * LOG2E; }
  __device__ __forceinline__ bf16* orow(int wid, int row) const { return O + (long)(8192 * b + qpos0(wid) + row) * 1024 + 64 * head(wid); }
};
struct UNa {
  const bf16* QKV; bf16* O; const ATT_LAS float* rpbl; int b, h, R4; int krlo, nloc;
  __device__ __forceinline__ static int clampi(int v, int lo, int hi_) { return v < lo ? lo : (v > hi_ ? hi_ : v); }
  __device__ __forceinline__ void init() { krlo = clampi(4 * R4 - 4, 0, 120); const int krhi = clampi(4 * R4 - 1, 0, 120) + 7; nloc = krhi - krlo + 1; }
  __device__ __forceinline__ int nt() const { return 4 + nloc; }
  __device__ __forceinline__ long krow(int t) const { return t < 4 ? (long)(ROWS_LAT + 256 * b + 64 * t) : (long)(8192 * b + 64 * (krlo + t - 4)); }
  __device__ __forceinline__ const bf16* kptr(long row, int ch) const { return QKV + row * 2304 + 1280 + 64 * h + ch * 8; }
  __device__ __forceinline__ const bf16* vptr(long row, int ch) const { return QKV + row * 2304 + 1792 + 64 * h + ch * 8; }
  __device__ __forceinline__ int qrow(int wid) const { return 4 * R4 + (wid >> 1); }
  __device__ __forceinline__ const bf16* qptr(int wid, int r32, int d0, int hi) const { return QKV + (long)(8192 * b + 64 * qrow(wid) + 32 * (wid & 1) + r32) * 2304 + 768 + 64 * h + 16 * d0 + 8 * hi; }
  __device__ __forceinline__ bool skip(int t, int wid) const { if (t < 4) return false; const int kr = krlo + t - 4, w0 = clampi(qrow(wid) - 4, 0, 120); return kr < w0 || kr > w0 + 7; }
  __device__ __forceinline__ void mask(f32x16& p0, f32x16& p1, int t, int wid, int r32, int hi) const {
    if (t < 4) return;
    const int kr = krlo + t - 4, qc = 32 * (wid & 1) + r32, c0 = clampi(qc - 8, 0, 48);
    const ATT_LAS float* brow = rpbl + (kr - qrow(wid) + 7) * 31 + 15;
#pragma unroll
    for (int r = 0; r < 16; ++r) {
      { const int kc = crow(r, hi); const bool ok = kc >= c0 && kc < c0 + 16; const float bv = brow[clampi(kc - qc, -15, 15)]; p0[r] = ok ? p0[r] + bv : -INFINITY; }
      { const int kc = 32 + crow(r, hi); const bool ok = kc >= c0 && kc < c0 + 16; const float bv = brow[clampi(kc - qc, -15, 15)]; p1[r] = ok ? p1[r] + bv : -INFINITY; } }
  }
  __device__ __forceinline__ float sink(int) const { return -INFINITY; }
  __device__ __forceinline__ bf16* orow(int wid, int row) const { return O + (long)(8192 * b + 64 * qrow(wid) + 32 * (wid & 1) + row) * 1024 + 512 + 64 * h; }
};
struct UCtx {
  const bf16* QKV; bf16* O; const float* sinkp; int b, hx; int qcol, kcol, vcol, ocol;
  __device__ __forceinline__ void init() { if (hx < 8) { qcol = 64 * hx; kcol = 512 + 64 * (hx >> 2); vcol = 640 + 64 * (hx >> 2); ocol = 64 * hx; }
    else { const int h = hx - 8; qcol = 768 + 64 * h; kcol = 1280 + 64 * h; vcol = 1792 + 64 * h; ocol = 512 + 64 * h; } }
  __device__ __forceinline__ int nt() const { return 4; }
  __device__ __forceinline__ long krow(int t) const { return (long)(ROWS_LAT + 256 * b + 64 * t); }
  __device__ __forceinline__ const bf16* kptr(long row, int ch) const { return QKV + row * 2304 + kcol + ch * 8; }
  __device__ __forceinline__ const bf16* vptr(long row, int ch) const { return QKV + row * 2304 + vcol + ch * 8; }
  __device__ __forceinline__ const bf16* qptr(int wid, int r32, int d0, int hi) const { return QKV + (long)(ROWS_LAT + 256 * b + 32 * wid + r32) * 2304 + qcol + 16 * d0 + 8 * hi; }
  __device__ __forceinline__ bool skip(int, int) const { return false; }
  __device__ __forceinline__ void mask(f32x16&, f32x16&, int, int, int, int) const {}
  __device__ __forceinline__ float sink(int) const { return hx < 8 ? sinkp[hx] * LOG2E : -INFINITY; }
  __device__ __forceinline__ bf16* orow(int wid, int row) const { return O + (long)(ROWS_LAT + 256 * b + 32 * wid + row) * 1024 + ocol; }
};
struct UDense {
  const bf16* Q; const bf16* KV; const bf16* KR; bf16* O; int b, h, qb;
  __device__ __forceinline__ int nt() const { return 132; }
  __device__ __forceinline__ long krow(int t) const { return t < 4 ? (long)(ROWS_LAT + 256 * b + 64 * t) : (long)(8192 * b + 64 * (t - 4)); }
  __device__ __forceinline__ const bf16* kptr(long row, int ch) const { return ch < 8 ? KV + row * 2048 + 64 * h + ch * 8 : KR + row * 32 + (ch - 8) * 8; }
  __device__ __forceinline__ const bf16* vptr(long row, int ch) const { return KV + row * 2048 + 1024 + 64 * h + ch * 8; }
  __device__ __forceinline__ const bf16* qptr(int wid, int r32, int d0, int hi) const { const bf16* qp = Q + (long)(8192 * b + 256 * qb + 32 * wid + r32) * 1536;
    return d0 < 4 ? qp + 64 * h + 16 * d0 + 8 * hi : qp + 1024 + 32 * h + 16 * (d0 - 4) + 8 * hi; }
  __device__ __forceinline__ bool skip(int, int) const { return false; }
  __device__ __forceinline__ void mask(f32x16&, f32x16&, int, int, int, int) const {}
  __device__ __forceinline__ float sink(int) const { return -INFINITY; }
  __device__ __forceinline__ bf16* orow(int wid, int row) const { return O + (long)(8192 * b + 256 * qb + 32 * wid + row) * 1024 + 64 * h; }
};
#undef ATT_SBAR
}
namespace attd {
typedef unsigned short bf16;
using bf16x8 = __attribute__((ext_vector_type(8))) short;
using s16x4 = __attribute__((ext_vector_type(4))) short;
using f32x16 = __attribute__((ext_vector_type(16))) float;
using u32x4 = __attribute__((ext_vector_type(4))) unsigned;
using i32x2 = __attribute__((ext_vector_type(2))) int;
using i32x4 = __attribute__((ext_vector_type(4))) int;
using i32x8 = __attribute__((ext_vector_type(8))) int;
using u32x6 = __attribute__((ext_vector_type(6))) unsigned;
using u32x16 = __attribute__((ext_vector_type(16))) unsigned;
typedef __bf16 bf16x32 __attribute__((ext_vector_type(32)));
constexpr int NW = 8, NT = 132, KSLOT = 5120, VSLOT = 8192;
constexpr int LDS_K = 0, LDS_V = 3 * KSLOT, LDS_WS = LDS_V + 3 * VSLOT, LDS_OST = LDS_WS + NW * 64 * 4, LDS_BYTES = LDS_OST + NW * 4096;
__device__ __forceinline__ int crow(int r, int hi) { return (r & 3) + 8 * (r >> 2) + 4 * hi; }
#define AF_SBAR() __builtin_amdgcn_sched_barrier(0)
__device__ __forceinline__ void glds16(unsigned voff, const void* sbase, unsigned lds_dst) { unsigned keep;
  asm volatile("s_mov_b32 %0, m0\n\ts_mov_b32 m0, %3\n\ts_nop 0\n\tglobal_load_lds_dwordx4 %1, %2\n\ts_mov_b32 m0, %0" : "=&s"(keep) : "v"(voff), "s"(sbase), "s"(lds_dst) : "memory"); }
typedef float f32x2_t __attribute__((ext_vector_type(2))); typedef __bf16 bf16x2_t __attribute__((ext_vector_type(2)));
__device__ __forceinline__ unsigned cvtpk_s(float lo, float hi) { f32x2_t v = {lo, hi}; bf16x2_t b = __builtin_convertvector(v, bf16x2_t); return __builtin_bit_cast(unsigned, b); }
#define AF_WAIT_BAR(N) asm volatile("s_waitcnt vmcnt(" #N ") lgkmcnt(0)\n\ts_barrier" ::: "memory")
typedef __attribute__((address_space(3))) const char* lds_cptr;
typedef short v4i16_t __attribute__((ext_vector_type(4)));
__device__ __forceinline__ i32x8 ld6(lds_cptr p16, lds_cptr p8) { const i32x4 a = *(const __attribute__((address_space(3))) i32x4*)p16; const i32x2 b = *(const __attribute__((address_space(3))) i32x2*)p8;
  return (i32x8){a.x, a.y, a.z, a.w, b.x, b.y, 0, 0}; }
__device__ __forceinline__ s16x4 vtr(lds_cptr p) { return __builtin_bit_cast(s16x4, __builtin_amdgcn_ds_read_tr16_b64_v4i16((__attribute__((address_space(3))) v4i16_t*)p)); }
__device__ __forceinline__ long tile_row(int b, int t) { return t < 4 ? (long)(16384 + 256 * b + 64 * t) : (long)(8192 * b + 64 * (t - 4)); }
__device__ __forceinline__ u32x6 to_fp6(u32x4 a0, u32x4 a1, u32x4 a2, u32x4 a3) { const u32x16 all = {a0.x, a0.y, a0.z, a0.w, a1.x, a1.y, a1.z, a1.w, a2.x, a2.y, a2.z, a2.w, a3.x, a3.y, a3.z, a3.w};
  return __builtin_amdgcn_cvt_scalef32_pk32_fp6_bf16(__builtin_bit_cast(bf16x32, all), 1.0f); }

__device__ __forceinline__ void dense_unit(int b, int h, int qb, const bf16* Q, const bf16* __restrict__ KV, const char* __restrict__ K6N, const char* __restrict__ K6R, bf16* O, char* shm, const int tid) {
  const int lane = tid & 63, r32 = lane & 31, hi = lane >> 5; const int wid = __builtin_amdgcn_readfirstlane(tid >> 6);
  const unsigned lds0 = (unsigned)(uintptr_t)shm;
  float* wsf = (float*)(shm + LDS_WS) + wid * 64;
  const bool wnp = wid < 3 || wid >= 5; const int pc = wnp ? (wid < 3 ? wid : wid - 5) : wid - 3;
  const unsigned voffK = (unsigned)(lane * 16);
  const char* sK = wnp ? K6N + h * 3072 + pc * 1024 : K6R + pc * 1024; const long kts = wnp ? 16 * 3072 : 2048;
  const unsigned voffV = (unsigned)((16 * (wid & 3) + (lane >> 2)) * 2048 + (wid >> 2) * 32 + (lane & 3) * 8) * 2u;
  const char* sV = (const char*)(KV + 1024 + 64 * h);
  const unsigned kdst = lds0 + LDS_K + (wnp ? pc * 1024 : 3072 + pc * 1024), vdst = lds0 + LDS_V + wid * 1024;
#define AF_DMA_K(t, ks) do { const long G_ = tile_row(b, (t)) >> 6; glds16(voffK, sK + G_ * kts, (unsigned)__builtin_amdgcn_readfirstlane(kdst + (ks))); } while (0)
#define AF_DMA_V(t, vs) do { const long R_ = tile_row(b, (t)); glds16(voffV, sV + R_ * 4096, (unsigned)__builtin_amdgcn_readfirstlane(vdst + (vs))); } while (0)
  const lds_cptr shm3 = (lds_cptr)shm;
  const lds_cptr kp16 = shm3 + LDS_K + hi * 1024 + r32 * 16;
  const lds_cptr kp8 = shm3 + LDS_K + 2048 + hi * 512 + r32 * 8;
  const lds_cptr vp0 = shm3 + LDS_V + ((lane >> 4) & 1) * 32 + (lane & 3) * 8 + (4 * hi + ((lane & 15) >> 2)) * 64;
  AF_DMA_K(0, 0); AF_DMA_V(0, 0); AF_DMA_K(1, KSLOT); AF_DMA_K(2, 2 * KSLOT);
  i32x8 qn, qr;
  { const bf16* qp = Q + (long)(8192 * b + 256 * qb + 32 * wid + r32) * 1536; const bf16* qa = qp + 64 * h + 32 * hi; const bf16* qc = qp + 1024 + 32 * h;
    const u32x6 n6 = to_fp6(*reinterpret_cast<const u32x4*>(qa), *reinterpret_cast<const u32x4*>(qa + 8), *reinterpret_cast<const u32x4*>(qa + 16), *reinterpret_cast<const u32x4*>(qa + 24));
    u32x6 r6 = to_fp6(*reinterpret_cast<const u32x4*>(qc), *reinterpret_cast<const u32x4*>(qc + 8), *reinterpret_cast<const u32x4*>(qc + 16), *reinterpret_cast<const u32x4*>(qc + 24));
    if (hi) r6 = (u32x6){0u, 0u, 0u, 0u, 0u, 0u};
    qn = (i32x8){(int)n6[0], (int)n6[1], (int)n6[2], (int)n6[3], (int)n6[4], (int)n6[5], 0, 0}; qr = (i32x8){(int)r6[0], (int)r6[1], (int)r6[2], (int)r6[3], (int)r6[4], (int)r6[5], 0, 0}; }
  float l_reg = 0.f; f32x16 o[2]; o[0] = f32x16{}; o[1] = f32x16{};
  f32x16 pA0, pA1, pB0, pB1; i32x8 kn0, kn1, kr0, kr1;
  int s_prev = 0, s_cur = 0, s_next = 1;
#define AF_ROT() do { s_prev = s_cur; s_cur = s_next; s_next = (s_next == 2) ? 0 : s_next + 1; } while (0)
#define AF_MF(a, b, c) __builtin_amdgcn_mfma_f32_32x32x16_bf16(a, b, c, 0, 0, 0)
#define AF_MX(a, b, c) __builtin_amdgcn_mfma_scale_f32_32x32x64_f8f6f4(a, b, c, 2, 2, 0, 0x7b7b7b7b, 0, 0x7f7f7f7f)
#define AF_EX(v) __builtin_amdgcn_exp2f(v)
  const f32x16 zero16 = f32x16{};
  AF_WAIT_BAR(0);
  { pA0 = AF_MX(ld6(kp16, kp8), qn, zero16); pA1 = AF_MX(ld6(kp16 + 512, kp8 + 256), qn, zero16);
    pA0 = AF_MX(ld6(kp16 + 3072, kp8 + 2048), qr, pA0); pA1 = AF_MX(ld6(kp16 + 3072 + 512, kp8 + 2048 + 256), qr, pA1);
#pragma unroll
    for (int r = 0; r < 16; ++r) { pA0[r] = AF_EX(pA0[r]); pA1[r] = AF_EX(pA1[r]); } }
  AF_WAIT_BAR(0);
  AF_DMA_K(3, 0); AF_DMA_V(1, VSLOT);
  AF_ROT();
  { const lds_cptr k16_ = kp16 + s_cur * KSLOT, k8_ = kp8 + s_cur * KSLOT; kn0 = ld6(k16_, k8_); kn1 = ld6(k16_ + 512, k8_ + 256); kr0 = ld6(k16_ + 3072, k8_ + 2048); kr1 = ld6(k16_ + 3072 + 512, k8_ + 2048 + 256); }
  AF_WAIT_BAR(2);
  s16x4 vlo[8], vhi[8]; u32x4 pw0, pw1, pw2, pw3;
#define AF_PKW(P, B) cvtpk_s(P[B], P[B + 1])
#define AF_PAF(k) __builtin_bit_cast(bf16x8, pw##k)
#define AF_VFR(i) (bf16x8){vlo[i][0], vlo[i][1], vlo[i][2], vlo[i][3], vhi[i][0], vhi[i][1], vhi[i][2], vhi[i][3]}
#define AF_PIN(x) asm volatile("" : "+v"(x))
#define AF_VRD(i) do { vlo[i] = vtr(vp_ + (((i) >> 2) * 4096 + ((i) & 3) * 1024)); vhi[i] = vtr(vp_ + (((i) >> 2) * 4096 + ((i) & 3) * 1024 + 512)); AF_SBAR(); } while (0)
#define AF_GB(MF, X, B) do { MF; X[B] = AF_EX(X[B]); X[B + 1] = AF_EX(X[B + 1]); X[B + 2] = AF_EX(X[B + 2]); X[B + 3] = AF_EX(X[B + 3]); AF_PIN(X); AF_SBAR(); } while (0)
#define AF_KRD(G, j) do { if (G) { const lds_cptr k16_ = kp16 + s_next * KSLOT, k8_ = kp8 + s_next * KSLOT; \
      if ((j) == 0) kn0 = ld6(k16_, k8_); if ((j) == 1) kn1 = ld6(k16_ + 512, k8_ + 256); \
      if ((j) == 2) kr0 = ld6(k16_ + 3072, k8_ + 2048); if ((j) == 3) kr1 = ld6(k16_ + 3072 + 512, k8_ + 2048 + 256); AF_SBAR(); } } while (0)
#define AF_A4(P, B) do { sacc += P[B]; sacc += P[B + 1]; sacc += P[B + 2]; sacc += P[B + 3]; } while (0)
#define AF_STEP(C0, C1, P0, P1, t, GK, GV, GL) do { AF_SBAR(); \
    const lds_cptr vp_ = vp0 + s_prev * VSLOT; \
    float sacc = (P0[0] + P0[1]); \
    AF_VRD(0); AF_VRD(4); \
    { C0 = AF_MX(kn0, qn, zero16); sacc += P0[2]; sacc += P0[3]; AF_A4(P0, 4); AF_PIN(sacc); \
      pw0[0] = AF_PKW(P0, 0); pw0[1] = AF_PKW(P0, 2); pw0[2] = AF_PKW(P0, 4); pw0[3] = AF_PKW(P0, 6); AF_PIN(pw0); AF_SBAR(); } \
    AF_VRD(1); AF_VRD(5); \
    { C1 = AF_MX(kn1, qn, zero16); AF_A4(P0, 8); AF_A4(P0, 12); AF_PIN(sacc); \
      pw1[0] = AF_PKW(P0, 8); pw1[1] = AF_PKW(P0, 10); pw1[2] = AF_PKW(P0, 12); pw1[3] = AF_PKW(P0, 14); AF_PIN(pw1); AF_SBAR(); } \
    AF_VRD(2); AF_VRD(6); \
    { C0 = AF_MX(kr0, qr, C0); AF_A4(P1, 0); AF_A4(P1, 4); AF_PIN(sacc); \
      pw2[0] = AF_PKW(P1, 0); pw2[1] = AF_PKW(P1, 2); pw2[2] = AF_PKW(P1, 4); pw2[3] = AF_PKW(P1, 6); AF_PIN(pw2); AF_SBAR(); } \
    if (GK) { AF_DMA_K((t) + 3, s_cur * KSLOT); AF_SBAR(); } \
    AF_VRD(3); AF_VRD(7); \
    { C1 = AF_MX(kr1, qr, C1); AF_A4(P1, 8); AF_A4(P1, 12); AF_PIN(sacc); \
      pw3[0] = AF_PKW(P1, 8); pw3[1] = AF_PKW(P1, 10); pw3[2] = AF_PKW(P1, 12); pw3[3] = AF_PKW(P1, 14); AF_PIN(pw3); AF_SBAR(); } \
    if (GV) { AF_DMA_V((t) + 1, s_next * VSLOT); AF_SBAR(); } \
    l_reg += sacc; \
    AF_SBAR(); \
    AF_GB(o[0] = AF_MF(AF_PAF(0), AF_VFR(0), o[0]), C0, 0);  AF_KRD(GL, 0); \
    AF_GB(o[1] = AF_MF(AF_PAF(0), AF_VFR(4), o[1]), C0, 4);  AF_KRD(GL, 1); \
    AF_GB(o[0] = AF_MF(AF_PAF(1), AF_VFR(1), o[0]), C0, 8);  AF_KRD(GL, 2); \
    AF_GB(o[1] = AF_MF(AF_PAF(1), AF_VFR(5), o[1]), C0, 12); AF_KRD(GL, 3); \
    AF_GB(o[0] = AF_MF(AF_PAF(2), AF_VFR(2), o[0]), C1, 0); \
    AF_GB(o[1] = AF_MF(AF_PAF(2), AF_VFR(6), o[1]), C1, 4); \
    AF_GB(o[0] = AF_MF(AF_PAF(3), AF_VFR(3), o[0]), C1, 8); \
    AF_GB(o[1] = AF_MF(AF_PAF(3), AF_VFR(7), o[1]), C1, 12); \
  } while (0)
  int t = 1;
  for (; t + 3 < NT; t += 2) {
    AF_STEP(pB0, pB1, pA0, pA1, t, true, true, true);     AF_WAIT_BAR(2); AF_ROT();
    AF_STEP(pA0, pA1, pB0, pB1, t + 1, true, true, true); AF_WAIT_BAR(2); AF_ROT();
  }
  AF_STEP(pB0, pB1, pA0, pA1, NT - 3, false, true, true);  AF_WAIT_BAR(1); AF_ROT();
  AF_STEP(pA0, pA1, pB0, pB1, NT - 2, false, true, true);  AF_WAIT_BAR(0); AF_ROT();
  AF_STEP(pB0, pB1, pA0, pA1, NT - 1, false, false, false);
  { float sacc = pB0[0] + pB0[1];
#pragma unroll
    for (int r = 2; r < 16; ++r) sacc += pB0[r];
#pragma unroll
    for (int r = 0; r < 16; ++r) sacc += pB1[r];
    l_reg += sacc;
    pw0 = (u32x4){AF_PKW(pB0, 0), AF_PKW(pB0, 2), AF_PKW(pB0, 4), AF_PKW(pB0, 6)}; pw1 = (u32x4){AF_PKW(pB0, 8), AF_PKW(pB0, 10), AF_PKW(pB0, 12), AF_PKW(pB0, 14)};
    pw2 = (u32x4){AF_PKW(pB1, 0), AF_PKW(pB1, 2), AF_PKW(pB1, 4), AF_PKW(pB1, 6)}; pw3 = (u32x4){AF_PKW(pB1, 8), AF_PKW(pB1, 10), AF_PKW(pB1, 12), AF_PKW(pB1, 14)};
    AF_SBAR();
    const lds_cptr vp_ = vp0 + s_cur * VSLOT;
#pragma unroll
    for (int i = 0; i < 8; ++i) { vlo[i] = vtr(vp_ + ((i >> 2) * 4096 + (i & 3) * 1024)); vhi[i] = vtr(vp_ + ((i >> 2) * 4096 + (i & 3) * 1024 + 512)); }
    o[0] = AF_MF(AF_PAF(0), AF_VFR(0), o[0]); o[1] = AF_MF(AF_PAF(0), AF_VFR(4), o[1]);
    o[0] = AF_MF(AF_PAF(1), AF_VFR(1), o[0]); o[1] = AF_MF(AF_PAF(1), AF_VFR(5), o[1]);
    o[0] = AF_MF(AF_PAF(2), AF_VFR(2), o[0]); o[1] = AF_MF(AF_PAF(2), AF_VFR(6), o[1]);
    o[0] = AF_MF(AF_PAF(3), AF_VFR(3), o[0]); o[1] = AF_MF(AF_PAF(3), AF_VFR(7), o[1]); }
  { auto rr = __builtin_amdgcn_permlane32_swap(__float_as_uint(l_reg), __float_as_uint(l_reg), false, false); l_reg = __uint_as_float(rr[0]) + __uint_as_float(rr[1]); }
  if (hi == 0) wsf[32 + r32] = l_reg; asm volatile("s_waitcnt lgkmcnt(0)" ::: "memory");
  float rli[16];
#pragma unroll
  for (int r = 0; r < 16; ++r) rli[r] = __builtin_amdgcn_rcpf(wsf[32 + crow(r, hi)]);
  bf16* Ow = O + (long)(8192 * b + 256 * qb + 32 * wid) * 1024 + 64 * h;
  { bf16* stg = (bf16*)(shm + LDS_OST) + wid * 2048;
#pragma unroll
    for (int r = 0; r < 16; ++r) { const int orow = crow(r, hi);
#pragma unroll
      for (int d0 = 0; d0 < 2; ++d0) stg[orow * 64 + d0 * 32 + r32] = (bf16)(cvtpk_s(o[d0][r] * rli[r], 0.f) & 0xffffu); }
    asm volatile("s_waitcnt lgkmcnt(0)" ::: "memory");
#pragma unroll
    for (int i = 0; i < 4; ++i) { const int row = i * 8 + (lane >> 3), ch = lane & 7; const u32x4 v = *(const u32x4*)(stg + row * 64 + ch * 8); *(u32x4*)(Ow + (long)row * 1024 + ch * 8) = v; } }
  asm volatile("s_waitcnt vmcnt(0) lgkmcnt(0)\n\ts_barrier" ::: "memory");
#undef AF_DMA_K
#undef AF_DMA_V
#undef AF_ROT
#undef AF_PKW
#undef AF_PAF
#undef AF_VFR
#undef AF_PIN
#undef AF_MF
#undef AF_MX
#undef AF_EX
#undef AF_VRD
#undef AF_GB
#undef AF_KRD
#undef AF_A4
#undef AF_STEP
}
#undef AF_SBAR
#undef AF_WAIT_BAR
}
namespace attf {
typedef unsigned short bf16;
using bf16x8 = __attribute__((ext_vector_type(8))) short;
using s16x4 = __attribute__((ext_vector_type(4))) short;
using f32x16 = __attribute__((ext_vector_type(16))) float;
using u32x4 = __attribute__((ext_vector_type(4))) unsigned;
constexpr int NW = 8, KSLOT = 12288, VSLOT = 8192;
constexpr int LDS_K = 0, LDS_V = 3 * KSLOT, LDS_WS = LDS_V + 3 * VSLOT, LDS_OST = LDS_WS + NW * 64 * 4, LDS_RPB = LDS_OST + NW * 4096, LDS_BYTES = LDS_RPB + 2048;
__device__ __forceinline__ int crow(int r, int hi) { return (r & 3) + 8 * (r >> 2) + 4 * hi; }
#define AF_SBAR() __builtin_amdgcn_sched_barrier(0)
__device__ __forceinline__ void glds16(unsigned voff, const void* sbase, unsigned lds_dst) { unsigned keep;
  asm volatile("s_mov_b32 %0, m0\n\ts_mov_b32 m0, %3\n\ts_nop 0\n\tglobal_load_lds_dwordx4 %1, %2\n\ts_mov_b32 m0, %0" : "=&s"(keep) : "v"(voff), "s"(sbase), "s"(lds_dst) : "memory"); }
typedef float f32x2_t __attribute__((ext_vector_type(2))); typedef __bf16 bf16x2_t __attribute__((ext_vector_type(2)));
__device__ __forceinline__ unsigned cvtpk_s(float lo, float hi) { f32x2_t v = {lo, hi}; bf16x2_t b = __builtin_convertvector(v, bf16x2_t); return __builtin_bit_cast(unsigned, b); }
#define AF_WAIT_BAR(N) asm volatile("s_waitcnt vmcnt(" #N ") lgkmcnt(0)\n\ts_barrier" ::: "memory")
typedef __attribute__((address_space(3))) const char* lds_cptr;
typedef short v4i16_t __attribute__((ext_vector_type(4)));
__device__ __forceinline__ void kload2(bf16x8* kf, lds_cptr kp, int j) { kf[2 * j] = *(const __attribute__((address_space(3))) bf16x8*)(kp + j * 2048); kf[2 * j + 1] = *(const __attribute__((address_space(3))) bf16x8*)(kp + j * 2048 + 512); }
__device__ __forceinline__ s16x4 vtr(lds_cptr p) { return __builtin_bit_cast(s16x4, __builtin_amdgcn_ds_read_tr16_b64_v4i16((__attribute__((address_space(3))) v4i16_t*)p)); }

template <int DKC, class U>
__device__ __forceinline__ void fast_unit(const U& u, char* shm, int tid) {
  static_assert(DKC == 8 || DKC == 12, "q/k dim 64 or 96");
  asm volatile("" : "+v"(tid));
  constexpr int ND0 = DKC / 2;
  const int lane = tid & 63, r32 = lane & 31, hi = lane >> 5; const int wid = __builtin_amdgcn_readfirstlane(tid >> 6);
  const unsigned lds0 = (unsigned)(uintptr_t)shm;
  float* wsf = (float*)(shm + LDS_WS) + wid * 64;
  const int NT = u.nt();
  const unsigned voffKA = (unsigned)(lane * u.kpitch + 8 * wid) * 2u;
  const unsigned voffKB = (unsigned)(lane * 32 + 8 * (wid & 3)) * 2u;
  const unsigned voffV = (unsigned)((16 * (wid & 3) + (lane >> 2)) * u.vpitch + (wid >> 2) * 32 + (lane & 3) * 8) * 2u;
  const unsigned kdstA = lds0 + LDS_K + wid * 1024, kdstB = lds0 + LDS_K + (8 + (wid & 3)) * 1024, vdst = lds0 + LDS_V + wid * 1024;
#define AF_DMA_KA(t, ks) do { const long R_ = u.trow(t); glds16(voffKA, (const char*)u.kbase + R_ * (2 * u.kpitch), (unsigned)__builtin_amdgcn_readfirstlane(kdstA + (ks))); } while (0)
#define AF_DMA_KB(t, ks) do { if constexpr (DKC == 12) { const long R_ = u.trow(t); glds16(voffKB, (const char*)u.krbase + R_ * 64, (unsigned)__builtin_amdgcn_readfirstlane(kdstB + (ks))); } } while (0)
#define AF_DMA_K(t, ks) do { AF_DMA_KA(t, ks); AF_DMA_KB(t, ks); } while (0)
#define AF_DMA_V(t, vs) do { const long R_ = u.trow(t); glds16(voffV, (const char*)u.vbase + R_ * (2 * u.vpitch), (unsigned)__builtin_amdgcn_readfirstlane(vdst + (vs))); } while (0)
#define AF_WAITN(NSTEPS_K, NV) do { if constexpr (DKC == 12) { if ((NSTEPS_K) == 2 && (NV) == 1) AF_WAIT_BAR(5); else if ((NSTEPS_K) == 1 && (NV) == 1) AF_WAIT_BAR(3); else if ((NV) == 1) AF_WAIT_BAR(1); else AF_WAIT_BAR(0); } \
    else { if ((NSTEPS_K) == 2 && (NV) == 1) AF_WAIT_BAR(3); else if ((NSTEPS_K) == 1 && (NV) == 1) AF_WAIT_BAR(2); else if ((NV) == 1) AF_WAIT_BAR(1); else AF_WAIT_BAR(0); } } while (0)
  const lds_cptr shm3 = (lds_cptr)shm; const lds_cptr kp0 = shm3 + LDS_K + hi * 1024 + r32 * 16;
  const lds_cptr vp0 = shm3 + LDS_V + ((lane >> 4) & 1) * 32 + (lane & 3) * 8 + (4 * hi + ((lane & 15) >> 2)) * 64;
  bf16x8 qr[ND0];
#pragma unroll
  for (int d0 = 0; d0 < ND0; ++d0) qr[d0] = *reinterpret_cast<const bf16x8*>(u.qptr(wid, r32, d0, hi));
  AF_DMA_K(0, 0); AF_DMA_V(0, 0); AF_DMA_K(1, KSLOT); AF_DMA_K(2, 2 * KSLOT);
  float l_reg = 0.f; f32x16 o[2]; o[0] = f32x16{}; o[1] = f32x16{};
  f32x16 pA0, pA1, pB0, pB1; bf16x8 kf[DKC];
  int s_prev = 0, s_cur = 0, s_next = 1;
#define AF_ROT() do { s_prev = s_cur; s_cur = s_next; s_next = (s_next == 2) ? 0 : s_next + 1; } while (0)
  AF_WAITN(2, 1);
  { const char* kb = shm + LDS_K + hi * 1024 + r32 * 16; pA0 = f32x16{}; pA1 = f32x16{};
#pragma unroll
    for (int d0 = 0; d0 < ND0; ++d0) { const bf16x8 b0 = *reinterpret_cast<const bf16x8*>(kb + d0 * 2048), b1 = *reinterpret_cast<const bf16x8*>(kb + d0 * 2048 + 512);
      pA0 = __builtin_amdgcn_mfma_f32_32x32x16_bf16(b0, qr[d0], pA0, 0, 0, 0); pA1 = __builtin_amdgcn_mfma_f32_32x32x16_bf16(b1, qr[d0], pA1, 0, 0, 0); }
    if constexpr (U::HAS_MASK) u.mask(pA0, pA1, 0, wid, r32, hi);
#pragma unroll
    for (int r = 0; r < 16; ++r) { pA0[r] = __builtin_amdgcn_exp2f(pA0[r]); pA1[r] = __builtin_amdgcn_exp2f(pA1[r]); } }
  AF_WAIT_BAR(0);
  AF_DMA_K(3, 0); AF_DMA_V(1, VSLOT);
  AF_ROT();
#pragma unroll
  for (int j = 0; j < ND0; ++j) kload2(kf, kp0 + s_cur * KSLOT, j);
  AF_WAITN(1, 1);
  s16x4 vlo[8], vhi[8]; u32x4 pw0, pw1, pw2, pw3;
#define AF_PKW(P, B) cvtpk_s(P[B], P[B + 1])
#define AF_PAF(k) __builtin_bit_cast(bf16x8, pw##k)
#define AF_VFR(i) (bf16x8){vlo[i][0], vlo[i][1], vlo[i][2], vlo[i][3], vhi[i][0], vhi[i][1], vhi[i][2], vhi[i][3]}
#define AF_PIN(x) asm volatile("" : "+v"(x))
#define AF_MF(a, b, c) __builtin_amdgcn_mfma_f32_32x32x16_bf16(a, b, c, 0, 0, 0)
#define AF_EX(v) __builtin_amdgcn_exp2f(v)
#define AF_VRD(i) do { vlo[i] = vtr(vp_ + (((i) >> 2) * 4096 + ((i) & 3) * 1024)); vhi[i] = vtr(vp_ + (((i) >> 2) * 4096 + ((i) & 3) * 1024 + 512)); AF_SBAR(); } while (0)
#define AF_GA4(MF, A0, A1, A2, A3, W0, W1, PW) do { MF; sacc += A0; sacc += A1; sacc += A2; sacc += A3; AF_PIN(sacc); W0; W1; AF_PIN(PW); AF_SBAR(); } while (0)
#define AF_GA3(MF, A0, A1, A2, W0, W1, PW) do { MF; sacc += A0; sacc += A1; sacc += A2; AF_PIN(sacc); W0; W1; AF_PIN(PW); AF_SBAR(); } while (0)
#define AF_GA2(MF, A0, A1, W0, PW) do { MF; sacc += A0; sacc += A1; AF_PIN(sacc); W0; AF_PIN(PW); AF_SBAR(); } while (0)
#define AF_GB(MF, X, B) do { MF; X[B] = AF_EX(X[B]); X[B + 1] = AF_EX(X[B + 1]); X[B + 2] = AF_EX(X[B + 2]); X[B + 3] = AF_EX(X[B + 3]); AF_PIN(X); AF_SBAR(); } while (0)
#define AF_KRD(G, j) do { if ((j) < ND0) { if (G) { kload2(kf, kp0 + s_next * KSLOT, (j) < ND0 ? (j) : 0); AF_SBAR(); } } } while (0)
  const f32x16 zero16 = f32x16{};
#define AF_PHASE_A12(C0, C1, P0, P1, t, GK, GV) do { \
    AF_VRD(0); float sacc = (P0[0] + P0[1]); \
    AF_GA3(C0 = AF_MF(kf[0], qr[0], zero16), P0[2], P0[3], P0[4],     pw0[0] = AF_PKW(P0, 0), pw0[1] = AF_PKW(P0, 2), pw0); \
    AF_VRD(4); AF_GA3(C1 = AF_MF(kf[1], qr[0], zero16), P0[5], P0[6], P0[7],     pw0[2] = AF_PKW(P0, 4), pw0[3] = AF_PKW(P0, 6), pw0); \
    AF_VRD(1); AF_GA3(C0 = AF_MF(kf[2], qr[1], C0),     P0[8], P0[9], P0[10],    pw1[0] = AF_PKW(P0, 8), pw1[1] = AF_PKW(P0, 10), pw1); \
    AF_VRD(5); AF_GA3(C1 = AF_MF(kf[3], qr[1], C1),     P0[11], P0[12], P0[13],  pw1[2] = AF_PKW(P0, 12), pw1[3] = AF_PKW(P0, 14), pw1); \
    AF_VRD(2); AF_GA3(C0 = AF_MF(kf[4], qr[2], C0),     P0[14], P0[15], P1[0],   pw2[0] = AF_PKW(P1, 0), pw2[1] = AF_PKW(P1, 2), pw2); \
    AF_VRD(6); AF_GA3(C1 = AF_MF(kf[5], qr[2], C1),     P1[1], P1[2], P1[3],     pw2[2] = AF_PKW(P1, 4), pw2[3] = AF_PKW(P1, 6), pw2); \
    AF_VRD(3); AF_GA2(C0 = AF_MF(kf[6], qr[3], C0),     P1[4], P1[5],            pw3[0] = AF_PKW(P1, 8), pw3); \
    AF_VRD(7); AF_GA2(C1 = AF_MF(kf[7], qr[3], C1),     P1[6], P1[7],            pw3[1] = AF_PKW(P1, 10), pw3); \
    AF_GA2(C0 = AF_MF(kf[8 % DKC], qr[4 % ND0], C0),    P1[8], P1[9],            pw3[2] = AF_PKW(P1, 12), pw3); \
    if (GK) { AF_DMA_KA((t) + 3, s_cur * KSLOT); AF_SBAR(); } \
    AF_GA2(C1 = AF_MF(kf[9 % DKC], qr[4 % ND0], C1),    P1[10], P1[11],          pw3[3] = AF_PKW(P1, 14), pw3); \
    if (GK) { AF_DMA_KB((t) + 3, s_cur * KSLOT); AF_SBAR(); } \
    { C0 = AF_MF(kf[10 % DKC], qr[5 % ND0], C0); sacc += P1[12]; sacc += P1[13]; AF_PIN(sacc); AF_SBAR(); } \
    if (GV) { AF_DMA_V((t) + 1, s_next * VSLOT); AF_SBAR(); } \
    { C1 = AF_MF(kf[11 % DKC], qr[5 % ND0], C1); sacc += P1[14]; sacc += P1[15]; AF_PIN(sacc); AF_SBAR(); } \
    l_reg += sacc; } while (0)
#define AF_PHASE_A8(C0, C1, P0, P1, t, GK, GV) do { \
    AF_VRD(0); float sacc = (P0[0] + P0[1]); \
    AF_GA4(C0 = AF_MF(kf[0], qr[0], zero16), P0[2], P0[3], P0[4], P0[5],       pw0[0] = AF_PKW(P0, 0), pw0[1] = AF_PKW(P0, 2), pw0); \
    AF_VRD(4); AF_GA4(C1 = AF_MF(kf[1], qr[0], zero16), P0[6], P0[7], P0[8], P0[9],       pw0[2] = AF_PKW(P0, 4), pw0[3] = AF_PKW(P0, 6), pw0); \
    AF_VRD(1); AF_GA4(C0 = AF_MF(kf[2], qr[1], C0),     P0[10], P0[11], P0[12], P0[13],   pw1[0] = AF_PKW(P0, 8), pw1[1] = AF_PKW(P0, 10), pw1); \
    AF_VRD(5); AF_GA4(C1 = AF_MF(kf[3], qr[1], C1),     P0[14], P0[15], P1[0], P1[1],     pw1[2] = AF_PKW(P0, 12), pw1[3] = AF_PKW(P0, 14), pw1); \
    AF_VRD(2); AF_GA4(C0 = AF_MF(kf[4], qr[2], C0),     P1[2], P1[3], P1[4], P1[5],       pw2[0] = AF_PKW(P1, 0), pw2[1] = AF_PKW(P1, 2), pw2); \
    AF_VRD(6); AF_GA4(C1 = AF_MF(kf[5], qr[2], C1),     P1[6], P1[7], P1[8], P1[9],       pw2[2] = AF_PKW(P1, 4), pw2[3] = AF_PKW(P1, 6), pw2); \
    AF_VRD(3); AF_GA4(C0 = AF_MF(kf[6], qr[3], C0),     P1[10], P1[11], P1[12], P1[13],   pw3[0] = AF_PKW(P1, 8), pw3[1] = AF_PKW(P1, 10), pw3); \
    AF_VRD(7); AF_GA4(C1 = AF_MF(kf[7], qr[3], C1),     P1[14], P1[15], 0.f, 0.f,         pw3[2] = AF_PKW(P1, 12), pw3[3] = AF_PKW(P1, 14), pw3); \
    l_reg += sacc; \
    if (GK) { AF_DMA_KA((t) + 3, s_cur * KSLOT); } if (GV) { AF_DMA_V((t) + 1, s_next * VSLOT); } } while (0)
#define AF_STEP(C0, C1, P0, P1, t, GK, GV, GL) do { AF_SBAR(); \
    const lds_cptr vp_ = vp0 + s_prev * VSLOT; \
    if constexpr (DKC == 12) AF_PHASE_A12(C0, C1, P0, P1, t, GK, GV); else AF_PHASE_A8(C0, C1, P0, P1, t, GK, GV); \
    if constexpr (U::HAS_MASK) u.mask(C0, C1, (t), wid, r32, hi); \
    AF_SBAR(); \
    AF_GB(o[0] = AF_MF(AF_PAF(0), AF_VFR(0), o[0]), C0, 0);  AF_KRD(GL, 0); \
    AF_GB(o[1] = AF_MF(AF_PAF(0), AF_VFR(4), o[1]), C0, 4);  AF_KRD(GL, 1); \
    AF_GB(o[0] = AF_MF(AF_PAF(1), AF_VFR(1), o[0]), C0, 8);  AF_KRD(GL, 2); \
    AF_GB(o[1] = AF_MF(AF_PAF(1), AF_VFR(5), o[1]), C0, 12); AF_KRD(GL, 3); \
    AF_GB(o[0] = AF_MF(AF_PAF(2), AF_VFR(2), o[0]), C1, 0);  AF_KRD(GL, 4); \
    AF_GB(o[1] = AF_MF(AF_PAF(2), AF_VFR(6), o[1]), C1, 4);  AF_KRD(GL, 5); \
    AF_GB(o[0] = AF_MF(AF_PAF(3), AF_VFR(3), o[0]), C1, 8); \
    AF_GB(o[1] = AF_MF(AF_PAF(3), AF_VFR(7), o[1]), C1, 12); \
  } while (0)
  int t = 1;
  for (; t + 3 < NT; t += 2) {
    AF_STEP(pB0, pB1, pA0, pA1, t, true, true, true);     AF_WAITN(1, 1); AF_ROT();
    AF_STEP(pA0, pA1, pB0, pB1, t + 1, true, true, true); AF_WAITN(1, 1); AF_ROT();
  }
  AF_STEP(pB0, pB1, pA0, pA1, NT - 3, false, true, true);  AF_WAITN(0, 1); AF_ROT();
  AF_STEP(pA0, pA1, pB0, pB1, NT - 2, false, true, true);  AF_WAIT_BAR(0); AF_ROT();
  AF_STEP(pB0, pB1, pA0, pA1, NT - 1, false, false, false);
  { float sacc = pB0[0] + pB0[1];
#pragma unroll
    for (int r = 2; r < 16; ++r) sacc += pB0[r];
#pragma unroll
    for (int r = 0; r < 16; ++r) sacc += pB1[r];
    l_reg += sacc;
    pw0 = (u32x4){AF_PKW(pB0, 0), AF_PKW(pB0, 2), AF_PKW(pB0, 4), AF_PKW(pB0, 6)}; pw1 = (u32x4){AF_PKW(pB0, 8), AF_PKW(pB0, 10), AF_PKW(pB0, 12), AF_PKW(pB0, 14)};
    pw2 = (u32x4){AF_PKW(pB1, 0), AF_PKW(pB1, 2), AF_PKW(pB1, 4), AF_PKW(pB1, 6)}; pw3 = (u32x4){AF_PKW(pB1, 8), AF_PKW(pB1, 10), AF_PKW(pB1, 12), AF_PKW(pB1, 14)};
    AF_SBAR();
    const lds_cptr vp_ = vp0 + s_cur * VSLOT;
#pragma unroll
    for (int i = 0; i < 8; ++i) { vlo[i] = vtr(vp_ + ((i >> 2) * 4096 + (i & 3) * 1024)); vhi[i] = vtr(vp_ + ((i >> 2) * 4096 + (i & 3) * 1024 + 512)); }
    o[0] = AF_MF(AF_PAF(0), AF_VFR(0), o[0]); o[1] = AF_MF(AF_PAF(0), AF_VFR(4), o[1]);
    o[0] = AF_MF(AF_PAF(1), AF_VFR(1), o[0]); o[1] = AF_MF(AF_PAF(1), AF_VFR(5), o[1]);
    o[0] = AF_MF(AF_PAF(2), AF_VFR(2), o[0]); o[1] = AF_MF(AF_PAF(2), AF_VFR(6), o[1]);
    o[0] = AF_MF(AF_PAF(3), AF_VFR(3), o[0]); o[1] = AF_MF(AF_PAF(3), AF_VFR(7), o[1]); }
  { auto rr = __builtin_amdgcn_permlane32_swap(__float_as_uint(l_reg), __float_as_uint(l_reg), false, false); l_reg = __uint_as_float(rr[0]) + __uint_as_float(rr[1]); }
  l_reg += __builtin_amdgcn_exp2f(u.sink(wid));
  if (hi == 0) wsf[32 + r32] = l_reg; asm volatile("s_waitcnt lgkmcnt(0)" ::: "memory");
  float rli[16];
#pragma unroll
  for (int r = 0; r < 16; ++r) rli[r] = __builtin_amdgcn_rcpf(wsf[32 + crow(r, hi)]);
  bf16* Ow = u.orow0(wid);
  { bf16* stg = (bf16*)(shm + LDS_OST) + wid * 2048;
#pragma unroll
    for (int r = 0; r < 16; ++r) { const int orow = crow(r, hi);
#pragma unroll
      for (int d0 = 0; d0 < 2; ++d0) stg[orow * 64 + d0 * 32 + r32] = (bf16)(cvtpk_s(o[d0][r] * rli[r], 0.f) & 0xffffu); }
    asm volatile("s_waitcnt lgkmcnt(0)" ::: "memory");
#pragma unroll
    for (int i = 0; i < 4; ++i) { const int row = i * 8 + (lane >> 3), ch = lane & 7; const u32x4 v = *(const u32x4*)(stg + row * 64 + ch * 8); *(u32x4*)(Ow + (long)row * 1024 + ch * 8) = v; } }
  asm volatile("s_waitcnt vmcnt(0) lgkmcnt(0)\n\ts_barrier" ::: "memory");
#undef AF_DMA_KA
#undef AF_DMA_KB
#undef AF_DMA_K
#undef AF_DMA_V
#undef AF_WAITN
#undef AF_ROT
#undef AF_PKW
#undef AF_PAF
#undef AF_VFR
#undef AF_PIN
#undef AF_MF
#undef AF_EX
#undef AF_VRD
#undef AF_GA4
#undef AF_GA3
#undef AF_GA2
#undef AF_GB
#undef AF_KRD
#undef AF_PHASE_A12
#undef AF_PHASE_A8
#undef AF_STEP
}

constexpr int ROWS_LAT = 16384;
constexpr float LOG2E_ = 1.4426950408889634f;
__device__ __forceinline__ int clampi(int v, int lo, int hi_) { return v < lo ? lo : (v > hi_ ? hi_ : v); }
struct FDense {
  static constexpr bool HAS_MASK = false;
  const bf16* Q; const bf16* kbase; const bf16* vbase; const bf16* krbase; bf16* O; int b, h, qb; static constexpr int kpitch = 2048, vpitch = 2048;
  __device__ __forceinline__ void init(const bf16* Q_, const bf16* KV, const bf16* KR, bf16* O_, int b_, int h_, int qb_) { Q = Q_; kbase = KV + 64 * h_; vbase = KV + 1024 + 64 * h_; krbase = KR; O = O_; b = b_; h = h_; qb = qb_; }
  __device__ __forceinline__ int nt() const { return 132; }
  __device__ __forceinline__ long trow(int t) const { return t < 4 ? (long)(ROWS_LAT + 256 * b + 64 * t) : (long)(8192 * b + 64 * (t - 4)); }
  __device__ __forceinline__ const bf16* qptr(int wid, int r32, int d0, int hi) const { const bf16* qp = Q + (long)(8192 * b + 256 * qb + 32 * wid + r32) * 1536;
    return d0 < 4 ? qp + 64 * h + 16 * d0 + 8 * hi : qp + 1024 + 32 * h + 16 * (d0 - 4) + 8 * hi; }
  __device__ __forceinline__ void mask(f32x16&, f32x16&, int, int, int, int) const {}
  __device__ __forceinline__ float sink(int) const { return -INFINITY; }
  __device__ __forceinline__ bf16* orow0(int wid) const { return O + (long)(8192 * b + 256 * qb + 32 * wid) * 1024 + 64 * h; }
};
struct FWin {
  static constexpr bool HAS_MASK = true; static constexpr int kpitch = 2304, vpitch = 2304;
  const bf16* QKV; const bf16* kbase; const bf16* vbase; const bf16* krbase; bf16* O; const float* sinkp; int b, n, g, hh, i0, cnt;
  __device__ __forceinline__ void init(const bf16* QKV_, bf16* O_, const float* sk, int b_, int n_, int g_, int hh_) { QKV = QKV_; O = O_; sinkp = sk; b = b_; n = n_; g = g_; hh = hh_; krbase = nullptr;
    kbase = QKV_ + 512 + 64 * g_; vbase = QKV_ + 640 + 64 * g_; i0 = (n_ == 0) ? 2 : 0; cnt = (n_ == 0 || n_ == 63) ? 4 : 6; }
  __device__ __forceinline__ int nt() const { return 4 + cnt; }
  __device__ __forceinline__ int kpos0(int t) const { return 128 * (n - 1) + 64 * (i0 + t - 4); }
  __device__ __forceinline__ long trow(int t) const { return t < 4 ? (long)(ROWS_LAT + 256 * b + 64 * t) : (long)(8192 * b + kpos0(t)); }
  __device__ __forceinline__ int head(int wid) const { return 4 * g + 2 * hh + (wid >> 2); }
  __device__ __forceinline__ int qpos0(int wid) const { return 128 * n + 32 * (wid & 3); }
  __device__ __forceinline__ const bf16* qptr(int wid, int r32, int d0, int hi) const { return QKV + (long)(8192 * b + qpos0(wid) + r32) * 2304 + 64 * head(wid) + 16 * d0 + 8 * hi; }
  __device__ __forceinline__ void mask(f32x16& p0, f32x16& p1, int t, int wid, int r32, int hi) const {
    if (t < 4) return;
    const int k0 = kpos0(t), q0 = qpos0(wid);
    if (k0 - (q0 + 31) >= -128 && k0 + 63 - q0 <= 128) return;
    asm volatile("" : "+v"(r32), "+v"(hi));
    const int dq = k0 - (q0 + r32);
#pragma unroll
    for (int r = 0; r < 16; ++r) { const int d = dq + crow(r, hi); if (d > 128 || d < -128) p0[r] = -INFINITY; if (d + 32 > 128 || d + 32 < -128) p1[r] = -INFINITY; }
  }
  __device__ __forceinline__ float sink(int wid) const { return sinkp[head(wid)] * LOG2E_; }
  __device__ __forceinline__ bf16* orow0(int wid) const { return O + (long)(8192 * b + qpos0(wid)) * 1024 + 64 * head(wid); }
};
struct FNa {
  static constexpr bool HAS_MASK = true; static constexpr int kpitch = 2304, vpitch = 2304;
  const bf16* QKV; const bf16* kbase; const bf16* vbase; const bf16* krbase; bf16* O; const float* rpbl; int b, h, R4, krlo, nloc;
  __device__ __forceinline__ void init(const bf16* QKV_, bf16* O_, const float* rpbl_, int b_, int h_, int R4_) { QKV = QKV_; O = O_; rpbl = rpbl_; b = b_; h = h_; R4 = R4_; krbase = nullptr;
    kbase = QKV_ + 1280 + 64 * h_; vbase = QKV_ + 1792 + 64 * h_; krlo = clampi(4 * R4_ - 4, 0, 120); nloc = clampi(4 * R4_ - 1, 0, 120) + 7 - krlo + 1; }
  __device__ __forceinline__ int nt() const { return (4 + nloc + 1) & ~1; }
  __device__ __forceinline__ long trow(int t) const { return (t < 4 || t >= 4 + nloc) ? (long)(ROWS_LAT + 256 * b + 64 * (t & 3)) : (long)(8192 * b + 64 * (krlo + t - 4)); }
  __device__ __forceinline__ int qrow(int wid) const { return 4 * R4 + (wid >> 1); }
  __device__ __forceinline__ const bf16* qptr(int wid, int r32, int d0, int hi) const { return QKV + (long)(8192 * b + 64 * qrow(wid) + 32 * (wid & 1) + r32) * 2304 + 768 + 64 * h + 16 * d0 + 8 * hi; }
  __device__ __forceinline__ void mask(f32x16& p0, f32x16& p1, int t, int wid, int r32, int hi) const {
    if (t < 4) return;
    const int kr = krlo + t - 4, w0 = clampi(qrow(wid) - 4, 0, 120);
    if (t >= 4 + nloc || kr < w0 || kr > w0 + 7) {
#pragma unroll
      for (int r = 0; r < 16; ++r) { p0[r] = -INFINITY; p1[r] = -INFINITY; }
      return; }
    asm volatile("" : "+v"(r32), "+v"(hi));
    const int qc = 32 * (wid & 1) + r32, c0 = clampi(qc - 8, 0, 48);
    const float* brow = rpbl + (kr - qrow(wid) + 7) * 31 + 15;
#pragma unroll
    for (int r = 0; r < 16; ++r) {
      { const int kc = crow(r, hi); const bool ok = kc >= c0 && kc < c0 + 16; const float bv = brow[clampi(kc - qc, -15, 15)]; p0[r] = ok ? p0[r] + bv : -INFINITY; }
      { const int kc = 32 + crow(r, hi); const bool ok = kc >= c0 && kc < c0 + 16; const float bv = brow[clampi(kc - qc, -15, 15)]; p1[r] = ok ? p1[r] + bv : -INFINITY; } }
  }
  __device__ __forceinline__ float sink(int) const { return -INFINITY; }
  __device__ __forceinline__ bf16* orow0(int wid) const { return O + (long)(8192 * b + 64 * qrow(wid) + 32 * (wid & 1)) * 1024 + 512 + 64 * h; }
};
struct FCtx {
  static constexpr bool HAS_MASK = false; static constexpr int kpitch = 2304, vpitch = 2304;
  const bf16* QKV; const bf16* kbase; const bf16* vbase; const bf16* krbase; bf16* O; const float* sinkp; int b, hx, qcol, ocol;
  __device__ __forceinline__ void init(const bf16* QKV_, bf16* O_, const float* sk, int b_, int hx_) { QKV = QKV_; O = O_; sinkp = sk; b = b_; hx = hx_; krbase = nullptr;
    if (hx_ < 8) { qcol = 64 * hx_; kbase = QKV_ + 512 + 64 * (hx_ >> 2); vbase = QKV_ + 640 + 64 * (hx_ >> 2); ocol = 64 * hx_; }
    else { const int h = hx_ - 8; qcol = 768 + 64 * h; kbase = QKV_ + 1280 + 64 * h; vbase = QKV_ + 1792 + 64 * h; ocol = 512 + 64 * h; } }
  __device__ __forceinline__ int nt() const { return 4; }
  __device__ __forceinline__ long trow(int t) const { return (long)(ROWS_LAT + 256 * b + 64 * (t & 3)); }
  __device__ __forceinline__ const bf16* qptr(int wid, int r32, int d0, int hi) const { return QKV + (long)(ROWS_LAT + 256 * b + 32 * wid + r32) * 2304 + qcol + 16 * d0 + 8 * hi; }
  __device__ __forceinline__ void mask(f32x16&, f32x16&, int, int, int, int) const {}
  __device__ __forceinline__ float sink(int) const { return hx < 8 ? sinkp[hx] * LOG2E_ : -INFINITY; }
  __device__ __forceinline__ bf16* orow0(int wid) const { return O + (long)(ROWS_LAT + 256 * b + 32 * wid) * 1024 + ocol; }
};
#undef AF_SBAR
#undef AF_WAIT_BAR
}
constexpr int NWAVES = 8;
#ifndef MK_PER_PHASE
#define MK_PER_PHASE 0
#endif
constexpr int BATCH = 2, SEQ = 8192, DM = 1024, CTXL = 256, FF = 4096;
constexpr int ML = BATCH * SEQ, MC = BATCH * CTXL, MR = ML + MC;
constexpr int NQKV = 2304, NCIN = 768, NUQ = 1536, NUKV = 2048;
constexpr float NORM_EPS = 1e-6f;
constexpr int ADA_KS = 16;
constexpr size_t MiB = 1u << 20;
constexpr size_t WS_CTL = 0, CTL_ZERO_BYTES = 64 * 1024;
constexpr size_t WS_MODP = 1 * MiB;
constexpr size_t WS_MOD = 3 * MiB + 512 * 1024;
constexpr size_t WS_ROPE = 3 * MiB + 768 * 1024;
constexpr size_t WS_HPAR = WS_ROPE + 32 * 1024;
constexpr size_t WS_CTXRES = 4 * MiB;
constexpr size_t WS_WQKV = 6 * MiB, WS_WO0 = WS_WQKV + 4608 * 1024, WS_W1_0 = WS_WO0 + 2 * MiB, WS_W2_0 = WS_W1_0 + 8 * MiB, WS_W1_1 = WS_W2_0 + 8 * MiB, WS_W2_1 = WS_W1_1 + 8 * MiB;
constexpr size_t WS_WIN = WS_W2_1 + 8 * MiB, WS_WUQ = WS_WIN + 1536 * 1024, WS_WUKV = WS_WUQ + 1152 * 1024, WS_WO1 = WS_WUKV + 1 * MiB, WS_WEND = WS_WO1 + 2 * MiB;
constexpr size_t WS_AR = 51 * MiB;
static_assert(WS_WEND <= WS_AR, "weights overlap the arena");
constexpr size_t WS_XN = WS_AR, WS_H = WS_AR + 33 * MiB;
constexpr size_t WS_QKV = WS_AR + 33 * MiB, WS_O0 = WS_AR + 108 * MiB;
constexpr size_t WS_CQKV = WS_AR + 33 * MiB, WS_CQN = WS_AR + 58 * MiB, WS_CKVN = WS_AR + 71 * MiB, WS_KR = WS_AR + 80 * MiB, WS_Q1 = WS_AR + 82 * MiB, WS_KV1 = WS_AR + 130 * MiB, WS_O1 = WS_AR;
constexpr size_t WS_K6N = WS_AR + 34 * MiB, WS_K6R = WS_AR + 48 * MiB;
constexpr size_t WS_PART5 = WS_AR + 33 * MiB;
constexpr size_t WS_PART8 = WS_AR + 166 * MiB;
constexpr size_t WS_END = 256 * MiB;
static_assert(WS_PART8 + (size_t)16 * 512 * 1024 * 4 <= WS_END && WS_KV1 + (size_t)MR * NUKV * 2 <= WS_END && WS_H + (size_t)MR * FF * 2 <= WS_END, "d_ws map");
constexpr int CW_BAR = 4096;
constexpr int RING_OFF = 0, RING_BYTES = 131072;
constexpr int LDSCTL_OFF = RING_BYTES, MISC_OFF = LDSCTL_OFF + 320;
constexpr int LDS_BYTES = 147456;
static_assert(att::L_END <= RING_BYTES && attf::LDS_BYTES <= RING_BYTES, "attention LDS");

#define GAS __attribute__((address_space(1)))
#define LAS __attribute__((address_space(3)))
typedef unsigned short bf16;
typedef unsigned v4u __attribute__((ext_vector_type(4)));
typedef unsigned v2u __attribute__((ext_vector_type(2)));
typedef float f32x4 __attribute__((ext_vector_type(4)));
typedef GAS unsigned gu32;
#define RLX_AGENT __ATOMIC_RELAXED, __HIP_MEMORY_SCOPE_AGENT
#define LDS_WAIT() asm volatile("s_waitcnt lgkmcnt(0)" ::: "memory")
#define VM_WAIT() asm volatile("s_waitcnt vmcnt(0)" ::: "memory")
__device__ __forceinline__ unsigned f2bf(float f) { unsigned u = __builtin_bit_cast(unsigned, f); return (u + 0x7fffu + ((u >> 16) & 1u)) >> 16; }
__device__ __forceinline__ unsigned pk2(float lo, float hi) { return f2bf(lo) | (f2bf(hi) << 16); }
__device__ __forceinline__ float bf2f(unsigned short h) { return __builtin_bit_cast(float, (unsigned)h << 16); }
__device__ __forceinline__ float bflo(unsigned w) { return __builtin_bit_cast(float, w << 16); }
__device__ __forceinline__ float bfhi(unsigned w) { return __builtin_bit_cast(float, w & 0xffff0000u); }

#define XB_TMO      128
#define XB_XCNT(j)  (256  + 64 * (j))
#define XB_XSUB(j)  (1280 + 64 * (j))
#define XB_XGEN(j)  (2304 + 64 * (j))
#define XB_TOP      3328
#define XB_TOPGEN   3392
#define XCD_BAR_WORDS 3456
#define XB_SPIN_CAP (1u << 18)

__device__ __forceinline__ unsigned xb_ld(unsigned* p)              { return __hip_atomic_load(p, __ATOMIC_RELAXED, __HIP_MEMORY_SCOPE_AGENT); }
__device__ __forceinline__ unsigned xb_add(unsigned* p, unsigned v) { return __hip_atomic_fetch_add(p, v, __ATOMIC_RELAXED, __HIP_MEMORY_SCOPE_AGENT); }
__device__ __forceinline__ unsigned xb_xcc_id() { return (unsigned)__builtin_amdgcn_s_getreg((3 << 11) | 20) & 0xFu; }
#define XB_SPIN(cond, bar) do { unsigned _sp = 0; while (cond) { __builtin_amdgcn_s_sleep(1); \
    if ((++_sp & 255u) == 0u) { if (xb_ld(&(bar)[XB_TMO])) break; if (_sp > XB_SPIN_CAP) { atomicAdd(&(bar)[XB_TMO], 1u); break; } } } } while (0)

struct XcdBarrier {
    unsigned* bar; unsigned x;
    volatile LAS unsigned* st;
};

__device__ __forceinline__ XcdBarrier xcd_barrier_post(unsigned* bar, volatile LAS unsigned* st) {
    XcdBarrier b; b.bar = bar; b.x = xb_xcc_id(); b.st = st;
    if (threadIdx.x == 0) (void)xb_add(&bar[XB_XCNT(b.x)], 1u);
    return b;
}
__device__ __forceinline__ void xcd_barrier_complete(unsigned* bar, unsigned x, unsigned& nloc, unsigned& nx) {
    const unsigned G = gridDim.x * gridDim.y * gridDim.z;
    unsigned sum, cnt, mine, sp = 0u;
    for (;;) {
        sum = 0u; cnt = 0u; mine = 0u;
#pragma unroll
        for (unsigned j = 0; j < 16; ++j) { const unsigned c = xb_ld(&bar[XB_XCNT(j)]); sum += c; cnt += (c > 0u) ? 1u : 0u; mine = (j == x) ? c : mine; }
        if (sum == G) break;
        __builtin_amdgcn_s_sleep(1);
        if ((++sp & 255u) == 0u) { if (xb_ld(&bar[XB_TMO])) break; if (sp > XB_SPIN_CAP) { atomicAdd(&bar[XB_TMO], 1u); break; } }
    }
    nloc = mine > 0u ? mine : 1u; nx = cnt > 0u ? cnt : 1u;
}

__device__ __forceinline__ void xcd_barrier(const XcdBarrier& b) {
    asm volatile("s_waitcnt vmcnt(0)" ::: "memory");
    __syncthreads();
    if (threadIdx.x == 0) {
        unsigned* bar = b.bar;
        __builtin_amdgcn_s_waitcnt(0);
        unsigned nloc = b.st[0], nx = b.st[1];
        if (nloc == 0u) { xcd_barrier_complete(bar, b.x, nloc, nx); b.st[0] = nloc; b.st[1] = nx; }
        const unsigned old = xb_add(&bar[XB_XSUB(b.x)], 1u);
        const unsigned gen = old / nloc;
        if (old + 1u == (gen + 1u) * nloc) {
            __builtin_amdgcn_fence(__ATOMIC_RELEASE, "agent");
            asm volatile("s_waitcnt vmcnt(0)" ::: "memory");
            const unsigned og = xb_add(&bar[XB_TOP], 1u);
            const unsigned tg = og / nx;
            if (og + 1u == (tg + 1u) * nx) xb_add(&bar[XB_TOPGEN], 1u);
            else XB_SPIN(xb_ld(&bar[XB_TOPGEN]) == tg, bar);
            __builtin_amdgcn_fence(__ATOMIC_ACQUIRE, "agent");
            xb_add(&bar[XB_XGEN(b.x)], 1u);
            asm volatile("s_waitcnt vmcnt(0)" ::: "memory");
        } else {
            XB_SPIN(xb_ld(&bar[XB_XGEN(b.x)]) == gen, bar);
            __builtin_amdgcn_fence(__ATOMIC_ACQUIRE, "agent");
            asm volatile("s_waitcnt vmcnt(0)" ::: "memory");
        }
    }
    __syncthreads();
}


template <int K> __device__ __forceinline__ const float* ldarg() {
    auto ka = __builtin_amdgcn_kernarg_segment_ptr();
    const __attribute__((address_space(1))) float* p; asm volatile("s_load_dwordx2 %0, %1, %2\n\ts_waitcnt lgkmcnt(0)" : "=s"(p) : "s"(ka), "i"(K * 8) : "memory"); return (const float*)p;
}
#define ARG(k) (ldarg<k>())
#define ARG_OUT ((float*)ldarg<28>())
#define ARG_WS ((unsigned char*)ldarg<29>())
struct Frame {
    LAS unsigned char* lds;
    volatile LAS unsigned* MISC;
    gu32* ctl;
    int tid, lane, wave;
    int vcu, G, bx;
    float* out; unsigned char* ws;
};
__device__ __forceinline__ float shx(float v, int mask, int lane) { return __builtin_bit_cast(float, __builtin_amdgcn_ds_bpermute((lane ^ mask) << 2, __builtin_bit_cast(int, v))); }
__device__ __forceinline__ float wave_sum(float v, int lane) {
#pragma unroll
    for (int o = 1; o < 64; o <<= 1) v += shx(v, o, lane);
    return v;
}
__device__ __forceinline__ void p0_transpose_item(const float* W, int K, int N, bf16* WT, int pmode, LAS float* scr, int item, int lane) {
    const int nblk = N / 32, kb = item / nblk, nb = item % nblk, k0 = 64 * kb, n0 = 32 * nb;
    int r0 = n0;
    if (pmode == 1) { const int h = n0 / 96, d = n0 % 96; r0 = d < 64 ? h * 64 + d : 1024 + h * 32 + (d - 64); }
    else if (pmode == 2) { const int h = n0 / 128, d = n0 % 128; r0 = d < 64 ? h * 64 + d : 1024 + h * 64 + (d - 64); }
#pragma unroll 8
    for (int i = 0; i < 32; ++i) { const int kk = 2 * i + (lane >> 5); scr[kk * 33 + (lane & 31)] = W[(size_t)(k0 + kk) * N + n0 + (lane & 31)]; }
    LDS_WAIT(); asm volatile("" ::: "memory");
    const int c = lane & 7;
#pragma unroll
    for (int j = 0; j < 4; ++j) { const int n = (lane >> 3) + 8 * j; const LAS float* s = scr + (8 * c) * 33 + n;
        v4u o; o.x = pk2(s[0 * 33], s[1 * 33]); o.y = pk2(s[2 * 33], s[3 * 33]); o.z = pk2(s[4 * 33], s[5 * 33]); o.w = pk2(s[6 * 33], s[7 * 33]);
        *(GAS v4u*)(WT + (size_t)(r0 + n) * K + k0 + 8 * c) = o; }
    LDS_WAIT(); asm volatile("" ::: "memory");
}
__device__ __forceinline__ float silu_f(float v) { return v / (1.f + __expf(-v)); }

__device__ __forceinline__ void p0_prologue(Frame& F) {
    LAS float* scr = (LAS float*)(F.lds + RING_OFF + F.wave * 16384);
    const float* c = ARG(1); const float* cctx = ARG(3);
    if (F.wave >= 5) {
        for (int it = F.vcu * 3 + (F.wave - 5); it < 2 * 24 * ADA_KS; it += F.G * 3) {
            const int l = it / (24 * ADA_KS), rem = it % (24 * ADA_KS), cg = rem / ADA_KS, ks = rem % ADA_KS;
            const float* W = ARG(4) + (size_t)l * DM * 6144 + cg * 256 + 4 * F.lane;
            f32x4 a0 = {0.f, 0.f, 0.f, 0.f}, a1 = a0, a2 = a0;
            const int kbeg = ks * (DM / ADA_KS);
#pragma unroll 8
            for (int k = kbeg; k < kbeg + DM / ADA_KS; ++k) {
                const f32x4 w = *(const GAS f32x4*)(W + (size_t)k * 6144);
                const float s0 = silu_f(c[k]), s1 = silu_f(c[DM + k]), s2 = silu_f(cctx[k]);
                a0 += w * s0; a1 += w * s1; a2 += w * s2;
            }
            float* P = (float*)(F.ws + WS_MODP) + ((size_t)(ks * 2 + l) * 3) * 6144 + cg * 256 + 4 * F.lane;
            *(GAS f32x4*)(P) = a0; *(GAS f32x4*)(P + 6144) = a1; *(GAS f32x4*)(P + 2 * 6144) = a2;
        }
    } else {
        const int gw = F.vcu * 5 + F.wave, NGW = F.G * 5;
        constexpr int I_QKV = 16 * 72, I_O = 16 * 32, I_1 = 16 * 128, I_2 = 64 * 32, I_IN = 16 * 21, I_UQ = 6 * 48, I_UKV = 4 * 64;
        constexpr int NITEMS = I_QKV + I_O + 2 * I_1 + 2 * I_2 + I_IN + I_UQ + I_UKV + I_O;
        for (int it = gw; it < NITEMS; it += NGW) {
            int r = it;
            if (r < I_QKV) { p0_transpose_item(ARG(10), DM, NQKV, (bf16*)(F.ws + WS_WQKV), 0, scr, r, F.lane); continue; } r -= I_QKV;
            if (r < I_O) { p0_transpose_item(ARG(11), DM, DM, (bf16*)(F.ws + WS_WO0), 0, scr, r, F.lane); continue; } r -= I_O;
            if (r < I_1) { p0_transpose_item(ARG(8), DM, FF, (bf16*)(F.ws + WS_W1_0), 0, scr, r, F.lane); continue; } r -= I_1;
            if (r < I_1) { p0_transpose_item(ARG(8) + (size_t)DM * FF, DM, FF, (bf16*)(F.ws + WS_W1_1), 0, scr, r, F.lane); continue; } r -= I_1;
            if (r < I_2) { p0_transpose_item(ARG(9), FF, DM, (bf16*)(F.ws + WS_W2_0), 0, scr, r, F.lane); continue; } r -= I_2;
            if (r < I_2) { p0_transpose_item(ARG(9) + (size_t)DM * FF, FF, DM, (bf16*)(F.ws + WS_W2_1), 0, scr, r, F.lane); continue; } r -= I_2;
            if (r < I_IN) { p0_transpose_item(ARG(18), DM, 672, (bf16*)(F.ws + WS_WIN), 0, scr, r, F.lane); continue; } r -= I_IN;
            if (r < I_UQ) { p0_transpose_item(ARG(21), 384, NUQ, (bf16*)(F.ws + WS_WUQ), 1, scr, r, F.lane); continue; } r -= I_UQ;
            if (r < I_UKV) { p0_transpose_item(ARG(22), 256, NUKV, (bf16*)(F.ws + WS_WUKV), 2, scr, r, F.lane); continue; } r -= I_UKV;
            p0_transpose_item(ARG(27), DM, DM, (bf16*)(F.ws + WS_WO1), 0, scr, r, F.lane);
        }
    }
    if (F.bx == 1 % F.G) {
        float* rt = (float*)(F.ws + WS_ROPE);
        for (int e = F.tid; e < 128 * 16; e += NWAVES * 64) { const int pos = e >> 4, i = e & 15; const float inv = exp2f(-(float)i * (13.287712379549449f / 16.f));
            float x = (float)pos * inv * 0.15915494309189535f; x -= rintf(x); rt[e] = __builtin_amdgcn_cosf(x); rt[2048 + e] = __builtin_amdgcn_sinf(x); }
        for (int e = F.tid; e < 128 * 8; e += NWAVES * 64) { const int pos = e >> 3, i = e & 7; const float inv = exp2f(-(float)i * (13.287712379549449f / 8.f));
            float x = (float)pos * inv * 0.15915494309189535f; x -= rintf(x); rt[4096 + e] = __builtin_amdgcn_cosf(x); rt[5120 + e] = __builtin_amdgcn_sinf(x); }
    }
    if (F.bx == 3 % F.G && F.tid < 64) {
        float* hp = (float*)(F.ws + WS_HPAR); const int i = F.tid;
        hp[i] = ARG(12)[i]; hp[64 + i] = ARG(13)[i]; hp[128 + i] = ARG(15)[i]; hp[192 + i] = ARG(16)[i]; hp[256 + i] = ARG(23)[i]; hp[320 + i] = ARG(24)[i & 31]; hp[384 + i] = ARG(25)[i];
        float a = fabsf(ARG(23)[i]), b_ = fabsf(ARG(25)[i]), c_ = fabsf(ARG(24)[i & 31]), d_ = fabsf(ARG(26)[i & 31]);
#pragma unroll
        for (int o_ = 1; o_ < 64; o_ <<= 1) { a = fmaxf(a, shx(a, o_, i)); b_ = fmaxf(b_, shx(b_, o_, i)); c_ = fmaxf(c_, shx(c_, o_, i)); d_ = fmaxf(d_, shx(d_, o_, i)); }
        const float bound = (64.f * a * b_ + 32.f * c_ * d_) * (0.10206207261596575f * 1.4426950408889634f);
        if (i == 0) hp[448] = (bound < 64.f && fmaxf(fmaxf(a, b_), fmaxf(c_, d_)) < 3.f) ? 1.f : 0.f;
    }
    if (F.bx == 2 % F.G) {
        GAS v4u* z = (GAS v4u*)((bf16*)(F.ws + WS_WIN) + (size_t)672 * DM);
        unsigned zz = 0u; asm volatile("" : "+v"(zz));
        for (int e = F.tid; e < 96 * DM / 8; e += NWAVES * 64) z[e] = (v4u){zz, zz, zz, zz};
    }
}

__device__ __forceinline__ void norm_phase(Frame& F, const float* src_lat, const float* src_ctx, int nrows, const float* gw_, int layer, int which  , bool from_partials, const float* parts = nullptr, int nparts = 0) {
    LAS float* gl = (LAS float*)(F.lds + RING_OFF); LAS float* scl = gl + 1024; LAS float* shl = scl + 3 * 1024;
    const float* modp = (const float*)(F.ws + WS_MODP); const float* mod = (const float*)(F.ws + WS_MOD); const float* ada_b = ARG(5);
    const int offsh = which * 3072, offsc = which * 3072 + 1024;
    for (int i = F.tid; i < 1024; i += NWAVES * 64) {
        gl[i] = gw_[i];
#pragma unroll
        for (int cnd = 0; cnd < 3; ++cnd) {
            float sh, sc;
            if (from_partials) { sh = ada_b[layer * 6144 + offsh + i]; sc = ada_b[layer * 6144 + offsc + i];
                float ph[ADA_KS], pc[ADA_KS];
#pragma unroll
                for (int ks = 0; ks < ADA_KS; ++ks) { const float* p = modp + ((size_t)(ks * 2 + layer) * 3 + cnd) * 6144; ph[ks] = p[offsh + i]; pc[ks] = p[offsc + i]; }
#pragma unroll
                for (int ks = 0; ks < ADA_KS; ++ks) { sh += ph[ks]; sc += pc[ks]; } }
            else { sh = mod[(layer * 3 + cnd) * 6144 + offsh + i]; sc = mod[(layer * 3 + cnd) * 6144 + offsc + i]; }
            scl[cnd * 1024 + i] = 1.f + sc; shl[cnd * 1024 + i] = sh;
        }
    }
    if (from_partials) {
        float* modw = (float*)(F.ws + WS_MOD);
        for (int e = F.vcu * (NWAVES * 64) + F.tid; e < 2 * 3 * 6144; e += F.G * NWAVES * 64) {
            const int l = e / (3 * 6144), rem = e % (3 * 6144), cnd = rem / 6144, col = rem % 6144;
            float v = ada_b[l * 6144 + col];
            float pv[ADA_KS];
#pragma unroll
            for (int ks = 0; ks < ADA_KS; ++ks) pv[ks] = modp[((size_t)(ks * 2 + l) * 3 + cnd) * 6144 + col];
#pragma unroll
            for (int ks = 0; ks < ADA_KS; ++ks) v += pv[ks];
            modw[e] = v;
        }
    }
    __syncthreads();
    bf16* XN = (bf16*)(F.ws + WS_XN);
    const int gw = F.vcu * NWAVES + F.wave, NGW = F.G * NWAVES;
    for (int m = gw; m < nrows; m += NGW) {
        const float* xrow = m < ML ? src_lat + (size_t)m * DM : src_ctx + (size_t)(m - ML) * DM;
        const int cnd = m < SEQ ? 0 : (m < ML ? 1 : 2);
        const GAS f32x4* xr = (const GAS f32x4*)xrow + F.lane;
        f32x4 v[4]; float s = 0.f;
#pragma unroll
        for (int j = 0; j < 4; ++j) v[j] = xr[64 * j];
        if (nparts > 0 && m >= ML) {
            for (int p = 0; p < nparts; p += 4) {
                const GAS f32x4* pr = (const GAS f32x4*)(parts + (size_t)p * (512 * 1024) + (size_t)(m - ML) * DM) + F.lane;
                f32x4 w[4][4];
#pragma unroll
                for (int q = 0; q < 4; ++q)
#pragma unroll
                    for (int j = 0; j < 4; ++j) w[q][j] = pr[(size_t)q * (512 * 1024 / 4) + 64 * j];
#pragma unroll
                for (int j = 0; j < 4; ++j) v[j] += (w[0][j] + w[1][j]) + (w[2][j] + w[3][j]); }
            GAS f32x4* cr = (GAS f32x4*)((float*)(F.ws + WS_CTXRES) + (size_t)(m - ML) * DM) + F.lane;
#pragma unroll
            for (int j = 0; j < 4; ++j) cr[64 * j] = v[j];
        }
#pragma unroll
        for (int j = 0; j < 4; ++j) s += (v[j].x * v[j].x + v[j].y * v[j].y) + (v[j].z * v[j].z + v[j].w * v[j].w);
        const float rstd = 1.f / sqrtf(wave_sum(s, F.lane) * (1.f / DM) + NORM_EPS);
        if (from_partials && m >= ML) { GAS f32x4* cr = (GAS f32x4*)((float*)(F.ws + WS_CTXRES) + (size_t)(m - ML) * DM) + F.lane;
#pragma unroll
            for (int j = 0; j < 4; ++j) cr[64 * j] = v[j]; }
        GAS v2u* o8 = (GAS v2u*)(XN + (size_t)m * DM) + F.lane;
#pragma unroll
        for (int j = 0; j < 4; ++j) { const int col = 4 * F.lane + 256 * j;
            const f32x4 g = *(const LAS f32x4*)(gl + col), sc = *(const LAS f32x4*)(scl + cnd * 1024 + col), sh = *(const LAS f32x4*)(shl + cnd * 1024 + col);
            const f32x4 y = (v[j] * rstd) * g * sc + sh;
            v2u w; w.x = pk2(y.x, y.y); w.y = pk2(y.z, y.w); o8[64 * j] = w; }
    }
    __syncthreads();
}

__device__ __forceinline__ void unpack8(const v4u w, float (&x)[8]) { x[0] = bflo(w.x); x[1] = bfhi(w.x); x[2] = bflo(w.y); x[3] = bfhi(w.y); x[4] = bflo(w.z); x[5] = bfhi(w.z); x[6] = bflo(w.w); x[7] = bfhi(w.w); }
__device__ __forceinline__ v4u pack8(const float (&x)[8]) { v4u w; w.x = pk2(x[0], x[1]); w.y = pk2(x[2], x[3]); w.z = pk2(x[4], x[5]); w.w = pk2(x[6], x[7]); return w; }

__device__ __forceinline__ void qknorm_phase(Frame& F) {
    bf16* QKV = (bf16*)(F.ws + WS_QKV);
    const float* rt = (const float*)(F.ws + WS_ROPE);
    const float* nw[4] = {ARG(12), ARG(13), ARG(15), ARG(16)};
    const float qscale = 0.125f * att::LOG2E;
    const int gw = F.vcu * NWAVES + F.wave, NGW = F.G * NWAVES;
    const int lane = F.lane, grp = lane >> 3, l8 = lane & 7;
    for (int m = gw; m < MR; m += NGW) {
        const bool lat = m < ML; const int t = m & (SEQ - 1); const int prow = t >> 6, pcol = t & 63;
        GAS v4u* rowp = (GAS v4u*)(QKV + (size_t)m * NQKV);
#pragma unroll
        for (int pass = 0; pass < 4; ++pass) {
            int type;
            if (pass == 0) type = 1; else if (pass == 1) type = grp < 2 ? 2 : (grp < 4 ? 0 : 3); else if (pass == 2) type = grp < 4 ? 3 : 4; else type = grp < 4 ? 4 : 0;
            const v4u w = rowp[pass * 64 + lane];
            float x[8]; unpack8(w, x);
            float ss = 0.f;
#pragma unroll
            for (int j = 0; j < 8; ++j) ss += x[j] * x[j];
            ss += shx(ss, 1, F.lane); ss += shx(ss, 2, F.lane); ss += shx(ss, 4, F.lane);
            const float rstd = 1.f / sqrtf(ss * (1.f / 64.f) + NORM_EPS);
            const float* g = type == 1 ? nw[0] : (type == 2 ? nw[1] : (type == 3 ? nw[2] : nw[3]));
            const f32x4 g0 = *(const GAS f32x4*)(g + l8 * 8), g1 = *(const GAS f32x4*)(g + l8 * 8 + 4);
            x[0] *= rstd * g0.x; x[1] *= rstd * g0.y; x[2] *= rstd * g0.z; x[3] *= rstd * g0.w; x[4] *= rstd * g1.x; x[5] *= rstd * g1.y; x[6] *= rstd * g1.z; x[7] *= rstd * g1.w;
            float px[8];
#pragma unroll
            for (int j = 0; j < 8; ++j) px[j] = shx(x[j], 2, F.lane);
            if (lat && (type == 1 || type == 2)) {
                const int pos = (l8 & 4) ? pcol : prow; const float* cs = rt + pos * 16 + (l8 & 1) * 8;
                const f32x4 c0 = *(const GAS f32x4*)(cs), c1 = *(const GAS f32x4*)(cs + 4), s0 = *(const GAS f32x4*)(cs + 2048), s1 = *(const GAS f32x4*)(cs + 2052);
                const float cc[8] = {c0.x, c0.y, c0.z, c0.w, c1.x, c1.y, c1.z, c1.w}, sn[8] = {s0.x, s0.y, s0.z, s0.w, s1.x, s1.y, s1.z, s1.w};
                const float sgn = (l8 & 2) ? 1.f : -1.f;
#pragma unroll
                for (int j = 0; j < 8; ++j) x[j] = x[j] * cc[j] + sgn * px[j] * sn[j];
            }
            if (type == 1 || type == 3) {
#pragma unroll
                for (int j = 0; j < 8; ++j) x[j] *= qscale;
            }
            if (type != 0) rowp[pass * 64 + lane] = pack8(x);
        }
    }
}

__device__ __forceinline__ void cnorm_phase(Frame& F) {
    const bf16* CQKV = (const bf16*)(F.ws + WS_CQKV); bf16* CQN = (bf16*)(F.ws + WS_CQN); bf16* CKVN = (bf16*)(F.ws + WS_CKVN); bf16* KR = (bf16*)(F.ws + WS_KR);
    const float* rt = (const float*)(F.ws + WS_ROPE) + 4096;
    const float* gq = ARG(19); const float* gkv = ARG(20); const float* gkr = ARG(26);
    const int gw = F.vcu * NWAVES + F.wave, NGW = F.G * NWAVES; const int lane = F.lane;
    for (int m = gw; m < MR; m += NGW) {
        const bool lat = m < ML; const int t = m & (SEQ - 1); const int prow = t >> 6, pcol = t & 63;
        const GAS v4u* rowp = (const GAS v4u*)(CQKV + (size_t)m * NCIN);
        const v4u w0 = rowp[lane]; v4u w1 = {0u, 0u, 0u, 0u}; if (lane < 32) w1 = rowp[64 + lane];
        float x0[8], x1[8]; unpack8(w0, x0); unpack8(w1, x1);
        float s0 = 0.f, s1 = 0.f;
#pragma unroll
        for (int j = 0; j < 8; ++j) { s0 += x0[j] * x0[j]; s1 += x1[j] * x1[j]; }
        const float ssq = wave_sum(lane < 48 ? s0 : 0.f, F.lane);
        const float sskv = wave_sum((lane >= 48 ? s0 : 0.f) + (lane < 16 ? s1 : 0.f), F.lane);
        const float sskr = wave_sum((lane >= 16 && lane < 20) ? s1 : 0.f, F.lane);
        const float rq = 1.f / sqrtf(ssq * (1.f / 384.f) + NORM_EPS), rkv = 1.f / sqrtf(sskv * (1.f / 256.f) + NORM_EPS), rkr = 1.f / sqrtf(sskr * (1.f / 32.f) + NORM_EPS);
        { const float* g = lane < 48 ? gq + lane * 8 : gkv + (lane - 48) * 8; const float r = lane < 48 ? rq : rkv;
          const f32x4 g0 = *(const GAS f32x4*)(g), g1 = *(const GAS f32x4*)(g + 4);
          float y[8] = {x0[0] * r * g0.x, x0[1] * r * g0.y, x0[2] * r * g0.z, x0[3] * r * g0.w, x0[4] * r * g1.x, x0[5] * r * g1.y, x0[6] * r * g1.z, x0[7] * r * g1.w};
          if (lane < 48) *(GAS v4u*)(CQN + (size_t)m * 384 + lane * 8) = pack8(y); else *(GAS v4u*)(CKVN + (size_t)m * 256 + (lane - 48) * 8) = pack8(y); }
        { const int li = lane < 16 ? lane : (lane < 20 ? lane - 16 : 0);
          const float* g = lane < 16 ? gkv + 128 + li * 8 : gkr + li * 8; const float r = lane < 16 ? rkv : rkr;
          const f32x4 g0 = *(const GAS f32x4*)(g), g1 = *(const GAS f32x4*)(g + 4);
          float y[8] = {x1[0] * r * g0.x, x1[1] * r * g0.y, x1[2] * r * g0.z, x1[3] * r * g0.w, x1[4] * r * g1.x, x1[5] * r * g1.y, x1[6] * r * g1.z, x1[7] * r * g1.w};
          float py[8];
#pragma unroll
          for (int j = 0; j < 8; ++j) py[j] = shx(y[j], 1, F.lane);
          if (lat && lane >= 16 && lane < 20) {
              const int pos = (lane & 2) ? pcol : prow; const float* cs = rt + pos * 8;
              const f32x4 c0 = *(const GAS f32x4*)(cs), c1 = *(const GAS f32x4*)(cs + 4), sa = *(const GAS f32x4*)(cs + 1024), sb = *(const GAS f32x4*)(cs + 1028);
              const float cc[8] = {c0.x, c0.y, c0.z, c0.w, c1.x, c1.y, c1.z, c1.w}, sn[8] = {sa.x, sa.y, sa.z, sa.w, sb.x, sb.y, sb.z, sb.w};
              const float sgn = (lane & 1) ? 1.f : -1.f;
#pragma unroll
              for (int j = 0; j < 8; ++j) y[j] = y[j] * cc[j] + sgn * py[j] * sn[j];
          }
          if (lane < 16) *(GAS v4u*)(CKVN + (size_t)m * 256 + 128 + lane * 8) = pack8(y);
          else if (lane < 20) *(GAS v4u*)(KR + (size_t)m * 32 + (lane - 16) * 8) = pack8(y); }
    }
}

__device__ __forceinline__ void hnorm_phase(Frame& F) {
    bf16* Q = (bf16*)(F.ws + WS_Q1); bf16* KV = (bf16*)(F.ws + WS_KV1);
    const float* rt = (const float*)(F.ws + WS_ROPE) + 4096;
    const float* gqn = ARG(23); const float* gqr = ARG(24); const float* gkn = ARG(25);
    const float qscale = 0.10206207261596575f * att::LOG2E;
    const int gw = F.vcu * NWAVES + F.wave, NGW = F.G * NWAVES; const int lane = F.lane, l8 = lane & 7, l4 = lane & 3;
    for (int m = gw; m < MR; m += NGW) {
        const bool lat = m < ML; const int t = m & (SEQ - 1); const int prow = t >> 6, pcol = t & 63;
        { GAS v4u* rowp = (GAS v4u*)(KV + (size_t)m * NUKV);
          const f32x4 g0 = *(const GAS f32x4*)(gkn + l8 * 8), g1 = *(const GAS f32x4*)(gkn + l8 * 8 + 4);
#pragma unroll
          for (int pass = 0; pass < 2; ++pass) {
              float x[8]; unpack8(rowp[pass * 64 + lane], x); float ss = 0.f;
#pragma unroll
              for (int j = 0; j < 8; ++j) ss += x[j] * x[j];
              ss += shx(ss, 1, F.lane); ss += shx(ss, 2, F.lane); ss += shx(ss, 4, F.lane);
              const float r = 1.f / sqrtf(ss * (1.f / 64.f) + NORM_EPS);
              x[0] *= r * g0.x; x[1] *= r * g0.y; x[2] *= r * g0.z; x[3] *= r * g0.w; x[4] *= r * g1.x; x[5] *= r * g1.y; x[6] *= r * g1.z; x[7] *= r * g1.w;
              rowp[pass * 64 + lane] = pack8(x); } }
        if (lat) {
            GAS v4u* rowp = (GAS v4u*)(Q + (size_t)m * NUQ);
            { const f32x4 g0 = *(const GAS f32x4*)(gqn + l8 * 8), g1 = *(const GAS f32x4*)(gqn + l8 * 8 + 4);
#pragma unroll
              for (int pass = 0; pass < 2; ++pass) {
                  float x[8]; unpack8(rowp[pass * 64 + lane], x); float ss = 0.f;
#pragma unroll
                  for (int j = 0; j < 8; ++j) ss += x[j] * x[j];
                  ss += shx(ss, 1, F.lane); ss += shx(ss, 2, F.lane); ss += shx(ss, 4, F.lane);
                  const float r = qscale / sqrtf(ss * (1.f / 64.f) + NORM_EPS);
                  x[0] *= r * g0.x; x[1] *= r * g0.y; x[2] *= r * g0.z; x[3] *= r * g0.w; x[4] *= r * g1.x; x[5] *= r * g1.y; x[6] *= r * g1.z; x[7] *= r * g1.w;
                  rowp[pass * 64 + lane] = pack8(x); } }
            {
              const f32x4 g0 = *(const GAS f32x4*)(gqr + l4 * 8), g1 = *(const GAS f32x4*)(gqr + l4 * 8 + 4);
              float x[8]; unpack8(rowp[128 + lane], x); float ss = 0.f;
#pragma unroll
              for (int j = 0; j < 8; ++j) ss += x[j] * x[j];
              ss += shx(ss, 1, F.lane); ss += shx(ss, 2, F.lane);
              const float r = 1.f / sqrtf(ss * (1.f / 32.f) + NORM_EPS);
              x[0] *= r * g0.x; x[1] *= r * g0.y; x[2] *= r * g0.z; x[3] *= r * g0.w; x[4] *= r * g1.x; x[5] *= r * g1.y; x[6] *= r * g1.z; x[7] *= r * g1.w;
              float px[8];
#pragma unroll
              for (int j = 0; j < 8; ++j) px[j] = shx(x[j], 1, F.lane);
              const int pos = (l4 & 2) ? pcol : prow; const float* cs = rt + pos * 8;
              const f32x4 c0 = *(const GAS f32x4*)(cs), c1 = *(const GAS f32x4*)(cs + 4), sa = *(const GAS f32x4*)(cs + 1024), sb = *(const GAS f32x4*)(cs + 1028);
              const float cc[8] = {c0.x, c0.y, c0.z, c0.w, c1.x, c1.y, c1.z, c1.w}, sn[8] = {sa.x, sa.y, sa.z, sa.w, sb.x, sb.y, sb.z, sb.w};
              const float sgn = (l4 & 1) ? 1.f : -1.f;
#pragma unroll
              for (int j = 0; j < 8; ++j) x[j] = (x[j] * cc[j] + sgn * px[j] * sn[j]) * qscale;
              rowp[128 + lane] = pack8(x); }
        }
    }
}

__device__ __forceinline__ void kr6_pass(Frame& F) {
    if (((const float*)(F.ws + WS_HPAR))[448] == 0.f) return;
    const bf16* KR = (const bf16*)(F.ws + WS_KR); unsigned char* K6R = (unsigned char*)(F.ws + WS_K6R);
    for (int r = F.vcu * (NWAVES * 64) + F.tid; r < MR; r += F.G * (NWAVES * 64)) {
        const GAS v4u* rp = (const GAS v4u*)(KR + (size_t)r * 32);
        v4u w[4] = {rp[0], rp[1], rp[2], rp[3]};
#pragma unroll
        for (int q = 0; q < 4; ++q) { float x[8]; unpack8(w[q], x);
#pragma unroll
            for (int j = 0; j < 8; ++j) x[j] *= 1.5349124f;
            w[q] = pack8(x); }
        const attd::u32x6 c = attd::to_fp6(w[0], w[1], w[2], w[3]);
        unsigned char* img = K6R + (size_t)(r >> 6) * 2048; const int key = r & 63;
        *(GAS v4u*)(img + key * 16) = (v4u){c[0], c[1], c[2], c[3]}; *(GAS v2u*)(img + 1024 + key * 8) = (v2u){c[4], c[5]};
    }
}
__device__ __forceinline__ void attn0_phase(Frame& F) {
    att::lchar* lds = (att::lchar*)(F.lds + RING_OFF);
    const att::bf16* QKV = (const att::bf16*)(F.ws + WS_QKV); att::bf16* O = (att::bf16*)(F.ws + WS_O0);
    bool fast;
    { float a = fabsf(ARG(12)[F.lane]), b_ = fabsf(ARG(13)[F.lane]), c_ = fabsf(ARG(15)[F.lane]), d_ = fabsf(ARG(16)[F.lane]), e_ = 0.f, f_ = fabsf(ARG(14)[F.lane & 7]);
      for (int i = F.lane; i < 8 * 465; i += 64) e_ = fmaxf(e_, fabsf(ARG(17)[i]));
#pragma unroll
      for (int o_ = 1; o_ < 64; o_ <<= 1) { a = fmaxf(a, shx(a, o_, F.lane)); b_ = fmaxf(b_, shx(b_, o_, F.lane)); c_ = fmaxf(c_, shx(c_, o_, F.lane)); d_ = fmaxf(d_, shx(d_, o_, F.lane)); e_ = fmaxf(e_, shx(e_, o_, F.lane)); f_ = fmaxf(f_, shx(f_, o_, F.lane)); }
      const float bound = fmaxf(fmaxf(8.f * a * b_, 8.f * c_ * d_ + e_), f_) * att::LOG2E;
      fast = __builtin_amdgcn_readfirstlane(bound < 64.f ? 1 : 0) != 0; }
    char* shm = (char*)(F.lds + RING_OFF);
    for (int ui = F.vcu; ui < 1056; ui += F.G) {
        if (ui < 512) {
            const int b = ui >> 8, h = (ui >> 5) & 7, R4 = ui & 31;
            const float* rpb = ARG(17) + h * 465;
            if (fast) {
                float* rl = (float*)(shm + attf::LDS_RPB);
                for (int i = F.tid; i < 465; i += NWAVES * 64) rl[i] = rpb[i] * att::LOG2E;
                __syncthreads();
                attf::FNa fu; fu.init((const attf::bf16*)QKV, (attf::bf16*)O, rl, b, h, R4);
                attf::fast_unit<8, attf::FNa>(fu, shm, F.tid);
            } else {
                att::UNa u; u.QKV = QKV; u.O = O; u.rpbl = (const LAS float*)(lds + att::L_RPB); u.b = b; u.h = h; u.R4 = R4; u.init();
                for (int i = F.tid; i < 465; i += NWAVES * 64) ((LAS float*)(lds + att::L_RPB))[i] = rpb[i] * att::LOG2E;
                att::unit<8, att::UNa>(u, lds, F.tid);
            }
        } else if (ui < 1024) {
            const int v = ui - 512;
            if (fast) { attf::FWin fu; fu.init((const attf::bf16*)QKV, (attf::bf16*)O, ARG(14), v >> 8, (v >> 2) & 63, (v >> 1) & 1, v & 1); attf::fast_unit<8, attf::FWin>(fu, shm, F.tid); }
            else { att::UWin u; u.QKV = QKV; u.O = O; u.sinkp = ARG(14); u.b = v >> 8; u.n = (v >> 2) & 63; u.g = (v >> 1) & 1; u.hh = v & 1; u.init(); att::unit<8, att::UWin>(u, lds, F.tid); }
        } else {
            const int v = ui - 1024;
            if (fast) { attf::FCtx fu; fu.init((const attf::bf16*)QKV, (attf::bf16*)O, ARG(14), v >> 4, v & 15); attf::fast_unit<8, attf::FCtx>(fu, shm, F.tid); }
            else { att::UCtx u; u.QKV = QKV; u.O = O; u.sinkp = ARG(14); u.b = v >> 4; u.hx = v & 15; u.init(); att::unit<8, att::UCtx>(u, lds, F.tid); }
        }
    }
}
__device__ __forceinline__ void attn1_phase(Frame& F) {
    att::lchar* lds = (att::lchar*)(F.lds + RING_OFF);
    const bool fast = __builtin_amdgcn_readfirstlane(__builtin_bit_cast(int, ((const float*)(F.ws + WS_HPAR))[448])) != 0;
    const bool g256 = F.G == 256; const int x = F.vcu >> 5, j = F.vcu & 31;
    const int nit = g256 ? 4 : (F.vcu < 1024 ? (1024 - F.vcu + F.G - 1) / F.G : 0);
    for (int i = 0; i < nit; ++i) {
        const int ui = g256 ? ((x * 4 + i) * 32 + j) : F.vcu + i * F.G;
        if (fast) attd::dense_unit(ui >> 9, (ui >> 5) & 15, ui & 31, (const attd::bf16*)(F.ws + WS_Q1), (const attd::bf16*)(F.ws + WS_KV1), (const char*)(F.ws + WS_K6N), (const char*)(F.ws + WS_K6R), (attd::bf16*)(F.ws + WS_O1), (char*)(F.lds + RING_OFF), F.tid);
        else {
        att::UDense u; u.Q = (const att::bf16*)(F.ws + WS_Q1); u.KV = (const att::bf16*)(F.ws + WS_KV1); u.KR = (const att::bf16*)(F.ws + WS_KR); u.O = (att::bf16*)(F.ws + WS_O1);
        u.b = ui >> 9; u.h = (ui >> 5) & 15; u.qb = ui & 31;
        att::unit<12, att::UDense>(u, lds, F.tid); }
    }
}

#ifndef PHASE_MASK
#define PHASE_MASK 0xFFFFFu
#endif
#ifndef PHASE_REP
#define PHASE_REP 0u
#endif
struct Args { const float* in[28]; float* out; unsigned char* ws; int ph_lo, ph_hi; };
constexpr int N_PHASES = 19;
__global__ void __launch_bounds__(NWAVES * 64, 2) fwd_kernel(Args args) {
    extern __shared__ __attribute__((aligned(16))) unsigned char lds[];
    for (int u = threadIdx.x; u < (LDS_BYTES - LDSCTL_OFF) / 4; u += NWAVES * 64) ((LAS unsigned*)((LAS unsigned char*)lds + LDSCTL_OFF))[u] = 0u;
    __syncthreads();
    if (!MK_PER_PHASE) (void)xcd_barrier_post((unsigned*)((gu32*)(ARG_WS + WS_CTL) + CW_BAR), (volatile LAS unsigned*)((LAS unsigned char*)lds + MISC_OFF) + 8);
    for (int ph2 = 2 * args.ph_lo; ph2 < 2 * args.ph_hi; ++ph2) {
        const int ph = ph2 >> 1; if ((ph2 & 1) && !((PHASE_REP >> ph) & 1)) continue;
        if (ph == 3 || ph == 14) continue;
        Frame F;
        { int t_ = threadIdx.x; asm volatile("" : "+v"(t_)); int b_ = blockIdx.x; asm volatile("" : "+s"(b_)); int g_ = gridDim.x; asm volatile("" : "+s"(g_)); F.tid = t_; F.bx = b_; F.G = g_; }
        F.lds = (LAS unsigned char*)lds; F.MISC = (volatile LAS unsigned*)(F.lds + MISC_OFF);
        F.lane = F.tid & 63; F.wave = __builtin_amdgcn_readfirstlane(F.tid >> 6);
        F.vcu = (F.G % 8 == 0) ? (F.bx % 8) * (F.G / 8) + F.bx / 8 : F.bx;
        F.ws = ARG_WS; F.out = ARG_OUT; F.ctl = (gu32*)(F.ws + WS_CTL);
        XcdBarrier bar; bar.bar = (unsigned*)(F.ctl + CW_BAR); bar.x = xb_xcc_id(); bar.st = F.MISC + 8;
        float* ctxres = (float*)(F.ws + WS_CTXRES);
        const float* mod = (const float*)(F.ws + WS_MOD);
        int gk = 0, xrows = 0, xS = 0;
        pg8::Gemm g{nullptr, nullptr, 0, 0, 0}; pg8::EpiAny ea{0, nullptr, nullptr, nullptr, nullptr, 0, 0};
        switch (ph) {
        case 0: if (!((PHASE_MASK >> 0) & 1)) break; p0_prologue(F); break;
        case 1: if (!((PHASE_MASK >> 1) & 1)) break; norm_phase(F, ARG(0), ARG(2), MR, ARG(6), 0, 0, true); break;
        case 2: if (!((PHASE_MASK >> 2) & 1)) break; gk = 1; g = pg8::Gemm{(const bf16*)(F.ws + WS_XN), (const bf16*)(F.ws + WS_WQKV), MR, NQKV, DM}; ea = pg8::EpiAny{3, (const float*)(F.ws + WS_HPAR), (void*)(F.ws + WS_QKV), nullptr, (const float*)(F.ws + WS_ROPE), NQKV, 0}; break;
        case 4: if (!((PHASE_MASK >> 4) & 1)) break; attn0_phase(F); break;
        case 5: if (!((PHASE_MASK >> 5) & 1)) break; gk = 2; g = pg8::Gemm{(const bf16*)(F.ws + WS_O0), (const bf16*)(F.ws + WS_WO0), ML, DM, DM}; xrows = MC; xS = 2; ea = pg8::EpiAny{2, ARG(0), (void*)F.out, (float*)(F.ws + WS_PART5), mod + 2048, 0, 0}; break;
        case 6: if (!((PHASE_MASK >> 6) & 1)) break; norm_phase(F, F.out, ctxres, MR, ARG(7), 0, 1, false, (const float*)(F.ws + WS_PART5), 4); break;
        case 7: if (!((PHASE_MASK >> 7) & 1)) break; gk = 1; g = pg8::Gemm{(const bf16*)(F.ws + WS_XN), (const bf16*)(F.ws + WS_W1_0), MR, FF, DM}; ea = pg8::EpiAny{1, nullptr, (void*)(F.ws + WS_H), nullptr, nullptr, FF, 1}; break;
        case 8: if (!((PHASE_MASK >> 8) & 1)) break; gk = 2; g = pg8::Gemm{(const bf16*)(F.ws + WS_H), (const bf16*)(F.ws + WS_W2_0), ML, DM, FF}; xrows = MC; xS = 4; ea = pg8::EpiAny{2, F.out, (void*)F.out, (float*)(F.ws + WS_PART8), mod + 5120, 0, 0}; break;
        case 9: if (!((PHASE_MASK >> 9) & 1)) break; norm_phase(F, F.out, ctxres, MR, ARG(6) + DM, 1, 0, false, (const float*)(F.ws + WS_PART8), 16); break;
        case 10: if (!((PHASE_MASK >> 10) & 1)) break; gk = 1; g = pg8::Gemm{(const bf16*)(F.ws + WS_XN), (const bf16*)(F.ws + WS_WIN), MR, NCIN, DM}; ea = pg8::EpiAny{1, nullptr, (void*)(F.ws + WS_CQKV), nullptr, nullptr, NCIN, 0}; break;
        case 11: if (!((PHASE_MASK >> 11) & 1)) break; cnorm_phase(F); break;
        case 12: if (!((PHASE_MASK >> 12) & 1)) break; kr6_pass(F); gk = 1; g = pg8::Gemm{(const bf16*)(F.ws + WS_CQN), (const bf16*)(F.ws + WS_WUQ), ML, NUQ, 384}; ea = pg8::EpiAny{3, (const float*)(F.ws + WS_HPAR), (void*)(F.ws + WS_Q1), nullptr, (const float*)(F.ws + WS_ROPE), NUQ, 1}; break;
        case 13: if (!((PHASE_MASK >> 13) & 1)) break; gk = 1; g = pg8::Gemm{(const bf16*)(F.ws + WS_CKVN), (const bf16*)(F.ws + WS_WUKV), MR, NUKV, 256}; ea = pg8::EpiAny{3, (const float*)(F.ws + WS_HPAR), (void*)(F.ws + WS_KV1), (float*)(F.ws + WS_K6N), (const float*)(F.ws + WS_ROPE), NUKV, 2}; break;
        case 15: if (!((PHASE_MASK >> 15) & 1)) break; attn1_phase(F); break;
        case 16: if (!((PHASE_MASK >> 16) & 1)) break; gk = 2; g = pg8::Gemm{(const bf16*)(F.ws + WS_O1), (const bf16*)(F.ws + WS_WO1), ML, DM, DM}; ea = pg8::EpiAny{2, F.out, (void*)F.out, ctxres, mod + 3 * 6144 + 2048, 0, 0}; break;
        case 17: if (!((PHASE_MASK >> 17) & 1)) break; norm_phase(F, F.out, ctxres, ML, ARG(7) + DM, 1, 1, false); break;
        case 18: if (!((PHASE_MASK >> 18) & 1)) break; gk = 1; g = pg8::Gemm{(const bf16*)(F.ws + WS_XN), (const bf16*)(F.ws + WS_W1_1), ML, FF, DM}; ea = pg8::EpiAny{1, nullptr, (void*)(F.ws + WS_H), nullptr, nullptr, FF, 1}; break;
        case 19: if (!((PHASE_MASK >> 19) & 1)) break; gk = 2; g = pg8::Gemm{(const bf16*)(F.ws + WS_H), (const bf16*)(F.ws + WS_W2_1), ML, DM, FF}; ea = pg8::EpiAny{2, F.out, (void*)F.out, ctxres, mod + 3 * 6144 + 5120, 0, 0}; break;
        default: break;
        }
        ea.scr = F.lds + LDSCTL_OFF + 4096;
        if (gk != 0) { pg8::StaticOrder S; S.init(g.M, g.N, g.K, F.G, F.bx, xrows, xS); pg8::gemm_phase<pg8::EpiAny, pg8::StaticOrder, true, true>(F.lds + RING_OFF, g, S, ea, F.tid); }
        const bool last_ = (ph == args.ph_hi - 1) && ((ph2 & 1) || !((PHASE_REP >> ph) & 1));
        if (!MK_PER_PHASE && !last_ && ph != 12) xcd_barrier(bar);
        else __syncthreads();
    }
}

extern "C" void kernel_launch(void* const* d_in, const int* in_sizes, int n_in, void* d_out, int out_size, void* d_ws, size_t ws_size, hipStream_t stream) {
    static int grid = 0;
    if (grid == 0) {
        if (n_in != 28 || in_sizes[0] != ML * DM || out_size != ML * DM || ws_size < WS_END) { fprintf(stderr, "kernel_launch: unexpected shapes: n_in %d in0 %d out %d ws %zu\n", n_in, n_in > 0 ? in_sizes[0] : -1, out_size, ws_size); grid = -1; return; }
        int dev = 0, cus = 0, per_cu = 0;
        if (hipGetDevice(&dev) != hipSuccess || hipDeviceGetAttribute(&cus, hipDeviceAttributeMultiprocessorCount, dev) != hipSuccess) { fprintf(stderr, "kernel_launch: device query failed\n"); grid = -1; return; }
        if (hipFuncSetAttribute((const void*)fwd_kernel, hipFuncAttributeMaxDynamicSharedMemorySize, LDS_BYTES) != hipSuccess) { fprintf(stderr, "kernel_launch: hipFuncSetAttribute failed\n"); grid = -1; return; }
        if (hipOccupancyMaxActiveBlocksPerMultiprocessor(&per_cu, (const void*)fwd_kernel, NWAVES * 64, LDS_BYTES) != hipSuccess || per_cu < 1)
            fprintf(stderr, "kernel_launch: note: occupancy query reports %d workgroups per CU\n", per_cu);
        (void)hipGetLastError();
        grid = cus;
    }
    if (grid < 0) return;
    if (hipMemsetAsync((char*)d_ws + WS_CTL, 0, CTL_ZERO_BYTES, stream) != hipSuccess) { fprintf(stderr, "kernel_launch: hipMemsetAsync failed\n"); return; }
    Args a{};
    for (int i = 0; i < 28; ++i) a.in[i] = (const float*)d_in[i];
    a.out = (float*)d_out; a.ws = (unsigned char*)d_ws;
#if MK_PER_PHASE
    for (int ph = 0; ph <= N_PHASES; ++ph) { a.ph_lo = ph; a.ph_hi = ph + 1; hipLaunchKernelGGL(fwd_kernel, dim3(grid), dim3(NWAVES * 64), LDS_BYTES, stream, a); }
#else
    a.ph_lo = 0; a.ph_hi = N_PHASES + 1;
    hipLaunchKernelGGL(fwd_kernel, dim3(grid), dim3(NWAVES * 64), LDS_BYTES, stream, a);
#endif
    const hipError_t le = hipPeekAtLastError();
    if (le != hipSuccess) fprintf(stderr, "kernel_launch: launch failed: %s\n", hipGetErrorName(le));
}
```

```cpp
#include <hip/hip_runtime.h>
#include <cstdio>
#include <cstdint>
namespace pg8 {
#define PG8_LAS __attribute__((address_space(3)))
typedef unsigned short bf16_t;
typedef short bf16x8 __attribute__((ext_vector_type(8)));
typedef float f32x4 __attribute__((ext_vector_type(4)));
typedef unsigned u32x4 __attribute__((ext_vector_type(4)));
typedef unsigned u32x2 __attribute__((ext_vector_type(2)));
typedef unsigned u32x6 __attribute__((ext_vector_type(6)));
typedef unsigned u32x16 __attribute__((ext_vector_type(16)));
typedef __bf16 bf16x32 __attribute__((ext_vector_type(32)));
constexpr int BM = 256, BK = 64, HALF = 128, HTB = HALF * BK * 2  , STAGE_BYTES = 8 * HTB, NXCD = 8, WGM = 8;

__host__ __device__ __forceinline__ int lds_byte(int r, int c) { const int st = (r >> 4) * 2 + (c >> 5), rr = r & 15, cc = c & 31, ob = rr * 64 + cc * 2; return st * 1024 + (ob ^ (((ob >> 9) & 1) << 5)); }
__host__ __device__ __forceinline__ void stage_rc(int b, int& R, int& C) { const int st = b / 1024, sb = b % 1024, swz = sb ^ (((sb >> 9) & 1) << 5); R = (st >> 1) * 16 + swz / 64; C = (st & 1) * 32 + (swz % 64) / 2; }
__host__ __device__ __forceinline__ int perm32(int rho) { const int n = rho >> 4, i = rho & 15; return 8 * (i >> 2) + 4 * n + (i & 3); }

struct Unit { int pm, pn, kinfo; };
struct Gemm { const bf16_t* A; const bf16_t* Bt; int M, N, K; };

struct StaticOrder {
    int nM, nN, nwg, G, c, ntK;
    int xtiles, xsh;
    __host__ __device__ void init(int M, int N, int K, int G_, int c_, int extra_rows = 0, int S = 1) { nM = M / BM; nN = N / BM; nwg = nM * nN; G = G_; c = c_; ntK = K / BK;
        xtiles = (extra_rows / BM) * nN; xsh = S; }
    __host__ __device__ bool next(int i, Unit& u) const {
        const long L = (long)i * G + c;
        if (L >= nwg) {
            if (xtiles == 0) return false;
            const int nb = (nwg - c + G - 1) / G;
            const int nbc = c < nwg ? nb : 0;
            const long e = (long)(i - nbc) * G + ((c + G - (nwg % G)) % G);
            if (e >= ((long)xtiles << xsh)) return false;
            const int tile = (int)(e >> xsh), ks = (int)e & ((1 << xsh) - 1), xnt = ntK >> xsh;
            u.pm = nM + tile / nN; u.pn = tile % nN; u.kinfo = (ks * xnt) | (xnt << 8) | (1 << 16); return true;
        }
        int wgid = (int)L; { const int q = nwg / NXCD, r = nwg % NXCD, xcd = wgid % NXCD, off = wgid / NXCD; wgid = (xcd < r ? xcd * (q + 1) : r * (q + 1) + (xcd - r) * q) + off; }
        const int nig = WGM * nN, gid = wgid / nig, fm = gid * WGM, gsz = (nM - fm) < WGM ? (nM - fm) : WGM;
        u.pm = fm + ((wgid % nig) % gsz); u.pn = (wgid % nig) / gsz; u.kinfo = ntK << 8; return true;
    }
    __device__ __forceinline__ void a_ready(const Unit&) const {}
    __device__ __forceinline__ void done(const Unit&) const {}
};

__device__ __forceinline__ unsigned cvt_pk_bf16(float lo, float hi) { unsigned r; asm volatile("v_cvt_pk_bf16_f32 %0, %1, %2" : "=v"(r) : "v"(lo), "v"(hi)); return r; }
__device__ __forceinline__ u32x2 pk4bf(f32x4 y) { u32x2 r; r.x = cvt_pk_bf16(y[0], y[1]); r.y = cvt_pk_bf16(y[2], y[3]); return r; }
__device__ __forceinline__ f32x4 unpk4bf(u32x2 w) { f32x4 r; r[0] = __builtin_bit_cast(float, w.x << 16); r[1] = __builtin_bit_cast(float, w.x & 0xffff0000u); r[2] = __builtin_bit_cast(float, w.y << 16); r[3] = __builtin_bit_cast(float, w.y & 0xffff0000u); return r; }
struct EpiAny {
    static constexpr bool AFTER_DRAIN = false;
    int mode; const float* base; void* out; float* ctxres; const float* gate; int ldc, relu2; PG8_LAS unsigned char* scr = nullptr;
    __device__ __forceinline__ bool perm() const { return mode == 1; }
    __device__ __forceinline__ bool headmode() const { return mode == 3; }
    __device__ __forceinline__ static float xsh(float v, int mask, int lane) { return __builtin_bit_cast(float, __builtin_amdgcn_ds_bpermute((lane ^ mask) << 2, __builtin_bit_cast(int, v))); }
    __device__ __forceinline__ void head_epilogue(const f32x4 (&acc)[2][2][4][2], const Unit& u, int wr, int wc, int fr, int fq) const {
        const int H = 4 * u.pn + wc, kind = relu2, lane = fr + 16 * fq;
        const bool f6 = kind != 0 && base[448] != 0.f;
        int cls, gsel; float qs = 1.f;
        if (kind == 0) { if (H < 8) { cls = 2; gsel = 0; qs = 0.125f * 1.4426950408889634f; } else if (H < 10) { cls = 2; gsel = 1; } else if (H < 12) { cls = 0; gsel = 0; }
                         else if (H < 20) { cls = 1; gsel = 2; qs = 0.125f * 1.4426950408889634f; } else if (H < 28) { cls = 1; gsel = 3; } else { cls = 0; gsel = 0; } }
        else if (kind == 1) { qs = f6 ? 1.5349124f : 0.10206207261596575f * 1.4426950408889634f; if (H < 16) { cls = 1; gsel = 4; } else { cls = 3; gsel = 5; } }
        else { if (H < 16) { cls = 1; gsel = 6; if (f6) qs = 1.5349124f; } else { cls = 0; gsel = 0; } }
        const bool lat = u.pm < 64;
        const bool k6 = f6 && kind == 2 && H < 16;
        bf16_t* O = (bf16_t*)out;
        const int col0 = u.pn * BM + 64 * wc + 8 * fq;
        f32x4 gv[2][2];
#pragma unroll
        for (int bj = 0; bj < 2; ++bj)
#pragma unroll
            for (int n = 0; n < 2; ++n) gv[bj][n] = *(const f32x4*)(base + gsel * 64 + 32 * bj + 8 * fq + 4 * n);
#pragma unroll
        for (int ai = 0; ai < 2; ++ai)
#pragma unroll
            for (int m = 0; m < 4; ++m) {
                const int row = u.pm * BM + ai * HALF + wr * 64 + m * 16 + fr;
                f32x4 v[2][2];
#pragma unroll
                for (int bj = 0; bj < 2; ++bj)
#pragma unroll
                    for (int n = 0; n < 2; ++n) v[bj][n] = acc[ai][bj][m][n];
                if (cls != 0) {
                    float s0 = 0.f, s1 = 0.f;
#pragma unroll
                    for (int n = 0; n < 2; ++n)
#pragma unroll
                        for (int e = 0; e < 4; ++e) { s0 += v[0][n][e] * v[0][n][e]; s1 += v[1][n][e] * v[1][n][e]; }
                    if (cls != 3) { s0 += s1; s0 += xsh(s0, 16, lane); s0 += xsh(s0, 32, lane); s0 = s0 * (1.f / 64.f); s1 = s0; }
                    else { s0 += xsh(s0, 16, lane); s0 += xsh(s0, 32, lane); s1 += xsh(s1, 16, lane); s1 += xsh(s1, 32, lane); s0 *= (1.f / 32.f); s1 *= (1.f / 32.f); }
                    const float r0 = 1.f / sqrtf(s0 + 1e-6f), r1 = 1.f / sqrtf(s1 + 1e-6f);
#pragma unroll
                    for (int n = 0; n < 2; ++n) { v[0][n] = v[0][n] * r0 * gv[0][n]; v[1][n] = v[1][n] * r1 * gv[1][n]; }
                    if (lat && cls == 2) {
                        const int t = row & 8191;
#pragma unroll
                        for (int bj = 0; bj < 2; ++bj) { const int pos = bj == 0 ? (t >> 6) : (t & 63); const float sgn = fq < 2 ? -1.f : 1.f;
#pragma unroll
                            for (int n = 0; n < 2; ++n) { const float* cs = gate + pos * 16 + 8 * (fq & 1) + 4 * n; const f32x4 c = *(const f32x4*)cs, sn = *(const f32x4*)(cs + 2048);
                                f32x4 p;
#pragma unroll
                                for (int e = 0; e < 4; ++e) p[e] = xsh(v[bj][n][e], 32, lane);
                                v[bj][n] = v[bj][n] * c + (p * sgn) * sn; } }
                    }
                    if (lat && cls == 3) {
                        const int t = row & 8191; const int pos = fq < 2 ? (t >> 6) : (t & 63); const float sgn = (fq & 1) ? 1.f : -1.f;
#pragma unroll
                        for (int bj = 0; bj < 2; ++bj)
#pragma unroll
                            for (int n = 0; n < 2; ++n) { const float* cs = gate + 4096 + pos * 8 + 4 * n; const f32x4 c = *(const f32x4*)cs, sn = *(const f32x4*)(cs + 1024);
                                f32x4 p;
#pragma unroll
                                for (int e = 0; e < 4; ++e) p[e] = xsh(v[bj][n][e], 16, lane);
                                v[bj][n] = v[bj][n] * c + (p * sgn) * sn; }
                    }
                    if (qs != 1.f) {
#pragma unroll
                        for (int bj = 0; bj < 2; ++bj)
#pragma unroll
                            for (int n = 0; n < 2; ++n) v[bj][n] = v[bj][n] * qs; }
                }
                if (k6) {
                    PG8_LAS unsigned char* sw = scr + (wr * 4 + wc) * 1024 + fr * 64;
                    unsigned char* img = (unsigned char*)ctxres + ((size_t)(row >> 6) * 16 + H) * 3072;
                    const int key = row & 63;
#pragma unroll
                    for (int bj = 0; bj < 2; ++bj) {
                        u32x4 w; w.x = cvt_pk_bf16(v[bj][0][0], v[bj][0][1]); w.y = cvt_pk_bf16(v[bj][0][2], v[bj][0][3]); w.z = cvt_pk_bf16(v[bj][1][0], v[bj][1][1]); w.w = cvt_pk_bf16(v[bj][1][2], v[bj][1][3]);
                        *(PG8_LAS u32x4*)(sw + fq * 16) = w;
                        asm volatile("s_waitcnt lgkmcnt(0)" ::: "memory");
                        if (fq == 0) {
                            const u32x4 a0 = *(PG8_LAS u32x4*)(sw), a1 = *(PG8_LAS u32x4*)(sw + 16), a2 = *(PG8_LAS u32x4*)(sw + 32), a3 = *(PG8_LAS u32x4*)(sw + 48);
                            const u32x16 all = {a0.x, a0.y, a0.z, a0.w, a1.x, a1.y, a1.z, a1.w, a2.x, a2.y, a2.z, a2.w, a3.x, a3.y, a3.z, a3.w};
                            const u32x6 c = __builtin_amdgcn_cvt_scalef32_pk32_fp6_bf16(__builtin_bit_cast(bf16x32, all), 1.0f);
                            *(u32x4*)(img + bj * 1024 + key * 16) = (u32x4){c[0], c[1], c[2], c[3]};
                            *(u32x2*)(img + 2048 + bj * 512 + key * 8) = (u32x2){c[4], c[5]};
                        }
                        asm volatile("s_waitcnt lgkmcnt(0)" ::: "memory");
                    }
                    continue;
                }
                bf16_t* rowp = O + (size_t)row * ldc + col0;
#pragma unroll
                for (int bj = 0; bj < 2; ++bj) { u32x4 w; w.x = cvt_pk_bf16(v[bj][0][0], v[bj][0][1]); w.y = cvt_pk_bf16(v[bj][0][2], v[bj][0][3]); w.z = cvt_pk_bf16(v[bj][1][0], v[bj][1][1]); w.w = cvt_pk_bf16(v[bj][1][2], v[bj][1][3]);
                    *(u32x4*)(rowp + 32 * bj) = w; }
            }
    }
    __device__ __forceinline__ void operator()(const f32x4 (&acc)[2][2][4][2], const Unit& u, int wr, int wc, int fr, int fq) const {
        asm volatile("" : "+v"(fr), "+v"(fq));
        if (mode == 1) {
            bf16_t* O = (bf16_t*)out;
            const int row0 = u.pm * BM + wr * 64 + fr, col0 = u.pn * BM + wc * 32 + 8 * fq;
#pragma unroll
            for (int ai = 0; ai < 2; ++ai)
#pragma unroll
                for (int m = 0; m < 4; ++m) { bf16_t* rowp = O + (size_t)(row0 + ai * HALF + m * 16) * ldc + col0;
#pragma unroll
                    for (int bj = 0; bj < 2; ++bj) { f32x4 v0 = acc[ai][bj][m][0], v1 = acc[ai][bj][m][1];
                        if (relu2) {
#pragma unroll
                            for (int e = 0; e < 4; ++e) { float a = fmaxf(v0[e], 0.f), b = fmaxf(v1[e], 0.f); v0[e] = a * a; v1[e] = b * b; } }
                        u32x4 w; w.x = cvt_pk_bf16(v0[0], v0[1]); w.y = cvt_pk_bf16(v0[2], v0[3]); w.z = cvt_pk_bf16(v1[0], v1[1]); w.w = cvt_pk_bf16(v1[2], v1[3]);
                        *(u32x4*)(rowp + bj * HALF) = w; } }
            return;
        }
        if (mode == 3) { head_epilogue(acc, u, wr, wc, fr, fq); return; }
        const int t0 = u.pm * BM; const bool split = (u.kinfo >> 16) != 0; const int cond = t0 < 8192 ? 0 : (t0 < 16384 ? 1 : 2);
        const int col0 = u.pn * BM + wc * 32 + 4 * fq; const float* g = gate + cond * 6144 + col0;
        f32x4 gv[2][2];
#pragma unroll
        for (int bj = 0; bj < 2; ++bj)
#pragma unroll
            for (int n = 0; n < 2; ++n) gv[bj][n] = *(const f32x4*)(g + bj * HALF + n * 16);
        if (split) {
            const int ks = (u.kinfo & 255) / ((u.kinfo >> 8) & 255);
            float* op = ctxres + (size_t)ks * (512 * 1024) + (size_t)(t0 - 16384) * 1024;
#pragma unroll
            for (int ai = 0; ai < 2; ++ai)
#pragma unroll
                for (int m = 0; m < 4; ++m) { const size_t off = (size_t)(wr * 64 + fr + ai * HALF + m * 16) * 1024 + col0;
#pragma unroll
                    for (int bj = 0; bj < 2; ++bj)
#pragma unroll
                        for (int n = 0; n < 2; ++n) *(f32x4*)(op + off + bj * HALF + n * 16) = gv[bj][n] * acc[ai][bj][m][n]; }
            return;
        }
#define PG8_RES_LOOP(LOADB, STOREO) _Pragma("unroll") for (int ai = 0; ai < 2; ++ai) _Pragma("unroll") for (int m = 0; m < 4; ++m) { const size_t off = (size_t)(wr * 64 + fr + ai * HALF + m * 16) * 1024 + col0; \
            _Pragma("unroll") for (int bj = 0; bj < 2; ++bj) _Pragma("unroll") for (int n = 0; n < 2; ++n) { const size_t o2 = off + bj * HALF + n * 16; f32x4 b; LOADB; const f32x4 y = b + gv[bj][n] * acc[ai][bj][m][n]; STOREO; } }
        if (relu2 == 2) { const float* bp = base + (size_t)t0 * 1024; bf16_t* op = (bf16_t*)out + (size_t)t0 * 1024;
            PG8_RES_LOOP(b = *(const f32x4*)(bp + o2), *(u32x2*)(op + o2) = pk4bf(y)); }
        else if (relu2 == 3) { const bf16_t* bp = (const bf16_t*)base + (size_t)t0 * 1024; bf16_t* op = (bf16_t*)out + (size_t)t0 * 1024;
            PG8_RES_LOOP(const u32x2 w = *(const u32x2*)(bp + o2); b = unpk4bf(w), *(u32x2*)(op + o2) = pk4bf(y)); }
        else { const bf16_t* bp = (const bf16_t*)base + (size_t)t0 * 1024; float* op = (float*)out + (size_t)t0 * 1024;
            PG8_RES_LOOP(const u32x2 w = *(const u32x2*)(bp + o2); b = unpk4bf(w), *(f32x4*)(op + o2) = y); }
#undef PG8_RES_LOOP
    }
};

template <class Epi, class Sched, bool ALIGN_EPI = false, bool SP2 = false>
__device__ __forceinline__ void gemm_phase(PG8_LAS unsigned char* lds, const Gemm g, const Sched& S, const Epi& E, const int tid) {
    const int wid = __builtin_amdgcn_readfirstlane(tid >> 6), lane = tid & 63, wr = wid >> 2, wc = wid & 3, fr = lane & 15, fq = lane >> 4;
    const int K = g.K;
    unsigned voffA[2], voffB[2];
#pragma unroll
    for (int i = 0; i < 2; ++i) { int R, C; stage_rc(tid * 16 + i * 8192, R, C); const int Rb = E.headmode() ? (64 * (R >> 5) + perm32(R & 31)) : (E.perm() ? ((R & ~31) + perm32(R & 31)) : R);
        voffA[i] = (unsigned)(R * K + C) * 2u; voffB[i] = (unsigned)(Rb * K + C) * 2u; }
    const size_t kstep = (size_t)(BK * 2);
    const size_t hstep = (size_t)HALF * K * 2;
    const size_t tstep = 2 * hstep;
    const size_t hstepB = E.headmode() ? (size_t)32 * K * 2 : hstep;
    const unsigned ldsw = (unsigned)wid * 1024u;
    const int aoff = lds_byte(wr * 64 + fr, fq * 8), boff = lds_byte(wc * 32 + fr, fq * 8);
#define PG8_SA(b, h) (((b) * 2 + (h)) * HTB)
#define PG8_SB(b, h) ((4 + (b) * 2 + (h)) * HTB)
#define PG8_STAGE(bufoff, gbase, voff) do { _Pragma("unroll") for (int _i = 0; _i < 2; ++_i) \
        __builtin_amdgcn_global_load_lds((const unsigned*)((const char*)(gbase) + (voff)[_i]), (PG8_LAS unsigned*)(lds + (bufoff) + ldsw + _i * 8192), 16, 0, 0); } while (0)
#define PG8_LDA(dst, b, h) do { _Pragma("unroll") for (int m = 0; m < 4; ++m) _Pragma("unroll") for (int k = 0; k < 2; ++k) dst[m][k] = *(const PG8_LAS bf16x8*)(lds + PG8_SA(b, h) + aoff + m * 2048 + k * 1024); } while (0)
#define PG8_LDB(dst, b, h) do { _Pragma("unroll") for (int n = 0; n < 2; ++n) _Pragma("unroll") for (int k = 0; k < 2; ++k) dst[n][k] = *(const PG8_LAS bf16x8*)(lds + PG8_SB(b, h) + boff + n * 2048 + k * 1024); } while (0)
#define PG8_MMA(ai, bj, At, Bt) do { __builtin_amdgcn_s_setprio(1); _Pragma("unroll") for (int m = 0; m < 4; ++m) _Pragma("unroll") for (int n = 0; n < 2; ++n) _Pragma("unroll") for (int k = 0; k < 2; ++k) \
        acc[ai][bj][m][n] = __builtin_amdgcn_mfma_f32_16x16x32_bf16(Bt[n][k], At[m][k], acc[ai][bj][m][n], 0, 0, 0); __builtin_amdgcn_s_setprio(0); } while (0)
#define PG8_WAIT_V(n) asm volatile("s_waitcnt vmcnt(" #n ")" ::: "memory")
#define PG8_WAIT_L(n) asm volatile("s_waitcnt lgkmcnt(" #n ")" ::: "memory")
#define PG8_BAR __builtin_amdgcn_s_barrier()
#define PG8_SCHED __builtin_amdgcn_sched_barrier(0)
    Unit cur, nxt; int ui = 0;
    if (!S.next(0, cur)) return;
    f32x4 acc[2][2][4][2];
#pragma unroll
    for (int a = 0; a < 2; ++a)
#pragma unroll
        for (int b = 0; b < 2; ++b)
#pragma unroll
            for (int m = 0; m < 4; ++m)
#pragma unroll
                for (int n = 0; n < 2; ++n) acc[a][b][m][n] = (f32x4){0.f, 0.f, 0.f, 0.f};
    bf16x8 At[4][2], B0[2][2], B1[2][2];
    const char* cA = (const char*)g.A + (size_t)cur.pm * tstep + (size_t)(cur.kinfo & 255) * (BK * 2); const char* cB = (const char*)g.Bt + (size_t)cur.pn * tstep + (size_t)(cur.kinfo & 255) * (BK * 2);
    S.a_ready(cur);
    if constexpr (SP2) {
        PG8_STAGE(PG8_SB(0, 0), cB, voffB); PG8_STAGE(PG8_SB(0, 1), cB + hstepB, voffB); PG8_STAGE(PG8_SA(0, 0), cA, voffA); PG8_STAGE(PG8_SA(0, 1), cA + hstep, voffA);
        if (wr == 1) PG8_BAR;
        PG8_WAIT_V(2); PG8_BAR;
        PG8_STAGE(PG8_SB(1, 0), cB + kstep, voffB); PG8_STAGE(PG8_SA(1, 0), cA + kstep, voffA); PG8_STAGE(PG8_SB(1, 1), cB + hstepB + kstep, voffB);
        PG8_WAIT_V(6); PG8_BAR;
    } else {
        PG8_STAGE(PG8_SB(0, 0), cB, voffB); PG8_STAGE(PG8_SA(0, 0), cA, voffA); PG8_STAGE(PG8_SB(0, 1), cB + hstepB, voffB); PG8_STAGE(PG8_SA(0, 1), cA + hstep, voffA);
        if (wr == 1) PG8_BAR;
        PG8_WAIT_V(4); PG8_BAR;
        PG8_STAGE(PG8_SB(1, 0), cB + kstep, voffB); PG8_STAGE(PG8_SA(1, 0), cA + kstep, voffA); PG8_STAGE(PG8_SB(1, 1), cB + hstepB + kstep, voffB);
        PG8_WAIT_V(6); PG8_BAR;
    }
    for (;;) {
        const bool has_next = S.next(ui + 1, nxt);
        const char* nA = has_next ? (const char*)g.A + (size_t)nxt.pm * tstep + (size_t)(nxt.kinfo & 255) * (BK * 2) : cA; const char* nB = has_next ? (const char*)g.Bt + (size_t)nxt.pn * tstep + (size_t)(nxt.kinfo & 255) * (BK * 2) : cB;
        const int nt = (cur.kinfo >> 8) & 255;
        for (int t = 0; t < nt; t += 2) {
            const bool last = (t == nt - 2);
            const char* a1 = cA + (size_t)(t + 1) * kstep;
            const char* a2 = last ? nA : cA + (size_t)(t + 2) * kstep; const char* b2 = last ? nB : cB + (size_t)(t + 2) * kstep;
            const char* a3 = a2 + kstep; const char* b3 = b2 + kstep;
            if (last && has_next) S.a_ready(nxt);
            if constexpr (SP2) {
            PG8_LDB(B0, 0, 0); PG8_LDB(B1, 0, 1); PG8_SCHED; PG8_LDA(At, 0, 0); PG8_STAGE(PG8_SA(1, 1), a1 + hstep, voffA);
            PG8_WAIT_V(8); PG8_WAIT_L(0); PG8_BAR; PG8_MMA(0, 0, At, B0); PG8_MMA(0, 1, At, B1); PG8_BAR; PG8_SCHED;
            PG8_LDA(At, 0, 1); PG8_STAGE(PG8_SB(0, 0), b2, voffB); PG8_STAGE(PG8_SB(0, 1), b2 + hstepB, voffB); PG8_STAGE(PG8_SA(0, 0), a2, voffA);
            PG8_WAIT_V(8); PG8_WAIT_L(0); PG8_BAR; PG8_MMA(1, 0, At, B0); PG8_MMA(1, 1, At, B1); PG8_BAR; PG8_SCHED;
            PG8_LDB(B0, 1, 0); PG8_LDB(B1, 1, 1); PG8_SCHED; PG8_LDA(At, 1, 0); PG8_STAGE(PG8_SA(0, 1), a2 + hstep, voffA);
            PG8_WAIT_V(8); PG8_WAIT_L(0); PG8_BAR; PG8_MMA(0, 0, At, B0); PG8_MMA(0, 1, At, B1); PG8_BAR; PG8_SCHED;
            PG8_LDA(At, 1, 1); PG8_STAGE(PG8_SB(1, 0), b3, voffB); PG8_STAGE(PG8_SB(1, 1), b3 + hstepB, voffB); PG8_STAGE(PG8_SA(1, 0), a3, voffA);
            PG8_WAIT_V(8); PG8_WAIT_L(0); PG8_BAR; PG8_MMA(1, 0, At, B0); PG8_MMA(1, 1, At, B1); PG8_BAR; PG8_SCHED;
            } else {
            PG8_LDB(B0, 0, 0); PG8_SCHED; PG8_LDA(At, 0, 0); PG8_STAGE(PG8_SA(1, 1), a1 + hstep, voffA);
            PG8_WAIT_L(8); PG8_BAR; PG8_WAIT_L(0); PG8_MMA(0, 0, At, B0); PG8_BAR; PG8_SCHED;
            PG8_LDB(B1, 0, 1); PG8_STAGE(PG8_SB(0, 0), b2, voffB);
            PG8_BAR; PG8_WAIT_L(0); PG8_MMA(0, 1, At, B1); PG8_BAR;
            PG8_LDA(At, 0, 1); PG8_STAGE(PG8_SA(0, 0), a2, voffA);
            PG8_BAR; PG8_WAIT_L(0); PG8_MMA(1, 0, At, B0); PG8_BAR; PG8_SCHED;
            PG8_STAGE(PG8_SB(0, 1), b2 + hstepB, voffB);
            PG8_WAIT_V(6); PG8_BAR; PG8_MMA(1, 1, At, B1); PG8_BAR;
            PG8_LDB(B0, 1, 0); PG8_SCHED; PG8_LDA(At, 1, 0); PG8_STAGE(PG8_SA(0, 1), a2 + hstep, voffA);
            PG8_WAIT_L(8); PG8_BAR; PG8_WAIT_L(0); PG8_MMA(0, 0, At, B0); PG8_BAR; PG8_SCHED;
            PG8_LDB(B1, 1, 1); PG8_STAGE(PG8_SB(1, 0), b3, voffB);
            PG8_BAR; PG8_WAIT_L(0); PG8_MMA(0, 1, At, B1); PG8_BAR;
            PG8_LDA(At, 1, 1); PG8_STAGE(PG8_SA(1, 0), a3, voffA);
            PG8_BAR; PG8_WAIT_L(0); PG8_MMA(1, 0, At, B0); PG8_BAR; PG8_SCHED;
            PG8_STAGE(PG8_SB(1, 1), b3 + hstepB, voffB);
            PG8_WAIT_V(6); PG8_BAR; PG8_MMA(1, 1, At, B1); PG8_BAR;
            }
        }
        if constexpr (ALIGN_EPI) { if (wr == 0) PG8_BAR; }
        if constexpr (!Epi::AFTER_DRAIN) { E(acc, cur, wr, wc, fr, fq); S.done(cur); }
        if (!has_next) break;
#pragma unroll
        for (int a = 0; a < 2; ++a)
#pragma unroll
            for (int b = 0; b < 2; ++b)
#pragma unroll
                for (int m = 0; m < 4; ++m)
#pragma unroll
                    for (int n = 0; n < 2; ++n) acc[a][b][m][n] = (f32x4){0.f, 0.f, 0.f, 0.f};
        cur = nxt; cA = nA; cB = nB; ++ui;
        if constexpr (ALIGN_EPI) { if (wr == 1) PG8_BAR; }
    }
    PG8_WAIT_V(0);
    if constexpr (!ALIGN_EPI) { if (wr == 0) PG8_BAR; }
    PG8_BAR;
    if constexpr (Epi::AFTER_DRAIN) { E.fused(acc, cur, wr, wc, fr, fq, lds, wid, lane); S.done(cur); }
#undef PG8_SA
#undef PG8_SB
#undef PG8_STAGE
#undef PG8_LDA
#undef PG8_LDB
#undef PG8_MMA
#undef PG8_WAIT_V
#undef PG8_WAIT_L
#undef PG8_BAR
#undef PG8_SCHED
}
}
namespace att {
#define ATT_LAS __attribute__((address_space(3)))
typedef unsigned short bf16;
typedef short bf16x8 __attribute__((ext_vector_type(8)));
typedef short s16x4 __attribute__((ext_vector_type(4)));
typedef float f32x16 __attribute__((ext_vector_type(16)));
typedef unsigned u32x4 __attribute__((ext_vector_type(4)));
typedef ATT_LAS char lchar;
constexpr int KBUF = 12288, VBUF = 16384;
constexpr int L_K = 0, L_V = 2 * KBUF, L_WS = L_V + 2 * VBUF, L_RPB = L_WS + 2048, L_END = L_RPB + 2048;
constexpr float LOG2E = 1.4426950408889634f;
#define ATT_SBAR() __builtin_amdgcn_sched_barrier(0)
__device__ __forceinline__ int crow(int r, int hi) { return (r & 3) + 8 * (r >> 2) + 4 * hi; }
__device__ __forceinline__ unsigned cvtpk(float lo, float hi) { unsigned r; asm volatile("v_cvt_pk_bf16_f32 %0, %1, %2" : "=v"(r) : "v"(lo), "v"(hi)); return r; }
__device__ __forceinline__ int v_st(int k, int c) { const int kk = (k & ~0xC) | ((k & 4) << 1) | ((k & 8) >> 1); return ((kk >> 3) * 4 + (c >> 5)) * 512 + ((kk & 7) * 32 + (c & 31)) * 2; }
__device__ __forceinline__ int v_rd_base(int lane) { return ((lane & 3) << 3) | (((lane >> 2) & 3) << 6) | (((lane >> 4) & 1) << 5) | (((lane >> 5) & 1) << 8); }
constexpr int v_rd_off(int d0, int ks, int half) { return d0 * 512 + ks * 4096 + half * 2048; }
template <int OFF> __device__ __forceinline__ s16x4 tr_read(unsigned vb) {
  s16x4 r; asm volatile("ds_read_b64_tr_b16 %0, %1 offset:%2" : "=&v"(r) : "v"(vb), "i"(OFF) : "memory"); return r;
}
template <int D0> __device__ __forceinline__ void pv_one(f32x16& od, unsigned vb, bf16x8 pa0, bf16x8 pa1, bf16x8 pa2, bf16x8 pa3) {
  const s16x4 l0 = tr_read<v_rd_off(D0, 0, 0)>(vb), h0 = tr_read<v_rd_off(D0, 0, 1)>(vb), l1 = tr_read<v_rd_off(D0, 1, 0)>(vb), h1 = tr_read<v_rd_off(D0, 1, 1)>(vb);
  const s16x4 l2 = tr_read<v_rd_off(D0, 2, 0)>(vb), h2 = tr_read<v_rd_off(D0, 2, 1)>(vb), l3 = tr_read<v_rd_off(D0, 3, 0)>(vb), h3 = tr_read<v_rd_off(D0, 3, 1)>(vb);
  asm volatile("s_waitcnt lgkmcnt(0)" ::: "memory"); ATT_SBAR();
#define ATT_PK(L, H) (bf16x8){L[0], L[1], L[2], L[3], H[0], H[1], H[2], H[3]}
  od = __builtin_amdgcn_mfma_f32_32x32x16_bf16(pa0, ATT_PK(l0, h0), od, 0, 0, 0);
  od = __builtin_amdgcn_mfma_f32_32x32x16_bf16(pa1, ATT_PK(l1, h1), od, 0, 0, 0);
  od = __builtin_amdgcn_mfma_f32_32x32x16_bf16(pa2, ATT_PK(l2, h2), od, 0, 0, 0);
  od = __builtin_amdgcn_mfma_f32_32x32x16_bf16(pa3, ATT_PK(l3, h3), od, 0, 0, 0);
#undef ATT_PK
}

template <int DKC, class U>
__device__ __forceinline__ void unit(const U& u, lchar* lds, int tid) {
  asm volatile("" : "+v"(tid));
  const int lane = tid & 63, r32 = lane & 31, hi = lane >> 5;
  const int wid = __builtin_amdgcn_readfirstlane(tid >> 6);
  lchar* Kl = lds + L_K; lchar* Vl = lds + L_V;
  ATT_LAS float* ws = (ATT_LAS float*)(lds + L_WS) + wid * 64;
  bf16x8 qr[DKC / 2];
#pragma unroll
  for (int d0 = 0; d0 < DKC / 2; ++d0) qr[d0] = *(const bf16x8*)u.qptr(wid, r32, d0, hi);
  const int vrow = tid >> 3, vch = tid & 7, vst = v_st(vrow, vch * 8);
  const int krow0 = tid & 63, kch0 = tid >> 6;
  const bool k2 = (DKC > 8) && (tid < 64 * (DKC - 8));
  const unsigned vb0 = (unsigned)(uintptr_t)Vl + (unsigned)v_rd_base(lane);
  bf16x8 kst0, kst1 = {}, vstr;
  const int NT = u.nt();
#define ATT_SLOAD(t) do { const long R_ = u.krow(t); kst0 = *(const bf16x8*)u.kptr(R_ + krow0, kch0); if (k2) kst1 = *(const bf16x8*)u.kptr(R_ + krow0, 8 + kch0); \
    vstr = *(const bf16x8*)u.vptr(R_ + vrow, vch); } while (0)
#define ATT_SWRITE(b) do { *(ATT_LAS bf16x8*)(Kl + (b) * KBUF + kch0 * 1024 + krow0 * 16) = kst0; if (k2) *(ATT_LAS bf16x8*)(Kl + (b) * KBUF + (8 + kch0) * 1024 + krow0 * 16) = kst1; \
    *(ATT_LAS bf16x8*)(Vl + (b) * VBUF + vst) = vstr; } while (0)
  float m_reg = -1e30f, l_reg = 0.f; f32x16 o[2]; o[0] = f32x16{}; o[1] = f32x16{};
  ATT_SLOAD(0); ATT_SWRITE(0); __syncthreads();
  for (int t = 0; t < NT; ++t) {
    const int buf = t & 1;
    if (t + 1 < NT) ATT_SLOAD(t + 1);
    if (!u.skip(t, wid)) {
      f32x16 p0 = f32x16{}, p1 = f32x16{};
      { const lchar* kb = Kl + buf * KBUF + hi * 1024 + r32 * 16;
#pragma unroll
        for (int d0 = 0; d0 < DKC / 2; ++d0) {
          const bf16x8 b0 = *(const ATT_LAS bf16x8*)(kb + d0 * 2048);
          const bf16x8 b1 = *(const ATT_LAS bf16x8*)(kb + d0 * 2048 + 512);
          p0 = __builtin_amdgcn_mfma_f32_32x32x16_bf16(b0, qr[d0], p0, 0, 0, 0);
          p1 = __builtin_amdgcn_mfma_f32_32x32x16_bf16(b1, qr[d0], p1, 0, 0, 0); } }
      u.mask(p0, p1, t, wid, r32, hi);
      float pmax = p0[0];
#pragma unroll
      for (int r = 1; r < 16; ++r) pmax = fmaxf(pmax, p0[r]);
#pragma unroll
      for (int r = 0; r < 16; ++r) pmax = fmaxf(pmax, p1[r]);
      { auto rr = __builtin_amdgcn_permlane32_swap(__float_as_uint(pmax), __float_as_uint(pmax), false, false);
        pmax = fmaxf(__uint_as_float(rr[0]), __uint_as_float(rr[1])); }
      const float mn = fmaxf(m_reg, pmax);
      const float alpha = __builtin_amdgcn_exp2f(m_reg - mn);
      m_reg = mn;
#pragma unroll
      for (int r = 0; r < 16; ++r) { p0[r] = __builtin_amdgcn_exp2f(p0[r] - mn); p1[r] = __builtin_amdgcn_exp2f(p1[r] - mn); }
      float ps = 0.f;
#pragma unroll
      for (int r = 0; r < 16; ++r) ps += p0[r];
#pragma unroll
      for (int r = 0; r < 16; ++r) ps += p1[r];
      { auto rr = __builtin_amdgcn_permlane32_swap(__float_as_uint(ps), __float_as_uint(ps), false, false);
        ps = __uint_as_float(rr[0]) + __uint_as_float(rr[1]); }
      l_reg = l_reg * alpha + ps;
      if (__any(alpha < 1.f)) {
        if (hi == 0) ws[r32] = alpha;
        asm volatile("s_waitcnt lgkmcnt(0)" ::: "memory");
#pragma unroll
        for (int r = 0; r < 16; ++r) { const float a = ws[crow(r, hi)]; o[0][r] *= a; o[1][r] *= a; }
      }
      bf16x8 pa0, pa1, pa2, pa3;
#define ATT_PK4(P, BASE, OUT) do { unsigned a0 = cvtpk(P[BASE + 0], P[BASE + 1]), a1 = cvtpk(P[BASE + 2], P[BASE + 3]);   \
    unsigned b0 = cvtpk(P[BASE + 4], P[BASE + 5]), b1 = cvtpk(P[BASE + 6], P[BASE + 7]);                              \
    auto r0 = __builtin_amdgcn_permlane32_swap(a0, b0, false, false); auto r1 = __builtin_amdgcn_permlane32_swap(a1, b1, false, false); \
    u32x4 w = {r0[0], r1[0], r0[1], r1[1]}; OUT = __builtin_bit_cast(bf16x8, w); } while (0)
      ATT_PK4(p0, 0, pa0); ATT_PK4(p0, 8, pa1); ATT_PK4(p1, 0, pa2); ATT_PK4(p1, 8, pa3);
#undef ATT_PK4
      const unsigned vb = vb0 + (unsigned)(buf * VBUF);
      pv_one<0>(o[0], vb, pa0, pa1, pa2, pa3); pv_one<1>(o[1], vb, pa0, pa1, pa2, pa3);
    }
    if (t + 1 < NT) ATT_SWRITE(buf ^ 1);
    __syncthreads();
  }
#undef ATT_SLOAD
#undef ATT_SWRITE
  { const float sk = u.sink(wid); l_reg += __builtin_amdgcn_exp2f(sk - m_reg); }
  if (hi == 0) ws[r32] = l_reg;
  asm volatile("s_waitcnt lgkmcnt(0)" ::: "memory");
  float rli[16];
#pragma unroll
  for (int r = 0; r < 16; ++r) rli[r] = __builtin_amdgcn_rcpf(ws[crow(r, hi)]);
#pragma unroll
  for (int r = 0; r < 16; ++r) { bf16* op = u.orow(wid, crow(r, hi));
    op[r32] = (bf16)(cvtpk(o[0][r] * rli[r], 0.f) & 0xffffu); op[32 + r32] = (bf16)(cvtpk(o[1][r] * rli[r], 0.f) & 0xffffu); }
  asm volatile("s_waitcnt lgkmcnt(0)" ::: "memory");
}

constexpr int ROWS_LAT = 16384;
struct UWin {
  const bf16* QKV; bf16* O; const float* sinkp; int b, n, g, hh; int i0, cnt;
  __device__ __forceinline__ void init() { i0 = (n == 0) ? 2 : 0; cnt = (n == 0 || n == 63) ? 4 : 6; }
  __device__ __forceinline__ int nt() const { return 4 + cnt; }
  __device__ __forceinline__ int kpos0(int t) const { return 128 * (n - 1) + 64 * (i0 + t - 4); }
  __device__ __forceinline__ long krow(int t) const { return t < 4 ? (long)(ROWS_LAT + 256 * b + 64 * t) : (long)(8192 * b + kpos0(t)); }
  __device__ __forceinline__ const bf16* kptr(long row, int ch) const { return QKV + row * 2304 + 512 + 64 * g + ch * 8; }
  __device__ __forceinline__ const bf16* vptr(long row, int ch) const { return QKV + row * 2304 + 640 + 64 * g + ch * 8; }
  __device__ __forceinline__ int head(int wid) const { return 4 * g + 2 * hh + (wid >> 2); }
  __device__ __forceinline__ int qpos0(int wid) const { return 128 * n + 32 * (wid & 3); }
  __device__ __forceinline__ const bf16* qptr(int wid, int r32, int d0, int hi) const { return QKV + (long)(8192 * b + qpos0(wid) + r32) * 2304 + 64 * head(wid) + 16 * d0 + 8 * hi; }
  __device__ __forceinline__ bool skip(int t, int wid) const { if (t < 4) return false; const int k0 = kpos0(t), q0 = qpos0(wid); return (k0 + 63 < q0 - 128) || (k0 > q0 + 31 + 128); }
  __device__ __forceinline__ void mask(f32x16& p0, f32x16& p1, int t, int wid, int r32, int hi) const {
    if (t < 4) return;
    const int dq = kpos0(t) - (qpos0(wid) + r32);
#pragma unroll
    for (int r = 0; r < 16; ++r) { const int d = dq + crow(r, hi); if (d > 128 || d < -128) p0[r] = -INFINITY; if (d + 32 > 128 || d + 32 < -128) p1[r] = -INFINITY; }
  }
  __device__ __forceinline__ float sink(int wid) const { return sinkp[head(wid)] * LOG2E; }
  __device__ __forceinline__ bf16* orow(int wid, int row) const { return O + (long)(8192 * b + qpos0(wid) + row) * 1024 + 64 * head(wid); }
};
struct UNa {
  const bf16* QKV; bf16* O; const ATT_LAS float* rpbl; int b, h, R4; int krlo, nloc;
  __device__ __forceinline__ static int clampi(int v, int lo, int hi_) { return v < lo ? lo : (v > hi_ ? hi_ : v); }
  __device__ __forceinline__ void init() { krlo = clampi(4 * R4 - 4, 0, 120); const int krhi = clampi(4 * R4 - 1, 0, 120) + 7; nloc = krhi - krlo + 1; }
  __device__ __forceinline__ int nt() const { return 4 + nloc; }
  __device__ __forceinline__ long krow(int t) const { return t < 4 ? (long)(ROWS_LAT + 256 * b + 64 * t) : (long)(8192 * b + 64 * (krlo + t - 4)); }
  __device__ __forceinline__ const bf16* kptr(long row, int ch) const { return QKV + row * 2304 + 1280 + 64 * h + ch * 8; }
  __device__ __forceinline__ const bf16* vptr(long row, int ch) const { return QKV + row * 2304 + 1792 + 64 * h + ch * 8; }
  __device__ __forceinline__ int qrow(int wid) const { return 4 * R4 + (wid >> 1); }
  __device__ __forceinline__ const bf16* qptr(int wid, int r32, int d0, int hi) const { return QKV + (long)(8192 * b + 64 * qrow(wid) + 32 * (wid & 1) + r32) * 2304 + 768 + 64 * h + 16 * d0 + 8 * hi; }
  __device__ __forceinline__ bool skip(int t, int wid) const { if (t < 4) return false; const int kr = krlo + t - 4, w0 = clampi(qrow(wid) - 4, 0, 120); return kr < w0 || kr > w0 + 7; }
  __device__ __forceinline__ void mask(f32x16& p0, f32x16& p1, int t, int wid, int r32, int hi) const {
    if (t < 4) return;
    const int kr = krlo + t - 4, qc = 32 * (wid & 1) + r32, c0 = clampi(qc - 8, 0, 48);
    const ATT_LAS float* brow = rpbl + (kr - qrow(wid) + 7) * 31 + 15;
#pragma unroll
    for (int r = 0; r < 16; ++r) {
      { const int kc = crow(r, hi); const bool ok = kc >= c0 && kc < c0 + 16; const float bv = brow[clampi(kc - qc, -15, 15)]; p0[r] = ok ? p0[r] + bv : -INFINITY; }
      { const int kc = 32 + crow(r, hi); const bool ok = kc >= c0 && kc < c0 + 16; const float bv = brow[clampi(kc - qc, -15, 15)]; p1[r] = ok ? p1[r] + bv : -INFINITY; } }
  }
  __device__ __forceinline__ float sink(int) const { return -INFINITY; }
  __device__ __forceinline__ bf16* orow(int wid, int row) const { return O + (long)(8192 * b + 64 * qrow(wid) + 32 * (wid & 1) + row) * 1024 + 512 + 64 * h; }
};
struct UCtx {
  const bf16* QKV; bf16* O; const float* sinkp; int b, hx; int qcol, kcol, vcol, ocol;
  __device__ __forceinline__ void init() { if (hx < 8) { qcol = 64 * hx; kcol = 512 + 64 * (hx >> 2); vcol = 640 + 64 * (hx >> 2); ocol = 64 * hx; }
    else { const int h = hx - 8; qcol = 768 + 64 * h; kcol = 1280 + 64 * h; vcol = 1792 + 64 * h; ocol = 512 + 64 * h; } }
  __device__ __forceinline__ int nt() const { return 4; }
  __device__ __forceinline__ long krow(int t) const { return (long)(ROWS_LAT + 256 * b + 64 * t); }
  __device__ __forceinline__ const bf16* kptr(long row, int ch) const { return QKV + row * 2304 + kcol + ch * 8; }
  __device__ __forceinline__ const bf16* vptr(long row, int ch) const { return QKV + row * 2304 + vcol + ch * 8; }
  __device__ __forceinline__ const bf16* qptr(int wid, int r32, int d0, int hi) const { return QKV + (long)(ROWS_LAT + 256 * b + 32 * wid + r32) * 2304 + qcol + 16 * d0 + 8 * hi; }
  __device__ __forceinline__ bool skip(int, int) const { return false; }
  __device__ __forceinline__ void mask(f32x16&, f32x16&, int, int, int, int) const {}
  __device__ __forceinline__ float sink(int) const { return hx < 8 ? sinkp[hx] * LOG2E : -INFINITY; }
  __device__ __forceinline__ bf16* orow(int wid, int row) const { return O + (long)(ROWS_LAT + 256 * b + 32 * wid + row) * 1024 + ocol; }
};
struct UDense {
  const bf16* Q; const bf16* KV; const bf16* KR; bf16* O; int b, h, qb;
  __device__ __forceinline__ int nt() const { return 132; }
  __device__ __forceinline__ long krow(int t) const { return t < 4 ? (long)(ROWS_LAT + 256 * b + 64 * t) : (long)(8192 * b + 64 * (t - 4)); }
  __device__ __forceinline__ const bf16* kptr(long row, int ch) const { return ch < 8 ? KV + row * 2048 + 64 * h + ch * 8 : KR + row * 32 + (ch - 8) * 8; }
  __device__ __forceinline__ const bf16* vptr(long row, int ch) const { return KV + row * 2048 + 1024 + 64 * h + ch * 8; }
  __device__ __forceinline__ const bf16* qptr(int wid, int r32, int d0, int hi) const { const bf16* qp = Q + (long)(8192 * b + 256 * qb + 32 * wid + r32) * 1536;
    return d0 < 4 ? qp + 64 * h + 16 * d0 + 8 * hi : qp + 1024 + 32 * h + 16 * (d0 - 4) + 8 * hi; }
  __device__ __forceinline__ bool skip(int, int) const { return false; }
  __device__ __forceinline__ void mask(f32x16&, f32x16&, int, int, int, int) const {}
  __device__ __forceinline__ float sink(int) const { return -INFINITY; }
  __device__ __forceinline__ bf16* orow(int wid, int row) const { return O + (long)(8192 * b + 256 * qb + 32 * wid + row) * 1024 + 64 * h; }
};
#undef ATT_SBAR
}
namespace attd {
typedef unsigned short bf16;
using bf16x8 = __attribute__((ext_vector_type(8))) short;
using s16x4 = __attribute__((ext_vector_type(4))) short;
using f32x16 = __attribute__((ext_vector_type(16))) float;
using u32x4 = __attribute__((ext_vector_type(4))) unsigned;
using i32x2 = __attribute__((ext_vector_type(2))) int;
using i32x4 = __attribute__((ext_vector_type(4))) int;
using i32x8 = __attribute__((ext_vector_type(8))) int;
using u32x6 = __attribute__((ext_vector_type(6))) unsigned;
using u32x16 = __attribute__((ext_vector_type(16))) unsigned;
typedef __bf16 bf16x32 __attribute__((ext_vector_type(32)));
constexpr int NW = 8, NT = 132, KSLOT = 5120, VSLOT = 8192;
constexpr int LDS_K = 0, LDS_V = 3 * KSLOT, LDS_WS = LDS_V + 3 * VSLOT, LDS_OST = LDS_WS + NW * 64 * 4, LDS_BYTES = LDS_OST + NW * 4096;
__device__ __forceinline__ int crow(int r, int hi) { return (r & 3) + 8 * (r >> 2) + 4 * hi; }
#define AF_SBAR() __builtin_amdgcn_sched_barrier(0)
__device__ __forceinline__ void glds16(unsigned voff, const void* sbase, unsigned lds_dst) { unsigned keep;
  asm volatile("s_mov_b32 %0, m0\n\ts_mov_b32 m0, %3\n\ts_nop 0\n\tglobal_load_lds_dwordx4 %1, %2\n\ts_mov_b32 m0, %0" : "=&s"(keep) : "v"(voff), "s"(sbase), "s"(lds_dst) : "memory"); }
typedef float f32x2_t __attribute__((ext_vector_type(2))); typedef __bf16 bf16x2_t __attribute__((ext_vector_type(2)));
__device__ __forceinline__ unsigned cvtpk_s(float lo, float hi) { f32x2_t v = {lo, hi}; bf16x2_t b = __builtin_convertvector(v, bf16x2_t); return __builtin_bit_cast(unsigned, b); }
#define AF_WAIT_BAR(N) asm volatile("s_waitcnt vmcnt(" #N ") lgkmcnt(0)\n\ts_barrier" ::: "memory")
typedef __attribute__((address_space(3))) const char* lds_cptr;
typedef short v4i16_t __attribute__((ext_vector_type(4)));
__device__ __forceinline__ i32x8 ld6(lds_cptr p16, lds_cptr p8) { const i32x4 a = *(const __attribute__((address_space(3))) i32x4*)p16; const i32x2 b = *(const __attribute__((address_space(3))) i32x2*)p8;
  return (i32x8){a.x, a.y, a.z, a.w, b.x, b.y, 0, 0}; }
__device__ __forceinline__ s16x4 vtr(lds_cptr p) { return __builtin_bit_cast(s16x4, __builtin_amdgcn_ds_read_tr16_b64_v4i16((__attribute__((address_space(3))) v4i16_t*)p)); }
__device__ __forceinline__ long tile_row(int b, int t) { return t < 4 ? (long)(16384 + 256 * b + 64 * t) : (long)(8192 * b + 64 * (t - 4)); }
__device__ __forceinline__ u32x6 to_fp6(u32x4 a0, u32x4 a1, u32x4 a2, u32x4 a3) { const u32x16 all = {a0.x, a0.y, a0.z, a0.w, a1.x, a1.y, a1.z, a1.w, a2.x, a2.y, a2.z, a2.w, a3.x, a3.y, a3.z, a3.w};
  return __builtin_amdgcn_cvt_scalef32_pk32_fp6_bf16(__builtin_bit_cast(bf16x32, all), 1.0f); }

__device__ __forceinline__ void dense_unit(int b, int h, int qb, const bf16* Q, const bf16* __restrict__ KV, const char* __restrict__ K6N, const char* __restrict__ K6R, bf16* O, char* shm, const int tid) {
  const int lane = tid & 63, r32 = lane & 31, hi = lane >> 5; const int wid = __builtin_amdgcn_readfirstlane(tid >> 6);
  const unsigned lds0 = (unsigned)(uintptr_t)shm;
  float* wsf = (float*)(shm + LDS_WS) + wid * 64;
  const bool wnp = wid < 3 || wid >= 5; const int pc = wnp ? (wid < 3 ? wid : wid - 5) : wid - 3;
  const unsigned voffK = (unsigned)(lane * 16);
  const char* sK = wnp ? K6N + h * 3072 + pc * 1024 : K6R + pc * 1024; const long kts = wnp ? 16 * 3072 : 2048;
  const unsigned voffV = (unsigned)((16 * (wid & 3) + (lane >> 2)) * 2048 + (wid >> 2) * 32 + (lane & 3) * 8) * 2u;
  const char* sV = (const char*)(KV + 1024 + 64 * h);
  const unsigned kdst = lds0 + LDS_K + (wnp ? pc * 1024 : 3072 + pc * 1024), vdst = lds0 + LDS_V + wid * 1024;
#define AF_DMA_K(t, ks) do { const long G_ = tile_row(b, (t)) >> 6; glds16(voffK, sK + G_ * kts, (unsigned)__builtin_amdgcn_readfirstlane(kdst + (ks))); } while (0)
#define AF_DMA_V(t, vs) do { const long R_ = tile_row(b, (t)); glds16(voffV, sV + R_ * 4096, (unsigned)__builtin_amdgcn_readfirstlane(vdst + (vs))); } while (0)
  const lds_cptr shm3 = (lds_cptr)shm;
  const lds_cptr kp16 = shm3 + LDS_K + hi * 1024 + r32 * 16;
  const lds_cptr kp8 = shm3 + LDS_K + 2048 + hi * 512 + r32 * 8;
  const lds_cptr vp0 = shm3 + LDS_V + ((lane >> 4) & 1) * 32 + (lane & 3) * 8 + (4 * hi + ((lane & 15) >> 2)) * 64;
  AF_DMA_K(0, 0); AF_DMA_V(0, 0); AF_DMA_K(1, KSLOT); AF_DMA_K(2, 2 * KSLOT);
  i32x8 qn, qr;
  { const bf16* qp = Q + (long)(8192 * b + 256 * qb + 32 * wid + r32) * 1536; const bf16* qa = qp + 64 * h + 32 * hi; const bf16* qc = qp + 1024 + 32 * h;
    const u32x6 n6 = to_fp6(*reinterpret_cast<const u32x4*>(qa), *reinterpret_cast<const u32x4*>(qa + 8), *reinterpret_cast<const u32x4*>(qa + 16), *reinterpret_cast<const u32x4*>(qa + 24));
    u32x6 r6 = to_fp6(*reinterpret_cast<const u32x4*>(qc), *reinterpret_cast<const u32x4*>(qc + 8), *reinterpret_cast<const u32x4*>(qc + 16), *reinterpret_cast<const u32x4*>(qc + 24));
    if (hi) r6 = (u32x6){0u, 0u, 0u, 0u, 0u, 0u};
    qn = (i32x8){(int)n6[0], (int)n6[1], (int)n6[2], (int)n6[3], (int)n6[4], (int)n6[5], 0, 0}; qr = (i32x8){(int)r6[0], (int)r6[1], (int)r6[2], (int)r6[3], (int)r6[4], (int)r6[5], 0, 0}; }
  float l_reg = 0.f; f32x16 o[2]; o[0] = f32x16{}; o[1] = f32x16{};
  f32x16 pA0, pA1, pB0, pB1; i32x8 kn0, kn1, kr0, kr1;
  int s_prev = 0, s_cur = 0, s_next = 1;
#define AF_ROT() do { s_prev = s_cur; s_cur = s_next; s_next = (s_next == 2) ? 0 : s_next + 1; } while (0)
#define AF_MF(a, b, c) __builtin_amdgcn_mfma_f32_32x32x16_bf16(a, b, c, 0, 0, 0)
#define AF_MX(a, b, c) __builtin_amdgcn_mfma_scale_f32_32x32x64_f8f6f4(a, b, c, 2, 2, 0, 0x7b7b7b7b, 0, 0x7f7f7f7f)
#define AF_EX(v) __builtin_amdgcn_exp2f(v)
  const f32x16 zero16 = f32x16{};
  AF_WAIT_BAR(0);
  { pA0 = AF_MX(ld6(kp16, kp8), qn, zero16); pA1 = AF_MX(ld6(kp16 + 512, kp8 + 256), qn, zero16);
    pA0 = AF_MX(ld6(kp16 + 3072, kp8 + 2048), qr, pA0); pA1 = AF_MX(ld6(kp16 + 3072 + 512, kp8 + 2048 + 256), qr, pA1);
#pragma unroll
    for (int r = 0; r < 16; ++r) { pA0[r] = AF_EX(pA0[r]); pA1[r] = AF_EX(pA1[r]); } }
  AF_WAIT_BAR(0);
  AF_DMA_K(3, 0); AF_DMA_V(1, VSLOT);
  AF_ROT();
  { const lds_cptr k16_ = kp16 + s_cur * KSLOT, k8_ = kp8 + s_cur * KSLOT; kn0 = ld6(k16_, k8_); kn1 = ld6(k16_ + 512, k8_ + 256); kr0 = ld6(k16_ + 3072, k8_ + 2048); kr1 = ld6(k16_ + 3072 + 512, k8_ + 2048 + 256); }
  AF_WAIT_BAR(2);
  s16x4 vlo[8], vhi[8]; u32x4 pw0, pw1, pw2, pw3;
#define AF_PKW(P, B) cvtpk_s(P[B], P[B + 1])
#define AF_PAF(k) __builtin_bit_cast(bf16x8, pw##k)
#define AF_VFR(i) (bf16x8){vlo[i][0], vlo[i][1], vlo[i][2], vlo[i][3], vhi[i][0], vhi[i][1], vhi[i][2], vhi[i][3]}
#define AF_PIN(x) asm volatile("" : "+v"(x))
#define AF_VRD(i) do { vlo[i] = vtr(vp_ + (((i) >> 2) * 4096 + ((i) & 3) * 1024)); vhi[i] = vtr(vp_ + (((i) >> 2) * 4096 + ((i) & 3) * 1024 + 512)); AF_SBAR(); } while (0)
#define AF_GB(MF, X, B) do { MF; X[B] = AF_EX(X[B]); X[B + 1] = AF_EX(X[B + 1]); X[B + 2] = AF_EX(X[B + 2]); X[B + 3] = AF_EX(X[B + 3]); AF_PIN(X); AF_SBAR(); } while (0)
#define AF_KRD(G, j) do { if (G) { const lds_cptr k16_ = kp16 + s_next * KSLOT, k8_ = kp8 + s_next * KSLOT; \
      if ((j) == 0) kn0 = ld6(k16_, k8_); if ((j) == 1) kn1 = ld6(k16_ + 512, k8_ + 256); \
      if ((j) == 2) kr0 = ld6(k16_ + 3072, k8_ + 2048); if ((j) == 3) kr1 = ld6(k16_ + 3072 + 512, k8_ + 2048 + 256); AF_SBAR(); } } while (0)
#define AF_A4(P, B) do { sacc += P[B]; sacc += P[B + 1]; sacc += P[B + 2]; sacc += P[B + 3]; } while (0)
#define AF_STEP(C0, C1, P0, P1, t, GK, GV, GL) do { AF_SBAR(); \
    const lds_cptr vp_ = vp0 + s_prev * VSLOT; \
    float sacc = (P0[0] + P0[1]); \
    AF_VRD(0); AF_VRD(4); \
    { C0 = AF_MX(kn0, qn, zero16); sacc += P0[2]; sacc += P0[3]; AF_A4(P0, 4); AF_PIN(sacc); \
      pw0[0] = AF_PKW(P0, 0); pw0[1] = AF_PKW(P0, 2); pw0[2] = AF_PKW(P0, 4); pw0[3] = AF_PKW(P0, 6); AF_PIN(pw0); AF_SBAR(); } \
    AF_VRD(1); AF_VRD(5); \
    { C1 = AF_MX(kn1, qn, zero16); AF_A4(P0, 8); AF_A4(P0, 12); AF_PIN(sacc); \
      pw1[0] = AF_PKW(P0, 8); pw1[1] = AF_PKW(P0, 10); pw1[2] = AF_PKW(P0, 12); pw1[3] = AF_PKW(P0, 14); AF_PIN(pw1); AF_SBAR(); } \
    AF_VRD(2); AF_VRD(6); \
    { C0 = AF_MX(kr0, qr, C0); AF_A4(P1, 0); AF_A4(P1, 4); AF_PIN(sacc); \
      pw2[0] = AF_PKW(P1, 0); pw2[1] = AF_PKW(P1, 2); pw2[2] = AF_PKW(P1, 4); pw2[3] = AF_PKW(P1, 6); AF_PIN(pw2); AF_SBAR(); } \
    if (GK) { AF_DMA_K((t) + 3, s_cur * KSLOT); AF_SBAR(); } \
    AF_VRD(3); AF_VRD(7); \
    { C1 = AF_MX(kr1, qr, C1); AF_A4(P1, 8); AF_A4(P1, 12); AF_PIN(sacc); \
      pw3[0] = AF_PKW(P1, 8); pw3[1] = AF_PKW(P1, 10); pw3[2] = AF_PKW(P1, 12); pw3[3] = AF_PKW(P1, 14); AF_PIN(pw3); AF_SBAR(); } \
    if (GV) { AF_DMA_V((t) + 1, s_next * VSLOT); AF_SBAR(); } \
    l_reg += sacc; \
    AF_SBAR(); \
    AF_GB(o[0] = AF_MF(AF_PAF(0), AF_VFR(0), o[0]), C0, 0);  AF_KRD(GL, 0); \
    AF_GB(o[1] = AF_MF(AF_PAF(0), AF_VFR(4), o[1]), C0, 4);  AF_KRD(GL, 1); \
    AF_GB(o[0] = AF_MF(AF_PAF(1), AF_VFR(1), o[0]), C0, 8);  AF_KRD(GL, 2); \
    AF_GB(o[1] = AF_MF(AF_PAF(1), AF_VFR(5), o[1]), C0, 12); AF_KRD(GL, 3); \
    AF_GB(o[0] = AF_MF(AF_PAF(2), AF_VFR(2), o[0]), C1, 0); \
    AF_GB(o[1] = AF_MF(AF_PAF(2), AF_VFR(6), o[1]), C1, 4); \
    AF_GB(o[0] = AF_MF(AF_PAF(3), AF_VFR(3), o[0]), C1, 8); \
    AF_GB(o[1] = AF_MF(AF_PAF(3), AF_VFR(7), o[1]), C1, 12); \
  } while (0)
  int t = 1;
  for (; t + 3 < NT; t += 2) {
    AF_STEP(pB0, pB1, pA0, pA1, t, true, true, true);     AF_WAIT_BAR(2); AF_ROT();
    AF_STEP(pA0, pA1, pB0, pB1, t + 1, true, true, true); AF_WAIT_BAR(2); AF_ROT();
  }
  AF_STEP(pB0, pB1, pA0, pA1, NT - 3, false, true, true);  AF_WAIT_BAR(1); AF_ROT();
  AF_STEP(pA0, pA1, pB0, pB1, NT - 2, false, true, true);  AF_WAIT_BAR(0); AF_ROT();
  AF_STEP(pB0, pB1, pA0, pA1, NT - 1, false, false, false);
  { float sacc = pB0[0] + pB0[1];
#pragma unroll
    for (int r = 2; r < 16; ++r) sacc += pB0[r];
#pragma unroll
    for (int r = 0; r < 16; ++r) sacc += pB1[r];
    l_reg += sacc;
    pw0 = (u32x4){AF_PKW(pB0, 0), AF_PKW(pB0, 2), AF_PKW(pB0, 4), AF_PKW(pB0, 6)}; pw1 = (u32x4){AF_PKW(pB0, 8), AF_PKW(pB0, 10), AF_PKW(pB0, 12), AF_PKW(pB0, 14)};
    pw2 = (u32x4){AF_PKW(pB1, 0), AF_PKW(pB1, 2), AF_PKW(pB1, 4), AF_PKW(pB1, 6)}; pw3 = (u32x4){AF_PKW(pB1, 8), AF_PKW(pB1, 10), AF_PKW(pB1, 12), AF_PKW(pB1, 14)};
    AF_SBAR();
    const lds_cptr vp_ = vp0 + s_cur * VSLOT;
#pragma unroll
    for (int i = 0; i < 8; ++i) { vlo[i] = vtr(vp_ + ((i >> 2) * 4096 + (i & 3) * 1024)); vhi[i] = vtr(vp_ + ((i >> 2) * 4096 + (i & 3) * 1024 + 512)); }
    o[0] = AF_MF(AF_PAF(0), AF_VFR(0), o[0]); o[1] = AF_MF(AF_PAF(0), AF_VFR(4), o[1]);
    o[0] = AF_MF(AF_PAF(1), AF_VFR(1), o[0]); o[1] = AF_MF(AF_PAF(1), AF_VFR(5), o[1]);
    o[0] = AF_MF(AF_PAF(2), AF_VFR(2), o[0]); o[1] = AF_MF(AF_PAF(2), AF_VFR(6), o[1]);
    o[0] = AF_MF(AF_PAF(3), AF_VFR(3), o[0]); o[1] = AF_MF(AF_PAF(3), AF_VFR(7), o[1]); }
  { auto rr = __builtin_amdgcn_permlane32_swap(__float_as_uint(l_reg), __float_as_uint(l_reg), false, false); l_reg = __uint_as_float(rr[0]) + __uint_as_float(rr[1]); }
  if (hi == 0) wsf[32 + r32] = l_reg; asm volatile("s_waitcnt lgkmcnt(0)" ::: "memory");
  float rli[16];
#pragma unroll
  for (int r = 0; r < 16; ++r) rli[r] = __builtin_amdgcn_rcpf(wsf[32 + crow(r, hi)]);
  bf16* Ow = O + (long)(8192 * b + 256 * qb + 32 * wid) * 1024 + 64 * h;
  { bf16* stg = (bf16*)(shm + LDS_OST) + wid * 2048;
#pragma unroll
    for (int r = 0; r < 16; ++r) { const int orow = crow(r, hi);
#pragma unroll
      for (int d0 = 0; d0 < 2; ++d0) stg[orow * 64 + d0 * 32 + r32] = (bf16)(cvtpk_s(o[d0][r] * rli[r], 0.f) & 0xffffu); }
    asm volatile("s_waitcnt lgkmcnt(0)" ::: "memory");
#pragma unroll
    for (int i = 0; i < 4; ++i) { const int row = i * 8 + (lane >> 3), ch = lane & 7; const u32x4 v = *(const u32x4*)(stg + row * 64 + ch * 8); *(u32x4*)(Ow + (long)row * 1024 + ch * 8) = v; } }
  asm volatile("s_waitcnt vmcnt(0) lgkmcnt(0)\n\ts_barrier" ::: "memory");
#undef AF_DMA_K
#undef AF_DMA_V
#undef AF_ROT
#undef AF_PKW
#undef AF_PAF
#undef AF_VFR
#undef AF_PIN
#undef AF_MF
#undef AF_MX
#undef AF_EX
#undef AF_VRD
#undef AF_GB
#undef AF_KRD
#undef AF_A4
#undef AF_STEP
}
#undef AF_SBAR
#undef AF_WAIT_BAR
}
namespace attf {
typedef unsigned short bf16;
using bf16x8 = __attribute__((ext_vector_type(8))) short;
using s16x4 = __attribute__((ext_vector_type(4))) short;
using f32x16 = __attribute__((ext_vector_type(16))) float;
using u32x4 = __attribute__((ext_vector_type(4))) unsigned;
constexpr int NW = 8, KSLOT = 12288, VSLOT = 8192;
constexpr int LDS_K = 0, LDS_V = 3 * KSLOT, LDS_WS = LDS_V + 3 * VSLOT, LDS_OST = LDS_WS + NW * 64 * 4, LDS_RPB = LDS_OST + NW * 4096, LDS_BYTES = LDS_RPB + 2048;
__device__ __forceinline__ int crow(int r, int hi) { return (r & 3) + 8 * (r >> 2) + 4 * hi; }
#define AF_SBAR() __builtin_amdgcn_sched_barrier(0)
__device__ __forceinline__ void glds16(unsigned voff, const void* sbase, unsigned lds_dst) { unsigned keep;
  asm volatile("s_mov_b32 %0, m0\n\ts_mov_b32 m0, %3\n\ts_nop 0\n\tglobal_load_lds_dwordx4 %1, %2\n\ts_mov_b32 m0, %0" : "=&s"(keep) : "v"(voff), "s"(sbase), "s"(lds_dst) : "memory"); }
typedef float f32x2_t __attribute__((ext_vector_type(2))); typedef __bf16 bf16x2_t __attribute__((ext_vector_type(2)));
__device__ __forceinline__ unsigned cvtpk_s(float lo, float hi) { f32x2_t v = {lo, hi}; bf16x2_t b = __builtin_convertvector(v, bf16x2_t); return __builtin_bit_cast(unsigned, b); }
#define AF_WAIT_BAR(N) asm volatile("s_waitcnt vmcnt(" #N ") lgkmcnt(0)\n\ts_barrier" ::: "memory")
typedef __attribute__((address_space(3))) const char* lds_cptr;
typedef short v4i16_t __attribute__((ext_vector_type(4)));
__device__ __forceinline__ void kload2(bf16x8* kf, lds_cptr kp, int j) { kf[2 * j] = *(const __attribute__((address_space(3))) bf16x8*)(kp + j * 2048); kf[2 * j + 1] = *(const __attribute__((address_space(3))) bf16x8*)(kp + j * 2048 + 512); }
__device__ __forceinline__ s16x4 vtr(lds_cptr p) { return __builtin_bit_cast(s16x4, __builtin_amdgcn_ds_read_tr16_b64_v4i16((__attribute__((address_space(3))) v4i16_t*)p)); }

template <int DKC, class U>
__device__ __forceinline__ void fast_unit(const U& u, char* shm, int tid) {
  static_assert(DKC == 8 || DKC == 12, "q/k dim 64 or 96");
  asm volatile("" : "+v"(tid));
  constexpr int ND0 = DKC / 2;
  const int lane = tid & 63, r32 = lane & 31, hi = lane >> 5; const int wid = __builtin_amdgcn_readfirstlane(tid >> 6);
  const unsigned lds0 = (unsigned)(uintptr_t)shm;
  float* wsf = (float*)(shm + LDS_WS) + wid * 64;
  const int NT = u.nt();
  const unsigned voffKA = (unsigned)(lane * u.kpitch + 8 * wid) * 2u;
  const unsigned voffKB = (unsigned)(lane * 32 + 8 * (wid & 3)) * 2u;
  const unsigned voffV = (unsigned)((16 * (wid & 3) + (lane >> 2)) * u.vpitch + (wid >> 2) * 32 + (lane & 3) * 8) * 2u;
  const unsigned kdstA = lds0 + LDS_K + wid * 1024, kdstB = lds0 + LDS_K + (8 + (wid & 3)) * 1024, vdst = lds0 + LDS_V + wid * 1024;
#define AF_DMA_KA(t, ks) do { const long R_ = u.trow(t); glds16(voffKA, (const char*)u.kbase + R_ * (2 * u.kpitch), (unsigned)__builtin_amdgcn_readfirstlane(kdstA + (ks))); } while (0)
#define AF_DMA_KB(t, ks) do { if constexpr (DKC == 12) { const long R_ = u.trow(t); glds16(voffKB, (const char*)u.krbase + R_ * 64, (unsigned)__builtin_amdgcn_readfirstlane(kdstB + (ks))); } } while (0)
#define AF_DMA_K(t, ks) do { AF_DMA_KA(t, ks); AF_DMA_KB(t, ks); } while (0)
#define AF_DMA_V(t, vs) do { const long R_ = u.trow(t); glds16(voffV, (const char*)u.vbase + R_ * (2 * u.vpitch), (unsigned)__builtin_amdgcn_readfirstlane(vdst + (vs))); } while (0)
#define AF_WAITN(NSTEPS_K, NV) do { if constexpr (DKC == 12) { if ((NSTEPS_K) == 2 && (NV) == 1) AF_WAIT_BAR(5); else if ((NSTEPS_K) == 1 && (NV) == 1) AF_WAIT_BAR(3); else if ((NV) == 1) AF_WAIT_BAR(1); else AF_WAIT_BAR(0); } \
    else { if ((NSTEPS_K) == 2 && (NV) == 1) AF_WAIT_BAR(3); else if ((NSTEPS_K) == 1 && (NV) == 1) AF_WAIT_BAR(2); else if ((NV) == 1) AF_WAIT_BAR(1); else AF_WAIT_BAR(0); } } while (0)
  const lds_cptr shm3 = (lds_cptr)shm; const lds_cptr kp0 = shm3 + LDS_K + hi * 1024 + r32 * 16;
  const lds_cptr vp0 = shm3 + LDS_V + ((lane >> 4) & 1) * 32 + (lane & 3) * 8 + (4 * hi + ((lane & 15) >> 2)) * 64;
  bf16x8 qr[ND0];
#pragma unroll
  for (int d0 = 0; d0 < ND0; ++d0) qr[d0] = *reinterpret_cast<const bf16x8*>(u.qptr(wid, r32, d0, hi));
  AF_DMA_K(0, 0); AF_DMA_V(0, 0); AF_DMA_K(1, KSLOT); AF_DMA_K(2, 2 * KSLOT);
  float l_reg = 0.f; f32x16 o[2]; o[0] = f32x16{}; o[1] = f32x16{};
  f32x16 pA0, pA1, pB0, pB1; bf16x8 kf[DKC];
  int s_prev = 0, s_cur = 0, s_next = 1;
#define AF_ROT() do { s_prev = s_cur; s_cur = s_next; s_next = (s_next == 2) ? 0 : s_next + 1; } while (0)
  AF_WAITN(2, 1);
  { const char* kb = shm + LDS_K + hi * 1024 + r32 * 16; pA0 = f32x16{}; pA1 = f32x16{};
#pragma unroll
    for (int d0 = 0; d0 < ND0; ++d0) { const bf16x8 b0 = *reinterpret_cast<const bf16x8*>(kb + d0 * 2048), b1 = *reinterpret_cast<const bf16x8*>(kb + d0 * 2048 + 512);
      pA0 = __builtin_amdgcn_mfma_f32_32x32x16_bf16(b0, qr[d0], pA0, 0, 0, 0); pA1 = __builtin_amdgcn_mfma_f32_32x32x16_bf16(b1, qr[d0], pA1, 0, 0, 0); }
    if constexpr (U::HAS_MASK) u.mask(pA0, pA1, 0, wid, r32, hi);
#pragma unroll
    for (int r = 0; r < 16; ++r) { pA0[r] = __builtin_amdgcn_exp2f(pA0[r]); pA1[r] = __builtin_amdgcn_exp2f(pA1[r]); } }
  AF_WAIT_BAR(0);
  AF_DMA_K(3, 0); AF_DMA_V(1, VSLOT);
  AF_ROT();
#pragma unroll
  for (int j = 0; j < ND0; ++j) kload2(kf, kp0 + s_cur * KSLOT, j);
  AF_WAITN(1, 1);
  s16x4 vlo[8], vhi[8]; u32x4 pw0, pw1, pw2, pw3;
#define AF_PKW(P, B) cvtpk_s(P[B], P[B + 1])
#define AF_PAF(k) __builtin_bit_cast(bf16x8, pw##k)
#define AF_VFR(i) (bf16x8){vlo[i][0], vlo[i][1], vlo[i][2], vlo[i][3], vhi[i][0], vhi[i][1], vhi[i][2], vhi[i][3]}
#define AF_PIN(x) asm volatile("" : "+v"(x))
#define AF_MF(a, b, c) __builtin_amdgcn_mfma_f32_32x32x16_bf16(a, b, c, 0, 0, 0)
#define AF_EX(v) __builtin_amdgcn_exp2f(v)
#define AF_VRD(i) do { vlo[i] = vtr(vp_ + (((i) >> 2) * 4096 + ((i) & 3) * 1024)); vhi[i] = vtr(vp_ + (((i) >> 2) * 4096 + ((i) & 3) * 1024 + 512)); AF_SBAR(); } while (0)
#define AF_GA4(MF, A0, A1, A2, A3, W0, W1, PW) do { MF; sacc += A0; sacc += A1; sacc += A2; sacc += A3; AF_PIN(sacc); W0; W1; AF_PIN(PW); AF_SBAR(); } while (0)
#define AF_GA3(MF, A0, A1, A2, W0, W1, PW) do { MF; sacc += A0; sacc += A1; sacc += A2; AF_PIN(sacc); W0; W1; AF_PIN(PW); AF_SBAR(); } while (0)
#define AF_GA2(MF, A0, A1, W0, PW) do { MF; sacc += A0; sacc += A1; AF_PIN(sacc); W0; AF_PIN(PW); AF_SBAR(); } while (0)
#define AF_GB(MF, X, B) do { MF; X[B] = AF_EX(X[B]); X[B + 1] = AF_EX(X[B + 1]); X[B + 2] = AF_EX(X[B + 2]); X[B + 3] = AF_EX(X[B + 3]); AF_PIN(X); AF_SBAR(); } while (0)
#define AF_KRD(G, j) do { if ((j) < ND0) { if (G) { kload2(kf, kp0 + s_next * KSLOT, (j) < ND0 ? (j) : 0); AF_SBAR(); } } } while (0)
  const f32x16 zero16 = f32x16{};
#define AF_PHASE_A12(C0, C1, P0, P1, t, GK, GV) do { \
    AF_VRD(0); float sacc = (P0[0] + P0[1]); \
    AF_GA3(C0 = AF_MF(kf[0], qr[0], zero16), P0[2], P0[3], P0[4],     pw0[0] = AF_PKW(P0, 0), pw0[1] = AF_PKW(P0, 2), pw0); \
    AF_VRD(4); AF_GA3(C1 = AF_MF(kf[1], qr[0], zero16), P0[5], P0[6], P0[7],     pw0[2] = AF_PKW(P0, 4), pw0[3] = AF_PKW(P0, 6), pw0); \
    AF_VRD(1); AF_GA3(C0 = AF_MF(kf[2], qr[1], C0),     P0[8], P0[9], P0[10],    pw1[0] = AF_PKW(P0, 8), pw1[1] = AF_PKW(P0, 10), pw1); \
    AF_VRD(5); AF_GA3(C1 = AF_MF(kf[3], qr[1], C1),     P0[11], P0[12], P0[13],  pw1[2] = AF_PKW(P0, 12), pw1[3] = AF_PKW(P0, 14), pw1); \
    AF_VRD(2); AF_GA3(C0 = AF_MF(kf[4], qr[2], C0),     P0[14], P0[15], P1[0],   pw2[0] = AF_PKW(P1, 0), pw2[1] = AF_PKW(P1, 2), pw2); \
    AF_VRD(6); AF_GA3(C1 = AF_MF(kf[5], qr[2], C1),     P1[1], P1[2], P1[3],     pw2[2] = AF_PKW(P1, 4), pw2[3] = AF_PKW(P1, 6), pw2); \
    AF_VRD(3); AF_GA2(C0 = AF_MF(kf[6], qr[3], C0),     P1[4], P1[5],            pw3[0] = AF_PKW(P1, 8), pw3); \
    AF_VRD(7); AF_GA2(C1 = AF_MF(kf[7], qr[3], C1),     P1[6], P1[7],            pw3[1] = AF_PKW(P1, 10), pw3); \
    AF_GA2(C0 = AF_MF(kf[8 % DKC], qr[4 % ND0], C0),    P1[8], P1[9],            pw3[2] = AF_PKW(P1, 12), pw3); \
    if (GK) { AF_DMA_KA((t) + 3, s_cur * KSLOT); AF_SBAR(); } \
    AF_GA2(C1 = AF_MF(kf[9 % DKC], qr[4 % ND0], C1),    P1[10], P1[11],          pw3[3] = AF_PKW(P1, 14), pw3); \
    if (GK) { AF_DMA_KB((t) + 3, s_cur * KSLOT); AF_SBAR(); } \
    { C0 = AF_MF(kf[10 % DKC], qr[5 % ND0], C0); sacc += P1[12]; sacc += P1[13]; AF_PIN(sacc); AF_SBAR(); } \
    if (GV) { AF_DMA_V((t) + 1, s_next * VSLOT); AF_SBAR(); } \
    { C1 = AF_MF(kf[11 % DKC], qr[5 % ND0], C1); sacc += P1[14]; sacc += P1[15]; AF_PIN(sacc); AF_SBAR(); } \
    l_reg += sacc; } while (0)
#define AF_PHASE_A8(C0, C1, P0, P1, t, GK, GV) do { \
    AF_VRD(0); float sacc = (P0[0] + P0[1]); \
    AF_GA4(C0 = AF_MF(kf[0], qr[0], zero16), P0[2], P0[3], P0[4], P0[5],       pw0[0] = AF_PKW(P0, 0), pw0[1] = AF_PKW(P0, 2), pw0); \
    AF_VRD(4); AF_GA4(C1 = AF_MF(kf[1], qr[0], zero16), P0[6], P0[7], P0[8], P0[9],       pw0[2] = AF_PKW(P0, 4), pw0[3] = AF_PKW(P0, 6), pw0); \
    AF_VRD(1); AF_GA4(C0 = AF_MF(kf[2], qr[1], C0),     P0[10], P0[11], P0[12], P0[13],   pw1[0] = AF_PKW(P0, 8), pw1[1] = AF_PKW(P0, 10), pw1); \
    AF_VRD(5); AF_GA4(C1 = AF_MF(kf[3], qr[1], C1),     P0[14], P0[15], P1[0], P1[1],     pw1[2] = AF_PKW(P0, 12), pw1[3] = AF_PKW(P0, 14), pw1); \
    AF_VRD(2); AF_GA4(C0 = AF_MF(kf[4], qr[2], C0),     P1[2], P1[3], P1[4], P1[5],       pw2[0] = AF_PKW(P1, 0), pw2[1] = AF_PKW(P1, 2), pw2); \
    AF_VRD(6); AF_GA4(C1 = AF_MF(kf[5], qr[2], C1),     P1[6], P1[7], P1[8], P1[9],       pw2[2] = AF_PKW(P1, 4), pw2[3] = AF_PKW(P1, 6), pw2); \
    AF_VRD(3); AF_GA4(C0 = AF_MF(kf[6], qr[3], C0),     P1[10], P1[11], P1[12], P1[13],   pw3[0] = AF_PKW(P1, 8), pw3[1] = AF_PKW(P1, 10), pw3); \
    AF_VRD(7); AF_GA4(C1 = AF_MF(kf[7], qr[3], C1),     P1[14], P1[15], 0.f, 0.f,         pw3[2] = AF_PKW(P1, 12), pw3[3] = AF_PKW(P1, 14), pw3); \
    l_reg += sacc; \
    if (GK) { AF_DMA_KA((t) + 3, s_cur * KSLOT); } if (GV) { AF_DMA_V((t) + 1, s_next * VSLOT); } } while (0)
#define AF_STEP(C0, C1, P0, P1, t, GK, GV, GL) do { AF_SBAR(); \
    const lds_cptr vp_ = vp0 + s_prev * VSLOT; \
    if constexpr (DKC == 12) AF_PHASE_A12(C0, C1, P0, P1, t, GK, GV); else AF_PHASE_A8(C0, C1, P0, P1, t, GK, GV); \
    if constexpr (U::HAS_MASK) u.mask(C0, C1, (t), wid, r32, hi); \
    AF_SBAR(); \
    AF_GB(o[0] = AF_MF(AF_PAF(0), AF_VFR(0), o[0]), C0, 0);  AF_KRD(GL, 0); \
    AF_GB(o[1] = AF_MF(AF_PAF(0), AF_VFR(4), o[1]), C0, 4);  AF_KRD(GL, 1); \
    AF_GB(o[0] = AF_MF(AF_PAF(1), AF_VFR(1), o[0]), C0, 8);  AF_KRD(GL, 2); \
    AF_GB(o[1] = AF_MF(AF_PAF(1), AF_VFR(5), o[1]), C0, 12); AF_KRD(GL, 3); \
    AF_GB(o[0] = AF_MF(AF_PAF(2), AF_VFR(2), o[0]), C1, 0);  AF_KRD(GL, 4); \
    AF_GB(o[1] = AF_MF(AF_PAF(2), AF_VFR(6), o[1]), C1, 4);  AF_KRD(GL, 5); \
    AF_GB(o[0] = AF_MF(AF_PAF(3), AF_VFR(3), o[0]), C1, 8); \
    AF_GB(o[1] = AF_MF(AF_PAF(3), AF_VFR(7), o[1]), C1, 12); \
  } while (0)
  int t = 1;
  for (; t + 3 < NT; t += 2) {
    AF_STEP(pB0, pB1, pA0, pA1, t, true, true, true);     AF_WAITN(1, 1); AF_ROT();
    AF_STEP(pA0, pA1, pB0, pB1, t + 1, true, true, true); AF_WAITN(1, 1); AF_ROT();
  }
  AF_STEP(pB0, pB1, pA0, pA1, NT - 3, false, true, true);  AF_WAITN(0, 1); AF_ROT();
  AF_STEP(pA0, pA1, pB0, pB1, NT - 2, false, true, true);  AF_WAIT_BAR(0); AF_ROT();
  AF_STEP(pB0, pB1, pA0, pA1, NT - 1, false, false, false);
  { float sacc = pB0[0] + pB0[1];
#pragma unroll
    for (int r = 2; r < 16; ++r) sacc += pB0[r];
#pragma unroll
    for (int r = 0; r < 16; ++r) sacc += pB1[r];
    l_reg += sacc;
    pw0 = (u32x4){AF_PKW(pB0, 0), AF_PKW(pB0, 2), AF_PKW(pB0, 4), AF_PKW(pB0, 6)}; pw1 = (u32x4){AF_PKW(pB0, 8), AF_PKW(pB0, 10), AF_PKW(pB0, 12), AF_PKW(pB0, 14)};
    pw2 = (u32x4){AF_PKW(pB1, 0), AF_PKW(pB1, 2), AF_PKW(pB1, 4), AF_PKW(pB1, 6)}; pw3 = (u32x4){AF_PKW(pB1, 8), AF_PKW(pB1, 10), AF_PKW(pB1, 12), AF_PKW(pB1, 14)};
    AF_SBAR();
    const lds_cptr vp_ = vp0 + s_cur * VSLOT;
#pragma unroll
    for (int i = 0; i < 8; ++i) { vlo[i] = vtr(vp_ + ((i >> 2) * 4096 + (i & 3) * 1024)); vhi[i] = vtr(vp_ + ((i >> 2) * 4096 + (i & 3) * 1024 + 512)); }
    o[0] = AF_MF(AF_PAF(0), AF_VFR(0), o[0]); o[1] = AF_MF(AF_PAF(0), AF_VFR(4), o[1]);
    o[0] = AF_MF(AF_PAF(1), AF_VFR(1), o[0]); o[1] = AF_MF(AF_PAF(1), AF_VFR(5), o[1]);
    o[0] = AF_MF(AF_PAF(2), AF_VFR(2), o[0]); o[1] = AF_MF(AF_PAF(2), AF_VFR(6), o[1]);
    o[0] = AF_MF(AF_PAF(3), AF_VFR(3), o[0]); o[1] = AF_MF(AF_PAF(3), AF_VFR(7), o[1]); }
  { auto rr = __builtin_amdgcn_permlane32_swap(__float_as_uint(l_reg), __float_as_uint(l_reg), false, false); l_reg = __uint_as_float(rr[0]) + __uint_as_float(rr[1]); }
  l_reg += __builtin_amdgcn_exp2f(u.sink(wid));
  if (hi == 0) wsf[32 + r32] = l_reg; asm volatile("s_waitcnt lgkmcnt(0)" ::: "memory");
  float rli[16];
#pragma unroll
  for (int r = 0; r < 16; ++r) rli[r] = __builtin_amdgcn_rcpf(wsf[32 + crow(r, hi)]);
  bf16* Ow = u.orow0(wid);
  { bf16* stg = (bf16*)(shm + LDS_OST) + wid * 2048;
#pragma unroll
    for (int r = 0; r < 16; ++r) { const int orow = crow(r, hi);
#pragma unroll
      for (int d0 = 0; d0 < 2; ++d0) stg[orow * 64 + d0 * 32 + r32] = (bf16)(cvtpk_s(o[d0][r] * rli[r], 0.f) & 0xffffu); }
    asm volatile("s_waitcnt lgkmcnt(0)" ::: "memory");
#pragma unroll
    for (int i = 0; i < 4; ++i) { const int row = i * 8 + (lane >> 3), ch = lane & 7; const u32x4 v = *(const u32x4*)(stg + row * 64 + ch * 8); *(u32x4*)(Ow + (long)row * 1024 + ch * 8) = v; } }
  asm volatile("s_waitcnt vmcnt(0) lgkmcnt(0)\n\ts_barrier" ::: "memory");
#undef AF_DMA_KA
#undef AF_DMA_KB
#undef AF_DMA_K
#undef AF_DMA_V
#undef AF_WAITN
#undef AF_ROT
#undef AF_PKW
#undef AF_PAF
#undef AF_VFR
#undef AF_PIN
#undef AF_MF
#undef AF_EX
#undef AF_VRD
#undef AF_GA4
#undef AF_GA3
#undef AF_GA2
#undef AF_GB
#undef AF_KRD
#undef AF_PHASE_A12
#undef AF_PHASE_A8
#undef AF_STEP
}

constexpr int ROWS_LAT = 16384;
constexpr float LOG2E_ = 1.4426950408889634f;
__device__ __forceinline__ int clampi(int v, int lo, int hi_) { return v < lo ? lo : (v > hi_ ? hi_ : v); }
struct FDense {
  static constexpr bool HAS_MASK = false;
  const bf16* Q; const bf16* kbase; const bf16* vbase; const bf16* krbase; bf16* O; int b, h, qb; static constexpr int kpitch = 2048, vpitch = 2048;
  __device__ __forceinline__ void init(const bf16* Q_, const bf16* KV, const bf16* KR, bf16* O_, int b_, int h_, int qb_) { Q = Q_; kbase = KV + 64 * h_; vbase = KV + 1024 + 64 * h_; krbase = KR; O = O_; b = b_; h = h_; qb = qb_; }
  __device__ __forceinline__ int nt() const { return 132; }
  __device__ __forceinline__ long trow(int t) const { return t < 4 ? (long)(ROWS_LAT + 256 * b + 64 * t) : (long)(8192 * b + 64 * (t - 4)); }
  __device__ __forceinline__ const bf16* qptr(int wid, int r32, int d0, int hi) const { const bf16* qp = Q + (long)(8192 * b + 256 * qb + 32 * wid + r32) * 1536;
    return d0 < 4 ? qp + 64 * h + 16 * d0 + 8 * hi : qp + 1024 + 32 * h + 16 * (d0 - 4) + 8 * hi; }
  __device__ __forceinline__ void mask(f32x16&, f32x16&, int, int, int, int) const {}
  __device__ __forceinline__ float sink(int) const { return -INFINITY; }
  __device__ __forceinline__ bf16* orow0(int wid) const { return O + (long)(8192 * b + 256 * qb + 32 * wid) * 1024 + 64 * h; }
};
struct FWin {
  static constexpr bool HAS_MASK = true; static constexpr int kpitch = 2304, vpitch = 2304;
  const bf16* QKV; const bf16* kbase; const bf16* vbase; const bf16* krbase; bf16* O; const float* sinkp; int b, n, g, hh, i0, cnt;
  __device__ __forceinline__ void init(const bf16* QKV_, bf16* O_, const float* sk, int b_, int n_, int g_, int hh_) { QKV = QKV_; O = O_; sinkp = sk; b = b_; n = n_; g = g_; hh = hh_; krbase = nullptr;
    kbase = QKV_ + 512 + 64 * g_; vbase = QKV_ + 640 + 64 * g_; i0 = (n_ == 0) ? 2 : 0; cnt = (n_ == 0 || n_ == 63) ? 4 : 6; }
  __device__ __forceinline__ int nt() const { return 4 + cnt; }
  __device__ __forceinline__ int kpos0(int t) const { return 128 * (n - 1) + 64 * (i0 + t - 4); }
  __device__ __forceinline__ long trow(int t) const { return t < 4 ? (long)(ROWS_LAT + 256 * b + 64 * t) : (long)(8192 * b + kpos0(t)); }
  __device__ __forceinline__ int head(int wid) const { return 4 * g + 2 * hh + (wid >> 2); }
  __device__ __forceinline__ int qpos0(int wid) const { return 128 * n + 32 * (wid & 3); }
  __device__ __forceinline__ const bf16* qptr(int wid, int r32, int d0, int hi) const { return QKV + (long)(8192 * b + qpos0(wid) + r32) * 2304 + 64 * head(wid) + 16 * d0 + 8 * hi; }
  __device__ __forceinline__ void mask(f32x16& p0, f32x16& p1, int t, int wid, int r32, int hi) const {
    if (t < 4) return;
    const int k0 = kpos0(t), q0 = qpos0(wid);
    if (k0 - (q0 + 31) >= -128 && k0 + 63 - q0 <= 128) return;
    asm volatile("" : "+v"(r32), "+v"(hi));
    const int dq = k0 - (q0 + r32);
#pragma unroll
    for (int r = 0; r < 16; ++r) { const int d = dq + crow(r, hi); if (d > 128 || d < -128) p0[r] = -INFINITY; if (d + 32 > 128 || d + 32 < -128) p1[r] = -INFINITY; }
  }
  __device__ __forceinline__ float sink(int wid) const { return sinkp[head(wid)] * LOG2E_; }
  __device__ __forceinline__ bf16* orow0(int wid) const { return O + (long)(8192 * b + qpos0(wid)) * 1024 + 64 * head(wid); }
};
struct FNa {
  static constexpr bool HAS_MASK = true; static constexpr int kpitch = 2304, vpitch = 2304;
  const bf16* QKV; const bf16* kbase; const bf16* vbase; const bf16* krbase; bf16* O; const float* rpbl; int b, h, R4, krlo, nloc;
  __device__ __forceinline__ void init(const bf16* QKV_, bf16* O_, const float* rpbl_, int b_, int h_, int R4_) { QKV = QKV_; O = O_; rpbl = rpbl_; b = b_; h = h_; R4 = R4_; krbase = nullptr;
    kbase = QKV_ + 1280 + 64 * h_; vbase = QKV_ + 1792 + 64 * h_; krlo = clampi(4 * R4_ - 4, 0, 120); nloc = clampi(4 * R4_ - 1, 0, 120) + 7 - krlo + 1; }
  __device__ __forceinline__ int nt() const { return (4 + nloc + 1) & ~1; }
  __device__ __forceinline__ long trow(int t) const { return (t < 4 || t >= 4 + nloc) ? (long)(ROWS_LAT + 256 * b + 64 * (t & 3)) : (long)(8192 * b + 64 * (krlo + t - 4)); }
  __device__ __forceinline__ int qrow(int wid) const { return 4 * R4 + (wid >> 1); }
  __device__ __forceinline__ const bf16* qptr(int wid, int r32, int d0, int hi) const { return QKV + (long)(8192 * b + 64 * qrow(wid) + 32 * (wid & 1) + r32) * 2304 + 768 + 64 * h + 16 * d0 + 8 * hi; }
  __device__ __forceinline__ void mask(f32x16& p0, f32x16& p1, int t, int wid, int r32, int hi) const {
    if (t < 4) return;
    const int kr = krlo + t - 4, w0 = clampi(qrow(wid) - 4, 0, 120);
    if (t >= 4 + nloc || kr < w0 || kr > w0 + 7) {
#pragma unroll
      for (int r = 0; r < 16; ++r) { p0[r] = -INFINITY; p1[r] = -INFINITY; }
      return; }
    asm volatile("" : "+v"(r32), "+v"(hi));
    const int qc = 32 * (wid & 1) + r32, c0 = clampi(qc - 8, 0, 48);
    const float* brow = rpbl + (kr - qrow(wid) + 7) * 31 + 15;
#pragma unroll
    for (int r = 0; r < 16; ++r) {
      { const int kc = crow(r, hi); const bool ok = kc >= c0 && kc < c0 + 16; const float bv = brow[clampi(kc - qc, -15, 15)]; p0[r] = ok ? p0[r] + bv : -INFINITY; }
      { const int kc = 32 + crow(r, hi); const bool ok = kc >= c0 && kc < c0 + 16; const float bv = brow[clampi(kc - qc, -15, 15)]; p1[r] = ok ? p1[r] + bv : -INFINITY; } }
  }
  __device__ __forceinline__ float sink(int) const { return -INFINITY; }
  __device__ __forceinline__ bf16* orow0(int wid) const { return O + (long)(8192 * b + 64 * qrow(wid) + 32 * (wid & 1)) * 1024 + 512 + 64 * h; }
};
struct FCtx {
  static constexpr bool HAS_MASK = false; static constexpr int kpitch = 2304, vpitch = 2304;
  const bf16* QKV; const bf16* kbase; const bf16* vbase; const bf16* krbase; bf16* O; const float* sinkp; int b, hx, qcol, ocol;
  __device__ __forceinline__ void init(const bf16* QKV_, bf16* O_, const float* sk, int b_, int hx_) { QKV = QKV_; O = O_; sinkp = sk; b = b_; hx = hx_; krbase = nullptr;
    if (hx_ < 8) { qcol = 64 * hx_; kbase = QKV_ + 512 + 64 * (hx_ >> 2); vbase = QKV_ + 640 + 64 * (hx_ >> 2); ocol = 64 * hx_; }
    else { const int h = hx_ - 8; qcol = 768 + 64 * h; kbase = QKV_ + 1280 + 64 * h; vbase = QKV_ + 1792 + 64 * h; ocol = 512 + 64 * h; } }
  __device__ __forceinline__ int nt() const { return 4; }
  __device__ __forceinline__ long trow(int t) const { return (long)(ROWS_LAT + 256 * b + 64 * (t & 3)); }
  __device__ __forceinline__ const bf16* qptr(int wid, int r32, int d0, int hi) const { return QKV + (long)(ROWS_LAT + 256 * b + 32 * wid + r32) * 2304 + qcol + 16 * d0 + 8 * hi; }
  __device__ __forceinline__ void mask(f32x16&, f32x16&, int, int, int, int) const {}
  __device__ __forceinline__ float sink(int) const { return hx < 8 ? sinkp[hx] * LOG2E_ : -INFINITY; }
  __device__ __forceinline__ bf16* orow0(int wid) const { return O + (long)(ROWS_LAT + 256 * b + 32 * wid) * 1024 + ocol; }
};
#undef AF_SBAR
#undef AF_WAIT_BAR
}
constexpr int NWAVES = 8;
#ifndef MK_PER_PHASE
#define MK_PER_PHASE 0
#endif
constexpr int BATCH = 2, SEQ = 8192, DM = 1024, CTXL = 256, FF = 4096;
constexpr int ML = BATCH * SEQ, MC = BATCH * CTXL, MR = ML + MC;
constexpr int NQKV = 2304, NCIN = 768, NUQ = 1536, NUKV = 2048;
constexpr float NORM_EPS = 1e-6f;
constexpr int ADA_KS = 16;
constexpr size_t MiB = 1u << 20;
constexpr size_t WS_CTL = 0, CTL_ZERO_BYTES = 64 * 1024;
constexpr size_t WS_MODP = 1 * MiB;
constexpr size_t WS_MOD = 3 * MiB + 512 * 1024;
constexpr size_t WS_ROPE = 3 * MiB + 768 * 1024;
constexpr size_t WS_HPAR = WS_ROPE + 32 * 1024;
constexpr size_t WS_CTXRES = 4 * MiB;
constexpr size_t WS_WQKV = 6 * MiB, WS_WO0 = WS_WQKV + 4608 * 1024, WS_W1_0 = WS_WO0 + 2 * MiB, WS_W2_0 = WS_W1_0 + 8 * MiB, WS_W1_1 = WS_W2_0 + 8 * MiB, WS_W2_1 = WS_W1_1 + 8 * MiB;
constexpr size_t WS_WIN = WS_W2_1 + 8 * MiB, WS_WUQ = WS_WIN + 1536 * 1024, WS_WUKV = WS_WUQ + 1152 * 1024, WS_WO1 = WS_WUKV + 1 * MiB, WS_WEND = WS_WO1 + 2 * MiB;
constexpr size_t WS_AR = 51 * MiB;
static_assert(WS_WEND <= WS_AR, "weights overlap the arena");
constexpr size_t WS_XN = WS_AR, WS_H = WS_AR + 33 * MiB;
constexpr size_t WS_QKV = WS_AR + 33 * MiB, WS_O0 = WS_AR + 108 * MiB;
constexpr size_t WS_CQKV = WS_AR + 33 * MiB, WS_CQN = WS_AR + 58 * MiB, WS_CKVN = WS_AR + 71 * MiB, WS_KR = WS_AR + 80 * MiB, WS_Q1 = WS_AR + 82 * MiB, WS_KV1 = WS_AR + 130 * MiB, WS_O1 = WS_AR;
constexpr size_t WS_K6N = WS_AR + 34 * MiB, WS_K6R = WS_AR + 48 * MiB;
constexpr size_t WS_PART5 = WS_AR + 33 * MiB;
constexpr size_t WS_XR = WS_AR + 166 * MiB;
constexpr size_t WS_PART8 = WS_AR + 166 * MiB;
constexpr size_t WS_END = 256 * MiB;
static_assert(WS_PART8 + (size_t)16 * 512 * 1024 * 4 <= WS_END && WS_KV1 + (size_t)MR * NUKV * 2 <= WS_END && WS_H + (size_t)MR * FF * 2 <= WS_END, "d_ws map");
constexpr int CW_BAR = 4096;
constexpr int RING_OFF = 0, RING_BYTES = 131072;
constexpr int LDSCTL_OFF = RING_BYTES, MISC_OFF = LDSCTL_OFF + 320;
constexpr int LDS_BYTES = 147456;
static_assert(att::L_END <= RING_BYTES && attf::LDS_BYTES <= RING_BYTES, "attention LDS");

#define GAS __attribute__((address_space(1)))
#define LAS __attribute__((address_space(3)))
typedef unsigned short bf16;
typedef unsigned v4u __attribute__((ext_vector_type(4)));
typedef unsigned v2u __attribute__((ext_vector_type(2)));
typedef float f32x4 __attribute__((ext_vector_type(4)));
typedef GAS unsigned gu32;
#define RLX_AGENT __ATOMIC_RELAXED, __HIP_MEMORY_SCOPE_AGENT
#define LDS_WAIT() asm volatile("s_waitcnt lgkmcnt(0)" ::: "memory")
#define VM_WAIT() asm volatile("s_waitcnt vmcnt(0)" ::: "memory")
__device__ __forceinline__ unsigned f2bf(float f) { unsigned u = __builtin_bit_cast(unsigned, f); return (u + 0x7fffu + ((u >> 16) & 1u)) >> 16; }
__device__ __forceinline__ unsigned pk2(float lo, float hi) { return f2bf(lo) | (f2bf(hi) << 16); }
__device__ __forceinline__ float bf2f(unsigned short h) { return __builtin_bit_cast(float, (unsigned)h << 16); }
__device__ __forceinline__ float bflo(unsigned w) { return __builtin_bit_cast(float, w << 16); }
__device__ __forceinline__ float bfhi(unsigned w) { return __builtin_bit_cast(float, w & 0xffff0000u); }

#define XB_TMO      128
#define XB_XCNT(j)  (256  + 64 * (j))
#define XB_XSUB(j)  (1280 + 64 * (j))
#define XB_XGEN(j)  (2304 + 64 * (j))
#define XB_TOP      3328
#define XB_TOPGEN   3392
#define XCD_BAR_WORDS 3456
#define XB_SPIN_CAP (1u << 18)

__device__ __forceinline__ unsigned xb_ld(unsigned* p)              { return __hip_atomic_load(p, __ATOMIC_RELAXED, __HIP_MEMORY_SCOPE_AGENT); }
__device__ __forceinline__ unsigned xb_add(unsigned* p, unsigned v) { return __hip_atomic_fetch_add(p, v, __ATOMIC_RELAXED, __HIP_MEMORY_SCOPE_AGENT); }
__device__ __forceinline__ unsigned xb_xcc_id() { return (unsigned)__builtin_amdgcn_s_getreg((3 << 11) | 20) & 0xFu; }
#define XB_SPIN(cond, bar) do { unsigned _sp = 0; while (cond) { __builtin_amdgcn_s_sleep(1); \
    if ((++_sp & 255u) == 0u) { if (xb_ld(&(bar)[XB_TMO])) break; if (_sp > XB_SPIN_CAP) { atomicAdd(&(bar)[XB_TMO], 1u); break; } } } } while (0)

struct XcdBarrier {
    unsigned* bar; unsigned x;
    volatile LAS unsigned* st;
};

__device__ __forceinline__ XcdBarrier xcd_barrier_post(unsigned* bar, volatile LAS unsigned* st) {
    XcdBarrier b; b.bar = bar; b.x = xb_xcc_id(); b.st = st;
    if (threadIdx.x == 0) (void)xb_add(&bar[XB_XCNT(b.x)], 1u);
    return b;
}
__device__ __forceinline__ void xcd_barrier_complete(unsigned* bar, unsigned x, unsigned& nloc, unsigned& nx) {
    const unsigned G = gridDim.x * gridDim.y * gridDim.z;
    unsigned sum, cnt, mine, sp = 0u;
    for (;;) {
        sum = 0u; cnt = 0u; mine = 0u;
#pragma unroll
        for (unsigned j = 0; j < 16; ++j) { const unsigned c = xb_ld(&bar[XB_XCNT(j)]); sum += c; cnt += (c > 0u) ? 1u : 0u; mine = (j == x) ? c : mine; }
        if (sum == G) break;
        __builtin_amdgcn_s_sleep(1);
        if ((++sp & 255u) == 0u) { if (xb_ld(&bar[XB_TMO])) break; if (sp > XB_SPIN_CAP) { atomicAdd(&bar[XB_TMO], 1u); break; } }
    }
    nloc = mine > 0u ? mine : 1u; nx = cnt > 0u ? cnt : 1u;
}

__device__ __forceinline__ void xcd_barrier(const XcdBarrier& b) {
    asm volatile("s_waitcnt vmcnt(0)" ::: "memory");
    __syncthreads();
    if (threadIdx.x == 0) {
        unsigned* bar = b.bar;
        __builtin_amdgcn_s_waitcnt(0);
        unsigned nloc = b.st[0], nx = b.st[1];
        if (nloc == 0u) { xcd_barrier_complete(bar, b.x, nloc, nx); b.st[0] = nloc; b.st[1] = nx; }
        const unsigned old = xb_add(&bar[XB_XSUB(b.x)], 1u);
        const unsigned gen = old / nloc;
        if (old + 1u == (gen + 1u) * nloc) {
            __builtin_amdgcn_fence(__ATOMIC_RELEASE, "agent");
            asm volatile("s_waitcnt vmcnt(0)" ::: "memory");
            const unsigned og = xb_add(&bar[XB_TOP], 1u);
            const unsigned tg = og / nx;
            if (og + 1u == (tg + 1u) * nx) xb_add(&bar[XB_TOPGEN], 1u);
            else XB_SPIN(xb_ld(&bar[XB_TOPGEN]) == tg, bar);
            __builtin_amdgcn_fence(__ATOMIC_ACQUIRE, "agent");
            xb_add(&bar[XB_XGEN(b.x)], 1u);
            asm volatile("s_waitcnt vmcnt(0)" ::: "memory");
        } else {
            XB_SPIN(xb_ld(&bar[XB_XGEN(b.x)]) == gen, bar);
            __builtin_amdgcn_fence(__ATOMIC_ACQUIRE, "agent");
            asm volatile("s_waitcnt vmcnt(0)" ::: "memory");
        }
    }
    __syncthreads();
}


template <int K> __device__ __forceinline__ const float* ldarg() {
    auto ka = __builtin_amdgcn_kernarg_segment_ptr();
    const __attribute__((address_space(1))) float* p; asm volatile("s_load_dwordx2 %0, %1, %2\n\ts_waitcnt lgkmcnt(0)" : "=s"(p) : "s"(ka), "i"(K * 8) : "memory"); return (const float*)p;
}
#define ARG(k) (ldarg<k>())
#define ARG_OUT ((float*)ldarg<28>())
#define ARG_WS ((unsigned char*)ldarg<29>())
struct Frame {
    LAS unsigned char* lds;
    volatile LAS unsigned* MISC;
    gu32* ctl;
    int tid, lane, wave;
    int vcu, G, bx;
    float* out; unsigned char* ws;
};
__device__ __forceinline__ float shx(float v, int mask, int lane) { return __builtin_bit_cast(float, __builtin_amdgcn_ds_bpermute((lane ^ mask) << 2, __builtin_bit_cast(int, v))); }
__device__ __forceinline__ float wave_sum(float v, int lane) {
#pragma unroll
    for (int o = 1; o < 64; o <<= 1) v += shx(v, o, lane);
    return v;
}
__device__ __forceinline__ void p0_transpose_item(const float* W, int K, int N, bf16* WT, int pmode, LAS float* scr, int item, int lane) {
    const int nblk = N / 32, kb = item / nblk, nb = item % nblk, k0 = 64 * kb, n0 = 32 * nb;
    int r0 = n0;
    if (pmode == 1) { const int h = n0 / 96, d = n0 % 96; r0 = d < 64 ? h * 64 + d : 1024 + h * 32 + (d - 64); }
    else if (pmode == 2) { const int h = n0 / 128, d = n0 % 128; r0 = d < 64 ? h * 64 + d : 1024 + h * 64 + (d - 64); }
#pragma unroll 8
    for (int i = 0; i < 32; ++i) { const int kk = 2 * i + (lane >> 5); scr[kk * 33 + (lane & 31)] = W[(size_t)(k0 + kk) * N + n0 + (lane & 31)]; }
    LDS_WAIT(); asm volatile("" ::: "memory");
    const int c = lane & 7;
#pragma unroll
    for (int j = 0; j < 4; ++j) { const int n = (lane >> 3) + 8 * j; const LAS float* s = scr + (8 * c) * 33 + n;
        v4u o; o.x = pk2(s[0 * 33], s[1 * 33]); o.y = pk2(s[2 * 33], s[3 * 33]); o.z = pk2(s[4 * 33], s[5 * 33]); o.w = pk2(s[6 * 33], s[7 * 33]);
        *(GAS v4u*)(WT + (size_t)(r0 + n) * K + k0 + 8 * c) = o; }
    LDS_WAIT(); asm volatile("" ::: "memory");
}
__device__ __forceinline__ float silu_f(float v) { return v / (1.f + __expf(-v)); }

__device__ __forceinline__ void p0_prologue(Frame& F) {
    LAS float* scr = (LAS float*)(F.lds + RING_OFF + F.wave * 16384);
    const float* c = ARG(1); const float* cctx = ARG(3);
    if (F.wave >= 5) {
        for (int it = F.vcu * 3 + (F.wave - 5); it < 2 * 24 * ADA_KS; it += F.G * 3) {
            const int l = it / (24 * ADA_KS), rem = it % (24 * ADA_KS), cg = rem / ADA_KS, ks = rem % ADA_KS;
            const float* W = ARG(4) + (size_t)l * DM * 6144 + cg * 256 + 4 * F.lane;
            f32x4 a0 = {0.f, 0.f, 0.f, 0.f}, a1 = a0, a2 = a0;
            const int kbeg = ks * (DM / ADA_KS);
#pragma unroll 8
            for (int k = kbeg; k < kbeg + DM / ADA_KS; ++k) {
                const f32x4 w = *(const GAS f32x4*)(W + (size_t)k * 6144);
                const float s0 = silu_f(c[k]), s1 = silu_f(c[DM + k]), s2 = silu_f(cctx[k]);
                a0 += w * s0; a1 += w * s1; a2 += w * s2;
            }
            float* P = (float*)(F.ws + WS_MODP) + ((size_t)(ks * 2 + l) * 3) * 6144 + cg * 256 + 4 * F.lane;
            *(GAS f32x4*)(P) = a0; *(GAS f32x4*)(P + 6144) = a1; *(GAS f32x4*)(P + 2 * 6144) = a2;
        }
    } else {
        const int gw = F.vcu * 5 + F.wave, NGW = F.G * 5;
        constexpr int I_QKV = 16 * 72, I_O = 16 * 32, I_1 = 16 * 128, I_2 = 64 * 32, I_IN = 16 * 21, I_UQ = 6 * 48, I_UKV = 4 * 64;
        constexpr int NITEMS = I_QKV + I_O + 2 * I_1 + 2 * I_2 + I_IN + I_UQ + I_UKV + I_O;
        for (int it = gw; it < NITEMS; it += NGW) {
            int r = it;
            if (r < I_QKV) { p0_transpose_item(ARG(10), DM, NQKV, (bf16*)(F.ws + WS_WQKV), 0, scr, r, F.lane); continue; } r -= I_QKV;
            if (r < I_O) { p0_transpose_item(ARG(11), DM, DM, (bf16*)(F.ws + WS_WO0), 0, scr, r, F.lane); continue; } r -= I_O;
            if (r < I_1) { p0_transpose_item(ARG(8), DM, FF, (bf16*)(F.ws + WS_W1_0), 0, scr, r, F.lane); continue; } r -= I_1;
            if (r < I_1) { p0_transpose_item(ARG(8) + (size_t)DM * FF, DM, FF, (bf16*)(F.ws + WS_W1_1), 0, scr, r, F.lane); continue; } r -= I_1;
            if (r < I_2) { p0_transpose_item(ARG(9), FF, DM, (bf16*)(F.ws + WS_W2_0), 0, scr, r, F.lane); continue; } r -= I_2;
            if (r < I_2) { p0_transpose_item(ARG(9) + (size_t)DM * FF, FF, DM, (bf16*)(F.ws + WS_W2_1), 0, scr, r, F.lane); continue; } r -= I_2;
            if (r < I_IN) { p0_transpose_item(ARG(18), DM, 672, (bf16*)(F.ws + WS_WIN), 0, scr, r, F.lane); continue; } r -= I_IN;
            if (r < I_UQ) { p0_transpose_item(ARG(21), 384, NUQ, (bf16*)(F.ws + WS_WUQ), 1, scr, r, F.lane); continue; } r -= I_UQ;
            if (r < I_UKV) { p0_transpose_item(ARG(22), 256, NUKV, (bf16*)(F.ws + WS_WUKV), 2, scr, r, F.lane); continue; } r -= I_UKV;
            p0_transpose_item(ARG(27), DM, DM, (bf16*)(F.ws + WS_WO1), 0, scr, r, F.lane);
        }
    }
    if (F.bx == 1 % F.G) {
        float* rt = (float*)(F.ws + WS_ROPE);
        for (int e = F.tid; e < 128 * 16; e += NWAVES * 64) { const int pos = e >> 4, i = e & 15; const float inv = exp2f(-(float)i * (13.287712379549449f / 16.f));
            float x = (float)pos * inv * 0.15915494309189535f; x -= rintf(x); rt[e] = __builtin_amdgcn_cosf(x); rt[2048 + e] = __builtin_amdgcn_sinf(x); }
        for (int e = F.tid; e < 128 * 8; e += NWAVES * 64) { const int pos = e >> 3, i = e & 7; const float inv = exp2f(-(float)i * (13.287712379549449f / 8.f));
            float x = (float)pos * inv * 0.15915494309189535f; x -= rintf(x); rt[4096 + e] = __builtin_amdgcn_cosf(x); rt[5120 + e] = __builtin_amdgcn_sinf(x); }
    }
    if (F.bx == 3 % F.G && F.tid < 64) {
        float* hp = (float*)(F.ws + WS_HPAR); const int i = F.tid;
        hp[i] = ARG(12)[i]; hp[64 + i] = ARG(13)[i]; hp[128 + i] = ARG(15)[i]; hp[192 + i] = ARG(16)[i]; hp[256 + i] = ARG(23)[i]; hp[320 + i] = ARG(24)[i & 31]; hp[384 + i] = ARG(25)[i];
        float a = fabsf(ARG(23)[i]), b_ = fabsf(ARG(25)[i]), c_ = fabsf(ARG(24)[i & 31]), d_ = fabsf(ARG(26)[i & 31]);
#pragma unroll
        for (int o_ = 1; o_ < 64; o_ <<= 1) { a = fmaxf(a, shx(a, o_, i)); b_ = fmaxf(b_, shx(b_, o_, i)); c_ = fmaxf(c_, shx(c_, o_, i)); d_ = fmaxf(d_, shx(d_, o_, i)); }
        const float bound = (64.f * a * b_ + 32.f * c_ * d_) * (0.10206207261596575f * 1.4426950408889634f);
        if (i == 0) hp[448] = (bound < 64.f && fmaxf(fmaxf(a, b_), fmaxf(c_, d_)) < 3.f) ? 1.f : 0.f;
    }
    if (F.bx == 2 % F.G) {
        GAS v4u* z = (GAS v4u*)((bf16*)(F.ws + WS_WIN) + (size_t)672 * DM);
        unsigned zz = 0u; asm volatile("" : "+v"(zz));
        for (int e = F.tid; e < 96 * DM / 8; e += NWAVES * 64) z[e] = (v4u){zz, zz, zz, zz};
    }
}

__device__ __forceinline__ void norm_phase(Frame& F, const float* src_lat, const float* src_ctx, int nrows, const float* gw_, int layer, int which  , bool from_partials, const float* parts = nullptr, int nparts = 0, bool lat_bf16 = false) {
    LAS float* gl = (LAS float*)(F.lds + RING_OFF); LAS float* scl = gl + 1024; LAS float* shl = scl + 3 * 1024;
    const float* modp = (const float*)(F.ws + WS_MODP); const float* mod = (const float*)(F.ws + WS_MOD); const float* ada_b = ARG(5);
    const int offsh = which * 3072, offsc = which * 3072 + 1024;
    for (int i = F.tid; i < 1024; i += NWAVES * 64) {
        gl[i] = gw_[i];
#pragma unroll
        for (int cnd = 0; cnd < 3; ++cnd) {
            float sh, sc;
            if (from_partials) { sh = ada_b[layer * 6144 + offsh + i]; sc = ada_b[layer * 6144 + offsc + i];
                float ph[ADA_KS], pc[ADA_KS];
#pragma unroll
                for (int ks = 0; ks < ADA_KS; ++ks) { const float* p = modp + ((size_t)(ks * 2 + layer) * 3 + cnd) * 6144; ph[ks] = p[offsh + i]; pc[ks] = p[offsc + i]; }
#pragma unroll
                for (int ks = 0; ks < ADA_KS; ++ks) { sh += ph[ks]; sc += pc[ks]; } }
            else { sh = mod[(layer * 3 + cnd) * 6144 + offsh + i]; sc = mod[(layer * 3 + cnd) * 6144 + offsc + i]; }
            scl[cnd * 1024 + i] = 1.f + sc; shl[cnd * 1024 + i] = sh;
        }
    }
    if (from_partials) {
        float* modw = (float*)(F.ws + WS_MOD);
        for (int e = F.vcu * (NWAVES * 64) + F.tid; e < 2 * 3 * 6144; e += F.G * NWAVES * 64) {
            const int l = e / (3 * 6144), rem = e % (3 * 6144), cnd = rem / 6144, col = rem % 6144;
            float v = ada_b[l * 6144 + col];
            float pv[ADA_KS];
#pragma unroll
            for (int ks = 0; ks < ADA_KS; ++ks) pv[ks] = modp[((size_t)(ks * 2 + l) * 3 + cnd) * 6144 + col];
#pragma unroll
            for (int ks = 0; ks < ADA_KS; ++ks) v += pv[ks];
            modw[e] = v;
        }
    }
    __syncthreads();
    bf16* XN = (bf16*)(F.ws + WS_XN);
    const int gw = F.vcu * NWAVES + F.wave, NGW = F.G * NWAVES;
    for (int m = gw; m < nrows; m += NGW) {
        const float* xrow = m < ML ? src_lat + (size_t)m * DM : src_ctx + (size_t)(m - ML) * DM;
        const int cnd = m < SEQ ? 0 : (m < ML ? 1 : 2);
        const GAS f32x4* xr = (const GAS f32x4*)xrow + F.lane;
        f32x4 v[4]; float s = 0.f;
        if (lat_bf16 && m < ML) {
            const GAS v2u* xb = (const GAS v2u*)((const bf16*)src_lat + (size_t)m * DM) + F.lane;
            v2u w[4];
#pragma unroll
            for (int j = 0; j < 4; ++j) w[j] = xb[64 * j];
#pragma unroll
            for (int j = 0; j < 4; ++j) v[j] = f32x4{bflo(w[j].x), bfhi(w[j].x), bflo(w[j].y), bfhi(w[j].y)};
        } else {
#pragma unroll
            for (int j = 0; j < 4; ++j) v[j] = xr[64 * j];
        }
        if (nparts > 0 && m >= ML) {
            for (int p = 0; p < nparts; p += 4) {
                const GAS f32x4* pr = (const GAS f32x4*)(parts + (size_t)p * (512 * 1024) + (size_t)(m - ML) * DM) + F.lane;
                f32x4 w[4][4];
#pragma unroll
                for (int q = 0; q < 4; ++q)
#pragma unroll
                    for (int j = 0; j < 4; ++j) w[q][j] = pr[(size_t)q * (512 * 1024 / 4) + 64 * j];
#pragma unroll
                for (int j = 0; j < 4; ++j) v[j] += (w[0][j] + w[1][j]) + (w[2][j] + w[3][j]); }
            GAS f32x4* cr = (GAS f32x4*)((float*)(F.ws + WS_CTXRES) + (size_t)(m - ML) * DM) + F.lane;
#pragma unroll
            for (int j = 0; j < 4; ++j) cr[64 * j] = v[j];
        }
#pragma unroll
        for (int j = 0; j < 4; ++j) s += (v[j].x * v[j].x + v[j].y * v[j].y) + (v[j].z * v[j].z + v[j].w * v[j].w);
        const float rstd = 1.f / sqrtf(wave_sum(s, F.lane) * (1.f / DM) + NORM_EPS);
        if (from_partials && m >= ML) { GAS f32x4* cr = (GAS f32x4*)((float*)(F.ws + WS_CTXRES) + (size_t)(m - ML) * DM) + F.lane;
#pragma unroll
            for (int j = 0; j < 4; ++j) cr[64 * j] = v[j]; }
        GAS v2u* o8 = (GAS v2u*)(XN + (size_t)m * DM) + F.lane;
#pragma unroll
        for (int j = 0; j < 4; ++j) { const int col = 4 * F.lane + 256 * j;
            const f32x4 g = *(const LAS f32x4*)(gl + col), sc = *(const LAS f32x4*)(scl + cnd * 1024 + col), sh = *(const LAS f32x4*)(shl + cnd * 1024 + col);
            const f32x4 y = (v[j] * rstd) * g * sc + sh;
            v2u w; w.x = pk2(y.x, y.y); w.y = pk2(y.z, y.w); o8[64 * j] = w; }
    }
    __syncthreads();
}

__device__ __forceinline__ void unpack8(const v4u w, float (&x)[8]) { x[0] = bflo(w.x); x[1] = bfhi(w.x); x[2] = bflo(w.y); x[3] = bfhi(w.y); x[4] = bflo(w.z); x[5] = bfhi(w.z); x[6] = bflo(w.w); x[7] = bfhi(w.w); }
__device__ __forceinline__ v4u pack8(const float (&x)[8]) { v4u w; w.x = pk2(x[0], x[1]); w.y = pk2(x[2], x[3]); w.z = pk2(x[4], x[5]); w.w = pk2(x[6], x[7]); return w; }

__device__ __forceinline__ void qknorm_phase(Frame& F) {
    bf16* QKV = (bf16*)(F.ws + WS_QKV);
    const float* rt = (const float*)(F.ws + WS_ROPE);
    const float* nw[4] = {ARG(12), ARG(13), ARG(15), ARG(16)};
    const float qscale = 0.125f * att::LOG2E;
    const int gw = F.vcu * NWAVES + F.wave, NGW = F.G * NWAVES;
    const int lane = F.lane, grp = lane >> 3, l8 = lane & 7;
    for (int m = gw; m < MR; m += NGW) {
        const bool lat = m < ML; const int t = m & (SEQ - 1); const int prow = t >> 6, pcol = t & 63;
        GAS v4u* rowp = (GAS v4u*)(QKV + (size_t)m * NQKV);
#pragma unroll
        for (int pass = 0; pass < 4; ++pass) {
            int type;
            if (pass == 0) type = 1; else if (pass == 1) type = grp < 2 ? 2 : (grp < 4 ? 0 : 3); else if (pass == 2) type = grp < 4 ? 3 : 4; else type = grp < 4 ? 4 : 0;
            const v4u w = rowp[pass * 64 + lane];
            float x[8]; unpack8(w, x);
            float ss = 0.f;
#pragma unroll
            for (int j = 0; j < 8; ++j) ss += x[j] * x[j];
            ss += shx(ss, 1, F.lane); ss += shx(ss, 2, F.lane); ss += shx(ss, 4, F.lane);
            const float rstd = 1.f / sqrtf(ss * (1.f / 64.f) + NORM_EPS);
            const float* g = type == 1 ? nw[0] : (type == 2 ? nw[1] : (type == 3 ? nw[2] : nw[3]));
            const f32x4 g0 = *(const GAS f32x4*)(g + l8 * 8), g1 = *(const GAS f32x4*)(g + l8 * 8 + 4);
            x[0] *= rstd * g0.x; x[1] *= rstd * g0.y; x[2] *= rstd * g0.z; x[3] *= rstd * g0.w; x[4] *= rstd * g1.x; x[5] *= rstd * g1.y; x[6] *= rstd * g1.z; x[7] *= rstd * g1.w;
            float px[8];
#pragma unroll
            for (int j = 0; j < 8; ++j) px[j] = shx(x[j], 2, F.lane);
            if (lat && (type == 1 || type == 2)) {
                const int pos = (l8 & 4) ? pcol : prow; const float* cs = rt + pos * 16 + (l8 & 1) * 8;
                const f32x4 c0 = *(const GAS f32x4*)(cs), c1 = *(const GAS f32x4*)(cs + 4), s0 = *(const GAS f32x4*)(cs + 2048), s1 = *(const GAS f32x4*)(cs + 2052);
                const float cc[8] = {c0.x, c0.y, c0.z, c0.w, c1.x, c1.y, c1.z, c1.w}, sn[8] = {s0.x, s0.y, s0.z, s0.w, s1.x, s1.y, s1.z, s1.w};
                const float sgn = (l8 & 2) ? 1.f : -1.f;
#pragma unroll
                for (int j = 0; j < 8; ++j) x[j] = x[j] * cc[j] + sgn * px[j] * sn[j];
            }
            if (type == 1 || type == 3) {
#pragma unroll
                for (int j = 0; j < 8; ++j) x[j] *= qscale;
            }
            if (type != 0) rowp[pass * 64 + lane] = pack8(x);
        }
    }
}

__device__ __forceinline__ void cnorm_phase(Frame& F) {
    const bf16* CQKV = (const bf16*)(F.ws + WS_CQKV); bf16* CQN = (bf16*)(F.ws + WS_CQN); bf16* CKVN = (bf16*)(F.ws + WS_CKVN); bf16* KR = (bf16*)(F.ws + WS_KR);
    const float* rt = (const float*)(F.ws + WS_ROPE) + 4096;
    const float* gq = ARG(19); const float* gkv = ARG(20); const float* gkr = ARG(26);
    const int gw = F.vcu * NWAVES + F.wave, NGW = F.G * NWAVES; const int lane = F.lane;
    for (int m = gw; m < MR; m += NGW) {
        const bool lat = m < ML; const int t = m & (SEQ - 1); const int prow = t >> 6, pcol = t & 63;
        const GAS v4u* rowp = (const GAS v4u*)(CQKV + (size_t)m * NCIN);
        const v4u w0 = rowp[lane]; v4u w1 = {0u, 0u, 0u, 0u}; if (lane < 32) w1 = rowp[64 + lane];
        float x0[8], x1[8]; unpack8(w0, x0); unpack8(w1, x1);
        float s0 = 0.f, s1 = 0.f;
#pragma unroll
        for (int j = 0; j < 8; ++j) { s0 += x0[j] * x0[j]; s1 += x1[j] * x1[j]; }
        const float ssq = wave_sum(lane < 48 ? s0 : 0.f, F.lane);
        const float sskv = wave_sum((lane >= 48 ? s0 : 0.f) + (lane < 16 ? s1 : 0.f), F.lane);
        const float sskr = wave_sum((lane >= 16 && lane < 20) ? s1 : 0.f, F.lane);
        const float rq = 1.f / sqrtf(ssq * (1.f / 384.f) + NORM_EPS), rkv = 1.f / sqrtf(sskv * (1.f / 256.f) + NORM_EPS), rkr = 1.f / sqrtf(sskr * (1.f / 32.f) + NORM_EPS);
        { const float* g = lane < 48 ? gq + lane * 8 : gkv + (lane - 48) * 8; const float r = lane < 48 ? rq : rkv;
          const f32x4 g0 = *(const GAS f32x4*)(g), g1 = *(const GAS f32x4*)(g + 4);
          float y[8] = {x0[0] * r * g0.x, x0[1] * r * g0.y, x0[2] * r * g0.z, x0[3] * r * g0.w, x0[4] * r * g1.x, x0[5] * r * g1.y, x0[6] * r * g1.z, x0[7] * r * g1.w};
          if (lane < 48) *(GAS v4u*)(CQN + (size_t)m * 384 + lane * 8) = pack8(y); else *(GAS v4u*)(CKVN + (size_t)m * 256 + (lane - 48) * 8) = pack8(y); }
        { const int li = lane < 16 ? lane : (lane < 20 ? lane - 16 : 0);
          const float* g = lane < 16 ? gkv + 128 + li * 8 : gkr + li * 8; const float r = lane < 16 ? rkv : rkr;
          const f32x4 g0 = *(const GAS f32x4*)(g), g1 = *(const GAS f32x4*)(g + 4);
          float y[8] = {x1[0] * r * g0.x, x1[1] * r * g0.y, x1[2] * r * g0.z, x1[3] * r * g0.w, x1[4] * r * g1.x, x1[5] * r * g1.y, x1[6] * r * g1.z, x1[7] * r * g1.w};
          float py[8];
#pragma unroll
          for (int j = 0; j < 8; ++j) py[j] = shx(y[j], 1, F.lane);
          if (lat && lane >= 16 && lane < 20) {
              const int pos = (lane & 2) ? pcol : prow; const float* cs = rt + pos * 8;
              const f32x4 c0 = *(const GAS f32x4*)(cs), c1 = *(const GAS f32x4*)(cs + 4), sa = *(const GAS f32x4*)(cs + 1024), sb = *(const GAS f32x4*)(cs + 1028);
              const float cc[8] = {c0.x, c0.y, c0.z, c0.w, c1.x, c1.y, c1.z, c1.w}, sn[8] = {sa.x, sa.y, sa.z, sa.w, sb.x, sb.y, sb.z, sb.w};
              const float sgn = (lane & 1) ? 1.f : -1.f;
#pragma unroll
              for (int j = 0; j < 8; ++j) y[j] = y[j] * cc[j] + sgn * py[j] * sn[j];
          }
          if (lane < 16) *(GAS v4u*)(CKVN + (size_t)m * 256 + 128 + lane * 8) = pack8(y);
          else if (lane < 20) *(GAS v4u*)(KR + (size_t)m * 32 + (lane - 16) * 8) = pack8(y); }
    }
}

__device__ __forceinline__ void hnorm_phase(Frame& F) {
    bf16* Q = (bf16*)(F.ws + WS_Q1); bf16* KV = (bf16*)(F.ws + WS_KV1);
    const float* rt = (const float*)(F.ws + WS_ROPE) + 4096;
    const float* gqn = ARG(23); const float* gqr = ARG(24); const float* gkn = ARG(25);
    const float qscale = 0.10206207261596575f * att::LOG2E;
    const int gw = F.vcu * NWAVES + F.wave, NGW = F.G * NWAVES; const int lane = F.lane, l8 = lane & 7, l4 = lane & 3;
    for (int m = gw; m < MR; m += NGW) {
        const bool lat = m < ML; const int t = m & (SEQ - 1); const int prow = t >> 6, pcol = t & 63;
        { GAS v4u* rowp = (GAS v4u*)(KV + (size_t)m * NUKV);
          const f32x4 g0 = *(const GAS f32x4*)(gkn + l8 * 8), g1 = *(const GAS f32x4*)(gkn + l8 * 8 + 4);
#pragma unroll
          for (int pass = 0; pass < 2; ++pass) {
              float x[8]; unpack8(rowp[pass * 64 + lane], x); float ss = 0.f;
#pragma unroll
              for (int j = 0; j < 8; ++j) ss += x[j] * x[j];
              ss += shx(ss, 1, F.lane); ss += shx(ss, 2, F.lane); ss += shx(ss, 4, F.lane);
              const float r = 1.f / sqrtf(ss * (1.f / 64.f) + NORM_EPS);
              x[0] *= r * g0.x; x[1] *= r * g0.y; x[2] *= r * g0.z; x[3] *= r * g0.w; x[4] *= r * g1.x; x[5] *= r * g1.y; x[6] *= r * g1.z; x[7] *= r * g1.w;
              rowp[pass * 64 + lane] = pack8(x); } }
        if (lat) {
            GAS v4u* rowp = (GAS v4u*)(Q + (size_t)m * NUQ);
            { const f32x4 g0 = *(const GAS f32x4*)(gqn + l8 * 8), g1 = *(const GAS f32x4*)(gqn + l8 * 8 + 4);
#pragma unroll
              for (int pass = 0; pass < 2; ++pass) {
                  float x[8]; unpack8(rowp[pass * 64 + lane], x); float ss = 0.f;
#pragma unroll
                  for (int j = 0; j < 8; ++j) ss += x[j] * x[j];
                  ss += shx(ss, 1, F.lane); ss += shx(ss, 2, F.lane); ss += shx(ss, 4, F.lane);
                  const float r = qscale / sqrtf(ss * (1.f / 64.f) + NORM_EPS);
                  x[0] *= r * g0.x; x[1] *= r * g0.y; x[2] *= r * g0.z; x[3] *= r * g0.w; x[4] *= r * g1.x; x[5] *= r * g1.y; x[6] *= r * g1.z; x[7] *= r * g1.w;
                  rowp[pass * 64 + lane] = pack8(x); } }
            {
              const f32x4 g0 = *(const GAS f32x4*)(gqr + l4 * 8), g1 = *(const GAS f32x4*)(gqr + l4 * 8 + 4);
              float x[8]; unpack8(rowp[128 + lane], x); float ss = 0.f;
#pragma unroll
              for (int j = 0; j < 8; ++j) ss += x[j] * x[j];
              ss += shx(ss, 1, F.lane); ss += shx(ss, 2, F.lane);
              const float r = 1.f / sqrtf(ss * (1.f / 32.f) + NORM_EPS);
              x[0] *= r * g0.x; x[1] *= r * g0.y; x[2] *= r * g0.z; x[3] *= r * g0.w; x[4] *= r * g1.x; x[5] *= r * g1.y; x[6] *= r * g1.z; x[7] *= r * g1.w;
              float px[8];
#pragma unroll
              for (int j = 0; j < 8; ++j) px[j] = shx(x[j], 1, F.lane);
              const int pos = (l4 & 2) ? pcol : prow; const float* cs = rt + pos * 8;
              const f32x4 c0 = *(const GAS f32x4*)(cs), c1 = *(const GAS f32x4*)(cs + 4), sa = *(const GAS f32x4*)(cs + 1024), sb = *(const GAS f32x4*)(cs + 1028);
              const float cc[8] = {c0.x, c0.y, c0.z, c0.w, c1.x, c1.y, c1.z, c1.w}, sn[8] = {sa.x, sa.y, sa.z, sa.w, sb.x, sb.y, sb.z, sb.w};
              const float sgn = (l4 & 1) ? 1.f : -1.f;
#pragma unroll
              for (int j = 0; j < 8; ++j) x[j] = (x[j] * cc[j] + sgn * px[j] * sn[j]) * qscale;
              rowp[128 + lane] = pack8(x); }
        }
    }
}

__device__ __forceinline__ void kr6_pass(Frame& F) {
    if (((const float*)(F.ws + WS_HPAR))[448] == 0.f) return;
    const bf16* KR = (const bf16*)(F.ws + WS_KR); unsigned char* K6R = (unsigned char*)(F.ws + WS_K6R);
    for (int r = F.vcu * (NWAVES * 64) + F.tid; r < MR; r += F.G * (NWAVES * 64)) {
        const GAS v4u* rp = (const GAS v4u*)(KR + (size_t)r * 32);
        v4u w[4] = {rp[0], rp[1], rp[2], rp[3]};
#pragma unroll
        for (int q = 0; q < 4; ++q) { float x[8]; unpack8(w[q], x);
#pragma unroll
            for (int j = 0; j < 8; ++j) x[j] *= 1.5349124f;
            w[q] = pack8(x); }
        const attd::u32x6 c = attd::to_fp6(w[0], w[1], w[2], w[3]);
        unsigned char* img = K6R + (size_t)(r >> 6) * 2048; const int key = r & 63;
        *(GAS v4u*)(img + key * 16) = (v4u){c[0], c[1], c[2], c[3]}; *(GAS v2u*)(img + 1024 + key * 8) = (v2u){c[4], c[5]};
    }
}
__device__ __forceinline__ void attn0_phase(Frame& F) {
    att::lchar* lds = (att::lchar*)(F.lds + RING_OFF);
    const att::bf16* QKV = (const att::bf16*)(F.ws + WS_QKV); att::bf16* O = (att::bf16*)(F.ws + WS_O0);
    bool fast;
    { float a = fabsf(ARG(12)[F.lane]), b_ = fabsf(ARG(13)[F.lane]), c_ = fabsf(ARG(15)[F.lane]), d_ = fabsf(ARG(16)[F.lane]), e_ = 0.f, f_ = fabsf(ARG(14)[F.lane & 7]);
      for (int i = F.lane; i < 8 * 465; i += 64) e_ = fmaxf(e_, fabsf(ARG(17)[i]));
#pragma unroll
      for (int o_ = 1; o_ < 64; o_ <<= 1) { a = fmaxf(a, shx(a, o_, F.lane)); b_ = fmaxf(b_, shx(b_, o_, F.lane)); c_ = fmaxf(c_, shx(c_, o_, F.lane)); d_ = fmaxf(d_, shx(d_, o_, F.lane)); e_ = fmaxf(e_, shx(e_, o_, F.lane)); f_ = fmaxf(f_, shx(f_, o_, F.lane)); }
      const float bound = fmaxf(fmaxf(8.f * a * b_, 8.f * c_ * d_ + e_), f_) * att::LOG2E;
      fast = __builtin_amdgcn_readfirstlane(bound < 64.f ? 1 : 0) != 0; }
    char* shm = (char*)(F.lds + RING_OFF);
    for (int ui = F.vcu; ui < 1056; ui += F.G) {
        if (ui < 512) {
            const int b = ui >> 8, h = (ui >> 5) & 7, R4 = ui & 31;
            const float* rpb = ARG(17) + h * 465;
            if (fast) {
                float* rl = (float*)(shm + attf::LDS_RPB);
                for (int i = F.tid; i < 465; i += NWAVES * 64) rl[i] = rpb[i] * att::LOG2E;
                __syncthreads();
                attf::FNa fu; fu.init((const attf::bf16*)QKV, (attf::bf16*)O, rl, b, h, R4);
                attf::fast_unit<8, attf::FNa>(fu, shm, F.tid);
            } else {
                att::UNa u; u.QKV = QKV; u.O = O; u.rpbl = (const LAS float*)(lds + att::L_RPB); u.b = b; u.h = h; u.R4 = R4; u.init();
                for (int i = F.tid; i < 465; i += NWAVES * 64) ((LAS float*)(lds + att::L_RPB))[i] = rpb[i] * att::LOG2E;
                att::unit<8, att::UNa>(u, lds, F.tid);
            }
        } else if (ui < 1024) {
            const int v = ui - 512;
            if (fast) { attf::FWin fu; fu.init((const attf::bf16*)QKV, (attf::bf16*)O, ARG(14), v >> 8, (v >> 2) & 63, (v >> 1) & 1, v & 1); attf::fast_unit<8, attf::FWin>(fu, shm, F.tid); }
            else { att::UWin u; u.QKV = QKV; u.O = O; u.sinkp = ARG(14); u.b = v >> 8; u.n = (v >> 2) & 63; u.g = (v >> 1) & 1; u.hh = v & 1; u.init(); att::unit<8, att::UWin>(u, lds, F.tid); }
        } else {
            const int v = ui - 1024;
            if (fast) { attf::FCtx fu; fu.init((const attf::bf16*)QKV, (attf::bf16*)O, ARG(14), v >> 4, v & 15); attf::fast_unit<8, attf::FCtx>(fu, shm, F.tid); }
            else { att::UCtx u; u.QKV = QKV; u.O = O; u.sinkp = ARG(14); u.b = v >> 4; u.hx = v & 15; u.init(); att::unit<8, att::UCtx>(u, lds, F.tid); }
        }
    }
}
__device__ __forceinline__ void attn1_phase(Frame& F) {
    att::lchar* lds = (att::lchar*)(F.lds + RING_OFF);
    const bool fast = __builtin_amdgcn_readfirstlane(__builtin_bit_cast(int, ((const float*)(F.ws + WS_HPAR))[448])) != 0;
    const bool g256 = F.G == 256; const int x = F.vcu >> 5, j = F.vcu & 31;
    const int nit = g256 ? 4 : (F.vcu < 1024 ? (1024 - F.vcu + F.G - 1) / F.G : 0);
    for (int i = 0; i < nit; ++i) {
        const int ui = g256 ? ((x * 4 + i) * 32 + j) : F.vcu + i * F.G;
        if (fast) attd::dense_unit(ui >> 9, (ui >> 5) & 15, ui & 31, (const attd::bf16*)(F.ws + WS_Q1), (const attd::bf16*)(F.ws + WS_KV1), (const char*)(F.ws + WS_K6N), (const char*)(F.ws + WS_K6R), (attd::bf16*)(F.ws + WS_O1), (char*)(F.lds + RING_OFF), F.tid);
        else {
        att::UDense u; u.Q = (const att::bf16*)(F.ws + WS_Q1); u.KV = (const att::bf16*)(F.ws + WS_KV1); u.KR = (const att::bf16*)(F.ws + WS_KR); u.O = (att::bf16*)(F.ws + WS_O1);
        u.b = ui >> 9; u.h = (ui >> 5) & 15; u.qb = ui & 31;
        att::unit<12, att::UDense>(u, lds, F.tid); }
    }
}

#ifndef PHASE_MASK
#define PHASE_MASK 0xFFFFFu
#endif
#ifndef PHASE_REP
#define PHASE_REP 0u
#endif
struct Args { const float* in[28]; float* out; unsigned char* ws; int ph_lo, ph_hi; };
constexpr int N_PHASES = 19;
__global__ void __launch_bounds__(NWAVES * 64, 2) fwd_kernel(Args args) {
    extern __shared__ __attribute__((aligned(16))) unsigned char lds[];
    for (int u = threadIdx.x; u < (LDS_BYTES - LDSCTL_OFF) / 4; u += NWAVES * 64) ((LAS unsigned*)((LAS unsigned char*)lds + LDSCTL_OFF))[u] = 0u;
    __syncthreads();
    if (!MK_PER_PHASE) (void)xcd_barrier_post((unsigned*)((gu32*)(ARG_WS + WS_CTL) + CW_BAR), (volatile LAS unsigned*)((LAS unsigned char*)lds + MISC_OFF) + 8);
    for (int ph2 = 2 * args.ph_lo; ph2 < 2 * args.ph_hi; ++ph2) {
        const int ph = ph2 >> 1; if ((ph2 & 1) && !((PHASE_REP >> ph) & 1)) continue;
        if (ph == 3 || ph == 14) continue;
        Frame F;
        { int t_ = threadIdx.x; asm volatile("" : "+v"(t_)); int b_ = blockIdx.x; asm volatile("" : "+s"(b_)); int g_ = gridDim.x; asm volatile("" : "+s"(g_)); F.tid = t_; F.bx = b_; F.G = g_; }
        F.lds = (LAS unsigned char*)lds; F.MISC = (volatile LAS unsigned*)(F.lds + MISC_OFF);
        F.lane = F.tid & 63; F.wave = __builtin_amdgcn_readfirstlane(F.tid >> 6);
        F.vcu = (F.G % 8 == 0) ? (F.bx % 8) * (F.G / 8) + F.bx / 8 : F.bx;
        F.ws = ARG_WS; F.out = ARG_OUT; F.ctl = (gu32*)(F.ws + WS_CTL);
        XcdBarrier bar; bar.bar = (unsigned*)(F.ctl + CW_BAR); bar.x = xb_xcc_id(); bar.st = F.MISC + 8;
        float* ctxres = (float*)(F.ws + WS_CTXRES);
        const float* mod = (const float*)(F.ws + WS_MOD);
        int gk = 0, xrows = 0, xS = 0;
        pg8::Gemm g{nullptr, nullptr, 0, 0, 0}; pg8::EpiAny ea{0, nullptr, nullptr, nullptr, nullptr, 0, 0};
        switch (ph) {
        case 0: if (!((PHASE_MASK >> 0) & 1)) break; p0_prologue(F); break;
        case 1: if (!((PHASE_MASK >> 1) & 1)) break; norm_phase(F, ARG(0), ARG(2), MR, ARG(6), 0, 0, true); break;
        case 2: if (!((PHASE_MASK >> 2) & 1)) break; gk = 1; g = pg8::Gemm{(const bf16*)(F.ws + WS_XN), (const bf16*)(F.ws + WS_WQKV), MR, NQKV, DM}; ea = pg8::EpiAny{3, (const float*)(F.ws + WS_HPAR), (void*)(F.ws + WS_QKV), nullptr, (const float*)(F.ws + WS_ROPE), NQKV, 0}; break;
        case 4: if (!((PHASE_MASK >> 4) & 1)) break; attn0_phase(F); break;
        case 5: if (!((PHASE_MASK >> 5) & 1)) break; gk = 2; g = pg8::Gemm{(const bf16*)(F.ws + WS_O0), (const bf16*)(F.ws + WS_WO0), ML, DM, DM}; xrows = MC; xS = 2; ea = pg8::EpiAny{2, ARG(0), (void*)F.out, (float*)(F.ws + WS_PART5), mod + 2048, 0, 2}; break;
        case 6: if (!((PHASE_MASK >> 6) & 1)) break; norm_phase(F, F.out, ctxres, MR, ARG(7), 0, 1, false, (const float*)(F.ws + WS_PART5), 4, true); break;
        case 7: if (!((PHASE_MASK >> 7) & 1)) break; gk = 1; g = pg8::Gemm{(const bf16*)(F.ws + WS_XN), (const bf16*)(F.ws + WS_W1_0), MR, FF, DM}; ea = pg8::EpiAny{1, nullptr, (void*)(F.ws + WS_H), nullptr, nullptr, FF, 1}; break;
        case 8: if (!((PHASE_MASK >> 8) & 1)) break; gk = 2; g = pg8::Gemm{(const bf16*)(F.ws + WS_H), (const bf16*)(F.ws + WS_W2_0), ML, DM, FF}; xrows = MC; xS = 4; ea = pg8::EpiAny{2, F.out, (void*)F.out, (float*)(F.ws + WS_PART8), mod + 5120, 0, 3}; break;
        case 9: if (!((PHASE_MASK >> 9) & 1)) break; norm_phase(F, F.out, ctxres, MR, ARG(6) + DM, 1, 0, false, (const float*)(F.ws + WS_PART8), 16, true); break;
        case 10: if (!((PHASE_MASK >> 10) & 1)) break; gk = 1; g = pg8::Gemm{(const bf16*)(F.ws + WS_XN), (const bf16*)(F.ws + WS_WIN), MR, NCIN, DM}; ea = pg8::EpiAny{1, nullptr, (void*)(F.ws + WS_CQKV), nullptr, nullptr, NCIN, 0}; break;
        case 11: if (!((PHASE_MASK >> 11) & 1)) break; cnorm_phase(F); break;
        case 12: if (!((PHASE_MASK >> 12) & 1)) break; kr6_pass(F); gk = 1; g = pg8::Gemm{(const bf16*)(F.ws + WS_CQN), (const bf16*)(F.ws + WS_WUQ), ML, NUQ, 384}; ea = pg8::EpiAny{3, (const float*)(F.ws + WS_HPAR), (void*)(F.ws + WS_Q1), nullptr, (const float*)(F.ws + WS_ROPE), NUQ, 1}; break;
        case 13: if (!((PHASE_MASK >> 13) & 1)) break; gk = 1; g = pg8::Gemm{(const bf16*)(F.ws + WS_CKVN), (const bf16*)(F.ws + WS_WUKV), MR, NUKV, 256}; ea = pg8::EpiAny{3, (const float*)(F.ws + WS_HPAR), (void*)(F.ws + WS_KV1), (float*)(F.ws + WS_K6N), (const float*)(F.ws + WS_ROPE), NUKV, 2}; break;
        case 15: if (!((PHASE_MASK >> 15) & 1)) break; attn1_phase(F); break;
        case 16: if (!((PHASE_MASK >> 16) & 1)) break; gk = 2; g = pg8::Gemm{(const bf16*)(F.ws + WS_O1), (const bf16*)(F.ws + WS_WO1), ML, DM, DM}; ea = pg8::EpiAny{2, F.out, (void*)(F.ws + WS_XR), ctxres, mod + 3 * 6144 + 2048, 0, 3}; break;
        case 17: if (!((PHASE_MASK >> 17) & 1)) break; norm_phase(F, (const float*)(F.ws + WS_XR), ctxres, ML, ARG(7) + DM, 1, 1, false, nullptr, 0, true); break;
        case 18: if (!((PHASE_MASK >> 18) & 1)) break; gk = 1; g = pg8::Gemm{(const bf16*)(F.ws + WS_XN), (const bf16*)(F.ws + WS_W1_1), ML, FF, DM}; ea = pg8::EpiAny{1, nullptr, (void*)(F.ws + WS_H), nullptr, nullptr, FF, 1}; break;
        case 19: if (!((PHASE_MASK >> 19) & 1)) break; gk = 2; g = pg8::Gemm{(const bf16*)(F.ws + WS_H), (const bf16*)(F.ws + WS_W2_1), ML, DM, FF}; ea = pg8::EpiAny{2, (const float*)(F.ws + WS_XR), (void*)F.out, ctxres, mod + 3 * 6144 + 5120, 0, 1}; break;
        default: break;
        }
        ea.scr = F.lds + LDSCTL_OFF + 4096;
        if (gk != 0) { pg8::StaticOrder S; S.init(g.M, g.N, g.K, F.G, F.bx, xrows, xS); pg8::gemm_phase<pg8::EpiAny, pg8::StaticOrder, true, true>(F.lds + RING_OFF, g, S, ea, F.tid); }
        const bool last_ = (ph == args.ph_hi - 1) && ((ph2 & 1) || !((PHASE_REP >> ph) & 1));
        if (!MK_PER_PHASE && !last_ && ph != 12) xcd_barrier(bar);
        else __syncthreads();
    }
}

extern "C" void kernel_launch(void* const* d_in, const int* in_sizes, int n_in, void* d_out, int out_size, void* d_ws, size_t ws_size, hipStream_t stream) {
    static int grid = 0;
    if (grid == 0) {
        if (n_in != 28 || in_sizes[0] != ML * DM || out_size != ML * DM || ws_size < WS_END) { fprintf(stderr, "kernel_launch: unexpected shapes: n_in %d in0 %d out %d ws %zu\n", n_in, n_in > 0 ? in_sizes[0] : -1, out_size, ws_size); grid = -1; return; }
        int dev = 0, cus = 0, per_cu = 0;
        if (hipGetDevice(&dev) != hipSuccess || hipDeviceGetAttribute(&cus, hipDeviceAttributeMultiprocessorCount, dev) != hipSuccess) { fprintf(stderr, "kernel_launch: device query failed\n"); grid = -1; return; }
        if (hipFuncSetAttribute((const void*)fwd_kernel, hipFuncAttributeMaxDynamicSharedMemorySize, LDS_BYTES) != hipSuccess) { fprintf(stderr, "kernel_launch: hipFuncSetAttribute failed\n"); grid = -1; return; }
        if (hipOccupancyMaxActiveBlocksPerMultiprocessor(&per_cu, (const void*)fwd_kernel, NWAVES * 64, LDS_BYTES) != hipSuccess || per_cu < 1)
            fprintf(stderr, "kernel_launch: note: occupancy query reports %d workgroups per CU\n", per_cu);
        (void)hipGetLastError();
        grid = cus;
    }
    if (grid < 0) return;
    if (hipMemsetAsync((char*)d_ws + WS_CTL, 0, CTL_ZERO_BYTES, stream) != hipSuccess) { fprintf(stderr, "kernel_launch: hipMemsetAsync failed\n"); return; }
    Args a{};
    for (int i = 0; i < 28; ++i) a.in[i] = (const float*)d_in[i];
    a.out = (float*)d_out; a.ws = (unsigned char*)d_ws;
#if MK_PER_PHASE
    for (int ph = 0; ph <= N_PHASES; ++ph) { a.ph_lo = ph; a.ph_hi = ph + 1; hipLaunchKernelGGL(fwd_kernel, dim3(grid), dim3(NWAVES * 64), LDS_BYTES, stream, a); }
#else
    a.ph_lo = 0; a.ph_hi = N_PHASES + 1;
    hipLaunchKernelGGL(fwd_kernel, dim3(grid), dim3(NWAVES * 64), LDS_BYTES, stream, a);
#endif
    const hipError_t le = hipPeekAtLastError();
    if (le != hipSuccess) fprintf(stderr, "kernel_launch: launch failed: %s\n", hipGetErrorName(le));
}
```

```cpp
#include <hip/hip_runtime.h>
#include <cstdio>
#include <cstdint>
namespace pg8 {
#define PG8_LAS __attribute__((address_space(3)))
typedef unsigned short bf16_t;
typedef short bf16x8 __attribute__((ext_vector_type(8)));
typedef float f32x4 __attribute__((ext_vector_type(4)));
typedef unsigned u32x4 __attribute__((ext_vector_type(4)));
typedef unsigned u32x2 __attribute__((ext_vector_type(2)));
typedef unsigned u32x6 __attribute__((ext_vector_type(6)));
typedef unsigned u32x16 __attribute__((ext_vector_type(16)));
typedef __bf16 bf16x32 __attribute__((ext_vector_type(32)));
constexpr int BM = 256, BK = 64, HALF = 128, HTB = HALF * BK * 2  , STAGE_BYTES = 8 * HTB, NXCD = 8, WGM = 8;

__host__ __device__ __forceinline__ int lds_byte(int r, int c) { const int st = (r >> 4) * 2 + (c >> 5), rr = r & 15, cc = c & 31, ob = rr * 64 + cc * 2; return st * 1024 + (ob ^ (((ob >> 9) & 1) << 5)); }
__host__ __device__ __forceinline__ void stage_rc(int b, int& R, int& C) { const int st = b / 1024, sb = b % 1024, swz = sb ^ (((sb >> 9) & 1) << 5); R = (st >> 1) * 16 + swz / 64; C = (st & 1) * 32 + (swz % 64) / 2; }
__host__ __device__ __forceinline__ int perm32(int rho) { const int n = rho >> 4, i = rho & 15; return 8 * (i >> 2) + 4 * n + (i & 3); }

struct Unit { int pm, pn, kinfo; };
struct Gemm { const bf16_t* A; const bf16_t* Bt; int M, N, K; };

struct StaticOrder {
    int nM, nN, nwg, G, c, ntK;
    int xtiles, xsh;
    __host__ __device__ void init(int M, int N, int K, int G_, int c_, int extra_rows = 0, int S = 1) { nM = M / BM; nN = N / BM; nwg = nM * nN; G = G_; c = c_; ntK = K / BK;
        xtiles = (extra_rows / BM) * nN; xsh = S; }
    __host__ __device__ bool next(int i, Unit& u) const {
        const long L = (long)i * G + c;
        if (L >= nwg) {
            if (xtiles == 0) return false;
            const int nb = (nwg - c + G - 1) / G;
            const int nbc = c < nwg ? nb : 0;
            const long e = (long)(i - nbc) * G + ((c + G - (nwg % G)) % G);
            if (e >= ((long)xtiles << xsh)) return false;
            const int tile = (int)(e >> xsh), ks = (int)e & ((1 << xsh) - 1), xnt = ntK >> xsh;
            u.pm = nM + tile / nN; u.pn = tile % nN; u.kinfo = (ks * xnt) | (xnt << 8) | (1 << 16); return true;
        }
        int wgid = (int)L; { const int q = nwg / NXCD, r = nwg % NXCD, xcd = wgid % NXCD, off = wgid / NXCD; wgid = (xcd < r ? xcd * (q + 1) : r * (q + 1) + (xcd - r) * q) + off; }
        const int nig = WGM * nN, gid = wgid / nig, fm = gid * WGM, gsz = (nM - fm) < WGM ? (nM - fm) : WGM;
        u.pm = fm + ((wgid % nig) % gsz); u.pn = (wgid % nig) / gsz; u.kinfo = ntK << 8; return true;
    }
    __device__ __forceinline__ void a_ready(const Unit&) const {}
    __device__ __forceinline__ void done(const Unit&) const {}
};

__device__ __forceinline__ unsigned cvt_pk_bf16(float lo, float hi) { unsigned r; asm volatile("v_cvt_pk_bf16_f32 %0, %1, %2" : "=v"(r) : "v"(lo), "v"(hi)); return r; }
__device__ __forceinline__ u32x2 pk4bf(f32x4 y) { u32x2 r; r.x = cvt_pk_bf16(y[0], y[1]); r.y = cvt_pk_bf16(y[2], y[3]); return r; }
__device__ __forceinline__ f32x4 unpk4bf(u32x2 w) { f32x4 r; r[0] = __builtin_bit_cast(float, w.x << 16); r[1] = __builtin_bit_cast(float, w.x & 0xffff0000u); r[2] = __builtin_bit_cast(float, w.y << 16); r[3] = __builtin_bit_cast(float, w.y & 0xffff0000u); return r; }
struct EpiAny {
    static constexpr bool AFTER_DRAIN = false;
    int mode; const float* base; void* out; float* ctxres; const float* gate; int ldc, relu2; PG8_LAS unsigned char* scr = nullptr;
    __device__ __forceinline__ bool perm() const { return mode == 1; }
    __device__ __forceinline__ bool headmode() const { return mode == 3; }
    __device__ __forceinline__ static float xsh(float v, int mask, int lane) { return __builtin_bit_cast(float, __builtin_amdgcn_ds_bpermute((lane ^ mask) << 2, __builtin_bit_cast(int, v))); }
    __device__ __forceinline__ void head_epilogue(const f32x4 (&acc)[2][2][4][2], const Unit& u, int wr, int wc, int fr, int fq) const {
        const int H = 4 * u.pn + wc, kind = relu2, lane = fr + 16 * fq;
        const bool f6 = kind != 0 && base[448] != 0.f;
        int cls, gsel; float qs = 1.f;
        if (kind == 0) { if (H < 8) { cls = 2; gsel = 0; qs = 0.125f * 1.4426950408889634f; } else if (H < 10) { cls = 2; gsel = 1; } else if (H < 12) { cls = 0; gsel = 0; }
                         else if (H < 20) { cls = 1; gsel = 2; qs = 0.125f * 1.4426950408889634f; } else if (H < 28) { cls = 1; gsel = 3; } else { cls = 0; gsel = 0; } }
        else if (kind == 1) { qs = f6 ? 1.5349124f : 0.10206207261596575f * 1.4426950408889634f; if (H < 16) { cls = 1; gsel = 4; } else { cls = 3; gsel = 5; } }
        else { if (H < 16) { cls = 1; gsel = 6; if (f6) qs = 1.5349124f; } else { cls = 0; gsel = 0; } }
        const bool lat = u.pm < 64;
        const bool k6 = f6 && kind == 2 && H < 16;
        bf16_t* O = (bf16_t*)out;
        const int col0 = u.pn * BM + 64 * wc + 8 * fq;
        f32x4 gv[2][2];
#pragma unroll
        for (int bj = 0; bj < 2; ++bj)
#pragma unroll
            for (int n = 0; n < 2; ++n) gv[bj][n] = *(const f32x4*)(base + gsel * 64 + 32 * bj + 8 * fq + 4 * n);
#pragma unroll
        for (int ai = 0; ai < 2; ++ai)
#pragma unroll
            for (int m = 0; m < 4; ++m) {
                const int row = u.pm * BM + ai * HALF + wr * 64 + m * 16 + fr;
                f32x4 v[2][2];
#pragma unroll
                for (int bj = 0; bj < 2; ++bj)
#pragma unroll
                    for (int n = 0; n < 2; ++n) v[bj][n] = acc[ai][bj][m][n];
                if (cls != 0) {
                    float s0 = 0.f, s1 = 0.f;
#pragma unroll
                    for (int n = 0; n < 2; ++n)
#pragma unroll
                        for (int e = 0; e < 4; ++e) { s0 += v[0][n][e] * v[0][n][e]; s1 += v[1][n][e] * v[1][n][e]; }
                    if (cls != 3) { s0 += s1; s0 += xsh(s0, 16, lane); s0 += xsh(s0, 32, lane); s0 = s0 * (1.f / 64.f); s1 = s0; }
                    else { s0 += xsh(s0, 16, lane); s0 += xsh(s0, 32, lane); s1 += xsh(s1, 16, lane); s1 += xsh(s1, 32, lane); s0 *= (1.f / 32.f); s1 *= (1.f / 32.f); }
                    const float r0 = 1.f / sqrtf(s0 + 1e-6f), r1 = 1.f / sqrtf(s1 + 1e-6f);
#pragma unroll
                    for (int n = 0; n < 2; ++n) { v[0][n] = v[0][n] * r0 * gv[0][n]; v[1][n] = v[1][n] * r1 * gv[1][n]; }
                    if (lat && cls == 2) {
                        const int t = row & 8191;
#pragma unroll
                        for (int bj = 0; bj < 2; ++bj) { const int pos = bj == 0 ? (t >> 6) : (t & 63); const float sgn = fq < 2 ? -1.f : 1.f;
#pragma unroll
                            for (int n = 0; n < 2; ++n) { const float* cs = gate + pos * 16 + 8 * (fq & 1) + 4 * n; const f32x4 c = *(const f32x4*)cs, sn = *(const f32x4*)(cs + 2048);
                                f32x4 p;
#pragma unroll
                                for (int e = 0; e < 4; ++e) p[e] = xsh(v[bj][n][e], 32, lane);
                                v[bj][n] = v[bj][n] * c + (p * sgn) * sn; } }
                    }
                    if (lat && cls == 3) {
                        const int t = row & 8191; const int pos = fq < 2 ? (t >> 6) : (t & 63); const float sgn = (fq & 1) ? 1.f : -1.f;
#pragma unroll
                        for (int bj = 0; bj < 2; ++bj)
#pragma unroll
                            for (int n = 0; n < 2; ++n) { const float* cs = gate + 4096 + pos * 8 + 4 * n; const f32x4 c = *(const f32x4*)cs, sn = *(const f32x4*)(cs + 1024);
                                f32x4 p;
#pragma unroll
                                for (int e = 0; e < 4; ++e) p[e] = xsh(v[bj][n][e], 16, lane);
                                v[bj][n] = v[bj][n] * c + (p * sgn) * sn; }
                    }
                    if (qs != 1.f) {
#pragma unroll
                        for (int bj = 0; bj < 2; ++bj)
#pragma unroll
                            for (int n = 0; n < 2; ++n) v[bj][n] = v[bj][n] * qs; }
                }
                if (k6) {
                    PG8_LAS unsigned char* sw = scr + (wr * 4 + wc) * 1024 + fr * 64;
                    unsigned char* img = (unsigned char*)ctxres + ((size_t)(row >> 6) * 16 + H) * 3072;
                    const int key = row & 63;
#pragma unroll
                    for (int bj = 0; bj < 2; ++bj) {
                        u32x4 w; w.x = cvt_pk_bf16(v[bj][0][0], v[bj][0][1]); w.y = cvt_pk_bf16(v[bj][0][2], v[bj][0][3]); w.z = cvt_pk_bf16(v[bj][1][0], v[bj][1][1]); w.w = cvt_pk_bf16(v[bj][1][2], v[bj][1][3]);
                        *(PG8_LAS u32x4*)(sw + fq * 16) = w;
                        asm volatile("s_waitcnt lgkmcnt(0)" ::: "memory");
                        if (fq == 0) {
                            const u32x4 a0 = *(PG8_LAS u32x4*)(sw), a1 = *(PG8_LAS u32x4*)(sw + 16), a2 = *(PG8_LAS u32x4*)(sw + 32), a3 = *(PG8_LAS u32x4*)(sw + 48);
                            const u32x16 all = {a0.x, a0.y, a0.z, a0.w, a1.x, a1.y, a1.z, a1.w, a2.x, a2.y, a2.z, a2.w, a3.x, a3.y, a3.z, a3.w};
                            const u32x6 c = __builtin_amdgcn_cvt_scalef32_pk32_fp6_bf16(__builtin_bit_cast(bf16x32, all), 1.0f);
                            *(u32x4*)(img + bj * 1024 + key * 16) = (u32x4){c[0], c[1], c[2], c[3]};
                            *(u32x2*)(img + 2048 + bj * 512 + key * 8) = (u32x2){c[4], c[5]};
                        }
                        asm volatile("s_waitcnt lgkmcnt(0)" ::: "memory");
                    }
                    continue;
                }
                bf16_t* rowp = O + (size_t)row * ldc + col0;
#pragma unroll
                for (int bj = 0; bj < 2; ++bj) { u32x4 w; w.x = cvt_pk_bf16(v[bj][0][0], v[bj][0][1]); w.y = cvt_pk_bf16(v[bj][0][2], v[bj][0][3]); w.z = cvt_pk_bf16(v[bj][1][0], v[bj][1][1]); w.w = cvt_pk_bf16(v[bj][1][2], v[bj][1][3]);
                    *(u32x4*)(rowp + 32 * bj) = w; }
            }
    }
    __device__ __forceinline__ void operator()(const f32x4 (&acc)[2][2][4][2], const Unit& u, int wr, int wc, int fr, int fq) const {
        asm volatile("" : "+v"(fr), "+v"(fq));
        if (mode == 1) {
            bf16_t* O = (bf16_t*)out;
            const int row0 = u.pm * BM + wr * 64 + fr, col0 = u.pn * BM + wc * 32 + 8 * fq;
#pragma unroll
            for (int ai = 0; ai < 2; ++ai)
#pragma unroll
                for (int m = 0; m < 4; ++m) { bf16_t* rowp = O + (size_t)(row0 + ai * HALF + m * 16) * ldc + col0;
#pragma unroll
                    for (int bj = 0; bj < 2; ++bj) { f32x4 v0 = acc[ai][bj][m][0], v1 = acc[ai][bj][m][1];
                        if (relu2) {
#pragma unroll
                            for (int e = 0; e < 4; ++e) { float a = fmaxf(v0[e], 0.f), b = fmaxf(v1[e], 0.f); v0[e] = a * a; v1[e] = b * b; } }
                        u32x4 w; w.x = cvt_pk_bf16(v0[0], v0[1]); w.y = cvt_pk_bf16(v0[2], v0[3]); w.z = cvt_pk_bf16(v1[0], v1[1]); w.w = cvt_pk_bf16(v1[2], v1[3]);
                        *(u32x4*)(rowp + bj * HALF) = w; } }
            return;
        }
        if (mode == 3) { head_epilogue(acc, u, wr, wc, fr, fq); return; }
        const int t0 = u.pm * BM; const bool split = (u.kinfo >> 16) != 0; const int cond = t0 < 8192 ? 0 : (t0 < 16384 ? 1 : 2);
        const int col0 = u.pn * BM + wc * 32 + 4 * fq; const float* g = gate + cond * 6144 + col0;
        f32x4 gv[2][2];
#pragma unroll
        for (int bj = 0; bj < 2; ++bj)
#pragma unroll
            for (int n = 0; n < 2; ++n) gv[bj][n] = *(const f32x4*)(g + bj * HALF + n * 16);
        if (split) {
            const int ks = (u.kinfo & 255) / ((u.kinfo >> 8) & 255);
            float* op = ctxres + (size_t)ks * (512 * 1024) + (size_t)(t0 - 16384) * 1024;
#pragma unroll
            for (int ai = 0; ai < 2; ++ai)
#pragma unroll
                for (int m = 0; m < 4; ++m) { const size_t off = (size_t)(wr * 64 + fr + ai * HALF + m * 16) * 1024 + col0;
#pragma unroll
                    for (int bj = 0; bj < 2; ++bj)
#pragma unroll
                        for (int n = 0; n < 2; ++n) *(f32x4*)(op + off + bj * HALF + n * 16) = gv[bj][n] * acc[ai][bj][m][n]; }
            return;
        }
#define PG8_RES_LOOP(LOADB, STOREO) _Pragma("unroll") for (int ai = 0; ai < 2; ++ai) _Pragma("unroll") for (int m = 0; m < 4; ++m) { const size_t off = (size_t)(wr * 64 + fr + ai * HALF + m * 16) * 1024 + col0; \
            _Pragma("unroll") for (int bj = 0; bj < 2; ++bj) _Pragma("unroll") for (int n = 0; n < 2; ++n) { const size_t o2 = off + bj * HALF + n * 16; f32x4 b; LOADB; const f32x4 y = b + gv[bj][n] * acc[ai][bj][m][n]; STOREO; } }
        if (relu2 == 2) { const float* bp = base + (size_t)t0 * 1024; bf16_t* op = (bf16_t*)out + (size_t)t0 * 1024;
            PG8_RES_LOOP(b = *(const f32x4*)(bp + o2), *(u32x2*)(op + o2) = pk4bf(y)); }
        else if (relu2 == 3) { const bf16_t* bp = (const bf16_t*)base + (size_t)t0 * 1024; bf16_t* op = (bf16_t*)out + (size_t)t0 * 1024;
            PG8_RES_LOOP(const u32x2 w = *(const u32x2*)(bp + o2); b = unpk4bf(w), *(u32x2*)(op + o2) = pk4bf(y)); }
        else { const bf16_t* bp = (const bf16_t*)base + (size_t)t0 * 1024; float* op = (float*)out + (size_t)t0 * 1024;
            PG8_RES_LOOP(const u32x2 w = *(const u32x2*)(bp + o2); b = unpk4bf(w), *(f32x4*)(op + o2) = y); }
#undef PG8_RES_LOOP
    }
};

template <class Epi, class Sched, bool ALIGN_EPI = false, bool SP2 = false>
__device__ __forceinline__ void gemm_phase(PG8_LAS unsigned char* lds, const Gemm g, const Sched& S, const Epi& E, const int tid) {
    const int wid = __builtin_amdgcn_readfirstlane(tid >> 6), lane = tid & 63, wr = wid >> 2, wc = wid & 3, fr = lane & 15, fq = lane >> 4;
    const int K = g.K;
    unsigned voffA[2], voffB[2];
#pragma unroll
    for (int i = 0; i < 2; ++i) { int R, C; stage_rc(tid * 16 + i * 8192, R, C); const int Rb = E.headmode() ? (64 * (R >> 5) + perm32(R & 31)) : (E.perm() ? ((R & ~31) + perm32(R & 31)) : R);
        voffA[i] = (unsigned)(R * K + C) * 2u; voffB[i] = (unsigned)(Rb * K + C) * 2u; }
    const size_t kstep = (size_t)(BK * 2);
    const size_t hstep = (size_t)HALF * K * 2;
    const size_t tstep = 2 * hstep;
    const size_t hstepB = E.headmode() ? (size_t)32 * K * 2 : hstep;
    const unsigned ldsw = (unsigned)wid * 1024u;
    const int aoff = lds_byte(wr * 64 + fr, fq * 8), boff = lds_byte(wc * 32 + fr, fq * 8);
#define PG8_SA(b, h) (((b) * 2 + (h)) * HTB)
#define PG8_SB(b, h) ((4 + (b) * 2 + (h)) * HTB)
#define PG8_STAGE(bufoff, gbase, voff) do { _Pragma("unroll") for (int _i = 0; _i < 2; ++_i) \
        __builtin_amdgcn_global_load_lds((const unsigned*)((const char*)(gbase) + (voff)[_i]), (PG8_LAS unsigned*)(lds + (bufoff) + ldsw + _i * 8192), 16, 0, 0); } while (0)
#define PG8_LDA(dst, b, h) do { _Pragma("unroll") for (int m = 0; m < 4; ++m) _Pragma("unroll") for (int k = 0; k < 2; ++k) dst[m][k] = *(const PG8_LAS bf16x8*)(lds + PG8_SA(b, h) + aoff + m * 2048 + k * 1024); } while (0)
#define PG8_LDB(dst, b, h) do { _Pragma("unroll") for (int n = 0; n < 2; ++n) _Pragma("unroll") for (int k = 0; k < 2; ++k) dst[n][k] = *(const PG8_LAS bf16x8*)(lds + PG8_SB(b, h) + boff + n * 2048 + k * 1024); } while (0)
#define PG8_MMA(ai, bj, At, Bt) do { __builtin_amdgcn_s_setprio(1); _Pragma("unroll") for (int m = 0; m < 4; ++m) _Pragma("unroll") for (int n = 0; n < 2; ++n) _Pragma("unroll") for (int k = 0; k < 2; ++k) \
        acc[ai][bj][m][n] = __builtin_amdgcn_mfma_f32_16x16x32_bf16(Bt[n][k], At[m][k], acc[ai][bj][m][n], 0, 0, 0); __builtin_amdgcn_s_setprio(0); } while (0)
#define PG8_WAIT_V(n) asm volatile("s_waitcnt vmcnt(" #n ")" ::: "memory")
#define PG8_WAIT_L(n) asm volatile("s_waitcnt lgkmcnt(" #n ")" ::: "memory")
#define PG8_BAR __builtin_amdgcn_s_barrier()
#define PG8_SCHED __builtin_amdgcn_sched_barrier(0)
    Unit cur, nxt; int ui = 0;
    if (!S.next(0, cur)) return;
    f32x4 acc[2][2][4][2];
#pragma unroll
    for (int a = 0; a < 2; ++a)
#pragma unroll
        for (int b = 0; b < 2; ++b)
#pragma unroll
            for (int m = 0; m < 4; ++m)
#pragma unroll
                for (int n = 0; n < 2; ++n) acc[a][b][m][n] = (f32x4){0.f, 0.f, 0.f, 0.f};
    bf16x8 At[4][2], B0[2][2], B1[2][2];
    const char* cA = (const char*)g.A + (size_t)cur.pm * tstep + (size_t)(cur.kinfo & 255) * (BK * 2); const char* cB = (const char*)g.Bt + (size_t)cur.pn * tstep + (size_t)(cur.kinfo & 255) * (BK * 2);
    S.a_ready(cur);
    if constexpr (SP2) {
        PG8_STAGE(PG8_SB(0, 0), cB, voffB); PG8_STAGE(PG8_SB(0, 1), cB + hstepB, voffB); PG8_STAGE(PG8_SA(0, 0), cA, voffA); PG8_STAGE(PG8_SA(0, 1), cA + hstep, voffA);
        if (wr == 1) PG8_BAR;
        PG8_WAIT_V(2); PG8_BAR;
        PG8_STAGE(PG8_SB(1, 0), cB + kstep, voffB); PG8_STAGE(PG8_SA(1, 0), cA + kstep, voffA); PG8_STAGE(PG8_SB(1, 1), cB + hstepB + kstep, voffB);
        PG8_WAIT_V(6); PG8_BAR;
    } else {
        PG8_STAGE(PG8_SB(0, 0), cB, voffB); PG8_STAGE(PG8_SA(0, 0), cA, voffA); PG8_STAGE(PG8_SB(0, 1), cB + hstepB, voffB); PG8_STAGE(PG8_SA(0, 1), cA + hstep, voffA);
        if (wr == 1) PG8_BAR;
        PG8_WAIT_V(4); PG8_BAR;
        PG8_STAGE(PG8_SB(1, 0), cB + kstep, voffB); PG8_STAGE(PG8_SA(1, 0), cA + kstep, voffA); PG8_STAGE(PG8_SB(1, 1), cB + hstepB + kstep, voffB);
        PG8_WAIT_V(6); PG8_BAR;
    }
    for (;;) {
        const bool has_next = S.next(ui + 1, nxt);
        const char* nA = has_next ? (const char*)g.A + (size_t)nxt.pm * tstep + (size_t)(nxt.kinfo & 255) * (BK * 2) : cA; const char* nB = has_next ? (const char*)g.Bt + (size_t)nxt.pn * tstep + (size_t)(nxt.kinfo & 255) * (BK * 2) : cB;
        const int nt = (cur.kinfo >> 8) & 255;
        for (int t = 0; t < nt; t += 2) {
            const bool last = (t == nt - 2);
            const char* a1 = cA + (size_t)(t + 1) * kstep;
            const char* a2 = last ? nA : cA + (size_t)(t + 2) * kstep; const char* b2 = last ? nB : cB + (size_t)(t + 2) * kstep;
            const char* a3 = a2 + kstep; const char* b3 = b2 + kstep;
            if (last && has_next) S.a_ready(nxt);
            if constexpr (SP2) {
            PG8_LDB(B0, 0, 0); PG8_LDB(B1, 0, 1); PG8_SCHED; PG8_LDA(At, 0, 0); PG8_STAGE(PG8_SA(1, 1), a1 + hstep, voffA);
            PG8_WAIT_V(8); PG8_WAIT_L(0); PG8_BAR; PG8_MMA(0, 0, At, B0); PG8_MMA(0, 1, At, B1); PG8_BAR; PG8_SCHED;
            PG8_LDA(At, 0, 1); PG8_STAGE(PG8_SB(0, 0), b2, voffB); PG8_STAGE(PG8_SB(0, 1), b2 + hstepB, voffB); PG8_STAGE(PG8_SA(0, 0), a2, voffA);
            PG8_WAIT_V(8); PG8_WAIT_L(0); PG8_BAR; PG8_MMA(1, 0, At, B0); PG8_MMA(1, 1, At, B1); PG8_BAR; PG8_SCHED;
            PG8_LDB(B0, 1, 0); PG8_LDB(B1, 1, 1); PG8_SCHED; PG8_LDA(At, 1, 0); PG8_STAGE(PG8_SA(0, 1), a2 + hstep, voffA);
            PG8_WAIT_V(8); PG8_WAIT_L(0); PG8_BAR; PG8_MMA(0, 0, At, B0); PG8_MMA(0, 1, At, B1); PG8_BAR; PG8_SCHED;
            PG8_LDA(At, 1, 1); PG8_STAGE(PG8_SB(1, 0), b3, voffB); PG8_STAGE(PG8_SB(1, 1), b3 + hstepB, voffB); PG8_STAGE(PG8_SA(1, 0), a3, voffA);
            PG8_WAIT_V(8); PG8_WAIT_L(0); PG8_BAR; PG8_MMA(1, 0, At, B0); PG8_MMA(1, 1, At, B1); PG8_BAR; PG8_SCHED;
            } else {
            PG8_LDB(B0, 0, 0); PG8_SCHED; PG8_LDA(At, 0, 0); PG8_STAGE(PG8_SA(1, 1), a1 + hstep, voffA);
            PG8_WAIT_L(8); PG8_BAR; PG8_WAIT_L(0); PG8_MMA(0, 0, At, B0); PG8_BAR; PG8_SCHED;
            PG8_LDB(B1, 0, 1); PG8_STAGE(PG8_SB(0, 0), b2, voffB);
            PG8_BAR; PG8_WAIT_L(0); PG8_MMA(0, 1, At, B1); PG8_BAR;
            PG8_LDA(At, 0, 1); PG8_STAGE(PG8_SA(0, 0), a2, voffA);
            PG8_BAR; PG8_WAIT_L(0); PG8_MMA(1, 0, At, B0); PG8_BAR; PG8_SCHED;
            PG8_STAGE(PG8_SB(0, 1), b2 + hstepB, voffB);
            PG8_WAIT_V(6); PG8_BAR; PG8_MMA(1, 1, At, B1); PG8_BAR;
            PG8_LDB(B0, 1, 0); PG8_SCHED; PG8_LDA(At, 1, 0); PG8_STAGE(PG8_SA(0, 1), a2 + hstep, voffA);
            PG8_WAIT_L(8); PG8_BAR; PG8_WAIT_L(0); PG8_MMA(0, 0, At, B0); PG8_BAR; PG8_SCHED;
            PG8_LDB(B1, 1, 1); PG8_STAGE(PG8_SB(1, 0), b3, voffB);
            PG8_BAR; PG8_WAIT_L(0); PG8_MMA(0, 1, At, B1); PG8_BAR;
            PG8_LDA(At, 1, 1); PG8_STAGE(PG8_SA(1, 0), a3, voffA);
            PG8_BAR; PG8_WAIT_L(0); PG8_MMA(1, 0, At, B0); PG8_BAR; PG8_SCHED;
            PG8_STAGE(PG8_SB(1, 1), b3 + hstepB, voffB);
            PG8_WAIT_V(6); PG8_BAR; PG8_MMA(1, 1, At, B1); PG8_BAR;
            }
        }
        if constexpr (ALIGN_EPI) { if (wr == 0) PG8_BAR; }
        if constexpr (!Epi::AFTER_DRAIN) { E(acc, cur, wr, wc, fr, fq); S.done(cur); }
        if (!has_next) break;
#pragma unroll
        for (int a = 0; a < 2; ++a)
#pragma unroll
            for (int b = 0; b < 2; ++b)
#pragma unroll
                for (int m = 0; m < 4; ++m)
#pragma unroll
                    for (int n = 0; n < 2; ++n) acc[a][b][m][n] = (f32x4){0.f, 0.f, 0.f, 0.f};
        cur = nxt; cA = nA; cB = nB; ++ui;
        if constexpr (ALIGN_EPI) { if (wr == 1) PG8_BAR; }
    }
    PG8_WAIT_V(0);
    if constexpr (!ALIGN_EPI) { if (wr == 0) PG8_BAR; }
    PG8_BAR;
    if constexpr (Epi::AFTER_DRAIN) { E.fused(acc, cur, wr, wc, fr, fq, lds, wid, lane); S.done(cur); }
#undef PG8_SA
#undef PG8_SB
#undef PG8_STAGE
#undef PG8_LDA
#undef PG8_LDB
#undef PG8_MMA
#undef PG8_WAIT_V
#undef PG8_WAIT_L
#undef PG8_BAR
#undef PG8_SCHED
}
}
namespace att {
#define ATT_LAS __attribute__((address_space(3)))
typedef unsigned short bf16;
typedef short bf16x8 __attribute__((ext_vector_type(8)));
typedef short s16x4 __attribute__((ext_vector_type(4)));
typedef float f32x16 __attribute__((ext_vector_type(16)));
typedef unsigned u32x4 __attribute__((ext_vector_type(4)));
typedef ATT_LAS char lchar;
constexpr int KBUF = 12288, VBUF = 16384;
constexpr int L_K = 0, L_V = 2 * KBUF, L_WS = L_V + 2 * VBUF, L_RPB = L_WS + 2048, L_END = L_RPB + 2048;
constexpr float LOG2E = 1.4426950408889634f;
#define ATT_SBAR() __builtin_amdgcn_sched_barrier(0)
__device__ __forceinline__ int crow(int r, int hi) { return (r & 3) + 8 * (r >> 2) + 4 * hi; }
__device__ __forceinline__ unsigned cvtpk(float lo, float hi) { unsigned r; asm volatile("v_cvt_pk_bf16_f32 %0, %1, %2" : "=v"(r) : "v"(lo), "v"(hi)); return r; }
__device__ __forceinline__ int v_st(int k, int c) { const int kk = (k & ~0xC) | ((k & 4) << 1) | ((k & 8) >> 1); return ((kk >> 3) * 4 + (c >> 5)) * 512 + ((kk & 7) * 32 + (c & 31)) * 2; }
__device__ __forceinline__ int v_rd_base(int lane) { return ((lane & 3) << 3) | (((lane >> 2) & 3) << 6) | (((lane >> 4) & 1) << 5) | (((lane >> 5) & 1) << 8); }
constexpr int v_rd_off(int d0, int ks, int half) { return d0 * 512 + ks * 4096 + half * 2048; }
template <int OFF> __device__ __forceinline__ s16x4 tr_read(unsigned vb) {
  s16x4 r; asm volatile("ds_read_b64_tr_b16 %0, %1 offset:%2" : "=&v"(r) : "v"(vb), "i"(OFF) : "memory"); return r;
}
template <int D0> __device__ __forceinline__ void pv_one(f32x16& od, unsigned vb, bf16x8 pa0, bf16x8 pa1, bf16x8 pa2, bf16x8 pa3) {
  const s16x4 l0 = tr_read<v_rd_off(D0, 0, 0)>(vb), h0 = tr_read<v_rd_off(D0, 0, 1)>(vb), l1 = tr_read<v_rd_off(D0, 1, 0)>(vb), h1 = tr_read<v_rd_off(D0, 1, 1)>(vb);
  const s16x4 l2 = tr_read<v_rd_off(D0, 2, 0)>(vb), h2 = tr_read<v_rd_off(D0, 2, 1)>(vb), l3 = tr_read<v_rd_off(D0, 3, 0)>(vb), h3 = tr_read<v_rd_off(D0, 3, 1)>(vb);
  asm volatile("s_waitcnt lgkmcnt(0)" ::: "memory"); ATT_SBAR();
#define ATT_PK(L, H) (bf16x8){L[0], L[1], L[2], L[3], H[0], H[1], H[2], H[3]}
  od = __builtin_amdgcn_mfma_f32_32x32x16_bf16(pa0, ATT_PK(l0, h0), od, 0, 0, 0);
  od = __builtin_amdgcn_mfma_f32_32x32x16_bf16(pa1, ATT_PK(l1, h1), od, 0, 0, 0);
  od = __builtin_amdgcn_mfma_f32_32x32x16_bf16(pa2, ATT_PK(l2, h2), od, 0, 0, 0);
  od = __builtin_amdgcn_mfma_f32_32x32x16_bf16(pa3, ATT_PK(l3, h3), od, 0, 0, 0);
#undef ATT_PK
}

template <int DKC, class U>
__device__ __forceinline__ void unit(const U& u, lchar* lds, int tid) {
  asm volatile("" : "+v"(tid));
  const int lane = tid & 63, r32 = lane & 31, hi = lane >> 5;
  const int wid = __builtin_amdgcn_readfirstlane(tid >> 6);
  lchar* Kl = lds + L_K; lchar* Vl = lds + L_V;
  ATT_LAS float* ws = (ATT_LAS float*)(lds + L_WS) + wid * 64;
  bf16x8 qr[DKC / 2];
#pragma unroll
  for (int d0 = 0; d0 < DKC / 2; ++d0) qr[d0] = *(const bf16x8*)u.qptr(wid, r32, d0, hi);
  const int vrow = tid >> 3, vch = tid & 7, vst = v_st(vrow, vch * 8);
  const int krow0 = tid & 63, kch0 = tid >> 6;
  const bool k2 = (DKC > 8) && (tid < 64 * (DKC - 8));
  const unsigned vb0 = (unsigned)(uintptr_t)Vl + (unsigned)v_rd_base(lane);
  bf16x8 kst0, kst1 = {}, vstr;
  const int NT = u.nt();
#define ATT_SLOAD(t) do { const long R_ = u.krow(t); kst0 = *(const bf16x8*)u.kptr(R_ + krow0, kch0); if (k2) kst1 = *(const bf16x8*)u.kptr(R_ + krow0, 8 + kch0); \
    vstr = *(const bf16x8*)u.vptr(R_ + vrow, vch); } while (0)
#define ATT_SWRITE(b) do { *(ATT_LAS bf16x8*)(Kl + (b) * KBUF + kch0 * 1024 + krow0 * 16) = kst0; if (k2) *(ATT_LAS bf16x8*)(Kl + (b) * KBUF + (8 + kch0) * 1024 + krow0 * 16) = kst1; \
    *(ATT_LAS bf16x8*)(Vl + (b) * VBUF + vst) = vstr; } while (0)
  float m_reg = -1e30f, l_reg = 0.f; f32x16 o[2]; o[0] = f32x16{}; o[1] = f32x16{};
  ATT_SLOAD(0); ATT_SWRITE(0); __syncthreads();
  for (int t = 0; t < NT; ++t) {
    const int buf = t & 1;
    if (t + 1 < NT) ATT_SLOAD(t + 1);
    if (!u.skip(t, wid)) {
      f32x16 p0 = f32x16{}, p1 = f32x16{};
      { const lchar* kb = Kl + buf * KBUF + hi * 1024 + r32 * 16;
#pragma unroll
        for (int d0 = 0; d0 < DKC / 2; ++d0) {
          const bf16x8 b0 = *(const ATT_LAS bf16x8*)(kb + d0 * 2048);
          const bf16x8 b1 = *(const ATT_LAS bf16x8*)(kb + d0 * 2048 + 512);
          p0 = __builtin_amdgcn_mfma_f32_32x32x16_bf16(b0, qr[d0], p0, 0, 0, 0);
          p1 = __builtin_amdgcn_mfma_f32_32x32x16_bf16(b1, qr[d0], p1, 0, 0, 0); } }
      u.mask(p0, p1, t, wid, r32, hi);
      float pmax = p0[0];
#pragma unroll
      for (int r = 1; r < 16; ++r) pmax = fmaxf(pmax, p0[r]);
#pragma unroll
      for (int r = 0; r < 16; ++r) pmax = fmaxf(pmax, p1[r]);
      { auto rr = __builtin_amdgcn_permlane32_swap(__float_as_uint(pmax), __float_as_uint(pmax), false, false);
        pmax = fmaxf(__uint_as_float(rr[0]), __uint_as_float(rr[1])); }
      const float mn = fmaxf(m_reg, pmax);
      const float alpha = __builtin_amdgcn_exp2f(m_reg - mn);
      m_reg = mn;
#pragma unroll
      for (int r = 0; r < 16; ++r) { p0[r] = __builtin_amdgcn_exp2f(p0[r] - mn); p1[r] = __builtin_amdgcn_exp2f(p1[r] - mn); }
      float ps = 0.f;
#pragma unroll
      for (int r = 0; r < 16; ++r) ps += p0[r];
#pragma unroll
      for (int r = 0; r < 16; ++r) ps += p1[r];
      { auto rr = __builtin_amdgcn_permlane32_swap(__float_as_uint(ps), __float_as_uint(ps), false, false);
        ps = __uint_as_float(rr[0]) + __uint_as_float(rr[1]); }
      l_reg = l_reg * alpha + ps;
      if (__any(alpha < 1.f)) {
        if (hi == 0) ws[r32] = alpha;
        asm volatile("s_waitcnt lgkmcnt(0)" ::: "memory");
#pragma unroll
        for (int r = 0; r < 16; ++r) { const float a = ws[crow(r, hi)]; o[0][r] *= a; o[1][r] *= a; }
      }
      bf16x8 pa0, pa1, pa2, pa3;
#define ATT_PK4(P, BASE, OUT) do { unsigned a0 = cvtpk(P[BASE + 0], P[BASE + 1]), a1 = cvtpk(P[BASE + 2], P[BASE + 3]);   \
    unsigned b0 = cvtpk(P[BASE + 4], P[BASE + 5]), b1 = cvtpk(P[BASE + 6], P[BASE + 7]);                              \
    auto r0 = __builtin_amdgcn_permlane32_swap(a0, b0, false, false); auto r1 = __builtin_amdgcn_permlane32_swap(a1, b1, false, false); \
    u32x4 w = {r0[0], r1[0], r0[1], r1[1]}; OUT = __builtin_bit_cast(bf16x8, w); } while (0)
      ATT_PK4(p0, 0, pa0); ATT_PK4(p0, 8, pa1); ATT_PK4(p1, 0, pa2); ATT_PK4(p1, 8, pa3);
#undef ATT_PK4
      const unsigned vb = vb0 + (unsigned)(buf * VBUF);
      pv_one<0>(o[0], vb, pa0, pa1, pa2, pa3); pv_one<1>(o[1], vb, pa0, pa1, pa2, pa3);
    }
    if (t + 1 < NT) ATT_SWRITE(buf ^ 1);
    __syncthreads();
  }
#undef ATT_SLOAD
#undef ATT_SWRITE
  { const float sk = u.sink(wid); l_reg += __builtin_amdgcn_exp2f(sk - m_reg); }
  if (hi == 0) ws[r32] = l_reg;
  asm volatile("s_waitcnt lgkmcnt(0)" ::: "memory");
  float rli[16];
#pragma unroll
  for (int r = 0; r < 16; ++r) rli[r] = __builtin_amdgcn_rcpf(ws[crow(r, hi)]);
#pragma unroll
  for (int r = 0; r < 16; ++r) { bf16* op = u.orow(wid, crow(r, hi));
    op[r32] = (bf16)(cvtpk(o[0][r] * rli[r], 0.f) & 0xffffu); op[32 + r32] = (bf16)(cvtpk(o[1][r] * rli[r], 0.f) & 0xffffu); }
  asm volatile("s_waitcnt lgkmcnt(0)" ::: "memory");
}

constexpr int ROWS_LAT = 16384;
struct UWin {
  const bf16* QKV; bf16* O; const float* sinkp; int b, n, g, hh; int i0, cnt;
  __device__ __forceinline__ void init() { i0 = (n == 0) ? 2 : 0; cnt = (n == 0 || n == 63) ? 4 : 6; }
  __device__ __forceinline__ int nt() const { return 4 + cnt; }
  __device__ __forceinline__ int kpos0(int t) const { return 128 * (n - 1) + 64 * (i0 + t - 4); }
  __device__ __forceinline__ long krow(int t) const { return t < 4 ? (long)(ROWS_LAT + 256 * b + 64 * t) : (long)(8192 * b + kpos0(t)); }
  __device__ __forceinline__ const bf16* kptr(long row, int ch) const { return QKV + row * 2304 + 512 + 64 * g + ch * 8; }
  __device__ __forceinline__ const bf16* vptr(long row, int ch) const { return QKV + row * 2304 + 640 + 64 * g + ch * 8; }
  __device__ __forceinline__ int head(int wid) const { return 4 * g + 2 * hh + (wid >> 2); }
  __device__ __forceinline__ int qpos0(int wid) const { return 128 * n + 32 * (wid & 3); }
  __device__ __forceinline__ const bf16* qptr(int wid, int r32, int d0, int hi) const { return QKV + (long)(8192 * b + qpos0(wid) + r32) * 2304 + 64 * head(wid) + 16 * d0 + 8 * hi; }
  __device__ __forceinline__ bool skip(int t, int wid) const { if (t < 4) return false; const int k0 = kpos0(t), q0 = qpos0(wid); return (k0 + 63 < q0 - 128) || (k0 > q0 + 31 + 128); }
  __device__ __forceinline__ void mask(f32x16& p0, f32x16& p1, int t, int wid, int r32, int hi) const {
    if (t < 4) return;
    const int dq = kpos0(t) - (qpos0(wid) + r32);
#pragma unroll
    for (int r = 0; r < 16; ++r) { const int d = dq + crow(r, hi); if (d > 128 || d < -128) p0[r] = -INFINITY; if (d + 32 > 128 || d + 32 < -128) p1[r] = -INFINITY; }
  }
  __device__ __forceinline__ float sink(int wid) const { return sinkp[head(wid)] * LOG2E; }
  __device__ __forceinline__ bf16* orow(int wid, int row) const { return O + (long)(8192 * b + qpos0(wid) + row) * 1024 + 64 * head(wid); }
};
struct UNa {
  const bf16* QKV; bf16* O; const ATT_LAS float* rpbl; int b, h, R4; int krlo, nloc;
  __device__ __forceinline__ static int clampi(int v, int lo, int hi_) { return v < lo ? lo : (v > hi_ ? hi_ : v); }
  __device__ __forceinline__ void init() { krlo = clampi(4 * R4 - 4, 0, 120); const int krhi = clampi(4 * R4 - 1, 0, 120) + 7; nloc = krhi - krlo + 1; }
  __device__ __forceinline__ int nt() const { return 4 + nloc; }
  __device__ __forceinline__ long krow(int t) const { return t < 4 ? (long)(ROWS_LAT + 256 * b + 64 * t) : (long)(8192 * b + 64 * (krlo + t - 4)); }
  __device__ __forceinline__ const bf16* kptr(long row, int ch) const { return QKV + row * 2304 + 1280 + 64 * h + ch * 8; }
  __device__ __forceinline__ const bf16* vptr(long row, int ch) const { return QKV + row * 2304 + 1792 + 64 * h + ch * 8; }
  __device__ __forceinline__ int qrow(int wid) const { return 4 * R4 + (wid >> 1); }
  __device__ __forceinline__ const bf16* qptr(int wid, int r32, int d0, int hi) const { return QKV + (long)(8192 * b + 64 * qrow(wid) + 32 * (wid & 1) + r32) * 2304 + 768 + 64 * h + 16 * d0 + 8 * hi; }
  __device__ __forceinline__ bool skip(int t, int wid) const { if (t < 4) return false; const int kr = krlo + t - 4, w0 = clampi(qrow(wid) - 4, 0, 120); return kr < w0 || kr > w0 + 7; }
  __device__ __forceinline__ void mask(f32x16& p0, f32x16& p1, int t, int wid, int r32, int hi) const {
    if (t < 4) return;
    const int kr = krlo + t - 4, qc = 32 * (wid & 1) + r32, c0 = clampi(qc - 8, 0, 48);
    const ATT_LAS float* brow = rpbl + (kr - qrow(wid) + 7) * 31 + 15;
#pragma unroll
    for (int r = 0; r < 16; ++r) {
      { const int kc = crow(r, hi); const bool ok = kc >= c0 && kc < c0 + 16; const float bv = brow[clampi(kc - qc, -15, 15)]; p0[r] = ok ? p0[r] + bv : -INFINITY; }
      { const int kc = 32 + crow(r, hi); const bool ok = kc >= c0 && kc < c0 + 16; const float bv = brow[clampi(kc - qc, -15, 15)]; p1[r] = ok ? p1[r] + bv : -INFINITY; } }
  }
  __device__ __forceinline__ float sink(int) const { return -INFINITY; }
  __device__ __forceinline__ bf16* orow(int wid, int row) const { return O + (long)(8192 * b + 64 * qrow(wid) + 32 * (wid & 1) + row) * 1024 + 512 + 64 * h; }
};
struct UCtx {
  const bf16* QKV; bf16* O; const float* sinkp; int b, hx; int qcol, kcol, vcol, ocol;
  __device__ __forceinline__ void init() { if (hx < 8) { qcol = 64 * hx; kcol = 512 + 64 * (hx >> 2); vcol = 640 + 64 * (hx >> 2); ocol = 64 * hx; }
    else { const int h = hx - 8; qcol = 768 + 64 * h; kcol = 1280 + 64 * h; vcol = 1792 + 64 * h; ocol = 512 + 64 * h; } }
  __device__ __forceinline__ int nt() const { return 4; }
  __device__ __forceinline__ long krow(int t) const { return (long)(ROWS_LAT + 256 * b + 64 * t); }
  __device__ __forceinline__ const bf16* kptr(long row, int ch) const { return QKV + row * 2304 + kcol + ch * 8; }
  __device__ __forceinline__ const bf16* vptr(long row, int ch) const { return QKV + row * 2304 + vcol + ch * 8; }
  __device__ __forceinline__ const bf16* qptr(int wid, int r32, int d0, int hi) const { return QKV + (long)(ROWS_LAT + 256 * b + 32 * wid + r32) * 2304 + qcol + 16 * d0 + 8 * hi; }
  __device__ __forceinline__ bool skip(int, int) const { return false; }
  __device__ __forceinline__ void mask(f32x16&, f32x16&, int, int, int, int) const {}
  __device__ __forceinline__ float sink(int) const { return hx < 8 ? sinkp[hx] * LOG2E : -INFINITY; }
  __device__ __forceinline__ bf16* orow(int wid, int row) const { return O + (long)(ROWS_LAT + 256 * b + 32 * wid + row) * 1024 + ocol; }
};
struct UDense {
  const bf16* Q; const bf16* KV; const bf16* KR; bf16* O; int b, h, qb;
  __device__ __forceinline__ int nt() const { return 132; }
  __device__ __forceinline__ long krow(int t) const { return t < 4 ? (long)(ROWS_LAT + 256 * b + 64 * t) : (long)(8192 * b + 64 * (t - 4)); }
  __device__ __forceinline__ const bf16* kptr(long row, int ch) const { return ch < 8 ? KV + row * 2048 + 64 * h + ch * 8 : KR + row * 32 + (ch - 8) * 8; }
  __device__ __forceinline__ const bf16* vptr(long row, int ch) const { return KV + row * 2048 + 1024 + 64 * h + ch * 8; }
  __device__ __forceinline__ const bf16* qptr(int wid, int r32, int d0, int hi) const { const bf16* qp = Q + (long)(8192 * b + 256 * qb + 32 * wid + r32) * 1536;
    return d0 < 4 ? qp + 64 * h + 16 * d0 + 8 * hi : qp + 1024 + 32 * h + 16 * (d0 - 4) + 8 * hi; }
  __device__ __forceinline__ bool skip(int, int) const { return false; }
  __device__ __forceinline__ void mask(f32x16&, f32x16&, int, int, int, int) const {}
  __device__ __forceinline__ float sink(int) const { return -INFINITY; }
  __device__ __forceinline__ bf16* orow(int wid, int row) const { return O + (long)(8192 * b + 256 * qb + 32 * wid + row) * 1024 + 64 * h; }
};
#undef ATT_SBAR
}
namespace attd {
typedef unsigned short bf16;
using bf16x8 = __attribute__((ext_vector_type(8))) short;
using s16x4 = __attribute__((ext_vector_type(4))) short;
using f32x16 = __attribute__((ext_vector_type(16))) float;
using u32x4 = __attribute__((ext_vector_type(4))) unsigned;
using i32x2 = __attribute__((ext_vector_type(2))) int;
using i32x4 = __attribute__((ext_vector_type(4))) int;
using i32x8 = __attribute__((ext_vector_type(8))) int;
using u32x6 = __attribute__((ext_vector_type(6))) unsigned;
using u32x16 = __attribute__((ext_vector_type(16))) unsigned;
typedef __bf16 bf16x32 __attribute__((ext_vector_type(32)));
constexpr int NW = 8, NT = 132, KSLOT = 5120, VSLOT = 8192;
constexpr int LDS_K = 0, LDS_V = 3 * KSLOT, LDS_WS = LDS_V + 3 * VSLOT, LDS_OST = LDS_WS + NW * 64 * 4, LDS_BYTES = LDS_OST + NW * 4096;
__device__ __forceinline__ int crow(int r, int hi) { return (r & 3) + 8 * (r >> 2) + 4 * hi; }
#define AF_SBAR() __builtin_amdgcn_sched_barrier(0)
__device__ __forceinline__ void glds16(unsigned voff, const void* sbase, unsigned lds_dst) { unsigned keep;
  asm volatile("s_mov_b32 %0, m0\n\ts_mov_b32 m0, %3\n\ts_nop 0\n\tglobal_load_lds_dwordx4 %1, %2\n\ts_mov_b32 m0, %0" : "=&s"(keep) : "v"(voff), "s"(sbase), "s"(lds_dst) : "memory"); }
typedef float f32x2_t __attribute__((ext_vector_type(2))); typedef __bf16 bf16x2_t __attribute__((ext_vector_type(2)));
__device__ __forceinline__ unsigned cvtpk_s(float lo, float hi) { f32x2_t v = {lo, hi}; bf16x2_t b = __builtin_convertvector(v, bf16x2_t); return __builtin_bit_cast(unsigned, b); }
#define AF_WAIT_BAR(N) asm volatile("s_waitcnt vmcnt(" #N ") lgkmcnt(0)\n\ts_barrier" ::: "memory")
typedef __attribute__((address_space(3))) const char* lds_cptr;
typedef short v4i16_t __attribute__((ext_vector_type(4)));
__device__ __forceinline__ i32x8 ld6(lds_cptr p16, lds_cptr p8) { const i32x4 a = *(const __attribute__((address_space(3))) i32x4*)p16; const i32x2 b = *(const __attribute__((address_space(3))) i32x2*)p8;
  return (i32x8){a.x, a.y, a.z, a.w, b.x, b.y, 0, 0}; }
__device__ __forceinline__ s16x4 vtr(lds_cptr p) { return __builtin_bit_cast(s16x4, __builtin_amdgcn_ds_read_tr16_b64_v4i16((__attribute__((address_space(3))) v4i16_t*)p)); }
__device__ __forceinline__ long tile_row(int b, int t) { return t < 4 ? (long)(16384 + 256 * b + 64 * t) : (long)(8192 * b + 64 * (t - 4)); }
__device__ __forceinline__ u32x6 to_fp6(u32x4 a0, u32x4 a1, u32x4 a2, u32x4 a3) { const u32x16 all = {a0.x, a0.y, a0.z, a0.w, a1.x, a1.y, a1.z, a1.w, a2.x, a2.y, a2.z, a2.w, a3.x, a3.y, a3.z, a3.w};
  return __builtin_amdgcn_cvt_scalef32_pk32_fp6_bf16(__builtin_bit_cast(bf16x32, all), 1.0f); }

__device__ __forceinline__ void dense_unit(int b, int h, int qb, const bf16* Q, const bf16* __restrict__ KV, const char* __restrict__ K6N, const char* __restrict__ K6R, bf16* O, char* shm, const int tid) {
  const int lane = tid & 63, r32 = lane & 31, hi = lane >> 5; const int wid = __builtin_amdgcn_readfirstlane(tid >> 6);
  const unsigned lds0 = (unsigned)(uintptr_t)shm;
  float* wsf = (float*)(shm + LDS_WS) + wid * 64;
  const bool wnp = wid < 3 || wid >= 5; const int pc = wnp ? (wid < 3 ? wid : wid - 5) : wid - 3;
  const unsigned voffK = (unsigned)(lane * 16);
  const char* sK = wnp ? K6N + h * 3072 + pc * 1024 : K6R + pc * 1024; const long kts = wnp ? 16 * 3072 : 2048;
  const unsigned voffV = (unsigned)((16 * (wid & 3) + (lane >> 2)) * 2048 + (wid >> 2) * 32 + (lane & 3) * 8) * 2u;
  const char* sV = (const char*)(KV + 1024 + 64 * h);
  const unsigned kdst = lds0 + LDS_K + (wnp ? pc * 1024 : 3072 + pc * 1024), vdst = lds0 + LDS_V + wid * 1024;
#define AF_DMA_K(t, ks) do { const long G_ = tile_row(b, (t)) >> 6; glds16(voffK, sK + G_ * kts, (unsigned)__builtin_amdgcn_readfirstlane(kdst + (ks))); } while (0)
#define AF_DMA_V(t, vs) do { const long R_ = tile_row(b, (t)); glds16(voffV, sV + R_ * 4096, (unsigned)__builtin_amdgcn_readfirstlane(vdst + (vs))); } while (0)
  const lds_cptr shm3 = (lds_cptr)shm;
  const lds_cptr kp16 = shm3 + LDS_K + hi * 1024 + r32 * 16;
  const lds_cptr kp8 = shm3 + LDS_K + 2048 + hi * 512 + r32 * 8;
  const lds_cptr vp0 = shm3 + LDS_V + ((lane >> 4) & 1) * 32 + (lane & 3) * 8 + (4 * hi + ((lane & 15) >> 2)) * 64;
  AF_DMA_K(0, 0); AF_DMA_V(0, 0); AF_DMA_K(1, KSLOT); AF_DMA_K(2, 2 * KSLOT);
  i32x8 qn, qr;
  { const bf16* qp = Q + (long)(8192 * b + 256 * qb + 32 * wid + r32) * 1536; const bf16* qa = qp + 64 * h + 32 * hi; const bf16* qc = qp + 1024 + 32 * h;
    const u32x6 n6 = to_fp6(*reinterpret_cast<const u32x4*>(qa), *reinterpret_cast<const u32x4*>(qa + 8), *reinterpret_cast<const u32x4*>(qa + 16), *reinterpret_cast<const u32x4*>(qa + 24));
    u32x6 r6 = to_fp6(*reinterpret_cast<const u32x4*>(qc), *reinterpret_cast<const u32x4*>(qc + 8), *reinterpret_cast<const u32x4*>(qc + 16), *reinterpret_cast<const u32x4*>(qc + 24));
    if (hi) r6 = (u32x6){0u, 0u, 0u, 0u, 0u, 0u};
    qn = (i32x8){(int)n6[0], (int)n6[1], (int)n6[2], (int)n6[3], (int)n6[4], (int)n6[5], 0, 0}; qr = (i32x8){(int)r6[0], (int)r6[1], (int)r6[2], (int)r6[3], (int)r6[4], (int)r6[5], 0, 0}; }
  float l_reg = 0.f; f32x16 o[2]; o[0] = f32x16{}; o[1] = f32x16{};
  f32x16 pA0, pA1, pB0, pB1; i32x8 kn0, kn1, kr0, kr1;
  int s_prev = 0, s_cur = 0, s_next = 1;
#define AF_ROT() do { s_prev = s_cur; s_cur = s_next; s_next = (s_next == 2) ? 0 : s_next + 1; } while (0)
#define AF_MF(a, b, c) __builtin_amdgcn_mfma_f32_32x32x16_bf16(a, b, c, 0, 0, 0)
#define AF_MX(a, b, c) __builtin_amdgcn_mfma_scale_f32_32x32x64_f8f6f4(a, b, c, 2, 2, 0, 0x7b7b7b7b, 0, 0x7f7f7f7f)
#define AF_EX(v) __builtin_amdgcn_exp2f(v)
  const f32x16 zero16 = f32x16{};
  AF_WAIT_BAR(0);
  { pA0 = AF_MX(ld6(kp16, kp8), qn, zero16); pA1 = AF_MX(ld6(kp16 + 512, kp8 + 256), qn, zero16);
    pA0 = AF_MX(ld6(kp16 + 3072, kp8 + 2048), qr, pA0); pA1 = AF_MX(ld6(kp16 + 3072 + 512, kp8 + 2048 + 256), qr, pA1);
#pragma unroll
    for (int r = 0; r < 16; ++r) { pA0[r] = AF_EX(pA0[r]); pA1[r] = AF_EX(pA1[r]); } }
  AF_WAIT_BAR(0);
  AF_DMA_K(3, 0); AF_DMA_V(1, VSLOT);
  AF_ROT();
  { const lds_cptr k16_ = kp16 + s_cur * KSLOT, k8_ = kp8 + s_cur * KSLOT; kn0 = ld6(k16_, k8_); kn1 = ld6(k16_ + 512, k8_ + 256); kr0 = ld6(k16_ + 3072, k8_ + 2048); kr1 = ld6(k16_ + 3072 + 512, k8_ + 2048 + 256); }
  AF_WAIT_BAR(2);
  s16x4 vlo[8], vhi[8]; u32x4 pw0, pw1, pw2, pw3;
#define AF_PKW(P, B) cvtpk_s(P[B], P[B + 1])
#define AF_PAF(k) __builtin_bit_cast(bf16x8, pw##k)
#define AF_VFR(i) (bf16x8){vlo[i][0], vlo[i][1], vlo[i][2], vlo[i][3], vhi[i][0], vhi[i][1], vhi[i][2], vhi[i][3]}
#define AF_PIN(x) asm volatile("" : "+v"(x))
#define AF_VRD(i) do { vlo[i] = vtr(vp_ + (((i) >> 2) * 4096 + ((i) & 3) * 1024)); vhi[i] = vtr(vp_ + (((i) >> 2) * 4096 + ((i) & 3) * 1024 + 512)); AF_SBAR(); } while (0)
#define AF_GB(MF, X, B) do { MF; X[B] = AF_EX(X[B]); X[B + 1] = AF_EX(X[B + 1]); X[B + 2] = AF_EX(X[B + 2]); X[B + 3] = AF_EX(X[B + 3]); AF_PIN(X); AF_SBAR(); } while (0)
#define AF_KRD(G, j) do { if (G) { const lds_cptr k16_ = kp16 + s_next * KSLOT, k8_ = kp8 + s_next * KSLOT; \
      if ((j) == 0) kn0 = ld6(k16_, k8_); if ((j) == 1) kn1 = ld6(k16_ + 512, k8_ + 256); \
      if ((j) == 2) kr0 = ld6(k16_ + 3072, k8_ + 2048); if ((j) == 3) kr1 = ld6(k16_ + 3072 + 512, k8_ + 2048 + 256); AF_SBAR(); } } while (0)
#define AF_A4(P, B) do { sacc += P[B]; sacc += P[B + 1]; sacc += P[B + 2]; sacc += P[B + 3]; } while (0)
#define AF_STEP(C0, C1, P0, P1, t, GK, GV, GL) do { AF_SBAR(); \
    const lds_cptr vp_ = vp0 + s_prev * VSLOT; \
    float sacc = (P0[0] + P0[1]); \
    AF_VRD(0); AF_VRD(4); \
    { C0 = AF_MX(kn0, qn, zero16); sacc += P0[2]; sacc += P0[3]; AF_A4(P0, 4); AF_PIN(sacc); \
      pw0[0] = AF_PKW(P0, 0); pw0[1] = AF_PKW(P0, 2); pw0[2] = AF_PKW(P0, 4); pw0[3] = AF_PKW(P0, 6); AF_PIN(pw0); AF_SBAR(); } \
    AF_VRD(1); AF_VRD(5); \
    { C1 = AF_MX(kn1, qn, zero16); AF_A4(P0, 8); AF_A4(P0, 12); AF_PIN(sacc); \
      pw1[0] = AF_PKW(P0, 8); pw1[1] = AF_PKW(P0, 10); pw1[2] = AF_PKW(P0, 12); pw1[3] = AF_PKW(P0, 14); AF_PIN(pw1); AF_SBAR(); } \
    AF_VRD(2); AF_VRD(6); \
    { C0 = AF_MX(kr0, qr, C0); AF_A4(P1, 0); AF_A4(P1, 4); AF_PIN(sacc); \
      pw2[0] = AF_PKW(P1, 0); pw2[1] = AF_PKW(P1, 2); pw2[2] = AF_PKW(P1, 4); pw2[3] = AF_PKW(P1, 6); AF_PIN(pw2); AF_SBAR(); } \
    if (GK) { AF_DMA_K((t) + 3, s_cur * KSLOT); AF_SBAR(); } \
    AF_VRD(3); AF_VRD(7); \
    { C1 = AF_MX(kr1, qr, C1); AF_A4(P1, 8); AF_A4(P1, 12); AF_PIN(sacc); \
      pw3[0] = AF_PKW(P1, 8); pw3[1] = AF_PKW(P1, 10); pw3[2] = AF_PKW(P1, 12); pw3[3] = AF_PKW(P1, 14); AF_PIN(pw3); AF_SBAR(); } \
    if (GV) { AF_DMA_V((t) + 1, s_next * VSLOT); AF_SBAR(); } \
    l_reg += sacc; \
    AF_SBAR(); \
    AF_GB(o[0] = AF_MF(AF_PAF(0), AF_VFR(0), o[0]), C0, 0);  AF_KRD(GL, 0); \
    AF_GB(o[1] = AF_MF(AF_PAF(0), AF_VFR(4), o[1]), C0, 4);  AF_KRD(GL, 1); \
    AF_GB(o[0] = AF_MF(AF_PAF(1), AF_VFR(1), o[0]), C0, 8);  AF_KRD(GL, 2); \
    AF_GB(o[1] = AF_MF(AF_PAF(1), AF_VFR(5), o[1]), C0, 12); AF_KRD(GL, 3); \
    AF_GB(o[0] = AF_MF(AF_PAF(2), AF_VFR(2), o[0]), C1, 0); \
    AF_GB(o[1] = AF_MF(AF_PAF(2), AF_VFR(6), o[1]), C1, 4); \
    AF_GB(o[0] = AF_MF(AF_PAF(3), AF_VFR(3), o[0]), C1, 8); \
    AF_GB(o[1] = AF_MF(AF_PAF(3), AF_VFR(7), o[1]), C1, 12); \
  } while (0)
  int t = 1;
  for (; t + 3 < NT; t += 2) {
    AF_STEP(pB0, pB1, pA0, pA1, t, true, true, true);     AF_WAIT_BAR(2); AF_ROT();
    AF_STEP(pA0, pA1, pB0, pB1, t + 1, true, true, true); AF_WAIT_BAR(2); AF_ROT();
  }
  AF_STEP(pB0, pB1, pA0, pA1, NT - 3, false, true, true);  AF_WAIT_BAR(1); AF_ROT();
  AF_STEP(pA0, pA1, pB0, pB1, NT - 2, false, true, true);  AF_WAIT_BAR(0); AF_ROT();
  AF_STEP(pB0, pB1, pA0, pA1, NT - 1, false, false, false);
  { float sacc = pB0[0] + pB0[1];
#pragma unroll
    for (int r = 2; r < 16; ++r) sacc += pB0[r];
#pragma unroll
    for (int r = 0; r < 16; ++r) sacc += pB1[r];
    l_reg += sacc;
    pw0 = (u32x4){AF_PKW(pB0, 0), AF_PKW(pB0, 2), AF_PKW(pB0, 4), AF_PKW(pB0, 6)}; pw1 = (u32x4){AF_PKW(pB0, 8), AF_PKW(pB0, 10), AF_PKW(pB0, 12), AF_PKW(pB0, 14)};
    pw2 = (u32x4){AF_PKW(pB1, 0), AF_PKW(pB1, 2), AF_PKW(pB1, 4), AF_PKW(pB1, 6)}; pw3 = (u32x4){AF_PKW(pB1, 8), AF_PKW(pB1, 10), AF_PKW(pB1, 12), AF_PKW(pB1, 14)};
    AF_SBAR();
    const lds_cptr vp_ = vp0 + s_cur * VSLOT;
#pragma unroll
    for (int i = 0; i < 8; ++i) { vlo[i] = vtr(vp_ + ((i >> 2) * 4096 + (i & 3) * 1024)); vhi[i] = vtr(vp_ + ((i >> 2) * 4096 + (i & 3) * 1024 + 512)); }
    o[0] = AF_MF(AF_PAF(0), AF_VFR(0), o[0]); o[1] = AF_MF(AF_PAF(0), AF_VFR(4), o[1]);
    o[0] = AF_MF(AF_PAF(1), AF_VFR(1), o[0]); o[1] = AF_MF(AF_PAF(1), AF_VFR(5), o[1]);
    o[0] = AF_MF(AF_PAF(2), AF_VFR(2), o[0]); o[1] = AF_MF(AF_PAF(2), AF_VFR(6), o[1]);
    o[0] = AF_MF(AF_PAF(3), AF_VFR(3), o[0]); o[1] = AF_MF(AF_PAF(3), AF_VFR(7), o[1]); }
  { auto rr = __builtin_amdgcn_permlane32_swap(__float_as_uint(l_reg), __float_as_uint(l_reg), false, false); l_reg = __uint_as_float(rr[0]) + __uint_as_float(rr[1]); }
  if (hi == 0) wsf[32 + r32] = l_reg; asm volatile("s_waitcnt lgkmcnt(0)" ::: "memory");
  float rli[16];
#pragma unroll
  for (int r = 0; r < 16; ++r) rli[r] = __builtin_amdgcn_rcpf(wsf[32 + crow(r, hi)]);
  bf16* Ow = O + (long)(8192 * b + 256 * qb + 32 * wid) * 1024 + 64 * h;
  { bf16* stg = (bf16*)(shm + LDS_OST) + wid * 2048;
#pragma unroll
    for (int r = 0; r < 16; ++r) { const int orow = crow(r, hi);
#pragma unroll
      for (int d0 = 0; d0 < 2; ++d0) stg[orow * 64 + d0 * 32 + r32] = (bf16)(cvtpk_s(o[d0][r] * rli[r], 0.f) & 0xffffu); }
    asm volatile("s_waitcnt lgkmcnt(0)" ::: "memory");
#pragma unroll
    for (int i = 0; i < 4; ++i) { const int row = i * 8 + (lane >> 3), ch = lane & 7; const u32x4 v = *(const u32x4*)(stg + row * 64 + ch * 8); *(u32x4*)(Ow + (long)row * 1024 + ch * 8) = v; } }
  asm volatile("s_waitcnt vmcnt(0) lgkmcnt(0)\n\ts_barrier" ::: "memory");
#undef AF_DMA_K
#undef AF_DMA_V
#undef AF_ROT
#undef AF_PKW
#undef AF_PAF
#undef AF_VFR
#undef AF_PIN
#undef AF_MF
#undef AF_MX
#undef AF_EX
#undef AF_VRD
#undef AF_GB
#undef AF_KRD
#undef AF_A4
#undef AF_STEP
}
#undef AF_SBAR
#undef AF_WAIT_BAR
}
namespace attf {
typedef unsigned short bf16;
using bf16x8 = __attribute__((ext_vector_type(8))) short;
using s16x4 = __attribute__((ext_vector_type(4))) short;
using f32x16 = __attribute__((ext_vector_type(16))) float;
using u32x4 = __attribute__((ext_vector_type(4))) unsigned;
constexpr int NW = 8, KSLOT = 12288, VSLOT = 8192;
constexpr int LDS_K = 0, LDS_V = 3 * KSLOT, LDS_WS = LDS_V + 3 * VSLOT, LDS_OST = LDS_WS + NW * 64 * 4, LDS_RPB = LDS_OST + NW * 4096, LDS_BYTES = LDS_RPB + 2048;
__device__ __forceinline__ int crow(int r, int hi) { return (r & 3) + 8 * (r >> 2) + 4 * hi; }
#define AF_SBAR() __builtin_amdgcn_sched_barrier(0)
__device__ __forceinline__ void glds16(unsigned voff, const void* sbase, unsigned lds_dst) { unsigned keep;
  asm volatile("s_mov_b32 %0, m0\n\ts_mov_b32 m0, %3\n\ts_nop 0\n\tglobal_load_lds_dwordx4 %1, %2\n\ts_mov_b32 m0, %0" : "=&s"(keep) : "v"(voff), "s"(sbase), "s"(lds_dst) : "memory"); }
typedef float f32x2_t __attribute__((ext_vector_type(2))); typedef __bf16 bf16x2_t __attribute__((ext_vector_type(2)));
__device__ __forceinline__ unsigned cvtpk_s(float lo, float hi) { f32x2_t v = {lo, hi}; bf16x2_t b = __builtin_convertvector(v, bf16x2_t); return __builtin_bit_cast(unsigned, b); }
#define AF_WAIT_BAR(N) asm volatile("s_waitcnt vmcnt(" #N ") lgkmcnt(0)\n\ts_barrier" ::: "memory")
typedef __attribute__((address_space(3))) const char* lds_cptr;
typedef short v4i16_t __attribute__((ext_vector_type(4)));
__device__ __forceinline__ void kload2(bf16x8* kf, lds_cptr kp, int j) { kf[2 * j] = *(const __attribute__((address_space(3))) bf16x8*)(kp + j * 2048); kf[2 * j + 1] = *(const __attribute__((address_space(3))) bf16x8*)(kp + j * 2048 + 512); }
__device__ __forceinline__ s16x4 vtr(lds_cptr p) { return __builtin_bit_cast(s16x4, __builtin_amdgcn_ds_read_tr16_b64_v4i16((__attribute__((address_space(3))) v4i16_t*)p)); }

template <int DKC, class U>
__device__ __forceinline__ void fast_unit(const U& u, char* shm, int tid) {
  static_assert(DKC == 8 || DKC == 12, "q/k dim 64 or 96");
  asm volatile("" : "+v"(tid));
  constexpr int ND0 = DKC / 2;
  const int lane = tid & 63, r32 = lane & 31, hi = lane >> 5; const int wid = __builtin_amdgcn_readfirstlane(tid >> 6);
  const unsigned lds0 = (unsigned)(uintptr_t)shm;
  float* wsf = (float*)(shm + LDS_WS) + wid * 64;
  const int NT = u.nt();
  const unsigned voffKA = (unsigned)(lane * u.kpitch + 8 * wid) * 2u;
  const unsigned voffKB = (unsigned)(lane * 32 + 8 * (wid & 3)) * 2u;
  const unsigned voffV = (unsigned)((16 * (wid & 3) + (lane >> 2)) * u.vpitch + (wid >> 2) * 32 + (lane & 3) * 8) * 2u;
  const unsigned kdstA = lds0 + LDS_K + wid * 1024, kdstB = lds0 + LDS_K + (8 + (wid & 3)) * 1024, vdst = lds0 + LDS_V + wid * 1024;
#define AF_DMA_KA(t, ks) do { const long R_ = u.trow(t); glds16(voffKA, (const char*)u.kbase + R_ * (2 * u.kpitch), (unsigned)__builtin_amdgcn_readfirstlane(kdstA + (ks))); } while (0)
#define AF_DMA_KB(t, ks) do { if constexpr (DKC == 12) { const long R_ = u.trow(t); glds16(voffKB, (const char*)u.krbase + R_ * 64, (unsigned)__builtin_amdgcn_readfirstlane(kdstB + (ks))); } } while (0)
#define AF_DMA_K(t, ks) do { AF_DMA_KA(t, ks); AF_DMA_KB(t, ks); } while (0)
#define AF_DMA_V(t, vs) do { const long R_ = u.trow(t); glds16(voffV, (const char*)u.vbase + R_ * (2 * u.vpitch), (unsigned)__builtin_amdgcn_readfirstlane(vdst + (vs))); } while (0)
#define AF_WAITN(NSTEPS_K, NV) do { if constexpr (DKC == 12) { if ((NSTEPS_K) == 2 && (NV) == 1) AF_WAIT_BAR(5); else if ((NSTEPS_K) == 1 && (NV) == 1) AF_WAIT_BAR(3); else if ((NV) == 1) AF_WAIT_BAR(1); else AF_WAIT_BAR(0); } \
    else { if ((NSTEPS_K) == 2 && (NV) == 1) AF_WAIT_BAR(3); else if ((NSTEPS_K) == 1 && (NV) == 1) AF_WAIT_BAR(2); else if ((NV) == 1) AF_WAIT_BAR(1); else AF_WAIT_BAR(0); } } while (0)
  const lds_cptr shm3 = (lds_cptr)shm; const lds_cptr kp0 = shm3 + LDS_K + hi * 1024 + r32 * 16;
  const lds_cptr vp0 = shm3 + LDS_V + ((lane >> 4) & 1) * 32 + (lane & 3) * 8 + (4 * hi + ((lane & 15) >> 2)) * 64;
  bf16x8 qr[ND0];
#pragma unroll
  for (int d0 = 0; d0 < ND0; ++d0) qr[d0] = *reinterpret_cast<const bf16x8*>(u.qptr(wid, r32, d0, hi));
  AF_DMA_K(0, 0); AF_DMA_V(0, 0); AF_DMA_K(1, KSLOT); AF_DMA_K(2, 2 * KSLOT);
  float l_reg = 0.f; f32x16 o[2]; o[0] = f32x16{}; o[1] = f32x16{};
  f32x16 pA0, pA1, pB0, pB1; bf16x8 kf[DKC];
  int s_prev = 0, s_cur = 0, s_next = 1;
#define AF_ROT() do { s_prev = s_cur; s_cur = s_next; s_next = (s_next == 2) ? 0 : s_next + 1; } while (0)
  AF_WAITN(2, 1);
  { const char* kb = shm + LDS_K + hi * 1024 + r32 * 16; pA0 = f32x16{}; pA1 = f32x16{};
#pragma unroll
    for (int d0 = 0; d0 < ND0; ++d0) { const bf16x8 b0 = *reinterpret_cast<const bf16x8*>(kb + d0 * 2048), b1 = *reinterpret_cast<const bf16x8*>(kb + d0 * 2048 + 512);
      pA0 = __builtin_amdgcn_mfma_f32_32x32x16_bf16(b0, qr[d0], pA0, 0, 0, 0); pA1 = __builtin_amdgcn_mfma_f32_32x32x16_bf16(b1, qr[d0], pA1, 0, 0, 0); }
    if constexpr (U::HAS_MASK) u.mask(pA0, pA1, 0, wid, r32, hi);
#pragma unroll
    for (int r = 0; r < 16; ++r) { pA0[r] = __builtin_amdgcn_exp2f(pA0[r]); pA1[r] = __builtin_amdgcn_exp2f(pA1[r]); } }
  AF_WAIT_BAR(0);
  AF_DMA_K(3, 0); AF_DMA_V(1, VSLOT);
  AF_ROT();
#pragma unroll
  for (int j = 0; j < ND0; ++j) kload2(kf, kp0 + s_cur * KSLOT, j);
  AF_WAITN(1, 1);
  s16x4 vlo[8], vhi[8]; u32x4 pw0, pw1, pw2, pw3;
#define AF_PKW(P, B) cvtpk_s(P[B], P[B + 1])
#define AF_PAF(k) __builtin_bit_cast(bf16x8, pw##k)
#define AF_VFR(i) (bf16x8){vlo[i][0], vlo[i][1], vlo[i][2], vlo[i][3], vhi[i][0], vhi[i][1], vhi[i][2], vhi[i][3]}
#define AF_PIN(x) asm volatile("" : "+v"(x))
#define AF_MF(a, b, c) __builtin_amdgcn_mfma_f32_32x32x16_bf16(a, b, c, 0, 0, 0)
#define AF_EX(v) __builtin_amdgcn_exp2f(v)
#define AF_VRD(i) do { vlo[i] = vtr(vp_ + (((i) >> 2) * 4096 + ((i) & 3) * 1024)); vhi[i] = vtr(vp_ + (((i) >> 2) * 4096 + ((i) & 3) * 1024 + 512)); AF_SBAR(); } while (0)
#define AF_GA4(MF, A0, A1, A2, A3, W0, W1, PW) do { MF; sacc += A0; sacc += A1; sacc += A2; sacc += A3; AF_PIN(sacc); W0; W1; AF_PIN(PW); AF_SBAR(); } while (0)
#define AF_GA3(MF, A0, A1, A2, W0, W1, PW) do { MF; sacc += A0; sacc += A1; sacc += A2; AF_PIN(sacc); W0; W1; AF_PIN(PW); AF_SBAR(); } while (0)
#define AF_GA2(MF, A0, A1, W0, PW) do { MF; sacc += A0; sacc += A1; AF_PIN(sacc); W0; AF_PIN(PW); AF_SBAR(); } while (0)
#define AF_GB(MF, X, B) do { MF; X[B] = AF_EX(X[B]); X[B + 1] = AF_EX(X[B + 1]); X[B + 2] = AF_EX(X[B + 2]); X[B + 3] = AF_EX(X[B + 3]); AF_PIN(X); AF_SBAR(); } while (0)
#define AF_KRD(G, j) do { if ((j) < ND0) { if (G) { kload2(kf, kp0 + s_next * KSLOT, (j) < ND0 ? (j) : 0); AF_SBAR(); } } } while (0)
  const f32x16 zero16 = f32x16{};
#define AF_PHASE_A12(C0, C1, P0, P1, t, GK, GV) do { \
    AF_VRD(0); float sacc = (P0[0] + P0[1]); \
    AF_GA3(C0 = AF_MF(kf[0], qr[0], zero16), P0[2], P0[3], P0[4],     pw0[0] = AF_PKW(P0, 0), pw0[1] = AF_PKW(P0, 2), pw0); \
    AF_VRD(4); AF_GA3(C1 = AF_MF(kf[1], qr[0], zero16), P0[5], P0[6], P0[7],     pw0[2] = AF_PKW(P0, 4), pw0[3] = AF_PKW(P0, 6), pw0); \
    AF_VRD(1); AF_GA3(C0 = AF_MF(kf[2], qr[1], C0),     P0[8], P0[9], P0[10],    pw1[0] = AF_PKW(P0, 8), pw1[1] = AF_PKW(P0, 10), pw1); \
    AF_VRD(5); AF_GA3(C1 = AF_MF(kf[3], qr[1], C1),     P0[11], P0[12], P0[13],  pw1[2] = AF_PKW(P0, 12), pw1[3] = AF_PKW(P0, 14), pw1); \
    AF_VRD(2); AF_GA3(C0 = AF_MF(kf[4], qr[2], C0),     P0[14], P0[15], P1[0],   pw2[0] = AF_PKW(P1, 0), pw2[1] = AF_PKW(P1, 2), pw2); \
    AF_VRD(6); AF_GA3(C1 = AF_MF(kf[5], qr[2], C1),     P1[1], P1[2], P1[3],     pw2[2] = AF_PKW(P1, 4), pw2[3] = AF_PKW(P1, 6), pw2); \
    AF_VRD(3); AF_GA2(C0 = AF_MF(kf[6], qr[3], C0),     P1[4], P1[5],            pw3[0] = AF_PKW(P1, 8), pw3); \
    AF_VRD(7); AF_GA2(C1 = AF_MF(kf[7], qr[3], C1),     P1[6], P1[7],            pw3[1] = AF_PKW(P1, 10), pw3); \
    AF_GA2(C0 = AF_MF(kf[8 % DKC], qr[4 % ND0], C0),    P1[8], P1[9],            pw3[2] = AF_PKW(P1, 12), pw3); \
    if (GK) { AF_DMA_KA((t) + 3, s_cur * KSLOT); AF_SBAR(); } \
    AF_GA2(C1 = AF_MF(kf[9 % DKC], qr[4 % ND0], C1),    P1[10], P1[11],          pw3[3] = AF_PKW(P1, 14), pw3); \
    if (GK) { AF_DMA_KB((t) + 3, s_cur * KSLOT); AF_SBAR(); } \
    { C0 = AF_MF(kf[10 % DKC], qr[5 % ND0], C0); sacc += P1[12]; sacc += P1[13]; AF_PIN(sacc); AF_SBAR(); } \
    if (GV) { AF_DMA_V((t) + 1, s_next * VSLOT); AF_SBAR(); } \
    { C1 = AF_MF(kf[11 % DKC], qr[5 % ND0], C1); sacc += P1[14]; sacc += P1[15]; AF_PIN(sacc); AF_SBAR(); } \
    l_reg += sacc; } while (0)
#define AF_PHASE_A8(C0, C1, P0, P1, t, GK, GV) do { \
    AF_VRD(0); float sacc = (P0[0] + P0[1]); \
    AF_GA4(C0 = AF_MF(kf[0], qr[0], zero16), P0[2], P0[3], P0[4], P0[5],       pw0[0] = AF_PKW(P0, 0), pw0[1] = AF_PKW(P0, 2), pw0); \
    AF_VRD(4); AF_GA4(C1 = AF_MF(kf[1], qr[0], zero16), P0[6], P0[7], P0[8], P0[9],       pw0[2] = AF_PKW(P0, 4), pw0[3] = AF_PKW(P0, 6), pw0); \
    AF_VRD(1); AF_GA4(C0 = AF_MF(kf[2], qr[1], C0),     P0[10], P0[11], P0[12], P0[13],   pw1[0] = AF_PKW(P0, 8), pw1[1] = AF_PKW(P0, 10), pw1); \
    AF_VRD(5); AF_GA4(C1 = AF_MF(kf[3], qr[1], C1),     P0[14], P0[15], P1[0], P1[1],     pw1[2] = AF_PKW(P0, 12), pw1[3] = AF_PKW(P0, 14), pw1); \
    AF_VRD(2); AF_GA4(C0 = AF_MF(kf[4], qr[2], C0),     P1[2], P1[3], P1[4], P1[5],       pw2[0] = AF_PKW(P1, 0), pw2[1] = AF_PKW(P1, 2), pw2); \
    AF_VRD(6); AF_GA4(C1 = AF_MF(kf[5], qr[2], C1),     P1[6], P1[7], P1[8], P1[9],       pw2[2] = AF_PKW(P1, 4), pw2[3] = AF_PKW(P1, 6), pw2); \
    AF_VRD(3); AF_GA4(C0 = AF_MF(kf[6], qr[3], C0),     P1[10], P1[11], P1[12], P1[13],   pw3[0] = AF_PKW(P1, 8), pw3[1] = AF_PKW(P1, 10), pw3); \
    AF_VRD(7); AF_GA4(C1 = AF_MF(kf[7], qr[3], C1),     P1[14], P1[15], 0.f, 0.f,         pw3[2] = AF_PKW(P1, 12), pw3[3] = AF_PKW(P1, 14), pw3); \
    l_reg += sacc; \
    if (GK) { AF_DMA_KA((t) + 3, s_cur * KSLOT); } if (GV) { AF_DMA_V((t) + 1, s_next * VSLOT); } } while (0)
#define AF_STEP(C0, C1, P0, P1, t, GK, GV, GL) do { AF_SBAR(); \
    const lds_cptr vp_ = vp0 + s_prev * VSLOT; \
    if constexpr (DKC == 12) AF_PHASE_A12(C0, C1, P0, P1, t, GK, GV); else AF_PHASE_A8(C0, C1, P0, P1, t, GK, GV); \
    if constexpr (U::HAS_MASK) u.mask(C0, C1, (t), wid, r32, hi); \
    AF_SBAR(); \
    AF_GB(o[0] = AF_MF(AF_PAF(0), AF_VFR(0), o[0]), C0, 0);  AF_KRD(GL, 0); \
    AF_GB(o[1] = AF_MF(AF_PAF(0), AF_VFR(4), o[1]), C0, 4);  AF_KRD(GL, 1); \
    AF_GB(o[0] = AF_MF(AF_PAF(1), AF_VFR(1), o[0]), C0, 8);  AF_KRD(GL, 2); \
    AF_GB(o[1] = AF_MF(AF_PAF(1), AF_VFR(5), o[1]), C0, 12); AF_KRD(GL, 3); \
    AF_GB(o[0] = AF_MF(AF_PAF(2), AF_VFR(2), o[0]), C1, 0);  AF_KRD(GL, 4); \
    AF_GB(o[1] = AF_MF(AF_PAF(2), AF_VFR(6), o[1]), C1, 4);  AF_KRD(GL, 5); \
    AF_GB(o[0] = AF_MF(AF_PAF(3), AF_VFR(3), o[0]), C1, 8); \
    AF_GB(o[1] = AF_MF(AF_PAF(3), AF_VFR(7), o[1]), C1, 12); \
  } while (0)
  int t = 1;
  for (; t + 3 < NT; t += 2) {
    AF_STEP(pB0, pB1, pA0, pA1, t, true, true, true);     AF_WAITN(1, 1); AF_ROT();
    AF_STEP(pA0, pA1, pB0, pB1, t + 1, true, true, true); AF_WAITN(1, 1); AF_ROT();
  }
  AF_STEP(pB0, pB1, pA0, pA1, NT - 3, false, true, true);  AF_WAITN(0, 1); AF_ROT();
  AF_STEP(pA0, pA1, pB0, pB1, NT - 2, false, true, true);  AF_WAIT_BAR(0); AF_ROT();
  AF_STEP(pB0, pB1, pA0, pA1, NT - 1, false, false, false);
  { float sacc = pB0[0] + pB0[1];
#pragma unroll
    for (int r = 2; r < 16; ++r) sacc += pB0[r];
#pragma unroll
    for (int r = 0; r < 16; ++r) sacc += pB1[r];
    l_reg += sacc;
    pw0 = (u32x4){AF_PKW(pB0, 0), AF_PKW(pB0, 2), AF_PKW(pB0, 4), AF_PKW(pB0, 6)}; pw1 = (u32x4){AF_PKW(pB0, 8), AF_PKW(pB0, 10), AF_PKW(pB0, 12), AF_PKW(pB0, 14)};
    pw2 = (u32x4){AF_PKW(pB1, 0), AF_PKW(pB1, 2), AF_PKW(pB1, 4), AF_PKW(pB1, 6)}; pw3 = (u32x4){AF_PKW(pB1, 8), AF_PKW(pB1, 10), AF_PKW(pB1, 12), AF_PKW(pB1, 14)};
    AF_SBAR();
    const lds_cptr vp_ = vp0 + s_cur * VSLOT;
#pragma unroll
    for (int i = 0; i < 8; ++i) { vlo[i] = vtr(vp_ + ((i >> 2) * 4096 + (i & 3) * 1024)); vhi[i] = vtr(vp_ + ((i >> 2) * 4096 + (i & 3) * 1024 + 512)); }
    o[0] = AF_MF(AF_PAF(0), AF_VFR(0), o[0]); o[1] = AF_MF(AF_PAF(0), AF_VFR(4), o[1]);
    o[0] = AF_MF(AF_PAF(1), AF_VFR(1), o[0]); o[1] = AF_MF(AF_PAF(1), AF_VFR(5), o[1]);
    o[0] = AF_MF(AF_PAF(2), AF_VFR(2), o[0]); o[1] = AF_MF(AF_PAF(2), AF_VFR(6), o[1]);
    o[0] = AF_MF(AF_PAF(3), AF_VFR(3), o[0]); o[1] = AF_MF(AF_PAF(3), AF_VFR(7), o[1]); }
  { auto rr = __builtin_amdgcn_permlane32_swap(__float_as_uint(l_reg), __float_as_uint(l_reg), false, false); l_reg = __uint_as_float(rr[0]) + __uint_as_float(rr[1]); }
  l_reg += __builtin_amdgcn_exp2f(u.sink(wid));
  if (hi == 0) wsf[32 + r32] = l_reg; asm volatile("s_waitcnt lgkmcnt(0)" ::: "memory");
  float rli[16];
#pragma unroll
  for (int r = 0; r < 16; ++r) rli[r] = __builtin_amdgcn_rcpf(wsf[32 + crow(r, hi)]);
  bf16* Ow = u.orow0(wid);
  { bf16* stg = (bf16*)(shm + LDS_OST) + wid * 2048;
#pragma unroll
    for (int r = 0; r < 16; ++r) { const int orow = crow(r, hi);
#pragma unroll
      for (int d0 = 0; d0 < 2; ++d0) stg[orow * 64 + d0 * 32 + r32] = (bf16)(cvtpk_s(o[d0][r] * rli[r], 0.f) & 0xffffu); }
    asm volatile("s_waitcnt lgkmcnt(0)" ::: "memory");
#pragma unroll
    for (int i = 0; i < 4; ++i) { const int row = i * 8 + (lane >> 3), ch = lane & 7; const u32x4 v = *(const u32x4*)(stg + row * 64 + ch * 8); *(u32x4*)(Ow + (long)row * 1024 + ch * 8) = v; } }
  asm volatile("s_waitcnt vmcnt(0) lgkmcnt(0)\n\ts_barrier" ::: "memory");
#undef AF_DMA_KA
#undef AF_DMA_KB
#undef AF_DMA_K
#undef AF_DMA_V
#undef AF_WAITN
#undef AF_ROT
#undef AF_PKW
#undef AF_PAF
#undef AF_VFR
#undef AF_PIN
#undef AF_MF
#undef AF_EX
#undef AF_VRD
#undef AF_GA4
#undef AF_GA3
#undef AF_GA2
#undef AF_GB
#undef AF_KRD
#undef AF_PHASE_A12
#undef AF_PHASE_A8
#undef AF_STEP
}

constexpr int ROWS_LAT = 16384;
constexpr float LOG2E_ = 1.4426950408889634f;
__device__ __forceinline__ int clampi(int v, int lo, int hi_) { return v < lo ? lo : (v > hi_ ? hi_ : v); }
struct FDense {
  static constexpr bool HAS_MASK = false;
  const bf16* Q; const bf16* kbase; const bf16* vbase; const bf16* krbase; bf16* O; int b, h, qb; static constexpr int kpitch = 2048, vpitch = 2048;
  __device__ __forceinline__ void init(const bf16* Q_, const bf16* KV, const bf16* KR, bf16* O_, int b_, int h_, int qb_) { Q = Q_; kbase = KV + 64 * h_; vbase = KV + 1024 + 64 * h_; krbase = KR; O = O_; b = b_; h = h_; qb = qb_; }
  __device__ __forceinline__ int nt() const { return 132; }
  __device__ __forceinline__ long trow(int t) const { return t < 4 ? (long)(ROWS_LAT + 256 * b + 64 * t) : (long)(8192 * b + 64 * (t - 4)); }
  __device__ __forceinline__ const bf16* qptr(int wid, int r32, int d0, int hi) const { const bf16* qp = Q + (long)(8192 * b + 256 * qb + 32 * wid + r32) * 1536;
    return d0 < 4 ? qp + 64 * h + 16 * d0 + 8 * hi : qp + 1024 + 32 * h + 16 * (d0 - 4) + 8 * hi; }
  __device__ __forceinline__ void mask(f32x16&, f32x16&, int, int, int, int) const {}
  __device__ __forceinline__ float sink(int) const { return -INFINITY; }
  __device__ __forceinline__ bf16* orow0(int wid) const { return O + (long)(8192 * b + 256 * qb + 32 * wid) * 1024 + 64 * h; }
};
struct FWin {
  static constexpr bool HAS_MASK = true; static constexpr int kpitch = 2304, vpitch = 2304;
  const bf16* QKV; const bf16* kbase; const bf16* vbase; const bf16* krbase; bf16* O; const float* sinkp; int b, n, g, hh, i0, cnt;
  __device__ __forceinline__ void init(const bf16* QKV_, bf16* O_, const float* sk, int b_, int n_, int g_, int hh_) { QKV = QKV_; O = O_; sinkp = sk; b = b_; n = n_; g = g_; hh = hh_; krbase = nullptr;
    kbase = QKV_ + 512 + 64 * g_; vbase = QKV_ + 640 + 64 * g_; i0 = (n_ == 0) ? 2 : 0; cnt = (n_ == 0 || n_ == 63) ? 4 : 6; }
  __device__ __forceinline__ int nt() const { return 4 + cnt; }
  __device__ __forceinline__ int kpos0(int t) const { return 128 * (n - 1) + 64 * (i0 + t - 4); }
  __device__ __forceinline__ long trow(int t) const { return t < 4 ? (long)(ROWS_LAT + 256 * b + 64 * t) : (long)(8192 * b + kpos0(t)); }
  __device__ __forceinline__ int head(int wid) const { return 4 * g + 2 * hh + (wid >> 2); }
  __device__ __forceinline__ int qpos0(int wid) const { return 128 * n + 32 * (wid & 3); }
  __device__ __forceinline__ const bf16* qptr(int wid, int r32, int d0, int hi) const { return QKV + (long)(8192 * b + qpos0(wid) + r32) * 2304 + 64 * head(wid) + 16 * d0 + 8 * hi; }
  __device__ __forceinline__ void mask(f32x16& p0, f32x16& p1, int t, int wid, int r32, int hi) const {
    if (t < 4) return;
    const int k0 = kpos0(t), q0 = qpos0(wid);
    if (k0 - (q0 + 31) >= -128 && k0 + 63 - q0 <= 128) return;
    asm volatile("" : "+v"(r32), "+v"(hi));
    const int dq = k0 - (q0 + r32);
#pragma unroll
    for (int r = 0; r < 16; ++r) { const int d = dq + crow(r, hi); if (d > 128 || d < -128) p0[r] = -INFINITY; if (d + 32 > 128 || d + 32 < -128) p1[r] = -INFINITY; }
  }
  __device__ __forceinline__ float sink(int wid) const { return sinkp[head(wid)] * LOG2E_; }
  __device__ __forceinline__ bf16* orow0(int wid) const { return O + (long)(8192 * b + qpos0(wid)) * 1024 + 64 * head(wid); }
};
struct FNa {
  static constexpr bool HAS_MASK = true; static constexpr int kpitch = 2304, vpitch = 2304;
  const bf16* QKV; const bf16* kbase; const bf16* vbase; const bf16* krbase; bf16* O; const float* rpbl; int b, h, R4, krlo, nloc;
  __device__ __forceinline__ void init(const bf16* QKV_, bf16* O_, const float* rpbl_, int b_, int h_, int R4_) { QKV = QKV_; O = O_; rpbl = rpbl_; b = b_; h = h_; R4 = R4_; krbase = nullptr;
    kbase = QKV_ + 1280 + 64 * h_; vbase = QKV_ + 1792 + 64 * h_; krlo = clampi(4 * R4_ - 4, 0, 120); nloc = clampi(4 * R4_ - 1, 0, 120) + 7 - krlo + 1; }
  __device__ __forceinline__ int nt() const { return (4 + nloc + 1) & ~1; }
  __device__ __forceinline__ long trow(int t) const { return (t < 4 || t >= 4 + nloc) ? (long)(ROWS_LAT + 256 * b + 64 * (t & 3)) : (long)(8192 * b + 64 * (krlo + t - 4)); }
  __device__ __forceinline__ int qrow(int wid) const { return 4 * R4 + (wid >> 1); }
  __device__ __forceinline__ const bf16* qptr(int wid, int r32, int d0, int hi) const { return QKV + (long)(8192 * b + 64 * qrow(wid) + 32 * (wid & 1) + r32) * 2304 + 768 + 64 * h + 16 * d0 + 8 * hi; }
  __device__ __forceinline__ void mask(f32x16& p0, f32x16& p1, int t, int wid, int r32, int hi) const {
    if (t < 4) return;
    const int kr = krlo + t - 4, w0 = clampi(qrow(wid) - 4, 0, 120);
    if (t >= 4 + nloc || kr < w0 || kr > w0 + 7) {
#pragma unroll
      for (int r = 0; r < 16; ++r) { p0[r] = -INFINITY; p1[r] = -INFINITY; }
      return; }
    asm volatile("" : "+v"(r32), "+v"(hi));
    const int qc = 32 * (wid & 1) + r32, c0 = clampi(qc - 8, 0, 48);
    const float* pb = rpbl + (kr - qrow(wid) + 7) * 31 + 15 - qc + 4 * hi;
    const unsigned t0 = (unsigned)(4 * hi - c0);
#define AF_PIN16(a) asm volatile("" : "+v"(a[0]), "+v"(a[1]), "+v"(a[2]), "+v"(a[3]), "+v"(a[4]), "+v"(a[5]), "+v"(a[6]), "+v"(a[7]), "+v"(a[8]), "+v"(a[9]), "+v"(a[10]), "+v"(a[11]), "+v"(a[12]), "+v"(a[13]), "+v"(a[14]), "+v"(a[15]))
    float bv[16];
#pragma unroll
    for (int r = 0; r < 16; ++r) bv[r] = pb[(r & 3) + 8 * (r >> 2)];
    AF_PIN16(bv);
#pragma unroll
    for (int r = 0; r < 16; ++r) { const bool ok = (t0 + (unsigned)((r & 3) + 8 * (r >> 2))) < 16u; p0[r] = ok ? p0[r] + bv[r] : -INFINITY; }
#pragma unroll
    for (int r = 0; r < 16; ++r) bv[r] = pb[32 + (r & 3) + 8 * (r >> 2)];
    AF_PIN16(bv);
#pragma unroll
    for (int r = 0; r < 16; ++r) { const bool ok = (t0 + (unsigned)(32 + (r & 3) + 8 * (r >> 2))) < 16u; p1[r] = ok ? p1[r] + bv[r] : -INFINITY; }
#undef AF_PIN16
  }
  __device__ __forceinline__ float sink(int) const { return -INFINITY; }
  __device__ __forceinline__ bf16* orow0(int wid) const { return O + (long)(8192 * b + 64 * qrow(wid) + 32 * (wid & 1)) * 1024 + 512 + 64 * h; }
};
struct FCtx {
  static constexpr bool HAS_MASK = false; static constexpr int kpitch = 2304, vpitch = 2304;
  const bf16* QKV; const bf16* kbase; const bf16* vbase; const bf16* krbase; bf16* O; const float* sinkp; int b, hx, qcol, ocol;
  __device__ __forceinline__ void init(const bf16* QKV_, bf16* O_, const float* sk, int b_, int hx_) { QKV = QKV_; O = O_; sinkp = sk; b = b_; hx = hx_; krbase = nullptr;
    if (hx_ < 8) { qcol = 64 * hx_; kbase = QKV_ + 512 + 64 * (hx_ >> 2); vbase = QKV_ + 640 + 64 * (hx_ >> 2); ocol = 64 * hx_; }
    else { const int h = hx_ - 8; qcol = 768 + 64 * h; kbase = QKV_ + 1280 + 64 * h; vbase = QKV_ + 1792 + 64 * h; ocol = 512 + 64 * h; } }
  __device__ __forceinline__ int nt() const { return 4; }
  __device__ __forceinline__ long trow(int t) const { return (long)(ROWS_LAT + 256 * b + 64 * (t & 3)); }
  __device__ __forceinline__ const bf16* qptr(int wid, int r32, int d0, int hi) const { return QKV + (long)(ROWS_LAT + 256 * b + 32 * wid + r32) * 2304 + qcol + 16 * d0 + 8 * hi; }
  __device__ __forceinline__ void mask(f32x16&, f32x16&, int, int, int, int) const {}
  __device__ __forceinline__ float sink(int) const { return hx < 8 ? sinkp[hx] * LOG2E_ : -INFINITY; }
  __device__ __forceinline__ bf16* orow0(int wid) const { return O + (long)(ROWS_LAT + 256 * b + 32 * wid) * 1024 + ocol; }
};
#undef AF_SBAR
#undef AF_WAIT_BAR
}
constexpr int NWAVES = 8;
#ifndef MK_PER_PHASE
#define MK_PER_PHASE 0
#endif
constexpr int BATCH = 2, SEQ = 8192, DM = 1024, CTXL = 256, FF = 4096;
constexpr int ML = BATCH * SEQ, MC = BATCH * CTXL, MR = ML + MC;
constexpr int NQKV = 2304, NCIN = 768, NUQ = 1536, NUKV = 2048;
constexpr float NORM_EPS = 1e-6f;
constexpr int ADA_KS = 16;
constexpr size_t MiB = 1u << 20;
constexpr size_t WS_CTL = 0, CTL_ZERO_BYTES = 64 * 1024;
constexpr size_t WS_MODP = 1 * MiB;
constexpr size_t WS_MOD = 3 * MiB + 512 * 1024;
constexpr size_t WS_ROPE = 3 * MiB + 768 * 1024;
constexpr size_t WS_HPAR = WS_ROPE + 32 * 1024;
constexpr size_t WS_CTXRES = 4 * MiB;
constexpr size_t WS_WQKV = 6 * MiB, WS_WO0 = WS_WQKV + 4608 * 1024, WS_W1_0 = WS_WO0 + 2 * MiB, WS_W2_0 = WS_W1_0 + 8 * MiB, WS_W1_1 = WS_W2_0 + 8 * MiB, WS_W2_1 = WS_W1_1 + 8 * MiB;
constexpr size_t WS_WIN = WS_W2_1 + 8 * MiB, WS_WUQ = WS_WIN + 1536 * 1024, WS_WUKV = WS_WUQ + 1152 * 1024, WS_WO1 = WS_WUKV + 1 * MiB, WS_WEND = WS_WO1 + 2 * MiB;
constexpr size_t WS_AR = 51 * MiB;
static_assert(WS_WEND <= WS_AR, "weights overlap the arena");
constexpr size_t WS_XN = WS_AR, WS_H = WS_AR + 33 * MiB;
constexpr size_t WS_QKV = WS_AR + 33 * MiB, WS_O0 = WS_AR + 108 * MiB;
constexpr size_t WS_CQKV = WS_AR + 33 * MiB, WS_CQN = WS_AR + 58 * MiB, WS_CKVN = WS_AR + 71 * MiB, WS_KR = WS_AR + 80 * MiB, WS_Q1 = WS_AR + 82 * MiB, WS_KV1 = WS_AR + 130 * MiB, WS_O1 = WS_AR;
constexpr size_t WS_K6N = WS_AR + 34 * MiB, WS_K6R = WS_AR + 48 * MiB;
constexpr size_t WS_PART5 = WS_AR + 33 * MiB;
constexpr size_t WS_XR = WS_AR + 166 * MiB;
constexpr size_t WS_PART8 = WS_AR + 166 * MiB;
constexpr size_t WS_END = 256 * MiB;
static_assert(WS_PART8 + (size_t)16 * 512 * 1024 * 4 <= WS_END && WS_KV1 + (size_t)MR * NUKV * 2 <= WS_END && WS_H + (size_t)MR * FF * 2 <= WS_END, "d_ws map");
constexpr int CW_BAR = 4096;
constexpr int RING_OFF = 0, RING_BYTES = 131072;
constexpr int LDSCTL_OFF = RING_BYTES, MISC_OFF = LDSCTL_OFF + 320;
constexpr int LDS_BYTES = 147456;
static_assert(att::L_END <= RING_BYTES && attf::LDS_BYTES <= RING_BYTES, "attention LDS");

#define GAS __attribute__((address_space(1)))
#define LAS __attribute__((address_space(3)))
typedef unsigned short bf16;
typedef unsigned v4u __attribute__((ext_vector_type(4)));
typedef unsigned v2u __attribute__((ext_vector_type(2)));
typedef float f32x4 __attribute__((ext_vector_type(4)));
typedef GAS unsigned gu32;
#define RLX_AGENT __ATOMIC_RELAXED, __HIP_MEMORY_SCOPE_AGENT
#define LDS_WAIT() asm volatile("s_waitcnt lgkmcnt(0)" ::: "memory")
#define VM_WAIT() asm volatile("s_waitcnt vmcnt(0)" ::: "memory")
__device__ __forceinline__ unsigned f2bf(float f) { unsigned u = __builtin_bit_cast(unsigned, f); return (u + 0x7fffu + ((u >> 16) & 1u)) >> 16; }
__device__ __forceinline__ unsigned pk2(float lo, float hi) { return f2bf(lo) | (f2bf(hi) << 16); }
__device__ __forceinline__ float bf2f(unsigned short h) { return __builtin_bit_cast(float, (unsigned)h << 16); }
__device__ __forceinline__ float bflo(unsigned w) { return __builtin_bit_cast(float, w << 16); }
__device__ __forceinline__ float bfhi(unsigned w) { return __builtin_bit_cast(float, w & 0xffff0000u); }

#define XB_TMO      128
#define XB_XCNT(j)  (256  + 64 * (j))
#define XB_XSUB(j)  (1280 + 64 * (j))
#define XB_XGEN(j)  (2304 + 64 * (j))
#define XB_TOP      3328
#define XB_TOPGEN   3392
#define XCD_BAR_WORDS 3456
#define XB_SPIN_CAP (1u << 18)

__device__ __forceinline__ unsigned xb_ld(unsigned* p)              { return __hip_atomic_load(p, __ATOMIC_RELAXED, __HIP_MEMORY_SCOPE_AGENT); }
__device__ __forceinline__ unsigned xb_add(unsigned* p, unsigned v) { return __hip_atomic_fetch_add(p, v, __ATOMIC_RELAXED, __HIP_MEMORY_SCOPE_AGENT); }
__device__ __forceinline__ unsigned xb_xcc_id() { return (unsigned)__builtin_amdgcn_s_getreg((3 << 11) | 20) & 0xFu; }
#define XB_SPIN(cond, bar) do { unsigned _sp = 0; while (cond) { __builtin_amdgcn_s_sleep(1); \
    if ((++_sp & 255u) == 0u) { if (xb_ld(&(bar)[XB_TMO])) break; if (_sp > XB_SPIN_CAP) { atomicAdd(&(bar)[XB_TMO], 1u); break; } } } } while (0)

struct XcdBarrier {
    unsigned* bar; unsigned x;
    volatile LAS unsigned* st;
};

__device__ __forceinline__ XcdBarrier xcd_barrier_post(unsigned* bar, volatile LAS unsigned* st) {
    XcdBarrier b; b.bar = bar; b.x = xb_xcc_id(); b.st = st;
    if (threadIdx.x == 0) (void)xb_add(&bar[XB_XCNT(b.x)], 1u);
    return b;
}
__device__ __forceinline__ void xcd_barrier_complete(unsigned* bar, unsigned x, unsigned& nloc, unsigned& nx) {
    const unsigned G = gridDim.x * gridDim.y * gridDim.z;
    unsigned sum, cnt, mine, sp = 0u;
    for (;;) {
        sum = 0u; cnt = 0u; mine = 0u;
#pragma unroll
        for (unsigned j = 0; j < 16; ++j) { const unsigned c = xb_ld(&bar[XB_XCNT(j)]); sum += c; cnt += (c > 0u) ? 1u : 0u; mine = (j == x) ? c : mine; }
        if (sum == G) break;
        __builtin_amdgcn_s_sleep(1);
        if ((++sp & 255u) == 0u) { if (xb_ld(&bar[XB_TMO])) break; if (sp > XB_SPIN_CAP) { atomicAdd(&bar[XB_TMO], 1u); break; } }
    }
    nloc = mine > 0u ? mine : 1u; nx = cnt > 0u ? cnt : 1u;
}

__device__ __forceinline__ void xcd_barrier(const XcdBarrier& b) {
    asm volatile("s_waitcnt vmcnt(0)" ::: "memory");
    __syncthreads();
    if (threadIdx.x == 0) {
        unsigned* bar = b.bar;
        __builtin_amdgcn_s_waitcnt(0);
        unsigned nloc = b.st[0], nx = b.st[1];
        if (nloc == 0u) { xcd_barrier_complete(bar, b.x, nloc, nx); b.st[0] = nloc; b.st[1] = nx; }
        const unsigned old = xb_add(&bar[XB_XSUB(b.x)], 1u);
        const unsigned gen = old / nloc;
        if (old + 1u == (gen + 1u) * nloc) {
            __builtin_amdgcn_fence(__ATOMIC_RELEASE, "agent");
            asm volatile("s_waitcnt vmcnt(0)" ::: "memory");
            const unsigned og = xb_add(&bar[XB_TOP], 1u);
            const unsigned tg = og / nx;
            if (og + 1u == (tg + 1u) * nx) xb_add(&bar[XB_TOPGEN], 1u);
            else XB_SPIN(xb_ld(&bar[XB_TOPGEN]) == tg, bar);
            __builtin_amdgcn_fence(__ATOMIC_ACQUIRE, "agent");
            xb_add(&bar[XB_XGEN(b.x)], 1u);
            asm volatile("s_waitcnt vmcnt(0)" ::: "memory");
        } else {
            XB_SPIN(xb_ld(&bar[XB_XGEN(b.x)]) == gen, bar);
            __builtin_amdgcn_fence(__ATOMIC_ACQUIRE, "agent");
            asm volatile("s_waitcnt vmcnt(0)" ::: "memory");
        }
    }
    __syncthreads();
}


template <int K> __device__ __forceinline__ const float* ldarg() {
    auto ka = __builtin_amdgcn_kernarg_segment_ptr();
    const __attribute__((address_space(1))) float* p; asm volatile("s_load_dwordx2 %0, %1, %2\n\ts_waitcnt lgkmcnt(0)" : "=s"(p) : "s"(ka), "i"(K * 8) : "memory"); return (const float*)p;
}
#define ARG(k) (ldarg<k>())
#define ARG_OUT ((float*)ldarg<28>())
#define ARG_WS ((unsigned char*)ldarg<29>())
struct Frame {
    LAS unsigned char* lds;
    volatile LAS unsigned* MISC;
    gu32* ctl;
    int tid, lane, wave;
    int vcu, G, bx;
    float* out; unsigned char* ws;
};
__device__ __forceinline__ float shx(float v, int mask, int lane) { return __builtin_bit_cast(float, __builtin_amdgcn_ds_bpermute((lane ^ mask) << 2, __builtin_bit_cast(int, v))); }
__device__ __forceinline__ float wave_sum(float v, int lane) {
#pragma unroll
    for (int o = 1; o < 64; o <<= 1) v += shx(v, o, lane);
    return v;
}
__device__ __forceinline__ void p0_transpose_item(const float* W, int K, int N, bf16* WT, int pmode, LAS float* scr, int item, int lane) {
    const int nblk = N / 32, kb = item / nblk, nb = item % nblk, k0 = 64 * kb, n0 = 32 * nb;
    int r0 = n0;
    if (pmode == 1) { const int h = n0 / 96, d = n0 % 96; r0 = d < 64 ? h * 64 + d : 1024 + h * 32 + (d - 64); }
    else if (pmode == 2) { const int h = n0 / 128, d = n0 % 128; r0 = d < 64 ? h * 64 + d : 1024 + h * 64 + (d - 64); }
#pragma unroll 8
    for (int i = 0; i < 32; ++i) { const int kk = 2 * i + (lane >> 5); scr[kk * 33 + (lane & 31)] = W[(size_t)(k0 + kk) * N + n0 + (lane & 31)]; }
    LDS_WAIT(); asm volatile("" ::: "memory");
    const int c = lane & 7;
#pragma unroll
    for (int j = 0; j < 4; ++j) { const int n = (lane >> 3) + 8 * j; const LAS float* s = scr + (8 * c) * 33 + n;
        v4u o; o.x = pk2(s[0 * 33], s[1 * 33]); o.y = pk2(s[2 * 33], s[3 * 33]); o.z = pk2(s[4 * 33], s[5 * 33]); o.w = pk2(s[6 * 33], s[7 * 33]);
        *(GAS v4u*)(WT + (size_t)(r0 + n) * K + k0 + 8 * c) = o; }
    LDS_WAIT(); asm volatile("" ::: "memory");
}
__device__ __forceinline__ float silu_f(float v) { return v / (1.f + __expf(-v)); }

__device__ __forceinline__ void p0_prologue(Frame& F) {
    LAS float* scr = (LAS float*)(F.lds + RING_OFF + F.wave * 16384);
    const float* c = ARG(1); const float* cctx = ARG(3);
    if (F.wave >= 5) {
        for (int it = F.vcu * 3 + (F.wave - 5); it < 2 * 24 * ADA_KS; it += F.G * 3) {
            const int l = it / (24 * ADA_KS), rem = it % (24 * ADA_KS), cg = rem / ADA_KS, ks = rem % ADA_KS;
            const float* W = ARG(4) + (size_t)l * DM * 6144 + cg * 256 + 4 * F.lane;
            f32x4 a0 = {0.f, 0.f, 0.f, 0.f}, a1 = a0, a2 = a0;
            const int kbeg = ks * (DM / ADA_KS);
#pragma unroll 8
            for (int k = kbeg; k < kbeg + DM / ADA_KS; ++k) {
                const f32x4 w = *(const GAS f32x4*)(W + (size_t)k * 6144);
                const float s0 = silu_f(c[k]), s1 = silu_f(c[DM + k]), s2 = silu_f(cctx[k]);
                a0 += w * s0; a1 += w * s1; a2 += w * s2;
            }
            float* P = (float*)(F.ws + WS_MODP) + ((size_t)(ks * 2 + l) * 3) * 6144 + cg * 256 + 4 * F.lane;
            *(GAS f32x4*)(P) = a0; *(GAS f32x4*)(P + 6144) = a1; *(GAS f32x4*)(P + 2 * 6144) = a2;
        }
    } else {
        const int gw = F.vcu * 5 + F.wave, NGW = F.G * 5;
        constexpr int I_QKV = 16 * 72, I_O = 16 * 32, I_1 = 16 * 128, I_2 = 64 * 32, I_IN = 16 * 21, I_UQ = 6 * 48, I_UKV = 4 * 64;
        constexpr int NITEMS = I_QKV + I_O + 2 * I_1 + 2 * I_2 + I_IN + I_UQ + I_UKV + I_O;
        for (int it = gw; it < NITEMS; it += NGW) {
            int r = it;
            if (r < I_QKV) { p0_transpose_item(ARG(10), DM, NQKV, (bf16*)(F.ws + WS_WQKV), 0, scr, r, F.lane); continue; } r -= I_QKV;
            if (r < I_O) { p0_transpose_item(ARG(11), DM, DM, (bf16*)(F.ws + WS_WO0), 0, scr, r, F.lane); continue; } r -= I_O;
            if (r < I_1) { p0_transpose_item(ARG(8), DM, FF, (bf16*)(F.ws + WS_W1_0), 0, scr, r, F.lane); continue; } r -= I_1;
            if (r < I_1) { p0_transpose_item(ARG(8) + (size_t)DM * FF, DM, FF, (bf16*)(F.ws + WS_W1_1), 0, scr, r, F.lane); continue; } r -= I_1;
            if (r < I_2) { p0_transpose_item(ARG(9), FF, DM, (bf16*)(F.ws + WS_W2_0), 0, scr, r, F.lane); continue; } r -= I_2;
            if (r < I_2) { p0_transpose_item(ARG(9) + (size_t)DM * FF, FF, DM, (bf16*)(F.ws + WS_W2_1), 0, scr, r, F.lane); continue; } r -= I_2;
            if (r < I_IN) { p0_transpose_item(ARG(18), DM, 672, (bf16*)(F.ws + WS_WIN), 0, scr, r, F.lane); continue; } r -= I_IN;
            if (r < I_UQ) { p0_transpose_item(ARG(21), 384, NUQ, (bf16*)(F.ws + WS_WUQ), 1, scr, r, F.lane); continue; } r -= I_UQ;
            if (r < I_UKV) { p0_transpose_item(ARG(22), 256, NUKV, (bf16*)(F.ws + WS_WUKV), 2, scr, r, F.lane); continue; } r -= I_UKV;
            p0_transpose_item(ARG(27), DM, DM, (bf16*)(F.ws + WS_WO1), 0, scr, r, F.lane);
        }
    }
    if (F.bx == 1 % F.G) {
        float* rt = (float*)(F.ws + WS_ROPE);
        for (int e = F.tid; e < 128 * 16; e += NWAVES * 64) { const int pos = e >> 4, i = e & 15; const float inv = exp2f(-(float)i * (13.287712379549449f / 16.f));
            float x = (float)pos * inv * 0.15915494309189535f; x -= rintf(x); rt[e] = __builtin_amdgcn_cosf(x); rt[2048 + e] = __builtin_amdgcn_sinf(x); }
        for (int e = F.tid; e < 128 * 8; e += NWAVES * 64) { const int pos = e >> 3, i = e & 7; const float inv = exp2f(-(float)i * (13.287712379549449f / 8.f));
            float x = (float)pos * inv * 0.15915494309189535f; x -= rintf(x); rt[4096 + e] = __builtin_amdgcn_cosf(x); rt[5120 + e] = __builtin_amdgcn_sinf(x); }
    }
    if (F.bx == 3 % F.G && F.tid < 64) {
        float* hp = (float*)(F.ws + WS_HPAR); const int i = F.tid;
        hp[i] = ARG(12)[i]; hp[64 + i] = ARG(13)[i]; hp[128 + i] = ARG(15)[i]; hp[192 + i] = ARG(16)[i]; hp[256 + i] = ARG(23)[i]; hp[320 + i] = ARG(24)[i & 31]; hp[384 + i] = ARG(25)[i];
        float a = fabsf(ARG(23)[i]), b_ = fabsf(ARG(25)[i]), c_ = fabsf(ARG(24)[i & 31]), d_ = fabsf(ARG(26)[i & 31]);
#pragma unroll
        for (int o_ = 1; o_ < 64; o_ <<= 1) { a = fmaxf(a, shx(a, o_, i)); b_ = fmaxf(b_, shx(b_, o_, i)); c_ = fmaxf(c_, shx(c_, o_, i)); d_ = fmaxf(d_, shx(d_, o_, i)); }
        const float bound = (64.f * a * b_ + 32.f * c_ * d_) * (0.10206207261596575f * 1.4426950408889634f);
        if (i == 0) hp[448] = (bound < 64.f && fmaxf(fmaxf(a, b_), fmaxf(c_, d_)) < 3.f) ? 1.f : 0.f;
    }
    if (F.bx == 2 % F.G) {
        GAS v4u* z = (GAS v4u*)((bf16*)(F.ws + WS_WIN) + (size_t)672 * DM);
        unsigned zz = 0u; asm volatile("" : "+v"(zz));
        for (int e = F.tid; e < 96 * DM / 8; e += NWAVES * 64) z[e] = (v4u){zz, zz, zz, zz};
    }
}

__device__ __forceinline__ void norm_phase(Frame& F, const float* src_lat, const float* src_ctx, int nrows, const float* gw_, int layer, int which  , bool from_partials, const float* parts = nullptr, int nparts = 0, bool lat_bf16 = false) {
    LAS float* gl = (LAS float*)(F.lds + RING_OFF); LAS float* scl = gl + 1024; LAS float* shl = scl + 3 * 1024;
    const float* modp = (const float*)(F.ws + WS_MODP); const float* mod = (const float*)(F.ws + WS_MOD); const float* ada_b = ARG(5);
    const int offsh = which * 3072, offsc = which * 3072 + 1024;
    for (int i = F.tid; i < 1024; i += NWAVES * 64) {
        gl[i] = gw_[i];
#pragma unroll
        for (int cnd = 0; cnd < 3; ++cnd) {
            float sh, sc;
            if (from_partials) { sh = ada_b[layer * 6144 + offsh + i]; sc = ada_b[layer * 6144 + offsc + i];
                float ph[ADA_KS], pc[ADA_KS];
#pragma unroll
                for (int ks = 0; ks < ADA_KS; ++ks) { const float* p = modp + ((size_t)(ks * 2 + layer) * 3 + cnd) * 6144; ph[ks] = p[offsh + i]; pc[ks] = p[offsc + i]; }
#pragma unroll
                for (int ks = 0; ks < ADA_KS; ++ks) { sh += ph[ks]; sc += pc[ks]; } }
            else { sh = mod[(layer * 3 + cnd) * 6144 + offsh + i]; sc = mod[(layer * 3 + cnd) * 6144 + offsc + i]; }
            scl[cnd * 1024 + i] = 1.f + sc; shl[cnd * 1024 + i] = sh;
        }
    }
    if (from_partials) {
        float* modw = (float*)(F.ws + WS_MOD);
        for (int e = F.vcu * (NWAVES * 64) + F.tid; e < 2 * 3 * 6144; e += F.G * NWAVES * 64) {
            const int l = e / (3 * 6144), rem = e % (3 * 6144), cnd = rem / 6144, col = rem % 6144;
            float v = ada_b[l * 6144 + col];
            float pv[ADA_KS];
#pragma unroll
            for (int ks = 0; ks < ADA_KS; ++ks) pv[ks] = modp[((size_t)(ks * 2 + l) * 3 + cnd) * 6144 + col];
#pragma unroll
            for (int ks = 0; ks < ADA_KS; ++ks) v += pv[ks];
            modw[e] = v;
        }
    }
    __syncthreads();
    bf16* XN = (bf16*)(F.ws + WS_XN);
    const int gw = F.vcu * NWAVES + F.wave, NGW = F.G * NWAVES;
    for (int m = gw; m < nrows; m += NGW) {
        const float* xrow = m < ML ? src_lat + (size_t)m * DM : src_ctx + (size_t)(m - ML) * DM;
        const int cnd = m < SEQ ? 0 : (m < ML ? 1 : 2);
        const GAS f32x4* xr = (const GAS f32x4*)xrow + F.lane;
        f32x4 v[4]; float s = 0.f;
        if (lat_bf16 && m < ML) {
            const GAS v2u* xb = (const GAS v2u*)((const bf16*)src_lat + (size_t)m * DM) + F.lane;
            v2u w[4];
#pragma unroll
            for (int j = 0; j < 4; ++j) w[j] = xb[64 * j];
#pragma unroll
            for (int j = 0; j < 4; ++j) v[j] = f32x4{bflo(w[j].x), bfhi(w[j].x), bflo(w[j].y), bfhi(w[j].y)};
        } else {
#pragma unroll
            for (int j = 0; j < 4; ++j) v[j] = xr[64 * j];
        }
        if (nparts > 0 && m >= ML) {
            for (int p = 0; p < nparts; p += 4) {
                const GAS f32x4* pr = (const GAS f32x4*)(parts + (size_t)p * (512 * 1024) + (size_t)(m - ML) * DM) + F.lane;
                f32x4 w[4][4];
#pragma unroll
                for (int q = 0; q < 4; ++q)
#pragma unroll
                    for (int j = 0; j < 4; ++j) w[q][j] = pr[(size_t)q * (512 * 1024 / 4) + 64 * j];
#pragma unroll
                for (int j = 0; j < 4; ++j) v[j] += (w[0][j] + w[1][j]) + (w[2][j] + w[3][j]); }
            GAS f32x4* cr = (GAS f32x4*)((float*)(F.ws + WS_CTXRES) + (size_t)(m - ML) * DM) + F.lane;
#pragma unroll
            for (int j = 0; j < 4; ++j) cr[64 * j] = v[j];
        }
#pragma unroll
        for (int j = 0; j < 4; ++j) s += (v[j].x * v[j].x + v[j].y * v[j].y) + (v[j].z * v[j].z + v[j].w * v[j].w);
        const float rstd = 1.f / sqrtf(wave_sum(s, F.lane) * (1.f / DM) + NORM_EPS);
        if (from_partials && m >= ML) { GAS f32x4* cr = (GAS f32x4*)((float*)(F.ws + WS_CTXRES) + (size_t)(m - ML) * DM) + F.lane;
#pragma unroll
            for (int j = 0; j < 4; ++j) cr[64 * j] = v[j]; }
        GAS v2u* o8 = (GAS v2u*)(XN + (size_t)m * DM) + F.lane;
#pragma unroll
        for (int j = 0; j < 4; ++j) { const int col = 4 * F.lane + 256 * j;
            const f32x4 g = *(const LAS f32x4*)(gl + col), sc = *(const LAS f32x4*)(scl + cnd * 1024 + col), sh = *(const LAS f32x4*)(shl + cnd * 1024 + col);
            const f32x4 y = (v[j] * rstd) * g * sc + sh;
            v2u w; w.x = pk2(y.x, y.y); w.y = pk2(y.z, y.w); o8[64 * j] = w; }
    }
    __syncthreads();
}

__device__ __forceinline__ void unpack8(const v4u w, float (&x)[8]) { x[0] = bflo(w.x); x[1] = bfhi(w.x); x[2] = bflo(w.y); x[3] = bfhi(w.y); x[4] = bflo(w.z); x[5] = bfhi(w.z); x[6] = bflo(w.w); x[7] = bfhi(w.w); }
__device__ __forceinline__ v4u pack8(const float (&x)[8]) { v4u w; w.x = pk2(x[0], x[1]); w.y = pk2(x[2], x[3]); w.z = pk2(x[4], x[5]); w.w = pk2(x[6], x[7]); return w; }

__device__ __forceinline__ void qknorm_phase(Frame& F) {
    bf16* QKV = (bf16*)(F.ws + WS_QKV);
    const float* rt = (const float*)(F.ws + WS_ROPE);
    const float* nw[4] = {ARG(12), ARG(13), ARG(15), ARG(16)};
    const float qscale = 0.125f * att::LOG2E;
    const int gw = F.vcu * NWAVES + F.wave, NGW = F.G * NWAVES;
    const int lane = F.lane, grp = lane >> 3, l8 = lane & 7;
    for (int m = gw; m < MR; m += NGW) {
        const bool lat = m < ML; const int t = m & (SEQ - 1); const int prow = t >> 6, pcol = t & 63;
        GAS v4u* rowp = (GAS v4u*)(QKV + (size_t)m * NQKV);
#pragma unroll
        for (int pass = 0; pass < 4; ++pass) {
            int type;
            if (pass == 0) type = 1; else if (pass == 1) type = grp < 2 ? 2 : (grp < 4 ? 0 : 3); else if (pass == 2) type = grp < 4 ? 3 : 4; else type = grp < 4 ? 4 : 0;
            const v4u w = rowp[pass * 64 + lane];
            float x[8]; unpack8(w, x);
            float ss = 0.f;
#pragma unroll
            for (int j = 0; j < 8; ++j) ss += x[j] * x[j];
            ss += shx(ss, 1, F.lane); ss += shx(ss, 2, F.lane); ss += shx(ss, 4, F.lane);
            const float rstd = 1.f / sqrtf(ss * (1.f / 64.f) + NORM_EPS);
            const float* g = type == 1 ? nw[0] : (type == 2 ? nw[1] : (type == 3 ? nw[2] : nw[3]));
            const f32x4 g0 = *(const GAS f32x4*)(g + l8 * 8), g1 = *(const GAS f32x4*)(g + l8 * 8 + 4);
            x[0] *= rstd * g0.x; x[1] *= rstd * g0.y; x[2] *= rstd * g0.z; x[3] *= rstd * g0.w; x[4] *= rstd * g1.x; x[5] *= rstd * g1.y; x[6] *= rstd * g1.z; x[7] *= rstd * g1.w;
            float px[8];
#pragma unroll
            for (int j = 0; j < 8; ++j) px[j] = shx(x[j], 2, F.lane);
            if (lat && (type == 1 || type == 2)) {
                const int pos = (l8 & 4) ? pcol : prow; const float* cs = rt + pos * 16 + (l8 & 1) * 8;
                const f32x4 c0 = *(const GAS f32x4*)(cs), c1 = *(const GAS f32x4*)(cs + 4), s0 = *(const GAS f32x4*)(cs + 2048), s1 = *(const GAS f32x4*)(cs + 2052);
                const float cc[8] = {c0.x, c0.y, c0.z, c0.w, c1.x, c1.y, c1.z, c1.w}, sn[8] = {s0.x, s0.y, s0.z, s0.w, s1.x, s1.y, s1.z, s1.w};
                const float sgn = (l8 & 2) ? 1.f : -1.f;
#pragma unroll
                for (int j = 0; j < 8; ++j) x[j] = x[j] * cc[j] + sgn * px[j] * sn[j];
            }
            if (type == 1 || type == 3) {
#pragma unroll
                for (int j = 0; j < 8; ++j) x[j] *= qscale;
            }
            if (type != 0) rowp[pass * 64 + lane] = pack8(x);
        }
    }
}

__device__ __forceinline__ void cnorm_phase(Frame& F) {
    const bf16* CQKV = (const bf16*)(F.ws + WS_CQKV); bf16* CQN = (bf16*)(F.ws + WS_CQN); bf16* CKVN = (bf16*)(F.ws + WS_CKVN); bf16* KR = (bf16*)(F.ws + WS_KR);
    const float* rt = (const float*)(F.ws + WS_ROPE) + 4096;
    const float* gq = ARG(19); const float* gkv = ARG(20); const float* gkr = ARG(26);
    const int gw = F.vcu * NWAVES + F.wave, NGW = F.G * NWAVES; const int lane = F.lane;
    for (int m = gw; m < MR; m += NGW) {
        const bool lat = m < ML; const int t = m & (SEQ - 1); const int prow = t >> 6, pcol = t & 63;
        const GAS v4u* rowp = (const GAS v4u*)(CQKV + (size_t)m * NCIN);
        const v4u w0 = rowp[lane]; v4u w1 = {0u, 0u, 0u, 0u}; if (lane < 32) w1 = rowp[64 + lane];
        float x0[8], x1[8]; unpack8(w0, x0); unpack8(w1, x1);
        float s0 = 0.f, s1 = 0.f;
#pragma unroll
        for (int j = 0; j < 8; ++j) { s0 += x0[j] * x0[j]; s1 += x1[j] * x1[j]; }
        const float ssq = wave_sum(lane < 48 ? s0 : 0.f, F.lane);
        const float sskv = wave_sum((lane >= 48 ? s0 : 0.f) + (lane < 16 ? s1 : 0.f), F.lane);
        const float sskr = wave_sum((lane >= 16 && lane < 20) ? s1 : 0.f, F.lane);
        const float rq = 1.f / sqrtf(ssq * (1.f / 384.f) + NORM_EPS), rkv = 1.f / sqrtf(sskv * (1.f / 256.f) + NORM_EPS), rkr = 1.f / sqrtf(sskr * (1.f / 32.f) + NORM_EPS);
        { const float* g = lane < 48 ? gq + lane * 8 : gkv + (lane - 48) * 8; const float r = lane < 48 ? rq : rkv;
          const f32x4 g0 = *(const GAS f32x4*)(g), g1 = *(const GAS f32x4*)(g + 4);
          float y[8] = {x0[0] * r * g0.x, x0[1] * r * g0.y, x0[2] * r * g0.z, x0[3] * r * g0.w, x0[4] * r * g1.x, x0[5] * r * g1.y, x0[6] * r * g1.z, x0[7] * r * g1.w};
          if (lane < 48) *(GAS v4u*)(CQN + (size_t)m * 384 + lane * 8) = pack8(y); else *(GAS v4u*)(CKVN + (size_t)m * 256 + (lane - 48) * 8) = pack8(y); }
        { const int li = lane < 16 ? lane : (lane < 20 ? lane - 16 : 0);
          const float* g = lane < 16 ? gkv + 128 + li * 8 : gkr + li * 8; const float r = lane < 16 ? rkv : rkr;
          const f32x4 g0 = *(const GAS f32x4*)(g), g1 = *(const GAS f32x4*)(g + 4);
          float y[8] = {x1[0] * r * g0.x, x1[1] * r * g0.y, x1[2] * r * g0.z, x1[3] * r * g0.w, x1[4] * r * g1.x, x1[5] * r * g1.y, x1[6] * r * g1.z, x1[7] * r * g1.w};
          float py[8];
#pragma unroll
          for (int j = 0; j < 8; ++j) py[j] = shx(y[j], 1, F.lane);
          if (lat && lane >= 16 && lane < 20) {
              const int pos = (lane & 2) ? pcol : prow; const float* cs = rt + pos * 8;
              const f32x4 c0 = *(const GAS f32x4*)(cs), c1 = *(const GAS f32x4*)(cs + 4), sa = *(const GAS f32x4*)(cs + 1024), sb = *(const GAS f32x4*)(cs + 1028);
              const float cc[8] = {c0.x, c0.y, c0.z, c0.w, c1.x, c1.y, c1.z, c1.w}, sn[8] = {sa.x, sa.y, sa.z, sa.w, sb.x, sb.y, sb.z, sb.w};
              const float sgn = (lane & 1) ? 1.f : -1.f;
#pragma unroll
              for (int j = 0; j < 8; ++j) y[j] = y[j] * cc[j] + sgn * py[j] * sn[j];
          }
          if (lane < 16) *(GAS v4u*)(CKVN + (size_t)m * 256 + 128 + lane * 8) = pack8(y);
          else if (lane < 20) *(GAS v4u*)(KR + (size_t)m * 32 + (lane - 16) * 8) = pack8(y); }
    }
}

__device__ __forceinline__ void hnorm_phase(Frame& F) {
    bf16* Q = (bf16*)(F.ws + WS_Q1); bf16* KV = (bf16*)(F.ws + WS_KV1);
    const float* rt = (const float*)(F.ws + WS_ROPE) + 4096;
    const float* gqn = ARG(23); const float* gqr = ARG(24); const float* gkn = ARG(25);
    const float qscale = 0.10206207261596575f * att::LOG2E;
    const int gw = F.vcu * NWAVES + F.wave, NGW = F.G * NWAVES; const int lane = F.lane, l8 = lane & 7, l4 = lane & 3;
    for (int m = gw; m < MR; m += NGW) {
        const bool lat = m < ML; const int t = m & (SEQ - 1); const int prow = t >> 6, pcol = t & 63;
        { GAS v4u* rowp = (GAS v4u*)(KV + (size_t)m * NUKV);
          const f32x4 g0 = *(const GAS f32x4*)(gkn + l8 * 8), g1 = *(const GAS f32x4*)(gkn + l8 * 8 + 4);
#pragma unroll
          for (int pass = 0; pass < 2; ++pass) {
              float x[8]; unpack8(rowp[pass * 64 + lane], x); float ss = 0.f;
#pragma unroll
              for (int j = 0; j < 8; ++j) ss += x[j] * x[j];
              ss += shx(ss, 1, F.lane); ss += shx(ss, 2, F.lane); ss += shx(ss, 4, F.lane);
              const float r = 1.f / sqrtf(ss * (1.f / 64.f) + NORM_EPS);
              x[0] *= r * g0.x; x[1] *= r * g0.y; x[2] *= r * g0.z; x[3] *= r * g0.w; x[4] *= r * g1.x; x[5] *= r * g1.y; x[6] *= r * g1.z; x[7] *= r * g1.w;
              rowp[pass * 64 + lane] = pack8(x); } }
        if (lat) {
            GAS v4u* rowp = (GAS v4u*)(Q + (size_t)m * NUQ);
            { const f32x4 g0 = *(const GAS f32x4*)(gqn + l8 * 8), g1 = *(const GAS f32x4*)(gqn + l8 * 8 + 4);
#pragma unroll
              for (int pass = 0; pass < 2; ++pass) {
                  float x[8]; unpack8(rowp[pass * 64 + lane], x); float ss = 0.f;
#pragma unroll
                  for (int j = 0; j < 8; ++j) ss += x[j] * x[j];
                  ss += shx(ss, 1, F.lane); ss += shx(ss, 2, F.lane); ss += shx(ss, 4, F.lane);
                  const float r = qscale / sqrtf(ss * (1.f / 64.f) + NORM_EPS);
                  x[0] *= r * g0.x; x[1] *= r * g0.y; x[2] *= r * g0.z; x[3] *= r * g0.w; x[4] *= r * g1.x; x[5] *= r * g1.y; x[6] *= r * g1.z; x[7] *= r * g1.w;
                  rowp[pass * 64 + lane] = pack8(x); } }
            {
              const f32x4 g0 = *(const GAS f32x4*)(gqr + l4 * 8), g1 = *(const GAS f32x4*)(gqr + l4 * 8 + 4);
              float x[8]; unpack8(rowp[128 + lane], x); float ss = 0.f;
#pragma unroll
              for (int j = 0; j < 8; ++j) ss += x[j] * x[j];
              ss += shx(ss, 1, F.lane); ss += shx(ss, 2, F.lane);
              const float r = 1.f / sqrtf(ss * (1.f / 32.f) + NORM_EPS);
              x[0] *= r * g0.x; x[1] *= r * g0.y; x[2] *= r * g0.z; x[3] *= r * g0.w; x[4] *= r * g1.x; x[5] *= r * g1.y; x[6] *= r * g1.z; x[7] *= r * g1.w;
              float px[8];
#pragma unroll
              for (int j = 0; j < 8; ++j) px[j] = shx(x[j], 1, F.lane);
              const int pos = (l4 & 2) ? pcol : prow; const float* cs = rt + pos * 8;
              const f32x4 c0 = *(const GAS f32x4*)(cs), c1 = *(const GAS f32x4*)(cs + 4), sa = *(const GAS f32x4*)(cs + 1024), sb = *(const GAS f32x4*)(cs + 1028);
              const float cc[8] = {c0.x, c0.y, c0.z, c0.w, c1.x, c1.y, c1.z, c1.w}, sn[8] = {sa.x, sa.y, sa.z, sa.w, sb.x, sb.y, sb.z, sb.w};
              const float sgn = (l4 & 1) ? 1.f : -1.f;
#pragma unroll
              for (int j = 0; j < 8; ++j) x[j] = (x[j] * cc[j] + sgn * px[j] * sn[j]) * qscale;
              rowp[128 + lane] = pack8(x); }
        }
    }
}

__device__ __forceinline__ void kr6_pass(Frame& F) {
    if (((const float*)(F.ws + WS_HPAR))[448] == 0.f) return;
    const bf16* KR = (const bf16*)(F.ws + WS_KR); unsigned char* K6R = (unsigned char*)(F.ws + WS_K6R);
    for (int r = F.vcu * (NWAVES * 64) + F.tid; r < MR; r += F.G * (NWAVES * 64)) {
        const GAS v4u* rp = (const GAS v4u*)(KR + (size_t)r * 32);
        v4u w[4] = {rp[0], rp[1], rp[2], rp[3]};
#pragma unroll
        for (int q = 0; q < 4; ++q) { float x[8]; unpack8(w[q], x);
#pragma unroll
            for (int j = 0; j < 8; ++j) x[j] *= 1.5349124f;
            w[q] = pack8(x); }
        const attd::u32x6 c = attd::to_fp6(w[0], w[1], w[2], w[3]);
        unsigned char* img = K6R + (size_t)(r >> 6) * 2048; const int key = r & 63;
        *(GAS v4u*)(img + key * 16) = (v4u){c[0], c[1], c[2], c[3]}; *(GAS v2u*)(img + 1024 + key * 8) = (v2u){c[4], c[5]};
    }
}
__device__ __forceinline__ void attn0_phase(Frame& F) {
    att::lchar* lds = (att::lchar*)(F.lds + RING_OFF);
    const att::bf16* QKV = (const att::bf16*)(F.ws + WS_QKV); att::bf16* O = (att::bf16*)(F.ws + WS_O0);
    bool fast;
    { float a = fabsf(ARG(12)[F.lane]), b_ = fabsf(ARG(13)[F.lane]), c_ = fabsf(ARG(15)[F.lane]), d_ = fabsf(ARG(16)[F.lane]), e_ = 0.f, f_ = fabsf(ARG(14)[F.lane & 7]);
      for (int i = F.lane; i < 8 * 465; i += 64) e_ = fmaxf(e_, fabsf(ARG(17)[i]));
#pragma unroll
      for (int o_ = 1; o_ < 64; o_ <<= 1) { a = fmaxf(a, shx(a, o_, F.lane)); b_ = fmaxf(b_, shx(b_, o_, F.lane)); c_ = fmaxf(c_, shx(c_, o_, F.lane)); d_ = fmaxf(d_, shx(d_, o_, F.lane)); e_ = fmaxf(e_, shx(e_, o_, F.lane)); f_ = fmaxf(f_, shx(f_, o_, F.lane)); }
      const float bound = fmaxf(fmaxf(8.f * a * b_, 8.f * c_ * d_ + e_), f_) * att::LOG2E;
      fast = __builtin_amdgcn_readfirstlane(bound < 64.f ? 1 : 0) != 0; }
    char* shm = (char*)(F.lds + RING_OFF);
    for (int ui = F.vcu; ui < 1056; ui += F.G) {
        if (ui < 512) {
            const int b = ui >> 8, h = (ui >> 5) & 7, R4 = ui & 31;
            const float* rpb = ARG(17) + h * 465;
            if (fast) {
                float* rl = (float*)(shm + attf::LDS_RPB);
                for (int i = F.tid; i < 465; i += NWAVES * 64) rl[i] = rpb[i] * att::LOG2E;
                __syncthreads();
                attf::FNa fu; fu.init((const attf::bf16*)QKV, (attf::bf16*)O, rl, b, h, R4);
                attf::fast_unit<8, attf::FNa>(fu, shm, F.tid);
            } else {
                att::UNa u; u.QKV = QKV; u.O = O; u.rpbl = (const LAS float*)(lds + att::L_RPB); u.b = b; u.h = h; u.R4 = R4; u.init();
                for (int i = F.tid; i < 465; i += NWAVES * 64) ((LAS float*)(lds + att::L_RPB))[i] = rpb[i] * att::LOG2E;
                att::unit<8, att::UNa>(u, lds, F.tid);
            }
        } else if (ui < 1024) {
            const int v = ui - 512;
            if (fast) { attf::FWin fu; fu.init((const attf::bf16*)QKV, (attf::bf16*)O, ARG(14), v >> 8, (v >> 2) & 63, (v >> 1) & 1, v & 1); attf::fast_unit<8, attf::FWin>(fu, shm, F.tid); }
            else { att::UWin u; u.QKV = QKV; u.O = O; u.sinkp = ARG(14); u.b = v >> 8; u.n = (v >> 2) & 63; u.g = (v >> 1) & 1; u.hh = v & 1; u.init(); att::unit<8, att::UWin>(u, lds, F.tid); }
        } else {
            const int v = ui - 1024;
            if (fast) { attf::FCtx fu; fu.init((const attf::bf16*)QKV, (attf::bf16*)O, ARG(14), v >> 4, v & 15); attf::fast_unit<8, attf::FCtx>(fu, shm, F.tid); }
            else { att::UCtx u; u.QKV = QKV; u.O = O; u.sinkp = ARG(14); u.b = v >> 4; u.hx = v & 15; u.init(); att::unit<8, att::UCtx>(u, lds, F.tid); }
        }
    }
}
__device__ __forceinline__ void attn1_phase(Frame& F) {
    att::lchar* lds = (att::lchar*)(F.lds + RING_OFF);
    const bool fast = __builtin_amdgcn_readfirstlane(__builtin_bit_cast(int, ((const float*)(F.ws + WS_HPAR))[448])) != 0;
    const bool g256 = F.G == 256; const int x = F.vcu >> 5, j = F.vcu & 31;
    const int nit = g256 ? 4 : (F.vcu < 1024 ? (1024 - F.vcu + F.G - 1) / F.G : 0);
    for (int i = 0; i < nit; ++i) {
        const int ui = g256 ? ((x * 4 + i) * 32 + j) : F.vcu + i * F.G;
        if (fast) attd::dense_unit(ui >> 9, (ui >> 5) & 15, ui & 31, (const attd::bf16*)(F.ws + WS_Q1), (const attd::bf16*)(F.ws + WS_KV1), (const char*)(F.ws + WS_K6N), (const char*)(F.ws + WS_K6R), (attd::bf16*)(F.ws + WS_O1), (char*)(F.lds + RING_OFF), F.tid);
        else {
        att::UDense u; u.Q = (const att::bf16*)(F.ws + WS_Q1); u.KV = (const att::bf16*)(F.ws + WS_KV1); u.KR = (const att::bf16*)(F.ws + WS_KR); u.O = (att::bf16*)(F.ws + WS_O1);
        u.b = ui >> 9; u.h = (ui >> 5) & 15; u.qb = ui & 31;
        att::unit<12, att::UDense>(u, lds, F.tid); }
    }
}

#ifndef PHASE_MASK
#define PHASE_MASK 0xFFFFFu
#endif
#ifndef PHASE_REP
#define PHASE_REP 0u
#endif
struct Args { const float* in[28]; float* out; unsigned char* ws; int ph_lo, ph_hi; };
constexpr int N_PHASES = 19;
__global__ void __launch_bounds__(NWAVES * 64, 2) fwd_kernel(Args args) {
    extern __shared__ __attribute__((aligned(16))) unsigned char lds[];
    for (int u = threadIdx.x; u < (LDS_BYTES - LDSCTL_OFF) / 4; u += NWAVES * 64) ((LAS unsigned*)((LAS unsigned char*)lds + LDSCTL_OFF))[u] = 0u;
    __syncthreads();
    if (!MK_PER_PHASE) (void)xcd_barrier_post((unsigned*)((gu32*)(ARG_WS + WS_CTL) + CW_BAR), (volatile LAS unsigned*)((LAS unsigned char*)lds + MISC_OFF) + 8);
    for (int ph2 = 2 * args.ph_lo; ph2 < 2 * args.ph_hi; ++ph2) {
        const int ph = ph2 >> 1; if ((ph2 & 1) && !((PHASE_REP >> ph) & 1)) continue;
        if (ph == 3 || ph == 14) continue;
        Frame F;
        { int t_ = threadIdx.x; asm volatile("" : "+v"(t_)); int b_ = blockIdx.x; asm volatile("" : "+s"(b_)); int g_ = gridDim.x; asm volatile("" : "+s"(g_)); F.tid = t_; F.bx = b_; F.G = g_; }
        F.lds = (LAS unsigned char*)lds; F.MISC = (volatile LAS unsigned*)(F.lds + MISC_OFF);
        F.lane = F.tid & 63; F.wave = __builtin_amdgcn_readfirstlane(F.tid >> 6);
        F.vcu = (F.G % 8 == 0) ? (F.bx % 8) * (F.G / 8) + F.bx / 8 : F.bx;
        F.ws = ARG_WS; F.out = ARG_OUT; F.ctl = (gu32*)(F.ws + WS_CTL);
        XcdBarrier bar; bar.bar = (unsigned*)(F.ctl + CW_BAR); bar.x = xb_xcc_id(); bar.st = F.MISC + 8;
        float* ctxres = (float*)(F.ws + WS_CTXRES);
        const float* mod = (const float*)(F.ws + WS_MOD);
        int gk = 0, xrows = 0, xS = 0;
        pg8::Gemm g{nullptr, nullptr, 0, 0, 0}; pg8::EpiAny ea{0, nullptr, nullptr, nullptr, nullptr, 0, 0};
        switch (ph) {
        case 0: if (!((PHASE_MASK >> 0) & 1)) break; p0_prologue(F); break;
        case 1: if (!((PHASE_MASK >> 1) & 1)) break; norm_phase(F, ARG(0), ARG(2), MR, ARG(6), 0, 0, true); break;
        case 2: if (!((PHASE_MASK >> 2) & 1)) break; gk = 1; g = pg8::Gemm{(const bf16*)(F.ws + WS_XN), (const bf16*)(F.ws + WS_WQKV), MR, NQKV, DM}; ea = pg8::EpiAny{3, (const float*)(F.ws + WS_HPAR), (void*)(F.ws + WS_QKV), nullptr, (const float*)(F.ws + WS_ROPE), NQKV, 0}; break;
        case 4: if (!((PHASE_MASK >> 4) & 1)) break; attn0_phase(F); break;
        case 5: if (!((PHASE_MASK >> 5) & 1)) break; gk = 2; g = pg8::Gemm{(const bf16*)(F.ws + WS_O0), (const bf16*)(F.ws + WS_WO0), ML, DM, DM}; xrows = MC; xS = 2; ea = pg8::EpiAny{2, ARG(0), (void*)F.out, (float*)(F.ws + WS_PART5), mod + 2048, 0, 2}; break;
        case 6: if (!((PHASE_MASK >> 6) & 1)) break; norm_phase(F, F.out, ctxres, MR, ARG(7), 0, 1, false, (const float*)(F.ws + WS_PART5), 4, true); break;
        case 7: if (!((PHASE_MASK >> 7) & 1)) break; gk = 1; g = pg8::Gemm{(const bf16*)(F.ws + WS_XN), (const bf16*)(F.ws + WS_W1_0), MR, FF, DM}; ea = pg8::EpiAny{1, nullptr, (void*)(F.ws + WS_H), nullptr, nullptr, FF, 1}; break;
        case 8: if (!((PHASE_MASK >> 8) & 1)) break; gk = 2; g = pg8::Gemm{(const bf16*)(F.ws + WS_H), (const bf16*)(F.ws + WS_W2_0), ML, DM, FF}; xrows = MC; xS = 4; ea = pg8::EpiAny{2, F.out, (void*)F.out, (float*)(F.ws + WS_PART8), mod + 5120, 0, 3}; break;
        case 9: if (!((PHASE_MASK >> 9) & 1)) break; norm_phase(F, F.out, ctxres, MR, ARG(6) + DM, 1, 0, false, (const float*)(F.ws + WS_PART8), 16, true); break;
        case 10: if (!((PHASE_MASK >> 10) & 1)) break; gk = 1; g = pg8::Gemm{(const bf16*)(F.ws + WS_XN), (const bf16*)(F.ws + WS_WIN), MR, NCIN, DM}; ea = pg8::EpiAny{1, nullptr, (void*)(F.ws + WS_CQKV), nullptr, nullptr, NCIN, 0}; break;
        case 11: if (!((PHASE_MASK >> 11) & 1)) break; cnorm_phase(F); break;
        case 12: if (!((PHASE_MASK >> 12) & 1)) break; kr6_pass(F); gk = 1; g = pg8::Gemm{(const bf16*)(F.ws + WS_CQN), (const bf16*)(F.ws + WS_WUQ), ML, NUQ, 384}; ea = pg8::EpiAny{3, (const float*)(F.ws + WS_HPAR), (void*)(F.ws + WS_Q1), nullptr, (const float*)(F.ws + WS_ROPE), NUQ, 1}; break;
        case 13: if (!((PHASE_MASK >> 13) & 1)) break; gk = 1; g = pg8::Gemm{(const bf16*)(F.ws + WS_CKVN), (const bf16*)(F.ws + WS_WUKV), MR, NUKV, 256}; ea = pg8::EpiAny{3, (const float*)(F.ws + WS_HPAR), (void*)(F.ws + WS_KV1), (float*)(F.ws + WS_K6N), (const float*)(F.ws + WS_ROPE), NUKV, 2}; break;
        case 15: if (!((PHASE_MASK >> 15) & 1)) break; attn1_phase(F); break;
        case 16: if (!((PHASE_MASK >> 16) & 1)) break; gk = 2; g = pg8::Gemm{(const bf16*)(F.ws + WS_O1), (const bf16*)(F.ws + WS_WO1), ML, DM, DM}; ea = pg8::EpiAny{2, F.out, (void*)(F.ws + WS_XR), ctxres, mod + 3 * 6144 + 2048, 0, 3}; break;
        case 17: if (!((PHASE_MASK >> 17) & 1)) break; norm_phase(F, (const float*)(F.ws + WS_XR), ctxres, ML, ARG(7) + DM, 1, 1, false, nullptr, 0, true); break;
        case 18: if (!((PHASE_MASK >> 18) & 1)) break; gk = 1; g = pg8::Gemm{(const bf16*)(F.ws + WS_XN), (const bf16*)(F.ws + WS_W1_1), ML, FF, DM}; ea = pg8::EpiAny{1, nullptr, (void*)(F.ws + WS_H), nullptr, nullptr, FF, 1}; break;
        case 19: if (!((PHASE_MASK >> 19) & 1)) break; gk = 2; g = pg8::Gemm{(const bf16*)(F.ws + WS_H), (const bf16*)(F.ws + WS_W2_1), ML, DM, FF}; ea = pg8::EpiAny{2, (const float*)(F.ws + WS_XR), (void*)F.out, ctxres, mod + 3 * 6144 + 5120, 0, 1}; break;
        default: break;
        }
        ea.scr = F.lds + LDSCTL_OFF + 4096;
        if (gk != 0) { pg8::StaticOrder S; S.init(g.M, g.N, g.K, F.G, F.bx, xrows, xS); pg8::gemm_phase<pg8::EpiAny, pg8::StaticOrder, true, true>(F.lds + RING_OFF, g, S, ea, F.tid); }
        const bool last_ = (ph == args.ph_hi - 1) && ((ph2 & 1) || !((PHASE_REP >> ph) & 1));
        if (!MK_PER_PHASE && !last_ && ph != 12) xcd_barrier(bar);
        else __syncthreads();
    }
}

extern "C" void kernel_launch(void* const* d_in, const int* in_sizes, int n_in, void* d_out, int out_size, void* d_ws, size_t ws_size, hipStream_t stream) {
    static int grid = 0;
    if (grid == 0) {
        if (n_in != 28 || in_sizes[0] != ML * DM || out_size != ML * DM || ws_size < WS_END) { fprintf(stderr, "kernel_launch: unexpected shapes: n_in %d in0 %d out %d ws %zu\n", n_in, n_in > 0 ? in_sizes[0] : -1, out_size, ws_size); grid = -1; return; }
        int dev = 0, cus = 0, per_cu = 0;
        if (hipGetDevice(&dev) != hipSuccess || hipDeviceGetAttribute(&cus, hipDeviceAttributeMultiprocessorCount, dev) != hipSuccess) { fprintf(stderr, "kernel_launch: device query failed\n"); grid = -1; return; }
        if (hipFuncSetAttribute((const void*)fwd_kernel, hipFuncAttributeMaxDynamicSharedMemorySize, LDS_BYTES) != hipSuccess) { fprintf(stderr, "kernel_launch: hipFuncSetAttribute failed\n"); grid = -1; return; }
        if (hipOccupancyMaxActiveBlocksPerMultiprocessor(&per_cu, (const void*)fwd_kernel, NWAVES * 64, LDS_BYTES) != hipSuccess || per_cu < 1)
            fprintf(stderr, "kernel_launch: note: occupancy query reports %d workgroups per CU\n", per_cu);
        (void)hipGetLastError();
        grid = cus;
    }
    if (grid < 0) return;
    if (hipMemsetAsync((char*)d_ws + WS_CTL, 0, CTL_ZERO_BYTES, stream) != hipSuccess) { fprintf(stderr, "kernel_launch: hipMemsetAsync failed\n"); return; }
    Args a{};
    for (int i = 0; i < 28; ++i) a.in[i] = (const float*)d_in[i];
    a.out = (float*)d_out; a.ws = (unsigned char*)d_ws;
#if MK_PER_PHASE
    for (int ph = 0; ph <= N_PHASES; ++ph) { a.ph_lo = ph; a.ph_hi = ph + 1; hipLaunchKernelGGL(fwd_kernel, dim3(grid), dim3(NWAVES * 64), LDS_BYTES, stream, a); }
#else
    a.ph_lo = 0; a.ph_hi = N_PHASES + 1;
    hipLaunchKernelGGL(fwd_kernel, dim3(grid), dim3(NWAVES * 64), LDS_BYTES, stream, a);
#endif
    const hipError_t le = hipPeekAtLastError();
    if (le != hipSuccess) fprintf(stderr, "kernel_launch: launch failed: %s\n", hipGetErrorName(le));
}
```

```cpp
#include <hip/hip_runtime.h>
#include <cstdio>
#include <cstdint>
namespace pg8 {
#define PG8_LAS __attribute__((address_space(3)))
typedef unsigned short bf16_t;
typedef short bf16x8 __attribute__((ext_vector_type(8)));
typedef float f32x4 __attribute__((ext_vector_type(4)));
typedef unsigned u32x4 __attribute__((ext_vector_type(4)));
typedef unsigned u32x2 __attribute__((ext_vector_type(2)));
typedef unsigned u32x6 __attribute__((ext_vector_type(6)));
typedef unsigned u32x16 __attribute__((ext_vector_type(16)));
typedef __bf16 bf16x32 __attribute__((ext_vector_type(32)));
constexpr int BM = 256, BK = 64, HALF = 128, HTB = HALF * BK * 2  , STAGE_BYTES = 8 * HTB, NXCD = 8, WGM = 8;

__host__ __device__ __forceinline__ int lds_byte(int r, int c) { const int st = (r >> 4) * 2 + (c >> 5), rr = r & 15, cc = c & 31, ob = rr * 64 + cc * 2; return st * 1024 + (ob ^ (((ob >> 9) & 1) << 5)); }
__host__ __device__ __forceinline__ void stage_rc(int b, int& R, int& C) { const int st = b / 1024, sb = b % 1024, swz = sb ^ (((sb >> 9) & 1) << 5); R = (st >> 1) * 16 + swz / 64; C = (st & 1) * 32 + (swz % 64) / 2; }
__host__ __device__ __forceinline__ int perm32(int rho) { const int n = rho >> 4, i = rho & 15; return 8 * (i >> 2) + 4 * n + (i & 3); }

struct Unit { int pm, pn, kinfo; };
struct Gemm { const bf16_t* A; const bf16_t* Bt; int M, N, K; };

struct StaticOrder {
    int nM, nN, nwg, G, c, ntK;
    int xtiles, xsh;
    __host__ __device__ void init(int M, int N, int K, int G_, int c_, int extra_rows = 0, int S = 1) { nM = M / BM; nN = N / BM; nwg = nM * nN; G = G_; c = c_; ntK = K / BK;
        xtiles = (extra_rows / BM) * nN; xsh = S; }
    __host__ __device__ bool next(int i, Unit& u) const {
        const long L = (long)i * G + c;
        if (L >= nwg) {
            if (xtiles == 0) return false;
            const int nb = (nwg - c + G - 1) / G;
            const int nbc = c < nwg ? nb : 0;
            const long e = (long)(i - nbc) * G + ((c + G - (nwg % G)) % G);
            if (e >= ((long)xtiles << xsh)) return false;
            const int tile = (int)(e >> xsh), ks = (int)e & ((1 << xsh) - 1), xnt = ntK >> xsh;
            u.pm = nM + tile / nN; u.pn = tile % nN; u.kinfo = (ks * xnt) | (xnt << 8) | (1 << 16); return true;
        }
        int wgid = (int)L; { const int q = nwg / NXCD, r = nwg % NXCD, xcd = wgid % NXCD, off = wgid / NXCD; wgid = (xcd < r ? xcd * (q + 1) : r * (q + 1) + (xcd - r) * q) + off; }
        const int nig = WGM * nN, gid = wgid / nig, fm = gid * WGM, gsz = (nM - fm) < WGM ? (nM - fm) : WGM;
        u.pm = fm + ((wgid % nig) % gsz); u.pn = (wgid % nig) / gsz; u.kinfo = ntK << 8; return true;
    }
    __device__ __forceinline__ void a_ready(const Unit&) const {}
    __device__ __forceinline__ void done(const Unit&) const {}
};

__device__ __forceinline__ unsigned cvt_pk_bf16(float lo, float hi) { unsigned r; asm volatile("v_cvt_pk_bf16_f32 %0, %1, %2" : "=v"(r) : "v"(lo), "v"(hi)); return r; }
__device__ __forceinline__ u32x2 pk4bf(f32x4 y) { u32x2 r; r.x = cvt_pk_bf16(y[0], y[1]); r.y = cvt_pk_bf16(y[2], y[3]); return r; }
__device__ __forceinline__ f32x4 unpk4bf(u32x2 w) { f32x4 r; r[0] = __builtin_bit_cast(float, w.x << 16); r[1] = __builtin_bit_cast(float, w.x & 0xffff0000u); r[2] = __builtin_bit_cast(float, w.y << 16); r[3] = __builtin_bit_cast(float, w.y & 0xffff0000u); return r; }
struct EpiAny {
    static constexpr bool AFTER_DRAIN = false;
    int mode; const float* base; void* out; float* ctxres; const float* gate; int ldc, relu2; PG8_LAS unsigned char* scr = nullptr;
    __device__ __forceinline__ bool perm() const { return mode == 1; }
    __device__ __forceinline__ bool headmode() const { return mode == 3; }
    __device__ __forceinline__ static float xsh(float v, int mask, int lane) { return __builtin_bit_cast(float, __builtin_amdgcn_ds_bpermute((lane ^ mask) << 2, __builtin_bit_cast(int, v))); }
    __device__ __forceinline__ void head_epilogue(const f32x4 (&acc)[2][2][4][2], const Unit& u, int wr, int wc, int fr, int fq) const {
        const int H = 4 * u.pn + wc, kind = relu2, lane = fr + 16 * fq;
        const bool f6 = kind != 0 && base[448] != 0.f;
        const bool f6e = kind == 0 && base[449] != 0.f;
        int cls, gsel; float qs = 1.f;
        if (kind == 0) { const float qq = f6e ? 1.6986436f : 0.125f * 1.4426950408889634f, kq = f6e ? 1.6986436f : 1.f;
                         if (H < 8) { cls = 2; gsel = 0; qs = qq; } else if (H < 10) { cls = 2; gsel = 1; qs = kq; } else if (H < 12) { cls = 0; gsel = 0; }
                         else if (H < 20) { cls = 1; gsel = 2; qs = qq; } else if (H < 28) { cls = 1; gsel = 3; qs = kq; } else { cls = 0; gsel = 0; } }
        else if (kind == 1) { qs = f6 ? 1.5349124f : 0.10206207261596575f * 1.4426950408889634f; if (H < 16) { cls = 1; gsel = 4; } else { cls = 3; gsel = 5; } }
        else { if (H < 16) { cls = 1; gsel = 6; if (f6) qs = 1.5349124f; } else { cls = 0; gsel = 0; } }
        const bool lat = u.pm < 64;
        const bool k6e = f6e && (H == 8 || H == 9 || (H >= 20 && H < 28));
        const bool k6 = (f6 && kind == 2 && H < 16) || k6e;
        bf16_t* O = (bf16_t*)out;
        const int col0 = u.pn * BM + 64 * wc + 8 * fq;
        f32x4 gv[2][2];
#pragma unroll
        for (int bj = 0; bj < 2; ++bj)
#pragma unroll
            for (int n = 0; n < 2; ++n) gv[bj][n] = *(const f32x4*)(base + gsel * 64 + 32 * bj + 8 * fq + 4 * n);
#pragma unroll
        for (int ai = 0; ai < 2; ++ai)
#pragma unroll
            for (int m = 0; m < 4; ++m) {
                const int row = u.pm * BM + ai * HALF + wr * 64 + m * 16 + fr;
                f32x4 v[2][2];
#pragma unroll
                for (int bj = 0; bj < 2; ++bj)
#pragma unroll
                    for (int n = 0; n < 2; ++n) v[bj][n] = acc[ai][bj][m][n];
                if (cls != 0) {
                    float s0 = 0.f, s1 = 0.f;
#pragma unroll
                    for (int n = 0; n < 2; ++n)
#pragma unroll
                        for (int e = 0; e < 4; ++e) { s0 += v[0][n][e] * v[0][n][e]; s1 += v[1][n][e] * v[1][n][e]; }
                    if (cls != 3) { s0 += s1; s0 += xsh(s0, 16, lane); s0 += xsh(s0, 32, lane); s0 = s0 * (1.f / 64.f); s1 = s0; }
                    else { s0 += xsh(s0, 16, lane); s0 += xsh(s0, 32, lane); s1 += xsh(s1, 16, lane); s1 += xsh(s1, 32, lane); s0 *= (1.f / 32.f); s1 *= (1.f / 32.f); }
                    const float r0 = 1.f / sqrtf(s0 + 1e-6f), r1 = 1.f / sqrtf(s1 + 1e-6f);
#pragma unroll
                    for (int n = 0; n < 2; ++n) { v[0][n] = v[0][n] * r0 * gv[0][n]; v[1][n] = v[1][n] * r1 * gv[1][n]; }
                    if (lat && cls == 2) {
                        const int t = row & 8191;
#pragma unroll
                        for (int bj = 0; bj < 2; ++bj) { const int pos = bj == 0 ? (t >> 6) : (t & 63); const float sgn = fq < 2 ? -1.f : 1.f;
#pragma unroll
                            for (int n = 0; n < 2; ++n) { const float* cs = gate + pos * 16 + 8 * (fq & 1) + 4 * n; const f32x4 c = *(const f32x4*)cs, sn = *(const f32x4*)(cs + 2048);
                                f32x4 p;
#pragma unroll
                                for (int e = 0; e < 4; ++e) p[e] = xsh(v[bj][n][e], 32, lane);
                                v[bj][n] = v[bj][n] * c + (p * sgn) * sn; } }
                    }
                    if (lat && cls == 3) {
                        const int t = row & 8191; const int pos = fq < 2 ? (t >> 6) : (t & 63); const float sgn = (fq & 1) ? 1.f : -1.f;
#pragma unroll
                        for (int bj = 0; bj < 2; ++bj)
#pragma unroll
                            for (int n = 0; n < 2; ++n) { const float* cs = gate + 4096 + pos * 8 + 4 * n; const f32x4 c = *(const f32x4*)cs, sn = *(const f32x4*)(cs + 1024);
                                f32x4 p;
#pragma unroll
                                for (int e = 0; e < 4; ++e) p[e] = xsh(v[bj][n][e], 16, lane);
                                v[bj][n] = v[bj][n] * c + (p * sgn) * sn; }
                    }
                    if (qs != 1.f) {
#pragma unroll
                        for (int bj = 0; bj < 2; ++bj)
#pragma unroll
                            for (int n = 0; n < 2; ++n) v[bj][n] = v[bj][n] * qs; }
                }
                if (k6) {
                    PG8_LAS unsigned char* sw = scr + (wr * 4 + wc) * 1024 + fr * 64;
                    unsigned char* img = (unsigned char*)ctxres + (k6e ? ((size_t)(row >> 6) * 10 + (H < 10 ? H - 8 : H - 18)) : ((size_t)(row >> 6) * 16 + H)) * 3072;
                    const int key = row & 63;
#pragma unroll
                    for (int bj = 0; bj < 2; ++bj) {
                        u32x4 w; w.x = cvt_pk_bf16(v[bj][0][0], v[bj][0][1]); w.y = cvt_pk_bf16(v[bj][0][2], v[bj][0][3]); w.z = cvt_pk_bf16(v[bj][1][0], v[bj][1][1]); w.w = cvt_pk_bf16(v[bj][1][2], v[bj][1][3]);
                        *(PG8_LAS u32x4*)(sw + fq * 16) = w;
                        asm volatile("s_waitcnt lgkmcnt(0)" ::: "memory");
                        if (fq == 0) {
                            const u32x4 a0 = *(PG8_LAS u32x4*)(sw), a1 = *(PG8_LAS u32x4*)(sw + 16), a2 = *(PG8_LAS u32x4*)(sw + 32), a3 = *(PG8_LAS u32x4*)(sw + 48);
                            const u32x16 all = {a0.x, a0.y, a0.z, a0.w, a1.x, a1.y, a1.z, a1.w, a2.x, a2.y, a2.z, a2.w, a3.x, a3.y, a3.z, a3.w};
                            const u32x6 c = __builtin_amdgcn_cvt_scalef32_pk32_fp6_bf16(__builtin_bit_cast(bf16x32, all), 1.0f);
                            *(u32x4*)(img + bj * 1024 + key * 16) = (u32x4){c[0], c[1], c[2], c[3]};
                            *(u32x2*)(img + 2048 + bj * 512 + key * 8) = (u32x2){c[4], c[5]};
                        }
                        asm volatile("s_waitcnt lgkmcnt(0)" ::: "memory");
                    }
                    continue;
                }
                bf16_t* rowp = O + (size_t)row * ldc + col0;
#pragma unroll
                for (int bj = 0; bj < 2; ++bj) { u32x4 w; w.x = cvt_pk_bf16(v[bj][0][0], v[bj][0][1]); w.y = cvt_pk_bf16(v[bj][0][2], v[bj][0][3]); w.z = cvt_pk_bf16(v[bj][1][0], v[bj][1][1]); w.w = cvt_pk_bf16(v[bj][1][2], v[bj][1][3]);
                    *(u32x4*)(rowp + 32 * bj) = w; }
            }
    }
    __device__ __forceinline__ void operator()(const f32x4 (&acc)[2][2][4][2], const Unit& u, int wr, int wc, int fr, int fq) const {
        asm volatile("" : "+v"(fr), "+v"(fq));
        if (mode == 1) {
            bf16_t* O = (bf16_t*)out;
            const int row0 = u.pm * BM + wr * 64 + fr, col0 = u.pn * BM + wc * 32 + 8 * fq;
#pragma unroll
            for (int ai = 0; ai < 2; ++ai)
#pragma unroll
                for (int m = 0; m < 4; ++m) { bf16_t* rowp = O + (size_t)(row0 + ai * HALF + m * 16) * ldc + col0;
#pragma unroll
                    for (int bj = 0; bj < 2; ++bj) { f32x4 v0 = acc[ai][bj][m][0], v1 = acc[ai][bj][m][1];
                        if (relu2) {
#pragma unroll
                            for (int e = 0; e < 4; ++e) { float a = fmaxf(v0[e], 0.f), b = fmaxf(v1[e], 0.f); v0[e] = a * a; v1[e] = b * b; } }
                        u32x4 w; w.x = cvt_pk_bf16(v0[0], v0[1]); w.y = cvt_pk_bf16(v0[2], v0[3]); w.z = cvt_pk_bf16(v1[0], v1[1]); w.w = cvt_pk_bf16(v1[2], v1[3]);
                        *(u32x4*)(rowp + bj * HALF) = w; } }
            return;
        }
        if (mode == 3) { head_epilogue(acc, u, wr, wc, fr, fq); return; }
        const int t0 = u.pm * BM; const bool split = (u.kinfo >> 16) != 0; const int cond = t0 < 8192 ? 0 : (t0 < 16384 ? 1 : 2);
        const int col0 = u.pn * BM + wc * 32 + 4 * fq; const float* g = gate + cond * 6144 + col0;
        f32x4 gv[2][2];
#pragma unroll
        for (int bj = 0; bj < 2; ++bj)
#pragma unroll
            for (int n = 0; n < 2; ++n) gv[bj][n] = *(const f32x4*)(g + bj * HALF + n * 16);
        if (split) {
            const int ks = (u.kinfo & 255) / ((u.kinfo >> 8) & 255);
            float* op = ctxres + (size_t)ks * (512 * 1024) + (size_t)(t0 - 16384) * 1024;
#pragma unroll
            for (int ai = 0; ai < 2; ++ai)
#pragma unroll
                for (int m = 0; m < 4; ++m) { const size_t off = (size_t)(wr * 64 + fr + ai * HALF + m * 16) * 1024 + col0;
#pragma unroll
                    for (int bj = 0; bj < 2; ++bj)
#pragma unroll
                        for (int n = 0; n < 2; ++n) *(f32x4*)(op + off + bj * HALF + n * 16) = gv[bj][n] * acc[ai][bj][m][n]; }
            return;
        }
#define PG8_RES_LOOP(LOADB, STOREO) _Pragma("unroll") for (int ai = 0; ai < 2; ++ai) _Pragma("unroll") for (int m = 0; m < 4; ++m) { const size_t off = (size_t)(wr * 64 + fr + ai * HALF + m * 16) * 1024 + col0; \
            _Pragma("unroll") for (int bj = 0; bj < 2; ++bj) _Pragma("unroll") for (int n = 0; n < 2; ++n) { const size_t o2 = off + bj * HALF + n * 16; f32x4 b; LOADB; const f32x4 y = b + gv[bj][n] * acc[ai][bj][m][n]; STOREO; } }
        if (relu2 == 2) { const float* bp = base + (size_t)t0 * 1024; bf16_t* op = (bf16_t*)out + (size_t)t0 * 1024;
            PG8_RES_LOOP(b = *(const f32x4*)(bp + o2), *(u32x2*)(op + o2) = pk4bf(y)); }
        else if (relu2 == 3) { const bf16_t* bp = (const bf16_t*)base + (size_t)t0 * 1024; bf16_t* op = (bf16_t*)out + (size_t)t0 * 1024;
            PG8_RES_LOOP(const u32x2 w = *(const u32x2*)(bp + o2); b = unpk4bf(w), *(u32x2*)(op + o2) = pk4bf(y)); }
        else { const bf16_t* bp = (const bf16_t*)base + (size_t)t0 * 1024; float* op = (float*)out + (size_t)t0 * 1024;
            PG8_RES_LOOP(const u32x2 w = *(const u32x2*)(bp + o2); b = unpk4bf(w), *(f32x4*)(op + o2) = y); }
#undef PG8_RES_LOOP
    }
};

template <class Epi, class Sched, bool ALIGN_EPI = false, bool SP2 = false>
__device__ __forceinline__ void gemm_phase(PG8_LAS unsigned char* lds, const Gemm g, const Sched& S, const Epi& E, const int tid) {
    const int wid = __builtin_amdgcn_readfirstlane(tid >> 6), lane = tid & 63, wr = wid >> 2, wc = wid & 3, fr = lane & 15, fq = lane >> 4;
    const int K = g.K;
    unsigned voffA[2], voffB[2];
#pragma unroll
    for (int i = 0; i < 2; ++i) { int R, C; stage_rc(tid * 16 + i * 8192, R, C); const int Rb = E.headmode() ? (64 * (R >> 5) + perm32(R & 31)) : (E.perm() ? ((R & ~31) + perm32(R & 31)) : R);
        voffA[i] = (unsigned)(R * K + C) * 2u; voffB[i] = (unsigned)(Rb * K + C) * 2u; }
    const size_t kstep = (size_t)(BK * 2);
    const size_t hstep = (size_t)HALF * K * 2;
    const size_t tstep = 2 * hstep;
    const size_t hstepB = E.headmode() ? (size_t)32 * K * 2 : hstep;
    const unsigned ldsw = (unsigned)wid * 1024u;
    const int aoff = lds_byte(wr * 64 + fr, fq * 8), boff = lds_byte(wc * 32 + fr, fq * 8);
#define PG8_SA(b, h) (((b) * 2 + (h)) * HTB)
#define PG8_SB(b, h) ((4 + (b) * 2 + (h)) * HTB)
#define PG8_STAGE(bufoff, gbase, voff) do { _Pragma("unroll") for (int _i = 0; _i < 2; ++_i) \
        __builtin_amdgcn_global_load_lds((const unsigned*)((const char*)(gbase) + (voff)[_i]), (PG8_LAS unsigned*)(lds + (bufoff) + ldsw + _i * 8192), 16, 0, 0); } while (0)
#define PG8_LDA(dst, b, h) do { _Pragma("unroll") for (int m = 0; m < 4; ++m) _Pragma("unroll") for (int k = 0; k < 2; ++k) dst[m][k] = *(const PG8_LAS bf16x8*)(lds + PG8_SA(b, h) + aoff + m * 2048 + k * 1024); } while (0)
#define PG8_LDB(dst, b, h) do { _Pragma("unroll") for (int n = 0; n < 2; ++n) _Pragma("unroll") for (int k = 0; k < 2; ++k) dst[n][k] = *(const PG8_LAS bf16x8*)(lds + PG8_SB(b, h) + boff + n * 2048 + k * 1024); } while (0)
#define PG8_MMA(ai, bj, At, Bt) do { __builtin_amdgcn_s_setprio(1); _Pragma("unroll") for (int m = 0; m < 4; ++m) _Pragma("unroll") for (int n = 0; n < 2; ++n) _Pragma("unroll") for (int k = 0; k < 2; ++k) \
        acc[ai][bj][m][n] = __builtin_amdgcn_mfma_f32_16x16x32_bf16(Bt[n][k], At[m][k], acc[ai][bj][m][n], 0, 0, 0); __builtin_amdgcn_s_setprio(0); } while (0)
#define PG8_WAIT_V(n) asm volatile("s_waitcnt vmcnt(" #n ")" ::: "memory")
#define PG8_WAIT_L(n) asm volatile("s_waitcnt lgkmcnt(" #n ")" ::: "memory")
#define PG8_BAR __builtin_amdgcn_s_barrier()
#define PG8_SCHED __builtin_amdgcn_sched_barrier(0)
    Unit cur, nxt; int ui = 0;
    if (!S.next(0, cur)) return;
    f32x4 acc[2][2][4][2];
#pragma unroll
    for (int a = 0; a < 2; ++a)
#pragma unroll
        for (int b = 0; b < 2; ++b)
#pragma unroll
            for (int m = 0; m < 4; ++m)
#pragma unroll
                for (int n = 0; n < 2; ++n) acc[a][b][m][n] = (f32x4){0.f, 0.f, 0.f, 0.f};
    bf16x8 At[4][2], B0[2][2], B1[2][2];
    const char* cA = (const char*)g.A + (size_t)cur.pm * tstep + (size_t)(cur.kinfo & 255) * (BK * 2); const char* cB = (const char*)g.Bt + (size_t)cur.pn * tstep + (size_t)(cur.kinfo & 255) * (BK * 2);
    S.a_ready(cur);
    if constexpr (SP2) {
        PG8_STAGE(PG8_SB(0, 0), cB, voffB); PG8_STAGE(PG8_SB(0, 1), cB + hstepB, voffB); PG8_STAGE(PG8_SA(0, 0), cA, voffA); PG8_STAGE(PG8_SA(0, 1), cA + hstep, voffA);
        if (wr == 1) PG8_BAR;
        PG8_WAIT_V(2); PG8_BAR;
        PG8_STAGE(PG8_SB(1, 0), cB + kstep, voffB); PG8_STAGE(PG8_SA(1, 0), cA + kstep, voffA); PG8_STAGE(PG8_SB(1, 1), cB + hstepB + kstep, voffB);
        PG8_WAIT_V(6); PG8_BAR;
    } else {
        PG8_STAGE(PG8_SB(0, 0), cB, voffB); PG8_STAGE(PG8_SA(0, 0), cA, voffA); PG8_STAGE(PG8_SB(0, 1), cB + hstepB, voffB); PG8_STAGE(PG8_SA(0, 1), cA + hstep, voffA);
        if (wr == 1) PG8_BAR;
        PG8_WAIT_V(4); PG8_BAR;
        PG8_STAGE(PG8_SB(1, 0), cB + kstep, voffB); PG8_STAGE(PG8_SA(1, 0), cA + kstep, voffA); PG8_STAGE(PG8_SB(1, 1), cB + hstepB + kstep, voffB);
        PG8_WAIT_V(6); PG8_BAR;
    }
    for (;;) {
        const bool has_next = S.next(ui + 1, nxt);
        const char* nA = has_next ? (const char*)g.A + (size_t)nxt.pm * tstep + (size_t)(nxt.kinfo & 255) * (BK * 2) : cA; const char* nB = has_next ? (const char*)g.Bt + (size_t)nxt.pn * tstep + (size_t)(nxt.kinfo & 255) * (BK * 2) : cB;
        const int nt = (cur.kinfo >> 8) & 255;
        for (int t = 0; t < nt; t += 2) {
            const bool last = (t == nt - 2);
            const char* a1 = cA + (size_t)(t + 1) * kstep;
            const char* a2 = last ? nA : cA + (size_t)(t + 2) * kstep; const char* b2 = last ? nB : cB + (size_t)(t + 2) * kstep;
            const char* a3 = a2 + kstep; const char* b3 = b2 + kstep;
            if (last && has_next) S.a_ready(nxt);
            if constexpr (SP2) {
            PG8_LDB(B0, 0, 0); PG8_LDB(B1, 0, 1); PG8_SCHED; PG8_LDA(At, 0, 0); PG8_STAGE(PG8_SA(1, 1), a1 + hstep, voffA);
            PG8_WAIT_V(8); PG8_WAIT_L(0); PG8_BAR; PG8_MMA(0, 0, At, B0); PG8_MMA(0, 1, At, B1); PG8_BAR; PG8_SCHED;
            PG8_LDA(At, 0, 1); PG8_STAGE(PG8_SB(0, 0), b2, voffB); PG8_STAGE(PG8_SB(0, 1), b2 + hstepB, voffB); PG8_STAGE(PG8_SA(0, 0), a2, voffA);
            PG8_WAIT_V(8); PG8_WAIT_L(0); PG8_BAR; PG8_MMA(1, 0, At, B0); PG8_MMA(1, 1, At, B1); PG8_BAR; PG8_SCHED;
            PG8_LDB(B0, 1, 0); PG8_LDB(B1, 1, 1); PG8_SCHED; PG8_LDA(At, 1, 0); PG8_STAGE(PG8_SA(0, 1), a2 + hstep, voffA);
            PG8_WAIT_V(8); PG8_WAIT_L(0); PG8_BAR; PG8_MMA(0, 0, At, B0); PG8_MMA(0, 1, At, B1); PG8_BAR; PG8_SCHED;
            PG8_LDA(At, 1, 1); PG8_STAGE(PG8_SB(1, 0), b3, voffB); PG8_STAGE(PG8_SB(1, 1), b3 + hstepB, voffB); PG8_STAGE(PG8_SA(1, 0), a3, voffA);
            PG8_WAIT_V(8); PG8_WAIT_L(0); PG8_BAR; PG8_MMA(1, 0, At, B0); PG8_MMA(1, 1, At, B1); PG8_BAR; PG8_SCHED;
            } else {
            PG8_LDB(B0, 0, 0); PG8_SCHED; PG8_LDA(At, 0, 0); PG8_STAGE(PG8_SA(1, 1), a1 + hstep, voffA);
            PG8_WAIT_L(8); PG8_BAR; PG8_WAIT_L(0); PG8_MMA(0, 0, At, B0); PG8_BAR; PG8_SCHED;
            PG8_LDB(B1, 0, 1); PG8_STAGE(PG8_SB(0, 0), b2, voffB);
            PG8_BAR; PG8_WAIT_L(0); PG8_MMA(0, 1, At, B1); PG8_BAR;
            PG8_LDA(At, 0, 1); PG8_STAGE(PG8_SA(0, 0), a2, voffA);
            PG8_BAR; PG8_WAIT_L(0); PG8_MMA(1, 0, At, B0); PG8_BAR; PG8_SCHED;
            PG8_STAGE(PG8_SB(0, 1), b2 + hstepB, voffB);
            PG8_WAIT_V(6); PG8_BAR; PG8_MMA(1, 1, At, B1); PG8_BAR;
            PG8_LDB(B0, 1, 0); PG8_SCHED; PG8_LDA(At, 1, 0); PG8_STAGE(PG8_SA(0, 1), a2 + hstep, voffA);
            PG8_WAIT_L(8); PG8_BAR; PG8_WAIT_L(0); PG8_MMA(0, 0, At, B0); PG8_BAR; PG8_SCHED;
            PG8_LDB(B1, 1, 1); PG8_STAGE(PG8_SB(1, 0), b3, voffB);
            PG8_BAR; PG8_WAIT_L(0); PG8_MMA(0, 1, At, B1); PG8_BAR;
            PG8_LDA(At, 1, 1); PG8_STAGE(PG8_SA(1, 0), a3, voffA);
            PG8_BAR; PG8_WAIT_L(0); PG8_MMA(1, 0, At, B0); PG8_BAR; PG8_SCHED;
            PG8_STAGE(PG8_SB(1, 1), b3 + hstepB, voffB);
            PG8_WAIT_V(6); PG8_BAR; PG8_MMA(1, 1, At, B1); PG8_BAR;
            }
        }
        if constexpr (ALIGN_EPI) { if (wr == 0) PG8_BAR; }
        if constexpr (!Epi::AFTER_DRAIN) { E(acc, cur, wr, wc, fr, fq); S.done(cur); }
        if (!has_next) break;
#pragma unroll
        for (int a = 0; a < 2; ++a)
#pragma unroll
            for (int b = 0; b < 2; ++b)
#pragma unroll
                for (int m = 0; m < 4; ++m)
#pragma unroll
                    for (int n = 0; n < 2; ++n) acc[a][b][m][n] = (f32x4){0.f, 0.f, 0.f, 0.f};
        cur = nxt; cA = nA; cB = nB; ++ui;
        if constexpr (ALIGN_EPI) { if (wr == 1) PG8_BAR; }
    }
    PG8_WAIT_V(0);
    if constexpr (!ALIGN_EPI) { if (wr == 0) PG8_BAR; }
    PG8_BAR;
    if constexpr (Epi::AFTER_DRAIN) { E.fused(acc, cur, wr, wc, fr, fq, lds, wid, lane); S.done(cur); }
#undef PG8_SA
#undef PG8_SB
#undef PG8_STAGE
#undef PG8_LDA
#undef PG8_LDB
#undef PG8_MMA
#undef PG8_WAIT_V
#undef PG8_WAIT_L
#undef PG8_BAR
#undef PG8_SCHED
}
}
namespace att {
#define ATT_LAS __attribute__((address_space(3)))
typedef unsigned short bf16;
typedef short bf16x8 __attribute__((ext_vector_type(8)));
typedef short s16x4 __attribute__((ext_vector_type(4)));
typedef float f32x16 __attribute__((ext_vector_type(16)));
typedef unsigned u32x4 __attribute__((ext_vector_type(4)));
typedef ATT_LAS char lchar;
constexpr int KBUF = 12288, VBUF = 16384;
constexpr int L_K = 0, L_V = 2 * KBUF, L_WS = L_V + 2 * VBUF, L_RPB = L_WS + 2048, L_END = L_RPB + 2048;
constexpr float LOG2E = 1.4426950408889634f;
#define ATT_SBAR() __builtin_amdgcn_sched_barrier(0)
__device__ __forceinline__ int crow(int r, int hi) { return (r & 3) + 8 * (r >> 2) + 4 * hi; }
__device__ __forceinline__ unsigned cvtpk(float lo, float hi) { unsigned r; asm volatile("v_cvt_pk_bf16_f32 %0, %1, %2" : "=v"(r) : "v"(lo), "v"(hi)); return r; }
__device__ __forceinline__ int v_st(int k, int c) { const int kk = (k & ~0xC) | ((k & 4) << 1) | ((k & 8) >> 1); return ((kk >> 3) * 4 + (c >> 5)) * 512 + ((kk & 7) * 32 + (c & 31)) * 2; }
__device__ __forceinline__ int v_rd_base(int lane) { return ((lane & 3) << 3) | (((lane >> 2) & 3) << 6) | (((lane >> 4) & 1) << 5) | (((lane >> 5) & 1) << 8); }
constexpr int v_rd_off(int d0, int ks, int half) { return d0 * 512 + ks * 4096 + half * 2048; }
template <int OFF> __device__ __forceinline__ s16x4 tr_read(unsigned vb) {
  s16x4 r; asm volatile("ds_read_b64_tr_b16 %0, %1 offset:%2" : "=&v"(r) : "v"(vb), "i"(OFF) : "memory"); return r;
}
template <int D0> __device__ __forceinline__ void pv_one(f32x16& od, unsigned vb, bf16x8 pa0, bf16x8 pa1, bf16x8 pa2, bf16x8 pa3) {
  const s16x4 l0 = tr_read<v_rd_off(D0, 0, 0)>(vb), h0 = tr_read<v_rd_off(D0, 0, 1)>(vb), l1 = tr_read<v_rd_off(D0, 1, 0)>(vb), h1 = tr_read<v_rd_off(D0, 1, 1)>(vb);
  const s16x4 l2 = tr_read<v_rd_off(D0, 2, 0)>(vb), h2 = tr_read<v_rd_off(D0, 2, 1)>(vb), l3 = tr_read<v_rd_off(D0, 3, 0)>(vb), h3 = tr_read<v_rd_off(D0, 3, 1)>(vb);
  asm volatile("s_waitcnt lgkmcnt(0)" ::: "memory"); ATT_SBAR();
#define ATT_PK(L, H) (bf16x8){L[0], L[1], L[2], L[3], H[0], H[1], H[2], H[3]}
  od = __builtin_amdgcn_mfma_f32_32x32x16_bf16(pa0, ATT_PK(l0, h0), od, 0, 0, 0);
  od = __builtin_amdgcn_mfma_f32_32x32x16_bf16(pa1, ATT_PK(l1, h1), od, 0, 0, 0);
  od = __builtin_amdgcn_mfma_f32_32x32x16_bf16(pa2, ATT_PK(l2, h2), od, 0, 0, 0);
  od = __builtin_amdgcn_mfma_f32_32x32x16_bf16(pa3, ATT_PK(l3, h3), od, 0, 0, 0);
#undef ATT_PK
}

template <int DKC, class U>
__device__ __forceinline__ void unit(const U& u, lchar* lds, int tid) {
  asm volatile("" : "+v"(tid));
  const int lane = tid & 63, r32 = lane & 31, hi = lane >> 5;
  const int wid = __builtin_amdgcn_readfirstlane(tid >> 6);
  lchar* Kl = lds + L_K; lchar* Vl = lds + L_V;
  ATT_LAS float* ws = (ATT_LAS float*)(lds + L_WS) + wid * 64;
  bf16x8 qr[DKC / 2];
#pragma unroll
  for (int d0 = 0; d0 < DKC / 2; ++d0) qr[d0] = *(const bf16x8*)u.qptr(wid, r32, d0, hi);
  const int vrow = tid >> 3, vch = tid & 7, vst = v_st(vrow, vch * 8);
  const int krow0 = tid & 63, kch0 = tid >> 6;
  const bool k2 = (DKC > 8) && (tid < 64 * (DKC - 8));
  const unsigned vb0 = (unsigned)(uintptr_t)Vl + (unsigned)v_rd_base(lane);
  bf16x8 kst0, kst1 = {}, vstr;
  const int NT = u.nt();
#define ATT_SLOAD(t) do { const long R_ = u.krow(t); kst0 = *(const bf16x8*)u.kptr(R_ + krow0, kch0); if (k2) kst1 = *(const bf16x8*)u.kptr(R_ + krow0, 8 + kch0); \
    vstr = *(const bf16x8*)u.vptr(R_ + vrow, vch); } while (0)
#define ATT_SWRITE(b) do { *(ATT_LAS bf16x8*)(Kl + (b) * KBUF + kch0 * 1024 + krow0 * 16) = kst0; if (k2) *(ATT_LAS bf16x8*)(Kl + (b) * KBUF + (8 + kch0) * 1024 + krow0 * 16) = kst1; \
    *(ATT_LAS bf16x8*)(Vl + (b) * VBUF + vst) = vstr; } while (0)
  float m_reg = -1e30f, l_reg = 0.f; f32x16 o[2]; o[0] = f32x16{}; o[1] = f32x16{};
  ATT_SLOAD(0); ATT_SWRITE(0); __syncthreads();
  for (int t = 0; t < NT; ++t) {
    const int buf = t & 1;
    if (t + 1 < NT) ATT_SLOAD(t + 1);
    if (!u.skip(t, wid)) {
      f32x16 p0 = f32x16{}, p1 = f32x16{};
      { const lchar* kb = Kl + buf * KBUF + hi * 1024 + r32 * 16;
#pragma unroll
        for (int d0 = 0; d0 < DKC / 2; ++d0) {
          const bf16x8 b0 = *(const ATT_LAS bf16x8*)(kb + d0 * 2048);
          const bf16x8 b1 = *(const ATT_LAS bf16x8*)(kb + d0 * 2048 + 512);
          p0 = __builtin_amdgcn_mfma_f32_32x32x16_bf16(b0, qr[d0], p0, 0, 0, 0);
          p1 = __builtin_amdgcn_mfma_f32_32x32x16_bf16(b1, qr[d0], p1, 0, 0, 0); } }
      u.mask(p0, p1, t, wid, r32, hi);
      float pmax = p0[0];
#pragma unroll
      for (int r = 1; r < 16; ++r) pmax = fmaxf(pmax, p0[r]);
#pragma unroll
      for (int r = 0; r < 16; ++r) pmax = fmaxf(pmax, p1[r]);
      { auto rr = __builtin_amdgcn_permlane32_swap(__float_as_uint(pmax), __float_as_uint(pmax), false, false);
        pmax = fmaxf(__uint_as_float(rr[0]), __uint_as_float(rr[1])); }
      const float mn = fmaxf(m_reg, pmax);
      const float alpha = __builtin_amdgcn_exp2f(m_reg - mn);
      m_reg = mn;
#pragma unroll
      for (int r = 0; r < 16; ++r) { p0[r] = __builtin_amdgcn_exp2f(p0[r] - mn); p1[r] = __builtin_amdgcn_exp2f(p1[r] - mn); }
      float ps = 0.f;
#pragma unroll
      for (int r = 0; r < 16; ++r) ps += p0[r];
#pragma unroll
      for (int r = 0; r < 16; ++r) ps += p1[r];
      { auto rr = __builtin_amdgcn_permlane32_swap(__float_as_uint(ps), __float_as_uint(ps), false, false);
        ps = __uint_as_float(rr[0]) + __uint_as_float(rr[1]); }
      l_reg = l_reg * alpha + ps;
      if (__any(alpha < 1.f)) {
        if (hi == 0) ws[r32] = alpha;
        asm volatile("s_waitcnt lgkmcnt(0)" ::: "memory");
#pragma unroll
        for (int r = 0; r < 16; ++r) { const float a = ws[crow(r, hi)]; o[0][r] *= a; o[1][r] *= a; }
      }
      bf16x8 pa0, pa1, pa2, pa3;
#define ATT_PK4(P, BASE, OUT) do { unsigned a0 = cvtpk(P[BASE + 0], P[BASE + 1]), a1 = cvtpk(P[BASE + 2], P[BASE + 3]);   \
    unsigned b0 = cvtpk(P[BASE + 4], P[BASE + 5]), b1 = cvtpk(P[BASE + 6], P[BASE + 7]);                              \
    auto r0 = __builtin_amdgcn_permlane32_swap(a0, b0, false, false); auto r1 = __builtin_amdgcn_permlane32_swap(a1, b1, false, false); \
    u32x4 w = {r0[0], r1[0], r0[1], r1[1]}; OUT = __builtin_bit_cast(bf16x8, w); } while (0)
      ATT_PK4(p0, 0, pa0); ATT_PK4(p0, 8, pa1); ATT_PK4(p1, 0, pa2); ATT_PK4(p1, 8, pa3);
#undef ATT_PK4
      const unsigned vb = vb0 + (unsigned)(buf * VBUF);
      pv_one<0>(o[0], vb, pa0, pa1, pa2, pa3); pv_one<1>(o[1], vb, pa0, pa1, pa2, pa3);
    }
    if (t + 1 < NT) ATT_SWRITE(buf ^ 1);
    __syncthreads();
  }
#undef ATT_SLOAD
#undef ATT_SWRITE
  { const float sk = u.sink(wid); l_reg += __builtin_amdgcn_exp2f(sk - m_reg); }
  if (hi == 0) ws[r32] = l_reg;
  asm volatile("s_waitcnt lgkmcnt(0)" ::: "memory");
  float rli[16];
#pragma unroll
  for (int r = 0; r < 16; ++r) rli[r] = __builtin_amdgcn_rcpf(ws[crow(r, hi)]);
#pragma unroll
  for (int r = 0; r < 16; ++r) { bf16* op = u.orow(wid, crow(r, hi));
    op[r32] = (bf16)(cvtpk(o[0][r] * rli[r], 0.f) & 0xffffu); op[32 + r32] = (bf16)(cvtpk(o[1][r] * rli[r], 0.f) & 0xffffu); }
  asm volatile("s_waitcnt lgkmcnt(0)" ::: "memory");
}

constexpr int ROWS_LAT = 16384;
struct UWin {
  const bf16* QKV; bf16* O; const float* sinkp; int b, n, g, hh; int i0, cnt;
  __device__ __forceinline__ void init() { i0 = (n == 0) ? 2 : 0; cnt = (n == 0 || n == 63) ? 4 : 6; }
  __device__ __forceinline__ int nt() const { return 4 + cnt; }
  __device__ __forceinline__ int kpos0(int t) const { return 128 * (n - 1) + 64 * (i0 + t - 4); }
  __device__ __forceinline__ long krow(int t) const { return t < 4 ? (long)(ROWS_LAT + 256 * b + 64 * t) : (long)(8192 * b + kpos0(t)); }
  __device__ __forceinline__ const bf16* kptr(long row, int ch) const { return QKV + row * 2304 + 512 + 64 * g + ch * 8; }
  __device__ __forceinline__ const bf16* vptr(long row, int ch) const { return QKV + row * 2304 + 640 + 64 * g + ch * 8; }
  __device__ __forceinline__ int head(int wid) const { return 4 * g + 2 * hh + (wid >> 2); }
  __device__ __forceinline__ int qpos0(int wid) const { return 128 * n + 32 * (wid & 3); }
  __device__ __forceinline__ const bf16* qptr(int wid, int r32, int d0, int hi) const { return QKV + (long)(8192 * b + qpos0(wid) + r32) * 2304 + 64 * head(wid) + 16 * d0 + 8 * hi; }
  __device__ __forceinline__ bool skip(int t, int wid) const { if (t < 4) return false; const int k0 = kpos0(t), q0 = qpos0(wid); return (k0 + 63 < q0 - 128) || (k0 > q0 + 31 + 128); }
  __device__ __forceinline__ void mask(f32x16& p0, f32x16& p1, int t, int wid, int r32, int hi) const {
    if (t < 4) return;
    const int dq = kpos0(t) - (qpos0(wid) + r32);
#pragma unroll
    for (int r = 0; r < 16; ++r) { const int d = dq + crow(r, hi); if (d > 128 || d < -128) p0[r] = -INFINITY; if (d + 32 > 128 || d + 32 < -128) p1[r] = -INFINITY; }
  }
  __device__ __forceinline__ float sink(int wid) const { return sinkp[head(wid)] * LOG2E; }
  __device__ __forceinline__ bf16* orow(int wid, int row) const { return O + (long)(8192 * b + qpos0(wid) + row) * 1024 + 64 * head(wid); }
};
struct UNa {
  const bf16* QKV; bf16* O; const ATT_LAS float* rpbl; int b, h, R4; int krlo, nloc;
  __device__ __forceinline__ static int clampi(int v, int lo, int hi_) { return v < lo ? lo : (v > hi_ ? hi_ : v); }
  __device__ __forceinline__ void init() { krlo = clampi(4 * R4 - 4, 0, 120); const int krhi = clampi(4 * R4 - 1, 0, 120) + 7; nloc = krhi - krlo + 1; }
  __device__ __forceinline__ int nt() const { return 4 + nloc; }
  __device__ __forceinline__ long krow(int t) const { return t < 4 ? (long)(ROWS_LAT + 256 * b + 64 * t) : (long)(8192 * b + 64 * (krlo + t - 4)); }
  __device__ __forceinline__ const bf16* kptr(long row, int ch) const { return QKV + row * 2304 + 1280 + 64 * h + ch * 8; }
  __device__ __forceinline__ const bf16* vptr(long row, int ch) const { return QKV + row * 2304 + 1792 + 64 * h + ch * 8; }
  __device__ __forceinline__ int qrow(int wid) const { return 4 * R4 + (wid >> 1); }
  __device__ __forceinline__ const bf16* qptr(int wid, int r32, int d0, int hi) const { return QKV + (long)(8192 * b + 64 * qrow(wid) + 32 * (wid & 1) + r32) * 2304 + 768 + 64 * h + 16 * d0 + 8 * hi; }
  __device__ __forceinline__ bool skip(int t, int wid) const { if (t < 4) return false; const int kr = krlo + t - 4, w0 = clampi(qrow(wid) - 4, 0, 120); return kr < w0 || kr > w0 + 7; }
  __device__ __forceinline__ void mask(f32x16& p0, f32x16& p1, int t, int wid, int r32, int hi) const {
    if (t < 4) return;
    const int kr = krlo + t - 4, qc = 32 * (wid & 1) + r32, c0 = clampi(qc - 8, 0, 48);
    const ATT_LAS float* brow = rpbl + (kr - qrow(wid) + 7) * 31 + 15;
#pragma unroll
    for (int r = 0; r < 16; ++r) {
      { const int kc = crow(r, hi); const bool ok = kc >= c0 && kc < c0 + 16; const float bv = brow[clampi(kc - qc, -15, 15)]; p0[r] = ok ? p0[r] + bv : -INFINITY; }
      { const int kc = 32 + crow(r, hi); const bool ok = kc >= c0 && kc < c0 + 16; const float bv = brow[clampi(kc - qc, -15, 15)]; p1[r] = ok ? p1[r] + bv : -INFINITY; } }
  }
  __device__ __forceinline__ float sink(int) const { return -INFINITY; }
  __device__ __forceinline__ bf16* orow(int wid, int row) const { return O + (long)(8192 * b + 64 * qrow(wid) + 32 * (wid & 1) + row) * 1024 + 512 + 64 * h; }
};
struct UCtx {
  const bf16* QKV; bf16* O; const float* sinkp; int b, hx; int qcol, kcol, vcol, ocol;
  __device__ __forceinline__ void init() { if (hx < 8) { qcol = 64 * hx; kcol = 512 + 64 * (hx >> 2); vcol = 640 + 64 * (hx >> 2); ocol = 64 * hx; }
    else { const int h = hx - 8; qcol = 768 + 64 * h; kcol = 1280 + 64 * h; vcol = 1792 + 64 * h; ocol = 512 + 64 * h; } }
  __device__ __forceinline__ int nt() const { return 4; }
  __device__ __forceinline__ long krow(int t) const { return (long)(ROWS_LAT + 256 * b + 64 * t); }
  __device__ __forceinline__ const bf16* kptr(long row, int ch) const { return QKV + row * 2304 + kcol + ch * 8; }
  __device__ __forceinline__ const bf16* vptr(long row, int ch) const { return QKV + row * 2304 + vcol + ch * 8; }
  __device__ __forceinline__ const bf16* qptr(int wid, int r32, int d0, int hi) const { return QKV + (long)(ROWS_LAT + 256 * b + 32 * wid + r32) * 2304 + qcol + 16 * d0 + 8 * hi; }
  __device__ __forceinline__ bool skip(int, int) const { return false; }
  __device__ __forceinline__ void mask(f32x16&, f32x16&, int, int, int, int) const {}
  __device__ __forceinline__ float sink(int) const { return hx < 8 ? sinkp[hx] * LOG2E : -INFINITY; }
  __device__ __forceinline__ bf16* orow(int wid, int row) const { return O + (long)(ROWS_LAT + 256 * b + 32 * wid + row) * 1024 + ocol; }
};
struct UDense {
  const bf16* Q; const bf16* KV; const bf16* KR; bf16* O; int b, h, qb;
  __device__ __forceinline__ int nt() const { return 132; }
  __device__ __forceinline__ long krow(int t) const { return t < 4 ? (long)(ROWS_LAT + 256 * b + 64 * t) : (long)(8192 * b + 64 * (t - 4)); }
  __device__ __forceinline__ const bf16* kptr(long row, int ch) const { return ch < 8 ? KV + row * 2048 + 64 * h + ch * 8 : KR + row * 32 + (ch - 8) * 8; }
  __device__ __forceinline__ const bf16* vptr(long row, int ch) const { return KV + row * 2048 + 1024 + 64 * h + ch * 8; }
  __device__ __forceinline__ const bf16* qptr(int wid, int r32, int d0, int hi) const { const bf16* qp = Q + (long)(8192 * b + 256 * qb + 32 * wid + r32) * 1536;
    return d0 < 4 ? qp + 64 * h + 16 * d0 + 8 * hi : qp + 1024 + 32 * h + 16 * (d0 - 4) + 8 * hi; }
  __device__ __forceinline__ bool skip(int, int) const { return false; }
  __device__ __forceinline__ void mask(f32x16&, f32x16&, int, int, int, int) const {}
  __device__ __forceinline__ float sink(int) const { return -INFINITY; }
  __device__ __forceinline__ bf16* orow(int wid, int row) const { return O + (long)(8192 * b + 256 * qb + 32 * wid + row) * 1024 + 64 * h; }
};
#undef ATT_SBAR
}
namespace attd {
typedef unsigned short bf16;
using bf16x8 = __attribute__((ext_vector_type(8))) short;
using s16x4 = __attribute__((ext_vector_type(4))) short;
using f32x16 = __attribute__((ext_vector_type(16))) float;
using u32x4 = __attribute__((ext_vector_type(4))) unsigned;
using i32x2 = __attribute__((ext_vector_type(2))) int;
using i32x4 = __attribute__((ext_vector_type(4))) int;
using i32x8 = __attribute__((ext_vector_type(8))) int;
using u32x6 = __attribute__((ext_vector_type(6))) unsigned;
using u32x16 = __attribute__((ext_vector_type(16))) unsigned;
typedef __bf16 bf16x32 __attribute__((ext_vector_type(32)));
constexpr int NW = 8, NT = 132, KSLOT = 5120, VSLOT = 8192;
constexpr int LDS_K = 0, LDS_V = 3 * KSLOT, LDS_WS = LDS_V + 3 * VSLOT, LDS_OST = LDS_WS + NW * 64 * 4, LDS_BYTES = LDS_OST + NW * 4096;
__device__ __forceinline__ int crow(int r, int hi) { return (r & 3) + 8 * (r >> 2) + 4 * hi; }
#define AF_SBAR() __builtin_amdgcn_sched_barrier(0)
__device__ __forceinline__ void glds16(unsigned voff, const void* sbase, unsigned lds_dst) { unsigned keep;
  asm volatile("s_mov_b32 %0, m0\n\ts_mov_b32 m0, %3\n\ts_nop 0\n\tglobal_load_lds_dwordx4 %1, %2\n\ts_mov_b32 m0, %0" : "=&s"(keep) : "v"(voff), "s"(sbase), "s"(lds_dst) : "memory"); }
typedef float f32x2_t __attribute__((ext_vector_type(2))); typedef __bf16 bf16x2_t __attribute__((ext_vector_type(2)));
__device__ __forceinline__ unsigned cvtpk_s(float lo, float hi) { f32x2_t v = {lo, hi}; bf16x2_t b = __builtin_convertvector(v, bf16x2_t); return __builtin_bit_cast(unsigned, b); }
#define AF_WAIT_BAR(N) asm volatile("s_waitcnt vmcnt(" #N ") lgkmcnt(0)\n\ts_barrier" ::: "memory")
typedef __attribute__((address_space(3))) const char* lds_cptr;
typedef short v4i16_t __attribute__((ext_vector_type(4)));
__device__ __forceinline__ i32x8 ld6(lds_cptr p16, lds_cptr p8) { const i32x4 a = *(const __attribute__((address_space(3))) i32x4*)p16; const i32x2 b = *(const __attribute__((address_space(3))) i32x2*)p8;
  return (i32x8){a.x, a.y, a.z, a.w, b.x, b.y, 0, 0}; }
__device__ __forceinline__ s16x4 vtr(lds_cptr p) { return __builtin_bit_cast(s16x4, __builtin_amdgcn_ds_read_tr16_b64_v4i16((__attribute__((address_space(3))) v4i16_t*)p)); }
__device__ __forceinline__ long tile_row(int b, int t) { return t < 4 ? (long)(16384 + 256 * b + 64 * t) : (long)(8192 * b + 64 * (t - 4)); }
__device__ __forceinline__ u32x6 to_fp6(u32x4 a0, u32x4 a1, u32x4 a2, u32x4 a3) { const u32x16 all = {a0.x, a0.y, a0.z, a0.w, a1.x, a1.y, a1.z, a1.w, a2.x, a2.y, a2.z, a2.w, a3.x, a3.y, a3.z, a3.w};
  return __builtin_amdgcn_cvt_scalef32_pk32_fp6_bf16(__builtin_bit_cast(bf16x32, all), 1.0f); }

__device__ __forceinline__ void dense_unit(int b, int h, int qb, const bf16* Q, const bf16* __restrict__ KV, const char* __restrict__ K6N, const char* __restrict__ K6R, bf16* O, char* shm, const int tid) {
  const int lane = tid & 63, r32 = lane & 31, hi = lane >> 5; const int wid = __builtin_amdgcn_readfirstlane(tid >> 6);
  const unsigned lds0 = (unsigned)(uintptr_t)shm;
  float* wsf = (float*)(shm + LDS_WS) + wid * 64;
  const bool wnp = wid < 3 || wid >= 5; const int pc = wnp ? (wid < 3 ? wid : wid - 5) : wid - 3;
  const unsigned voffK = (unsigned)(lane * 16);
  const char* sK = wnp ? K6N + h * 3072 + pc * 1024 : K6R + pc * 1024; const long kts = wnp ? 16 * 3072 : 2048;
  const unsigned voffV = (unsigned)((16 * (wid & 3) + (lane >> 2)) * 2048 + (wid >> 2) * 32 + (lane & 3) * 8) * 2u;
  const char* sV = (const char*)(KV + 1024 + 64 * h);
  const unsigned kdst = lds0 + LDS_K + (wnp ? pc * 1024 : 3072 + pc * 1024), vdst = lds0 + LDS_V + wid * 1024;
#define AF_DMA_K(t, ks) do { const long G_ = tile_row(b, (t)) >> 6; glds16(voffK, sK + G_ * kts, (unsigned)__builtin_amdgcn_readfirstlane(kdst + (ks))); } while (0)
#define AF_DMA_V(t, vs) do { const long R_ = tile_row(b, (t)); glds16(voffV, sV + R_ * 4096, (unsigned)__builtin_amdgcn_readfirstlane(vdst + (vs))); } while (0)
  const lds_cptr shm3 = (lds_cptr)shm;
  const lds_cptr kp16 = shm3 + LDS_K + hi * 1024 + r32 * 16;
  const lds_cptr kp8 = shm3 + LDS_K + 2048 + hi * 512 + r32 * 8;
  const lds_cptr vp0 = shm3 + LDS_V + ((lane >> 4) & 1) * 32 + (lane & 3) * 8 + (4 * hi + ((lane & 15) >> 2)) * 64;
  AF_DMA_K(0, 0); AF_DMA_V(0, 0); AF_DMA_K(1, KSLOT); AF_DMA_K(2, 2 * KSLOT);
  i32x8 qn, qr;
  { const bf16* qp = Q + (long)(8192 * b + 256 * qb + 32 * wid + r32) * 1536; const bf16* qa = qp + 64 * h + 32 * hi; const bf16* qc = qp + 1024 + 32 * h;
    const u32x6 n6 = to_fp6(*reinterpret_cast<const u32x4*>(qa), *reinterpret_cast<const u32x4*>(qa + 8), *reinterpret_cast<const u32x4*>(qa + 16), *reinterpret_cast<const u32x4*>(qa + 24));
    u32x6 r6 = to_fp6(*reinterpret_cast<const u32x4*>(qc), *reinterpret_cast<const u32x4*>(qc + 8), *reinterpret_cast<const u32x4*>(qc + 16), *reinterpret_cast<const u32x4*>(qc + 24));
    if (hi) r6 = (u32x6){0u, 0u, 0u, 0u, 0u, 0u};
    qn = (i32x8){(int)n6[0], (int)n6[1], (int)n6[2], (int)n6[3], (int)n6[4], (int)n6[5], 0, 0}; qr = (i32x8){(int)r6[0], (int)r6[1], (int)r6[2], (int)r6[3], (int)r6[4], (int)r6[5], 0, 0}; }
  float l_reg = 0.f; f32x16 o[2]; o[0] = f32x16{}; o[1] = f32x16{};
  f32x16 pA0, pA1, pB0, pB1; i32x8 kn0, kn1, kr0, kr1;
  int s_prev = 0, s_cur = 0, s_next = 1;
#define AF_ROT() do { s_prev = s_cur; s_cur = s_next; s_next = (s_next == 2) ? 0 : s_next + 1; } while (0)
#define AF_MF(a, b, c) __builtin_amdgcn_mfma_f32_32x32x16_bf16(a, b, c, 0, 0, 0)
#define AF_MX(a, b, c) __builtin_amdgcn_mfma_scale_f32_32x32x64_f8f6f4(a, b, c, 2, 2, 0, 0x7b7b7b7b, 0, 0x7f7f7f7f)
#define AF_EX(v) __builtin_amdgcn_exp2f(v)
  const f32x16 zero16 = f32x16{};
  AF_WAIT_BAR(0);
  { pA0 = AF_MX(ld6(kp16, kp8), qn, zero16); pA1 = AF_MX(ld6(kp16 + 512, kp8 + 256), qn, zero16);
    pA0 = AF_MX(ld6(kp16 + 3072, kp8 + 2048), qr, pA0); pA1 = AF_MX(ld6(kp16 + 3072 + 512, kp8 + 2048 + 256), qr, pA1);
#pragma unroll
    for (int r = 0; r < 16; ++r) { pA0[r] = AF_EX(pA0[r]); pA1[r] = AF_EX(pA1[r]); } }
  AF_WAIT_BAR(0);
  AF_DMA_K(3, 0); AF_DMA_V(1, VSLOT);
  AF_ROT();
  { const lds_cptr k16_ = kp16 + s_cur * KSLOT, k8_ = kp8 + s_cur * KSLOT; kn0 = ld6(k16_, k8_); kn1 = ld6(k16_ + 512, k8_ + 256); kr0 = ld6(k16_ + 3072, k8_ + 2048); kr1 = ld6(k16_ + 3072 + 512, k8_ + 2048 + 256); }
  AF_WAIT_BAR(2);
  s16x4 vlo[8], vhi[8]; u32x4 pw0, pw1, pw2, pw3;
#define AF_PKW(P, B) cvtpk_s(P[B], P[B + 1])
#define AF_PAF(k) __builtin_bit_cast(bf16x8, pw##k)
#define AF_VFR(i) (bf16x8){vlo[i][0], vlo[i][1], vlo[i][2], vlo[i][3], vhi[i][0], vhi[i][1], vhi[i][2], vhi[i][3]}
#define AF_PIN(x) asm volatile("" : "+v"(x))
#define AF_VRD(i) do { vlo[i] = vtr(vp_ + (((i) >> 2) * 4096 + ((i) & 3) * 1024)); vhi[i] = vtr(vp_ + (((i) >> 2) * 4096 + ((i) & 3) * 1024 + 512)); AF_SBAR(); } while (0)
#define AF_GB(MF, X, B) do { MF; X[B] = AF_EX(X[B]); X[B + 1] = AF_EX(X[B + 1]); X[B + 2] = AF_EX(X[B + 2]); X[B + 3] = AF_EX(X[B + 3]); AF_PIN(X); AF_SBAR(); } while (0)
#define AF_KRD(G, j) do { if (G) { const lds_cptr k16_ = kp16 + s_next * KSLOT, k8_ = kp8 + s_next * KSLOT; \
      if ((j) == 0) kn0 = ld6(k16_, k8_); if ((j) == 1) kn1 = ld6(k16_ + 512, k8_ + 256); \
      if ((j) == 2) kr0 = ld6(k16_ + 3072, k8_ + 2048); if ((j) == 3) kr1 = ld6(k16_ + 3072 + 512, k8_ + 2048 + 256); AF_SBAR(); } } while (0)
#define AF_A4(P, B) do { sacc += P[B]; sacc += P[B + 1]; sacc += P[B + 2]; sacc += P[B + 3]; } while (0)
#define AF_STEP(C0, C1, P0, P1, t, GK, GV, GL) do { AF_SBAR(); \
    const lds_cptr vp_ = vp0 + s_prev * VSLOT; \
    float sacc = (P0[0] + P0[1]); \
    AF_VRD(0); AF_VRD(4); \
    { C0 = AF_MX(kn0, qn, zero16); sacc += P0[2]; sacc += P0[3]; AF_A4(P0, 4); AF_PIN(sacc); \
      pw0[0] = AF_PKW(P0, 0); pw0[1] = AF_PKW(P0, 2); pw0[2] = AF_PKW(P0, 4); pw0[3] = AF_PKW(P0, 6); AF_PIN(pw0); AF_SBAR(); } \
    AF_VRD(1); AF_VRD(5); \
    { C1 = AF_MX(kn1, qn, zero16); AF_A4(P0, 8); AF_A4(P0, 12); AF_PIN(sacc); \
      pw1[0] = AF_PKW(P0, 8); pw1[1] = AF_PKW(P0, 10); pw1[2] = AF_PKW(P0, 12); pw1[3] = AF_PKW(P0, 14); AF_PIN(pw1); AF_SBAR(); } \
    AF_VRD(2); AF_VRD(6); \
    { C0 = AF_MX(kr0, qr, C0); AF_A4(P1, 0); AF_A4(P1, 4); AF_PIN(sacc); \
      pw2[0] = AF_PKW(P1, 0); pw2[1] = AF_PKW(P1, 2); pw2[2] = AF_PKW(P1, 4); pw2[3] = AF_PKW(P1, 6); AF_PIN(pw2); AF_SBAR(); } \
    if (GK) { AF_DMA_K((t) + 3, s_cur * KSLOT); AF_SBAR(); } \
    AF_VRD(3); AF_VRD(7); \
    { C1 = AF_MX(kr1, qr, C1); AF_A4(P1, 8); AF_A4(P1, 12); AF_PIN(sacc); \
      pw3[0] = AF_PKW(P1, 8); pw3[1] = AF_PKW(P1, 10); pw3[2] = AF_PKW(P1, 12); pw3[3] = AF_PKW(P1, 14); AF_PIN(pw3); AF_SBAR(); } \
    if (GV) { AF_DMA_V((t) + 1, s_next * VSLOT); AF_SBAR(); } \
    l_reg += sacc; \
    AF_SBAR(); \
    AF_GB(o[0] = AF_MF(AF_PAF(0), AF_VFR(0), o[0]), C0, 0);  AF_KRD(GL, 0); \
    AF_GB(o[1] = AF_MF(AF_PAF(0), AF_VFR(4), o[1]), C0, 4);  AF_KRD(GL, 1); \
    AF_GB(o[0] = AF_MF(AF_PAF(1), AF_VFR(1), o[0]), C0, 8);  AF_KRD(GL, 2); \
    AF_GB(o[1] = AF_MF(AF_PAF(1), AF_VFR(5), o[1]), C0, 12); AF_KRD(GL, 3); \
    AF_GB(o[0] = AF_MF(AF_PAF(2), AF_VFR(2), o[0]), C1, 0); \
    AF_GB(o[1] = AF_MF(AF_PAF(2), AF_VFR(6), o[1]), C1, 4); \
    AF_GB(o[0] = AF_MF(AF_PAF(3), AF_VFR(3), o[0]), C1, 8); \
    AF_GB(o[1] = AF_MF(AF_PAF(3), AF_VFR(7), o[1]), C1, 12); \
  } while (0)
  int t = 1;
  for (; t + 3 < NT; t += 2) {
    AF_STEP(pB0, pB1, pA0, pA1, t, true, true, true);     AF_WAIT_BAR(2); AF_ROT();
    AF_STEP(pA0, pA1, pB0, pB1, t + 1, true, true, true); AF_WAIT_BAR(2); AF_ROT();
  }
  AF_STEP(pB0, pB1, pA0, pA1, NT - 3, false, true, true);  AF_WAIT_BAR(1); AF_ROT();
  AF_STEP(pA0, pA1, pB0, pB1, NT - 2, false, true, true);  AF_WAIT_BAR(0); AF_ROT();
  AF_STEP(pB0, pB1, pA0, pA1, NT - 1, false, false, false);
  { float sacc = pB0[0] + pB0[1];
#pragma unroll
    for (int r = 2; r < 16; ++r) sacc += pB0[r];
#pragma unroll
    for (int r = 0; r < 16; ++r) sacc += pB1[r];
    l_reg += sacc;
    pw0 = (u32x4){AF_PKW(pB0, 0), AF_PKW(pB0, 2), AF_PKW(pB0, 4), AF_PKW(pB0, 6)}; pw1 = (u32x4){AF_PKW(pB0, 8), AF_PKW(pB0, 10), AF_PKW(pB0, 12), AF_PKW(pB0, 14)};
    pw2 = (u32x4){AF_PKW(pB1, 0), AF_PKW(pB1, 2), AF_PKW(pB1, 4), AF_PKW(pB1, 6)}; pw3 = (u32x4){AF_PKW(pB1, 8), AF_PKW(pB1, 10), AF_PKW(pB1, 12), AF_PKW(pB1, 14)};
    AF_SBAR();
    const lds_cptr vp_ = vp0 + s_cur * VSLOT;
#pragma unroll
    for (int i = 0; i < 8; ++i) { vlo[i] = vtr(vp_ + ((i >> 2) * 4096 + (i & 3) * 1024)); vhi[i] = vtr(vp_ + ((i >> 2) * 4096 + (i & 3) * 1024 + 512)); }
    o[0] = AF_MF(AF_PAF(0), AF_VFR(0), o[0]); o[1] = AF_MF(AF_PAF(0), AF_VFR(4), o[1]);
    o[0] = AF_MF(AF_PAF(1), AF_VFR(1), o[0]); o[1] = AF_MF(AF_PAF(1), AF_VFR(5), o[1]);
    o[0] = AF_MF(AF_PAF(2), AF_VFR(2), o[0]); o[1] = AF_MF(AF_PAF(2), AF_VFR(6), o[1]);
    o[0] = AF_MF(AF_PAF(3), AF_VFR(3), o[0]); o[1] = AF_MF(AF_PAF(3), AF_VFR(7), o[1]); }
  { auto rr = __builtin_amdgcn_permlane32_swap(__float_as_uint(l_reg), __float_as_uint(l_reg), false, false); l_reg = __uint_as_float(rr[0]) + __uint_as_float(rr[1]); }
  if (hi == 0) wsf[32 + r32] = l_reg; asm volatile("s_waitcnt lgkmcnt(0)" ::: "memory");
  float rli[16];
#pragma unroll
  for (int r = 0; r < 16; ++r) rli[r] = __builtin_amdgcn_rcpf(wsf[32 + crow(r, hi)]);
  bf16* Ow = O + (long)(8192 * b + 256 * qb + 32 * wid) * 1024 + 64 * h;
  { bf16* stg = (bf16*)(shm + LDS_OST) + wid * 2048;
#pragma unroll
    for (int r = 0; r < 16; ++r) { const int orow = crow(r, hi);
#pragma unroll
      for (int d0 = 0; d0 < 2; ++d0) stg[orow * 64 + d0 * 32 + r32] = (bf16)(cvtpk_s(o[d0][r] * rli[r], 0.f) & 0xffffu); }
    asm volatile("s_waitcnt lgkmcnt(0)" ::: "memory");
#pragma unroll
    for (int i = 0; i < 4; ++i) { const int row = i * 8 + (lane >> 3), ch = lane & 7; const u32x4 v = *(const u32x4*)(stg + row * 64 + ch * 8); *(u32x4*)(Ow + (long)row * 1024 + ch * 8) = v; } }
  asm volatile("s_waitcnt vmcnt(0) lgkmcnt(0)\n\ts_barrier" ::: "memory");
#undef AF_DMA_K
#undef AF_DMA_V
#undef AF_ROT
#undef AF_PKW
#undef AF_PAF
#undef AF_VFR
#undef AF_PIN
#undef AF_MF
#undef AF_MX
#undef AF_EX
#undef AF_VRD
#undef AF_GB
#undef AF_KRD
#undef AF_A4
#undef AF_STEP
}
#undef AF_SBAR
#undef AF_WAIT_BAR
}
namespace attf {
typedef unsigned short bf16;
using bf16x8 = __attribute__((ext_vector_type(8))) short;
using s16x4 = __attribute__((ext_vector_type(4))) short;
using f32x16 = __attribute__((ext_vector_type(16))) float;
using u32x4 = __attribute__((ext_vector_type(4))) unsigned;
using i32x2 = __attribute__((ext_vector_type(2))) int;
using i32x4 = __attribute__((ext_vector_type(4))) int;
using i32x8 = __attribute__((ext_vector_type(8))) int;
using u32x6 = __attribute__((ext_vector_type(6))) unsigned;
using u32x16 = __attribute__((ext_vector_type(16))) unsigned;
typedef __bf16 bf16x32 __attribute__((ext_vector_type(32)));
constexpr int NW = 8, KSLOT = 12288, VSLOT = 8192;
constexpr int LDS_K = 0, LDS_V = 3 * KSLOT, LDS_WS = LDS_V + 3 * VSLOT, LDS_OST = LDS_WS + NW * 64 * 4, LDS_RPB = LDS_OST + NW * 4096, LDS_BYTES = LDS_RPB + 2048;
__device__ __forceinline__ int crow(int r, int hi) { return (r & 3) + 8 * (r >> 2) + 4 * hi; }
#define AF_SBAR() __builtin_amdgcn_sched_barrier(0)
__device__ __forceinline__ void glds16(unsigned voff, const void* sbase, unsigned lds_dst) { unsigned keep;
  asm volatile("s_mov_b32 %0, m0\n\ts_mov_b32 m0, %3\n\ts_nop 0\n\tglobal_load_lds_dwordx4 %1, %2\n\ts_mov_b32 m0, %0" : "=&s"(keep) : "v"(voff), "s"(sbase), "s"(lds_dst) : "memory"); }
typedef float f32x2_t __attribute__((ext_vector_type(2))); typedef __bf16 bf16x2_t __attribute__((ext_vector_type(2)));
__device__ __forceinline__ unsigned cvtpk_s(float lo, float hi) { f32x2_t v = {lo, hi}; bf16x2_t b = __builtin_convertvector(v, bf16x2_t); return __builtin_bit_cast(unsigned, b); }
#define AF_WAIT_BAR(N) asm volatile("s_waitcnt vmcnt(" #N ") lgkmcnt(0)\n\ts_barrier" ::: "memory")
typedef __attribute__((address_space(3))) const char* lds_cptr;
typedef short v4i16_t __attribute__((ext_vector_type(4)));
__device__ __forceinline__ void kload2(bf16x8* kf, lds_cptr kp, int j) { kf[2 * j] = *(const __attribute__((address_space(3))) bf16x8*)(kp + j * 2048); kf[2 * j + 1] = *(const __attribute__((address_space(3))) bf16x8*)(kp + j * 2048 + 512); }
__device__ __forceinline__ i32x8 ld6(lds_cptr p16, lds_cptr p8) { const i32x4 a = *(const __attribute__((address_space(3))) i32x4*)p16; const i32x2 b = *(const __attribute__((address_space(3))) i32x2*)p8;
  const i32x4 b4 = __builtin_shufflevector(b, b, 0, 1, -1, -1); return __builtin_shufflevector(a, b4, 0, 1, 2, 3, 4, 5, -1, -1); }
__device__ __forceinline__ i32x8 to_fp6(u32x4 a0, u32x4 a1, u32x4 a2, u32x4 a3) { const u32x16 all = {a0.x, a0.y, a0.z, a0.w, a1.x, a1.y, a1.z, a1.w, a2.x, a2.y, a2.z, a2.w, a3.x, a3.y, a3.z, a3.w};
  const u32x6 c = __builtin_amdgcn_cvt_scalef32_pk32_fp6_bf16(__builtin_bit_cast(bf16x32, all), 1.0f); return __builtin_bit_cast(i32x8, __builtin_shufflevector(c, c, 0, 1, 2, 3, 4, 5, -1, -1)); }
__device__ __forceinline__ s16x4 vtr(lds_cptr p) { return __builtin_bit_cast(s16x4, __builtin_amdgcn_ds_read_tr16_b64_v4i16((__attribute__((address_space(3))) v4i16_t*)p)); }

template <int DKC, class U, bool F6 = false>
__device__ __forceinline__ void fast_unit(const U& u, char* shm, int tid) {
  static_assert(DKC == 8 || DKC == 12, "q/k dim 64 or 96"); static_assert(!F6 || DKC == 8, "fp6 logits: q/k dim 64");
  asm volatile("" : "+v"(tid));
  constexpr int ND0 = DKC / 2;
  const int lane = tid & 63, r32 = lane & 31, hi = lane >> 5; const int wid = __builtin_amdgcn_readfirstlane(tid >> 6);
  const unsigned lds0 = (unsigned)(uintptr_t)shm;
  float* wsf = (float*)(shm + LDS_WS) + wid * 64;
  const int NT = u.nt();
  const unsigned voffKA = (unsigned)(lane * u.kpitch + 8 * wid) * 2u;
  const unsigned voffKB = (unsigned)(lane * 32 + 8 * (wid & 3)) * 2u;
  const unsigned voffV = (unsigned)((16 * (wid & 3) + (lane >> 2)) * u.vpitch + (wid >> 2) * 32 + (lane & 3) * 8) * 2u;
  const unsigned kdstA = lds0 + LDS_K + wid * 1024, kdstB = lds0 + LDS_K + (8 + (wid & 3)) * 1024, vdst = lds0 + LDS_V + wid * 1024;
  const int pc6 = wid % 3; const unsigned voffK6 = (unsigned)(lane * 16), kdst6 = lds0 + LDS_K + pc6 * 1024;
#define AF_DMA_KA(t, ks) do { const long R_ = u.trow(t); if constexpr (F6) glds16(voffK6, u.k6base + (R_ >> 6) * 30720 + pc6 * 1024, (unsigned)__builtin_amdgcn_readfirstlane(kdst6 + (ks))); \
    else glds16(voffKA, (const char*)u.kbase + R_ * (2 * u.kpitch), (unsigned)__builtin_amdgcn_readfirstlane(kdstA + (ks))); } while (0)
#define AF_DMA_KB(t, ks) do { if constexpr (DKC == 12) { const long R_ = u.trow(t); glds16(voffKB, (const char*)u.krbase + R_ * 64, (unsigned)__builtin_amdgcn_readfirstlane(kdstB + (ks))); } } while (0)
#define AF_DMA_K(t, ks) do { AF_DMA_KA(t, ks); AF_DMA_KB(t, ks); } while (0)
#define AF_DMA_V(t, vs) do { const long R_ = u.trow(t); glds16(voffV, (const char*)u.vbase + R_ * (2 * u.vpitch), (unsigned)__builtin_amdgcn_readfirstlane(vdst + (vs))); } while (0)
#define AF_WAITN(NSTEPS_K, NV) do { if constexpr (DKC == 12) { if ((NSTEPS_K) == 2 && (NV) == 1) AF_WAIT_BAR(5); else if ((NSTEPS_K) == 1 && (NV) == 1) AF_WAIT_BAR(3); else if ((NV) == 1) AF_WAIT_BAR(1); else AF_WAIT_BAR(0); } \
    else { if ((NSTEPS_K) == 2 && (NV) == 1) AF_WAIT_BAR(3); else if ((NSTEPS_K) == 1 && (NV) == 1) AF_WAIT_BAR(2); else if ((NV) == 1) AF_WAIT_BAR(1); else AF_WAIT_BAR(0); } } while (0)
  const lds_cptr shm3 = (lds_cptr)shm; const lds_cptr kp0 = shm3 + LDS_K + hi * 1024 + r32 * 16;
  const lds_cptr kp8 = shm3 + LDS_K + 2048 + hi * 512 + r32 * 8;
  const lds_cptr vp0 = shm3 + LDS_V + ((lane >> 4) & 1) * 32 + (lane & 3) * 8 + (4 * hi + ((lane & 15) >> 2)) * 64;
  bf16x8 qr[ND0]; i32x8 qn;
  if constexpr (F6) { const bf16* qa = u.qptr(wid, r32, 0, 0) + 32 * hi;
    qn = to_fp6(*reinterpret_cast<const u32x4*>(qa), *reinterpret_cast<const u32x4*>(qa + 8), *reinterpret_cast<const u32x4*>(qa + 16), *reinterpret_cast<const u32x4*>(qa + 24)); }
  else {
#pragma unroll
    for (int d0 = 0; d0 < ND0; ++d0) qr[d0] = *reinterpret_cast<const bf16x8*>(u.qptr(wid, r32, d0, hi)); }
  AF_DMA_K(0, 0); AF_DMA_V(0, 0); AF_DMA_K(1, KSLOT); AF_DMA_K(2, 2 * KSLOT);
  float l_reg = 0.f; f32x16 o[2]; o[0] = f32x16{}; o[1] = f32x16{};
  f32x16 pA0, pA1, pB0, pB1; bf16x8 kf[DKC]; i32x8 kn0, kn1;
#define AF_MX6(a, b, c) __builtin_amdgcn_mfma_scale_f32_32x32x64_f8f6f4(a, b, c, 2, 2, 0, 0x7b7b7b7b, 0, 0x7f7f7f7f)
  int s_prev = 0, s_cur = 0, s_next = 1;
#define AF_ROT() do { s_prev = s_cur; s_cur = s_next; s_next = (s_next == 2) ? 0 : s_next + 1; } while (0)
  AF_WAITN(2, 1);
  { const char* kb = shm + LDS_K + hi * 1024 + r32 * 16; pA0 = f32x16{}; pA1 = f32x16{};
    if constexpr (F6) { pA0 = AF_MX6(ld6(kp0, kp8), qn, pA0); pA1 = AF_MX6(ld6(kp0 + 512, kp8 + 256), qn, pA1); }
    else
#pragma unroll
    for (int d0 = 0; d0 < ND0; ++d0) { const bf16x8 b0 = *reinterpret_cast<const bf16x8*>(kb + d0 * 2048), b1 = *reinterpret_cast<const bf16x8*>(kb + d0 * 2048 + 512);
      pA0 = __builtin_amdgcn_mfma_f32_32x32x16_bf16(b0, qr[d0], pA0, 0, 0, 0); pA1 = __builtin_amdgcn_mfma_f32_32x32x16_bf16(b1, qr[d0], pA1, 0, 0, 0); }
    if constexpr (U::HAS_MASK) u.mask(pA0, pA1, 0, wid, r32, hi);
#pragma unroll
    for (int r = 0; r < 16; ++r) { pA0[r] = __builtin_amdgcn_exp2f(pA0[r]); pA1[r] = __builtin_amdgcn_exp2f(pA1[r]); } }
  AF_WAIT_BAR(0);
  AF_DMA_K(3, 0); AF_DMA_V(1, VSLOT);
  AF_ROT();
  if constexpr (F6) { kn0 = ld6(kp0 + s_cur * KSLOT, kp8 + s_cur * KSLOT); kn1 = ld6(kp0 + s_cur * KSLOT + 512, kp8 + s_cur * KSLOT + 256); }
  else {
#pragma unroll
    for (int j = 0; j < ND0; ++j) kload2(kf, kp0 + s_cur * KSLOT, j); }
  AF_WAITN(1, 1);
  s16x4 vlo[8], vhi[8]; u32x4 pw0, pw1, pw2, pw3;
#define AF_PKW(P, B) cvtpk_s(P[B], P[B + 1])
#define AF_PAF(k) __builtin_bit_cast(bf16x8, pw##k)
#define AF_VFR(i) (bf16x8){vlo[i][0], vlo[i][1], vlo[i][2], vlo[i][3], vhi[i][0], vhi[i][1], vhi[i][2], vhi[i][3]}
#define AF_PIN(x) asm volatile("" : "+v"(x))
#define AF_MF(a, b, c) __builtin_amdgcn_mfma_f32_32x32x16_bf16(a, b, c, 0, 0, 0)
#define AF_EX(v) __builtin_amdgcn_exp2f(v)
#define AF_VRD(i) do { vlo[i] = vtr(vp_ + (((i) >> 2) * 4096 + ((i) & 3) * 1024)); vhi[i] = vtr(vp_ + (((i) >> 2) * 4096 + ((i) & 3) * 1024 + 512)); AF_SBAR(); } while (0)
#define AF_GA4(MF, A0, A1, A2, A3, W0, W1, PW) do { MF; sacc += A0; sacc += A1; sacc += A2; sacc += A3; AF_PIN(sacc); W0; W1; AF_PIN(PW); AF_SBAR(); } while (0)
#define AF_GA3(MF, A0, A1, A2, W0, W1, PW) do { MF; sacc += A0; sacc += A1; sacc += A2; AF_PIN(sacc); W0; W1; AF_PIN(PW); AF_SBAR(); } while (0)
#define AF_GA2(MF, A0, A1, W0, PW) do { MF; sacc += A0; sacc += A1; AF_PIN(sacc); W0; AF_PIN(PW); AF_SBAR(); } while (0)
#define AF_GB(MF, X, B) do { MF; X[B] = AF_EX(X[B]); X[B + 1] = AF_EX(X[B + 1]); X[B + 2] = AF_EX(X[B + 2]); X[B + 3] = AF_EX(X[B + 3]); AF_PIN(X); AF_SBAR(); } while (0)
#define AF_KRD(G, j) do { if constexpr (F6) { if ((j) < 2) { if (G) { if ((j) == 0) kn0 = ld6(kp0 + s_next * KSLOT, kp8 + s_next * KSLOT); else kn1 = ld6(kp0 + s_next * KSLOT + 512, kp8 + s_next * KSLOT + 256); AF_SBAR(); } } } \
    else if ((j) < ND0) { if (G) { kload2(kf, kp0 + s_next * KSLOT, (j) < ND0 ? (j) : 0); AF_SBAR(); } } } while (0)
  const f32x16 zero16 = f32x16{};
#define AF_PHASE_A12(C0, C1, P0, P1, t, GK, GV) do { \
    AF_VRD(0); float sacc = (P0[0] + P0[1]); \
    AF_GA3(C0 = AF_MF(kf[0], qr[0], zero16), P0[2], P0[3], P0[4],     pw0[0] = AF_PKW(P0, 0), pw0[1] = AF_PKW(P0, 2), pw0); \
    AF_VRD(4); AF_GA3(C1 = AF_MF(kf[1], qr[0], zero16), P0[5], P0[6], P0[7],     pw0[2] = AF_PKW(P0, 4), pw0[3] = AF_PKW(P0, 6), pw0); \
    AF_VRD(1); AF_GA3(C0 = AF_MF(kf[2], qr[1], C0),     P0[8], P0[9], P0[10],    pw1[0] = AF_PKW(P0, 8), pw1[1] = AF_PKW(P0, 10), pw1); \
    AF_VRD(5); AF_GA3(C1 = AF_MF(kf[3], qr[1], C1),     P0[11], P0[12], P0[13],  pw1[2] = AF_PKW(P0, 12), pw1[3] = AF_PKW(P0, 14), pw1); \
    AF_VRD(2); AF_GA3(C0 = AF_MF(kf[4], qr[2], C0),     P0[14], P0[15], P1[0],   pw2[0] = AF_PKW(P1, 0), pw2[1] = AF_PKW(P1, 2), pw2); \
    AF_VRD(6); AF_GA3(C1 = AF_MF(kf[5], qr[2], C1),     P1[1], P1[2], P1[3],     pw2[2] = AF_PKW(P1, 4), pw2[3] = AF_PKW(P1, 6), pw2); \
    AF_VRD(3); AF_GA2(C0 = AF_MF(kf[6], qr[3], C0),     P1[4], P1[5],            pw3[0] = AF_PKW(P1, 8), pw3); \
    AF_VRD(7); AF_GA2(C1 = AF_MF(kf[7], qr[3], C1),     P1[6], P1[7],            pw3[1] = AF_PKW(P1, 10), pw3); \
    AF_GA2(C0 = AF_MF(kf[8 % DKC], qr[4 % ND0], C0),    P1[8], P1[9],            pw3[2] = AF_PKW(P1, 12), pw3); \
    if (GK) { AF_DMA_KA((t) + 3, s_cur * KSLOT); AF_SBAR(); } \
    AF_GA2(C1 = AF_MF(kf[9 % DKC], qr[4 % ND0], C1),    P1[10], P1[11],          pw3[3] = AF_PKW(P1, 14), pw3); \
    if (GK) { AF_DMA_KB((t) + 3, s_cur * KSLOT); AF_SBAR(); } \
    { C0 = AF_MF(kf[10 % DKC], qr[5 % ND0], C0); sacc += P1[12]; sacc += P1[13]; AF_PIN(sacc); AF_SBAR(); } \
    if (GV) { AF_DMA_V((t) + 1, s_next * VSLOT); AF_SBAR(); } \
    { C1 = AF_MF(kf[11 % DKC], qr[5 % ND0], C1); sacc += P1[14]; sacc += P1[15]; AF_PIN(sacc); AF_SBAR(); } \
    l_reg += sacc; } while (0)
#define AF_PHASE_A8(C0, C1, P0, P1, t, GK, GV) do { \
    AF_VRD(0); float sacc = (P0[0] + P0[1]); \
    AF_GA4(C0 = AF_MF(kf[0], qr[0], zero16), P0[2], P0[3], P0[4], P0[5],       pw0[0] = AF_PKW(P0, 0), pw0[1] = AF_PKW(P0, 2), pw0); \
    AF_VRD(4); AF_GA4(C1 = AF_MF(kf[1], qr[0], zero16), P0[6], P0[7], P0[8], P0[9],       pw0[2] = AF_PKW(P0, 4), pw0[3] = AF_PKW(P0, 6), pw0); \
    AF_VRD(1); AF_GA4(C0 = AF_MF(kf[2], qr[1], C0),     P0[10], P0[11], P0[12], P0[13],   pw1[0] = AF_PKW(P0, 8), pw1[1] = AF_PKW(P0, 10), pw1); \
    AF_VRD(5); AF_GA4(C1 = AF_MF(kf[3], qr[1], C1),     P0[14], P0[15], P1[0], P1[1],     pw1[2] = AF_PKW(P0, 12), pw1[3] = AF_PKW(P0, 14), pw1); \
    AF_VRD(2); AF_GA4(C0 = AF_MF(kf[4], qr[2], C0),     P1[2], P1[3], P1[4], P1[5],       pw2[0] = AF_PKW(P1, 0), pw2[1] = AF_PKW(P1, 2), pw2); \
    AF_VRD(6); AF_GA4(C1 = AF_MF(kf[5], qr[2], C1),     P1[6], P1[7], P1[8], P1[9],       pw2[2] = AF_PKW(P1, 4), pw2[3] = AF_PKW(P1, 6), pw2); \
    AF_VRD(3); AF_GA4(C0 = AF_MF(kf[6], qr[3], C0),     P1[10], P1[11], P1[12], P1[13],   pw3[0] = AF_PKW(P1, 8), pw3[1] = AF_PKW(P1, 10), pw3); \
    AF_VRD(7); AF_GA4(C1 = AF_MF(kf[7], qr[3], C1),     P1[14], P1[15], 0.f, 0.f,         pw3[2] = AF_PKW(P1, 12), pw3[3] = AF_PKW(P1, 14), pw3); \
    l_reg += sacc; \
    if (GK) { AF_DMA_KA((t) + 3, s_cur * KSLOT); } if (GV) { AF_DMA_V((t) + 1, s_next * VSLOT); } } while (0)
#define AF_A4(P, B) do { sacc += P[B]; sacc += P[B + 1]; sacc += P[B + 2]; sacc += P[B + 3]; } while (0)
#define AF_PHASE_A6(C0, C1, P0, P1, t, GK, GV) do { \
    AF_VRD(0); AF_VRD(4); float sacc = (P0[0] + P0[1]); \
    { C0 = AF_MX6(kn0, qn, zero16); sacc += P0[2]; sacc += P0[3]; AF_A4(P0, 4); AF_A4(P0, 8); AF_A4(P0, 12); AF_PIN(sacc); \
      pw0[0] = AF_PKW(P0, 0); pw0[1] = AF_PKW(P0, 2); pw0[2] = AF_PKW(P0, 4); pw0[3] = AF_PKW(P0, 6); AF_PIN(pw0); pw1[0] = AF_PKW(P0, 8); pw1[1] = AF_PKW(P0, 10); pw1[2] = AF_PKW(P0, 12); pw1[3] = AF_PKW(P0, 14); AF_PIN(pw1); AF_SBAR(); } \
    AF_VRD(1); AF_VRD(5); AF_VRD(2); AF_VRD(6); \
    { C1 = AF_MX6(kn1, qn, zero16); AF_A4(P1, 0); AF_A4(P1, 4); AF_A4(P1, 8); AF_A4(P1, 12); AF_PIN(sacc); \
      pw2[0] = AF_PKW(P1, 0); pw2[1] = AF_PKW(P1, 2); pw2[2] = AF_PKW(P1, 4); pw2[3] = AF_PKW(P1, 6); AF_PIN(pw2); pw3[0] = AF_PKW(P1, 8); pw3[1] = AF_PKW(P1, 10); pw3[2] = AF_PKW(P1, 12); pw3[3] = AF_PKW(P1, 14); AF_PIN(pw3); AF_SBAR(); } \
    AF_VRD(3); AF_VRD(7); \
    l_reg += sacc; \
    if (GK) { AF_DMA_KA((t) + 3, s_cur * KSLOT); } if (GV) { AF_DMA_V((t) + 1, s_next * VSLOT); } } while (0)
#define AF_STEP(C0, C1, P0, P1, t, GK, GV, GL) do { AF_SBAR(); \
    const lds_cptr vp_ = vp0 + s_prev * VSLOT; \
    if constexpr (F6) AF_PHASE_A6(C0, C1, P0, P1, t, GK, GV); else if constexpr (DKC == 12) AF_PHASE_A12(C0, C1, P0, P1, t, GK, GV); else AF_PHASE_A8(C0, C1, P0, P1, t, GK, GV); \
    if constexpr (U::HAS_MASK) u.mask(C0, C1, (t), wid, r32, hi); \
    AF_SBAR(); \
    AF_GB(o[0] = AF_MF(AF_PAF(0), AF_VFR(0), o[0]), C0, 0);  AF_KRD(GL, 0); \
    AF_GB(o[1] = AF_MF(AF_PAF(0), AF_VFR(4), o[1]), C0, 4);  AF_KRD(GL, 1); \
    AF_GB(o[0] = AF_MF(AF_PAF(1), AF_VFR(1), o[0]), C0, 8);  AF_KRD(GL, 2); \
    AF_GB(o[1] = AF_MF(AF_PAF(1), AF_VFR(5), o[1]), C0, 12); AF_KRD(GL, 3); \
    AF_GB(o[0] = AF_MF(AF_PAF(2), AF_VFR(2), o[0]), C1, 0);  AF_KRD(GL, 4); \
    AF_GB(o[1] = AF_MF(AF_PAF(2), AF_VFR(6), o[1]), C1, 4);  AF_KRD(GL, 5); \
    AF_GB(o[0] = AF_MF(AF_PAF(3), AF_VFR(3), o[0]), C1, 8); \
    AF_GB(o[1] = AF_MF(AF_PAF(3), AF_VFR(7), o[1]), C1, 12); \
  } while (0)
  int t = 1;
  for (; t + 3 < NT; t += 2) {
    AF_STEP(pB0, pB1, pA0, pA1, t, true, true, true);     AF_WAITN(1, 1); AF_ROT();
    AF_STEP(pA0, pA1, pB0, pB1, t + 1, true, true, true); AF_WAITN(1, 1); AF_ROT();
  }
  AF_STEP(pB0, pB1, pA0, pA1, NT - 3, false, true, true);  AF_WAITN(0, 1); AF_ROT();
  AF_STEP(pA0, pA1, pB0, pB1, NT - 2, false, true, true);  AF_WAIT_BAR(0); AF_ROT();
  AF_STEP(pB0, pB1, pA0, pA1, NT - 1, false, false, false);
  { float sacc = pB0[0] + pB0[1];
#pragma unroll
    for (int r = 2; r < 16; ++r) sacc += pB0[r];
#pragma unroll
    for (int r = 0; r < 16; ++r) sacc += pB1[r];
    l_reg += sacc;
    pw0 = (u32x4){AF_PKW(pB0, 0), AF_PKW(pB0, 2), AF_PKW(pB0, 4), AF_PKW(pB0, 6)}; pw1 = (u32x4){AF_PKW(pB0, 8), AF_PKW(pB0, 10), AF_PKW(pB0, 12), AF_PKW(pB0, 14)};
    pw2 = (u32x4){AF_PKW(pB1, 0), AF_PKW(pB1, 2), AF_PKW(pB1, 4), AF_PKW(pB1, 6)}; pw3 = (u32x4){AF_PKW(pB1, 8), AF_PKW(pB1, 10), AF_PKW(pB1, 12), AF_PKW(pB1, 14)};
    AF_SBAR();
    const lds_cptr vp_ = vp0 + s_cur * VSLOT;
#pragma unroll
    for (int i = 0; i < 8; ++i) { vlo[i] = vtr(vp_ + ((i >> 2) * 4096 + (i & 3) * 1024)); vhi[i] = vtr(vp_ + ((i >> 2) * 4096 + (i & 3) * 1024 + 512)); }
    o[0] = AF_MF(AF_PAF(0), AF_VFR(0), o[0]); o[1] = AF_MF(AF_PAF(0), AF_VFR(4), o[1]);
    o[0] = AF_MF(AF_PAF(1), AF_VFR(1), o[0]); o[1] = AF_MF(AF_PAF(1), AF_VFR(5), o[1]);
    o[0] = AF_MF(AF_PAF(2), AF_VFR(2), o[0]); o[1] = AF_MF(AF_PAF(2), AF_VFR(6), o[1]);
    o[0] = AF_MF(AF_PAF(3), AF_VFR(3), o[0]); o[1] = AF_MF(AF_PAF(3), AF_VFR(7), o[1]); }
  { auto rr = __builtin_amdgcn_permlane32_swap(__float_as_uint(l_reg), __float_as_uint(l_reg), false, false); l_reg = __uint_as_float(rr[0]) + __uint_as_float(rr[1]); }
  l_reg += __builtin_amdgcn_exp2f(u.sink(wid));
  if (hi == 0) wsf[32 + r32] = l_reg; asm volatile("s_waitcnt lgkmcnt(0)" ::: "memory");
  float rli[16];
#pragma unroll
  for (int r = 0; r < 16; ++r) rli[r] = __builtin_amdgcn_rcpf(wsf[32 + crow(r, hi)]);
  bf16* Ow = u.orow0(wid);
  { bf16* stg = (bf16*)(shm + LDS_OST) + wid * 2048;
#pragma unroll
    for (int r = 0; r < 16; ++r) { const int orow = crow(r, hi);
#pragma unroll
      for (int d0 = 0; d0 < 2; ++d0) stg[orow * 64 + d0 * 32 + r32] = (bf16)(cvtpk_s(o[d0][r] * rli[r], 0.f) & 0xffffu); }
    asm volatile("s_waitcnt lgkmcnt(0)" ::: "memory");
#pragma unroll
    for (int i = 0; i < 4; ++i) { const int row = i * 8 + (lane >> 3), ch = lane & 7; const u32x4 v = *(const u32x4*)(stg + row * 64 + ch * 8); *(u32x4*)(Ow + (long)row * 1024 + ch * 8) = v; } }
  asm volatile("s_waitcnt vmcnt(0) lgkmcnt(0)\n\ts_barrier" ::: "memory");
#undef AF_DMA_KA
#undef AF_DMA_KB
#undef AF_DMA_K
#undef AF_DMA_V
#undef AF_WAITN
#undef AF_ROT
#undef AF_PKW
#undef AF_PAF
#undef AF_VFR
#undef AF_PIN
#undef AF_MF
#undef AF_EX
#undef AF_VRD
#undef AF_GA4
#undef AF_GA3
#undef AF_GA2
#undef AF_GB
#undef AF_KRD
#undef AF_PHASE_A12
#undef AF_PHASE_A8
#undef AF_PHASE_A6
#undef AF_A4
#undef AF_MX6
#undef AF_STEP
}

constexpr int ROWS_LAT = 16384;
constexpr float LOG2E_ = 1.4426950408889634f;
__device__ __forceinline__ int clampi(int v, int lo, int hi_) { return v < lo ? lo : (v > hi_ ? hi_ : v); }
struct FDense {
  static constexpr bool HAS_MASK = false;
  const bf16* Q; const bf16* kbase; const bf16* vbase; const bf16* krbase; bf16* O; int b, h, qb; static constexpr int kpitch = 2048, vpitch = 2048; const char* k6base = nullptr;
  __device__ __forceinline__ void init(const bf16* Q_, const bf16* KV, const bf16* KR, bf16* O_, int b_, int h_, int qb_) { Q = Q_; kbase = KV + 64 * h_; vbase = KV + 1024 + 64 * h_; krbase = KR; O = O_; b = b_; h = h_; qb = qb_; }
  __device__ __forceinline__ int nt() const { return 132; }
  __device__ __forceinline__ long trow(int t) const { return t < 4 ? (long)(ROWS_LAT + 256 * b + 64 * t) : (long)(8192 * b + 64 * (t - 4)); }
  __device__ __forceinline__ const bf16* qptr(int wid, int r32, int d0, int hi) const { const bf16* qp = Q + (long)(8192 * b + 256 * qb + 32 * wid + r32) * 1536;
    return d0 < 4 ? qp + 64 * h + 16 * d0 + 8 * hi : qp + 1024 + 32 * h + 16 * (d0 - 4) + 8 * hi; }
  __device__ __forceinline__ void mask(f32x16&, f32x16&, int, int, int, int) const {}
  __device__ __forceinline__ float sink(int) const { return -INFINITY; }
  __device__ __forceinline__ bf16* orow0(int wid) const { return O + (long)(8192 * b + 256 * qb + 32 * wid) * 1024 + 64 * h; }
};
struct FWin {
  static constexpr bool HAS_MASK = true; static constexpr int kpitch = 2304, vpitch = 2304;
  const bf16* QKV; const bf16* kbase; const bf16* vbase; const bf16* krbase; bf16* O; const float* sinkp; int b, n, g, hh, i0, cnt; const char* k6base;
  __device__ __forceinline__ void init(const bf16* QKV_, bf16* O_, const float* sk, int b_, int n_, int g_, int hh_, const char* K6E = nullptr) { QKV = QKV_; O = O_; sinkp = sk; b = b_; n = n_; g = g_; hh = hh_; krbase = nullptr; k6base = K6E + g_ * 3072;
    kbase = QKV_ + 512 + 64 * g_; vbase = QKV_ + 640 + 64 * g_; i0 = (n_ == 0) ? 2 : 0; cnt = (n_ == 0 || n_ == 63) ? 4 : 6; }
  __device__ __forceinline__ int nt() const { return 4 + cnt; }
  __device__ __forceinline__ int kpos0(int t) const { return 128 * (n - 1) + 64 * (i0 + t - 4); }
  __device__ __forceinline__ long trow(int t) const { return t < 4 ? (long)(ROWS_LAT + 256 * b + 64 * t) : (long)(8192 * b + kpos0(t)); }
  __device__ __forceinline__ int head(int wid) const { return 4 * g + 2 * hh + (wid >> 2); }
  __device__ __forceinline__ int qpos0(int wid) const { return 128 * n + 32 * (wid & 3); }
  __device__ __forceinline__ const bf16* qptr(int wid, int r32, int d0, int hi) const { return QKV + (long)(8192 * b + qpos0(wid) + r32) * 2304 + 64 * head(wid) + 16 * d0 + 8 * hi; }
  __device__ __forceinline__ void mask(f32x16& p0, f32x16& p1, int t, int wid, int r32, int hi) const {
    if (t < 4) return;
    const int k0 = kpos0(t), q0 = qpos0(wid);
    if (k0 - (q0 + 31) >= -128 && k0 + 63 - q0 <= 128) return;
    asm volatile("" : "+v"(r32), "+v"(hi));
    const int dq = k0 - (q0 + r32);
#pragma unroll
    for (int r = 0; r < 16; ++r) { const int d = dq + crow(r, hi); if (d > 128 || d < -128) p0[r] = -INFINITY; if (d + 32 > 128 || d + 32 < -128) p1[r] = -INFINITY; }
  }
  __device__ __forceinline__ float sink(int wid) const { return sinkp[head(wid)] * LOG2E_; }
  __device__ __forceinline__ bf16* orow0(int wid) const { return O + (long)(8192 * b + qpos0(wid)) * 1024 + 64 * head(wid); }
};
struct FNa {
  static constexpr bool HAS_MASK = true; static constexpr int kpitch = 2304, vpitch = 2304;
  const bf16* QKV; const bf16* kbase; const bf16* vbase; const bf16* krbase; bf16* O; const float* rpbl; int b, h, R4, krlo, nloc; const char* k6base;
  __device__ __forceinline__ void init(const bf16* QKV_, bf16* O_, const float* rpbl_, int b_, int h_, int R4_, const char* K6E = nullptr) { QKV = QKV_; O = O_; rpbl = rpbl_; b = b_; h = h_; R4 = R4_; krbase = nullptr; k6base = K6E + (2 + h_) * 3072;
    kbase = QKV_ + 1280 + 64 * h_; vbase = QKV_ + 1792 + 64 * h_; krlo = clampi(4 * R4_ - 4, 0, 120); nloc = clampi(4 * R4_ - 1, 0, 120) + 7 - krlo + 1; }
  __device__ __forceinline__ int nt() const { return (4 + nloc + 1) & ~1; }
  __device__ __forceinline__ long trow(int t) const { return (t < 4 || t >= 4 + nloc) ? (long)(ROWS_LAT + 256 * b + 64 * (t & 3)) : (long)(8192 * b + 64 * (krlo + t - 4)); }
  __device__ __forceinline__ int qrow(int wid) const { return 4 * R4 + (wid >> 1); }
  __device__ __forceinline__ const bf16* qptr(int wid, int r32, int d0, int hi) const { return QKV + (long)(8192 * b + 64 * qrow(wid) + 32 * (wid & 1) + r32) * 2304 + 768 + 64 * h + 16 * d0 + 8 * hi; }
  __device__ __forceinline__ void mask(f32x16& p0, f32x16& p1, int t, int wid, int r32, int hi) const {
    if (t < 4) return;
    const int kr = krlo + t - 4, w0 = clampi(qrow(wid) - 4, 0, 120);
    if (t >= 4 + nloc || kr < w0 || kr > w0 + 7) {
#pragma unroll
      for (int r = 0; r < 16; ++r) { p0[r] = -INFINITY; p1[r] = -INFINITY; }
      return; }
    asm volatile("" : "+v"(r32), "+v"(hi));
    const int qc = 32 * (wid & 1) + r32, c0 = clampi(qc - 8, 0, 48);
    const float* pb = rpbl + (kr - qrow(wid) + 7) * 31 + 15 - qc + 4 * hi;
    const unsigned t0 = (unsigned)(4 * hi - c0);
#define AF_PIN16(a) asm volatile("" : "+v"(a[0]), "+v"(a[1]), "+v"(a[2]), "+v"(a[3]), "+v"(a[4]), "+v"(a[5]), "+v"(a[6]), "+v"(a[7]), "+v"(a[8]), "+v"(a[9]), "+v"(a[10]), "+v"(a[11]), "+v"(a[12]), "+v"(a[13]), "+v"(a[14]), "+v"(a[15]))
    float bv[16];
#pragma unroll
    for (int r = 0; r < 16; ++r) bv[r] = pb[(r & 3) + 8 * (r >> 2)];
    AF_PIN16(bv);
#pragma unroll
    for (int r = 0; r < 16; ++r) { const bool ok = (t0 + (unsigned)((r & 3) + 8 * (r >> 2))) < 16u; p0[r] = ok ? p0[r] + bv[r] : -INFINITY; }
#pragma unroll
    for (int r = 0; r < 16; ++r) bv[r] = pb[32 + (r & 3) + 8 * (r >> 2)];
    AF_PIN16(bv);
#pragma unroll
    for (int r = 0; r < 16; ++r) { const bool ok = (t0 + (unsigned)(32 + (r & 3) + 8 * (r >> 2))) < 16u; p1[r] = ok ? p1[r] + bv[r] : -INFINITY; }
#undef AF_PIN16
  }
  __device__ __forceinline__ float sink(int) const { return -INFINITY; }
  __device__ __forceinline__ bf16* orow0(int wid) const { return O + (long)(8192 * b + 64 * qrow(wid) + 32 * (wid & 1)) * 1024 + 512 + 64 * h; }
};
struct FCtx {
  static constexpr bool HAS_MASK = false; static constexpr int kpitch = 2304, vpitch = 2304;
  const bf16* QKV; const bf16* kbase; const bf16* vbase; const bf16* krbase; bf16* O; const float* sinkp; int b, hx, qcol, ocol; const char* k6base;
  __device__ __forceinline__ void init(const bf16* QKV_, bf16* O_, const float* sk, int b_, int hx_, const char* K6E = nullptr) { QKV = QKV_; O = O_; sinkp = sk; b = b_; hx = hx_; krbase = nullptr; k6base = K6E + (hx_ < 8 ? (hx_ >> 2) : 2 + (hx_ - 8)) * 3072;
    if (hx_ < 8) { qcol = 64 * hx_; kbase = QKV_ + 512 + 64 * (hx_ >> 2); vbase = QKV_ + 640 + 64 * (hx_ >> 2); ocol = 64 * hx_; }
    else { const int h = hx_ - 8; qcol = 768 + 64 * h; kbase = QKV_ + 1280 + 64 * h; vbase = QKV_ + 1792 + 64 * h; ocol = 512 + 64 * h; } }
  __device__ __forceinline__ int nt() const { return 4; }
  __device__ __forceinline__ long trow(int t) const { return (long)(ROWS_LAT + 256 * b + 64 * (t & 3)); }
  __device__ __forceinline__ const bf16* qptr(int wid, int r32, int d0, int hi) const { return QKV + (long)(ROWS_LAT + 256 * b + 32 * wid + r32) * 2304 + qcol + 16 * d0 + 8 * hi; }
  __device__ __forceinline__ void mask(f32x16&, f32x16&, int, int, int, int) const {}
  __device__ __forceinline__ float sink(int) const { return hx < 8 ? sinkp[hx] * LOG2E_ : -INFINITY; }
  __device__ __forceinline__ bf16* orow0(int wid) const { return O + (long)(ROWS_LAT + 256 * b + 32 * wid) * 1024 + ocol; }
};
#undef AF_SBAR
#undef AF_WAIT_BAR
}
constexpr int NWAVES = 8;
#ifndef MK_PER_PHASE
#define MK_PER_PHASE 0
#endif
constexpr int BATCH = 2, SEQ = 8192, DM = 1024, CTXL = 256, FF = 4096;
constexpr int ML = BATCH * SEQ, MC = BATCH * CTXL, MR = ML + MC;
constexpr int NQKV = 2304, NCIN = 768, NUQ = 1536, NUKV = 2048;
constexpr float NORM_EPS = 1e-6f;
constexpr int ADA_KS = 16;
constexpr size_t MiB = 1u << 20;
constexpr size_t WS_CTL = 0, CTL_ZERO_BYTES = 64 * 1024;
constexpr size_t WS_MODP = 1 * MiB;
constexpr size_t WS_MOD = 3 * MiB + 512 * 1024;
constexpr size_t WS_ROPE = 3 * MiB + 768 * 1024;
constexpr size_t WS_HPAR = WS_ROPE + 32 * 1024;
constexpr size_t WS_CTXRES = 4 * MiB;
constexpr size_t WS_WQKV = 6 * MiB, WS_WO0 = WS_WQKV + 4608 * 1024, WS_W1_0 = WS_WO0 + 2 * MiB, WS_W2_0 = WS_W1_0 + 8 * MiB, WS_W1_1 = WS_W2_0 + 8 * MiB, WS_W2_1 = WS_W1_1 + 8 * MiB;
constexpr size_t WS_WIN = WS_W2_1 + 8 * MiB, WS_WUQ = WS_WIN + 1536 * 1024, WS_WUKV = WS_WUQ + 1152 * 1024, WS_WO1 = WS_WUKV + 1 * MiB, WS_WEND = WS_WO1 + 2 * MiB;
constexpr size_t WS_AR = 51 * MiB;
static_assert(WS_WEND <= WS_AR, "weights overlap the arena");
constexpr size_t WS_XN = WS_AR, WS_H = WS_AR + 33 * MiB;
constexpr size_t WS_QKV = WS_AR + 33 * MiB, WS_O0 = WS_AR + 108 * MiB;
constexpr size_t WS_CQKV = WS_AR + 33 * MiB, WS_CQN = WS_AR + 58 * MiB, WS_CKVN = WS_AR + 71 * MiB, WS_KR = WS_AR + 80 * MiB, WS_Q1 = WS_AR + 82 * MiB, WS_KV1 = WS_AR + 130 * MiB, WS_O1 = WS_AR;
constexpr size_t WS_K6E = WS_AR + 150 * MiB;
constexpr size_t WS_K6N = WS_AR + 34 * MiB, WS_K6R = WS_AR + 48 * MiB;
constexpr size_t WS_PART5 = WS_AR + 33 * MiB;
constexpr size_t WS_XR = WS_AR + 166 * MiB;
constexpr size_t WS_PART8 = WS_AR + 166 * MiB;
constexpr size_t WS_END = 256 * MiB;
static_assert(WS_PART8 + (size_t)16 * 512 * 1024 * 4 <= WS_END && WS_KV1 + (size_t)MR * NUKV * 2 <= WS_END && WS_H + (size_t)MR * FF * 2 <= WS_END, "d_ws map");
constexpr int CW_BAR = 4096;
constexpr int RING_OFF = 0, RING_BYTES = 131072;
constexpr int LDSCTL_OFF = RING_BYTES, MISC_OFF = LDSCTL_OFF + 320;
constexpr int LDS_BYTES = 147456;
static_assert(att::L_END <= RING_BYTES && attf::LDS_BYTES <= RING_BYTES, "attention LDS");

#define GAS __attribute__((address_space(1)))
#define LAS __attribute__((address_space(3)))
typedef unsigned short bf16;
typedef unsigned v4u __attribute__((ext_vector_type(4)));
typedef unsigned v2u __attribute__((ext_vector_type(2)));
typedef float f32x4 __attribute__((ext_vector_type(4)));
typedef GAS unsigned gu32;
#define RLX_AGENT __ATOMIC_RELAXED, __HIP_MEMORY_SCOPE_AGENT
#define LDS_WAIT() asm volatile("s_waitcnt lgkmcnt(0)" ::: "memory")
#define VM_WAIT() asm volatile("s_waitcnt vmcnt(0)" ::: "memory")
__device__ __forceinline__ unsigned f2bf(float f) { unsigned u = __builtin_bit_cast(unsigned, f); return (u + 0x7fffu + ((u >> 16) & 1u)) >> 16; }
__device__ __forceinline__ unsigned pk2(float lo, float hi) { return f2bf(lo) | (f2bf(hi) << 16); }
__device__ __forceinline__ float bf2f(unsigned short h) { return __builtin_bit_cast(float, (unsigned)h << 16); }
__device__ __forceinline__ float bflo(unsigned w) { return __builtin_bit_cast(float, w << 16); }
__device__ __forceinline__ float bfhi(unsigned w) { return __builtin_bit_cast(float, w & 0xffff0000u); }

#define XB_TMO      128
#define XB_XCNT(j)  (256  + 64 * (j))
#define XB_XSUB(j)  (1280 + 64 * (j))
#define XB_XGEN(j)  (2304 + 64 * (j))
#define XB_TOP      3328
#define XB_TOPGEN   3392
#define XCD_BAR_WORDS 3456
#define XB_SPIN_CAP (1u << 18)

__device__ __forceinline__ unsigned xb_ld(unsigned* p)              { return __hip_atomic_load(p, __ATOMIC_RELAXED, __HIP_MEMORY_SCOPE_AGENT); }
__device__ __forceinline__ unsigned xb_add(unsigned* p, unsigned v) { return __hip_atomic_fetch_add(p, v, __ATOMIC_RELAXED, __HIP_MEMORY_SCOPE_AGENT); }
__device__ __forceinline__ unsigned xb_xcc_id() { return (unsigned)__builtin_amdgcn_s_getreg((3 << 11) | 20) & 0xFu; }
#define XB_SPIN(cond, bar) do { unsigned _sp = 0; while (cond) { __builtin_amdgcn_s_sleep(1); \
    if ((++_sp & 255u) == 0u) { if (xb_ld(&(bar)[XB_TMO])) break; if (_sp > XB_SPIN_CAP) { atomicAdd(&(bar)[XB_TMO], 1u); break; } } } } while (0)

struct XcdBarrier {
    unsigned* bar; unsigned x;
    volatile LAS unsigned* st;
};

__device__ __forceinline__ XcdBarrier xcd_barrier_post(unsigned* bar, volatile LAS unsigned* st) {
    XcdBarrier b; b.bar = bar; b.x = xb_xcc_id(); b.st = st;
    if (threadIdx.x == 0) (void)xb_add(&bar[XB_XCNT(b.x)], 1u);
    return b;
}
__device__ __forceinline__ void xcd_barrier_complete(unsigned* bar, unsigned x, unsigned& nloc, unsigned& nx) {
    const unsigned G = gridDim.x * gridDim.y * gridDim.z;
    unsigned sum, cnt, mine, sp = 0u;
    for (;;) {
        sum = 0u; cnt = 0u; mine = 0u;
#pragma unroll
        for (unsigned j = 0; j < 16; ++j) { const unsigned c = xb_ld(&bar[XB_XCNT(j)]); sum += c; cnt += (c > 0u) ? 1u : 0u; mine = (j == x) ? c : mine; }
        if (sum == G) break;
        __builtin_amdgcn_s_sleep(1);
        if ((++sp & 255u) == 0u) { if (xb_ld(&bar[XB_TMO])) break; if (sp > XB_SPIN_CAP) { atomicAdd(&bar[XB_TMO], 1u); break; } }
    }
    nloc = mine > 0u ? mine : 1u; nx = cnt > 0u ? cnt : 1u;
}

__device__ __forceinline__ void xcd_barrier(const XcdBarrier& b) {
    asm volatile("s_waitcnt vmcnt(0)" ::: "memory");
    __syncthreads();
    if (threadIdx.x == 0) {
        unsigned* bar = b.bar;
        __builtin_amdgcn_s_waitcnt(0);
        unsigned nloc = b.st[0], nx = b.st[1];
        if (nloc == 0u) { xcd_barrier_complete(bar, b.x, nloc, nx); b.st[0] = nloc; b.st[1] = nx; }
        const unsigned old = xb_add(&bar[XB_XSUB(b.x)], 1u);
        const unsigned gen = old / nloc;
        if (old + 1u == (gen + 1u) * nloc) {
            __builtin_amdgcn_fence(__ATOMIC_RELEASE, "agent");
            asm volatile("s_waitcnt vmcnt(0)" ::: "memory");
            const unsigned og = xb_add(&bar[XB_TOP], 1u);
            const unsigned tg = og / nx;
            if (og + 1u == (tg + 1u) * nx) xb_add(&bar[XB_TOPGEN], 1u);
            else XB_SPIN(xb_ld(&bar[XB_TOPGEN]) == tg, bar);
            __builtin_amdgcn_fence(__ATOMIC_ACQUIRE, "agent");
            xb_add(&bar[XB_XGEN(b.x)], 1u);
            asm volatile("s_waitcnt vmcnt(0)" ::: "memory");
        } else {
            XB_SPIN(xb_ld(&bar[XB_XGEN(b.x)]) == gen, bar);
            __builtin_amdgcn_fence(__ATOMIC_ACQUIRE, "agent");
            asm volatile("s_waitcnt vmcnt(0)" ::: "memory");
        }
    }
    __syncthreads();
}


template <int K> __device__ __forceinline__ const float* ldarg() {
    auto ka = __builtin_amdgcn_kernarg_segment_ptr();
    const __attribute__((address_space(1))) float* p; asm volatile("s_load_dwordx2 %0, %1, %2\n\ts_waitcnt lgkmcnt(0)" : "=s"(p) : "s"(ka), "i"(K * 8) : "memory"); return (const float*)p;
}
#define ARG(k) (ldarg<k>())
#define ARG_OUT ((float*)ldarg<28>())
#define ARG_WS ((unsigned char*)ldarg<29>())
struct Frame {
    LAS unsigned char* lds;
    volatile LAS unsigned* MISC;
    gu32* ctl;
    int tid, lane, wave;
    int vcu, G, bx;
    float* out; unsigned char* ws;
};
__device__ __forceinline__ float shx(float v, int mask, int lane) { return __builtin_bit_cast(float, __builtin_amdgcn_ds_bpermute((lane ^ mask) << 2, __builtin_bit_cast(int, v))); }
__device__ __forceinline__ float wave_sum(float v, int lane) {
#pragma unroll
    for (int o = 1; o < 64; o <<= 1) v += shx(v, o, lane);
    return v;
}
__device__ __forceinline__ void p0_transpose_item(const float* W, int K, int N, bf16* WT, int pmode, LAS float* scr, int item, int lane) {
    const int nblk = N / 32, kb = item / nblk, nb = item % nblk, k0 = 64 * kb, n0 = 32 * nb;
    int r0 = n0;
    if (pmode == 1) { const int h = n0 / 96, d = n0 % 96; r0 = d < 64 ? h * 64 + d : 1024 + h * 32 + (d - 64); }
    else if (pmode == 2) { const int h = n0 / 128, d = n0 % 128; r0 = d < 64 ? h * 64 + d : 1024 + h * 64 + (d - 64); }
#pragma unroll 8
    for (int i = 0; i < 32; ++i) { const int kk = 2 * i + (lane >> 5); scr[kk * 33 + (lane & 31)] = W[(size_t)(k0 + kk) * N + n0 + (lane & 31)]; }
    LDS_WAIT(); asm volatile("" ::: "memory");
    const int c = lane & 7;
#pragma unroll
    for (int j = 0; j < 4; ++j) { const int n = (lane >> 3) + 8 * j; const LAS float* s = scr + (8 * c) * 33 + n;
        v4u o; o.x = pk2(s[0 * 33], s[1 * 33]); o.y = pk2(s[2 * 33], s[3 * 33]); o.z = pk2(s[4 * 33], s[5 * 33]); o.w = pk2(s[6 * 33], s[7 * 33]);
        *(GAS v4u*)(WT + (size_t)(r0 + n) * K + k0 + 8 * c) = o; }
    LDS_WAIT(); asm volatile("" ::: "memory");
}
__device__ __forceinline__ float silu_f(float v) { return v / (1.f + __expf(-v)); }

__device__ __forceinline__ void p0_prologue(Frame& F) {
    LAS float* scr = (LAS float*)(F.lds + RING_OFF + F.wave * 16384);
    const float* c = ARG(1); const float* cctx = ARG(3);
    if (F.wave >= 5) {
        for (int it = F.vcu * 3 + (F.wave - 5); it < 2 * 24 * ADA_KS; it += F.G * 3) {
            const int l = it / (24 * ADA_KS), rem = it % (24 * ADA_KS), cg = rem / ADA_KS, ks = rem % ADA_KS;
            const float* W = ARG(4) + (size_t)l * DM * 6144 + cg * 256 + 4 * F.lane;
            f32x4 a0 = {0.f, 0.f, 0.f, 0.f}, a1 = a0, a2 = a0;
            const int kbeg = ks * (DM / ADA_KS);
#pragma unroll 8
            for (int k = kbeg; k < kbeg + DM / ADA_KS; ++k) {
                const f32x4 w = *(const GAS f32x4*)(W + (size_t)k * 6144);
                const float s0 = silu_f(c[k]), s1 = silu_f(c[DM + k]), s2 = silu_f(cctx[k]);
                a0 += w * s0; a1 += w * s1; a2 += w * s2;
            }
            float* P = (float*)(F.ws + WS_MODP) + ((size_t)(ks * 2 + l) * 3) * 6144 + cg * 256 + 4 * F.lane;
            *(GAS f32x4*)(P) = a0; *(GAS f32x4*)(P + 6144) = a1; *(GAS f32x4*)(P + 2 * 6144) = a2;
        }
    } else {
        const int gw = F.vcu * 5 + F.wave, NGW = F.G * 5;
        constexpr int I_QKV = 16 * 72, I_O = 16 * 32, I_1 = 16 * 128, I_2 = 64 * 32, I_IN = 16 * 21, I_UQ = 6 * 48, I_UKV = 4 * 64;
        constexpr int NITEMS = I_QKV + I_O + 2 * I_1 + 2 * I_2 + I_IN + I_UQ + I_UKV + I_O;
        for (int it = gw; it < NITEMS; it += NGW) {
            int r = it;
            if (r < I_QKV) { p0_transpose_item(ARG(10), DM, NQKV, (bf16*)(F.ws + WS_WQKV), 0, scr, r, F.lane); continue; } r -= I_QKV;
            if (r < I_O) { p0_transpose_item(ARG(11), DM, DM, (bf16*)(F.ws + WS_WO0), 0, scr, r, F.lane); continue; } r -= I_O;
            if (r < I_1) { p0_transpose_item(ARG(8), DM, FF, (bf16*)(F.ws + WS_W1_0), 0, scr, r, F.lane); continue; } r -= I_1;
            if (r < I_1) { p0_transpose_item(ARG(8) + (size_t)DM * FF, DM, FF, (bf16*)(F.ws + WS_W1_1), 0, scr, r, F.lane); continue; } r -= I_1;
            if (r < I_2) { p0_transpose_item(ARG(9), FF, DM, (bf16*)(F.ws + WS_W2_0), 0, scr, r, F.lane); continue; } r -= I_2;
            if (r < I_2) { p0_transpose_item(ARG(9) + (size_t)DM * FF, FF, DM, (bf16*)(F.ws + WS_W2_1), 0, scr, r, F.lane); continue; } r -= I_2;
            if (r < I_IN) { p0_transpose_item(ARG(18), DM, 672, (bf16*)(F.ws + WS_WIN), 0, scr, r, F.lane); continue; } r -= I_IN;
            if (r < I_UQ) { p0_transpose_item(ARG(21), 384, NUQ, (bf16*)(F.ws + WS_WUQ), 1, scr, r, F.lane); continue; } r -= I_UQ;
            if (r < I_UKV) { p0_transpose_item(ARG(22), 256, NUKV, (bf16*)(F.ws + WS_WUKV), 2, scr, r, F.lane); continue; } r -= I_UKV;
            p0_transpose_item(ARG(27), DM, DM, (bf16*)(F.ws + WS_WO1), 0, scr, r, F.lane);
        }
    }
    if (F.bx == 1 % F.G) {
        float* rt = (float*)(F.ws + WS_ROPE);
        for (int e = F.tid; e < 128 * 16; e += NWAVES * 64) { const int pos = e >> 4, i = e & 15; const float inv = exp2f(-(float)i * (13.287712379549449f / 16.f));
            float x = (float)pos * inv * 0.15915494309189535f; x -= rintf(x); rt[e] = __builtin_amdgcn_cosf(x); rt[2048 + e] = __builtin_amdgcn_sinf(x); }
        for (int e = F.tid; e < 128 * 8; e += NWAVES * 64) { const int pos = e >> 3, i = e & 7; const float inv = exp2f(-(float)i * (13.287712379549449f / 8.f));
            float x = (float)pos * inv * 0.15915494309189535f; x -= rintf(x); rt[4096 + e] = __builtin_amdgcn_cosf(x); rt[5120 + e] = __builtin_amdgcn_sinf(x); }
    }
    if (F.bx == 3 % F.G && F.tid < 64) {
        float* hp = (float*)(F.ws + WS_HPAR); const int i = F.tid;
        hp[i] = ARG(12)[i]; hp[64 + i] = ARG(13)[i]; hp[128 + i] = ARG(15)[i]; hp[192 + i] = ARG(16)[i]; hp[256 + i] = ARG(23)[i]; hp[320 + i] = ARG(24)[i & 31]; hp[384 + i] = ARG(25)[i];
        float a = fabsf(ARG(23)[i]), b_ = fabsf(ARG(25)[i]), c_ = fabsf(ARG(24)[i & 31]), d_ = fabsf(ARG(26)[i & 31]);
#pragma unroll
        for (int o_ = 1; o_ < 64; o_ <<= 1) { a = fmaxf(a, shx(a, o_, i)); b_ = fmaxf(b_, shx(b_, o_, i)); c_ = fmaxf(c_, shx(c_, o_, i)); d_ = fmaxf(d_, shx(d_, o_, i)); }
        const float bound = (64.f * a * b_ + 32.f * c_ * d_) * (0.10206207261596575f * 1.4426950408889634f);
        if (i == 0) hp[448] = (bound < 64.f && fmaxf(fmaxf(a, b_), fmaxf(c_, d_)) < 3.f) ? 1.f : 0.f;
        { float a2 = fabsf(ARG(12)[i]), b2 = fabsf(ARG(13)[i]), c2 = fabsf(ARG(15)[i]), d2 = fabsf(ARG(16)[i]), e2 = 0.f, f2 = fabsf(ARG(14)[i & 7]);
          for (int j = i; j < 8 * 465; j += 64) e2 = fmaxf(e2, fabsf(ARG(17)[j]));
#pragma unroll
          for (int o_ = 1; o_ < 64; o_ <<= 1) { a2 = fmaxf(a2, shx(a2, o_, i)); b2 = fmaxf(b2, shx(b2, o_, i)); c2 = fmaxf(c2, shx(c2, o_, i)); d2 = fmaxf(d2, shx(d2, o_, i)); e2 = fmaxf(e2, shx(e2, o_, i)); f2 = fmaxf(f2, shx(f2, o_, i)); }
          const float bound0 = fmaxf(fmaxf(8.f * a2 * b2, 8.f * c2 * d2 + e2), f2) * 1.4426950408889634f;
          if (i == 0) hp[449] = (bound0 < 64.f && fmaxf(fmaxf(a2, b2), fmaxf(c2, d2)) < 3.f) ? 1.f : 0.f; }
    }
    if (F.bx == 2 % F.G) {
        GAS v4u* z = (GAS v4u*)((bf16*)(F.ws + WS_WIN) + (size_t)672 * DM);
        unsigned zz = 0u; asm volatile("" : "+v"(zz));
        for (int e = F.tid; e < 96 * DM / 8; e += NWAVES * 64) z[e] = (v4u){zz, zz, zz, zz};
    }
}

__device__ __forceinline__ void norm_phase(Frame& F, const float* src_lat, const float* src_ctx, int nrows, const float* gw_, int layer, int which  , bool from_partials, const float* parts = nullptr, int nparts = 0, bool lat_bf16 = false) {
    LAS float* gl = (LAS float*)(F.lds + RING_OFF); LAS float* scl = gl + 1024; LAS float* shl = scl + 3 * 1024;
    const float* modp = (const float*)(F.ws + WS_MODP); const float* mod = (const float*)(F.ws + WS_MOD); const float* ada_b = ARG(5);
    const int offsh = which * 3072, offsc = which * 3072 + 1024;
    for (int i = F.tid; i < 1024; i += NWAVES * 64) {
        gl[i] = gw_[i];
#pragma unroll
        for (int cnd = 0; cnd < 3; ++cnd) {
            float sh, sc;
            if (from_partials) { sh = ada_b[layer * 6144 + offsh + i]; sc = ada_b[layer * 6144 + offsc + i];
                float ph[ADA_KS], pc[ADA_KS];
#pragma unroll
                for (int ks = 0; ks < ADA_KS; ++ks) { const float* p = modp + ((size_t)(ks * 2 + layer) * 3 + cnd) * 6144; ph[ks] = p[offsh + i]; pc[ks] = p[offsc + i]; }
#pragma unroll
                for (int ks = 0; ks < ADA_KS; ++ks) { sh += ph[ks]; sc += pc[ks]; } }
            else { sh = mod[(layer * 3 + cnd) * 6144 + offsh + i]; sc = mod[(layer * 3 + cnd) * 6144 + offsc + i]; }
            scl[cnd * 1024 + i] = 1.f + sc; shl[cnd * 1024 + i] = sh;
        }
    }
    if (from_partials) {
        float* modw = (float*)(F.ws + WS_MOD);
        for (int e = F.vcu * (NWAVES * 64) + F.tid; e < 2 * 3 * 6144; e += F.G * NWAVES * 64) {
            const int l = e / (3 * 6144), rem = e % (3 * 6144), cnd = rem / 6144, col = rem % 6144;
            float v = ada_b[l * 6144 + col];
            float pv[ADA_KS];
#pragma unroll
            for (int ks = 0; ks < ADA_KS; ++ks) pv[ks] = modp[((size_t)(ks * 2 + l) * 3 + cnd) * 6144 + col];
#pragma unroll
            for (int ks = 0; ks < ADA_KS; ++ks) v += pv[ks];
            modw[e] = v;
        }
    }
    __syncthreads();
    bf16* XN = (bf16*)(F.ws + WS_XN);
    const int gw = F.vcu * NWAVES + F.wave, NGW = F.G * NWAVES;
    for (int m = gw; m < nrows; m += NGW) {
        const float* xrow = m < ML ? src_lat + (size_t)m * DM : src_ctx + (size_t)(m - ML) * DM;
        const int cnd = m < SEQ ? 0 : (m < ML ? 1 : 2);
        const GAS f32x4* xr = (const GAS f32x4*)xrow + F.lane;
        f32x4 v[4]; float s = 0.f;
        if (lat_bf16 && m < ML) {
            const GAS v2u* xb = (const GAS v2u*)((const bf16*)src_lat + (size_t)m * DM) + F.lane;
            v2u w[4];
#pragma unroll
            for (int j = 0; j < 4; ++j) w[j] = xb[64 * j];
#pragma unroll
            for (int j = 0; j < 4; ++j) v[j] = f32x4{bflo(w[j].x), bfhi(w[j].x), bflo(w[j].y), bfhi(w[j].y)};
        } else {
#pragma unroll
            for (int j = 0; j < 4; ++j) v[j] = xr[64 * j];
        }
        if (nparts > 0 && m >= ML) {
            for (int p = 0; p < nparts; p += 4) {
                const GAS f32x4* pr = (const GAS f32x4*)(parts + (size_t)p * (512 * 1024) + (size_t)(m - ML) * DM) + F.lane;
                f32x4 w[4][4];
#pragma unroll
                for (int q = 0; q < 4; ++q)
#pragma unroll
                    for (int j = 0; j < 4; ++j) w[q][j] = pr[(size_t)q * (512 * 1024 / 4) + 64 * j];
#pragma unroll
                for (int j = 0; j < 4; ++j) v[j] += (w[0][j] + w[1][j]) + (w[2][j] + w[3][j]); }
            GAS f32x4* cr = (GAS f32x4*)((float*)(F.ws + WS_CTXRES) + (size_t)(m - ML) * DM) + F.lane;
#pragma unroll
            for (int j = 0; j < 4; ++j) cr[64 * j] = v[j];
        }
#pragma unroll
        for (int j = 0; j < 4; ++j) s += (v[j].x * v[j].x + v[j].y * v[j].y) + (v[j].z * v[j].z + v[j].w * v[j].w);
        const float rstd = 1.f / sqrtf(wave_sum(s, F.lane) * (1.f / DM) + NORM_EPS);
        if (from_partials && m >= ML) { GAS f32x4* cr = (GAS f32x4*)((float*)(F.ws + WS_CTXRES) + (size_t)(m - ML) * DM) + F.lane;
#pragma unroll
            for (int j = 0; j < 4; ++j) cr[64 * j] = v[j]; }
        GAS v2u* o8 = (GAS v2u*)(XN + (size_t)m * DM) + F.lane;
#pragma unroll
        for (int j = 0; j < 4; ++j) { const int col = 4 * F.lane + 256 * j;
            const f32x4 g = *(const LAS f32x4*)(gl + col), sc = *(const LAS f32x4*)(scl + cnd * 1024 + col), sh = *(const LAS f32x4*)(shl + cnd * 1024 + col);
            const f32x4 y = (v[j] * rstd) * g * sc + sh;
            v2u w; w.x = pk2(y.x, y.y); w.y = pk2(y.z, y.w); o8[64 * j] = w; }
    }
    __syncthreads();
}

__device__ __forceinline__ void unpack8(const v4u w, float (&x)[8]) { x[0] = bflo(w.x); x[1] = bfhi(w.x); x[2] = bflo(w.y); x[3] = bfhi(w.y); x[4] = bflo(w.z); x[5] = bfhi(w.z); x[6] = bflo(w.w); x[7] = bfhi(w.w); }
__device__ __forceinline__ v4u pack8(const float (&x)[8]) { v4u w; w.x = pk2(x[0], x[1]); w.y = pk2(x[2], x[3]); w.z = pk2(x[4], x[5]); w.w = pk2(x[6], x[7]); return w; }

__device__ __forceinline__ void qknorm_phase(Frame& F) {
    bf16* QKV = (bf16*)(F.ws + WS_QKV);
    const float* rt = (const float*)(F.ws + WS_ROPE);
    const float* nw[4] = {ARG(12), ARG(13), ARG(15), ARG(16)};
    const float qscale = 0.125f * att::LOG2E;
    const int gw = F.vcu * NWAVES + F.wave, NGW = F.G * NWAVES;
    const int lane = F.lane, grp = lane >> 3, l8 = lane & 7;
    for (int m = gw; m < MR; m += NGW) {
        const bool lat = m < ML; const int t = m & (SEQ - 1); const int prow = t >> 6, pcol = t & 63;
        GAS v4u* rowp = (GAS v4u*)(QKV + (size_t)m * NQKV);
#pragma unroll
        for (int pass = 0; pass < 4; ++pass) {
            int type;
            if (pass == 0) type = 1; else if (pass == 1) type = grp < 2 ? 2 : (grp < 4 ? 0 : 3); else if (pass == 2) type = grp < 4 ? 3 : 4; else type = grp < 4 ? 4 : 0;
            const v4u w = rowp[pass * 64 + lane];
            float x[8]; unpack8(w, x);
            float ss = 0.f;
#pragma unroll
            for (int j = 0; j < 8; ++j) ss += x[j] * x[j];
            ss += shx(ss, 1, F.lane); ss += shx(ss, 2, F.lane); ss += shx(ss, 4, F.lane);
            const float rstd = 1.f / sqrtf(ss * (1.f / 64.f) + NORM_EPS);
            const float* g = type == 1 ? nw[0] : (type == 2 ? nw[1] : (type == 3 ? nw[2] : nw[3]));
            const f32x4 g0 = *(const GAS f32x4*)(g + l8 * 8), g1 = *(const GAS f32x4*)(g + l8 * 8 + 4);
            x[0] *= rstd * g0.x; x[1] *= rstd * g0.y; x[2] *= rstd * g0.z; x[3] *= rstd * g0.w; x[4] *= rstd * g1.x; x[5] *= rstd * g1.y; x[6] *= rstd * g1.z; x[7] *= rstd * g1.w;
            float px[8];
#pragma unroll
            for (int j = 0; j < 8; ++j) px[j] = shx(x[j], 2, F.lane);
            if (lat && (type == 1 || type == 2)) {
                const int pos = (l8 & 4) ? pcol : prow; const float* cs = rt + pos * 16 + (l8 & 1) * 8;
                const f32x4 c0 = *(const GAS f32x4*)(cs), c1 = *(const GAS f32x4*)(cs + 4), s0 = *(const GAS f32x4*)(cs + 2048), s1 = *(const GAS f32x4*)(cs + 2052);
                const float cc[8] = {c0.x, c0.y, c0.z, c0.w, c1.x, c1.y, c1.z, c1.w}, sn[8] = {s0.x, s0.y, s0.z, s0.w, s1.x, s1.y, s1.z, s1.w};
                const float sgn = (l8 & 2) ? 1.f : -1.f;
#pragma unroll
                for (int j = 0; j < 8; ++j) x[j] = x[j] * cc[j] + sgn * px[j] * sn[j];
            }
            if (type == 1 || type == 3) {
#pragma unroll
                for (int j = 0; j < 8; ++j) x[j] *= qscale;
            }
            if (type != 0) rowp[pass * 64 + lane] = pack8(x);
        }
    }
}

__device__ __forceinline__ void cnorm_phase(Frame& F) {
    const bf16* CQKV = (const bf16*)(F.ws + WS_CQKV); bf16* CQN = (bf16*)(F.ws + WS_CQN); bf16* CKVN = (bf16*)(F.ws + WS_CKVN); bf16* KR = (bf16*)(F.ws + WS_KR);
    const float* rt = (const float*)(F.ws + WS_ROPE) + 4096;
    const float* gq = ARG(19); const float* gkv = ARG(20); const float* gkr = ARG(26);
    const int gw = F.vcu * NWAVES + F.wave, NGW = F.G * NWAVES; const int lane = F.lane;
    for (int m = gw; m < MR; m += NGW) {
        const bool lat = m < ML; const int t = m & (SEQ - 1); const int prow = t >> 6, pcol = t & 63;
        const GAS v4u* rowp = (const GAS v4u*)(CQKV + (size_t)m * NCIN);
        const v4u w0 = rowp[lane]; v4u w1 = {0u, 0u, 0u, 0u}; if (lane < 32) w1 = rowp[64 + lane];
        float x0[8], x1[8]; unpack8(w0, x0); unpack8(w1, x1);
        float s0 = 0.f, s1 = 0.f;
#pragma unroll
        for (int j = 0; j < 8; ++j) { s0 += x0[j] * x0[j]; s1 += x1[j] * x1[j]; }
        const float ssq = wave_sum(lane < 48 ? s0 : 0.f, F.lane);
        const float sskv = wave_sum((lane >= 48 ? s0 : 0.f) + (lane < 16 ? s1 : 0.f), F.lane);
        const float sskr = wave_sum((lane >= 16 && lane < 20) ? s1 : 0.f, F.lane);
        const float rq = 1.f / sqrtf(ssq * (1.f / 384.f) + NORM_EPS), rkv = 1.f / sqrtf(sskv * (1.f / 256.f) + NORM_EPS), rkr = 1.f / sqrtf(sskr * (1.f / 32.f) + NORM_EPS);
        { const float* g = lane < 48 ? gq + lane * 8 : gkv + (lane - 48) * 8; const float r = lane < 48 ? rq : rkv;
          const f32x4 g0 = *(const GAS f32x4*)(g), g1 = *(const GAS f32x4*)(g + 4);
          float y[8] = {x0[0] * r * g0.x, x0[1] * r * g0.y, x0[2] * r * g0.z, x0[3] * r * g0.w, x0[4] * r * g1.x, x0[5] * r * g1.y, x0[6] * r * g1.z, x0[7] * r * g1.w};
          if (lane < 48) *(GAS v4u*)(CQN + (size_t)m * 384 + lane * 8) = pack8(y); else *(GAS v4u*)(CKVN + (size_t)m * 256 + (lane - 48) * 8) = pack8(y); }
        { const int li = lane < 16 ? lane : (lane < 20 ? lane - 16 : 0);
          const float* g = lane < 16 ? gkv + 128 + li * 8 : gkr + li * 8; const float r = lane < 16 ? rkv : rkr;
          const f32x4 g0 = *(const GAS f32x4*)(g), g1 = *(const GAS f32x4*)(g + 4);
          float y[8] = {x1[0] * r * g0.x, x1[1] * r * g0.y, x1[2] * r * g0.z, x1[3] * r * g0.w, x1[4] * r * g1.x, x1[5] * r * g1.y, x1[6] * r * g1.z, x1[7] * r * g1.w};
          float py[8];
#pragma unroll
          for (int j = 0; j < 8; ++j) py[j] = shx(y[j], 1, F.lane);
          if (lat && lane >= 16 && lane < 20) {
              const int pos = (lane & 2) ? pcol : prow; const float* cs = rt + pos * 8;
              const f32x4 c0 = *(const GAS f32x4*)(cs), c1 = *(const GAS f32x4*)(cs + 4), sa = *(const GAS f32x4*)(cs + 1024), sb = *(const GAS f32x4*)(cs + 1028);
              const float cc[8] = {c0.x, c0.y, c0.z, c0.w, c1.x, c1.y, c1.z, c1.w}, sn[8] = {sa.x, sa.y, sa.z, sa.w, sb.x, sb.y, sb.z, sb.w};
              const float sgn = (lane & 1) ? 1.f : -1.f;
#pragma unroll
              for (int j = 0; j < 8; ++j) y[j] = y[j] * cc[j] + sgn * py[j] * sn[j];
          }
          if (lane < 16) *(GAS v4u*)(CKVN + (size_t)m * 256 + 128 + lane * 8) = pack8(y);
          else if (lane < 20) *(GAS v4u*)(KR + (size_t)m * 32 + (lane - 16) * 8) = pack8(y); }
    }
}

__device__ __forceinline__ void hnorm_phase(Frame& F) {
    bf16* Q = (bf16*)(F.ws + WS_Q1); bf16* KV = (bf16*)(F.ws + WS_KV1);
    const float* rt = (const float*)(F.ws + WS_ROPE) + 4096;
    const float* gqn = ARG(23); const float* gqr = ARG(24); const float* gkn = ARG(25);
    const float qscale = 0.10206207261596575f * att::LOG2E;
    const int gw = F.vcu * NWAVES + F.wave, NGW = F.G * NWAVES; const int lane = F.lane, l8 = lane & 7, l4 = lane & 3;
    for (int m = gw; m < MR; m += NGW) {
        const bool lat = m < ML; const int t = m & (SEQ - 1); const int prow = t >> 6, pcol = t & 63;
        { GAS v4u* rowp = (GAS v4u*)(KV + (size_t)m * NUKV);
          const f32x4 g0 = *(const GAS f32x4*)(gkn + l8 * 8), g1 = *(const GAS f32x4*)(gkn + l8 * 8 + 4);
#pragma unroll
          for (int pass = 0; pass < 2; ++pass) {
              float x[8]; unpack8(rowp[pass * 64 + lane], x); float ss = 0.f;
#pragma unroll
              for (int j = 0; j < 8; ++j) ss += x[j] * x[j];
              ss += shx(ss, 1, F.lane); ss += shx(ss, 2, F.lane); ss += shx(ss, 4, F.lane);
              const float r = 1.f / sqrtf(ss * (1.f / 64.f) + NORM_EPS);
              x[0] *= r * g0.x; x[1] *= r * g0.y; x[2] *= r * g0.z; x[3] *= r * g0.w; x[4] *= r * g1.x; x[5] *= r * g1.y; x[6] *= r * g1.z; x[7] *= r * g1.w;
              rowp[pass * 64 + lane] = pack8(x); } }
        if (lat) {
            GAS v4u* rowp = (GAS v4u*)(Q + (size_t)m * NUQ);
            { const f32x4 g0 = *(const GAS f32x4*)(gqn + l8 * 8), g1 = *(const GAS f32x4*)(gqn + l8 * 8 + 4);
#pragma unroll
              for (int pass = 0; pass < 2; ++pass) {
                  float x[8]; unpack8(rowp[pass * 64 + lane], x); float ss = 0.f;
#pragma unroll
                  for (int j = 0; j < 8; ++j) ss += x[j] * x[j];
                  ss += shx(ss, 1, F.lane); ss += shx(ss, 2, F.lane); ss += shx(ss, 4, F.lane);
                  const float r = qscale / sqrtf(ss * (1.f / 64.f) + NORM_EPS);
                  x[0] *= r * g0.x; x[1] *= r * g0.y; x[2] *= r * g0.z; x[3] *= r * g0.w; x[4] *= r * g1.x; x[5] *= r * g1.y; x[6] *= r * g1.z; x[7] *= r * g1.w;
                  rowp[pass * 64 + lane] = pack8(x); } }
            {
              const f32x4 g0 = *(const GAS f32x4*)(gqr + l4 * 8), g1 = *(const GAS f32x4*)(gqr + l4 * 8 + 4);
              float x[8]; unpack8(rowp[128 + lane], x); float ss = 0.f;
#pragma unroll
              for (int j = 0; j < 8; ++j) ss += x[j] * x[j];
              ss += shx(ss, 1, F.lane); ss += shx(ss, 2, F.lane);
              const float r = 1.f / sqrtf(ss * (1.f / 32.f) + NORM_EPS);
              x[0] *= r * g0.x; x[1] *= r * g0.y; x[2] *= r * g0.z; x[3] *= r * g0.w; x[4] *= r * g1.x; x[5] *= r * g1.y; x[6] *= r * g1.z; x[7] *= r * g1.w;
              float px[8];
#pragma unroll
              for (int j = 0; j < 8; ++j) px[j] = shx(x[j], 1, F.lane);
              const int pos = (l4 & 2) ? pcol : prow; const float* cs = rt + pos * 8;
              const f32x4 c0 = *(const GAS f32x4*)(cs), c1 = *(const GAS f32x4*)(cs + 4), sa = *(const GAS f32x4*)(cs + 1024), sb = *(const GAS f32x4*)(cs + 1028);
              const float cc[8] = {c0.x, c0.y, c0.z, c0.w, c1.x, c1.y, c1.z, c1.w}, sn[8] = {sa.x, sa.y, sa.z, sa.w, sb.x, sb.y, sb.z, sb.w};
              const float sgn = (l4 & 1) ? 1.f : -1.f;
#pragma unroll
              for (int j = 0; j < 8; ++j) x[j] = (x[j] * cc[j] + sgn * px[j] * sn[j]) * qscale;
              rowp[128 + lane] = pack8(x); }
        }
    }
}

__device__ __forceinline__ void kr6_pass(Frame& F) {
    if (((const float*)(F.ws + WS_HPAR))[448] == 0.f) return;
    const bf16* KR = (const bf16*)(F.ws + WS_KR); unsigned char* K6R = (unsigned char*)(F.ws + WS_K6R);
    for (int r = F.vcu * (NWAVES * 64) + F.tid; r < MR; r += F.G * (NWAVES * 64)) {
        const GAS v4u* rp = (const GAS v4u*)(KR + (size_t)r * 32);
        v4u w[4] = {rp[0], rp[1], rp[2], rp[3]};
#pragma unroll
        for (int q = 0; q < 4; ++q) { float x[8]; unpack8(w[q], x);
#pragma unroll
            for (int j = 0; j < 8; ++j) x[j] *= 1.5349124f;
            w[q] = pack8(x); }
        const attd::u32x6 c = attd::to_fp6(w[0], w[1], w[2], w[3]);
        unsigned char* img = K6R + (size_t)(r >> 6) * 2048; const int key = r & 63;
        *(GAS v4u*)(img + key * 16) = (v4u){c[0], c[1], c[2], c[3]}; *(GAS v2u*)(img + 1024 + key * 8) = (v2u){c[4], c[5]};
    }
}
__device__ __forceinline__ void attn0_phase(Frame& F) {
    att::lchar* lds = (att::lchar*)(F.lds + RING_OFF);
    const att::bf16* QKV = (const att::bf16*)(F.ws + WS_QKV); att::bf16* O = (att::bf16*)(F.ws + WS_O0);
    const bool fast = __builtin_amdgcn_readfirstlane(__builtin_bit_cast(int, ((const float*)(F.ws + WS_HPAR))[449])) != 0;
    const char* K6E = (const char*)(F.ws + WS_K6E);
    char* shm = (char*)(F.lds + RING_OFF);
    for (int ui = F.vcu; ui < 1056; ui += F.G) {
        if (ui < 512) {
            const int b = ui >> 8, h = (ui >> 5) & 7, R4 = ui & 31;
            const float* rpb = ARG(17) + h * 465;
            if (fast) {
                float* rl = (float*)(shm + attf::LDS_RPB);
                for (int i = F.tid; i < 465; i += NWAVES * 64) rl[i] = rpb[i] * att::LOG2E;
                __syncthreads();
                attf::FNa fu; fu.init((const attf::bf16*)QKV, (attf::bf16*)O, rl, b, h, R4, K6E);
                attf::fast_unit<8, attf::FNa, true>(fu, shm, F.tid);
            } else {
                att::UNa u; u.QKV = QKV; u.O = O; u.rpbl = (const LAS float*)(lds + att::L_RPB); u.b = b; u.h = h; u.R4 = R4; u.init();
                for (int i = F.tid; i < 465; i += NWAVES * 64) ((LAS float*)(lds + att::L_RPB))[i] = rpb[i] * att::LOG2E;
                att::unit<8, att::UNa>(u, lds, F.tid);
            }
        } else if (ui < 1024) {
            const int v = ui - 512;
            if (fast) { attf::FWin fu; fu.init((const attf::bf16*)QKV, (attf::bf16*)O, ARG(14), v >> 8, (v >> 2) & 63, (v >> 1) & 1, v & 1, K6E); attf::fast_unit<8, attf::FWin, true>(fu, shm, F.tid); }
            else { att::UWin u; u.QKV = QKV; u.O = O; u.sinkp = ARG(14); u.b = v >> 8; u.n = (v >> 2) & 63; u.g = (v >> 1) & 1; u.hh = v & 1; u.init(); att::unit<8, att::UWin>(u, lds, F.tid); }
        } else {
            const int v = ui - 1024;
            if (fast) { attf::FCtx fu; fu.init((const attf::bf16*)QKV, (attf::bf16*)O, ARG(14), v >> 4, v & 15, K6E); attf::fast_unit<8, attf::FCtx, true>(fu, shm, F.tid); }
            else { att::UCtx u; u.QKV = QKV; u.O = O; u.sinkp = ARG(14); u.b = v >> 4; u.hx = v & 15; u.init(); att::unit<8, att::UCtx>(u, lds, F.tid); }
        }
    }
}
__device__ __forceinline__ void attn1_phase(Frame& F) {
    att::lchar* lds = (att::lchar*)(F.lds + RING_OFF);
    const bool fast = __builtin_amdgcn_readfirstlane(__builtin_bit_cast(int, ((const float*)(F.ws + WS_HPAR))[448])) != 0;
    const bool g256 = F.G == 256; const int x = F.vcu >> 5, j = F.vcu & 31;
    const int nit = g256 ? 4 : (F.vcu < 1024 ? (1024 - F.vcu + F.G - 1) / F.G : 0);
    for (int i = 0; i < nit; ++i) {
        const int ui = g256 ? ((x * 4 + i) * 32 + j) : F.vcu + i * F.G;
        if (fast) attd::dense_unit(ui >> 9, (ui >> 5) & 15, ui & 31, (const attd::bf16*)(F.ws + WS_Q1), (const attd::bf16*)(F.ws + WS_KV1), (const char*)(F.ws + WS_K6N), (const char*)(F.ws + WS_K6R), (attd::bf16*)(F.ws + WS_O1), (char*)(F.lds + RING_OFF), F.tid);
        else {
        att::UDense u; u.Q = (const att::bf16*)(F.ws + WS_Q1); u.KV = (const att::bf16*)(F.ws + WS_KV1); u.KR = (const att::bf16*)(F.ws + WS_KR); u.O = (att::bf16*)(F.ws + WS_O1);
        u.b = ui >> 9; u.h = (ui >> 5) & 15; u.qb = ui & 31;
        att::unit<12, att::UDense>(u, lds, F.tid); }
    }
}

#ifndef PHASE_MASK
#define PHASE_MASK 0xFFFFFu
#endif
#ifndef PHASE_REP
#define PHASE_REP 0u
#endif
struct Args { const float* in[28]; float* out; unsigned char* ws; int ph_lo, ph_hi; };
constexpr int N_PHASES = 19;
__global__ void __launch_bounds__(NWAVES * 64, 2) fwd_kernel(Args args) {
    extern __shared__ __attribute__((aligned(16))) unsigned char lds[];
    for (int u = threadIdx.x; u < (LDS_BYTES - LDSCTL_OFF) / 4; u += NWAVES * 64) ((LAS unsigned*)((LAS unsigned char*)lds + LDSCTL_OFF))[u] = 0u;
    __syncthreads();
    if (!MK_PER_PHASE) (void)xcd_barrier_post((unsigned*)((gu32*)(ARG_WS + WS_CTL) + CW_BAR), (volatile LAS unsigned*)((LAS unsigned char*)lds + MISC_OFF) + 8);
    for (int ph2 = 2 * args.ph_lo; ph2 < 2 * args.ph_hi; ++ph2) {
        const int ph = ph2 >> 1; if ((ph2 & 1) && !((PHASE_REP >> ph) & 1)) continue;
        if (ph == 3 || ph == 14) continue;
        Frame F;
        { int t_ = threadIdx.x; asm volatile("" : "+v"(t_)); int b_ = blockIdx.x; asm volatile("" : "+s"(b_)); int g_ = gridDim.x; asm volatile("" : "+s"(g_)); F.tid = t_; F.bx = b_; F.G = g_; }
        F.lds = (LAS unsigned char*)lds; F.MISC = (volatile LAS unsigned*)(F.lds + MISC_OFF);
        F.lane = F.tid & 63; F.wave = __builtin_amdgcn_readfirstlane(F.tid >> 6);
        F.vcu = (F.G % 8 == 0) ? (F.bx % 8) * (F.G / 8) + F.bx / 8 : F.bx;
        F.ws = ARG_WS; F.out = ARG_OUT; F.ctl = (gu32*)(F.ws + WS_CTL);
        XcdBarrier bar; bar.bar = (unsigned*)(F.ctl + CW_BAR); bar.x = xb_xcc_id(); bar.st = F.MISC + 8;
        float* ctxres = (float*)(F.ws + WS_CTXRES);
        const float* mod = (const float*)(F.ws + WS_MOD);
        int gk = 0, xrows = 0, xS = 0;
        pg8::Gemm g{nullptr, nullptr, 0, 0, 0}; pg8::EpiAny ea{0, nullptr, nullptr, nullptr, nullptr, 0, 0};
        switch (ph) {
        case 0: if (!((PHASE_MASK >> 0) & 1)) break; p0_prologue(F); break;
        case 1: if (!((PHASE_MASK >> 1) & 1)) break; norm_phase(F, ARG(0), ARG(2), MR, ARG(6), 0, 0, true); break;
        case 2: if (!((PHASE_MASK >> 2) & 1)) break; gk = 1; g = pg8::Gemm{(const bf16*)(F.ws + WS_XN), (const bf16*)(F.ws + WS_WQKV), MR, NQKV, DM}; ea = pg8::EpiAny{3, (const float*)(F.ws + WS_HPAR), (void*)(F.ws + WS_QKV), (float*)(F.ws + WS_K6E), (const float*)(F.ws + WS_ROPE), NQKV, 0}; break;
        case 4: if (!((PHASE_MASK >> 4) & 1)) break; attn0_phase(F); break;
        case 5: if (!((PHASE_MASK >> 5) & 1)) break; gk = 2; g = pg8::Gemm{(const bf16*)(F.ws + WS_O0), (const bf16*)(F.ws + WS_WO0), ML, DM, DM}; xrows = MC; xS = 2; ea = pg8::EpiAny{2, ARG(0), (void*)F.out, (float*)(F.ws + WS_PART5), mod + 2048, 0, 2}; break;
        case 6: if (!((PHASE_MASK >> 6) & 1)) break; norm_phase(F, F.out, ctxres, MR, ARG(7), 0, 1, false, (const float*)(F.ws + WS_PART5), 4, true); break;
        case 7: if (!((PHASE_MASK >> 7) & 1)) break; gk = 1; g = pg8::Gemm{(const bf16*)(F.ws + WS_XN), (const bf16*)(F.ws + WS_W1_0), MR, FF, DM}; ea = pg8::EpiAny{1, nullptr, (void*)(F.ws + WS_H), nullptr, nullptr, FF, 1}; break;
        case 8: if (!((PHASE_MASK >> 8) & 1)) break; gk = 2; g = pg8::Gemm{(const bf16*)(F.ws + WS_H), (const bf16*)(F.ws + WS_W2_0), ML, DM, FF}; xrows = MC; xS = 4; ea = pg8::EpiAny{2, F.out, (void*)F.out, (float*)(F.ws + WS_PART8), mod + 5120, 0, 3}; break;
        case 9: if (!((PHASE_MASK >> 9) & 1)) break; norm_phase(F, F.out, ctxres, MR, ARG(6) + DM, 1, 0, false, (const float*)(F.ws + WS_PART8), 16, true); break;
        case 10: if (!((PHASE_MASK >> 10) & 1)) break; gk = 1; g = pg8::Gemm{(const bf16*)(F.ws + WS_XN), (const bf16*)(F.ws + WS_WIN), MR, NCIN, DM}; ea = pg8::EpiAny{1, nullptr, (void*)(F.ws + WS_CQKV), nullptr, nullptr, NCIN, 0}; break;
        case 11: if (!((PHASE_MASK >> 11) & 1)) break; cnorm_phase(F); break;
        case 12: if (!((PHASE_MASK >> 12) & 1)) break; kr6_pass(F); gk = 1; g = pg8::Gemm{(const bf16*)(F.ws + WS_CQN), (const bf16*)(F.ws + WS_WUQ), ML, NUQ, 384}; ea = pg8::EpiAny{3, (const float*)(F.ws + WS_HPAR), (void*)(F.ws + WS_Q1), nullptr, (const float*)(F.ws + WS_ROPE), NUQ, 1}; break;
        case 13: if (!((PHASE_MASK >> 13) & 1)) break; gk = 1; g = pg8::Gemm{(const bf16*)(F.ws + WS_CKVN), (const bf16*)(F.ws + WS_WUKV), MR, NUKV, 256}; ea = pg8::EpiAny{3, (const float*)(F.ws + WS_HPAR), (void*)(F.ws + WS_KV1), (float*)(F.ws + WS_K6N), (const float*)(F.ws + WS_ROPE), NUKV, 2}; break;
        case 15: if (!((PHASE_MASK >> 15) & 1)) break; attn1_phase(F); break;
        case 16: if (!((PHASE_MASK >> 16) & 1)) break; gk = 2; g = pg8::Gemm{(const bf16*)(F.ws + WS_O1), (const bf16*)(F.ws + WS_WO1), ML, DM, DM}; ea = pg8::EpiAny{2, F.out, (void*)(F.ws + WS_XR), ctxres, mod + 3 * 6144 + 2048, 0, 3}; break;
        case 17: if (!((PHASE_MASK >> 17) & 1)) break; norm_phase(F, (const float*)(F.ws + WS_XR), ctxres, ML, ARG(7) + DM, 1, 1, false, nullptr, 0, true); break;
        case 18: if (!((PHASE_MASK >> 18) & 1)) break; gk = 1; g = pg8::Gemm{(const bf16*)(F.ws + WS_XN), (const bf16*)(F.ws + WS_W1_1), ML, FF, DM}; ea = pg8::EpiAny{1, nullptr, (void*)(F.ws + WS_H), nullptr, nullptr, FF, 1}; break;
        case 19: if (!((PHASE_MASK >> 19) & 1)) break; gk = 2; g = pg8::Gemm{(const bf16*)(F.ws + WS_H), (const bf16*)(F.ws + WS_W2_1), ML, DM, FF}; ea = pg8::EpiAny{2, (const float*)(F.ws + WS_XR), (void*)F.out, ctxres, mod + 3 * 6144 + 5120, 0, 1}; break;
        default: break;
        }
        ea.scr = F.lds + LDSCTL_OFF + 4096;
        if (gk != 0) { pg8::StaticOrder S; S.init(g.M, g.N, g.K, F.G, F.bx, xrows, xS); pg8::gemm_phase<pg8::EpiAny, pg8::StaticOrder, true, true>(F.lds + RING_OFF, g, S, ea, F.tid); }
        const bool last_ = (ph == args.ph_hi - 1) && ((ph2 & 1) || !((PHASE_REP >> ph) & 1));
        if (!MK_PER_PHASE && !last_ && ph != 12) xcd_barrier(bar);
        else __syncthreads();
    }
}

extern "C" void kernel_launch(void* const* d_in, const int* in_sizes, int n_in, void* d_out, int out_size, void* d_ws, size_t ws_size, hipStream_t stream) {
    static int grid = 0;
    if (grid == 0) {
        if (n_in != 28 || in_sizes[0] != ML * DM || out_size != ML * DM || ws_size < WS_END) { fprintf(stderr, "kernel_launch: unexpected shapes: n_in %d in0 %d out %d ws %zu\n", n_in, n_in > 0 ? in_sizes[0] : -1, out_size, ws_size); grid = -1; return; }
        int dev = 0, cus = 0, per_cu = 0;
        if (hipGetDevice(&dev) != hipSuccess || hipDeviceGetAttribute(&cus, hipDeviceAttributeMultiprocessorCount, dev) != hipSuccess) { fprintf(stderr, "kernel_launch: device query failed\n"); grid = -1; return; }
        if (hipFuncSetAttribute((const void*)fwd_kernel, hipFuncAttributeMaxDynamicSharedMemorySize, LDS_BYTES) != hipSuccess) { fprintf(stderr, "kernel_launch: hipFuncSetAttribute failed\n"); grid = -1; return; }
        if (hipOccupancyMaxActiveBlocksPerMultiprocessor(&per_cu, (const void*)fwd_kernel, NWAVES * 64, LDS_BYTES) != hipSuccess || per_cu < 1)
            fprintf(stderr, "kernel_launch: note: occupancy query reports %d workgroups per CU\n", per_cu);
        (void)hipGetLastError();
        grid = cus;
    }
    if (grid < 0) return;
    if (hipMemsetAsync((char*)d_ws + WS_CTL, 0, CTL_ZERO_BYTES, stream) != hipSuccess) { fprintf(stderr, "kernel_launch: hipMemsetAsync failed\n"); return; }
    Args a{};
    for (int i = 0; i < 28; ++i) a.in[i] = (const float*)d_in[i];
    a.out = (float*)d_out; a.ws = (unsigned char*)d_ws;
#if MK_PER_PHASE
    for (int ph = 0; ph <= N_PHASES; ++ph) { a.ph_lo = ph; a.ph_hi = ph + 1; hipLaunchKernelGGL(fwd_kernel, dim3(grid), dim3(NWAVES * 64), LDS_BYTES, stream, a); }
#else
    a.ph_lo = 0; a.ph_hi = N_PHASES + 1;
    hipLaunchKernelGGL(fwd_kernel, dim3(grid), dim3(NWAVES * 64), LDS_BYTES, stream, a);
#endif
    const hipError_t le = hipPeekAtLastError();
    if (le != hipSuccess) fprintf(stderr, "kernel_launch: launch failed: %s\n", hipGetErrorName(le));
}
```

```cpp
#include <hip/hip_runtime.h>
#include <cstdio>
#include <cstdint>
namespace pg8 {
#define PG8_LAS __attribute__((address_space(3)))
typedef unsigned short bf16_t;
typedef short bf16x8 __attribute__((ext_vector_type(8)));
typedef float f32x4 __attribute__((ext_vector_type(4)));
typedef unsigned u32x4 __attribute__((ext_vector_type(4)));
typedef unsigned u32x2 __attribute__((ext_vector_type(2)));
typedef unsigned u32x6 __attribute__((ext_vector_type(6)));
typedef unsigned u32x16 __attribute__((ext_vector_type(16)));
typedef __bf16 bf16x32 __attribute__((ext_vector_type(32)));
constexpr int BM = 256, BK = 64, HALF = 128, HTB = HALF * BK * 2  , STAGE_BYTES = 8 * HTB, NXCD = 8, WGM = 8;

__host__ __device__ __forceinline__ int lds_byte(int r, int c) { const int st = (r >> 4) * 2 + (c >> 5), rr = r & 15, cc = c & 31, ob = rr * 64 + cc * 2; return st * 1024 + (ob ^ (((ob >> 9) & 1) << 5)); }
__host__ __device__ __forceinline__ void stage_rc(int b, int& R, int& C) { const int st = b / 1024, sb = b % 1024, swz = sb ^ (((sb >> 9) & 1) << 5); R = (st >> 1) * 16 + swz / 64; C = (st & 1) * 32 + (swz % 64) / 2; }
__host__ __device__ __forceinline__ int perm32(int rho) { const int n = rho >> 4, i = rho & 15; return 8 * (i >> 2) + 4 * n + (i & 3); }

struct Unit { int pm, pn, kinfo; };
struct Gemm { const bf16_t* A; const bf16_t* Bt; int M, N, K; };

struct StaticOrder {
    int nM, nN, nwg, G, c, ntK;
    int xtiles, xsh;
    __host__ __device__ void init(int M, int N, int K, int G_, int c_, int extra_rows = 0, int S = 1) { nM = M / BM; nN = N / BM; nwg = nM * nN; G = G_; c = c_; ntK = K / BK;
        xtiles = (extra_rows / BM) * nN; xsh = S; }
    __host__ __device__ bool next(int i, Unit& u) const {
        const long L = (long)i * G + c;
        if (L >= nwg) {
            if (xtiles == 0) return false;
            const int nb = (nwg - c + G - 1) / G;
            const int nbc = c < nwg ? nb : 0;
            const long e = (long)(i - nbc) * G + ((c + G - (nwg % G)) % G);
            if (e >= ((long)xtiles << xsh)) return false;
            const int tile = (int)(e >> xsh), ks = (int)e & ((1 << xsh) - 1), xnt = ntK >> xsh;
            u.pm = nM + tile / nN; u.pn = tile % nN; u.kinfo = (ks * xnt) | (xnt << 8) | (1 << 16); return true;
        }
        int wgid = (int)L; { const int q = nwg / NXCD, r = nwg % NXCD, xcd = wgid % NXCD, off = wgid / NXCD; wgid = (xcd < r ? xcd * (q + 1) : r * (q + 1) + (xcd - r) * q) + off; }
        const int nig = WGM * nN, gid = wgid / nig, fm = gid * WGM, gsz = (nM - fm) < WGM ? (nM - fm) : WGM;
        u.pm = fm + ((wgid % nig) % gsz); u.pn = (wgid % nig) / gsz; u.kinfo = ntK << 8; return true;
    }
    __device__ __forceinline__ void a_ready(const Unit&) const {}
    __device__ __forceinline__ void done(const Unit&) const {}
};

__device__ __forceinline__ unsigned cvt_pk_bf16(float lo, float hi) { unsigned r; asm volatile("v_cvt_pk_bf16_f32 %0, %1, %2" : "=v"(r) : "v"(lo), "v"(hi)); return r; }
__device__ __forceinline__ u32x2 pk4bf(f32x4 y) { u32x2 r; r.x = cvt_pk_bf16(y[0], y[1]); r.y = cvt_pk_bf16(y[2], y[3]); return r; }
__device__ __forceinline__ f32x4 unpk4bf(u32x2 w) { f32x4 r; r[0] = __builtin_bit_cast(float, w.x << 16); r[1] = __builtin_bit_cast(float, w.x & 0xffff0000u); r[2] = __builtin_bit_cast(float, w.y << 16); r[3] = __builtin_bit_cast(float, w.y & 0xffff0000u); return r; }
struct EpiAny {
    static constexpr bool AFTER_DRAIN = false;
    int mode; const float* base; void* out; float* ctxres; const float* gate; int ldc, relu2; PG8_LAS unsigned char* scr = nullptr;
    __device__ __forceinline__ bool perm() const { return mode == 1; }
    __device__ __forceinline__ bool headmode() const { return mode == 3; }
    __device__ __forceinline__ static float xsh(float v, int mask, int lane) { return __builtin_bit_cast(float, __builtin_amdgcn_ds_bpermute((lane ^ mask) << 2, __builtin_bit_cast(int, v))); }
    __device__ __forceinline__ void head_epilogue(const f32x4 (&acc)[2][2][4][2], const Unit& u, int wr, int wc, int fr, int fq) const {
        const int H = 4 * u.pn + wc, kind = relu2, lane = fr + 16 * fq;
        const bool f6 = kind != 0 && base[448] != 0.f;
        const bool f6e = kind == 0 && base[449] != 0.f;
        int cls, gsel; float qs = 1.f;
        if (kind == 0) { const float qq = f6e ? 1.6986436f : 0.125f * 1.4426950408889634f, kq = f6e ? 1.6986436f : 1.f;
                         if (H < 8) { cls = 2; gsel = 0; qs = qq; } else if (H < 10) { cls = 2; gsel = 1; qs = kq; } else if (H < 12) { cls = 0; gsel = 0; }
                         else if (H < 20) { cls = 1; gsel = 2; qs = qq; } else if (H < 28) { cls = 1; gsel = 3; qs = kq; } else { cls = 0; gsel = 0; } }
        else if (kind == 1) { qs = f6 ? 1.5349124f : 0.10206207261596575f * 1.4426950408889634f; if (H < 16) { cls = 1; gsel = 4; } else { cls = 3; gsel = 5; } }
        else { if (H < 16) { cls = 1; gsel = 6; if (f6) qs = 1.5349124f; } else { cls = 0; gsel = 0; } }
        const bool lat = u.pm < 64;
        const bool k6e = f6e && (H == 8 || H == 9 || (H >= 20 && H < 28));
        const bool k6 = (f6 && kind == 2 && H < 16) || k6e;
        bf16_t* O = (bf16_t*)out;
        const int col0 = u.pn * BM + 64 * wc + 8 * fq;
        f32x4 gv[2][2];
#pragma unroll
        for (int bj = 0; bj < 2; ++bj)
#pragma unroll
            for (int n = 0; n < 2; ++n) gv[bj][n] = *(const f32x4*)(base + gsel * 64 + 32 * bj + 8 * fq + 4 * n);
#pragma unroll
        for (int ai = 0; ai < 2; ++ai)
#pragma unroll
            for (int m = 0; m < 4; ++m) {
                const int row = u.pm * BM + ai * HALF + wr * 64 + m * 16 + fr;
                f32x4 v[2][2];
#pragma unroll
                for (int bj = 0; bj < 2; ++bj)
#pragma unroll
                    for (int n = 0; n < 2; ++n) v[bj][n] = acc[ai][bj][m][n];
                if (cls != 0) {
                    float s0 = 0.f, s1 = 0.f;
#pragma unroll
                    for (int n = 0; n < 2; ++n)
#pragma unroll
                        for (int e = 0; e < 4; ++e) { s0 += v[0][n][e] * v[0][n][e]; s1 += v[1][n][e] * v[1][n][e]; }
                    if (cls != 3) { s0 += s1; s0 += xsh(s0, 16, lane); s0 += xsh(s0, 32, lane); s0 = s0 * (1.f / 64.f); s1 = s0; }
                    else { s0 += xsh(s0, 16, lane); s0 += xsh(s0, 32, lane); s1 += xsh(s1, 16, lane); s1 += xsh(s1, 32, lane); s0 *= (1.f / 32.f); s1 *= (1.f / 32.f); }
                    const float r0 = 1.f / sqrtf(s0 + 1e-6f), r1 = 1.f / sqrtf(s1 + 1e-6f);
#pragma unroll
                    for (int n = 0; n < 2; ++n) { v[0][n] = v[0][n] * r0 * gv[0][n]; v[1][n] = v[1][n] * r1 * gv[1][n]; }
                    if (lat && cls == 2) {
                        const int t = row & 8191;
                        u32x4 cw[2][2]; const float sgn = fq < 2 ? -1.f : 1.f;
#pragma unroll
                        for (int bj = 0; bj < 2; ++bj) { const int pos = bj == 0 ? (t >> 6) : (t & 63);
#pragma unroll
                            for (int n = 0; n < 2; ++n) cw[bj][n] = *(const u32x4*)((const unsigned*)gate + pos * 16 + 8 * (fq & 1) + 4 * n); }
#pragma unroll
                        for (int bj = 0; bj < 2; ++bj)
#pragma unroll
                            for (int n = 0; n < 2; ++n) { f32x4 p, c, sn;
#pragma unroll
                                for (int e = 0; e < 4; ++e) { p[e] = xsh(v[bj][n][e], 32, lane); c[e] = __builtin_bit_cast(float, cw[bj][n][e] << 16); sn[e] = __builtin_bit_cast(float, cw[bj][n][e] & 0xffff0000u); }
                                v[bj][n] = v[bj][n] * c + (p * sgn) * sn; }
                    }
                    if (lat && cls == 3) {
                        const int t = row & 8191; const int pos = fq < 2 ? (t >> 6) : (t & 63); const float sgn = (fq & 1) ? 1.f : -1.f;
                        u32x4 cw[2];
#pragma unroll
                        for (int n = 0; n < 2; ++n) cw[n] = *(const u32x4*)((const unsigned*)gate + 2048 + pos * 8 + 4 * n);
#pragma unroll
                        for (int bj = 0; bj < 2; ++bj)
#pragma unroll
                            for (int n = 0; n < 2; ++n) { f32x4 p, c, sn;
#pragma unroll
                                for (int e = 0; e < 4; ++e) { p[e] = xsh(v[bj][n][e], 16, lane); c[e] = __builtin_bit_cast(float, cw[n][e] << 16); sn[e] = __builtin_bit_cast(float, cw[n][e] & 0xffff0000u); }
                                v[bj][n] = v[bj][n] * c + (p * sgn) * sn; }
                    }
                    if (qs != 1.f) {
#pragma unroll
                        for (int bj = 0; bj < 2; ++bj)
#pragma unroll
                            for (int n = 0; n < 2; ++n) v[bj][n] = v[bj][n] * qs; }
                }
                if (k6) {
                    PG8_LAS unsigned char* sw = scr + (wr * 4 + wc) * 1024 + fr * 64;
                    unsigned char* img = (unsigned char*)ctxres + (k6e ? ((size_t)(row >> 6) * 10 + (H < 10 ? H - 8 : H - 18)) : ((size_t)(row >> 6) * 16 + H)) * 3072;
                    const int key = row & 63;
#pragma unroll
                    for (int bj = 0; bj < 2; ++bj) {
                        u32x4 w; w.x = cvt_pk_bf16(v[bj][0][0], v[bj][0][1]); w.y = cvt_pk_bf16(v[bj][0][2], v[bj][0][3]); w.z = cvt_pk_bf16(v[bj][1][0], v[bj][1][1]); w.w = cvt_pk_bf16(v[bj][1][2], v[bj][1][3]);
                        *(PG8_LAS u32x4*)(sw + fq * 16) = w;
                        asm volatile("s_waitcnt lgkmcnt(0)" ::: "memory");
                        if (fq == 0) {
                            const u32x4 a0 = *(PG8_LAS u32x4*)(sw), a1 = *(PG8_LAS u32x4*)(sw + 16), a2 = *(PG8_LAS u32x4*)(sw + 32), a3 = *(PG8_LAS u32x4*)(sw + 48);
                            const u32x16 all = {a0.x, a0.y, a0.z, a0.w, a1.x, a1.y, a1.z, a1.w, a2.x, a2.y, a2.z, a2.w, a3.x, a3.y, a3.z, a3.w};
                            const u32x6 c = __builtin_amdgcn_cvt_scalef32_pk32_fp6_bf16(__builtin_bit_cast(bf16x32, all), 1.0f);
                            *(u32x4*)(img + bj * 1024 + key * 16) = (u32x4){c[0], c[1], c[2], c[3]};
                            *(u32x2*)(img + 2048 + bj * 512 + key * 8) = (u32x2){c[4], c[5]};
                        }
                        asm volatile("s_waitcnt lgkmcnt(0)" ::: "memory");
                    }
                    continue;
                }
                bf16_t* rowp = O + (size_t)row * ldc + col0;
#pragma unroll
                for (int bj = 0; bj < 2; ++bj) { u32x4 w; w.x = cvt_pk_bf16(v[bj][0][0], v[bj][0][1]); w.y = cvt_pk_bf16(v[bj][0][2], v[bj][0][3]); w.z = cvt_pk_bf16(v[bj][1][0], v[bj][1][1]); w.w = cvt_pk_bf16(v[bj][1][2], v[bj][1][3]);
                    *(u32x4*)(rowp + 32 * bj) = w; }
            }
    }
    __device__ __forceinline__ void operator()(const f32x4 (&acc)[2][2][4][2], const Unit& u, int wr, int wc, int fr, int fq) const {
        asm volatile("" : "+v"(fr), "+v"(fq));
        if (mode == 1) {
            bf16_t* O = (bf16_t*)out;
            const int row0 = u.pm * BM + wr * 64 + fr, col0 = u.pn * BM + wc * 32 + 8 * fq;
#pragma unroll
            for (int ai = 0; ai < 2; ++ai)
#pragma unroll
                for (int m = 0; m < 4; ++m) { bf16_t* rowp = O + (size_t)(row0 + ai * HALF + m * 16) * ldc + col0;
#pragma unroll
                    for (int bj = 0; bj < 2; ++bj) { f32x4 v0 = acc[ai][bj][m][0], v1 = acc[ai][bj][m][1];
                        if (relu2) {
#pragma unroll
                            for (int e = 0; e < 4; ++e) { float a = fmaxf(v0[e], 0.f), b = fmaxf(v1[e], 0.f); v0[e] = a * a; v1[e] = b * b; } }
                        u32x4 w; w.x = cvt_pk_bf16(v0[0], v0[1]); w.y = cvt_pk_bf16(v0[2], v0[3]); w.z = cvt_pk_bf16(v1[0], v1[1]); w.w = cvt_pk_bf16(v1[2], v1[3]);
                        *(u32x4*)(rowp + bj * HALF) = w; } }
            return;
        }
        if (mode == 3) { head_epilogue(acc, u, wr, wc, fr, fq); return; }
        const int t0 = u.pm * BM; const bool split = (u.kinfo >> 16) != 0; const int cond = t0 < 8192 ? 0 : (t0 < 16384 ? 1 : 2);
        const int col0 = u.pn * BM + wc * 32 + 4 * fq; const float* g = gate + cond * 6144 + col0;
        f32x4 gv[2][2];
#pragma unroll
        for (int bj = 0; bj < 2; ++bj)
#pragma unroll
            for (int n = 0; n < 2; ++n) gv[bj][n] = *(const f32x4*)(g + bj * HALF + n * 16);
        if (split) {
            const int ks = (u.kinfo & 255) / ((u.kinfo >> 8) & 255);
            float* op = ctxres + (size_t)ks * (512 * 1024) + (size_t)(t0 - 16384) * 1024;
#pragma unroll
            for (int ai = 0; ai < 2; ++ai)
#pragma unroll
                for (int m = 0; m < 4; ++m) { const size_t off = (size_t)(wr * 64 + fr + ai * HALF + m * 16) * 1024 + col0;
#pragma unroll
                    for (int bj = 0; bj < 2; ++bj)
#pragma unroll
                        for (int n = 0; n < 2; ++n) *(f32x4*)(op + off + bj * HALF + n * 16) = gv[bj][n] * acc[ai][bj][m][n]; }
            return;
        }
#define PG8_RES_LOOP(LOADB, STOREO) _Pragma("unroll") for (int ai = 0; ai < 2; ++ai) _Pragma("unroll") for (int m = 0; m < 4; ++m) { const size_t off = (size_t)(wr * 64 + fr + ai * HALF + m * 16) * 1024 + col0; \
            _Pragma("unroll") for (int bj = 0; bj < 2; ++bj) _Pragma("unroll") for (int n = 0; n < 2; ++n) { const size_t o2 = off + bj * HALF + n * 16; f32x4 b; LOADB; const f32x4 y = b + gv[bj][n] * acc[ai][bj][m][n]; STOREO; } }
        if (relu2 == 2) { const float* bp = base + (size_t)t0 * 1024; bf16_t* op = (bf16_t*)out + (size_t)t0 * 1024;
            PG8_RES_LOOP(b = *(const f32x4*)(bp + o2), *(u32x2*)(op + o2) = pk4bf(y)); }
        else if (relu2 == 3) { const bf16_t* bp = (const bf16_t*)base + (size_t)t0 * 1024; bf16_t* op = (bf16_t*)out + (size_t)t0 * 1024;
            PG8_RES_LOOP(const u32x2 w = *(const u32x2*)(bp + o2); b = unpk4bf(w), *(u32x2*)(op + o2) = pk4bf(y)); }
        else { const bf16_t* bp = (const bf16_t*)base + (size_t)t0 * 1024; float* op = (float*)out + (size_t)t0 * 1024;
            PG8_RES_LOOP(const u32x2 w = *(const u32x2*)(bp + o2); b = unpk4bf(w), *(f32x4*)(op + o2) = y); }
#undef PG8_RES_LOOP
    }
};

template <class Epi, class Sched, bool ALIGN_EPI = false, bool SP2 = false>
__device__ __forceinline__ void gemm_phase(PG8_LAS unsigned char* lds, const Gemm g, const Sched& S, const Epi& E, const int tid) {
    const int wid = __builtin_amdgcn_readfirstlane(tid >> 6), lane = tid & 63, wr = wid >> 2, wc = wid & 3, fr = lane & 15, fq = lane >> 4;
    const int K = g.K;
    unsigned voffA[2], voffB[2];
#pragma unroll
    for (int i = 0; i < 2; ++i) { int R, C; stage_rc(tid * 16 + i * 8192, R, C); const int Rb = E.headmode() ? (64 * (R >> 5) + perm32(R & 31)) : (E.perm() ? ((R & ~31) + perm32(R & 31)) : R);
        voffA[i] = (unsigned)(R * K + C) * 2u; voffB[i] = (unsigned)(Rb * K + C) * 2u; }
    const size_t kstep = (size_t)(BK * 2);
    const size_t hstep = (size_t)HALF * K * 2;
    const size_t tstep = 2 * hstep;
    const size_t hstepB = E.headmode() ? (size_t)32 * K * 2 : hstep;
    const unsigned ldsw = (unsigned)wid * 1024u;
    const int aoff = lds_byte(wr * 64 + fr, fq * 8), boff = lds_byte(wc * 32 + fr, fq * 8);
#define PG8_SA(b, h) (((b) * 2 + (h)) * HTB)
#define PG8_SB(b, h) ((4 + (b) * 2 + (h)) * HTB)
#define PG8_STAGE(bufoff, gbase, voff) do { _Pragma("unroll") for (int _i = 0; _i < 2; ++_i) \
        __builtin_amdgcn_global_load_lds((const unsigned*)((const char*)(gbase) + (voff)[_i]), (PG8_LAS unsigned*)(lds + (bufoff) + ldsw + _i * 8192), 16, 0, 0); } while (0)
#define PG8_LDA(dst, b, h) do { _Pragma("unroll") for (int m = 0; m < 4; ++m) _Pragma("unroll") for (int k = 0; k < 2; ++k) dst[m][k] = *(const PG8_LAS bf16x8*)(lds + PG8_SA(b, h) + aoff + m * 2048 + k * 1024); } while (0)
#define PG8_LDB(dst, b, h) do { _Pragma("unroll") for (int n = 0; n < 2; ++n) _Pragma("unroll") for (int k = 0; k < 2; ++k) dst[n][k] = *(const PG8_LAS bf16x8*)(lds + PG8_SB(b, h) + boff + n * 2048 + k * 1024); } while (0)
#define PG8_MMA(ai, bj, At, Bt) do { __builtin_amdgcn_s_setprio(1); _Pragma("unroll") for (int m = 0; m < 4; ++m) _Pragma("unroll") for (int n = 0; n < 2; ++n) _Pragma("unroll") for (int k = 0; k < 2; ++k) \
        acc[ai][bj][m][n] = __builtin_amdgcn_mfma_f32_16x16x32_bf16(Bt[n][k], At[m][k], acc[ai][bj][m][n], 0, 0, 0); __builtin_amdgcn_s_setprio(0); } while (0)
#define PG8_WAIT_V(n) asm volatile("s_waitcnt vmcnt(" #n ")" ::: "memory")
#define PG8_WAIT_L(n) asm volatile("s_waitcnt lgkmcnt(" #n ")" ::: "memory")
#define PG8_BAR __builtin_amdgcn_s_barrier()
#define PG8_SCHED __builtin_amdgcn_sched_barrier(0)
    Unit cur, nxt; int ui = 0;
    if (!S.next(0, cur)) return;
    f32x4 acc[2][2][4][2];
#pragma unroll
    for (int a = 0; a < 2; ++a)
#pragma unroll
        for (int b = 0; b < 2; ++b)
#pragma unroll
            for (int m = 0; m < 4; ++m)
#pragma unroll
                for (int n = 0; n < 2; ++n) acc[a][b][m][n] = (f32x4){0.f, 0.f, 0.f, 0.f};
    bf16x8 At[4][2], B0[2][2], B1[2][2];
    const char* cA = (const char*)g.A + (size_t)cur.pm * tstep + (size_t)(cur.kinfo & 255) * (BK * 2); const char* cB = (const char*)g.Bt + (size_t)cur.pn * tstep + (size_t)(cur.kinfo & 255) * (BK * 2);
    S.a_ready(cur);
    if constexpr (SP2) {
        PG8_STAGE(PG8_SB(0, 0), cB, voffB); PG8_STAGE(PG8_SB(0, 1), cB + hstepB, voffB); PG8_STAGE(PG8_SA(0, 0), cA, voffA); PG8_STAGE(PG8_SA(0, 1), cA + hstep, voffA);
        if (wr == 1) PG8_BAR;
        PG8_WAIT_V(2); PG8_BAR;
        PG8_STAGE(PG8_SB(1, 0), cB + kstep, voffB); PG8_STAGE(PG8_SA(1, 0), cA + kstep, voffA); PG8_STAGE(PG8_SB(1, 1), cB + hstepB + kstep, voffB);
        PG8_WAIT_V(6); PG8_BAR;
    } else {
        PG8_STAGE(PG8_SB(0, 0), cB, voffB); PG8_STAGE(PG8_SA(0, 0), cA, voffA); PG8_STAGE(PG8_SB(0, 1), cB + hstepB, voffB); PG8_STAGE(PG8_SA(0, 1), cA + hstep, voffA);
        if (wr == 1) PG8_BAR;
        PG8_WAIT_V(4); PG8_BAR;
        PG8_STAGE(PG8_SB(1, 0), cB + kstep, voffB); PG8_STAGE(PG8_SA(1, 0), cA + kstep, voffA); PG8_STAGE(PG8_SB(1, 1), cB + hstepB + kstep, voffB);
        PG8_WAIT_V(6); PG8_BAR;
    }
    for (;;) {
        const bool has_next = S.next(ui + 1, nxt);
        const char* nA = has_next ? (const char*)g.A + (size_t)nxt.pm * tstep + (size_t)(nxt.kinfo & 255) * (BK * 2) : cA; const char* nB = has_next ? (const char*)g.Bt + (size_t)nxt.pn * tstep + (size_t)(nxt.kinfo & 255) * (BK * 2) : cB;
        const int nt = (cur.kinfo >> 8) & 255;
        for (int t = 0; t < nt; t += 2) {
            const bool last = (t == nt - 2);
            const char* a1 = cA + (size_t)(t + 1) * kstep;
            const char* a2 = last ? nA : cA + (size_t)(t + 2) * kstep; const char* b2 = last ? nB : cB + (size_t)(t + 2) * kstep;
            const char* a3 = a2 + kstep; const char* b3 = b2 + kstep;
            if (last && has_next) S.a_ready(nxt);
            if constexpr (SP2) {
            PG8_LDB(B0, 0, 0); PG8_LDB(B1, 0, 1); PG8_SCHED; PG8_LDA(At, 0, 0); PG8_STAGE(PG8_SA(1, 1), a1 + hstep, voffA);
            PG8_WAIT_V(8); PG8_WAIT_L(0); PG8_BAR; PG8_MMA(0, 0, At, B0); PG8_MMA(0, 1, At, B1); PG8_BAR; PG8_SCHED;
            PG8_LDA(At, 0, 1); PG8_STAGE(PG8_SB(0, 0), b2, voffB); PG8_STAGE(PG8_SB(0, 1), b2 + hstepB, voffB); PG8_STAGE(PG8_SA(0, 0), a2, voffA);
            PG8_WAIT_V(8); PG8_WAIT_L(0); PG8_BAR; PG8_MMA(1, 0, At, B0); PG8_MMA(1, 1, At, B1); PG8_BAR; PG8_SCHED;
            PG8_LDB(B0, 1, 0); PG8_LDB(B1, 1, 1); PG8_SCHED; PG8_LDA(At, 1, 0); PG8_STAGE(PG8_SA(0, 1), a2 + hstep, voffA);
            PG8_WAIT_V(8); PG8_WAIT_L(0); PG8_BAR; PG8_MMA(0, 0, At, B0); PG8_MMA(0, 1, At, B1); PG8_BAR; PG8_SCHED;
            PG8_LDA(At, 1, 1); PG8_STAGE(PG8_SB(1, 0), b3, voffB); PG8_STAGE(PG8_SB(1, 1), b3 + hstepB, voffB); PG8_STAGE(PG8_SA(1, 0), a3, voffA);
            PG8_WAIT_V(8); PG8_WAIT_L(0); PG8_BAR; PG8_MMA(1, 0, At, B0); PG8_MMA(1, 1, At, B1); PG8_BAR; PG8_SCHED;
            } else {
            PG8_LDB(B0, 0, 0); PG8_SCHED; PG8_LDA(At, 0, 0); PG8_STAGE(PG8_SA(1, 1), a1 + hstep, voffA);
            PG8_WAIT_L(8); PG8_BAR; PG8_WAIT_L(0); PG8_MMA(0, 0, At, B0); PG8_BAR; PG8_SCHED;
            PG8_LDB(B1, 0, 1); PG8_STAGE(PG8_SB(0, 0), b2, voffB);
            PG8_BAR; PG8_WAIT_L(0); PG8_MMA(0, 1, At, B1); PG8_BAR;
            PG8_LDA(At, 0, 1); PG8_STAGE(PG8_SA(0, 0), a2, voffA);
            PG8_BAR; PG8_WAIT_L(0); PG8_MMA(1, 0, At, B0); PG8_BAR; PG8_SCHED;
            PG8_STAGE(PG8_SB(0, 1), b2 + hstepB, voffB);
            PG8_WAIT_V(6); PG8_BAR; PG8_MMA(1, 1, At, B1); PG8_BAR;
            PG8_LDB(B0, 1, 0); PG8_SCHED; PG8_LDA(At, 1, 0); PG8_STAGE(PG8_SA(0, 1), a2 + hstep, voffA);
            PG8_WAIT_L(8); PG8_BAR; PG8_WAIT_L(0); PG8_MMA(0, 0, At, B0); PG8_BAR; PG8_SCHED;
            PG8_LDB(B1, 1, 1); PG8_STAGE(PG8_SB(1, 0), b3, voffB);
            PG8_BAR; PG8_WAIT_L(0); PG8_MMA(0, 1, At, B1); PG8_BAR;
            PG8_LDA(At, 1, 1); PG8_STAGE(PG8_SA(1, 0), a3, voffA);
            PG8_BAR; PG8_WAIT_L(0); PG8_MMA(1, 0, At, B0); PG8_BAR; PG8_SCHED;
            PG8_STAGE(PG8_SB(1, 1), b3 + hstepB, voffB);
            PG8_WAIT_V(6); PG8_BAR; PG8_MMA(1, 1, At, B1); PG8_BAR;
            }
        }
        if constexpr (ALIGN_EPI) { if (wr == 0) PG8_BAR; }
        if constexpr (!Epi::AFTER_DRAIN) { E(acc, cur, wr, wc, fr, fq); S.done(cur); }
        if (!has_next) break;
#pragma unroll
        for (int a = 0; a < 2; ++a)
#pragma unroll
            for (int b = 0; b < 2; ++b)
#pragma unroll
                for (int m = 0; m < 4; ++m)
#pragma unroll
                    for (int n = 0; n < 2; ++n) acc[a][b][m][n] = (f32x4){0.f, 0.f, 0.f, 0.f};
        cur = nxt; cA = nA; cB = nB; ++ui;
        if constexpr (ALIGN_EPI) { if (wr == 1) PG8_BAR; }
    }
    PG8_WAIT_V(0);
    if constexpr (!ALIGN_EPI) { if (wr == 0) PG8_BAR; }
    PG8_BAR;
    if constexpr (Epi::AFTER_DRAIN) { E.fused(acc, cur, wr, wc, fr, fq, lds, wid, lane); S.done(cur); }
#undef PG8_SA
#undef PG8_SB
#undef PG8_STAGE
#undef PG8_LDA
#undef PG8_LDB
#undef PG8_MMA
#undef PG8_WAIT_V
#undef PG8_WAIT_L
#undef PG8_BAR
#undef PG8_SCHED
}
}
namespace att {
#define ATT_LAS __attribute__((address_space(3)))
typedef unsigned short bf16;
typedef short bf16x8 __attribute__((ext_vector_type(8)));
typedef short s16x4 __attribute__((ext_vector_type(4)));
typedef float f32x16 __attribute__((ext_vector_type(16)));
typedef unsigned u32x4 __attribute__((ext_vector_type(4)));
typedef ATT_LAS char lchar;
constexpr int KBUF = 12288, VBUF = 16384;
constexpr int L_K = 0, L_V = 2 * KBUF, L_WS = L_V + 2 * VBUF, L_RPB = L_WS + 2048, L_END = L_RPB + 2048;
constexpr float LOG2E = 1.4426950408889634f;
#define ATT_SBAR() __builtin_amdgcn_sched_barrier(0)
__device__ __forceinline__ int crow(int r, int hi) { return (r & 3) + 8 * (r >> 2) + 4 * hi; }
__device__ __forceinline__ unsigned cvtpk(float lo, float hi) { unsigned r; asm volatile("v_cvt_pk_bf16_f32 %0, %1, %2" : "=v"(r) : "v"(lo), "v"(hi)); return r; }
__device__ __forceinline__ int v_st(int k, int c) { const int kk = (k & ~0xC) | ((k & 4) << 1) | ((k & 8) >> 1); return ((kk >> 3) * 4 + (c >> 5)) * 512 + ((kk & 7) * 32 + (c & 31)) * 2; }
__device__ __forceinline__ int v_rd_base(int lane) { return ((lane & 3) << 3) | (((lane >> 2) & 3) << 6) | (((lane >> 4) & 1) << 5) | (((lane >> 5) & 1) << 8); }
constexpr int v_rd_off(int d0, int ks, int half) { return d0 * 512 + ks * 4096 + half * 2048; }
template <int OFF> __device__ __forceinline__ s16x4 tr_read(unsigned vb) {
  s16x4 r; asm volatile("ds_read_b64_tr_b16 %0, %1 offset:%2" : "=&v"(r) : "v"(vb), "i"(OFF) : "memory"); return r;
}
template <int D0> __device__ __forceinline__ void pv_one(f32x16& od, unsigned vb, bf16x8 pa0, bf16x8 pa1, bf16x8 pa2, bf16x8 pa3) {
  const s16x4 l0 = tr_read<v_rd_off(D0, 0, 0)>(vb), h0 = tr_read<v_rd_off(D0, 0, 1)>(vb), l1 = tr_read<v_rd_off(D0, 1, 0)>(vb), h1 = tr_read<v_rd_off(D0, 1, 1)>(vb);
  const s16x4 l2 = tr_read<v_rd_off(D0, 2, 0)>(vb), h2 = tr_read<v_rd_off(D0, 2, 1)>(vb), l3 = tr_read<v_rd_off(D0, 3, 0)>(vb), h3 = tr_read<v_rd_off(D0, 3, 1)>(vb);
  asm volatile("s_waitcnt lgkmcnt(0)" ::: "memory"); ATT_SBAR();
#define ATT_PK(L, H) (bf16x8){L[0], L[1], L[2], L[3], H[0], H[1], H[2], H[3]}
  od = __builtin_amdgcn_mfma_f32_32x32x16_bf16(pa0, ATT_PK(l0, h0), od, 0, 0, 0);
  od = __builtin_amdgcn_mfma_f32_32x32x16_bf16(pa1, ATT_PK(l1, h1), od, 0, 0, 0);
  od = __builtin_amdgcn_mfma_f32_32x32x16_bf16(pa2, ATT_PK(l2, h2), od, 0, 0, 0);
  od = __builtin_amdgcn_mfma_f32_32x32x16_bf16(pa3, ATT_PK(l3, h3), od, 0, 0, 0);
#undef ATT_PK
}

template <int DKC, class U>
__device__ __forceinline__ void unit(const U& u, lchar* lds, int tid) {
  asm volatile("" : "+v"(tid));
  const int lane = tid & 63, r32 = lane & 31, hi = lane >> 5;
  const int wid = __builtin_amdgcn_readfirstlane(tid >> 6);
  lchar* Kl = lds + L_K; lchar* Vl = lds + L_V;
  ATT_LAS float* ws = (ATT_LAS float*)(lds + L_WS) + wid * 64;
  bf16x8 qr[DKC / 2];
#pragma unroll
  for (int d0 = 0; d0 < DKC / 2; ++d0) qr[d0] = *(const bf16x8*)u.qptr(wid, r32, d0, hi);
  const int vrow = tid >> 3, vch = tid & 7, vst = v_st(vrow, vch * 8);
  const int krow0 = tid & 63, kch0 = tid >> 6;
  const bool k2 = (DKC > 8) && (tid < 64 * (DKC - 8));
  const unsigned vb0 = (unsigned)(uintptr_t)Vl + (unsigned)v_rd_base(lane);
  bf16x8 kst0, kst1 = {}, vstr;
  const int NT = u.nt();
#define ATT_SLOAD(t) do { const long R_ = u.krow(t); kst0 = *(const bf16x8*)u.kptr(R_ + krow0, kch0); if (k2) kst1 = *(const bf16x8*)u.kptr(R_ + krow0, 8 + kch0); \
    vstr = *(const bf16x8*)u.vptr(R_ + vrow, vch); } while (0)
#define ATT_SWRITE(b) do { *(ATT_LAS bf16x8*)(Kl + (b) * KBUF + kch0 * 1024 + krow0 * 16) = kst0; if (k2) *(ATT_LAS bf16x8*)(Kl + (b) * KBUF + (8 + kch0) * 1024 + krow0 * 16) = kst1; \
    *(ATT_LAS bf16x8*)(Vl + (b) * VBUF + vst) = vstr; } while (0)
  float m_reg = -1e30f, l_reg = 0.f; f32x16 o[2]; o[0] = f32x16{}; o[1] = f32x16{};
  ATT_SLOAD(0); ATT_SWRITE(0); __syncthreads();
  for (int t = 0; t < NT; ++t) {
    const int buf = t & 1;
    if (t + 1 < NT) ATT_SLOAD(t + 1);
    if (!u.skip(t, wid)) {
      f32x16 p0 = f32x16{}, p1 = f32x16{};
      { const lchar* kb = Kl + buf * KBUF + hi * 1024 + r32 * 16;
#pragma unroll
        for (int d0 = 0; d0 < DKC / 2; ++d0) {
          const bf16x8 b0 = *(const ATT_LAS bf16x8*)(kb + d0 * 2048);
          const bf16x8 b1 = *(const ATT_LAS bf16x8*)(kb + d0 * 2048 + 512);
          p0 = __builtin_amdgcn_mfma_f32_32x32x16_bf16(b0, qr[d0], p0, 0, 0, 0);
          p1 = __builtin_amdgcn_mfma_f32_32x32x16_bf16(b1, qr[d0], p1, 0, 0, 0); } }
      u.mask(p0, p1, t, wid, r32, hi);
      float pmax = p0[0];
#pragma unroll
      for (int r = 1; r < 16; ++r) pmax = fmaxf(pmax, p0[r]);
#pragma unroll
      for (int r = 0; r < 16; ++r) pmax = fmaxf(pmax, p1[r]);
      { auto rr = __builtin_amdgcn_permlane32_swap(__float_as_uint(pmax), __float_as_uint(pmax), false, false);
        pmax = fmaxf(__uint_as_float(rr[0]), __uint_as_float(rr[1])); }
      const float mn = fmaxf(m_reg, pmax);
      const float alpha = __builtin_amdgcn_exp2f(m_reg - mn);
      m_reg = mn;
#pragma unroll
      for (int r = 0; r < 16; ++r) { p0[r] = __builtin_amdgcn_exp2f(p0[r] - mn); p1[r] = __builtin_amdgcn_exp2f(p1[r] - mn); }
      float ps = 0.f;
#pragma unroll
      for (int r = 0; r < 16; ++r) ps += p0[r];
#pragma unroll
      for (int r = 0; r < 16; ++r) ps += p1[r];
      { auto rr = __builtin_amdgcn_permlane32_swap(__float_as_uint(ps), __float_as_uint(ps), false, false);
        ps = __uint_as_float(rr[0]) + __uint_as_float(rr[1]); }
      l_reg = l_reg * alpha + ps;
      if (__any(alpha < 1.f)) {
        if (hi == 0) ws[r32] = alpha;
        asm volatile("s_waitcnt lgkmcnt(0)" ::: "memory");
#pragma unroll
        for (int r = 0; r < 16; ++r) { const float a = ws[crow(r, hi)]; o[0][r] *= a; o[1][r] *= a; }
      }
      bf16x8 pa0, pa1, pa2, pa3;
#define ATT_PK4(P, BASE, OUT) do { unsigned a0 = cvtpk(P[BASE + 0], P[BASE + 1]), a1 = cvtpk(P[BASE + 2], P[BASE + 3]);   \
    unsigned b0 = cvtpk(P[BASE + 4], P[BASE + 5]), b1 = cvtpk(P[BASE + 6], P[BASE + 7]);                              \
    auto r0 = __builtin_amdgcn_permlane32_swap(a0, b0, false, false); auto r1 = __builtin_amdgcn_permlane32_swap(a1, b1, false, false); \
    u32x4 w = {r0[0], r1[0], r0[1], r1[1]}; OUT = __builtin_bit_cast(bf16x8, w); } while (0)
      ATT_PK4(p0, 0, pa0); ATT_PK4(p0, 8, pa1); ATT_PK4(p1, 0, pa2); ATT_PK4(p1, 8, pa3);
#undef ATT_PK4
      const unsigned vb = vb0 + (unsigned)(buf * VBUF);
      pv_one<0>(o[0], vb, pa0, pa1, pa2, pa3); pv_one<1>(o[1], vb, pa0, pa1, pa2, pa3);
    }
    if (t + 1 < NT) ATT_SWRITE(buf ^ 1);
    __syncthreads();
  }
#undef ATT_SLOAD
#undef ATT_SWRITE
  { const float sk = u.sink(wid); l_reg += __builtin_amdgcn_exp2f(sk - m_reg); }
  if (hi == 0) ws[r32] = l_reg;
  asm volatile("s_waitcnt lgkmcnt(0)" ::: "memory");
  float rli[16];
#pragma unroll
  for (int r = 0; r < 16; ++r) rli[r] = __builtin_amdgcn_rcpf(ws[crow(r, hi)]);
#pragma unroll
  for (int r = 0; r < 16; ++r) { bf16* op = u.orow(wid, crow(r, hi));
    op[r32] = (bf16)(cvtpk(o[0][r] * rli[r], 0.f) & 0xffffu); op[32 + r32] = (bf16)(cvtpk(o[1][r] * rli[r], 0.f) & 0xffffu); }
  asm volatile("s_waitcnt lgkmcnt(0)" ::: "memory");
}

constexpr int ROWS_LAT = 16384;
struct UWin {
  const bf16* QKV; bf16* O; const float* sinkp; int b, n, g, hh; int i0, cnt;
  __device__ __forceinline__ void init() { i0 = (n == 0) ? 2 : 0; cnt = (n == 0 || n == 63) ? 4 : 6; }
  __device__ __forceinline__ int nt() const { return 4 + cnt; }
  __device__ __forceinline__ int kpos0(int t) const { return 128 * (n - 1) + 64 * (i0 + t - 4); }
  __device__ __forceinline__ long krow(int t) const { return t < 4 ? (long)(ROWS_LAT + 256 * b + 64 * t) : (long)(8192 * b + kpos0(t)); }
  __device__ __forceinline__ const bf16* kptr(long row, int ch) const { return QKV + row * 2304 + 512 + 64 * g + ch * 8; }
  __device__ __forceinline__ const bf16* vptr(long row, int ch) const { return QKV + row * 2304 + 640 + 64 * g + ch * 8; }
  __device__ __forceinline__ int head(int wid) const { return 4 * g + 2 * hh + (wid >> 2); }
  __device__ __forceinline__ int qpos0(int wid) const { return 128 * n + 32 * (wid & 3); }
  __device__ __forceinline__ const bf16* qptr(int wid, int r32, int d0, int hi) const { return QKV + (long)(8192 * b + qpos0(wid) + r32) * 2304 + 64 * head(wid) + 16 * d0 + 8 * hi; }
  __device__ __forceinline__ bool skip(int t, int wid) const { if (t < 4) return false; const int k0 = kpos0(t), q0 = qpos0(wid); return (k0 + 63 < q0 - 128) || (k0 > q0 + 31 + 128); }
  __device__ __forceinline__ void mask(f32x16& p0, f32x16& p1, int t, int wid, int r32, int hi) const {
    if (t < 4) return;
    const int dq = kpos0(t) - (qpos0(wid) + r32);
#pragma unroll
    for (int r = 0; r < 16; ++r) { const int d = dq + crow(r, hi); if (d > 128 || d < -128) p0[r] = -INFINITY; if (d + 32 > 128 || d + 32 < -128) p1[r] = -INFINITY; }
  }
  __device__ __forceinline__ float sink(int wid) const { return sinkp[head(wid)] * LOG2E; }
  __device__ __forceinline__ bf16* orow(int wid, int row) const { return O + (long)(8192 * b + qpos0(wid) + row) * 1024 + 64 * head(wid); }
};
struct UNa {
  const bf16* QKV; bf16* O; const ATT_LAS float* rpbl; int b, h, R4; int krlo, nloc;
  __device__ __forceinline__ static int clampi(int v, int lo, int hi_) { return v < lo ? lo : (v > hi_ ? hi_ : v); }
  __device__ __forceinline__ void init() { krlo = clampi(4 * R4 - 4, 0, 120); const int krhi = clampi(4 * R4 - 1, 0, 120) + 7; nloc = krhi - krlo + 1; }
  __device__ __forceinline__ int nt() const { return 4 + nloc; }
  __device__ __forceinline__ long krow(int t) const { return t < 4 ? (long)(ROWS_LAT + 256 * b + 64 * t) : (long)(8192 * b + 64 * (krlo + t - 4)); }
  __device__ __forceinline__ const bf16* kptr(long row, int ch) const { return QKV + row * 2304 + 1280 + 64 * h + ch * 8; }
  __device__ __forceinline__ const bf16* vptr(long row, int ch) const { return QKV + row * 2304 + 1792 + 64 * h + ch * 8; }
  __device__ __forceinline__ int qrow(int wid) const { return 4 * R4 + (wid >> 1); }
  __device__ __forceinline__ const bf16* qptr(int wid, int r32, int d0, int hi) const { return QKV + (long)(8192 * b + 64 * qrow(wid) + 32 * (wid & 1) + r32) * 2304 + 768 + 64 * h + 16 * d0 + 8 * hi; }
  __device__ __forceinline__ bool skip(int t, int wid) const { if (t < 4) return false; const int kr = krlo + t - 4, w0 = clampi(qrow(wid) - 4, 0, 120); return kr < w0 || kr > w0 + 7; }
  __device__ __forceinline__ void mask(f32x16& p0, f32x16& p1, int t, int wid, int r32, int hi) const {
    if (t < 4) return;
    const int kr = krlo + t - 4, qc = 32 * (wid & 1) + r32, c0 = clampi(qc - 8, 0, 48);
    const ATT_LAS float* brow = rpbl + (kr - qrow(wid) + 7) * 31 + 15;
#pragma unroll
    for (int r = 0; r < 16; ++r) {
      { const int kc = crow(r, hi); const bool ok = kc >= c0 && kc < c0 + 16; const float bv = brow[clampi(kc - qc, -15, 15)]; p0[r] = ok ? p0[r] + bv : -INFINITY; }
      { const int kc = 32 + crow(r, hi); const bool ok = kc >= c0 && kc < c0 + 16; const float bv = brow[clampi(kc - qc, -15, 15)]; p1[r] = ok ? p1[r] + bv : -INFINITY; } }
  }
  __device__ __forceinline__ float sink(int) const { return -INFINITY; }
  __device__ __forceinline__ bf16* orow(int wid, int row) const { return O + (long)(8192 * b + 64 * qrow(wid) + 32 * (wid & 1) + row) * 1024 + 512 + 64 * h; }
};
struct UCtx {
  const bf16* QKV; bf16* O; const float* sinkp; int b, hx; int qcol, kcol, vcol, ocol;
  __device__ __forceinline__ void init() { if (hx < 8) { qcol = 64 * hx; kcol = 512 + 64 * (hx >> 2); vcol = 640 + 64 * (hx >> 2); ocol = 64 * hx; }
    else { const int h = hx - 8; qcol = 768 + 64 * h; kcol = 1280 + 64 * h; vcol = 1792 + 64 * h; ocol = 512 + 64 * h; } }
  __device__ __forceinline__ int nt() const { return 4; }
  __device__ __forceinline__ long krow(int t) const { return (long)(ROWS_LAT + 256 * b + 64 * t); }
  __device__ __forceinline__ const bf16* kptr(long row, int ch) const { return QKV + row * 2304 + kcol + ch * 8; }
  __device__ __forceinline__ const bf16* vptr(long row, int ch) const { return QKV + row * 2304 + vcol + ch * 8; }
  __device__ __forceinline__ const bf16* qptr(int wid, int r32, int d0, int hi) const { return QKV + (long)(ROWS_LAT + 256 * b + 32 * wid + r32) * 2304 + qcol + 16 * d0 + 8 * hi; }
  __device__ __forceinline__ bool skip(int, int) const { return false; }
  __device__ __forceinline__ void mask(f32x16&, f32x16&, int, int, int, int) const {}
  __device__ __forceinline__ float sink(int) const { return hx < 8 ? sinkp[hx] * LOG2E : -INFINITY; }
  __device__ __forceinline__ bf16* orow(int wid, int row) const { return O + (long)(ROWS_LAT + 256 * b + 32 * wid + row) * 1024 + ocol; }
};
struct UDense {
  const bf16* Q; const bf16* KV; const bf16* KR; bf16* O; int b, h, qb;
  __device__ __forceinline__ int nt() const { return 132; }
  __device__ __forceinline__ long krow(int t) const { return t < 4 ? (long)(ROWS_LAT + 256 * b + 64 * t) : (long)(8192 * b + 64 * (t - 4)); }
  __device__ __forceinline__ const bf16* kptr(long row, int ch) const { return ch < 8 ? KV + row * 2048 + 64 * h + ch * 8 : KR + row * 32 + (ch - 8) * 8; }
  __device__ __forceinline__ const bf16* vptr(long row, int ch) const { return KV + row * 2048 + 1024 + 64 * h + ch * 8; }
  __device__ __forceinline__ const bf16* qptr(int wid, int r32, int d0, int hi) const { const bf16* qp = Q + (long)(8192 * b + 256 * qb + 32 * wid + r32) * 1536;
    return d0 < 4 ? qp + 64 * h + 16 * d0 + 8 * hi : qp + 1024 + 32 * h + 16 * (d0 - 4) + 8 * hi; }
  __device__ __forceinline__ bool skip(int, int) const { return false; }
  __device__ __forceinline__ void mask(f32x16&, f32x16&, int, int, int, int) const {}
  __device__ __forceinline__ float sink(int) const { return -INFINITY; }
  __device__ __forceinline__ bf16* orow(int wid, int row) const { return O + (long)(8192 * b + 256 * qb + 32 * wid + row) * 1024 + 64 * h; }
};
#undef ATT_SBAR
}
namespace attd {
typedef unsigned short bf16;
using bf16x8 = __attribute__((ext_vector_type(8))) short;
using s16x4 = __attribute__((ext_vector_type(4))) short;
using f32x16 = __attribute__((ext_vector_type(16))) float;
using u32x4 = __attribute__((ext_vector_type(4))) unsigned;
using i32x2 = __attribute__((ext_vector_type(2))) int;
using i32x4 = __attribute__((ext_vector_type(4))) int;
using i32x8 = __attribute__((ext_vector_type(8))) int;
using u32x6 = __attribute__((ext_vector_type(6))) unsigned;
using u32x16 = __attribute__((ext_vector_type(16))) unsigned;
typedef __bf16 bf16x32 __attribute__((ext_vector_type(32)));
constexpr int NW = 8, NT = 132, KSLOT = 5120, VSLOT = 8192;
constexpr int LDS_K = 0, LDS_V = 3 * KSLOT, LDS_WS = LDS_V + 3 * VSLOT, LDS_OST = LDS_WS + NW * 64 * 4, LDS_BYTES = LDS_OST + NW * 4096;
__device__ __forceinline__ int crow(int r, int hi) { return (r & 3) + 8 * (r >> 2) + 4 * hi; }
#define AF_SBAR() __builtin_amdgcn_sched_barrier(0)
__device__ __forceinline__ void glds16(unsigned voff, const void* sbase, unsigned lds_dst) { unsigned keep;
  asm volatile("s_mov_b32 %0, m0\n\ts_mov_b32 m0, %3\n\ts_nop 0\n\tglobal_load_lds_dwordx4 %1, %2\n\ts_mov_b32 m0, %0" : "=&s"(keep) : "v"(voff), "s"(sbase), "s"(lds_dst) : "memory"); }
typedef float f32x2_t __attribute__((ext_vector_type(2))); typedef __bf16 bf16x2_t __attribute__((ext_vector_type(2)));
__device__ __forceinline__ unsigned cvtpk_s(float lo, float hi) { f32x2_t v = {lo, hi}; bf16x2_t b = __builtin_convertvector(v, bf16x2_t); return __builtin_bit_cast(unsigned, b); }
#define AF_WAIT_BAR(N) asm volatile("s_waitcnt vmcnt(" #N ") lgkmcnt(0)\n\ts_barrier" ::: "memory")
typedef __attribute__((address_space(3))) const char* lds_cptr;
typedef short v4i16_t __attribute__((ext_vector_type(4)));
__device__ __forceinline__ i32x8 ld6(lds_cptr p16, lds_cptr p8) { const i32x4 a = *(const __attribute__((address_space(3))) i32x4*)p16; const i32x2 b = *(const __attribute__((address_space(3))) i32x2*)p8;
  return (i32x8){a.x, a.y, a.z, a.w, b.x, b.y, 0, 0}; }
__device__ __forceinline__ s16x4 vtr(lds_cptr p) { return __builtin_bit_cast(s16x4, __builtin_amdgcn_ds_read_tr16_b64_v4i16((__attribute__((address_space(3))) v4i16_t*)p)); }
__device__ __forceinline__ long tile_row(int b, int t) { return t < 4 ? (long)(16384 + 256 * b + 64 * t) : (long)(8192 * b + 64 * (t - 4)); }
__device__ __forceinline__ u32x6 to_fp6(u32x4 a0, u32x4 a1, u32x4 a2, u32x4 a3) { const u32x16 all = {a0.x, a0.y, a0.z, a0.w, a1.x, a1.y, a1.z, a1.w, a2.x, a2.y, a2.z, a2.w, a3.x, a3.y, a3.z, a3.w};
  return __builtin_amdgcn_cvt_scalef32_pk32_fp6_bf16(__builtin_bit_cast(bf16x32, all), 1.0f); }

__device__ __forceinline__ void dense_unit(int b, int h, int qb, const bf16* Q, const bf16* __restrict__ KV, const char* __restrict__ K6N, const char* __restrict__ K6R, bf16* O, char* shm, const int tid) {
  const int lane = tid & 63, r32 = lane & 31, hi = lane >> 5; const int wid = __builtin_amdgcn_readfirstlane(tid >> 6);
  const unsigned lds0 = (unsigned)(uintptr_t)shm;
  float* wsf = (float*)(shm + LDS_WS) + wid * 64;
  const bool wnp = wid < 3 || wid >= 5; const int pc = wnp ? (wid < 3 ? wid : wid - 5) : wid - 3;
  const unsigned voffK = (unsigned)(lane * 16);
  const char* sK = wnp ? K6N + h * 3072 + pc * 1024 : K6R + pc * 1024; const long kts = wnp ? 16 * 3072 : 2048;
  const unsigned voffV = (unsigned)((16 * (wid & 3) + (lane >> 2)) * 2048 + (wid >> 2) * 32 + (lane & 3) * 8) * 2u;
  const char* sV = (const char*)(KV + 1024 + 64 * h);
  const unsigned kdst = lds0 + LDS_K + (wnp ? pc * 1024 : 3072 + pc * 1024), vdst = lds0 + LDS_V + wid * 1024;
#define AF_DMA_K(t, ks) do { const long G_ = tile_row(b, (t)) >> 6; glds16(voffK, sK + G_ * kts, (unsigned)__builtin_amdgcn_readfirstlane(kdst + (ks))); } while (0)
#define AF_DMA_V(t, vs) do { const long R_ = tile_row(b, (t)); glds16(voffV, sV + R_ * 4096, (unsigned)__builtin_amdgcn_readfirstlane(vdst + (vs))); } while (0)
  const lds_cptr shm3 = (lds_cptr)shm;
  const lds_cptr kp16 = shm3 + LDS_K + hi * 1024 + r32 * 16;
  const lds_cptr kp8 = shm3 + LDS_K + 2048 + hi * 512 + r32 * 8;
  const lds_cptr vp0 = shm3 + LDS_V + ((lane >> 4) & 1) * 32 + (lane & 3) * 8 + (4 * hi + ((lane & 15) >> 2)) * 64;
  AF_DMA_K(0, 0); AF_DMA_V(0, 0); AF_DMA_K(1, KSLOT); AF_DMA_K(2, 2 * KSLOT);
  i32x8 qn, qr;
  { const bf16* qp = Q + (long)(8192 * b + 256 * qb + 32 * wid + r32) * 1536; const bf16* qa = qp + 64 * h + 32 * hi; const bf16* qc = qp + 1024 + 32 * h;
    const u32x6 n6 = to_fp6(*reinterpret_cast<const u32x4*>(qa), *reinterpret_cast<const u32x4*>(qa + 8), *reinterpret_cast<const u32x4*>(qa + 16), *reinterpret_cast<const u32x4*>(qa + 24));
    u32x6 r6 = to_fp6(*reinterpret_cast<const u32x4*>(qc), *reinterpret_cast<const u32x4*>(qc + 8), *reinterpret_cast<const u32x4*>(qc + 16), *reinterpret_cast<const u32x4*>(qc + 24));
    if (hi) r6 = (u32x6){0u, 0u, 0u, 0u, 0u, 0u};
    qn = (i32x8){(int)n6[0], (int)n6[1], (int)n6[2], (int)n6[3], (int)n6[4], (int)n6[5], 0, 0}; qr = (i32x8){(int)r6[0], (int)r6[1], (int)r6[2], (int)r6[3], (int)r6[4], (int)r6[5], 0, 0}; }
  float l_reg = 0.f; f32x16 o[2]; o[0] = f32x16{}; o[1] = f32x16{};
  f32x16 pA0, pA1, pB0, pB1; i32x8 kn0, kn1, kr0, kr1;
  int s_prev = 0, s_cur = 0, s_next = 1;
#define AF_ROT() do { s_prev = s_cur; s_cur = s_next; s_next = (s_next == 2) ? 0 : s_next + 1; } while (0)
#define AF_MF(a, b, c) __builtin_amdgcn_mfma_f32_32x32x16_bf16(a, b, c, 0, 0, 0)
#define AF_MX(a, b, c) __builtin_amdgcn_mfma_scale_f32_32x32x64_f8f6f4(a, b, c, 2, 2, 0, 0x7b7b7b7b, 0, 0x7f7f7f7f)
#define AF_EX(v) __builtin_amdgcn_exp2f(v)
  const f32x16 zero16 = f32x16{};
  AF_WAIT_BAR(0);
  { pA0 = AF_MX(ld6(kp16, kp8), qn, zero16); pA1 = AF_MX(ld6(kp16 + 512, kp8 + 256), qn, zero16);
    pA0 = AF_MX(ld6(kp16 + 3072, kp8 + 2048), qr, pA0); pA1 = AF_MX(ld6(kp16 + 3072 + 512, kp8 + 2048 + 256), qr, pA1);
#pragma unroll
    for (int r = 0; r < 16; ++r) { pA0[r] = AF_EX(pA0[r]); pA1[r] = AF_EX(pA1[r]); } }
  AF_WAIT_BAR(0);
  AF_DMA_K(3, 0); AF_DMA_V(1, VSLOT);
  AF_ROT();
  { const lds_cptr k16_ = kp16 + s_cur * KSLOT, k8_ = kp8 + s_cur * KSLOT; kn0 = ld6(k16_, k8_); kn1 = ld6(k16_ + 512, k8_ + 256); kr0 = ld6(k16_ + 3072, k8_ + 2048); kr1 = ld6(k16_ + 3072 + 512, k8_ + 2048 + 256); }
  AF_WAIT_BAR(2);
  s16x4 vlo[8], vhi[8]; u32x4 pw0, pw1, pw2, pw3;
#define AF_PKW(P, B) cvtpk_s(P[B], P[B + 1])
#define AF_PAF(k) __builtin_bit_cast(bf16x8, pw##k)
#define AF_VFR(i) (bf16x8){vlo[i][0], vlo[i][1], vlo[i][2], vlo[i][3], vhi[i][0], vhi[i][1], vhi[i][2], vhi[i][3]}
#define AF_PIN(x) asm volatile("" : "+v"(x))
#define AF_VRD(i) do { vlo[i] = vtr(vp_ + (((i) >> 2) * 4096 + ((i) & 3) * 1024)); vhi[i] = vtr(vp_ + (((i) >> 2) * 4096 + ((i) & 3) * 1024 + 512)); AF_SBAR(); } while (0)
#define AF_GB(MF, X, B) do { MF; X[B] = AF_EX(X[B]); X[B + 1] = AF_EX(X[B + 1]); X[B + 2] = AF_EX(X[B + 2]); X[B + 3] = AF_EX(X[B + 3]); AF_PIN(X); AF_SBAR(); } while (0)
#define AF_KRD(G, j) do { if (G) { const lds_cptr k16_ = kp16 + s_next * KSLOT, k8_ = kp8 + s_next * KSLOT; \
      if ((j) == 0) kn0 = ld6(k16_, k8_); if ((j) == 1) kn1 = ld6(k16_ + 512, k8_ + 256); \
      if ((j) == 2) kr0 = ld6(k16_ + 3072, k8_ + 2048); if ((j) == 3) kr1 = ld6(k16_ + 3072 + 512, k8_ + 2048 + 256); AF_SBAR(); } } while (0)
#define AF_A4(P, B) do { sacc += P[B]; sacc += P[B + 1]; sacc += P[B + 2]; sacc += P[B + 3]; } while (0)
#define AF_STEP(C0, C1, P0, P1, t, GK, GV, GL) do { AF_SBAR(); \
    const lds_cptr vp_ = vp0 + s_prev * VSLOT; \
    float sacc = (P0[0] + P0[1]); \
    AF_VRD(0); AF_VRD(4); \
    { C0 = AF_MX(kn0, qn, zero16); sacc += P0[2]; sacc += P0[3]; AF_A4(P0, 4); AF_PIN(sacc); \
      pw0[0] = AF_PKW(P0, 0); pw0[1] = AF_PKW(P0, 2); pw0[2] = AF_PKW(P0, 4); pw0[3] = AF_PKW(P0, 6); AF_PIN(pw0); AF_SBAR(); } \
    AF_VRD(1); AF_VRD(5); \
    { C1 = AF_MX(kn1, qn, zero16); AF_A4(P0, 8); AF_A4(P0, 12); AF_PIN(sacc); \
      pw1[0] = AF_PKW(P0, 8); pw1[1] = AF_PKW(P0, 10); pw1[2] = AF_PKW(P0, 12); pw1[3] = AF_PKW(P0, 14); AF_PIN(pw1); AF_SBAR(); } \
    AF_VRD(2); AF_VRD(6); \
    { C0 = AF_MX(kr0, qr, C0); AF_A4(P1, 0); AF_A4(P1, 4); AF_PIN(sacc); \
      pw2[0] = AF_PKW(P1, 0); pw2[1] = AF_PKW(P1, 2); pw2[2] = AF_PKW(P1, 4); pw2[3] = AF_PKW(P1, 6); AF_PIN(pw2); AF_SBAR(); } \
    if (GK) { AF_DMA_K((t) + 3, s_cur * KSLOT); AF_SBAR(); } \
    AF_VRD(3); AF_VRD(7); \
    { C1 = AF_MX(kr1, qr, C1); AF_A4(P1, 8); AF_A4(P1, 12); AF_PIN(sacc); \
      pw3[0] = AF_PKW(P1, 8); pw3[1] = AF_PKW(P1, 10); pw3[2] = AF_PKW(P1, 12); pw3[3] = AF_PKW(P1, 14); AF_PIN(pw3); AF_SBAR(); } \
    if (GV) { AF_DMA_V((t) + 1, s_next * VSLOT); AF_SBAR(); } \
    l_reg += sacc; \
    AF_SBAR(); \
    AF_GB(o[0] = AF_MF(AF_PAF(0), AF_VFR(0), o[0]), C0, 0);  AF_KRD(GL, 0); \
    AF_GB(o[1] = AF_MF(AF_PAF(0), AF_VFR(4), o[1]), C0, 4);  AF_KRD(GL, 1); \
    AF_GB(o[0] = AF_MF(AF_PAF(1), AF_VFR(1), o[0]), C0, 8);  AF_KRD(GL, 2); \
    AF_GB(o[1] = AF_MF(AF_PAF(1), AF_VFR(5), o[1]), C0, 12); AF_KRD(GL, 3); \
    AF_GB(o[0] = AF_MF(AF_PAF(2), AF_VFR(2), o[0]), C1, 0); \
    AF_GB(o[1] = AF_MF(AF_PAF(2), AF_VFR(6), o[1]), C1, 4); \
    AF_GB(o[0] = AF_MF(AF_PAF(3), AF_VFR(3), o[0]), C1, 8); \
    AF_GB(o[1] = AF_MF(AF_PAF(3), AF_VFR(7), o[1]), C1, 12); \
  } while (0)
  int t = 1;
  for (; t + 3 < NT; t += 2) {
    AF_STEP(pB0, pB1, pA0, pA1, t, true, true, true);     AF_WAIT_BAR(2); AF_ROT();
    AF_STEP(pA0, pA1, pB0, pB1, t + 1, true, true, true); AF_WAIT_BAR(2); AF_ROT();
  }
  AF_STEP(pB0, pB1, pA0, pA1, NT - 3, false, true, true);  AF_WAIT_BAR(1); AF_ROT();
  AF_STEP(pA0, pA1, pB0, pB1, NT - 2, false, true, true);  AF_WAIT_BAR(0); AF_ROT();
  AF_STEP(pB0, pB1, pA0, pA1, NT - 1, false, false, false);
  { float sacc = pB0[0] + pB0[1];
#pragma unroll
    for (int r = 2; r < 16; ++r) sacc += pB0[r];
#pragma unroll
    for (int r = 0; r < 16; ++r) sacc += pB1[r];
    l_reg += sacc;
    pw0 = (u32x4){AF_PKW(pB0, 0), AF_PKW(pB0, 2), AF_PKW(pB0, 4), AF_PKW(pB0, 6)}; pw1 = (u32x4){AF_PKW(pB0, 8), AF_PKW(pB0, 10), AF_PKW(pB0, 12), AF_PKW(pB0, 14)};
    pw2 = (u32x4){AF_PKW(pB1, 0), AF_PKW(pB1, 2), AF_PKW(pB1, 4), AF_PKW(pB1, 6)}; pw3 = (u32x4){AF_PKW(pB1, 8), AF_PKW(pB1, 10), AF_PKW(pB1, 12), AF_PKW(pB1, 14)};
    AF_SBAR();
    const lds_cptr vp_ = vp0 + s_cur * VSLOT;
#pragma unroll
    for (int i = 0; i < 8; ++i) { vlo[i] = vtr(vp_ + ((i >> 2) * 4096 + (i & 3) * 1024)); vhi[i] = vtr(vp_ + ((i >> 2) * 4096 + (i & 3) * 1024 + 512)); }
    o[0] = AF_MF(AF_PAF(0), AF_VFR(0), o[0]); o[1] = AF_MF(AF_PAF(0), AF_VFR(4), o[1]);
    o[0] = AF_MF(AF_PAF(1), AF_VFR(1), o[0]); o[1] = AF_MF(AF_PAF(1), AF_VFR(5), o[1]);
    o[0] = AF_MF(AF_PAF(2), AF_VFR(2), o[0]); o[1] = AF_MF(AF_PAF(2), AF_VFR(6), o[1]);
    o[0] = AF_MF(AF_PAF(3), AF_VFR(3), o[0]); o[1] = AF_MF(AF_PAF(3), AF_VFR(7), o[1]); }
  { auto rr = __builtin_amdgcn_permlane32_swap(__float_as_uint(l_reg), __float_as_uint(l_reg), false, false); l_reg = __uint_as_float(rr[0]) + __uint_as_float(rr[1]); }
  if (hi == 0) wsf[32 + r32] = l_reg; asm volatile("s_waitcnt lgkmcnt(0)" ::: "memory");
  float rli[16];
#pragma unroll
  for (int r = 0; r < 16; ++r) rli[r] = __builtin_amdgcn_rcpf(wsf[32 + crow(r, hi)]);
  bf16* Ow = O + (long)(8192 * b + 256 * qb + 32 * wid) * 1024 + 64 * h;
  { bf16* stg = (bf16*)(shm + LDS_OST) + wid * 2048;
#pragma unroll
    for (int r = 0; r < 16; ++r) { const int orow = crow(r, hi);
#pragma unroll
      for (int d0 = 0; d0 < 2; ++d0) stg[orow * 64 + d0 * 32 + r32] = (bf16)(cvtpk_s(o[d0][r] * rli[r], 0.f) & 0xffffu); }
    asm volatile("s_waitcnt lgkmcnt(0)" ::: "memory");
#pragma unroll
    for (int i = 0; i < 4; ++i) { const int row = i * 8 + (lane >> 3), ch = lane & 7; const u32x4 v = *(const u32x4*)(stg + row * 64 + ch * 8); *(u32x4*)(Ow + (long)row * 1024 + ch * 8) = v; } }
  asm volatile("s_waitcnt vmcnt(0) lgkmcnt(0)\n\ts_barrier" ::: "memory");
#undef AF_DMA_K
#undef AF_DMA_V
#undef AF_ROT
#undef AF_PKW
#undef AF_PAF
#undef AF_VFR
#undef AF_PIN
#undef AF_MF
#undef AF_MX
#undef AF_EX
#undef AF_VRD
#undef AF_GB
#undef AF_KRD
#undef AF_A4
#undef AF_STEP
}
#undef AF_SBAR
#undef AF_WAIT_BAR
}
namespace attf {
typedef unsigned short bf16;
using bf16x8 = __attribute__((ext_vector_type(8))) short;
using s16x4 = __attribute__((ext_vector_type(4))) short;
using f32x16 = __attribute__((ext_vector_type(16))) float;
using u32x4 = __attribute__((ext_vector_type(4))) unsigned;
using i32x2 = __attribute__((ext_vector_type(2))) int;
using i32x4 = __attribute__((ext_vector_type(4))) int;
using i32x8 = __attribute__((ext_vector_type(8))) int;
using u32x6 = __attribute__((ext_vector_type(6))) unsigned;
using u32x16 = __attribute__((ext_vector_type(16))) unsigned;
typedef __bf16 bf16x32 __attribute__((ext_vector_type(32)));
constexpr int NW = 8, KSLOT = 12288, VSLOT = 8192;
constexpr int LDS_K = 0, LDS_V = 3 * KSLOT, LDS_WS = LDS_V + 3 * VSLOT, LDS_OST = LDS_WS + NW * 64 * 4, LDS_RPB = LDS_OST + NW * 4096, LDS_BYTES = LDS_RPB + 2048;
__device__ __forceinline__ int crow(int r, int hi) { return (r & 3) + 8 * (r >> 2) + 4 * hi; }
#define AF_SBAR() __builtin_amdgcn_sched_barrier(0)
__device__ __forceinline__ void glds16(unsigned voff, const void* sbase, unsigned lds_dst) { unsigned keep;
  asm volatile("s_mov_b32 %0, m0\n\ts_mov_b32 m0, %3\n\ts_nop 0\n\tglobal_load_lds_dwordx4 %1, %2\n\ts_mov_b32 m0, %0" : "=&s"(keep) : "v"(voff), "s"(sbase), "s"(lds_dst) : "memory"); }
typedef float f32x2_t __attribute__((ext_vector_type(2))); typedef __bf16 bf16x2_t __attribute__((ext_vector_type(2)));
__device__ __forceinline__ unsigned cvtpk_s(float lo, float hi) { f32x2_t v = {lo, hi}; bf16x2_t b = __builtin_convertvector(v, bf16x2_t); return __builtin_bit_cast(unsigned, b); }
#define AF_WAIT_BAR(N) asm volatile("s_waitcnt vmcnt(" #N ") lgkmcnt(0)\n\ts_barrier" ::: "memory")
typedef __attribute__((address_space(3))) const char* lds_cptr;
typedef short v4i16_t __attribute__((ext_vector_type(4)));
__device__ __forceinline__ void kload2(bf16x8* kf, lds_cptr kp, int j) { kf[2 * j] = *(const __attribute__((address_space(3))) bf16x8*)(kp + j * 2048); kf[2 * j + 1] = *(const __attribute__((address_space(3))) bf16x8*)(kp + j * 2048 + 512); }
__device__ __forceinline__ i32x8 ld6(lds_cptr p16, lds_cptr p8) { const i32x4 a = *(const __attribute__((address_space(3))) i32x4*)p16; const i32x2 b = *(const __attribute__((address_space(3))) i32x2*)p8;
  const i32x4 b4 = __builtin_shufflevector(b, b, 0, 1, -1, -1); return __builtin_shufflevector(a, b4, 0, 1, 2, 3, 4, 5, -1, -1); }
__device__ __forceinline__ i32x8 to_fp6(u32x4 a0, u32x4 a1, u32x4 a2, u32x4 a3) { const u32x16 all = {a0.x, a0.y, a0.z, a0.w, a1.x, a1.y, a1.z, a1.w, a2.x, a2.y, a2.z, a2.w, a3.x, a3.y, a3.z, a3.w};
  const u32x6 c = __builtin_amdgcn_cvt_scalef32_pk32_fp6_bf16(__builtin_bit_cast(bf16x32, all), 1.0f); return __builtin_bit_cast(i32x8, __builtin_shufflevector(c, c, 0, 1, 2, 3, 4, 5, -1, -1)); }
__device__ __forceinline__ s16x4 vtr(lds_cptr p) { return __builtin_bit_cast(s16x4, __builtin_amdgcn_ds_read_tr16_b64_v4i16((__attribute__((address_space(3))) v4i16_t*)p)); }

template <int DKC, class U, bool F6 = false>
__device__ __forceinline__ void fast_unit(const U& u, char* shm, int tid) {
  static_assert(DKC == 8 || DKC == 12, "q/k dim 64 or 96"); static_assert(!F6 || DKC == 8, "fp6 logits: q/k dim 64");
  asm volatile("" : "+v"(tid));
  constexpr int ND0 = DKC / 2;
  const int lane = tid & 63, r32 = lane & 31, hi = lane >> 5; const int wid = __builtin_amdgcn_readfirstlane(tid >> 6);
  const unsigned lds0 = (unsigned)(uintptr_t)shm;
  float* wsf = (float*)(shm + LDS_WS) + wid * 64;
  const int NT = u.nt();
  const unsigned voffKA = (unsigned)(lane * u.kpitch + 8 * wid) * 2u;
  const unsigned voffKB = (unsigned)(lane * 32 + 8 * (wid & 3)) * 2u;
  const unsigned voffV = (unsigned)((16 * (wid & 3) + (lane >> 2)) * u.vpitch + (wid >> 2) * 32 + (lane & 3) * 8) * 2u;
  const unsigned kdstA = lds0 + LDS_K + wid * 1024, kdstB = lds0 + LDS_K + (8 + (wid & 3)) * 1024, vdst = lds0 + LDS_V + wid * 1024;
  const int pc6 = wid % 3; const unsigned voffK6 = (unsigned)(lane * 16), kdst6 = lds0 + LDS_K + pc6 * 1024;
#define AF_DMA_KA(t, ks) do { const long R_ = u.trow(t); if constexpr (F6) glds16(voffK6, u.k6base + (R_ >> 6) * 30720 + pc6 * 1024, (unsigned)__builtin_amdgcn_readfirstlane(kdst6 + (ks))); \
    else glds16(voffKA, (const char*)u.kbase + R_ * (2 * u.kpitch), (unsigned)__builtin_amdgcn_readfirstlane(kdstA + (ks))); } while (0)
#define AF_DMA_KB(t, ks) do { if constexpr (DKC == 12) { const long R_ = u.trow(t); glds16(voffKB, (const char*)u.krbase + R_ * 64, (unsigned)__builtin_amdgcn_readfirstlane(kdstB + (ks))); } } while (0)
#define AF_DMA_K(t, ks) do { AF_DMA_KA(t, ks); AF_DMA_KB(t, ks); } while (0)
#define AF_DMA_V(t, vs) do { const long R_ = u.trow(t); glds16(voffV, (const char*)u.vbase + R_ * (2 * u.vpitch), (unsigned)__builtin_amdgcn_readfirstlane(vdst + (vs))); } while (0)
#define AF_WAITN(NSTEPS_K, NV) do { if constexpr (DKC == 12) { if ((NSTEPS_K) == 2 && (NV) == 1) AF_WAIT_BAR(5); else if ((NSTEPS_K) == 1 && (NV) == 1) AF_WAIT_BAR(3); else if ((NV) == 1) AF_WAIT_BAR(1); else AF_WAIT_BAR(0); } \
    else { if ((NSTEPS_K) == 2 && (NV) == 1) AF_WAIT_BAR(3); else if ((NSTEPS_K) == 1 && (NV) == 1) AF_WAIT_BAR(2); else if ((NV) == 1) AF_WAIT_BAR(1); else AF_WAIT_BAR(0); } } while (0)
  const lds_cptr shm3 = (lds_cptr)shm; const lds_cptr kp0 = shm3 + LDS_K + hi * 1024 + r32 * 16;
  const lds_cptr kp8 = shm3 + LDS_K + 2048 + hi * 512 + r32 * 8;
  const lds_cptr vp0 = shm3 + LDS_V + ((lane >> 4) & 1) * 32 + (lane & 3) * 8 + (4 * hi + ((lane & 15) >> 2)) * 64;
  bf16x8 qr[ND0]; i32x8 qn;
  if constexpr (F6) { const bf16* qa = u.qptr(wid, r32, 0, 0) + 32 * hi;
    qn = to_fp6(*reinterpret_cast<const u32x4*>(qa), *reinterpret_cast<const u32x4*>(qa + 8), *reinterpret_cast<const u32x4*>(qa + 16), *reinterpret_cast<const u32x4*>(qa + 24)); }
  else {
#pragma unroll
    for (int d0 = 0; d0 < ND0; ++d0) qr[d0] = *reinterpret_cast<const bf16x8*>(u.qptr(wid, r32, d0, hi)); }
  AF_DMA_K(0, 0); AF_DMA_V(0, 0); AF_DMA_K(1, KSLOT); AF_DMA_K(2, 2 * KSLOT);
  float l_reg = 0.f; f32x16 o[2]; o[0] = f32x16{}; o[1] = f32x16{};
  f32x16 pA0, pA1, pB0, pB1; bf16x8 kf[DKC]; i32x8 kn0, kn1;
#define AF_MX6(a, b, c) __builtin_amdgcn_mfma_scale_f32_32x32x64_f8f6f4(a, b, c, 2, 2, 0, 0x7b7b7b7b, 0, 0x7f7f7f7f)
  int s_prev = 0, s_cur = 0, s_next = 1;
#define AF_ROT() do { s_prev = s_cur; s_cur = s_next; s_next = (s_next == 2) ? 0 : s_next + 1; } while (0)
  AF_WAITN(2, 1);
  { const char* kb = shm + LDS_K + hi * 1024 + r32 * 16; pA0 = f32x16{}; pA1 = f32x16{};
    if constexpr (F6) { pA0 = AF_MX6(ld6(kp0, kp8), qn, pA0); pA1 = AF_MX6(ld6(kp0 + 512, kp8 + 256), qn, pA1); }
    else
#pragma unroll
    for (int d0 = 0; d0 < ND0; ++d0) { const bf16x8 b0 = *reinterpret_cast<const bf16x8*>(kb + d0 * 2048), b1 = *reinterpret_cast<const bf16x8*>(kb + d0 * 2048 + 512);
      pA0 = __builtin_amdgcn_mfma_f32_32x32x16_bf16(b0, qr[d0], pA0, 0, 0, 0); pA1 = __builtin_amdgcn_mfma_f32_32x32x16_bf16(b1, qr[d0], pA1, 0, 0, 0); }
    if constexpr (U::HAS_MASK) u.mask(pA0, pA1, 0, wid, r32, hi);
#pragma unroll
    for (int r = 0; r < 16; ++r) { pA0[r] = __builtin_amdgcn_exp2f(pA0[r]); pA1[r] = __builtin_amdgcn_exp2f(pA1[r]); } }
  AF_WAIT_BAR(0);
  AF_DMA_K(3, 0); AF_DMA_V(1, VSLOT);
  AF_ROT();
  if constexpr (F6) { kn0 = ld6(kp0 + s_cur * KSLOT, kp8 + s_cur * KSLOT); kn1 = ld6(kp0 + s_cur * KSLOT + 512, kp8 + s_cur * KSLOT + 256); }
  else {
#pragma unroll
    for (int j = 0; j < ND0; ++j) kload2(kf, kp0 + s_cur * KSLOT, j); }
  AF_WAITN(1, 1);
  s16x4 vlo[8], vhi[8]; u32x4 pw0, pw1, pw2, pw3;
#define AF_PKW(P, B) cvtpk_s(P[B], P[B + 1])
#define AF_PAF(k) __builtin_bit_cast(bf16x8, pw##k)
#define AF_VFR(i) (bf16x8){vlo[i][0], vlo[i][1], vlo[i][2], vlo[i][3], vhi[i][0], vhi[i][1], vhi[i][2], vhi[i][3]}
#define AF_PIN(x) asm volatile("" : "+v"(x))
#define AF_MF(a, b, c) __builtin_amdgcn_mfma_f32_32x32x16_bf16(a, b, c, 0, 0, 0)
#define AF_EX(v) __builtin_amdgcn_exp2f(v)
#define AF_VRD(i) do { vlo[i] = vtr(vp_ + (((i) >> 2) * 4096 + ((i) & 3) * 1024)); vhi[i] = vtr(vp_ + (((i) >> 2) * 4096 + ((i) & 3) * 1024 + 512)); AF_SBAR(); } while (0)
#define AF_GA4(MF, A0, A1, A2, A3, W0, W1, PW) do { MF; sacc += A0; sacc += A1; sacc += A2; sacc += A3; AF_PIN(sacc); W0; W1; AF_PIN(PW); AF_SBAR(); } while (0)
#define AF_GA3(MF, A0, A1, A2, W0, W1, PW) do { MF; sacc += A0; sacc += A1; sacc += A2; AF_PIN(sacc); W0; W1; AF_PIN(PW); AF_SBAR(); } while (0)
#define AF_GA2(MF, A0, A1, W0, PW) do { MF; sacc += A0; sacc += A1; AF_PIN(sacc); W0; AF_PIN(PW); AF_SBAR(); } while (0)
#define AF_GB(MF, X, B) do { MF; X[B] = AF_EX(X[B]); X[B + 1] = AF_EX(X[B + 1]); X[B + 2] = AF_EX(X[B + 2]); X[B + 3] = AF_EX(X[B + 3]); AF_PIN(X); AF_SBAR(); } while (0)
#define AF_KRD(G, j) do { if constexpr (F6) { if ((j) < 2) { if (G) { if ((j) == 0) kn0 = ld6(kp0 + s_next * KSLOT, kp8 + s_next * KSLOT); else kn1 = ld6(kp0 + s_next * KSLOT + 512, kp8 + s_next * KSLOT + 256); AF_SBAR(); } } } \
    else if ((j) < ND0) { if (G) { kload2(kf, kp0 + s_next * KSLOT, (j) < ND0 ? (j) : 0); AF_SBAR(); } } } while (0)
  const f32x16 zero16 = f32x16{};
#define AF_PHASE_A12(C0, C1, P0, P1, t, GK, GV) do { \
    AF_VRD(0); float sacc = (P0[0] + P0[1]); \
    AF_GA3(C0 = AF_MF(kf[0], qr[0], zero16), P0[2], P0[3], P0[4],     pw0[0] = AF_PKW(P0, 0), pw0[1] = AF_PKW(P0, 2), pw0); \
    AF_VRD(4); AF_GA3(C1 = AF_MF(kf[1], qr[0], zero16), P0[5], P0[6], P0[7],     pw0[2] = AF_PKW(P0, 4), pw0[3] = AF_PKW(P0, 6), pw0); \
    AF_VRD(1); AF_GA3(C0 = AF_MF(kf[2], qr[1], C0),     P0[8], P0[9], P0[10],    pw1[0] = AF_PKW(P0, 8), pw1[1] = AF_PKW(P0, 10), pw1); \
    AF_VRD(5); AF_GA3(C1 = AF_MF(kf[3], qr[1], C1),     P0[11], P0[12], P0[13],  pw1[2] = AF_PKW(P0, 12), pw1[3] = AF_PKW(P0, 14), pw1); \
    AF_VRD(2); AF_GA3(C0 = AF_MF(kf[4], qr[2], C0),     P0[14], P0[15], P1[0],   pw2[0] = AF_PKW(P1, 0), pw2[1] = AF_PKW(P1, 2), pw2); \
    AF_VRD(6); AF_GA3(C1 = AF_MF(kf[5], qr[2], C1),     P1[1], P1[2], P1[3],     pw2[2] = AF_PKW(P1, 4), pw2[3] = AF_PKW(P1, 6), pw2); \
    AF_VRD(3); AF_GA2(C0 = AF_MF(kf[6], qr[3], C0),     P1[4], P1[5],            pw3[0] = AF_PKW(P1, 8), pw3); \
    AF_VRD(7); AF_GA2(C1 = AF_MF(kf[7], qr[3], C1),     P1[6], P1[7],            pw3[1] = AF_PKW(P1, 10), pw3); \
    AF_GA2(C0 = AF_MF(kf[8 % DKC], qr[4 % ND0], C0),    P1[8], P1[9],            pw3[2] = AF_PKW(P1, 12), pw3); \
    if (GK) { AF_DMA_KA((t) + 3, s_cur * KSLOT); AF_SBAR(); } \
    AF_GA2(C1 = AF_MF(kf[9 % DKC], qr[4 % ND0], C1),    P1[10], P1[11],          pw3[3] = AF_PKW(P1, 14), pw3); \
    if (GK) { AF_DMA_KB((t) + 3, s_cur * KSLOT); AF_SBAR(); } \
    { C0 = AF_MF(kf[10 % DKC], qr[5 % ND0], C0); sacc += P1[12]; sacc += P1[13]; AF_PIN(sacc); AF_SBAR(); } \
    if (GV) { AF_DMA_V((t) + 1, s_next * VSLOT); AF_SBAR(); } \
    { C1 = AF_MF(kf[11 % DKC], qr[5 % ND0], C1); sacc += P1[14]; sacc += P1[15]; AF_PIN(sacc); AF_SBAR(); } \
    l_reg += sacc; } while (0)
#define AF_PHASE_A8(C0, C1, P0, P1, t, GK, GV) do { \
    AF_VRD(0); float sacc = (P0[0] + P0[1]); \
    AF_GA4(C0 = AF_MF(kf[0], qr[0], zero16), P0[2], P0[3], P0[4], P0[5],       pw0[0] = AF_PKW(P0, 0), pw0[1] = AF_PKW(P0, 2), pw0); \
    AF_VRD(4); AF_GA4(C1 = AF_MF(kf[1], qr[0], zero16), P0[6], P0[7], P0[8], P0[9],       pw0[2] = AF_PKW(P0, 4), pw0[3] = AF_PKW(P0, 6), pw0); \
    AF_VRD(1); AF_GA4(C0 = AF_MF(kf[2], qr[1], C0),     P0[10], P0[11], P0[12], P0[13],   pw1[0] = AF_PKW(P0, 8), pw1[1] = AF_PKW(P0, 10), pw1); \
    AF_VRD(5); AF_GA4(C1 = AF_MF(kf[3], qr[1], C1),     P0[14], P0[15], P1[0], P1[1],     pw1[2] = AF_PKW(P0, 12), pw1[3] = AF_PKW(P0, 14), pw1); \
    AF_VRD(2); AF_GA4(C0 = AF_MF(kf[4], qr[2], C0),     P1[2], P1[3], P1[4], P1[5],       pw2[0] = AF_PKW(P1, 0), pw2[1] = AF_PKW(P1, 2), pw2); \
    AF_VRD(6); AF_GA4(C1 = AF_MF(kf[5], qr[2], C1),     P1[6], P1[7], P1[8], P1[9],       pw2[2] = AF_PKW(P1, 4), pw2[3] = AF_PKW(P1, 6), pw2); \
    AF_VRD(3); AF_GA4(C0 = AF_MF(kf[6], qr[3], C0),     P1[10], P1[11], P1[12], P1[13],   pw3[0] = AF_PKW(P1, 8), pw3[1] = AF_PKW(P1, 10), pw3); \
    AF_VRD(7); AF_GA4(C1 = AF_MF(kf[7], qr[3], C1),     P1[14], P1[15], 0.f, 0.f,         pw3[2] = AF_PKW(P1, 12), pw3[3] = AF_PKW(P1, 14), pw3); \
    l_reg += sacc; \
    if (GK) { AF_DMA_KA((t) + 3, s_cur * KSLOT); } if (GV) { AF_DMA_V((t) + 1, s_next * VSLOT); } } while (0)
#define AF_A4(P, B) do { sacc += P[B]; sacc += P[B + 1]; sacc += P[B + 2]; sacc += P[B + 3]; } while (0)
#define AF_PHASE_A6(C0, C1, P0, P1, t, GK, GV) do { \
    AF_VRD(0); AF_VRD(4); float sacc = (P0[0] + P0[1]); \
    { C0 = AF_MX6(kn0, qn, zero16); sacc += P0[2]; sacc += P0[3]; AF_A4(P0, 4); AF_A4(P0, 8); AF_A4(P0, 12); AF_PIN(sacc); \
      pw0[0] = AF_PKW(P0, 0); pw0[1] = AF_PKW(P0, 2); pw0[2] = AF_PKW(P0, 4); pw0[3] = AF_PKW(P0, 6); AF_PIN(pw0); pw1[0] = AF_PKW(P0, 8); pw1[1] = AF_PKW(P0, 10); pw1[2] = AF_PKW(P0, 12); pw1[3] = AF_PKW(P0, 14); AF_PIN(pw1); AF_SBAR(); } \
    AF_VRD(1); AF_VRD(5); AF_VRD(2); AF_VRD(6); \
    { C1 = AF_MX6(kn1, qn, zero16); AF_A4(P1, 0); AF_A4(P1, 4); AF_A4(P1, 8); AF_A4(P1, 12); AF_PIN(sacc); \
      pw2[0] = AF_PKW(P1, 0); pw2[1] = AF_PKW(P1, 2); pw2[2] = AF_PKW(P1, 4); pw2[3] = AF_PKW(P1, 6); AF_PIN(pw2); pw3[0] = AF_PKW(P1, 8); pw3[1] = AF_PKW(P1, 10); pw3[2] = AF_PKW(P1, 12); pw3[3] = AF_PKW(P1, 14); AF_PIN(pw3); AF_SBAR(); } \
    AF_VRD(3); AF_VRD(7); \
    l_reg += sacc; \
    if (GK) { AF_DMA_KA((t) + 3, s_cur * KSLOT); } if (GV) { AF_DMA_V((t) + 1, s_next * VSLOT); } } while (0)
#define AF_STEP(C0, C1, P0, P1, t, GK, GV, GL) do { AF_SBAR(); \
    const lds_cptr vp_ = vp0 + s_prev * VSLOT; \
    if constexpr (F6) AF_PHASE_A6(C0, C1, P0, P1, t, GK, GV); else if constexpr (DKC == 12) AF_PHASE_A12(C0, C1, P0, P1, t, GK, GV); else AF_PHASE_A8(C0, C1, P0, P1, t, GK, GV); \
    if constexpr (U::HAS_MASK) u.mask(C0, C1, (t), wid, r32, hi); \
    AF_SBAR(); \
    AF_GB(o[0] = AF_MF(AF_PAF(0), AF_VFR(0), o[0]), C0, 0);  AF_KRD(GL, 0); \
    AF_GB(o[1] = AF_MF(AF_PAF(0), AF_VFR(4), o[1]), C0, 4);  AF_KRD(GL, 1); \
    AF_GB(o[0] = AF_MF(AF_PAF(1), AF_VFR(1), o[0]), C0, 8);  AF_KRD(GL, 2); \
    AF_GB(o[1] = AF_MF(AF_PAF(1), AF_VFR(5), o[1]), C0, 12); AF_KRD(GL, 3); \
    AF_GB(o[0] = AF_MF(AF_PAF(2), AF_VFR(2), o[0]), C1, 0);  AF_KRD(GL, 4); \
    AF_GB(o[1] = AF_MF(AF_PAF(2), AF_VFR(6), o[1]), C1, 4);  AF_KRD(GL, 5); \
    AF_GB(o[0] = AF_MF(AF_PAF(3), AF_VFR(3), o[0]), C1, 8); \
    AF_GB(o[1] = AF_MF(AF_PAF(3), AF_VFR(7), o[1]), C1, 12); \
  } while (0)
  int t = 1;
  for (; t + 3 < NT; t += 2) {
    AF_STEP(pB0, pB1, pA0, pA1, t, true, true, true);     AF_WAITN(1, 1); AF_ROT();
    AF_STEP(pA0, pA1, pB0, pB1, t + 1, true, true, true); AF_WAITN(1, 1); AF_ROT();
  }
  AF_STEP(pB0, pB1, pA0, pA1, NT - 3, false, true, true);  AF_WAITN(0, 1); AF_ROT();
  AF_STEP(pA0, pA1, pB0, pB1, NT - 2, false, true, true);  AF_WAIT_BAR(0); AF_ROT();
  AF_STEP(pB0, pB1, pA0, pA1, NT - 1, false, false, false);
  { float sacc = pB0[0] + pB0[1];
#pragma unroll
    for (int r = 2; r < 16; ++r) sacc += pB0[r];
#pragma unroll
    for (int r = 0; r < 16; ++r) sacc += pB1[r];
    l_reg += sacc;
    pw0 = (u32x4){AF_PKW(pB0, 0), AF_PKW(pB0, 2), AF_PKW(pB0, 4), AF_PKW(pB0, 6)}; pw1 = (u32x4){AF_PKW(pB0, 8), AF_PKW(pB0, 10), AF_PKW(pB0, 12), AF_PKW(pB0, 14)};
    pw2 = (u32x4){AF_PKW(pB1, 0), AF_PKW(pB1, 2), AF_PKW(pB1, 4), AF_PKW(pB1, 6)}; pw3 = (u32x4){AF_PKW(pB1, 8), AF_PKW(pB1, 10), AF_PKW(pB1, 12), AF_PKW(pB1, 14)};
    AF_SBAR();
    const lds_cptr vp_ = vp0 + s_cur * VSLOT;
#pragma unroll
    for (int i = 0; i < 8; ++i) { vlo[i] = vtr(vp_ + ((i >> 2) * 4096 + (i & 3) * 1024)); vhi[i] = vtr(vp_ + ((i >> 2) * 4096 + (i & 3) * 1024 + 512)); }
    o[0] = AF_MF(AF_PAF(0), AF_VFR(0), o[0]); o[1] = AF_MF(AF_PAF(0), AF_VFR(4), o[1]);
    o[0] = AF_MF(AF_PAF(1), AF_VFR(1), o[0]); o[1] = AF_MF(AF_PAF(1), AF_VFR(5), o[1]);
    o[0] = AF_MF(AF_PAF(2), AF_VFR(2), o[0]); o[1] = AF_MF(AF_PAF(2), AF_VFR(6), o[1]);
    o[0] = AF_MF(AF_PAF(3), AF_VFR(3), o[0]); o[1] = AF_MF(AF_PAF(3), AF_VFR(7), o[1]); }
  { auto rr = __builtin_amdgcn_permlane32_swap(__float_as_uint(l_reg), __float_as_uint(l_reg), false, false); l_reg = __uint_as_float(rr[0]) + __uint_as_float(rr[1]); }
  l_reg += __builtin_amdgcn_exp2f(u.sink(wid));
  if (hi == 0) wsf[32 + r32] = l_reg; asm volatile("s_waitcnt lgkmcnt(0)" ::: "memory");
  float rli[16];
#pragma unroll
  for (int r = 0; r < 16; ++r) rli[r] = __builtin_amdgcn_rcpf(wsf[32 + crow(r, hi)]);
  bf16* Ow = u.orow0(wid);
  { bf16* stg = (bf16*)(shm + LDS_OST) + wid * 2048;
#pragma unroll
    for (int r = 0; r < 16; ++r) { const int orow = crow(r, hi);
#pragma unroll
      for (int d0 = 0; d0 < 2; ++d0) stg[orow * 64 + d0 * 32 + r32] = (bf16)(cvtpk_s(o[d0][r] * rli[r], 0.f) & 0xffffu); }
    asm volatile("s_waitcnt lgkmcnt(0)" ::: "memory");
#pragma unroll
    for (int i = 0; i < 4; ++i) { const int row = i * 8 + (lane >> 3), ch = lane & 7; const u32x4 v = *(const u32x4*)(stg + row * 64 + ch * 8); *(u32x4*)(Ow + (long)row * 1024 + ch * 8) = v; } }
  asm volatile("s_waitcnt vmcnt(0) lgkmcnt(0)\n\ts_barrier" ::: "memory");
#undef AF_DMA_KA
#undef AF_DMA_KB
#undef AF_DMA_K
#undef AF_DMA_V
#undef AF_WAITN
#undef AF_ROT
#undef AF_PKW
#undef AF_PAF
#undef AF_VFR
#undef AF_PIN
#undef AF_MF
#undef AF_EX
#undef AF_VRD
#undef AF_GA4
#undef AF_GA3
#undef AF_GA2
#undef AF_GB
#undef AF_KRD
#undef AF_PHASE_A12
#undef AF_PHASE_A8
#undef AF_PHASE_A6
#undef AF_A4
#undef AF_MX6
#undef AF_STEP
}

constexpr int ROWS_LAT = 16384;
constexpr float LOG2E_ = 1.4426950408889634f;
__device__ __forceinline__ int clampi(int v, int lo, int hi_) { return v < lo ? lo : (v > hi_ ? hi_ : v); }
struct FDense {
  static constexpr bool HAS_MASK = false;
  const bf16* Q; const bf16* kbase; const bf16* vbase; const bf16* krbase; bf16* O; int b, h, qb; static constexpr int kpitch = 2048, vpitch = 2048; const char* k6base = nullptr;
  __device__ __forceinline__ void init(const bf16* Q_, const bf16* KV, const bf16* KR, bf16* O_, int b_, int h_, int qb_) { Q = Q_; kbase = KV + 64 * h_; vbase = KV + 1024 + 64 * h_; krbase = KR; O = O_; b = b_; h = h_; qb = qb_; }
  __device__ __forceinline__ int nt() const { return 132; }
  __device__ __forceinline__ long trow(int t) const { return t < 4 ? (long)(ROWS_LAT + 256 * b + 64 * t) : (long)(8192 * b + 64 * (t - 4)); }
  __device__ __forceinline__ const bf16* qptr(int wid, int r32, int d0, int hi) const { const bf16* qp = Q + (long)(8192 * b + 256 * qb + 32 * wid + r32) * 1536;
    return d0 < 4 ? qp + 64 * h + 16 * d0 + 8 * hi : qp + 1024 + 32 * h + 16 * (d0 - 4) + 8 * hi; }
  __device__ __forceinline__ void mask(f32x16&, f32x16&, int, int, int, int) const {}
  __device__ __forceinline__ float sink(int) const { return -INFINITY; }
  __device__ __forceinline__ bf16* orow0(int wid) const { return O + (long)(8192 * b + 256 * qb + 32 * wid) * 1024 + 64 * h; }
};
struct FWin {
  static constexpr bool HAS_MASK = true; static constexpr int kpitch = 2304, vpitch = 2304;
  const bf16* QKV; const bf16* kbase; const bf16* vbase; const bf16* krbase; bf16* O; const float* sinkp; int b, n, g, hh, i0, cnt; const char* k6base;
  __device__ __forceinline__ void init(const bf16* QKV_, bf16* O_, const float* sk, int b_, int n_, int g_, int hh_, const char* K6E = nullptr) { QKV = QKV_; O = O_; sinkp = sk; b = b_; n = n_; g = g_; hh = hh_; krbase = nullptr; k6base = K6E + g_ * 3072;
    kbase = QKV_ + 512 + 64 * g_; vbase = QKV_ + 640 + 64 * g_; i0 = (n_ == 0) ? 2 : 0; cnt = (n_ == 0 || n_ == 63) ? 4 : 6; }
  __device__ __forceinline__ int nt() const { return 4 + cnt; }
  __device__ __forceinline__ int kpos0(int t) const { return 128 * (n - 1) + 64 * (i0 + t - 4); }
  __device__ __forceinline__ long trow(int t) const { return t < 4 ? (long)(ROWS_LAT + 256 * b + 64 * t) : (long)(8192 * b + kpos0(t)); }
  __device__ __forceinline__ int head(int wid) const { return 4 * g + 2 * hh + (wid >> 2); }
  __device__ __forceinline__ int qpos0(int wid) const { return 128 * n + 32 * (wid & 3); }
  __device__ __forceinline__ const bf16* qptr(int wid, int r32, int d0, int hi) const { return QKV + (long)(8192 * b + qpos0(wid) + r32) * 2304 + 64 * head(wid) + 16 * d0 + 8 * hi; }
  __device__ __forceinline__ void mask(f32x16& p0, f32x16& p1, int t, int wid, int r32, int hi) const {
    if (t < 4) return;
    const int k0 = kpos0(t), q0 = qpos0(wid);
    if (k0 - (q0 + 31) >= -128 && k0 + 63 - q0 <= 128) return;
    asm volatile("" : "+v"(r32), "+v"(hi));
    const int dq = k0 - (q0 + r32);
#pragma unroll
    for (int r = 0; r < 16; ++r) { const int d = dq + crow(r, hi); if (d > 128 || d < -128) p0[r] = -INFINITY; if (d + 32 > 128 || d + 32 < -128) p1[r] = -INFINITY; }
  }
  __device__ __forceinline__ float sink(int wid) const { return sinkp[head(wid)] * LOG2E_; }
  __device__ __forceinline__ bf16* orow0(int wid) const { return O + (long)(8192 * b + qpos0(wid)) * 1024 + 64 * head(wid); }
};
struct FNa {
  static constexpr bool HAS_MASK = true; static constexpr int kpitch = 2304, vpitch = 2304;
  const bf16* QKV; const bf16* kbase; const bf16* vbase; const bf16* krbase; bf16* O; const float* rpbl; int b, h, R4, krlo, nloc; const char* k6base;
  __device__ __forceinline__ void init(const bf16* QKV_, bf16* O_, const float* rpbl_, int b_, int h_, int R4_, const char* K6E = nullptr) { QKV = QKV_; O = O_; rpbl = rpbl_; b = b_; h = h_; R4 = R4_; krbase = nullptr; k6base = K6E + (2 + h_) * 3072;
    kbase = QKV_ + 1280 + 64 * h_; vbase = QKV_ + 1792 + 64 * h_; krlo = clampi(4 * R4_ - 4, 0, 120); nloc = clampi(4 * R4_ - 1, 0, 120) + 7 - krlo + 1; }
  __device__ __forceinline__ int nt() const { return (4 + nloc + 1) & ~1; }
  __device__ __forceinline__ long trow(int t) const { return (t < 4 || t >= 4 + nloc) ? (long)(ROWS_LAT + 256 * b + 64 * (t & 3)) : (long)(8192 * b + 64 * (krlo + t - 4)); }
  __device__ __forceinline__ int qrow(int wid) const { return 4 * R4 + (wid >> 1); }
  __device__ __forceinline__ const bf16* qptr(int wid, int r32, int d0, int hi) const { return QKV + (long)(8192 * b + 64 * qrow(wid) + 32 * (wid & 1) + r32) * 2304 + 768 + 64 * h + 16 * d0 + 8 * hi; }
  __device__ __forceinline__ void mask(f32x16& p0, f32x16& p1, int t, int wid, int r32, int hi) const {
    if (t < 4) return;
    const int kr = krlo + t - 4, w0 = clampi(qrow(wid) - 4, 0, 120);
    if (t >= 4 + nloc || kr < w0 || kr > w0 + 7) {
#pragma unroll
      for (int r = 0; r < 16; ++r) { p0[r] = -INFINITY; p1[r] = -INFINITY; }
      return; }
    asm volatile("" : "+v"(r32), "+v"(hi));
    const int qc = 32 * (wid & 1) + r32, c0 = clampi(qc - 8, 0, 48);
    const float* pb = rpbl + (kr - qrow(wid) + 7) * 31 + 15 - qc + 4 * hi;
    const unsigned t0 = (unsigned)(4 * hi - c0);
#define AF_PIN16(a) asm volatile("" : "+v"(a[0]), "+v"(a[1]), "+v"(a[2]), "+v"(a[3]), "+v"(a[4]), "+v"(a[5]), "+v"(a[6]), "+v"(a[7]), "+v"(a[8]), "+v"(a[9]), "+v"(a[10]), "+v"(a[11]), "+v"(a[12]), "+v"(a[13]), "+v"(a[14]), "+v"(a[15]))
    float bv[16];
#pragma unroll
    for (int r = 0; r < 16; ++r) bv[r] = pb[(r & 3) + 8 * (r >> 2)];
    AF_PIN16(bv);
#pragma unroll
    for (int r = 0; r < 16; ++r) { const bool ok = (t0 + (unsigned)((r & 3) + 8 * (r >> 2))) < 16u; p0[r] = ok ? p0[r] + bv[r] : -INFINITY; }
#pragma unroll
    for (int r = 0; r < 16; ++r) bv[r] = pb[32 + (r & 3) + 8 * (r >> 2)];
    AF_PIN16(bv);
#pragma unroll
    for (int r = 0; r < 16; ++r) { const bool ok = (t0 + (unsigned)(32 + (r & 3) + 8 * (r >> 2))) < 16u; p1[r] = ok ? p1[r] + bv[r] : -INFINITY; }
#undef AF_PIN16
  }
  __device__ __forceinline__ float sink(int) const { return -INFINITY; }
  __device__ __forceinline__ bf16* orow0(int wid) const { return O + (long)(8192 * b + 64 * qrow(wid) + 32 * (wid & 1)) * 1024 + 512 + 64 * h; }
};
struct FCtx {
  static constexpr bool HAS_MASK = false; static constexpr int kpitch = 2304, vpitch = 2304;
  const bf16* QKV; const bf16* kbase; const bf16* vbase; const bf16* krbase; bf16* O; const float* sinkp; int b, hx, qcol, ocol; const char* k6base;
  __device__ __forceinline__ void init(const bf16* QKV_, bf16* O_, const float* sk, int b_, int hx_, const char* K6E = nullptr) { QKV = QKV_; O = O_; sinkp = sk; b = b_; hx = hx_; krbase = nullptr; k6base = K6E + (hx_ < 8 ? (hx_ >> 2) : 2 + (hx_ - 8)) * 3072;
    if (hx_ < 8) { qcol = 64 * hx_; kbase = QKV_ + 512 + 64 * (hx_ >> 2); vbase = QKV_ + 640 + 64 * (hx_ >> 2); ocol = 64 * hx_; }
    else { const int h = hx_ - 8; qcol = 768 + 64 * h; kbase = QKV_ + 1280 + 64 * h; vbase = QKV_ + 1792 + 64 * h; ocol = 512 + 64 * h; } }
  __device__ __forceinline__ int nt() const { return 4; }
  __device__ __forceinline__ long trow(int t) const { return (long)(ROWS_LAT + 256 * b + 64 * (t & 3)); }
  __device__ __forceinline__ const bf16* qptr(int wid, int r32, int d0, int hi) const { return QKV + (long)(ROWS_LAT + 256 * b + 32 * wid + r32) * 2304 + qcol + 16 * d0 + 8 * hi; }
  __device__ __forceinline__ void mask(f32x16&, f32x16&, int, int, int, int) const {}
  __device__ __forceinline__ float sink(int) const { return hx < 8 ? sinkp[hx] * LOG2E_ : -INFINITY; }
  __device__ __forceinline__ bf16* orow0(int wid) const { return O + (long)(ROWS_LAT + 256 * b + 32 * wid) * 1024 + ocol; }
};
#undef AF_SBAR
#undef AF_WAIT_BAR
}
constexpr int NWAVES = 8;
#ifndef MK_PER_PHASE
#define MK_PER_PHASE 0
#endif
constexpr int BATCH = 2, SEQ = 8192, DM = 1024, CTXL = 256, FF = 4096;
constexpr int ML = BATCH * SEQ, MC = BATCH * CTXL, MR = ML + MC;
constexpr int NQKV = 2304, NCIN = 768, NUQ = 1536, NUKV = 2048;
constexpr float NORM_EPS = 1e-6f;
constexpr int ADA_KS = 16;
constexpr size_t MiB = 1u << 20;
constexpr size_t WS_CTL = 0, CTL_ZERO_BYTES = 64 * 1024;
constexpr size_t WS_MODP = 1 * MiB;
constexpr size_t WS_MOD = 3 * MiB + 512 * 1024;
constexpr size_t WS_ROPE = 3 * MiB + 768 * 1024;
constexpr size_t WS_ROPEP = WS_ROPE + 64 * 1024;
constexpr size_t WS_HPAR = WS_ROPE + 32 * 1024;
constexpr size_t WS_CTXRES = 4 * MiB;
constexpr size_t WS_WQKV = 6 * MiB, WS_WO0 = WS_WQKV + 4608 * 1024, WS_W1_0 = WS_WO0 + 2 * MiB, WS_W2_0 = WS_W1_0 + 8 * MiB, WS_W1_1 = WS_W2_0 + 8 * MiB, WS_W2_1 = WS_W1_1 + 8 * MiB;
constexpr size_t WS_WIN = WS_W2_1 + 8 * MiB, WS_WUQ = WS_WIN + 1536 * 1024, WS_WUKV = WS_WUQ + 1152 * 1024, WS_WO1 = WS_WUKV + 1 * MiB, WS_WEND = WS_WO1 + 2 * MiB;
constexpr size_t WS_AR = 51 * MiB;
static_assert(WS_WEND <= WS_AR, "weights overlap the arena");
constexpr size_t WS_XN = WS_AR, WS_H = WS_AR + 33 * MiB;
constexpr size_t WS_QKV = WS_AR + 33 * MiB, WS_O0 = WS_AR + 108 * MiB;
constexpr size_t WS_CQKV = WS_AR + 33 * MiB, WS_CQN = WS_AR + 58 * MiB, WS_CKVN = WS_AR + 71 * MiB, WS_KR = WS_AR + 80 * MiB, WS_Q1 = WS_AR + 82 * MiB, WS_KV1 = WS_AR + 130 * MiB, WS_O1 = WS_AR;
constexpr size_t WS_K6E = WS_AR + 150 * MiB;
constexpr size_t WS_K6N = WS_AR + 34 * MiB, WS_K6R = WS_AR + 48 * MiB;
constexpr size_t WS_PART5 = WS_AR + 33 * MiB;
constexpr size_t WS_XR = WS_AR + 166 * MiB;
constexpr size_t WS_PART8 = WS_AR + 166 * MiB;
constexpr size_t WS_END = 256 * MiB;
static_assert(WS_PART8 + (size_t)16 * 512 * 1024 * 4 <= WS_END && WS_KV1 + (size_t)MR * NUKV * 2 <= WS_END && WS_H + (size_t)MR * FF * 2 <= WS_END, "d_ws map");
constexpr int CW_BAR = 4096;
constexpr int RING_OFF = 0, RING_BYTES = 131072;
constexpr int LDSCTL_OFF = RING_BYTES, MISC_OFF = LDSCTL_OFF + 320;
constexpr int LDS_BYTES = 147456;
static_assert(att::L_END <= RING_BYTES && attf::LDS_BYTES <= RING_BYTES, "attention LDS");

#define GAS __attribute__((address_space(1)))
#define LAS __attribute__((address_space(3)))
typedef unsigned short bf16;
typedef unsigned v4u __attribute__((ext_vector_type(4)));
typedef unsigned v2u __attribute__((ext_vector_type(2)));
typedef float f32x4 __attribute__((ext_vector_type(4)));
typedef GAS unsigned gu32;
#define RLX_AGENT __ATOMIC_RELAXED, __HIP_MEMORY_SCOPE_AGENT
#define LDS_WAIT() asm volatile("s_waitcnt lgkmcnt(0)" ::: "memory")
#define VM_WAIT() asm volatile("s_waitcnt vmcnt(0)" ::: "memory")
__device__ __forceinline__ unsigned f2bf(float f) { unsigned u = __builtin_bit_cast(unsigned, f); return (u + 0x7fffu + ((u >> 16) & 1u)) >> 16; }
__device__ __forceinline__ unsigned pk2(float lo, float hi) { return f2bf(lo) | (f2bf(hi) << 16); }
__device__ __forceinline__ float bf2f(unsigned short h) { return __builtin_bit_cast(float, (unsigned)h << 16); }
__device__ __forceinline__ float bflo(unsigned w) { return __builtin_bit_cast(float, w << 16); }
__device__ __forceinline__ float bfhi(unsigned w) { return __builtin_bit_cast(float, w & 0xffff0000u); }

#define XB_TMO      128
#define XB_XCNT(j)  (256  + 64 * (j))
#define XB_XSUB(j)  (1280 + 64 * (j))
#define XB_XGEN(j)  (2304 + 64 * (j))
#define XB_TOP      3328
#define XB_TOPGEN   3392
#define XCD_BAR_WORDS 3456
#define XB_SPIN_CAP (1u << 18)

__device__ __forceinline__ unsigned xb_ld(unsigned* p)              { return __hip_atomic_load(p, __ATOMIC_RELAXED, __HIP_MEMORY_SCOPE_AGENT); }
__device__ __forceinline__ unsigned xb_add(unsigned* p, unsigned v) { return __hip_atomic_fetch_add(p, v, __ATOMIC_RELAXED, __HIP_MEMORY_SCOPE_AGENT); }
__device__ __forceinline__ unsigned xb_xcc_id() { return (unsigned)__builtin_amdgcn_s_getreg((3 << 11) | 20) & 0xFu; }
#define XB_SPIN(cond, bar) do { unsigned _sp = 0; while (cond) { __builtin_amdgcn_s_sleep(1); \
    if ((++_sp & 255u) == 0u) { if (xb_ld(&(bar)[XB_TMO])) break; if (_sp > XB_SPIN_CAP) { atomicAdd(&(bar)[XB_TMO], 1u); break; } } } } while (0)

struct XcdBarrier {
    unsigned* bar; unsigned x;
    volatile LAS unsigned* st;
};

__device__ __forceinline__ XcdBarrier xcd_barrier_post(unsigned* bar, volatile LAS unsigned* st) {
    XcdBarrier b; b.bar = bar; b.x = xb_xcc_id(); b.st = st;
    if (threadIdx.x == 0) (void)xb_add(&bar[XB_XCNT(b.x)], 1u);
    return b;
}
__device__ __forceinline__ void xcd_barrier_complete(unsigned* bar, unsigned x, unsigned& nloc, unsigned& nx) {
    const unsigned G = gridDim.x * gridDim.y * gridDim.z;
    unsigned sum, cnt, mine, sp = 0u;
    for (;;) {
        sum = 0u; cnt = 0u; mine = 0u;
#pragma unroll
        for (unsigned j = 0; j < 16; ++j) { const unsigned c = xb_ld(&bar[XB_XCNT(j)]); sum += c; cnt += (c > 0u) ? 1u : 0u; mine = (j == x) ? c : mine; }
        if (sum == G) break;
        __builtin_amdgcn_s_sleep(1);
        if ((++sp & 255u) == 0u) { if (xb_ld(&bar[XB_TMO])) break; if (sp > XB_SPIN_CAP) { atomicAdd(&bar[XB_TMO], 1u); break; } }
    }
    nloc = mine > 0u ? mine : 1u; nx = cnt > 0u ? cnt : 1u;
}

__device__ __forceinline__ void xcd_barrier(const XcdBarrier& b) {
    asm volatile("s_waitcnt vmcnt(0)" ::: "memory");
    __syncthreads();
    if (threadIdx.x == 0) {
        unsigned* bar = b.bar;
        __builtin_amdgcn_s_waitcnt(0);
        unsigned nloc = b.st[0], nx = b.st[1];
        if (nloc == 0u) { xcd_barrier_complete(bar, b.x, nloc, nx); b.st[0] = nloc; b.st[1] = nx; }
        const unsigned old = xb_add(&bar[XB_XSUB(b.x)], 1u);
        const unsigned gen = old / nloc;
        if (old + 1u == (gen + 1u) * nloc) {
            __builtin_amdgcn_fence(__ATOMIC_RELEASE, "agent");
            asm volatile("s_waitcnt vmcnt(0)" ::: "memory");
            const unsigned og = xb_add(&bar[XB_TOP], 1u);
            const unsigned tg = og / nx;
            if (og + 1u == (tg + 1u) * nx) xb_add(&bar[XB_TOPGEN], 1u);
            else XB_SPIN(xb_ld(&bar[XB_TOPGEN]) == tg, bar);
            __builtin_amdgcn_fence(__ATOMIC_ACQUIRE, "agent");
            xb_add(&bar[XB_XGEN(b.x)], 1u);
            asm volatile("s_waitcnt vmcnt(0)" ::: "memory");
        } else {
            XB_SPIN(xb_ld(&bar[XB_XGEN(b.x)]) == gen, bar);
            __builtin_amdgcn_fence(__ATOMIC_ACQUIRE, "agent");
            asm volatile("s_waitcnt vmcnt(0)" ::: "memory");
        }
    }
    __syncthreads();
}


template <int K> __device__ __forceinline__ const float* ldarg() {
    auto ka = __builtin_amdgcn_kernarg_segment_ptr();
    const __attribute__((address_space(1))) float* p; asm volatile("s_load_dwordx2 %0, %1, %2\n\ts_waitcnt lgkmcnt(0)" : "=s"(p) : "s"(ka), "i"(K * 8) : "memory"); return (const float*)p;
}
#define ARG(k) (ldarg<k>())
#define ARG_OUT ((float*)ldarg<28>())
#define ARG_WS ((unsigned char*)ldarg<29>())
struct Frame {
    LAS unsigned char* lds;
    volatile LAS unsigned* MISC;
    gu32* ctl;
    int tid, lane, wave;
    int vcu, G, bx;
    float* out; unsigned char* ws;
};
__device__ __forceinline__ float shx(float v, int mask, int lane) { return __builtin_bit_cast(float, __builtin_amdgcn_ds_bpermute((lane ^ mask) << 2, __builtin_bit_cast(int, v))); }
__device__ __forceinline__ float wave_sum(float v, int lane) {
#pragma unroll
    for (int o = 1; o < 64; o <<= 1) v += shx(v, o, lane);
    return v;
}
__device__ __forceinline__ void p0_transpose_item(const float* W, int K, int N, bf16* WT, int pmode, LAS float* scr, int item, int lane) {
    const int nblk = N / 32, kb = item / nblk, nb = item % nblk, k0 = 64 * kb, n0 = 32 * nb;
    int r0 = n0;
    if (pmode == 1) { const int h = n0 / 96, d = n0 % 96; r0 = d < 64 ? h * 64 + d : 1024 + h * 32 + (d - 64); }
    else if (pmode == 2) { const int h = n0 / 128, d = n0 % 128; r0 = d < 64 ? h * 64 + d : 1024 + h * 64 + (d - 64); }
#pragma unroll 8
    for (int i = 0; i < 32; ++i) { const int kk = 2 * i + (lane >> 5); scr[kk * 33 + (lane & 31)] = W[(size_t)(k0 + kk) * N + n0 + (lane & 31)]; }
    LDS_WAIT(); asm volatile("" ::: "memory");
    const int c = lane & 7;
#pragma unroll
    for (int j = 0; j < 4; ++j) { const int n = (lane >> 3) + 8 * j; const LAS float* s = scr + (8 * c) * 33 + n;
        v4u o; o.x = pk2(s[0 * 33], s[1 * 33]); o.y = pk2(s[2 * 33], s[3 * 33]); o.z = pk2(s[4 * 33], s[5 * 33]); o.w = pk2(s[6 * 33], s[7 * 33]);
        *(GAS v4u*)(WT + (size_t)(r0 + n) * K + k0 + 8 * c) = o; }
    LDS_WAIT(); asm volatile("" ::: "memory");
}
__device__ __forceinline__ float silu_f(float v) { return v / (1.f + __expf(-v)); }

__device__ __forceinline__ void p0_prologue(Frame& F) {
    LAS float* scr = (LAS float*)(F.lds + RING_OFF + F.wave * 16384);
    const float* c = ARG(1); const float* cctx = ARG(3);
    if (F.wave >= 5) {
        for (int it = F.vcu * 3 + (F.wave - 5); it < 2 * 24 * ADA_KS; it += F.G * 3) {
            const int l = it / (24 * ADA_KS), rem = it % (24 * ADA_KS), cg = rem / ADA_KS, ks = rem % ADA_KS;
            const float* W = ARG(4) + (size_t)l * DM * 6144 + cg * 256 + 4 * F.lane;
            f32x4 a0 = {0.f, 0.f, 0.f, 0.f}, a1 = a0, a2 = a0;
            const int kbeg = ks * (DM / ADA_KS);
#pragma unroll 8
            for (int k = kbeg; k < kbeg + DM / ADA_KS; ++k) {
                const f32x4 w = *(const GAS f32x4*)(W + (size_t)k * 6144);
                const float s0 = silu_f(c[k]), s1 = silu_f(c[DM + k]), s2 = silu_f(cctx[k]);
                a0 += w * s0; a1 += w * s1; a2 += w * s2;
            }
            float* P = (float*)(F.ws + WS_MODP) + ((size_t)(ks * 2 + l) * 3) * 6144 + cg * 256 + 4 * F.lane;
            *(GAS f32x4*)(P) = a0; *(GAS f32x4*)(P + 6144) = a1; *(GAS f32x4*)(P + 2 * 6144) = a2;
        }
    } else {
        const int gw = F.vcu * 5 + F.wave, NGW = F.G * 5;
        constexpr int I_QKV = 16 * 72, I_O = 16 * 32, I_1 = 16 * 128, I_2 = 64 * 32, I_IN = 16 * 21, I_UQ = 6 * 48, I_UKV = 4 * 64;
        constexpr int NITEMS = I_QKV + I_O + 2 * I_1 + 2 * I_2 + I_IN + I_UQ + I_UKV + I_O;
        for (int it = gw; it < NITEMS; it += NGW) {
            int r = it;
            if (r < I_QKV) { p0_transpose_item(ARG(10), DM, NQKV, (bf16*)(F.ws + WS_WQKV), 0, scr, r, F.lane); continue; } r -= I_QKV;
            if (r < I_O) { p0_transpose_item(ARG(11), DM, DM, (bf16*)(F.ws + WS_WO0), 0, scr, r, F.lane); continue; } r -= I_O;
            if (r < I_1) { p0_transpose_item(ARG(8), DM, FF, (bf16*)(F.ws + WS_W1_0), 0, scr, r, F.lane); continue; } r -= I_1;
            if (r < I_1) { p0_transpose_item(ARG(8) + (size_t)DM * FF, DM, FF, (bf16*)(F.ws + WS_W1_1), 0, scr, r, F.lane); continue; } r -= I_1;
            if (r < I_2) { p0_transpose_item(ARG(9), FF, DM, (bf16*)(F.ws + WS_W2_0), 0, scr, r, F.lane); continue; } r -= I_2;
            if (r < I_2) { p0_transpose_item(ARG(9) + (size_t)DM * FF, FF, DM, (bf16*)(F.ws + WS_W2_1), 0, scr, r, F.lane); continue; } r -= I_2;
            if (r < I_IN) { p0_transpose_item(ARG(18), DM, 672, (bf16*)(F.ws + WS_WIN), 0, scr, r, F.lane); continue; } r -= I_IN;
            if (r < I_UQ) { p0_transpose_item(ARG(21), 384, NUQ, (bf16*)(F.ws + WS_WUQ), 1, scr, r, F.lane); continue; } r -= I_UQ;
            if (r < I_UKV) { p0_transpose_item(ARG(22), 256, NUKV, (bf16*)(F.ws + WS_WUKV), 2, scr, r, F.lane); continue; } r -= I_UKV;
            p0_transpose_item(ARG(27), DM, DM, (bf16*)(F.ws + WS_WO1), 0, scr, r, F.lane);
        }
    }
    if (F.bx == 1 % F.G) {
        float* rt = (float*)(F.ws + WS_ROPE);
        for (int e = F.tid; e < 128 * 16; e += NWAVES * 64) { const int pos = e >> 4, i = e & 15; const float inv = exp2f(-(float)i * (13.287712379549449f / 16.f));
            float x = (float)pos * inv * 0.15915494309189535f; x -= rintf(x); const float c_ = __builtin_amdgcn_cosf(x), s_ = __builtin_amdgcn_sinf(x); rt[e] = c_; rt[2048 + e] = s_; ((unsigned*)(F.ws + WS_ROPEP))[e] = pk2(c_, s_); }
        for (int e = F.tid; e < 128 * 8; e += NWAVES * 64) { const int pos = e >> 3, i = e & 7; const float inv = exp2f(-(float)i * (13.287712379549449f / 8.f));
            float x = (float)pos * inv * 0.15915494309189535f; x -= rintf(x); const float c_ = __builtin_amdgcn_cosf(x), s_ = __builtin_amdgcn_sinf(x); rt[4096 + e] = c_; rt[5120 + e] = s_; ((unsigned*)(F.ws + WS_ROPEP))[2048 + e] = pk2(c_, s_); }
    }
    if (F.bx == 3 % F.G && F.tid < 64) {
        float* hp = (float*)(F.ws + WS_HPAR); const int i = F.tid;
        hp[i] = ARG(12)[i]; hp[64 + i] = ARG(13)[i]; hp[128 + i] = ARG(15)[i]; hp[192 + i] = ARG(16)[i]; hp[256 + i] = ARG(23)[i]; hp[320 + i] = ARG(24)[i & 31]; hp[384 + i] = ARG(25)[i];
        float a = fabsf(ARG(23)[i]), b_ = fabsf(ARG(25)[i]), c_ = fabsf(ARG(24)[i & 31]), d_ = fabsf(ARG(26)[i & 31]);
#pragma unroll
        for (int o_ = 1; o_ < 64; o_ <<= 1) { a = fmaxf(a, shx(a, o_, i)); b_ = fmaxf(b_, shx(b_, o_, i)); c_ = fmaxf(c_, shx(c_, o_, i)); d_ = fmaxf(d_, shx(d_, o_, i)); }
        const float bound = (64.f * a * b_ + 32.f * c_ * d_) * (0.10206207261596575f * 1.4426950408889634f);
        if (i == 0) hp[448] = (bound < 64.f && fmaxf(fmaxf(a, b_), fmaxf(c_, d_)) < 3.f) ? 1.f : 0.f;
        { float a2 = fabsf(ARG(12)[i]), b2 = fabsf(ARG(13)[i]), c2 = fabsf(ARG(15)[i]), d2 = fabsf(ARG(16)[i]), e2 = 0.f, f2 = fabsf(ARG(14)[i & 7]);
          for (int j = i; j < 8 * 465; j += 64) e2 = fmaxf(e2, fabsf(ARG(17)[j]));
#pragma unroll
          for (int o_ = 1; o_ < 64; o_ <<= 1) { a2 = fmaxf(a2, shx(a2, o_, i)); b2 = fmaxf(b2, shx(b2, o_, i)); c2 = fmaxf(c2, shx(c2, o_, i)); d2 = fmaxf(d2, shx(d2, o_, i)); e2 = fmaxf(e2, shx(e2, o_, i)); f2 = fmaxf(f2, shx(f2, o_, i)); }
          const float bound0 = fmaxf(fmaxf(8.f * a2 * b2, 8.f * c2 * d2 + e2), f2) * 1.4426950408889634f;
          if (i == 0) hp[449] = (bound0 < 64.f && fmaxf(fmaxf(a2, b2), fmaxf(c2, d2)) < 3.f) ? 1.f : 0.f; }
    }
    if (F.bx == 2 % F.G) {
        GAS v4u* z = (GAS v4u*)((bf16*)(F.ws + WS_WIN) + (size_t)672 * DM);
        unsigned zz = 0u; asm volatile("" : "+v"(zz));
        for (int e = F.tid; e < 96 * DM / 8; e += NWAVES * 64) z[e] = (v4u){zz, zz, zz, zz};
    }
}

__device__ __forceinline__ void norm_phase(Frame& F, const float* src_lat, const float* src_ctx, int nrows, const float* gw_, int layer, int which  , bool from_partials, const float* parts = nullptr, int nparts = 0, bool lat_bf16 = false) {
    LAS float* gl = (LAS float*)(F.lds + RING_OFF); LAS float* scl = gl + 1024; LAS float* shl = scl + 3 * 1024;
    const float* modp = (const float*)(F.ws + WS_MODP); const float* mod = (const float*)(F.ws + WS_MOD); const float* ada_b = ARG(5);
    const int offsh = which * 3072, offsc = which * 3072 + 1024;
    for (int i = F.tid; i < 1024; i += NWAVES * 64) {
        gl[i] = gw_[i];
#pragma unroll
        for (int cnd = 0; cnd < 3; ++cnd) {
            float sh, sc;
            if (from_partials) { sh = ada_b[layer * 6144 + offsh + i]; sc = ada_b[layer * 6144 + offsc + i];
                float ph[ADA_KS], pc[ADA_KS];
#pragma unroll
                for (int ks = 0; ks < ADA_KS; ++ks) { const float* p = modp + ((size_t)(ks * 2 + layer) * 3 + cnd) * 6144; ph[ks] = p[offsh + i]; pc[ks] = p[offsc + i]; }
#pragma unroll
                for (int ks = 0; ks < ADA_KS; ++ks) { sh += ph[ks]; sc += pc[ks]; } }
            else { sh = mod[(layer * 3 + cnd) * 6144 + offsh + i]; sc = mod[(layer * 3 + cnd) * 6144 + offsc + i]; }
            scl[cnd * 1024 + i] = 1.f + sc; shl[cnd * 1024 + i] = sh;
        }
    }
    if (from_partials) {
        float* modw = (float*)(F.ws + WS_MOD);
        for (int e = F.vcu * (NWAVES * 64) + F.tid; e < 2 * 3 * 6144; e += F.G * NWAVES * 64) {
            const int l = e / (3 * 6144), rem = e % (3 * 6144), cnd = rem / 6144, col = rem % 6144;
            float v = ada_b[l * 6144 + col];
            float pv[ADA_KS];
#pragma unroll
            for (int ks = 0; ks < ADA_KS; ++ks) pv[ks] = modp[((size_t)(ks * 2 + l) * 3 + cnd) * 6144 + col];
#pragma unroll
            for (int ks = 0; ks < ADA_KS; ++ks) v += pv[ks];
            modw[e] = v;
        }
    }
    __syncthreads();
    bf16* XN = (bf16*)(F.ws + WS_XN);
    const int gw = F.vcu * NWAVES + F.wave, NGW = F.G * NWAVES;
    for (int m = gw; m < nrows; m += NGW) {
        const float* xrow = m < ML ? src_lat + (size_t)m * DM : src_ctx + (size_t)(m - ML) * DM;
        const int cnd = m < SEQ ? 0 : (m < ML ? 1 : 2);
        const GAS f32x4* xr = (const GAS f32x4*)xrow + F.lane;
        f32x4 v[4]; float s = 0.f;
        if (lat_bf16 && m < ML) {
            const GAS v2u* xb = (const GAS v2u*)((const bf16*)src_lat + (size_t)m * DM) + F.lane;
            v2u w[4];
#pragma unroll
            for (int j = 0; j < 4; ++j) w[j] = xb[64 * j];
#pragma unroll
            for (int j = 0; j < 4; ++j) v[j] = f32x4{bflo(w[j].x), bfhi(w[j].x), bflo(w[j].y), bfhi(w[j].y)};
        } else {
#pragma unroll
            for (int j = 0; j < 4; ++j) v[j] = xr[64 * j];
        }
        if (nparts > 0 && m >= ML) {
            for (int p = 0; p < nparts; p += 4) {
                const GAS f32x4* pr = (const GAS f32x4*)(parts + (size_t)p * (512 * 1024) + (size_t)(m - ML) * DM) + F.lane;
                f32x4 w[4][4];
#pragma unroll
                for (int q = 0; q < 4; ++q)
#pragma unroll
                    for (int j = 0; j < 4; ++j) w[q][j] = pr[(size_t)q * (512 * 1024 / 4) + 64 * j];
#pragma unroll
                for (int j = 0; j < 4; ++j) v[j] += (w[0][j] + w[1][j]) + (w[2][j] + w[3][j]); }
            GAS f32x4* cr = (GAS f32x4*)((float*)(F.ws + WS_CTXRES) + (size_t)(m - ML) * DM) + F.lane;
#pragma unroll
            for (int j = 0; j < 4; ++j) cr[64 * j] = v[j];
        }
#pragma unroll
        for (int j = 0; j < 4; ++j) s += (v[j].x * v[j].x + v[j].y * v[j].y) + (v[j].z * v[j].z + v[j].w * v[j].w);
        const float rstd = 1.f / sqrtf(wave_sum(s, F.lane) * (1.f / DM) + NORM_EPS);
        if (from_partials && m >= ML) { GAS f32x4* cr = (GAS f32x4*)((float*)(F.ws + WS_CTXRES) + (size_t)(m - ML) * DM) + F.lane;
#pragma unroll
            for (int j = 0; j < 4; ++j) cr[64 * j] = v[j]; }
        GAS v2u* o8 = (GAS v2u*)(XN + (size_t)m * DM) + F.lane;
#pragma unroll
        for (int j = 0; j < 4; ++j) { const int col = 4 * F.lane + 256 * j;
            const f32x4 g = *(const LAS f32x4*)(gl + col), sc = *(const LAS f32x4*)(scl + cnd * 1024 + col), sh = *(const LAS f32x4*)(shl + cnd * 1024 + col);
            const f32x4 y = (v[j] * rstd) * g * sc + sh;
            v2u w; w.x = pk2(y.x, y.y); w.y = pk2(y.z, y.w); o8[64 * j] = w; }
    }
    __syncthreads();
}

__device__ __forceinline__ void unpack8(const v4u w, float (&x)[8]) { x[0] = bflo(w.x); x[1] = bfhi(w.x); x[2] = bflo(w.y); x[3] = bfhi(w.y); x[4] = bflo(w.z); x[5] = bfhi(w.z); x[6] = bflo(w.w); x[7] = bfhi(w.w); }
__device__ __forceinline__ v4u pack8(const float (&x)[8]) { v4u w; w.x = pk2(x[0], x[1]); w.y = pk2(x[2], x[3]); w.z = pk2(x[4], x[5]); w.w = pk2(x[6], x[7]); return w; }

__device__ __forceinline__ void qknorm_phase(Frame& F) {
    bf16* QKV = (bf16*)(F.ws + WS_QKV);
    const float* rt = (const float*)(F.ws + WS_ROPE);
    const float* nw[4] = {ARG(12), ARG(13), ARG(15), ARG(16)};
    const float qscale = 0.125f * att::LOG2E;
    const int gw = F.vcu * NWAVES + F.wave, NGW = F.G * NWAVES;
    const int lane = F.lane, grp = lane >> 3, l8 = lane & 7;
    for (int m = gw; m < MR; m += NGW) {
        const bool lat = m < ML; const int t = m & (SEQ - 1); const int prow = t >> 6, pcol = t & 63;
        GAS v4u* rowp = (GAS v4u*)(QKV + (size_t)m * NQKV);
#pragma unroll
        for (int pass = 0; pass < 4; ++pass) {
            int type;
            if (pass == 0) type = 1; else if (pass == 1) type = grp < 2 ? 2 : (grp < 4 ? 0 : 3); else if (pass == 2) type = grp < 4 ? 3 : 4; else type = grp < 4 ? 4 : 0;
            const v4u w = rowp[pass * 64 + lane];
            float x[8]; unpack8(w, x);
            float ss = 0.f;
#pragma unroll
            for (int j = 0; j < 8; ++j) ss += x[j] * x[j];
            ss += shx(ss, 1, F.lane); ss += shx(ss, 2, F.lane); ss += shx(ss, 4, F.lane);
            const float rstd = 1.f / sqrtf(ss * (1.f / 64.f) + NORM_EPS);
            const float* g = type == 1 ? nw[0] : (type == 2 ? nw[1] : (type == 3 ? nw[2] : nw[3]));
            const f32x4 g0 = *(const GAS f32x4*)(g + l8 * 8), g1 = *(const GAS f32x4*)(g + l8 * 8 + 4);
            x[0] *= rstd * g0.x; x[1] *= rstd * g0.y; x[2] *= rstd * g0.z; x[3] *= rstd * g0.w; x[4] *= rstd * g1.x; x[5] *= rstd * g1.y; x[6] *= rstd * g1.z; x[7] *= rstd * g1.w;
            float px[8];
#pragma unroll
            for (int j = 0; j < 8; ++j) px[j] = shx(x[j], 2, F.lane);
            if (lat && (type == 1 || type == 2)) {
                const int pos = (l8 & 4) ? pcol : prow; const float* cs = rt + pos * 16 + (l8 & 1) * 8;
                const f32x4 c0 = *(const GAS f32x4*)(cs), c1 = *(const GAS f32x4*)(cs + 4), s0 = *(const GAS f32x4*)(cs + 2048), s1 = *(const GAS f32x4*)(cs + 2052);
                const float cc[8] = {c0.x, c0.y, c0.z, c0.w, c1.x, c1.y, c1.z, c1.w}, sn[8] = {s0.x, s0.y, s0.z, s0.w, s1.x, s1.y, s1.z, s1.w};
                const float sgn = (l8 & 2) ? 1.f : -1.f;
#pragma unroll
                for (int j = 0; j < 8; ++j) x[j] = x[j] * cc[j] + sgn * px[j] * sn[j];
            }
            if (type == 1 || type == 3) {
#pragma unroll
                for (int j = 0; j < 8; ++j) x[j] *= qscale;
            }
            if (type != 0) rowp[pass * 64 + lane] = pack8(x);
        }
    }
}

__device__ __forceinline__ void cnorm_phase(Frame& F) {
    const bf16* CQKV = (const bf16*)(F.ws + WS_CQKV); bf16* CQN = (bf16*)(F.ws + WS_CQN); bf16* CKVN = (bf16*)(F.ws + WS_CKVN); bf16* KR = (bf16*)(F.ws + WS_KR);
    const float* rt = (const float*)(F.ws + WS_ROPE) + 4096;
    const float* gq = ARG(19); const float* gkv = ARG(20); const float* gkr = ARG(26);
    const int gw = F.vcu * NWAVES + F.wave, NGW = F.G * NWAVES; const int lane = F.lane;
    for (int m = gw; m < MR; m += NGW) {
        const bool lat = m < ML; const int t = m & (SEQ - 1); const int prow = t >> 6, pcol = t & 63;
        const GAS v4u* rowp = (const GAS v4u*)(CQKV + (size_t)m * NCIN);
        const v4u w0 = rowp[lane]; v4u w1 = {0u, 0u, 0u, 0u}; if (lane < 32) w1 = rowp[64 + lane];
        float x0[8], x1[8]; unpack8(w0, x0); unpack8(w1, x1);
        float s0 = 0.f, s1 = 0.f;
#pragma unroll
        for (int j = 0; j < 8; ++j) { s0 += x0[j] * x0[j]; s1 += x1[j] * x1[j]; }
        const float ssq = wave_sum(lane < 48 ? s0 : 0.f, F.lane);
        const float sskv = wave_sum((lane >= 48 ? s0 : 0.f) + (lane < 16 ? s1 : 0.f), F.lane);
        const float sskr = wave_sum((lane >= 16 && lane < 20) ? s1 : 0.f, F.lane);
        const float rq = 1.f / sqrtf(ssq * (1.f / 384.f) + NORM_EPS), rkv = 1.f / sqrtf(sskv * (1.f / 256.f) + NORM_EPS), rkr = 1.f / sqrtf(sskr * (1.f / 32.f) + NORM_EPS);
        { const float* g = lane < 48 ? gq + lane * 8 : gkv + (lane - 48) * 8; const float r = lane < 48 ? rq : rkv;
          const f32x4 g0 = *(const GAS f32x4*)(g), g1 = *(const GAS f32x4*)(g + 4);
          float y[8] = {x0[0] * r * g0.x, x0[1] * r * g0.y, x0[2] * r * g0.z, x0[3] * r * g0.w, x0[4] * r * g1.x, x0[5] * r * g1.y, x0[6] * r * g1.z, x0[7] * r * g1.w};
          if (lane < 48) *(GAS v4u*)(CQN + (size_t)m * 384 + lane * 8) = pack8(y); else *(GAS v4u*)(CKVN + (size_t)m * 256 + (lane - 48) * 8) = pack8(y); }
        { const int li = lane < 16 ? lane : (lane < 20 ? lane - 16 : 0);
          const float* g = lane < 16 ? gkv + 128 + li * 8 : gkr + li * 8; const float r = lane < 16 ? rkv : rkr;
          const f32x4 g0 = *(const GAS f32x4*)(g), g1 = *(const GAS f32x4*)(g + 4);
          float y[8] = {x1[0] * r * g0.x, x1[1] * r * g0.y, x1[2] * r * g0.z, x1[3] * r * g0.w, x1[4] * r * g1.x, x1[5] * r * g1.y, x1[6] * r * g1.z, x1[7] * r * g1.w};
          float py[8];
#pragma unroll
          for (int j = 0; j < 8; ++j) py[j] = shx(y[j], 1, F.lane);
          if (lat && lane >= 16 && lane < 20) {
              const int pos = (lane & 2) ? pcol : prow; const float* cs = rt + pos * 8;
              const f32x4 c0 = *(const GAS f32x4*)(cs), c1 = *(const GAS f32x4*)(cs + 4), sa = *(const GAS f32x4*)(cs + 1024), sb = *(const GAS f32x4*)(cs + 1028);
              const float cc[8] = {c0.x, c0.y, c0.z, c0.w, c1.x, c1.y, c1.z, c1.w}, sn[8] = {sa.x, sa.y, sa.z, sa.w, sb.x, sb.y, sb.z, sb.w};
              const float sgn = (lane & 1) ? 1.f : -1.f;
#pragma unroll
              for (int j = 0; j < 8; ++j) y[j] = y[j] * cc[j] + sgn * py[j] * sn[j];
          }
          if (lane < 16) *(GAS v4u*)(CKVN + (size_t)m * 256 + 128 + lane * 8) = pack8(y);
          else if (lane < 20) *(GAS v4u*)(KR + (size_t)m * 32 + (lane - 16) * 8) = pack8(y); }
    }
}

__device__ __forceinline__ void hnorm_phase(Frame& F) {
    bf16* Q = (bf16*)(F.ws + WS_Q1); bf16* KV = (bf16*)(F.ws + WS_KV1);
    const float* rt = (const float*)(F.ws + WS_ROPE) + 4096;
    const float* gqn = ARG(23); const float* gqr = ARG(24); const float* gkn = ARG(25);
    const float qscale = 0.10206207261596575f * att::LOG2E;
    const int gw = F.vcu * NWAVES + F.wave, NGW = F.G * NWAVES; const int lane = F.lane, l8 = lane & 7, l4 = lane & 3;
    for (int m = gw; m < MR; m += NGW) {
        const bool lat = m < ML; const int t = m & (SEQ - 1); const int prow = t >> 6, pcol = t & 63;
        { GAS v4u* rowp = (GAS v4u*)(KV + (size_t)m * NUKV);
          const f32x4 g0 = *(const GAS f32x4*)(gkn + l8 * 8), g1 = *(const GAS f32x4*)(gkn + l8 * 8 + 4);
#pragma unroll
          for (int pass = 0; pass < 2; ++pass) {
              float x[8]; unpack8(rowp[pass * 64 + lane], x); float ss = 0.f;
#pragma unroll
              for (int j = 0; j < 8; ++j) ss += x[j] * x[j];
              ss += shx(ss, 1, F.lane); ss += shx(ss, 2, F.lane); ss += shx(ss, 4, F.lane);
              const float r = 1.f / sqrtf(ss * (1.f / 64.f) + NORM_EPS);
              x[0] *= r * g0.x; x[1] *= r * g0.y; x[2] *= r * g0.z; x[3] *= r * g0.w; x[4] *= r * g1.x; x[5] *= r * g1.y; x[6] *= r * g1.z; x[7] *= r * g1.w;
              rowp[pass * 64 + lane] = pack8(x); } }
        if (lat) {
            GAS v4u* rowp = (GAS v4u*)(Q + (size_t)m * NUQ);
            { const f32x4 g0 = *(const GAS f32x4*)(gqn + l8 * 8), g1 = *(const GAS f32x4*)(gqn + l8 * 8 + 4);
#pragma unroll
              for (int pass = 0; pass < 2; ++pass) {
                  float x[8]; unpack8(rowp[pass * 64 + lane], x); float ss = 0.f;
#pragma unroll
                  for (int j = 0; j < 8; ++j) ss += x[j] * x[j];
                  ss += shx(ss, 1, F.lane); ss += shx(ss, 2, F.lane); ss += shx(ss, 4, F.lane);
                  const float r = qscale / sqrtf(ss * (1.f / 64.f) + NORM_EPS);
                  x[0] *= r * g0.x; x[1] *= r * g0.y; x[2] *= r * g0.z; x[3] *= r * g0.w; x[4] *= r * g1.x; x[5] *= r * g1.y; x[6] *= r * g1.z; x[7] *= r * g1.w;
                  rowp[pass * 64 + lane] = pack8(x); } }
            {
              const f32x4 g0 = *(const GAS f32x4*)(gqr + l4 * 8), g1 = *(const GAS f32x4*)(gqr + l4 * 8 + 4);
              float x[8]; unpack8(rowp[128 + lane], x); float ss = 0.f;
#pragma unroll
              for (int j = 0; j < 8; ++j) ss += x[j] * x[j];
              ss += shx(ss, 1, F.lane); ss += shx(ss, 2, F.lane);
              const float r = 1.f / sqrtf(ss * (1.f / 32.f) + NORM_EPS);
              x[0] *= r * g0.x; x[1] *= r * g0.y; x[2] *= r * g0.z; x[3] *= r * g0.w; x[4] *= r * g1.x; x[5] *= r * g1.y; x[6] *= r * g1.z; x[7] *= r * g1.w;
              float px[8];
#pragma unroll
              for (int j = 0; j < 8; ++j) px[j] = shx(x[j], 1, F.lane);
              const int pos = (l4 & 2) ? pcol : prow; const float* cs = rt + pos * 8;
              const f32x4 c0 = *(const GAS f32x4*)(cs), c1 = *(const GAS f32x4*)(cs + 4), sa = *(const GAS f32x4*)(cs + 1024), sb = *(const GAS f32x4*)(cs + 1028);
              const float cc[8] = {c0.x, c0.y, c0.z, c0.w, c1.x, c1.y, c1.z, c1.w}, sn[8] = {sa.x, sa.y, sa.z, sa.w, sb.x, sb.y, sb.z, sb.w};
              const float sgn = (l4 & 1) ? 1.f : -1.f;
#pragma unroll
              for (int j = 0; j < 8; ++j) x[j] = (x[j] * cc[j] + sgn * px[j] * sn[j]) * qscale;
              rowp[128 + lane] = pack8(x); }
        }
    }
}

__device__ __forceinline__ void kr6_pass(Frame& F) {
    if (((const float*)(F.ws + WS_HPAR))[448] == 0.f) return;
    const bf16* KR = (const bf16*)(F.ws + WS_KR); unsigned char* K6R = (unsigned char*)(F.ws + WS_K6R);
    for (int r = F.vcu * (NWAVES * 64) + F.tid; r < MR; r += F.G * (NWAVES * 64)) {
        const GAS v4u* rp = (const GAS v4u*)(KR + (size_t)r * 32);
        v4u w[4] = {rp[0], rp[1], rp[2], rp[3]};
#pragma unroll
        for (int q = 0; q < 4; ++q) { float x[8]; unpack8(w[q], x);
#pragma unroll
            for (int j = 0; j < 8; ++j) x[j] *= 1.5349124f;
            w[q] = pack8(x); }
        const attd::u32x6 c = attd::to_fp6(w[0], w[1], w[2], w[3]);
        unsigned char* img = K6R + (size_t)(r >> 6) * 2048; const int key = r & 63;
        *(GAS v4u*)(img + key * 16) = (v4u){c[0], c[1], c[2], c[3]}; *(GAS v2u*)(img + 1024 + key * 8) = (v2u){c[4], c[5]};
    }
}
__device__ __forceinline__ void attn0_phase(Frame& F) {
    att::lchar* lds = (att::lchar*)(F.lds + RING_OFF);
    const att::bf16* QKV = (const att::bf16*)(F.ws + WS_QKV); att::bf16* O = (att::bf16*)(F.ws + WS_O0);
    const bool fast = __builtin_amdgcn_readfirstlane(__builtin_bit_cast(int, ((const float*)(F.ws + WS_HPAR))[449])) != 0;
    const char* K6E = (const char*)(F.ws + WS_K6E);
    char* shm = (char*)(F.lds + RING_OFF);
    for (int ui = F.vcu; ui < 1056; ui += F.G) {
        if (ui < 512) {
            const int b = ui >> 8, h = (ui >> 5) & 7, R4 = ui & 31;
            const float* rpb = ARG(17) + h * 465;
            if (fast) {
                float* rl = (float*)(shm + attf::LDS_RPB);
                for (int i = F.tid; i < 465; i += NWAVES * 64) rl[i] = rpb[i] * att::LOG2E;
                __syncthreads();
                attf::FNa fu; fu.init((const attf::bf16*)QKV, (attf::bf16*)O, rl, b, h, R4, K6E);
                attf::fast_unit<8, attf::FNa, true>(fu, shm, F.tid);
            } else {
                att::UNa u; u.QKV = QKV; u.O = O; u.rpbl = (const LAS float*)(lds + att::L_RPB); u.b = b; u.h = h; u.R4 = R4; u.init();
                for (int i = F.tid; i < 465; i += NWAVES * 64) ((LAS float*)(lds + att::L_RPB))[i] = rpb[i] * att::LOG2E;
                att::unit<8, att::UNa>(u, lds, F.tid);
            }
        } else if (ui < 1024) {
            const int v = ui - 512;
            if (fast) { attf::FWin fu; fu.init((const attf::bf16*)QKV, (attf::bf16*)O, ARG(14), v >> 8, (v >> 2) & 63, (v >> 1) & 1, v & 1, K6E); attf::fast_unit<8, attf::FWin, true>(fu, shm, F.tid); }
            else { att::UWin u; u.QKV = QKV; u.O = O; u.sinkp = ARG(14); u.b = v >> 8; u.n = (v >> 2) & 63; u.g = (v >> 1) & 1; u.hh = v & 1; u.init(); att::unit<8, att::UWin>(u, lds, F.tid); }
        } else {
            const int v = ui - 1024;
            if (fast) { attf::FCtx fu; fu.init((const attf::bf16*)QKV, (attf::bf16*)O, ARG(14), v >> 4, v & 15, K6E); attf::fast_unit<8, attf::FCtx, true>(fu, shm, F.tid); }
            else { att::UCtx u; u.QKV = QKV; u.O = O; u.sinkp = ARG(14); u.b = v >> 4; u.hx = v & 15; u.init(); att::unit<8, att::UCtx>(u, lds, F.tid); }
        }
    }
}
__device__ __forceinline__ void attn1_phase(Frame& F) {
    att::lchar* lds = (att::lchar*)(F.lds + RING_OFF);
    const bool fast = __builtin_amdgcn_readfirstlane(__builtin_bit_cast(int, ((const float*)(F.ws + WS_HPAR))[448])) != 0;
    const bool g256 = F.G == 256; const int x = F.vcu >> 5, j = F.vcu & 31;
    const int nit = g256 ? 4 : (F.vcu < 1024 ? (1024 - F.vcu + F.G - 1) / F.G : 0);
    for (int i = 0; i < nit; ++i) {
        const int ui = g256 ? ((x * 4 + i) * 32 + j) : F.vcu + i * F.G;
        if (fast) attd::dense_unit(ui >> 9, (ui >> 5) & 15, ui & 31, (const attd::bf16*)(F.ws + WS_Q1), (const attd::bf16*)(F.ws + WS_KV1), (const char*)(F.ws + WS_K6N), (const char*)(F.ws + WS_K6R), (attd::bf16*)(F.ws + WS_O1), (char*)(F.lds + RING_OFF), F.tid);
        else {
        att::UDense u; u.Q = (const att::bf16*)(F.ws + WS_Q1); u.KV = (const att::bf16*)(F.ws + WS_KV1); u.KR = (const att::bf16*)(F.ws + WS_KR); u.O = (att::bf16*)(F.ws + WS_O1);
        u.b = ui >> 9; u.h = (ui >> 5) & 15; u.qb = ui & 31;
        att::unit<12, att::UDense>(u, lds, F.tid); }
    }
}

#ifndef PHASE_MASK
#define PHASE_MASK 0xFFFFFu
#endif
#ifndef PHASE_REP
#define PHASE_REP 0u
#endif
struct Args { const float* in[28]; float* out; unsigned char* ws; int ph_lo, ph_hi; };
constexpr int N_PHASES = 19;
__global__ void __launch_bounds__(NWAVES * 64, 2) fwd_kernel(Args args) {
    extern __shared__ __attribute__((aligned(16))) unsigned char lds[];
    for (int u = threadIdx.x; u < (LDS_BYTES - LDSCTL_OFF) / 4; u += NWAVES * 64) ((LAS unsigned*)((LAS unsigned char*)lds + LDSCTL_OFF))[u] = 0u;
    __syncthreads();
    if (!MK_PER_PHASE) (void)xcd_barrier_post((unsigned*)((gu32*)(ARG_WS + WS_CTL) + CW_BAR), (volatile LAS unsigned*)((LAS unsigned char*)lds + MISC_OFF) + 8);
    for (int ph2 = 2 * args.ph_lo; ph2 < 2 * args.ph_hi; ++ph2) {
        const int ph = ph2 >> 1; if ((ph2 & 1) && !((PHASE_REP >> ph) & 1)) continue;
        if (ph == 3 || ph == 14) continue;
        Frame F;
        { int t_ = threadIdx.x; asm volatile("" : "+v"(t_)); int b_ = blockIdx.x; asm volatile("" : "+s"(b_)); int g_ = gridDim.x; asm volatile("" : "+s"(g_)); F.tid = t_; F.bx = b_; F.G = g_; }
        F.lds = (LAS unsigned char*)lds; F.MISC = (volatile LAS unsigned*)(F.lds + MISC_OFF);
        F.lane = F.tid & 63; F.wave = __builtin_amdgcn_readfirstlane(F.tid >> 6);
        F.vcu = (F.G % 8 == 0) ? (F.bx % 8) * (F.G / 8) + F.bx / 8 : F.bx;
        F.ws = ARG_WS; F.out = ARG_OUT; F.ctl = (gu32*)(F.ws + WS_CTL);
        XcdBarrier bar; bar.bar = (unsigned*)(F.ctl + CW_BAR); bar.x = xb_xcc_id(); bar.st = F.MISC + 8;
        float* ctxres = (float*)(F.ws + WS_CTXRES);
        const float* mod = (const float*)(F.ws + WS_MOD);
        int gk = 0, xrows = 0, xS = 0;
        pg8::Gemm g{nullptr, nullptr, 0, 0, 0}; pg8::EpiAny ea{0, nullptr, nullptr, nullptr, nullptr, 0, 0};
        switch (ph) {
        case 0: if (!((PHASE_MASK >> 0) & 1)) break; p0_prologue(F); break;
        case 1: if (!((PHASE_MASK >> 1) & 1)) break; norm_phase(F, ARG(0), ARG(2), MR, ARG(6), 0, 0, true); break;
        case 2: if (!((PHASE_MASK >> 2) & 1)) break; gk = 1; g = pg8::Gemm{(const bf16*)(F.ws + WS_XN), (const bf16*)(F.ws + WS_WQKV), MR, NQKV, DM}; ea = pg8::EpiAny{3, (const float*)(F.ws + WS_HPAR), (void*)(F.ws + WS_QKV), (float*)(F.ws + WS_K6E), (const float*)(F.ws + WS_ROPEP), NQKV, 0}; break;
        case 4: if (!((PHASE_MASK >> 4) & 1)) break; attn0_phase(F); break;
        case 5: if (!((PHASE_MASK >> 5) & 1)) break; gk = 2; g = pg8::Gemm{(const bf16*)(F.ws + WS_O0), (const bf16*)(F.ws + WS_WO0), ML, DM, DM}; xrows = MC; xS = 2; ea = pg8::EpiAny{2, ARG(0), (void*)F.out, (float*)(F.ws + WS_PART5), mod + 2048, 0, 2}; break;
        case 6: if (!((PHASE_MASK >> 6) & 1)) break; norm_phase(F, F.out, ctxres, MR, ARG(7), 0, 1, false, (const float*)(F.ws + WS_PART5), 4, true); break;
        case 7: if (!((PHASE_MASK >> 7) & 1)) break; gk = 1; g = pg8::Gemm{(const bf16*)(F.ws + WS_XN), (const bf16*)(F.ws + WS_W1_0), MR, FF, DM}; ea = pg8::EpiAny{1, nullptr, (void*)(F.ws + WS_H), nullptr, nullptr, FF, 1}; break;
        case 8: if (!((PHASE_MASK >> 8) & 1)) break; gk = 2; g = pg8::Gemm{(const bf16*)(F.ws + WS_H), (const bf16*)(F.ws + WS_W2_0), ML, DM, FF}; xrows = MC; xS = 4; ea = pg8::EpiAny{2, F.out, (void*)F.out, (float*)(F.ws + WS_PART8), mod + 5120, 0, 3}; break;
        case 9: if (!((PHASE_MASK >> 9) & 1)) break; norm_phase(F, F.out, ctxres, MR, ARG(6) + DM, 1, 0, false, (const float*)(F.ws + WS_PART8), 16, true); break;
        case 10: if (!((PHASE_MASK >> 10) & 1)) break; gk = 1; g = pg8::Gemm{(const bf16*)(F.ws + WS_XN), (const bf16*)(F.ws + WS_WIN), MR, NCIN, DM}; ea = pg8::EpiAny{1, nullptr, (void*)(F.ws + WS_CQKV), nullptr, nullptr, NCIN, 0}; break;
        case 11: if (!((PHASE_MASK >> 11) & 1)) break; cnorm_phase(F); break;
        case 12: if (!((PHASE_MASK >> 12) & 1)) break; kr6_pass(F); gk = 1; g = pg8::Gemm{(const bf16*)(F.ws + WS_CQN), (const bf16*)(F.ws + WS_WUQ), ML, NUQ, 384}; ea = pg8::EpiAny{3, (const float*)(F.ws + WS_HPAR), (void*)(F.ws + WS_Q1), nullptr, (const float*)(F.ws + WS_ROPEP), NUQ, 1}; break;
        case 13: if (!((PHASE_MASK >> 13) & 1)) break; gk = 1; g = pg8::Gemm{(const bf16*)(F.ws + WS_CKVN), (const bf16*)(F.ws + WS_WUKV), MR, NUKV, 256}; ea = pg8::EpiAny{3, (const float*)(F.ws + WS_HPAR), (void*)(F.ws + WS_KV1), (float*)(F.ws + WS_K6N), (const float*)(F.ws + WS_ROPEP), NUKV, 2}; break;
        case 15: if (!((PHASE_MASK >> 15) & 1)) break; attn1_phase(F); break;
        case 16: if (!((PHASE_MASK >> 16) & 1)) break; gk = 2; g = pg8::Gemm{(const bf16*)(F.ws + WS_O1), (const bf16*)(F.ws + WS_WO1), ML, DM, DM}; ea = pg8::EpiAny{2, F.out, (void*)(F.ws + WS_XR), ctxres, mod + 3 * 6144 + 2048, 0, 3}; break;
        case 17: if (!((PHASE_MASK >> 17) & 1)) break; norm_phase(F, (const float*)(F.ws + WS_XR), ctxres, ML, ARG(7) + DM, 1, 1, false, nullptr, 0, true); break;
        case 18: if (!((PHASE_MASK >> 18) & 1)) break; gk = 1; g = pg8::Gemm{(const bf16*)(F.ws + WS_XN), (const bf16*)(F.ws + WS_W1_1), ML, FF, DM}; ea = pg8::EpiAny{1, nullptr, (void*)(F.ws + WS_H), nullptr, nullptr, FF, 1}; break;
        case 19: if (!((PHASE_MASK >> 19) & 1)) break; gk = 2; g = pg8::Gemm{(const bf16*)(F.ws + WS_H), (const bf16*)(F.ws + WS_W2_1), ML, DM, FF}; ea = pg8::EpiAny{2, (const float*)(F.ws + WS_XR), (void*)F.out, ctxres, mod + 3 * 6144 + 5120, 0, 1}; break;
        default: break;
        }
        ea.scr = F.lds + LDSCTL_OFF + 4096;
        if (gk != 0) { pg8::StaticOrder S; S.init(g.M, g.N, g.K, F.G, F.bx, xrows, xS); pg8::gemm_phase<pg8::EpiAny, pg8::StaticOrder, true, true>(F.lds + RING_OFF, g, S, ea, F.tid); }
        const bool last_ = (ph == args.ph_hi - 1) && ((ph2 & 1) || !((PHASE_REP >> ph) & 1));
        if (!MK_PER_PHASE && !last_ && ph != 12) xcd_barrier(bar);
        else __syncthreads();
    }
}

extern "C" void kernel_launch(void* const* d_in, const int* in_sizes, int n_in, void* d_out, int out_size, void* d_ws, size_t ws_size, hipStream_t stream) {
    static int grid = 0;
    if (grid == 0) {
        if (n_in != 28 || in_sizes[0] != ML * DM || out_size != ML * DM || ws_size < WS_END) { fprintf(stderr, "kernel_launch: unexpected shapes: n_in %d in0 %d out %d ws %zu\n", n_in, n_in > 0 ? in_sizes[0] : -1, out_size, ws_size); grid = -1; return; }
        int dev = 0, cus = 0, per_cu = 0;
        if (hipGetDevice(&dev) != hipSuccess || hipDeviceGetAttribute(&cus, hipDeviceAttributeMultiprocessorCount, dev) != hipSuccess) { fprintf(stderr, "kernel_launch: device query failed\n"); grid = -1; return; }
        if (hipFuncSetAttribute((const void*)fwd_kernel, hipFuncAttributeMaxDynamicSharedMemorySize, LDS_BYTES) != hipSuccess) { fprintf(stderr, "kernel_launch: hipFuncSetAttribute failed\n"); grid = -1; return; }
        if (hipOccupancyMaxActiveBlocksPerMultiprocessor(&per_cu, (const void*)fwd_kernel, NWAVES * 64, LDS_BYTES) != hipSuccess || per_cu < 1)
            fprintf(stderr, "kernel_launch: note: occupancy query reports %d workgroups per CU\n", per_cu);
        (void)hipGetLastError();
        grid = cus;
    }
    if (grid < 0) return;
    if (hipMemsetAsync((char*)d_ws + WS_CTL, 0, CTL_ZERO_BYTES, stream) != hipSuccess) { fprintf(stderr, "kernel_launch: hipMemsetAsync failed\n"); return; }
    Args a{};
    for (int i = 0; i < 28; ++i) a.in[i] = (const float*)d_in[i];
    a.out = (float*)d_out; a.ws = (unsigned char*)d_ws;
#if MK_PER_PHASE
    for (int ph = 0; ph <= N_PHASES; ++ph) { a.ph_lo = ph; a.ph_hi = ph + 1; hipLaunchKernelGGL(fwd_kernel, dim3(grid), dim3(NWAVES * 64), LDS_BYTES, stream, a); }
#else
    a.ph_lo = 0; a.ph_hi = N_PHASES + 1;
    hipLaunchKernelGGL(fwd_kernel, dim3(grid), dim3(NWAVES * 64), LDS_BYTES, stream, a);
#endif
    const hipError_t le = hipPeekAtLastError();
    if (le != hipSuccess) fprintf(stderr, "kernel_launch: launch failed: %s\n", hipGetErrorName(le));
}
```

```cpp
#include <hip/hip_runtime.h>
#include <cstdio>
#include <cstdint>
namespace pg8 {
#define PG8_LAS __attribute__((address_space(3)))
typedef unsigned short bf16_t;
typedef short bf16x8 __attribute__((ext_vector_type(8)));
typedef float f32x4 __attribute__((ext_vector_type(4)));
typedef unsigned u32x4 __attribute__((ext_vector_type(4)));
typedef unsigned u32x2 __attribute__((ext_vector_type(2)));
typedef unsigned u32x6 __attribute__((ext_vector_type(6)));
typedef unsigned u32x16 __attribute__((ext_vector_type(16)));
typedef __bf16 bf16x32 __attribute__((ext_vector_type(32)));
constexpr int BM = 256, BK = 64, HALF = 128, HTB = HALF * BK * 2  , STAGE_BYTES = 8 * HTB, NXCD = 8, WGM = 8;

__host__ __device__ __forceinline__ int lds_byte(int r, int c) { const int st = (r >> 4) * 2 + (c >> 5), rr = r & 15, cc = c & 31, ob = rr * 64 + cc * 2; return st * 1024 + (ob ^ (((ob >> 9) & 1) << 5)); }
__host__ __device__ __forceinline__ void stage_rc(int b, int& R, int& C) { const int st = b / 1024, sb = b % 1024, swz = sb ^ (((sb >> 9) & 1) << 5); R = (st >> 1) * 16 + swz / 64; C = (st & 1) * 32 + (swz % 64) / 2; }
__host__ __device__ __forceinline__ int perm32(int rho) { const int n = rho >> 4, i = rho & 15; return 8 * (i >> 2) + 4 * n + (i & 3); }

struct Unit { int pm, pn, kinfo; };
struct Gemm { const bf16_t* A; const bf16_t* Bt; int M, N, K; int mx = 0; };

struct StaticOrder {
    int nM, nN, nwg, G, c, ntK;
    int xtiles, xsh;
    __host__ __device__ void init(int M, int N, int K, int G_, int c_, int extra_rows = 0, int S = 1) { nM = M / BM; nN = N / BM; nwg = nM * nN; G = G_; c = c_; ntK = K / BK;
        xtiles = (extra_rows / BM) * nN; xsh = S; }
    __host__ __device__ bool next(int i, Unit& u) const {
        const long L = (long)i * G + c;
        if (L >= nwg) {
            if (xtiles == 0) return false;
            const int nb = (nwg - c + G - 1) / G;
            const int nbc = c < nwg ? nb : 0;
            const long e = (long)(i - nbc) * G + ((c + G - (nwg % G)) % G);
            if (e >= ((long)xtiles << xsh)) return false;
            const int tile = (int)(e >> xsh), ks = (int)e & ((1 << xsh) - 1), xnt = ntK >> xsh;
            u.pm = nM + tile / nN; u.pn = tile % nN; u.kinfo = (ks * xnt) | (xnt << 8) | (1 << 16); return true;
        }
        int wgid = (int)L; { const int q = nwg / NXCD, r = nwg % NXCD, xcd = wgid % NXCD, off = wgid / NXCD; wgid = (xcd < r ? xcd * (q + 1) : r * (q + 1) + (xcd - r) * q) + off; }
        const int nig = WGM * nN, gid = wgid / nig, fm = gid * WGM, gsz = (nM - fm) < WGM ? (nM - fm) : WGM;
        u.pm = fm + ((wgid % nig) % gsz); u.pn = (wgid % nig) / gsz; u.kinfo = ntK << 8; return true;
    }
    __device__ __forceinline__ void a_ready(const Unit&) const {}
    __device__ __forceinline__ void done(const Unit&) const {}
};

__device__ __forceinline__ unsigned cvt_pk_bf16(float lo, float hi) { unsigned r; asm volatile("v_cvt_pk_bf16_f32 %0, %1, %2" : "=v"(r) : "v"(lo), "v"(hi)); return r; }
__device__ __forceinline__ u32x2 pk4bf(f32x4 y) { u32x2 r; r.x = cvt_pk_bf16(y[0], y[1]); r.y = cvt_pk_bf16(y[2], y[3]); return r; }
__device__ __forceinline__ f32x4 unpk4bf(u32x2 w) { f32x4 r; r[0] = __builtin_bit_cast(float, w.x << 16); r[1] = __builtin_bit_cast(float, w.x & 0xffff0000u); r[2] = __builtin_bit_cast(float, w.y << 16); r[3] = __builtin_bit_cast(float, w.y & 0xffff0000u); return r; }
struct EpiAny {
    static constexpr bool AFTER_DRAIN = false;
    int mode; const float* base; void* out; float* ctxres; const float* gate; int ldc, relu2; PG8_LAS unsigned char* scr = nullptr;
    __device__ __forceinline__ bool perm() const { return mode == 1; }
    __device__ __forceinline__ bool headmode() const { return mode == 3; }
    __device__ __forceinline__ static float xsh(float v, int mask, int lane) { return __builtin_bit_cast(float, __builtin_amdgcn_ds_bpermute((lane ^ mask) << 2, __builtin_bit_cast(int, v))); }
    __device__ __forceinline__ void head_epilogue(const f32x4 (&acc)[2][2][4][2], const Unit& u, int wr, int wc, int fr, int fq) const {
        const int H = 4 * u.pn + wc, kind = relu2, lane = fr + 16 * fq;
        const bool f6 = kind != 0 && base[448] != 0.f;
        const bool f6e = kind == 0 && base[449] != 0.f;
        int cls, gsel; float qs = 1.f;
        if (kind == 0) { const float qq = f6e ? 1.6986436f : 0.125f * 1.4426950408889634f, kq = f6e ? 1.6986436f : 1.f;
                         if (H < 8) { cls = 2; gsel = 0; qs = qq; } else if (H < 10) { cls = 2; gsel = 1; qs = kq; } else if (H < 12) { cls = 0; gsel = 0; }
                         else if (H < 20) { cls = 1; gsel = 2; qs = qq; } else if (H < 28) { cls = 1; gsel = 3; qs = kq; } else { cls = 0; gsel = 0; } }
        else if (kind == 1) { qs = f6 ? 1.5349124f : 0.10206207261596575f * 1.4426950408889634f; if (H < 16) { cls = 1; gsel = 4; } else { cls = 3; gsel = 5; } }
        else { if (H < 16) { cls = 1; gsel = 6; if (f6) qs = 1.5349124f; } else { cls = 0; gsel = 0; } }
        const bool lat = u.pm < 64;
        const bool k6e = f6e && (H == 8 || H == 9 || (H >= 20 && H < 28));
        const bool k6 = (f6 && kind == 2 && H < 16) || k6e;
        bf16_t* O = (bf16_t*)out;
        const int col0 = u.pn * BM + 64 * wc + 8 * fq;
        f32x4 gv[2][2];
#pragma unroll
        for (int bj = 0; bj < 2; ++bj)
#pragma unroll
            for (int n = 0; n < 2; ++n) gv[bj][n] = *(const f32x4*)(base + gsel * 64 + 32 * bj + 8 * fq + 4 * n);
#pragma unroll
        for (int ai = 0; ai < 2; ++ai)
#pragma unroll
            for (int m = 0; m < 4; ++m) {
                const int row = u.pm * BM + ai * HALF + wr * 64 + m * 16 + fr;
                f32x4 v[2][2];
#pragma unroll
                for (int bj = 0; bj < 2; ++bj)
#pragma unroll
                    for (int n = 0; n < 2; ++n) v[bj][n] = acc[ai][bj][m][n];
                if (cls != 0) {
                    float s0 = 0.f, s1 = 0.f;
#pragma unroll
                    for (int n = 0; n < 2; ++n)
#pragma unroll
                        for (int e = 0; e < 4; ++e) { s0 += v[0][n][e] * v[0][n][e]; s1 += v[1][n][e] * v[1][n][e]; }
                    if (cls != 3) { s0 += s1; s0 += xsh(s0, 16, lane); s0 += xsh(s0, 32, lane); s0 = s0 * (1.f / 64.f); s1 = s0; }
                    else { s0 += xsh(s0, 16, lane); s0 += xsh(s0, 32, lane); s1 += xsh(s1, 16, lane); s1 += xsh(s1, 32, lane); s0 *= (1.f / 32.f); s1 *= (1.f / 32.f); }
                    const float r0 = 1.f / sqrtf(s0 + 1e-6f), r1 = 1.f / sqrtf(s1 + 1e-6f);
#pragma unroll
                    for (int n = 0; n < 2; ++n) { v[0][n] = v[0][n] * r0 * gv[0][n]; v[1][n] = v[1][n] * r1 * gv[1][n]; }
                    if (lat && cls == 2) {
                        const int t = row & 8191;
                        u32x4 cw[2][2]; const float sgn = fq < 2 ? -1.f : 1.f;
#pragma unroll
                        for (int bj = 0; bj < 2; ++bj) { const int pos = bj == 0 ? (t >> 6) : (t & 63);
#pragma unroll
                            for (int n = 0; n < 2; ++n) cw[bj][n] = *(const u32x4*)((const unsigned*)gate + pos * 16 + 8 * (fq & 1) + 4 * n); }
#pragma unroll
                        for (int bj = 0; bj < 2; ++bj)
#pragma unroll
                            for (int n = 0; n < 2; ++n) { f32x4 p, c, sn;
#pragma unroll
                                for (int e = 0; e < 4; ++e) { p[e] = xsh(v[bj][n][e], 32, lane); c[e] = __builtin_bit_cast(float, cw[bj][n][e] << 16); sn[e] = __builtin_bit_cast(float, cw[bj][n][e] & 0xffff0000u); }
                                v[bj][n] = v[bj][n] * c + (p * sgn) * sn; }
                    }
                    if (lat && cls == 3) {
                        const int t = row & 8191; const int pos = fq < 2 ? (t >> 6) : (t & 63); const float sgn = (fq & 1) ? 1.f : -1.f;
                        u32x4 cw[2];
#pragma unroll
                        for (int n = 0; n < 2; ++n) cw[n] = *(const u32x4*)((const unsigned*)gate + 2048 + pos * 8 + 4 * n);
#pragma unroll
                        for (int bj = 0; bj < 2; ++bj)
#pragma unroll
                            for (int n = 0; n < 2; ++n) { f32x4 p, c, sn;
#pragma unroll
                                for (int e = 0; e < 4; ++e) { p[e] = xsh(v[bj][n][e], 16, lane); c[e] = __builtin_bit_cast(float, cw[n][e] << 16); sn[e] = __builtin_bit_cast(float, cw[n][e] & 0xffff0000u); }
                                v[bj][n] = v[bj][n] * c + (p * sgn) * sn; }
                    }
                    if (qs != 1.f) {
#pragma unroll
                        for (int bj = 0; bj < 2; ++bj)
#pragma unroll
                            for (int n = 0; n < 2; ++n) v[bj][n] = v[bj][n] * qs; }
                }
                if (k6) {
                    PG8_LAS unsigned char* sw = scr + (wr * 4 + wc) * 1024 + fr * 64;
                    unsigned char* img = (unsigned char*)ctxres + (k6e ? ((size_t)(row >> 6) * 10 + (H < 10 ? H - 8 : H - 18)) : ((size_t)(row >> 6) * 16 + H)) * 3072;
                    const int key = row & 63;
#pragma unroll
                    for (int bj = 0; bj < 2; ++bj) {
                        u32x4 w; w.x = cvt_pk_bf16(v[bj][0][0], v[bj][0][1]); w.y = cvt_pk_bf16(v[bj][0][2], v[bj][0][3]); w.z = cvt_pk_bf16(v[bj][1][0], v[bj][1][1]); w.w = cvt_pk_bf16(v[bj][1][2], v[bj][1][3]);
                        *(PG8_LAS u32x4*)(sw + fq * 16) = w;
                        asm volatile("s_waitcnt lgkmcnt(0)" ::: "memory");
                        if (fq == 0) {
                            const u32x4 a0 = *(PG8_LAS u32x4*)(sw), a1 = *(PG8_LAS u32x4*)(sw + 16), a2 = *(PG8_LAS u32x4*)(sw + 32), a3 = *(PG8_LAS u32x4*)(sw + 48);
                            const u32x16 all = {a0.x, a0.y, a0.z, a0.w, a1.x, a1.y, a1.z, a1.w, a2.x, a2.y, a2.z, a2.w, a3.x, a3.y, a3.z, a3.w};
                            const u32x6 c = __builtin_amdgcn_cvt_scalef32_pk32_fp6_bf16(__builtin_bit_cast(bf16x32, all), 1.0f);
                            *(u32x4*)(img + bj * 1024 + key * 16) = (u32x4){c[0], c[1], c[2], c[3]};
                            *(u32x2*)(img + 2048 + bj * 512 + key * 8) = (u32x2){c[4], c[5]};
                        }
                        asm volatile("s_waitcnt lgkmcnt(0)" ::: "memory");
                    }
                    continue;
                }
                bf16_t* rowp = O + (size_t)row * ldc + col0;
#pragma unroll
                for (int bj = 0; bj < 2; ++bj) { u32x4 w; w.x = cvt_pk_bf16(v[bj][0][0], v[bj][0][1]); w.y = cvt_pk_bf16(v[bj][0][2], v[bj][0][3]); w.z = cvt_pk_bf16(v[bj][1][0], v[bj][1][1]); w.w = cvt_pk_bf16(v[bj][1][2], v[bj][1][3]);
                    *(u32x4*)(rowp + 32 * bj) = w; }
            }
    }
    __device__ __forceinline__ void operator()(const f32x4 (&acc)[2][2][4][2], const Unit& u, int wr, int wc, int fr, int fq) const {
        asm volatile("" : "+v"(fr), "+v"(fq));
        if (mode == 1) {
            bf16_t* O = (bf16_t*)out;
            const int row0 = u.pm * BM + wr * 64 + fr, col0 = u.pn * BM + wc * 32 + 8 * fq;
#pragma unroll
            for (int ai = 0; ai < 2; ++ai)
#pragma unroll
                for (int m = 0; m < 4; ++m) { bf16_t* rowp = O + (size_t)(row0 + ai * HALF + m * 16) * ldc + col0;
#pragma unroll
                    for (int bj = 0; bj < 2; ++bj) { f32x4 v0 = acc[ai][bj][m][0], v1 = acc[ai][bj][m][1];
                        if (relu2) {
#pragma unroll
                            for (int e = 0; e < 4; ++e) { float a = fmaxf(v0[e], 0.f), b = fmaxf(v1[e], 0.f); v0[e] = a * a; v1[e] = b * b; } }
                        u32x4 w; w.x = cvt_pk_bf16(v0[0], v0[1]); w.y = cvt_pk_bf16(v0[2], v0[3]); w.z = cvt_pk_bf16(v1[0], v1[1]); w.w = cvt_pk_bf16(v1[2], v1[3]);
                        *(u32x4*)(rowp + bj * HALF) = w; } }
            return;
        }
        if (mode == 3) { head_epilogue(acc, u, wr, wc, fr, fq); return; }
        const int t0 = u.pm * BM; const bool split = (u.kinfo >> 16) != 0; const int cond = t0 < 8192 ? 0 : (t0 < 16384 ? 1 : 2);
        const int col0 = u.pn * BM + wc * 32 + 4 * fq; const float* g = gate + cond * 6144 + col0;
        f32x4 gv[2][2];
#pragma unroll
        for (int bj = 0; bj < 2; ++bj)
#pragma unroll
            for (int n = 0; n < 2; ++n) gv[bj][n] = *(const f32x4*)(g + bj * HALF + n * 16);
        if (split) {
            const int ks = (u.kinfo & 255) / ((u.kinfo >> 8) & 255);
            float* op = ctxres + (size_t)ks * (512 * 1024) + (size_t)(t0 - 16384) * 1024;
#pragma unroll
            for (int ai = 0; ai < 2; ++ai)
#pragma unroll
                for (int m = 0; m < 4; ++m) { const size_t off = (size_t)(wr * 64 + fr + ai * HALF + m * 16) * 1024 + col0;
#pragma unroll
                    for (int bj = 0; bj < 2; ++bj)
#pragma unroll
                        for (int n = 0; n < 2; ++n) *(f32x4*)(op + off + bj * HALF + n * 16) = gv[bj][n] * acc[ai][bj][m][n]; }
            return;
        }
#define PG8_RES_LOOP(LOADB, STOREO) _Pragma("unroll") for (int ai = 0; ai < 2; ++ai) _Pragma("unroll") for (int m = 0; m < 4; ++m) { const size_t off = (size_t)(wr * 64 + fr + ai * HALF + m * 16) * 1024 + col0; \
            _Pragma("unroll") for (int bj = 0; bj < 2; ++bj) _Pragma("unroll") for (int n = 0; n < 2; ++n) { const size_t o2 = off + bj * HALF + n * 16; f32x4 b; LOADB; const f32x4 y = b + gv[bj][n] * acc[ai][bj][m][n]; STOREO; } }
        if (relu2 == 2) { const float* bp = base + (size_t)t0 * 1024; bf16_t* op = (bf16_t*)out + (size_t)t0 * 1024;
            PG8_RES_LOOP(b = *(const f32x4*)(bp + o2), *(u32x2*)(op + o2) = pk4bf(y)); }
        else if (relu2 == 3) { const bf16_t* bp = (const bf16_t*)base + (size_t)t0 * 1024; bf16_t* op = (bf16_t*)out + (size_t)t0 * 1024;
            PG8_RES_LOOP(const u32x2 w = *(const u32x2*)(bp + o2); b = unpk4bf(w), *(u32x2*)(op + o2) = pk4bf(y)); }
        else { const bf16_t* bp = (const bf16_t*)base + (size_t)t0 * 1024; float* op = (float*)out + (size_t)t0 * 1024;
            PG8_RES_LOOP(const u32x2 w = *(const u32x2*)(bp + o2); b = unpk4bf(w), *(f32x4*)(op + o2) = y); }
#undef PG8_RES_LOOP
    }
};

template <class Epi, class Sched, bool ALIGN_EPI = false, bool SP2 = false, bool MX8 = false>
__device__ __forceinline__ void gemm_phase(PG8_LAS unsigned char* lds, const Gemm g, const Sched& S, const Epi& E, const int tid) {
    const int wid = __builtin_amdgcn_readfirstlane(tid >> 6), lane = tid & 63, wr = wid >> 2, wc = wid & 3, fr = lane & 15, fq = lane >> 4;
    const int K = g.K;
    typedef int i32x4_t __attribute__((ext_vector_type(4)));
    int scw_ = 0x7a7a7a7a, sca_ = 0x7f7f7f7f; asm volatile("" : "+v"(scw_), "+v"(sca_));
    unsigned voffA[2], voffB[2];
#pragma unroll
    for (int i = 0; i < 2; ++i) { int R, C; stage_rc(tid * 16 + i * 8192, R, C); const int Rb = E.headmode() ? (64 * (R >> 5) + perm32(R & 31)) : (E.perm() ? ((R & ~31) + perm32(R & 31)) : R);
        voffA[i] = (unsigned)(R * K + C) * 2u; voffB[i] = (unsigned)(Rb * K + C) * 2u; }
    const size_t kstep = (size_t)(BK * 2);
    const size_t hstep = (size_t)HALF * K * 2;
    const size_t tstep = 2 * hstep;
    const size_t hstepB = E.headmode() ? (size_t)32 * K * 2 : hstep;
    const unsigned ldsw = (unsigned)wid * 1024u;
    const int aoff = lds_byte(wr * 64 + fr, fq * 8), boff = lds_byte(wc * 32 + fr, fq * 8);
#define PG8_SA(b, h) (((b) * 2 + (h)) * HTB)
#define PG8_SB(b, h) ((4 + (b) * 2 + (h)) * HTB)
    const unsigned ldsb = (unsigned)(uintptr_t)lds + ldsw;
#define PG8_STAGE(bufoff, gbase, voff) do { _Pragma("unroll") for (int _i = 0; _i < 2; ++_i) { unsigned keep_; \
        asm volatile("s_mov_b32 %0, m0\n\ts_mov_b32 m0, %3\n\ts_nop 0\n\tglobal_load_lds_dwordx4 %1, %2\n\ts_mov_b32 m0, %0" : "=&s"(keep_) : "v"((voff)[_i]), "s"((const char*)(gbase)), "s"(ldsb + (unsigned)((bufoff) + _i * 8192)) : "memory"); } } while (0)
#define PG8_LDA(dst, b, h) do { _Pragma("unroll") for (int m = 0; m < 4; ++m) _Pragma("unroll") for (int k = 0; k < 2; ++k) dst[m][k] = *(const PG8_LAS bf16x8*)(lds + PG8_SA(b, h) + aoff + m * 2048 + k * 1024); } while (0)
#define PG8_LDB(dst, b, h) do { _Pragma("unroll") for (int n = 0; n < 2; ++n) _Pragma("unroll") for (int k = 0; k < 2; ++k) dst[n][k] = *(const PG8_LAS bf16x8*)(lds + PG8_SB(b, h) + boff + n * 2048 + k * 1024); } while (0)
#define PG8_CAT(x, y) __builtin_shufflevector(__builtin_bit_cast(i32x4_t, x), __builtin_bit_cast(i32x4_t, y), 0, 1, 2, 3, 4, 5, 6, 7)
#define PG8_MMA(ai, bj, At, Bt) do { __builtin_amdgcn_s_setprio(1); \
        if constexpr (MX8) { _Pragma("unroll") for (int m = 0; m < 4; ++m) _Pragma("unroll") for (int n = 0; n < 2; ++n) \
            acc[ai][bj][m][n] = __builtin_amdgcn_mfma_scale_f32_16x16x128_f8f6f4(PG8_CAT(Bt[n][0], Bt[n][1]), PG8_CAT(At[m][0], At[m][1]), acc[ai][bj][m][n], 0, 0, 0, scw_, 0, sca_); } \
        else { _Pragma("unroll") for (int m = 0; m < 4; ++m) _Pragma("unroll") for (int n = 0; n < 2; ++n) _Pragma("unroll") for (int k = 0; k < 2; ++k) \
            acc[ai][bj][m][n] = __builtin_amdgcn_mfma_f32_16x16x32_bf16(Bt[n][k], At[m][k], acc[ai][bj][m][n], 0, 0, 0); } \
        __builtin_amdgcn_s_setprio(0); } while (0)
#define PG8_WAIT_V(n) asm volatile("s_waitcnt vmcnt(" #n ")" ::: "memory")
#define PG8_WAIT_L(n) asm volatile("s_waitcnt lgkmcnt(" #n ")" ::: "memory")
#define PG8_BAR __builtin_amdgcn_s_barrier()
#define PG8_SCHED __builtin_amdgcn_sched_barrier(0)
    Unit cur, nxt; int ui = 0;
    if (!S.next(0, cur)) return;
    f32x4 acc[2][2][4][2];
#pragma unroll
    for (int a = 0; a < 2; ++a)
#pragma unroll
        for (int b = 0; b < 2; ++b)
#pragma unroll
            for (int m = 0; m < 4; ++m)
#pragma unroll
                for (int n = 0; n < 2; ++n) acc[a][b][m][n] = (f32x4){0.f, 0.f, 0.f, 0.f};
    bf16x8 At[4][2], B0[2][2], B1[2][2];
    const char* cA = (const char*)g.A + (size_t)cur.pm * tstep + (size_t)(cur.kinfo & 255) * (BK * 2); const char* cB = (const char*)g.Bt + (size_t)cur.pn * tstep + (size_t)(cur.kinfo & 255) * (BK * 2);
    S.a_ready(cur);
    if constexpr (SP2) {
        PG8_STAGE(PG8_SB(0, 0), cB, voffB); PG8_STAGE(PG8_SB(0, 1), cB + hstepB, voffB); PG8_STAGE(PG8_SA(0, 0), cA, voffA); PG8_STAGE(PG8_SA(0, 1), cA + hstep, voffA);
        if (wr == 1) PG8_BAR;
        PG8_WAIT_V(2); PG8_BAR;
        PG8_STAGE(PG8_SB(1, 0), cB + kstep, voffB); PG8_STAGE(PG8_SA(1, 0), cA + kstep, voffA); PG8_STAGE(PG8_SB(1, 1), cB + hstepB + kstep, voffB);
        PG8_WAIT_V(6); PG8_BAR;
    } else {
        PG8_STAGE(PG8_SB(0, 0), cB, voffB); PG8_STAGE(PG8_SA(0, 0), cA, voffA); PG8_STAGE(PG8_SB(0, 1), cB + hstepB, voffB); PG8_STAGE(PG8_SA(0, 1), cA + hstep, voffA);
        if (wr == 1) PG8_BAR;
        PG8_WAIT_V(4); PG8_BAR;
        PG8_STAGE(PG8_SB(1, 0), cB + kstep, voffB); PG8_STAGE(PG8_SA(1, 0), cA + kstep, voffA); PG8_STAGE(PG8_SB(1, 1), cB + hstepB + kstep, voffB);
        PG8_WAIT_V(6); PG8_BAR;
    }
    for (;;) {
        const bool has_next = S.next(ui + 1, nxt);
        const char* nA = has_next ? (const char*)g.A + (size_t)nxt.pm * tstep + (size_t)(nxt.kinfo & 255) * (BK * 2) : cA; const char* nB = has_next ? (const char*)g.Bt + (size_t)nxt.pn * tstep + (size_t)(nxt.kinfo & 255) * (BK * 2) : cB;
        const int nt = (cur.kinfo >> 8) & 255;
        for (int t = 0; t < nt; t += 2) {
            const bool last = (t == nt - 2);
            const char* a1 = cA + (size_t)(t + 1) * kstep;
            const char* a2 = last ? nA : cA + (size_t)(t + 2) * kstep; const char* b2 = last ? nB : cB + (size_t)(t + 2) * kstep;
            const char* a3 = a2 + kstep; const char* b3 = b2 + kstep;
            if (last && has_next) S.a_ready(nxt);
            if constexpr (SP2) {
            PG8_LDB(B0, 0, 0); PG8_LDB(B1, 0, 1); PG8_SCHED; PG8_LDA(At, 0, 0); PG8_STAGE(PG8_SA(1, 1), a1 + hstep, voffA);
            PG8_WAIT_V(8); PG8_WAIT_L(0); PG8_BAR; PG8_MMA(0, 0, At, B0); PG8_MMA(0, 1, At, B1); PG8_BAR; PG8_SCHED;
            PG8_LDA(At, 0, 1); PG8_STAGE(PG8_SB(0, 0), b2, voffB); PG8_STAGE(PG8_SB(0, 1), b2 + hstepB, voffB); PG8_STAGE(PG8_SA(0, 0), a2, voffA);
            PG8_WAIT_V(8); PG8_WAIT_L(0); PG8_BAR; PG8_MMA(1, 0, At, B0); PG8_MMA(1, 1, At, B1); PG8_BAR; PG8_SCHED;
            PG8_LDB(B0, 1, 0); PG8_LDB(B1, 1, 1); PG8_SCHED; PG8_LDA(At, 1, 0); PG8_STAGE(PG8_SA(0, 1), a2 + hstep, voffA);
            PG8_WAIT_V(8); PG8_WAIT_L(0); PG8_BAR; PG8_MMA(0, 0, At, B0); PG8_MMA(0, 1, At, B1); PG8_BAR; PG8_SCHED;
            PG8_LDA(At, 1, 1); PG8_STAGE(PG8_SB(1, 0), b3, voffB); PG8_STAGE(PG8_SB(1, 1), b3 + hstepB, voffB); PG8_STAGE(PG8_SA(1, 0), a3, voffA);
            PG8_WAIT_V(8); PG8_WAIT_L(0); PG8_BAR; PG8_MMA(1, 0, At, B0); PG8_MMA(1, 1, At, B1); PG8_BAR; PG8_SCHED;
            } else {
            PG8_LDB(B0, 0, 0); PG8_SCHED; PG8_LDA(At, 0, 0); PG8_STAGE(PG8_SA(1, 1), a1 + hstep, voffA);
            PG8_WAIT_L(8); PG8_BAR; PG8_WAIT_L(0); PG8_MMA(0, 0, At, B0); PG8_BAR; PG8_SCHED;
            PG8_LDB(B1, 0, 1); PG8_STAGE(PG8_SB(0, 0), b2, voffB);
            PG8_BAR; PG8_WAIT_L(0); PG8_MMA(0, 1, At, B1); PG8_BAR;
            PG8_LDA(At, 0, 1); PG8_STAGE(PG8_SA(0, 0), a2, voffA);
            PG8_BAR; PG8_WAIT_L(0); PG8_MMA(1, 0, At, B0); PG8_BAR; PG8_SCHED;
            PG8_STAGE(PG8_SB(0, 1), b2 + hstepB, voffB);
            PG8_WAIT_V(6); PG8_BAR; PG8_MMA(1, 1, At, B1); PG8_BAR;
            PG8_LDB(B0, 1, 0); PG8_SCHED; PG8_LDA(At, 1, 0); PG8_STAGE(PG8_SA(0, 1), a2 + hstep, voffA);
            PG8_WAIT_L(8); PG8_BAR; PG8_WAIT_L(0); PG8_MMA(0, 0, At, B0); PG8_BAR; PG8_SCHED;
            PG8_LDB(B1, 1, 1); PG8_STAGE(PG8_SB(1, 0), b3, voffB);
            PG8_BAR; PG8_WAIT_L(0); PG8_MMA(0, 1, At, B1); PG8_BAR;
            PG8_LDA(At, 1, 1); PG8_STAGE(PG8_SA(1, 0), a3, voffA);
            PG8_BAR; PG8_WAIT_L(0); PG8_MMA(1, 0, At, B0); PG8_BAR; PG8_SCHED;
            PG8_STAGE(PG8_SB(1, 1), b3 + hstepB, voffB);
            PG8_WAIT_V(6); PG8_BAR; PG8_MMA(1, 1, At, B1); PG8_BAR;
            }
        }
        if constexpr (ALIGN_EPI) { if (wr == 0) PG8_BAR; }
        if constexpr (!Epi::AFTER_DRAIN) { E(acc, cur, wr, wc, fr, fq); S.done(cur); }
        if (!has_next) break;
#pragma unroll
        for (int a = 0; a < 2; ++a)
#pragma unroll
            for (int b = 0; b < 2; ++b)
#pragma unroll
                for (int m = 0; m < 4; ++m)
#pragma unroll
                    for (int n = 0; n < 2; ++n) acc[a][b][m][n] = (f32x4){0.f, 0.f, 0.f, 0.f};
        cur = nxt; cA = nA; cB = nB; ++ui;
        if constexpr (ALIGN_EPI) { if (wr == 1) PG8_BAR; }
    }
    PG8_WAIT_V(0);
    if constexpr (!ALIGN_EPI) { if (wr == 0) PG8_BAR; }
    PG8_BAR;
    if constexpr (Epi::AFTER_DRAIN) { E.fused(acc, cur, wr, wc, fr, fq, lds, wid, lane); S.done(cur); }
#undef PG8_SA
#undef PG8_SB
#undef PG8_STAGE
#undef PG8_CAT
#undef PG8_LDA
#undef PG8_LDB
#undef PG8_MMA
#undef PG8_WAIT_V
#undef PG8_WAIT_L
#undef PG8_BAR
#undef PG8_SCHED
}
}
namespace att {
#define ATT_LAS __attribute__((address_space(3)))
typedef unsigned short bf16;
typedef short bf16x8 __attribute__((ext_vector_type(8)));
typedef short s16x4 __attribute__((ext_vector_type(4)));
typedef float f32x16 __attribute__((ext_vector_type(16)));
typedef unsigned u32x4 __attribute__((ext_vector_type(4)));
typedef ATT_LAS char lchar;
constexpr int KBUF = 12288, VBUF = 16384;
constexpr int L_K = 0, L_V = 2 * KBUF, L_WS = L_V + 2 * VBUF, L_RPB = L_WS + 2048, L_END = L_RPB + 2048;
constexpr float LOG2E = 1.4426950408889634f;
#define ATT_SBAR() __builtin_amdgcn_sched_barrier(0)
__device__ __forceinline__ int crow(int r, int hi) { return (r & 3) + 8 * (r >> 2) + 4 * hi; }
__device__ __forceinline__ unsigned cvtpk(float lo, float hi) { unsigned r; asm volatile("v_cvt_pk_bf16_f32 %0, %1, %2" : "=v"(r) : "v"(lo), "v"(hi)); return r; }
__device__ __forceinline__ int v_st(int k, int c) { const int kk = (k & ~0xC) | ((k & 4) << 1) | ((k & 8) >> 1); return ((kk >> 3) * 4 + (c >> 5)) * 512 + ((kk & 7) * 32 + (c & 31)) * 2; }
__device__ __forceinline__ int v_rd_base(int lane) { return ((lane & 3) << 3) | (((lane >> 2) & 3) << 6) | (((lane >> 4) & 1) << 5) | (((lane >> 5) & 1) << 8); }
constexpr int v_rd_off(int d0, int ks, int half) { return d0 * 512 + ks * 4096 + half * 2048; }
template <int OFF> __device__ __forceinline__ s16x4 tr_read(unsigned vb) {
  s16x4 r; asm volatile("ds_read_b64_tr_b16 %0, %1 offset:%2" : "=&v"(r) : "v"(vb), "i"(OFF) : "memory"); return r;
}
template <int D0> __device__ __forceinline__ void pv_one(f32x16& od, unsigned vb, bf16x8 pa0, bf16x8 pa1, bf16x8 pa2, bf16x8 pa3) {
  const s16x4 l0 = tr_read<v_rd_off(D0, 0, 0)>(vb), h0 = tr_read<v_rd_off(D0, 0, 1)>(vb), l1 = tr_read<v_rd_off(D0, 1, 0)>(vb), h1 = tr_read<v_rd_off(D0, 1, 1)>(vb);
  const s16x4 l2 = tr_read<v_rd_off(D0, 2, 0)>(vb), h2 = tr_read<v_rd_off(D0, 2, 1)>(vb), l3 = tr_read<v_rd_off(D0, 3, 0)>(vb), h3 = tr_read<v_rd_off(D0, 3, 1)>(vb);
  asm volatile("s_waitcnt lgkmcnt(0)" ::: "memory"); ATT_SBAR();
#define ATT_PK(L, H) (bf16x8){L[0], L[1], L[2], L[3], H[0], H[1], H[2], H[3]}
  od = __builtin_amdgcn_mfma_f32_32x32x16_bf16(pa0, ATT_PK(l0, h0), od, 0, 0, 0);
  od = __builtin_amdgcn_mfma_f32_32x32x16_bf16(pa1, ATT_PK(l1, h1), od, 0, 0, 0);
  od = __builtin_amdgcn_mfma_f32_32x32x16_bf16(pa2, ATT_PK(l2, h2), od, 0, 0, 0);
  od = __builtin_amdgcn_mfma_f32_32x32x16_bf16(pa3, ATT_PK(l3, h3), od, 0, 0, 0);
#undef ATT_PK
}

template <int DKC, class U>
__device__ __forceinline__ void unit(const U& u, lchar* lds, int tid) {
  asm volatile("" : "+v"(tid));
  const int lane = tid & 63, r32 = lane & 31, hi = lane >> 5;
  const int wid = __builtin_amdgcn_readfirstlane(tid >> 6);
  lchar* Kl = lds + L_K; lchar* Vl = lds + L_V;
  ATT_LAS float* ws = (ATT_LAS float*)(lds + L_WS) + wid * 64;
  bf16x8 qr[DKC / 2];
#pragma unroll
  for (int d0 = 0; d0 < DKC / 2; ++d0) qr[d0] = *(const bf16x8*)u.qptr(wid, r32, d0, hi);
  const int vrow = tid >> 3, vch = tid & 7, vst = v_st(vrow, vch * 8);
  const int krow0 = tid & 63, kch0 = tid >> 6;
  const bool k2 = (DKC > 8) && (tid < 64 * (DKC - 8));
  const unsigned vb0 = (unsigned)(uintptr_t)Vl + (unsigned)v_rd_base(lane);
  bf16x8 kst0, kst1 = {}, vstr;
  const int NT = u.nt();
#define ATT_SLOAD(t) do { const long R_ = u.krow(t); kst0 = *(const bf16x8*)u.kptr(R_ + krow0, kch0); if (k2) kst1 = *(const bf16x8*)u.kptr(R_ + krow0, 8 + kch0); \
    vstr = *(const bf16x8*)u.vptr(R_ + vrow, vch); } while (0)
#define ATT_SWRITE(b) do { *(ATT_LAS bf16x8*)(Kl + (b) * KBUF + kch0 * 1024 + krow0 * 16) = kst0; if (k2) *(ATT_LAS bf16x8*)(Kl + (b) * KBUF + (8 + kch0) * 1024 + krow0 * 16) = kst1; \
    *(ATT_LAS bf16x8*)(Vl + (b) * VBUF + vst) = vstr; } while (0)
  float m_reg = -1e30f, l_reg = 0.f; f32x16 o[2]; o[0] = f32x16{}; o[1] = f32x16{};
  ATT_SLOAD(0); ATT_SWRITE(0); __syncthreads();
  for (int t = 0; t < NT; ++t) {
    const int buf = t & 1;
    if (t + 1 < NT) ATT_SLOAD(t + 1);
    if (!u.skip(t, wid)) {
      f32x16 p0 = f32x16{}, p1 = f32x16{};
      { const lchar* kb = Kl + buf * KBUF + hi * 1024 + r32 * 16;
#pragma unroll
        for (int d0 = 0; d0 < DKC / 2; ++d0) {
          const bf16x8 b0 = *(const ATT_LAS bf16x8*)(kb + d0 * 2048);
          const bf16x8 b1 = *(const ATT_LAS bf16x8*)(kb + d0 * 2048 + 512);
          p0 = __builtin_amdgcn_mfma_f32_32x32x16_bf16(b0, qr[d0], p0, 0, 0, 0);
          p1 = __builtin_amdgcn_mfma_f32_32x32x16_bf16(b1, qr[d0], p1, 0, 0, 0); } }
      u.mask(p0, p1, t, wid, r32, hi);
      float pmax = p0[0];
#pragma unroll
      for (int r = 1; r < 16; ++r) pmax = fmaxf(pmax, p0[r]);
#pragma unroll
      for (int r = 0; r < 16; ++r) pmax = fmaxf(pmax, p1[r]);
      { auto rr = __builtin_amdgcn_permlane32_swap(__float_as_uint(pmax), __float_as_uint(pmax), false, false);
        pmax = fmaxf(__uint_as_float(rr[0]), __uint_as_float(rr[1])); }
      const float mn = fmaxf(m_reg, pmax);
      const float alpha = __builtin_amdgcn_exp2f(m_reg - mn);
      m_reg = mn;
#pragma unroll
      for (int r = 0; r < 16; ++r) { p0[r] = __builtin_amdgcn_exp2f(p0[r] - mn); p1[r] = __builtin_amdgcn_exp2f(p1[r] - mn); }
      float ps = 0.f;
#pragma unroll
      for (int r = 0; r < 16; ++r) ps += p0[r];
#pragma unroll
      for (int r = 0; r < 16; ++r) ps += p1[r];
      { auto rr = __builtin_amdgcn_permlane32_swap(__float_as_uint(ps), __float_as_uint(ps), false, false);
        ps = __uint_as_float(rr[0]) + __uint_as_float(rr[1]); }
      l_reg = l_reg * alpha + ps;
      if (__any(alpha < 1.f)) {
        if (hi == 0) ws[r32] = alpha;
        asm volatile("s_waitcnt lgkmcnt(0)" ::: "memory");
#pragma unroll
        for (int r = 0; r < 16; ++r) { const float a = ws[crow(r, hi)]; o[0][r] *= a; o[1][r] *= a; }
      }
      bf16x8 pa0, pa1, pa2, pa3;
#define ATT_PK4(P, BASE, OUT) do { unsigned a0 = cvtpk(P[BASE + 0], P[BASE + 1]), a1 = cvtpk(P[BASE + 2], P[BASE + 3]);   \
    unsigned b0 = cvtpk(P[BASE + 4], P[BASE + 5]), b1 = cvtpk(P[BASE + 6], P[BASE + 7]);                              \
    auto r0 = __builtin_amdgcn_permlane32_swap(a0, b0, false, false); auto r1 = __builtin_amdgcn_permlane32_swap(a1, b1, false, false); \
    u32x4 w = {r0[0], r1[0], r0[1], r1[1]}; OUT = __builtin_bit_cast(bf16x8, w); } while (0)
      ATT_PK4(p0, 0, pa0); ATT_PK4(p0, 8, pa1); ATT_PK4(p1, 0, pa2); ATT_PK4(p1, 8, pa3);
#undef ATT_PK4
      const unsigned vb = vb0 + (unsigned)(buf * VBUF);
      pv_one<0>(o[0], vb, pa0, pa1, pa2, pa3); pv_one<1>(o[1], vb, pa0, pa1, pa2, pa3);
    }
    if (t + 1 < NT) ATT_SWRITE(buf ^ 1);
    __syncthreads();
  }
#undef ATT_SLOAD
#undef ATT_SWRITE
  { const float sk = u.sink(wid); l_reg += __builtin_amdgcn_exp2f(sk - m_reg); }
  if (hi == 0) ws[r32] = l_reg;
  asm volatile("s_waitcnt lgkmcnt(0)" ::: "memory");
  float rli[16];
#pragma unroll
  for (int r = 0; r < 16; ++r) rli[r] = __builtin_amdgcn_rcpf(ws[crow(r, hi)]);
#pragma unroll
  for (int r = 0; r < 16; ++r) { bf16* op = u.orow(wid, crow(r, hi));
    op[r32] = (bf16)(cvtpk(o[0][r] * rli[r], 0.f) & 0xffffu); op[32 + r32] = (bf16)(cvtpk(o[1][r] * rli[r], 0.f) & 0xffffu); }
  asm volatile("s_waitcnt lgkmcnt(0)" ::: "memory");
}

constexpr int ROWS_LAT = 16384;
struct UWin {
  const bf16* QKV; bf16* O; const float* sinkp; int b, n, g, hh; int i0, cnt;
  __device__ __forceinline__ void init() { i0 = (n == 0) ? 2 : 0; cnt = (n == 0 || n == 63) ? 4 : 6; }
  __device__ __forceinline__ int nt() const { return 4 + cnt; }
  __device__ __forceinline__ int kpos0(int t) const { return 128 * (n - 1) + 64 * (i0 + t - 4); }
  __device__ __forceinline__ long krow(int t) const { return t < 4 ? (long)(ROWS_LAT + 256 * b + 64 * t) : (long)(8192 * b + kpos0(t)); }
  __device__ __forceinline__ const bf16* kptr(long row, int ch) const { return QKV + row * 2304 + 512 + 64 * g + ch * 8; }
  __device__ __forceinline__ const bf16* vptr(long row, int ch) const { return QKV + row * 2304 + 640 + 64 * g + ch * 8; }
  __device__ __forceinline__ int head(int wid) const { return 4 * g + 2 * hh + (wid >> 2); }
  __device__ __forceinline__ int qpos0(int wid) const { return 128 * n + 32 * (wid & 3); }
  __device__ __forceinline__ const bf16* qptr(int wid, int r32, int d0, int hi) const { return QKV + (long)(8192 * b + qpos0(wid) + r32) * 2304 + 64 * head(wid) + 16 * d0 + 8 * hi; }
  __device__ __forceinline__ bool skip(int t, int wid) const { if (t < 4) return false; const int k0 = kpos0(t), q0 = qpos0(wid); return (k0 + 63 < q0 - 128) || (k0 > q0 + 31 + 128); }
  __device__ __forceinline__ void mask(f32x16& p0, f32x16& p1, int t, int wid, int r32, int hi) const {
    if (t < 4) return;
    const int dq = kpos0(t) - (qpos0(wid) + r32);
#pragma unroll
    for (int r = 0; r < 16; ++r) { const int d = dq + crow(r, hi); if (d > 128 || d < -128) p0[r] = -INFINITY; if (d + 32 > 128 || d + 32 < -128) p1[r] = -INFINITY; }
  }
  __device__ __forceinline__ float sink(int wid) const { return sinkp[head(wid)] * LOG2E; }
  __device__ __forceinline__ bf16* orow(int wid, int row) const { return O + (long)(8192 * b + qpos0(wid) + row) * 1024 + 64 * head(wid); }
};
struct UNa {
  const bf16* QKV; bf16* O; const ATT_LAS float* rpbl; int b, h, R4; int krlo, nloc;
  __device__ __forceinline__ static int clampi(int v, int lo, int hi_) { return v < lo ? lo : (v > hi_ ? hi_ : v); }
  __device__ __forceinline__ void init() { krlo = clampi(4 * R4 - 4, 0, 120); const int krhi = clampi(4 * R4 - 1, 0, 120) + 7; nloc = krhi - krlo + 1; }
  __device__ __forceinline__ int nt() const { return 4 + nloc; }
  __device__ __forceinline__ long krow(int t) const { return t < 4 ? (long)(ROWS_LAT + 256 * b + 64 * t) : (long)(8192 * b + 64 * (krlo + t - 4)); }
  __device__ __forceinline__ const bf16* kptr(long row, int ch) const { return QKV + row * 2304 + 1280 + 64 * h + ch * 8; }
  __device__ __forceinline__ const bf16* vptr(long row, int ch) const { return QKV + row * 2304 + 1792 + 64 * h + ch * 8; }
  __device__ __forceinline__ int qrow(int wid) const { return 4 * R4 + (wid >> 1); }
  __device__ __forceinline__ const bf16* qptr(int wid, int r32, int d0, int hi) const { return QKV + (long)(8192 * b + 64 * qrow(wid) + 32 * (wid & 1) + r32) * 2304 + 768 + 64 * h + 16 * d0 + 8 * hi; }
  __device__ __forceinline__ bool skip(int t, int wid) const { if (t < 4) return false; const int kr = krlo + t - 4, w0 = clampi(qrow(wid) - 4, 0, 120); return kr < w0 || kr > w0 + 7; }
  __device__ __forceinline__ void mask(f32x16& p0, f32x16& p1, int t, int wid, int r32, int hi) const {
    if (t < 4) return;
    const int kr = krlo + t - 4, qc = 32 * (wid & 1) + r32, c0 = clampi(qc - 8, 0, 48);
    const ATT_LAS float* brow = rpbl + (kr - qrow(wid) + 7) * 31 + 15;
#pragma unroll
    for (int r = 0; r < 16; ++r) {
      { const int kc = crow(r, hi); const bool ok = kc >= c0 && kc < c0 + 16; const float bv = brow[clampi(kc - qc, -15, 15)]; p0[r] = ok ? p0[r] + bv : -INFINITY; }
      { const int kc = 32 + crow(r, hi); const bool ok = kc >= c0 && kc < c0 + 16; const float bv = brow[clampi(kc - qc, -15, 15)]; p1[r] = ok ? p1[r] + bv : -INFINITY; } }
  }
  __device__ __forceinline__ float sink(int) const { return -INFINITY; }
  __device__ __forceinline__ bf16* orow(int wid, int row) const { return O + (long)(8192 * b + 64 * qrow(wid) + 32 * (wid & 1) + row) * 1024 + 512 + 64 * h; }
};
struct UCtx {
  const bf16* QKV; bf16* O; const float* sinkp; int b, hx; int qcol, kcol, vcol, ocol;
  __device__ __forceinline__ void init() { if (hx < 8) { qcol = 64 * hx; kcol = 512 + 64 * (hx >> 2); vcol = 640 + 64 * (hx >> 2); ocol = 64 * hx; }
    else { const int h = hx - 8; qcol = 768 + 64 * h; kcol = 1280 + 64 * h; vcol = 1792 + 64 * h; ocol = 512 + 64 * h; } }
  __device__ __forceinline__ int nt() const { return 4; }
  __device__ __forceinline__ long krow(int t) const { return (long)(ROWS_LAT + 256 * b + 64 * t); }
  __device__ __forceinline__ const bf16* kptr(long row, int ch) const { return QKV + row * 2304 + kcol + ch * 8; }
  __device__ __forceinline__ const bf16* vptr(long row, int ch) const { return QKV + row * 2304 + vcol + ch * 8; }
  __device__ __forceinline__ const bf16* qptr(int wid, int r32, int d0, int hi) const { return QKV + (long)(ROWS_LAT + 256 * b + 32 * wid + r32) * 2304 + qcol + 16 * d0 + 8 * hi; }
  __device__ __forceinline__ bool skip(int, int) const { return false; }
  __device__ __forceinline__ void mask(f32x16&, f32x16&, int, int, int, int) const {}
  __device__ __forceinline__ float sink(int) const { return hx < 8 ? sinkp[hx] * LOG2E : -INFINITY; }
  __device__ __forceinline__ bf16* orow(int wid, int row) const { return O + (long)(ROWS_LAT + 256 * b + 32 * wid + row) * 1024 + ocol; }
};
struct UDense {
  const bf16* Q; const bf16* KV; const bf16* KR; bf16* O; int b, h, qb;
  __device__ __forceinline__ int nt() const { return 132; }
  __device__ __forceinline__ long krow(int t) const { return t < 4 ? (long)(ROWS_LAT + 256 * b + 64 * t) : (long)(8192 * b + 64 * (t - 4)); }
  __device__ __forceinline__ const bf16* kptr(long row, int ch) const { return ch < 8 ? KV + row * 2048 + 64 * h + ch * 8 : KR + row * 32 + (ch - 8) * 8; }
  __device__ __forceinline__ const bf16* vptr(long row, int ch) const { return KV + row * 2048 + 1024 + 64 * h + ch * 8; }
  __device__ __forceinline__ const bf16* qptr(int wid, int r32, int d0, int hi) const { const bf16* qp = Q + (long)(8192 * b + 256 * qb + 32 * wid + r32) * 1536;
    return d0 < 4 ? qp + 64 * h + 16 * d0 + 8 * hi : qp + 1024 + 32 * h + 16 * (d0 - 4) + 8 * hi; }
  __device__ __forceinline__ bool skip(int, int) const { return false; }
  __device__ __forceinline__ void mask(f32x16&, f32x16&, int, int, int, int) const {}
  __device__ __forceinline__ float sink(int) const { return -INFINITY; }
  __device__ __forceinline__ bf16* orow(int wid, int row) const { return O + (long)(8192 * b + 256 * qb + 32 * wid + row) * 1024 + 64 * h; }
};
#undef ATT_SBAR
}
namespace attd {
typedef unsigned short bf16;
using bf16x8 = __attribute__((ext_vector_type(8))) short;
using s16x4 = __attribute__((ext_vector_type(4))) short;
using f32x16 = __attribute__((ext_vector_type(16))) float;
using u32x4 = __attribute__((ext_vector_type(4))) unsigned;
using i32x2 = __attribute__((ext_vector_type(2))) int;
using i32x4 = __attribute__((ext_vector_type(4))) int;
using i32x8 = __attribute__((ext_vector_type(8))) int;
using u32x6 = __attribute__((ext_vector_type(6))) unsigned;
using u32x16 = __attribute__((ext_vector_type(16))) unsigned;
typedef __bf16 bf16x32 __attribute__((ext_vector_type(32)));
constexpr int NW = 8, NT = 132, KSLOT = 5120, VSLOT = 8192;
constexpr int LDS_K = 0, LDS_V = 3 * KSLOT, LDS_WS = LDS_V + 3 * VSLOT, LDS_OST = LDS_WS + NW * 64 * 4, LDS_BYTES = LDS_OST + NW * 4096;
__device__ __forceinline__ int crow(int r, int hi) { return (r & 3) + 8 * (r >> 2) + 4 * hi; }
#define AF_SBAR() __builtin_amdgcn_sched_barrier(0)
__device__ __forceinline__ void glds16(unsigned voff, const void* sbase, unsigned lds_dst) { unsigned keep;
  asm volatile("s_mov_b32 %0, m0\n\ts_mov_b32 m0, %3\n\ts_nop 0\n\tglobal_load_lds_dwordx4 %1, %2\n\ts_mov_b32 m0, %0" : "=&s"(keep) : "v"(voff), "s"(sbase), "s"(lds_dst) : "memory"); }
typedef float f32x2_t __attribute__((ext_vector_type(2))); typedef __bf16 bf16x2_t __attribute__((ext_vector_type(2)));
__device__ __forceinline__ unsigned cvtpk_s(float lo, float hi) { f32x2_t v = {lo, hi}; bf16x2_t b = __builtin_convertvector(v, bf16x2_t); return __builtin_bit_cast(unsigned, b); }
#define AF_WAIT_BAR(N) asm volatile("s_waitcnt vmcnt(" #N ") lgkmcnt(0)\n\ts_barrier" ::: "memory")
typedef __attribute__((address_space(3))) const char* lds_cptr;
typedef short v4i16_t __attribute__((ext_vector_type(4)));
__device__ __forceinline__ i32x8 ld6(lds_cptr p16, lds_cptr p8) { const i32x4 a = *(const __attribute__((address_space(3))) i32x4*)p16; const i32x2 b = *(const __attribute__((address_space(3))) i32x2*)p8;
  return (i32x8){a.x, a.y, a.z, a.w, b.x, b.y, 0, 0}; }
__device__ __forceinline__ s16x4 vtr(lds_cptr p) { return __builtin_bit_cast(s16x4, __builtin_amdgcn_ds_read_tr16_b64_v4i16((__attribute__((address_space(3))) v4i16_t*)p)); }
__device__ __forceinline__ long tile_row(int b, int t) { return t < 4 ? (long)(16384 + 256 * b + 64 * t) : (long)(8192 * b + 64 * (t - 4)); }
__device__ __forceinline__ u32x6 to_fp6(u32x4 a0, u32x4 a1, u32x4 a2, u32x4 a3) { const u32x16 all = {a0.x, a0.y, a0.z, a0.w, a1.x, a1.y, a1.z, a1.w, a2.x, a2.y, a2.z, a2.w, a3.x, a3.y, a3.z, a3.w};
  return __builtin_amdgcn_cvt_scalef32_pk32_fp6_bf16(__builtin_bit_cast(bf16x32, all), 1.0f); }

__device__ __forceinline__ void dense_unit(int b, int h, int qb, const bf16* Q, const bf16* __restrict__ KV, const char* __restrict__ K6N, const char* __restrict__ K6R, bf16* O, char* shm, const int tid) {
  const int lane = tid & 63, r32 = lane & 31, hi = lane >> 5; const int wid = __builtin_amdgcn_readfirstlane(tid >> 6);
  const unsigned lds0 = (unsigned)(uintptr_t)shm;
  float* wsf = (float*)(shm + LDS_WS) + wid * 64;
  const bool wnp = wid < 3 || wid >= 5; const int pc = wnp ? (wid < 3 ? wid : wid - 5) : wid - 3;
  const unsigned voffK = (unsigned)(lane * 16);
  const char* sK = wnp ? K6N + h * 3072 + pc * 1024 : K6R + pc * 1024; const long kts = wnp ? 16 * 3072 : 2048;
  const unsigned voffV = (unsigned)((16 * (wid & 3) + (lane >> 2)) * 2048 + (wid >> 2) * 32 + (lane & 3) * 8) * 2u;
  const char* sV = (const char*)(KV + 1024 + 64 * h);
  const unsigned kdst = lds0 + LDS_K + (wnp ? pc * 1024 : 3072 + pc * 1024), vdst = lds0 + LDS_V + wid * 1024;
#define AF_DMA_K(t, ks) do { const long G_ = tile_row(b, (t)) >> 6; glds16(voffK, sK + G_ * kts, (unsigned)__builtin_amdgcn_readfirstlane(kdst + (ks))); } while (0)
#define AF_DMA_V(t, vs) do { const long R_ = tile_row(b, (t)); glds16(voffV, sV + R_ * 4096, (unsigned)__builtin_amdgcn_readfirstlane(vdst + (vs))); } while (0)
  const lds_cptr shm3 = (lds_cptr)shm;
  const lds_cptr kp16 = shm3 + LDS_K + hi * 1024 + r32 * 16;
  const lds_cptr kp8 = shm3 + LDS_K + 2048 + hi * 512 + r32 * 8;
  const lds_cptr vp0 = shm3 + LDS_V + ((lane >> 4) & 1) * 32 + (lane & 3) * 8 + (4 * hi + ((lane & 15) >> 2)) * 64;
  AF_DMA_K(0, 0); AF_DMA_V(0, 0); AF_DMA_K(1, KSLOT); AF_DMA_K(2, 2 * KSLOT);
  i32x8 qn, qr;
  { const bf16* qp = Q + (long)(8192 * b + 256 * qb + 32 * wid + r32) * 1536; const bf16* qa = qp + 64 * h + 32 * hi; const bf16* qc = qp + 1024 + 32 * h;
    const u32x6 n6 = to_fp6(*reinterpret_cast<const u32x4*>(qa), *reinterpret_cast<const u32x4*>(qa + 8), *reinterpret_cast<const u32x4*>(qa + 16), *reinterpret_cast<const u32x4*>(qa + 24));
    u32x6 r6 = to_fp6(*reinterpret_cast<const u32x4*>(qc), *reinterpret_cast<const u32x4*>(qc + 8), *reinterpret_cast<const u32x4*>(qc + 16), *reinterpret_cast<const u32x4*>(qc + 24));
    if (hi) r6 = (u32x6){0u, 0u, 0u, 0u, 0u, 0u};
    qn = (i32x8){(int)n6[0], (int)n6[1], (int)n6[2], (int)n6[3], (int)n6[4], (int)n6[5], 0, 0}; qr = (i32x8){(int)r6[0], (int)r6[1], (int)r6[2], (int)r6[3], (int)r6[4], (int)r6[5], 0, 0}; }
  float l_reg = 0.f; f32x16 o[2]; o[0] = f32x16{}; o[1] = f32x16{};
  f32x16 pA0, pA1, pB0, pB1; i32x8 kn0, kn1, kr0, kr1;
  int s_prev = 0, s_cur = 0, s_next = 1;
#define AF_ROT() do { s_prev = s_cur; s_cur = s_next; s_next = (s_next == 2) ? 0 : s_next + 1; } while (0)
#define AF_MF(a, b, c) __builtin_amdgcn_mfma_f32_32x32x16_bf16(a, b, c, 0, 0, 0)
  int sck_ = 0x7b7b7b7b, scq_ = 0x7f7f7f7f; asm volatile("" : "+v"(sck_), "+v"(scq_));
#define AF_MX(a, b, c) __builtin_amdgcn_mfma_scale_f32_32x32x64_f8f6f4(a, b, c, 2, 2, 0, sck_, 0, scq_)
#define AF_EX(v) __builtin_amdgcn_exp2f(v)
  const f32x16 zero16 = f32x16{};
  AF_WAIT_BAR(0);
  { pA0 = AF_MX(ld6(kp16, kp8), qn, zero16); pA1 = AF_MX(ld6(kp16 + 512, kp8 + 256), qn, zero16);
    pA0 = AF_MX(ld6(kp16 + 3072, kp8 + 2048), qr, pA0); pA1 = AF_MX(ld6(kp16 + 3072 + 512, kp8 + 2048 + 256), qr, pA1);
#pragma unroll
    for (int r = 0; r < 16; ++r) { pA0[r] = AF_EX(pA0[r]); pA1[r] = AF_EX(pA1[r]); } }
  AF_WAIT_BAR(0);
  AF_DMA_K(3, 0); AF_DMA_V(1, VSLOT);
  AF_ROT();
  { const lds_cptr k16_ = kp16 + s_cur * KSLOT, k8_ = kp8 + s_cur * KSLOT; kn0 = ld6(k16_, k8_); kn1 = ld6(k16_ + 512, k8_ + 256); kr0 = ld6(k16_ + 3072, k8_ + 2048); kr1 = ld6(k16_ + 3072 + 512, k8_ + 2048 + 256); }
  AF_WAIT_BAR(2);
  s16x4 vlo[8], vhi[8]; u32x4 pw0, pw1, pw2, pw3;
#define AF_PKW(P, B) cvtpk_s(P[B], P[B + 1])
#define AF_PAF(k) __builtin_bit_cast(bf16x8, pw##k)
#define AF_VFR(i) (bf16x8){vlo[i][0], vlo[i][1], vlo[i][2], vlo[i][3], vhi[i][0], vhi[i][1], vhi[i][2], vhi[i][3]}
#define AF_PIN(x) asm volatile("" : "+v"(x))
#define AF_VRD(i) do { vlo[i] = vtr(vp_ + (((i) >> 2) * 4096 + ((i) & 3) * 1024)); vhi[i] = vtr(vp_ + (((i) >> 2) * 4096 + ((i) & 3) * 1024 + 512)); AF_SBAR(); } while (0)
#define AF_GB(MF, X, B) do { MF; X[B] = AF_EX(X[B]); X[B + 1] = AF_EX(X[B + 1]); X[B + 2] = AF_EX(X[B + 2]); X[B + 3] = AF_EX(X[B + 3]); AF_PIN(X); AF_SBAR(); } while (0)
#define AF_KRD(G, j) do { if (G) { const lds_cptr k16_ = kp16 + s_next * KSLOT, k8_ = kp8 + s_next * KSLOT; \
      if ((j) == 0) kn0 = ld6(k16_, k8_); if ((j) == 1) kn1 = ld6(k16_ + 512, k8_ + 256); \
      if ((j) == 2) kr0 = ld6(k16_ + 3072, k8_ + 2048); if ((j) == 3) kr1 = ld6(k16_ + 3072 + 512, k8_ + 2048 + 256); AF_SBAR(); } } while (0)
#define AF_A4(P, B) do { sacc += P[B]; sacc += P[B + 1]; sacc += P[B + 2]; sacc += P[B + 3]; } while (0)
#define AF_STEP(C0, C1, P0, P1, t, GK, GV, GL) do { AF_SBAR(); \
    const lds_cptr vp_ = vp0 + s_prev * VSLOT; \
    float sacc = (P0[0] + P0[1]); \
    AF_VRD(0); AF_VRD(4); \
    { C0 = AF_MX(kn0, qn, zero16); sacc += P0[2]; sacc += P0[3]; AF_A4(P0, 4); AF_PIN(sacc); \
      pw0[0] = AF_PKW(P0, 0); pw0[1] = AF_PKW(P0, 2); pw0[2] = AF_PKW(P0, 4); pw0[3] = AF_PKW(P0, 6); AF_PIN(pw0); AF_SBAR(); } \
    AF_VRD(1); AF_VRD(5); \
    { C1 = AF_MX(kn1, qn, zero16); AF_A4(P0, 8); AF_A4(P0, 12); AF_PIN(sacc); \
      pw1[0] = AF_PKW(P0, 8); pw1[1] = AF_PKW(P0, 10); pw1[2] = AF_PKW(P0, 12); pw1[3] = AF_PKW(P0, 14); AF_PIN(pw1); AF_SBAR(); } \
    AF_VRD(2); AF_VRD(6); \
    { C0 = AF_MX(kr0, qr, C0); AF_A4(P1, 0); AF_A4(P1, 4); AF_PIN(sacc); \
      pw2[0] = AF_PKW(P1, 0); pw2[1] = AF_PKW(P1, 2); pw2[2] = AF_PKW(P1, 4); pw2[3] = AF_PKW(P1, 6); AF_PIN(pw2); AF_SBAR(); } \
    if (GK) { AF_DMA_K((t) + 3, s_cur * KSLOT); AF_SBAR(); } \
    AF_VRD(3); AF_VRD(7); \
    { C1 = AF_MX(kr1, qr, C1); AF_A4(P1, 8); AF_A4(P1, 12); AF_PIN(sacc); \
      pw3[0] = AF_PKW(P1, 8); pw3[1] = AF_PKW(P1, 10); pw3[2] = AF_PKW(P1, 12); pw3[3] = AF_PKW(P1, 14); AF_PIN(pw3); AF_SBAR(); } \
    if (GV) { AF_DMA_V((t) + 1, s_next * VSLOT); AF_SBAR(); } \
    l_reg += sacc; \
    AF_SBAR(); \
    AF_GB(o[0] = AF_MF(AF_PAF(0), AF_VFR(0), o[0]), C0, 0);  AF_KRD(GL, 0); \
    AF_GB(o[1] = AF_MF(AF_PAF(0), AF_VFR(4), o[1]), C0, 4);  AF_KRD(GL, 1); \
    AF_GB(o[0] = AF_MF(AF_PAF(1), AF_VFR(1), o[0]), C0, 8);  AF_KRD(GL, 2); \
    AF_GB(o[1] = AF_MF(AF_PAF(1), AF_VFR(5), o[1]), C0, 12); AF_KRD(GL, 3); \
    AF_GB(o[0] = AF_MF(AF_PAF(2), AF_VFR(2), o[0]), C1, 0); \
    AF_GB(o[1] = AF_MF(AF_PAF(2), AF_VFR(6), o[1]), C1, 4); \
    AF_GB(o[0] = AF_MF(AF_PAF(3), AF_VFR(3), o[0]), C1, 8); \
    AF_GB(o[1] = AF_MF(AF_PAF(3), AF_VFR(7), o[1]), C1, 12); \
  } while (0)
  int t = 1;
  for (; t + 3 < NT; t += 2) {
    AF_STEP(pB0, pB1, pA0, pA1, t, true, true, true);     AF_WAIT_BAR(2); AF_ROT();
    AF_STEP(pA0, pA1, pB0, pB1, t + 1, true, true, true); AF_WAIT_BAR(2); AF_ROT();
  }
  AF_STEP(pB0, pB1, pA0, pA1, NT - 3, false, true, true);  AF_WAIT_BAR(1); AF_ROT();
  AF_STEP(pA0, pA1, pB0, pB1, NT - 2, false, true, true);  AF_WAIT_BAR(0); AF_ROT();
  AF_STEP(pB0, pB1, pA0, pA1, NT - 1, false, false, false);
  { float sacc = pB0[0] + pB0[1];
#pragma unroll
    for (int r = 2; r < 16; ++r) sacc += pB0[r];
#pragma unroll
    for (int r = 0; r < 16; ++r) sacc += pB1[r];
    l_reg += sacc;
    pw0 = (u32x4){AF_PKW(pB0, 0), AF_PKW(pB0, 2), AF_PKW(pB0, 4), AF_PKW(pB0, 6)}; pw1 = (u32x4){AF_PKW(pB0, 8), AF_PKW(pB0, 10), AF_PKW(pB0, 12), AF_PKW(pB0, 14)};
    pw2 = (u32x4){AF_PKW(pB1, 0), AF_PKW(pB1, 2), AF_PKW(pB1, 4), AF_PKW(pB1, 6)}; pw3 = (u32x4){AF_PKW(pB1, 8), AF_PKW(pB1, 10), AF_PKW(pB1, 12), AF_PKW(pB1, 14)};
    AF_SBAR();
    const lds_cptr vp_ = vp0 + s_cur * VSLOT;
#pragma unroll
    for (int i = 0; i < 8; ++i) { vlo[i] = vtr(vp_ + ((i >> 2) * 4096 + (i & 3) * 1024)); vhi[i] = vtr(vp_ + ((i >> 2) * 4096 + (i & 3) * 1024 + 512)); }
    o[0] = AF_MF(AF_PAF(0), AF_VFR(0), o[0]); o[1] = AF_MF(AF_PAF(0), AF_VFR(4), o[1]);
    o[0] = AF_MF(AF_PAF(1), AF_VFR(1), o[0]); o[1] = AF_MF(AF_PAF(1), AF_VFR(5), o[1]);
    o[0] = AF_MF(AF_PAF(2), AF_VFR(2), o[0]); o[1] = AF_MF(AF_PAF(2), AF_VFR(6), o[1]);
    o[0] = AF_MF(AF_PAF(3), AF_VFR(3), o[0]); o[1] = AF_MF(AF_PAF(3), AF_VFR(7), o[1]); }
  { auto rr = __builtin_amdgcn_permlane32_swap(__float_as_uint(l_reg), __float_as_uint(l_reg), false, false); l_reg = __uint_as_float(rr[0]) + __uint_as_float(rr[1]); }
  if (hi == 0) wsf[32 + r32] = l_reg; asm volatile("s_waitcnt lgkmcnt(0)" ::: "memory");
  float rli[16];
#pragma unroll
  for (int r = 0; r < 16; ++r) rli[r] = __builtin_amdgcn_rcpf(wsf[32 + crow(r, hi)]);
  bf16* Ow = O + (long)(8192 * b + 256 * qb + 32 * wid) * 1024 + 64 * h;
  { bf16* stg = (bf16*)(shm + LDS_OST) + wid * 2048;
#pragma unroll
    for (int r = 0; r < 16; ++r) { const int orow = crow(r, hi);
#pragma unroll
      for (int d0 = 0; d0 < 2; ++d0) stg[orow * 64 + d0 * 32 + r32] = (bf16)(cvtpk_s(o[d0][r] * rli[r], 0.f) & 0xffffu); }
    asm volatile("s_waitcnt lgkmcnt(0)" ::: "memory");
#pragma unroll
    for (int i = 0; i < 4; ++i) { const int row = i * 8 + (lane >> 3), ch = lane & 7; const u32x4 v = *(const u32x4*)(stg + row * 64 + ch * 8); *(u32x4*)(Ow + (long)row * 1024 + ch * 8) = v; } }
  asm volatile("s_waitcnt vmcnt(0) lgkmcnt(0)\n\ts_barrier" ::: "memory");
#undef AF_DMA_K
#undef AF_DMA_V
#undef AF_ROT
#undef AF_PKW
#undef AF_PAF
#undef AF_VFR
#undef AF_PIN
#undef AF_MF
#undef AF_MX
#undef AF_EX
#undef AF_VRD
#undef AF_GB
#undef AF_KRD
#undef AF_A4
#undef AF_STEP
}
#undef AF_SBAR
#undef AF_WAIT_BAR
}
namespace attf {
typedef unsigned short bf16;
using bf16x8 = __attribute__((ext_vector_type(8))) short;
using s16x4 = __attribute__((ext_vector_type(4))) short;
using f32x16 = __attribute__((ext_vector_type(16))) float;
using u32x4 = __attribute__((ext_vector_type(4))) unsigned;
using i32x2 = __attribute__((ext_vector_type(2))) int;
using i32x4 = __attribute__((ext_vector_type(4))) int;
using i32x8 = __attribute__((ext_vector_type(8))) int;
using u32x6 = __attribute__((ext_vector_type(6))) unsigned;
using u32x16 = __attribute__((ext_vector_type(16))) unsigned;
typedef __bf16 bf16x32 __attribute__((ext_vector_type(32)));
constexpr int NW = 8, KSLOT = 12288, VSLOT = 8192;
constexpr int LDS_K = 0, LDS_V = 3 * KSLOT, LDS_WS = LDS_V + 3 * VSLOT, LDS_OST = LDS_WS + NW * 64 * 4, LDS_RPB = LDS_OST + NW * 4096, LDS_BYTES = LDS_RPB + 2048;
__device__ __forceinline__ int crow(int r, int hi) { return (r & 3) + 8 * (r >> 2) + 4 * hi; }
#define AF_SBAR() __builtin_amdgcn_sched_barrier(0)
__device__ __forceinline__ void glds16(unsigned voff, const void* sbase, unsigned lds_dst) { unsigned keep;
  asm volatile("s_mov_b32 %0, m0\n\ts_mov_b32 m0, %3\n\ts_nop 0\n\tglobal_load_lds_dwordx4 %1, %2\n\ts_mov_b32 m0, %0" : "=&s"(keep) : "v"(voff), "s"(sbase), "s"(lds_dst) : "memory"); }
typedef float f32x2_t __attribute__((ext_vector_type(2))); typedef __bf16 bf16x2_t __attribute__((ext_vector_type(2)));
__device__ __forceinline__ unsigned cvtpk_s(float lo, float hi) { f32x2_t v = {lo, hi}; bf16x2_t b = __builtin_convertvector(v, bf16x2_t); return __builtin_bit_cast(unsigned, b); }
#define AF_WAIT_BAR(N) asm volatile("s_waitcnt vmcnt(" #N ") lgkmcnt(0)\n\ts_barrier" ::: "memory")
typedef __attribute__((address_space(3))) const char* lds_cptr;
typedef short v4i16_t __attribute__((ext_vector_type(4)));
__device__ __forceinline__ void kload2(bf16x8* kf, lds_cptr kp, int j) { kf[2 * j] = *(const __attribute__((address_space(3))) bf16x8*)(kp + j * 2048); kf[2 * j + 1] = *(const __attribute__((address_space(3))) bf16x8*)(kp + j * 2048 + 512); }
__device__ __forceinline__ i32x8 ld6(lds_cptr p16, lds_cptr p8) { const i32x4 a = *(const __attribute__((address_space(3))) i32x4*)p16; const i32x2 b = *(const __attribute__((address_space(3))) i32x2*)p8;
  const i32x4 b4 = __builtin_shufflevector(b, b, 0, 1, -1, -1); return __builtin_shufflevector(a, b4, 0, 1, 2, 3, 4, 5, -1, -1); }
__device__ __forceinline__ i32x8 to_fp6(u32x4 a0, u32x4 a1, u32x4 a2, u32x4 a3) { const u32x16 all = {a0.x, a0.y, a0.z, a0.w, a1.x, a1.y, a1.z, a1.w, a2.x, a2.y, a2.z, a2.w, a3.x, a3.y, a3.z, a3.w};
  const u32x6 c = __builtin_amdgcn_cvt_scalef32_pk32_fp6_bf16(__builtin_bit_cast(bf16x32, all), 1.0f); return __builtin_bit_cast(i32x8, __builtin_shufflevector(c, c, 0, 1, 2, 3, 4, 5, -1, -1)); }
__device__ __forceinline__ s16x4 vtr(lds_cptr p) { return __builtin_bit_cast(s16x4, __builtin_amdgcn_ds_read_tr16_b64_v4i16((__attribute__((address_space(3))) v4i16_t*)p)); }

template <int DKC, class U, bool F6 = false>
__device__ __forceinline__ void fast_unit(const U& u, char* shm, int tid) {
  static_assert(DKC == 8 || DKC == 12, "q/k dim 64 or 96"); static_assert(!F6 || DKC == 8, "fp6 logits: q/k dim 64");
  asm volatile("" : "+v"(tid));
  constexpr int ND0 = DKC / 2;
  const int lane = tid & 63, r32 = lane & 31, hi = lane >> 5; const int wid = __builtin_amdgcn_readfirstlane(tid >> 6);
  const unsigned lds0 = (unsigned)(uintptr_t)shm;
  float* wsf = (float*)(shm + LDS_WS) + wid * 64;
  const int NT = u.nt();
  const unsigned voffKA = (unsigned)(lane * u.kpitch + 8 * wid) * 2u;
  const unsigned voffKB = (unsigned)(lane * 32 + 8 * (wid & 3)) * 2u;
  const unsigned voffV = (unsigned)((16 * (wid & 3) + (lane >> 2)) * u.vpitch + (wid >> 2) * 32 + (lane & 3) * 8) * 2u;
  const unsigned kdstA = lds0 + LDS_K + wid * 1024, kdstB = lds0 + LDS_K + (8 + (wid & 3)) * 1024, vdst = lds0 + LDS_V + wid * 1024;
  const int pc6 = wid % 3; const unsigned voffK6 = (unsigned)(lane * 16), kdst6 = lds0 + LDS_K + pc6 * 1024;
#define AF_DMA_KA(t, ks) do { const long R_ = u.trow(t); if constexpr (F6) glds16(voffK6, u.k6base + (R_ >> 6) * 30720 + pc6 * 1024, (unsigned)__builtin_amdgcn_readfirstlane(kdst6 + (ks))); \
    else glds16(voffKA, (const char*)u.kbase + R_ * (2 * u.kpitch), (unsigned)__builtin_amdgcn_readfirstlane(kdstA + (ks))); } while (0)
#define AF_DMA_KB(t, ks) do { if constexpr (DKC == 12) { const long R_ = u.trow(t); glds16(voffKB, (const char*)u.krbase + R_ * 64, (unsigned)__builtin_amdgcn_readfirstlane(kdstB + (ks))); } } while (0)
#define AF_DMA_K(t, ks) do { AF_DMA_KA(t, ks); AF_DMA_KB(t, ks); } while (0)
#define AF_DMA_V(t, vs) do { const long R_ = u.trow(t); glds16(voffV, (const char*)u.vbase + R_ * (2 * u.vpitch), (unsigned)__builtin_amdgcn_readfirstlane(vdst + (vs))); } while (0)
#define AF_WAITN(NSTEPS_K, NV) do { if constexpr (DKC == 12) { if ((NSTEPS_K) == 2 && (NV) == 1) AF_WAIT_BAR(5); else if ((NSTEPS_K) == 1 && (NV) == 1) AF_WAIT_BAR(3); else if ((NV) == 1) AF_WAIT_BAR(1); else AF_WAIT_BAR(0); } \
    else { if ((NSTEPS_K) == 2 && (NV) == 1) AF_WAIT_BAR(3); else if ((NSTEPS_K) == 1 && (NV) == 1) AF_WAIT_BAR(2); else if ((NV) == 1) AF_WAIT_BAR(1); else AF_WAIT_BAR(0); } } while (0)
  const lds_cptr shm3 = (lds_cptr)shm; const lds_cptr kp0 = shm3 + LDS_K + hi * 1024 + r32 * 16;
  const lds_cptr kp8 = shm3 + LDS_K + 2048 + hi * 512 + r32 * 8;
  const lds_cptr vp0 = shm3 + LDS_V + ((lane >> 4) & 1) * 32 + (lane & 3) * 8 + (4 * hi + ((lane & 15) >> 2)) * 64;
  bf16x8 qr[ND0]; i32x8 qn;
  if constexpr (F6) { const bf16* qa = u.qptr(wid, r32, 0, 0) + 32 * hi;
    qn = to_fp6(*reinterpret_cast<const u32x4*>(qa), *reinterpret_cast<const u32x4*>(qa + 8), *reinterpret_cast<const u32x4*>(qa + 16), *reinterpret_cast<const u32x4*>(qa + 24)); }
  else {
#pragma unroll
    for (int d0 = 0; d0 < ND0; ++d0) qr[d0] = *reinterpret_cast<const bf16x8*>(u.qptr(wid, r32, d0, hi)); }
  AF_DMA_K(0, 0); AF_DMA_V(0, 0); AF_DMA_K(1, KSLOT); AF_DMA_K(2, 2 * KSLOT);
  float l_reg = 0.f; f32x16 o[2]; o[0] = f32x16{}; o[1] = f32x16{};
  f32x16 pA0, pA1, pB0, pB1; bf16x8 kf[DKC]; i32x8 kn0, kn1;
  int sck_ = 0x7b7b7b7b, scq_ = 0x7f7f7f7f; asm volatile("" : "+v"(sck_), "+v"(scq_));
#define AF_MX6(a, b, c) __builtin_amdgcn_mfma_scale_f32_32x32x64_f8f6f4(a, b, c, 2, 2, 0, sck_, 0, scq_)
  int s_prev = 0, s_cur = 0, s_next = 1;
#define AF_ROT() do { s_prev = s_cur; s_cur = s_next; s_next = (s_next == 2) ? 0 : s_next + 1; } while (0)
  AF_WAITN(2, 1);
  { const char* kb = shm + LDS_K + hi * 1024 + r32 * 16; pA0 = f32x16{}; pA1 = f32x16{};
    if constexpr (F6) { pA0 = AF_MX6(ld6(kp0, kp8), qn, pA0); pA1 = AF_MX6(ld6(kp0 + 512, kp8 + 256), qn, pA1); }
    else
#pragma unroll
    for (int d0 = 0; d0 < ND0; ++d0) { const bf16x8 b0 = *reinterpret_cast<const bf16x8*>(kb + d0 * 2048), b1 = *reinterpret_cast<const bf16x8*>(kb + d0 * 2048 + 512);
      pA0 = __builtin_amdgcn_mfma_f32_32x32x16_bf16(b0, qr[d0], pA0, 0, 0, 0); pA1 = __builtin_amdgcn_mfma_f32_32x32x16_bf16(b1, qr[d0], pA1, 0, 0, 0); }
    if constexpr (U::HAS_MASK) u.mask(pA0, pA1, 0, wid, r32, hi);
#pragma unroll
    for (int r = 0; r < 16; ++r) { pA0[r] = __builtin_amdgcn_exp2f(pA0[r]); pA1[r] = __builtin_amdgcn_exp2f(pA1[r]); } }
  AF_WAIT_BAR(0);
  AF_DMA_K(3, 0); AF_DMA_V(1, VSLOT);
  AF_ROT();
  if constexpr (F6) { kn0 = ld6(kp0 + s_cur * KSLOT, kp8 + s_cur * KSLOT); kn1 = ld6(kp0 + s_cur * KSLOT + 512, kp8 + s_cur * KSLOT + 256); }
  else {
#pragma unroll
    for (int j = 0; j < ND0; ++j) kload2(kf, kp0 + s_cur * KSLOT, j); }
  AF_WAITN(1, 1);
  s16x4 vlo[8], vhi[8]; u32x4 pw0, pw1, pw2, pw3;
#define AF_PKW(P, B) cvtpk_s(P[B], P[B + 1])
#define AF_PAF(k) __builtin_bit_cast(bf16x8, pw##k)
#define AF_VFR(i) (bf16x8){vlo[i][0], vlo[i][1], vlo[i][2], vlo[i][3], vhi[i][0], vhi[i][1], vhi[i][2], vhi[i][3]}
#define AF_PIN(x) asm volatile("" : "+v"(x))
#define AF_MF(a, b, c) __builtin_amdgcn_mfma_f32_32x32x16_bf16(a, b, c, 0, 0, 0)
#define AF_EX(v) __builtin_amdgcn_exp2f(v)
#define AF_VRD(i) do { vlo[i] = vtr(vp_ + (((i) >> 2) * 4096 + ((i) & 3) * 1024)); vhi[i] = vtr(vp_ + (((i) >> 2) * 4096 + ((i) & 3) * 1024 + 512)); AF_SBAR(); } while (0)
#define AF_GA4(MF, A0, A1, A2, A3, W0, W1, PW) do { MF; sacc += A0; sacc += A1; sacc += A2; sacc += A3; AF_PIN(sacc); W0; W1; AF_PIN(PW); AF_SBAR(); } while (0)
#define AF_GA3(MF, A0, A1, A2, W0, W1, PW) do { MF; sacc += A0; sacc += A1; sacc += A2; AF_PIN(sacc); W0; W1; AF_PIN(PW); AF_SBAR(); } while (0)
#define AF_GA2(MF, A0, A1, W0, PW) do { MF; sacc += A0; sacc += A1; AF_PIN(sacc); W0; AF_PIN(PW); AF_SBAR(); } while (0)
#define AF_GB(MF, X, B) do { MF; X[B] = AF_EX(X[B]); X[B + 1] = AF_EX(X[B + 1]); X[B + 2] = AF_EX(X[B + 2]); X[B + 3] = AF_EX(X[B + 3]); AF_PIN(X); AF_SBAR(); } while (0)
#define AF_KRD(G, j) do { if constexpr (F6) { if ((j) < 2) { if (G) { if ((j) == 0) kn0 = ld6(kp0 + s_next * KSLOT, kp8 + s_next * KSLOT); else kn1 = ld6(kp0 + s_next * KSLOT + 512, kp8 + s_next * KSLOT + 256); AF_SBAR(); } } } \
    else if ((j) < ND0) { if (G) { kload2(kf, kp0 + s_next * KSLOT, (j) < ND0 ? (j) : 0); AF_SBAR(); } } } while (0)
  const f32x16 zero16 = f32x16{};
#define AF_PHASE_A12(C0, C1, P0, P1, t, GK, GV) do { \
    AF_VRD(0); float sacc = (P0[0] + P0[1]); \
    AF_GA3(C0 = AF_MF(kf[0], qr[0], zero16), P0[2], P0[3], P0[4],     pw0[0] = AF_PKW(P0, 0), pw0[1] = AF_PKW(P0, 2), pw0); \
    AF_VRD(4); AF_GA3(C1 = AF_MF(kf[1], qr[0], zero16), P0[5], P0[6], P0[7],     pw0[2] = AF_PKW(P0, 4), pw0[3] = AF_PKW(P0, 6), pw0); \
    AF_VRD(1); AF_GA3(C0 = AF_MF(kf[2], qr[1], C0),     P0[8], P0[9], P0[10],    pw1[0] = AF_PKW(P0, 8), pw1[1] = AF_PKW(P0, 10), pw1); \
    AF_VRD(5); AF_GA3(C1 = AF_MF(kf[3], qr[1], C1),     P0[11], P0[12], P0[13],  pw1[2] = AF_PKW(P0, 12), pw1[3] = AF_PKW(P0, 14), pw1); \
    AF_VRD(2); AF_GA3(C0 = AF_MF(kf[4], qr[2], C0),     P0[14], P0[15], P1[0],   pw2[0] = AF_PKW(P1, 0), pw2[1] = AF_PKW(P1, 2), pw2); \
    AF_VRD(6); AF_GA3(C1 = AF_MF(kf[5], qr[2], C1),     P1[1], P1[2], P1[3],     pw2[2] = AF_PKW(P1, 4), pw2[3] = AF_PKW(P1, 6), pw2); \
    AF_VRD(3); AF_GA2(C0 = AF_MF(kf[6], qr[3], C0),     P1[4], P1[5],            pw3[0] = AF_PKW(P1, 8), pw3); \
    AF_VRD(7); AF_GA2(C1 = AF_MF(kf[7], qr[3], C1),     P1[6], P1[7],            pw3[1] = AF_PKW(P1, 10), pw3); \
    AF_GA2(C0 = AF_MF(kf[8 % DKC], qr[4 % ND0], C0),    P1[8], P1[9],            pw3[2] = AF_PKW(P1, 12), pw3); \
    if (GK) { AF_DMA_KA((t) + 3, s_cur * KSLOT); AF_SBAR(); } \
    AF_GA2(C1 = AF_MF(kf[9 % DKC], qr[4 % ND0], C1),    P1[10], P1[11],          pw3[3] = AF_PKW(P1, 14), pw3); \
    if (GK) { AF_DMA_KB((t) + 3, s_cur * KSLOT); AF_SBAR(); } \
    { C0 = AF_MF(kf[10 % DKC], qr[5 % ND0], C0); sacc += P1[12]; sacc += P1[13]; AF_PIN(sacc); AF_SBAR(); } \
    if (GV) { AF_DMA_V((t) + 1, s_next * VSLOT); AF_SBAR(); } \
    { C1 = AF_MF(kf[11 % DKC], qr[5 % ND0], C1); sacc += P1[14]; sacc += P1[15]; AF_PIN(sacc); AF_SBAR(); } \
    l_reg += sacc; } while (0)
#define AF_PHASE_A8(C0, C1, P0, P1, t, GK, GV) do { \
    AF_VRD(0); float sacc = (P0[0] + P0[1]); \
    AF_GA4(C0 = AF_MF(kf[0], qr[0], zero16), P0[2], P0[3], P0[4], P0[5],       pw0[0] = AF_PKW(P0, 0), pw0[1] = AF_PKW(P0, 2), pw0); \
    AF_VRD(4); AF_GA4(C1 = AF_MF(kf[1], qr[0], zero16), P0[6], P0[7], P0[8], P0[9],       pw0[2] = AF_PKW(P0, 4), pw0[3] = AF_PKW(P0, 6), pw0); \
    AF_VRD(1); AF_GA4(C0 = AF_MF(kf[2], qr[1], C0),     P0[10], P0[11], P0[12], P0[13],   pw1[0] = AF_PKW(P0, 8), pw1[1] = AF_PKW(P0, 10), pw1); \
    AF_VRD(5); AF_GA4(C1 = AF_MF(kf[3], qr[1], C1),     P0[14], P0[15], P1[0], P1[1],     pw1[2] = AF_PKW(P0, 12), pw1[3] = AF_PKW(P0, 14), pw1); \
    AF_VRD(2); AF_GA4(C0 = AF_MF(kf[4], qr[2], C0),     P1[2], P1[3], P1[4], P1[5],       pw2[0] = AF_PKW(P1, 0), pw2[1] = AF_PKW(P1, 2), pw2); \
    AF_VRD(6); AF_GA4(C1 = AF_MF(kf[5], qr[2], C1),     P1[6], P1[7], P1[8], P1[9],       pw2[2] = AF_PKW(P1, 4), pw2[3] = AF_PKW(P1, 6), pw2); \
    AF_VRD(3); AF_GA4(C0 = AF_MF(kf[6], qr[3], C0),     P1[10], P1[11], P1[12], P1[13],   pw3[0] = AF_PKW(P1, 8), pw3[1] = AF_PKW(P1, 10), pw3); \
    AF_VRD(7); AF_GA4(C1 = AF_MF(kf[7], qr[3], C1),     P1[14], P1[15], 0.f, 0.f,         pw3[2] = AF_PKW(P1, 12), pw3[3] = AF_PKW(P1, 14), pw3); \
    l_reg += sacc; \
    if (GK) { AF_DMA_KA((t) + 3, s_cur * KSLOT); } if (GV) { AF_DMA_V((t) + 1, s_next * VSLOT); } } while (0)
#define AF_A4(P, B) do { sacc += P[B]; sacc += P[B + 1]; sacc += P[B + 2]; sacc += P[B + 3]; } while (0)
#define AF_PHASE_A6(C0, C1, P0, P1, t, GK, GV) do { \
    AF_VRD(0); AF_VRD(4); float sacc = (P0[0] + P0[1]); \
    { C0 = AF_MX6(kn0, qn, zero16); sacc += P0[2]; sacc += P0[3]; AF_A4(P0, 4); AF_A4(P0, 8); AF_A4(P0, 12); AF_PIN(sacc); \
      pw0[0] = AF_PKW(P0, 0); pw0[1] = AF_PKW(P0, 2); pw0[2] = AF_PKW(P0, 4); pw0[3] = AF_PKW(P0, 6); AF_PIN(pw0); pw1[0] = AF_PKW(P0, 8); pw1[1] = AF_PKW(P0, 10); pw1[2] = AF_PKW(P0, 12); pw1[3] = AF_PKW(P0, 14); AF_PIN(pw1); AF_SBAR(); } \
    AF_VRD(1); AF_VRD(5); AF_VRD(2); AF_VRD(6); \
    { C1 = AF_MX6(kn1, qn, zero16); AF_A4(P1, 0); AF_A4(P1, 4); AF_A4(P1, 8); AF_A4(P1, 12); AF_PIN(sacc); \
      pw2[0] = AF_PKW(P1, 0); pw2[1] = AF_PKW(P1, 2); pw2[2] = AF_PKW(P1, 4); pw2[3] = AF_PKW(P1, 6); AF_PIN(pw2); pw3[0] = AF_PKW(P1, 8); pw3[1] = AF_PKW(P1, 10); pw3[2] = AF_PKW(P1, 12); pw3[3] = AF_PKW(P1, 14); AF_PIN(pw3); AF_SBAR(); } \
    AF_VRD(3); AF_VRD(7); \
    l_reg += sacc; \
    if (GK) { AF_DMA_KA((t) + 3, s_cur * KSLOT); } if (GV) { AF_DMA_V((t) + 1, s_next * VSLOT); } } while (0)
#define AF_STEP(C0, C1, P0, P1, t, GK, GV, GL) do { AF_SBAR(); \
    const lds_cptr vp_ = vp0 + s_prev * VSLOT; \
    if constexpr (F6) AF_PHASE_A6(C0, C1, P0, P1, t, GK, GV); else if constexpr (DKC == 12) AF_PHASE_A12(C0, C1, P0, P1, t, GK, GV); else AF_PHASE_A8(C0, C1, P0, P1, t, GK, GV); \
    if constexpr (U::HAS_MASK) u.mask(C0, C1, (t), wid, r32, hi); \
    AF_SBAR(); \
    AF_GB(o[0] = AF_MF(AF_PAF(0), AF_VFR(0), o[0]), C0, 0);  AF_KRD(GL, 0); \
    AF_GB(o[1] = AF_MF(AF_PAF(0), AF_VFR(4), o[1]), C0, 4);  AF_KRD(GL, 1); \
    AF_GB(o[0] = AF_MF(AF_PAF(1), AF_VFR(1), o[0]), C0, 8);  AF_KRD(GL, 2); \
    AF_GB(o[1] = AF_MF(AF_PAF(1), AF_VFR(5), o[1]), C0, 12); AF_KRD(GL, 3); \
    AF_GB(o[0] = AF_MF(AF_PAF(2), AF_VFR(2), o[0]), C1, 0);  AF_KRD(GL, 4); \
    AF_GB(o[1] = AF_MF(AF_PAF(2), AF_VFR(6), o[1]), C1, 4);  AF_KRD(GL, 5); \
    AF_GB(o[0] = AF_MF(AF_PAF(3), AF_VFR(3), o[0]), C1, 8); \
    AF_GB(o[1] = AF_MF(AF_PAF(3), AF_VFR(7), o[1]), C1, 12); \
  } while (0)
  int t = 1;
  for (; t + 3 < NT; t += 2) {
    AF_STEP(pB0, pB1, pA0, pA1, t, true, true, true);     AF_WAITN(1, 1); AF_ROT();
    AF_STEP(pA0, pA1, pB0, pB1, t + 1, true, true, true); AF_WAITN(1, 1); AF_ROT();
  }
  AF_STEP(pB0, pB1, pA0, pA1, NT - 3, false, true, true);  AF_WAITN(0, 1); AF_ROT();
  AF_STEP(pA0, pA1, pB0, pB1, NT - 2, false, true, true);  AF_WAIT_BAR(0); AF_ROT();
  AF_STEP(pB0, pB1, pA0, pA1, NT - 1, false, false, false);
  { float sacc = pB0[0] + pB0[1];
#pragma unroll
    for (int r = 2; r < 16; ++r) sacc += pB0[r];
#pragma unroll
    for (int r = 0; r < 16; ++r) sacc += pB1[r];
    l_reg += sacc;
    pw0 = (u32x4){AF_PKW(pB0, 0), AF_PKW(pB0, 2), AF_PKW(pB0, 4), AF_PKW(pB0, 6)}; pw1 = (u32x4){AF_PKW(pB0, 8), AF_PKW(pB0, 10), AF_PKW(pB0, 12), AF_PKW(pB0, 14)};
    pw2 = (u32x4){AF_PKW(pB1, 0), AF_PKW(pB1, 2), AF_PKW(pB1, 4), AF_PKW(pB1, 6)}; pw3 = (u32x4){AF_PKW(pB1, 8), AF_PKW(pB1, 10), AF_PKW(pB1, 12), AF_PKW(pB1, 14)};
    AF_SBAR();
    const lds_cptr vp_ = vp0 + s_cur * VSLOT;
#pragma unroll
    for (int i = 0; i < 8; ++i) { vlo[i] = vtr(vp_ + ((i >> 2) * 4096 + (i & 3) * 1024)); vhi[i] = vtr(vp_ + ((i >> 2) * 4096 + (i & 3) * 1024 + 512)); }
    o[0] = AF_MF(AF_PAF(0), AF_VFR(0), o[0]); o[1] = AF_MF(AF_PAF(0), AF_VFR(4), o[1]);
    o[0] = AF_MF(AF_PAF(1), AF_VFR(1), o[0]); o[1] = AF_MF(AF_PAF(1), AF_VFR(5), o[1]);
    o[0] = AF_MF(AF_PAF(2), AF_VFR(2), o[0]); o[1] = AF_MF(AF_PAF(2), AF_VFR(6), o[1]);
    o[0] = AF_MF(AF_PAF(3), AF_VFR(3), o[0]); o[1] = AF_MF(AF_PAF(3), AF_VFR(7), o[1]); }
  { auto rr = __builtin_amdgcn_permlane32_swap(__float_as_uint(l_reg), __float_as_uint(l_reg), false, false); l_reg = __uint_as_float(rr[0]) + __uint_as_float(rr[1]); }
  l_reg += __builtin_amdgcn_exp2f(u.sink(wid));
  if (hi == 0) wsf[32 + r32] = l_reg; asm volatile("s_waitcnt lgkmcnt(0)" ::: "memory");
  float rli[16];
#pragma unroll
  for (int r = 0; r < 16; ++r) rli[r] = __builtin_amdgcn_rcpf(wsf[32 + crow(r, hi)]);
  bf16* Ow = u.orow0(wid);
  { bf16* stg = (bf16*)(shm + LDS_OST) + wid * 2048;
#pragma unroll
    for (int r = 0; r < 16; ++r) { const int orow = crow(r, hi);
#pragma unroll
      for (int d0 = 0; d0 < 2; ++d0) stg[orow * 64 + d0 * 32 + r32] = (bf16)(cvtpk_s(o[d0][r] * rli[r], 0.f) & 0xffffu); }
    asm volatile("s_waitcnt lgkmcnt(0)" ::: "memory");
#pragma unroll
    for (int i = 0; i < 4; ++i) { const int row = i * 8 + (lane >> 3), ch = lane & 7; const u32x4 v = *(const u32x4*)(stg + row * 64 + ch * 8); *(u32x4*)(Ow + (long)row * 1024 + ch * 8) = v; } }
  asm volatile("s_waitcnt vmcnt(0) lgkmcnt(0)\n\ts_barrier" ::: "memory");
#undef AF_DMA_KA
#undef AF_DMA_KB
#undef AF_DMA_K
#undef AF_DMA_V
#undef AF_WAITN
#undef AF_ROT
#undef AF_PKW
#undef AF_PAF
#undef AF_VFR
#undef AF_PIN
#undef AF_MF
#undef AF_EX
#undef AF_VRD
#undef AF_GA4
#undef AF_GA3
#undef AF_GA2
#undef AF_GB
#undef AF_KRD
#undef AF_PHASE_A12
#undef AF_PHASE_A8
#undef AF_PHASE_A6
#undef AF_A4
#undef AF_MX6
#undef AF_STEP
}

constexpr int ROWS_LAT = 16384;
constexpr float LOG2E_ = 1.4426950408889634f;
__device__ __forceinline__ int clampi(int v, int lo, int hi_) { return v < lo ? lo : (v > hi_ ? hi_ : v); }
struct FDense {
  static constexpr bool HAS_MASK = false;
  const bf16* Q; const bf16* kbase; const bf16* vbase; const bf16* krbase; bf16* O; int b, h, qb; static constexpr int kpitch = 2048, vpitch = 2048; const char* k6base = nullptr;
  __device__ __forceinline__ void init(const bf16* Q_, const bf16* KV, const bf16* KR, bf16* O_, int b_, int h_, int qb_) { Q = Q_; kbase = KV + 64 * h_; vbase = KV + 1024 + 64 * h_; krbase = KR; O = O_; b = b_; h = h_; qb = qb_; }
  __device__ __forceinline__ int nt() const { return 132; }
  __device__ __forceinline__ long trow(int t) const { return t < 4 ? (long)(ROWS_LAT + 256 * b + 64 * t) : (long)(8192 * b + 64 * (t - 4)); }
  __device__ __forceinline__ const bf16* qptr(int wid, int r32, int d0, int hi) const { const bf16* qp = Q + (long)(8192 * b + 256 * qb + 32 * wid + r32) * 1536;
    return d0 < 4 ? qp + 64 * h + 16 * d0 + 8 * hi : qp + 1024 + 32 * h + 16 * (d0 - 4) + 8 * hi; }
  __device__ __forceinline__ void mask(f32x16&, f32x16&, int, int, int, int) const {}
  __device__ __forceinline__ float sink(int) const { return -INFINITY; }
  __device__ __forceinline__ bf16* orow0(int wid) const { return O + (long)(8192 * b + 256 * qb + 32 * wid) * 1024 + 64 * h; }
};
struct FWin {
  static constexpr bool HAS_MASK = true; static constexpr int kpitch = 2304, vpitch = 2304;
  const bf16* QKV; const bf16* kbase; const bf16* vbase; const bf16* krbase; bf16* O; const float* sinkp; int b, n, g, hh, i0, cnt; const char* k6base;
  __device__ __forceinline__ void init(const bf16* QKV_, bf16* O_, const float* sk, int b_, int n_, int g_, int hh_, const char* K6E = nullptr) { QKV = QKV_; O = O_; sinkp = sk; b = b_; n = n_; g = g_; hh = hh_; krbase = nullptr; k6base = K6E + g_ * 3072;
    kbase = QKV_ + 512 + 64 * g_; vbase = QKV_ + 640 + 64 * g_; i0 = (n_ == 0) ? 2 : 0; cnt = (n_ == 0 || n_ == 63) ? 4 : 6; }
  __device__ __forceinline__ int nt() const { return 4 + cnt; }
  __device__ __forceinline__ int kpos0(int t) const { return 128 * (n - 1) + 64 * (i0 + t - 4); }
  __device__ __forceinline__ long trow(int t) const { return t < 4 ? (long)(ROWS_LAT + 256 * b + 64 * t) : (long)(8192 * b + kpos0(t)); }
  __device__ __forceinline__ int head(int wid) const { return 4 * g + 2 * hh + (wid >> 2); }
  __device__ __forceinline__ int qpos0(int wid) const { return 128 * n + 32 * (wid & 3); }
  __device__ __forceinline__ const bf16* qptr(int wid, int r32, int d0, int hi) const { return QKV + (long)(8192 * b + qpos0(wid) + r32) * 2304 + 64 * head(wid) + 16 * d0 + 8 * hi; }
  __device__ __forceinline__ void mask(f32x16& p0, f32x16& p1, int t, int wid, int r32, int hi) const {
    if (t < 4) return;
    const int k0 = kpos0(t), q0 = qpos0(wid);
    if (k0 - (q0 + 31) >= -128 && k0 + 63 - q0 <= 128) return;
    asm volatile("" : "+v"(r32), "+v"(hi));
    const int dq = k0 - (q0 + r32);
#pragma unroll
    for (int r = 0; r < 16; ++r) { const int d = dq + crow(r, hi); if (d > 128 || d < -128) p0[r] = -INFINITY; if (d + 32 > 128 || d + 32 < -128) p1[r] = -INFINITY; }
  }
  __device__ __forceinline__ float sink(int wid) const { return sinkp[head(wid)] * LOG2E_; }
  __device__ __forceinline__ bf16* orow0(int wid) const { return O + (long)(8192 * b + qpos0(wid)) * 1024 + 64 * head(wid); }
};
struct FNa {
  static constexpr bool HAS_MASK = true; static constexpr int kpitch = 2304, vpitch = 2304;
  const bf16* QKV; const bf16* kbase; const bf16* vbase; const bf16* krbase; bf16* O; const float* rpbl; int b, h, R4, krlo, nloc; const char* k6base;
  __device__ __forceinline__ void init(const bf16* QKV_, bf16* O_, const float* rpbl_, int b_, int h_, int R4_, const char* K6E = nullptr) { QKV = QKV_; O = O_; rpbl = rpbl_; b = b_; h = h_; R4 = R4_; krbase = nullptr; k6base = K6E + (2 + h_) * 3072;
    kbase = QKV_ + 1280 + 64 * h_; vbase = QKV_ + 1792 + 64 * h_; krlo = clampi(4 * R4_ - 4, 0, 120); nloc = clampi(4 * R4_ - 1, 0, 120) + 7 - krlo + 1; }
  __device__ __forceinline__ int nt() const { return (4 + nloc + 1) & ~1; }
  __device__ __forceinline__ long trow(int t) const { return (t < 4 || t >= 4 + nloc) ? (long)(ROWS_LAT + 256 * b + 64 * (t & 3)) : (long)(8192 * b + 64 * (krlo + t - 4)); }
  __device__ __forceinline__ int qrow(int wid) const { return 4 * R4 + (wid >> 1); }
  __device__ __forceinline__ const bf16* qptr(int wid, int r32, int d0, int hi) const { return QKV + (long)(8192 * b + 64 * qrow(wid) + 32 * (wid & 1) + r32) * 2304 + 768 + 64 * h + 16 * d0 + 8 * hi; }
  __device__ __forceinline__ void mask(f32x16& p0, f32x16& p1, int t, int wid, int r32, int hi) const {
    if (t < 4) return;
    const int kr = krlo + t - 4, w0 = clampi(qrow(wid) - 4, 0, 120);
    if (t >= 4 + nloc || kr < w0 || kr > w0 + 7) {
#pragma unroll
      for (int r = 0; r < 16; ++r) { p0[r] = -INFINITY; p1[r] = -INFINITY; }
      return; }
    asm volatile("" : "+v"(r32), "+v"(hi));
    const int qc = 32 * (wid & 1) + r32, c0 = clampi(qc - 8, 0, 48);
    const float* pb = rpbl + (kr - qrow(wid) + 7) * 31 + 15 - qc + 4 * hi;
    const unsigned t0 = (unsigned)(4 * hi - c0);
#define AF_PIN16(a) asm volatile("" : "+v"(a[0]), "+v"(a[1]), "+v"(a[2]), "+v"(a[3]), "+v"(a[4]), "+v"(a[5]), "+v"(a[6]), "+v"(a[7]), "+v"(a[8]), "+v"(a[9]), "+v"(a[10]), "+v"(a[11]), "+v"(a[12]), "+v"(a[13]), "+v"(a[14]), "+v"(a[15]))
    float bv[16];
#pragma unroll
    for (int r = 0; r < 16; ++r) bv[r] = pb[(r & 3) + 8 * (r >> 2)];
    AF_PIN16(bv);
#pragma unroll
    for (int r = 0; r < 16; ++r) { const bool ok = (t0 + (unsigned)((r & 3) + 8 * (r >> 2))) < 16u; p0[r] = ok ? p0[r] + bv[r] : -INFINITY; }
#pragma unroll
    for (int r = 0; r < 16; ++r) bv[r] = pb[32 + (r & 3) + 8 * (r >> 2)];
    AF_PIN16(bv);
#pragma unroll
    for (int r = 0; r < 16; ++r) { const bool ok = (t0 + (unsigned)(32 + (r & 3) + 8 * (r >> 2))) < 16u; p1[r] = ok ? p1[r] + bv[r] : -INFINITY; }
#undef AF_PIN16
  }
  __device__ __forceinline__ float sink(int) const { return -INFINITY; }
  __device__ __forceinline__ bf16* orow0(int wid) const { return O + (long)(8192 * b + 64 * qrow(wid) + 32 * (wid & 1)) * 1024 + 512 + 64 * h; }
};
struct FCtx {
  static constexpr bool HAS_MASK = false; static constexpr int kpitch = 2304, vpitch = 2304;
  const bf16* QKV; const bf16* kbase; const bf16* vbase; const bf16* krbase; bf16* O; const float* sinkp; int b, hx, qcol, ocol; const char* k6base;
  __device__ __forceinline__ void init(const bf16* QKV_, bf16* O_, const float* sk, int b_, int hx_, const char* K6E = nullptr) { QKV = QKV_; O = O_; sinkp = sk; b = b_; hx = hx_; krbase = nullptr; k6base = K6E + (hx_ < 8 ? (hx_ >> 2) : 2 + (hx_ - 8)) * 3072;
    if (hx_ < 8) { qcol = 64 * hx_; kbase = QKV_ + 512 + 64 * (hx_ >> 2); vbase = QKV_ + 640 + 64 * (hx_ >> 2); ocol = 64 * hx_; }
    else { const int h = hx_ - 8; qcol = 768 + 64 * h; kbase = QKV_ + 1280 + 64 * h; vbase = QKV_ + 1792 + 64 * h; ocol = 512 + 64 * h; } }
  __device__ __forceinline__ int nt() const { return 4; }
  __device__ __forceinline__ long trow(int t) const { return (long)(ROWS_LAT + 256 * b + 64 * (t & 3)); }
  __device__ __forceinline__ const bf16* qptr(int wid, int r32, int d0, int hi) const { return QKV + (long)(ROWS_LAT + 256 * b + 32 * wid + r32) * 2304 + qcol + 16 * d0 + 8 * hi; }
  __device__ __forceinline__ void mask(f32x16&, f32x16&, int, int, int, int) const {}
  __device__ __forceinline__ float sink(int) const { return hx < 8 ? sinkp[hx] * LOG2E_ : -INFINITY; }
  __device__ __forceinline__ bf16* orow0(int wid) const { return O + (long)(ROWS_LAT + 256 * b + 32 * wid) * 1024 + ocol; }
};
#undef AF_SBAR
#undef AF_WAIT_BAR
}
constexpr int NWAVES = 8;
#ifndef MK_PER_PHASE
#define MK_PER_PHASE 0
#endif
constexpr int BATCH = 2, SEQ = 8192, DM = 1024, CTXL = 256, FF = 4096;
constexpr int ML = BATCH * SEQ, MC = BATCH * CTXL, MR = ML + MC;
constexpr int NQKV = 2304, NCIN = 768, NUQ = 1536, NUKV = 2048;
constexpr float NORM_EPS = 1e-6f;
constexpr int ADA_KS = 16;
constexpr size_t MiB = 1u << 20;
constexpr size_t WS_CTL = 0, CTL_ZERO_BYTES = 64 * 1024;
constexpr size_t WS_MODP = 1 * MiB;
constexpr size_t WS_MOD = 3 * MiB + 512 * 1024;
constexpr size_t WS_ROPE = 3 * MiB + 768 * 1024;
constexpr size_t WS_ROPEP = WS_ROPE + 64 * 1024;
constexpr size_t WS_HPAR = WS_ROPE + 32 * 1024;
constexpr size_t WS_CTXRES = 4 * MiB;
constexpr size_t WS_WQKV = 6 * MiB, WS_WO0 = WS_WQKV + 4608 * 1024, WS_W1_0 = WS_WO0 + 2 * MiB, WS_W2_0 = WS_W1_0 + 8 * MiB, WS_W1_1 = WS_W2_0 + 8 * MiB, WS_W2_1 = WS_W1_1 + 8 * MiB;
constexpr size_t WS_WIN = WS_W2_1 + 8 * MiB, WS_WUQ = WS_WIN + 1536 * 1024, WS_WUKV = WS_WUQ + 1152 * 1024, WS_WO1 = WS_WUKV + 1 * MiB, WS_WEND = WS_WO1 + 2 * MiB;
constexpr size_t WS_AR = 51 * MiB;
static_assert(WS_WEND <= WS_AR, "weights overlap the arena");
constexpr size_t WS_XN = WS_AR, WS_H = WS_AR + 33 * MiB;
constexpr size_t WS_QKV = WS_AR + 33 * MiB, WS_O0 = WS_AR + 108 * MiB;
constexpr size_t WS_CQKV = WS_AR + 33 * MiB, WS_CQN = WS_AR + 58 * MiB, WS_CKVN = WS_AR + 71 * MiB, WS_KR = WS_AR + 80 * MiB, WS_Q1 = WS_AR + 82 * MiB, WS_KV1 = WS_AR + 130 * MiB, WS_O1 = WS_AR;
constexpr size_t WS_K6E = WS_AR + 150 * MiB;
constexpr size_t WS_K6N = WS_AR + 34 * MiB, WS_K6R = WS_AR + 48 * MiB;
constexpr size_t WS_PART5 = WS_AR + 33 * MiB;
constexpr size_t WS_XR = WS_AR + 166 * MiB;
constexpr size_t WS_PART8 = WS_AR + 166 * MiB;
constexpr size_t WS_END = 256 * MiB;
static_assert(WS_PART8 + (size_t)16 * 512 * 1024 * 4 <= WS_END && WS_KV1 + (size_t)MR * NUKV * 2 <= WS_END && WS_H + (size_t)MR * FF * 2 <= WS_END, "d_ws map");
constexpr int CW_BAR = 4096;
constexpr int RING_OFF = 0, RING_BYTES = 131072;
constexpr int LDSCTL_OFF = RING_BYTES, MISC_OFF = LDSCTL_OFF + 320;
constexpr int LDS_BYTES = 147456;
static_assert(att::L_END <= RING_BYTES && attf::LDS_BYTES <= RING_BYTES, "attention LDS");

#define GAS __attribute__((address_space(1)))
#define LAS __attribute__((address_space(3)))
typedef unsigned short bf16;
typedef unsigned v4u __attribute__((ext_vector_type(4)));
typedef unsigned v2u __attribute__((ext_vector_type(2)));
typedef float f32x4 __attribute__((ext_vector_type(4)));
typedef GAS unsigned gu32;
#define RLX_AGENT __ATOMIC_RELAXED, __HIP_MEMORY_SCOPE_AGENT
#define LDS_WAIT() asm volatile("s_waitcnt lgkmcnt(0)" ::: "memory")
#define VM_WAIT() asm volatile("s_waitcnt vmcnt(0)" ::: "memory")
__device__ __forceinline__ unsigned f2bf(float f) { unsigned u = __builtin_bit_cast(unsigned, f); return (u + 0x7fffu + ((u >> 16) & 1u)) >> 16; }
__device__ __forceinline__ unsigned pk2(float lo, float hi) { return f2bf(lo) | (f2bf(hi) << 16); }
__device__ __forceinline__ float bf2f(unsigned short h) { return __builtin_bit_cast(float, (unsigned)h << 16); }
__device__ __forceinline__ float bflo(unsigned w) { return __builtin_bit_cast(float, w << 16); }
__device__ __forceinline__ float bfhi(unsigned w) { return __builtin_bit_cast(float, w & 0xffff0000u); }

#define XB_TMO      128
#define XB_XCNT(j)  (256  + 64 * (j))
#define XB_XSUB(j)  (1280 + 64 * (j))
#define XB_XGEN(j)  (2304 + 64 * (j))
#define XB_TOP      3328
#define XB_TOPGEN   3392
#define XCD_BAR_WORDS 3456
#define XB_SPIN_CAP (1u << 18)

__device__ __forceinline__ unsigned xb_ld(unsigned* p)              { return __hip_atomic_load(p, __ATOMIC_RELAXED, __HIP_MEMORY_SCOPE_AGENT); }
__device__ __forceinline__ unsigned xb_add(unsigned* p, unsigned v) { return __hip_atomic_fetch_add(p, v, __ATOMIC_RELAXED, __HIP_MEMORY_SCOPE_AGENT); }
__device__ __forceinline__ unsigned xb_xcc_id() { return (unsigned)__builtin_amdgcn_s_getreg((3 << 11) | 20) & 0xFu; }
#define XB_SPIN(cond, bar) do { unsigned _sp = 0; while (cond) { __builtin_amdgcn_s_sleep(1); \
    if ((++_sp & 255u) == 0u) { if (xb_ld(&(bar)[XB_TMO])) break; if (_sp > XB_SPIN_CAP) { atomicAdd(&(bar)[XB_TMO], 1u); break; } } } } while (0)

struct XcdBarrier {
    unsigned* bar; unsigned x;
    volatile LAS unsigned* st;
};

__device__ __forceinline__ XcdBarrier xcd_barrier_post(unsigned* bar, volatile LAS unsigned* st) {
    XcdBarrier b; b.bar = bar; b.x = xb_xcc_id(); b.st = st;
    if (threadIdx.x == 0) (void)xb_add(&bar[XB_XCNT(b.x)], 1u);
    return b;
}
__device__ __forceinline__ void xcd_barrier_complete(unsigned* bar, unsigned x, unsigned& nloc, unsigned& nx) {
    const unsigned G = gridDim.x * gridDim.y * gridDim.z;
    unsigned sum, cnt, mine, sp = 0u;
    for (;;) {
        sum = 0u; cnt = 0u; mine = 0u;
#pragma unroll
        for (unsigned j = 0; j < 16; ++j) { const unsigned c = xb_ld(&bar[XB_XCNT(j)]); sum += c; cnt += (c > 0u) ? 1u : 0u; mine = (j == x) ? c : mine; }
        if (sum == G) break;
        __builtin_amdgcn_s_sleep(1);
        if ((++sp & 255u) == 0u) { if (xb_ld(&bar[XB_TMO])) break; if (sp > XB_SPIN_CAP) { atomicAdd(&bar[XB_TMO], 1u); break; } }
    }
    nloc = mine > 0u ? mine : 1u; nx = cnt > 0u ? cnt : 1u;
}

__device__ __forceinline__ void xcd_barrier(const XcdBarrier& b) {
    asm volatile("s_waitcnt vmcnt(0)" ::: "memory");
    __syncthreads();
    if (threadIdx.x == 0) {
        unsigned* bar = b.bar;
        __builtin_amdgcn_s_waitcnt(0);
        unsigned nloc = b.st[0], nx = b.st[1];
        if (nloc == 0u) { xcd_barrier_complete(bar, b.x, nloc, nx); b.st[0] = nloc; b.st[1] = nx; }
        const unsigned old = xb_add(&bar[XB_XSUB(b.x)], 1u);
        const unsigned gen = old / nloc;
        if (old + 1u == (gen + 1u) * nloc) {
            __builtin_amdgcn_fence(__ATOMIC_RELEASE, "agent");
            asm volatile("s_waitcnt vmcnt(0)" ::: "memory");
            const unsigned og = xb_add(&bar[XB_TOP], 1u);
            const unsigned tg = og / nx;
            if (og + 1u == (tg + 1u) * nx) xb_add(&bar[XB_TOPGEN], 1u);
            else XB_SPIN(xb_ld(&bar[XB_TOPGEN]) == tg, bar);
            __builtin_amdgcn_fence(__ATOMIC_ACQUIRE, "agent");
            xb_add(&bar[XB_XGEN(b.x)], 1u);
            asm volatile("s_waitcnt vmcnt(0)" ::: "memory");
        } else {
            XB_SPIN(xb_ld(&bar[XB_XGEN(b.x)]) == gen, bar);
            __builtin_amdgcn_fence(__ATOMIC_ACQUIRE, "agent");
            asm volatile("s_waitcnt vmcnt(0)" ::: "memory");
        }
    }
    __syncthreads();
}


template <int K> __device__ __forceinline__ const float* ldarg() {
    auto ka = __builtin_amdgcn_kernarg_segment_ptr();
    const __attribute__((address_space(1))) float* p; asm volatile("s_load_dwordx2 %0, %1, %2\n\ts_waitcnt lgkmcnt(0)" : "=s"(p) : "s"(ka), "i"(K * 8) : "memory"); return (const float*)p;
}
#define ARG(k) (ldarg<k>())
#define ARG_OUT ((float*)ldarg<28>())
#define ARG_WS ((unsigned char*)ldarg<29>())
struct Frame {
    LAS unsigned char* lds;
    volatile LAS unsigned* MISC;
    gu32* ctl;
    int tid, lane, wave;
    int vcu, G, bx;
    float* out; unsigned char* ws;
};
__device__ __forceinline__ float shx(float v, int mask, int lane) { return __builtin_bit_cast(float, __builtin_amdgcn_ds_bpermute((lane ^ mask) << 2, __builtin_bit_cast(int, v))); }
__device__ __forceinline__ float wave_sum(float v, int lane) {
#pragma unroll
    for (int o = 1; o < 64; o <<= 1) v += shx(v, o, lane);
    return v;
}
__device__ __forceinline__ unsigned pk4f8(float a, float b, float c, float d) { int w = 0; w = __builtin_amdgcn_cvt_pk_fp8_f32(a, b, w, false); w = __builtin_amdgcn_cvt_pk_fp8_f32(c, d, w, true); return (unsigned)w; }
__device__ __forceinline__ void p0_transpose_item(const float* W, int K, int N, bf16* WT, int pmode, LAS float* scr, int item, int lane, bool f8 = false) {
    const int nblk = N / 32, kb = item / nblk, nb = item % nblk, k0 = 64 * kb, n0 = 32 * nb;
    int r0 = n0;
    if (pmode == 1) { const int h = n0 / 96, d = n0 % 96; r0 = d < 64 ? h * 64 + d : 1024 + h * 32 + (d - 64); }
    else if (pmode == 2) { const int h = n0 / 128, d = n0 % 128; r0 = d < 64 ? h * 64 + d : 1024 + h * 64 + (d - 64); }
#pragma unroll 8
    for (int i = 0; i < 32; ++i) { const int kk = 2 * i + (lane >> 5); scr[kk * 33 + (lane & 31)] = W[(size_t)(k0 + kk) * N + n0 + (lane & 31)]; }
    LDS_WAIT(); asm volatile("" ::: "memory");
    const int c = lane & 7;
#pragma unroll
    for (int j = 0; j < 4; ++j) { const int n = (lane >> 3) + 8 * j; const LAS float* s = scr + (8 * c) * 33 + n;
        if (f8) {
            v2u o; o.x = pk4f8(s[0 * 33] * 32.f, s[1 * 33] * 32.f, s[2 * 33] * 32.f, s[3 * 33] * 32.f); o.y = pk4f8(s[4 * 33] * 32.f, s[5 * 33] * 32.f, s[6 * 33] * 32.f, s[7 * 33] * 32.f);
            *(GAS v2u*)((unsigned char*)WT + (size_t)(r0 + n) * K + k0 + 8 * c) = o; continue; }
        v4u o; o.x = pk2(s[0 * 33], s[1 * 33]); o.y = pk2(s[2 * 33], s[3 * 33]); o.z = pk2(s[4 * 33], s[5 * 33]); o.w = pk2(s[6 * 33], s[7 * 33]);
        *(GAS v4u*)(WT + (size_t)(r0 + n) * K + k0 + 8 * c) = o; }
    LDS_WAIT(); asm volatile("" ::: "memory");
}
__device__ __forceinline__ float silu_f(float v) { return v / (1.f + __expf(-v)); }

__device__ __forceinline__ void p0_prologue(Frame& F) {
    LAS float* scr = (LAS float*)(F.lds + RING_OFF + F.wave * 16384);
    const float* c = ARG(1); const float* cctx = ARG(3);
    if (F.wave >= 5) {
        for (int it = F.vcu * 3 + (F.wave - 5); it < 2 * 24 * ADA_KS; it += F.G * 3) {
            const int l = it / (24 * ADA_KS), rem = it % (24 * ADA_KS), cg = rem / ADA_KS, ks = rem % ADA_KS;
            const float* W = ARG(4) + (size_t)l * DM * 6144 + cg * 256 + 4 * F.lane;
            f32x4 a0 = {0.f, 0.f, 0.f, 0.f}, a1 = a0, a2 = a0;
            const int kbeg = ks * (DM / ADA_KS);
#pragma unroll 8
            for (int k = kbeg; k < kbeg + DM / ADA_KS; ++k) {
                const f32x4 w = *(const GAS f32x4*)(W + (size_t)k * 6144);
                const float s0 = silu_f(c[k]), s1 = silu_f(c[DM + k]), s2 = silu_f(cctx[k]);
                a0 += w * s0; a1 += w * s1; a2 += w * s2;
            }
            float* P = (float*)(F.ws + WS_MODP) + ((size_t)(ks * 2 + l) * 3) * 6144 + cg * 256 + 4 * F.lane;
            *(GAS f32x4*)(P) = a0; *(GAS f32x4*)(P + 6144) = a1; *(GAS f32x4*)(P + 2 * 6144) = a2;
        }
    } else {
        const int gw = F.vcu * 5 + F.wave, NGW = F.G * 5;
        constexpr int I_QKV = 16 * 72, I_O = 16 * 32, I_1 = 16 * 128, I_2 = 64 * 32, I_IN = 16 * 21, I_UQ = 6 * 48, I_UKV = 4 * 64;
        constexpr int NITEMS = I_QKV + I_O + 2 * I_1 + 2 * I_2 + I_IN + I_UQ + I_UKV + I_O;
        for (int it = gw; it < NITEMS; it += NGW) {
            int r = it;
            if (r < I_QKV) { p0_transpose_item(ARG(10), DM, NQKV, (bf16*)(F.ws + WS_WQKV), 0, scr, r, F.lane, true); continue; } r -= I_QKV;
            if (r < I_O) { p0_transpose_item(ARG(11), DM, DM, (bf16*)(F.ws + WS_WO0), 0, scr, r, F.lane); continue; } r -= I_O;
            if (r < I_1) { p0_transpose_item(ARG(8), DM, FF, (bf16*)(F.ws + WS_W1_0), 0, scr, r, F.lane); continue; } r -= I_1;
            if (r < I_1) { p0_transpose_item(ARG(8) + (size_t)DM * FF, DM, FF, (bf16*)(F.ws + WS_W1_1), 0, scr, r, F.lane); continue; } r -= I_1;
            if (r < I_2) { p0_transpose_item(ARG(9), FF, DM, (bf16*)(F.ws + WS_W2_0), 0, scr, r, F.lane); continue; } r -= I_2;
            if (r < I_2) { p0_transpose_item(ARG(9) + (size_t)DM * FF, FF, DM, (bf16*)(F.ws + WS_W2_1), 0, scr, r, F.lane); continue; } r -= I_2;
            if (r < I_IN) { p0_transpose_item(ARG(18), DM, 672, (bf16*)(F.ws + WS_WIN), 0, scr, r, F.lane); continue; } r -= I_IN;
            if (r < I_UQ) { p0_transpose_item(ARG(21), 384, NUQ, (bf16*)(F.ws + WS_WUQ), 1, scr, r, F.lane); continue; } r -= I_UQ;
            if (r < I_UKV) { p0_transpose_item(ARG(22), 256, NUKV, (bf16*)(F.ws + WS_WUKV), 2, scr, r, F.lane); continue; } r -= I_UKV;
            p0_transpose_item(ARG(27), DM, DM, (bf16*)(F.ws + WS_WO1), 0, scr, r, F.lane);
        }
    }
    if (F.bx == 1 % F.G) {
        float* rt = (float*)(F.ws + WS_ROPE);
        for (int e = F.tid; e < 128 * 16; e += NWAVES * 64) { const int pos = e >> 4, i = e & 15; const float inv = exp2f(-(float)i * (13.287712379549449f / 16.f));
            float x = (float)pos * inv * 0.15915494309189535f; x -= rintf(x); const float c_ = __builtin_amdgcn_cosf(x), s_ = __builtin_amdgcn_sinf(x); rt[e] = c_; rt[2048 + e] = s_; ((unsigned*)(F.ws + WS_ROPEP))[e] = pk2(c_, s_); }
        for (int e = F.tid; e < 128 * 8; e += NWAVES * 64) { const int pos = e >> 3, i = e & 7; const float inv = exp2f(-(float)i * (13.287712379549449f / 8.f));
            float x = (float)pos * inv * 0.15915494309189535f; x -= rintf(x); const float c_ = __builtin_amdgcn_cosf(x), s_ = __builtin_amdgcn_sinf(x); rt[4096 + e] = c_; rt[5120 + e] = s_; ((unsigned*)(F.ws + WS_ROPEP))[2048 + e] = pk2(c_, s_); }
    }
    if (F.bx == 3 % F.G && F.tid < 64) {
        float* hp = (float*)(F.ws + WS_HPAR); const int i = F.tid;
        hp[i] = ARG(12)[i]; hp[64 + i] = ARG(13)[i]; hp[128 + i] = ARG(15)[i]; hp[192 + i] = ARG(16)[i]; hp[256 + i] = ARG(23)[i]; hp[320 + i] = ARG(24)[i & 31]; hp[384 + i] = ARG(25)[i];
        float a = fabsf(ARG(23)[i]), b_ = fabsf(ARG(25)[i]), c_ = fabsf(ARG(24)[i & 31]), d_ = fabsf(ARG(26)[i & 31]);
#pragma unroll
        for (int o_ = 1; o_ < 64; o_ <<= 1) { a = fmaxf(a, shx(a, o_, i)); b_ = fmaxf(b_, shx(b_, o_, i)); c_ = fmaxf(c_, shx(c_, o_, i)); d_ = fmaxf(d_, shx(d_, o_, i)); }
        const float bound = (64.f * a * b_ + 32.f * c_ * d_) * (0.10206207261596575f * 1.4426950408889634f);
        if (i == 0) hp[448] = (bound < 64.f && fmaxf(fmaxf(a, b_), fmaxf(c_, d_)) < 3.f) ? 1.f : 0.f;
        { float a2 = fabsf(ARG(12)[i]), b2 = fabsf(ARG(13)[i]), c2 = fabsf(ARG(15)[i]), d2 = fabsf(ARG(16)[i]), e2 = 0.f, f2 = fabsf(ARG(14)[i & 7]);
          for (int j = i; j < 8 * 465; j += 64) e2 = fmaxf(e2, fabsf(ARG(17)[j]));
#pragma unroll
          for (int o_ = 1; o_ < 64; o_ <<= 1) { a2 = fmaxf(a2, shx(a2, o_, i)); b2 = fmaxf(b2, shx(b2, o_, i)); c2 = fmaxf(c2, shx(c2, o_, i)); d2 = fmaxf(d2, shx(d2, o_, i)); e2 = fmaxf(e2, shx(e2, o_, i)); f2 = fmaxf(f2, shx(f2, o_, i)); }
          const float bound0 = fmaxf(fmaxf(8.f * a2 * b2, 8.f * c2 * d2 + e2), f2) * 1.4426950408889634f;
          if (i == 0) hp[449] = (bound0 < 64.f && fmaxf(fmaxf(a2, b2), fmaxf(c2, d2)) < 3.f) ? 1.f : 0.f; }
    }
    if (F.bx == 2 % F.G) {
        GAS v4u* z = (GAS v4u*)((bf16*)(F.ws + WS_WIN) + (size_t)672 * DM);
        unsigned zz = 0u; asm volatile("" : "+v"(zz));
        for (int e = F.tid; e < 96 * DM / 8; e += NWAVES * 64) z[e] = (v4u){zz, zz, zz, zz};
    }
}

__device__ __forceinline__ void norm_phase(Frame& F, const float* src_lat, const float* src_ctx, int nrows, const float* gw_, int layer, int which  , bool from_partials, const float* parts = nullptr, int nparts = 0, bool lat_bf16 = false, bool xn_fp8 = false) {
    LAS float* gl = (LAS float*)(F.lds + RING_OFF); LAS float* scl = gl + 1024; LAS float* shl = scl + 3 * 1024;
    const float* modp = (const float*)(F.ws + WS_MODP); const float* mod = (const float*)(F.ws + WS_MOD); const float* ada_b = ARG(5);
    const int offsh = which * 3072, offsc = which * 3072 + 1024;
    for (int i = F.tid; i < 1024; i += NWAVES * 64) {
        gl[i] = gw_[i];
#pragma unroll
        for (int cnd = 0; cnd < 3; ++cnd) {
            float sh, sc;
            if (from_partials) { sh = ada_b[layer * 6144 + offsh + i]; sc = ada_b[layer * 6144 + offsc + i];
                float ph[ADA_KS], pc[ADA_KS];
#pragma unroll
                for (int ks = 0; ks < ADA_KS; ++ks) { const float* p = modp + ((size_t)(ks * 2 + layer) * 3 + cnd) * 6144; ph[ks] = p[offsh + i]; pc[ks] = p[offsc + i]; }
#pragma unroll
                for (int ks = 0; ks < ADA_KS; ++ks) { sh += ph[ks]; sc += pc[ks]; } }
            else { sh = mod[(layer * 3 + cnd) * 6144 + offsh + i]; sc = mod[(layer * 3 + cnd) * 6144 + offsc + i]; }
            scl[cnd * 1024 + i] = 1.f + sc; shl[cnd * 1024 + i] = sh;
        }
    }
    if (from_partials) {
        float* modw = (float*)(F.ws + WS_MOD);
        for (int e = F.vcu * (NWAVES * 64) + F.tid; e < 2 * 3 * 6144; e += F.G * NWAVES * 64) {
            const int l = e / (3 * 6144), rem = e % (3 * 6144), cnd = rem / 6144, col = rem % 6144;
            float v = ada_b[l * 6144 + col];
            float pv[ADA_KS];
#pragma unroll
            for (int ks = 0; ks < ADA_KS; ++ks) pv[ks] = modp[((size_t)(ks * 2 + l) * 3 + cnd) * 6144 + col];
#pragma unroll
            for (int ks = 0; ks < ADA_KS; ++ks) v += pv[ks];
            modw[e] = v;
        }
    }
    __syncthreads();
    bf16* XN = (bf16*)(F.ws + WS_XN);
    const int gw = F.vcu * NWAVES + F.wave, NGW = F.G * NWAVES;
    for (int m = gw; m < nrows; m += NGW) {
        const float* xrow = m < ML ? src_lat + (size_t)m * DM : src_ctx + (size_t)(m - ML) * DM;
        const int cnd = m < SEQ ? 0 : (m < ML ? 1 : 2);
        const GAS f32x4* xr = (const GAS f32x4*)xrow + F.lane;
        f32x4 v[4]; float s = 0.f;
        if (lat_bf16 && m < ML) {
            const GAS v2u* xb = (const GAS v2u*)((const bf16*)src_lat + (size_t)m * DM) + F.lane;
            v2u w[4];
#pragma unroll
            for (int j = 0; j < 4; ++j) w[j] = xb[64 * j];
#pragma unroll
            for (int j = 0; j < 4; ++j) v[j] = f32x4{bflo(w[j].x), bfhi(w[j].x), bflo(w[j].y), bfhi(w[j].y)};
        } else {
#pragma unroll
            for (int j = 0; j < 4; ++j) v[j] = xr[64 * j];
        }
        if (nparts > 0 && m >= ML) {
            for (int p = 0; p < nparts; p += 4) {
                const GAS f32x4* pr = (const GAS f32x4*)(parts + (size_t)p * (512 * 1024) + (size_t)(m - ML) * DM) + F.lane;
                f32x4 w[4][4];
#pragma unroll
                for (int q = 0; q < 4; ++q)
#pragma unroll
                    for (int j = 0; j < 4; ++j) w[q][j] = pr[(size_t)q * (512 * 1024 / 4) + 64 * j];
#pragma unroll
                for (int j = 0; j < 4; ++j) v[j] += (w[0][j] + w[1][j]) + (w[2][j] + w[3][j]); }
            GAS f32x4* cr = (GAS f32x4*)((float*)(F.ws + WS_CTXRES) + (size_t)(m - ML) * DM) + F.lane;
#pragma unroll
            for (int j = 0; j < 4; ++j) cr[64 * j] = v[j];
        }
#pragma unroll
        for (int j = 0; j < 4; ++j) s += (v[j].x * v[j].x + v[j].y * v[j].y) + (v[j].z * v[j].z + v[j].w * v[j].w);
        const float rstd = 1.f / sqrtf(wave_sum(s, F.lane) * (1.f / DM) + NORM_EPS);
        if (from_partials && m >= ML) { GAS f32x4* cr = (GAS f32x4*)((float*)(F.ws + WS_CTXRES) + (size_t)(m - ML) * DM) + F.lane;
#pragma unroll
            for (int j = 0; j < 4; ++j) cr[64 * j] = v[j]; }
        GAS v2u* o8 = (GAS v2u*)(XN + (size_t)m * DM) + F.lane;
        GAS unsigned* o4 = (GAS unsigned*)((unsigned char*)XN + (size_t)m * DM) + F.lane;
#pragma unroll
        for (int j = 0; j < 4; ++j) { const int col = 4 * F.lane + 256 * j;
            const f32x4 g = *(const LAS f32x4*)(gl + col), sc = *(const LAS f32x4*)(scl + cnd * 1024 + col), sh = *(const LAS f32x4*)(shl + cnd * 1024 + col);
            const f32x4 y = (v[j] * rstd) * g * sc + sh;
            if (xn_fp8) o4[64 * j] = pk4f8(y.x, y.y, y.z, y.w);
            else { v2u w; w.x = pk2(y.x, y.y); w.y = pk2(y.z, y.w); o8[64 * j] = w; } }
    }
    __syncthreads();
}

__device__ __forceinline__ void unpack8(const v4u w, float (&x)[8]) { x[0] = bflo(w.x); x[1] = bfhi(w.x); x[2] = bflo(w.y); x[3] = bfhi(w.y); x[4] = bflo(w.z); x[5] = bfhi(w.z); x[6] = bflo(w.w); x[7] = bfhi(w.w); }
__device__ __forceinline__ v4u pack8(const float (&x)[8]) { v4u w; w.x = pk2(x[0], x[1]); w.y = pk2(x[2], x[3]); w.z = pk2(x[4], x[5]); w.w = pk2(x[6], x[7]); return w; }

__device__ __forceinline__ void qknorm_phase(Frame& F) {
    bf16* QKV = (bf16*)(F.ws + WS_QKV);
    const float* rt = (const float*)(F.ws + WS_ROPE);
    const float* nw[4] = {ARG(12), ARG(13), ARG(15), ARG(16)};
    const float qscale = 0.125f * att::LOG2E;
    const int gw = F.vcu * NWAVES + F.wave, NGW = F.G * NWAVES;
    const int lane = F.lane, grp = lane >> 3, l8 = lane & 7;
    for (int m = gw; m < MR; m += NGW) {
        const bool lat = m < ML; const int t = m & (SEQ - 1); const int prow = t >> 6, pcol = t & 63;
        GAS v4u* rowp = (GAS v4u*)(QKV + (size_t)m * NQKV);
#pragma unroll
        for (int pass = 0; pass < 4; ++pass) {
            int type;
            if (pass == 0) type = 1; else if (pass == 1) type = grp < 2 ? 2 : (grp < 4 ? 0 : 3); else if (pass == 2) type = grp < 4 ? 3 : 4; else type = grp < 4 ? 4 : 0;
            const v4u w = rowp[pass * 64 + lane];
            float x[8]; unpack8(w, x);
            float ss = 0.f;
#pragma unroll
            for (int j = 0; j < 8; ++j) ss += x[j] * x[j];
            ss += shx(ss, 1, F.lane); ss += shx(ss, 2, F.lane); ss += shx(ss, 4, F.lane);
            const float rstd = 1.f / sqrtf(ss * (1.f / 64.f) + NORM_EPS);
            const float* g = type == 1 ? nw[0] : (type == 2 ? nw[1] : (type == 3 ? nw[2] : nw[3]));
            const f32x4 g0 = *(const GAS f32x4*)(g + l8 * 8), g1 = *(const GAS f32x4*)(g + l8 * 8 + 4);
            x[0] *= rstd * g0.x; x[1] *= rstd * g0.y; x[2] *= rstd * g0.z; x[3] *= rstd * g0.w; x[4] *= rstd * g1.x; x[5] *= rstd * g1.y; x[6] *= rstd * g1.z; x[7] *= rstd * g1.w;
            float px[8];
#pragma unroll
            for (int j = 0; j < 8; ++j) px[j] = shx(x[j], 2, F.lane);
            if (lat && (type == 1 || type == 2)) {
                const int pos = (l8 & 4) ? pcol : prow; const float* cs = rt + pos * 16 + (l8 & 1) * 8;
                const f32x4 c0 = *(const GAS f32x4*)(cs), c1 = *(const GAS f32x4*)(cs + 4), s0 = *(const GAS f32x4*)(cs + 2048), s1 = *(const GAS f32x4*)(cs + 2052);
                const float cc[8] = {c0.x, c0.y, c0.z, c0.w, c1.x, c1.y, c1.z, c1.w}, sn[8] = {s0.x, s0.y, s0.z, s0.w, s1.x, s1.y, s1.z, s1.w};
                const float sgn = (l8 & 2) ? 1.f : -1.f;
#pragma unroll
                for (int j = 0; j < 8; ++j) x[j] = x[j] * cc[j] + sgn * px[j] * sn[j];
            }
            if (type == 1 || type == 3) {
#pragma unroll
                for (int j = 0; j < 8; ++j) x[j] *= qscale;
            }
            if (type != 0) rowp[pass * 64 + lane] = pack8(x);
        }
    }
}

__device__ __forceinline__ void cnorm_phase(Frame& F) {
    const bf16* CQKV = (const bf16*)(F.ws + WS_CQKV); bf16* CQN = (bf16*)(F.ws + WS_CQN); bf16* CKVN = (bf16*)(F.ws + WS_CKVN); bf16* KR = (bf16*)(F.ws + WS_KR);
    const float* rt = (const float*)(F.ws + WS_ROPE) + 4096;
    const float* gq = ARG(19); const float* gkv = ARG(20); const float* gkr = ARG(26);
    const int gw = F.vcu * NWAVES + F.wave, NGW = F.G * NWAVES; const int lane = F.lane;
    for (int m = gw; m < MR; m += NGW) {
        const bool lat = m < ML; const int t = m & (SEQ - 1); const int prow = t >> 6, pcol = t & 63;
        const GAS v4u* rowp = (const GAS v4u*)(CQKV + (size_t)m * NCIN);
        const v4u w0 = rowp[lane]; v4u w1 = {0u, 0u, 0u, 0u}; if (lane < 32) w1 = rowp[64 + lane];
        float x0[8], x1[8]; unpack8(w0, x0); unpack8(w1, x1);
        float s0 = 0.f, s1 = 0.f;
#pragma unroll
        for (int j = 0; j < 8; ++j) { s0 += x0[j] * x0[j]; s1 += x1[j] * x1[j]; }
        const float ssq = wave_sum(lane < 48 ? s0 : 0.f, F.lane);
        const float sskv = wave_sum((lane >= 48 ? s0 : 0.f) + (lane < 16 ? s1 : 0.f), F.lane);
        const float sskr = wave_sum((lane >= 16 && lane < 20) ? s1 : 0.f, F.lane);
        const float rq = 1.f / sqrtf(ssq * (1.f / 384.f) + NORM_EPS), rkv = 1.f / sqrtf(sskv * (1.f / 256.f) + NORM_EPS), rkr = 1.f / sqrtf(sskr * (1.f / 32.f) + NORM_EPS);
        { const float* g = lane < 48 ? gq + lane * 8 : gkv + (lane - 48) * 8; const float r = lane < 48 ? rq : rkv;
          const f32x4 g0 = *(const GAS f32x4*)(g), g1 = *(const GAS f32x4*)(g + 4);
          float y[8] = {x0[0] * r * g0.x, x0[1] * r * g0.y, x0[2] * r * g0.z, x0[3] * r * g0.w, x0[4] * r * g1.x, x0[5] * r * g1.y, x0[6] * r * g1.z, x0[7] * r * g1.w};
          if (lane < 48) *(GAS v4u*)(CQN + (size_t)m * 384 + lane * 8) = pack8(y); else *(GAS v4u*)(CKVN + (size_t)m * 256 + (lane - 48) * 8) = pack8(y); }
        { const int li = lane < 16 ? lane : (lane < 20 ? lane - 16 : 0);
          const float* g = lane < 16 ? gkv + 128 + li * 8 : gkr + li * 8; const float r = lane < 16 ? rkv : rkr;
          const f32x4 g0 = *(const GAS f32x4*)(g), g1 = *(const GAS f32x4*)(g + 4);
          float y[8] = {x1[0] * r * g0.x, x1[1] * r * g0.y, x1[2] * r * g0.z, x1[3] * r * g0.w, x1[4] * r * g1.x, x1[5] * r * g1.y, x1[6] * r * g1.z, x1[7] * r * g1.w};
          float py[8];
#pragma unroll
          for (int j = 0; j < 8; ++j) py[j] = shx(y[j], 1, F.lane);
          if (lat && lane >= 16 && lane < 20) {
              const int pos = (lane & 2) ? pcol : prow; const float* cs = rt + pos * 8;
              const f32x4 c0 = *(const GAS f32x4*)(cs), c1 = *(const GAS f32x4*)(cs + 4), sa = *(const GAS f32x4*)(cs + 1024), sb = *(const GAS f32x4*)(cs + 1028);
              const float cc[8] = {c0.x, c0.y, c0.z, c0.w, c1.x, c1.y, c1.z, c1.w}, sn[8] = {sa.x, sa.y, sa.z, sa.w, sb.x, sb.y, sb.z, sb.w};
              const float sgn = (lane & 1) ? 1.f : -1.f;
#pragma unroll
              for (int j = 0; j < 8; ++j) y[j] = y[j] * cc[j] + sgn * py[j] * sn[j];
          }
          if (lane < 16) *(GAS v4u*)(CKVN + (size_t)m * 256 + 128 + lane * 8) = pack8(y);
          else if (lane < 20) *(GAS v4u*)(KR + (size_t)m * 32 + (lane - 16) * 8) = pack8(y); }
    }
}

__device__ __forceinline__ void hnorm_phase(Frame& F) {
    bf16* Q = (bf16*)(F.ws + WS_Q1); bf16* KV = (bf16*)(F.ws + WS_KV1);
    const float* rt = (const float*)(F.ws + WS_ROPE) + 4096;
    const float* gqn = ARG(23); const float* gqr = ARG(24); const float* gkn = ARG(25);
    const float qscale = 0.10206207261596575f * att::LOG2E;
    const int gw = F.vcu * NWAVES + F.wave, NGW = F.G * NWAVES; const int lane = F.lane, l8 = lane & 7, l4 = lane & 3;
    for (int m = gw; m < MR; m += NGW) {
        const bool lat = m < ML; const int t = m & (SEQ - 1); const int prow = t >> 6, pcol = t & 63;
        { GAS v4u* rowp = (GAS v4u*)(KV + (size_t)m * NUKV);
          const f32x4 g0 = *(const GAS f32x4*)(gkn + l8 * 8), g1 = *(const GAS f32x4*)(gkn + l8 * 8 + 4);
#pragma unroll
          for (int pass = 0; pass < 2; ++pass) {
              float x[8]; unpack8(rowp[pass * 64 + lane], x); float ss = 0.f;
#pragma unroll
              for (int j = 0; j < 8; ++j) ss += x[j] * x[j];
              ss += shx(ss, 1, F.lane); ss += shx(ss, 2, F.lane); ss += shx(ss, 4, F.lane);
              const float r = 1.f / sqrtf(ss * (1.f / 64.f) + NORM_EPS);
              x[0] *= r * g0.x; x[1] *= r * g0.y; x[2] *= r * g0.z; x[3] *= r * g0.w; x[4] *= r * g1.x; x[5] *= r * g1.y; x[6] *= r * g1.z; x[7] *= r * g1.w;
              rowp[pass * 64 + lane] = pack8(x); } }
        if (lat) {
            GAS v4u* rowp = (GAS v4u*)(Q + (size_t)m * NUQ);
            { const f32x4 g0 = *(const GAS f32x4*)(gqn + l8 * 8), g1 = *(const GAS f32x4*)(gqn + l8 * 8 + 4);
#pragma unroll
              for (int pass = 0; pass < 2; ++pass) {
                  float x[8]; unpack8(rowp[pass * 64 + lane], x); float ss = 0.f;
#pragma unroll
                  for (int j = 0; j < 8; ++j) ss += x[j] * x[j];
                  ss += shx(ss, 1, F.lane); ss += shx(ss, 2, F.lane); ss += shx(ss, 4, F.lane);
                  const float r = qscale / sqrtf(ss * (1.f / 64.f) + NORM_EPS);
                  x[0] *= r * g0.x; x[1] *= r * g0.y; x[2] *= r * g0.z; x[3] *= r * g0.w; x[4] *= r * g1.x; x[5] *= r * g1.y; x[6] *= r * g1.z; x[7] *= r * g1.w;
                  rowp[pass * 64 + lane] = pack8(x); } }
            {
              const f32x4 g0 = *(const GAS f32x4*)(gqr + l4 * 8), g1 = *(const GAS f32x4*)(gqr + l4 * 8 + 4);
              float x[8]; unpack8(rowp[128 + lane], x); float ss = 0.f;
#pragma unroll
              for (int j = 0; j < 8; ++j) ss += x[j] * x[j];
              ss += shx(ss, 1, F.lane); ss += shx(ss, 2, F.lane);
              const float r = 1.f / sqrtf(ss * (1.f / 32.f) + NORM_EPS);
              x[0] *= r * g0.x; x[1] *= r * g0.y; x[2] *= r * g0.z; x[3] *= r * g0.w; x[4] *= r * g1.x; x[5] *= r * g1.y; x[6] *= r * g1.z; x[7] *= r * g1.w;
              float px[8];
#pragma unroll
              for (int j = 0; j < 8; ++j) px[j] = shx(x[j], 1, F.lane);
              const int pos = (l4 & 2) ? pcol : prow; const float* cs = rt + pos * 8;
              const f32x4 c0 = *(const GAS f32x4*)(cs), c1 = *(const GAS f32x4*)(cs + 4), sa = *(const GAS f32x4*)(cs + 1024), sb = *(const GAS f32x4*)(cs + 1028);
              const float cc[8] = {c0.x, c0.y, c0.z, c0.w, c1.x, c1.y, c1.z, c1.w}, sn[8] = {sa.x, sa.y, sa.z, sa.w, sb.x, sb.y, sb.z, sb.w};
              const float sgn = (l4 & 1) ? 1.f : -1.f;
#pragma unroll
              for (int j = 0; j < 8; ++j) x[j] = (x[j] * cc[j] + sgn * px[j] * sn[j]) * qscale;
              rowp[128 + lane] = pack8(x); }
        }
    }
}

__device__ __forceinline__ void kr6_pass(Frame& F) {
    if (((const float*)(F.ws + WS_HPAR))[448] == 0.f) return;
    const bf16* KR = (const bf16*)(F.ws + WS_KR); unsigned char* K6R = (unsigned char*)(F.ws + WS_K6R);
    for (int r = F.vcu * (NWAVES * 64) + F.tid; r < MR; r += F.G * (NWAVES * 64)) {
        const GAS v4u* rp = (const GAS v4u*)(KR + (size_t)r * 32);
        v4u w[4] = {rp[0], rp[1], rp[2], rp[3]};
#pragma unroll
        for (int q = 0; q < 4; ++q) { float x[8]; unpack8(w[q], x);
#pragma unroll
            for (int j = 0; j < 8; ++j) x[j] *= 1.5349124f;
            w[q] = pack8(x); }
        const attd::u32x6 c = attd::to_fp6(w[0], w[1], w[2], w[3]);
        unsigned char* img = K6R + (size_t)(r >> 6) * 2048; const int key = r & 63;
        *(GAS v4u*)(img + key * 16) = (v4u){c[0], c[1], c[2], c[3]}; *(GAS v2u*)(img + 1024 + key * 8) = (v2u){c[4], c[5]};
    }
}
__device__ __forceinline__ void attn0_phase(Frame& F) {
    att::lchar* lds = (att::lchar*)(F.lds + RING_OFF);
    const att::bf16* QKV = (const att::bf16*)(F.ws + WS_QKV); att::bf16* O = (att::bf16*)(F.ws + WS_O0);
    const bool fast = __builtin_amdgcn_readfirstlane(__builtin_bit_cast(int, ((const float*)(F.ws + WS_HPAR))[449])) != 0;
    const char* K6E = (const char*)(F.ws + WS_K6E);
    char* shm = (char*)(F.lds + RING_OFF);
    for (int ui = F.vcu; ui < 1056; ui += F.G) {
        if (ui < 512) {
            const int b = ui >> 8, h = (ui >> 5) & 7, R4 = ui & 31;
            const float* rpb = ARG(17) + h * 465;
            if (fast) {
                float* rl = (float*)(shm + attf::LDS_RPB);
                for (int i = F.tid; i < 465; i += NWAVES * 64) rl[i] = rpb[i] * att::LOG2E;
                __syncthreads();
                attf::FNa fu; fu.init((const attf::bf16*)QKV, (attf::bf16*)O, rl, b, h, R4, K6E);
                attf::fast_unit<8, attf::FNa, true>(fu, shm, F.tid);
            } else {
                att::UNa u; u.QKV = QKV; u.O = O; u.rpbl = (const LAS float*)(lds + att::L_RPB); u.b = b; u.h = h; u.R4 = R4; u.init();
                for (int i = F.tid; i < 465; i += NWAVES * 64) ((LAS float*)(lds + att::L_RPB))[i] = rpb[i] * att::LOG2E;
                att::unit<8, att::UNa>(u, lds, F.tid);
            }
        } else if (ui < 1024) {
            const int v = ui - 512;
            if (fast) { attf::FWin fu; fu.init((const attf::bf16*)QKV, (attf::bf16*)O, ARG(14), v >> 8, (v >> 2) & 63, (v >> 1) & 1, v & 1, K6E); attf::fast_unit<8, attf::FWin, true>(fu, shm, F.tid); }
            else { att::UWin u; u.QKV = QKV; u.O = O; u.sinkp = ARG(14); u.b = v >> 8; u.n = (v >> 2) & 63; u.g = (v >> 1) & 1; u.hh = v & 1; u.init(); att::unit<8, att::UWin>(u, lds, F.tid); }
        } else {
            const int v = ui - 1024;
            if (fast) { attf::FCtx fu; fu.init((const attf::bf16*)QKV, (attf::bf16*)O, ARG(14), v >> 4, v & 15, K6E); attf::fast_unit<8, attf::FCtx, true>(fu, shm, F.tid); }
            else { att::UCtx u; u.QKV = QKV; u.O = O; u.sinkp = ARG(14); u.b = v >> 4; u.hx = v & 15; u.init(); att::unit<8, att::UCtx>(u, lds, F.tid); }
        }
    }
}
__device__ __forceinline__ void attn1_phase(Frame& F) {
    att::lchar* lds = (att::lchar*)(F.lds + RING_OFF);
    const bool fast = __builtin_amdgcn_readfirstlane(__builtin_bit_cast(int, ((const float*)(F.ws + WS_HPAR))[448])) != 0;
    const bool g256 = F.G == 256; const int x = F.vcu >> 5, j = F.vcu & 31;
    const int nit = g256 ? 4 : (F.vcu < 1024 ? (1024 - F.vcu + F.G - 1) / F.G : 0);
    for (int i = 0; i < nit; ++i) {
        const int ui = g256 ? ((x * 4 + i) * 32 + j) : F.vcu + i * F.G;
        if (fast) attd::dense_unit(ui >> 9, (ui >> 5) & 15, ui & 31, (const attd::bf16*)(F.ws + WS_Q1), (const attd::bf16*)(F.ws + WS_KV1), (const char*)(F.ws + WS_K6N), (const char*)(F.ws + WS_K6R), (attd::bf16*)(F.ws + WS_O1), (char*)(F.lds + RING_OFF), F.tid);
        else {
        att::UDense u; u.Q = (const att::bf16*)(F.ws + WS_Q1); u.KV = (const att::bf16*)(F.ws + WS_KV1); u.KR = (const att::bf16*)(F.ws + WS_KR); u.O = (att::bf16*)(F.ws + WS_O1);
        u.b = ui >> 9; u.h = (ui >> 5) & 15; u.qb = ui & 31;
        att::unit<12, att::UDense>(u, lds, F.tid); }
    }
}

#ifndef PHASE_MASK
#define PHASE_MASK 0xFFFFFu
#endif
#ifndef PHASE_REP
#define PHASE_REP 0u
#endif
struct Args { const float* in[28]; float* out; unsigned char* ws; int ph_lo, ph_hi; };
constexpr int N_PHASES = 19;
__global__ void __launch_bounds__(NWAVES * 64, 2) fwd_kernel(Args args) {
    extern __shared__ __attribute__((aligned(16))) unsigned char lds[];
    for (int u = threadIdx.x; u < (LDS_BYTES - LDSCTL_OFF) / 4; u += NWAVES * 64) ((LAS unsigned*)((LAS unsigned char*)lds + LDSCTL_OFF))[u] = 0u;
    __syncthreads();
    if (!MK_PER_PHASE) (void)xcd_barrier_post((unsigned*)((gu32*)(ARG_WS + WS_CTL) + CW_BAR), (volatile LAS unsigned*)((LAS unsigned char*)lds + MISC_OFF) + 8);
    const int wv0_ = __builtin_amdgcn_readfirstlane((int)threadIdx.x >> 6);
    for (int ph2 = 2 * args.ph_lo; ph2 < 2 * args.ph_hi; ++ph2) {
        const int ph = ph2 >> 1; if ((ph2 & 1) && !((PHASE_REP >> ph) & 1)) continue;
        if (ph == 3 || ph == 14) continue;
        Frame F;
        { int t_ = wv0_ * 64 + (int)__builtin_amdgcn_mbcnt_hi(~0u, __builtin_amdgcn_mbcnt_lo(~0u, 0u)); asm volatile("" : "+v"(t_)); int b_ = blockIdx.x; asm volatile("" : "+s"(b_)); int g_ = gridDim.x; asm volatile("" : "+s"(g_)); F.tid = t_; F.bx = b_; F.G = g_; }
        F.lds = (LAS unsigned char*)lds; F.MISC = (volatile LAS unsigned*)(F.lds + MISC_OFF);
        F.lane = F.tid & 63; F.wave = __builtin_amdgcn_readfirstlane(F.tid >> 6);
        F.vcu = (F.G % 8 == 0) ? (F.bx % 8) * (F.G / 8) + F.bx / 8 : F.bx;
        F.ws = ARG_WS; F.out = ARG_OUT; F.ctl = (gu32*)(F.ws + WS_CTL);
        XcdBarrier bar; bar.bar = (unsigned*)(F.ctl + CW_BAR); bar.x = xb_xcc_id(); bar.st = F.MISC + 8;
        float* ctxres = (float*)(F.ws + WS_CTXRES);
        const float* mod = (const float*)(F.ws + WS_MOD);
        int gk = 0, xrows = 0, xS = 0;
        pg8::Gemm g{nullptr, nullptr, 0, 0, 0, 0}; pg8::EpiAny ea{0, nullptr, nullptr, nullptr, nullptr, 0, 0};
        switch (ph) {
        case 0: if (!((PHASE_MASK >> 0) & 1)) break; p0_prologue(F); break;
        case 1: if (!((PHASE_MASK >> 1) & 1)) break; norm_phase(F, ARG(0), ARG(2), MR, ARG(6), 0, 0, true, nullptr, 0, false, true); break;
        case 2: if (!((PHASE_MASK >> 2) & 1)) break; gk = 1; g = pg8::Gemm{(const bf16*)(F.ws + WS_XN), (const bf16*)(F.ws + WS_WQKV), MR, NQKV, DM / 2, 1}; ea = pg8::EpiAny{3, (const float*)(F.ws + WS_HPAR), (void*)(F.ws + WS_QKV), (float*)(F.ws + WS_K6E), (const float*)(F.ws + WS_ROPEP), NQKV, 0}; break;
        case 4: if (!((PHASE_MASK >> 4) & 1)) break; attn0_phase(F); break;
        case 5: if (!((PHASE_MASK >> 5) & 1)) break; gk = 2; g = pg8::Gemm{(const bf16*)(F.ws + WS_O0), (const bf16*)(F.ws + WS_WO0), ML, DM, DM}; xrows = MC; xS = 2; ea = pg8::EpiAny{2, ARG(0), (void*)F.out, (float*)(F.ws + WS_PART5), mod + 2048, 0, 2}; break;
        case 6: if (!((PHASE_MASK >> 6) & 1)) break; norm_phase(F, F.out, ctxres, MR, ARG(7), 0, 1, false, (const float*)(F.ws + WS_PART5), 4, true); break;
        case 7: if (!((PHASE_MASK >> 7) & 1)) break; gk = 1; g = pg8::Gemm{(const bf16*)(F.ws + WS_XN), (const bf16*)(F.ws + WS_W1_0), MR, FF, DM}; ea = pg8::EpiAny{1, nullptr, (void*)(F.ws + WS_H), nullptr, nullptr, FF, 1}; break;
        case 8: if (!((PHASE_MASK >> 8) & 1)) break; gk = 2; g = pg8::Gemm{(const bf16*)(F.ws + WS_H), (const bf16*)(F.ws + WS_W2_0), ML, DM, FF}; xrows = MC; xS = 4; ea = pg8::EpiAny{2, F.out, (void*)F.out, (float*)(F.ws + WS_PART8), mod + 5120, 0, 3}; break;
        case 9: if (!((PHASE_MASK >> 9) & 1)) break; norm_phase(F, F.out, ctxres, MR, ARG(6) + DM, 1, 0, false, (const float*)(F.ws + WS_PART8), 16, true); break;
        case 10: if (!((PHASE_MASK >> 10) & 1)) break; gk = 1; g = pg8::Gemm{(const bf16*)(F.ws + WS_XN), (const bf16*)(F.ws + WS_WIN), MR, NCIN, DM}; ea = pg8::EpiAny{1, nullptr, (void*)(F.ws + WS_CQKV), nullptr, nullptr, NCIN, 0}; break;
        case 11: if (!((PHASE_MASK >> 11) & 1)) break; cnorm_phase(F); break;
        case 12: if (!((PHASE_MASK >> 12) & 1)) break; kr6_pass(F); gk = 1; g = pg8::Gemm{(const bf16*)(F.ws + WS_CQN), (const bf16*)(F.ws + WS_WUQ), ML, NUQ, 384}; ea = pg8::EpiAny{3, (const float*)(F.ws + WS_HPAR), (void*)(F.ws + WS_Q1), nullptr, (const float*)(F.ws + WS_ROPEP), NUQ, 1}; break;
        case 13: if (!((PHASE_MASK >> 13) & 1)) break; gk = 1; g = pg8::Gemm{(const bf16*)(F.ws + WS_CKVN), (const bf16*)(F.ws + WS_WUKV), MR, NUKV, 256}; ea = pg8::EpiAny{3, (const float*)(F.ws + WS_HPAR), (void*)(F.ws + WS_KV1), (float*)(F.ws + WS_K6N), (const float*)(F.ws + WS_ROPEP), NUKV, 2}; break;
        case 15: if (!((PHASE_MASK >> 15) & 1)) break; attn1_phase(F); break;
        case 16: if (!((PHASE_MASK >> 16) & 1)) break; gk = 2; g = pg8::Gemm{(const bf16*)(F.ws + WS_O1), (const bf16*)(F.ws + WS_WO1), ML, DM, DM}; ea = pg8::EpiAny{2, F.out, (void*)(F.ws + WS_XR), ctxres, mod + 3 * 6144 + 2048, 0, 3}; break;
        case 17: if (!((PHASE_MASK >> 17) & 1)) break; norm_phase(F, (const float*)(F.ws + WS_XR), ctxres, ML, ARG(7) + DM, 1, 1, false, nullptr, 0, true); break;
        case 18: if (!((PHASE_MASK >> 18) & 1)) break; gk = 1; g = pg8::Gemm{(const bf16*)(F.ws + WS_XN), (const bf16*)(F.ws + WS_W1_1), ML, FF, DM}; ea = pg8::EpiAny{1, nullptr, (void*)(F.ws + WS_H), nullptr, nullptr, FF, 1}; break;
        case 19: if (!((PHASE_MASK >> 19) & 1)) break; gk = 2; g = pg8::Gemm{(const bf16*)(F.ws + WS_H), (const bf16*)(F.ws + WS_W2_1), ML, DM, FF}; ea = pg8::EpiAny{2, (const float*)(F.ws + WS_XR), (void*)F.out, ctxres, mod + 3 * 6144 + 5120, 0, 1}; break;
        default: break;
        }
        ea.scr = F.lds + LDSCTL_OFF + 4096;
        if (gk != 0) { pg8::StaticOrder S; S.init(g.M, g.N, g.K, F.G, F.bx, xrows, xS);
            if (g.mx) pg8::gemm_phase<pg8::EpiAny, pg8::StaticOrder, true, true, true>(F.lds + RING_OFF, g, S, ea, F.tid);
            else pg8::gemm_phase<pg8::EpiAny, pg8::StaticOrder, true, true, false>(F.lds + RING_OFF, g, S, ea, F.tid); }
        const bool last_ = (ph == args.ph_hi - 1) && ((ph2 & 1) || !((PHASE_REP >> ph) & 1));
        if (!MK_PER_PHASE && !last_ && ph != 12) xcd_barrier(bar);
        else __syncthreads();
    }
}

extern "C" void kernel_launch(void* const* d_in, const int* in_sizes, int n_in, void* d_out, int out_size, void* d_ws, size_t ws_size, hipStream_t stream) {
    static int grid = 0;
    if (grid == 0) {
        if (n_in != 28 || in_sizes[0] != ML * DM || out_size != ML * DM || ws_size < WS_END) { fprintf(stderr, "kernel_launch: unexpected shapes: n_in %d in0 %d out %d ws %zu\n", n_in, n_in > 0 ? in_sizes[0] : -1, out_size, ws_size); grid = -1; return; }
        int dev = 0, cus = 0, per_cu = 0;
        if (hipGetDevice(&dev) != hipSuccess || hipDeviceGetAttribute(&cus, hipDeviceAttributeMultiprocessorCount, dev) != hipSuccess) { fprintf(stderr, "kernel_launch: device query failed\n"); grid = -1; return; }
        if (hipFuncSetAttribute((const void*)fwd_kernel, hipFuncAttributeMaxDynamicSharedMemorySize, LDS_BYTES) != hipSuccess) { fprintf(stderr, "kernel_launch: hipFuncSetAttribute failed\n"); grid = -1; return; }
        if (hipOccupancyMaxActiveBlocksPerMultiprocessor(&per_cu, (const void*)fwd_kernel, NWAVES * 64, LDS_BYTES) != hipSuccess || per_cu < 1)
            fprintf(stderr, "kernel_launch: note: occupancy query reports %d workgroups per CU\n", per_cu);
        (void)hipGetLastError();
        grid = cus;
    }
    if (grid < 0) return;
    if (hipMemsetAsync((char*)d_ws + WS_CTL, 0, CTL_ZERO_BYTES, stream) != hipSuccess) { fprintf(stderr, "kernel_launch: hipMemsetAsync failed\n"); return; }
    Args a{};
    for (int i = 0; i < 28; ++i) a.in[i] = (const float*)d_in[i];
    a.out = (float*)d_out; a.ws = (unsigned char*)d_ws;
#if MK_PER_PHASE
    for (int ph = 0; ph <= N_PHASES; ++ph) { a.ph_lo = ph; a.ph_hi = ph + 1; hipLaunchKernelGGL(fwd_kernel, dim3(grid), dim3(NWAVES * 64), LDS_BYTES, stream, a); }
#else
    a.ph_lo = 0; a.ph_hi = N_PHASES + 1;
    hipLaunchKernelGGL(fwd_kernel, dim3(grid), dim3(NWAVES * 64), LDS_BYTES, stream, a);
#endif
    const hipError_t le = hipPeekAtLastError();
    if (le != hipSuccess) fprintf(stderr, "kernel_launch: launch failed: %s\n", hipGetErrorName(le));
}
```

```cpp
#include <hip/hip_runtime.h>
#include <cstdio>
#include <cstdint>
namespace pg8 {
#define PG8_LAS __attribute__((address_space(3)))
typedef unsigned short bf16_t;
typedef short bf16x8 __attribute__((ext_vector_type(8)));
typedef float f32x4 __attribute__((ext_vector_type(4)));
typedef unsigned u32x4 __attribute__((ext_vector_type(4)));
typedef unsigned u32x2 __attribute__((ext_vector_type(2)));
typedef unsigned u32x6 __attribute__((ext_vector_type(6)));
typedef unsigned u32x16 __attribute__((ext_vector_type(16)));
typedef __bf16 bf16x32 __attribute__((ext_vector_type(32)));
constexpr int BM = 256, BK = 64, HALF = 128, HTB = HALF * BK * 2  , STAGE_BYTES = 8 * HTB, NXCD = 8, WGM = 8;

__host__ __device__ __forceinline__ int lds_byte(int r, int c) { const int st = (r >> 4) * 2 + (c >> 5), rr = r & 15, cc = c & 31, ob = rr * 64 + cc * 2; return st * 1024 + (ob ^ (((ob >> 9) & 1) << 5)); }
__host__ __device__ __forceinline__ void stage_rc(int b, int& R, int& C) { const int st = b / 1024, sb = b % 1024, swz = sb ^ (((sb >> 9) & 1) << 5); R = (st >> 1) * 16 + swz / 64; C = (st & 1) * 32 + (swz % 64) / 2; }
__host__ __device__ __forceinline__ int perm32(int rho) { const int n = rho >> 4, i = rho & 15; return 8 * (i >> 2) + 4 * n + (i & 3); }

struct Unit { int pm, pn, kinfo; };
struct Gemm { const bf16_t* A; const bf16_t* Bt; int M, N, K; int mx = 0; };

struct StaticOrder {
    int nM, nN, nwg, G, c, ntK;
    int xtiles, xsh;
    __host__ __device__ void init(int M, int N, int K, int G_, int c_, int extra_rows = 0, int S = 1) { nM = M / BM; nN = N / BM; nwg = nM * nN; G = G_; c = c_; ntK = K / BK;
        xtiles = (extra_rows / BM) * nN; xsh = S; }
    __host__ __device__ bool next(int i, Unit& u) const {
        const long L = (long)i * G + c;
        if (L >= nwg) {
            if (xtiles == 0) return false;
            const int nb = (nwg - c + G - 1) / G;
            const int nbc = c < nwg ? nb : 0;
            const long e = (long)(i - nbc) * G + ((c + G - (nwg % G)) % G);
            if (e >= ((long)xtiles << xsh)) return false;
            const int tile = (int)(e >> xsh), ks = (int)e & ((1 << xsh) - 1), xnt = ntK >> xsh;
            u.pm = nM + tile / nN; u.pn = tile % nN; u.kinfo = (ks * xnt) | (xnt << 8) | (1 << 16); return true;
        }
        int wgid = (int)L; { const int q = nwg / NXCD, r = nwg % NXCD, xcd = wgid % NXCD, off = wgid / NXCD; wgid = (xcd < r ? xcd * (q + 1) : r * (q + 1) + (xcd - r) * q) + off; }
        const int nig = WGM * nN, gid = wgid / nig, fm = gid * WGM, gsz = (nM - fm) < WGM ? (nM - fm) : WGM;
        u.pm = fm + ((wgid % nig) % gsz); u.pn = (wgid % nig) / gsz; u.kinfo = ntK << 8; return true;
    }
    __device__ __forceinline__ void a_ready(const Unit&) const {}
    __device__ __forceinline__ void done(const Unit&) const {}
};

__device__ __forceinline__ unsigned cvt_pk_bf16(float lo, float hi) { unsigned r; asm volatile("v_cvt_pk_bf16_f32 %0, %1, %2" : "=v"(r) : "v"(lo), "v"(hi)); return r; }
__device__ __forceinline__ u32x2 pk4bf(f32x4 y) { u32x2 r; r.x = cvt_pk_bf16(y[0], y[1]); r.y = cvt_pk_bf16(y[2], y[3]); return r; }
__device__ __forceinline__ f32x4 unpk4bf(u32x2 w) { f32x4 r; r[0] = __builtin_bit_cast(float, w.x << 16); r[1] = __builtin_bit_cast(float, w.x & 0xffff0000u); r[2] = __builtin_bit_cast(float, w.y << 16); r[3] = __builtin_bit_cast(float, w.y & 0xffff0000u); return r; }
struct EpiAny {
    static constexpr bool AFTER_DRAIN = false;
    int mode; const float* base; void* out; float* ctxres; const float* gate; int ldc, relu2; PG8_LAS unsigned char* scr = nullptr;
    __device__ __forceinline__ bool perm() const { return mode == 1; }
    __device__ __forceinline__ bool headmode() const { return mode == 3; }
    __device__ __forceinline__ static float xsh(float v, int mask, int lane) { return __builtin_bit_cast(float, __builtin_amdgcn_ds_bpermute((lane ^ mask) << 2, __builtin_bit_cast(int, v))); }
    __device__ __forceinline__ void head_epilogue(const f32x4 (&acc)[2][2][4][2], const Unit& u, int wr, int wc, int fr, int fq) const {
        const int H = 4 * u.pn + wc, kind = relu2, lane = fr + 16 * fq;
        const bool f6 = kind != 0 && base[448] != 0.f;
        const bool f6e = kind == 0 && base[449] != 0.f;
        int cls, gsel; float qs = 1.f;
        if (kind == 0) { const float qq = f6e ? 1.6986436f : 0.125f * 1.4426950408889634f, kq = f6e ? 1.6986436f : 1.f;
                         if (H < 8) { cls = 2; gsel = 0; qs = qq; } else if (H < 10) { cls = 2; gsel = 1; qs = kq; } else if (H < 12) { cls = 0; gsel = 0; }
                         else if (H < 20) { cls = 1; gsel = 2; qs = qq; } else if (H < 28) { cls = 1; gsel = 3; qs = kq; } else { cls = 0; gsel = 0; } }
        else if (kind == 1) { qs = f6 ? 1.5349124f : 0.10206207261596575f * 1.4426950408889634f; if (H < 16) { cls = 1; gsel = 4; } else { cls = 3; gsel = 5; } }
        else { if (H < 16) { cls = 1; gsel = 6; if (f6) qs = 1.5349124f; } else { cls = 0; gsel = 0; } }
        const bool lat = u.pm < 64;
        const bool k6e = f6e && (H == 8 || H == 9 || (H >= 20 && H < 28));
        const bool k6 = (f6 && kind == 2 && H < 16) || k6e;
        bf16_t* O = (bf16_t*)out;
        const int col0 = u.pn * BM + 64 * wc + 8 * fq;
        f32x4 gv[2][2];
#pragma unroll
        for (int bj = 0; bj < 2; ++bj)
#pragma unroll
            for (int n = 0; n < 2; ++n) gv[bj][n] = *(const f32x4*)(base + gsel * 64 + 32 * bj + 8 * fq + 4 * n);
#pragma unroll
        for (int ai = 0; ai < 2; ++ai)
#pragma unroll
            for (int m = 0; m < 4; ++m) {
                const int row = u.pm * BM + ai * HALF + wr * 64 + m * 16 + fr;
                f32x4 v[2][2];
#pragma unroll
                for (int bj = 0; bj < 2; ++bj)
#pragma unroll
                    for (int n = 0; n < 2; ++n) v[bj][n] = acc[ai][bj][m][n];
                if (cls != 0) {
                    float s0 = 0.f, s1 = 0.f;
#pragma unroll
                    for (int n = 0; n < 2; ++n)
#pragma unroll
                        for (int e = 0; e < 4; ++e) { s0 += v[0][n][e] * v[0][n][e]; s1 += v[1][n][e] * v[1][n][e]; }
                    if (cls != 3) { s0 += s1; s0 += xsh(s0, 16, lane); s0 += xsh(s0, 32, lane); s0 = s0 * (1.f / 64.f); s1 = s0; }
                    else { s0 += xsh(s0, 16, lane); s0 += xsh(s0, 32, lane); s1 += xsh(s1, 16, lane); s1 += xsh(s1, 32, lane); s0 *= (1.f / 32.f); s1 *= (1.f / 32.f); }
                    const float r0 = 1.f / sqrtf(s0 + 1e-6f), r1 = 1.f / sqrtf(s1 + 1e-6f);
#pragma unroll
                    for (int n = 0; n < 2; ++n) { v[0][n] = v[0][n] * r0 * gv[0][n]; v[1][n] = v[1][n] * r1 * gv[1][n]; }
                    if (lat && cls == 2) {
                        const int t = row & 8191;
                        u32x4 cw[2][2]; const float sgn = fq < 2 ? -1.f : 1.f;
#pragma unroll
                        for (int bj = 0; bj < 2; ++bj) { const int pos = bj == 0 ? (t >> 6) : (t & 63);
#pragma unroll
                            for (int n = 0; n < 2; ++n) cw[bj][n] = *(const u32x4*)((const unsigned*)gate + pos * 16 + 8 * (fq & 1) + 4 * n); }
#pragma unroll
                        for (int bj = 0; bj < 2; ++bj)
#pragma unroll
                            for (int n = 0; n < 2; ++n) { f32x4 p, c, sn;
#pragma unroll
                                for (int e = 0; e < 4; ++e) { p[e] = xsh(v[bj][n][e], 32, lane); c[e] = __builtin_bit_cast(float, cw[bj][n][e] << 16); sn[e] = __builtin_bit_cast(float, cw[bj][n][e] & 0xffff0000u); }
                                v[bj][n] = v[bj][n] * c + (p * sgn) * sn; }
                    }
                    if (lat && cls == 3) {
                        const int t = row & 8191; const int pos = fq < 2 ? (t >> 6) : (t & 63); const float sgn = (fq & 1) ? 1.f : -1.f;
                        u32x4 cw[2];
#pragma unroll
                        for (int n = 0; n < 2; ++n) cw[n] = *(const u32x4*)((const unsigned*)gate + 2048 + pos * 8 + 4 * n);
#pragma unroll
                        for (int bj = 0; bj < 2; ++bj)
#pragma unroll
                            for (int n = 0; n < 2; ++n) { f32x4 p, c, sn;
#pragma unroll
                                for (int e = 0; e < 4; ++e) { p[e] = xsh(v[bj][n][e], 16, lane); c[e] = __builtin_bit_cast(float, cw[n][e] << 16); sn[e] = __builtin_bit_cast(float, cw[n][e] & 0xffff0000u); }
                                v[bj][n] = v[bj][n] * c + (p * sgn) * sn; }
                    }
                    if (qs != 1.f) {
#pragma unroll
                        for (int bj = 0; bj < 2; ++bj)
#pragma unroll
                            for (int n = 0; n < 2; ++n) v[bj][n] = v[bj][n] * qs; }
                }
                if (k6) {
                    PG8_LAS unsigned char* sw = scr + (wr * 4 + wc) * 1024 + fr * 64;
                    unsigned char* img = (unsigned char*)ctxres + (k6e ? ((size_t)(row >> 6) * 10 + (H < 10 ? H - 8 : H - 18)) : ((size_t)(row >> 6) * 16 + H)) * 3072;
                    const int key = row & 63;
#pragma unroll
                    for (int bj = 0; bj < 2; ++bj) {
                        u32x4 w; w.x = cvt_pk_bf16(v[bj][0][0], v[bj][0][1]); w.y = cvt_pk_bf16(v[bj][0][2], v[bj][0][3]); w.z = cvt_pk_bf16(v[bj][1][0], v[bj][1][1]); w.w = cvt_pk_bf16(v[bj][1][2], v[bj][1][3]);
                        *(PG8_LAS u32x4*)(sw + fq * 16) = w;
                        asm volatile("s_waitcnt lgkmcnt(0)" ::: "memory");
                        if (fq == 0) {
                            const u32x4 a0 = *(PG8_LAS u32x4*)(sw), a1 = *(PG8_LAS u32x4*)(sw + 16), a2 = *(PG8_LAS u32x4*)(sw + 32), a3 = *(PG8_LAS u32x4*)(sw + 48);
                            const u32x16 all = {a0.x, a0.y, a0.z, a0.w, a1.x, a1.y, a1.z, a1.w, a2.x, a2.y, a2.z, a2.w, a3.x, a3.y, a3.z, a3.w};
                            const u32x6 c = __builtin_amdgcn_cvt_scalef32_pk32_fp6_bf16(__builtin_bit_cast(bf16x32, all), 1.0f);
                            *(u32x4*)(img + bj * 1024 + key * 16) = (u32x4){c[0], c[1], c[2], c[3]};
                            *(u32x2*)(img + 2048 + bj * 512 + key * 8) = (u32x2){c[4], c[5]};
                        }
                        asm volatile("s_waitcnt lgkmcnt(0)" ::: "memory");
                    }
                    continue;
                }
                bf16_t* rowp = O + (size_t)row * ldc + col0;
#pragma unroll
                for (int bj = 0; bj < 2; ++bj) { u32x4 w; w.x = cvt_pk_bf16(v[bj][0][0], v[bj][0][1]); w.y = cvt_pk_bf16(v[bj][0][2], v[bj][0][3]); w.z = cvt_pk_bf16(v[bj][1][0], v[bj][1][1]); w.w = cvt_pk_bf16(v[bj][1][2], v[bj][1][3]);
                    *(u32x4*)(rowp + 32 * bj) = w; }
            }
    }
    __device__ __forceinline__ void operator()(const f32x4 (&acc)[2][2][4][2], const Unit& u, int wr, int wc, int fr, int fq) const {
        asm volatile("" : "+v"(fr), "+v"(fq));
        if (mode == 1) {
            bf16_t* O = (bf16_t*)out;
            const int row0 = u.pm * BM + wr * 64 + fr, col0 = u.pn * BM + wc * 32 + 8 * fq;
#pragma unroll
            for (int ai = 0; ai < 2; ++ai)
#pragma unroll
                for (int m = 0; m < 4; ++m) { bf16_t* rowp = O + (size_t)(row0 + ai * HALF + m * 16) * ldc + col0;
#pragma unroll
                    for (int bj = 0; bj < 2; ++bj) { f32x4 v0 = acc[ai][bj][m][0], v1 = acc[ai][bj][m][1];
                        if (relu2) {
#pragma unroll
                            for (int e = 0; e < 4; ++e) { float a = fmaxf(v0[e], 0.f), b = fmaxf(v1[e], 0.f); v0[e] = a * a; v1[e] = b * b; } }
                        u32x4 w; w.x = cvt_pk_bf16(v0[0], v0[1]); w.y = cvt_pk_bf16(v0[2], v0[3]); w.z = cvt_pk_bf16(v1[0], v1[1]); w.w = cvt_pk_bf16(v1[2], v1[3]);
                        *(u32x4*)(rowp + bj * HALF) = w; } }
            return;
        }
        if (mode == 3) { head_epilogue(acc, u, wr, wc, fr, fq); return; }
        const int t0 = u.pm * BM; const bool split = (u.kinfo >> 16) != 0; const int cond = t0 < 8192 ? 0 : (t0 < 16384 ? 1 : 2);
        const int col0 = u.pn * BM + wc * 32 + 4 * fq; const float* g = gate + cond * 6144 + col0;
        f32x4 gv[2][2];
#pragma unroll
        for (int bj = 0; bj < 2; ++bj)
#pragma unroll
            for (int n = 0; n < 2; ++n) gv[bj][n] = *(const f32x4*)(g + bj * HALF + n * 16);
        if (split) {
            const int ks = (u.kinfo & 255) / ((u.kinfo >> 8) & 255);
            float* op = ctxres + (size_t)ks * (512 * 1024) + (size_t)(t0 - 16384) * 1024;
#pragma unroll
            for (int ai = 0; ai < 2; ++ai)
#pragma unroll
                for (int m = 0; m < 4; ++m) { const size_t off = (size_t)(wr * 64 + fr + ai * HALF + m * 16) * 1024 + col0;
#pragma unroll
                    for (int bj = 0; bj < 2; ++bj)
#pragma unroll
                        for (int n = 0; n < 2; ++n) *(f32x4*)(op + off + bj * HALF + n * 16) = gv[bj][n] * acc[ai][bj][m][n]; }
            return;
        }
#define PG8_RES_LOOP(LOADB, STOREO) _Pragma("unroll") for (int ai = 0; ai < 2; ++ai) _Pragma("unroll") for (int m = 0; m < 4; ++m) { const size_t off = (size_t)(wr * 64 + fr + ai * HALF + m * 16) * 1024 + col0; \
            _Pragma("unroll") for (int bj = 0; bj < 2; ++bj) _Pragma("unroll") for (int n = 0; n < 2; ++n) { const size_t o2 = off + bj * HALF + n * 16; f32x4 b; LOADB; const f32x4 y = b + gv[bj][n] * acc[ai][bj][m][n]; STOREO; } }
        if (relu2 == 2) { const float* bp = base + (size_t)t0 * 1024; bf16_t* op = (bf16_t*)out + (size_t)t0 * 1024;
            PG8_RES_LOOP(b = *(const f32x4*)(bp + o2), *(u32x2*)(op + o2) = pk4bf(y)); }
        else if (relu2 == 3) { const bf16_t* bp = (const bf16_t*)base + (size_t)t0 * 1024; bf16_t* op = (bf16_t*)out + (size_t)t0 * 1024;
            PG8_RES_LOOP(const u32x2 w = *(const u32x2*)(bp + o2); b = unpk4bf(w), *(u32x2*)(op + o2) = pk4bf(y)); }
        else { const bf16_t* bp = (const bf16_t*)base + (size_t)t0 * 1024; float* op = (float*)out + (size_t)t0 * 1024;
            PG8_RES_LOOP(const u32x2 w = *(const u32x2*)(bp + o2); b = unpk4bf(w), *(f32x4*)(op + o2) = y); }
#undef PG8_RES_LOOP
    }
};

template <class Epi, class Sched, bool ALIGN_EPI = false, bool SP2 = false, bool MX8 = false>
__device__ __forceinline__ void gemm_phase(PG8_LAS unsigned char* lds, const Gemm g, const Sched& S, const Epi& E, const int tid) {
    const int wid = __builtin_amdgcn_readfirstlane(tid >> 6), lane = tid & 63, wr = wid >> 2, wc = wid & 3, fr = lane & 15, fq = lane >> 4;
    const int K = g.K;
    typedef int i32x4_t __attribute__((ext_vector_type(4)));
    int scw_ = 0x7a7a7a7a, sca_ = 0x7f7f7f7f; asm volatile("" : "+v"(scw_), "+v"(sca_));
    unsigned voffA[2], voffB[2];
#pragma unroll
    for (int i = 0; i < 2; ++i) { int R, C; stage_rc(tid * 16 + i * 8192, R, C); const int Rb = E.headmode() ? (64 * (R >> 5) + perm32(R & 31)) : (E.perm() ? ((R & ~31) + perm32(R & 31)) : R);
        voffA[i] = (unsigned)(R * K + C) * 2u; voffB[i] = (unsigned)(Rb * K + C) * 2u; }
    const size_t kstep = (size_t)(BK * 2);
    const size_t hstep = (size_t)HALF * K * 2;
    const size_t tstep = 2 * hstep;
    const size_t hstepB = E.headmode() ? (size_t)32 * K * 2 : hstep;
    const unsigned ldsw = (unsigned)wid * 1024u;
    const int aoff = lds_byte(wr * 64 + fr, fq * 8), boff = lds_byte(wc * 32 + fr, fq * 8);
#define PG8_SA(b, h) (((b) * 2 + (h)) * HTB)
#define PG8_SB(b, h) ((4 + (b) * 2 + (h)) * HTB)
    const unsigned ldsb = (unsigned)(uintptr_t)lds + ldsw;
#define PG8_STAGE(bufoff, gbase, voff) do { _Pragma("unroll") for (int _i = 0; _i < 2; ++_i) { unsigned keep_; \
        asm volatile("s_mov_b32 %0, m0\n\ts_mov_b32 m0, %3\n\ts_nop 0\n\tglobal_load_lds_dwordx4 %1, %2\n\ts_mov_b32 m0, %0" : "=&s"(keep_) : "v"((voff)[_i]), "s"((const char*)(gbase)), "s"(ldsb + (unsigned)((bufoff) + _i * 8192)) : "memory"); } } while (0)
#define PG8_LDA(dst, b, h) do { _Pragma("unroll") for (int m = 0; m < 4; ++m) _Pragma("unroll") for (int k = 0; k < 2; ++k) dst[m][k] = *(const PG8_LAS bf16x8*)(lds + PG8_SA(b, h) + aoff + m * 2048 + k * 1024); } while (0)
#define PG8_LDB(dst, b, h) do { _Pragma("unroll") for (int n = 0; n < 2; ++n) _Pragma("unroll") for (int k = 0; k < 2; ++k) dst[n][k] = *(const PG8_LAS bf16x8*)(lds + PG8_SB(b, h) + boff + n * 2048 + k * 1024); } while (0)
#define PG8_CAT(x, y) __builtin_shufflevector(__builtin_bit_cast(i32x4_t, x), __builtin_bit_cast(i32x4_t, y), 0, 1, 2, 3, 4, 5, 6, 7)
#define PG8_MMA(ai, bj, At, Bt) do { __builtin_amdgcn_s_setprio(1); \
        if constexpr (MX8) { _Pragma("unroll") for (int m = 0; m < 4; ++m) _Pragma("unroll") for (int n = 0; n < 2; ++n) \
            asm volatile("v_mfma_scale_f32_16x16x128_f8f6f4 %0, %1, %2, %0, %3, %4 op_sel_hi:[0,0,0]" : "+v"(acc[ai][bj][m][n]) : "v"(PG8_CAT(Bt[n][0], Bt[n][1])), "v"(PG8_CAT(At[m][0], At[m][1])), "v"(scw_), "v"(sca_)); } \
        else { _Pragma("unroll") for (int m = 0; m < 4; ++m) _Pragma("unroll") for (int n = 0; n < 2; ++n) _Pragma("unroll") for (int k = 0; k < 2; ++k) \
            acc[ai][bj][m][n] = __builtin_amdgcn_mfma_f32_16x16x32_bf16(Bt[n][k], At[m][k], acc[ai][bj][m][n], 0, 0, 0); } \
        __builtin_amdgcn_s_setprio(0); } while (0)
#define PG8_WAIT_V(n) asm volatile("s_waitcnt vmcnt(" #n ")" ::: "memory")
#define PG8_WAIT_L(n) asm volatile("s_waitcnt lgkmcnt(" #n ")" ::: "memory")
#define PG8_BAR __builtin_amdgcn_s_barrier()
#define PG8_SCHED __builtin_amdgcn_sched_barrier(0)
    Unit cur, nxt; int ui = 0;
    if (!S.next(0, cur)) return;
    f32x4 acc[2][2][4][2];
#pragma unroll
    for (int a = 0; a < 2; ++a)
#pragma unroll
        for (int b = 0; b < 2; ++b)
#pragma unroll
            for (int m = 0; m < 4; ++m)
#pragma unroll
                for (int n = 0; n < 2; ++n) acc[a][b][m][n] = (f32x4){0.f, 0.f, 0.f, 0.f};
    bf16x8 At[4][2], B0[2][2], B1[2][2];
    const char* cA = (const char*)g.A + (size_t)cur.pm * tstep + (size_t)(cur.kinfo & 255) * (BK * 2); const char* cB = (const char*)g.Bt + (size_t)cur.pn * tstep + (size_t)(cur.kinfo & 255) * (BK * 2);
    S.a_ready(cur);
    if constexpr (SP2) {
        PG8_STAGE(PG8_SB(0, 0), cB, voffB); PG8_STAGE(PG8_SB(0, 1), cB + hstepB, voffB); PG8_STAGE(PG8_SA(0, 0), cA, voffA); PG8_STAGE(PG8_SA(0, 1), cA + hstep, voffA);
        if (wr == 1) PG8_BAR;
        PG8_WAIT_V(2); PG8_BAR;
        PG8_STAGE(PG8_SB(1, 0), cB + kstep, voffB); PG8_STAGE(PG8_SA(1, 0), cA + kstep, voffA); PG8_STAGE(PG8_SB(1, 1), cB + hstepB + kstep, voffB);
        PG8_WAIT_V(6); PG8_BAR;
    } else {
        PG8_STAGE(PG8_SB(0, 0), cB, voffB); PG8_STAGE(PG8_SA(0, 0), cA, voffA); PG8_STAGE(PG8_SB(0, 1), cB + hstepB, voffB); PG8_STAGE(PG8_SA(0, 1), cA + hstep, voffA);
        if (wr == 1) PG8_BAR;
        PG8_WAIT_V(4); PG8_BAR;
        PG8_STAGE(PG8_SB(1, 0), cB + kstep, voffB); PG8_STAGE(PG8_SA(1, 0), cA + kstep, voffA); PG8_STAGE(PG8_SB(1, 1), cB + hstepB + kstep, voffB);
        PG8_WAIT_V(6); PG8_BAR;
    }
    for (;;) {
        const bool has_next = S.next(ui + 1, nxt);
        const char* nA = has_next ? (const char*)g.A + (size_t)nxt.pm * tstep + (size_t)(nxt.kinfo & 255) * (BK * 2) : cA; const char* nB = has_next ? (const char*)g.Bt + (size_t)nxt.pn * tstep + (size_t)(nxt.kinfo & 255) * (BK * 2) : cB;
        const int nt = (cur.kinfo >> 8) & 255;
        for (int t = 0; t < nt; t += 2) {
            const bool last = (t == nt - 2);
            const char* a1 = cA + (size_t)(t + 1) * kstep;
            const char* a2 = last ? nA : cA + (size_t)(t + 2) * kstep; const char* b2 = last ? nB : cB + (size_t)(t + 2) * kstep;
            const char* a3 = a2 + kstep; const char* b3 = b2 + kstep;
            if (last && has_next) S.a_ready(nxt);
            if constexpr (SP2) {
            PG8_LDB(B0, 0, 0); PG8_LDB(B1, 0, 1); PG8_SCHED; PG8_LDA(At, 0, 0); PG8_STAGE(PG8_SA(1, 1), a1 + hstep, voffA);
            PG8_WAIT_V(8); PG8_WAIT_L(0); PG8_BAR; PG8_MMA(0, 0, At, B0); PG8_MMA(0, 1, At, B1); PG8_BAR; PG8_SCHED;
            PG8_LDA(At, 0, 1); PG8_STAGE(PG8_SB(0, 0), b2, voffB); PG8_STAGE(PG8_SB(0, 1), b2 + hstepB, voffB); PG8_STAGE(PG8_SA(0, 0), a2, voffA);
            PG8_WAIT_V(8); PG8_WAIT_L(0); PG8_BAR; PG8_MMA(1, 0, At, B0); PG8_MMA(1, 1, At, B1); PG8_BAR; PG8_SCHED;
            PG8_LDB(B0, 1, 0); PG8_LDB(B1, 1, 1); PG8_SCHED; PG8_LDA(At, 1, 0); PG8_STAGE(PG8_SA(0, 1), a2 + hstep, voffA);
            PG8_WAIT_V(8); PG8_WAIT_L(0); PG8_BAR; PG8_MMA(0, 0, At, B0); PG8_MMA(0, 1, At, B1); PG8_BAR; PG8_SCHED;
            PG8_LDA(At, 1, 1); PG8_STAGE(PG8_SB(1, 0), b3, voffB); PG8_STAGE(PG8_SB(1, 1), b3 + hstepB, voffB); PG8_STAGE(PG8_SA(1, 0), a3, voffA);
            PG8_WAIT_V(8); PG8_WAIT_L(0); PG8_BAR; PG8_MMA(1, 0, At, B0); PG8_MMA(1, 1, At, B1); PG8_BAR; PG8_SCHED;
            } else {
            PG8_LDB(B0, 0, 0); PG8_SCHED; PG8_LDA(At, 0, 0); PG8_STAGE(PG8_SA(1, 1), a1 + hstep, voffA);
            PG8_WAIT_L(8); PG8_BAR; PG8_WAIT_L(0); PG8_MMA(0, 0, At, B0); PG8_BAR; PG8_SCHED;
            PG8_LDB(B1, 0, 1); PG8_STAGE(PG8_SB(0, 0), b2, voffB);
            PG8_BAR; PG8_WAIT_L(0); PG8_MMA(0, 1, At, B1); PG8_BAR;
            PG8_LDA(At, 0, 1); PG8_STAGE(PG8_SA(0, 0), a2, voffA);
            PG8_BAR; PG8_WAIT_L(0); PG8_MMA(1, 0, At, B0); PG8_BAR; PG8_SCHED;
            PG8_STAGE(PG8_SB(0, 1), b2 + hstepB, voffB);
            PG8_WAIT_V(6); PG8_BAR; PG8_MMA(1, 1, At, B1); PG8_BAR;
            PG8_LDB(B0, 1, 0); PG8_SCHED; PG8_LDA(At, 1, 0); PG8_STAGE(PG8_SA(0, 1), a2 + hstep, voffA);
            PG8_WAIT_L(8); PG8_BAR; PG8_WAIT_L(0); PG8_MMA(0, 0, At, B0); PG8_BAR; PG8_SCHED;
            PG8_LDB(B1, 1, 1); PG8_STAGE(PG8_SB(1, 0), b3, voffB);
            PG8_BAR; PG8_WAIT_L(0); PG8_MMA(0, 1, At, B1); PG8_BAR;
            PG8_LDA(At, 1, 1); PG8_STAGE(PG8_SA(1, 0), a3, voffA);
            PG8_BAR; PG8_WAIT_L(0); PG8_MMA(1, 0, At, B0); PG8_BAR; PG8_SCHED;
            PG8_STAGE(PG8_SB(1, 1), b3 + hstepB, voffB);
            PG8_WAIT_V(6); PG8_BAR; PG8_MMA(1, 1, At, B1); PG8_BAR;
            }
        }
        if constexpr (MX8) asm volatile("s_nop 15\n\ts_nop 15" ::: "memory");
        if constexpr (ALIGN_EPI) { if (wr == 0) PG8_BAR; }
        if constexpr (!Epi::AFTER_DRAIN) { E(acc, cur, wr, wc, fr, fq); S.done(cur); }
        if (!has_next) break;
#pragma unroll
        for (int a = 0; a < 2; ++a)
#pragma unroll
            for (int b = 0; b < 2; ++b)
#pragma unroll
                for (int m = 0; m < 4; ++m)
#pragma unroll
                    for (int n = 0; n < 2; ++n) acc[a][b][m][n] = (f32x4){0.f, 0.f, 0.f, 0.f};
        cur = nxt; cA = nA; cB = nB; ++ui;
        if constexpr (ALIGN_EPI) { if (wr == 1) PG8_BAR; }
    }
    PG8_WAIT_V(0);
    if constexpr (!ALIGN_EPI) { if (wr == 0) PG8_BAR; }
    PG8_BAR;
    if constexpr (Epi::AFTER_DRAIN) { E.fused(acc, cur, wr, wc, fr, fq, lds, wid, lane); S.done(cur); }
#undef PG8_SA
#undef PG8_SB
#undef PG8_STAGE
#undef PG8_CAT
#undef PG8_LDA
#undef PG8_LDB
#undef PG8_MMA
#undef PG8_WAIT_V
#undef PG8_WAIT_L
#undef PG8_BAR
#undef PG8_SCHED
}
}
namespace att {
#define ATT_LAS __attribute__((address_space(3)))
typedef unsigned short bf16;
typedef short bf16x8 __attribute__((ext_vector_type(8)));
typedef short s16x4 __attribute__((ext_vector_type(4)));
typedef float f32x16 __attribute__((ext_vector_type(16)));
typedef unsigned u32x4 __attribute__((ext_vector_type(4)));
typedef ATT_LAS char lchar;
constexpr int KBUF = 12288, VBUF = 16384;
constexpr int L_K = 0, L_V = 2 * KBUF, L_WS = L_V + 2 * VBUF, L_RPB = L_WS + 2048, L_END = L_RPB + 2048;
constexpr float LOG2E = 1.4426950408889634f;
#define ATT_SBAR() __builtin_amdgcn_sched_barrier(0)
__device__ __forceinline__ int crow(int r, int hi) { return (r & 3) + 8 * (r >> 2) + 4 * hi; }
__device__ __forceinline__ unsigned cvtpk(float lo, float hi) { unsigned r; asm volatile("v_cvt_pk_bf16_f32 %0, %1, %2" : "=v"(r) : "v"(lo), "v"(hi)); return r; }
__device__ __forceinline__ int v_st(int k, int c) { const int kk = (k & ~0xC) | ((k & 4) << 1) | ((k & 8) >> 1); return ((kk >> 3) * 4 + (c >> 5)) * 512 + ((kk & 7) * 32 + (c & 31)) * 2; }
__device__ __forceinline__ int v_rd_base(int lane) { return ((lane & 3) << 3) | (((lane >> 2) & 3) << 6) | (((lane >> 4) & 1) << 5) | (((lane >> 5) & 1) << 8); }
constexpr int v_rd_off(int d0, int ks, int half) { return d0 * 512 + ks * 4096 + half * 2048; }
template <int OFF> __device__ __forceinline__ s16x4 tr_read(unsigned vb) {
  s16x4 r; asm volatile("ds_read_b64_tr_b16 %0, %1 offset:%2" : "=&v"(r) : "v"(vb), "i"(OFF) : "memory"); return r;
}
template <int D0> __device__ __forceinline__ void pv_one(f32x16& od, unsigned vb, bf16x8 pa0, bf16x8 pa1, bf16x8 pa2, bf16x8 pa3) {
  const s16x4 l0 = tr_read<v_rd_off(D0, 0, 0)>(vb), h0 = tr_read<v_rd_off(D0, 0, 1)>(vb), l1 = tr_read<v_rd_off(D0, 1, 0)>(vb), h1 = tr_read<v_rd_off(D0, 1, 1)>(vb);
  const s16x4 l2 = tr_read<v_rd_off(D0, 2, 0)>(vb), h2 = tr_read<v_rd_off(D0, 2, 1)>(vb), l3 = tr_read<v_rd_off(D0, 3, 0)>(vb), h3 = tr_read<v_rd_off(D0, 3, 1)>(vb);
  asm volatile("s_waitcnt lgkmcnt(0)" ::: "memory"); ATT_SBAR();
#define ATT_PK(L, H) (bf16x8){L[0], L[1], L[2], L[3], H[0], H[1], H[2], H[3]}
  od = __builtin_amdgcn_mfma_f32_32x32x16_bf16(pa0, ATT_PK(l0, h0), od, 0, 0, 0);
  od = __builtin_amdgcn_mfma_f32_32x32x16_bf16(pa1, ATT_PK(l1, h1), od, 0, 0, 0);
  od = __builtin_amdgcn_mfma_f32_32x32x16_bf16(pa2, ATT_PK(l2, h2), od, 0, 0, 0);
  od = __builtin_amdgcn_mfma_f32_32x32x16_bf16(pa3, ATT_PK(l3, h3), od, 0, 0, 0);
#undef ATT_PK
}

template <int DKC, class U>
__device__ __forceinline__ void unit(const U& u, lchar* lds, int tid) {
  asm volatile("" : "+v"(tid));
  const int lane = tid & 63, r32 = lane & 31, hi = lane >> 5;
  const int wid = __builtin_amdgcn_readfirstlane(tid >> 6);
  lchar* Kl = lds + L_K; lchar* Vl = lds + L_V;
  ATT_LAS float* ws = (ATT_LAS float*)(lds + L_WS) + wid * 64;
  bf16x8 qr[DKC / 2];
#pragma unroll
  for (int d0 = 0; d0 < DKC / 2; ++d0) qr[d0] = *(const bf16x8*)u.qptr(wid, r32, d0, hi);
  const int vrow = tid >> 3, vch = tid & 7, vst = v_st(vrow, vch * 8);
  const int krow0 = tid & 63, kch0 = tid >> 6;
  const bool k2 = (DKC > 8) && (tid < 64 * (DKC - 8));
  const unsigned vb0 = (unsigned)(uintptr_t)Vl + (unsigned)v_rd_base(lane);
  bf16x8 kst0, kst1 = {}, vstr;
  const int NT = u.nt();
#define ATT_SLOAD(t) do { const long R_ = u.krow(t); kst0 = *(const bf16x8*)u.kptr(R_ + krow0, kch0); if (k2) kst1 = *(const bf16x8*)u.kptr(R_ + krow0, 8 + kch0); \
    vstr = *(const bf16x8*)u.vptr(R_ + vrow, vch); } while (0)
#define ATT_SWRITE(b) do { *(ATT_LAS bf16x8*)(Kl + (b) * KBUF + kch0 * 1024 + krow0 * 16) = kst0; if (k2) *(ATT_LAS bf16x8*)(Kl + (b) * KBUF + (8 + kch0) * 1024 + krow0 * 16) = kst1; \
    *(ATT_LAS bf16x8*)(Vl + (b) * VBUF + vst) = vstr; } while (0)
  float m_reg = -1e30f, l_reg = 0.f; f32x16 o[2]; o[0] = f32x16{}; o[1] = f32x16{};
  ATT_SLOAD(0); ATT_SWRITE(0); __syncthreads();
  for (int t = 0; t < NT; ++t) {
    const int buf = t & 1;
    if (t + 1 < NT) ATT_SLOAD(t + 1);
    if (!u.skip(t, wid)) {
      f32x16 p0 = f32x16{}, p1 = f32x16{};
      { const lchar* kb = Kl + buf * KBUF + hi * 1024 + r32 * 16;
#pragma unroll
        for (int d0 = 0; d0 < DKC / 2; ++d0) {
          const bf16x8 b0 = *(const ATT_LAS bf16x8*)(kb + d0 * 2048);
          const bf16x8 b1 = *(const ATT_LAS bf16x8*)(kb + d0 * 2048 + 512);
          p0 = __builtin_amdgcn_mfma_f32_32x32x16_bf16(b0, qr[d0], p0, 0, 0, 0);
          p1 = __builtin_amdgcn_mfma_f32_32x32x16_bf16(b1, qr[d0], p1, 0, 0, 0); } }
      u.mask(p0, p1, t, wid, r32, hi);
      float pmax = p0[0];
#pragma unroll
      for (int r = 1; r < 16; ++r) pmax = fmaxf(pmax, p0[r]);
#pragma unroll
      for (int r = 0; r < 16; ++r) pmax = fmaxf(pmax, p1[r]);
      { auto rr = __builtin_amdgcn_permlane32_swap(__float_as_uint(pmax), __float_as_uint(pmax), false, false);
        pmax = fmaxf(__uint_as_float(rr[0]), __uint_as_float(rr[1])); }
      const float mn = fmaxf(m_reg, pmax);
      const float alpha = __builtin_amdgcn_exp2f(m_reg - mn);
      m_reg = mn;
#pragma unroll
      for (int r = 0; r < 16; ++r) { p0[r] = __builtin_amdgcn_exp2f(p0[r] - mn); p1[r] = __builtin_amdgcn_exp2f(p1[r] - mn); }
      float ps = 0.f;
#pragma unroll
      for (int r = 0; r < 16; ++r) ps += p0[r];
#pragma unroll
      for (int r = 0; r < 16; ++r) ps += p1[r];
      { auto rr = __builtin_amdgcn_permlane32_swap(__float_as_uint(ps), __float_as_uint(ps), false, false);
        ps = __uint_as_float(rr[0]) + __uint_as_float(rr[1]); }
      l_reg = l_reg * alpha + ps;
      if (__any(alpha < 1.f)) {
        if (hi == 0) ws[r32] = alpha;
        asm volatile("s_waitcnt lgkmcnt(0)" ::: "memory");
#pragma unroll
        for (int r = 0; r < 16; ++r) { const float a = ws[crow(r, hi)]; o[0][r] *= a; o[1][r] *= a; }
      }
      bf16x8 pa0, pa1, pa2, pa3;
#define ATT_PK4(P, BASE, OUT) do { unsigned a0 = cvtpk(P[BASE + 0], P[BASE + 1]), a1 = cvtpk(P[BASE + 2], P[BASE + 3]);   \
    unsigned b0 = cvtpk(P[BASE + 4], P[BASE + 5]), b1 = cvtpk(P[BASE + 6], P[BASE + 7]);                              \
    auto r0 = __builtin_amdgcn_permlane32_swap(a0, b0, false, false); auto r1 = __builtin_amdgcn_permlane32_swap(a1, b1, false, false); \
    u32x4 w = {r0[0], r1[0], r0[1], r1[1]}; OUT = __builtin_bit_cast(bf16x8, w); } while (0)
      ATT_PK4(p0, 0, pa0); ATT_PK4(p0, 8, pa1); ATT_PK4(p1, 0, pa2); ATT_PK4(p1, 8, pa3);
#undef ATT_PK4
      const unsigned vb = vb0 + (unsigned)(buf * VBUF);
      pv_one<0>(o[0], vb, pa0, pa1, pa2, pa3); pv_one<1>(o[1], vb, pa0, pa1, pa2, pa3);
    }
    if (t + 1 < NT) ATT_SWRITE(buf ^ 1);
    __syncthreads();
  }
#undef ATT_SLOAD
#undef ATT_SWRITE
  { const float sk = u.sink(wid); l_reg += __builtin_amdgcn_exp2f(sk - m_reg); }
  if (hi == 0) ws[r32] = l_reg;
  asm volatile("s_waitcnt lgkmcnt(0)" ::: "memory");
  float rli[16];
#pragma unroll
  for (int r = 0; r < 16; ++r) rli[r] = __builtin_amdgcn_rcpf(ws[crow(r, hi)]);
#pragma unroll
  for (int r = 0; r < 16; ++r) { bf16* op = u.orow(wid, crow(r, hi));
    op[r32] = (bf16)(cvtpk(o[0][r] * rli[r], 0.f) & 0xffffu); op[32 + r32] = (bf16)(cvtpk(o[1][r] * rli[r], 0.f) & 0xffffu); }
  asm volatile("s_waitcnt lgkmcnt(0)" ::: "memory");
}

constexpr int ROWS_LAT = 16384;
struct UWin {
  const bf16* QKV; bf16* O; const float* sinkp; int b, n, g, hh; int i0, cnt;
  __device__ __forceinline__ void init() { i0 = (n == 0) ? 2 : 0; cnt = (n == 0 || n == 63) ? 4 : 6; }
  __device__ __forceinline__ int nt() const { return 4 + cnt; }
  __device__ __forceinline__ int kpos0(int t) const { return 128 * (n - 1) + 64 * (i0 + t - 4); }
  __device__ __forceinline__ long krow(int t) const { return t < 4 ? (long)(ROWS_LAT + 256 * b + 64 * t) : (long)(8192 * b + kpos0(t)); }
  __device__ __forceinline__ const bf16* kptr(long row, int ch) const { return QKV + row * 2304 + 512 + 64 * g + ch * 8; }
  __device__ __forceinline__ const bf16* vptr(long row, int ch) const { return QKV + row * 2304 + 640 + 64 * g + ch * 8; }
  __device__ __forceinline__ int head(int wid) const { return 4 * g + 2 * hh + (wid >> 2); }
  __device__ __forceinline__ int qpos0(int wid) const { return 128 * n + 32 * (wid & 3); }
  __device__ __forceinline__ const bf16* qptr(int wid, int r32, int d0, int hi) const { return QKV + (long)(8192 * b + qpos0(wid) + r32) * 2304 + 64 * head(wid) + 16 * d0 + 8 * hi; }
  __device__ __forceinline__ bool skip(int t, int wid) const { if (t < 4) return false; const int k0 = kpos0(t), q0 = qpos0(wid); return (k0 + 63 < q0 - 128) || (k0 > q0 + 31 + 128); }
  __device__ __forceinline__ void mask(f32x16& p0, f32x16& p1, int t, int wid, int r32, int hi) const {
    if (t < 4) return;
    const int dq = kpos0(t) - (qpos0(wid) + r32);
#pragma unroll
    for (int r = 0; r < 16; ++r) { const int d = dq + crow(r, hi); if (d > 128 || d < -128) p0[r] = -INFINITY; if (d + 32 > 128 || d + 32 < -128) p1[r] = -INFINITY; }
  }
  __device__ __forceinline__ float sink(int wid) const { return sinkp[head(wid)] * LOG2E; }
  __device__ __forceinline__ bf16* orow(int wid, int row) const { return O + (long)(8192 * b + qpos0(wid) + row) * 1024 + 64 * head(wid); }
};
struct UNa {
  const bf16* QKV; bf16* O; const ATT_LAS float* rpbl; int b, h, R4; int krlo, nloc;
  __device__ __forceinline__ static int clampi(int v, int lo, int hi_) { return v < lo ? lo : (v > hi_ ? hi_ : v); }
  __device__ __forceinline__ void init() { krlo = clampi(4 * R4 - 4, 0, 120); const int krhi = clampi(4 * R4 - 1, 0, 120) + 7; nloc = krhi - krlo + 1; }
  __device__ __forceinline__ int nt() const { return 4 + nloc; }
  __device__ __forceinline__ long krow(int t) const { return t < 4 ? (long)(ROWS_LAT + 256 * b + 64 * t) : (long)(8192 * b + 64 * (krlo + t - 4)); }
  __device__ __forceinline__ const bf16* kptr(long row, int ch) const { return QKV + row * 2304 + 1280 + 64 * h + ch * 8; }
  __device__ __forceinline__ const bf16* vptr(long row, int ch) const { return QKV + row * 2304 + 1792 + 64 * h + ch * 8; }
  __device__ __forceinline__ int qrow(int wid) const { return 4 * R4 + (wid >> 1); }
  __device__ __forceinline__ const bf16* qptr(int wid, int r32, int d0, int hi) const { return QKV + (long)(8192 * b + 64 * qrow(wid) + 32 * (wid & 1) + r32) * 2304 + 768 + 64 * h + 16 * d0 + 8 * hi; }
  __device__ __forceinline__ bool skip(int t, int wid) const { if (t < 4) return false; const int kr = krlo + t - 4, w0 = clampi(qrow(wid) - 4, 0, 120); return kr < w0 || kr > w0 + 7; }
  __device__ __forceinline__ void mask(f32x16& p0, f32x16& p1, int t, int wid, int r32, int hi) const {
    if (t < 4) return;
    const int kr = krlo + t - 4, qc = 32 * (wid & 1) + r32, c0 = clampi(qc - 8, 0, 48);
    const ATT_LAS float* brow = rpbl + (kr - qrow(wid) + 7) * 31 + 15;
#pragma unroll
    for (int r = 0; r < 16; ++r) {
      { const int kc = crow(r, hi); const bool ok = kc >= c0 && kc < c0 + 16; const float bv = brow[clampi(kc - qc, -15, 15)]; p0[r] = ok ? p0[r] + bv : -INFINITY; }
      { const int kc = 32 + crow(r, hi); const bool ok = kc >= c0 && kc < c0 + 16; const float bv = brow[clampi(kc - qc, -15, 15)]; p1[r] = ok ? p1[r] + bv : -INFINITY; } }
  }
  __device__ __forceinline__ float sink(int) const { return -INFINITY; }
  __device__ __forceinline__ bf16* orow(int wid, int row) const { return O + (long)(8192 * b + 64 * qrow(wid) + 32 * (wid & 1) + row) * 1024 + 512 + 64 * h; }
};
struct UCtx {
  const bf16* QKV; bf16* O; const float* sinkp; int b, hx; int qcol, kcol, vcol, ocol;
  __device__ __forceinline__ void init() { if (hx < 8) { qcol = 64 * hx; kcol = 512 + 64 * (hx >> 2); vcol = 640 + 64 * (hx >> 2); ocol = 64 * hx; }
    else { const int h = hx - 8; qcol = 768 + 64 * h; kcol = 1280 + 64 * h; vcol = 1792 + 64 * h; ocol = 512 + 64 * h; } }
  __device__ __forceinline__ int nt() const { return 4; }
  __device__ __forceinline__ long krow(int t) const { return (long)(ROWS_LAT + 256 * b + 64 * t); }
  __device__ __forceinline__ const bf16* kptr(long row, int ch) const { return QKV + row * 2304 + kcol + ch * 8; }
  __device__ __forceinline__ const bf16* vptr(long row, int ch) const { return QKV + row * 2304 + vcol + ch * 8; }
  __device__ __forceinline__ const bf16* qptr(int wid, int r32, int d0, int hi) const { return QKV + (long)(ROWS_LAT + 256 * b + 32 * wid + r32) * 2304 + qcol + 16 * d0 + 8 * hi; }
  __device__ __forceinline__ bool skip(int, int) const { return false; }
  __device__ __forceinline__ void mask(f32x16&, f32x16&, int, int, int, int) const {}
  __device__ __forceinline__ float sink(int) const { return hx < 8 ? sinkp[hx] * LOG2E : -INFINITY; }
  __device__ __forceinline__ bf16* orow(int wid, int row) const { return O + (long)(ROWS_LAT + 256 * b + 32 * wid + row) * 1024 + ocol; }
};
struct UDense {
  const bf16* Q; const bf16* KV; const bf16* KR; bf16* O; int b, h, qb;
  __device__ __forceinline__ int nt() const { return 132; }
  __device__ __forceinline__ long krow(int t) const { return t < 4 ? (long)(ROWS_LAT + 256 * b + 64 * t) : (long)(8192 * b + 64 * (t - 4)); }
  __device__ __forceinline__ const bf16* kptr(long row, int ch) const { return ch < 8 ? KV + row * 2048 + 64 * h + ch * 8 : KR + row * 32 + (ch - 8) * 8; }
  __device__ __forceinline__ const bf16* vptr(long row, int ch) const { return KV + row * 2048 + 1024 + 64 * h + ch * 8; }
  __device__ __forceinline__ const bf16* qptr(int wid, int r32, int d0, int hi) const { const bf16* qp = Q + (long)(8192 * b + 256 * qb + 32 * wid + r32) * 1536;
    return d0 < 4 ? qp + 64 * h + 16 * d0 + 8 * hi : qp + 1024 + 32 * h + 16 * (d0 - 4) + 8 * hi; }
  __device__ __forceinline__ bool skip(int, int) const { return false; }
  __device__ __forceinline__ void mask(f32x16&, f32x16&, int, int, int, int) const {}
  __device__ __forceinline__ float sink(int) const { return -INFINITY; }
  __device__ __forceinline__ bf16* orow(int wid, int row) const { return O + (long)(8192 * b + 256 * qb + 32 * wid + row) * 1024 + 64 * h; }
};
#undef ATT_SBAR
}
namespace attd {
typedef unsigned short bf16;
using bf16x8 = __attribute__((ext_vector_type(8))) short;
using s16x4 = __attribute__((ext_vector_type(4))) short;
using f32x16 = __attribute__((ext_vector_type(16))) float;
using u32x4 = __attribute__((ext_vector_type(4))) unsigned;
using i32x2 = __attribute__((ext_vector_type(2))) int;
using i32x4 = __attribute__((ext_vector_type(4))) int;
using i32x8 = __attribute__((ext_vector_type(8))) int;
using u32x6 = __attribute__((ext_vector_type(6))) unsigned;
using u32x16 = __attribute__((ext_vector_type(16))) unsigned;
typedef __bf16 bf16x32 __attribute__((ext_vector_type(32)));
constexpr int NW = 8, NT = 132, KSLOT = 5120, VSLOT = 8192;
constexpr int LDS_K = 0, LDS_V = 3 * KSLOT, LDS_WS = LDS_V + 3 * VSLOT, LDS_OST = LDS_WS + NW * 64 * 4, LDS_BYTES = LDS_OST + NW * 4096;
__device__ __forceinline__ int crow(int r, int hi) { return (r & 3) + 8 * (r >> 2) + 4 * hi; }
#define AF_SBAR() __builtin_amdgcn_sched_barrier(0)
__device__ __forceinline__ void glds16(unsigned voff, const void* sbase, unsigned lds_dst) { unsigned keep;
  asm volatile("s_mov_b32 %0, m0\n\ts_mov_b32 m0, %3\n\ts_nop 0\n\tglobal_load_lds_dwordx4 %1, %2\n\ts_mov_b32 m0, %0" : "=&s"(keep) : "v"(voff), "s"(sbase), "s"(lds_dst) : "memory"); }
typedef float f32x2_t __attribute__((ext_vector_type(2))); typedef __bf16 bf16x2_t __attribute__((ext_vector_type(2)));
__device__ __forceinline__ unsigned cvtpk_s(float lo, float hi) { f32x2_t v = {lo, hi}; bf16x2_t b = __builtin_convertvector(v, bf16x2_t); return __builtin_bit_cast(unsigned, b); }
#define AF_WAIT_BAR(N) asm volatile("s_waitcnt vmcnt(" #N ") lgkmcnt(0)\n\ts_barrier" ::: "memory")
typedef __attribute__((address_space(3))) const char* lds_cptr;
typedef short v4i16_t __attribute__((ext_vector_type(4)));
__device__ __forceinline__ i32x8 ld6(lds_cptr p16, lds_cptr p8) { const i32x4 a = *(const __attribute__((address_space(3))) i32x4*)p16; const i32x2 b = *(const __attribute__((address_space(3))) i32x2*)p8;
  return (i32x8){a.x, a.y, a.z, a.w, b.x, b.y, 0, 0}; }
__device__ __forceinline__ s16x4 vtr(lds_cptr p) { return __builtin_bit_cast(s16x4, __builtin_amdgcn_ds_read_tr16_b64_v4i16((__attribute__((address_space(3))) v4i16_t*)p)); }
__device__ __forceinline__ long tile_row(int b, int t) { return t < 4 ? (long)(16384 + 256 * b + 64 * t) : (long)(8192 * b + 64 * (t - 4)); }
__device__ __forceinline__ u32x6 to_fp6(u32x4 a0, u32x4 a1, u32x4 a2, u32x4 a3) { const u32x16 all = {a0.x, a0.y, a0.z, a0.w, a1.x, a1.y, a1.z, a1.w, a2.x, a2.y, a2.z, a2.w, a3.x, a3.y, a3.z, a3.w};
  return __builtin_amdgcn_cvt_scalef32_pk32_fp6_bf16(__builtin_bit_cast(bf16x32, all), 1.0f); }

__device__ __forceinline__ void dense_unit(int b, int h, int qb, const bf16* Q, const bf16* __restrict__ KV, const char* __restrict__ K6N, const char* __restrict__ K6R, bf16* O, char* shm, const int tid) {
  const int lane = tid & 63, r32 = lane & 31, hi = lane >> 5; const int wid = __builtin_amdgcn_readfirstlane(tid >> 6);
  const unsigned lds0 = (unsigned)(uintptr_t)shm;
  float* wsf = (float*)(shm + LDS_WS) + wid * 64;
  const bool wnp = wid < 3 || wid >= 5; const int pc = wnp ? (wid < 3 ? wid : wid - 5) : wid - 3;
  const unsigned voffK = (unsigned)(lane * 16);
  const char* sK = wnp ? K6N + h * 3072 + pc * 1024 : K6R + pc * 1024; const long kts = wnp ? 16 * 3072 : 2048;
  const unsigned voffV = (unsigned)((16 * (wid & 3) + (lane >> 2)) * 2048 + (wid >> 2) * 32 + (lane & 3) * 8) * 2u;
  const char* sV = (const char*)(KV + 1024 + 64 * h);
  const unsigned kdst = lds0 + LDS_K + (wnp ? pc * 1024 : 3072 + pc * 1024), vdst = lds0 + LDS_V + wid * 1024;
#define AF_DMA_K(t, ks) do { const long G_ = tile_row(b, (t)) >> 6; glds16(voffK, sK + G_ * kts, (unsigned)__builtin_amdgcn_readfirstlane(kdst + (ks))); } while (0)
#define AF_DMA_V(t, vs) do { const long R_ = tile_row(b, (t)); glds16(voffV, sV + R_ * 4096, (unsigned)__builtin_amdgcn_readfirstlane(vdst + (vs))); } while (0)
  const lds_cptr shm3 = (lds_cptr)shm;
  const lds_cptr kp16 = shm3 + LDS_K + hi * 1024 + r32 * 16;
  const lds_cptr kp8 = shm3 + LDS_K + 2048 + hi * 512 + r32 * 8;
  const lds_cptr vp0 = shm3 + LDS_V + ((lane >> 4) & 1) * 32 + (lane & 3) * 8 + (4 * hi + ((lane & 15) >> 2)) * 64;
  AF_DMA_K(0, 0); AF_DMA_V(0, 0); AF_DMA_K(1, KSLOT); AF_DMA_K(2, 2 * KSLOT);
  i32x8 qn, qr;
  { const bf16* qp = Q + (long)(8192 * b + 256 * qb + 32 * wid + r32) * 1536; const bf16* qa = qp + 64 * h + 32 * hi; const bf16* qc = qp + 1024 + 32 * h;
    const u32x6 n6 = to_fp6(*reinterpret_cast<const u32x4*>(qa), *reinterpret_cast<const u32x4*>(qa + 8), *reinterpret_cast<const u32x4*>(qa + 16), *reinterpret_cast<const u32x4*>(qa + 24));
    u32x6 r6 = to_fp6(*reinterpret_cast<const u32x4*>(qc), *reinterpret_cast<const u32x4*>(qc + 8), *reinterpret_cast<const u32x4*>(qc + 16), *reinterpret_cast<const u32x4*>(qc + 24));
    if (hi) r6 = (u32x6){0u, 0u, 0u, 0u, 0u, 0u};
    qn = (i32x8){(int)n6[0], (int)n6[1], (int)n6[2], (int)n6[3], (int)n6[4], (int)n6[5], 0, 0}; qr = (i32x8){(int)r6[0], (int)r6[1], (int)r6[2], (int)r6[3], (int)r6[4], (int)r6[5], 0, 0}; }
  float l_reg = 0.f; f32x16 o[2]; o[0] = f32x16{}; o[1] = f32x16{};
  f32x16 pA0, pA1, pB0, pB1; i32x8 kn0, kn1, kr0, kr1;
  int s_prev = 0, s_cur = 0, s_next = 1;
#define AF_ROT() do { s_prev = s_cur; s_cur = s_next; s_next = (s_next == 2) ? 0 : s_next + 1; } while (0)
#define AF_MF(a, b, c) __builtin_amdgcn_mfma_f32_32x32x16_bf16(a, b, c, 0, 0, 0)
  int sck_ = 0x7b7b7b7b, scq_ = 0x7f7f7f7f; asm volatile("" : "+v"(sck_), "+v"(scq_));
#define AF_MX(a, b, c) __builtin_amdgcn_mfma_scale_f32_32x32x64_f8f6f4(a, b, c, 2, 2, 0, sck_, 0, scq_)
#define AF_EX(v) __builtin_amdgcn_exp2f(v)
  const f32x16 zero16 = f32x16{};
  AF_WAIT_BAR(0);
  { pA0 = AF_MX(ld6(kp16, kp8), qn, zero16); pA1 = AF_MX(ld6(kp16 + 512, kp8 + 256), qn, zero16);
    pA0 = AF_MX(ld6(kp16 + 3072, kp8 + 2048), qr, pA0); pA1 = AF_MX(ld6(kp16 + 3072 + 512, kp8 + 2048 + 256), qr, pA1);
#pragma unroll
    for (int r = 0; r < 16; ++r) { pA0[r] = AF_EX(pA0[r]); pA1[r] = AF_EX(pA1[r]); } }
  AF_WAIT_BAR(0);
  AF_DMA_K(3, 0); AF_DMA_V(1, VSLOT);
  AF_ROT();
  { const lds_cptr k16_ = kp16 + s_cur * KSLOT, k8_ = kp8 + s_cur * KSLOT; kn0 = ld6(k16_, k8_); kn1 = ld6(k16_ + 512, k8_ + 256); kr0 = ld6(k16_ + 3072, k8_ + 2048); kr1 = ld6(k16_ + 3072 + 512, k8_ + 2048 + 256); }
  AF_WAIT_BAR(2);
  s16x4 vlo[8], vhi[8]; u32x4 pw0, pw1, pw2, pw3;
#define AF_PKW(P, B) cvtpk_s(P[B], P[B + 1])
#define AF_PAF(k) __builtin_bit_cast(bf16x8, pw##k)
#define AF_VFR(i) (bf16x8){vlo[i][0], vlo[i][1], vlo[i][2], vlo[i][3], vhi[i][0], vhi[i][1], vhi[i][2], vhi[i][3]}
#define AF_PIN(x) asm volatile("" : "+v"(x))
#define AF_VRD(i) do { vlo[i] = vtr(vp_ + (((i) >> 2) * 4096 + ((i) & 3) * 1024)); vhi[i] = vtr(vp_ + (((i) >> 2) * 4096 + ((i) & 3) * 1024 + 512)); AF_SBAR(); } while (0)
#define AF_GB(MF, X, B) do { MF; X[B] = AF_EX(X[B]); X[B + 1] = AF_EX(X[B + 1]); X[B + 2] = AF_EX(X[B + 2]); X[B + 3] = AF_EX(X[B + 3]); AF_PIN(X); AF_SBAR(); } while (0)
#define AF_KRD(G, j) do { if (G) { const lds_cptr k16_ = kp16 + s_next * KSLOT, k8_ = kp8 + s_next * KSLOT; \
      if ((j) == 0) kn0 = ld6(k16_, k8_); if ((j) == 1) kn1 = ld6(k16_ + 512, k8_ + 256); \
      if ((j) == 2) kr0 = ld6(k16_ + 3072, k8_ + 2048); if ((j) == 3) kr1 = ld6(k16_ + 3072 + 512, k8_ + 2048 + 256); AF_SBAR(); } } while (0)
#define AF_A4(P, B) do { sacc += P[B]; sacc += P[B + 1]; sacc += P[B + 2]; sacc += P[B + 3]; } while (0)
#define AF_STEP(C0, C1, P0, P1, t, GK, GV, GL) do { AF_SBAR(); \
    const lds_cptr vp_ = vp0 + s_prev * VSLOT; \
    float sacc = (P0[0] + P0[1]); \
    AF_VRD(0); AF_VRD(4); \
    { C0 = AF_MX(kn0, qn, zero16); sacc += P0[2]; sacc += P0[3]; AF_A4(P0, 4); AF_PIN(sacc); \
      pw0[0] = AF_PKW(P0, 0); pw0[1] = AF_PKW(P0, 2); pw0[2] = AF_PKW(P0, 4); pw0[3] = AF_PKW(P0, 6); AF_PIN(pw0); AF_SBAR(); } \
    AF_VRD(1); AF_VRD(5); \
    { C1 = AF_MX(kn1, qn, zero16); AF_A4(P0, 8); AF_A4(P0, 12); AF_PIN(sacc); \
      pw1[0] = AF_PKW(P0, 8); pw1[1] = AF_PKW(P0, 10); pw1[2] = AF_PKW(P0, 12); pw1[3] = AF_PKW(P0, 14); AF_PIN(pw1); AF_SBAR(); } \
    AF_VRD(2); AF_VRD(6); \
    { C0 = AF_MX(kr0, qr, C0); AF_A4(P1, 0); AF_A4(P1, 4); AF_PIN(sacc); \
      pw2[0] = AF_PKW(P1, 0); pw2[1] = AF_PKW(P1, 2); pw2[2] = AF_PKW(P1, 4); pw2[3] = AF_PKW(P1, 6); AF_PIN(pw2); AF_SBAR(); } \
    if (GK) { AF_DMA_K((t) + 3, s_cur * KSLOT); AF_SBAR(); } \
    AF_VRD(3); AF_VRD(7); \
    { C1 = AF_MX(kr1, qr, C1); AF_A4(P1, 8); AF_A4(P1, 12); AF_PIN(sacc); \
      pw3[0] = AF_PKW(P1, 8); pw3[1] = AF_PKW(P1, 10); pw3[2] = AF_PKW(P1, 12); pw3[3] = AF_PKW(P1, 14); AF_PIN(pw3); AF_SBAR(); } \
    if (GV) { AF_DMA_V((t) + 1, s_next * VSLOT); AF_SBAR(); } \
    l_reg += sacc; \
    AF_SBAR(); \
    AF_GB(o[0] = AF_MF(AF_PAF(0), AF_VFR(0), o[0]), C0, 0);  AF_KRD(GL, 0); \
    AF_GB(o[1] = AF_MF(AF_PAF(0), AF_VFR(4), o[1]), C0, 4);  AF_KRD(GL, 1); \
    AF_GB(o[0] = AF_MF(AF_PAF(1), AF_VFR(1), o[0]), C0, 8);  AF_KRD(GL, 2); \
    AF_GB(o[1] = AF_MF(AF_PAF(1), AF_VFR(5), o[1]), C0, 12); AF_KRD(GL, 3); \
    AF_GB(o[0] = AF_MF(AF_PAF(2), AF_VFR(2), o[0]), C1, 0); \
    AF_GB(o[1] = AF_MF(AF_PAF(2), AF_VFR(6), o[1]), C1, 4); \
    AF_GB(o[0] = AF_MF(AF_PAF(3), AF_VFR(3), o[0]), C1, 8); \
    AF_GB(o[1] = AF_MF(AF_PAF(3), AF_VFR(7), o[1]), C1, 12); \
  } while (0)
  int t = 1;
  for (; t + 3 < NT; t += 2) {
    AF_STEP(pB0, pB1, pA0, pA1, t, true, true, true);     AF_WAIT_BAR(2); AF_ROT();
    AF_STEP(pA0, pA1, pB0, pB1, t + 1, true, true, true); AF_WAIT_BAR(2); AF_ROT();
  }
  AF_STEP(pB0, pB1, pA0, pA1, NT - 3, false, true, true);  AF_WAIT_BAR(1); AF_ROT();
  AF_STEP(pA0, pA1, pB0, pB1, NT - 2, false, true, true);  AF_WAIT_BAR(0); AF_ROT();
  AF_STEP(pB0, pB1, pA0, pA1, NT - 1, false, false, false);
  { float sacc = pB0[0] + pB0[1];
#pragma unroll
    for (int r = 2; r < 16; ++r) sacc += pB0[r];
#pragma unroll
    for (int r = 0; r < 16; ++r) sacc += pB1[r];
    l_reg += sacc;
    pw0 = (u32x4){AF_PKW(pB0, 0), AF_PKW(pB0, 2), AF_PKW(pB0, 4), AF_PKW(pB0, 6)}; pw1 = (u32x4){AF_PKW(pB0, 8), AF_PKW(pB0, 10), AF_PKW(pB0, 12), AF_PKW(pB0, 14)};
    pw2 = (u32x4){AF_PKW(pB1, 0), AF_PKW(pB1, 2), AF_PKW(pB1, 4), AF_PKW(pB1, 6)}; pw3 = (u32x4){AF_PKW(pB1, 8), AF_PKW(pB1, 10), AF_PKW(pB1, 12), AF_PKW(pB1, 14)};
    AF_SBAR();
    const lds_cptr vp_ = vp0 + s_cur * VSLOT;
#pragma unroll
    for (int i = 0; i < 8; ++i) { vlo[i] = vtr(vp_ + ((i >> 2) * 4096 + (i & 3) * 1024)); vhi[i] = vtr(vp_ + ((i >> 2) * 4096 + (i & 3) * 1024 + 512)); }
    o[0] = AF_MF(AF_PAF(0), AF_VFR(0), o[0]); o[1] = AF_MF(AF_PAF(0), AF_VFR(4), o[1]);
    o[0] = AF_MF(AF_PAF(1), AF_VFR(1), o[0]); o[1] = AF_MF(AF_PAF(1), AF_VFR(5), o[1]);
    o[0] = AF_MF(AF_PAF(2), AF_VFR(2), o[0]); o[1] = AF_MF(AF_PAF(2), AF_VFR(6), o[1]);
    o[0] = AF_MF(AF_PAF(3), AF_VFR(3), o[0]); o[1] = AF_MF(AF_PAF(3), AF_VFR(7), o[1]); }
  { auto rr = __builtin_amdgcn_permlane32_swap(__float_as_uint(l_reg), __float_as_uint(l_reg), false, false); l_reg = __uint_as_float(rr[0]) + __uint_as_float(rr[1]); }
  if (hi == 0) wsf[32 + r32] = l_reg; asm volatile("s_waitcnt lgkmcnt(0)" ::: "memory");
  float rli[16];
#pragma unroll
  for (int r = 0; r < 16; ++r) rli[r] = __builtin_amdgcn_rcpf(wsf[32 + crow(r, hi)]);
  bf16* Ow = O + (long)(8192 * b + 256 * qb + 32 * wid) * 1024 + 64 * h;
  { bf16* stg = (bf16*)(shm + LDS_OST) + wid * 2048;
#pragma unroll
    for (int r = 0; r < 16; ++r) { const int orow = crow(r, hi);
#pragma unroll
      for (int d0 = 0; d0 < 2; ++d0) stg[orow * 64 + d0 * 32 + r32] = (bf16)(cvtpk_s(o[d0][r] * rli[r], 0.f) & 0xffffu); }
    asm volatile("s_waitcnt lgkmcnt(0)" ::: "memory");
#pragma unroll
    for (int i = 0; i < 4; ++i) { const int row = i * 8 + (lane >> 3), ch = lane & 7; const u32x4 v = *(const u32x4*)(stg + row * 64 + ch * 8); *(u32x4*)(Ow + (long)row * 1024 + ch * 8) = v; } }
  asm volatile("s_waitcnt vmcnt(0) lgkmcnt(0)\n\ts_barrier" ::: "memory");
#undef AF_DMA_K
#undef AF_DMA_V
#undef AF_ROT
#undef AF_PKW
#undef AF_PAF
#undef AF_VFR
#undef AF_PIN
#undef AF_MF
#undef AF_MX
#undef AF_EX
#undef AF_VRD
#undef AF_GB
#undef AF_KRD
#undef AF_A4
#undef AF_STEP
}
#undef AF_SBAR
#undef AF_WAIT_BAR
}
namespace attf {
typedef unsigned short bf16;
using bf16x8 = __attribute__((ext_vector_type(8))) short;
using s16x4 = __attribute__((ext_vector_type(4))) short;
using f32x16 = __attribute__((ext_vector_type(16))) float;
using u32x4 = __attribute__((ext_vector_type(4))) unsigned;
using i32x2 = __attribute__((ext_vector_type(2))) int;
using i32x4 = __attribute__((ext_vector_type(4))) int;
using i32x8 = __attribute__((ext_vector_type(8))) int;
using u32x6 = __attribute__((ext_vector_type(6))) unsigned;
using u32x16 = __attribute__((ext_vector_type(16))) unsigned;
typedef __bf16 bf16x32 __attribute__((ext_vector_type(32)));
constexpr int NW = 8, KSLOT = 12288, VSLOT = 8192;
constexpr int LDS_K = 0, LDS_V = 3 * KSLOT, LDS_WS = LDS_V + 3 * VSLOT, LDS_OST = LDS_WS + NW * 64 * 4, LDS_RPB = LDS_OST + NW * 4096, LDS_BYTES = LDS_RPB + 2048;
__device__ __forceinline__ int crow(int r, int hi) { return (r & 3) + 8 * (r >> 2) + 4 * hi; }
#define AF_SBAR() __builtin_amdgcn_sched_barrier(0)
__device__ __forceinline__ void glds16(unsigned voff, const void* sbase, unsigned lds_dst) { unsigned keep;
  asm volatile("s_mov_b32 %0, m0\n\ts_mov_b32 m0, %3\n\ts_nop 0\n\tglobal_load_lds_dwordx4 %1, %2\n\ts_mov_b32 m0, %0" : "=&s"(keep) : "v"(voff), "s"(sbase), "s"(lds_dst) : "memory"); }
typedef float f32x2_t __attribute__((ext_vector_type(2))); typedef __bf16 bf16x2_t __attribute__((ext_vector_type(2)));
__device__ __forceinline__ unsigned cvtpk_s(float lo, float hi) { f32x2_t v = {lo, hi}; bf16x2_t b = __builtin_convertvector(v, bf16x2_t); return __builtin_bit_cast(unsigned, b); }
#define AF_WAIT_BAR(N) asm volatile("s_waitcnt vmcnt(" #N ") lgkmcnt(0)\n\ts_barrier" ::: "memory")
typedef __attribute__((address_space(3))) const char* lds_cptr;
typedef short v4i16_t __attribute__((ext_vector_type(4)));
__device__ __forceinline__ void kload2(bf16x8* kf, lds_cptr kp, int j) { kf[2 * j] = *(const __attribute__((address_space(3))) bf16x8*)(kp + j * 2048); kf[2 * j + 1] = *(const __attribute__((address_space(3))) bf16x8*)(kp + j * 2048 + 512); }
__device__ __forceinline__ i32x8 ld6(lds_cptr p16, lds_cptr p8) { const i32x4 a = *(const __attribute__((address_space(3))) i32x4*)p16; const i32x2 b = *(const __attribute__((address_space(3))) i32x2*)p8;
  const i32x4 b4 = __builtin_shufflevector(b, b, 0, 1, -1, -1); return __builtin_shufflevector(a, b4, 0, 1, 2, 3, 4, 5, -1, -1); }
__device__ __forceinline__ i32x8 to_fp6(u32x4 a0, u32x4 a1, u32x4 a2, u32x4 a3) { const u32x16 all = {a0.x, a0.y, a0.z, a0.w, a1.x, a1.y, a1.z, a1.w, a2.x, a2.y, a2.z, a2.w, a3.x, a3.y, a3.z, a3.w};
  const u32x6 c = __builtin_amdgcn_cvt_scalef32_pk32_fp6_bf16(__builtin_bit_cast(bf16x32, all), 1.0f); return __builtin_bit_cast(i32x8, __builtin_shufflevector(c, c, 0, 1, 2, 3, 4, 5, -1, -1)); }
__device__ __forceinline__ s16x4 vtr(lds_cptr p) { return __builtin_bit_cast(s16x4, __builtin_amdgcn_ds_read_tr16_b64_v4i16((__attribute__((address_space(3))) v4i16_t*)p)); }

template <int DKC, class U, bool F6 = false>
__device__ __forceinline__ void fast_unit(const U& u, char* shm, int tid) {
  static_assert(DKC == 8 || DKC == 12, "q/k dim 64 or 96"); static_assert(!F6 || DKC == 8, "fp6 logits: q/k dim 64");
  asm volatile("" : "+v"(tid));
  constexpr int ND0 = DKC / 2;
  const int lane = tid & 63, r32 = lane & 31, hi = lane >> 5; const int wid = __builtin_amdgcn_readfirstlane(tid >> 6);
  const unsigned lds0 = (unsigned)(uintptr_t)shm;
  float* wsf = (float*)(shm + LDS_WS) + wid * 64;
  const int NT = u.nt();
  const unsigned voffKA = (unsigned)(lane * u.kpitch + 8 * wid) * 2u;
  const unsigned voffKB = (unsigned)(lane * 32 + 8 * (wid & 3)) * 2u;
  const unsigned voffV = (unsigned)((16 * (wid & 3) + (lane >> 2)) * u.vpitch + (wid >> 2) * 32 + (lane & 3) * 8) * 2u;
  const unsigned kdstA = lds0 + LDS_K + wid * 1024, kdstB = lds0 + LDS_K + (8 + (wid & 3)) * 1024, vdst = lds0 + LDS_V + wid * 1024;
  const int pc6 = wid % 3; const unsigned voffK6 = (unsigned)(lane * 16), kdst6 = lds0 + LDS_K + pc6 * 1024;
#define AF_DMA_KA(t, ks) do { const long R_ = u.trow(t); if constexpr (F6) glds16(voffK6, u.k6base + (R_ >> 6) * 30720 + pc6 * 1024, (unsigned)__builtin_amdgcn_readfirstlane(kdst6 + (ks))); \
    else glds16(voffKA, (const char*)u.kbase + R_ * (2 * u.kpitch), (unsigned)__builtin_amdgcn_readfirstlane(kdstA + (ks))); } while (0)
#define AF_DMA_KB(t, ks) do { if constexpr (DKC == 12) { const long R_ = u.trow(t); glds16(voffKB, (const char*)u.krbase + R_ * 64, (unsigned)__builtin_amdgcn_readfirstlane(kdstB + (ks))); } } while (0)
#define AF_DMA_K(t, ks) do { AF_DMA_KA(t, ks); AF_DMA_KB(t, ks); } while (0)
#define AF_DMA_V(t, vs) do { const long R_ = u.trow(t); glds16(voffV, (const char*)u.vbase + R_ * (2 * u.vpitch), (unsigned)__builtin_amdgcn_readfirstlane(vdst + (vs))); } while (0)
#define AF_WAITN(NSTEPS_K, NV) do { if constexpr (DKC == 12) { if ((NSTEPS_K) == 2 && (NV) == 1) AF_WAIT_BAR(5); else if ((NSTEPS_K) == 1 && (NV) == 1) AF_WAIT_BAR(3); else if ((NV) == 1) AF_WAIT_BAR(1); else AF_WAIT_BAR(0); } \
    else { if ((NSTEPS_K) == 2 && (NV) == 1) AF_WAIT_BAR(3); else if ((NSTEPS_K) == 1 && (NV) == 1) AF_WAIT_BAR(2); else if ((NV) == 1) AF_WAIT_BAR(1); else AF_WAIT_BAR(0); } } while (0)
  const lds_cptr shm3 = (lds_cptr)shm; const lds_cptr kp0 = shm3 + LDS_K + hi * 1024 + r32 * 16;
  const lds_cptr kp8 = shm3 + LDS_K + 2048 + hi * 512 + r32 * 8;
  const lds_cptr vp0 = shm3 + LDS_V + ((lane >> 4) & 1) * 32 + (lane & 3) * 8 + (4 * hi + ((lane & 15) >> 2)) * 64;
  bf16x8 qr[ND0]; i32x8 qn;
  if constexpr (F6) { const bf16* qa = u.qptr(wid, r32, 0, 0) + 32 * hi;
    qn = to_fp6(*reinterpret_cast<const u32x4*>(qa), *reinterpret_cast<const u32x4*>(qa + 8), *reinterpret_cast<const u32x4*>(qa + 16), *reinterpret_cast<const u32x4*>(qa + 24)); }
  else {
#pragma unroll
    for (int d0 = 0; d0 < ND0; ++d0) qr[d0] = *reinterpret_cast<const bf16x8*>(u.qptr(wid, r32, d0, hi)); }
  AF_DMA_K(0, 0); AF_DMA_V(0, 0); AF_DMA_K(1, KSLOT); AF_DMA_K(2, 2 * KSLOT);
  float l_reg = 0.f; f32x16 o[2]; o[0] = f32x16{}; o[1] = f32x16{};
  f32x16 pA0, pA1, pB0, pB1; bf16x8 kf[DKC]; i32x8 kn0, kn1;
  int sck_ = 0x7b7b7b7b, scq_ = 0x7f7f7f7f; asm volatile("" : "+v"(sck_), "+v"(scq_));
#define AF_MX6(a, b, c) __builtin_amdgcn_mfma_scale_f32_32x32x64_f8f6f4(a, b, c, 2, 2, 0, sck_, 0, scq_)
  int s_prev = 0, s_cur = 0, s_next = 1;
#define AF_ROT() do { s_prev = s_cur; s_cur = s_next; s_next = (s_next == 2) ? 0 : s_next + 1; } while (0)
  AF_WAITN(2, 1);
  { const char* kb = shm + LDS_K + hi * 1024 + r32 * 16; pA0 = f32x16{}; pA1 = f32x16{};
    if constexpr (F6) { pA0 = AF_MX6(ld6(kp0, kp8), qn, pA0); pA1 = AF_MX6(ld6(kp0 + 512, kp8 + 256), qn, pA1); }
    else
#pragma unroll
    for (int d0 = 0; d0 < ND0; ++d0) { const bf16x8 b0 = *reinterpret_cast<const bf16x8*>(kb + d0 * 2048), b1 = *reinterpret_cast<const bf16x8*>(kb + d0 * 2048 + 512);
      pA0 = __builtin_amdgcn_mfma_f32_32x32x16_bf16(b0, qr[d0], pA0, 0, 0, 0); pA1 = __builtin_amdgcn_mfma_f32_32x32x16_bf16(b1, qr[d0], pA1, 0, 0, 0); }
    if constexpr (U::HAS_MASK) u.mask(pA0, pA1, 0, wid, r32, hi);
#pragma unroll
    for (int r = 0; r < 16; ++r) { pA0[r] = __builtin_amdgcn_exp2f(pA0[r]); pA1[r] = __builtin_amdgcn_exp2f(pA1[r]); } }
  AF_WAIT_BAR(0);
  AF_DMA_K(3, 0); AF_DMA_V(1, VSLOT);
  AF_ROT();
  if constexpr (F6) { kn0 = ld6(kp0 + s_cur * KSLOT, kp8 + s_cur * KSLOT); kn1 = ld6(kp0 + s_cur * KSLOT + 512, kp8 + s_cur * KSLOT + 256); }
  else {
#pragma unroll
    for (int j = 0; j < ND0; ++j) kload2(kf, kp0 + s_cur * KSLOT, j); }
  AF_WAITN(1, 1);
  s16x4 vlo[8], vhi[8]; u32x4 pw0, pw1, pw2, pw3;
#define AF_PKW(P, B) cvtpk_s(P[B], P[B + 1])
#define AF_PAF(k) __builtin_bit_cast(bf16x8, pw##k)
#define AF_VFR(i) (bf16x8){vlo[i][0], vlo[i][1], vlo[i][2], vlo[i][3], vhi[i][0], vhi[i][1], vhi[i][2], vhi[i][3]}
#define AF_PIN(x) asm volatile("" : "+v"(x))
#define AF_MF(a, b, c) __builtin_amdgcn_mfma_f32_32x32x16_bf16(a, b, c, 0, 0, 0)
#define AF_EX(v) __builtin_amdgcn_exp2f(v)
#define AF_VRD(i) do { vlo[i] = vtr(vp_ + (((i) >> 2) * 4096 + ((i) & 3) * 1024)); vhi[i] = vtr(vp_ + (((i) >> 2) * 4096 + ((i) & 3) * 1024 + 512)); AF_SBAR(); } while (0)
#define AF_GA4(MF, A0, A1, A2, A3, W0, W1, PW) do { MF; sacc += A0; sacc += A1; sacc += A2; sacc += A3; AF_PIN(sacc); W0; W1; AF_PIN(PW); AF_SBAR(); } while (0)
#define AF_GA3(MF, A0, A1, A2, W0, W1, PW) do { MF; sacc += A0; sacc += A1; sacc += A2; AF_PIN(sacc); W0; W1; AF_PIN(PW); AF_SBAR(); } while (0)
#define AF_GA2(MF, A0, A1, W0, PW) do { MF; sacc += A0; sacc += A1; AF_PIN(sacc); W0; AF_PIN(PW); AF_SBAR(); } while (0)
#define AF_GB(MF, X, B) do { MF; X[B] = AF_EX(X[B]); X[B + 1] = AF_EX(X[B + 1]); X[B + 2] = AF_EX(X[B + 2]); X[B + 3] = AF_EX(X[B + 3]); AF_PIN(X); AF_SBAR(); } while (0)
#define AF_KRD(G, j) do { if constexpr (F6) { if ((j) < 2) { if (G) { if ((j) == 0) kn0 = ld6(kp0 + s_next * KSLOT, kp8 + s_next * KSLOT); else kn1 = ld6(kp0 + s_next * KSLOT + 512, kp8 + s_next * KSLOT + 256); AF_SBAR(); } } } \
    else if ((j) < ND0) { if (G) { kload2(kf, kp0 + s_next * KSLOT, (j) < ND0 ? (j) : 0); AF_SBAR(); } } } while (0)
  const f32x16 zero16 = f32x16{};
#define AF_PHASE_A12(C0, C1, P0, P1, t, GK, GV) do { \
    AF_VRD(0); float sacc = (P0[0] + P0[1]); \
    AF_GA3(C0 = AF_MF(kf[0], qr[0], zero16), P0[2], P0[3], P0[4],     pw0[0] = AF_PKW(P0, 0), pw0[1] = AF_PKW(P0, 2), pw0); \
    AF_VRD(4); AF_GA3(C1 = AF_MF(kf[1], qr[0], zero16), P0[5], P0[6], P0[7],     pw0[2] = AF_PKW(P0, 4), pw0[3] = AF_PKW(P0, 6), pw0); \
    AF_VRD(1); AF_GA3(C0 = AF_MF(kf[2], qr[1], C0),     P0[8], P0[9], P0[10],    pw1[0] = AF_PKW(P0, 8), pw1[1] = AF_PKW(P0, 10), pw1); \
    AF_VRD(5); AF_GA3(C1 = AF_MF(kf[3], qr[1], C1),     P0[11], P0[12], P0[13],  pw1[2] = AF_PKW(P0, 12), pw1[3] = AF_PKW(P0, 14), pw1); \
    AF_VRD(2); AF_GA3(C0 = AF_MF(kf[4], qr[2], C0),     P0[14], P0[15], P1[0],   pw2[0] = AF_PKW(P1, 0), pw2[1] = AF_PKW(P1, 2), pw2); \
    AF_VRD(6); AF_GA3(C1 = AF_MF(kf[5], qr[2], C1),     P1[1], P1[2], P1[3],     pw2[2] = AF_PKW(P1, 4), pw2[3] = AF_PKW(P1, 6), pw2); \
    AF_VRD(3); AF_GA2(C0 = AF_MF(kf[6], qr[3], C0),     P1[4], P1[5],            pw3[0] = AF_PKW(P1, 8), pw3); \
    AF_VRD(7); AF_GA2(C1 = AF_MF(kf[7], qr[3], C1),     P1[6], P1[7],            pw3[1] = AF_PKW(P1, 10), pw3); \
    AF_GA2(C0 = AF_MF(kf[8 % DKC], qr[4 % ND0], C0),    P1[8], P1[9],            pw3[2] = AF_PKW(P1, 12), pw3); \
    if (GK) { AF_DMA_KA((t) + 3, s_cur * KSLOT); AF_SBAR(); } \
    AF_GA2(C1 = AF_MF(kf[9 % DKC], qr[4 % ND0], C1),    P1[10], P1[11],          pw3[3] = AF_PKW(P1, 14), pw3); \
    if (GK) { AF_DMA_KB((t) + 3, s_cur * KSLOT); AF_SBAR(); } \
    { C0 = AF_MF(kf[10 % DKC], qr[5 % ND0], C0); sacc += P1[12]; sacc += P1[13]; AF_PIN(sacc); AF_SBAR(); } \
    if (GV) { AF_DMA_V((t) + 1, s_next * VSLOT); AF_SBAR(); } \
    { C1 = AF_MF(kf[11 % DKC], qr[5 % ND0], C1); sacc += P1[14]; sacc += P1[15]; AF_PIN(sacc); AF_SBAR(); } \
    l_reg += sacc; } while (0)
#define AF_PHASE_A8(C0, C1, P0, P1, t, GK, GV) do { \
    AF_VRD(0); float sacc = (P0[0] + P0[1]); \
    AF_GA4(C0 = AF_MF(kf[0], qr[0], zero16), P0[2], P0[3], P0[4], P0[5],       pw0[0] = AF_PKW(P0, 0), pw0[1] = AF_PKW(P0, 2), pw0); \
    AF_VRD(4); AF_GA4(C1 = AF_MF(kf[1], qr[0], zero16), P0[6], P0[7], P0[8], P0[9],       pw0[2] = AF_PKW(P0, 4), pw0[3] = AF_PKW(P0, 6), pw0); \
    AF_VRD(1); AF_GA4(C0 = AF_MF(kf[2], qr[1], C0),     P0[10], P0[11], P0[12], P0[13],   pw1[0] = AF_PKW(P0, 8), pw1[1] = AF_PKW(P0, 10), pw1); \
    AF_VRD(5); AF_GA4(C1 = AF_MF(kf[3], qr[1], C1),     P0[14], P0[15], P1[0], P1[1],     pw1[2] = AF_PKW(P0, 12), pw1[3] = AF_PKW(P0, 14), pw1); \
    AF_VRD(2); AF_GA4(C0 = AF_MF(kf[4], qr[2], C0),     P1[2], P1[3], P1[4], P1[5],       pw2[0] = AF_PKW(P1, 0), pw2[1] = AF_PKW(P1, 2), pw2); \
    AF_VRD(6); AF_GA4(C1 = AF_MF(kf[5], qr[2], C1),     P1[6], P1[7], P1[8], P1[9],       pw2[2] = AF_PKW(P1, 4), pw2[3] = AF_PKW(P1, 6), pw2); \
    AF_VRD(3); AF_GA4(C0 = AF_MF(kf[6], qr[3], C0),     P1[10], P1[11], P1[12], P1[13],   pw3[0] = AF_PKW(P1, 8), pw3[1] = AF_PKW(P1, 10), pw3); \
    AF_VRD(7); AF_GA4(C1 = AF_MF(kf[7], qr[3], C1),     P1[14], P1[15], 0.f, 0.f,         pw3[2] = AF_PKW(P1, 12), pw3[3] = AF_PKW(P1, 14), pw3); \
    l_reg += sacc; \
    if (GK) { AF_DMA_KA((t) + 3, s_cur * KSLOT); } if (GV) { AF_DMA_V((t) + 1, s_next * VSLOT); } } while (0)
#define AF_A4(P, B) do { sacc += P[B]; sacc += P[B + 1]; sacc += P[B + 2]; sacc += P[B + 3]; } while (0)
#define AF_PHASE_A6(C0, C1, P0, P1, t, GK, GV) do { \
    AF_VRD(0); AF_VRD(4); float sacc = (P0[0] + P0[1]); \
    { C0 = AF_MX6(kn0, qn, zero16); sacc += P0[2]; sacc += P0[3]; AF_A4(P0, 4); AF_A4(P0, 8); AF_A4(P0, 12); AF_PIN(sacc); \
      pw0[0] = AF_PKW(P0, 0); pw0[1] = AF_PKW(P0, 2); pw0[2] = AF_PKW(P0, 4); pw0[3] = AF_PKW(P0, 6); AF_PIN(pw0); pw1[0] = AF_PKW(P0, 8); pw1[1] = AF_PKW(P0, 10); pw1[2] = AF_PKW(P0, 12); pw1[3] = AF_PKW(P0, 14); AF_PIN(pw1); AF_SBAR(); } \
    AF_VRD(1); AF_VRD(5); AF_VRD(2); AF_VRD(6); \
    { C1 = AF_MX6(kn1, qn, zero16); AF_A4(P1, 0); AF_A4(P1, 4); AF_A4(P1, 8); AF_A4(P1, 12); AF_PIN(sacc); \
      pw2[0] = AF_PKW(P1, 0); pw2[1] = AF_PKW(P1, 2); pw2[2] = AF_PKW(P1, 4); pw2[3] = AF_PKW(P1, 6); AF_PIN(pw2); pw3[0] = AF_PKW(P1, 8); pw3[1] = AF_PKW(P1, 10); pw3[2] = AF_PKW(P1, 12); pw3[3] = AF_PKW(P1, 14); AF_PIN(pw3); AF_SBAR(); } \
    AF_VRD(3); AF_VRD(7); \
    l_reg += sacc; \
    if (GK) { AF_DMA_KA((t) + 3, s_cur * KSLOT); } if (GV) { AF_DMA_V((t) + 1, s_next * VSLOT); } } while (0)
#define AF_STEP(C0, C1, P0, P1, t, GK, GV, GL) do { AF_SBAR(); \
    const lds_cptr vp_ = vp0 + s_prev * VSLOT; \
    if constexpr (F6) AF_PHASE_A6(C0, C1, P0, P1, t, GK, GV); else if constexpr (DKC == 12) AF_PHASE_A12(C0, C1, P0, P1, t, GK, GV); else AF_PHASE_A8(C0, C1, P0, P1, t, GK, GV); \
    if constexpr (U::HAS_MASK) u.mask(C0, C1, (t), wid, r32, hi); \
    AF_SBAR(); \
    AF_GB(o[0] = AF_MF(AF_PAF(0), AF_VFR(0), o[0]), C0, 0);  AF_KRD(GL, 0); \
    AF_GB(o[1] = AF_MF(AF_PAF(0), AF_VFR(4), o[1]), C0, 4);  AF_KRD(GL, 1); \
    AF_GB(o[0] = AF_MF(AF_PAF(1), AF_VFR(1), o[0]), C0, 8);  AF_KRD(GL, 2); \
    AF_GB(o[1] = AF_MF(AF_PAF(1), AF_VFR(5), o[1]), C0, 12); AF_KRD(GL, 3); \
    AF_GB(o[0] = AF_MF(AF_PAF(2), AF_VFR(2), o[0]), C1, 0);  AF_KRD(GL, 4); \
    AF_GB(o[1] = AF_MF(AF_PAF(2), AF_VFR(6), o[1]), C1, 4);  AF_KRD(GL, 5); \
    AF_GB(o[0] = AF_MF(AF_PAF(3), AF_VFR(3), o[0]), C1, 8); \
    AF_GB(o[1] = AF_MF(AF_PAF(3), AF_VFR(7), o[1]), C1, 12); \
  } while (0)
  int t = 1;
  for (; t + 3 < NT; t += 2) {
    AF_STEP(pB0, pB1, pA0, pA1, t, true, true, true);     AF_WAITN(1, 1); AF_ROT();
    AF_STEP(pA0, pA1, pB0, pB1, t + 1, true, true, true); AF_WAITN(1, 1); AF_ROT();
  }
  AF_STEP(pB0, pB1, pA0, pA1, NT - 3, false, true, true);  AF_WAITN(0, 1); AF_ROT();
  AF_STEP(pA0, pA1, pB0, pB1, NT - 2, false, true, true);  AF_WAIT_BAR(0); AF_ROT();
  AF_STEP(pB0, pB1, pA0, pA1, NT - 1, false, false, false);
  { float sacc = pB0[0] + pB0[1];
#pragma unroll
    for (int r = 2; r < 16; ++r) sacc += pB0[r];
#pragma unroll
    for (int r = 0; r < 16; ++r) sacc += pB1[r];
    l_reg += sacc;
    pw0 = (u32x4){AF_PKW(pB0, 0), AF_PKW(pB0, 2), AF_PKW(pB0, 4), AF_PKW(pB0, 6)}; pw1 = (u32x4){AF_PKW(pB0, 8), AF_PKW(pB0, 10), AF_PKW(pB0, 12), AF_PKW(pB0, 14)};
    pw2 = (u32x4){AF_PKW(pB1, 0), AF_PKW(pB1, 2), AF_PKW(pB1, 4), AF_PKW(pB1, 6)}; pw3 = (u32x4){AF_PKW(pB1, 8), AF_PKW(pB1, 10), AF_PKW(pB1, 12), AF_PKW(pB1, 14)};
    AF_SBAR();
    const lds_cptr vp_ = vp0 + s_cur * VSLOT;
#pragma unroll
    for (int i = 0; i < 8; ++i) { vlo[i] = vtr(vp_ + ((i >> 2) * 4096 + (i & 3) * 1024)); vhi[i] = vtr(vp_ + ((i >> 2) * 4096 + (i & 3) * 1024 + 512)); }
    o[0] = AF_MF(AF_PAF(0), AF_VFR(0), o[0]); o[1] = AF_MF(AF_PAF(0), AF_VFR(4), o[1]);
    o[0] = AF_MF(AF_PAF(1), AF_VFR(1), o[0]); o[1] = AF_MF(AF_PAF(1), AF_VFR(5), o[1]);
    o[0] = AF_MF(AF_PAF(2), AF_VFR(2), o[0]); o[1] = AF_MF(AF_PAF(2), AF_VFR(6), o[1]);
    o[0] = AF_MF(AF_PAF(3), AF_VFR(3), o[0]); o[1] = AF_MF(AF_PAF(3), AF_VFR(7), o[1]); }
  { auto rr = __builtin_amdgcn_permlane32_swap(__float_as_uint(l_reg), __float_as_uint(l_reg), false, false); l_reg = __uint_as_float(rr[0]) + __uint_as_float(rr[1]); }
  l_reg += __builtin_amdgcn_exp2f(u.sink(wid));
  if (hi == 0) wsf[32 + r32] = l_reg; asm volatile("s_waitcnt lgkmcnt(0)" ::: "memory");
  float rli[16];
#pragma unroll
  for (int r = 0; r < 16; ++r) rli[r] = __builtin_amdgcn_rcpf(wsf[32 + crow(r, hi)]);
  bf16* Ow = u.orow0(wid);
  { bf16* stg = (bf16*)(shm + LDS_OST) + wid * 2048;
#pragma unroll
    for (int r = 0; r < 16; ++r) { const int orow = crow(r, hi);
#pragma unroll
      for (int d0 = 0; d0 < 2; ++d0) stg[orow * 64 + d0 * 32 + r32] = (bf16)(cvtpk_s(o[d0][r] * rli[r], 0.f) & 0xffffu); }
    asm volatile("s_waitcnt lgkmcnt(0)" ::: "memory");
#pragma unroll
    for (int i = 0; i < 4; ++i) { const int row = i * 8 + (lane >> 3), ch = lane & 7; const u32x4 v = *(const u32x4*)(stg + row * 64 + ch * 8); *(u32x4*)(Ow + (long)row * 1024 + ch * 8) = v; } }
  asm volatile("s_waitcnt vmcnt(0) lgkmcnt(0)\n\ts_barrier" ::: "memory");
#undef AF_DMA_KA
#undef AF_DMA_KB
#undef AF_DMA_K
#undef AF_DMA_V
#undef AF_WAITN
#undef AF_ROT
#undef AF_PKW
#undef AF_PAF
#undef AF_VFR
#undef AF_PIN
#undef AF_MF
#undef AF_EX
#undef AF_VRD
#undef AF_GA4
#undef AF_GA3
#undef AF_GA2
#undef AF_GB
#undef AF_KRD
#undef AF_PHASE_A12
#undef AF_PHASE_A8
#undef AF_PHASE_A6
#undef AF_A4
#undef AF_MX6
#undef AF_STEP
}

constexpr int ROWS_LAT = 16384;
constexpr float LOG2E_ = 1.4426950408889634f;
__device__ __forceinline__ int clampi(int v, int lo, int hi_) { return v < lo ? lo : (v > hi_ ? hi_ : v); }
struct FDense {
  static constexpr bool HAS_MASK = false;
  const bf16* Q; const bf16* kbase; const bf16* vbase; const bf16* krbase; bf16* O; int b, h, qb; static constexpr int kpitch = 2048, vpitch = 2048; const char* k6base = nullptr;
  __device__ __forceinline__ void init(const bf16* Q_, const bf16* KV, const bf16* KR, bf16* O_, int b_, int h_, int qb_) { Q = Q_; kbase = KV + 64 * h_; vbase = KV + 1024 + 64 * h_; krbase = KR; O = O_; b = b_; h = h_; qb = qb_; }
  __device__ __forceinline__ int nt() const { return 132; }
  __device__ __forceinline__ long trow(int t) const { return t < 4 ? (long)(ROWS_LAT + 256 * b + 64 * t) : (long)(8192 * b + 64 * (t - 4)); }
  __device__ __forceinline__ const bf16* qptr(int wid, int r32, int d0, int hi) const { const bf16* qp = Q + (long)(8192 * b + 256 * qb + 32 * wid + r32) * 1536;
    return d0 < 4 ? qp + 64 * h + 16 * d0 + 8 * hi : qp + 1024 + 32 * h + 16 * (d0 - 4) + 8 * hi; }
  __device__ __forceinline__ void mask(f32x16&, f32x16&, int, int, int, int) const {}
  __device__ __forceinline__ float sink(int) const { return -INFINITY; }
  __device__ __forceinline__ bf16* orow0(int wid) const { return O + (long)(8192 * b + 256 * qb + 32 * wid) * 1024 + 64 * h; }
};
struct FWin {
  static constexpr bool HAS_MASK = true; static constexpr int kpitch = 2304, vpitch = 2304;
  const bf16* QKV; const bf16* kbase; const bf16* vbase; const bf16* krbase; bf16* O; const float* sinkp; int b, n, g, hh, i0, cnt; const char* k6base;
  __device__ __forceinline__ void init(const bf16* QKV_, bf16* O_, const float* sk, int b_, int n_, int g_, int hh_, const char* K6E = nullptr) { QKV = QKV_; O = O_; sinkp = sk; b = b_; n = n_; g = g_; hh = hh_; krbase = nullptr; k6base = K6E + g_ * 3072;
    kbase = QKV_ + 512 + 64 * g_; vbase = QKV_ + 640 + 64 * g_; i0 = (n_ == 0) ? 2 : 0; cnt = (n_ == 0 || n_ == 63) ? 4 : 6; }
  __device__ __forceinline__ int nt() const { return 4 + cnt; }
  __device__ __forceinline__ int kpos0(int t) const { return 128 * (n - 1) + 64 * (i0 + t - 4); }
  __device__ __forceinline__ long trow(int t) const { return t < 4 ? (long)(ROWS_LAT + 256 * b + 64 * t) : (long)(8192 * b + kpos0(t)); }
  __device__ __forceinline__ int head(int wid) const { return 4 * g + 2 * hh + (wid >> 2); }
  __device__ __forceinline__ int qpos0(int wid) const { return 128 * n + 32 * (wid & 3); }
  __device__ __forceinline__ const bf16* qptr(int wid, int r32, int d0, int hi) const { return QKV + (long)(8192 * b + qpos0(wid) + r32) * 2304 + 64 * head(wid) + 16 * d0 + 8 * hi; }
  __device__ __forceinline__ void mask(f32x16& p0, f32x16& p1, int t, int wid, int r32, int hi) const {
    if (t < 4) return;
    const int k0 = kpos0(t), q0 = qpos0(wid);
    if (k0 - (q0 + 31) >= -128 && k0 + 63 - q0 <= 128) return;
    asm volatile("" : "+v"(r32), "+v"(hi));
    const int dq = k0 - (q0 + r32);
#pragma unroll
    for (int r = 0; r < 16; ++r) { const int d = dq + crow(r, hi); if (d > 128 || d < -128) p0[r] = -INFINITY; if (d + 32 > 128 || d + 32 < -128) p1[r] = -INFINITY; }
  }
  __device__ __forceinline__ float sink(int wid) const { return sinkp[head(wid)] * LOG2E_; }
  __device__ __forceinline__ bf16* orow0(int wid) const { return O + (long)(8192 * b + qpos0(wid)) * 1024 + 64 * head(wid); }
};
struct FNa {
  static constexpr bool HAS_MASK = true; static constexpr int kpitch = 2304, vpitch = 2304;
  const bf16* QKV; const bf16* kbase; const bf16* vbase; const bf16* krbase; bf16* O; const float* rpbl; int b, h, R4, krlo, nloc; const char* k6base;
  __device__ __forceinline__ void init(const bf16* QKV_, bf16* O_, const float* rpbl_, int b_, int h_, int R4_, const char* K6E = nullptr) { QKV = QKV_; O = O_; rpbl = rpbl_; b = b_; h = h_; R4 = R4_; krbase = nullptr; k6base = K6E + (2 + h_) * 3072;
    kbase = QKV_ + 1280 + 64 * h_; vbase = QKV_ + 1792 + 64 * h_; krlo = clampi(4 * R4_ - 4, 0, 120); nloc = clampi(4 * R4_ - 1, 0, 120) + 7 - krlo + 1; }
  __device__ __forceinline__ int nt() const { return (4 + nloc + 1) & ~1; }
  __device__ __forceinline__ long trow(int t) const { return (t < 4 || t >= 4 + nloc) ? (long)(ROWS_LAT + 256 * b + 64 * (t & 3)) : (long)(8192 * b + 64 * (krlo + t - 4)); }
  __device__ __forceinline__ int qrow(int wid) const { return 4 * R4 + (wid >> 1); }
  __device__ __forceinline__ const bf16* qptr(int wid, int r32, int d0, int hi) const { return QKV + (long)(8192 * b + 64 * qrow(wid) + 32 * (wid & 1) + r32) * 2304 + 768 + 64 * h + 16 * d0 + 8 * hi; }
  __device__ __forceinline__ void mask(f32x16& p0, f32x16& p1, int t, int wid, int r32, int hi) const {
    if (t < 4) return;
    const int kr = krlo + t - 4, w0 = clampi(qrow(wid) - 4, 0, 120);
    if (t >= 4 + nloc || kr < w0 || kr > w0 + 7) {
#pragma unroll
      for (int r = 0; r < 16; ++r) { p0[r] = -INFINITY; p1[r] = -INFINITY; }
      return; }
    asm volatile("" : "+v"(r32), "+v"(hi));
    const int qc = 32 * (wid & 1) + r32, c0 = clampi(qc - 8, 0, 48);
    const float* pb = rpbl + (kr - qrow(wid) + 7) * 31 + 15 - qc + 4 * hi;
    const unsigned t0 = (unsigned)(4 * hi - c0);
#define AF_PIN16(a) asm volatile("" : "+v"(a[0]), "+v"(a[1]), "+v"(a[2]), "+v"(a[3]), "+v"(a[4]), "+v"(a[5]), "+v"(a[6]), "+v"(a[7]), "+v"(a[8]), "+v"(a[9]), "+v"(a[10]), "+v"(a[11]), "+v"(a[12]), "+v"(a[13]), "+v"(a[14]), "+v"(a[15]))
    float bv[16];
#pragma unroll
    for (int r = 0; r < 16; ++r) bv[r] = pb[(r & 3) + 8 * (r >> 2)];
    AF_PIN16(bv);
#pragma unroll
    for (int r = 0; r < 16; ++r) { const bool ok = (t0 + (unsigned)((r & 3) + 8 * (r >> 2))) < 16u; p0[r] = ok ? p0[r] + bv[r] : -INFINITY; }
#pragma unroll
    for (int r = 0; r < 16; ++r) bv[r] = pb[32 + (r & 3) + 8 * (r >> 2)];
    AF_PIN16(bv);
#pragma unroll
    for (int r = 0; r < 16; ++r) { const bool ok = (t0 + (unsigned)(32 + (r & 3) + 8 * (r >> 2))) < 16u; p1[r] = ok ? p1[r] + bv[r] : -INFINITY; }
#undef AF_PIN16
  }
  __device__ __forceinline__ float sink(int) const { return -INFINITY; }
  __device__ __forceinline__ bf16* orow0(int wid) const { return O + (long)(8192 * b + 64 * qrow(wid) + 32 * (wid & 1)) * 1024 + 512 + 64 * h; }
};
struct FCtx {
  static constexpr bool HAS_MASK = false; static constexpr int kpitch = 2304, vpitch = 2304;
  const bf16* QKV; const bf16* kbase; const bf16* vbase; const bf16* krbase; bf16* O; const float* sinkp; int b, hx, qcol, ocol; const char* k6base;
  __device__ __forceinline__ void init(const bf16* QKV_, bf16* O_, const float* sk, int b_, int hx_, const char* K6E = nullptr) { QKV = QKV_; O = O_; sinkp = sk; b = b_; hx = hx_; krbase = nullptr; k6base = K6E + (hx_ < 8 ? (hx_ >> 2) : 2 + (hx_ - 8)) * 3072;
    if (hx_ < 8) { qcol = 64 * hx_; kbase = QKV_ + 512 + 64 * (hx_ >> 2); vbase = QKV_ + 640 + 64 * (hx_ >> 2); ocol = 64 * hx_; }
    else { const int h = hx_ - 8; qcol = 768 + 64 * h; kbase = QKV_ + 1280 + 64 * h; vbase = QKV_ + 1792 + 64 * h; ocol = 512 + 64 * h; } }
  __device__ __forceinline__ int nt() const { return 4; }
  __device__ __forceinline__ long trow(int t) const { return (long)(ROWS_LAT + 256 * b + 64 * (t & 3)); }
  __device__ __forceinline__ const bf16* qptr(int wid, int r32, int d0, int hi) const { return QKV + (long)(ROWS_LAT + 256 * b + 32 * wid + r32) * 2304 + qcol + 16 * d0 + 8 * hi; }
  __device__ __forceinline__ void mask(f32x16&, f32x16&, int, int, int, int) const {}
  __device__ __forceinline__ float sink(int) const { return hx < 8 ? sinkp[hx] * LOG2E_ : -INFINITY; }
  __device__ __forceinline__ bf16* orow0(int wid) const { return O + (long)(ROWS_LAT + 256 * b + 32 * wid) * 1024 + ocol; }
};
#undef AF_SBAR
#undef AF_WAIT_BAR
}
constexpr int NWAVES = 8;
#ifndef MK_PER_PHASE
#define MK_PER_PHASE 0
#endif
constexpr int BATCH = 2, SEQ = 8192, DM = 1024, CTXL = 256, FF = 4096;
constexpr int ML = BATCH * SEQ, MC = BATCH * CTXL, MR = ML + MC;
constexpr int NQKV = 2304, NCIN = 768, NUQ = 1536, NUKV = 2048;
constexpr float NORM_EPS = 1e-6f;
constexpr int ADA_KS = 16;
constexpr size_t MiB = 1u << 20;
constexpr size_t WS_CTL = 0, CTL_ZERO_BYTES = 64 * 1024;
constexpr size_t WS_MODP = 1 * MiB;
constexpr size_t WS_MOD = 3 * MiB + 512 * 1024;
constexpr size_t WS_ROPE = 3 * MiB + 768 * 1024;
constexpr size_t WS_ROPEP = WS_ROPE + 64 * 1024;
constexpr size_t WS_HPAR = WS_ROPE + 32 * 1024;
constexpr size_t WS_CTXRES = 4 * MiB;
constexpr size_t WS_WQKV = 6 * MiB, WS_WO0 = WS_WQKV + 4608 * 1024, WS_W1_0 = WS_WO0 + 2 * MiB, WS_W2_0 = WS_W1_0 + 8 * MiB, WS_W1_1 = WS_W2_0 + 8 * MiB, WS_W2_1 = WS_W1_1 + 8 * MiB;
constexpr size_t WS_WIN = WS_W2_1 + 8 * MiB, WS_WUQ = WS_WIN + 1536 * 1024, WS_WUKV = WS_WUQ + 1152 * 1024, WS_WO1 = WS_WUKV + 1 * MiB, WS_WEND = WS_WO1 + 2 * MiB;
constexpr size_t WS_AR = 51 * MiB;
static_assert(WS_WEND <= WS_AR, "weights overlap the arena");
constexpr size_t WS_XN = WS_AR, WS_H = WS_AR + 33 * MiB;
constexpr size_t WS_QKV = WS_AR + 33 * MiB, WS_O0 = WS_AR + 108 * MiB;
constexpr size_t WS_CQKV = WS_AR + 33 * MiB, WS_CQN = WS_AR + 58 * MiB, WS_CKVN = WS_AR + 71 * MiB, WS_KR = WS_AR + 80 * MiB, WS_Q1 = WS_AR + 82 * MiB, WS_KV1 = WS_AR + 130 * MiB, WS_O1 = WS_AR;
constexpr size_t WS_K6E = WS_AR + 150 * MiB;
constexpr size_t WS_K6N = WS_AR + 34 * MiB, WS_K6R = WS_AR + 48 * MiB;
constexpr size_t WS_PART5 = WS_AR + 33 * MiB;
constexpr size_t WS_XR = WS_AR + 166 * MiB;
constexpr size_t WS_PART8 = WS_AR + 166 * MiB;
constexpr size_t WS_END = 256 * MiB;
static_assert(WS_PART8 + (size_t)16 * 512 * 1024 * 4 <= WS_END && WS_KV1 + (size_t)MR * NUKV * 2 <= WS_END && WS_H + (size_t)MR * FF * 2 <= WS_END, "d_ws map");
constexpr int CW_BAR = 4096;
constexpr int RING_OFF = 0, RING_BYTES = 131072;
constexpr int LDSCTL_OFF = RING_BYTES, MISC_OFF = LDSCTL_OFF + 320;
constexpr int LDS_BYTES = 147456;
static_assert(att::L_END <= RING_BYTES && attf::LDS_BYTES <= RING_BYTES, "attention LDS");

#define GAS __attribute__((address_space(1)))
#define LAS __attribute__((address_space(3)))
typedef unsigned short bf16;
typedef unsigned v4u __attribute__((ext_vector_type(4)));
typedef unsigned v2u __attribute__((ext_vector_type(2)));
typedef float f32x4 __attribute__((ext_vector_type(4)));
typedef GAS unsigned gu32;
#define RLX_AGENT __ATOMIC_RELAXED, __HIP_MEMORY_SCOPE_AGENT
#define LDS_WAIT() asm volatile("s_waitcnt lgkmcnt(0)" ::: "memory")
#define VM_WAIT() asm volatile("s_waitcnt vmcnt(0)" ::: "memory")
__device__ __forceinline__ unsigned f2bf(float f) { unsigned u = __builtin_bit_cast(unsigned, f); return (u + 0x7fffu + ((u >> 16) & 1u)) >> 16; }
__device__ __forceinline__ unsigned pk2(float lo, float hi) { return f2bf(lo) | (f2bf(hi) << 16); }
__device__ __forceinline__ float bf2f(unsigned short h) { return __builtin_bit_cast(float, (unsigned)h << 16); }
__device__ __forceinline__ float bflo(unsigned w) { return __builtin_bit_cast(float, w << 16); }
__device__ __forceinline__ float bfhi(unsigned w) { return __builtin_bit_cast(float, w & 0xffff0000u); }

#define XB_TMO      128
#define XB_XCNT(j)  (256  + 64 * (j))
#define XB_XSUB(j)  (1280 + 64 * (j))
#define XB_XGEN(j)  (2304 + 64 * (j))
#define XB_TOP      3328
#define XB_TOPGEN   3392
#define XCD_BAR_WORDS 3456
#define XB_SPIN_CAP (1u << 18)

__device__ __forceinline__ unsigned xb_ld(unsigned* p)              { return __hip_atomic_load(p, __ATOMIC_RELAXED, __HIP_MEMORY_SCOPE_AGENT); }
__device__ __forceinline__ unsigned xb_add(unsigned* p, unsigned v) { return __hip_atomic_fetch_add(p, v, __ATOMIC_RELAXED, __HIP_MEMORY_SCOPE_AGENT); }
__device__ __forceinline__ unsigned xb_xcc_id() { return (unsigned)__builtin_amdgcn_s_getreg((3 << 11) | 20) & 0xFu; }
#define XB_SPIN(cond, bar) do { unsigned _sp = 0; while (cond) { __builtin_amdgcn_s_sleep(1); \
    if ((++_sp & 255u) == 0u) { if (xb_ld(&(bar)[XB_TMO])) break; if (_sp > XB_SPIN_CAP) { atomicAdd(&(bar)[XB_TMO], 1u); break; } } } } while (0)

struct XcdBarrier {
    unsigned* bar; unsigned x;
    volatile LAS unsigned* st;
};

__device__ __forceinline__ XcdBarrier xcd_barrier_post(unsigned* bar, volatile LAS unsigned* st) {
    XcdBarrier b; b.bar = bar; b.x = xb_xcc_id(); b.st = st;
    if (threadIdx.x == 0) (void)xb_add(&bar[XB_XCNT(b.x)], 1u);
    return b;
}
__device__ __forceinline__ void xcd_barrier_complete(unsigned* bar, unsigned x, unsigned& nloc, unsigned& nx) {
    const unsigned G = gridDim.x * gridDim.y * gridDim.z;
    unsigned sum, cnt, mine, sp = 0u;
    for (;;) {
        sum = 0u; cnt = 0u; mine = 0u;
#pragma unroll
        for (unsigned j = 0; j < 16; ++j) { const unsigned c = xb_ld(&bar[XB_XCNT(j)]); sum += c; cnt += (c > 0u) ? 1u : 0u; mine = (j == x) ? c : mine; }
        if (sum == G) break;
        __builtin_amdgcn_s_sleep(1);
        if ((++sp & 255u) == 0u) { if (xb_ld(&bar[XB_TMO])) break; if (sp > XB_SPIN_CAP) { atomicAdd(&bar[XB_TMO], 1u); break; } }
    }
    nloc = mine > 0u ? mine : 1u; nx = cnt > 0u ? cnt : 1u;
}

__device__ __forceinline__ void xcd_barrier(const XcdBarrier& b) {
    asm volatile("s_waitcnt vmcnt(0)" ::: "memory");
    __syncthreads();
    if (threadIdx.x == 0) {
        unsigned* bar = b.bar;
        __builtin_amdgcn_s_waitcnt(0);
        unsigned nloc = b.st[0], nx = b.st[1];
        if (nloc == 0u) { xcd_barrier_complete(bar, b.x, nloc, nx); b.st[0] = nloc; b.st[1] = nx; }
        const unsigned old = xb_add(&bar[XB_XSUB(b.x)], 1u);
        const unsigned gen = old / nloc;
        if (old + 1u == (gen + 1u) * nloc) {
            __builtin_amdgcn_fence(__ATOMIC_RELEASE, "agent");
            asm volatile("s_waitcnt vmcnt(0)" ::: "memory");
            const unsigned og = xb_add(&bar[XB_TOP], 1u);
            const unsigned tg = og / nx;
            if (og + 1u == (tg + 1u) * nx) xb_add(&bar[XB_TOPGEN], 1u);
            else XB_SPIN(xb_ld(&bar[XB_TOPGEN]) == tg, bar);
            __builtin_amdgcn_fence(__ATOMIC_ACQUIRE, "agent");
            xb_add(&bar[XB_XGEN(b.x)], 1u);
            asm volatile("s_waitcnt vmcnt(0)" ::: "memory");
        } else {
            XB_SPIN(xb_ld(&bar[XB_XGEN(b.x)]) == gen, bar);
            __builtin_amdgcn_fence(__ATOMIC_ACQUIRE, "agent");
            asm volatile("s_waitcnt vmcnt(0)" ::: "memory");
        }
    }
    __syncthreads();
}


template <int K> __device__ __forceinline__ const float* ldarg() {
    auto ka = __builtin_amdgcn_kernarg_segment_ptr();
    const __attribute__((address_space(1))) float* p; asm volatile("s_load_dwordx2 %0, %1, %2\n\ts_waitcnt lgkmcnt(0)" : "=s"(p) : "s"(ka), "i"(K * 8) : "memory"); return (const float*)p;
}
#define ARG(k) (ldarg<k>())
#define ARG_OUT ((float*)ldarg<28>())
#define ARG_WS ((unsigned char*)ldarg<29>())
struct Frame {
    LAS unsigned char* lds;
    volatile LAS unsigned* MISC;
    gu32* ctl;
    int tid, lane, wave;
    int vcu, G, bx;
    float* out; unsigned char* ws;
};
__device__ __forceinline__ float shx(float v, int mask, int lane) { return __builtin_bit_cast(float, __builtin_amdgcn_ds_bpermute((lane ^ mask) << 2, __builtin_bit_cast(int, v))); }
__device__ __forceinline__ float wave_sum(float v, int lane) {
#pragma unroll
    for (int o = 1; o < 64; o <<= 1) v += shx(v, o, lane);
    return v;
}
__device__ __forceinline__ unsigned pk4f8(float a, float b, float c, float d) { int w = 0; w = __builtin_amdgcn_cvt_pk_fp8_f32(a, b, w, false); w = __builtin_amdgcn_cvt_pk_fp8_f32(c, d, w, true); return (unsigned)w; }
__device__ __forceinline__ void p0_transpose_item(const float* W, int K, int N, bf16* WT, int pmode, LAS float* scr, int item, int lane, bool f8 = false) {
    const int nblk = N / 32, kb = item / nblk, nb = item % nblk, k0 = 64 * kb, n0 = 32 * nb;
    int r0 = n0;
    if (pmode == 1) { const int h = n0 / 96, d = n0 % 96; r0 = d < 64 ? h * 64 + d : 1024 + h * 32 + (d - 64); }
    else if (pmode == 2) { const int h = n0 / 128, d = n0 % 128; r0 = d < 64 ? h * 64 + d : 1024 + h * 64 + (d - 64); }
#pragma unroll 8
    for (int i = 0; i < 32; ++i) { const int kk = 2 * i + (lane >> 5); scr[kk * 33 + (lane & 31)] = W[(size_t)(k0 + kk) * N + n0 + (lane & 31)]; }
    LDS_WAIT(); asm volatile("" ::: "memory");
    const int c = lane & 7;
#pragma unroll
    for (int j = 0; j < 4; ++j) { const int n = (lane >> 3) + 8 * j; const LAS float* s = scr + (8 * c) * 33 + n;
        if (f8) {
            v2u o; o.x = pk4f8(s[0 * 33] * 32.f, s[1 * 33] * 32.f, s[2 * 33] * 32.f, s[3 * 33] * 32.f); o.y = pk4f8(s[4 * 33] * 32.f, s[5 * 33] * 32.f, s[6 * 33] * 32.f, s[7 * 33] * 32.f);
            *(GAS v2u*)((unsigned char*)WT + (size_t)(r0 + n) * K + k0 + 8 * c) = o; continue; }
        v4u o; o.x = pk2(s[0 * 33], s[1 * 33]); o.y = pk2(s[2 * 33], s[3 * 33]); o.z = pk2(s[4 * 33], s[5 * 33]); o.w = pk2(s[6 * 33], s[7 * 33]);
        *(GAS v4u*)(WT + (size_t)(r0 + n) * K + k0 + 8 * c) = o; }
    LDS_WAIT(); asm volatile("" ::: "memory");
}
__device__ __forceinline__ float silu_f(float v) { return v / (1.f + __expf(-v)); }

__device__ __forceinline__ void p0_prologue(Frame& F) {
    LAS float* scr = (LAS float*)(F.lds + RING_OFF + F.wave * 16384);
    const float* c = ARG(1); const float* cctx = ARG(3);
    if (F.wave >= 5) {
        for (int it = F.vcu * 3 + (F.wave - 5); it < 2 * 24 * ADA_KS; it += F.G * 3) {
            const int l = it / (24 * ADA_KS), rem = it % (24 * ADA_KS), cg = rem / ADA_KS, ks = rem % ADA_KS;
            const float* W = ARG(4) + (size_t)l * DM * 6144 + cg * 256 + 4 * F.lane;
            f32x4 a0 = {0.f, 0.f, 0.f, 0.f}, a1 = a0, a2 = a0;
            const int kbeg = ks * (DM / ADA_KS);
#pragma unroll 8
            for (int k = kbeg; k < kbeg + DM / ADA_KS; ++k) {
                const f32x4 w = *(const GAS f32x4*)(W + (size_t)k * 6144);
                const float s0 = silu_f(c[k]), s1 = silu_f(c[DM + k]), s2 = silu_f(cctx[k]);
                a0 += w * s0; a1 += w * s1; a2 += w * s2;
            }
            float* P = (float*)(F.ws + WS_MODP) + ((size_t)(ks * 2 + l) * 3) * 6144 + cg * 256 + 4 * F.lane;
            *(GAS f32x4*)(P) = a0; *(GAS f32x4*)(P + 6144) = a1; *(GAS f32x4*)(P + 2 * 6144) = a2;
        }
    } else {
        const int gw = F.vcu * 5 + F.wave, NGW = F.G * 5;
        constexpr int I_QKV = 16 * 72, I_O = 16 * 32, I_1 = 16 * 128, I_2 = 64 * 32, I_IN = 16 * 21, I_UQ = 6 * 48, I_UKV = 4 * 64;
        constexpr int NITEMS = I_QKV + I_O + 2 * I_1 + 2 * I_2 + I_IN + I_UQ + I_UKV + I_O;
        for (int it = gw; it < NITEMS; it += NGW) {
            int r = it;
            if (r < I_QKV) { p0_transpose_item(ARG(10), DM, NQKV, (bf16*)(F.ws + WS_WQKV), 0, scr, r, F.lane, true); continue; } r -= I_QKV;
            if (r < I_O) { p0_transpose_item(ARG(11), DM, DM, (bf16*)(F.ws + WS_WO0), 0, scr, r, F.lane); continue; } r -= I_O;
            if (r < I_1) { p0_transpose_item(ARG(8), DM, FF, (bf16*)(F.ws + WS_W1_0), 0, scr, r, F.lane); continue; } r -= I_1;
            if (r < I_1) { p0_transpose_item(ARG(8) + (size_t)DM * FF, DM, FF, (bf16*)(F.ws + WS_W1_1), 0, scr, r, F.lane); continue; } r -= I_1;
            if (r < I_2) { p0_transpose_item(ARG(9), FF, DM, (bf16*)(F.ws + WS_W2_0), 0, scr, r, F.lane); continue; } r -= I_2;
            if (r < I_2) { p0_transpose_item(ARG(9) + (size_t)DM * FF, FF, DM, (bf16*)(F.ws + WS_W2_1), 0, scr, r, F.lane); continue; } r -= I_2;
            if (r < I_IN) { p0_transpose_item(ARG(18), DM, 672, (bf16*)(F.ws + WS_WIN), 0, scr, r, F.lane); continue; } r -= I_IN;
            if (r < I_UQ) { p0_transpose_item(ARG(21), 384, NUQ, (bf16*)(F.ws + WS_WUQ), 1, scr, r, F.lane); continue; } r -= I_UQ;
            if (r < I_UKV) { p0_transpose_item(ARG(22), 256, NUKV, (bf16*)(F.ws + WS_WUKV), 2, scr, r, F.lane); continue; } r -= I_UKV;
            p0_transpose_item(ARG(27), DM, DM, (bf16*)(F.ws + WS_WO1), 0, scr, r, F.lane);
        }
    }
    if (F.bx == 1 % F.G) {
        float* rt = (float*)(F.ws + WS_ROPE);
        for (int e = F.tid; e < 128 * 16; e += NWAVES * 64) { const int pos = e >> 4, i = e & 15; const float inv = exp2f(-(float)i * (13.287712379549449f / 16.f));
            float x = (float)pos * inv * 0.15915494309189535f; x -= rintf(x); const float c_ = __builtin_amdgcn_cosf(x), s_ = __builtin_amdgcn_sinf(x); rt[e] = c_; rt[2048 + e] = s_; ((unsigned*)(F.ws + WS_ROPEP))[e] = pk2(c_, s_); }
        for (int e = F.tid; e < 128 * 8; e += NWAVES * 64) { const int pos = e >> 3, i = e & 7; const float inv = exp2f(-(float)i * (13.287712379549449f / 8.f));
            float x = (float)pos * inv * 0.15915494309189535f; x -= rintf(x); const float c_ = __builtin_amdgcn_cosf(x), s_ = __builtin_amdgcn_sinf(x); rt[4096 + e] = c_; rt[5120 + e] = s_; ((unsigned*)(F.ws + WS_ROPEP))[2048 + e] = pk2(c_, s_); }
    }
    if (F.bx == 3 % F.G && F.tid < 64) {
        float* hp = (float*)(F.ws + WS_HPAR); const int i = F.tid;
        hp[i] = ARG(12)[i]; hp[64 + i] = ARG(13)[i]; hp[128 + i] = ARG(15)[i]; hp[192 + i] = ARG(16)[i]; hp[256 + i] = ARG(23)[i]; hp[320 + i] = ARG(24)[i & 31]; hp[384 + i] = ARG(25)[i];
        float a = fabsf(ARG(23)[i]), b_ = fabsf(ARG(25)[i]), c_ = fabsf(ARG(24)[i & 31]), d_ = fabsf(ARG(26)[i & 31]);
#pragma unroll
        for (int o_ = 1; o_ < 64; o_ <<= 1) { a = fmaxf(a, shx(a, o_, i)); b_ = fmaxf(b_, shx(b_, o_, i)); c_ = fmaxf(c_, shx(c_, o_, i)); d_ = fmaxf(d_, shx(d_, o_, i)); }
        const float bound = (64.f * a * b_ + 32.f * c_ * d_) * (0.10206207261596575f * 1.4426950408889634f);
        if (i == 0) hp[448] = (bound < 64.f && fmaxf(fmaxf(a, b_), fmaxf(c_, d_)) < 3.f) ? 1.f : 0.f;
        { float a2 = fabsf(ARG(12)[i]), b2 = fabsf(ARG(13)[i]), c2 = fabsf(ARG(15)[i]), d2 = fabsf(ARG(16)[i]), e2 = 0.f, f2 = fabsf(ARG(14)[i & 7]);
          for (int j = i; j < 8 * 465; j += 64) e2 = fmaxf(e2, fabsf(ARG(17)[j]));
#pragma unroll
          for (int o_ = 1; o_ < 64; o_ <<= 1) { a2 = fmaxf(a2, shx(a2, o_, i)); b2 = fmaxf(b2, shx(b2, o_, i)); c2 = fmaxf(c2, shx(c2, o_, i)); d2 = fmaxf(d2, shx(d2, o_, i)); e2 = fmaxf(e2, shx(e2, o_, i)); f2 = fmaxf(f2, shx(f2, o_, i)); }
          const float bound0 = fmaxf(fmaxf(8.f * a2 * b2, 8.f * c2 * d2 + e2), f2) * 1.4426950408889634f;
          if (i == 0) hp[449] = (bound0 < 64.f && fmaxf(fmaxf(a2, b2), fmaxf(c2, d2)) < 3.f) ? 1.f : 0.f; }
    }
    if (F.bx == 2 % F.G) {
        GAS v4u* z = (GAS v4u*)((bf16*)(F.ws + WS_WIN) + (size_t)672 * DM);
        unsigned zz = 0u; asm volatile("" : "+v"(zz));
        for (int e = F.tid; e < 96 * DM / 8; e += NWAVES * 64) z[e] = (v4u){zz, zz, zz, zz};
    }
}

__device__ __forceinline__ void norm_phase(Frame& F, const float* src_lat, const float* src_ctx, int nrows, const float* gw_, int layer, int which  , bool from_partials, const float* parts = nullptr, int nparts = 0, bool lat_bf16 = false, bool xn_fp8 = false) {
    LAS float* gl = (LAS float*)(F.lds + RING_OFF); LAS float* scl = gl + 1024; LAS float* shl = scl + 3 * 1024;
    const float* modp = (const float*)(F.ws + WS_MODP); const float* mod = (const float*)(F.ws + WS_MOD); const float* ada_b = ARG(5);
    const int offsh = which * 3072, offsc = which * 3072 + 1024;
    for (int i = F.tid; i < 1024; i += NWAVES * 64) {
        gl[i] = gw_[i];
#pragma unroll
        for (int cnd = 0; cnd < 3; ++cnd) {
            float sh, sc;
            if (from_partials) { sh = ada_b[layer * 6144 + offsh + i]; sc = ada_b[layer * 6144 + offsc + i];
                float ph[ADA_KS], pc[ADA_KS];
#pragma unroll
                for (int ks = 0; ks < ADA_KS; ++ks) { const float* p = modp + ((size_t)(ks * 2 + layer) * 3 + cnd) * 6144; ph[ks] = p[offsh + i]; pc[ks] = p[offsc + i]; }
#pragma unroll
                for (int ks = 0; ks < ADA_KS; ++ks) { sh += ph[ks]; sc += pc[ks]; } }
            else { sh = mod[(layer * 3 + cnd) * 6144 + offsh + i]; sc = mod[(layer * 3 + cnd) * 6144 + offsc + i]; }
            scl[cnd * 1024 + i] = 1.f + sc; shl[cnd * 1024 + i] = sh;
        }
    }
    if (from_partials) {
        float* modw = (float*)(F.ws + WS_MOD);
        for (int e = F.vcu * (NWAVES * 64) + F.tid; e < 2 * 3 * 6144; e += F.G * NWAVES * 64) {
            const int l = e / (3 * 6144), rem = e % (3 * 6144), cnd = rem / 6144, col = rem % 6144;
            float v = ada_b[l * 6144 + col];
            float pv[ADA_KS];
#pragma unroll
            for (int ks = 0; ks < ADA_KS; ++ks) pv[ks] = modp[((size_t)(ks * 2 + l) * 3 + cnd) * 6144 + col];
#pragma unroll
            for (int ks = 0; ks < ADA_KS; ++ks) v += pv[ks];
            modw[e] = v;
        }
    }
    __syncthreads();
    bf16* XN = (bf16*)(F.ws + WS_XN);
    const int gw = F.vcu * NWAVES + F.wave, NGW = F.G * NWAVES;
    for (int m = gw; m < nrows; m += NGW) {
        const float* xrow = m < ML ? src_lat + (size_t)m * DM : src_ctx + (size_t)(m - ML) * DM;
        const int cnd = m < SEQ ? 0 : (m < ML ? 1 : 2);
        const GAS f32x4* xr = (const GAS f32x4*)xrow + F.lane;
        f32x4 v[4]; float s = 0.f;
        if (lat_bf16 && m < ML) {
            const GAS v2u* xb = (const GAS v2u*)((const bf16*)src_lat + (size_t)m * DM) + F.lane;
            v2u w[4];
#pragma unroll
            for (int j = 0; j < 4; ++j) w[j] = xb[64 * j];
#pragma unroll
            for (int j = 0; j < 4; ++j) v[j] = f32x4{bflo(w[j].x), bfhi(w[j].x), bflo(w[j].y), bfhi(w[j].y)};
        } else {
#pragma unroll
            for (int j = 0; j < 4; ++j) v[j] = xr[64 * j];
        }
        if (nparts > 0 && m >= ML) {
            for (int p = 0; p < nparts; p += 4) {
                const GAS f32x4* pr = (const GAS f32x4*)(parts + (size_t)p * (512 * 1024) + (size_t)(m - ML) * DM) + F.lane;
                f32x4 w[4][4];
#pragma unroll
                for (int q = 0; q < 4; ++q)
#pragma unroll
                    for (int j = 0; j < 4; ++j) w[q][j] = pr[(size_t)q * (512 * 1024 / 4) + 64 * j];
#pragma unroll
                for (int j = 0; j < 4; ++j) v[j] += (w[0][j] + w[1][j]) + (w[2][j] + w[3][j]); }
            GAS f32x4* cr = (GAS f32x4*)((float*)(F.ws + WS_CTXRES) + (size_t)(m - ML) * DM) + F.lane;
#pragma unroll
            for (int j = 0; j < 4; ++j) cr[64 * j] = v[j];
        }
#pragma unroll
        for (int j = 0; j < 4; ++j) s += (v[j].x * v[j].x + v[j].y * v[j].y) + (v[j].z * v[j].z + v[j].w * v[j].w);
        const float rstd = 1.f / sqrtf(wave_sum(s, F.lane) * (1.f / DM) + NORM_EPS);
        if (from_partials && m >= ML) { GAS f32x4* cr = (GAS f32x4*)((float*)(F.ws + WS_CTXRES) + (size_t)(m - ML) * DM) + F.lane;
#pragma unroll
            for (int j = 0; j < 4; ++j) cr[64 * j] = v[j]; }
        GAS v2u* o8 = (GAS v2u*)(XN + (size_t)m * DM) + F.lane;
        GAS unsigned* o4 = (GAS unsigned*)((unsigned char*)XN + (size_t)m * DM) + F.lane;
#pragma unroll
        for (int j = 0; j < 4; ++j) { const int col = 4 * F.lane + 256 * j;
            const f32x4 g = *(const LAS f32x4*)(gl + col), sc = *(const LAS f32x4*)(scl + cnd * 1024 + col), sh = *(const LAS f32x4*)(shl + cnd * 1024 + col);
            const f32x4 y = (v[j] * rstd) * g * sc + sh;
            if (xn_fp8) o4[64 * j] = pk4f8(y.x, y.y, y.z, y.w);
            else { v2u w; w.x = pk2(y.x, y.y); w.y = pk2(y.z, y.w); o8[64 * j] = w; } }
    }
    __syncthreads();
}

__device__ __forceinline__ void unpack8(const v4u w, float (&x)[8]) { x[0] = bflo(w.x); x[1] = bfhi(w.x); x[2] = bflo(w.y); x[3] = bfhi(w.y); x[4] = bflo(w.z); x[5] = bfhi(w.z); x[6] = bflo(w.w); x[7] = bfhi(w.w); }
__device__ __forceinline__ v4u pack8(const float (&x)[8]) { v4u w; w.x = pk2(x[0], x[1]); w.y = pk2(x[2], x[3]); w.z = pk2(x[4], x[5]); w.w = pk2(x[6], x[7]); return w; }

__device__ __forceinline__ void qknorm_phase(Frame& F) {
    bf16* QKV = (bf16*)(F.ws + WS_QKV);
    const float* rt = (const float*)(F.ws + WS_ROPE);
    const float* nw[4] = {ARG(12), ARG(13), ARG(15), ARG(16)};
    const float qscale = 0.125f * att::LOG2E;
    const int gw = F.vcu * NWAVES + F.wave, NGW = F.G * NWAVES;
    const int lane = F.lane, grp = lane >> 3, l8 = lane & 7;
    for (int m = gw; m < MR; m += NGW) {
        const bool lat = m < ML; const int t = m & (SEQ - 1); const int prow = t >> 6, pcol = t & 63;
        GAS v4u* rowp = (GAS v4u*)(QKV + (size_t)m * NQKV);
#pragma unroll
        for (int pass = 0; pass < 4; ++pass) {
            int type;
            if (pass == 0) type = 1; else if (pass == 1) type = grp < 2 ? 2 : (grp < 4 ? 0 : 3); else if (pass == 2) type = grp < 4 ? 3 : 4; else type = grp < 4 ? 4 : 0;
            const v4u w = rowp[pass * 64 + lane];
            float x[8]; unpack8(w, x);
            float ss = 0.f;
#pragma unroll
            for (int j = 0; j < 8; ++j) ss += x[j] * x[j];
            ss += shx(ss, 1, F.lane); ss += shx(ss, 2, F.lane); ss += shx(ss, 4, F.lane);
            const float rstd = 1.f / sqrtf(ss * (1.f / 64.f) + NORM_EPS);
            const float* g = type == 1 ? nw[0] : (type == 2 ? nw[1] : (type == 3 ? nw[2] : nw[3]));
            const f32x4 g0 = *(const GAS f32x4*)(g + l8 * 8), g1 = *(const GAS f32x4*)(g + l8 * 8 + 4);
            x[0] *= rstd * g0.x; x[1] *= rstd * g0.y; x[2] *= rstd * g0.z; x[3] *= rstd * g0.w; x[4] *= rstd * g1.x; x[5] *= rstd * g1.y; x[6] *= rstd * g1.z; x[7] *= rstd * g1.w;
            float px[8];
#pragma unroll
            for (int j = 0; j < 8; ++j) px[j] = shx(x[j], 2, F.lane);
            if (lat && (type == 1 || type == 2)) {
                const int pos = (l8 & 4) ? pcol : prow; const float* cs = rt + pos * 16 + (l8 & 1) * 8;
                const f32x4 c0 = *(const GAS f32x4*)(cs), c1 = *(const GAS f32x4*)(cs + 4), s0 = *(const GAS f32x4*)(cs + 2048), s1 = *(const GAS f32x4*)(cs + 2052);
                const float cc[8] = {c0.x, c0.y, c0.z, c0.w, c1.x, c1.y, c1.z, c1.w}, sn[8] = {s0.x, s0.y, s0.z, s0.w, s1.x, s1.y, s1.z, s1.w};
                const float sgn = (l8 & 2) ? 1.f : -1.f;
#pragma unroll
                for (int j = 0; j < 8; ++j) x[j] = x[j] * cc[j] + sgn * px[j] * sn[j];
            }
            if (type == 1 || type == 3) {
#pragma unroll
                for (int j = 0; j < 8; ++j) x[j] *= qscale;
            }
            if (type != 0) rowp[pass * 64 + lane] = pack8(x);
        }
    }
}

__device__ __forceinline__ void cnorm_phase(Frame& F) {
    const bf16* CQKV = (const bf16*)(F.ws + WS_CQKV); bf16* CQN = (bf16*)(F.ws + WS_CQN); bf16* CKVN = (bf16*)(F.ws + WS_CKVN); bf16* KR = (bf16*)(F.ws + WS_KR);
    const float* rt = (const float*)(F.ws + WS_ROPE) + 4096;
    const float* gq = ARG(19); const float* gkv = ARG(20); const float* gkr = ARG(26);
    const int gw = F.vcu * NWAVES + F.wave, NGW = F.G * NWAVES; const int lane = F.lane;
    for (int m = gw; m < MR; m += NGW) {
        const bool lat = m < ML; const int t = m & (SEQ - 1); const int prow = t >> 6, pcol = t & 63;
        const GAS v4u* rowp = (const GAS v4u*)(CQKV + (size_t)m * NCIN);
        const v4u w0 = rowp[lane]; v4u w1 = {0u, 0u, 0u, 0u}; if (lane < 32) w1 = rowp[64 + lane];
        float x0[8], x1[8]; unpack8(w0, x0); unpack8(w1, x1);
        float s0 = 0.f, s1 = 0.f;
#pragma unroll
        for (int j = 0; j < 8; ++j) { s0 += x0[j] * x0[j]; s1 += x1[j] * x1[j]; }
        const float ssq = wave_sum(lane < 48 ? s0 : 0.f, F.lane);
        const float sskv = wave_sum((lane >= 48 ? s0 : 0.f) + (lane < 16 ? s1 : 0.f), F.lane);
        const float sskr = wave_sum((lane >= 16 && lane < 20) ? s1 : 0.f, F.lane);
        const float rq = 1.f / sqrtf(ssq * (1.f / 384.f) + NORM_EPS), rkv = 1.f / sqrtf(sskv * (1.f / 256.f) + NORM_EPS), rkr = 1.f / sqrtf(sskr * (1.f / 32.f) + NORM_EPS);
        { const float* g = lane < 48 ? gq + lane * 8 : gkv + (lane - 48) * 8; const float r = lane < 48 ? rq : rkv;
          const f32x4 g0 = *(const GAS f32x4*)(g), g1 = *(const GAS f32x4*)(g + 4);
          float y[8] = {x0[0] * r * g0.x, x0[1] * r * g0.y, x0[2] * r * g0.z, x0[3] * r * g0.w, x0[4] * r * g1.x, x0[5] * r * g1.y, x0[6] * r * g1.z, x0[7] * r * g1.w};
          if (lane < 48) *(GAS v4u*)(CQN + (size_t)m * 384 + lane * 8) = pack8(y); else *(GAS v4u*)(CKVN + (size_t)m * 256 + (lane - 48) * 8) = pack8(y); }
        { const int li = lane < 16 ? lane : (lane < 20 ? lane - 16 : 0);
          const float* g = lane < 16 ? gkv + 128 + li * 8 : gkr + li * 8; const float r = lane < 16 ? rkv : rkr;
          const f32x4 g0 = *(const GAS f32x4*)(g), g1 = *(const GAS f32x4*)(g + 4);
          float y[8] = {x1[0] * r * g0.x, x1[1] * r * g0.y, x1[2] * r * g0.z, x1[3] * r * g0.w, x1[4] * r * g1.x, x1[5] * r * g1.y, x1[6] * r * g1.z, x1[7] * r * g1.w};
          float py[8];
#pragma unroll
          for (int j = 0; j < 8; ++j) py[j] = shx(y[j], 1, F.lane);
          if (lat && lane >= 16 && lane < 20) {
              const int pos = (lane & 2) ? pcol : prow; const float* cs = rt + pos * 8;
              const f32x4 c0 = *(const GAS f32x4*)(cs), c1 = *(const GAS f32x4*)(cs + 4), sa = *(const GAS f32x4*)(cs + 1024), sb = *(const GAS f32x4*)(cs + 1028);
              const float cc[8] = {c0.x, c0.y, c0.z, c0.w, c1.x, c1.y, c1.z, c1.w}, sn[8] = {sa.x, sa.y, sa.z, sa.w, sb.x, sb.y, sb.z, sb.w};
              const float sgn = (lane & 1) ? 1.f : -1.f;
#pragma unroll
              for (int j = 0; j < 8; ++j) y[j] = y[j] * cc[j] + sgn * py[j] * sn[j];
          }
          if (lane < 16) *(GAS v4u*)(CKVN + (size_t)m * 256 + 128 + lane * 8) = pack8(y);
          else if (lane < 20) *(GAS v4u*)(KR + (size_t)m * 32 + (lane - 16) * 8) = pack8(y); }
    }
}

__device__ __forceinline__ void hnorm_phase(Frame& F) {
    bf16* Q = (bf16*)(F.ws + WS_Q1); bf16* KV = (bf16*)(F.ws + WS_KV1);
    const float* rt = (const float*)(F.ws + WS_ROPE) + 4096;
    const float* gqn = ARG(23); const float* gqr = ARG(24); const float* gkn = ARG(25);
    const float qscale = 0.10206207261596575f * att::LOG2E;
    const int gw = F.vcu * NWAVES + F.wave, NGW = F.G * NWAVES; const int lane = F.lane, l8 = lane & 7, l4 = lane & 3;
    for (int m = gw; m < MR; m += NGW) {
        const bool lat = m < ML; const int t = m & (SEQ - 1); const int prow = t >> 6, pcol = t & 63;
        { GAS v4u* rowp = (GAS v4u*)(KV + (size_t)m * NUKV);
          const f32x4 g0 = *(const GAS f32x4*)(gkn + l8 * 8), g1 = *(const GAS f32x4*)(gkn + l8 * 8 + 4);
#pragma unroll
          for (int pass = 0; pass < 2; ++pass) {
              float x[8]; unpack8(rowp[pass * 64 + lane], x); float ss = 0.f;
#pragma unroll
              for (int j = 0; j < 8; ++j) ss += x[j] * x[j];
              ss += shx(ss, 1, F.lane); ss += shx(ss, 2, F.lane); ss += shx(ss, 4, F.lane);
              const float r = 1.f / sqrtf(ss * (1.f / 64.f) + NORM_EPS);
              x[0] *= r * g0.x; x[1] *= r * g0.y; x[2] *= r * g0.z; x[3] *= r * g0.w; x[4] *= r * g1.x; x[5] *= r * g1.y; x[6] *= r * g1.z; x[7] *= r * g1.w;
              rowp[pass * 64 + lane] = pack8(x); } }
        if (lat) {
            GAS v4u* rowp = (GAS v4u*)(Q + (size_t)m * NUQ);
            { const f32x4 g0 = *(const GAS f32x4*)(gqn + l8 * 8), g1 = *(const GAS f32x4*)(gqn + l8 * 8 + 4);
#pragma unroll
              for (int pass = 0; pass < 2; ++pass) {
                  float x[8]; unpack8(rowp[pass * 64 + lane], x); float ss = 0.f;
#pragma unroll
                  for (int j = 0; j < 8; ++j) ss += x[j] * x[j];
                  ss += shx(ss, 1, F.lane); ss += shx(ss, 2, F.lane); ss += shx(ss, 4, F.lane);
                  const float r = qscale / sqrtf(ss * (1.f / 64.f) + NORM_EPS);
                  x[0] *= r * g0.x; x[1] *= r * g0.y; x[2] *= r * g0.z; x[3] *= r * g0.w; x[4] *= r * g1.x; x[5] *= r * g1.y; x[6] *= r * g1.z; x[7] *= r * g1.w;
                  rowp[pass * 64 + lane] = pack8(x); } }
            {
              const f32x4 g0 = *(const GAS f32x4*)(gqr + l4 * 8), g1 = *(const GAS f32x4*)(gqr + l4 * 8 + 4);
              float x[8]; unpack8(rowp[128 + lane], x); float ss = 0.f;
#pragma unroll
              for (int j = 0; j < 8; ++j) ss += x[j] * x[j];
              ss += shx(ss, 1, F.lane); ss += shx(ss, 2, F.lane);
              const float r = 1.f / sqrtf(ss * (1.f / 32.f) + NORM_EPS);
              x[0] *= r * g0.x; x[1] *= r * g0.y; x[2] *= r * g0.z; x[3] *= r * g0.w; x[4] *= r * g1.x; x[5] *= r * g1.y; x[6] *= r * g1.z; x[7] *= r * g1.w;
              float px[8];
#pragma unroll
              for (int j = 0; j < 8; ++j) px[j] = shx(x[j], 1, F.lane);
              const int pos = (l4 & 2) ? pcol : prow; const float* cs = rt + pos * 8;
              const f32x4 c0 = *(const GAS f32x4*)(cs), c1 = *(const GAS f32x4*)(cs + 4), sa = *(const GAS f32x4*)(cs + 1024), sb = *(const GAS f32x4*)(cs + 1028);
              const float cc[8] = {c0.x, c0.y, c0.z, c0.w, c1.x, c1.y, c1.z, c1.w}, sn[8] = {sa.x, sa.y, sa.z, sa.w, sb.x, sb.y, sb.z, sb.w};
              const float sgn = (l4 & 1) ? 1.f : -1.f;
#pragma unroll
              for (int j = 0; j < 8; ++j) x[j] = (x[j] * cc[j] + sgn * px[j] * sn[j]) * qscale;
              rowp[128 + lane] = pack8(x); }
        }
    }
}

__device__ __forceinline__ void kr6_pass(Frame& F) {
    if (((const float*)(F.ws + WS_HPAR))[448] == 0.f) return;
    const bf16* KR = (const bf16*)(F.ws + WS_KR); unsigned char* K6R = (unsigned char*)(F.ws + WS_K6R);
    for (int r = F.vcu * (NWAVES * 64) + F.tid; r < MR; r += F.G * (NWAVES * 64)) {
        const GAS v4u* rp = (const GAS v4u*)(KR + (size_t)r * 32);
        v4u w[4] = {rp[0], rp[1], rp[2], rp[3]};
#pragma unroll
        for (int q = 0; q < 4; ++q) { float x[8]; unpack8(w[q], x);
#pragma unroll
            for (int j = 0; j < 8; ++j) x[j] *= 1.5349124f;
            w[q] = pack8(x); }
        const attd::u32x6 c = attd::to_fp6(w[0], w[1], w[2], w[3]);
        unsigned char* img = K6R + (size_t)(r >> 6) * 2048; const int key = r & 63;
        *(GAS v4u*)(img + key * 16) = (v4u){c[0], c[1], c[2], c[3]}; *(GAS v2u*)(img + 1024 + key * 8) = (v2u){c[4], c[5]};
    }
}
__device__ __forceinline__ void attn0_phase(Frame& F) {
    att::lchar* lds = (att::lchar*)(F.lds + RING_OFF);
    const att::bf16* QKV = (const att::bf16*)(F.ws + WS_QKV); att::bf16* O = (att::bf16*)(F.ws + WS_O0);
    const bool fast = __builtin_amdgcn_readfirstlane(__builtin_bit_cast(int, ((const float*)(F.ws + WS_HPAR))[449])) != 0;
    const char* K6E = (const char*)(F.ws + WS_K6E);
    char* shm = (char*)(F.lds + RING_OFF);
    for (int ui = F.vcu; ui < 1056; ui += F.G) {
        if (ui < 512) {
            const int b = ui >> 8, h = (ui >> 5) & 7, R4 = ui & 31;
            const float* rpb = ARG(17) + h * 465;
            if (fast) {
                float* rl = (float*)(shm + attf::LDS_RPB);
                for (int i = F.tid; i < 465; i += NWAVES * 64) rl[i] = rpb[i] * att::LOG2E;
                __syncthreads();
                attf::FNa fu; fu.init((const attf::bf16*)QKV, (attf::bf16*)O, rl, b, h, R4, K6E);
                attf::fast_unit<8, attf::FNa, true>(fu, shm, F.tid);
            } else {
                att::UNa u; u.QKV = QKV; u.O = O; u.rpbl = (const LAS float*)(lds + att::L_RPB); u.b = b; u.h = h; u.R4 = R4; u.init();
                for (int i = F.tid; i < 465; i += NWAVES * 64) ((LAS float*)(lds + att::L_RPB))[i] = rpb[i] * att::LOG2E;
                att::unit<8, att::UNa>(u, lds, F.tid);
            }
        } else if (ui < 1024) {
            const int v = ui - 512;
            if (fast) { attf::FWin fu; fu.init((const attf::bf16*)QKV, (attf::bf16*)O, ARG(14), v >> 8, (v >> 2) & 63, (v >> 1) & 1, v & 1, K6E); attf::fast_unit<8, attf::FWin, true>(fu, shm, F.tid); }
            else { att::UWin u; u.QKV = QKV; u.O = O; u.sinkp = ARG(14); u.b = v >> 8; u.n = (v >> 2) & 63; u.g = (v >> 1) & 1; u.hh = v & 1; u.init(); att::unit<8, att::UWin>(u, lds, F.tid); }
        } else {
            const int v = ui - 1024;
            if (fast) { attf::FCtx fu; fu.init((const attf::bf16*)QKV, (attf::bf16*)O, ARG(14), v >> 4, v & 15, K6E); attf::fast_unit<8, attf::FCtx, true>(fu, shm, F.tid); }
            else { att::UCtx u; u.QKV = QKV; u.O = O; u.sinkp = ARG(14); u.b = v >> 4; u.hx = v & 15; u.init(); att::unit<8, att::UCtx>(u, lds, F.tid); }
        }
    }
}
__device__ __forceinline__ void attn1_phase(Frame& F) {
    att::lchar* lds = (att::lchar*)(F.lds + RING_OFF);
    const bool fast = __builtin_amdgcn_readfirstlane(__builtin_bit_cast(int, ((const float*)(F.ws + WS_HPAR))[448])) != 0;
    const bool g256 = F.G == 256; const int x = F.vcu >> 5, j = F.vcu & 31;
    const int nit = g256 ? 4 : (F.vcu < 1024 ? (1024 - F.vcu + F.G - 1) / F.G : 0);
    for (int i = 0; i < nit; ++i) {
        const int ui = g256 ? ((x * 4 + i) * 32 + j) : F.vcu + i * F.G;
        if (fast) attd::dense_unit(ui >> 9, (ui >> 5) & 15, ui & 31, (const attd::bf16*)(F.ws + WS_Q1), (const attd::bf16*)(F.ws + WS_KV1), (const char*)(F.ws + WS_K6N), (const char*)(F.ws + WS_K6R), (attd::bf16*)(F.ws + WS_O1), (char*)(F.lds + RING_OFF), F.tid);
        else {
        att::UDense u; u.Q = (const att::bf16*)(F.ws + WS_Q1); u.KV = (const att::bf16*)(F.ws + WS_KV1); u.KR = (const att::bf16*)(F.ws + WS_KR); u.O = (att::bf16*)(F.ws + WS_O1);
        u.b = ui >> 9; u.h = (ui >> 5) & 15; u.qb = ui & 31;
        att::unit<12, att::UDense>(u, lds, F.tid); }
    }
}

#ifndef PHASE_MASK
#define PHASE_MASK 0xFFFFFu
#endif
#ifndef PHASE_REP
#define PHASE_REP 0u
#endif
struct Args { const float* in[28]; float* out; unsigned char* ws; int ph_lo, ph_hi; };
constexpr int N_PHASES = 19;
__global__ void __launch_bounds__(NWAVES * 64, 2) fwd_kernel(Args args) {
    extern __shared__ __attribute__((aligned(16))) unsigned char lds[];
    for (int u = threadIdx.x; u < (LDS_BYTES - LDSCTL_OFF) / 4; u += NWAVES * 64) ((LAS unsigned*)((LAS unsigned char*)lds + LDSCTL_OFF))[u] = 0u;
    __syncthreads();
    if (!MK_PER_PHASE) (void)xcd_barrier_post((unsigned*)((gu32*)(ARG_WS + WS_CTL) + CW_BAR), (volatile LAS unsigned*)((LAS unsigned char*)lds + MISC_OFF) + 8);
    const int wv0_ = __builtin_amdgcn_readfirstlane((int)threadIdx.x >> 6);
    for (int ph2 = 2 * args.ph_lo; ph2 < 2 * args.ph_hi; ++ph2) {
        const int ph = ph2 >> 1; if ((ph2 & 1) && !((PHASE_REP >> ph) & 1)) continue;
        if (ph == 3 || ph == 14) continue;
        Frame F;
        { int t_ = wv0_ * 64 + (int)__builtin_amdgcn_mbcnt_hi(~0u, __builtin_amdgcn_mbcnt_lo(~0u, 0u)); asm volatile("" : "+v"(t_)); int b_ = blockIdx.x; asm volatile("" : "+s"(b_)); int g_ = gridDim.x; asm volatile("" : "+s"(g_)); F.tid = t_; F.bx = b_; F.G = g_; }
        F.lds = (LAS unsigned char*)lds; F.MISC = (volatile LAS unsigned*)(F.lds + MISC_OFF);
        F.lane = F.tid & 63; F.wave = __builtin_amdgcn_readfirstlane(F.tid >> 6);
        F.vcu = (F.G % 8 == 0) ? (F.bx % 8) * (F.G / 8) + F.bx / 8 : F.bx;
        F.ws = ARG_WS; F.out = ARG_OUT; F.ctl = (gu32*)(F.ws + WS_CTL);
        XcdBarrier bar; bar.bar = (unsigned*)(F.ctl + CW_BAR); bar.x = xb_xcc_id(); bar.st = F.MISC + 8;
        float* ctxres = (float*)(F.ws + WS_CTXRES);
        const float* mod = (const float*)(F.ws + WS_MOD);
        int gk = 0, xrows = 0, xS = 0;
        pg8::Gemm g{nullptr, nullptr, 0, 0, 0, 0}; pg8::EpiAny ea{0, nullptr, nullptr, nullptr, nullptr, 0, 0};
        switch (ph) {
        case 0: if (!((PHASE_MASK >> 0) & 1)) break; p0_prologue(F); break;
        case 1: if (!((PHASE_MASK >> 1) & 1)) break; norm_phase(F, ARG(0), ARG(2), MR, ARG(6), 0, 0, true, nullptr, 0, false, true); break;
        case 2: if (!((PHASE_MASK >> 2) & 1)) break; gk = 1; g = pg8::Gemm{(const bf16*)(F.ws + WS_XN), (const bf16*)(F.ws + WS_WQKV), MR, NQKV, DM / 2, 1}; ea = pg8::EpiAny{3, (const float*)(F.ws + WS_HPAR), (void*)(F.ws + WS_QKV), (float*)(F.ws + WS_K6E), (const float*)(F.ws + WS_ROPEP), NQKV, 0}; break;
        case 4: if (!((PHASE_MASK >> 4) & 1)) break; attn0_phase(F); break;
        case 5: if (!((PHASE_MASK >> 5) & 1)) break; gk = 2; g = pg8::Gemm{(const bf16*)(F.ws + WS_O0), (const bf16*)(F.ws + WS_WO0), ML, DM, DM}; xrows = MC; xS = 2; ea = pg8::EpiAny{2, ARG(0), (void*)F.out, (float*)(F.ws + WS_PART5), mod + 2048, 0, 2}; break;
        case 6: if (!((PHASE_MASK >> 6) & 1)) break; norm_phase(F, F.out, ctxres, MR, ARG(7), 0, 1, false, (const float*)(F.ws + WS_PART5), 4, true); break;
        case 7: if (!((PHASE_MASK >> 7) & 1)) break; gk = 1; g = pg8::Gemm{(const bf16*)(F.ws + WS_XN), (const bf16*)(F.ws + WS_W1_0), MR, FF, DM}; ea = pg8::EpiAny{1, nullptr, (void*)(F.ws + WS_H), nullptr, nullptr, FF, 1}; break;
        case 8: if (!((PHASE_MASK >> 8) & 1)) break; gk = 2; g = pg8::Gemm{(const bf16*)(F.ws + WS_H), (const bf16*)(F.ws + WS_W2_0), ML, DM, FF}; xrows = MC; xS = 4; ea = pg8::EpiAny{2, F.out, (void*)F.out, (float*)(F.ws + WS_PART8), mod + 5120, 0, 3}; break;
        case 9: if (!((PHASE_MASK >> 9) & 1)) break; norm_phase(F, F.out, ctxres, MR, ARG(6) + DM, 1, 0, false, (const float*)(F.ws + WS_PART8), 16, true); break;
        case 10: if (!((PHASE_MASK >> 10) & 1)) break; gk = 1; g = pg8::Gemm{(const bf16*)(F.ws + WS_XN), (const bf16*)(F.ws + WS_WIN), MR, NCIN, DM}; ea = pg8::EpiAny{1, nullptr, (void*)(F.ws + WS_CQKV), nullptr, nullptr, NCIN, 0}; break;
        case 11: if (!((PHASE_MASK >> 11) & 1)) break; cnorm_phase(F); break;
        case 12: if (!((PHASE_MASK >> 12) & 1)) break; kr6_pass(F); gk = 1; g = pg8::Gemm{(const bf16*)(F.ws + WS_CQN), (const bf16*)(F.ws + WS_WUQ), ML, NUQ, 384}; ea = pg8::EpiAny{3, (const float*)(F.ws + WS_HPAR), (void*)(F.ws + WS_Q1), nullptr, (const float*)(F.ws + WS_ROPEP), NUQ, 1}; break;
        case 13: if (!((PHASE_MASK >> 13) & 1)) break; gk = 1; g = pg8::Gemm{(const bf16*)(F.ws + WS_CKVN), (const bf16*)(F.ws + WS_WUKV), MR, NUKV, 256}; ea = pg8::EpiAny{3, (const float*)(F.ws + WS_HPAR), (void*)(F.ws + WS_KV1), (float*)(F.ws + WS_K6N), (const float*)(F.ws + WS_ROPEP), NUKV, 2}; break;
        case 15: if (!((PHASE_MASK >> 15) & 1)) break; attn1_phase(F); break;
        case 16: if (!((PHASE_MASK >> 16) & 1)) break; gk = 2; g = pg8::Gemm{(const bf16*)(F.ws + WS_O1), (const bf16*)(F.ws + WS_WO1), ML, DM, DM}; ea = pg8::EpiAny{2, F.out, (void*)(F.ws + WS_XR), ctxres, mod + 3 * 6144 + 2048, 0, 3}; break;
        case 17: if (!((PHASE_MASK >> 17) & 1)) break; norm_phase(F, (const float*)(F.ws + WS_XR), ctxres, ML, ARG(7) + DM, 1, 1, false, nullptr, 0, true); break;
        case 18: if (!((PHASE_MASK >> 18) & 1)) break; gk = 1; g = pg8::Gemm{(const bf16*)(F.ws + WS_XN), (const bf16*)(F.ws + WS_W1_1), ML, FF, DM}; ea = pg8::EpiAny{1, nullptr, (void*)(F.ws + WS_H), nullptr, nullptr, FF, 1}; break;
        case 19: if (!((PHASE_MASK >> 19) & 1)) break; gk = 2; g = pg8::Gemm{(const bf16*)(F.ws + WS_H), (const bf16*)(F.ws + WS_W2_1), ML, DM, FF}; ea = pg8::EpiAny{2, (const float*)(F.ws + WS_XR), (void*)F.out, ctxres, mod + 3 * 6144 + 5120, 0, 1}; break;
        default: break;
        }
        ea.scr = F.lds + LDSCTL_OFF + 4096;
        if (gk != 0) { pg8::StaticOrder S; S.init(g.M, g.N, g.K, F.G, F.bx, xrows, xS);
            if (g.mx) pg8::gemm_phase<pg8::EpiAny, pg8::StaticOrder, true, true, true>(F.lds + RING_OFF, g, S, ea, F.tid);
            else pg8::gemm_phase<pg8::EpiAny, pg8::StaticOrder, true, true, false>(F.lds + RING_OFF, g, S, ea, F.tid); }
        const bool last_ = (ph == args.ph_hi - 1) && ((ph2 & 1) || !((PHASE_REP >> ph) & 1));
        if (!MK_PER_PHASE && !last_ && ph != 12) xcd_barrier(bar);
        else __syncthreads();
    }
}

extern "C" void kernel_launch(void* const* d_in, const int* in_sizes, int n_in, void* d_out, int out_size, void* d_ws, size_t ws_size, hipStream_t stream) {
    static int grid = 0;
    if (grid == 0) {
        if (n_in != 28 || in_sizes[0] != ML * DM || out_size != ML * DM || ws_size < WS_END) { fprintf(stderr, "kernel_launch: unexpected shapes: n_in %d in0 %d out %d ws %zu\n", n_in, n_in > 0 ? in_sizes[0] : -1, out_size, ws_size); grid = -1; return; }
        int dev = 0, cus = 0, per_cu = 0;
        if (hipGetDevice(&dev) != hipSuccess || hipDeviceGetAttribute(&cus, hipDeviceAttributeMultiprocessorCount, dev) != hipSuccess) { fprintf(stderr, "kernel_launch: device query failed\n"); grid = -1; return; }
        if (hipFuncSetAttribute((const void*)fwd_kernel, hipFuncAttributeMaxDynamicSharedMemorySize, LDS_BYTES) != hipSuccess) { fprintf(stderr, "kernel_launch: hipFuncSetAttribute failed\n"); grid = -1; return; }
        if (hipOccupancyMaxActiveBlocksPerMultiprocessor(&per_cu, (const void*)fwd_kernel, NWAVES * 64, LDS_BYTES) != hipSuccess || per_cu < 1)
            fprintf(stderr, "kernel_launch: note: occupancy query reports %d workgroups per CU\n", per_cu);
        (void)hipGetLastError();
        grid = cus;
    }
    if (grid < 0) return;
    if (hipMemsetAsync((char*)d_ws + WS_CTL, 0, CTL_ZERO_BYTES, stream) != hipSuccess) { fprintf(stderr, "kernel_launch: hipMemsetAsync failed\n"); return; }
    Args a{};
    for (int i = 0; i < 28; ++i) a.in[i] = (const float*)d_in[i];
    a.out = (float*)d_out; a.ws = (unsigned char*)d_ws;
#if MK_PER_PHASE
    for (int ph = 0; ph <= N_PHASES; ++ph) { a.ph_lo = ph; a.ph_hi = ph + 1; hipLaunchKernelGGL(fwd_kernel, dim3(grid), dim3(NWAVES * 64), LDS_BYTES, stream, a); }
#else
    a.ph_lo = 0; a.ph_hi = N_PHASES + 1;
    hipLaunchKernelGGL(fwd_kernel, dim3(grid), dim3(NWAVES * 64), LDS_BYTES, stream, a);
#endif
    const hipError_t le = hipPeekAtLastError();
    if (le != hipSuccess) fprintf(stderr, "kernel_launch: launch failed: %s\n", hipGetErrorName(le));
}
```

```cpp
#include <hip/hip_runtime.h>
#include <cstdio>
#include <cstdint>
namespace pg8 {
#define PG8_LAS __attribute__((address_space(3)))
typedef unsigned short bf16_t;
typedef short bf16x8 __attribute__((ext_vector_type(8)));
typedef float f32x4 __attribute__((ext_vector_type(4)));
typedef unsigned u32x4 __attribute__((ext_vector_type(4)));
typedef unsigned u32x2 __attribute__((ext_vector_type(2)));
typedef unsigned u32x6 __attribute__((ext_vector_type(6)));
typedef unsigned u32x16 __attribute__((ext_vector_type(16)));
typedef __bf16 bf16x32 __attribute__((ext_vector_type(32)));
constexpr int BM = 256, BK = 64, HALF = 128, HTB = HALF * BK * 2  , STAGE_BYTES = 8 * HTB, NXCD = 8, WGM = 8;

__host__ __device__ __forceinline__ int lds_byte(int r, int c) { const int st = (r >> 4) * 2 + (c >> 5), rr = r & 15, cc = c & 31, ob = rr * 64 + cc * 2; return st * 1024 + (ob ^ (((ob >> 9) & 1) << 5)); }
__host__ __device__ __forceinline__ void stage_rc(int b, int& R, int& C) { const int st = b / 1024, sb = b % 1024, swz = sb ^ (((sb >> 9) & 1) << 5); R = (st >> 1) * 16 + swz / 64; C = (st & 1) * 32 + (swz % 64) / 2; }
__host__ __device__ __forceinline__ int perm32(int rho) { const int n = rho >> 4, i = rho & 15; return 8 * (i >> 2) + 4 * n + (i & 3); }

struct Unit { int pm, pn, kinfo; };
struct Gemm { const bf16_t* A; const bf16_t* Bt; int M, N, K; int mx = 0; };

struct StaticOrder {
    int nM, nN, nwg, G, c, ntK;
    int xtiles, xsh;
    __host__ __device__ void init(int M, int N, int K, int G_, int c_, int extra_rows = 0, int S = 1) { nM = M / BM; nN = N / BM; nwg = nM * nN; G = G_; c = c_; ntK = K / BK;
        xtiles = (extra_rows / BM) * nN; xsh = S; }
    __host__ __device__ bool next(int i, Unit& u) const {
        const long L = (long)i * G + c;
        if (L >= nwg) {
            if (xtiles == 0) return false;
            const int nb = (nwg - c + G - 1) / G;
            const int nbc = c < nwg ? nb : 0;
            const long e = (long)(i - nbc) * G + ((c + G - (nwg % G)) % G);
            if (e >= ((long)xtiles << xsh)) return false;
            const int tile = (int)(e >> xsh), ks = (int)e & ((1 << xsh) - 1), xnt = ntK >> xsh;
            u.pm = nM + tile / nN; u.pn = tile % nN; u.kinfo = (ks * xnt) | (xnt << 8) | (1 << 16); return true;
        }
        int wgid = (int)L; { const int q = nwg / NXCD, r = nwg % NXCD, xcd = wgid % NXCD, off = wgid / NXCD; wgid = (xcd < r ? xcd * (q + 1) : r * (q + 1) + (xcd - r) * q) + off; }
        const int nig = WGM * nN, gid = wgid / nig, fm = gid * WGM, gsz = (nM - fm) < WGM ? (nM - fm) : WGM;
        u.pm = fm + ((wgid % nig) % gsz); u.pn = (wgid % nig) / gsz; u.kinfo = ntK << 8; return true;
    }
    __device__ __forceinline__ void a_ready(const Unit&) const {}
    __device__ __forceinline__ void done(const Unit&) const {}
};

__device__ __forceinline__ unsigned cvt_pk_bf16(float lo, float hi) { unsigned r; asm volatile("v_cvt_pk_bf16_f32 %0, %1, %2" : "=v"(r) : "v"(lo), "v"(hi)); return r; }
__device__ __forceinline__ u32x2 pk4bf(f32x4 y) { u32x2 r; r.x = cvt_pk_bf16(y[0], y[1]); r.y = cvt_pk_bf16(y[2], y[3]); return r; }
__device__ __forceinline__ f32x4 unpk4bf(u32x2 w) { f32x4 r; r[0] = __builtin_bit_cast(float, w.x << 16); r[1] = __builtin_bit_cast(float, w.x & 0xffff0000u); r[2] = __builtin_bit_cast(float, w.y << 16); r[3] = __builtin_bit_cast(float, w.y & 0xffff0000u); return r; }
struct EpiAny {
    static constexpr bool AFTER_DRAIN = false;
    int mode; const float* base; void* out; float* ctxres; const float* gate; int ldc, relu2; PG8_LAS unsigned char* scr = nullptr;
    __device__ __forceinline__ bool perm() const { return mode == 1; }
    __device__ __forceinline__ bool headmode() const { return mode == 3; }
    __device__ __forceinline__ static float xsh(float v, int mask, int lane) { return __builtin_bit_cast(float, __builtin_amdgcn_ds_bpermute((lane ^ mask) << 2, __builtin_bit_cast(int, v))); }
    __device__ __forceinline__ void head_epilogue(const f32x4 (&acc)[2][2][4][2], const Unit& u, int wr, int wc, int fr, int fq) const {
        const int H = 4 * u.pn + wc, kind = relu2, lane = fr + 16 * fq;
        const bool f6 = kind != 0 && base[448] != 0.f;
        const bool f6e = kind == 0 && base[449] != 0.f;
        int cls, gsel; float qs = 1.f;
        if (kind == 0) { const float qq = f6e ? 1.6986436f : 0.125f * 1.4426950408889634f, kq = f6e ? 1.6986436f : 1.f;
                         if (H < 8) { cls = 2; gsel = 0; qs = qq; } else if (H < 10) { cls = 2; gsel = 1; qs = kq; } else if (H < 12) { cls = 0; gsel = 0; }
                         else if (H < 20) { cls = 1; gsel = 2; qs = qq; } else if (H < 28) { cls = 1; gsel = 3; qs = kq; } else { cls = 0; gsel = 0; } }
        else if (kind == 1) { qs = f6 ? 1.5349124f : 0.10206207261596575f * 1.4426950408889634f; if (H < 16) { cls = 1; gsel = 4; } else { cls = 3; gsel = 5; } }
        else { if (H < 16) { cls = 1; gsel = 6; if (f6) qs = 1.5349124f; } else { cls = 0; gsel = 0; } }
        const bool lat = u.pm < 64;
        const bool k6e = f6e && (H == 8 || H == 9 || (H >= 20 && H < 28));
        const bool k6 = (f6 && kind == 2 && H < 16) || k6e;
        bf16_t* O = (bf16_t*)out;
        const int col0 = u.pn * BM + 64 * wc + 8 * fq;
        f32x4 gv[2][2];
#pragma unroll
        for (int bj = 0; bj < 2; ++bj)
#pragma unroll
            for (int n = 0; n < 2; ++n) gv[bj][n] = *(const f32x4*)(base + gsel * 64 + 32 * bj + 8 * fq + 4 * n);
#pragma unroll
        for (int ai = 0; ai < 2; ++ai)
#pragma unroll
            for (int m = 0; m < 4; ++m) {
                const int row = u.pm * BM + ai * HALF + wr * 64 + m * 16 + fr;
                f32x4 v[2][2];
#pragma unroll
                for (int bj = 0; bj < 2; ++bj)
#pragma unroll
                    for (int n = 0; n < 2; ++n) v[bj][n] = acc[ai][bj][m][n];
                if (cls != 0) {
                    float s0 = 0.f, s1 = 0.f;
#pragma unroll
                    for (int n = 0; n < 2; ++n)
#pragma unroll
                        for (int e = 0; e < 4; ++e) { s0 += v[0][n][e] * v[0][n][e]; s1 += v[1][n][e] * v[1][n][e]; }
                    if (cls != 3) { s0 += s1; s0 += xsh(s0, 16, lane); s0 += xsh(s0, 32, lane); s0 = s0 * (1.f / 64.f); s1 = s0; }
                    else { s0 += xsh(s0, 16, lane); s0 += xsh(s0, 32, lane); s1 += xsh(s1, 16, lane); s1 += xsh(s1, 32, lane); s0 *= (1.f / 32.f); s1 *= (1.f / 32.f); }
                    const float r0 = 1.f / sqrtf(s0 + 1e-6f), r1 = 1.f / sqrtf(s1 + 1e-6f);
#pragma unroll
                    for (int n = 0; n < 2; ++n) { v[0][n] = v[0][n] * r0 * gv[0][n]; v[1][n] = v[1][n] * r1 * gv[1][n]; }
                    if (lat && cls == 2) {
                        const int t = row & 8191;
                        u32x4 cw[2][2]; const float sgn = fq < 2 ? -1.f : 1.f;
#pragma unroll
                        for (int bj = 0; bj < 2; ++bj) { const int pos = bj == 0 ? (t >> 6) : (t & 63);
#pragma unroll
                            for (int n = 0; n < 2; ++n) cw[bj][n] = *(const u32x4*)((const unsigned*)gate + pos * 16 + 8 * (fq & 1) + 4 * n); }
#pragma unroll
                        for (int bj = 0; bj < 2; ++bj)
#pragma unroll
                            for (int n = 0; n < 2; ++n) { f32x4 p, c, sn;
#pragma unroll
                                for (int e = 0; e < 4; ++e) { p[e] = xsh(v[bj][n][e], 32, lane); c[e] = __builtin_bit_cast(float, cw[bj][n][e] << 16); sn[e] = __builtin_bit_cast(float, cw[bj][n][e] & 0xffff0000u); }
                                v[bj][n] = v[bj][n] * c + (p * sgn) * sn; }
                    }
                    if (lat && cls == 3) {
                        const int t = row & 8191; const int pos = fq < 2 ? (t >> 6) : (t & 63); const float sgn = (fq & 1) ? 1.f : -1.f;
                        u32x4 cw[2];
#pragma unroll
                        for (int n = 0; n < 2; ++n) cw[n] = *(const u32x4*)((const unsigned*)gate + 2048 + pos * 8 + 4 * n);
#pragma unroll
                        for (int bj = 0; bj < 2; ++bj)
#pragma unroll
                            for (int n = 0; n < 2; ++n) { f32x4 p, c, sn;
#pragma unroll
                                for (int e = 0; e < 4; ++e) { p[e] = xsh(v[bj][n][e], 16, lane); c[e] = __builtin_bit_cast(float, cw[n][e] << 16); sn[e] = __builtin_bit_cast(float, cw[n][e] & 0xffff0000u); }
                                v[bj][n] = v[bj][n] * c + (p * sgn) * sn; }
                    }
                    if (qs != 1.f) {
#pragma unroll
                        for (int bj = 0; bj < 2; ++bj)
#pragma unroll
                            for (int n = 0; n < 2; ++n) v[bj][n] = v[bj][n] * qs; }
                }
                if (k6) {
                    PG8_LAS unsigned char* sw = scr + (wr * 4 + wc) * 1024 + fr * 64;
                    unsigned char* img = (unsigned char*)ctxres + (k6e ? ((size_t)(row >> 6) * 10 + (H < 10 ? H - 8 : H - 18)) : ((size_t)(row >> 6) * 16 + H)) * 3072;
                    const int key = row & 63;
#pragma unroll
                    for (int bj = 0; bj < 2; ++bj) {
                        u32x4 w; w.x = cvt_pk_bf16(v[bj][0][0], v[bj][0][1]); w.y = cvt_pk_bf16(v[bj][0][2], v[bj][0][3]); w.z = cvt_pk_bf16(v[bj][1][0], v[bj][1][1]); w.w = cvt_pk_bf16(v[bj][1][2], v[bj][1][3]);
                        *(PG8_LAS u32x4*)(sw + fq * 16) = w;
                        asm volatile("s_waitcnt lgkmcnt(0)" ::: "memory");
                        if (fq == 0) {
                            const u32x4 a0 = *(PG8_LAS u32x4*)(sw), a1 = *(PG8_LAS u32x4*)(sw + 16), a2 = *(PG8_LAS u32x4*)(sw + 32), a3 = *(PG8_LAS u32x4*)(sw + 48);
                            const u32x16 all = {a0.x, a0.y, a0.z, a0.w, a1.x, a1.y, a1.z, a1.w, a2.x, a2.y, a2.z, a2.w, a3.x, a3.y, a3.z, a3.w};
                            const u32x6 c = __builtin_amdgcn_cvt_scalef32_pk32_fp6_bf16(__builtin_bit_cast(bf16x32, all), 1.0f);
                            *(u32x4*)(img + bj * 1024 + key * 16) = (u32x4){c[0], c[1], c[2], c[3]};
                            *(u32x2*)(img + 2048 + bj * 512 + key * 8) = (u32x2){c[4], c[5]};
                        }
                        asm volatile("s_waitcnt lgkmcnt(0)" ::: "memory");
                    }
                    continue;
                }
                bf16_t* rowp = O + (size_t)row * ldc + col0;
#pragma unroll
                for (int bj = 0; bj < 2; ++bj) { u32x4 w; w.x = cvt_pk_bf16(v[bj][0][0], v[bj][0][1]); w.y = cvt_pk_bf16(v[bj][0][2], v[bj][0][3]); w.z = cvt_pk_bf16(v[bj][1][0], v[bj][1][1]); w.w = cvt_pk_bf16(v[bj][1][2], v[bj][1][3]);
                    *(u32x4*)(rowp + 32 * bj) = w; }
            }
    }
    __device__ __forceinline__ void operator()(const f32x4 (&acc)[2][2][4][2], const Unit& u, int wr, int wc, int fr, int fq) const {
        asm volatile("" : "+v"(fr), "+v"(fq));
        if (mode == 1) {
            bf16_t* O = (bf16_t*)out;
            const int row0 = u.pm * BM + wr * 64 + fr, col0 = u.pn * BM + wc * 32 + 8 * fq;
#pragma unroll
            for (int ai = 0; ai < 2; ++ai)
#pragma unroll
                for (int m = 0; m < 4; ++m) { bf16_t* rowp = O + (size_t)(row0 + ai * HALF + m * 16) * ldc + col0;
#pragma unroll
                    for (int bj = 0; bj < 2; ++bj) { f32x4 v0 = acc[ai][bj][m][0], v1 = acc[ai][bj][m][1];
                        if (relu2) {
#pragma unroll
                            for (int e = 0; e < 4; ++e) { float a = fmaxf(v0[e], 0.f), b = fmaxf(v1[e], 0.f); v0[e] = a * a; v1[e] = b * b; } }
                        u32x4 w; w.x = cvt_pk_bf16(v0[0], v0[1]); w.y = cvt_pk_bf16(v0[2], v0[3]); w.z = cvt_pk_bf16(v1[0], v1[1]); w.w = cvt_pk_bf16(v1[2], v1[3]);
                        *(u32x4*)(rowp + bj * HALF) = w; } }
            return;
        }
        if (mode == 3) { head_epilogue(acc, u, wr, wc, fr, fq); return; }
        const int t0 = u.pm * BM; const bool split = (u.kinfo >> 16) != 0; const int cond = t0 < 8192 ? 0 : (t0 < 16384 ? 1 : 2);
        const int col0 = u.pn * BM + wc * 32 + 4 * fq; const float* g = gate + cond * 6144 + col0;
        f32x4 gv[2][2];
#pragma unroll
        for (int bj = 0; bj < 2; ++bj)
#pragma unroll
            for (int n = 0; n < 2; ++n) gv[bj][n] = *(const f32x4*)(g + bj * HALF + n * 16);
        if (split) {
            const int ks = (u.kinfo & 255) / ((u.kinfo >> 8) & 255);
            float* op = ctxres + (size_t)ks * (512 * 1024) + (size_t)(t0 - 16384) * 1024;
#pragma unroll
            for (int ai = 0; ai < 2; ++ai)
#pragma unroll
                for (int m = 0; m < 4; ++m) { const size_t off = (size_t)(wr * 64 + fr + ai * HALF + m * 16) * 1024 + col0;
#pragma unroll
                    for (int bj = 0; bj < 2; ++bj)
#pragma unroll
                        for (int n = 0; n < 2; ++n) *(f32x4*)(op + off + bj * HALF + n * 16) = gv[bj][n] * acc[ai][bj][m][n]; }
            return;
        }
#define PG8_RES_LOOP(LOADB, STOREO) _Pragma("unroll") for (int ai = 0; ai < 2; ++ai) _Pragma("unroll") for (int m = 0; m < 4; ++m) { const size_t off = (size_t)(wr * 64 + fr + ai * HALF + m * 16) * 1024 + col0; \
            _Pragma("unroll") for (int bj = 0; bj < 2; ++bj) _Pragma("unroll") for (int n = 0; n < 2; ++n) { const size_t o2 = off + bj * HALF + n * 16; f32x4 b; LOADB; const f32x4 y = b + gv[bj][n] * acc[ai][bj][m][n]; STOREO; } }
        if (relu2 == 2) { const float* bp = base + (size_t)t0 * 1024; bf16_t* op = (bf16_t*)out + (size_t)t0 * 1024;
            PG8_RES_LOOP(b = *(const f32x4*)(bp + o2), *(u32x2*)(op + o2) = pk4bf(y)); }
        else if (relu2 == 3) { const bf16_t* bp = (const bf16_t*)base + (size_t)t0 * 1024; bf16_t* op = (bf16_t*)out + (size_t)t0 * 1024;
            PG8_RES_LOOP(const u32x2 w = *(const u32x2*)(bp + o2); b = unpk4bf(w), *(u32x2*)(op + o2) = pk4bf(y)); }
        else { const bf16_t* bp = (const bf16_t*)base + (size_t)t0 * 1024; float* op = (float*)out + (size_t)t0 * 1024;
            PG8_RES_LOOP(const u32x2 w = *(const u32x2*)(bp + o2); b = unpk4bf(w), *(f32x4*)(op + o2) = y); }
#undef PG8_RES_LOOP
    }
};

template <class Epi, class Sched, bool ALIGN_EPI = false, bool SP2 = false, bool MX8 = false>
__device__ __forceinline__ void gemm_phase(PG8_LAS unsigned char* lds, const Gemm g, const Sched& S, const Epi& E, const int tid) {
    const int wid = __builtin_amdgcn_readfirstlane(tid >> 6), lane = tid & 63, wr = wid >> 2, wc = wid & 3, fr = lane & 15, fq = lane >> 4;
    const int K = g.K;
    typedef int i32x4_t __attribute__((ext_vector_type(4)));
    int scw_ = 0x7a7a7a7a, sca_ = 0x7f7f7f7f; asm volatile("" : "+v"(scw_), "+v"(sca_));
    unsigned voffA[2], voffB[2];
#pragma unroll
    for (int i = 0; i < 2; ++i) { int R, C; stage_rc(tid * 16 + i * 8192, R, C); const int Rb = E.headmode() ? (64 * (R >> 5) + perm32(R & 31)) : (E.perm() ? ((R & ~31) + perm32(R & 31)) : R);
        voffA[i] = (unsigned)(R * K + C) * 2u; voffB[i] = (unsigned)(Rb * K + C) * 2u; }
    const size_t kstep = (size_t)(BK * 2);
    const size_t hstep = (size_t)HALF * K * 2;
    const size_t tstep = 2 * hstep;
    const size_t hstepB = E.headmode() ? (size_t)32 * K * 2 : hstep;
    const unsigned ldsw = (unsigned)wid * 1024u;
    const int aoff = lds_byte(wr * 64 + fr, fq * 8), boff = lds_byte(wc * 32 + fr, fq * 8);
#define PG8_SA(b, h) (((b) * 2 + (h)) * HTB)
#define PG8_SB(b, h) ((4 + (b) * 2 + (h)) * HTB)
    const unsigned ldsb = (unsigned)(uintptr_t)lds + ldsw;
#define PG8_STAGE(bufoff, gbase, voff) do { _Pragma("unroll") for (int _i = 0; _i < 2; ++_i) { unsigned keep_; \
        asm volatile("s_mov_b32 %0, m0\n\ts_mov_b32 m0, %3\n\ts_nop 0\n\tglobal_load_lds_dwordx4 %1, %2\n\ts_mov_b32 m0, %0" : "=&s"(keep_) : "v"((voff)[_i]), "s"((const char*)(gbase)), "s"(ldsb + (unsigned)((bufoff) + _i * 8192)) : "memory"); } } while (0)
#define PG8_LDA(dst, b, h) do { _Pragma("unroll") for (int m = 0; m < 4; ++m) _Pragma("unroll") for (int k = 0; k < 2; ++k) dst[m][k] = *(const PG8_LAS bf16x8*)(lds + PG8_SA(b, h) + aoff + m * 2048 + k * 1024); } while (0)
#define PG8_LDB(dst, b, h) do { _Pragma("unroll") for (int n = 0; n < 2; ++n) _Pragma("unroll") for (int k = 0; k < 2; ++k) dst[n][k] = *(const PG8_LAS bf16x8*)(lds + PG8_SB(b, h) + boff + n * 2048 + k * 1024); } while (0)
#define PG8_CAT(x, y) __builtin_shufflevector(__builtin_bit_cast(i32x4_t, x), __builtin_bit_cast(i32x4_t, y), 0, 1, 2, 3, 4, 5, 6, 7)
#define PG8_MMA(ai, bj, At, Bt) do { __builtin_amdgcn_s_setprio(1); \
        if constexpr (MX8) { _Pragma("unroll") for (int m = 0; m < 4; ++m) _Pragma("unroll") for (int n = 0; n < 2; ++n) \
            asm volatile("v_mfma_scale_f32_16x16x128_f8f6f4 %0, %1, %2, %0, %3, %4 op_sel_hi:[0,0,0]" : "+v"(acc[ai][bj][m][n]) : "v"(PG8_CAT(Bt[n][0], Bt[n][1])), "v"(PG8_CAT(At[m][0], At[m][1])), "v"(scw_), "v"(sca_)); } \
        else { _Pragma("unroll") for (int m = 0; m < 4; ++m) _Pragma("unroll") for (int n = 0; n < 2; ++n) _Pragma("unroll") for (int k = 0; k < 2; ++k) \
            acc[ai][bj][m][n] = __builtin_amdgcn_mfma_f32_16x16x32_bf16(Bt[n][k], At[m][k], acc[ai][bj][m][n], 0, 0, 0); } \
        __builtin_amdgcn_s_setprio(0); } while (0)
#define PG8_WAIT_V(n) asm volatile("s_waitcnt vmcnt(" #n ")" ::: "memory")
#define PG8_WAIT_L(n) asm volatile("s_waitcnt lgkmcnt(" #n ")" ::: "memory")
#define PG8_BAR __builtin_amdgcn_s_barrier()
#define PG8_SCHED __builtin_amdgcn_sched_barrier(0)
    Unit cur, nxt; int ui = 0;
    if (!S.next(0, cur)) return;
    f32x4 acc[2][2][4][2];
#pragma unroll
    for (int a = 0; a < 2; ++a)
#pragma unroll
        for (int b = 0; b < 2; ++b)
#pragma unroll
            for (int m = 0; m < 4; ++m)
#pragma unroll
                for (int n = 0; n < 2; ++n) acc[a][b][m][n] = (f32x4){0.f, 0.f, 0.f, 0.f};
    bf16x8 At[4][2], B0[2][2], B1[2][2];
    const char* cA = (const char*)g.A + (size_t)cur.pm * tstep + (size_t)(cur.kinfo & 255) * (BK * 2); const char* cB = (const char*)g.Bt + (size_t)cur.pn * tstep + (size_t)(cur.kinfo & 255) * (BK * 2);
    S.a_ready(cur);
    if constexpr (SP2) {
        PG8_STAGE(PG8_SB(0, 0), cB, voffB); PG8_STAGE(PG8_SB(0, 1), cB + hstepB, voffB); PG8_STAGE(PG8_SA(0, 0), cA, voffA); PG8_STAGE(PG8_SA(0, 1), cA + hstep, voffA);
        if (wr == 1) PG8_BAR;
        PG8_WAIT_V(2); PG8_BAR;
        PG8_STAGE(PG8_SB(1, 0), cB + kstep, voffB); PG8_STAGE(PG8_SA(1, 0), cA + kstep, voffA); PG8_STAGE(PG8_SB(1, 1), cB + hstepB + kstep, voffB);
        PG8_WAIT_V(6); PG8_BAR;
    } else {
        PG8_STAGE(PG8_SB(0, 0), cB, voffB); PG8_STAGE(PG8_SA(0, 0), cA, voffA); PG8_STAGE(PG8_SB(0, 1), cB + hstepB, voffB); PG8_STAGE(PG8_SA(0, 1), cA + hstep, voffA);
        if (wr == 1) PG8_BAR;
        PG8_WAIT_V(4); PG8_BAR;
        PG8_STAGE(PG8_SB(1, 0), cB + kstep, voffB); PG8_STAGE(PG8_SA(1, 0), cA + kstep, voffA); PG8_STAGE(PG8_SB(1, 1), cB + hstepB + kstep, voffB);
        PG8_WAIT_V(6); PG8_BAR;
    }
    for (;;) {
        const bool has_next = S.next(ui + 1, nxt);
        const char* nA = has_next ? (const char*)g.A + (size_t)nxt.pm * tstep + (size_t)(nxt.kinfo & 255) * (BK * 2) : cA; const char* nB = has_next ? (const char*)g.Bt + (size_t)nxt.pn * tstep + (size_t)(nxt.kinfo & 255) * (BK * 2) : cB;
        const int nt = (cur.kinfo >> 8) & 255;
        for (int t = 0; t < nt; t += 2) {
            const bool last = (t == nt - 2);
            const char* a1 = cA + (size_t)(t + 1) * kstep;
            const char* a2 = last ? nA : cA + (size_t)(t + 2) * kstep; const char* b2 = last ? nB : cB + (size_t)(t + 2) * kstep;
            const char* a3 = a2 + kstep; const char* b3 = b2 + kstep;
            if (last && has_next) S.a_ready(nxt);
            if constexpr (SP2) {
            PG8_LDB(B0, 0, 0); PG8_LDB(B1, 0, 1); PG8_SCHED; PG8_LDA(At, 0, 0); PG8_STAGE(PG8_SA(1, 1), a1 + hstep, voffA);
            PG8_WAIT_V(8); PG8_WAIT_L(0); PG8_BAR; PG8_MMA(0, 0, At, B0); PG8_MMA(0, 1, At, B1); PG8_BAR; PG8_SCHED;
            PG8_LDA(At, 0, 1); PG8_STAGE(PG8_SB(0, 0), b2, voffB); PG8_STAGE(PG8_SB(0, 1), b2 + hstepB, voffB); PG8_STAGE(PG8_SA(0, 0), a2, voffA);
            PG8_WAIT_V(8); PG8_WAIT_L(0); PG8_BAR; PG8_MMA(1, 0, At, B0); PG8_MMA(1, 1, At, B1); PG8_BAR; PG8_SCHED;
            PG8_LDB(B0, 1, 0); PG8_LDB(B1, 1, 1); PG8_SCHED; PG8_LDA(At, 1, 0); PG8_STAGE(PG8_SA(0, 1), a2 + hstep, voffA);
            PG8_WAIT_V(8); PG8_WAIT_L(0); PG8_BAR; PG8_MMA(0, 0, At, B0); PG8_MMA(0, 1, At, B1); PG8_BAR; PG8_SCHED;
            PG8_LDA(At, 1, 1); PG8_STAGE(PG8_SB(1, 0), b3, voffB); PG8_STAGE(PG8_SB(1, 1), b3 + hstepB, voffB); PG8_STAGE(PG8_SA(1, 0), a3, voffA);
            PG8_WAIT_V(8); PG8_WAIT_L(0); PG8_BAR; PG8_MMA(1, 0, At, B0); PG8_MMA(1, 1, At, B1); PG8_BAR; PG8_SCHED;
            } else {
            PG8_LDB(B0, 0, 0); PG8_SCHED; PG8_LDA(At, 0, 0); PG8_STAGE(PG8_SA(1, 1), a1 + hstep, voffA);
            PG8_WAIT_L(8); PG8_BAR; PG8_WAIT_L(0); PG8_MMA(0, 0, At, B0); PG8_BAR; PG8_SCHED;
            PG8_LDB(B1, 0, 1); PG8_STAGE(PG8_SB(0, 0), b2, voffB);
            PG8_BAR; PG8_WAIT_L(0); PG8_MMA(0, 1, At, B1); PG8_BAR;
            PG8_LDA(At, 0, 1); PG8_STAGE(PG8_SA(0, 0), a2, voffA);
            PG8_BAR; PG8_WAIT_L(0); PG8_MMA(1, 0, At, B0); PG8_BAR; PG8_SCHED;
            PG8_STAGE(PG8_SB(0, 1), b2 + hstepB, voffB);
            PG8_WAIT_V(6); PG8_BAR; PG8_MMA(1, 1, At, B1); PG8_BAR;
            PG8_LDB(B0, 1, 0); PG8_SCHED; PG8_LDA(At, 1, 0); PG8_STAGE(PG8_SA(0, 1), a2 + hstep, voffA);
            PG8_WAIT_L(8); PG8_BAR; PG8_WAIT_L(0); PG8_MMA(0, 0, At, B0); PG8_BAR; PG8_SCHED;
            PG8_LDB(B1, 1, 1); PG8_STAGE(PG8_SB(1, 0), b3, voffB);
            PG8_BAR; PG8_WAIT_L(0); PG8_MMA(0, 1, At, B1); PG8_BAR;
            PG8_LDA(At, 1, 1); PG8_STAGE(PG8_SA(1, 0), a3, voffA);
            PG8_BAR; PG8_WAIT_L(0); PG8_MMA(1, 0, At, B0); PG8_BAR; PG8_SCHED;
            PG8_STAGE(PG8_SB(1, 1), b3 + hstepB, voffB);
            PG8_WAIT_V(6); PG8_BAR; PG8_MMA(1, 1, At, B1); PG8_BAR;
            }
        }
        if constexpr (MX8) asm volatile("s_nop 15\n\ts_nop 15" ::: "memory");
        if constexpr (ALIGN_EPI) { if (wr == 0) PG8_BAR; }
        if constexpr (!Epi::AFTER_DRAIN) { E(acc, cur, wr, wc, fr, fq); S.done(cur); }
        if (!has_next) break;
#pragma unroll
        for (int a = 0; a < 2; ++a)
#pragma unroll
            for (int b = 0; b < 2; ++b)
#pragma unroll
                for (int m = 0; m < 4; ++m)
#pragma unroll
                    for (int n = 0; n < 2; ++n) acc[a][b][m][n] = (f32x4){0.f, 0.f, 0.f, 0.f};
        cur = nxt; cA = nA; cB = nB; ++ui;
        if constexpr (ALIGN_EPI) { if (wr == 1) PG8_BAR; }
    }
    PG8_WAIT_V(0);
    if constexpr (!ALIGN_EPI) { if (wr == 0) PG8_BAR; }
    PG8_BAR;
    if constexpr (Epi::AFTER_DRAIN) { E.fused(acc, cur, wr, wc, fr, fq, lds, wid, lane); S.done(cur); }
#undef PG8_SA
#undef PG8_SB
#undef PG8_STAGE
#undef PG8_CAT
#undef PG8_LDA
#undef PG8_LDB
#undef PG8_MMA
#undef PG8_WAIT_V
#undef PG8_WAIT_L
#undef PG8_BAR
#undef PG8_SCHED
}
}
namespace att {
#define ATT_LAS __attribute__((address_space(3)))
typedef unsigned short bf16;
typedef short bf16x8 __attribute__((ext_vector_type(8)));
typedef short s16x4 __attribute__((ext_vector_type(4)));
typedef float f32x16 __attribute__((ext_vector_type(16)));
typedef unsigned u32x4 __attribute__((ext_vector_type(4)));
typedef ATT_LAS char lchar;
constexpr int KBUF = 12288, VBUF = 16384;
constexpr int L_K = 0, L_V = 2 * KBUF, L_WS = L_V + 2 * VBUF, L_RPB = L_WS + 2048, L_END = L_RPB + 2048;
constexpr float LOG2E = 1.4426950408889634f;
#define ATT_SBAR() __builtin_amdgcn_sched_barrier(0)
__device__ __forceinline__ int crow(int r, int hi) { return (r & 3) + 8 * (r >> 2) + 4 * hi; }
__device__ __forceinline__ unsigned cvtpk(float lo, float hi) { unsigned r; asm volatile("v_cvt_pk_bf16_f32 %0, %1, %2" : "=v"(r) : "v"(lo), "v"(hi)); return r; }
__device__ __forceinline__ int v_st(int k, int c) { const int kk = (k & ~0xC) | ((k & 4) << 1) | ((k & 8) >> 1); return ((kk >> 3) * 4 + (c >> 5)) * 512 + ((kk & 7) * 32 + (c & 31)) * 2; }
__device__ __forceinline__ int v_rd_base(int lane) { return ((lane & 3) << 3) | (((lane >> 2) & 3) << 6) | (((lane >> 4) & 1) << 5) | (((lane >> 5) & 1) << 8); }
constexpr int v_rd_off(int d0, int ks, int half) { return d0 * 512 + ks * 4096 + half * 2048; }
template <int OFF> __device__ __forceinline__ s16x4 tr_read(unsigned vb) {
  s16x4 r; asm volatile("ds_read_b64_tr_b16 %0, %1 offset:%2" : "=&v"(r) : "v"(vb), "i"(OFF) : "memory"); return r;
}
template <int D0> __device__ __forceinline__ void pv_one(f32x16& od, unsigned vb, bf16x8 pa0, bf16x8 pa1, bf16x8 pa2, bf16x8 pa3) {
  const s16x4 l0 = tr_read<v_rd_off(D0, 0, 0)>(vb), h0 = tr_read<v_rd_off(D0, 0, 1)>(vb), l1 = tr_read<v_rd_off(D0, 1, 0)>(vb), h1 = tr_read<v_rd_off(D0, 1, 1)>(vb);
  const s16x4 l2 = tr_read<v_rd_off(D0, 2, 0)>(vb), h2 = tr_read<v_rd_off(D0, 2, 1)>(vb), l3 = tr_read<v_rd_off(D0, 3, 0)>(vb), h3 = tr_read<v_rd_off(D0, 3, 1)>(vb);
  asm volatile("s_waitcnt lgkmcnt(0)" ::: "memory"); ATT_SBAR();
#define ATT_PK(L, H) (bf16x8){L[0], L[1], L[2], L[3], H[0], H[1], H[2], H[3]}
  od = __builtin_amdgcn_mfma_f32_32x32x16_bf16(pa0, ATT_PK(l0, h0), od, 0, 0, 0);
  od = __builtin_amdgcn_mfma_f32_32x32x16_bf16(pa1, ATT_PK(l1, h1), od, 0, 0, 0);
  od = __builtin_amdgcn_mfma_f32_32x32x16_bf16(pa2, ATT_PK(l2, h2), od, 0, 0, 0);
  od = __builtin_amdgcn_mfma_f32_32x32x16_bf16(pa3, ATT_PK(l3, h3), od, 0, 0, 0);
#undef ATT_PK
}

template <int DKC, class U>
__device__ __forceinline__ void unit(const U& u, lchar* lds, int tid) {
  asm volatile("" : "+v"(tid));
  const int lane = tid & 63, r32 = lane & 31, hi = lane >> 5;
  const int wid = __builtin_amdgcn_readfirstlane(tid >> 6);
  lchar* Kl = lds + L_K; lchar* Vl = lds + L_V;
  ATT_LAS float* ws = (ATT_LAS float*)(lds + L_WS) + wid * 64;
  bf16x8 qr[DKC / 2];
#pragma unroll
  for (int d0 = 0; d0 < DKC / 2; ++d0) qr[d0] = *(const bf16x8*)u.qptr(wid, r32, d0, hi);
  const int vrow = tid >> 3, vch = tid & 7, vst = v_st(vrow, vch * 8);
  const int krow0 = tid & 63, kch0 = tid >> 6;
  const bool k2 = (DKC > 8) && (tid < 64 * (DKC - 8));
  const unsigned vb0 = (unsigned)(uintptr_t)Vl + (unsigned)v_rd_base(lane);
  bf16x8 kst0, kst1 = {}, vstr;
  const int NT = u.nt();
#define ATT_SLOAD(t) do { const long R_ = u.krow(t); kst0 = *(const bf16x8*)u.kptr(R_ + krow0, kch0); if (k2) kst1 = *(const bf16x8*)u.kptr(R_ + krow0, 8 + kch0); \
    vstr = *(const bf16x8*)u.vptr(R_ + vrow, vch); } while (0)
#define ATT_SWRITE(b) do { *(ATT_LAS bf16x8*)(Kl + (b) * KBUF + kch0 * 1024 + krow0 * 16) = kst0; if (k2) *(ATT_LAS bf16x8*)(Kl + (b) * KBUF + (8 + kch0) * 1024 + krow0 * 16) = kst1; \
    *(ATT_LAS bf16x8*)(Vl + (b) * VBUF + vst) = vstr; } while (0)
  float m_reg = -1e30f, l_reg = 0.f; f32x16 o[2]; o[0] = f32x16{}; o[1] = f32x16{};
  ATT_SLOAD(0); ATT_SWRITE(0); __syncthreads();
  for (int t = 0; t < NT; ++t) {
    const int buf = t & 1;
    if (t + 1 < NT) ATT_SLOAD(t + 1);
    if (!u.skip(t, wid)) {
      f32x16 p0 = f32x16{}, p1 = f32x16{};
      { const lchar* kb = Kl + buf * KBUF + hi * 1024 + r32 * 16;
#pragma unroll
        for (int d0 = 0; d0 < DKC / 2; ++d0) {
          const bf16x8 b0 = *(const ATT_LAS bf16x8*)(kb + d0 * 2048);
          const bf16x8 b1 = *(const ATT_LAS bf16x8*)(kb + d0 * 2048 + 512);
          p0 = __builtin_amdgcn_mfma_f32_32x32x16_bf16(b0, qr[d0], p0, 0, 0, 0);
          p1 = __builtin_amdgcn_mfma_f32_32x32x16_bf16(b1, qr[d0], p1, 0, 0, 0); } }
      u.mask(p0, p1, t, wid, r32, hi);
      float pmax = p0[0];
#pragma unroll
      for (int r = 1; r < 16; ++r) pmax = fmaxf(pmax, p0[r]);
#pragma unroll
      for (int r = 0; r < 16; ++r) pmax = fmaxf(pmax, p1[r]);
      { auto rr = __builtin_amdgcn_permlane32_swap(__float_as_uint(pmax), __float_as_uint(pmax), false, false);
        pmax = fmaxf(__uint_as_float(rr[0]), __uint_as_float(rr[1])); }
      const float mn = fmaxf(m_reg, pmax);
      const float alpha = __builtin_amdgcn_exp2f(m_reg - mn);
      m_reg = mn;
#pragma unroll
      for (int r = 0; r < 16; ++r) { p0[r] = __builtin_amdgcn_exp2f(p0[r] - mn); p1[r] = __builtin_amdgcn_exp2f(p1[r] - mn); }
      float ps = 0.f;
#pragma unroll
      for (int r = 0; r < 16; ++r) ps += p0[r];
#pragma unroll
      for (int r = 0; r < 16; ++r) ps += p1[r];
      { auto rr = __builtin_amdgcn_permlane32_swap(__float_as_uint(ps), __float_as_uint(ps), false, false);
        ps = __uint_as_float(rr[0]) + __uint_as_float(rr[1]); }
      l_reg = l_reg * alpha + ps;
      if (__any(alpha < 1.f)) {
        if (hi == 0) ws[r32] = alpha;
        asm volatile("s_waitcnt lgkmcnt(0)" ::: "memory");
#pragma unroll
        for (int r = 0; r < 16; ++r) { const float a = ws[crow(r, hi)]; o[0][r] *= a; o[1][r] *= a; }
      }
      bf16x8 pa0, pa1, pa2, pa3;
#define ATT_PK4(P, BASE, OUT) do { unsigned a0 = cvtpk(P[BASE + 0], P[BASE + 1]), a1 = cvtpk(P[BASE + 2], P[BASE + 3]);   \
    unsigned b0 = cvtpk(P[BASE + 4], P[BASE + 5]), b1 = cvtpk(P[BASE + 6], P[BASE + 7]);                              \
    auto r0 = __builtin_amdgcn_permlane32_swap(a0, b0, false, false); auto r1 = __builtin_amdgcn_permlane32_swap(a1, b1, false, false); \
    u32x4 w = {r0[0], r1[0], r0[1], r1[1]}; OUT = __builtin_bit_cast(bf16x8, w); } while (0)
      ATT_PK4(p0, 0, pa0); ATT_PK4(p0, 8, pa1); ATT_PK4(p1, 0, pa2); ATT_PK4(p1, 8, pa3);
#undef ATT_PK4
      const unsigned vb = vb0 + (unsigned)(buf * VBUF);
      pv_one<0>(o[0], vb, pa0, pa1, pa2, pa3); pv_one<1>(o[1], vb, pa0, pa1, pa2, pa3);
    }
    if (t + 1 < NT) ATT_SWRITE(buf ^ 1);
    __syncthreads();
  }
#undef ATT_SLOAD
#undef ATT_SWRITE
  { const float sk = u.sink(wid); l_reg += __builtin_amdgcn_exp2f(sk - m_reg); }
  if (hi == 0) ws[r32] = l_reg;
  asm volatile("s_waitcnt lgkmcnt(0)" ::: "memory");
  float rli[16];
#pragma unroll
  for (int r = 0; r < 16; ++r) rli[r] = __builtin_amdgcn_rcpf(ws[crow(r, hi)]);
#pragma unroll
  for (int r = 0; r < 16; ++r) { bf16* op = u.orow(wid, crow(r, hi));
    op[r32] = (bf16)(cvtpk(o[0][r] * rli[r], 0.f) & 0xffffu); op[32 + r32] = (bf16)(cvtpk(o[1][r] * rli[r], 0.f) & 0xffffu); }
  asm volatile("s_waitcnt lgkmcnt(0)" ::: "memory");
}

constexpr int ROWS_LAT = 16384;
struct UWin {
  const bf16* QKV; bf16* O; const float* sinkp; int b, n, g, hh; int i0, cnt;
  __device__ __forceinline__ void init() { i0 = (n == 0) ? 2 : 0; cnt = (n == 0 || n == 63) ? 4 : 6; }
  __device__ __forceinline__ int nt() const { return 4 + cnt; }
  __device__ __forceinline__ int kpos0(int t) const { return 128 * (n - 1) + 64 * (i0 + t - 4); }
  __device__ __forceinline__ long krow(int t) const { return t < 4 ? (long)(ROWS_LAT + 256 * b + 64 * t) : (long)(8192 * b + kpos0(t)); }
  __device__ __forceinline__ const bf16* kptr(long row, int ch) const { return QKV + row * 2304 + 512 + 64 * g + ch * 8; }
  __device__ __forceinline__ const bf16* vptr(long row, int ch) const { return QKV + row * 2304 + 640 + 64 * g + ch * 8; }
  __device__ __forceinline__ int head(int wid) const { return 4 * g + 2 * hh + (wid >> 2); }
  __device__ __forceinline__ int qpos0(int wid) const { return 128 * n + 32 * (wid & 3); }
  __device__ __forceinline__ const bf16* qptr(int wid, int r32, int d0, int hi) const { return QKV + (long)(8192 * b + qpos0(wid) + r32) * 2304 + 64 * head(wid) + 16 * d0 + 8 * hi; }
  __device__ __forceinline__ bool skip(int t, int wid) const { if (t < 4) return false; const int k0 = kpos0(t), q0 = qpos0(wid); return (k0 + 63 < q0 - 128) || (k0 > q0 + 31 + 128); }
  __device__ __forceinline__ void mask(f32x16& p0, f32x16& p1, int t, int wid, int r32, int hi) const {
    if (t < 4) return;
    const int dq = kpos0(t) - (qpos0(wid) + r32);
#pragma unroll
    for (int r = 0; r < 16; ++r) { const int d = dq + crow(r, hi); if (d > 128 || d < -128) p0[r] = -INFINITY; if (d + 32 > 128 || d + 32 < -128) p1[r] = -INFINITY; }
  }
  __device__ __forceinline__ float sink(int wid) const { return sinkp[head(wid)] * LOG2E; }
  __device__ __forceinline__ bf16* orow(int wid, int row) const { return O + (long)(8192 * b + qpos0(wid) + row) * 1024 + 64 * head(wid); }
};
struct UNa {
  const bf16* QKV; bf16* O; const ATT_LAS float* rpbl; int b, h, R4; int krlo, nloc;
  __device__ __forceinline__ static int clampi(int v, int lo, int hi_) { return v < lo ? lo : (v > hi_ ? hi_ : v); }
  __device__ __forceinline__ void init() { krlo = clampi(4 * R4 - 4, 0, 120); const int krhi = clampi(4 * R4 - 1, 0, 120) + 7; nloc = krhi - krlo + 1; }
  __device__ __forceinline__ int nt() const { return 4 + nloc; }
  __device__ __forceinline__ long krow(int t) const { return t < 4 ? (long)(ROWS_LAT + 256 * b + 64 * t) : (long)(8192 * b + 64 * (krlo + t - 4)); }
  __device__ __forceinline__ const bf16* kptr(long row, int ch) const { return QKV + row * 2304 + 1280 + 64 * h + ch * 8; }
  __device__ __forceinline__ const bf16* vptr(long row, int ch) const { return QKV + row * 2304 + 1792 + 64 * h + ch * 8; }
  __device__ __forceinline__ int qrow(int wid) const { return 4 * R4 + (wid >> 1); }
  __device__ __forceinline__ const bf16* qptr(int wid, int r32, int d0, int hi) const { return QKV + (long)(8192 * b + 64 * qrow(wid) + 32 * (wid & 1) + r32) * 2304 + 768 + 64 * h + 16 * d0 + 8 * hi; }
  __device__ __forceinline__ bool skip(int t, int wid) const { if (t < 4) return false; const int kr = krlo + t - 4, w0 = clampi(qrow(wid) - 4, 0, 120); return kr < w0 || kr > w0 + 7; }
  __device__ __forceinline__ void mask(f32x16& p0, f32x16& p1, int t, int wid, int r32, int hi) const {
    if (t < 4) return;
    const int kr = krlo + t - 4, qc = 32 * (wid & 1) + r32, c0 = clampi(qc - 8, 0, 48);
    const ATT_LAS float* brow = rpbl + (kr - qrow(wid) + 7) * 31 + 15;
#pragma unroll
    for (int r = 0; r < 16; ++r) {
      { const int kc = crow(r, hi); const bool ok = kc >= c0 && kc < c0 + 16; const float bv = brow[clampi(kc - qc, -15, 15)]; p0[r] = ok ? p0[r] + bv : -INFINITY; }
      { const int kc = 32 + crow(r, hi); const bool ok = kc >= c0 && kc < c0 + 16; const float bv = brow[clampi(kc - qc, -15, 15)]; p1[r] = ok ? p1[r] + bv : -INFINITY; } }
  }
  __device__ __forceinline__ float sink(int) const { return -INFINITY; }
  __device__ __forceinline__ bf16* orow(int wid, int row) const { return O + (long)(8192 * b + 64 * qrow(wid) + 32 * (wid & 1) + row) * 1024 + 512 + 64 * h; }
};
struct UCtx {
  const bf16* QKV; bf16* O; const float* sinkp; int b, hx; int qcol, kcol, vcol, ocol;
  __device__ __forceinline__ void init() { if (hx < 8) { qcol = 64 * hx; kcol = 512 + 64 * (hx >> 2); vcol = 640 + 64 * (hx >> 2); ocol = 64 * hx; }
    else { const int h = hx - 8; qcol = 768 + 64 * h; kcol = 1280 + 64 * h; vcol = 1792 + 64 * h; ocol = 512 + 64 * h; } }
  __device__ __forceinline__ int nt() const { return 4; }
  __device__ __forceinline__ long krow(int t) const { return (long)(ROWS_LAT + 256 * b + 64 * t); }
  __device__ __forceinline__ const bf16* kptr(long row, int ch) const { return QKV + row * 2304 + kcol + ch * 8; }
  __device__ __forceinline__ const bf16* vptr(long row, int ch) const { return QKV + row * 2304 + vcol + ch * 8; }
  __device__ __forceinline__ const bf16* qptr(int wid, int r32, int d0, int hi) const { return QKV + (long)(ROWS_LAT + 256 * b + 32 * wid + r32) * 2304 + qcol + 16 * d0 + 8 * hi; }
  __device__ __forceinline__ bool skip(int, int) const { return false; }
  __device__ __forceinline__ void mask(f32x16&, f32x16&, int, int, int, int) const {}
  __device__ __forceinline__ float sink(int) const { return hx < 8 ? sinkp[hx] * LOG2E : -INFINITY; }
  __device__ __forceinline__ bf16* orow(int wid, int row) const { return O + (long)(ROWS_LAT + 256 * b + 32 * wid + row) * 1024 + ocol; }
};
struct UDense {
  const bf16* Q; const bf16* KV; const bf16* KR; bf16* O; int b, h, qb;
  __device__ __forceinline__ int nt() const { return 132; }
  __device__ __forceinline__ long krow(int t) const { return t < 4 ? (long)(ROWS_LAT + 256 * b + 64 * t) : (long)(8192 * b + 64 * (t - 4)); }
  __device__ __forceinline__ const bf16* kptr(long row, int ch) const { return ch < 8 ? KV + row * 2048 + 64 * h + ch * 8 : KR + row * 32 + (ch - 8) * 8; }
  __device__ __forceinline__ const bf16* vptr(long row, int ch) const { return KV + row * 2048 + 1024 + 64 * h + ch * 8; }
  __device__ __forceinline__ const bf16* qptr(int wid, int r32, int d0, int hi) const { const bf16* qp = Q + (long)(8192 * b + 256 * qb + 32 * wid + r32) * 1536;
    return d0 < 4 ? qp + 64 * h + 16 * d0 + 8 * hi : qp + 1024 + 32 * h + 16 * (d0 - 4) + 8 * hi; }
  __device__ __forceinline__ bool skip(int, int) const { return false; }
  __device__ __forceinline__ void mask(f32x16&, f32x16&, int, int, int, int) const {}
  __device__ __forceinline__ float sink(int) const { return -INFINITY; }
  __device__ __forceinline__ bf16* orow(int wid, int row) const { return O + (long)(8192 * b + 256 * qb + 32 * wid + row) * 1024 + 64 * h; }
};
#undef ATT_SBAR
}
namespace attd {
typedef unsigned short bf16;
using bf16x8 = __attribute__((ext_vector_type(8))) short;
using s16x4 = __attribute__((ext_vector_type(4))) short;
using f32x16 = __attribute__((ext_vector_type(16))) float;
using u32x4 = __attribute__((ext_vector_type(4))) unsigned;
using i32x2 = __attribute__((ext_vector_type(2))) int;
using i32x4 = __attribute__((ext_vector_type(4))) int;
using i32x8 = __attribute__((ext_vector_type(8))) int;
using u32x6 = __attribute__((ext_vector_type(6))) unsigned;
using u32x16 = __attribute__((ext_vector_type(16))) unsigned;
typedef __bf16 bf16x32 __attribute__((ext_vector_type(32)));
constexpr int NW = 8, NT = 132, KSLOT = 5120, VSLOT = 8192;
constexpr int LDS_K = 0, LDS_V = 3 * KSLOT, LDS_WS = LDS_V + 3 * VSLOT, LDS_OST = LDS_WS + NW * 64 * 4, LDS_BYTES = LDS_OST + NW * 4096;
__device__ __forceinline__ int crow(int r, int hi) { return (r & 3) + 8 * (r >> 2) + 4 * hi; }
#define AF_SBAR() __builtin_amdgcn_sched_barrier(0)
__device__ __forceinline__ void glds16(unsigned voff, const void* sbase, unsigned lds_dst) { unsigned keep;
  asm volatile("s_mov_b32 %0, m0\n\ts_mov_b32 m0, %3\n\ts_nop 0\n\tglobal_load_lds_dwordx4 %1, %2\n\ts_mov_b32 m0, %0" : "=&s"(keep) : "v"(voff), "s"(sbase), "s"(lds_dst) : "memory"); }
typedef float f32x2_t __attribute__((ext_vector_type(2))); typedef __bf16 bf16x2_t __attribute__((ext_vector_type(2)));
__device__ __forceinline__ unsigned cvtpk_s(float lo, float hi) { f32x2_t v = {lo, hi}; bf16x2_t b = __builtin_convertvector(v, bf16x2_t); return __builtin_bit_cast(unsigned, b); }
#define AF_WAIT_BAR(N) asm volatile("s_waitcnt vmcnt(" #N ") lgkmcnt(0)\n\ts_barrier" ::: "memory")
typedef __attribute__((address_space(3))) const char* lds_cptr;
typedef short v4i16_t __attribute__((ext_vector_type(4)));
__device__ __forceinline__ i32x8 ld6(lds_cptr p16, lds_cptr p8) { const i32x4 a = *(const __attribute__((address_space(3))) i32x4*)p16; const i32x2 b = *(const __attribute__((address_space(3))) i32x2*)p8;
  return (i32x8){a.x, a.y, a.z, a.w, b.x, b.y, 0, 0}; }
__device__ __forceinline__ s16x4 vtr(lds_cptr p) { return __builtin_bit_cast(s16x4, __builtin_amdgcn_ds_read_tr16_b64_v4i16((__attribute__((address_space(3))) v4i16_t*)p)); }
__device__ __forceinline__ long tile_row(int b, int t) { return t < 4 ? (long)(16384 + 256 * b + 64 * t) : (long)(8192 * b + 64 * (t - 4)); }
__device__ __forceinline__ u32x6 to_fp6(u32x4 a0, u32x4 a1, u32x4 a2, u32x4 a3) { const u32x16 all = {a0.x, a0.y, a0.z, a0.w, a1.x, a1.y, a1.z, a1.w, a2.x, a2.y, a2.z, a2.w, a3.x, a3.y, a3.z, a3.w};
  return __builtin_amdgcn_cvt_scalef32_pk32_fp6_bf16(__builtin_bit_cast(bf16x32, all), 1.0f); }

__device__ __forceinline__ void dense_unit(int b, int h, int qb, const bf16* Q, const bf16* __restrict__ KV, const char* __restrict__ K6N, const char* __restrict__ K6R, bf16* O, char* shm, const int tid) {
  const int lane = tid & 63, r32 = lane & 31, hi = lane >> 5; const int wid = __builtin_amdgcn_readfirstlane(tid >> 6);
  const unsigned lds0 = (unsigned)(uintptr_t)shm;
  float* wsf = (float*)(shm + LDS_WS) + wid * 64;
  const bool wnp = wid < 3 || wid >= 5; const int pc = wnp ? (wid < 3 ? wid : wid - 5) : wid - 3;
  const unsigned voffK = (unsigned)(lane * 16);
  const char* sK = wnp ? K6N + h * 3072 + pc * 1024 : K6R + pc * 1024; const long kts = wnp ? 16 * 3072 : 2048;
  const unsigned voffV = (unsigned)((16 * (wid & 3) + (lane >> 2)) * 2048 + (wid >> 2) * 32 + (lane & 3) * 8) * 2u;
  const char* sV = (const char*)(KV + 1024 + 64 * h);
  const unsigned kdst = lds0 + LDS_K + (wnp ? pc * 1024 : 3072 + pc * 1024), vdst = lds0 + LDS_V + wid * 1024;
#define AF_DMA_K(t, ks) do { const long G_ = tile_row(b, (t)) >> 6; glds16(voffK, sK + G_ * kts, (unsigned)__builtin_amdgcn_readfirstlane(kdst + (ks))); } while (0)
#define AF_DMA_V(t, vs) do { const long R_ = tile_row(b, (t)); glds16(voffV, sV + R_ * 4096, (unsigned)__builtin_amdgcn_readfirstlane(vdst + (vs))); } while (0)
  const lds_cptr shm3 = (lds_cptr)shm;
  const lds_cptr kp16 = shm3 + LDS_K + hi * 1024 + r32 * 16;
  const lds_cptr kp8 = shm3 + LDS_K + 2048 + hi * 512 + r32 * 8;
  const lds_cptr vp0 = shm3 + LDS_V + ((lane >> 4) & 1) * 32 + (lane & 3) * 8 + (4 * hi + ((lane & 15) >> 2)) * 64;
  AF_DMA_K(0, 0); AF_DMA_V(0, 0); AF_DMA_K(1, KSLOT); AF_DMA_K(2, 2 * KSLOT);
  i32x8 qn, qr;
  { const bf16* qp = Q + (long)(8192 * b + 256 * qb + 32 * wid + r32) * 1536; const bf16* qa = qp + 64 * h + 32 * hi; const bf16* qc = qp + 1024 + 32 * h;
    const u32x6 n6 = to_fp6(*reinterpret_cast<const u32x4*>(qa), *reinterpret_cast<const u32x4*>(qa + 8), *reinterpret_cast<const u32x4*>(qa + 16), *reinterpret_cast<const u32x4*>(qa + 24));
    u32x6 r6 = to_fp6(*reinterpret_cast<const u32x4*>(qc), *reinterpret_cast<const u32x4*>(qc + 8), *reinterpret_cast<const u32x4*>(qc + 16), *reinterpret_cast<const u32x4*>(qc + 24));
    if (hi) r6 = (u32x6){0u, 0u, 0u, 0u, 0u, 0u};
    qn = (i32x8){(int)n6[0], (int)n6[1], (int)n6[2], (int)n6[3], (int)n6[4], (int)n6[5], 0, 0}; qr = (i32x8){(int)r6[0], (int)r6[1], (int)r6[2], (int)r6[3], (int)r6[4], (int)r6[5], 0, 0}; }
  float l_reg = 0.f; f32x16 o[2]; o[0] = f32x16{}; o[1] = f32x16{};
  f32x16 pA0, pA1, pB0, pB1; i32x8 kn0, kn1, kr0, kr1;
  int s_prev = 0, s_cur = 0, s_next = 1;
#define AF_ROT() do { s_prev = s_cur; s_cur = s_next; s_next = (s_next == 2) ? 0 : s_next + 1; } while (0)
#define AF_MF(a, b, c) __builtin_amdgcn_mfma_f32_32x32x16_bf16(a, b, c, 0, 0, 0)
  int sck_ = 0x7b7b7b7b, scq_ = 0x7f7f7f7f; asm volatile("" : "+v"(sck_), "+v"(scq_));
#define AF_MX(a, b, c) __builtin_amdgcn_mfma_scale_f32_32x32x64_f8f6f4(a, b, c, 2, 2, 0, sck_, 0, scq_)
#define AF_EX(v) __builtin_amdgcn_exp2f(v)
  const f32x16 zero16 = f32x16{};
  AF_WAIT_BAR(0);
  { pA0 = AF_MX(ld6(kp16, kp8), qn, zero16); pA1 = AF_MX(ld6(kp16 + 512, kp8 + 256), qn, zero16);
    pA0 = AF_MX(ld6(kp16 + 3072, kp8 + 2048), qr, pA0); pA1 = AF_MX(ld6(kp16 + 3072 + 512, kp8 + 2048 + 256), qr, pA1);
#pragma unroll
    for (int r = 0; r < 16; ++r) { pA0[r] = AF_EX(pA0[r]); pA1[r] = AF_EX(pA1[r]); } }
  AF_WAIT_BAR(0);
  AF_DMA_K(3, 0); AF_DMA_V(1, VSLOT);
  AF_ROT();
  { const lds_cptr k16_ = kp16 + s_cur * KSLOT, k8_ = kp8 + s_cur * KSLOT; kn0 = ld6(k16_, k8_); kn1 = ld6(k16_ + 512, k8_ + 256); kr0 = ld6(k16_ + 3072, k8_ + 2048); kr1 = ld6(k16_ + 3072 + 512, k8_ + 2048 + 256); }
  AF_WAIT_BAR(2);
  s16x4 vlo[8], vhi[8]; u32x4 pw0, pw1, pw2, pw3;
#define AF_PKW(P, B) cvtpk_s(P[B], P[B + 1])
#define AF_PAF(k) __builtin_bit_cast(bf16x8, pw##k)
#define AF_VFR(i) (bf16x8){vlo[i][0], vlo[i][1], vlo[i][2], vlo[i][3], vhi[i][0], vhi[i][1], vhi[i][2], vhi[i][3]}
#define AF_PIN(x) asm volatile("" : "+v"(x))
#define AF_VRD(i) do { vlo[i] = vtr(vp_ + (((i) >> 2) * 4096 + ((i) & 3) * 1024)); vhi[i] = vtr(vp_ + (((i) >> 2) * 4096 + ((i) & 3) * 1024 + 512)); AF_SBAR(); } while (0)
#define AF_GB(MF, X, B) do { MF; X[B] = AF_EX(X[B]); X[B + 1] = AF_EX(X[B + 1]); X[B + 2] = AF_EX(X[B + 2]); X[B + 3] = AF_EX(X[B + 3]); AF_PIN(X); AF_SBAR(); } while (0)
#define AF_KRD(G, j) do { if (G) { const lds_cptr k16_ = kp16 + s_next * KSLOT, k8_ = kp8 + s_next * KSLOT; \
      if ((j) == 0) kn0 = ld6(k16_, k8_); if ((j) == 1) kn1 = ld6(k16_ + 512, k8_ + 256); \
      if ((j) == 2) kr0 = ld6(k16_ + 3072, k8_ + 2048); if ((j) == 3) kr1 = ld6(k16_ + 3072 + 512, k8_ + 2048 + 256); AF_SBAR(); } } while (0)
#define AF_A4(P, B) do { sacc += P[B]; sacc += P[B + 1]; sacc += P[B + 2]; sacc += P[B + 3]; } while (0)
#define AF_STEP(C0, C1, P0, P1, t, GK, GV, GL) do { AF_SBAR(); \
    const lds_cptr vp_ = vp0 + s_prev * VSLOT; \
    float sacc = (P0[0] + P0[1]); \
    AF_VRD(0); AF_VRD(4); \
    { C0 = AF_MX(kn0, qn, zero16); sacc += P0[2]; sacc += P0[3]; AF_A4(P0, 4); AF_PIN(sacc); \
      pw0[0] = AF_PKW(P0, 0); pw0[1] = AF_PKW(P0, 2); pw0[2] = AF_PKW(P0, 4); pw0[3] = AF_PKW(P0, 6); AF_PIN(pw0); AF_SBAR(); } \
    AF_VRD(1); AF_VRD(5); \
    { C1 = AF_MX(kn1, qn, zero16); AF_A4(P0, 8); AF_A4(P0, 12); AF_PIN(sacc); \
      pw1[0] = AF_PKW(P0, 8); pw1[1] = AF_PKW(P0, 10); pw1[2] = AF_PKW(P0, 12); pw1[3] = AF_PKW(P0, 14); AF_PIN(pw1); AF_SBAR(); } \
    AF_VRD(2); AF_VRD(6); \
    { C0 = AF_MX(kr0, qr, C0); AF_A4(P1, 0); AF_A4(P1, 4); AF_PIN(sacc); \
      pw2[0] = AF_PKW(P1, 0); pw2[1] = AF_PKW(P1, 2); pw2[2] = AF_PKW(P1, 4); pw2[3] = AF_PKW(P1, 6); AF_PIN(pw2); AF_SBAR(); } \
    if (GK) { AF_DMA_K((t) + 3, s_cur * KSLOT); AF_SBAR(); } \
    AF_VRD(3); AF_VRD(7); \
    { C1 = AF_MX(kr1, qr, C1); AF_A4(P1, 8); AF_A4(P1, 12); AF_PIN(sacc); \
      pw3[0] = AF_PKW(P1, 8); pw3[1] = AF_PKW(P1, 10); pw3[2] = AF_PKW(P1, 12); pw3[3] = AF_PKW(P1, 14); AF_PIN(pw3); AF_SBAR(); } \
    if (GV) { AF_DMA_V((t) + 1, s_next * VSLOT); AF_SBAR(); } \
    l_reg += sacc; \
    AF_SBAR(); \
    AF_GB(o[0] = AF_MF(AF_PAF(0), AF_VFR(0), o[0]), C0, 0);  AF_KRD(GL, 0); \
    AF_GB(o[1] = AF_MF(AF_PAF(0), AF_VFR(4), o[1]), C0, 4);  AF_KRD(GL, 1); \
    AF_GB(o[0] = AF_MF(AF_PAF(1), AF_VFR(1), o[0]), C0, 8);  AF_KRD(GL, 2); \
    AF_GB(o[1] = AF_MF(AF_PAF(1), AF_VFR(5), o[1]), C0, 12); AF_KRD(GL, 3); \
    AF_GB(o[0] = AF_MF(AF_PAF(2), AF_VFR(2), o[0]), C1, 0); \
    AF_GB(o[1] = AF_MF(AF_PAF(2), AF_VFR(6), o[1]), C1, 4); \
    AF_GB(o[0] = AF_MF(AF_PAF(3), AF_VFR(3), o[0]), C1, 8); \
    AF_GB(o[1] = AF_MF(AF_PAF(3), AF_VFR(7), o[1]), C1, 12); \
  } while (0)
  int t = 1;
  for (; t + 3 < NT; t += 2) {
    AF_STEP(pB0, pB1, pA0, pA1, t, true, true, true);     AF_WAIT_BAR(2); AF_ROT();
    AF_STEP(pA0, pA1, pB0, pB1, t + 1, true, true, true); AF_WAIT_BAR(2); AF_ROT();
  }
  AF_STEP(pB0, pB1, pA0, pA1, NT - 3, false, true, true);  AF_WAIT_BAR(1); AF_ROT();
  AF_STEP(pA0, pA1, pB0, pB1, NT - 2, false, true, true);  AF_WAIT_BAR(0); AF_ROT();
  AF_STEP(pB0, pB1, pA0, pA1, NT - 1, false, false, false);
  { float sacc = pB0[0] + pB0[1];
#pragma unroll
    for (int r = 2; r < 16; ++r) sacc += pB0[r];
#pragma unroll
    for (int r = 0; r < 16; ++r) sacc += pB1[r];
    l_reg += sacc;
    pw0 = (u32x4){AF_PKW(pB0, 0), AF_PKW(pB0, 2), AF_PKW(pB0, 4), AF_PKW(pB0, 6)}; pw1 = (u32x4){AF_PKW(pB0, 8), AF_PKW(pB0, 10), AF_PKW(pB0, 12), AF_PKW(pB0, 14)};
    pw2 = (u32x4){AF_PKW(pB1, 0), AF_PKW(pB1, 2), AF_PKW(pB1, 4), AF_PKW(pB1, 6)}; pw3 = (u32x4){AF_PKW(pB1, 8), AF_PKW(pB1, 10), AF_PKW(pB1, 12), AF_PKW(pB1, 14)};
    AF_SBAR();
    const lds_cptr vp_ = vp0 + s_cur * VSLOT;
#pragma unroll
    for (int i = 0; i < 8; ++i) { vlo[i] = vtr(vp_ + ((i >> 2) * 4096 + (i & 3) * 1024)); vhi[i] = vtr(vp_ + ((i >> 2) * 4096 + (i & 3) * 1024 + 512)); }
    o[0] = AF_MF(AF_PAF(0), AF_VFR(0), o[0]); o[1] = AF_MF(AF_PAF(0), AF_VFR(4), o[1]);
    o[0] = AF_MF(AF_PAF(1), AF_VFR(1), o[0]); o[1] = AF_MF(AF_PAF(1), AF_VFR(5), o[1]);
    o[0] = AF_MF(AF_PAF(2), AF_VFR(2), o[0]); o[1] = AF_MF(AF_PAF(2), AF_VFR(6), o[1]);
    o[0] = AF_MF(AF_PAF(3), AF_VFR(3), o[0]); o[1] = AF_MF(AF_PAF(3), AF_VFR(7), o[1]); }
  { auto rr = __builtin_amdgcn_permlane32_swap(__float_as_uint(l_reg), __float_as_uint(l_reg), false, false); l_reg = __uint_as_float(rr[0]) + __uint_as_float(rr[1]); }
  if (hi == 0) wsf[32 + r32] = l_reg; asm volatile("s_waitcnt lgkmcnt(0)" ::: "memory");
  float rli[16];
#pragma unroll
  for (int r = 0; r < 16; ++r) rli[r] = __builtin_amdgcn_rcpf(wsf[32 + crow(r, hi)]);
  bf16* Ow = O + (long)(8192 * b + 256 * qb + 32 * wid) * 1024 + 64 * h;
  { bf16* stg = (bf16*)(shm + LDS_OST) + wid * 2048;
#pragma unroll
    for (int r = 0; r < 16; ++r) { const int orow = crow(r, hi);
#pragma unroll
      for (int d0 = 0; d0 < 2; ++d0) stg[orow * 64 + d0 * 32 + r32] = (bf16)(cvtpk_s(o[d0][r] * rli[r], 0.f) & 0xffffu); }
    asm volatile("s_waitcnt lgkmcnt(0)" ::: "memory");
#pragma unroll
    for (int i = 0; i < 4; ++i) { const int row = i * 8 + (lane >> 3), ch = lane & 7; const u32x4 v = *(const u32x4*)(stg + row * 64 + ch * 8); *(u32x4*)(Ow + (long)row * 1024 + ch * 8) = v; } }
  asm volatile("s_waitcnt vmcnt(0) lgkmcnt(0)\n\ts_barrier" ::: "memory");
#undef AF_DMA_K
#undef AF_DMA_V
#undef AF_ROT
#undef AF_PKW
#undef AF_PAF
#undef AF_VFR
#undef AF_PIN
#undef AF_MF
#undef AF_MX
#undef AF_EX
#undef AF_VRD
#undef AF_GB
#undef AF_KRD
#undef AF_A4
#undef AF_STEP
}
#undef AF_SBAR
#undef AF_WAIT_BAR
}
namespace attf {
typedef unsigned short bf16;
using bf16x8 = __attribute__((ext_vector_type(8))) short;
using s16x4 = __attribute__((ext_vector_type(4))) short;
using f32x16 = __attribute__((ext_vector_type(16))) float;
using u32x4 = __attribute__((ext_vector_type(4))) unsigned;
using i32x2 = __attribute__((ext_vector_type(2))) int;
using i32x4 = __attribute__((ext_vector_type(4))) int;
using i32x8 = __attribute__((ext_vector_type(8))) int;
using u32x6 = __attribute__((ext_vector_type(6))) unsigned;
using u32x16 = __attribute__((ext_vector_type(16))) unsigned;
typedef __bf16 bf16x32 __attribute__((ext_vector_type(32)));
constexpr int NW = 8, KSLOT = 12288, VSLOT = 8192;
constexpr int LDS_K = 0, LDS_V = 3 * KSLOT, LDS_WS = LDS_V + 3 * VSLOT, LDS_OST = LDS_WS + NW * 64 * 4, LDS_RPB = LDS_OST + NW * 4096, LDS_BYTES = LDS_RPB + 2048;
__device__ __forceinline__ int crow(int r, int hi) { return (r & 3) + 8 * (r >> 2) + 4 * hi; }
#define AF_SBAR() __builtin_amdgcn_sched_barrier(0)
__device__ __forceinline__ void glds16(unsigned voff, const void* sbase, unsigned lds_dst) { unsigned keep;
  asm volatile("s_mov_b32 %0, m0\n\ts_mov_b32 m0, %3\n\ts_nop 0\n\tglobal_load_lds_dwordx4 %1, %2\n\ts_mov_b32 m0, %0" : "=&s"(keep) : "v"(voff), "s"(sbase), "s"(lds_dst) : "memory"); }
typedef float f32x2_t __attribute__((ext_vector_type(2))); typedef __bf16 bf16x2_t __attribute__((ext_vector_type(2)));
__device__ __forceinline__ unsigned cvtpk_s(float lo, float hi) { f32x2_t v = {lo, hi}; bf16x2_t b = __builtin_convertvector(v, bf16x2_t); return __builtin_bit_cast(unsigned, b); }
#define AF_WAIT_BAR(N) asm volatile("s_waitcnt vmcnt(" #N ") lgkmcnt(0)\n\ts_barrier" ::: "memory")
typedef __attribute__((address_space(3))) const char* lds_cptr;
typedef short v4i16_t __attribute__((ext_vector_type(4)));
__device__ __forceinline__ void kload2(bf16x8* kf, lds_cptr kp, int j) { kf[2 * j] = *(const __attribute__((address_space(3))) bf16x8*)(kp + j * 2048); kf[2 * j + 1] = *(const __attribute__((address_space(3))) bf16x8*)(kp + j * 2048 + 512); }
__device__ __forceinline__ i32x8 ld6(lds_cptr p16, lds_cptr p8) { const i32x4 a = *(const __attribute__((address_space(3))) i32x4*)p16; const i32x2 b = *(const __attribute__((address_space(3))) i32x2*)p8;
  const i32x4 b4 = __builtin_shufflevector(b, b, 0, 1, -1, -1); return __builtin_shufflevector(a, b4, 0, 1, 2, 3, 4, 5, -1, -1); }
__device__ __forceinline__ i32x8 to_fp6(u32x4 a0, u32x4 a1, u32x4 a2, u32x4 a3) { const u32x16 all = {a0.x, a0.y, a0.z, a0.w, a1.x, a1.y, a1.z, a1.w, a2.x, a2.y, a2.z, a2.w, a3.x, a3.y, a3.z, a3.w};
  const u32x6 c = __builtin_amdgcn_cvt_scalef32_pk32_fp6_bf16(__builtin_bit_cast(bf16x32, all), 1.0f); return __builtin_bit_cast(i32x8, __builtin_shufflevector(c, c, 0, 1, 2, 3, 4, 5, -1, -1)); }
__device__ __forceinline__ s16x4 vtr(lds_cptr p) { return __builtin_bit_cast(s16x4, __builtin_amdgcn_ds_read_tr16_b64_v4i16((__attribute__((address_space(3))) v4i16_t*)p)); }

template <int DKC, class U, bool F6 = false>
__device__ __forceinline__ void fast_unit(const U& u, char* shm, int tid) {
  static_assert(DKC == 8 || DKC == 12, "q/k dim 64 or 96"); static_assert(!F6 || DKC == 8, "fp6 logits: q/k dim 64");
  asm volatile("" : "+v"(tid));
  constexpr int ND0 = DKC / 2;
  const int lane = tid & 63, r32 = lane & 31, hi = lane >> 5; const int wid = __builtin_amdgcn_readfirstlane(tid >> 6);
  const unsigned lds0 = (unsigned)(uintptr_t)shm;
  float* wsf = (float*)(shm + LDS_WS) + wid * 64;
  const int NT = u.nt();
  const unsigned voffKA = (unsigned)(lane * u.kpitch + 8 * wid) * 2u;
  const unsigned voffKB = (unsigned)(lane * 32 + 8 * (wid & 3)) * 2u;
  const unsigned voffV = (unsigned)((16 * (wid & 3) + (lane >> 2)) * u.vpitch + (wid >> 2) * 32 + (lane & 3) * 8) * 2u;
  const unsigned kdstA = lds0 + LDS_K + wid * 1024, kdstB = lds0 + LDS_K + (8 + (wid & 3)) * 1024, vdst = lds0 + LDS_V + wid * 1024;
  const int pc6 = wid % 3; const unsigned voffK6 = (unsigned)(lane * 16), kdst6 = lds0 + LDS_K + pc6 * 1024;
#define AF_DMA_KA(t, ks) do { const long R_ = u.trow(t); if constexpr (F6) glds16(voffK6, u.k6base + (R_ >> 6) * 30720 + pc6 * 1024, (unsigned)__builtin_amdgcn_readfirstlane(kdst6 + (ks))); \
    else glds16(voffKA, (const char*)u.kbase + R_ * (2 * u.kpitch), (unsigned)__builtin_amdgcn_readfirstlane(kdstA + (ks))); } while (0)
#define AF_DMA_KB(t, ks) do { if constexpr (DKC == 12) { const long R_ = u.trow(t); glds16(voffKB, (const char*)u.krbase + R_ * 64, (unsigned)__builtin_amdgcn_readfirstlane(kdstB + (ks))); } } while (0)
#define AF_DMA_K(t, ks) do { AF_DMA_KA(t, ks); AF_DMA_KB(t, ks); } while (0)
#define AF_DMA_V(t, vs) do { const long R_ = u.trow(t); glds16(voffV, (const char*)u.vbase + R_ * (2 * u.vpitch), (unsigned)__builtin_amdgcn_readfirstlane(vdst + (vs))); } while (0)
#define AF_WAITN(NSTEPS_K, NV) do { if constexpr (DKC == 12) { if ((NSTEPS_K) == 2 && (NV) == 1) AF_WAIT_BAR(5); else if ((NSTEPS_K) == 1 && (NV) == 1) AF_WAIT_BAR(3); else if ((NV) == 1) AF_WAIT_BAR(1); else AF_WAIT_BAR(0); } \
    else { if ((NSTEPS_K) == 2 && (NV) == 1) AF_WAIT_BAR(3); else if ((NSTEPS_K) == 1 && (NV) == 1) AF_WAIT_BAR(2); else if ((NV) == 1) AF_WAIT_BAR(1); else AF_WAIT_BAR(0); } } while (0)
  const lds_cptr shm3 = (lds_cptr)shm; const lds_cptr kp0 = shm3 + LDS_K + hi * 1024 + r32 * 16;
  const lds_cptr kp8 = shm3 + LDS_K + 2048 + hi * 512 + r32 * 8;
  const lds_cptr vp0 = shm3 + LDS_V + ((lane >> 4) & 1) * 32 + (lane & 3) * 8 + (4 * hi + ((lane & 15) >> 2)) * 64;
  bf16x8 qr[ND0]; i32x8 qn;
  if constexpr (F6) { const bf16* qa = u.qptr(wid, r32, 0, 0) + 32 * hi;
    qn = to_fp6(*reinterpret_cast<const u32x4*>(qa), *reinterpret_cast<const u32x4*>(qa + 8), *reinterpret_cast<const u32x4*>(qa + 16), *reinterpret_cast<const u32x4*>(qa + 24)); }
  else {
#pragma unroll
    for (int d0 = 0; d0 < ND0; ++d0) qr[d0] = *reinterpret_cast<const bf16x8*>(u.qptr(wid, r32, d0, hi)); }
  AF_DMA_K(0, 0); AF_DMA_V(0, 0); AF_DMA_K(1, KSLOT); AF_DMA_K(2, 2 * KSLOT);
  float l_reg = 0.f; f32x16 o[2]; o[0] = f32x16{}; o[1] = f32x16{};
  f32x16 pA0, pA1, pB0, pB1; bf16x8 kf[DKC]; i32x8 kn0, kn1;
  int sck_ = 0x7b7b7b7b, scq_ = 0x7f7f7f7f; asm volatile("" : "+v"(sck_), "+v"(scq_));
#define AF_MX6(a, b, c) __builtin_amdgcn_mfma_scale_f32_32x32x64_f8f6f4(a, b, c, 2, 2, 0, sck_, 0, scq_)
  int s_prev = 0, s_cur = 0, s_next = 1;
#define AF_ROT() do { s_prev = s_cur; s_cur = s_next; s_next = (s_next == 2) ? 0 : s_next + 1; } while (0)
  AF_WAITN(2, 1);
  { const char* kb = shm + LDS_K + hi * 1024 + r32 * 16; pA0 = f32x16{}; pA1 = f32x16{};
    if constexpr (F6) { pA0 = AF_MX6(ld6(kp0, kp8), qn, pA0); pA1 = AF_MX6(ld6(kp0 + 512, kp8 + 256), qn, pA1); }
    else
#pragma unroll
    for (int d0 = 0; d0 < ND0; ++d0) { const bf16x8 b0 = *reinterpret_cast<const bf16x8*>(kb + d0 * 2048), b1 = *reinterpret_cast<const bf16x8*>(kb + d0 * 2048 + 512);
      pA0 = __builtin_amdgcn_mfma_f32_32x32x16_bf16(b0, qr[d0], pA0, 0, 0, 0); pA1 = __builtin_amdgcn_mfma_f32_32x32x16_bf16(b1, qr[d0], pA1, 0, 0, 0); }
    if constexpr (U::HAS_MASK) u.mask(pA0, pA1, 0, wid, r32, hi);
#pragma unroll
    for (int r = 0; r < 16; ++r) { pA0[r] = __builtin_amdgcn_exp2f(pA0[r]); pA1[r] = __builtin_amdgcn_exp2f(pA1[r]); } }
  AF_WAIT_BAR(0);
  AF_DMA_K(3, 0); AF_DMA_V(1, VSLOT);
  AF_ROT();
  if constexpr (F6) { kn0 = ld6(kp0 + s_cur * KSLOT, kp8 + s_cur * KSLOT); kn1 = ld6(kp0 + s_cur * KSLOT + 512, kp8 + s_cur * KSLOT + 256); }
  else {
#pragma unroll
    for (int j = 0; j < ND0; ++j) kload2(kf, kp0 + s_cur * KSLOT, j); }
  AF_WAITN(1, 1);
  s16x4 vlo[8], vhi[8]; u32x4 pw0, pw1, pw2, pw3;
#define AF_PKW(P, B) cvtpk_s(P[B], P[B + 1])
#define AF_PAF(k) __builtin_bit_cast(bf16x8, pw##k)
#define AF_VFR(i) (bf16x8){vlo[i][0], vlo[i][1], vlo[i][2], vlo[i][3], vhi[i][0], vhi[i][1], vhi[i][2], vhi[i][3]}
#define AF_PIN(x) asm volatile("" : "+v"(x))
#define AF_MF(a, b, c) __builtin_amdgcn_mfma_f32_32x32x16_bf16(a, b, c, 0, 0, 0)
#define AF_EX(v) __builtin_amdgcn_exp2f(v)
#define AF_VRD(i) do { vlo[i] = vtr(vp_ + (((i) >> 2) * 4096 + ((i) & 3) * 1024)); vhi[i] = vtr(vp_ + (((i) >> 2) * 4096 + ((i) & 3) * 1024 + 512)); AF_SBAR(); } while (0)
#define AF_GA4(MF, A0, A1, A2, A3, W0, W1, PW) do { MF; sacc += A0; sacc += A1; sacc += A2; sacc += A3; AF_PIN(sacc); W0; W1; AF_PIN(PW); AF_SBAR(); } while (0)
#define AF_GA3(MF, A0, A1, A2, W0, W1, PW) do { MF; sacc += A0; sacc += A1; sacc += A2; AF_PIN(sacc); W0; W1; AF_PIN(PW); AF_SBAR(); } while (0)
#define AF_GA2(MF, A0, A1, W0, PW) do { MF; sacc += A0; sacc += A1; AF_PIN(sacc); W0; AF_PIN(PW); AF_SBAR(); } while (0)
#define AF_GB(MF, X, B) do { MF; X[B] = AF_EX(X[B]); X[B + 1] = AF_EX(X[B + 1]); X[B + 2] = AF_EX(X[B + 2]); X[B + 3] = AF_EX(X[B + 3]); AF_PIN(X); AF_SBAR(); } while (0)
#define AF_KRD(G, j) do { if constexpr (F6) { if ((j) < 2) { if (G) { if ((j) == 0) kn0 = ld6(kp0 + s_next * KSLOT, kp8 + s_next * KSLOT); else kn1 = ld6(kp0 + s_next * KSLOT + 512, kp8 + s_next * KSLOT + 256); AF_SBAR(); } } } \
    else if ((j) < ND0) { if (G) { kload2(kf, kp0 + s_next * KSLOT, (j) < ND0 ? (j) : 0); AF_SBAR(); } } } while (0)
  const f32x16 zero16 = f32x16{};
#define AF_PHASE_A12(C0, C1, P0, P1, t, GK, GV) do { \
    AF_VRD(0); float sacc = (P0[0] + P0[1]); \
    AF_GA3(C0 = AF_MF(kf[0], qr[0], zero16), P0[2], P0[3], P0[4],     pw0[0] = AF_PKW(P0, 0), pw0[1] = AF_PKW(P0, 2), pw0); \
    AF_VRD(4); AF_GA3(C1 = AF_MF(kf[1], qr[0], zero16), P0[5], P0[6], P0[7],     pw0[2] = AF_PKW(P0, 4), pw0[3] = AF_PKW(P0, 6), pw0); \
    AF_VRD(1); AF_GA3(C0 = AF_MF(kf[2], qr[1], C0),     P0[8], P0[9], P0[10],    pw1[0] = AF_PKW(P0, 8), pw1[1] = AF_PKW(P0, 10), pw1); \
    AF_VRD(5); AF_GA3(C1 = AF_MF(kf[3], qr[1], C1),     P0[11], P0[12], P0[13],  pw1[2] = AF_PKW(P0, 12), pw1[3] = AF_PKW(P0, 14), pw1); \
    AF_VRD(2); AF_GA3(C0 = AF_MF(kf[4], qr[2], C0),     P0[14], P0[15], P1[0],   pw2[0] = AF_PKW(P1, 0), pw2[1] = AF_PKW(P1, 2), pw2); \
    AF_VRD(6); AF_GA3(C1 = AF_MF(kf[5], qr[2], C1),     P1[1], P1[2], P1[3],     pw2[2] = AF_PKW(P1, 4), pw2[3] = AF_PKW(P1, 6), pw2); \
    AF_VRD(3); AF_GA2(C0 = AF_MF(kf[6], qr[3], C0),     P1[4], P1[5],            pw3[0] = AF_PKW(P1, 8), pw3); \
    AF_VRD(7); AF_GA2(C1 = AF_MF(kf[7], qr[3], C1),     P1[6], P1[7],            pw3[1] = AF_PKW(P1, 10), pw3); \
    AF_GA2(C0 = AF_MF(kf[8 % DKC], qr[4 % ND0], C0),    P1[8], P1[9],            pw3[2] = AF_PKW(P1, 12), pw3); \
    if (GK) { AF_DMA_KA((t) + 3, s_cur * KSLOT); AF_SBAR(); } \
    AF_GA2(C1 = AF_MF(kf[9 % DKC], qr[4 % ND0], C1),    P1[10], P1[11],          pw3[3] = AF_PKW(P1, 14), pw3); \
    if (GK) { AF_DMA_KB((t) + 3, s_cur * KSLOT); AF_SBAR(); } \
    { C0 = AF_MF(kf[10 % DKC], qr[5 % ND0], C0); sacc += P1[12]; sacc += P1[13]; AF_PIN(sacc); AF_SBAR(); } \
    if (GV) { AF_DMA_V((t) + 1, s_next * VSLOT); AF_SBAR(); } \
    { C1 = AF_MF(kf[11 % DKC], qr[5 % ND0], C1); sacc += P1[14]; sacc += P1[15]; AF_PIN(sacc); AF_SBAR(); } \
    l_reg += sacc; } while (0)
#define AF_PHASE_A8(C0, C1, P0, P1, t, GK, GV) do { \
    AF_VRD(0); float sacc = (P0[0] + P0[1]); \
    AF_GA4(C0 = AF_MF(kf[0], qr[0], zero16), P0[2], P0[3], P0[4], P0[5],       pw0[0] = AF_PKW(P0, 0), pw0[1] = AF_PKW(P0, 2), pw0); \
    AF_VRD(4); AF_GA4(C1 = AF_MF(kf[1], qr[0], zero16), P0[6], P0[7], P0[8], P0[9],       pw0[2] = AF_PKW(P0, 4), pw0[3] = AF_PKW(P0, 6), pw0); \
    AF_VRD(1); AF_GA4(C0 = AF_MF(kf[2], qr[1], C0),     P0[10], P0[11], P0[12], P0[13],   pw1[0] = AF_PKW(P0, 8), pw1[1] = AF_PKW(P0, 10), pw1); \
    AF_VRD(5); AF_GA4(C1 = AF_MF(kf[3], qr[1], C1),     P0[14], P0[15], P1[0], P1[1],     pw1[2] = AF_PKW(P0, 12), pw1[3] = AF_PKW(P0, 14), pw1); \
    AF_VRD(2); AF_GA4(C0 = AF_MF(kf[4], qr[2], C0),     P1[2], P1[3], P1[4], P1[5],       pw2[0] = AF_PKW(P1, 0), pw2[1] = AF_PKW(P1, 2), pw2); \
    AF_VRD(6); AF_GA4(C1 = AF_MF(kf[5], qr[2], C1),     P1[6], P1[7], P1[8], P1[9],       pw2[2] = AF_PKW(P1, 4), pw2[3] = AF_PKW(P1, 6), pw2); \
    AF_VRD(3); AF_GA4(C0 = AF_MF(kf[6], qr[3], C0),     P1[10], P1[11], P1[12], P1[13],   pw3[0] = AF_PKW(P1, 8), pw3[1] = AF_PKW(P1, 10), pw3); \
    AF_VRD(7); AF_GA4(C1 = AF_MF(kf[7], qr[3], C1),     P1[14], P1[15], 0.f, 0.f,         pw3[2] = AF_PKW(P1, 12), pw3[3] = AF_PKW(P1, 14), pw3); \
    l_reg += sacc; \
    if (GK) { AF_DMA_KA((t) + 3, s_cur * KSLOT); } if (GV) { AF_DMA_V((t) + 1, s_next * VSLOT); } } while (0)
#define AF_A4(P, B) do { sacc += P[B]; sacc += P[B + 1]; sacc += P[B + 2]; sacc += P[B + 3]; } while (0)
#define AF_PHASE_A6(C0, C1, P0, P1, t, GK, GV) do { \
    AF_VRD(0); AF_VRD(4); float sacc = (P0[0] + P0[1]); \
    { C0 = AF_MX6(kn0, qn, zero16); sacc += P0[2]; sacc += P0[3]; AF_A4(P0, 4); AF_A4(P0, 8); AF_A4(P0, 12); AF_PIN(sacc); \
      pw0[0] = AF_PKW(P0, 0); pw0[1] = AF_PKW(P0, 2); pw0[2] = AF_PKW(P0, 4); pw0[3] = AF_PKW(P0, 6); AF_PIN(pw0); pw1[0] = AF_PKW(P0, 8); pw1[1] = AF_PKW(P0, 10); pw1[2] = AF_PKW(P0, 12); pw1[3] = AF_PKW(P0, 14); AF_PIN(pw1); AF_SBAR(); } \
    AF_VRD(1); AF_VRD(5); AF_VRD(2); AF_VRD(6); \
    { C1 = AF_MX6(kn1, qn, zero16); AF_A4(P1, 0); AF_A4(P1, 4); AF_A4(P1, 8); AF_A4(P1, 12); AF_PIN(sacc); \
      pw2[0] = AF_PKW(P1, 0); pw2[1] = AF_PKW(P1, 2); pw2[2] = AF_PKW(P1, 4); pw2[3] = AF_PKW(P1, 6); AF_PIN(pw2); pw3[0] = AF_PKW(P1, 8); pw3[1] = AF_PKW(P1, 10); pw3[2] = AF_PKW(P1, 12); pw3[3] = AF_PKW(P1, 14); AF_PIN(pw3); AF_SBAR(); } \
    AF_VRD(3); AF_VRD(7); \
    l_reg += sacc; \
    if (GK) { AF_DMA_KA((t) + 3, s_cur * KSLOT); } if (GV) { AF_DMA_V((t) + 1, s_next * VSLOT); } } while (0)
#define AF_STEP(C0, C1, P0, P1, t, GK, GV, GL) do { AF_SBAR(); \
    const lds_cptr vp_ = vp0 + s_prev * VSLOT; \
    if constexpr (F6) AF_PHASE_A6(C0, C1, P0, P1, t, GK, GV); else if constexpr (DKC == 12) AF_PHASE_A12(C0, C1, P0, P1, t, GK, GV); else AF_PHASE_A8(C0, C1, P0, P1, t, GK, GV); \
    if constexpr (U::HAS_MASK) u.mask(C0, C1, (t), wid, r32, hi); \
    AF_SBAR(); \
    AF_GB(o[0] = AF_MF(AF_PAF(0), AF_VFR(0), o[0]), C0, 0);  AF_KRD(GL, 0); \
    AF_GB(o[1] = AF_MF(AF_PAF(0), AF_VFR(4), o[1]), C0, 4);  AF_KRD(GL, 1); \
    AF_GB(o[0] = AF_MF(AF_PAF(1), AF_VFR(1), o[0]), C0, 8);  AF_KRD(GL, 2); \
    AF_GB(o[1] = AF_MF(AF_PAF(1), AF_VFR(5), o[1]), C0, 12); AF_KRD(GL, 3); \
    AF_GB(o[0] = AF_MF(AF_PAF(2), AF_VFR(2), o[0]), C1, 0);  AF_KRD(GL, 4); \
    AF_GB(o[1] = AF_MF(AF_PAF(2), AF_VFR(6), o[1]), C1, 4);  AF_KRD(GL, 5); \
    AF_GB(o[0] = AF_MF(AF_PAF(3), AF_VFR(3), o[0]), C1, 8); \
    AF_GB(o[1] = AF_MF(AF_PAF(3), AF_VFR(7), o[1]), C1, 12); \
  } while (0)
  int t = 1;
  for (; t + 3 < NT; t += 2) {
    AF_STEP(pB0, pB1, pA0, pA1, t, true, true, true);     AF_WAITN(1, 1); AF_ROT();
    AF_STEP(pA0, pA1, pB0, pB1, t + 1, true, true, true); AF_WAITN(1, 1); AF_ROT();
  }
  AF_STEP(pB0, pB1, pA0, pA1, NT - 3, false, true, true);  AF_WAITN(0, 1); AF_ROT();
  AF_STEP(pA0, pA1, pB0, pB1, NT - 2, false, true, true);  AF_WAIT_BAR(0); AF_ROT();
  AF_STEP(pB0, pB1, pA0, pA1, NT - 1, false, false, false);
  { float sacc = pB0[0] + pB0[1];
#pragma unroll
    for (int r = 2; r < 16; ++r) sacc += pB0[r];
#pragma unroll
    for (int r = 0; r < 16; ++r) sacc += pB1[r];
    l_reg += sacc;
    pw0 = (u32x4){AF_PKW(pB0, 0), AF_PKW(pB0, 2), AF_PKW(pB0, 4), AF_PKW(pB0, 6)}; pw1 = (u32x4){AF_PKW(pB0, 8), AF_PKW(pB0, 10), AF_PKW(pB0, 12), AF_PKW(pB0, 14)};
    pw2 = (u32x4){AF_PKW(pB1, 0), AF_PKW(pB1, 2), AF_PKW(pB1, 4), AF_PKW(pB1, 6)}; pw3 = (u32x4){AF_PKW(pB1, 8), AF_PKW(pB1, 10), AF_PKW(pB1, 12), AF_PKW(pB1, 14)};
    AF_SBAR();
    const lds_cptr vp_ = vp0 + s_cur * VSLOT;
#pragma unroll
    for (int i = 0; i < 8; ++i) { vlo[i] = vtr(vp_ + ((i >> 2) * 4096 + (i & 3) * 1024)); vhi[i] = vtr(vp_ + ((i >> 2) * 4096 + (i & 3) * 1024 + 512)); }
    o[0] = AF_MF(AF_PAF(0), AF_VFR(0), o[0]); o[1] = AF_MF(AF_PAF(0), AF_VFR(4), o[1]);
    o[0] = AF_MF(AF_PAF(1), AF_VFR(1), o[0]); o[1] = AF_MF(AF_PAF(1), AF_VFR(5), o[1]);
    o[0] = AF_MF(AF_PAF(2), AF_VFR(2), o[0]); o[1] = AF_MF(AF_PAF(2), AF_VFR(6), o[1]);
    o[0] = AF_MF(AF_PAF(3), AF_VFR(3), o[0]); o[1] = AF_MF(AF_PAF(3), AF_VFR(7), o[1]); }
  { auto rr = __builtin_amdgcn_permlane32_swap(__float_as_uint(l_reg), __float_as_uint(l_reg), false, false); l_reg = __uint_as_float(rr[0]) + __uint_as_float(rr[1]); }
  l_reg += __builtin_amdgcn_exp2f(u.sink(wid));
  if (hi == 0) wsf[32 + r32] = l_reg; asm volatile("s_waitcnt lgkmcnt(0)" ::: "memory");
  float rli[16];
#pragma unroll
  for (int r = 0; r < 16; ++r) rli[r] = __builtin_amdgcn_rcpf(wsf[32 + crow(r, hi)]);
  bf16* Ow = u.orow0(wid);
  { bf16* stg = (bf16*)(shm + LDS_OST) + wid * 2048;
#pragma unroll
    for (int r = 0; r < 16; ++r) { const int orow = crow(r, hi);
#pragma unroll
      for (int d0 = 0; d0 < 2; ++d0) stg[orow * 64 + d0 * 32 + r32] = (bf16)(cvtpk_s(o[d0][r] * rli[r], 0.f) & 0xffffu); }
    asm volatile("s_waitcnt lgkmcnt(0)" ::: "memory");
#pragma unroll
    for (int i = 0; i < 4; ++i) { const int row = i * 8 + (lane >> 3), ch = lane & 7; const u32x4 v = *(const u32x4*)(stg + row * 64 + ch * 8); *(u32x4*)(Ow + (long)row * 1024 + ch * 8) = v; } }
  asm volatile("s_waitcnt vmcnt(0) lgkmcnt(0)\n\ts_barrier" ::: "memory");
#undef AF_DMA_KA
#undef AF_DMA_KB
#undef AF_DMA_K
#undef AF_DMA_V
#undef AF_WAITN
#undef AF_ROT
#undef AF_PKW
#undef AF_PAF
#undef AF_VFR
#undef AF_PIN
#undef AF_MF
#undef AF_EX
#undef AF_VRD
#undef AF_GA4
#undef AF_GA3
#undef AF_GA2
#undef AF_GB
#undef AF_KRD
#undef AF_PHASE_A12
#undef AF_PHASE_A8
#undef AF_PHASE_A6
#undef AF_A4
#undef AF_MX6
#undef AF_STEP
}

constexpr int ROWS_LAT = 16384;
constexpr float LOG2E_ = 1.4426950408889634f;
__device__ __forceinline__ int clampi(int v, int lo, int hi_) { return v < lo ? lo : (v > hi_ ? hi_ : v); }
struct FDense {
  static constexpr bool HAS_MASK = false;
  const bf16* Q; const bf16* kbase; const bf16* vbase; const bf16* krbase; bf16* O; int b, h, qb; static constexpr int kpitch = 2048, vpitch = 2048; const char* k6base = nullptr;
  __device__ __forceinline__ void init(const bf16* Q_, const bf16* KV, const bf16* KR, bf16* O_, int b_, int h_, int qb_) { Q = Q_; kbase = KV + 64 * h_; vbase = KV + 1024 + 64 * h_; krbase = KR; O = O_; b = b_; h = h_; qb = qb_; }
  __device__ __forceinline__ int nt() const { return 132; }
  __device__ __forceinline__ long trow(int t) const { return t < 4 ? (long)(ROWS_LAT + 256 * b + 64 * t) : (long)(8192 * b + 64 * (t - 4)); }
  __device__ __forceinline__ const bf16* qptr(int wid, int r32, int d0, int hi) const { const bf16* qp = Q + (long)(8192 * b + 256 * qb + 32 * wid + r32) * 1536;
    return d0 < 4 ? qp + 64 * h + 16 * d0 + 8 * hi : qp + 1024 + 32 * h + 16 * (d0 - 4) + 8 * hi; }
  __device__ __forceinline__ void mask(f32x16&, f32x16&, int, int, int, int) const {}
  __device__ __forceinline__ float sink(int) const { return -INFINITY; }
  __device__ __forceinline__ bf16* orow0(int wid) const { return O + (long)(8192 * b + 256 * qb + 32 * wid) * 1024 + 64 * h; }
};
struct FWin {
  static constexpr bool HAS_MASK = true; static constexpr int kpitch = 2304, vpitch = 2304;
  const bf16* QKV; const bf16* kbase; const bf16* vbase; const bf16* krbase; bf16* O; const float* sinkp; int b, n, g, hh, i0, cnt; const char* k6base;
  __device__ __forceinline__ void init(const bf16* QKV_, bf16* O_, const float* sk, int b_, int n_, int g_, int hh_, const char* K6E = nullptr) { QKV = QKV_; O = O_; sinkp = sk; b = b_; n = n_; g = g_; hh = hh_; krbase = nullptr; k6base = K6E + g_ * 3072;
    kbase = QKV_ + 512 + 64 * g_; vbase = QKV_ + 640 + 64 * g_; i0 = (n_ == 0) ? 2 : 0; cnt = (n_ == 0 || n_ == 63) ? 4 : 6; }
  __device__ __forceinline__ int nt() const { return 4 + cnt; }
  __device__ __forceinline__ int kpos0(int t) const { return 128 * (n - 1) + 64 * (i0 + t - 4); }
  __device__ __forceinline__ long trow(int t) const { return t < 4 ? (long)(ROWS_LAT + 256 * b + 64 * t) : (long)(8192 * b + kpos0(t)); }
  __device__ __forceinline__ int head(int wid) const { return 4 * g + 2 * hh + (wid >> 2); }
  __device__ __forceinline__ int qpos0(int wid) const { return 128 * n + 32 * (wid & 3); }
  __device__ __forceinline__ const bf16* qptr(int wid, int r32, int d0, int hi) const { return QKV + (long)(8192 * b + qpos0(wid) + r32) * 2304 + 64 * head(wid) + 16 * d0 + 8 * hi; }
  __device__ __forceinline__ void mask(f32x16& p0, f32x16& p1, int t, int wid, int r32, int hi) const {
    if (t < 4) return;
    const int k0 = kpos0(t), q0 = qpos0(wid);
    if (k0 - (q0 + 31) >= -128 && k0 + 63 - q0 <= 128) return;
    asm volatile("" : "+v"(r32), "+v"(hi));
    const int dq = k0 - (q0 + r32);
#pragma unroll
    for (int r = 0; r < 16; ++r) { const int d = dq + crow(r, hi); if (d > 128 || d < -128) p0[r] = -INFINITY; if (d + 32 > 128 || d + 32 < -128) p1[r] = -INFINITY; }
  }
  __device__ __forceinline__ float sink(int wid) const { return sinkp[head(wid)] * LOG2E_; }
  __device__ __forceinline__ bf16* orow0(int wid) const { return O + (long)(8192 * b + qpos0(wid)) * 1024 + 64 * head(wid); }
};
struct FNa {
  static constexpr bool HAS_MASK = true; static constexpr int kpitch = 2304, vpitch = 2304;
  const bf16* QKV; const bf16* kbase; const bf16* vbase; const bf16* krbase; bf16* O; const float* rpbl; int b, h, R4, krlo, nloc; const char* k6base;
  __device__ __forceinline__ void init(const bf16* QKV_, bf16* O_, const float* rpbl_, int b_, int h_, int R4_, const char* K6E = nullptr) { QKV = QKV_; O = O_; rpbl = rpbl_; b = b_; h = h_; R4 = R4_; krbase = nullptr; k6base = K6E + (2 + h_) * 3072;
    kbase = QKV_ + 1280 + 64 * h_; vbase = QKV_ + 1792 + 64 * h_; krlo = clampi(4 * R4_ - 4, 0, 120); nloc = clampi(4 * R4_ - 1, 0, 120) + 7 - krlo + 1; }
  __device__ __forceinline__ int nt() const { return (4 + nloc + 1) & ~1; }
  __device__ __forceinline__ long trow(int t) const { return (t < 4 || t >= 4 + nloc) ? (long)(ROWS_LAT + 256 * b + 64 * (t & 3)) : (long)(8192 * b + 64 * (krlo + t - 4)); }
  __device__ __forceinline__ int qrow(int wid) const { return 4 * R4 + (wid >> 1); }
  __device__ __forceinline__ const bf16* qptr(int wid, int r32, int d0, int hi) const { return QKV + (long)(8192 * b + 64 * qrow(wid) + 32 * (wid & 1) + r32) * 2304 + 768 + 64 * h + 16 * d0 + 8 * hi; }
  __device__ __forceinline__ void mask(f32x16& p0, f32x16& p1, int t, int wid, int r32, int hi) const {
    if (t < 4) return;
    const int kr = krlo + t - 4, w0 = clampi(qrow(wid) - 4, 0, 120);
    if (t >= 4 + nloc || kr < w0 || kr > w0 + 7) {
#pragma unroll
      for (int r = 0; r < 16; ++r) { p0[r] = -INFINITY; p1[r] = -INFINITY; }
      return; }
    asm volatile("" : "+v"(r32), "+v"(hi));
    const int qc = 32 * (wid & 1) + r32, c0 = clampi(qc - 8, 0, 48);
    const float* pb = rpbl + (kr - qrow(wid) + 7) * 31 + 15 - qc + 4 * hi;
    const unsigned t0 = (unsigned)(4 * hi - c0);
#define AF_PIN16(a) asm volatile("" : "+v"(a[0]), "+v"(a[1]), "+v"(a[2]), "+v"(a[3]), "+v"(a[4]), "+v"(a[5]), "+v"(a[6]), "+v"(a[7]), "+v"(a[8]), "+v"(a[9]), "+v"(a[10]), "+v"(a[11]), "+v"(a[12]), "+v"(a[13]), "+v"(a[14]), "+v"(a[15]))
    float bv[16];
#pragma unroll
    for (int r = 0; r < 16; ++r) bv[r] = pb[(r & 3) + 8 * (r >> 2)];
    AF_PIN16(bv);
#pragma unroll
    for (int r = 0; r < 16; ++r) { const bool ok = (t0 + (unsigned)((r & 3) + 8 * (r >> 2))) < 16u; p0[r] = ok ? p0[r] + bv[r] : -INFINITY; }
#pragma unroll
    for (int r = 0; r < 16; ++r) bv[r] = pb[32 + (r & 3) + 8 * (r >> 2)];
    AF_PIN16(bv);
#pragma unroll
    for (int r = 0; r < 16; ++r) { const bool ok = (t0 + (unsigned)(32 + (r & 3) + 8 * (r >> 2))) < 16u; p1[r] = ok ? p1[r] + bv[r] : -INFINITY; }
#undef AF_PIN16
  }
  __device__ __forceinline__ float sink(int) const { return -INFINITY; }
  __device__ __forceinline__ bf16* orow0(int wid) const { return O + (long)(8192 * b + 64 * qrow(wid) + 32 * (wid & 1)) * 1024 + 512 + 64 * h; }
};
struct FCtx {
  static constexpr bool HAS_MASK = false; static constexpr int kpitch = 2304, vpitch = 2304;
  const bf16* QKV; const bf16* kbase; const bf16* vbase; const bf16* krbase; bf16* O; const float* sinkp; int b, hx, qcol, ocol; const char* k6base;
  __device__ __forceinline__ void init(const bf16* QKV_, bf16* O_, const float* sk, int b_, int hx_, const char* K6E = nullptr) { QKV = QKV_; O = O_; sinkp = sk; b = b_; hx = hx_; krbase = nullptr; k6base = K6E + (hx_ < 8 ? (hx_ >> 2) : 2 + (hx_ - 8)) * 3072;
    if (hx_ < 8) { qcol = 64 * hx_; kbase = QKV_ + 512 + 64 * (hx_ >> 2); vbase = QKV_ + 640 + 64 * (hx_ >> 2); ocol = 64 * hx_; }
    else { const int h = hx_ - 8; qcol = 768 + 64 * h; kbase = QKV_ + 1280 + 64 * h; vbase = QKV_ + 1792 + 64 * h; ocol = 512 + 64 * h; } }
  __device__ __forceinline__ int nt() const { return 4; }
  __device__ __forceinline__ long trow(int t) const { return (long)(ROWS_LAT + 256 * b + 64 * (t & 3)); }
  __device__ __forceinline__ const bf16* qptr(int wid, int r32, int d0, int hi) const { return QKV + (long)(ROWS_LAT + 256 * b + 32 * wid + r32) * 2304 + qcol + 16 * d0 + 8 * hi; }
  __device__ __forceinline__ void mask(f32x16&, f32x16&, int, int, int, int) const {}
  __device__ __forceinline__ float sink(int) const { return hx < 8 ? sinkp[hx] * LOG2E_ : -INFINITY; }
  __device__ __forceinline__ bf16* orow0(int wid) const { return O + (long)(ROWS_LAT + 256 * b + 32 * wid) * 1024 + ocol; }
};
#undef AF_SBAR
#undef AF_WAIT_BAR
}
constexpr int NWAVES = 8;
#ifndef MK_PER_PHASE
#define MK_PER_PHASE 0
#endif
constexpr int BATCH = 2, SEQ = 8192, DM = 1024, CTXL = 256, FF = 4096;
constexpr int ML = BATCH * SEQ, MC = BATCH * CTXL, MR = ML + MC;
constexpr int NQKV = 2304, NCIN = 768, NUQ = 1536, NUKV = 2048;
constexpr float NORM_EPS = 1e-6f;
constexpr int ADA_KS = 16;
constexpr size_t MiB = 1u << 20;
constexpr size_t WS_CTL = 0, CTL_ZERO_BYTES = 64 * 1024;
constexpr size_t WS_MODP = 1 * MiB;
constexpr size_t WS_MOD = 3 * MiB + 512 * 1024;
constexpr size_t WS_ROPE = 3 * MiB + 768 * 1024;
constexpr size_t WS_ROPEP = WS_ROPE + 64 * 1024;
constexpr size_t WS_HPAR = WS_ROPE + 32 * 1024;
constexpr size_t WS_CTXRES = 4 * MiB;
constexpr size_t WS_WQKV = 6 * MiB, WS_WO0 = WS_WQKV + 4608 * 1024, WS_W1_0 = WS_WO0 + 2 * MiB, WS_W2_0 = WS_W1_0 + 8 * MiB, WS_W1_1 = WS_W2_0 + 8 * MiB, WS_W2_1 = WS_W1_1 + 8 * MiB;
constexpr size_t WS_WIN = WS_W2_1 + 8 * MiB, WS_WUQ = WS_WIN + 1536 * 1024, WS_WUKV = WS_WUQ + 1152 * 1024, WS_WO1 = WS_WUKV + 1 * MiB, WS_WEND = WS_WO1 + 2 * MiB;
constexpr size_t WS_AR = 51 * MiB;
static_assert(WS_WEND <= WS_AR, "weights overlap the arena");
constexpr size_t WS_XN = WS_AR, WS_H = WS_AR + 33 * MiB;
constexpr size_t WS_QKV = WS_AR + 33 * MiB, WS_O0 = WS_AR + 108 * MiB;
constexpr size_t WS_CQKV = WS_AR + 33 * MiB, WS_CQN = WS_AR + 58 * MiB, WS_CKVN = WS_AR + 71 * MiB, WS_KR = WS_AR + 80 * MiB, WS_Q1 = WS_AR + 82 * MiB, WS_KV1 = WS_AR + 130 * MiB, WS_O1 = WS_AR;
constexpr size_t WS_K6E = WS_AR + 150 * MiB;
constexpr size_t WS_K6N = WS_AR + 34 * MiB, WS_K6R = WS_AR + 48 * MiB;
constexpr size_t WS_PART5 = WS_AR + 33 * MiB;
constexpr size_t WS_XR = WS_AR + 166 * MiB;
constexpr size_t WS_PART8 = WS_AR + 166 * MiB;
constexpr size_t WS_END = 256 * MiB;
static_assert(WS_PART8 + (size_t)16 * 512 * 1024 * 4 <= WS_END && WS_KV1 + (size_t)MR * NUKV * 2 <= WS_END && WS_H + (size_t)MR * FF * 2 <= WS_END, "d_ws map");
constexpr int CW_BAR = 4096;
constexpr int RING_OFF = 0, RING_BYTES = 131072;
constexpr int LDSCTL_OFF = RING_BYTES, MISC_OFF = LDSCTL_OFF + 320;
constexpr int LDS_BYTES = 147456;
static_assert(att::L_END <= RING_BYTES && attf::LDS_BYTES <= RING_BYTES, "attention LDS");

#define GAS __attribute__((address_space(1)))
#define LAS __attribute__((address_space(3)))
typedef unsigned short bf16;
typedef unsigned v4u __attribute__((ext_vector_type(4)));
typedef unsigned v2u __attribute__((ext_vector_type(2)));
typedef float f32x4 __attribute__((ext_vector_type(4)));
typedef GAS unsigned gu32;
#define RLX_AGENT __ATOMIC_RELAXED, __HIP_MEMORY_SCOPE_AGENT
#define LDS_WAIT() asm volatile("s_waitcnt lgkmcnt(0)" ::: "memory")
#define VM_WAIT() asm volatile("s_waitcnt vmcnt(0)" ::: "memory")
__device__ __forceinline__ unsigned f2bf(float f) { unsigned u = __builtin_bit_cast(unsigned, f); return (u + 0x7fffu + ((u >> 16) & 1u)) >> 16; }
__device__ __forceinline__ unsigned pk2(float lo, float hi) { return f2bf(lo) | (f2bf(hi) << 16); }
__device__ __forceinline__ float bf2f(unsigned short h) { return __builtin_bit_cast(float, (unsigned)h << 16); }
__device__ __forceinline__ float bflo(unsigned w) { return __builtin_bit_cast(float, w << 16); }
__device__ __forceinline__ float bfhi(unsigned w) { return __builtin_bit_cast(float, w & 0xffff0000u); }

#define XB_TMO      128
#define XB_XCNT(j)  (256  + 64 * (j))
#define XB_XSUB(j)  (1280 + 64 * (j))
#define XB_XGEN(j)  (2304 + 64 * (j))
#define XB_TOP      3328
#define XB_TOPGEN   3392
#define XCD_BAR_WORDS 3456
#define XB_SPIN_CAP (1u << 18)

__device__ __forceinline__ unsigned xb_ld(unsigned* p)              { return __hip_atomic_load(p, __ATOMIC_RELAXED, __HIP_MEMORY_SCOPE_AGENT); }
__device__ __forceinline__ unsigned xb_add(unsigned* p, unsigned v) { return __hip_atomic_fetch_add(p, v, __ATOMIC_RELAXED, __HIP_MEMORY_SCOPE_AGENT); }
__device__ __forceinline__ unsigned xb_xcc_id() { return (unsigned)__builtin_amdgcn_s_getreg((3 << 11) | 20) & 0xFu; }
#define XB_SPIN(cond, bar) do { unsigned _sp = 0; while (cond) { __builtin_amdgcn_s_sleep(1); \
    if ((++_sp & 255u) == 0u) { if (xb_ld(&(bar)[XB_TMO])) break; if (_sp > XB_SPIN_CAP) { atomicAdd(&(bar)[XB_TMO], 1u); break; } } } } while (0)

struct XcdBarrier {
    unsigned* bar; unsigned x;
    volatile LAS unsigned* st;
};

__device__ __forceinline__ XcdBarrier xcd_barrier_post(unsigned* bar, volatile LAS unsigned* st) {
    XcdBarrier b; b.bar = bar; b.x = xb_xcc_id(); b.st = st;
    if (threadIdx.x == 0) (void)xb_add(&bar[XB_XCNT(b.x)], 1u);
    return b;
}
__device__ __forceinline__ void xcd_barrier_complete(unsigned* bar, unsigned x, unsigned& nloc, unsigned& nx) {
    const unsigned G = gridDim.x * gridDim.y * gridDim.z;
    unsigned sum, cnt, mine, sp = 0u;
    for (;;) {
        sum = 0u; cnt = 0u; mine = 0u;
#pragma unroll
        for (unsigned j = 0; j < 16; ++j) { const unsigned c = xb_ld(&bar[XB_XCNT(j)]); sum += c; cnt += (c > 0u) ? 1u : 0u; mine = (j == x) ? c : mine; }
        if (sum == G) break;
        __builtin_amdgcn_s_sleep(1);
        if ((++sp & 255u) == 0u) { if (xb_ld(&bar[XB_TMO])) break; if (sp > XB_SPIN_CAP) { atomicAdd(&bar[XB_TMO], 1u); break; } }
    }
    nloc = mine > 0u ? mine : 1u; nx = cnt > 0u ? cnt : 1u;
}

__device__ __forceinline__ void xcd_barrier(const XcdBarrier& b) {
    asm volatile("s_waitcnt vmcnt(0)" ::: "memory");
    __syncthreads();
    if (threadIdx.x == 0) {
        unsigned* bar = b.bar;
        __builtin_amdgcn_s_waitcnt(0);
        unsigned nloc = b.st[0], nx = b.st[1];
        if (nloc == 0u) { xcd_barrier_complete(bar, b.x, nloc, nx); b.st[0] = nloc; b.st[1] = nx; }
        const unsigned old = xb_add(&bar[XB_XSUB(b.x)], 1u);
        const unsigned gen = old / nloc;
        if (old + 1u == (gen + 1u) * nloc) {
            __builtin_amdgcn_fence(__ATOMIC_RELEASE, "agent");
            asm volatile("s_waitcnt vmcnt(0)" ::: "memory");
            const unsigned og = xb_add(&bar[XB_TOP], 1u);
            const unsigned tg = og / nx;
            if (og + 1u == (tg + 1u) * nx) xb_add(&bar[XB_TOPGEN], 1u);
            else XB_SPIN(xb_ld(&bar[XB_TOPGEN]) == tg, bar);
            __builtin_amdgcn_fence(__ATOMIC_ACQUIRE, "agent");
            xb_add(&bar[XB_XGEN(b.x)], 1u);
            asm volatile("s_waitcnt vmcnt(0)" ::: "memory");
        } else {
            XB_SPIN(xb_ld(&bar[XB_XGEN(b.x)]) == gen, bar);
            __builtin_amdgcn_fence(__ATOMIC_ACQUIRE, "agent");
            asm volatile("s_waitcnt vmcnt(0)" ::: "memory");
        }
    }
    __syncthreads();
}


template <int K> __device__ __forceinline__ const float* ldarg() {
    auto ka = __builtin_amdgcn_kernarg_segment_ptr();
    const __attribute__((address_space(1))) float* p; asm volatile("s_load_dwordx2 %0, %1, %2\n\ts_waitcnt lgkmcnt(0)" : "=s"(p) : "s"(ka), "i"(K * 8) : "memory"); return (const float*)p;
}
#define ARG(k) (ldarg<k>())
#define ARG_OUT ((float*)ldarg<28>())
#define ARG_WS ((unsigned char*)ldarg<29>())
struct Frame {
    LAS unsigned char* lds;
    volatile LAS unsigned* MISC;
    gu32* ctl;
    int tid, lane, wave;
    int vcu, G, bx;
    float* out; unsigned char* ws;
};
__device__ __forceinline__ float shx(float v, int mask, int lane) { return __builtin_bit_cast(float, __builtin_amdgcn_ds_bpermute((lane ^ mask) << 2, __builtin_bit_cast(int, v))); }
__device__ __forceinline__ float wave_sum(float v, int lane) {
    (void)lane;
#define WS_ROR(x, n) __builtin_bit_cast(float, __builtin_amdgcn_update_dpp(0, __builtin_bit_cast(int, x), 0x120 | (n), 0xf, 0xf, false))
    v += WS_ROR(v, 8); v += WS_ROR(v, 4); v += WS_ROR(v, 2); v += WS_ROR(v, 1);
#undef WS_ROR
    const int b = __builtin_bit_cast(int, v);
    return (__builtin_bit_cast(float, __builtin_amdgcn_readlane(b, 0)) + __builtin_bit_cast(float, __builtin_amdgcn_readlane(b, 16))) + (__builtin_bit_cast(float, __builtin_amdgcn_readlane(b, 32)) + __builtin_bit_cast(float, __builtin_amdgcn_readlane(b, 48)));
}
__device__ __forceinline__ unsigned pk4f8(float a, float b, float c, float d) { int w = 0; w = __builtin_amdgcn_cvt_pk_fp8_f32(a, b, w, false); w = __builtin_amdgcn_cvt_pk_fp8_f32(c, d, w, true); return (unsigned)w; }
__device__ __forceinline__ void p0_transpose_item(const float* W, int K, int N, bf16* WT, int pmode, LAS float* scr, int item, int lane, bool f8 = false) {
    const int nblk = N / 32, kb = item / nblk, nb = item % nblk, k0 = 64 * kb, n0 = 32 * nb;
    int r0 = n0;
    if (pmode == 1) { const int h = n0 / 96, d = n0 % 96; r0 = d < 64 ? h * 64 + d : 1024 + h * 32 + (d - 64); }
    else if (pmode == 2) { const int h = n0 / 128, d = n0 % 128; r0 = d < 64 ? h * 64 + d : 1024 + h * 64 + (d - 64); }
#pragma unroll 8
    for (int i = 0; i < 32; ++i) { const int kk = 2 * i + (lane >> 5); scr[kk * 33 + (lane & 31)] = W[(size_t)(k0 + kk) * N + n0 + (lane & 31)]; }
    LDS_WAIT(); asm volatile("" ::: "memory");
    const int c = lane & 7;
#pragma unroll
    for (int j = 0; j < 4; ++j) { const int n = (lane >> 3) + 8 * j; const LAS float* s = scr + (8 * c) * 33 + n;
        if (f8) {
            v2u o; o.x = pk4f8(s[0 * 33] * 32.f, s[1 * 33] * 32.f, s[2 * 33] * 32.f, s[3 * 33] * 32.f); o.y = pk4f8(s[4 * 33] * 32.f, s[5 * 33] * 32.f, s[6 * 33] * 32.f, s[7 * 33] * 32.f);
            *(GAS v2u*)((unsigned char*)WT + (size_t)(r0 + n) * K + k0 + 8 * c) = o; continue; }
        v4u o; o.x = pk2(s[0 * 33], s[1 * 33]); o.y = pk2(s[2 * 33], s[3 * 33]); o.z = pk2(s[4 * 33], s[5 * 33]); o.w = pk2(s[6 * 33], s[7 * 33]);
        *(GAS v4u*)(WT + (size_t)(r0 + n) * K + k0 + 8 * c) = o; }
    LDS_WAIT(); asm volatile("" ::: "memory");
}
__device__ __forceinline__ float silu_f(float v) { return v / (1.f + __expf(-v)); }

__device__ __forceinline__ void p0_prologue(Frame& F) {
    LAS float* scr = (LAS float*)(F.lds + RING_OFF + F.wave * 16384);
    const float* c = ARG(1); const float* cctx = ARG(3);
    if (F.wave >= 5) {
        for (int it = F.vcu * 3 + (F.wave - 5); it < 2 * 24 * ADA_KS; it += F.G * 3) {
            const int l = it / (24 * ADA_KS), rem = it % (24 * ADA_KS), cg = rem / ADA_KS, ks = rem % ADA_KS;
            const float* W = ARG(4) + (size_t)l * DM * 6144 + cg * 256 + 4 * F.lane;
            f32x4 a0 = {0.f, 0.f, 0.f, 0.f}, a1 = a0, a2 = a0;
            const int kbeg = ks * (DM / ADA_KS);
#pragma unroll 8
            for (int k = kbeg; k < kbeg + DM / ADA_KS; ++k) {
                const f32x4 w = *(const GAS f32x4*)(W + (size_t)k * 6144);
                const float s0 = silu_f(c[k]), s1 = silu_f(c[DM + k]), s2 = silu_f(cctx[k]);
                a0 += w * s0; a1 += w * s1; a2 += w * s2;
            }
            float* P = (float*)(F.ws + WS_MODP) + ((size_t)(ks * 2 + l) * 3) * 6144 + cg * 256 + 4 * F.lane;
            *(GAS f32x4*)(P) = a0; *(GAS f32x4*)(P + 6144) = a1; *(GAS f32x4*)(P + 2 * 6144) = a2;
        }
    } else {
        const int gw = F.vcu * 5 + F.wave, NGW = F.G * 5;
        constexpr int I_QKV = 16 * 72, I_O = 16 * 32, I_1 = 16 * 128, I_2 = 64 * 32, I_IN = 16 * 21, I_UQ = 6 * 48, I_UKV = 4 * 64;
        constexpr int NITEMS = I_QKV + I_O + 2 * I_1 + 2 * I_2 + I_IN + I_UQ + I_UKV + I_O;
        for (int it = gw; it < NITEMS; it += NGW) {
            int r = it;
            if (r < I_QKV) { p0_transpose_item(ARG(10), DM, NQKV, (bf16*)(F.ws + WS_WQKV), 0, scr, r, F.lane, true); continue; } r -= I_QKV;
            if (r < I_O) { p0_transpose_item(ARG(11), DM, DM, (bf16*)(F.ws + WS_WO0), 0, scr, r, F.lane); continue; } r -= I_O;
            if (r < I_1) { p0_transpose_item(ARG(8), DM, FF, (bf16*)(F.ws + WS_W1_0), 0, scr, r, F.lane); continue; } r -= I_1;
            if (r < I_1) { p0_transpose_item(ARG(8) + (size_t)DM * FF, DM, FF, (bf16*)(F.ws + WS_W1_1), 0, scr, r, F.lane); continue; } r -= I_1;
            if (r < I_2) { p0_transpose_item(ARG(9), FF, DM, (bf16*)(F.ws + WS_W2_0), 0, scr, r, F.lane); continue; } r -= I_2;
            if (r < I_2) { p0_transpose_item(ARG(9) + (size_t)DM * FF, FF, DM, (bf16*)(F.ws + WS_W2_1), 0, scr, r, F.lane); continue; } r -= I_2;
            if (r < I_IN) { p0_transpose_item(ARG(18), DM, 672, (bf16*)(F.ws + WS_WIN), 0, scr, r, F.lane); continue; } r -= I_IN;
            if (r < I_UQ) { p0_transpose_item(ARG(21), 384, NUQ, (bf16*)(F.ws + WS_WUQ), 1, scr, r, F.lane); continue; } r -= I_UQ;
            if (r < I_UKV) { p0_transpose_item(ARG(22), 256, NUKV, (bf16*)(F.ws + WS_WUKV), 2, scr, r, F.lane); continue; } r -= I_UKV;
            p0_transpose_item(ARG(27), DM, DM, (bf16*)(F.ws + WS_WO1), 0, scr, r, F.lane);
        }
    }
    if (F.bx == 1 % F.G) {
        float* rt = (float*)(F.ws + WS_ROPE);
        for (int e = F.tid; e < 128 * 16; e += NWAVES * 64) { const int pos = e >> 4, i = e & 15; const float inv = exp2f(-(float)i * (13.287712379549449f / 16.f));
            float x = (float)pos * inv * 0.15915494309189535f; x -= rintf(x); const float c_ = __builtin_amdgcn_cosf(x), s_ = __builtin_amdgcn_sinf(x); rt[e] = c_; rt[2048 + e] = s_; ((unsigned*)(F.ws + WS_ROPEP))[e] = pk2(c_, s_); }
        for (int e = F.tid; e < 128 * 8; e += NWAVES * 64) { const int pos = e >> 3, i = e & 7; const float inv = exp2f(-(float)i * (13.287712379549449f / 8.f));
            float x = (float)pos * inv * 0.15915494309189535f; x -= rintf(x); const float c_ = __builtin_amdgcn_cosf(x), s_ = __builtin_amdgcn_sinf(x); rt[4096 + e] = c_; rt[5120 + e] = s_; ((unsigned*)(F.ws + WS_ROPEP))[2048 + e] = pk2(c_, s_); }
    }
    if (F.bx == 3 % F.G && F.wave == NWAVES - 1) {
        float* hp = (float*)(F.ws + WS_HPAR); const int i = F.lane;
        hp[i] = ARG(12)[i]; hp[64 + i] = ARG(13)[i]; hp[128 + i] = ARG(15)[i]; hp[192 + i] = ARG(16)[i]; hp[256 + i] = ARG(23)[i]; hp[320 + i] = ARG(24)[i & 31]; hp[384 + i] = ARG(25)[i];
        float a = fabsf(ARG(23)[i]), b_ = fabsf(ARG(25)[i]), c_ = fabsf(ARG(24)[i & 31]), d_ = fabsf(ARG(26)[i & 31]);
#pragma unroll
        for (int o_ = 1; o_ < 64; o_ <<= 1) { a = fmaxf(a, shx(a, o_, i)); b_ = fmaxf(b_, shx(b_, o_, i)); c_ = fmaxf(c_, shx(c_, o_, i)); d_ = fmaxf(d_, shx(d_, o_, i)); }
        const float bound = (64.f * a * b_ + 32.f * c_ * d_) * (0.10206207261596575f * 1.4426950408889634f);
        if (i == 0) hp[448] = (bound < 64.f && fmaxf(fmaxf(a, b_), fmaxf(c_, d_)) < 3.f) ? 1.f : 0.f;
        { float a2 = fabsf(ARG(12)[i]), b2 = fabsf(ARG(13)[i]), c2 = fabsf(ARG(15)[i]), d2 = fabsf(ARG(16)[i]), e2 = 0.f, f2 = fabsf(ARG(14)[i & 7]);
          const float* rpbp = ARG(17);
          float e3 = 0.f, e4 = 0.f, e5 = 0.f;
          for (int j = i; j < 8 * 465; j += 256) { e2 = fmaxf(e2, fabsf(rpbp[j])); if (j + 64 < 8 * 465) e3 = fmaxf(e3, fabsf(rpbp[j + 64])); if (j + 128 < 8 * 465) e4 = fmaxf(e4, fabsf(rpbp[j + 128])); if (j + 192 < 8 * 465) e5 = fmaxf(e5, fabsf(rpbp[j + 192])); }
          e2 = fmaxf(fmaxf(e2, e3), fmaxf(e4, e5));
#pragma unroll
          for (int o_ = 1; o_ < 64; o_ <<= 1) { a2 = fmaxf(a2, shx(a2, o_, i)); b2 = fmaxf(b2, shx(b2, o_, i)); c2 = fmaxf(c2, shx(c2, o_, i)); d2 = fmaxf(d2, shx(d2, o_, i)); e2 = fmaxf(e2, shx(e2, o_, i)); f2 = fmaxf(f2, shx(f2, o_, i)); }
          const float bound0 = fmaxf(fmaxf(8.f * a2 * b2, 8.f * c2 * d2 + e2), f2) * 1.4426950408889634f;
          if (i == 0) hp[449] = (bound0 < 64.f && fmaxf(fmaxf(a2, b2), fmaxf(c2, d2)) < 3.f) ? 1.f : 0.f; }
    }
    if (F.bx == 2 % F.G) {
        GAS v4u* z = (GAS v4u*)((bf16*)(F.ws + WS_WIN) + (size_t)672 * DM);
        unsigned zz = 0u; asm volatile("" : "+v"(zz));
        for (int e = F.tid; e < 96 * DM / 8; e += NWAVES * 64) z[e] = (v4u){zz, zz, zz, zz};
    }
}

__device__ __forceinline__ void norm_phase(Frame& F, const float* src_lat, const float* src_ctx, int nrows, const float* gw_, int layer, int which  , bool from_partials, const float* parts = nullptr, int nparts = 0, bool lat_bf16 = false, bool xn_fp8 = false) {
    LAS float* gl = (LAS float*)(F.lds + RING_OFF); LAS float* scl = gl + 1024; LAS float* shl = scl + 3 * 1024;
    const float* modp = (const float*)(F.ws + WS_MODP); const float* mod = (const float*)(F.ws + WS_MOD); const float* ada_b = ARG(5);
    const int offsh = which * 3072, offsc = which * 3072 + 1024;
    for (int i = F.tid; i < 1024; i += NWAVES * 64) {
        gl[i] = gw_[i];
#pragma unroll
        for (int cnd = 0; cnd < 3; ++cnd) {
            float sh, sc;
            if (from_partials) { sh = ada_b[layer * 6144 + offsh + i]; sc = ada_b[layer * 6144 + offsc + i];
                float ph[ADA_KS], pc[ADA_KS];
#pragma unroll
                for (int ks = 0; ks < ADA_KS; ++ks) { const float* p = modp + ((size_t)(ks * 2 + layer) * 3 + cnd) * 6144; ph[ks] = p[offsh + i]; pc[ks] = p[offsc + i]; }
#pragma unroll
                for (int ks = 0; ks < ADA_KS; ++ks) { sh += ph[ks]; sc += pc[ks]; } }
            else { sh = mod[(layer * 3 + cnd) * 6144 + offsh + i]; sc = mod[(layer * 3 + cnd) * 6144 + offsc + i]; }
            scl[cnd * 1024 + i] = 1.f + sc; shl[cnd * 1024 + i] = sh;
        }
    }
    if (from_partials) {
        float* modw = (float*)(F.ws + WS_MOD);
        for (int e = F.vcu * (NWAVES * 64) + F.tid; e < 2 * 3 * 6144; e += F.G * NWAVES * 64) {
            const int l = e / (3 * 6144), rem = e % (3 * 6144), cnd = rem / 6144, col = rem % 6144;
            float v = ada_b[l * 6144 + col];
            float pv[ADA_KS];
#pragma unroll
            for (int ks = 0; ks < ADA_KS; ++ks) pv[ks] = modp[((size_t)(ks * 2 + l) * 3 + cnd) * 6144 + col];
#pragma unroll
            for (int ks = 0; ks < ADA_KS; ++ks) v += pv[ks];
            modw[e] = v;
        }
    }
    __syncthreads();
    bf16* XN = (bf16*)(F.ws + WS_XN);
    const int gw = F.vcu * NWAVES + F.wave, NGW = F.G * NWAVES;
    for (int m = gw; m < nrows; m += NGW) {
        const float* xrow = m < ML ? src_lat + (size_t)m * DM : src_ctx + (size_t)(m - ML) * DM;
        const int cnd = m < SEQ ? 0 : (m < ML ? 1 : 2);
        const GAS f32x4* xr = (const GAS f32x4*)xrow + F.lane;
        f32x4 v[4]; float s = 0.f;
        if (lat_bf16 && m < ML) {
            const GAS v2u* xb = (const GAS v2u*)((const bf16*)src_lat + (size_t)m * DM) + F.lane;
            v2u w[4];
#pragma unroll
            for (int j = 0; j < 4; ++j) w[j] = xb[64 * j];
#pragma unroll
            for (int j = 0; j < 4; ++j) v[j] = f32x4{bflo(w[j].x), bfhi(w[j].x), bflo(w[j].y), bfhi(w[j].y)};
        } else {
#pragma unroll
            for (int j = 0; j < 4; ++j) v[j] = xr[64 * j];
        }
        if (nparts > 0 && m >= ML) {
            for (int p = 0; p < nparts; p += 4) {
                const GAS f32x4* pr = (const GAS f32x4*)(parts + (size_t)p * (512 * 1024) + (size_t)(m - ML) * DM) + F.lane;
                f32x4 w[4][4];
#pragma unroll
                for (int q = 0; q < 4; ++q)
#pragma unroll
                    for (int j = 0; j < 4; ++j) w[q][j] = pr[(size_t)q * (512 * 1024 / 4) + 64 * j];
#pragma unroll
                for (int j = 0; j < 4; ++j) v[j] += (w[0][j] + w[1][j]) + (w[2][j] + w[3][j]); }
            GAS f32x4* cr = (GAS f32x4*)((float*)(F.ws + WS_CTXRES) + (size_t)(m - ML) * DM) + F.lane;
#pragma unroll
            for (int j = 0; j < 4; ++j) cr[64 * j] = v[j];
        }
#pragma unroll
        for (int j = 0; j < 4; ++j) s += (v[j].x * v[j].x + v[j].y * v[j].y) + (v[j].z * v[j].z + v[j].w * v[j].w);
        const float rstd = 1.f / sqrtf(wave_sum(s, F.lane) * (1.f / DM) + NORM_EPS);
        if (from_partials && m >= ML) { GAS f32x4* cr = (GAS f32x4*)((float*)(F.ws + WS_CTXRES) + (size_t)(m - ML) * DM) + F.lane;
#pragma unroll
            for (int j = 0; j < 4; ++j) cr[64 * j] = v[j]; }
        GAS v2u* o8 = (GAS v2u*)(XN + (size_t)m * DM) + F.lane;
        GAS unsigned* o4 = (GAS unsigned*)((unsigned char*)XN + (size_t)m * DM) + F.lane;
#pragma unroll
        for (int j = 0; j < 4; ++j) { const int col = 4 * F.lane + 256 * j;
            const f32x4 g = *(const LAS f32x4*)(gl + col), sc = *(const LAS f32x4*)(scl + cnd * 1024 + col), sh = *(const LAS f32x4*)(shl + cnd * 1024 + col);
            const f32x4 y = (v[j] * rstd) * g * sc + sh;
            if (xn_fp8) o4[64 * j] = pk4f8(y.x, y.y, y.z, y.w);
            else { v2u w; w.x = pk2(y.x, y.y); w.y = pk2(y.z, y.w); o8[64 * j] = w; } }
    }
    __syncthreads();
}

__device__ __forceinline__ void unpack8(const v4u w, float (&x)[8]) { x[0] = bflo(w.x); x[1] = bfhi(w.x); x[2] = bflo(w.y); x[3] = bfhi(w.y); x[4] = bflo(w.z); x[5] = bfhi(w.z); x[6] = bflo(w.w); x[7] = bfhi(w.w); }
__device__ __forceinline__ v4u pack8(const float (&x)[8]) { v4u w; w.x = pk2(x[0], x[1]); w.y = pk2(x[2], x[3]); w.z = pk2(x[4], x[5]); w.w = pk2(x[6], x[7]); return w; }

__device__ __forceinline__ void qknorm_phase(Frame& F) {
    bf16* QKV = (bf16*)(F.ws + WS_QKV);
    const float* rt = (const float*)(F.ws + WS_ROPE);
    const float* nw[4] = {ARG(12), ARG(13), ARG(15), ARG(16)};
    const float qscale = 0.125f * att::LOG2E;
    const int gw = F.vcu * NWAVES + F.wave, NGW = F.G * NWAVES;
    const int lane = F.lane, grp = lane >> 3, l8 = lane & 7;
    for (int m = gw; m < MR; m += NGW) {
        const bool lat = m < ML; const int t = m & (SEQ - 1); const int prow = t >> 6, pcol = t & 63;
        GAS v4u* rowp = (GAS v4u*)(QKV + (size_t)m * NQKV);
#pragma unroll
        for (int pass = 0; pass < 4; ++pass) {
            int type;
            if (pass == 0) type = 1; else if (pass == 1) type = grp < 2 ? 2 : (grp < 4 ? 0 : 3); else if (pass == 2) type = grp < 4 ? 3 : 4; else type = grp < 4 ? 4 : 0;
            const v4u w = rowp[pass * 64 + lane];
            float x[8]; unpack8(w, x);
            float ss = 0.f;
#pragma unroll
            for (int j = 0; j < 8; ++j) ss += x[j] * x[j];
            ss += shx(ss, 1, F.lane); ss += shx(ss, 2, F.lane); ss += shx(ss, 4, F.lane);
            const float rstd = 1.f / sqrtf(ss * (1.f / 64.f) + NORM_EPS);
            const float* g = type == 1 ? nw[0] : (type == 2 ? nw[1] : (type == 3 ? nw[2] : nw[3]));
            const f32x4 g0 = *(const GAS f32x4*)(g + l8 * 8), g1 = *(const GAS f32x4*)(g + l8 * 8 + 4);
            x[0] *= rstd * g0.x; x[1] *= rstd * g0.y; x[2] *= rstd * g0.z; x[3] *= rstd * g0.w; x[4] *= rstd * g1.x; x[5] *= rstd * g1.y; x[6] *= rstd * g1.z; x[7] *= rstd * g1.w;
            float px[8];
#pragma unroll
            for (int j = 0; j < 8; ++j) px[j] = shx(x[j], 2, F.lane);
            if (lat && (type == 1 || type == 2)) {
                const int pos = (l8 & 4) ? pcol : prow; const float* cs = rt + pos * 16 + (l8 & 1) * 8;
                const f32x4 c0 = *(const GAS f32x4*)(cs), c1 = *(const GAS f32x4*)(cs + 4), s0 = *(const GAS f32x4*)(cs + 2048), s1 = *(const GAS f32x4*)(cs + 2052);
                const float cc[8] = {c0.x, c0.y, c0.z, c0.w, c1.x, c1.y, c1.z, c1.w}, sn[8] = {s0.x, s0.y, s0.z, s0.w, s1.x, s1.y, s1.z, s1.w};
                const float sgn = (l8 & 2) ? 1.f : -1.f;
#pragma unroll
                for (int j = 0; j < 8; ++j) x[j] = x[j] * cc[j] + sgn * px[j] * sn[j];
            }
            if (type == 1 || type == 3) {
#pragma unroll
                for (int j = 0; j < 8; ++j) x[j] *= qscale;
            }
            if (type != 0) rowp[pass * 64 + lane] = pack8(x);
        }
    }
}

__device__ __forceinline__ void cnorm_phase(Frame& F) {
    const bf16* CQKV = (const bf16*)(F.ws + WS_CQKV); bf16* CQN = (bf16*)(F.ws + WS_CQN); bf16* CKVN = (bf16*)(F.ws + WS_CKVN); bf16* KR = (bf16*)(F.ws + WS_KR);
    const float* rt = (const float*)(F.ws + WS_ROPE) + 4096;
    const float* gq = ARG(19); const float* gkv = ARG(20); const float* gkr = ARG(26);
    const int gw = F.vcu * NWAVES + F.wave, NGW = F.G * NWAVES; const int lane = F.lane;
    const float* gA = lane < 48 ? gq + lane * 8 : gkv + (lane - 48) * 8;
    const int li = lane < 16 ? lane : (lane < 20 ? lane - 16 : 0);
    const float* gB = lane < 16 ? gkv + 128 + li * 8 : gkr + li * 8;
    const f32x4 gA0 = *(const GAS f32x4*)(gA), gA1 = *(const GAS f32x4*)(gA + 4), gB0 = *(const GAS f32x4*)(gB), gB1 = *(const GAS f32x4*)(gB + 4);
    v4u w0 = {0u, 0u, 0u, 0u}, w1 = {0u, 0u, 0u, 0u};
    if (gw < MR) { const GAS v4u* rowp = (const GAS v4u*)(CQKV + (size_t)gw * NCIN); w0 = rowp[lane]; if (lane < 32) w1 = rowp[64 + lane]; }
    for (int m = gw; m < MR; m += NGW) {
        const bool lat = m < ML; const int t = m & (SEQ - 1); const int prow = t >> 6, pcol = t & 63;
        const int pos = (lane & 2) ? pcol : prow; const float* cs = rt + pos * 8;
        const f32x4 c0 = *(const GAS f32x4*)(cs), c1 = *(const GAS f32x4*)(cs + 4), sa = *(const GAS f32x4*)(cs + 1024), sb = *(const GAS f32x4*)(cs + 1028);
        v4u n0 = {0u, 0u, 0u, 0u}, n1 = {0u, 0u, 0u, 0u};
        if (m + NGW < MR) { const GAS v4u* rowp = (const GAS v4u*)(CQKV + (size_t)(m + NGW) * NCIN); n0 = rowp[lane]; if (lane < 32) n1 = rowp[64 + lane]; }
        float x0[8], x1[8]; unpack8(w0, x0); unpack8(w1, x1);
        float s0 = 0.f, s1 = 0.f;
#pragma unroll
        for (int j = 0; j < 8; ++j) { s0 += x0[j] * x0[j]; s1 += x1[j] * x1[j]; }
        const float ssq = wave_sum(lane < 48 ? s0 : 0.f, F.lane);
        const float sskv = wave_sum((lane >= 48 ? s0 : 0.f) + (lane < 16 ? s1 : 0.f), F.lane);
        const float sskr = wave_sum((lane >= 16 && lane < 20) ? s1 : 0.f, F.lane);
        const float rq = 1.f / sqrtf(ssq * (1.f / 384.f) + NORM_EPS), rkv = 1.f / sqrtf(sskv * (1.f / 256.f) + NORM_EPS), rkr = 1.f / sqrtf(sskr * (1.f / 32.f) + NORM_EPS);
        { const float r = lane < 48 ? rq : rkv;
          float y[8] = {x0[0] * r * gA0.x, x0[1] * r * gA0.y, x0[2] * r * gA0.z, x0[3] * r * gA0.w, x0[4] * r * gA1.x, x0[5] * r * gA1.y, x0[6] * r * gA1.z, x0[7] * r * gA1.w};
          if (lane < 48) *(GAS v4u*)(CQN + (size_t)m * 384 + lane * 8) = pack8(y); else *(GAS v4u*)(CKVN + (size_t)m * 256 + (lane - 48) * 8) = pack8(y); }
        { const float r = lane < 16 ? rkv : rkr;
          float y[8] = {x1[0] * r * gB0.x, x1[1] * r * gB0.y, x1[2] * r * gB0.z, x1[3] * r * gB0.w, x1[4] * r * gB1.x, x1[5] * r * gB1.y, x1[6] * r * gB1.z, x1[7] * r * gB1.w};
          float py[8];
#pragma unroll
          for (int j = 0; j < 8; ++j) py[j] = shx(y[j], 1, F.lane);
          if (lat && lane >= 16 && lane < 20) {
              const float cc[8] = {c0.x, c0.y, c0.z, c0.w, c1.x, c1.y, c1.z, c1.w}, sn[8] = {sa.x, sa.y, sa.z, sa.w, sb.x, sb.y, sb.z, sb.w};
              const float sgn = (lane & 1) ? 1.f : -1.f;
#pragma unroll
              for (int j = 0; j < 8; ++j) y[j] = y[j] * cc[j] + sgn * py[j] * sn[j];
          }
          if (lane < 16) *(GAS v4u*)(CKVN + (size_t)m * 256 + 128 + lane * 8) = pack8(y);
          else if (lane < 20) *(GAS v4u*)(KR + (size_t)m * 32 + (lane - 16) * 8) = pack8(y); }
        w0 = n0; w1 = n1;
    }
}

__device__ __forceinline__ void hnorm_phase(Frame& F) {
    bf16* Q = (bf16*)(F.ws + WS_Q1); bf16* KV = (bf16*)(F.ws + WS_KV1);
    const float* rt = (const float*)(F.ws + WS_ROPE) + 4096;
    const float* gqn = ARG(23); const float* gqr = ARG(24); const float* gkn = ARG(25);
    const float qscale = 0.10206207261596575f * att::LOG2E;
    const int gw = F.vcu * NWAVES + F.wave, NGW = F.G * NWAVES; const int lane = F.lane, l8 = lane & 7, l4 = lane & 3;
    for (int m = gw; m < MR; m += NGW) {
        const bool lat = m < ML; const int t = m & (SEQ - 1); const int prow = t >> 6, pcol = t & 63;
        { GAS v4u* rowp = (GAS v4u*)(KV + (size_t)m * NUKV);
          const f32x4 g0 = *(const GAS f32x4*)(gkn + l8 * 8), g1 = *(const GAS f32x4*)(gkn + l8 * 8 + 4);
#pragma unroll
          for (int pass = 0; pass < 2; ++pass) {
              float x[8]; unpack8(rowp[pass * 64 + lane], x); float ss = 0.f;
#pragma unroll
              for (int j = 0; j < 8; ++j) ss += x[j] * x[j];
              ss += shx(ss, 1, F.lane); ss += shx(ss, 2, F.lane); ss += shx(ss, 4, F.lane);
              const float r = 1.f / sqrtf(ss * (1.f / 64.f) + NORM_EPS);
              x[0] *= r * g0.x; x[1] *= r * g0.y; x[2] *= r * g0.z; x[3] *= r * g0.w; x[4] *= r * g1.x; x[5] *= r * g1.y; x[6] *= r * g1.z; x[7] *= r * g1.w;
              rowp[pass * 64 + lane] = pack8(x); } }
        if (lat) {
            GAS v4u* rowp = (GAS v4u*)(Q + (size_t)m * NUQ);
            { const f32x4 g0 = *(const GAS f32x4*)(gqn + l8 * 8), g1 = *(const GAS f32x4*)(gqn + l8 * 8 + 4);
#pragma unroll
              for (int pass = 0; pass < 2; ++pass) {
                  float x[8]; unpack8(rowp[pass * 64 + lane], x); float ss = 0.f;
#pragma unroll
                  for (int j = 0; j < 8; ++j) ss += x[j] * x[j];
                  ss += shx(ss, 1, F.lane); ss += shx(ss, 2, F.lane); ss += shx(ss, 4, F.lane);
                  const float r = qscale / sqrtf(ss * (1.f / 64.f) + NORM_EPS);
                  x[0] *= r * g0.x; x[1] *= r * g0.y; x[2] *= r * g0.z; x[3] *= r * g0.w; x[4] *= r * g1.x; x[5] *= r * g1.y; x[6] *= r * g1.z; x[7] *= r * g1.w;
                  rowp[pass * 64 + lane] = pack8(x); } }
            {
              const f32x4 g0 = *(const GAS f32x4*)(gqr + l4 * 8), g1 = *(const GAS f32x4*)(gqr + l4 * 8 + 4);
              float x[8]; unpack8(rowp[128 + lane], x); float ss = 0.f;
#pragma unroll
              for (int j = 0; j < 8; ++j) ss += x[j] * x[j];
              ss += shx(ss, 1, F.lane); ss += shx(ss, 2, F.lane);
              const float r = 1.f / sqrtf(ss * (1.f / 32.f) + NORM_EPS);
              x[0] *= r * g0.x; x[1] *= r * g0.y; x[2] *= r * g0.z; x[3] *= r * g0.w; x[4] *= r * g1.x; x[5] *= r * g1.y; x[6] *= r * g1.z; x[7] *= r * g1.w;
              float px[8];
#pragma unroll
              for (int j = 0; j < 8; ++j) px[j] = shx(x[j], 1, F.lane);
              const int pos = (l4 & 2) ? pcol : prow; const float* cs = rt + pos * 8;
              const f32x4 c0 = *(const GAS f32x4*)(cs), c1 = *(const GAS f32x4*)(cs + 4), sa = *(const GAS f32x4*)(cs + 1024), sb = *(const GAS f32x4*)(cs + 1028);
              const float cc[8] = {c0.x, c0.y, c0.z, c0.w, c1.x, c1.y, c1.z, c1.w}, sn[8] = {sa.x, sa.y, sa.z, sa.w, sb.x, sb.y, sb.z, sb.w};
              const float sgn = (l4 & 1) ? 1.f : -1.f;
#pragma unroll
              for (int j = 0; j < 8; ++j) x[j] = (x[j] * cc[j] + sgn * px[j] * sn[j]) * qscale;
              rowp[128 + lane] = pack8(x); }
        }
    }
}

__device__ __forceinline__ void kr6_pass(Frame& F) {
    if (((const float*)(F.ws + WS_HPAR))[448] == 0.f) return;
    const bf16* KR = (const bf16*)(F.ws + WS_KR); unsigned char* K6R = (unsigned char*)(F.ws + WS_K6R);
    for (int r = F.vcu * (NWAVES * 64) + F.tid; r < MR; r += F.G * (NWAVES * 64)) {
        const GAS v4u* rp = (const GAS v4u*)(KR + (size_t)r * 32);
        v4u w[4] = {rp[0], rp[1], rp[2], rp[3]};
#pragma unroll
        for (int q = 0; q < 4; ++q) { float x[8]; unpack8(w[q], x);
#pragma unroll
            for (int j = 0; j < 8; ++j) x[j] *= 1.5349124f;
            w[q] = pack8(x); }
        const attd::u32x6 c = attd::to_fp6(w[0], w[1], w[2], w[3]);
        unsigned char* img = K6R + (size_t)(r >> 6) * 2048; const int key = r & 63;
        *(GAS v4u*)(img + key * 16) = (v4u){c[0], c[1], c[2], c[3]}; *(GAS v2u*)(img + 1024 + key * 8) = (v2u){c[4], c[5]};
    }
}
__device__ __forceinline__ void attn0_phase(Frame& F) {
    att::lchar* lds = (att::lchar*)(F.lds + RING_OFF);
    const att::bf16* QKV = (const att::bf16*)(F.ws + WS_QKV); att::bf16* O = (att::bf16*)(F.ws + WS_O0);
    const bool fast = __builtin_amdgcn_readfirstlane(__builtin_bit_cast(int, ((const float*)(F.ws + WS_HPAR))[449])) != 0;
    const char* K6E = (const char*)(F.ws + WS_K6E);
    char* shm = (char*)(F.lds + RING_OFF);
    for (int ui = F.vcu; ui < 1056; ui += F.G) {
        if (ui < 512) {
            const int b = ui >> 8, h = (ui >> 5) & 7, R4 = ui & 31;
            const float* rpb = ARG(17) + h * 465;
            if (fast) {
                float* rl = (float*)(shm + attf::LDS_RPB);
                for (int i = F.tid; i < 465; i += NWAVES * 64) rl[i] = rpb[i] * att::LOG2E;
                __syncthreads();
                attf::FNa fu; fu.init((const attf::bf16*)QKV, (attf::bf16*)O, rl, b, h, R4, K6E);
                attf::fast_unit<8, attf::FNa, true>(fu, shm, F.tid);
            } else {
                att::UNa u; u.QKV = QKV; u.O = O; u.rpbl = (const LAS float*)(lds + att::L_RPB); u.b = b; u.h = h; u.R4 = R4; u.init();
                for (int i = F.tid; i < 465; i += NWAVES * 64) ((LAS float*)(lds + att::L_RPB))[i] = rpb[i] * att::LOG2E;
                att::unit<8, att::UNa>(u, lds, F.tid);
            }
        } else if (ui < 1024) {
            const int v = ui - 512;
            if (fast) { attf::FWin fu; fu.init((const attf::bf16*)QKV, (attf::bf16*)O, ARG(14), v >> 8, (v >> 2) & 63, (v >> 1) & 1, v & 1, K6E); attf::fast_unit<8, attf::FWin, true>(fu, shm, F.tid); }
            else { att::UWin u; u.QKV = QKV; u.O = O; u.sinkp = ARG(14); u.b = v >> 8; u.n = (v >> 2) & 63; u.g = (v >> 1) & 1; u.hh = v & 1; u.init(); att::unit<8, att::UWin>(u, lds, F.tid); }
        } else {
            const int v = ui - 1024;
            if (fast) { attf::FCtx fu; fu.init((const attf::bf16*)QKV, (attf::bf16*)O, ARG(14), v >> 4, v & 15, K6E); attf::fast_unit<8, attf::FCtx, true>(fu, shm, F.tid); }
            else { att::UCtx u; u.QKV = QKV; u.O = O; u.sinkp = ARG(14); u.b = v >> 4; u.hx = v & 15; u.init(); att::unit<8, att::UCtx>(u, lds, F.tid); }
        }
    }
}
__device__ __forceinline__ void attn1_phase(Frame& F) {
    att::lchar* lds = (att::lchar*)(F.lds + RING_OFF);
    const bool fast = __builtin_amdgcn_readfirstlane(__builtin_bit_cast(int, ((const float*)(F.ws + WS_HPAR))[448])) != 0;
    const bool g256 = F.G == 256; const int x = F.vcu >> 5, j = F.vcu & 31;
    const int nit = g256 ? 4 : (F.vcu < 1024 ? (1024 - F.vcu + F.G - 1) / F.G : 0);
    for (int i = 0; i < nit; ++i) {
        const int ui = g256 ? ((x * 4 + i) * 32 + j) : F.vcu + i * F.G;
        if (fast) attd::dense_unit(ui >> 9, (ui >> 5) & 15, ui & 31, (const attd::bf16*)(F.ws + WS_Q1), (const attd::bf16*)(F.ws + WS_KV1), (const char*)(F.ws + WS_K6N), (const char*)(F.ws + WS_K6R), (attd::bf16*)(F.ws + WS_O1), (char*)(F.lds + RING_OFF), F.tid);
        else {
        att::UDense u; u.Q = (const att::bf16*)(F.ws + WS_Q1); u.KV = (const att::bf16*)(F.ws + WS_KV1); u.KR = (const att::bf16*)(F.ws + WS_KR); u.O = (att::bf16*)(F.ws + WS_O1);
        u.b = ui >> 9; u.h = (ui >> 5) & 15; u.qb = ui & 31;
        att::unit<12, att::UDense>(u, lds, F.tid); }
    }
}

#ifndef PHASE_MASK
#define PHASE_MASK 0xFFFFFu
#endif
#ifndef PHASE_REP
#define PHASE_REP 0u
#endif
struct Args { const float* in[28]; float* out; unsigned char* ws; int ph_lo, ph_hi; };
constexpr int N_PHASES = 19;
__global__ void __launch_bounds__(NWAVES * 64, 2) fwd_kernel(Args args) {
    extern __shared__ __attribute__((aligned(16))) unsigned char lds[];
    for (int u = threadIdx.x; u < (LDS_BYTES - LDSCTL_OFF) / 4; u += NWAVES * 64) ((LAS unsigned*)((LAS unsigned char*)lds + LDSCTL_OFF))[u] = 0u;
    __syncthreads();
    if (!MK_PER_PHASE) (void)xcd_barrier_post((unsigned*)((gu32*)(ARG_WS + WS_CTL) + CW_BAR), (volatile LAS unsigned*)((LAS unsigned char*)lds + MISC_OFF) + 8);
    const int wv0_ = __builtin_amdgcn_readfirstlane((int)threadIdx.x >> 6);
    for (int ph2 = 2 * args.ph_lo; ph2 < 2 * args.ph_hi; ++ph2) {
        const int ph = ph2 >> 1; if ((ph2 & 1) && !((PHASE_REP >> ph) & 1)) continue;
        if (ph == 3 || ph == 14) continue;
        Frame F;
        { int t_ = wv0_ * 64 + (int)__builtin_amdgcn_mbcnt_hi(~0u, __builtin_amdgcn_mbcnt_lo(~0u, 0u)); asm volatile("" : "+v"(t_)); int b_ = blockIdx.x; asm volatile("" : "+s"(b_)); int g_ = gridDim.x; asm volatile("" : "+s"(g_)); F.tid = t_; F.bx = b_; F.G = g_; }
        F.lds = (LAS unsigned char*)lds; F.MISC = (volatile LAS unsigned*)(F.lds + MISC_OFF);
        F.lane = F.tid & 63; F.wave = __builtin_amdgcn_readfirstlane(F.tid >> 6);
        F.vcu = (F.G % 8 == 0) ? (F.bx % 8) * (F.G / 8) + F.bx / 8 : F.bx;
        F.ws = ARG_WS; F.out = ARG_OUT; F.ctl = (gu32*)(F.ws + WS_CTL);
        XcdBarrier bar; bar.bar = (unsigned*)(F.ctl + CW_BAR); bar.x = xb_xcc_id(); bar.st = F.MISC + 8;
        float* ctxres = (float*)(F.ws + WS_CTXRES);
        const float* mod = (const float*)(F.ws + WS_MOD);
        int gk = 0, xrows = 0, xS = 0;
        pg8::Gemm g{nullptr, nullptr, 0, 0, 0, 0}; pg8::EpiAny ea{0, nullptr, nullptr, nullptr, nullptr, 0, 0};
        switch (ph) {
        case 0: if (!((PHASE_MASK >> 0) & 1)) break; p0_prologue(F); break;
        case 1: if (!((PHASE_MASK >> 1) & 1)) break; norm_phase(F, ARG(0), ARG(2), MR, ARG(6), 0, 0, true, nullptr, 0, false, true); break;
        case 2: if (!((PHASE_MASK >> 2) & 1)) break; gk = 1; g = pg8::Gemm{(const bf16*)(F.ws + WS_XN), (const bf16*)(F.ws + WS_WQKV), MR, NQKV, DM / 2, 1}; ea = pg8::EpiAny{3, (const float*)(F.ws + WS_HPAR), (void*)(F.ws + WS_QKV), (float*)(F.ws + WS_K6E), (const float*)(F.ws + WS_ROPEP), NQKV, 0}; break;
        case 4: if (!((PHASE_MASK >> 4) & 1)) break; attn0_phase(F); break;
        case 5: if (!((PHASE_MASK >> 5) & 1)) break; gk = 2; g = pg8::Gemm{(const bf16*)(F.ws + WS_O0), (const bf16*)(F.ws + WS_WO0), ML, DM, DM}; xrows = MC; xS = 2; ea = pg8::EpiAny{2, ARG(0), (void*)F.out, (float*)(F.ws + WS_PART5), mod + 2048, 0, 2}; break;
        case 6: if (!((PHASE_MASK >> 6) & 1)) break; norm_phase(F, F.out, ctxres, MR, ARG(7), 0, 1, false, (const float*)(F.ws + WS_PART5), 4, true); break;
        case 7: if (!((PHASE_MASK >> 7) & 1)) break; gk = 1; g = pg8::Gemm{(const bf16*)(F.ws + WS_XN), (const bf16*)(F.ws + WS_W1_0), MR, FF, DM}; ea = pg8::EpiAny{1, nullptr, (void*)(F.ws + WS_H), nullptr, nullptr, FF, 1}; break;
        case 8: if (!((PHASE_MASK >> 8) & 1)) break; gk = 2; g = pg8::Gemm{(const bf16*)(F.ws + WS_H), (const bf16*)(F.ws + WS_W2_0), ML, DM, FF}; xrows = MC; xS = 4; ea = pg8::EpiAny{2, F.out, (void*)F.out, (float*)(F.ws + WS_PART8), mod + 5120, 0, 3}; break;
        case 9: if (!((PHASE_MASK >> 9) & 1)) break; norm_phase(F, F.out, ctxres, MR, ARG(6) + DM, 1, 0, false, (const float*)(F.ws + WS_PART8), 16, true); break;
        case 10: if (!((PHASE_MASK >> 10) & 1)) break; gk = 1; g = pg8::Gemm{(const bf16*)(F.ws + WS_XN), (const bf16*)(F.ws + WS_WIN), MR, NCIN, DM}; ea = pg8::EpiAny{1, nullptr, (void*)(F.ws + WS_CQKV), nullptr, nullptr, NCIN, 0}; break;
        case 11: if (!((PHASE_MASK >> 11) & 1)) break; cnorm_phase(F); break;
        case 12: if (!((PHASE_MASK >> 12) & 1)) break; kr6_pass(F); gk = 1; g = pg8::Gemm{(const bf16*)(F.ws + WS_CQN), (const bf16*)(F.ws + WS_WUQ), ML, NUQ, 384}; ea = pg8::EpiAny{3, (const float*)(F.ws + WS_HPAR), (void*)(F.ws + WS_Q1), nullptr, (const float*)(F.ws + WS_ROPEP), NUQ, 1}; break;
        case 13: if (!((PHASE_MASK >> 13) & 1)) break; gk = 1; g = pg8::Gemm{(const bf16*)(F.ws + WS_CKVN), (const bf16*)(F.ws + WS_WUKV), MR, NUKV, 256}; ea = pg8::EpiAny{3, (const float*)(F.ws + WS_HPAR), (void*)(F.ws + WS_KV1), (float*)(F.ws + WS_K6N), (const float*)(F.ws + WS_ROPEP), NUKV, 2}; break;
        case 15: if (!((PHASE_MASK >> 15) & 1)) break; attn1_phase(F); break;
        case 16: if (!((PHASE_MASK >> 16) & 1)) break; gk = 2; g = pg8::Gemm{(const bf16*)(F.ws + WS_O1), (const bf16*)(F.ws + WS_WO1), ML, DM, DM}; ea = pg8::EpiAny{2, F.out, (void*)(F.ws + WS_XR), ctxres, mod + 3 * 6144 + 2048, 0, 3}; break;
        case 17: if (!((PHASE_MASK >> 17) & 1)) break; norm_phase(F, (const float*)(F.ws + WS_XR), ctxres, ML, ARG(7) + DM, 1, 1, false, nullptr, 0, true); break;
        case 18: if (!((PHASE_MASK >> 18) & 1)) break; gk = 1; g = pg8::Gemm{(const bf16*)(F.ws + WS_XN), (const bf16*)(F.ws + WS_W1_1), ML, FF, DM}; ea = pg8::EpiAny{1, nullptr, (void*)(F.ws + WS_H), nullptr, nullptr, FF, 1}; break;
        case 19: if (!((PHASE_MASK >> 19) & 1)) break; gk = 2; g = pg8::Gemm{(const bf16*)(F.ws + WS_H), (const bf16*)(F.ws + WS_W2_1), ML, DM, FF}; ea = pg8::EpiAny{2, (const float*)(F.ws + WS_XR), (void*)F.out, ctxres, mod + 3 * 6144 + 5120, 0, 1}; break;
        default: break;
        }
        ea.scr = F.lds + LDSCTL_OFF + 4096;
        if (gk != 0) { pg8::StaticOrder S; S.init(g.M, g.N, g.K, F.G, ph == 13 ? (F.bx + F.G / 2) % F.G : F.bx, xrows, xS);
            if (g.mx) pg8::gemm_phase<pg8::EpiAny, pg8::StaticOrder, true, true, true>(F.lds + RING_OFF, g, S, ea, F.tid);
            else pg8::gemm_phase<pg8::EpiAny, pg8::StaticOrder, true, true, false>(F.lds + RING_OFF, g, S, ea, F.tid); }
        const bool last_ = (ph == args.ph_hi - 1) && ((ph2 & 1) || !((PHASE_REP >> ph) & 1));
        if (!MK_PER_PHASE && !last_ && ph != 12) xcd_barrier(bar);
        else __syncthreads();
    }
}

extern "C" void kernel_launch(void* const* d_in, const int* in_sizes, int n_in, void* d_out, int out_size, void* d_ws, size_t ws_size, hipStream_t stream) {
    static int grid = 0;
    if (grid == 0) {
        if (n_in != 28 || in_sizes[0] != ML * DM || out_size != ML * DM || ws_size < WS_END) { fprintf(stderr, "kernel_launch: unexpected shapes: n_in %d in0 %d out %d ws %zu\n", n_in, n_in > 0 ? in_sizes[0] : -1, out_size, ws_size); grid = -1; return; }
        int dev = 0, cus = 0, per_cu = 0;
        if (hipGetDevice(&dev) != hipSuccess || hipDeviceGetAttribute(&cus, hipDeviceAttributeMultiprocessorCount, dev) != hipSuccess) { fprintf(stderr, "kernel_launch: device query failed\n"); grid = -1; return; }
        if (hipFuncSetAttribute((const void*)fwd_kernel, hipFuncAttributeMaxDynamicSharedMemorySize, LDS_BYTES) != hipSuccess) { fprintf(stderr, "kernel_launch: hipFuncSetAttribute failed\n"); grid = -1; return; }
        if (hipOccupancyMaxActiveBlocksPerMultiprocessor(&per_cu, (const void*)fwd_kernel, NWAVES * 64, LDS_BYTES) != hipSuccess || per_cu < 1)
            fprintf(stderr, "kernel_launch: note: occupancy query reports %d workgroups per CU\n", per_cu);
        (void)hipGetLastError();
        grid = cus;
    }
    if (grid < 0) return;
    if (hipMemsetAsync((char*)d_ws + WS_CTL, 0, CTL_ZERO_BYTES, stream) != hipSuccess) { fprintf(stderr, "kernel_launch: hipMemsetAsync failed\n"); return; }
    Args a{};
    for (int i = 0; i < 28; ++i) a.in[i] = (const float*)d_in[i];
    a.out = (float*)d_out; a.ws = (unsigned char*)d_ws;
#if MK_PER_PHASE
    for (int ph = 0; ph <= N_PHASES; ++ph) { a.ph_lo = ph; a.ph_hi = ph + 1; hipLaunchKernelGGL(fwd_kernel, dim3(grid), dim3(NWAVES * 64), LDS_BYTES, stream, a); }
#else
    a.ph_lo = 0; a.ph_hi = N_PHASES + 1;
    hipLaunchKernelGGL(fwd_kernel, dim3(grid), dim3(NWAVES * 64), LDS_BYTES, stream, a);
#endif
    const hipError_t le = hipPeekAtLastError();
    if (le != hipSuccess) fprintf(stderr, "kernel_launch: launch failed: %s\n", hipGetErrorName(le));
}
```

```cpp
#include <hip/hip_runtime.h>
#include <cstdio>
#include <cstdint>
namespace pg8 {
#define PG8_LAS __attribute__((address_space(3)))
typedef unsigned short bf16_t;
typedef short bf16x8 __attribute__((ext_vector_type(8)));
typedef float f32x4 __attribute__((ext_vector_type(4)));
typedef unsigned u32x4 __attribute__((ext_vector_type(4)));
typedef unsigned u32x2 __attribute__((ext_vector_type(2)));
typedef unsigned u32x6 __attribute__((ext_vector_type(6)));
typedef unsigned u32x16 __attribute__((ext_vector_type(16)));
typedef __bf16 bf16x32 __attribute__((ext_vector_type(32)));
constexpr int BM = 256, BK = 64, HALF = 128, HTB = HALF * BK * 2  , STAGE_BYTES = 8 * HTB, NXCD = 8, WGM = 8;

__host__ __device__ __forceinline__ int lds_byte(int r, int c) { const int st = (r >> 4) * 2 + (c >> 5), rr = r & 15, cc = c & 31, ob = rr * 64 + cc * 2; return st * 1024 + (ob ^ (((ob >> 9) & 1) << 5)); }
__host__ __device__ __forceinline__ void stage_rc(int b, int& R, int& C) { const int st = b / 1024, sb = b % 1024, swz = sb ^ (((sb >> 9) & 1) << 5); R = (st >> 1) * 16 + swz / 64; C = (st & 1) * 32 + (swz % 64) / 2; }
__host__ __device__ __forceinline__ int perm32(int rho) { const int n = rho >> 4, i = rho & 15; return 8 * (i >> 2) + 4 * n + (i & 3); }

struct Unit { int pm, pn, kinfo; };
struct Gemm { const bf16_t* A; const bf16_t* Bt; int M, N, K; int mx = 0; };

struct StaticOrder {
    int nM, nN, nwg, G, c, ntK;
    int xtiles, xsh;
    __host__ __device__ void init(int M, int N, int K, int G_, int c_, int extra_rows = 0, int S = 1) { nM = M / BM; nN = N / BM; nwg = nM * nN; G = G_; c = c_; ntK = K / BK;
        xtiles = (extra_rows / BM) * nN; xsh = S; }
    __host__ __device__ bool next(int i, Unit& u) const {
        const long L = (long)i * G + c;
        if (L >= nwg) {
            if (xtiles == 0) return false;
            const int nb = (nwg - c + G - 1) / G;
            const int nbc = c < nwg ? nb : 0;
            const long e = (long)(i - nbc) * G + ((c + G - (nwg % G)) % G);
            if (e >= ((long)xtiles << xsh)) return false;
            const int tile = (int)(e >> xsh), ks = (int)e & ((1 << xsh) - 1), xnt = ntK >> xsh;
            u.pm = nM + tile / nN; u.pn = tile % nN; u.kinfo = (ks * xnt) | (xnt << 8) | (1 << 16); return true;
        }
        int wgid = (int)L; { const int q = nwg / NXCD, r = nwg % NXCD, xcd = wgid % NXCD, off = wgid / NXCD; wgid = (xcd < r ? xcd * (q + 1) : r * (q + 1) + (xcd - r) * q) + off; }
        const int nig = WGM * nN, gid = wgid / nig, fm = gid * WGM, gsz = (nM - fm) < WGM ? (nM - fm) : WGM;
        u.pm = fm + ((wgid % nig) % gsz); u.pn = (wgid % nig) / gsz; u.kinfo = ntK << 8; return true;
    }
    __device__ __forceinline__ void a_ready(const Unit&) const {}
    __device__ __forceinline__ void done(const Unit&) const {}
};

__device__ __forceinline__ unsigned cvt_pk_bf16(float lo, float hi) { unsigned r; asm volatile("v_cvt_pk_bf16_f32 %0, %1, %2" : "=v"(r) : "v"(lo), "v"(hi)); return r; }
__device__ __forceinline__ u32x2 pk4bf(f32x4 y) { u32x2 r; r.x = cvt_pk_bf16(y[0], y[1]); r.y = cvt_pk_bf16(y[2], y[3]); return r; }
__device__ __forceinline__ f32x4 unpk4bf(u32x2 w) { f32x4 r; r[0] = __builtin_bit_cast(float, w.x << 16); r[1] = __builtin_bit_cast(float, w.x & 0xffff0000u); r[2] = __builtin_bit_cast(float, w.y << 16); r[3] = __builtin_bit_cast(float, w.y & 0xffff0000u); return r; }
struct EpiAny {
    static constexpr bool AFTER_DRAIN = false;
    int mode; const float* base; void* out; float* ctxres; const float* gate; int ldc, relu2; PG8_LAS unsigned char* scr = nullptr;
    __device__ __forceinline__ bool perm() const { return mode == 1; }
    __device__ __forceinline__ bool headmode() const { return mode == 3; }
    __device__ __forceinline__ static float xsh(float v, int mask, int lane) { return __builtin_bit_cast(float, __builtin_amdgcn_ds_bpermute((lane ^ mask) << 2, __builtin_bit_cast(int, v))); }
    __device__ __forceinline__ void head_epilogue(const f32x4 (&acc)[2][2][4][2], const Unit& u, int wr, int wc, int fr, int fq) const {
        const int H = 4 * u.pn + wc, kind = relu2, lane = fr + 16 * fq;
        const bool f6 = kind != 0 && base[448] != 0.f;
        const bool f6e = kind == 0 && base[449] != 0.f;
        int cls, gsel; float qs = 1.f;
        if (kind == 0) { const float qq = f6e ? 1.6986436f : 0.125f * 1.4426950408889634f, kq = f6e ? 1.6986436f : 1.f;
                         if (H < 8) { cls = 2; gsel = 0; qs = qq; } else if (H < 10) { cls = 2; gsel = 1; qs = kq; } else if (H < 12) { cls = 0; gsel = 0; }
                         else if (H < 20) { cls = 1; gsel = 2; qs = qq; } else if (H < 28) { cls = 1; gsel = 3; qs = kq; } else { cls = 0; gsel = 0; } }
        else if (kind == 1) { qs = f6 ? 1.5349124f : 0.10206207261596575f * 1.4426950408889634f; if (H < 16) { cls = 1; gsel = 4; } else { cls = 3; gsel = 5; } }
        else { if (H < 16) { cls = 1; gsel = 6; if (f6) qs = 1.5349124f; } else { cls = 0; gsel = 0; } }
        const bool lat = u.pm < 64;
        const bool k6e = f6e && (H == 8 || H == 9 || (H >= 20 && H < 28));
        const bool k6 = (f6 && kind == 2 && H < 16) || k6e;
        bf16_t* O = (bf16_t*)out;
        const int col0 = u.pn * BM + 64 * wc + 8 * fq;
        f32x4 gv[2][2];
#pragma unroll
        for (int bj = 0; bj < 2; ++bj)
#pragma unroll
            for (int n = 0; n < 2; ++n) gv[bj][n] = *(const f32x4*)(base + gsel * 64 + 32 * bj + 8 * fq + 4 * n);
#pragma unroll
        for (int ai = 0; ai < 2; ++ai)
#pragma unroll
            for (int m = 0; m < 4; ++m) {
                const int row = u.pm * BM + ai * HALF + wr * 64 + m * 16 + fr;
                f32x4 v[2][2];
#pragma unroll
                for (int bj = 0; bj < 2; ++bj)
#pragma unroll
                    for (int n = 0; n < 2; ++n) v[bj][n] = acc[ai][bj][m][n];
                if (cls != 0) {
                    float s0 = 0.f, s1 = 0.f;
#pragma unroll
                    for (int n = 0; n < 2; ++n)
#pragma unroll
                        for (int e = 0; e < 4; ++e) { s0 += v[0][n][e] * v[0][n][e]; s1 += v[1][n][e] * v[1][n][e]; }
                    if (cls != 3) { s0 += s1; s0 += xsh(s0, 16, lane); s0 += xsh(s0, 32, lane); s0 = s0 * (1.f / 64.f); s1 = s0; }
                    else { s0 += xsh(s0, 16, lane); s0 += xsh(s0, 32, lane); s1 += xsh(s1, 16, lane); s1 += xsh(s1, 32, lane); s0 *= (1.f / 32.f); s1 *= (1.f / 32.f); }
                    const float r0 = 1.f / sqrtf(s0 + 1e-6f), r1 = 1.f / sqrtf(s1 + 1e-6f);
#pragma unroll
                    for (int n = 0; n < 2; ++n) { v[0][n] = v[0][n] * r0 * gv[0][n]; v[1][n] = v[1][n] * r1 * gv[1][n]; }
                    if (lat && cls == 2) {
                        const int t = row & 8191;
                        u32x4 cw[2][2]; const float sgn = fq < 2 ? -1.f : 1.f;
#pragma unroll
                        for (int bj = 0; bj < 2; ++bj) { const int pos = bj == 0 ? (t >> 6) : (t & 63);
#pragma unroll
                            for (int n = 0; n < 2; ++n) cw[bj][n] = *(const u32x4*)((const unsigned*)gate + pos * 16 + 8 * (fq & 1) + 4 * n); }
#pragma unroll
                        for (int bj = 0; bj < 2; ++bj)
#pragma unroll
                            for (int n = 0; n < 2; ++n) { f32x4 p, c, sn;
#pragma unroll
                                for (int e = 0; e < 4; ++e) { p[e] = xsh(v[bj][n][e], 32, lane); c[e] = __builtin_bit_cast(float, cw[bj][n][e] << 16); sn[e] = __builtin_bit_cast(float, cw[bj][n][e] & 0xffff0000u); }
                                v[bj][n] = v[bj][n] * c + (p * sgn) * sn; }
                    }
                    if (lat && cls == 3) {
                        const int t = row & 8191; const int pos = fq < 2 ? (t >> 6) : (t & 63); const float sgn = (fq & 1) ? 1.f : -1.f;
                        u32x4 cw[2];
#pragma unroll
                        for (int n = 0; n < 2; ++n) cw[n] = *(const u32x4*)((const unsigned*)gate + 2048 + pos * 8 + 4 * n);
#pragma unroll
                        for (int bj = 0; bj < 2; ++bj)
#pragma unroll
                            for (int n = 0; n < 2; ++n) { f32x4 p, c, sn;
#pragma unroll
                                for (int e = 0; e < 4; ++e) { p[e] = xsh(v[bj][n][e], 16, lane); c[e] = __builtin_bit_cast(float, cw[n][e] << 16); sn[e] = __builtin_bit_cast(float, cw[n][e] & 0xffff0000u); }
                                v[bj][n] = v[bj][n] * c + (p * sgn) * sn; }
                    }
                    if (qs != 1.f) {
#pragma unroll
                        for (int bj = 0; bj < 2; ++bj)
#pragma unroll
                            for (int n = 0; n < 2; ++n) v[bj][n] = v[bj][n] * qs; }
                }
                if (k6) {
                    PG8_LAS unsigned char* sw = scr + (wr * 4 + wc) * 1024 + fr * 64;
                    unsigned char* img = (unsigned char*)ctxres + (k6e ? ((size_t)(row >> 6) * 10 + (H < 10 ? H - 8 : H - 18)) : ((size_t)(row >> 6) * 16 + H)) * 3072;
                    const int key = row & 63;
#pragma unroll
                    for (int bj = 0; bj < 2; ++bj) {
                        u32x4 w; w.x = cvt_pk_bf16(v[bj][0][0], v[bj][0][1]); w.y = cvt_pk_bf16(v[bj][0][2], v[bj][0][3]); w.z = cvt_pk_bf16(v[bj][1][0], v[bj][1][1]); w.w = cvt_pk_bf16(v[bj][1][2], v[bj][1][3]);
                        *(PG8_LAS u32x4*)(sw + fq * 16) = w;
                        asm volatile("s_waitcnt lgkmcnt(0)" ::: "memory");
                        if (fq == 0) {
                            const u32x4 a0 = *(PG8_LAS u32x4*)(sw), a1 = *(PG8_LAS u32x4*)(sw + 16), a2 = *(PG8_LAS u32x4*)(sw + 32), a3 = *(PG8_LAS u32x4*)(sw + 48);
                            const u32x16 all = {a0.x, a0.y, a0.z, a0.w, a1.x, a1.y, a1.z, a1.w, a2.x, a2.y, a2.z, a2.w, a3.x, a3.y, a3.z, a3.w};
                            const u32x6 c = __builtin_amdgcn_cvt_scalef32_pk32_fp6_bf16(__builtin_bit_cast(bf16x32, all), 1.0f);
                            *(u32x4*)(img + bj * 1024 + key * 16) = (u32x4){c[0], c[1], c[2], c[3]};
                            *(u32x2*)(img + 2048 + bj * 512 + key * 8) = (u32x2){c[4], c[5]};
                        }
                        asm volatile("s_waitcnt lgkmcnt(0)" ::: "memory");
                    }
                    continue;
                }
                bf16_t* rowp = O + (size_t)row * ldc + col0;
#pragma unroll
                for (int bj = 0; bj < 2; ++bj) { u32x4 w; w.x = cvt_pk_bf16(v[bj][0][0], v[bj][0][1]); w.y = cvt_pk_bf16(v[bj][0][2], v[bj][0][3]); w.z = cvt_pk_bf16(v[bj][1][0], v[bj][1][1]); w.w = cvt_pk_bf16(v[bj][1][2], v[bj][1][3]);
                    *(u32x4*)(rowp + 32 * bj) = w; }
            }
    }
    __device__ __forceinline__ void operator()(const f32x4 (&acc)[2][2][4][2], const Unit& u, int wr, int wc, int fr, int fq) const {
        asm volatile("" : "+v"(fr), "+v"(fq));
        if (mode == 1) {
            bf16_t* O = (bf16_t*)out;
            const int row0 = u.pm * BM + wr * 64 + fr, col0 = u.pn * BM + wc * 32 + 8 * fq;
#pragma unroll
            for (int ai = 0; ai < 2; ++ai)
#pragma unroll
                for (int m = 0; m < 4; ++m) { bf16_t* rowp = O + (size_t)(row0 + ai * HALF + m * 16) * ldc + col0;
#pragma unroll
                    for (int bj = 0; bj < 2; ++bj) { f32x4 v0 = acc[ai][bj][m][0], v1 = acc[ai][bj][m][1];
                        if (relu2) {
#pragma unroll
                            for (int e = 0; e < 4; ++e) { float a = fmaxf(v0[e], 0.f), b = fmaxf(v1[e], 0.f); v0[e] = a * a; v1[e] = b * b; } }
                        u32x4 w; w.x = cvt_pk_bf16(v0[0], v0[1]); w.y = cvt_pk_bf16(v0[2], v0[3]); w.z = cvt_pk_bf16(v1[0], v1[1]); w.w = cvt_pk_bf16(v1[2], v1[3]);
                        *(u32x4*)(rowp + bj * HALF) = w; } }
            return;
        }
        if (mode == 3) { head_epilogue(acc, u, wr, wc, fr, fq); return; }
        const int t0 = u.pm * BM; const bool split = (u.kinfo >> 16) != 0; const int cond = t0 < 8192 ? 0 : (t0 < 16384 ? 1 : 2);
        const int col0 = u.pn * BM + wc * 32 + 4 * fq; const float* g = gate + cond * 6144 + col0;
        f32x4 gv[2][2];
#pragma unroll
        for (int bj = 0; bj < 2; ++bj)
#pragma unroll
            for (int n = 0; n < 2; ++n) gv[bj][n] = *(const f32x4*)(g + bj * HALF + n * 16);
        if (split) {
            const int ks = (u.kinfo & 255) / ((u.kinfo >> 8) & 255);
            float* op = ctxres + (size_t)ks * (512 * 1024) + (size_t)(t0 - 16384) * 1024;
#pragma unroll
            for (int ai = 0; ai < 2; ++ai)
#pragma unroll
                for (int m = 0; m < 4; ++m) { const size_t off = (size_t)(wr * 64 + fr + ai * HALF + m * 16) * 1024 + col0;
#pragma unroll
                    for (int bj = 0; bj < 2; ++bj)
#pragma unroll
                        for (int n = 0; n < 2; ++n) *(f32x4*)(op + off + bj * HALF + n * 16) = gv[bj][n] * acc[ai][bj][m][n]; }
            return;
        }
#define PG8_RES_LOOP(LOADB, STOREO) _Pragma("unroll") for (int ai = 0; ai < 2; ++ai) _Pragma("unroll") for (int m = 0; m < 4; ++m) { const size_t off = (size_t)(wr * 64 + fr + ai * HALF + m * 16) * 1024 + col0; \
            _Pragma("unroll") for (int bj = 0; bj < 2; ++bj) _Pragma("unroll") for (int n = 0; n < 2; ++n) { const size_t o2 = off + bj * HALF + n * 16; f32x4 b; LOADB; const f32x4 y = b + gv[bj][n] * acc[ai][bj][m][n]; STOREO; } }
        if (relu2 == 2) { const float* bp = base + (size_t)t0 * 1024; bf16_t* op = (bf16_t*)out + (size_t)t0 * 1024;
            PG8_RES_LOOP(b = *(const f32x4*)(bp + o2), *(u32x2*)(op + o2) = pk4bf(y)); }
        else if (relu2 == 3) { const bf16_t* bp = (const bf16_t*)base + (size_t)t0 * 1024; bf16_t* op = (bf16_t*)out + (size_t)t0 * 1024;
            PG8_RES_LOOP(const u32x2 w = *(const u32x2*)(bp + o2); b = unpk4bf(w), *(u32x2*)(op + o2) = pk4bf(y)); }
        else { const bf16_t* bp = (const bf16_t*)base + (size_t)t0 * 1024; float* op = (float*)out + (size_t)t0 * 1024;
            PG8_RES_LOOP(const u32x2 w = *(const u32x2*)(bp + o2); b = unpk4bf(w), *(f32x4*)(op + o2) = y); }
#undef PG8_RES_LOOP
    }
};

template <class Epi, class Sched, bool ALIGN_EPI = false, bool SP2 = false, bool MX8 = false>
__device__ __forceinline__ void gemm_phase(PG8_LAS unsigned char* lds, const Gemm g, const Sched& S, const Epi& E, const int tid) {
    const int wid = __builtin_amdgcn_readfirstlane(tid >> 6), lane = tid & 63, wr = wid >> 2, wc = wid & 3, fr = lane & 15, fq = lane >> 4;
    const int K = g.K;
    typedef int i32x4_t __attribute__((ext_vector_type(4)));
    int scw_ = 0x7a7a7a7a, sca_ = 0x7f7f7f7f; asm volatile("" : "+v"(scw_), "+v"(sca_));
    unsigned voffA[2], voffB[2];
#pragma unroll
    for (int i = 0; i < 2; ++i) { int R, C; stage_rc(tid * 16 + i * 8192, R, C); const int Rb = E.headmode() ? (64 * (R >> 5) + perm32(R & 31)) : (E.perm() ? ((R & ~31) + perm32(R & 31)) : R);
        voffA[i] = (unsigned)(R * K + C) * 2u; voffB[i] = (unsigned)(Rb * K + C) * 2u; }
    const size_t kstep = (size_t)(BK * 2);
    const size_t hstep = (size_t)HALF * K * 2;
    const size_t tstep = 2 * hstep;
    const size_t hstepB = E.headmode() ? (size_t)32 * K * 2 : hstep;
    const unsigned ldsw = (unsigned)wid * 1024u;
    const int aoff = lds_byte(wr * 64 + fr, fq * 8), boff = lds_byte(wc * 32 + fr, fq * 8);
#define PG8_SA(b, h) (((b) * 2 + (h)) * HTB)
#define PG8_SB(b, h) ((4 + (b) * 2 + (h)) * HTB)
    const unsigned ldsb = (unsigned)(uintptr_t)lds + ldsw;
#define PG8_STAGE(bufoff, gbase, voff) do { _Pragma("unroll") for (int _i = 0; _i < 2; ++_i) { unsigned keep_; \
        asm volatile("s_mov_b32 %0, m0\n\ts_mov_b32 m0, %3\n\ts_nop 0\n\tglobal_load_lds_dwordx4 %1, %2\n\ts_mov_b32 m0, %0" : "=&s"(keep_) : "v"((voff)[_i]), "s"((const char*)(gbase)), "s"(ldsb + (unsigned)((bufoff) + _i * 8192)) : "memory"); } } while (0)
#define PG8_LDA(dst, b, h) do { _Pragma("unroll") for (int m = 0; m < 4; ++m) _Pragma("unroll") for (int k = 0; k < 2; ++k) dst[m][k] = *(const PG8_LAS bf16x8*)(lds + PG8_SA(b, h) + aoff + m * 2048 + k * 1024); } while (0)
#define PG8_LDB(dst, b, h) do { _Pragma("unroll") for (int n = 0; n < 2; ++n) _Pragma("unroll") for (int k = 0; k < 2; ++k) dst[n][k] = *(const PG8_LAS bf16x8*)(lds + PG8_SB(b, h) + boff + n * 2048 + k * 1024); } while (0)
#define PG8_CAT(x, y) __builtin_shufflevector(__builtin_bit_cast(i32x4_t, x), __builtin_bit_cast(i32x4_t, y), 0, 1, 2, 3, 4, 5, 6, 7)
#define PG8_MMA(ai, bj, At, Bt) do { __builtin_amdgcn_s_setprio(1); \
        if constexpr (MX8) { _Pragma("unroll") for (int m = 0; m < 4; ++m) _Pragma("unroll") for (int n = 0; n < 2; ++n) \
            asm volatile("v_mfma_scale_f32_16x16x128_f8f6f4 %0, %1, %2, %0, %3, %4 op_sel_hi:[0,0,0]" : "+v"(acc[ai][bj][m][n]) : "v"(PG8_CAT(Bt[n][0], Bt[n][1])), "v"(PG8_CAT(At[m][0], At[m][1])), "v"(scw_), "v"(sca_)); } \
        else { _Pragma("unroll") for (int m = 0; m < 4; ++m) _Pragma("unroll") for (int n = 0; n < 2; ++n) _Pragma("unroll") for (int k = 0; k < 2; ++k) \
            acc[ai][bj][m][n] = __builtin_amdgcn_mfma_f32_16x16x32_bf16(Bt[n][k], At[m][k], acc[ai][bj][m][n], 0, 0, 0); } \
        __builtin_amdgcn_s_setprio(0); } while (0)
#define PG8_WAIT_V(n) asm volatile("s_waitcnt vmcnt(" #n ")" ::: "memory")
#define PG8_WAIT_L(n) asm volatile("s_waitcnt lgkmcnt(" #n ")" ::: "memory")
#define PG8_BAR __builtin_amdgcn_s_barrier()
#define PG8_SCHED __builtin_amdgcn_sched_barrier(0)
    Unit cur, nxt; int ui = 0;
    if (!S.next(0, cur)) return;
    f32x4 acc[2][2][4][2];
#pragma unroll
    for (int a = 0; a < 2; ++a)
#pragma unroll
        for (int b = 0; b < 2; ++b)
#pragma unroll
            for (int m = 0; m < 4; ++m)
#pragma unroll
                for (int n = 0; n < 2; ++n) acc[a][b][m][n] = (f32x4){0.f, 0.f, 0.f, 0.f};
    bf16x8 At[4][2], B0[2][2], B1[2][2];
    const char* cA = (const char*)g.A + (size_t)cur.pm * tstep + (size_t)(cur.kinfo & 255) * (BK * 2); const char* cB = (const char*)g.Bt + (size_t)cur.pn * tstep + (size_t)(cur.kinfo & 255) * (BK * 2);
    S.a_ready(cur);
    if constexpr (SP2) {
        PG8_STAGE(PG8_SB(0, 0), cB, voffB); PG8_STAGE(PG8_SB(0, 1), cB + hstepB, voffB); PG8_STAGE(PG8_SA(0, 0), cA, voffA); PG8_STAGE(PG8_SA(0, 1), cA + hstep, voffA);
        if (wr == 1) PG8_BAR;
        PG8_WAIT_V(2); PG8_BAR;
        PG8_STAGE(PG8_SB(1, 0), cB + kstep, voffB); PG8_STAGE(PG8_SA(1, 0), cA + kstep, voffA); PG8_STAGE(PG8_SB(1, 1), cB + hstepB + kstep, voffB);
        PG8_WAIT_V(6); PG8_BAR;
    } else {
        PG8_STAGE(PG8_SB(0, 0), cB, voffB); PG8_STAGE(PG8_SA(0, 0), cA, voffA); PG8_STAGE(PG8_SB(0, 1), cB + hstepB, voffB); PG8_STAGE(PG8_SA(0, 1), cA + hstep, voffA);
        if (wr == 1) PG8_BAR;
        PG8_WAIT_V(4); PG8_BAR;
        PG8_STAGE(PG8_SB(1, 0), cB + kstep, voffB); PG8_STAGE(PG8_SA(1, 0), cA + kstep, voffA); PG8_STAGE(PG8_SB(1, 1), cB + hstepB + kstep, voffB);
        PG8_WAIT_V(6); PG8_BAR;
    }
    for (;;) {
        const bool has_next = S.next(ui + 1, nxt);
        const char* nA = has_next ? (const char*)g.A + (size_t)nxt.pm * tstep + (size_t)(nxt.kinfo & 255) * (BK * 2) : cA; const char* nB = has_next ? (const char*)g.Bt + (size_t)nxt.pn * tstep + (size_t)(nxt.kinfo & 255) * (BK * 2) : cB;
        const int nt = (cur.kinfo >> 8) & 255;
        for (int t = 0; t < nt; t += 2) {
            const bool last = (t == nt - 2);
            const char* a1 = cA + (size_t)(t + 1) * kstep;
            const char* a2 = last ? nA : cA + (size_t)(t + 2) * kstep; const char* b2 = last ? nB : cB + (size_t)(t + 2) * kstep;
            const char* a3 = a2 + kstep; const char* b3 = b2 + kstep;
            if (last && has_next) S.a_ready(nxt);
            if constexpr (SP2) {
            PG8_LDB(B0, 0, 0); PG8_LDB(B1, 0, 1); PG8_SCHED; PG8_LDA(At, 0, 0); PG8_STAGE(PG8_SA(1, 1), a1 + hstep, voffA);
            PG8_WAIT_V(8); PG8_WAIT_L(0); PG8_BAR; PG8_MMA(0, 0, At, B0); PG8_MMA(0, 1, At, B1); PG8_BAR; PG8_SCHED;
            PG8_LDA(At, 0, 1); PG8_STAGE(PG8_SB(0, 0), b2, voffB); PG8_STAGE(PG8_SB(0, 1), b2 + hstepB, voffB); PG8_STAGE(PG8_SA(0, 0), a2, voffA);
            PG8_WAIT_V(8); PG8_WAIT_L(0); PG8_BAR; PG8_MMA(1, 0, At, B0); PG8_MMA(1, 1, At, B1); PG8_BAR; PG8_SCHED;
            PG8_LDB(B0, 1, 0); PG8_LDB(B1, 1, 1); PG8_SCHED; PG8_LDA(At, 1, 0); PG8_STAGE(PG8_SA(0, 1), a2 + hstep, voffA);
            PG8_WAIT_V(8); PG8_WAIT_L(0); PG8_BAR; PG8_MMA(0, 0, At, B0); PG8_MMA(0, 1, At, B1); PG8_BAR; PG8_SCHED;
            PG8_LDA(At, 1, 1); PG8_STAGE(PG8_SB(1, 0), b3, voffB); PG8_STAGE(PG8_SB(1, 1), b3 + hstepB, voffB); PG8_STAGE(PG8_SA(1, 0), a3, voffA);
            PG8_WAIT_V(8); PG8_WAIT_L(0); PG8_BAR; PG8_MMA(1, 0, At, B0); PG8_MMA(1, 1, At, B1); PG8_BAR; PG8_SCHED;
            } else {
            PG8_LDB(B0, 0, 0); PG8_SCHED; PG8_LDA(At, 0, 0); PG8_STAGE(PG8_SA(1, 1), a1 + hstep, voffA);
            PG8_WAIT_L(8); PG8_BAR; PG8_WAIT_L(0); PG8_MMA(0, 0, At, B0); PG8_BAR; PG8_SCHED;
            PG8_LDB(B1, 0, 1); PG8_STAGE(PG8_SB(0, 0), b2, voffB);
            PG8_BAR; PG8_WAIT_L(0); PG8_MMA(0, 1, At, B1); PG8_BAR;
            PG8_LDA(At, 0, 1); PG8_STAGE(PG8_SA(0, 0), a2, voffA);
            PG8_BAR; PG8_WAIT_L(0); PG8_MMA(1, 0, At, B0); PG8_BAR; PG8_SCHED;
            PG8_STAGE(PG8_SB(0, 1), b2 + hstepB, voffB);
            PG8_WAIT_V(6); PG8_BAR; PG8_MMA(1, 1, At, B1); PG8_BAR;
            PG8_LDB(B0, 1, 0); PG8_SCHED; PG8_LDA(At, 1, 0); PG8_STAGE(PG8_SA(0, 1), a2 + hstep, voffA);
            PG8_WAIT_L(8); PG8_BAR; PG8_WAIT_L(0); PG8_MMA(0, 0, At, B0); PG8_BAR; PG8_SCHED;
            PG8_LDB(B1, 1, 1); PG8_STAGE(PG8_SB(1, 0), b3, voffB);
            PG8_BAR; PG8_WAIT_L(0); PG8_MMA(0, 1, At, B1); PG8_BAR;
            PG8_LDA(At, 1, 1); PG8_STAGE(PG8_SA(1, 0), a3, voffA);
            PG8_BAR; PG8_WAIT_L(0); PG8_MMA(1, 0, At, B0); PG8_BAR; PG8_SCHED;
            PG8_STAGE(PG8_SB(1, 1), b3 + hstepB, voffB);
            PG8_WAIT_V(6); PG8_BAR; PG8_MMA(1, 1, At, B1); PG8_BAR;
            }
        }
        if constexpr (MX8) asm volatile("s_nop 15\n\ts_nop 15" ::: "memory");
        if constexpr (ALIGN_EPI) { if (wr == 0) PG8_BAR; }
        if constexpr (!Epi::AFTER_DRAIN) { E(acc, cur, wr, wc, fr, fq); S.done(cur); }
        if (!has_next) break;
#pragma unroll
        for (int a = 0; a < 2; ++a)
#pragma unroll
            for (int b = 0; b < 2; ++b)
#pragma unroll
                for (int m = 0; m < 4; ++m)
#pragma unroll
                    for (int n = 0; n < 2; ++n) acc[a][b][m][n] = (f32x4){0.f, 0.f, 0.f, 0.f};
        cur = nxt; cA = nA; cB = nB; ++ui;
        if constexpr (ALIGN_EPI) { if (wr == 1) PG8_BAR; }
    }
    PG8_WAIT_V(0);
    if constexpr (!ALIGN_EPI) { if (wr == 0) PG8_BAR; }
    PG8_BAR;
    if constexpr (Epi::AFTER_DRAIN) { E.fused(acc, cur, wr, wc, fr, fq, lds, wid, lane); S.done(cur); }
#undef PG8_SA
#undef PG8_SB
#undef PG8_STAGE
#undef PG8_CAT
#undef PG8_LDA
#undef PG8_LDB
#undef PG8_MMA
#undef PG8_WAIT_V
#undef PG8_WAIT_L
#undef PG8_BAR
#undef PG8_SCHED
}
}
namespace att {
#define ATT_LAS __attribute__((address_space(3)))
typedef unsigned short bf16;
typedef short bf16x8 __attribute__((ext_vector_type(8)));
typedef short s16x4 __attribute__((ext_vector_type(4)));
typedef float f32x16 __attribute__((ext_vector_type(16)));
typedef unsigned u32x4 __attribute__((ext_vector_type(4)));
typedef ATT_LAS char lchar;
constexpr int KBUF = 12288, VBUF = 16384;
constexpr int L_K = 0, L_V = 2 * KBUF, L_WS = L_V + 2 * VBUF, L_RPB = L_WS + 2048, L_END = L_RPB + 2048;
constexpr float LOG2E = 1.4426950408889634f;
#define ATT_SBAR() __builtin_amdgcn_sched_barrier(0)
__device__ __forceinline__ int crow(int r, int hi) { return (r & 3) + 8 * (r >> 2) + 4 * hi; }
__device__ __forceinline__ unsigned cvtpk(float lo, float hi) { unsigned r; asm volatile("v_cvt_pk_bf16_f32 %0, %1, %2" : "=v"(r) : "v"(lo), "v"(hi)); return r; }
__device__ __forceinline__ int v_st(int k, int c) { const int kk = (k & ~0xC) | ((k & 4) << 1) | ((k & 8) >> 1); return ((kk >> 3) * 4 + (c >> 5)) * 512 + ((kk & 7) * 32 + (c & 31)) * 2; }
__device__ __forceinline__ int v_rd_base(int lane) { return ((lane & 3) << 3) | (((lane >> 2) & 3) << 6) | (((lane >> 4) & 1) << 5) | (((lane >> 5) & 1) << 8); }
constexpr int v_rd_off(int d0, int ks, int half) { return d0 * 512 + ks * 4096 + half * 2048; }
template <int OFF> __device__ __forceinline__ s16x4 tr_read(unsigned vb) {
  s16x4 r; asm volatile("ds_read_b64_tr_b16 %0, %1 offset:%2" : "=&v"(r) : "v"(vb), "i"(OFF) : "memory"); return r;
}
template <int D0> __device__ __forceinline__ void pv_one(f32x16& od, unsigned vb, bf16x8 pa0, bf16x8 pa1, bf16x8 pa2, bf16x8 pa3) {
  const s16x4 l0 = tr_read<v_rd_off(D0, 0, 0)>(vb), h0 = tr_read<v_rd_off(D0, 0, 1)>(vb), l1 = tr_read<v_rd_off(D0, 1, 0)>(vb), h1 = tr_read<v_rd_off(D0, 1, 1)>(vb);
  const s16x4 l2 = tr_read<v_rd_off(D0, 2, 0)>(vb), h2 = tr_read<v_rd_off(D0, 2, 1)>(vb), l3 = tr_read<v_rd_off(D0, 3, 0)>(vb), h3 = tr_read<v_rd_off(D0, 3, 1)>(vb);
  asm volatile("s_waitcnt lgkmcnt(0)" ::: "memory"); ATT_SBAR();
#define ATT_PK(L, H) (bf16x8){L[0], L[1], L[2], L[3], H[0], H[1], H[2], H[3]}
  od = __builtin_amdgcn_mfma_f32_32x32x16_bf16(pa0, ATT_PK(l0, h0), od, 0, 0, 0);
  od = __builtin_amdgcn_mfma_f32_32x32x16_bf16(pa1, ATT_PK(l1, h1), od, 0, 0, 0);
  od = __builtin_amdgcn_mfma_f32_32x32x16_bf16(pa2, ATT_PK(l2, h2), od, 0, 0, 0);
  od = __builtin_amdgcn_mfma_f32_32x32x16_bf16(pa3, ATT_PK(l3, h3), od, 0, 0, 0);
#undef ATT_PK
}

template <int DKC, class U>
__device__ __forceinline__ void unit(const U& u, lchar* lds, int tid) {
  asm volatile("" : "+v"(tid));
  const int lane = tid & 63, r32 = lane & 31, hi = lane >> 5;
  const int wid = __builtin_amdgcn_readfirstlane(tid >> 6);
  lchar* Kl = lds + L_K; lchar* Vl = lds + L_V;
  ATT_LAS float* ws = (ATT_LAS float*)(lds + L_WS) + wid * 64;
  bf16x8 qr[DKC / 2];
#pragma unroll
  for (int d0 = 0; d0 < DKC / 2; ++d0) qr[d0] = *(const bf16x8*)u.qptr(wid, r32, d0, hi);
  const int vrow = tid >> 3, vch = tid & 7, vst = v_st(vrow, vch * 8);
  const int krow0 = tid & 63, kch0 = tid >> 6;
  const bool k2 = (DKC > 8) && (tid < 64 * (DKC - 8));
  const unsigned vb0 = (unsigned)(uintptr_t)Vl + (unsigned)v_rd_base(lane);
  bf16x8 kst0, kst1 = {}, vstr;
  const int NT = u.nt();
#define ATT_SLOAD(t) do { const long R_ = u.krow(t); kst0 = *(const bf16x8*)u.kptr(R_ + krow0, kch0); if (k2) kst1 = *(const bf16x8*)u.kptr(R_ + krow0, 8 + kch0); \
    vstr = *(const bf16x8*)u.vptr(R_ + vrow, vch); } while (0)
#define ATT_SWRITE(b) do { *(ATT_LAS bf16x8*)(Kl + (b) * KBUF + kch0 * 1024 + krow0 * 16) = kst0; if (k2) *(ATT_LAS bf16x8*)(Kl + (b) * KBUF + (8 + kch0) * 1024 + krow0 * 16) = kst1; \
    *(ATT_LAS bf16x8*)(Vl + (b) * VBUF + vst) = vstr; } while (0)
  float m_reg = -1e30f, l_reg = 0.f; f32x16 o[2]; o[0] = f32x16{}; o[1] = f32x16{};
  ATT_SLOAD(0); ATT_SWRITE(0); __syncthreads();
  for (int t = 0; t < NT; ++t) {
    const int buf = t & 1;
    if (t + 1 < NT) ATT_SLOAD(t + 1);
    if (!u.skip(t, wid)) {
      f32x16 p0 = f32x16{}, p1 = f32x16{};
      { const lchar* kb = Kl + buf * KBUF + hi * 1024 + r32 * 16;
#pragma unroll
        for (int d0 = 0; d0 < DKC / 2; ++d0) {
          const bf16x8 b0 = *(const ATT_LAS bf16x8*)(kb + d0 * 2048);
          const bf16x8 b1 = *(const ATT_LAS bf16x8*)(kb + d0 * 2048 + 512);
          p0 = __builtin_amdgcn_mfma_f32_32x32x16_bf16(b0, qr[d0], p0, 0, 0, 0);
          p1 = __builtin_amdgcn_mfma_f32_32x32x16_bf16(b1, qr[d0], p1, 0, 0, 0); } }
      u.mask(p0, p1, t, wid, r32, hi);
      float pmax = p0[0];
#pragma unroll
      for (int r = 1; r < 16; ++r) pmax = fmaxf(pmax, p0[r]);
#pragma unroll
      for (int r = 0; r < 16; ++r) pmax = fmaxf(pmax, p1[r]);
      { auto rr = __builtin_amdgcn_permlane32_swap(__float_as_uint(pmax), __float_as_uint(pmax), false, false);
        pmax = fmaxf(__uint_as_float(rr[0]), __uint_as_float(rr[1])); }
      const float mn = fmaxf(m_reg, pmax);
      const float alpha = __builtin_amdgcn_exp2f(m_reg - mn);
      m_reg = mn;
#pragma unroll
      for (int r = 0; r < 16; ++r) { p0[r] = __builtin_amdgcn_exp2f(p0[r] - mn); p1[r] = __builtin_amdgcn_exp2f(p1[r] - mn); }
      float ps = 0.f;
#pragma unroll
      for (int r = 0; r < 16; ++r) ps += p0[r];
#pragma unroll
      for (int r = 0; r < 16; ++r) ps += p1[r];
      { auto rr = __builtin_amdgcn_permlane32_swap(__float_as_uint(ps), __float_as_uint(ps), false, false);
        ps = __uint_as_float(rr[0]) + __uint_as_float(rr[1]); }
      l_reg = l_reg * alpha + ps;
      if (__any(alpha < 1.f)) {
        if (hi == 0) ws[r32] = alpha;
        asm volatile("s_waitcnt lgkmcnt(0)" ::: "memory");
#pragma unroll
        for (int r = 0; r < 16; ++r) { const float a = ws[crow(r, hi)]; o[0][r] *= a; o[1][r] *= a; }
      }
      bf16x8 pa0, pa1, pa2, pa3;
#define ATT_PK4(P, BASE, OUT) do { unsigned a0 = cvtpk(P[BASE + 0], P[BASE + 1]), a1 = cvtpk(P[BASE + 2], P[BASE + 3]);   \
    unsigned b0 = cvtpk(P[BASE + 4], P[BASE + 5]), b1 = cvtpk(P[BASE + 6], P[BASE + 7]);                              \
    auto r0 = __builtin_amdgcn_permlane32_swap(a0, b0, false, false); auto r1 = __builtin_amdgcn_permlane32_swap(a1, b1, false, false); \
    u32x4 w = {r0[0], r1[0], r0[1], r1[1]}; OUT = __builtin_bit_cast(bf16x8, w); } while (0)
      ATT_PK4(p0, 0, pa0); ATT_PK4(p0, 8, pa1); ATT_PK4(p1, 0, pa2); ATT_PK4(p1, 8, pa3);
#undef ATT_PK4
      const unsigned vb = vb0 + (unsigned)(buf * VBUF);
      pv_one<0>(o[0], vb, pa0, pa1, pa2, pa3); pv_one<1>(o[1], vb, pa0, pa1, pa2, pa3);
    }
    if (t + 1 < NT) ATT_SWRITE(buf ^ 1);
    __syncthreads();
  }
#undef ATT_SLOAD
#undef ATT_SWRITE
  { const float sk = u.sink(wid); l_reg += __builtin_amdgcn_exp2f(sk - m_reg); }
  if (hi == 0) ws[r32] = l_reg;
  asm volatile("s_waitcnt lgkmcnt(0)" ::: "memory");
  float rli[16];
#pragma unroll
  for (int r = 0; r < 16; ++r) rli[r] = __builtin_amdgcn_rcpf(ws[crow(r, hi)]);
#pragma unroll
  for (int r = 0; r < 16; ++r) { bf16* op = u.orow(wid, crow(r, hi));
    op[r32] = (bf16)(cvtpk(o[0][r] * rli[r], 0.f) & 0xffffu); op[32 + r32] = (bf16)(cvtpk(o[1][r] * rli[r], 0.f) & 0xffffu); }
  asm volatile("s_waitcnt lgkmcnt(0)" ::: "memory");
}

constexpr int ROWS_LAT = 16384;
struct UWin {
  const bf16* QKV; bf16* O; const float* sinkp; int b, n, g, hh; int i0, cnt;
  __device__ __forceinline__ void init() { i0 = (n == 0) ? 2 : 0; cnt = (n == 0 || n == 63) ? 4 : 6; }
  __device__ __forceinline__ int nt() const { return 4 + cnt; }
  __device__ __forceinline__ int kpos0(int t) const { return 128 * (n - 1) + 64 * (i0 + t - 4); }
  __device__ __forceinline__ long krow(int t) const { return t < 4 ? (long)(ROWS_LAT + 256 * b + 64 * t) : (long)(8192 * b + kpos0(t)); }
  __device__ __forceinline__ const bf16* kptr(long row, int ch) const { return QKV + row * 2304 + 512 + 64 * g + ch * 8; }
  __device__ __forceinline__ const bf16* vptr(long row, int ch) const { return QKV + row * 2304 + 640 + 64 * g + ch * 8; }
  __device__ __forceinline__ int head(int wid) const { return 4 * g + 2 * hh + (wid >> 2); }
  __device__ __forceinline__ int qpos0(int wid) const { return 128 * n + 32 * (wid & 3); }
  __device__ __forceinline__ const bf16* qptr(int wid, int r32, int d0, int hi) const { return QKV + (long)(8192 * b + qpos0(wid) + r32) * 2304 + 64 * head(wid) + 16 * d0 + 8 * hi; }
  __device__ __forceinline__ bool skip(int t, int wid) const { if (t < 4) return false; const int k0 = kpos0(t), q0 = qpos0(wid); return (k0 + 63 < q0 - 128) || (k0 > q0 + 31 + 128); }
  __device__ __forceinline__ void mask(f32x16& p0, f32x16& p1, int t, int wid, int r32, int hi) const {
    if (t < 4) return;
    const int dq = kpos0(t) - (qpos0(wid) + r32);
#pragma unroll
    for (int r = 0; r < 16; ++r) { const int d = dq + crow(r, hi); if (d > 128 || d < -128) p0[r] = -INFINITY; if (d + 32 > 128 || d + 32 < -128) p1[r] = -INFINITY; }
  }
  __device__ __forceinline__ float sink(int wid) const { return sinkp[head(wid)] * LOG2E; }
  __device__ __forceinline__ bf16* orow(int wid, int row) const { return O + (long)(8192 * b + qpos0(wid) + row) * 1024 + 64 * head(wid); }
};
struct UNa {
  const bf16* QKV; bf16* O; const ATT_LAS float* rpbl; int b, h, R4; int krlo, nloc;
  __device__ __forceinline__ static int clampi(int v, int lo, int hi_) { return v < lo ? lo : (v > hi_ ? hi_ : v); }
  __device__ __forceinline__ void init() { krlo = clampi(4 * R4 - 4, 0, 120); const int krhi = clampi(4 * R4 - 1, 0, 120) + 7; nloc = krhi - krlo + 1; }
  __device__ __forceinline__ int nt() const { return 4 + nloc; }
  __device__ __forceinline__ long krow(int t) const { return t < 4 ? (long)(ROWS_LAT + 256 * b + 64 * t) : (long)(8192 * b + 64 * (krlo + t - 4)); }
  __device__ __forceinline__ const bf16* kptr(long row, int ch) const { return QKV + row * 2304 + 1280 + 64 * h + ch * 8; }
  __device__ __forceinline__ const bf16* vptr(long row, int ch) const { return QKV + row * 2304 + 1792 + 64 * h + ch * 8; }
  __device__ __forceinline__ int qrow(int wid) const { return 4 * R4 + (wid >> 1); }
  __device__ __forceinline__ const bf16* qptr(int wid, int r32, int d0, int hi) const { return QKV + (long)(8192 * b + 64 * qrow(wid) + 32 * (wid & 1) + r32) * 2304 + 768 + 64 * h + 16 * d0 + 8 * hi; }
  __device__ __forceinline__ bool skip(int t, int wid) const { if (t < 4) return false; const int kr = krlo + t - 4, w0 = clampi(qrow(wid) - 4, 0, 120); return kr < w0 || kr > w0 + 7; }
  __device__ __forceinline__ void mask(f32x16& p0, f32x16& p1, int t, int wid, int r32, int hi) const {
    if (t < 4) return;
    const int kr = krlo + t - 4, qc = 32 * (wid & 1) + r32, c0 = clampi(qc - 8, 0, 48);
    const ATT_LAS float* brow = rpbl + (kr - qrow(wid) + 7) * 31 + 15;
#pragma unroll
    for (int r = 0; r < 16; ++r) {
      { const int kc = crow(r, hi); const bool ok = kc >= c0 && kc < c0 + 16; const float bv = brow[clampi(kc - qc, -15, 15)]; p0[r] = ok ? p0[r] + bv : -INFINITY; }
      { const int kc = 32 + crow(r, hi); const bool ok = kc >= c0 && kc < c0 + 16; const float bv = brow[clampi(kc - qc, -15, 15)]; p1[r] = ok ? p1[r] + bv : -INFINITY; } }
  }
  __device__ __forceinline__ float sink(int) const { return -INFINITY; }
  __device__ __forceinline__ bf16* orow(int wid, int row) const { return O + (long)(8192 * b + 64 * qrow(wid) + 32 * (wid & 1) + row) * 1024 + 512 + 64 * h; }
};
struct UCtx {
  const bf16* QKV; bf16* O; const float* sinkp; int b, hx; int qcol, kcol, vcol, ocol;
  __device__ __forceinline__ void init() { if (hx < 8) { qcol = 64 * hx; kcol = 512 + 64 * (hx >> 2); vcol = 640 + 64 * (hx >> 2); ocol = 64 * hx; }
    else { const int h = hx - 8; qcol = 768 + 64 * h; kcol = 1280 + 64 * h; vcol = 1792 + 64 * h; ocol = 512 + 64 * h; } }
  __device__ __forceinline__ int nt() const { return 4; }
  __device__ __forceinline__ long krow(int t) const { return (long)(ROWS_LAT + 256 * b + 64 * t); }
  __device__ __forceinline__ const bf16* kptr(long row, int ch) const { return QKV + row * 2304 + kcol + ch * 8; }
  __device__ __forceinline__ const bf16* vptr(long row, int ch) const { return QKV + row * 2304 + vcol + ch * 8; }
  __device__ __forceinline__ const bf16* qptr(int wid, int r32, int d0, int hi) const { return QKV + (long)(ROWS_LAT + 256 * b + 32 * wid + r32) * 2304 + qcol + 16 * d0 + 8 * hi; }
  __device__ __forceinline__ bool skip(int, int) const { return false; }
  __device__ __forceinline__ void mask(f32x16&, f32x16&, int, int, int, int) const {}
  __device__ __forceinline__ float sink(int) const { return hx < 8 ? sinkp[hx] * LOG2E : -INFINITY; }
  __device__ __forceinline__ bf16* orow(int wid, int row) const { return O + (long)(ROWS_LAT + 256 * b + 32 * wid + row) * 1024 + ocol; }
};
struct UDense {
  const bf16* Q; const bf16* KV; const bf16* KR; bf16* O; int b, h, qb;
  __device__ __forceinline__ int nt() const { return 132; }
  __device__ __forceinline__ long krow(int t) const { return t < 4 ? (long)(ROWS_LAT + 256 * b + 64 * t) : (long)(8192 * b + 64 * (t - 4)); }
  __device__ __forceinline__ const bf16* kptr(long row, int ch) const { return ch < 8 ? KV + row * 2048 + 64 * h + ch * 8 : KR + row * 32 + (ch - 8) * 8; }
  __device__ __forceinline__ const bf16* vptr(long row, int ch) const { return KV + row * 2048 + 1024 + 64 * h + ch * 8; }
  __device__ __forceinline__ const bf16* qptr(int wid, int r32, int d0, int hi) const { const bf16* qp = Q + (long)(8192 * b + 256 * qb + 32 * wid + r32) * 1536;
    return d0 < 4 ? qp + 64 * h + 16 * d0 + 8 * hi : qp + 1024 + 32 * h + 16 * (d0 - 4) + 8 * hi; }
  __device__ __forceinline__ bool skip(int, int) const { return false; }
  __device__ __forceinline__ void mask(f32x16&, f32x16&, int, int, int, int) const {}
  __device__ __forceinline__ float sink(int) const { return -INFINITY; }
  __device__ __forceinline__ bf16* orow(int wid, int row) const { return O + (long)(8192 * b + 256 * qb + 32 * wid + row) * 1024 + 64 * h; }
};
#undef ATT_SBAR
}
namespace attd {
typedef unsigned short bf16;
using bf16x8 = __attribute__((ext_vector_type(8))) short;
using s16x4 = __attribute__((ext_vector_type(4))) short;
using f32x16 = __attribute__((ext_vector_type(16))) float;
using u32x4 = __attribute__((ext_vector_type(4))) unsigned;
using i32x2 = __attribute__((ext_vector_type(2))) int;
using i32x4 = __attribute__((ext_vector_type(4))) int;
using i32x8 = __attribute__((ext_vector_type(8))) int;
using u32x6 = __attribute__((ext_vector_type(6))) unsigned;
using u32x16 = __attribute__((ext_vector_type(16))) unsigned;
typedef __bf16 bf16x32 __attribute__((ext_vector_type(32)));
constexpr int NW = 8, NT = 132, KSLOT = 5120, VSLOT = 8192;
constexpr int LDS_K = 0, LDS_V = 3 * KSLOT, LDS_WS = LDS_V + 3 * VSLOT, LDS_OST = LDS_WS + NW * 64 * 4, LDS_BYTES = LDS_OST + NW * 4096;
__device__ __forceinline__ int crow(int r, int hi) { return (r & 3) + 8 * (r >> 2) + 4 * hi; }
#define AF_SBAR() __builtin_amdgcn_sched_barrier(0)
__device__ __forceinline__ void glds16(unsigned voff, const void* sbase, unsigned lds_dst) { unsigned keep;
  asm volatile("s_mov_b32 %0, m0\n\ts_mov_b32 m0, %3\n\ts_nop 0\n\tglobal_load_lds_dwordx4 %1, %2\n\ts_mov_b32 m0, %0" : "=&s"(keep) : "v"(voff), "s"(sbase), "s"(lds_dst) : "memory"); }
typedef float f32x2_t __attribute__((ext_vector_type(2))); typedef __bf16 bf16x2_t __attribute__((ext_vector_type(2)));
__device__ __forceinline__ unsigned cvtpk_s(float lo, float hi) { f32x2_t v = {lo, hi}; bf16x2_t b = __builtin_convertvector(v, bf16x2_t); return __builtin_bit_cast(unsigned, b); }
#define AF_WAIT_BAR(N) asm volatile("s_waitcnt vmcnt(" #N ") lgkmcnt(0)\n\ts_barrier" ::: "memory")
typedef __attribute__((address_space(3))) const char* lds_cptr;
typedef short v4i16_t __attribute__((ext_vector_type(4)));
__device__ __forceinline__ i32x8 ld6(lds_cptr p16, lds_cptr p8) { const i32x4 a = *(const __attribute__((address_space(3))) i32x4*)p16; const i32x2 b = *(const __attribute__((address_space(3))) i32x2*)p8;
  return (i32x8){a.x, a.y, a.z, a.w, b.x, b.y, 0, 0}; }
__device__ __forceinline__ s16x4 vtr(lds_cptr p) { return __builtin_bit_cast(s16x4, __builtin_amdgcn_ds_read_tr16_b64_v4i16((__attribute__((address_space(3))) v4i16_t*)p)); }
__device__ __forceinline__ long tile_row(int b, int t) { return t < 4 ? (long)(16384 + 256 * b + 64 * t) : (long)(8192 * b + 64 * (t - 4)); }
__device__ __forceinline__ u32x6 to_fp6(u32x4 a0, u32x4 a1, u32x4 a2, u32x4 a3) { const u32x16 all = {a0.x, a0.y, a0.z, a0.w, a1.x, a1.y, a1.z, a1.w, a2.x, a2.y, a2.z, a2.w, a3.x, a3.y, a3.z, a3.w};
  return __builtin_amdgcn_cvt_scalef32_pk32_fp6_bf16(__builtin_bit_cast(bf16x32, all), 1.0f); }

__device__ __forceinline__ void dense_unit(int b, int h, int qb, const bf16* Q, const bf16* __restrict__ KV, const char* __restrict__ K6N, const char* __restrict__ K6R, bf16* O, char* shm, const int tid) {
  const int lane = tid & 63, r32 = lane & 31, hi = lane >> 5; const int wid = __builtin_amdgcn_readfirstlane(tid >> 6);
  const unsigned lds0 = (unsigned)(uintptr_t)shm;
  float* wsf = (float*)(shm + LDS_WS) + wid * 64;
  const bool wnp = wid < 3 || wid >= 5; const int pc = wnp ? (wid < 3 ? wid : wid - 5) : wid - 3;
  const unsigned voffK = (unsigned)(lane * 16);
  const char* sK = wnp ? K6N + h * 3072 + pc * 1024 : K6R + pc * 1024; const long kts = wnp ? 16 * 3072 : 2048;
  const unsigned voffV = (unsigned)((16 * (wid & 3) + (lane >> 2)) * 2048 + (wid >> 2) * 32 + (lane & 3) * 8) * 2u;
  const char* sV = (const char*)(KV + 1024 + 64 * h);
  const unsigned kdst = lds0 + LDS_K + (wnp ? pc * 1024 : 3072 + pc * 1024), vdst = lds0 + LDS_V + wid * 1024;
#define AF_DMA_K(t, ks) do { const long G_ = tile_row(b, (t)) >> 6; glds16(voffK, sK + G_ * kts, (unsigned)__builtin_amdgcn_readfirstlane(kdst + (ks))); } while (0)
#define AF_DMA_V(t, vs) do { const long R_ = tile_row(b, (t)); glds16(voffV, sV + R_ * 4096, (unsigned)__builtin_amdgcn_readfirstlane(vdst + (vs))); } while (0)
  const lds_cptr shm3 = (lds_cptr)shm;
  const lds_cptr kp16 = shm3 + LDS_K + hi * 1024 + r32 * 16;
  const lds_cptr kp8 = shm3 + LDS_K + 2048 + hi * 512 + r32 * 8;
  const lds_cptr vp0 = shm3 + LDS_V + ((lane >> 4) & 1) * 32 + (lane & 3) * 8 + (4 * hi + ((lane & 15) >> 2)) * 64;
  AF_DMA_K(0, 0); AF_DMA_V(0, 0); AF_DMA_K(1, KSLOT); AF_DMA_K(2, 2 * KSLOT);
  i32x8 qn, qr;
  { const bf16* qp = Q + (long)(8192 * b + 256 * qb + 32 * wid + r32) * 1536; const bf16* qa = qp + 64 * h + 32 * hi; const bf16* qc = qp + 1024 + 32 * h;
    const u32x6 n6 = to_fp6(*reinterpret_cast<const u32x4*>(qa), *reinterpret_cast<const u32x4*>(qa + 8), *reinterpret_cast<const u32x4*>(qa + 16), *reinterpret_cast<const u32x4*>(qa + 24));
    u32x6 r6 = to_fp6(*reinterpret_cast<const u32x4*>(qc), *reinterpret_cast<const u32x4*>(qc + 8), *reinterpret_cast<const u32x4*>(qc + 16), *reinterpret_cast<const u32x4*>(qc + 24));
    if (hi) r6 = (u32x6){0u, 0u, 0u, 0u, 0u, 0u};
    qn = (i32x8){(int)n6[0], (int)n6[1], (int)n6[2], (int)n6[3], (int)n6[4], (int)n6[5], 0, 0}; qr = (i32x8){(int)r6[0], (int)r6[1], (int)r6[2], (int)r6[3], (int)r6[4], (int)r6[5], 0, 0}; }
  float l_reg = 0.f; f32x16 o[2]; o[0] = f32x16{}; o[1] = f32x16{};
  f32x16 pA0, pA1, pB0, pB1; i32x8 kn0, kn1, kr0, kr1;
  int s_prev = 0, s_cur = 0, s_next = 1;
#define AF_ROT() do { s_prev = s_cur; s_cur = s_next; s_next = (s_next == 2) ? 0 : s_next + 1; } while (0)
#define AF_MF(a, b, c) __builtin_amdgcn_mfma_f32_32x32x16_bf16(a, b, c, 0, 0, 0)
  int sck_ = 0x7b7b7b7b, scq_ = 0x7f7f7f7f; asm volatile("" : "+v"(sck_), "+v"(scq_));
#define AF_MX(a, b, c) __builtin_amdgcn_mfma_scale_f32_32x32x64_f8f6f4(a, b, c, 2, 2, 0, sck_, 0, scq_)
#define AF_EX(v) __builtin_amdgcn_exp2f(v)
  const f32x16 zero16 = f32x16{};
  AF_WAIT_BAR(0);
  { pA0 = AF_MX(ld6(kp16, kp8), qn, zero16); pA1 = AF_MX(ld6(kp16 + 512, kp8 + 256), qn, zero16);
    pA0 = AF_MX(ld6(kp16 + 3072, kp8 + 2048), qr, pA0); pA1 = AF_MX(ld6(kp16 + 3072 + 512, kp8 + 2048 + 256), qr, pA1);
#pragma unroll
    for (int r = 0; r < 16; ++r) { pA0[r] = AF_EX(pA0[r]); pA1[r] = AF_EX(pA1[r]); } }
  AF_WAIT_BAR(0);
  AF_DMA_K(3, 0); AF_DMA_V(1, VSLOT);
  AF_ROT();
  { const lds_cptr k16_ = kp16 + s_cur * KSLOT, k8_ = kp8 + s_cur * KSLOT; kn0 = ld6(k16_, k8_); kn1 = ld6(k16_ + 512, k8_ + 256); kr0 = ld6(k16_ + 3072, k8_ + 2048); kr1 = ld6(k16_ + 3072 + 512, k8_ + 2048 + 256); }
  AF_WAIT_BAR(2);
  s16x4 vlo[8], vhi[8]; u32x4 pw0, pw1, pw2, pw3;
#define AF_PKW(P, B) cvtpk_s(P[B], P[B + 1])
#define AF_PAF(k) __builtin_bit_cast(bf16x8, pw##k)
#define AF_VFR(i) (bf16x8){vlo[i][0], vlo[i][1], vlo[i][2], vlo[i][3], vhi[i][0], vhi[i][1], vhi[i][2], vhi[i][3]}
#define AF_PIN(x) asm volatile("" : "+v"(x))
#define AF_VRD(i) do { vlo[i] = vtr(vp_ + (((i) >> 2) * 4096 + ((i) & 3) * 1024)); vhi[i] = vtr(vp_ + (((i) >> 2) * 4096 + ((i) & 3) * 1024 + 512)); AF_SBAR(); } while (0)
#define AF_GB(MF, X, B) do { MF; X[B] = AF_EX(X[B]); X[B + 1] = AF_EX(X[B + 1]); X[B + 2] = AF_EX(X[B + 2]); X[B + 3] = AF_EX(X[B + 3]); AF_PIN(X); AF_SBAR(); } while (0)
#define AF_KRD(G, j) do { if (G) { const lds_cptr k16_ = kp16 + s_next * KSLOT, k8_ = kp8 + s_next * KSLOT; \
      if ((j) == 0) kn0 = ld6(k16_, k8_); if ((j) == 1) kn1 = ld6(k16_ + 512, k8_ + 256); \
      if ((j) == 2) kr0 = ld6(k16_ + 3072, k8_ + 2048); if ((j) == 3) kr1 = ld6(k16_ + 3072 + 512, k8_ + 2048 + 256); AF_SBAR(); } } while (0)
#define AF_A4(P, B) do { sacc += P[B]; sacc += P[B + 1]; sacc += P[B + 2]; sacc += P[B + 3]; } while (0)
#define AF_STEP(C0, C1, P0, P1, t, GK, GV, GL) do { AF_SBAR(); \
    const lds_cptr vp_ = vp0 + s_prev * VSLOT; \
    float sacc = (P0[0] + P0[1]); \
    AF_VRD(0); AF_VRD(4); \
    { C0 = AF_MX(kn0, qn, zero16); sacc += P0[2]; sacc += P0[3]; AF_A4(P0, 4); AF_PIN(sacc); \
      pw0[0] = AF_PKW(P0, 0); pw0[1] = AF_PKW(P0, 2); pw0[2] = AF_PKW(P0, 4); pw0[3] = AF_PKW(P0, 6); AF_PIN(pw0); AF_SBAR(); } \
    AF_VRD(1); AF_VRD(5); \
    { C1 = AF_MX(kn1, qn, zero16); AF_A4(P0, 8); AF_A4(P0, 12); AF_PIN(sacc); \
      pw1[0] = AF_PKW(P0, 8); pw1[1] = AF_PKW(P0, 10); pw1[2] = AF_PKW(P0, 12); pw1[3] = AF_PKW(P0, 14); AF_PIN(pw1); AF_SBAR(); } \
    AF_VRD(2); AF_VRD(6); \
    { C0 = AF_MX(kr0, qr, C0); AF_A4(P1, 0); AF_A4(P1, 4); AF_PIN(sacc); \
      pw2[0] = AF_PKW(P1, 0); pw2[1] = AF_PKW(P1, 2); pw2[2] = AF_PKW(P1, 4); pw2[3] = AF_PKW(P1, 6); AF_PIN(pw2); AF_SBAR(); } \
    if (GK) { AF_DMA_K((t) + 3, s_cur * KSLOT); AF_SBAR(); } \
    AF_VRD(3); AF_VRD(7); \
    { C1 = AF_MX(kr1, qr, C1); AF_A4(P1, 8); AF_A4(P1, 12); AF_PIN(sacc); \
      pw3[0] = AF_PKW(P1, 8); pw3[1] = AF_PKW(P1, 10); pw3[2] = AF_PKW(P1, 12); pw3[3] = AF_PKW(P1, 14); AF_PIN(pw3); AF_SBAR(); } \
    if (GV) { AF_DMA_V((t) + 1, s_next * VSLOT); AF_SBAR(); } \
    l_reg += sacc; \
    AF_SBAR(); \
    AF_GB(o[0] = AF_MF(AF_PAF(0), AF_VFR(0), o[0]), C0, 0);  AF_KRD(GL, 0); \
    AF_GB(o[1] = AF_MF(AF_PAF(0), AF_VFR(4), o[1]), C0, 4);  AF_KRD(GL, 1); \
    AF_GB(o[0] = AF_MF(AF_PAF(1), AF_VFR(1), o[0]), C0, 8);  AF_KRD(GL, 2); \
    AF_GB(o[1] = AF_MF(AF_PAF(1), AF_VFR(5), o[1]), C0, 12); AF_KRD(GL, 3); \
    AF_GB(o[0] = AF_MF(AF_PAF(2), AF_VFR(2), o[0]), C1, 0); \
    AF_GB(o[1] = AF_MF(AF_PAF(2), AF_VFR(6), o[1]), C1, 4); \
    AF_GB(o[0] = AF_MF(AF_PAF(3), AF_VFR(3), o[0]), C1, 8); \
    AF_GB(o[1] = AF_MF(AF_PAF(3), AF_VFR(7), o[1]), C1, 12); \
  } while (0)
  int t = 1;
  for (; t + 3 < NT; t += 2) {
    AF_STEP(pB0, pB1, pA0, pA1, t, true, true, true);     AF_WAIT_BAR(2); AF_ROT();
    AF_STEP(pA0, pA1, pB0, pB1, t + 1, true, true, true); AF_WAIT_BAR(2); AF_ROT();
  }
  AF_STEP(pB0, pB1, pA0, pA1, NT - 3, false, true, true);  AF_WAIT_BAR(1); AF_ROT();
  AF_STEP(pA0, pA1, pB0, pB1, NT - 2, false, true, true);  AF_WAIT_BAR(0); AF_ROT();
  AF_STEP(pB0, pB1, pA0, pA1, NT - 1, false, false, false);
  { float sacc = pB0[0] + pB0[1];
#pragma unroll
    for (int r = 2; r < 16; ++r) sacc += pB0[r];
#pragma unroll
    for (int r = 0; r < 16; ++r) sacc += pB1[r];
    l_reg += sacc;
    pw0 = (u32x4){AF_PKW(pB0, 0), AF_PKW(pB0, 2), AF_PKW(pB0, 4), AF_PKW(pB0, 6)}; pw1 = (u32x4){AF_PKW(pB0, 8), AF_PKW(pB0, 10), AF_PKW(pB0, 12), AF_PKW(pB0, 14)};
    pw2 = (u32x4){AF_PKW(pB1, 0), AF_PKW(pB1, 2), AF_PKW(pB1, 4), AF_PKW(pB1, 6)}; pw3 = (u32x4){AF_PKW(pB1, 8), AF_PKW(pB1, 10), AF_PKW(pB1, 12), AF_PKW(pB1, 14)};
    AF_SBAR();
    const lds_cptr vp_ = vp0 + s_cur * VSLOT;
#pragma unroll
    for (int i = 0; i < 8; ++i) { vlo[i] = vtr(vp_ + ((i >> 2) * 4096 + (i & 3) * 1024)); vhi[i] = vtr(vp_ + ((i >> 2) * 4096 + (i & 3) * 1024 + 512)); }
    o[0] = AF_MF(AF_PAF(0), AF_VFR(0), o[0]); o[1] = AF_MF(AF_PAF(0), AF_VFR(4), o[1]);
    o[0] = AF_MF(AF_PAF(1), AF_VFR(1), o[0]); o[1] = AF_MF(AF_PAF(1), AF_VFR(5), o[1]);
    o[0] = AF_MF(AF_PAF(2), AF_VFR(2), o[0]); o[1] = AF_MF(AF_PAF(2), AF_VFR(6), o[1]);
    o[0] = AF_MF(AF_PAF(3), AF_VFR(3), o[0]); o[1] = AF_MF(AF_PAF(3), AF_VFR(7), o[1]); }
  { auto rr = __builtin_amdgcn_permlane32_swap(__float_as_uint(l_reg), __float_as_uint(l_reg), false, false); l_reg = __uint_as_float(rr[0]) + __uint_as_float(rr[1]); }
  if (hi == 0) wsf[32 + r32] = l_reg; asm volatile("s_waitcnt lgkmcnt(0)" ::: "memory");
  float rli[16];
#pragma unroll
  for (int r = 0; r < 16; ++r) rli[r] = __builtin_amdgcn_rcpf(wsf[32 + crow(r, hi)]);
  bf16* Ow = O + (long)(8192 * b + 256 * qb + 32 * wid) * 1024 + 64 * h;
  { bf16* stg = (bf16*)(shm + LDS_OST) + wid * 2048;
#pragma unroll
    for (int r = 0; r < 16; ++r) { const int orow = crow(r, hi);
#pragma unroll
      for (int d0 = 0; d0 < 2; ++d0) stg[orow * 64 + d0 * 32 + r32] = (bf16)(cvtpk_s(o[d0][r] * rli[r], 0.f) & 0xffffu); }
    asm volatile("s_waitcnt lgkmcnt(0)" ::: "memory");
#pragma unroll
    for (int i = 0; i < 4; ++i) { const int row = i * 8 + (lane >> 3), ch = lane & 7; const u32x4 v = *(const u32x4*)(stg + row * 64 + ch * 8); *(u32x4*)(Ow + (long)row * 1024 + ch * 8) = v; } }
  asm volatile("s_waitcnt vmcnt(0) lgkmcnt(0)\n\ts_barrier" ::: "memory");
#undef AF_DMA_K
#undef AF_DMA_V
#undef AF_ROT
#undef AF_PKW
#undef AF_PAF
#undef AF_VFR
#undef AF_PIN
#undef AF_MF
#undef AF_MX
#undef AF_EX
#undef AF_VRD
#undef AF_GB
#undef AF_KRD
#undef AF_A4
#undef AF_STEP
}
#undef AF_SBAR
#undef AF_WAIT_BAR
}
namespace attf {
typedef unsigned short bf16;
using bf16x8 = __attribute__((ext_vector_type(8))) short;
using s16x4 = __attribute__((ext_vector_type(4))) short;
using f32x16 = __attribute__((ext_vector_type(16))) float;
using u32x4 = __attribute__((ext_vector_type(4))) unsigned;
using i32x2 = __attribute__((ext_vector_type(2))) int;
using i32x4 = __attribute__((ext_vector_type(4))) int;
using i32x8 = __attribute__((ext_vector_type(8))) int;
using u32x6 = __attribute__((ext_vector_type(6))) unsigned;
using u32x16 = __attribute__((ext_vector_type(16))) unsigned;
typedef __bf16 bf16x32 __attribute__((ext_vector_type(32)));
constexpr int NW = 8, KSLOT = 12288, VSLOT = 8192;
constexpr int LDS_K = 0, LDS_V = 3 * KSLOT, LDS_WS = LDS_V + 3 * VSLOT, LDS_OST = LDS_WS + NW * 64 * 4, LDS_RPB = LDS_OST + NW * 4096, LDS_BYTES = LDS_RPB + 2048;
__device__ __forceinline__ int crow(int r, int hi) { return (r & 3) + 8 * (r >> 2) + 4 * hi; }
#define AF_SBAR() __builtin_amdgcn_sched_barrier(0)
__device__ __forceinline__ void glds16(unsigned voff, const void* sbase, unsigned lds_dst) { unsigned keep;
  asm volatile("s_mov_b32 %0, m0\n\ts_mov_b32 m0, %3\n\ts_nop 0\n\tglobal_load_lds_dwordx4 %1, %2\n\ts_mov_b32 m0, %0" : "=&s"(keep) : "v"(voff), "s"(sbase), "s"(lds_dst) : "memory"); }
typedef float f32x2_t __attribute__((ext_vector_type(2))); typedef __bf16 bf16x2_t __attribute__((ext_vector_type(2)));
__device__ __forceinline__ unsigned cvtpk_s(float lo, float hi) { f32x2_t v = {lo, hi}; bf16x2_t b = __builtin_convertvector(v, bf16x2_t); return __builtin_bit_cast(unsigned, b); }
#define AF_WAIT_BAR(N) asm volatile("s_waitcnt vmcnt(" #N ") lgkmcnt(0)\n\ts_barrier" ::: "memory")
typedef __attribute__((address_space(3))) const char* lds_cptr;
typedef short v4i16_t __attribute__((ext_vector_type(4)));
__device__ __forceinline__ void kload2(bf16x8* kf, lds_cptr kp, int j) { kf[2 * j] = *(const __attribute__((address_space(3))) bf16x8*)(kp + j * 2048); kf[2 * j + 1] = *(const __attribute__((address_space(3))) bf16x8*)(kp + j * 2048 + 512); }
__device__ __forceinline__ i32x8 ld6(lds_cptr p16, lds_cptr p8) { const i32x4 a = *(const __attribute__((address_space(3))) i32x4*)p16; const i32x2 b = *(const __attribute__((address_space(3))) i32x2*)p8;
  const i32x4 b4 = __builtin_shufflevector(b, b, 0, 1, -1, -1); return __builtin_shufflevector(a, b4, 0, 1, 2, 3, 4, 5, -1, -1); }
__device__ __forceinline__ i32x8 to_fp6(u32x4 a0, u32x4 a1, u32x4 a2, u32x4 a3) { const u32x16 all = {a0.x, a0.y, a0.z, a0.w, a1.x, a1.y, a1.z, a1.w, a2.x, a2.y, a2.z, a2.w, a3.x, a3.y, a3.z, a3.w};
  const u32x6 c = __builtin_amdgcn_cvt_scalef32_pk32_fp6_bf16(__builtin_bit_cast(bf16x32, all), 1.0f); return __builtin_bit_cast(i32x8, __builtin_shufflevector(c, c, 0, 1, 2, 3, 4, 5, -1, -1)); }
__device__ __forceinline__ s16x4 vtr(lds_cptr p) { return __builtin_bit_cast(s16x4, __builtin_amdgcn_ds_read_tr16_b64_v4i16((__attribute__((address_space(3))) v4i16_t*)p)); }

template <int DKC, class U, bool F6 = false>
__device__ __forceinline__ void fast_unit(const U& u, char* shm, int tid) {
  static_assert(DKC == 8 || DKC == 12, "q/k dim 64 or 96"); static_assert(!F6 || DKC == 8, "fp6 logits: q/k dim 64");
  asm volatile("" : "+v"(tid));
  constexpr int ND0 = DKC / 2;
  const int lane = tid & 63, r32 = lane & 31, hi = lane >> 5; const int wid = __builtin_amdgcn_readfirstlane(tid >> 6);
  const unsigned lds0 = (unsigned)(uintptr_t)shm;
  float* wsf = (float*)(shm + LDS_WS) + wid * 64;
  const int NT = u.nt();
  const unsigned voffKA = (unsigned)(lane * u.kpitch + 8 * wid) * 2u;
  const unsigned voffKB = (unsigned)(lane * 32 + 8 * (wid & 3)) * 2u;
  const unsigned voffV = (unsigned)((16 * (wid & 3) + (lane >> 2)) * u.vpitch + (wid >> 2) * 32 + (lane & 3) * 8) * 2u;
  const unsigned kdstA = lds0 + LDS_K + wid * 1024, kdstB = lds0 + LDS_K + (8 + (wid & 3)) * 1024, vdst = lds0 + LDS_V + wid * 1024;
  const int pc6 = wid % 3; const unsigned voffK6 = (unsigned)(lane * 16), kdst6 = lds0 + LDS_K + pc6 * 1024;
#define AF_DMA_KA(t, ks) do { const long R_ = u.trow(t); if constexpr (F6) glds16(voffK6, u.k6base + (R_ >> 6) * 30720 + pc6 * 1024, (unsigned)__builtin_amdgcn_readfirstlane(kdst6 + (ks))); \
    else glds16(voffKA, (const char*)u.kbase + R_ * (2 * u.kpitch), (unsigned)__builtin_amdgcn_readfirstlane(kdstA + (ks))); } while (0)
#define AF_DMA_KB(t, ks) do { if constexpr (DKC == 12) { const long R_ = u.trow(t); glds16(voffKB, (const char*)u.krbase + R_ * 64, (unsigned)__builtin_amdgcn_readfirstlane(kdstB + (ks))); } } while (0)
#define AF_DMA_K(t, ks) do { AF_DMA_KA(t, ks); AF_DMA_KB(t, ks); } while (0)
#define AF_DMA_V(t, vs) do { const long R_ = u.trow(t); glds16(voffV, (const char*)u.vbase + R_ * (2 * u.vpitch), (unsigned)__builtin_amdgcn_readfirstlane(vdst + (vs))); } while (0)
#define AF_WAITN(NSTEPS_K, NV) do { if constexpr (DKC == 12) { if ((NSTEPS_K) == 2 && (NV) == 1) AF_WAIT_BAR(5); else if ((NSTEPS_K) == 1 && (NV) == 1) AF_WAIT_BAR(3); else if ((NV) == 1) AF_WAIT_BAR(1); else AF_WAIT_BAR(0); } \
    else { if ((NSTEPS_K) == 2 && (NV) == 1) AF_WAIT_BAR(3); else if ((NSTEPS_K) == 1 && (NV) == 1) AF_WAIT_BAR(2); else if ((NV) == 1) AF_WAIT_BAR(1); else AF_WAIT_BAR(0); } } while (0)
  const lds_cptr shm3 = (lds_cptr)shm; const lds_cptr kp0 = shm3 + LDS_K + hi * 1024 + r32 * 16;
  const lds_cptr kp8 = shm3 + LDS_K + 2048 + hi * 512 + r32 * 8;
  const lds_cptr vp0 = shm3 + LDS_V + ((lane >> 4) & 1) * 32 + (lane & 3) * 8 + (4 * hi + ((lane & 15) >> 2)) * 64;
  bf16x8 qr[ND0]; i32x8 qn; u32x4 qw0_, qw1_, qw2_, qw3_;
  if constexpr (F6) { const bf16* qa = u.qptr(wid, r32, 0, 0) + 32 * hi;
    qw0_ = *reinterpret_cast<const u32x4*>(qa); qw1_ = *reinterpret_cast<const u32x4*>(qa + 8); qw2_ = *reinterpret_cast<const u32x4*>(qa + 16); qw3_ = *reinterpret_cast<const u32x4*>(qa + 24); }
  else {
#pragma unroll
    for (int d0 = 0; d0 < ND0; ++d0) qr[d0] = *reinterpret_cast<const bf16x8*>(u.qptr(wid, r32, d0, hi)); }
  AF_DMA_K(0, 0); AF_DMA_V(0, 0); AF_DMA_K(1, KSLOT); AF_DMA_K(2, 2 * KSLOT);
  if constexpr (F6) qn = to_fp6(qw0_, qw1_, qw2_, qw3_);
  float l_reg = 0.f; f32x16 o[2]; o[0] = f32x16{}; o[1] = f32x16{};
  f32x16 pA0, pA1, pB0, pB1; bf16x8 kf[DKC]; i32x8 kn0, kn1;
  int sck_ = 0x7b7b7b7b, scq_ = 0x7f7f7f7f; asm volatile("" : "+v"(sck_), "+v"(scq_));
#define AF_MX6(a, b, c) __builtin_amdgcn_mfma_scale_f32_32x32x64_f8f6f4(a, b, c, 2, 2, 0, sck_, 0, scq_)
  int s_prev = 0, s_cur = 0, s_next = 1;
#define AF_ROT() do { s_prev = s_cur; s_cur = s_next; s_next = (s_next == 2) ? 0 : s_next + 1; } while (0)
  AF_WAITN(2, 1);
  { const char* kb = shm + LDS_K + hi * 1024 + r32 * 16; pA0 = f32x16{}; pA1 = f32x16{};
    if constexpr (F6) { pA0 = AF_MX6(ld6(kp0, kp8), qn, pA0); pA1 = AF_MX6(ld6(kp0 + 512, kp8 + 256), qn, pA1); }
    else
#pragma unroll
    for (int d0 = 0; d0 < ND0; ++d0) { const bf16x8 b0 = *reinterpret_cast<const bf16x8*>(kb + d0 * 2048), b1 = *reinterpret_cast<const bf16x8*>(kb + d0 * 2048 + 512);
      pA0 = __builtin_amdgcn_mfma_f32_32x32x16_bf16(b0, qr[d0], pA0, 0, 0, 0); pA1 = __builtin_amdgcn_mfma_f32_32x32x16_bf16(b1, qr[d0], pA1, 0, 0, 0); }
    if constexpr (U::HAS_MASK) u.mask(pA0, pA1, 0, wid, r32, hi);
#pragma unroll
    for (int r = 0; r < 16; ++r) { pA0[r] = __builtin_amdgcn_exp2f(pA0[r]); pA1[r] = __builtin_amdgcn_exp2f(pA1[r]); } }
  AF_WAIT_BAR(0);
  AF_DMA_K(3, 0); AF_DMA_V(1, VSLOT);
  AF_ROT();
  if constexpr (F6) { kn0 = ld6(kp0 + s_cur * KSLOT, kp8 + s_cur * KSLOT); kn1 = ld6(kp0 + s_cur * KSLOT + 512, kp8 + s_cur * KSLOT + 256); }
  else {
#pragma unroll
    for (int j = 0; j < ND0; ++j) kload2(kf, kp0 + s_cur * KSLOT, j); }
  AF_WAITN(1, 1);
  s16x4 vlo[8], vhi[8]; u32x4 pw0, pw1, pw2, pw3;
#define AF_PKW(P, B) cvtpk_s(P[B], P[B + 1])
#define AF_PAF(k) __builtin_bit_cast(bf16x8, pw##k)
#define AF_VFR(i) (bf16x8){vlo[i][0], vlo[i][1], vlo[i][2], vlo[i][3], vhi[i][0], vhi[i][1], vhi[i][2], vhi[i][3]}
#define AF_PIN(x) asm volatile("" : "+v"(x))
#define AF_MF(a, b, c) __builtin_amdgcn_mfma_f32_32x32x16_bf16(a, b, c, 0, 0, 0)
#define AF_EX(v) __builtin_amdgcn_exp2f(v)
#define AF_VRD(i) do { vlo[i] = vtr(vp_ + (((i) >> 2) * 4096 + ((i) & 3) * 1024)); vhi[i] = vtr(vp_ + (((i) >> 2) * 4096 + ((i) & 3) * 1024 + 512)); AF_SBAR(); } while (0)
#define AF_GA4(MF, A0, A1, A2, A3, W0, W1, PW) do { MF; sacc += A0; sacc += A1; sacc += A2; sacc += A3; AF_PIN(sacc); W0; W1; AF_PIN(PW); AF_SBAR(); } while (0)
#define AF_GA3(MF, A0, A1, A2, W0, W1, PW) do { MF; sacc += A0; sacc += A1; sacc += A2; AF_PIN(sacc); W0; W1; AF_PIN(PW); AF_SBAR(); } while (0)
#define AF_GA2(MF, A0, A1, W0, PW) do { MF; sacc += A0; sacc += A1; AF_PIN(sacc); W0; AF_PIN(PW); AF_SBAR(); } while (0)
#define AF_GB(MF, X, B) do { MF; X[B] = AF_EX(X[B]); X[B + 1] = AF_EX(X[B + 1]); X[B + 2] = AF_EX(X[B + 2]); X[B + 3] = AF_EX(X[B + 3]); AF_PIN(X); AF_SBAR(); } while (0)
#define AF_KRD(G, j) do { if constexpr (F6) { if ((j) < 2) { if (G) { if ((j) == 0) kn0 = ld6(kp0 + s_next * KSLOT, kp8 + s_next * KSLOT); else kn1 = ld6(kp0 + s_next * KSLOT + 512, kp8 + s_next * KSLOT + 256); AF_SBAR(); } } } \
    else if ((j) < ND0) { if (G) { kload2(kf, kp0 + s_next * KSLOT, (j) < ND0 ? (j) : 0); AF_SBAR(); } } } while (0)
  const f32x16 zero16 = f32x16{};
#define AF_PHASE_A12(C0, C1, P0, P1, t, GK, GV) do { \
    AF_VRD(0); float sacc = (P0[0] + P0[1]); \
    AF_GA3(C0 = AF_MF(kf[0], qr[0], zero16), P0[2], P0[3], P0[4],     pw0[0] = AF_PKW(P0, 0), pw0[1] = AF_PKW(P0, 2), pw0); \
    AF_VRD(4); AF_GA3(C1 = AF_MF(kf[1], qr[0], zero16), P0[5], P0[6], P0[7],     pw0[2] = AF_PKW(P0, 4), pw0[3] = AF_PKW(P0, 6), pw0); \
    AF_VRD(1); AF_GA3(C0 = AF_MF(kf[2], qr[1], C0),     P0[8], P0[9], P0[10],    pw1[0] = AF_PKW(P0, 8), pw1[1] = AF_PKW(P0, 10), pw1); \
    AF_VRD(5); AF_GA3(C1 = AF_MF(kf[3], qr[1], C1),     P0[11], P0[12], P0[13],  pw1[2] = AF_PKW(P0, 12), pw1[3] = AF_PKW(P0, 14), pw1); \
    AF_VRD(2); AF_GA3(C0 = AF_MF(kf[4], qr[2], C0),     P0[14], P0[15], P1[0],   pw2[0] = AF_PKW(P1, 0), pw2[1] = AF_PKW(P1, 2), pw2); \
    AF_VRD(6); AF_GA3(C1 = AF_MF(kf[5], qr[2], C1),     P1[1], P1[2], P1[3],     pw2[2] = AF_PKW(P1, 4), pw2[3] = AF_PKW(P1, 6), pw2); \
    AF_VRD(3); AF_GA2(C0 = AF_MF(kf[6], qr[3], C0),     P1[4], P1[5],            pw3[0] = AF_PKW(P1, 8), pw3); \
    AF_VRD(7); AF_GA2(C1 = AF_MF(kf[7], qr[3], C1),     P1[6], P1[7],            pw3[1] = AF_PKW(P1, 10), pw3); \
    AF_GA2(C0 = AF_MF(kf[8 % DKC], qr[4 % ND0], C0),    P1[8], P1[9],            pw3[2] = AF_PKW(P1, 12), pw3); \
    if (GK) { AF_DMA_KA((t) + 3, s_cur * KSLOT); AF_SBAR(); } \
    AF_GA2(C1 = AF_MF(kf[9 % DKC], qr[4 % ND0], C1),    P1[10], P1[11],          pw3[3] = AF_PKW(P1, 14), pw3); \
    if (GK) { AF_DMA_KB((t) + 3, s_cur * KSLOT); AF_SBAR(); } \
    { C0 = AF_MF(kf[10 % DKC], qr[5 % ND0], C0); sacc += P1[12]; sacc += P1[13]; AF_PIN(sacc); AF_SBAR(); } \
    if (GV) { AF_DMA_V((t) + 1, s_next * VSLOT); AF_SBAR(); } \
    { C1 = AF_MF(kf[11 % DKC], qr[5 % ND0], C1); sacc += P1[14]; sacc += P1[15]; AF_PIN(sacc); AF_SBAR(); } \
    l_reg += sacc; } while (0)
#define AF_PHASE_A8(C0, C1, P0, P1, t, GK, GV) do { \
    AF_VRD(0); float sacc = (P0[0] + P0[1]); \
    AF_GA4(C0 = AF_MF(kf[0], qr[0], zero16), P0[2], P0[3], P0[4], P0[5],       pw0[0] = AF_PKW(P0, 0), pw0[1] = AF_PKW(P0, 2), pw0); \
    AF_VRD(4); AF_GA4(C1 = AF_MF(kf[1], qr[0], zero16), P0[6], P0[7], P0[8], P0[9],       pw0[2] = AF_PKW(P0, 4), pw0[3] = AF_PKW(P0, 6), pw0); \
    AF_VRD(1); AF_GA4(C0 = AF_MF(kf[2], qr[1], C0),     P0[10], P0[11], P0[12], P0[13],   pw1[0] = AF_PKW(P0, 8), pw1[1] = AF_PKW(P0, 10), pw1); \
    AF_VRD(5); AF_GA4(C1 = AF_MF(kf[3], qr[1], C1),     P0[14], P0[15], P1[0], P1[1],     pw1[2] = AF_PKW(P0, 12), pw1[3] = AF_PKW(P0, 14), pw1); \
    AF_VRD(2); AF_GA4(C0 = AF_MF(kf[4], qr[2], C0),     P1[2], P1[3], P1[4], P1[5],       pw2[0] = AF_PKW(P1, 0), pw2[1] = AF_PKW(P1, 2), pw2); \
    AF_VRD(6); AF_GA4(C1 = AF_MF(kf[5], qr[2], C1),     P1[6], P1[7], P1[8], P1[9],       pw2[2] = AF_PKW(P1, 4), pw2[3] = AF_PKW(P1, 6), pw2); \
    AF_VRD(3); AF_GA4(C0 = AF_MF(kf[6], qr[3], C0),     P1[10], P1[11], P1[12], P1[13],   pw3[0] = AF_PKW(P1, 8), pw3[1] = AF_PKW(P1, 10), pw3); \
    AF_VRD(7); AF_GA4(C1 = AF_MF(kf[7], qr[3], C1),     P1[14], P1[15], 0.f, 0.f,         pw3[2] = AF_PKW(P1, 12), pw3[3] = AF_PKW(P1, 14), pw3); \
    l_reg += sacc; \
    if (GK) { AF_DMA_KA((t) + 3, s_cur * KSLOT); } if (GV) { AF_DMA_V((t) + 1, s_next * VSLOT); } } while (0)
#define AF_A4(P, B) do { sacc += P[B]; sacc += P[B + 1]; sacc += P[B + 2]; sacc += P[B + 3]; } while (0)
#define AF_PHASE_A6(C0, C1, P0, P1, t, GK, GV) do { \
    AF_VRD(0); AF_VRD(4); float sacc = (P0[0] + P0[1]); \
    { C0 = AF_MX6(kn0, qn, zero16); sacc += P0[2]; sacc += P0[3]; AF_A4(P0, 4); AF_A4(P0, 8); AF_A4(P0, 12); AF_PIN(sacc); \
      pw0[0] = AF_PKW(P0, 0); pw0[1] = AF_PKW(P0, 2); pw0[2] = AF_PKW(P0, 4); pw0[3] = AF_PKW(P0, 6); AF_PIN(pw0); pw1[0] = AF_PKW(P0, 8); pw1[1] = AF_PKW(P0, 10); pw1[2] = AF_PKW(P0, 12); pw1[3] = AF_PKW(P0, 14); AF_PIN(pw1); AF_SBAR(); } \
    AF_VRD(1); AF_VRD(5); AF_VRD(2); AF_VRD(6); \
    { C1 = AF_MX6(kn1, qn, zero16); AF_A4(P1, 0); AF_A4(P1, 4); AF_A4(P1, 8); AF_A4(P1, 12); AF_PIN(sacc); \
      pw2[0] = AF_PKW(P1, 0); pw2[1] = AF_PKW(P1, 2); pw2[2] = AF_PKW(P1, 4); pw2[3] = AF_PKW(P1, 6); AF_PIN(pw2); pw3[0] = AF_PKW(P1, 8); pw3[1] = AF_PKW(P1, 10); pw3[2] = AF_PKW(P1, 12); pw3[3] = AF_PKW(P1, 14); AF_PIN(pw3); AF_SBAR(); } \
    AF_VRD(3); AF_VRD(7); \
    l_reg += sacc; \
    if (GK) { AF_DMA_KA((t) + 3, s_cur * KSLOT); } if (GV) { AF_DMA_V((t) + 1, s_next * VSLOT); } } while (0)
#define AF_STEP(C0, C1, P0, P1, t, GK, GV, GL) do { AF_SBAR(); \
    const lds_cptr vp_ = vp0 + s_prev * VSLOT; \
    if constexpr (F6) AF_PHASE_A6(C0, C1, P0, P1, t, GK, GV); else if constexpr (DKC == 12) AF_PHASE_A12(C0, C1, P0, P1, t, GK, GV); else AF_PHASE_A8(C0, C1, P0, P1, t, GK, GV); \
    if constexpr (U::HAS_MASK) u.mask(C0, C1, (t), wid, r32, hi); \
    AF_SBAR(); \
    AF_GB(o[0] = AF_MF(AF_PAF(0), AF_VFR(0), o[0]), C0, 0);  AF_KRD(GL, 0); \
    AF_GB(o[1] = AF_MF(AF_PAF(0), AF_VFR(4), o[1]), C0, 4);  AF_KRD(GL, 1); \
    AF_GB(o[0] = AF_MF(AF_PAF(1), AF_VFR(1), o[0]), C0, 8);  AF_KRD(GL, 2); \
    AF_GB(o[1] = AF_MF(AF_PAF(1), AF_VFR(5), o[1]), C0, 12); AF_KRD(GL, 3); \
    AF_GB(o[0] = AF_MF(AF_PAF(2), AF_VFR(2), o[0]), C1, 0);  AF_KRD(GL, 4); \
    AF_GB(o[1] = AF_MF(AF_PAF(2), AF_VFR(6), o[1]), C1, 4);  AF_KRD(GL, 5); \
    AF_GB(o[0] = AF_MF(AF_PAF(3), AF_VFR(3), o[0]), C1, 8); \
    AF_GB(o[1] = AF_MF(AF_PAF(3), AF_VFR(7), o[1]), C1, 12); \
  } while (0)
  int t = 1;
  for (; t + 3 < NT; t += 2) {
    AF_STEP(pB0, pB1, pA0, pA1, t, true, true, true);     AF_WAITN(1, 1); AF_ROT();
    AF_STEP(pA0, pA1, pB0, pB1, t + 1, true, true, true); AF_WAITN(1, 1); AF_ROT();
  }
  AF_STEP(pB0, pB1, pA0, pA1, NT - 3, false, true, true);  AF_WAITN(0, 1); AF_ROT();
  AF_STEP(pA0, pA1, pB0, pB1, NT - 2, false, true, true);  AF_WAIT_BAR(0); AF_ROT();
  AF_STEP(pB0, pB1, pA0, pA1, NT - 1, false, false, false);
  { float sacc = pB0[0] + pB0[1];
#pragma unroll
    for (int r = 2; r < 16; ++r) sacc += pB0[r];
#pragma unroll
    for (int r = 0; r < 16; ++r) sacc += pB1[r];
    l_reg += sacc;
    pw0 = (u32x4){AF_PKW(pB0, 0), AF_PKW(pB0, 2), AF_PKW(pB0, 4), AF_PKW(pB0, 6)}; pw1 = (u32x4){AF_PKW(pB0, 8), AF_PKW(pB0, 10), AF_PKW(pB0, 12), AF_PKW(pB0, 14)};
    pw2 = (u32x4){AF_PKW(pB1, 0), AF_PKW(pB1, 2), AF_PKW(pB1, 4), AF_PKW(pB1, 6)}; pw3 = (u32x4){AF_PKW(pB1, 8), AF_PKW(pB1, 10), AF_PKW(pB1, 12), AF_PKW(pB1, 14)};
    AF_SBAR();
    const lds_cptr vp_ = vp0 + s_cur * VSLOT;
#pragma unroll
    for (int i = 0; i < 8; ++i) { vlo[i] = vtr(vp_ + ((i >> 2) * 4096 + (i & 3) * 1024)); vhi[i] = vtr(vp_ + ((i >> 2) * 4096 + (i & 3) * 1024 + 512)); }
    o[0] = AF_MF(AF_PAF(0), AF_VFR(0), o[0]); o[1] = AF_MF(AF_PAF(0), AF_VFR(4), o[1]);
    o[0] = AF_MF(AF_PAF(1), AF_VFR(1), o[0]); o[1] = AF_MF(AF_PAF(1), AF_VFR(5), o[1]);
    o[0] = AF_MF(AF_PAF(2), AF_VFR(2), o[0]); o[1] = AF_MF(AF_PAF(2), AF_VFR(6), o[1]);
    o[0] = AF_MF(AF_PAF(3), AF_VFR(3), o[0]); o[1] = AF_MF(AF_PAF(3), AF_VFR(7), o[1]); }
  { auto rr = __builtin_amdgcn_permlane32_swap(__float_as_uint(l_reg), __float_as_uint(l_reg), false, false); l_reg = __uint_as_float(rr[0]) + __uint_as_float(rr[1]); }
  l_reg += __builtin_amdgcn_exp2f(u.sink(wid));
  if (hi == 0) wsf[32 + r32] = l_reg; asm volatile("s_waitcnt lgkmcnt(0)" ::: "memory");
  float rli[16];
#pragma unroll
  for (int r = 0; r < 16; ++r) rli[r] = __builtin_amdgcn_rcpf(wsf[32 + crow(r, hi)]);
  bf16* Ow = u.orow0(wid);
  { bf16* stg = (bf16*)(shm + LDS_OST) + wid * 2048;
#pragma unroll
    for (int r = 0; r < 16; ++r) { const int orow = crow(r, hi);
#pragma unroll
      for (int d0 = 0; d0 < 2; ++d0) stg[orow * 64 + d0 * 32 + r32] = (bf16)(cvtpk_s(o[d0][r] * rli[r], 0.f) & 0xffffu); }
    asm volatile("s_waitcnt lgkmcnt(0)" ::: "memory");
#pragma unroll
    for (int i = 0; i < 4; ++i) { const int row = i * 8 + (lane >> 3), ch = lane & 7; const u32x4 v = *(const u32x4*)(stg + row * 64 + ch * 8); *(u32x4*)(Ow + (long)row * 1024 + ch * 8) = v; } }
  asm volatile("s_waitcnt vmcnt(0) lgkmcnt(0)\n\ts_barrier" ::: "memory");
#undef AF_DMA_KA
#undef AF_DMA_KB
#undef AF_DMA_K
#undef AF_DMA_V
#undef AF_WAITN
#undef AF_ROT
#undef AF_PKW
#undef AF_PAF
#undef AF_VFR
#undef AF_PIN
#undef AF_MF
#undef AF_EX
#undef AF_VRD
#undef AF_GA4
#undef AF_GA3
#undef AF_GA2
#undef AF_GB
#undef AF_KRD
#undef AF_PHASE_A12
#undef AF_PHASE_A8
#undef AF_PHASE_A6
#undef AF_A4
#undef AF_MX6
#undef AF_STEP
}

constexpr int ROWS_LAT = 16384;
constexpr float LOG2E_ = 1.4426950408889634f;
__device__ __forceinline__ int clampi(int v, int lo, int hi_) { return v < lo ? lo : (v > hi_ ? hi_ : v); }
struct FDense {
  static constexpr bool HAS_MASK = false;
  const bf16* Q; const bf16* kbase; const bf16* vbase; const bf16* krbase; bf16* O; int b, h, qb; static constexpr int kpitch = 2048, vpitch = 2048; const char* k6base = nullptr;
  __device__ __forceinline__ void init(const bf16* Q_, const bf16* KV, const bf16* KR, bf16* O_, int b_, int h_, int qb_) { Q = Q_; kbase = KV + 64 * h_; vbase = KV + 1024 + 64 * h_; krbase = KR; O = O_; b = b_; h = h_; qb = qb_; }
  __device__ __forceinline__ int nt() const { return 132; }
  __device__ __forceinline__ long trow(int t) const { return t < 4 ? (long)(ROWS_LAT + 256 * b + 64 * t) : (long)(8192 * b + 64 * (t - 4)); }
  __device__ __forceinline__ const bf16* qptr(int wid, int r32, int d0, int hi) const { const bf16* qp = Q + (long)(8192 * b + 256 * qb + 32 * wid + r32) * 1536;
    return d0 < 4 ? qp + 64 * h + 16 * d0 + 8 * hi : qp + 1024 + 32 * h + 16 * (d0 - 4) + 8 * hi; }
  __device__ __forceinline__ void mask(f32x16&, f32x16&, int, int, int, int) const {}
  __device__ __forceinline__ float sink(int) const { return -INFINITY; }
  __device__ __forceinline__ bf16* orow0(int wid) const { return O + (long)(8192 * b + 256 * qb + 32 * wid) * 1024 + 64 * h; }
};
struct FWin {
  static constexpr bool HAS_MASK = true; static constexpr int kpitch = 2304, vpitch = 2304;
  const bf16* QKV; const bf16* kbase; const bf16* vbase; const bf16* krbase; bf16* O; const float* sinkp; int b, n, g, hh, i0, cnt; const char* k6base;
  __device__ __forceinline__ void init(const bf16* QKV_, bf16* O_, const float* sk, int b_, int n_, int g_, int hh_, const char* K6E = nullptr) { QKV = QKV_; O = O_; sinkp = sk; b = b_; n = n_; g = g_; hh = hh_; krbase = nullptr; k6base = K6E + g_ * 3072;
    kbase = QKV_ + 512 + 64 * g_; vbase = QKV_ + 640 + 64 * g_; i0 = (n_ == 0) ? 2 : 0; cnt = (n_ == 0 || n_ == 63) ? 4 : 6; }
  __device__ __forceinline__ int nt() const { return 4 + cnt; }
  __device__ __forceinline__ int kpos0(int t) const { return 128 * (n - 1) + 64 * (i0 + t - 4); }
  __device__ __forceinline__ long trow(int t) const { return t < 4 ? (long)(ROWS_LAT + 256 * b + 64 * t) : (long)(8192 * b + kpos0(t)); }
  __device__ __forceinline__ int head(int wid) const { return 4 * g + 2 * hh + (wid >> 2); }
  __device__ __forceinline__ int qpos0(int wid) const { return 128 * n + 32 * (wid & 3); }
  __device__ __forceinline__ const bf16* qptr(int wid, int r32, int d0, int hi) const { return QKV + (long)(8192 * b + qpos0(wid) + r32) * 2304 + 64 * head(wid) + 16 * d0 + 8 * hi; }
  __device__ __forceinline__ void mask(f32x16& p0, f32x16& p1, int t, int wid, int r32, int hi) const {
    if (t < 4) return;
    const int k0 = kpos0(t), q0 = qpos0(wid);
    if (k0 - (q0 + 31) >= -128 && k0 + 63 - q0 <= 128) return;
    asm volatile("" : "+v"(r32), "+v"(hi));
    const int dq = k0 - (q0 + r32);
#pragma unroll
    for (int r = 0; r < 16; ++r) { const int d = dq + crow(r, hi); if (d > 128 || d < -128) p0[r] = -INFINITY; if (d + 32 > 128 || d + 32 < -128) p1[r] = -INFINITY; }
  }
  __device__ __forceinline__ float sink(int wid) const { return sinkp[head(wid)] * LOG2E_; }
  __device__ __forceinline__ bf16* orow0(int wid) const { return O + (long)(8192 * b + qpos0(wid)) * 1024 + 64 * head(wid); }
};
struct FNa {
  static constexpr bool HAS_MASK = true; static constexpr int kpitch = 2304, vpitch = 2304;
  const bf16* QKV; const bf16* kbase; const bf16* vbase; const bf16* krbase; bf16* O; const float* rpbl; int b, h, R4, krlo, nloc; const char* k6base;
  __device__ __forceinline__ void init(const bf16* QKV_, bf16* O_, const float* rpbl_, int b_, int h_, int R4_, const char* K6E = nullptr) { QKV = QKV_; O = O_; rpbl = rpbl_; b = b_; h = h_; R4 = R4_; krbase = nullptr; k6base = K6E + (2 + h_) * 3072;
    kbase = QKV_ + 1280 + 64 * h_; vbase = QKV_ + 1792 + 64 * h_; krlo = clampi(4 * R4_ - 4, 0, 120); nloc = clampi(4 * R4_ - 1, 0, 120) + 7 - krlo + 1; }
  __device__ __forceinline__ int nt() const { return (4 + nloc + 1) & ~1; }
  __device__ __forceinline__ long trow(int t) const { return (t < 4 || t >= 4 + nloc) ? (long)(ROWS_LAT + 256 * b + 64 * (t & 3)) : (long)(8192 * b + 64 * (krlo + t - 4)); }
  __device__ __forceinline__ int qrow(int wid) const { return 4 * R4 + (wid >> 1); }
  __device__ __forceinline__ const bf16* qptr(int wid, int r32, int d0, int hi) const { return QKV + (long)(8192 * b + 64 * qrow(wid) + 32 * (wid & 1) + r32) * 2304 + 768 + 64 * h + 16 * d0 + 8 * hi; }
  __device__ __forceinline__ void mask(f32x16& p0, f32x16& p1, int t, int wid, int r32, int hi) const {
    if (t < 4) return;
    const int kr = krlo + t - 4, w0 = clampi(qrow(wid) - 4, 0, 120);
    if (t >= 4 + nloc || kr < w0 || kr > w0 + 7) {
#pragma unroll
      for (int r = 0; r < 16; ++r) { p0[r] = -INFINITY; p1[r] = -INFINITY; }
      return; }
    asm volatile("" : "+v"(r32), "+v"(hi));
    const int qc = 32 * (wid & 1) + r32, c0 = clampi(qc - 8, 0, 48);
    const float* pb = rpbl + (kr - qrow(wid) + 7) * 31 + 15 - qc + 4 * hi;
    const unsigned t0 = (unsigned)(4 * hi - c0);
#define AF_PIN16(a) asm volatile("" : "+v"(a[0]), "+v"(a[1]), "+v"(a[2]), "+v"(a[3]), "+v"(a[4]), "+v"(a[5]), "+v"(a[6]), "+v"(a[7]), "+v"(a[8]), "+v"(a[9]), "+v"(a[10]), "+v"(a[11]), "+v"(a[12]), "+v"(a[13]), "+v"(a[14]), "+v"(a[15]))
    float bv[16];
#pragma unroll
    for (int r = 0; r < 16; ++r) bv[r] = pb[(r & 3) + 8 * (r >> 2)];
    AF_PIN16(bv);
#pragma unroll
    for (int r = 0; r < 16; ++r) { const bool ok = (t0 + (unsigned)((r & 3) + 8 * (r >> 2))) < 16u; p0[r] = ok ? p0[r] + bv[r] : -INFINITY; }
#pragma unroll
    for (int r = 0; r < 16; ++r) bv[r] = pb[32 + (r & 3) + 8 * (r >> 2)];
    AF_PIN16(bv);
#pragma unroll
    for (int r = 0; r < 16; ++r) { const bool ok = (t0 + (unsigned)(32 + (r & 3) + 8 * (r >> 2))) < 16u; p1[r] = ok ? p1[r] + bv[r] : -INFINITY; }
#undef AF_PIN16
  }
  __device__ __forceinline__ float sink(int) const { return -INFINITY; }
  __device__ __forceinline__ bf16* orow0(int wid) const { return O + (long)(8192 * b + 64 * qrow(wid) + 32 * (wid & 1)) * 1024 + 512 + 64 * h; }
};
struct FCtx {
  static constexpr bool HAS_MASK = false; static constexpr int kpitch = 2304, vpitch = 2304;
  const bf16* QKV; const bf16* kbase; const bf16* vbase; const bf16* krbase; bf16* O; const float* sinkp; int b, hx, qcol, ocol; const char* k6base;
  __device__ __forceinline__ void init(const bf16* QKV_, bf16* O_, const float* sk, int b_, int hx_, const char* K6E = nullptr) { QKV = QKV_; O = O_; sinkp = sk; b = b_; hx = hx_; krbase = nullptr; k6base = K6E + (hx_ < 8 ? (hx_ >> 2) : 2 + (hx_ - 8)) * 3072;
    if (hx_ < 8) { qcol = 64 * hx_; kbase = QKV_ + 512 + 64 * (hx_ >> 2); vbase = QKV_ + 640 + 64 * (hx_ >> 2); ocol = 64 * hx_; }
    else { const int h = hx_ - 8; qcol = 768 + 64 * h; kbase = QKV_ + 1280 + 64 * h; vbase = QKV_ + 1792 + 64 * h; ocol = 512 + 64 * h; } }
  __device__ __forceinline__ int nt() const { return 4; }
  __device__ __forceinline__ long trow(int t) const { return (long)(ROWS_LAT + 256 * b + 64 * (t & 3)); }
  __device__ __forceinline__ const bf16* qptr(int wid, int r32, int d0, int hi) const { return QKV + (long)(ROWS_LAT + 256 * b + 32 * wid + r32) * 2304 + qcol + 16 * d0 + 8 * hi; }
  __device__ __forceinline__ void mask(f32x16&, f32x16&, int, int, int, int) const {}
  __device__ __forceinline__ float sink(int) const { return hx < 8 ? sinkp[hx] * LOG2E_ : -INFINITY; }
  __device__ __forceinline__ bf16* orow0(int wid) const { return O + (long)(ROWS_LAT + 256 * b + 32 * wid) * 1024 + ocol; }
};
#undef AF_SBAR
#undef AF_WAIT_BAR
}
constexpr int NWAVES = 8;
#ifndef MK_PER_PHASE
#define MK_PER_PHASE 0
#endif
constexpr int BATCH = 2, SEQ = 8192, DM = 1024, CTXL = 256, FF = 4096;
constexpr int ML = BATCH * SEQ, MC = BATCH * CTXL, MR = ML + MC;
constexpr int NQKV = 2304, NCIN = 768, NUQ = 1536, NUKV = 2048;
constexpr float NORM_EPS = 1e-6f;
constexpr int ADA_KS = 16;
constexpr size_t MiB = 1u << 20;
constexpr size_t WS_CTL = 0, CTL_ZERO_BYTES = 64 * 1024;
constexpr size_t WS_MODP = 1 * MiB;
constexpr size_t WS_MOD = 3 * MiB + 512 * 1024;
constexpr size_t WS_ROPE = 3 * MiB + 768 * 1024;
constexpr size_t WS_ROPEP = WS_ROPE + 64 * 1024;
constexpr size_t WS_HPAR = WS_ROPE + 32 * 1024;
constexpr size_t WS_CTXRES = 4 * MiB;
constexpr size_t WS_WQKV = 6 * MiB, WS_WO0 = WS_WQKV + 4608 * 1024, WS_W1_0 = WS_WO0 + 2 * MiB, WS_W2_0 = WS_W1_0 + 8 * MiB, WS_W1_1 = WS_W2_0 + 8 * MiB, WS_W2_1 = WS_W1_1 + 8 * MiB;
constexpr size_t WS_WIN = WS_W2_1 + 8 * MiB, WS_WUQ = WS_WIN + 1536 * 1024, WS_WUKV = WS_WUQ + 1152 * 1024, WS_WO1 = WS_WUKV + 1 * MiB, WS_WEND = WS_WO1 + 2 * MiB;
constexpr size_t WS_AR = 51 * MiB;
static_assert(WS_WEND <= WS_AR, "weights overlap the arena");
constexpr size_t WS_XN = WS_AR, WS_H = WS_AR + 33 * MiB;
constexpr size_t WS_QKV = WS_AR + 33 * MiB, WS_O0 = WS_AR + 108 * MiB;
constexpr size_t WS_CQKV = WS_AR + 33 * MiB, WS_CQN = WS_AR + 58 * MiB, WS_CKVN = WS_AR + 71 * MiB, WS_KR = WS_AR + 80 * MiB, WS_Q1 = WS_AR + 82 * MiB, WS_KV1 = WS_AR + 130 * MiB, WS_O1 = WS_AR;
constexpr size_t WS_K6E = WS_AR + 150 * MiB;
constexpr size_t WS_K6N = WS_AR + 34 * MiB, WS_K6R = WS_AR + 48 * MiB;
constexpr size_t WS_PART5 = WS_AR + 33 * MiB;
constexpr size_t WS_XR = WS_AR + 166 * MiB;
constexpr size_t WS_PART8 = WS_AR + 166 * MiB;
constexpr size_t WS_END = 256 * MiB;
static_assert(WS_PART8 + (size_t)16 * 512 * 1024 * 4 <= WS_END && WS_KV1 + (size_t)MR * NUKV * 2 <= WS_END && WS_H + (size_t)MR * FF * 2 <= WS_END, "d_ws map");
constexpr int CW_BAR = 4096;
constexpr int RING_OFF = 0, RING_BYTES = 131072;
constexpr int LDSCTL_OFF = RING_BYTES, MISC_OFF = LDSCTL_OFF + 320;
constexpr int LDS_BYTES = 147456;
static_assert(att::L_END <= RING_BYTES && attf::LDS_BYTES <= RING_BYTES, "attention LDS");

#define GAS __attribute__((address_space(1)))
#define LAS __attribute__((address_space(3)))
typedef unsigned short bf16;
typedef unsigned v4u __attribute__((ext_vector_type(4)));
typedef unsigned v2u __attribute__((ext_vector_type(2)));
typedef float f32x4 __attribute__((ext_vector_type(4)));
typedef GAS unsigned gu32;
#define RLX_AGENT __ATOMIC_RELAXED, __HIP_MEMORY_SCOPE_AGENT
#define LDS_WAIT() asm volatile("s_waitcnt lgkmcnt(0)" ::: "memory")
#define VM_WAIT() asm volatile("s_waitcnt vmcnt(0)" ::: "memory")
__device__ __forceinline__ unsigned f2bf(float f) { unsigned u = __builtin_bit_cast(unsigned, f); return (u + 0x7fffu + ((u >> 16) & 1u)) >> 16; }
__device__ __forceinline__ unsigned pk2(float lo, float hi) { return f2bf(lo) | (f2bf(hi) << 16); }
__device__ __forceinline__ float bf2f(unsigned short h) { return __builtin_bit_cast(float, (unsigned)h << 16); }
__device__ __forceinline__ float bflo(unsigned w) { return __builtin_bit_cast(float, w << 16); }
__device__ __forceinline__ float bfhi(unsigned w) { return __builtin_bit_cast(float, w & 0xffff0000u); }

#define XB_TMO      128
#define XB_XCNT(j)  (256  + 64 * (j))
#define XB_XSUB(j)  (1280 + 64 * (j))
#define XB_XGEN(j)  (2304 + 64 * (j))
#define XB_TOP      3328
#define XB_TOPGEN   3392
#define XCD_BAR_WORDS 3456
#define XB_SPIN_CAP (1u << 18)

__device__ __forceinline__ unsigned xb_ld(unsigned* p)              { return __hip_atomic_load(p, __ATOMIC_RELAXED, __HIP_MEMORY_SCOPE_AGENT); }
__device__ __forceinline__ unsigned xb_add(unsigned* p, unsigned v) { return __hip_atomic_fetch_add(p, v, __ATOMIC_RELAXED, __HIP_MEMORY_SCOPE_AGENT); }
__device__ __forceinline__ unsigned xb_xcc_id() { return (unsigned)__builtin_amdgcn_s_getreg((3 << 11) | 20) & 0xFu; }
#define XB_SPIN(cond, bar) do { unsigned _sp = 0; while (cond) { __builtin_amdgcn_s_sleep(1); \
    if ((++_sp & 255u) == 0u) { if (xb_ld(&(bar)[XB_TMO])) break; if (_sp > XB_SPIN_CAP) { atomicAdd(&(bar)[XB_TMO], 1u); break; } } } } while (0)

struct XcdBarrier {
    unsigned* bar; unsigned x;
    volatile LAS unsigned* st;
};

__device__ __forceinline__ XcdBarrier xcd_barrier_post(unsigned* bar, volatile LAS unsigned* st) {
    XcdBarrier b; b.bar = bar; b.x = xb_xcc_id(); b.st = st;
    if (threadIdx.x == 0) (void)xb_add(&bar[XB_XCNT(b.x)], 1u);
    return b;
}
__device__ __forceinline__ void xcd_barrier_complete(unsigned* bar, unsigned x, unsigned& nloc, unsigned& nx) {
    const unsigned G = gridDim.x * gridDim.y * gridDim.z;
    unsigned sum, cnt, mine, sp = 0u;
    for (;;) {
        sum = 0u; cnt = 0u; mine = 0u;
#pragma unroll
        for (unsigned j = 0; j < 16; ++j) { const unsigned c = xb_ld(&bar[XB_XCNT(j)]); sum += c; cnt += (c > 0u) ? 1u : 0u; mine = (j == x) ? c : mine; }
        if (sum == G) break;
        __builtin_amdgcn_s_sleep(1);
        if ((++sp & 255u) == 0u) { if (xb_ld(&bar[XB_TMO])) break; if (sp > XB_SPIN_CAP) { atomicAdd(&bar[XB_TMO], 1u); break; } }
    }
    nloc = mine > 0u ? mine : 1u; nx = cnt > 0u ? cnt : 1u;
}

__device__ __forceinline__ void xcd_barrier(const XcdBarrier& b) {
    asm volatile("s_waitcnt vmcnt(0)" ::: "memory");
    __syncthreads();
    if (threadIdx.x == 0) {
        unsigned* bar = b.bar;
        __builtin_amdgcn_s_waitcnt(0);
        unsigned nloc = b.st[0], nx = b.st[1];
        if (nloc == 0u) { xcd_barrier_complete(bar, b.x, nloc, nx); b.st[0] = nloc; b.st[1] = nx; }
        const unsigned old = xb_add(&bar[XB_XSUB(b.x)], 1u);
        const unsigned gen = old / nloc;
        if (old + 1u == (gen + 1u) * nloc) {
            __builtin_amdgcn_fence(__ATOMIC_RELEASE, "agent");
            asm volatile("s_waitcnt vmcnt(0)" ::: "memory");
            const unsigned og = xb_add(&bar[XB_TOP], 1u);
            const unsigned tg = og / nx;
            if (og + 1u == (tg + 1u) * nx) xb_add(&bar[XB_TOPGEN], 1u);
            else XB_SPIN(xb_ld(&bar[XB_TOPGEN]) == tg, bar);
            __builtin_amdgcn_fence(__ATOMIC_ACQUIRE, "agent");
            xb_add(&bar[XB_XGEN(b.x)], 1u);
            asm volatile("s_waitcnt vmcnt(0)" ::: "memory");
        } else {
            XB_SPIN(xb_ld(&bar[XB_XGEN(b.x)]) == gen, bar);
            __builtin_amdgcn_fence(__ATOMIC_ACQUIRE, "agent");
            asm volatile("s_waitcnt vmcnt(0)" ::: "memory");
        }
    }
    __syncthreads();
}


template <int K> __device__ __forceinline__ const float* ldarg() {
    auto ka = __builtin_amdgcn_kernarg_segment_ptr();
    const __attribute__((address_space(1))) float* p; asm volatile("s_load_dwordx2 %0, %1, %2\n\ts_waitcnt lgkmcnt(0)" : "=s"(p) : "s"(ka), "i"(K * 8) : "memory"); return (const float*)p;
}
#define ARG(k) (ldarg<k>())
#define ARG_OUT ((float*)ldarg<28>())
#define ARG_WS ((unsigned char*)ldarg<29>())
struct Frame {
    LAS unsigned char* lds;
    volatile LAS unsigned* MISC;
    gu32* ctl;
    int tid, lane, wave;
    int vcu, G, bx;
    float* out; unsigned char* ws;
};
__device__ __forceinline__ float shx(float v, int mask, int lane) { return __builtin_bit_cast(float, __builtin_amdgcn_ds_bpermute((lane ^ mask) << 2, __builtin_bit_cast(int, v))); }
__device__ __forceinline__ float wave_sum(float v, int lane) {
    (void)lane;
#define WS_ROR(x, n) __builtin_bit_cast(float, __builtin_amdgcn_update_dpp(0, __builtin_bit_cast(int, x), 0x120 | (n), 0xf, 0xf, false))
    v += WS_ROR(v, 8); v += WS_ROR(v, 4); v += WS_ROR(v, 2); v += WS_ROR(v, 1);
#undef WS_ROR
    const int b = __builtin_bit_cast(int, v);
    return (__builtin_bit_cast(float, __builtin_amdgcn_readlane(b, 0)) + __builtin_bit_cast(float, __builtin_amdgcn_readlane(b, 16))) + (__builtin_bit_cast(float, __builtin_amdgcn_readlane(b, 32)) + __builtin_bit_cast(float, __builtin_amdgcn_readlane(b, 48)));
}
__device__ __forceinline__ unsigned pk4f8(float a, float b, float c, float d) { int w = 0; w = __builtin_amdgcn_cvt_pk_fp8_f32(a, b, w, false); w = __builtin_amdgcn_cvt_pk_fp8_f32(c, d, w, true); return (unsigned)w; }
__device__ __forceinline__ void p0_transpose_item(const float* W, int K, int N, bf16* WT, int pmode, LAS float* scr, int item, int lane, bool f8 = false) {
    const int nblk = N / 32, kb = item / nblk, nb = item % nblk, k0 = 64 * kb, n0 = 32 * nb;
    int r0 = n0;
    if (pmode == 1) { const int h = n0 / 96, d = n0 % 96; r0 = d < 64 ? h * 64 + d : 1024 + h * 32 + (d - 64); }
    else if (pmode == 2) { const int h = n0 / 128, d = n0 % 128; r0 = d < 64 ? h * 64 + d : 1024 + h * 64 + (d - 64); }
#pragma unroll 8
    for (int i = 0; i < 32; ++i) { const int kk = 2 * i + (lane >> 5); scr[kk * 33 + (lane & 31)] = W[(size_t)(k0 + kk) * N + n0 + (lane & 31)]; }
    LDS_WAIT(); asm volatile("" ::: "memory");
    const int c = lane & 7;
#pragma unroll
    for (int j = 0; j < 4; ++j) { const int n = (lane >> 3) + 8 * j; const LAS float* s = scr + (8 * c) * 33 + n;
        if (f8) {
            v2u o; o.x = pk4f8(s[0 * 33] * 32.f, s[1 * 33] * 32.f, s[2 * 33] * 32.f, s[3 * 33] * 32.f); o.y = pk4f8(s[4 * 33] * 32.f, s[5 * 33] * 32.f, s[6 * 33] * 32.f, s[7 * 33] * 32.f);
            *(GAS v2u*)((unsigned char*)WT + (size_t)(r0 + n) * K + k0 + 8 * c) = o; continue; }
        v4u o; o.x = pk2(s[0 * 33], s[1 * 33]); o.y = pk2(s[2 * 33], s[3 * 33]); o.z = pk2(s[4 * 33], s[5 * 33]); o.w = pk2(s[6 * 33], s[7 * 33]);
        *(GAS v4u*)(WT + (size_t)(r0 + n) * K + k0 + 8 * c) = o; }
    LDS_WAIT(); asm volatile("" ::: "memory");
}
__device__ __forceinline__ float silu_f(float v) { return v / (1.f + __expf(-v)); }

__device__ __forceinline__ void p0_prologue(Frame& F) {
    LAS float* scr = (LAS float*)(F.lds + RING_OFF + F.wave * 16384);
    const float* c = ARG(1); const float* cctx = ARG(3);
    if (F.wave >= 5) {
        for (int it = F.vcu * 3 + (F.wave - 5); it < 2 * 24 * ADA_KS; it += F.G * 3) {
            const int l = it / (24 * ADA_KS), rem = it % (24 * ADA_KS), cg = rem / ADA_KS, ks = rem % ADA_KS;
            const float* W = ARG(4) + (size_t)l * DM * 6144 + cg * 256 + 4 * F.lane;
            f32x4 a0 = {0.f, 0.f, 0.f, 0.f}, a1 = a0, a2 = a0;
            const int kbeg = ks * (DM / ADA_KS);
#pragma unroll 8
            for (int k = kbeg; k < kbeg + DM / ADA_KS; ++k) {
                const f32x4 w = *(const GAS f32x4*)(W + (size_t)k * 6144);
                const float s0 = silu_f(c[k]), s1 = silu_f(c[DM + k]), s2 = silu_f(cctx[k]);
                a0 += w * s0; a1 += w * s1; a2 += w * s2;
            }
            float* P = (float*)(F.ws + WS_MODP) + ((size_t)(ks * 2 + l) * 3) * 6144 + cg * 256 + 4 * F.lane;
            *(GAS f32x4*)(P) = a0; *(GAS f32x4*)(P + 6144) = a1; *(GAS f32x4*)(P + 2 * 6144) = a2;
        }
    } else {
        const int gw = F.vcu * 5 + F.wave, NGW = F.G * 5;
        constexpr int I_QKV = 16 * 72, I_O = 16 * 32, I_1 = 16 * 128, I_2 = 64 * 32, I_IN = 16 * 21, I_UQ = 6 * 48, I_UKV = 4 * 64;
        constexpr int NITEMS = I_QKV + I_O + 2 * I_1 + 2 * I_2 + I_IN + I_UQ + I_UKV + I_O;
        for (int it = gw; it < NITEMS; it += NGW) {
            int r = it;
            if (r < I_QKV) { p0_transpose_item(ARG(10), DM, NQKV, (bf16*)(F.ws + WS_WQKV), 0, scr, r, F.lane, true); continue; } r -= I_QKV;
            if (r < I_O) { p0_transpose_item(ARG(11), DM, DM, (bf16*)(F.ws + WS_WO0), 0, scr, r, F.lane); continue; } r -= I_O;
            if (r < I_1) { p0_transpose_item(ARG(8), DM, FF, (bf16*)(F.ws + WS_W1_0), 0, scr, r, F.lane); continue; } r -= I_1;
            if (r < I_1) { p0_transpose_item(ARG(8) + (size_t)DM * FF, DM, FF, (bf16*)(F.ws + WS_W1_1), 0, scr, r, F.lane); continue; } r -= I_1;
            if (r < I_2) { p0_transpose_item(ARG(9), FF, DM, (bf16*)(F.ws + WS_W2_0), 0, scr, r, F.lane); continue; } r -= I_2;
            if (r < I_2) { p0_transpose_item(ARG(9) + (size_t)DM * FF, FF, DM, (bf16*)(F.ws + WS_W2_1), 0, scr, r, F.lane); continue; } r -= I_2;
            if (r < I_IN) { p0_transpose_item(ARG(18), DM, 672, (bf16*)(F.ws + WS_WIN), 0, scr, r, F.lane); continue; } r -= I_IN;
            if (r < I_UQ) { p0_transpose_item(ARG(21), 384, NUQ, (bf16*)(F.ws + WS_WUQ), 1, scr, r, F.lane); continue; } r -= I_UQ;
            if (r < I_UKV) { p0_transpose_item(ARG(22), 256, NUKV, (bf16*)(F.ws + WS_WUKV), 2, scr, r, F.lane); continue; } r -= I_UKV;
            p0_transpose_item(ARG(27), DM, DM, (bf16*)(F.ws + WS_WO1), 0, scr, r, F.lane);
        }
    }
    if (F.bx == 1 % F.G) {
        float* rt = (float*)(F.ws + WS_ROPE);
        for (int e = F.tid; e < 128 * 16; e += NWAVES * 64) { const int pos = e >> 4, i = e & 15; const float inv = exp2f(-(float)i * (13.287712379549449f / 16.f));
            float x = (float)pos * inv * 0.15915494309189535f; x -= rintf(x); const float c_ = __builtin_amdgcn_cosf(x), s_ = __builtin_amdgcn_sinf(x); rt[e] = c_; rt[2048 + e] = s_; ((unsigned*)(F.ws + WS_ROPEP))[e] = pk2(c_, s_); }
        for (int e = F.tid; e < 128 * 8; e += NWAVES * 64) { const int pos = e >> 3, i = e & 7; const float inv = exp2f(-(float)i * (13.287712379549449f / 8.f));
            float x = (float)pos * inv * 0.15915494309189535f; x -= rintf(x); const float c_ = __builtin_amdgcn_cosf(x), s_ = __builtin_amdgcn_sinf(x); rt[4096 + e] = c_; rt[5120 + e] = s_; ((unsigned*)(F.ws + WS_ROPEP))[2048 + e] = pk2(c_, s_); }
    }
    if (F.bx == 3 % F.G && F.wave == NWAVES - 1) {
        float* hp = (float*)(F.ws + WS_HPAR); const int i = F.lane;
        hp[i] = ARG(12)[i]; hp[64 + i] = ARG(13)[i]; hp[128 + i] = ARG(15)[i]; hp[192 + i] = ARG(16)[i]; hp[256 + i] = ARG(23)[i]; hp[320 + i] = ARG(24)[i & 31]; hp[384 + i] = ARG(25)[i];
        float a = fabsf(ARG(23)[i]), b_ = fabsf(ARG(25)[i]), c_ = fabsf(ARG(24)[i & 31]), d_ = fabsf(ARG(26)[i & 31]);
#pragma unroll
        for (int o_ = 1; o_ < 64; o_ <<= 1) { a = fmaxf(a, shx(a, o_, i)); b_ = fmaxf(b_, shx(b_, o_, i)); c_ = fmaxf(c_, shx(c_, o_, i)); d_ = fmaxf(d_, shx(d_, o_, i)); }
        const float bound = (64.f * a * b_ + 32.f * c_ * d_) * (0.10206207261596575f * 1.4426950408889634f);
        if (i == 0) hp[448] = (bound < 64.f && fmaxf(fmaxf(a, b_), fmaxf(c_, d_)) < 3.f) ? 1.f : 0.f;
        { float a2 = fabsf(ARG(12)[i]), b2 = fabsf(ARG(13)[i]), c2 = fabsf(ARG(15)[i]), d2 = fabsf(ARG(16)[i]), e2 = 0.f, f2 = fabsf(ARG(14)[i & 7]);
          const float* rpbp = ARG(17);
          float e3 = 0.f, e4 = 0.f, e5 = 0.f;
          for (int j = i; j < 8 * 465; j += 256) { e2 = fmaxf(e2, fabsf(rpbp[j])); if (j + 64 < 8 * 465) e3 = fmaxf(e3, fabsf(rpbp[j + 64])); if (j + 128 < 8 * 465) e4 = fmaxf(e4, fabsf(rpbp[j + 128])); if (j + 192 < 8 * 465) e5 = fmaxf(e5, fabsf(rpbp[j + 192])); }
          e2 = fmaxf(fmaxf(e2, e3), fmaxf(e4, e5));
#pragma unroll
          for (int o_ = 1; o_ < 64; o_ <<= 1) { a2 = fmaxf(a2, shx(a2, o_, i)); b2 = fmaxf(b2, shx(b2, o_, i)); c2 = fmaxf(c2, shx(c2, o_, i)); d2 = fmaxf(d2, shx(d2, o_, i)); e2 = fmaxf(e2, shx(e2, o_, i)); f2 = fmaxf(f2, shx(f2, o_, i)); }
          const float bound0 = fmaxf(fmaxf(8.f * a2 * b2, 8.f * c2 * d2 + e2), f2) * 1.4426950408889634f;
          if (i == 0) hp[449] = (bound0 < 64.f && fmaxf(fmaxf(a2, b2), fmaxf(c2, d2)) < 3.f) ? 1.f : 0.f; }
    }
    if (F.bx == 2 % F.G) {
        GAS v4u* z = (GAS v4u*)((bf16*)(F.ws + WS_WIN) + (size_t)672 * DM);
        unsigned zz = 0u; asm volatile("" : "+v"(zz));
        for (int e = F.tid; e < 96 * DM / 8; e += NWAVES * 64) z[e] = (v4u){zz, zz, zz, zz};
    }
}

__device__ __forceinline__ void norm_phase(Frame& F, const float* src_lat, const float* src_ctx, int nrows, const float* gw_, int layer, int which  , bool from_partials, const float* parts = nullptr, int nparts = 0, bool lat_bf16 = false, bool xn_fp8 = false) {
    LAS float* gl = (LAS float*)(F.lds + RING_OFF); LAS float* scl = gl + 1024; LAS float* shl = scl + 3 * 1024;
    const float* modp = (const float*)(F.ws + WS_MODP); const float* mod = (const float*)(F.ws + WS_MOD); const float* ada_b = ARG(5);
    const int offsh = which * 3072, offsc = which * 3072 + 1024;
    for (int i = F.tid; i < 1024; i += NWAVES * 64) {
        gl[i] = gw_[i];
#pragma unroll
        for (int cnd = 0; cnd < 3; ++cnd) {
            float sh, sc;
            if (from_partials) { sh = ada_b[layer * 6144 + offsh + i]; sc = ada_b[layer * 6144 + offsc + i];
                float ph[ADA_KS], pc[ADA_KS];
#pragma unroll
                for (int ks = 0; ks < ADA_KS; ++ks) { const float* p = modp + ((size_t)(ks * 2 + layer) * 3 + cnd) * 6144; ph[ks] = p[offsh + i]; pc[ks] = p[offsc + i]; }
#pragma unroll
                for (int ks = 0; ks < ADA_KS; ++ks) { sh += ph[ks]; sc += pc[ks]; } }
            else { sh = mod[(layer * 3 + cnd) * 6144 + offsh + i]; sc = mod[(layer * 3 + cnd) * 6144 + offsc + i]; }
            scl[cnd * 1024 + i] = 1.f + sc; shl[cnd * 1024 + i] = sh;
        }
    }
    if (from_partials) {
        float* modw = (float*)(F.ws + WS_MOD);
        for (int e = F.vcu * (NWAVES * 64) + F.tid; e < 2 * 3 * 6144; e += F.G * NWAVES * 64) {
            const int l = e / (3 * 6144), rem = e % (3 * 6144), cnd = rem / 6144, col = rem % 6144;
            float v = ada_b[l * 6144 + col];
            float pv[ADA_KS];
#pragma unroll
            for (int ks = 0; ks < ADA_KS; ++ks) pv[ks] = modp[((size_t)(ks * 2 + l) * 3 + cnd) * 6144 + col];
#pragma unroll
            for (int ks = 0; ks < ADA_KS; ++ks) v += pv[ks];
            modw[e] = v;
        }
    }
    __syncthreads();
    bf16* XN = (bf16*)(F.ws + WS_XN);
    const int gw = F.vcu * NWAVES + F.wave, NGW = F.G * NWAVES;
    for (int m = gw; m < nrows; m += NGW) {
        const float* xrow = m < ML ? src_lat + (size_t)m * DM : src_ctx + (size_t)(m - ML) * DM;
        const int cnd = m < SEQ ? 0 : (m < ML ? 1 : 2);
        const GAS f32x4* xr = (const GAS f32x4*)xrow + F.lane;
        f32x4 v[4]; float s = 0.f;
        if (lat_bf16 && m < ML) {
            const GAS v2u* xb = (const GAS v2u*)((const bf16*)src_lat + (size_t)m * DM) + F.lane;
            v2u w[4];
#pragma unroll
            for (int j = 0; j < 4; ++j) w[j] = xb[64 * j];
#pragma unroll
            for (int j = 0; j < 4; ++j) v[j] = f32x4{bflo(w[j].x), bfhi(w[j].x), bflo(w[j].y), bfhi(w[j].y)};
        } else {
#pragma unroll
            for (int j = 0; j < 4; ++j) v[j] = xr[64 * j];
        }
        if (nparts > 0 && m >= ML) {
            for (int p = 0; p < nparts; p += 4) {
                const GAS f32x4* pr = (const GAS f32x4*)(parts + (size_t)p * (512 * 1024) + (size_t)(m - ML) * DM) + F.lane;
                f32x4 w[4][4];
#pragma unroll
                for (int q = 0; q < 4; ++q)
#pragma unroll
                    for (int j = 0; j < 4; ++j) w[q][j] = pr[(size_t)q * (512 * 1024 / 4) + 64 * j];
#pragma unroll
                for (int j = 0; j < 4; ++j) v[j] += (w[0][j] + w[1][j]) + (w[2][j] + w[3][j]); }
            GAS f32x4* cr = (GAS f32x4*)((float*)(F.ws + WS_CTXRES) + (size_t)(m - ML) * DM) + F.lane;
#pragma unroll
            for (int j = 0; j < 4; ++j) cr[64 * j] = v[j];
        }
#pragma unroll
        for (int j = 0; j < 4; ++j) s += (v[j].x * v[j].x + v[j].y * v[j].y) + (v[j].z * v[j].z + v[j].w * v[j].w);
        const float rstd = 1.f / sqrtf(wave_sum(s, F.lane) * (1.f / DM) + NORM_EPS);
        if (from_partials && m >= ML) { GAS f32x4* cr = (GAS f32x4*)((float*)(F.ws + WS_CTXRES) + (size_t)(m - ML) * DM) + F.lane;
#pragma unroll
            for (int j = 0; j < 4; ++j) cr[64 * j] = v[j]; }
        GAS v2u* o8 = (GAS v2u*)(XN + (size_t)m * DM) + F.lane;
        GAS unsigned* o4 = (GAS unsigned*)((unsigned char*)XN + (size_t)m * DM) + F.lane;
#pragma unroll
        for (int j = 0; j < 4; ++j) { const int col = 4 * F.lane + 256 * j;
            const f32x4 g = *(const LAS f32x4*)(gl + col), sc = *(const LAS f32x4*)(scl + cnd * 1024 + col), sh = *(const LAS f32x4*)(shl + cnd * 1024 + col);
            const f32x4 y = (v[j] * rstd) * g * sc + sh;
            if (xn_fp8) o4[64 * j] = pk4f8(y.x, y.y, y.z, y.w);
            else { v2u w; w.x = pk2(y.x, y.y); w.y = pk2(y.z, y.w); o8[64 * j] = w; } }
    }
    __syncthreads();
}

__device__ __forceinline__ void unpack8(const v4u w, float (&x)[8]) { x[0] = bflo(w.x); x[1] = bfhi(w.x); x[2] = bflo(w.y); x[3] = bfhi(w.y); x[4] = bflo(w.z); x[5] = bfhi(w.z); x[6] = bflo(w.w); x[7] = bfhi(w.w); }
__device__ __forceinline__ v4u pack8(const float (&x)[8]) { v4u w; w.x = pk2(x[0], x[1]); w.y = pk2(x[2], x[3]); w.z = pk2(x[4], x[5]); w.w = pk2(x[6], x[7]); return w; }

__device__ __forceinline__ void qknorm_phase(Frame& F) {
    bf16* QKV = (bf16*)(F.ws + WS_QKV);
    const float* rt = (const float*)(F.ws + WS_ROPE);
    const float* nw[4] = {ARG(12), ARG(13), ARG(15), ARG(16)};
    const float qscale = 0.125f * att::LOG2E;
    const int gw = F.vcu * NWAVES + F.wave, NGW = F.G * NWAVES;
    const int lane = F.lane, grp = lane >> 3, l8 = lane & 7;
    for (int m = gw; m < MR; m += NGW) {
        const bool lat = m < ML; const int t = m & (SEQ - 1); const int prow = t >> 6, pcol = t & 63;
        GAS v4u* rowp = (GAS v4u*)(QKV + (size_t)m * NQKV);
#pragma unroll
        for (int pass = 0; pass < 4; ++pass) {
            int type;
            if (pass == 0) type = 1; else if (pass == 1) type = grp < 2 ? 2 : (grp < 4 ? 0 : 3); else if (pass == 2) type = grp < 4 ? 3 : 4; else type = grp < 4 ? 4 : 0;
            const v4u w = rowp[pass * 64 + lane];
            float x[8]; unpack8(w, x);
            float ss = 0.f;
#pragma unroll
            for (int j = 0; j < 8; ++j) ss += x[j] * x[j];
            ss += shx(ss, 1, F.lane); ss += shx(ss, 2, F.lane); ss += shx(ss, 4, F.lane);
            const float rstd = 1.f / sqrtf(ss * (1.f / 64.f) + NORM_EPS);
            const float* g = type == 1 ? nw[0] : (type == 2 ? nw[1] : (type == 3 ? nw[2] : nw[3]));
            const f32x4 g0 = *(const GAS f32x4*)(g + l8 * 8), g1 = *(const GAS f32x4*)(g + l8 * 8 + 4);
            x[0] *= rstd * g0.x; x[1] *= rstd * g0.y; x[2] *= rstd * g0.z; x[3] *= rstd * g0.w; x[4] *= rstd * g1.x; x[5] *= rstd * g1.y; x[6] *= rstd * g1.z; x[7] *= rstd * g1.w;
            float px[8];
#pragma unroll
            for (int j = 0; j < 8; ++j) px[j] = shx(x[j], 2, F.lane);
            if (lat && (type == 1 || type == 2)) {
                const int pos = (l8 & 4) ? pcol : prow; const float* cs = rt + pos * 16 + (l8 & 1) * 8;
                const f32x4 c0 = *(const GAS f32x4*)(cs), c1 = *(const GAS f32x4*)(cs + 4), s0 = *(const GAS f32x4*)(cs + 2048), s1 = *(const GAS f32x4*)(cs + 2052);
                const float cc[8] = {c0.x, c0.y, c0.z, c0.w, c1.x, c1.y, c1.z, c1.w}, sn[8] = {s0.x, s0.y, s0.z, s0.w, s1.x, s1.y, s1.z, s1.w};
                const float sgn = (l8 & 2) ? 1.f : -1.f;
#pragma unroll
                for (int j = 0; j < 8; ++j) x[j] = x[j] * cc[j] + sgn * px[j] * sn[j];
            }
            if (type == 1 || type == 3) {
#pragma unroll
                for (int j = 0; j < 8; ++j) x[j] *= qscale;
            }
            if (type != 0) rowp[pass * 64 + lane] = pack8(x);
        }
    }
}

__device__ __forceinline__ void cnorm_phase(Frame& F) {
    const bf16* CQKV = (const bf16*)(F.ws + WS_CQKV); bf16* CQN = (bf16*)(F.ws + WS_CQN); bf16* CKVN = (bf16*)(F.ws + WS_CKVN); bf16* KR = (bf16*)(F.ws + WS_KR);
    const float* rt = (const float*)(F.ws + WS_ROPE) + 4096;
    const float* gq = ARG(19); const float* gkv = ARG(20); const float* gkr = ARG(26);
    const int gw = F.vcu * NWAVES + F.wave, NGW = F.G * NWAVES; const int lane = F.lane;
    const float* gA = lane < 48 ? gq + lane * 8 : gkv + (lane - 48) * 8;
    const int li = lane < 16 ? lane : (lane < 20 ? lane - 16 : 0);
    const float* gB = lane < 16 ? gkv + 128 + li * 8 : gkr + li * 8;
    const f32x4 gA0 = *(const GAS f32x4*)(gA), gA1 = *(const GAS f32x4*)(gA + 4), gB0 = *(const GAS f32x4*)(gB), gB1 = *(const GAS f32x4*)(gB + 4);
    v4u w0 = {0u, 0u, 0u, 0u}, w1 = {0u, 0u, 0u, 0u};
    if (gw < MR) { const GAS v4u* rowp = (const GAS v4u*)(CQKV + (size_t)gw * NCIN); w0 = rowp[lane]; if (lane < 32) w1 = rowp[64 + lane]; }
    for (int m = gw; m < MR; m += NGW) {
        const bool lat = m < ML; const int t = m & (SEQ - 1); const int prow = t >> 6, pcol = t & 63;
        const int pos = (lane & 2) ? pcol : prow; const float* cs = rt + pos * 8;
        const f32x4 c0 = *(const GAS f32x4*)(cs), c1 = *(const GAS f32x4*)(cs + 4), sa = *(const GAS f32x4*)(cs + 1024), sb = *(const GAS f32x4*)(cs + 1028);
        v4u n0 = {0u, 0u, 0u, 0u}, n1 = {0u, 0u, 0u, 0u};
        if (m + NGW < MR) { const GAS v4u* rowp = (const GAS v4u*)(CQKV + (size_t)(m + NGW) * NCIN); n0 = rowp[lane]; if (lane < 32) n1 = rowp[64 + lane]; }
        float x0[8], x1[8]; unpack8(w0, x0); unpack8(w1, x1);
        float s0 = 0.f, s1 = 0.f;
#pragma unroll
        for (int j = 0; j < 8; ++j) { s0 += x0[j] * x0[j]; s1 += x1[j] * x1[j]; }
        const float ssq = wave_sum(lane < 48 ? s0 : 0.f, F.lane);
        const float sskv = wave_sum((lane >= 48 ? s0 : 0.f) + (lane < 16 ? s1 : 0.f), F.lane);
        const float sskr = wave_sum((lane >= 16 && lane < 20) ? s1 : 0.f, F.lane);
        const float rq = 1.f / sqrtf(ssq * (1.f / 384.f) + NORM_EPS), rkv = 1.f / sqrtf(sskv * (1.f / 256.f) + NORM_EPS), rkr = 1.f / sqrtf(sskr * (1.f / 32.f) + NORM_EPS);
        { const float r = lane < 48 ? rq : rkv;
          float y[8] = {x0[0] * r * gA0.x, x0[1] * r * gA0.y, x0[2] * r * gA0.z, x0[3] * r * gA0.w, x0[4] * r * gA1.x, x0[5] * r * gA1.y, x0[6] * r * gA1.z, x0[7] * r * gA1.w};
          if (lane < 48) *(GAS v4u*)(CQN + (size_t)m * 384 + lane * 8) = pack8(y); else *(GAS v4u*)(CKVN + (size_t)m * 256 + (lane - 48) * 8) = pack8(y); }
        { const float r = lane < 16 ? rkv : rkr;
          float y[8] = {x1[0] * r * gB0.x, x1[1] * r * gB0.y, x1[2] * r * gB0.z, x1[3] * r * gB0.w, x1[4] * r * gB1.x, x1[5] * r * gB1.y, x1[6] * r * gB1.z, x1[7] * r * gB1.w};
          float py[8];
#pragma unroll
          for (int j = 0; j < 8; ++j) py[j] = shx(y[j], 1, F.lane);
          if (lat && lane >= 16 && lane < 20) {
              const float cc[8] = {c0.x, c0.y, c0.z, c0.w, c1.x, c1.y, c1.z, c1.w}, sn[8] = {sa.x, sa.y, sa.z, sa.w, sb.x, sb.y, sb.z, sb.w};
              const float sgn = (lane & 1) ? 1.f : -1.f;
#pragma unroll
              for (int j = 0; j < 8; ++j) y[j] = y[j] * cc[j] + sgn * py[j] * sn[j];
          }
          if (lane < 16) *(GAS v4u*)(CKVN + (size_t)m * 256 + 128 + lane * 8) = pack8(y);
          else if (lane < 20) *(GAS v4u*)(KR + (size_t)m * 32 + (lane - 16) * 8) = pack8(y); }
        w0 = n0; w1 = n1;
    }
}

__device__ __forceinline__ void hnorm_phase(Frame& F) {
    bf16* Q = (bf16*)(F.ws + WS_Q1); bf16* KV = (bf16*)(F.ws + WS_KV1);
    const float* rt = (const float*)(F.ws + WS_ROPE) + 4096;
    const float* gqn = ARG(23); const float* gqr = ARG(24); const float* gkn = ARG(25);
    const float qscale = 0.10206207261596575f * att::LOG2E;
    const int gw = F.vcu * NWAVES + F.wave, NGW = F.G * NWAVES; const int lane = F.lane, l8 = lane & 7, l4 = lane & 3;
    for (int m = gw; m < MR; m += NGW) {
        const bool lat = m < ML; const int t = m & (SEQ - 1); const int prow = t >> 6, pcol = t & 63;
        { GAS v4u* rowp = (GAS v4u*)(KV + (size_t)m * NUKV);
          const f32x4 g0 = *(const GAS f32x4*)(gkn + l8 * 8), g1 = *(const GAS f32x4*)(gkn + l8 * 8 + 4);
#pragma unroll
          for (int pass = 0; pass < 2; ++pass) {
              float x[8]; unpack8(rowp[pass * 64 + lane], x); float ss = 0.f;
#pragma unroll
              for (int j = 0; j < 8; ++j) ss += x[j] * x[j];
              ss += shx(ss, 1, F.lane); ss += shx(ss, 2, F.lane); ss += shx(ss, 4, F.lane);
              const float r = 1.f / sqrtf(ss * (1.f / 64.f) + NORM_EPS);
              x[0] *= r * g0.x; x[1] *= r * g0.y; x[2] *= r * g0.z; x[3] *= r * g0.w; x[4] *= r * g1.x; x[5] *= r * g1.y; x[6] *= r * g1.z; x[7] *= r * g1.w;
              rowp[pass * 64 + lane] = pack8(x); } }
        if (lat) {
            GAS v4u* rowp = (GAS v4u*)(Q + (size_t)m * NUQ);
            { const f32x4 g0 = *(const GAS f32x4*)(gqn + l8 * 8), g1 = *(const GAS f32x4*)(gqn + l8 * 8 + 4);
#pragma unroll
              for (int pass = 0; pass < 2; ++pass) {
                  float x[8]; unpack8(rowp[pass * 64 + lane], x); float ss = 0.f;
#pragma unroll
                  for (int j = 0; j < 8; ++j) ss += x[j] * x[j];
                  ss += shx(ss, 1, F.lane); ss += shx(ss, 2, F.lane); ss += shx(ss, 4, F.lane);
                  const float r = qscale / sqrtf(ss * (1.f / 64.f) + NORM_EPS);
                  x[0] *= r * g0.x; x[1] *= r * g0.y; x[2] *= r * g0.z; x[3] *= r * g0.w; x[4] *= r * g1.x; x[5] *= r * g1.y; x[6] *= r * g1.z; x[7] *= r * g1.w;
                  rowp[pass * 64 + lane] = pack8(x); } }
            {
              const f32x4 g0 = *(const GAS f32x4*)(gqr + l4 * 8), g1 = *(const GAS f32x4*)(gqr + l4 * 8 + 4);
              float x[8]; unpack8(rowp[128 + lane], x); float ss = 0.f;
#pragma unroll
              for (int j = 0; j < 8; ++j) ss += x[j] * x[j];
              ss += shx(ss, 1, F.lane); ss += shx(ss, 2, F.lane);
              const float r = 1.f / sqrtf(ss * (1.f / 32.f) + NORM_EPS);
              x[0] *= r * g0.x; x[1] *= r * g0.y; x[2] *= r * g0.z; x[3] *= r * g0.w; x[4] *= r * g1.x; x[5] *= r * g1.y; x[6] *= r * g1.z; x[7] *= r * g1.w;
              float px[8];
#pragma unroll
              for (int j = 0; j < 8; ++j) px[j] = shx(x[j], 1, F.lane);
              const int pos = (l4 & 2) ? pcol : prow; const float* cs = rt + pos * 8;
              const f32x4 c0 = *(const GAS f32x4*)(cs), c1 = *(const GAS f32x4*)(cs + 4), sa = *(const GAS f32x4*)(cs + 1024), sb = *(const GAS f32x4*)(cs + 1028);
              const float cc[8] = {c0.x, c0.y, c0.z, c0.w, c1.x, c1.y, c1.z, c1.w}, sn[8] = {sa.x, sa.y, sa.z, sa.w, sb.x, sb.y, sb.z, sb.w};
              const float sgn = (l4 & 1) ? 1.f : -1.f;
#pragma unroll
              for (int j = 0; j < 8; ++j) x[j] = (x[j] * cc[j] + sgn * px[j] * sn[j]) * qscale;
              rowp[128 + lane] = pack8(x); }
        }
    }
}

__device__ __forceinline__ void kr6_pass(Frame& F) {
    if (((const float*)(F.ws + WS_HPAR))[448] == 0.f) return;
    const bf16* KR = (const bf16*)(F.ws + WS_KR); unsigned char* K6R = (unsigned char*)(F.ws + WS_K6R);
    for (int r = F.vcu * (NWAVES * 64) + F.tid; r < MR; r += F.G * (NWAVES * 64)) {
        const GAS v4u* rp = (const GAS v4u*)(KR + (size_t)r * 32);
        v4u w[4] = {rp[0], rp[1], rp[2], rp[3]};
#pragma unroll
        for (int q = 0; q < 4; ++q) { float x[8]; unpack8(w[q], x);
#pragma unroll
            for (int j = 0; j < 8; ++j) x[j] *= 1.5349124f;
            w[q] = pack8(x); }
        const attd::u32x6 c = attd::to_fp6(w[0], w[1], w[2], w[3]);
        unsigned char* img = K6R + (size_t)(r >> 6) * 2048; const int key = r & 63;
        *(GAS v4u*)(img + key * 16) = (v4u){c[0], c[1], c[2], c[3]}; *(GAS v2u*)(img + 1024 + key * 8) = (v2u){c[4], c[5]};
    }
}
__device__ __forceinline__ void attn0_phase(Frame& F) {
    att::lchar* lds = (att::lchar*)(F.lds + RING_OFF);
    const att::bf16* QKV = (const att::bf16*)(F.ws + WS_QKV); att::bf16* O = (att::bf16*)(F.ws + WS_O0);
    const bool fast = __builtin_amdgcn_readfirstlane(__builtin_bit_cast(int, ((const float*)(F.ws + WS_HPAR))[449])) != 0;
    const char* K6E = (const char*)(F.ws + WS_K6E);
    char* shm = (char*)(F.lds + RING_OFF);
    for (int ui = F.vcu; ui < 1056; ui += F.G) {
        if (ui < 512) {
            const int b = ui >> 8, h = (ui >> 5) & 7, R4 = ui & 31;
            const float* rpb = ARG(17) + h * 465;
            if (fast) {
                float* rl = (float*)(shm + attf::LDS_RPB);
                for (int i = F.tid; i < 465; i += NWAVES * 64) rl[i] = rpb[i] * att::LOG2E;
                __syncthreads();
                attf::FNa fu; fu.init((const attf::bf16*)QKV, (attf::bf16*)O, rl, b, h, R4, K6E);
                attf::fast_unit<8, attf::FNa, true>(fu, shm, F.tid);
            } else {
                att::UNa u; u.QKV = QKV; u.O = O; u.rpbl = (const LAS float*)(lds + att::L_RPB); u.b = b; u.h = h; u.R4 = R4; u.init();
                for (int i = F.tid; i < 465; i += NWAVES * 64) ((LAS float*)(lds + att::L_RPB))[i] = rpb[i] * att::LOG2E;
                att::unit<8, att::UNa>(u, lds, F.tid);
            }
        } else if (ui < 1024) {
            const int v = ui - 512;
            if (fast) { attf::FWin fu; fu.init((const attf::bf16*)QKV, (attf::bf16*)O, ARG(14), v >> 8, (v >> 2) & 63, (v >> 1) & 1, v & 1, K6E); attf::fast_unit<8, attf::FWin, true>(fu, shm, F.tid); }
            else { att::UWin u; u.QKV = QKV; u.O = O; u.sinkp = ARG(14); u.b = v >> 8; u.n = (v >> 2) & 63; u.g = (v >> 1) & 1; u.hh = v & 1; u.init(); att::unit<8, att::UWin>(u, lds, F.tid); }
        } else {
            const int v = ui - 1024;
            if (fast) { attf::FCtx fu; fu.init((const attf::bf16*)QKV, (attf::bf16*)O, ARG(14), v >> 4, v & 15, K6E); attf::fast_unit<8, attf::FCtx, true>(fu, shm, F.tid); }
            else { att::UCtx u; u.QKV = QKV; u.O = O; u.sinkp = ARG(14); u.b = v >> 4; u.hx = v & 15; u.init(); att::unit<8, att::UCtx>(u, lds, F.tid); }
        }
    }
}
__device__ __forceinline__ void attn1_phase(Frame& F) {
    att::lchar* lds = (att::lchar*)(F.lds + RING_OFF);
    const bool fast = __builtin_amdgcn_readfirstlane(__builtin_bit_cast(int, ((const float*)(F.ws + WS_HPAR))[448])) != 0;
    const bool g256 = F.G == 256; const int x = F.vcu >> 5, j = F.vcu & 31;
    const int nit = g256 ? 4 : (F.vcu < 1024 ? (1024 - F.vcu + F.G - 1) / F.G : 0);
    for (int i = 0; i < nit; ++i) {
        const int ui = g256 ? ((x * 4 + i) * 32 + j) : F.vcu + i * F.G;
        if (fast) attd::dense_unit(ui >> 9, (ui >> 5) & 15, ui & 31, (const attd::bf16*)(F.ws + WS_Q1), (const attd::bf16*)(F.ws + WS_KV1), (const char*)(F.ws + WS_K6N), (const char*)(F.ws + WS_K6R), (attd::bf16*)(F.ws + WS_O1), (char*)(F.lds + RING_OFF), F.tid);
        else {
        att::UDense u; u.Q = (const att::bf16*)(F.ws + WS_Q1); u.KV = (const att::bf16*)(F.ws + WS_KV1); u.KR = (const att::bf16*)(F.ws + WS_KR); u.O = (att::bf16*)(F.ws + WS_O1);
        u.b = ui >> 9; u.h = (ui >> 5) & 15; u.qb = ui & 31;
        att::unit<12, att::UDense>(u, lds, F.tid); }
    }
}

#ifndef PHASE_MASK
#define PHASE_MASK 0xFFFFFu
#endif
#ifndef PHASE_REP
#define PHASE_REP 0u
#endif
struct Args { const float* in[28]; float* out; unsigned char* ws; int ph_lo, ph_hi; };
constexpr int N_PHASES = 19;
__global__ void __launch_bounds__(NWAVES * 64, 2) fwd_kernel(Args args) {
    extern __shared__ __attribute__((aligned(16))) unsigned char lds[];
    for (int u = threadIdx.x; u < (LDS_BYTES - LDSCTL_OFF) / 4; u += NWAVES * 64) ((LAS unsigned*)((LAS unsigned char*)lds + LDSCTL_OFF))[u] = 0u;
    __syncthreads();
    if (!MK_PER_PHASE) (void)xcd_barrier_post((unsigned*)((gu32*)(ARG_WS + WS_CTL) + CW_BAR), (volatile LAS unsigned*)((LAS unsigned char*)lds + MISC_OFF) + 8);
    const int wv0_ = __builtin_amdgcn_readfirstlane((int)threadIdx.x >> 6);
    for (int ph2 = 2 * args.ph_lo; ph2 < 2 * args.ph_hi; ++ph2) {
        const int ph = ph2 >> 1; if ((ph2 & 1) && !((PHASE_REP >> ph) & 1)) continue;
        if (ph == 3 || ph == 14) continue;
        Frame F;
        { int t_ = wv0_ * 64 + (int)__builtin_amdgcn_mbcnt_hi(~0u, __builtin_amdgcn_mbcnt_lo(~0u, 0u)); asm volatile("" : "+v"(t_)); int b_ = blockIdx.x; asm volatile("" : "+s"(b_)); int g_ = gridDim.x; asm volatile("" : "+s"(g_)); F.tid = t_; F.bx = b_; F.G = g_; }
        F.lds = (LAS unsigned char*)lds; F.MISC = (volatile LAS unsigned*)(F.lds + MISC_OFF);
        F.lane = F.tid & 63; F.wave = __builtin_amdgcn_readfirstlane(F.tid >> 6);
        F.vcu = (F.G % 8 == 0) ? (F.bx % 8) * (F.G / 8) + F.bx / 8 : F.bx;
        F.ws = ARG_WS; F.out = ARG_OUT; F.ctl = (gu32*)(F.ws + WS_CTL);
        XcdBarrier bar; bar.bar = (unsigned*)(F.ctl + CW_BAR); bar.x = xb_xcc_id(); bar.st = F.MISC + 8;
        float* ctxres = (float*)(F.ws + WS_CTXRES);
        const float* mod = (const float*)(F.ws + WS_MOD);
        int gk = 0, xrows = 0, xS = 0;
        pg8::Gemm g{nullptr, nullptr, 0, 0, 0, 0}; pg8::EpiAny ea{0, nullptr, nullptr, nullptr, nullptr, 0, 0};
        switch (ph) {
        case 0: if (!((PHASE_MASK >> 0) & 1)) break; p0_prologue(F); break;
        case 1: if (!((PHASE_MASK >> 1) & 1)) break; norm_phase(F, ARG(0), ARG(2), MR, ARG(6), 0, 0, true, nullptr, 0, false, true); break;
        case 2: if (!((PHASE_MASK >> 2) & 1)) break; gk = 1; g = pg8::Gemm{(const bf16*)(F.ws + WS_XN), (const bf16*)(F.ws + WS_WQKV), MR, NQKV, DM / 2, 1}; ea = pg8::EpiAny{3, (const float*)(F.ws + WS_HPAR), (void*)(F.ws + WS_QKV), (float*)(F.ws + WS_K6E), (const float*)(F.ws + WS_ROPEP), NQKV, 0}; break;
        case 4: if (!((PHASE_MASK >> 4) & 1)) break; attn0_phase(F); break;
        case 5: if (!((PHASE_MASK >> 5) & 1)) break; gk = 2; g = pg8::Gemm{(const bf16*)(F.ws + WS_O0), (const bf16*)(F.ws + WS_WO0), ML, DM, DM}; xrows = MC; xS = 2; ea = pg8::EpiAny{2, ARG(0), (void*)F.out, (float*)(F.ws + WS_PART5), mod + 2048, 0, 2}; break;
        case 6: if (!((PHASE_MASK >> 6) & 1)) break; norm_phase(F, F.out, ctxres, MR, ARG(7), 0, 1, false, (const float*)(F.ws + WS_PART5), 4, true); break;
        case 7: if (!((PHASE_MASK >> 7) & 1)) break; gk = 1; g = pg8::Gemm{(const bf16*)(F.ws + WS_XN), (const bf16*)(F.ws + WS_W1_0), MR, FF, DM}; ea = pg8::EpiAny{1, nullptr, (void*)(F.ws + WS_H), nullptr, nullptr, FF, 1}; break;
        case 8: if (!((PHASE_MASK >> 8) & 1)) break; gk = 2; g = pg8::Gemm{(const bf16*)(F.ws + WS_H), (const bf16*)(F.ws + WS_W2_0), ML, DM, FF}; xrows = MC; xS = 4; ea = pg8::EpiAny{2, F.out, (void*)F.out, (float*)(F.ws + WS_PART8), mod + 5120, 0, 3}; break;
        case 9: if (!((PHASE_MASK >> 9) & 1)) break; norm_phase(F, F.out, ctxres, MR, ARG(6) + DM, 1, 0, false, (const float*)(F.ws + WS_PART8), 16, true); break;
        case 10: if (!((PHASE_MASK >> 10) & 1)) break; gk = 1; g = pg8::Gemm{(const bf16*)(F.ws + WS_XN), (const bf16*)(F.ws + WS_WIN), MR, NCIN, DM}; ea = pg8::EpiAny{1, nullptr, (void*)(F.ws + WS_CQKV), nullptr, nullptr, NCIN, 0}; break;
        case 11: if (!((PHASE_MASK >> 11) & 1)) break; cnorm_phase(F); break;
        case 12: if (!((PHASE_MASK >> 12) & 1)) break; kr6_pass(F); gk = 1; g = pg8::Gemm{(const bf16*)(F.ws + WS_CQN), (const bf16*)(F.ws + WS_WUQ), ML, NUQ, 384}; ea = pg8::EpiAny{3, (const float*)(F.ws + WS_HPAR), (void*)(F.ws + WS_Q1), nullptr, (const float*)(F.ws + WS_ROPEP), NUQ, 1}; break;
        case 13: if (!((PHASE_MASK >> 13) & 1)) break; gk = 1; g = pg8::Gemm{(const bf16*)(F.ws + WS_CKVN), (const bf16*)(F.ws + WS_WUKV), MR, NUKV, 256}; ea = pg8::EpiAny{3, (const float*)(F.ws + WS_HPAR), (void*)(F.ws + WS_KV1), (float*)(F.ws + WS_K6N), (const float*)(F.ws + WS_ROPEP), NUKV, 2}; break;
        case 15: if (!((PHASE_MASK >> 15) & 1)) break; attn1_phase(F); break;
        case 16: if (!((PHASE_MASK >> 16) & 1)) break; gk = 2; g = pg8::Gemm{(const bf16*)(F.ws + WS_O1), (const bf16*)(F.ws + WS_WO1), ML, DM, DM}; ea = pg8::EpiAny{2, F.out, (void*)(F.ws + WS_XR), ctxres, mod + 3 * 6144 + 2048, 0, 3}; break;
        case 17: if (!((PHASE_MASK >> 17) & 1)) break; norm_phase(F, (const float*)(F.ws + WS_XR), ctxres, ML, ARG(7) + DM, 1, 1, false, nullptr, 0, true); break;
        case 18: if (!((PHASE_MASK >> 18) & 1)) break; gk = 1; g = pg8::Gemm{(const bf16*)(F.ws + WS_XN), (const bf16*)(F.ws + WS_W1_1), ML, FF, DM}; ea = pg8::EpiAny{1, nullptr, (void*)(F.ws + WS_H), nullptr, nullptr, FF, 1}; break;
        case 19: if (!((PHASE_MASK >> 19) & 1)) break; gk = 2; g = pg8::Gemm{(const bf16*)(F.ws + WS_H), (const bf16*)(F.ws + WS_W2_1), ML, DM, FF}; ea = pg8::EpiAny{2, (const float*)(F.ws + WS_XR), (void*)F.out, ctxres, mod + 3 * 6144 + 5120, 0, 1}; break;
        default: break;
        }
        ea.scr = F.lds + LDSCTL_OFF + 4096;
        if (gk != 0) { pg8::StaticOrder S; S.init(g.M, g.N, g.K, F.G, ph == 13 ? (F.bx + F.G / 2) % F.G : F.bx, xrows, xS);
            if (g.mx) pg8::gemm_phase<pg8::EpiAny, pg8::StaticOrder, true, true, true>(F.lds + RING_OFF, g, S, ea, F.tid);
            else pg8::gemm_phase<pg8::EpiAny, pg8::StaticOrder, true, true, false>(F.lds + RING_OFF, g, S, ea, F.tid); }
        const bool last_ = (ph == args.ph_hi - 1) && ((ph2 & 1) || !((PHASE_REP >> ph) & 1));
        if (!MK_PER_PHASE && !last_ && ph != 12) xcd_barrier(bar);
        else __syncthreads();
    }
}

extern "C" void kernel_launch(void* const* d_in, const int* in_sizes, int n_in, void* d_out, int out_size, void* d_ws, size_t ws_size, hipStream_t stream) {
    static int grid = 0;
    if (grid == 0) {
        if (n_in != 28 || in_sizes[0] != ML * DM || out_size != ML * DM || ws_size < WS_END) { fprintf(stderr, "kernel_launch: unexpected shapes: n_in %d in0 %d out %d ws %zu\n", n_in, n_in > 0 ? in_sizes[0] : -1, out_size, ws_size); grid = -1; return; }
        int dev = 0, cus = 0, per_cu = 0;
        if (hipGetDevice(&dev) != hipSuccess || hipDeviceGetAttribute(&cus, hipDeviceAttributeMultiprocessorCount, dev) != hipSuccess) { fprintf(stderr, "kernel_launch: device query failed\n"); grid = -1; return; }
        if (hipFuncSetAttribute((const void*)fwd_kernel, hipFuncAttributeMaxDynamicSharedMemorySize, LDS_BYTES) != hipSuccess) { fprintf(stderr, "kernel_launch: hipFuncSetAttribute failed\n"); grid = -1; return; }
        if (hipOccupancyMaxActiveBlocksPerMultiprocessor(&per_cu, (const void*)fwd_kernel, NWAVES * 64, LDS_BYTES) != hipSuccess || per_cu < 1)
            fprintf(stderr, "kernel_launch: note: occupancy query reports %d workgroups per CU\n", per_cu);
        (void)hipGetLastError();
        grid = cus;
    }
    if (grid < 0) return;
    if (hipMemsetAsync((char*)d_ws + WS_CTL, 0, CTL_ZERO_BYTES, stream) != hipSuccess) { fprintf(stderr, "kernel_launch: hipMemsetAsync failed\n"); return; }
    Args a{};
    for (int i = 0; i < 28; ++i) a.in[i] = (const float*)d_in[i];
    a.out = (float*)d_out; a.ws = (unsigned char*)d_ws;
#if MK_PER_PHASE
    for (int ph = 0; ph <= N_PHASES; ++ph) { a.ph_lo = ph; a.ph_hi = ph + 1; hipLaunchKernelGGL(fwd_kernel, dim3(grid), dim3(NWAVES * 64), LDS_BYTES, stream, a); }
#else
    a.ph_lo = 0; a.ph_hi = N_PHASES + 1;
    hipLaunchKernelGGL(fwd_kernel, dim3(grid), dim3(NWAVES * 64), LDS_BYTES, stream, a);
#endif
    const hipError_t le = hipPeekAtLastError();
    if (le != hipSuccess) fprintf(stderr, "kernel_launch: launch failed: %s\n", hipGetErrorName(le));
}
```

```cpp
#include <hip/hip_runtime.h>
#include <cstdio>
#include <cstdint>
namespace pg8 {
#define PG8_LAS __attribute__((address_space(3)))
typedef unsigned short bf16_t;
typedef short bf16x8 __attribute__((ext_vector_type(8)));
typedef float f32x4 __attribute__((ext_vector_type(4)));
typedef unsigned u32x4 __attribute__((ext_vector_type(4)));
typedef unsigned u32x2 __attribute__((ext_vector_type(2)));
typedef unsigned u32x6 __attribute__((ext_vector_type(6)));
typedef unsigned u32x16 __attribute__((ext_vector_type(16)));
typedef __bf16 bf16x32 __attribute__((ext_vector_type(32)));
constexpr int BM = 256, BK = 64, HALF = 128, HTB = HALF * BK * 2  , STAGE_BYTES = 8 * HTB, NXCD = 8, WGM = 8;

__host__ __device__ __forceinline__ int lds_byte(int r, int c) { const int st = (r >> 4) * 2 + (c >> 5), rr = r & 15, cc = c & 31, ob = rr * 64 + cc * 2; return st * 1024 + (ob ^ (((ob >> 9) & 1) << 5)); }
__host__ __device__ __forceinline__ void stage_rc(int b, int& R, int& C) { const int st = b / 1024, sb = b % 1024, swz = sb ^ (((sb >> 9) & 1) << 5); R = (st >> 1) * 16 + swz / 64; C = (st & 1) * 32 + (swz % 64) / 2; }
__host__ __device__ __forceinline__ int perm32(int rho) { const int n = rho >> 4, i = rho & 15; return 8 * (i >> 2) + 4 * n + (i & 3); }

struct Unit { int pm, pn, kinfo; };
struct Gemm { const bf16_t* A; const bf16_t* Bt; int M, N, K; int mx = 0; };

struct StaticOrder {
    int nM, nN, nwg, G, c, ntK;
    int xtiles, xsh;
    __host__ __device__ void init(int M, int N, int K, int G_, int c_, int extra_rows = 0, int S = 1) { nM = M / BM; nN = N / BM; nwg = nM * nN; G = G_; c = c_; ntK = K / BK;
        xtiles = (extra_rows / BM) * nN; xsh = S; }
    __host__ __device__ bool next(int i, Unit& u) const {
        const long L = (long)i * G + c;
        if (L >= nwg) {
            if (xtiles == 0) return false;
            const int nb = (nwg - c + G - 1) / G;
            const int nbc = c < nwg ? nb : 0;
            const long e = (long)(i - nbc) * G + ((c + G - (nwg % G)) % G);
            if (e >= ((long)xtiles << xsh)) return false;
            const int tile = (int)(e >> xsh), ks = (int)e & ((1 << xsh) - 1), xnt = ntK >> xsh;
            u.pm = nM + tile / nN; u.pn = tile % nN; u.kinfo = (ks * xnt) | (xnt << 8) | (1 << 16); return true;
        }
        int wgid = (int)L; { const int q = nwg / NXCD, r = nwg % NXCD, xcd = wgid % NXCD, off = wgid / NXCD; wgid = (xcd < r ? xcd * (q + 1) : r * (q + 1) + (xcd - r) * q) + off; }
        const int nig = WGM * nN, gid = wgid / nig, fm = gid * WGM, gsz = (nM - fm) < WGM ? (nM - fm) : WGM;
        u.pm = fm + ((wgid % nig) % gsz); u.pn = (wgid % nig) / gsz; u.kinfo = ntK << 8; return true;
    }
    __device__ __forceinline__ void a_ready(const Unit&) const {}
    __device__ __forceinline__ void done(const Unit&) const {}
};

__device__ __forceinline__ unsigned cvt_pk_bf16(float lo, float hi) { unsigned r; asm volatile("v_cvt_pk_bf16_f32 %0, %1, %2" : "=v"(r) : "v"(lo), "v"(hi)); return r; }
__device__ __forceinline__ u32x2 pk4bf(f32x4 y) { u32x2 r; r.x = cvt_pk_bf16(y[0], y[1]); r.y = cvt_pk_bf16(y[2], y[3]); return r; }
__device__ __forceinline__ f32x4 unpk4bf(u32x2 w) { f32x4 r; r[0] = __builtin_bit_cast(float, w.x << 16); r[1] = __builtin_bit_cast(float, w.x & 0xffff0000u); r[2] = __builtin_bit_cast(float, w.y << 16); r[3] = __builtin_bit_cast(float, w.y & 0xffff0000u); return r; }
struct EpiAny {
    static constexpr bool AFTER_DRAIN = false;
    int mode; const float* base; void* out; float* ctxres; const float* gate; int ldc, relu2; PG8_LAS unsigned char* scr = nullptr;
    __device__ __forceinline__ bool perm() const { return mode == 1; }
    __device__ __forceinline__ bool headmode() const { return mode == 3; }
    __device__ __forceinline__ static float xsh(float v, int mask, int lane) { return __builtin_bit_cast(float, __builtin_amdgcn_ds_bpermute((lane ^ mask) << 2, __builtin_bit_cast(int, v))); }
    __device__ __forceinline__ void head_epilogue(const f32x4 (&acc)[2][2][4][2], const Unit& u, int wr, int wc, int fr, int fq) const {
        const int H = 4 * u.pn + wc, kind = relu2, lane = fr + 16 * fq;
        const bool f6 = kind != 0 && base[448] != 0.f;
        const bool f6e = kind == 0 && base[449] != 0.f;
        int cls, gsel; float qs = 1.f;
        if (kind == 0) { const float qq = f6e ? 1.6986436f : 0.125f * 1.4426950408889634f, kq = f6e ? 1.6986436f : 1.f;
                         if (H < 8) { cls = 2; gsel = 0; qs = qq; } else if (H < 10) { cls = 2; gsel = 1; qs = kq; } else if (H < 12) { cls = 0; gsel = 0; }
                         else if (H < 20) { cls = 1; gsel = 2; qs = qq; } else if (H < 28) { cls = 1; gsel = 3; qs = kq; } else { cls = 0; gsel = 0; } }
        else if (kind == 1) { qs = f6 ? 1.5349124f : 0.10206207261596575f * 1.4426950408889634f; if (H < 16) { cls = 1; gsel = 4; } else { cls = 3; gsel = 5; } }
        else { if (H < 16) { cls = 1; gsel = 6; if (f6) qs = 1.5349124f; } else { cls = 0; gsel = 0; } }
        const bool lat = u.pm < 64;
        const bool k6e = f6e && (H == 8 || H == 9 || (H >= 20 && H < 28));
        const bool k6 = (f6 && kind == 2 && H < 16) || k6e;
        bf16_t* O = (bf16_t*)out;
        const int col0 = u.pn * BM + 64 * wc + 8 * fq;
        f32x4 gv[2][2];
#pragma unroll
        for (int bj = 0; bj < 2; ++bj)
#pragma unroll
            for (int n = 0; n < 2; ++n) gv[bj][n] = *(const f32x4*)(base + gsel * 64 + 32 * bj + 8 * fq + 4 * n);
#pragma unroll
        for (int ai = 0; ai < 2; ++ai)
#pragma unroll
            for (int m = 0; m < 4; ++m) {
                const int row = u.pm * BM + ai * HALF + wr * 64 + m * 16 + fr;
                f32x4 v[2][2];
#pragma unroll
                for (int bj = 0; bj < 2; ++bj)
#pragma unroll
                    for (int n = 0; n < 2; ++n) v[bj][n] = acc[ai][bj][m][n];
                if (cls != 0) {
                    float s0 = 0.f, s1 = 0.f;
#pragma unroll
                    for (int n = 0; n < 2; ++n)
#pragma unroll
                        for (int e = 0; e < 4; ++e) { s0 += v[0][n][e] * v[0][n][e]; s1 += v[1][n][e] * v[1][n][e]; }
                    if (cls != 3) { s0 += s1; s0 += xsh(s0, 16, lane); s0 += xsh(s0, 32, lane); s0 = s0 * (1.f / 64.f); s1 = s0; }
                    else { s0 += xsh(s0, 16, lane); s0 += xsh(s0, 32, lane); s1 += xsh(s1, 16, lane); s1 += xsh(s1, 32, lane); s0 *= (1.f / 32.f); s1 *= (1.f / 32.f); }
                    const float r0 = 1.f / sqrtf(s0 + 1e-6f), r1 = 1.f / sqrtf(s1 + 1e-6f);
#pragma unroll
                    for (int n = 0; n < 2; ++n) { v[0][n] = v[0][n] * r0 * gv[0][n]; v[1][n] = v[1][n] * r1 * gv[1][n]; }
                    if (lat && cls == 2) {
                        const int t = row & 8191;
                        u32x4 cw[2][2]; const float sgn = fq < 2 ? -1.f : 1.f;
#pragma unroll
                        for (int bj = 0; bj < 2; ++bj) { const int pos = bj == 0 ? (t >> 6) : (t & 63);
#pragma unroll
                            for (int n = 0; n < 2; ++n) cw[bj][n] = *(const u32x4*)((const unsigned*)gate + pos * 16 + 8 * (fq & 1) + 4 * n); }
#pragma unroll
                        for (int bj = 0; bj < 2; ++bj)
#pragma unroll
                            for (int n = 0; n < 2; ++n) { f32x4 p, c, sn;
#pragma unroll
                                for (int e = 0; e < 4; ++e) { p[e] = xsh(v[bj][n][e], 32, lane); c[e] = __builtin_bit_cast(float, cw[bj][n][e] << 16); sn[e] = __builtin_bit_cast(float, cw[bj][n][e] & 0xffff0000u); }
                                v[bj][n] = v[bj][n] * c + (p * sgn) * sn; }
                    }
                    if (lat && cls == 3) {
                        const int t = row & 8191; const int pos = fq < 2 ? (t >> 6) : (t & 63); const float sgn = (fq & 1) ? 1.f : -1.f;
                        u32x4 cw[2];
#pragma unroll
                        for (int n = 0; n < 2; ++n) cw[n] = *(const u32x4*)((const unsigned*)gate + 2048 + pos * 8 + 4 * n);
#pragma unroll
                        for (int bj = 0; bj < 2; ++bj)
#pragma unroll
                            for (int n = 0; n < 2; ++n) { f32x4 p, c, sn;
#pragma unroll
                                for (int e = 0; e < 4; ++e) { p[e] = xsh(v[bj][n][e], 16, lane); c[e] = __builtin_bit_cast(float, cw[n][e] << 16); sn[e] = __builtin_bit_cast(float, cw[n][e] & 0xffff0000u); }
                                v[bj][n] = v[bj][n] * c + (p * sgn) * sn; }
                    }
                    if (qs != 1.f) {
#pragma unroll
                        for (int bj = 0; bj < 2; ++bj)
#pragma unroll
                            for (int n = 0; n < 2; ++n) v[bj][n] = v[bj][n] * qs; }
                }
                if (k6) {
                    PG8_LAS unsigned char* sw = scr + (wr * 4 + wc) * 1024 + fr * 64;
                    unsigned char* img = (unsigned char*)ctxres + (k6e ? ((size_t)(row >> 6) * 10 + (H < 10 ? H - 8 : H - 18)) : ((size_t)(row >> 6) * 16 + H)) * 3072;
                    const int key = row & 63;
#pragma unroll
                    for (int bj = 0; bj < 2; ++bj) {
                        u32x4 w; w.x = cvt_pk_bf16(v[bj][0][0], v[bj][0][1]); w.y = cvt_pk_bf16(v[bj][0][2], v[bj][0][3]); w.z = cvt_pk_bf16(v[bj][1][0], v[bj][1][1]); w.w = cvt_pk_bf16(v[bj][1][2], v[bj][1][3]);
                        *(PG8_LAS u32x4*)(sw + fq * 16) = w;
                        asm volatile("s_waitcnt lgkmcnt(0)" ::: "memory");
                        if (fq == 0) {
                            const u32x4 a0 = *(PG8_LAS u32x4*)(sw), a1 = *(PG8_LAS u32x4*)(sw + 16), a2 = *(PG8_LAS u32x4*)(sw + 32), a3 = *(PG8_LAS u32x4*)(sw + 48);
                            const u32x16 all = {a0.x, a0.y, a0.z, a0.w, a1.x, a1.y, a1.z, a1.w, a2.x, a2.y, a2.z, a2.w, a3.x, a3.y, a3.z, a3.w};
                            const u32x6 c = __builtin_amdgcn_cvt_scalef32_pk32_fp6_bf16(__builtin_bit_cast(bf16x32, all), 1.0f);
                            *(u32x4*)(img + bj * 1024 + key * 16) = (u32x4){c[0], c[1], c[2], c[3]};
                            *(u32x2*)(img + 2048 + bj * 512 + key * 8) = (u32x2){c[4], c[5]};
                        }
                        asm volatile("s_waitcnt lgkmcnt(0)" ::: "memory");
                    }
                    continue;
                }
                bf16_t* rowp = O + (size_t)row * ldc + col0;
#pragma unroll
                for (int bj = 0; bj < 2; ++bj) { u32x4 w; w.x = cvt_pk_bf16(v[bj][0][0], v[bj][0][1]); w.y = cvt_pk_bf16(v[bj][0][2], v[bj][0][3]); w.z = cvt_pk_bf16(v[bj][1][0], v[bj][1][1]); w.w = cvt_pk_bf16(v[bj][1][2], v[bj][1][3]);
                    *(u32x4*)(rowp + 32 * bj) = w; }
            }
    }
    __device__ __forceinline__ void operator()(const f32x4 (&acc)[2][2][4][2], const Unit& u, int wr, int wc, int fr, int fq) const {
        asm volatile("" : "+v"(fr), "+v"(fq));
        if (mode == 1) {
            bf16_t* O = (bf16_t*)out;
            const int row0 = u.pm * BM + wr * 64 + fr, col0 = u.pn * BM + wc * 32 + 8 * fq;
#pragma unroll
            for (int ai = 0; ai < 2; ++ai)
#pragma unroll
                for (int m = 0; m < 4; ++m) { bf16_t* rowp = O + (size_t)(row0 + ai * HALF + m * 16) * ldc + col0;
#pragma unroll
                    for (int bj = 0; bj < 2; ++bj) { f32x4 v0 = acc[ai][bj][m][0], v1 = acc[ai][bj][m][1];
                        if (relu2) {
#pragma unroll
                            for (int e = 0; e < 4; ++e) { float a = fmaxf(v0[e], 0.f), b = fmaxf(v1[e], 0.f); v0[e] = a * a; v1[e] = b * b; } }
                        u32x4 w; w.x = cvt_pk_bf16(v0[0], v0[1]); w.y = cvt_pk_bf16(v0[2], v0[3]); w.z = cvt_pk_bf16(v1[0], v1[1]); w.w = cvt_pk_bf16(v1[2], v1[3]);
                        *(u32x4*)(rowp + bj * HALF) = w; } }
            return;
        }
        if (mode == 3) { head_epilogue(acc, u, wr, wc, fr, fq); return; }
        const int t0 = u.pm * BM; const bool split = (u.kinfo >> 16) != 0; const int cond = t0 < 8192 ? 0 : (t0 < 16384 ? 1 : 2);
        const int col0 = u.pn * BM + wc * 32 + 4 * fq; const float* g = gate + cond * 6144 + col0;
        f32x4 gv[2][2];
#pragma unroll
        for (int bj = 0; bj < 2; ++bj)
#pragma unroll
            for (int n = 0; n < 2; ++n) gv[bj][n] = *(const f32x4*)(g + bj * HALF + n * 16);
        if (split) {
            const int ks = (u.kinfo & 255) / ((u.kinfo >> 8) & 255);
            float* op = ctxres + (size_t)ks * (512 * 1024) + (size_t)(t0 - 16384) * 1024;
#pragma unroll
            for (int ai = 0; ai < 2; ++ai)
#pragma unroll
                for (int m = 0; m < 4; ++m) { const size_t off = (size_t)(wr * 64 + fr + ai * HALF + m * 16) * 1024 + col0;
#pragma unroll
                    for (int bj = 0; bj < 2; ++bj)
#pragma unroll
                        for (int n = 0; n < 2; ++n) *(f32x4*)(op + off + bj * HALF + n * 16) = gv[bj][n] * acc[ai][bj][m][n]; }
            return;
        }
#define PG8_RES_LOOP(LOADB, STOREO) _Pragma("unroll") for (int ai = 0; ai < 2; ++ai) _Pragma("unroll") for (int m = 0; m < 4; ++m) { const size_t off = (size_t)(wr * 64 + fr + ai * HALF + m * 16) * 1024 + col0; \
            _Pragma("unroll") for (int bj = 0; bj < 2; ++bj) _Pragma("unroll") for (int n = 0; n < 2; ++n) { const size_t o2 = off + bj * HALF + n * 16; f32x4 b; LOADB; const f32x4 y = b + gv[bj][n] * acc[ai][bj][m][n]; STOREO; } }
        if (relu2 == 2) { const float* bp = base + (size_t)t0 * 1024; bf16_t* op = (bf16_t*)out + (size_t)t0 * 1024;
            PG8_RES_LOOP(b = *(const f32x4*)(bp + o2), *(u32x2*)(op + o2) = pk4bf(y)); }
        else if (relu2 == 3) { const bf16_t* bp = (const bf16_t*)base + (size_t)t0 * 1024; bf16_t* op = (bf16_t*)out + (size_t)t0 * 1024;
            PG8_RES_LOOP(const u32x2 w = *(const u32x2*)(bp + o2); b = unpk4bf(w), *(u32x2*)(op + o2) = pk4bf(y)); }
        else { const bf16_t* bp = (const bf16_t*)base + (size_t)t0 * 1024; float* op = (float*)out + (size_t)t0 * 1024;
            PG8_RES_LOOP(const u32x2 w = *(const u32x2*)(bp + o2); b = unpk4bf(w), *(f32x4*)(op + o2) = y); }
#undef PG8_RES_LOOP
    }
};

template <class Epi, class Sched, bool ALIGN_EPI = false, bool SP2 = false, bool MX8 = false>
__device__ __forceinline__ void gemm_phase(PG8_LAS unsigned char* lds, const Gemm g, const Sched& S, const Epi& E, const int tid) {
    const int wid = __builtin_amdgcn_readfirstlane(tid >> 6), lane = tid & 63, wr = wid >> 2, wc = wid & 3, fr = lane & 15, fq = lane >> 4;
    const int K = g.K;
    typedef int i32x4_t __attribute__((ext_vector_type(4)));
    int scw_ = 0x7a7a7a7a, sca_ = 0x7f7f7f7f; asm volatile("" : "+v"(scw_), "+v"(sca_));
    unsigned voffA[2], voffB[2];
#pragma unroll
    for (int i = 0; i < 2; ++i) { int R, C; stage_rc(tid * 16 + i * 8192, R, C); const int Rb = E.headmode() ? (64 * (R >> 5) + perm32(R & 31)) : (E.perm() ? ((R & ~31) + perm32(R & 31)) : R);
        voffA[i] = (unsigned)(R * K + C) * 2u; voffB[i] = (unsigned)(Rb * K + C) * 2u; }
    const size_t kstep = (size_t)(BK * 2);
    const size_t hstep = (size_t)HALF * K * 2;
    const size_t tstep = 2 * hstep;
    const size_t hstepB = E.headmode() ? (size_t)32 * K * 2 : hstep;
    const unsigned ldsw = (unsigned)wid * 1024u;
    const int aoff = lds_byte(wr * 64 + fr, fq * 8), boff = lds_byte(wc * 32 + fr, fq * 8);
#define PG8_SA(b, h) (((b) * 2 + (h)) * HTB)
#define PG8_SB(b, h) ((4 + (b) * 2 + (h)) * HTB)
    const unsigned ldsb = (unsigned)(uintptr_t)lds + ldsw;
#define PG8_STAGE(bufoff, gbase, voff) do { _Pragma("unroll") for (int _i = 0; _i < 2; ++_i) { unsigned keep_; \
        asm volatile("s_mov_b32 %0, m0\n\ts_mov_b32 m0, %3\n\ts_nop 0\n\tglobal_load_lds_dwordx4 %1, %2\n\ts_mov_b32 m0, %0" : "=&s"(keep_) : "v"((voff)[_i]), "s"((const char*)(gbase)), "s"(ldsb + (unsigned)((bufoff) + _i * 8192)) : "memory"); } } while (0)
#define PG8_LDA(dst, b, h) do { _Pragma("unroll") for (int m = 0; m < 4; ++m) _Pragma("unroll") for (int k = 0; k < 2; ++k) dst[m][k] = *(const PG8_LAS bf16x8*)(lds + PG8_SA(b, h) + aoff + m * 2048 + k * 1024); } while (0)
#define PG8_LDB(dst, b, h) do { _Pragma("unroll") for (int n = 0; n < 2; ++n) _Pragma("unroll") for (int k = 0; k < 2; ++k) dst[n][k] = *(const PG8_LAS bf16x8*)(lds + PG8_SB(b, h) + boff + n * 2048 + k * 1024); } while (0)
#define PG8_CAT(x, y) __builtin_shufflevector(__builtin_bit_cast(i32x4_t, x), __builtin_bit_cast(i32x4_t, y), 0, 1, 2, 3, 4, 5, 6, 7)
#define PG8_MMA(ai, bj, At, Bt) do { __builtin_amdgcn_s_setprio(1); \
        if constexpr (MX8) { _Pragma("unroll") for (int m = 0; m < 4; ++m) _Pragma("unroll") for (int n = 0; n < 2; ++n) \
            asm volatile("v_mfma_scale_f32_16x16x128_f8f6f4 %0, %1, %2, %0, %3, %4 op_sel_hi:[0,0,0]" : "+v"(acc[ai][bj][m][n]) : "v"(PG8_CAT(Bt[n][0], Bt[n][1])), "v"(PG8_CAT(At[m][0], At[m][1])), "v"(scw_), "v"(sca_)); } \
        else { _Pragma("unroll") for (int m = 0; m < 4; ++m) _Pragma("unroll") for (int n = 0; n < 2; ++n) _Pragma("unroll") for (int k = 0; k < 2; ++k) \
            acc[ai][bj][m][n] = __builtin_amdgcn_mfma_f32_16x16x32_bf16(Bt[n][k], At[m][k], acc[ai][bj][m][n], 0, 0, 0); } \
        __builtin_amdgcn_s_setprio(0); } while (0)
#define PG8_WAIT_V(n) asm volatile("s_waitcnt vmcnt(" #n ")" ::: "memory")
#define PG8_WAIT_L(n) asm volatile("s_waitcnt lgkmcnt(" #n ")" ::: "memory")
#define PG8_BAR __builtin_amdgcn_s_barrier()
#define PG8_SCHED __builtin_amdgcn_sched_barrier(0)
    Unit cur, nxt; int ui = 0;
    if (!S.next(0, cur)) return;
    f32x4 acc[2][2][4][2];
#pragma unroll
    for (int a = 0; a < 2; ++a)
#pragma unroll
        for (int b = 0; b < 2; ++b)
#pragma unroll
            for (int m = 0; m < 4; ++m)
#pragma unroll
                for (int n = 0; n < 2; ++n) acc[a][b][m][n] = (f32x4){0.f, 0.f, 0.f, 0.f};
    bf16x8 At[4][2], B0[2][2], B1[2][2];
    const char* cA = (const char*)g.A + (size_t)cur.pm * tstep + (size_t)(cur.kinfo & 255) * (BK * 2); const char* cB = (const char*)g.Bt + (size_t)cur.pn * tstep + (size_t)(cur.kinfo & 255) * (BK * 2);
    S.a_ready(cur);
    if constexpr (SP2) {
        PG8_STAGE(PG8_SB(0, 0), cB, voffB); PG8_STAGE(PG8_SB(0, 1), cB + hstepB, voffB); PG8_STAGE(PG8_SA(0, 0), cA, voffA); PG8_STAGE(PG8_SA(0, 1), cA + hstep, voffA);
        if (wr == 1) PG8_BAR;
        PG8_WAIT_V(2); PG8_BAR;
        PG8_STAGE(PG8_SB(1, 0), cB + kstep, voffB); PG8_STAGE(PG8_SA(1, 0), cA + kstep, voffA); PG8_STAGE(PG8_SB(1, 1), cB + hstepB + kstep, voffB);
        PG8_WAIT_V(6); PG8_BAR;
    } else {
        PG8_STAGE(PG8_SB(0, 0), cB, voffB); PG8_STAGE(PG8_SA(0, 0), cA, voffA); PG8_STAGE(PG8_SB(0, 1), cB + hstepB, voffB); PG8_STAGE(PG8_SA(0, 1), cA + hstep, voffA);
        if (wr == 1) PG8_BAR;
        PG8_WAIT_V(4); PG8_BAR;
        PG8_STAGE(PG8_SB(1, 0), cB + kstep, voffB); PG8_STAGE(PG8_SA(1, 0), cA + kstep, voffA); PG8_STAGE(PG8_SB(1, 1), cB + hstepB + kstep, voffB);
        PG8_WAIT_V(6); PG8_BAR;
    }
    for (;;) {
        const bool has_next = S.next(ui + 1, nxt);
        const char* nA = has_next ? (const char*)g.A + (size_t)nxt.pm * tstep + (size_t)(nxt.kinfo & 255) * (BK * 2) : cA; const char* nB = has_next ? (const char*)g.Bt + (size_t)nxt.pn * tstep + (size_t)(nxt.kinfo & 255) * (BK * 2) : cB;
        const int nt = (cur.kinfo >> 8) & 255;
        for (int t = 0; t < nt; t += 2) {
            const bool last = (t == nt - 2);
            const char* a1 = cA + (size_t)(t + 1) * kstep;
            const char* a2 = last ? nA : cA + (size_t)(t + 2) * kstep; const char* b2 = last ? nB : cB + (size_t)(t + 2) * kstep;
            const char* a3 = a2 + kstep; const char* b3 = b2 + kstep;
            if (last && has_next) S.a_ready(nxt);
            if constexpr (SP2) {
            PG8_LDB(B0, 0, 0); PG8_LDB(B1, 0, 1); PG8_SCHED; PG8_LDA(At, 0, 0); PG8_STAGE(PG8_SA(1, 1), a1 + hstep, voffA);
            PG8_WAIT_V(8); PG8_WAIT_L(0); PG8_BAR; PG8_MMA(0, 0, At, B0); PG8_MMA(0, 1, At, B1); PG8_BAR; PG8_SCHED;
            PG8_LDA(At, 0, 1); PG8_STAGE(PG8_SB(0, 0), b2, voffB); PG8_STAGE(PG8_SB(0, 1), b2 + hstepB, voffB); PG8_STAGE(PG8_SA(0, 0), a2, voffA);
            PG8_WAIT_V(8); PG8_WAIT_L(0); PG8_BAR; PG8_MMA(1, 0, At, B0); PG8_MMA(1, 1, At, B1); PG8_BAR; PG8_SCHED;
            PG8_LDB(B0, 1, 0); PG8_LDB(B1, 1, 1); PG8_SCHED; PG8_LDA(At, 1, 0); PG8_STAGE(PG8_SA(0, 1), a2 + hstep, voffA);
            PG8_WAIT_V(8); PG8_WAIT_L(0); PG8_BAR; PG8_MMA(0, 0, At, B0); PG8_MMA(0, 1, At, B1); PG8_BAR; PG8_SCHED;
            PG8_LDA(At, 1, 1); PG8_STAGE(PG8_SB(1, 0), b3, voffB); PG8_STAGE(PG8_SB(1, 1), b3 + hstepB, voffB); PG8_STAGE(PG8_SA(1, 0), a3, voffA);
            PG8_WAIT_V(8); PG8_WAIT_L(0); PG8_BAR; PG8_MMA(1, 0, At, B0); PG8_MMA(1, 1, At, B1); PG8_BAR; PG8_SCHED;
            } else {
            PG8_LDB(B0, 0, 0); PG8_SCHED; PG8_LDA(At, 0, 0); PG8_STAGE(PG8_SA(1, 1), a1 + hstep, voffA);
            PG8_WAIT_L(8); PG8_BAR; PG8_WAIT_L(0); PG8_MMA(0, 0, At, B0); PG8_BAR; PG8_SCHED;
            PG8_LDB(B1, 0, 1); PG8_STAGE(PG8_SB(0, 0), b2, voffB);
            PG8_BAR; PG8_WAIT_L(0); PG8_MMA(0, 1, At, B1); PG8_BAR;
            PG8_LDA(At, 0, 1); PG8_STAGE(PG8_SA(0, 0), a2, voffA);
            PG8_BAR; PG8_WAIT_L(0); PG8_MMA(1, 0, At, B0); PG8_BAR; PG8_SCHED;
            PG8_STAGE(PG8_SB(0, 1), b2 + hstepB, voffB);
            PG8_WAIT_V(6); PG8_BAR; PG8_MMA(1, 1, At, B1); PG8_BAR;
            PG8_LDB(B0, 1, 0); PG8_SCHED; PG8_LDA(At, 1, 0); PG8_STAGE(PG8_SA(0, 1), a2 + hstep, voffA);
            PG8_WAIT_L(8); PG8_BAR; PG8_WAIT_L(0); PG8_MMA(0, 0, At, B0); PG8_BAR; PG8_SCHED;
            PG8_LDB(B1, 1, 1); PG8_STAGE(PG8_SB(1, 0), b3, voffB);
            PG8_BAR; PG8_WAIT_L(0); PG8_MMA(0, 1, At, B1); PG8_BAR;
            PG8_LDA(At, 1, 1); PG8_STAGE(PG8_SA(1, 0), a3, voffA);
            PG8_BAR; PG8_WAIT_L(0); PG8_MMA(1, 0, At, B0); PG8_BAR; PG8_SCHED;
            PG8_STAGE(PG8_SB(1, 1), b3 + hstepB, voffB);
            PG8_WAIT_V(6); PG8_BAR; PG8_MMA(1, 1, At, B1); PG8_BAR;
            }
        }
        if constexpr (MX8) asm volatile("s_nop 15\n\ts_nop 15" ::: "memory");
        if constexpr (ALIGN_EPI) { if (wr == 0) PG8_BAR; }
        if constexpr (!Epi::AFTER_DRAIN) { E(acc, cur, wr, wc, fr, fq); S.done(cur); }
        if (!has_next) break;
#pragma unroll
        for (int a = 0; a < 2; ++a)
#pragma unroll
            for (int b = 0; b < 2; ++b)
#pragma unroll
                for (int m = 0; m < 4; ++m)
#pragma unroll
                    for (int n = 0; n < 2; ++n) acc[a][b][m][n] = (f32x4){0.f, 0.f, 0.f, 0.f};
        cur = nxt; cA = nA; cB = nB; ++ui;
        if constexpr (ALIGN_EPI) { if (wr == 1) PG8_BAR; }
    }
    PG8_WAIT_V(0);
    if constexpr (!ALIGN_EPI) { if (wr == 0) PG8_BAR; }
    PG8_BAR;
    if constexpr (Epi::AFTER_DRAIN) { E.fused(acc, cur, wr, wc, fr, fq, lds, wid, lane); S.done(cur); }
#undef PG8_SA
#undef PG8_SB
#undef PG8_STAGE
#undef PG8_CAT
#undef PG8_LDA
#undef PG8_LDB
#undef PG8_MMA
#undef PG8_WAIT_V
#undef PG8_WAIT_L
#undef PG8_BAR
#undef PG8_SCHED
}
}
namespace att {
#define ATT_LAS __attribute__((address_space(3)))
typedef unsigned short bf16;
typedef short bf16x8 __attribute__((ext_vector_type(8)));
typedef short s16x4 __attribute__((ext_vector_type(4)));
typedef float f32x16 __attribute__((ext_vector_type(16)));
typedef unsigned u32x4 __attribute__((ext_vector_type(4)));
typedef ATT_LAS char lchar;
constexpr int KBUF = 12288, VBUF = 16384;
constexpr int L_K = 0, L_V = 2 * KBUF, L_WS = L_V + 2 * VBUF, L_RPB = L_WS + 2048, L_END = L_RPB + 2048;
constexpr float LOG2E = 1.4426950408889634f;
#define ATT_SBAR() __builtin_amdgcn_sched_barrier(0)
__device__ __forceinline__ int crow(int r, int hi) { return (r & 3) + 8 * (r >> 2) + 4 * hi; }
__device__ __forceinline__ unsigned cvtpk(float lo, float hi) { unsigned r; asm volatile("v_cvt_pk_bf16_f32 %0, %1, %2" : "=v"(r) : "v"(lo), "v"(hi)); return r; }
__device__ __forceinline__ int v_st(int k, int c) { const int kk = (k & ~0xC) | ((k & 4) << 1) | ((k & 8) >> 1); return ((kk >> 3) * 4 + (c >> 5)) * 512 + ((kk & 7) * 32 + (c & 31)) * 2; }
__device__ __forceinline__ int v_rd_base(int lane) { return ((lane & 3) << 3) | (((lane >> 2) & 3) << 6) | (((lane >> 4) & 1) << 5) | (((lane >> 5) & 1) << 8); }
constexpr int v_rd_off(int d0, int ks, int half) { return d0 * 512 + ks * 4096 + half * 2048; }
template <int OFF> __device__ __forceinline__ s16x4 tr_read(unsigned vb) {
  s16x4 r; asm volatile("ds_read_b64_tr_b16 %0, %1 offset:%2" : "=&v"(r) : "v"(vb), "i"(OFF) : "memory"); return r;
}
template <int D0> __device__ __forceinline__ void pv_one(f32x16& od, unsigned vb, bf16x8 pa0, bf16x8 pa1, bf16x8 pa2, bf16x8 pa3) {
  const s16x4 l0 = tr_read<v_rd_off(D0, 0, 0)>(vb), h0 = tr_read<v_rd_off(D0, 0, 1)>(vb), l1 = tr_read<v_rd_off(D0, 1, 0)>(vb), h1 = tr_read<v_rd_off(D0, 1, 1)>(vb);
  const s16x4 l2 = tr_read<v_rd_off(D0, 2, 0)>(vb), h2 = tr_read<v_rd_off(D0, 2, 1)>(vb), l3 = tr_read<v_rd_off(D0, 3, 0)>(vb), h3 = tr_read<v_rd_off(D0, 3, 1)>(vb);
  asm volatile("s_waitcnt lgkmcnt(0)" ::: "memory"); ATT_SBAR();
#define ATT_PK(L, H) (bf16x8){L[0], L[1], L[2], L[3], H[0], H[1], H[2], H[3]}
  od = __builtin_amdgcn_mfma_f32_32x32x16_bf16(pa0, ATT_PK(l0, h0), od, 0, 0, 0);
  od = __builtin_amdgcn_mfma_f32_32x32x16_bf16(pa1, ATT_PK(l1, h1), od, 0, 0, 0);
  od = __builtin_amdgcn_mfma_f32_32x32x16_bf16(pa2, ATT_PK(l2, h2), od, 0, 0, 0);
  od = __builtin_amdgcn_mfma_f32_32x32x16_bf16(pa3, ATT_PK(l3, h3), od, 0, 0, 0);
#undef ATT_PK
}

template <int DKC, class U>
__device__ __forceinline__ void unit(const U& u, lchar* lds, int tid) {
  asm volatile("" : "+v"(tid));
  const int lane = tid & 63, r32 = lane & 31, hi = lane >> 5;
  const int wid = __builtin_amdgcn_readfirstlane(tid >> 6);
  lchar* Kl = lds + L_K; lchar* Vl = lds + L_V;
  ATT_LAS float* ws = (ATT_LAS float*)(lds + L_WS) + wid * 64;
  bf16x8 qr[DKC / 2];
#pragma unroll
  for (int d0 = 0; d0 < DKC / 2; ++d0) qr[d0] = *(const bf16x8*)u.qptr(wid, r32, d0, hi);
  const int vrow = tid >> 3, vch = tid & 7, vst = v_st(vrow, vch * 8);
  const int krow0 = tid & 63, kch0 = tid >> 6;
  const bool k2 = (DKC > 8) && (tid < 64 * (DKC - 8));
  const unsigned vb0 = (unsigned)(uintptr_t)Vl + (unsigned)v_rd_base(lane);
  bf16x8 kst0, kst1 = {}, vstr;
  const int NT = u.nt();
#define ATT_SLOAD(t) do { const long R_ = u.krow(t); kst0 = *(const bf16x8*)u.kptr(R_ + krow0, kch0); if (k2) kst1 = *(const bf16x8*)u.kptr(R_ + krow0, 8 + kch0); \
    vstr = *(const bf16x8*)u.vptr(R_ + vrow, vch); } while (0)
#define ATT_SWRITE(b) do { *(ATT_LAS bf16x8*)(Kl + (b) * KBUF + kch0 * 1024 + krow0 * 16) = kst0; if (k2) *(ATT_LAS bf16x8*)(Kl + (b) * KBUF + (8 + kch0) * 1024 + krow0 * 16) = kst1; \
    *(ATT_LAS bf16x8*)(Vl + (b) * VBUF + vst) = vstr; } while (0)
  float m_reg = -1e30f, l_reg = 0.f; f32x16 o[2]; o[0] = f32x16{}; o[1] = f32x16{};
  ATT_SLOAD(0); ATT_SWRITE(0); __syncthreads();
  for (int t = 0; t < NT; ++t) {
    const int buf = t & 1;
    if (t + 1 < NT) ATT_SLOAD(t + 1);
    if (!u.skip(t, wid)) {
      f32x16 p0 = f32x16{}, p1 = f32x16{};
      { const lchar* kb = Kl + buf * KBUF + hi * 1024 + r32 * 16;
#pragma unroll
        for (int d0 = 0; d0 < DKC / 2; ++d0) {
          const bf16x8 b0 = *(const ATT_LAS bf16x8*)(kb + d0 * 2048);
          const bf16x8 b1 = *(const ATT_LAS bf16x8*)(kb + d0 * 2048 + 512);
          p0 = __builtin_amdgcn_mfma_f32_32x32x16_bf16(b0, qr[d0], p0, 0, 0, 0);
          p1 = __builtin_amdgcn_mfma_f32_32x32x16_bf16(b1, qr[d0], p1, 0, 0, 0); } }
      u.mask(p0, p1, t, wid, r32, hi);
      float pmax = p0[0];
#pragma unroll
      for (int r = 1; r < 16; ++r) pmax = fmaxf(pmax, p0[r]);
#pragma unroll
      for (int r = 0; r < 16; ++r) pmax = fmaxf(pmax, p1[r]);
      { auto rr = __builtin_amdgcn_permlane32_swap(__float_as_uint(pmax), __float_as_uint(pmax), false, false);
        pmax = fmaxf(__uint_as_float(rr[0]), __uint_as_float(rr[1])); }
      const float mn = fmaxf(m_reg, pmax);
      const float alpha = __builtin_amdgcn_exp2f(m_reg - mn);
      m_reg = mn;
#pragma unroll
      for (int r = 0; r < 16; ++r) { p0[r] = __builtin_amdgcn_exp2f(p0[r] - mn); p1[r] = __builtin_amdgcn_exp2f(p1[r] - mn); }
      float ps = 0.f;
#pragma unroll
      for (int r = 0; r < 16; ++r) ps += p0[r];
#pragma unroll
      for (int r = 0; r < 16; ++r) ps += p1[r];
      { auto rr = __builtin_amdgcn_permlane32_swap(__float_as_uint(ps), __float_as_uint(ps), false, false);
        ps = __uint_as_float(rr[0]) + __uint_as_float(rr[1]); }
      l_reg = l_reg * alpha + ps;
      if (__any(alpha < 1.f)) {
        if (hi == 0) ws[r32] = alpha;
        asm volatile("s_waitcnt lgkmcnt(0)" ::: "memory");
#pragma unroll
        for (int r = 0; r < 16; ++r) { const float a = ws[crow(r, hi)]; o[0][r] *= a; o[1][r] *= a; }
      }
      bf16x8 pa0, pa1, pa2, pa3;
#define ATT_PK4(P, BASE, OUT) do { unsigned a0 = cvtpk(P[BASE + 0], P[BASE + 1]), a1 = cvtpk(P[BASE + 2], P[BASE + 3]);   \
    unsigned b0 = cvtpk(P[BASE + 4], P[BASE + 5]), b1 = cvtpk(P[BASE + 6], P[BASE + 7]);                              \
    auto r0 = __builtin_amdgcn_permlane32_swap(a0, b0, false, false); auto r1 = __builtin_amdgcn_permlane32_swap(a1, b1, false, false); \
    u32x4 w = {r0[0], r1[0], r0[1], r1[1]}; OUT = __builtin_bit_cast(bf16x8, w); } while (0)
      ATT_PK4(p0, 0, pa0); ATT_PK4(p0, 8, pa1); ATT_PK4(p1, 0, pa2); ATT_PK4(p1, 8, pa3);
#undef ATT_PK4
      const unsigned vb = vb0 + (unsigned)(buf * VBUF);
      pv_one<0>(o[0], vb, pa0, pa1, pa2, pa3); pv_one<1>(o[1], vb, pa0, pa1, pa2, pa3);
    }
    if (t + 1 < NT) ATT_SWRITE(buf ^ 1);
    __syncthreads();
  }
#undef ATT_SLOAD
#undef ATT_SWRITE
  { const float sk = u.sink(wid); l_reg += __builtin_amdgcn_exp2f(sk - m_reg); }
  if (hi == 0) ws[r32] = l_reg;
  asm volatile("s_waitcnt lgkmcnt(0)" ::: "memory");
  float rli[16];
#pragma unroll
  for (int r = 0; r < 16; ++r) rli[r] = __builtin_amdgcn_rcpf(ws[crow(r, hi)]);
#pragma unroll
  for (int r = 0; r < 16; ++r) { bf16* op = u.orow(wid, crow(r, hi));
    op[r32] = (bf16)(cvtpk(o[0][r] * rli[r], 0.f) & 0xffffu); op[32 + r32] = (bf16)(cvtpk(o[1][r] * rli[r], 0.f) & 0xffffu); }
  asm volatile("s_waitcnt lgkmcnt(0)" ::: "memory");
}

constexpr int ROWS_LAT = 16384;
struct UWin {
  const bf16* QKV; bf16* O; const float* sinkp; int b, n, g, hh; int i0, cnt;
  __device__ __forceinline__ void init() { i0 = (n == 0) ? 2 : 0; cnt = (n == 0 || n == 63) ? 4 : 6; }
  __device__ __forceinline__ int nt() const { return 4 + cnt; }
  __device__ __forceinline__ int kpos0(int t) const { return 128 * (n - 1) + 64 * (i0 + t - 4); }
  __device__ __forceinline__ long krow(int t) const { return t < 4 ? (long)(ROWS_LAT + 256 * b + 64 * t) : (long)(8192 * b + kpos0(t)); }
  __device__ __forceinline__ const bf16* kptr(long row, int ch) const { return QKV + row * 2304 + 512 + 64 * g + ch * 8; }
  __device__ __forceinline__ const bf16* vptr(long row, int ch) const { return QKV + row * 2304 + 640 + 64 * g + ch * 8; }
  __device__ __forceinline__ int head(int wid) const { return 4 * g + 2 * hh + (wid >> 2); }
  __device__ __forceinline__ int qpos0(int wid) const { return 128 * n + 32 * (wid & 3); }
  __device__ __forceinline__ const bf16* qptr(int wid, int r32, int d0, int hi) const { return QKV + (long)(8192 * b + qpos0(wid) + r32) * 2304 + 64 * head(wid) + 16 * d0 + 8 * hi; }
  __device__ __forceinline__ bool skip(int t, int wid) const { if (t < 4) return false; const int k0 = kpos0(t), q0 = qpos0(wid); return (k0 + 63 < q0 - 128) || (k0 > q0 + 31 + 128); }
  __device__ __forceinline__ void mask(f32x16& p0, f32x16& p1, int t, int wid, int r32, int hi) const {
    if (t < 4) return;
    const int dq = kpos0(t) - (qpos0(wid) + r32);
#pragma unroll
    for (int r = 0; r < 16; ++r) { const int d = dq + crow(r, hi); if (d > 128 || d < -128) p0[r] = -INFINITY; if (d + 32 > 128 || d + 32 < -128) p1[r] = -INFINITY; }
  }
  __device__ __forceinline__ float sink(int wid) const { return sinkp[head(wid)] * LOG2E; }
  __device__ __forceinline__ bf16* orow(int wid, int row) const { return O + (long)(8192 * b + qpos0(wid) + row) * 1024 + 64 * head(wid); }
};
struct UNa {
  const bf16* QKV; bf16* O; const ATT_LAS float* rpbl; int b, h, R4; int krlo, nloc;
  __device__ __forceinline__ static int clampi(int v, int lo, int hi_) { return v < lo ? lo : (v > hi_ ? hi_ : v); }
  __device__ __forceinline__ void init() { krlo = clampi(4 * R4 - 4, 0, 120); const int krhi = clampi(4 * R4 - 1, 0, 120) + 7; nloc = krhi - krlo + 1; }
  __device__ __forceinline__ int nt() const { return 4 + nloc; }
  __device__ __forceinline__ long krow(int t) const { return t < 4 ? (long)(ROWS_LAT + 256 * b + 64 * t) : (long)(8192 * b + 64 * (krlo + t - 4)); }
  __device__ __forceinline__ const bf16* kptr(long row, int ch) const { return QKV + row * 2304 + 1280 + 64 * h + ch * 8; }
  __device__ __forceinline__ const bf16* vptr(long row, int ch) const { return QKV + row * 2304 + 1792 + 64 * h + ch * 8; }
  __device__ __forceinline__ int qrow(int wid) const { return 4 * R4 + (wid >> 1); }
  __device__ __forceinline__ const bf16* qptr(int wid, int r32, int d0, int hi) const { return QKV + (long)(8192 * b + 64 * qrow(wid) + 32 * (wid & 1) + r32) * 2304 + 768 + 64 * h + 16 * d0 + 8 * hi; }
  __device__ __forceinline__ bool skip(int t, int wid) const { if (t < 4) return false; const int kr = krlo + t - 4, w0 = clampi(qrow(wid) - 4, 0, 120); return kr < w0 || kr > w0 + 7; }
  __device__ __forceinline__ void mask(f32x16& p0, f32x16& p1, int t, int wid, int r32, int hi) const {
    if (t < 4) return;
    const int kr = krlo + t - 4, qc = 32 * (wid & 1) + r32, c0 = clampi(qc - 8, 0, 48);
    const ATT_LAS float* brow = rpbl + (kr - qrow(wid) + 7) * 31 + 15;
#pragma unroll
    for (int r = 0; r < 16; ++r) {
      { const int kc = crow(r, hi); const bool ok = kc >= c0 && kc < c0 + 16; const float bv = brow[clampi(kc - qc, -15, 15)]; p0[r] = ok ? p0[r] + bv : -INFINITY; }
      { const int kc = 32 + crow(r, hi); const bool ok = kc >= c0 && kc < c0 + 16; const float bv = brow[clampi(kc - qc, -15, 15)]; p1[r] = ok ? p1[r] + bv : -INFINITY; } }
  }
  __device__ __forceinline__ float sink(int) const { return -INFINITY; }
  __device__ __forceinline__ bf16* orow(int wid, int row) const { return O + (long)(8192 * b + 64 * qrow(wid) + 32 * (wid & 1) + row) * 1024 + 512 + 64 * h; }
};
struct UCtx {
  const bf16* QKV; bf16* O; const float* sinkp; int b, hx; int qcol, kcol, vcol, ocol;
  __device__ __forceinline__ void init() { if (hx < 8) { qcol = 64 * hx; kcol = 512 + 64 * (hx >> 2); vcol = 640 + 64 * (hx >> 2); ocol = 64 * hx; }
    else { const int h = hx - 8; qcol = 768 + 64 * h; kcol = 1280 + 64 * h; vcol = 1792 + 64 * h; ocol = 512 + 64 * h; } }
  __device__ __forceinline__ int nt() const { return 4; }
  __device__ __forceinline__ long krow(int t) const { return (long)(ROWS_LAT + 256 * b + 64 * t); }
  __device__ __forceinline__ const bf16* kptr(long row, int ch) const { return QKV + row * 2304 + kcol + ch * 8; }
  __device__ __forceinline__ const bf16* vptr(long row, int ch) const { return QKV + row * 2304 + vcol + ch * 8; }
  __device__ __forceinline__ const bf16* qptr(int wid, int r32, int d0, int hi) const { return QKV + (long)(ROWS_LAT + 256 * b + 32 * wid + r32) * 2304 + qcol + 16 * d0 + 8 * hi; }
  __device__ __forceinline__ bool skip(int, int) const { return false; }
  __device__ __forceinline__ void mask(f32x16&, f32x16&, int, int, int, int) const {}
  __device__ __forceinline__ float sink(int) const { return hx < 8 ? sinkp[hx] * LOG2E : -INFINITY; }
  __device__ __forceinline__ bf16* orow(int wid, int row) const { return O + (long)(ROWS_LAT + 256 * b + 32 * wid + row) * 1024 + ocol; }
};
struct UDense {
  const bf16* Q; const bf16* KV; const bf16* KR; bf16* O; int b, h, qb;
  __device__ __forceinline__ int nt() const { return 132; }
  __device__ __forceinline__ long krow(int t) const { return t < 4 ? (long)(ROWS_LAT + 256 * b + 64 * t) : (long)(8192 * b + 64 * (t - 4)); }
  __device__ __forceinline__ const bf16* kptr(long row, int ch) const { return ch < 8 ? KV + row * 2048 + 64 * h + ch * 8 : KR + row * 32 + (ch - 8) * 8; }
  __device__ __forceinline__ const bf16* vptr(long row, int ch) const { return KV + row * 2048 + 1024 + 64 * h + ch * 8; }
  __device__ __forceinline__ const bf16* qptr(int wid, int r32, int d0, int hi) const { const bf16* qp = Q + (long)(8192 * b + 256 * qb + 32 * wid + r32) * 1536;
    return d0 < 4 ? qp + 64 * h + 16 * d0 + 8 * hi : qp + 1024 + 32 * h + 16 * (d0 - 4) + 8 * hi; }
  __device__ __forceinline__ bool skip(int, int) const { return false; }
  __device__ __forceinline__ void mask(f32x16&, f32x16&, int, int, int, int) const {}
  __device__ __forceinline__ float sink(int) const { return -INFINITY; }
  __device__ __forceinline__ bf16* orow(int wid, int row) const { return O + (long)(8192 * b + 256 * qb + 32 * wid + row) * 1024 + 64 * h; }
};
#undef ATT_SBAR
}
namespace attd {
typedef unsigned short bf16;
using bf16x8 = __attribute__((ext_vector_type(8))) short;
using s16x4 = __attribute__((ext_vector_type(4))) short;
using f32x16 = __attribute__((ext_vector_type(16))) float;
using u32x4 = __attribute__((ext_vector_type(4))) unsigned;
using i32x2 = __attribute__((ext_vector_type(2))) int;
using i32x4 = __attribute__((ext_vector_type(4))) int;
using i32x8 = __attribute__((ext_vector_type(8))) int;
using u32x6 = __attribute__((ext_vector_type(6))) unsigned;
using u32x16 = __attribute__((ext_vector_type(16))) unsigned;
typedef __bf16 bf16x32 __attribute__((ext_vector_type(32)));
constexpr int NW = 8, NT = 132, KSLOT = 5120, VSLOT = 8192;
constexpr int LDS_K = 0, LDS_V = 3 * KSLOT, LDS_WS = LDS_V + 3 * VSLOT, LDS_OST = LDS_WS + NW * 64 * 4, LDS_BYTES = LDS_OST + NW * 4096;
__device__ __forceinline__ int crow(int r, int hi) { return (r & 3) + 8 * (r >> 2) + 4 * hi; }
#define AF_SBAR() __builtin_amdgcn_sched_barrier(0)
__device__ __forceinline__ void glds16(unsigned voff, const void* sbase, unsigned lds_dst) { unsigned keep;
  asm volatile("s_mov_b32 %0, m0\n\ts_mov_b32 m0, %3\n\ts_nop 0\n\tglobal_load_lds_dwordx4 %1, %2\n\ts_mov_b32 m0, %0" : "=&s"(keep) : "v"(voff), "s"(sbase), "s"(lds_dst) : "memory"); }
typedef float f32x2_t __attribute__((ext_vector_type(2))); typedef __bf16 bf16x2_t __attribute__((ext_vector_type(2)));
__device__ __forceinline__ unsigned cvtpk_s(float lo, float hi) { f32x2_t v = {lo, hi}; bf16x2_t b = __builtin_convertvector(v, bf16x2_t); return __builtin_bit_cast(unsigned, b); }
#define AF_WAIT_BAR(N) asm volatile("s_waitcnt vmcnt(" #N ") lgkmcnt(0)\n\ts_barrier" ::: "memory")
typedef __attribute__((address_space(3))) const char* lds_cptr;
typedef short v4i16_t __attribute__((ext_vector_type(4)));
__device__ __forceinline__ i32x8 ld6(lds_cptr p16, lds_cptr p8) { const i32x4 a = *(const __attribute__((address_space(3))) i32x4*)p16; const i32x2 b = *(const __attribute__((address_space(3))) i32x2*)p8;
  return (i32x8){a.x, a.y, a.z, a.w, b.x, b.y, 0, 0}; }
__device__ __forceinline__ s16x4 vtr(lds_cptr p) { return __builtin_bit_cast(s16x4, __builtin_amdgcn_ds_read_tr16_b64_v4i16((__attribute__((address_space(3))) v4i16_t*)p)); }
__device__ __forceinline__ long tile_row(int b, int t) { return t < 4 ? (long)(16384 + 256 * b + 64 * t) : (long)(8192 * b + 64 * (t - 4)); }
__device__ __forceinline__ u32x6 to_fp6(u32x4 a0, u32x4 a1, u32x4 a2, u32x4 a3) { const u32x16 all = {a0.x, a0.y, a0.z, a0.w, a1.x, a1.y, a1.z, a1.w, a2.x, a2.y, a2.z, a2.w, a3.x, a3.y, a3.z, a3.w};
  return __builtin_amdgcn_cvt_scalef32_pk32_fp6_bf16(__builtin_bit_cast(bf16x32, all), 1.0f); }

__device__ __forceinline__ void dense_unit(int b, int h, int qb, const bf16* Q, const bf16* __restrict__ KV, const char* __restrict__ K6N, const char* __restrict__ K6R, bf16* O, char* shm, const int tid) {
  const int lane = tid & 63, r32 = lane & 31, hi = lane >> 5; const int wid = __builtin_amdgcn_readfirstlane(tid >> 6);
  const unsigned lds0 = (unsigned)(uintptr_t)shm;
  float* wsf = (float*)(shm + LDS_WS) + wid * 64;
  const bool wnp = wid < 3 || wid >= 5; const int pc = wnp ? (wid < 3 ? wid : wid - 5) : wid - 3;
  const unsigned voffK = (unsigned)(lane * 16);
  const char* sK = wnp ? K6N + h * 3072 + pc * 1024 : K6R + pc * 1024; const long kts = wnp ? 16 * 3072 : 2048;
  const unsigned voffV = (unsigned)((16 * (wid & 3) + (lane >> 2)) * 2048 + (wid >> 2) * 32 + (lane & 3) * 8) * 2u;
  const char* sV = (const char*)(KV + 1024 + 64 * h);
  const unsigned kdst = lds0 + LDS_K + (wnp ? pc * 1024 : 3072 + pc * 1024), vdst = lds0 + LDS_V + wid * 1024;
#define AF_DMA_K(t, ks) do { const long G_ = tile_row(b, (t)) >> 6; glds16(voffK, sK + G_ * kts, (unsigned)__builtin_amdgcn_readfirstlane(kdst + (ks))); } while (0)
#define AF_DMA_V(t, vs) do { const long R_ = tile_row(b, (t)); glds16(voffV, sV + R_ * 4096, (unsigned)__builtin_amdgcn_readfirstlane(vdst + (vs))); } while (0)
  const lds_cptr shm3 = (lds_cptr)shm;
  const lds_cptr kp16 = shm3 + LDS_K + hi * 1024 + r32 * 16;
  const lds_cptr kp8 = shm3 + LDS_K + 2048 + hi * 512 + r32 * 8;
  const lds_cptr vp0 = shm3 + LDS_V + ((lane >> 4) & 1) * 32 + (lane & 3) * 8 + (4 * hi + ((lane & 15) >> 2)) * 64;
  AF_DMA_K(0, 0); AF_DMA_V(0, 0); AF_DMA_K(1, KSLOT); AF_DMA_K(2, 2 * KSLOT);
  i32x8 qn, qr;
  { const bf16* qp = Q + (long)(8192 * b + 256 * qb + 32 * wid + r32) * 1536; const bf16* qa = qp + 64 * h + 32 * hi; const bf16* qc = qp + 1024 + 32 * h;
    const u32x6 n6 = to_fp6(*reinterpret_cast<const u32x4*>(qa), *reinterpret_cast<const u32x4*>(qa + 8), *reinterpret_cast<const u32x4*>(qa + 16), *reinterpret_cast<const u32x4*>(qa + 24));
    u32x6 r6 = to_fp6(*reinterpret_cast<const u32x4*>(qc), *reinterpret_cast<const u32x4*>(qc + 8), *reinterpret_cast<const u32x4*>(qc + 16), *reinterpret_cast<const u32x4*>(qc + 24));
    if (hi) r6 = (u32x6){0u, 0u, 0u, 0u, 0u, 0u};
    qn = (i32x8){(int)n6[0], (int)n6[1], (int)n6[2], (int)n6[3], (int)n6[4], (int)n6[5], 0, 0}; qr = (i32x8){(int)r6[0], (int)r6[1], (int)r6[2], (int)r6[3], (int)r6[4], (int)r6[5], 0, 0}; }
  float l_reg = 0.f; f32x16 o[2]; o[0] = f32x16{}; o[1] = f32x16{};
  f32x16 pA0, pA1, pB0, pB1; i32x8 kn0, kn1, kr0, kr1;
  int s_prev = 0, s_cur = 0, s_next = 1;
#define AF_ROT() do { s_prev = s_cur; s_cur = s_next; s_next = (s_next == 2) ? 0 : s_next + 1; } while (0)
#define AF_MF(a, b, c) __builtin_amdgcn_mfma_f32_32x32x16_bf16(a, b, c, 0, 0, 0)
  int sck_ = 0x7b7b7b7b, scq_ = 0x7f7f7f7f; asm volatile("" : "+v"(sck_), "+v"(scq_));
#define AF_MX(a, b, c) __builtin_amdgcn_mfma_scale_f32_32x32x64_f8f6f4(a, b, c, 2, 2, 0, sck_, 0, scq_)
#define AF_EX(v) __builtin_amdgcn_exp2f(v)
  const f32x16 zero16 = f32x16{};
  AF_WAIT_BAR(0);
  { pA0 = AF_MX(ld6(kp16, kp8), qn, zero16); pA1 = AF_MX(ld6(kp16 + 512, kp8 + 256), qn, zero16);
    pA0 = AF_MX(ld6(kp16 + 3072, kp8 + 2048), qr, pA0); pA1 = AF_MX(ld6(kp16 + 3072 + 512, kp8 + 2048 + 256), qr, pA1);
#pragma unroll
    for (int r = 0; r < 16; ++r) { pA0[r] = AF_EX(pA0[r]); pA1[r] = AF_EX(pA1[r]); } }
  AF_WAIT_BAR(0);
  AF_DMA_K(3, 0); AF_DMA_V(1, VSLOT);
  AF_ROT();
  { const lds_cptr k16_ = kp16 + s_cur * KSLOT, k8_ = kp8 + s_cur * KSLOT; kn0 = ld6(k16_, k8_); kn1 = ld6(k16_ + 512, k8_ + 256); kr0 = ld6(k16_ + 3072, k8_ + 2048); kr1 = ld6(k16_ + 3072 + 512, k8_ + 2048 + 256); }
  AF_WAIT_BAR(2);
  s16x4 vlo[8], vhi[8]; u32x4 pw0, pw1, pw2, pw3;
#define AF_PKW(P, B) cvtpk_s(P[B], P[B + 1])
#define AF_PAF(k) __builtin_bit_cast(bf16x8, pw##k)
#define AF_VFR(i) (bf16x8){vlo[i][0], vlo[i][1], vlo[i][2], vlo[i][3], vhi[i][0], vhi[i][1], vhi[i][2], vhi[i][3]}
#define AF_PIN(x) asm volatile("" : "+v"(x))
#define AF_VRD(i) do { vlo[i] = vtr(vp_ + (((i) >> 2) * 4096 + ((i) & 3) * 1024)); vhi[i] = vtr(vp_ + (((i) >> 2) * 4096 + ((i) & 3) * 1024 + 512)); AF_SBAR(); } while (0)
#define AF_GB(MF, X, B) do { MF; X[B] = AF_EX(X[B]); X[B + 1] = AF_EX(X[B + 1]); X[B + 2] = AF_EX(X[B + 2]); X[B + 3] = AF_EX(X[B + 3]); AF_PIN(X); AF_SBAR(); } while (0)
#define AF_KRD(G, j) do { if (G) { const lds_cptr k16_ = kp16 + s_next * KSLOT, k8_ = kp8 + s_next * KSLOT; \
      if ((j) == 0) kn0 = ld6(k16_, k8_); if ((j) == 1) kn1 = ld6(k16_ + 512, k8_ + 256); \
      if ((j) == 2) kr0 = ld6(k16_ + 3072, k8_ + 2048); if ((j) == 3) kr1 = ld6(k16_ + 3072 + 512, k8_ + 2048 + 256); AF_SBAR(); } } while (0)
#define AF_A4(P, B) do { sacc += P[B]; sacc += P[B + 1]; sacc += P[B + 2]; sacc += P[B + 3]; } while (0)
#define AF_STEP(C0, C1, P0, P1, t, GK, GV, GL) do { AF_SBAR(); \
    const lds_cptr vp_ = vp0 + s_prev * VSLOT; \
    float sacc = (P0[0] + P0[1]); \
    AF_VRD(0); AF_VRD(4); \
    { C0 = AF_MX(kn0, qn, zero16); sacc += P0[2]; sacc += P0[3]; AF_A4(P0, 4); AF_PIN(sacc); \
      pw0[0] = AF_PKW(P0, 0); pw0[1] = AF_PKW(P0, 2); pw0[2] = AF_PKW(P0, 4); pw0[3] = AF_PKW(P0, 6); AF_PIN(pw0); AF_SBAR(); } \
    AF_VRD(1); AF_VRD(5); \
    { C1 = AF_MX(kn1, qn, zero16); AF_A4(P0, 8); AF_A4(P0, 12); AF_PIN(sacc); \
      pw1[0] = AF_PKW(P0, 8); pw1[1] = AF_PKW(P0, 10); pw1[2] = AF_PKW(P0, 12); pw1[3] = AF_PKW(P0, 14); AF_PIN(pw1); AF_SBAR(); } \
    AF_VRD(2); AF_VRD(6); \
    { C0 = AF_MX(kr0, qr, C0); AF_A4(P1, 0); AF_A4(P1, 4); AF_PIN(sacc); \
      pw2[0] = AF_PKW(P1, 0); pw2[1] = AF_PKW(P1, 2); pw2[2] = AF_PKW(P1, 4); pw2[3] = AF_PKW(P1, 6); AF_PIN(pw2); AF_SBAR(); } \
    if (GK) { AF_DMA_K((t) + 3, s_cur * KSLOT); AF_SBAR(); } \
    AF_VRD(3); AF_VRD(7); \
    { C1 = AF_MX(kr1, qr, C1); AF_A4(P1, 8); AF_A4(P1, 12); AF_PIN(sacc); \
      pw3[0] = AF_PKW(P1, 8); pw3[1] = AF_PKW(P1, 10); pw3[2] = AF_PKW(P1, 12); pw3[3] = AF_PKW(P1, 14); AF_PIN(pw3); AF_SBAR(); } \
    if (GV) { AF_DMA_V((t) + 1, s_next * VSLOT); AF_SBAR(); } \
    l_reg += sacc; \
    AF_SBAR(); \
    AF_GB(o[0] = AF_MF(AF_PAF(0), AF_VFR(0), o[0]), C0, 0);  AF_KRD(GL, 0); \
    AF_GB(o[1] = AF_MF(AF_PAF(0), AF_VFR(4), o[1]), C0, 4);  AF_KRD(GL, 1); \
    AF_GB(o[0] = AF_MF(AF_PAF(1), AF_VFR(1), o[0]), C0, 8);  AF_KRD(GL, 2); \
    AF_GB(o[1] = AF_MF(AF_PAF(1), AF_VFR(5), o[1]), C0, 12); AF_KRD(GL, 3); \
    AF_GB(o[0] = AF_MF(AF_PAF(2), AF_VFR(2), o[0]), C1, 0); \
    AF_GB(o[1] = AF_MF(AF_PAF(2), AF_VFR(6), o[1]), C1, 4); \
    AF_GB(o[0] = AF_MF(AF_PAF(3), AF_VFR(3), o[0]), C1, 8); \
    AF_GB(o[1] = AF_MF(AF_PAF(3), AF_VFR(7), o[1]), C1, 12); \
  } while (0)
  int t = 1;
  for (; t + 3 < NT; t += 2) {
    AF_STEP(pB0, pB1, pA0, pA1, t, true, true, true);     AF_WAIT_BAR(2); AF_ROT();
    AF_STEP(pA0, pA1, pB0, pB1, t + 1, true, true, true); AF_WAIT_BAR(2); AF_ROT();
  }
  AF_STEP(pB0, pB1, pA0, pA1, NT - 3, false, true, true);  AF_WAIT_BAR(1); AF_ROT();
  AF_STEP(pA0, pA1, pB0, pB1, NT - 2, false, true, true);  AF_WAIT_BAR(0); AF_ROT();
  AF_STEP(pB0, pB1, pA0, pA1, NT - 1, false, false, false);
  { float sacc = pB0[0] + pB0[1];
#pragma unroll
    for (int r = 2; r < 16; ++r) sacc += pB0[r];
#pragma unroll
    for (int r = 0; r < 16; ++r) sacc += pB1[r];
    l_reg += sacc;
    pw0 = (u32x4){AF_PKW(pB0, 0), AF_PKW(pB0, 2), AF_PKW(pB0, 4), AF_PKW(pB0, 6)}; pw1 = (u32x4){AF_PKW(pB0, 8), AF_PKW(pB0, 10), AF_PKW(pB0, 12), AF_PKW(pB0, 14)};
    pw2 = (u32x4){AF_PKW(pB1, 0), AF_PKW(pB1, 2), AF_PKW(pB1, 4), AF_PKW(pB1, 6)}; pw3 = (u32x4){AF_PKW(pB1, 8), AF_PKW(pB1, 10), AF_PKW(pB1, 12), AF_PKW(pB1, 14)};
    AF_SBAR();
    const lds_cptr vp_ = vp0 + s_cur * VSLOT;
#pragma unroll
    for (int i = 0; i < 8; ++i) { vlo[i] = vtr(vp_ + ((i >> 2) * 4096 + (i & 3) * 1024)); vhi[i] = vtr(vp_ + ((i >> 2) * 4096 + (i & 3) * 1024 + 512)); }
    o[0] = AF_MF(AF_PAF(0), AF_VFR(0), o[0]); o[1] = AF_MF(AF_PAF(0), AF_VFR(4), o[1]);
    o[0] = AF_MF(AF_PAF(1), AF_VFR(1), o[0]); o[1] = AF_MF(AF_PAF(1), AF_VFR(5), o[1]);
    o[0] = AF_MF(AF_PAF(2), AF_VFR(2), o[0]); o[1] = AF_MF(AF_PAF(2), AF_VFR(6), o[1]);
    o[0] = AF_MF(AF_PAF(3), AF_VFR(3), o[0]); o[1] = AF_MF(AF_PAF(3), AF_VFR(7), o[1]); }
  { auto rr = __builtin_amdgcn_permlane32_swap(__float_as_uint(l_reg), __float_as_uint(l_reg), false, false); l_reg = __uint_as_float(rr[0]) + __uint_as_float(rr[1]); }
  if (hi == 0) wsf[32 + r32] = l_reg; asm volatile("s_waitcnt lgkmcnt(0)" ::: "memory");
  float rli[16];
#pragma unroll
  for (int r = 0; r < 16; ++r) rli[r] = __builtin_amdgcn_rcpf(wsf[32 + crow(r, hi)]);
  bf16* Ow = O + (long)(8192 * b + 256 * qb + 32 * wid) * 1024 + 64 * h;
  { bf16* stg = (bf16*)(shm + LDS_OST) + wid * 2048;
#pragma unroll
    for (int r = 0; r < 16; ++r) { const int orow = crow(r, hi);
#pragma unroll
      for (int d0 = 0; d0 < 2; ++d0) stg[orow * 64 + d0 * 32 + r32] = (bf16)(cvtpk_s(o[d0][r] * rli[r], 0.f) & 0xffffu); }
    asm volatile("s_waitcnt lgkmcnt(0)" ::: "memory");
#pragma unroll
    for (int i = 0; i < 4; ++i) { const int row = i * 8 + (lane >> 3), ch = lane & 7; const u32x4 v = *(const u32x4*)(stg + row * 64 + ch * 8); *(u32x4*)(Ow + (long)row * 1024 + ch * 8) = v; } }
  asm volatile("s_waitcnt lgkmcnt(0)\n\ts_barrier" ::: "memory");
#undef AF_DMA_K
#undef AF_DMA_V
#undef AF_ROT
#undef AF_PKW
#undef AF_PAF
#undef AF_VFR
#undef AF_PIN
#undef AF_MF
#undef AF_MX
#undef AF_EX
#undef AF_VRD
#undef AF_GB
#undef AF_KRD
#undef AF_A4
#undef AF_STEP
}
#undef AF_SBAR
#undef AF_WAIT_BAR
}
namespace attf {
typedef unsigned short bf16;
using bf16x8 = __attribute__((ext_vector_type(8))) short;
using s16x4 = __attribute__((ext_vector_type(4))) short;
using f32x16 = __attribute__((ext_vector_type(16))) float;
using u32x4 = __attribute__((ext_vector_type(4))) unsigned;
using i32x2 = __attribute__((ext_vector_type(2))) int;
using i32x4 = __attribute__((ext_vector_type(4))) int;
using i32x8 = __attribute__((ext_vector_type(8))) int;
using u32x6 = __attribute__((ext_vector_type(6))) unsigned;
using u32x16 = __attribute__((ext_vector_type(16))) unsigned;
typedef __bf16 bf16x32 __attribute__((ext_vector_type(32)));
constexpr int NW = 8, KSLOT = 12288, VSLOT = 8192;
constexpr int LDS_K = 0, LDS_V = 3 * KSLOT, LDS_WS = LDS_V + 3 * VSLOT, LDS_OST = LDS_WS + NW * 64 * 4, LDS_RPB = LDS_OST + NW * 4096, LDS_BYTES = LDS_RPB + 2048;
__device__ __forceinline__ int crow(int r, int hi) { return (r & 3) + 8 * (r >> 2) + 4 * hi; }
#define AF_SBAR() __builtin_amdgcn_sched_barrier(0)
__device__ __forceinline__ void glds16(unsigned voff, const void* sbase, unsigned lds_dst) { unsigned keep;
  asm volatile("s_mov_b32 %0, m0\n\ts_mov_b32 m0, %3\n\ts_nop 0\n\tglobal_load_lds_dwordx4 %1, %2\n\ts_mov_b32 m0, %0" : "=&s"(keep) : "v"(voff), "s"(sbase), "s"(lds_dst) : "memory"); }
typedef float f32x2_t __attribute__((ext_vector_type(2))); typedef __bf16 bf16x2_t __attribute__((ext_vector_type(2)));
__device__ __forceinline__ unsigned cvtpk_s(float lo, float hi) { f32x2_t v = {lo, hi}; bf16x2_t b = __builtin_convertvector(v, bf16x2_t); return __builtin_bit_cast(unsigned, b); }
#define AF_WAIT_BAR(N) asm volatile("s_waitcnt vmcnt(" #N ") lgkmcnt(0)\n\ts_barrier" ::: "memory")
typedef __attribute__((address_space(3))) const char* lds_cptr;
typedef short v4i16_t __attribute__((ext_vector_type(4)));
__device__ __forceinline__ void kload2(bf16x8* kf, lds_cptr kp, int j) { kf[2 * j] = *(const __attribute__((address_space(3))) bf16x8*)(kp + j * 2048); kf[2 * j + 1] = *(const __attribute__((address_space(3))) bf16x8*)(kp + j * 2048 + 512); }
__device__ __forceinline__ i32x8 ld6(lds_cptr p16, lds_cptr p8) { const i32x4 a = *(const __attribute__((address_space(3))) i32x4*)p16; const i32x2 b = *(const __attribute__((address_space(3))) i32x2*)p8;
  const i32x4 b4 = __builtin_shufflevector(b, b, 0, 1, -1, -1); return __builtin_shufflevector(a, b4, 0, 1, 2, 3, 4, 5, -1, -1); }
__device__ __forceinline__ i32x8 to_fp6(u32x4 a0, u32x4 a1, u32x4 a2, u32x4 a3) { const u32x16 all = {a0.x, a0.y, a0.z, a0.w, a1.x, a1.y, a1.z, a1.w, a2.x, a2.y, a2.z, a2.w, a3.x, a3.y, a3.z, a3.w};
  const u32x6 c = __builtin_amdgcn_cvt_scalef32_pk32_fp6_bf16(__builtin_bit_cast(bf16x32, all), 1.0f); return __builtin_bit_cast(i32x8, __builtin_shufflevector(c, c, 0, 1, 2, 3, 4, 5, -1, -1)); }
__device__ __forceinline__ s16x4 vtr(lds_cptr p) { return __builtin_bit_cast(s16x4, __builtin_amdgcn_ds_read_tr16_b64_v4i16((__attribute__((address_space(3))) v4i16_t*)p)); }

template <int DKC, class U, bool F6 = false>
__device__ __forceinline__ void fast_unit(const U& u, char* shm, int tid) {
  static_assert(DKC == 8 || DKC == 12, "q/k dim 64 or 96"); static_assert(!F6 || DKC == 8, "fp6 logits: q/k dim 64");
  asm volatile("" : "+v"(tid));
  constexpr int ND0 = DKC / 2;
  const int lane = tid & 63, r32 = lane & 31, hi = lane >> 5; const int wid = __builtin_amdgcn_readfirstlane(tid >> 6);
  const unsigned lds0 = (unsigned)(uintptr_t)shm;
  float* wsf = (float*)(shm + LDS_WS) + wid * 64;
  const int NT = u.nt();
  const unsigned voffKA = (unsigned)(lane * u.kpitch + 8 * wid) * 2u;
  const unsigned voffKB = (unsigned)(lane * 32 + 8 * (wid & 3)) * 2u;
  const unsigned voffV = (unsigned)((16 * (wid & 3) + (lane >> 2)) * u.vpitch + (wid >> 2) * 32 + (lane & 3) * 8) * 2u;
  const unsigned kdstA = lds0 + LDS_K + wid * 1024, kdstB = lds0 + LDS_K + (8 + (wid & 3)) * 1024, vdst = lds0 + LDS_V + wid * 1024;
  const int pc6 = wid % 3; const unsigned voffK6 = (unsigned)(lane * 16), kdst6 = lds0 + LDS_K + pc6 * 1024;
#define AF_DMA_KA(t, ks) do { const long R_ = u.trow(t); if constexpr (F6) glds16(voffK6, u.k6base + (R_ >> 6) * 30720 + pc6 * 1024, (unsigned)__builtin_amdgcn_readfirstlane(kdst6 + (ks))); \
    else glds16(voffKA, (const char*)u.kbase + R_ * (2 * u.kpitch), (unsigned)__builtin_amdgcn_readfirstlane(kdstA + (ks))); } while (0)
#define AF_DMA_KB(t, ks) do { if constexpr (DKC == 12) { const long R_ = u.trow(t); glds16(voffKB, (const char*)u.krbase + R_ * 64, (unsigned)__builtin_amdgcn_readfirstlane(kdstB + (ks))); } } while (0)
#define AF_DMA_K(t, ks) do { AF_DMA_KA(t, ks); AF_DMA_KB(t, ks); } while (0)
#define AF_DMA_V(t, vs) do { const long R_ = u.trow(t); glds16(voffV, (const char*)u.vbase + R_ * (2 * u.vpitch), (unsigned)__builtin_amdgcn_readfirstlane(vdst + (vs))); } while (0)
#define AF_WAITN(NSTEPS_K, NV) do { if constexpr (DKC == 12) { if ((NSTEPS_K) == 2 && (NV) == 1) AF_WAIT_BAR(5); else if ((NSTEPS_K) == 1 && (NV) == 1) AF_WAIT_BAR(3); else if ((NV) == 1) AF_WAIT_BAR(1); else AF_WAIT_BAR(0); } \
    else { if ((NSTEPS_K) == 2 && (NV) == 1) AF_WAIT_BAR(3); else if ((NSTEPS_K) == 1 && (NV) == 1) AF_WAIT_BAR(2); else if ((NV) == 1) AF_WAIT_BAR(1); else AF_WAIT_BAR(0); } } while (0)
  const lds_cptr shm3 = (lds_cptr)shm; const lds_cptr kp0 = shm3 + LDS_K + hi * 1024 + r32 * 16;
  const lds_cptr kp8 = shm3 + LDS_K + 2048 + hi * 512 + r32 * 8;
  const lds_cptr vp0 = shm3 + LDS_V + ((lane >> 4) & 1) * 32 + (lane & 3) * 8 + (4 * hi + ((lane & 15) >> 2)) * 64;
  bf16x8 qr[ND0]; i32x8 qn; u32x4 qw0_, qw1_, qw2_, qw3_;
  if constexpr (F6) { const bf16* qa = u.qptr(wid, r32, 0, 0) + 32 * hi;
    qw0_ = *reinterpret_cast<const u32x4*>(qa); qw1_ = *reinterpret_cast<const u32x4*>(qa + 8); qw2_ = *reinterpret_cast<const u32x4*>(qa + 16); qw3_ = *reinterpret_cast<const u32x4*>(qa + 24); }
  else {
#pragma unroll
    for (int d0 = 0; d0 < ND0; ++d0) qr[d0] = *reinterpret_cast<const bf16x8*>(u.qptr(wid, r32, d0, hi)); }
  AF_DMA_K(0, 0); AF_DMA_V(0, 0); AF_DMA_K(1, KSLOT); AF_DMA_K(2, 2 * KSLOT);
  if constexpr (F6) qn = to_fp6(qw0_, qw1_, qw2_, qw3_);
  float l_reg = 0.f; f32x16 o[2]; o[0] = f32x16{}; o[1] = f32x16{};
  f32x16 pA0, pA1, pB0, pB1; bf16x8 kf[DKC]; i32x8 kn0, kn1;
  int sck_ = 0x7b7b7b7b, scq_ = 0x7f7f7f7f; asm volatile("" : "+v"(sck_), "+v"(scq_));
#define AF_MX6(a, b, c) __builtin_amdgcn_mfma_scale_f32_32x32x64_f8f6f4(a, b, c, 2, 2, 0, sck_, 0, scq_)
  int s_prev = 0, s_cur = 0, s_next = 1;
#define AF_ROT() do { s_prev = s_cur; s_cur = s_next; s_next = (s_next == 2) ? 0 : s_next + 1; } while (0)
  AF_WAITN(2, 1);
  { const char* kb = shm + LDS_K + hi * 1024 + r32 * 16; pA0 = f32x16{}; pA1 = f32x16{};
    if constexpr (F6) { pA0 = AF_MX6(ld6(kp0, kp8), qn, pA0); pA1 = AF_MX6(ld6(kp0 + 512, kp8 + 256), qn, pA1); }
    else
#pragma unroll
    for (int d0 = 0; d0 < ND0; ++d0) { const bf16x8 b0 = *reinterpret_cast<const bf16x8*>(kb + d0 * 2048), b1 = *reinterpret_cast<const bf16x8*>(kb + d0 * 2048 + 512);
      pA0 = __builtin_amdgcn_mfma_f32_32x32x16_bf16(b0, qr[d0], pA0, 0, 0, 0); pA1 = __builtin_amdgcn_mfma_f32_32x32x16_bf16(b1, qr[d0], pA1, 0, 0, 0); }
    if constexpr (U::HAS_MASK) u.mask(pA0, pA1, 0, wid, r32, hi);
#pragma unroll
    for (int r = 0; r < 16; ++r) { pA0[r] = __builtin_amdgcn_exp2f(pA0[r]); pA1[r] = __builtin_amdgcn_exp2f(pA1[r]); } }
  AF_WAIT_BAR(0);
  AF_DMA_K(3, 0); AF_DMA_V(1, VSLOT);
  AF_ROT();
  if constexpr (F6) { kn0 = ld6(kp0 + s_cur * KSLOT, kp8 + s_cur * KSLOT); kn1 = ld6(kp0 + s_cur * KSLOT + 512, kp8 + s_cur * KSLOT + 256); }
  else {
#pragma unroll
    for (int j = 0; j < ND0; ++j) kload2(kf, kp0 + s_cur * KSLOT, j); }
  AF_WAITN(1, 1);
  s16x4 vlo[8], vhi[8]; u32x4 pw0, pw1, pw2, pw3;
#define AF_PKW(P, B) cvtpk_s(P[B], P[B + 1])
#define AF_PAF(k) __builtin_bit_cast(bf16x8, pw##k)
#define AF_VFR(i) (bf16x8){vlo[i][0], vlo[i][1], vlo[i][2], vlo[i][3], vhi[i][0], vhi[i][1], vhi[i][2], vhi[i][3]}
#define AF_PIN(x) asm volatile("" : "+v"(x))
#define AF_MF(a, b, c) __builtin_amdgcn_mfma_f32_32x32x16_bf16(a, b, c, 0, 0, 0)
#define AF_EX(v) __builtin_amdgcn_exp2f(v)
#define AF_VRD(i) do { vlo[i] = vtr(vp_ + (((i) >> 2) * 4096 + ((i) & 3) * 1024)); vhi[i] = vtr(vp_ + (((i) >> 2) * 4096 + ((i) & 3) * 1024 + 512)); AF_SBAR(); } while (0)
#define AF_GA4(MF, A0, A1, A2, A3, W0, W1, PW) do { MF; sacc += A0; sacc += A1; sacc += A2; sacc += A3; AF_PIN(sacc); W0; W1; AF_PIN(PW); AF_SBAR(); } while (0)
#define AF_GA3(MF, A0, A1, A2, W0, W1, PW) do { MF; sacc += A0; sacc += A1; sacc += A2; AF_PIN(sacc); W0; W1; AF_PIN(PW); AF_SBAR(); } while (0)
#define AF_GA2(MF, A0, A1, W0, PW) do { MF; sacc += A0; sacc += A1; AF_PIN(sacc); W0; AF_PIN(PW); AF_SBAR(); } while (0)
#define AF_GB(MF, X, B) do { MF; X[B] = AF_EX(X[B]); X[B + 1] = AF_EX(X[B + 1]); X[B + 2] = AF_EX(X[B + 2]); X[B + 3] = AF_EX(X[B + 3]); AF_PIN(X); AF_SBAR(); } while (0)
#define AF_KRD(G, j) do { if constexpr (F6) { if ((j) < 2) { if (G) { if ((j) == 0) kn0 = ld6(kp0 + s_next * KSLOT, kp8 + s_next * KSLOT); else kn1 = ld6(kp0 + s_next * KSLOT + 512, kp8 + s_next * KSLOT + 256); AF_SBAR(); } } } \
    else if ((j) < ND0) { if (G) { kload2(kf, kp0 + s_next * KSLOT, (j) < ND0 ? (j) : 0); AF_SBAR(); } } } while (0)
  const f32x16 zero16 = f32x16{};
#define AF_PHASE_A12(C0, C1, P0, P1, t, GK, GV) do { \
    AF_VRD(0); float sacc = (P0[0] + P0[1]); \
    AF_GA3(C0 = AF_MF(kf[0], qr[0], zero16), P0[2], P0[3], P0[4],     pw0[0] = AF_PKW(P0, 0), pw0[1] = AF_PKW(P0, 2), pw0); \
    AF_VRD(4); AF_GA3(C1 = AF_MF(kf[1], qr[0], zero16), P0[5], P0[6], P0[7],     pw0[2] = AF_PKW(P0, 4), pw0[3] = AF_PKW(P0, 6), pw0); \
    AF_VRD(1); AF_GA3(C0 = AF_MF(kf[2], qr[1], C0),     P0[8], P0[9], P0[10],    pw1[0] = AF_PKW(P0, 8), pw1[1] = AF_PKW(P0, 10), pw1); \
    AF_VRD(5); AF_GA3(C1 = AF_MF(kf[3], qr[1], C1),     P0[11], P0[12], P0[13],  pw1[2] = AF_PKW(P0, 12), pw1[3] = AF_PKW(P0, 14), pw1); \
    AF_VRD(2); AF_GA3(C0 = AF_MF(kf[4], qr[2], C0),     P0[14], P0[15], P1[0],   pw2[0] = AF_PKW(P1, 0), pw2[1] = AF_PKW(P1, 2), pw2); \
    AF_VRD(6); AF_GA3(C1 = AF_MF(kf[5], qr[2], C1),     P1[1], P1[2], P1[3],     pw2[2] = AF_PKW(P1, 4), pw2[3] = AF_PKW(P1, 6), pw2); \
    AF_VRD(3); AF_GA2(C0 = AF_MF(kf[6], qr[3], C0),     P1[4], P1[5],            pw3[0] = AF_PKW(P1, 8), pw3); \
    AF_VRD(7); AF_GA2(C1 = AF_MF(kf[7], qr[3], C1),     P1[6], P1[7],            pw3[1] = AF_PKW(P1, 10), pw3); \
    AF_GA2(C0 = AF_MF(kf[8 % DKC], qr[4 % ND0], C0),    P1[8], P1[9],            pw3[2] = AF_PKW(P1, 12), pw3); \
    if (GK) { AF_DMA_KA((t) + 3, s_cur * KSLOT); AF_SBAR(); } \
    AF_GA2(C1 = AF_MF(kf[9 % DKC], qr[4 % ND0], C1),    P1[10], P1[11],          pw3[3] = AF_PKW(P1, 14), pw3); \
    if (GK) { AF_DMA_KB((t) + 3, s_cur * KSLOT); AF_SBAR(); } \
    { C0 = AF_MF(kf[10 % DKC], qr[5 % ND0], C0); sacc += P1[12]; sacc += P1[13]; AF_PIN(sacc); AF_SBAR(); } \
    if (GV) { AF_DMA_V((t) + 1, s_next * VSLOT); AF_SBAR(); } \
    { C1 = AF_MF(kf[11 % DKC], qr[5 % ND0], C1); sacc += P1[14]; sacc += P1[15]; AF_PIN(sacc); AF_SBAR(); } \
    l_reg += sacc; } while (0)
#define AF_PHASE_A8(C0, C1, P0, P1, t, GK, GV) do { \
    AF_VRD(0); float sacc = (P0[0] + P0[1]); \
    AF_GA4(C0 = AF_MF(kf[0], qr[0], zero16), P0[2], P0[3], P0[4], P0[5],       pw0[0] = AF_PKW(P0, 0), pw0[1] = AF_PKW(P0, 2), pw0); \
    AF_VRD(4); AF_GA4(C1 = AF_MF(kf[1], qr[0], zero16), P0[6], P0[7], P0[8], P0[9],       pw0[2] = AF_PKW(P0, 4), pw0[3] = AF_PKW(P0, 6), pw0); \
    AF_VRD(1); AF_GA4(C0 = AF_MF(kf[2], qr[1], C0),     P0[10], P0[11], P0[12], P0[13],   pw1[0] = AF_PKW(P0, 8), pw1[1] = AF_PKW(P0, 10), pw1); \
    AF_VRD(5); AF_GA4(C1 = AF_MF(kf[3], qr[1], C1),     P0[14], P0[15], P1[0], P1[1],     pw1[2] = AF_PKW(P0, 12), pw1[3] = AF_PKW(P0, 14), pw1); \
    AF_VRD(2); AF_GA4(C0 = AF_MF(kf[4], qr[2], C0),     P1[2], P1[3], P1[4], P1[5],       pw2[0] = AF_PKW(P1, 0), pw2[1] = AF_PKW(P1, 2), pw2); \
    AF_VRD(6); AF_GA4(C1 = AF_MF(kf[5], qr[2], C1),     P1[6], P1[7], P1[8], P1[9],       pw2[2] = AF_PKW(P1, 4), pw2[3] = AF_PKW(P1, 6), pw2); \
    AF_VRD(3); AF_GA4(C0 = AF_MF(kf[6], qr[3], C0),     P1[10], P1[11], P1[12], P1[13],   pw3[0] = AF_PKW(P1, 8), pw3[1] = AF_PKW(P1, 10), pw3); \
    AF_VRD(7); AF_GA4(C1 = AF_MF(kf[7], qr[3], C1),     P1[14], P1[15], 0.f, 0.f,         pw3[2] = AF_PKW(P1, 12), pw3[3] = AF_PKW(P1, 14), pw3); \
    l_reg += sacc; \
    if (GK) { AF_DMA_KA((t) + 3, s_cur * KSLOT); } if (GV) { AF_DMA_V((t) + 1, s_next * VSLOT); } } while (0)
#define AF_A4(P, B) do { sacc += P[B]; sacc += P[B + 1]; sacc += P[B + 2]; sacc += P[B + 3]; } while (0)
#define AF_PHASE_A6(C0, C1, P0, P1, t, GK, GV) do { \
    AF_VRD(0); AF_VRD(4); float sacc = (P0[0] + P0[1]); \
    { C0 = AF_MX6(kn0, qn, zero16); sacc += P0[2]; sacc += P0[3]; AF_A4(P0, 4); AF_A4(P0, 8); AF_A4(P0, 12); AF_PIN(sacc); \
      pw0[0] = AF_PKW(P0, 0); pw0[1] = AF_PKW(P0, 2); pw0[2] = AF_PKW(P0, 4); pw0[3] = AF_PKW(P0, 6); AF_PIN(pw0); pw1[0] = AF_PKW(P0, 8); pw1[1] = AF_PKW(P0, 10); pw1[2] = AF_PKW(P0, 12); pw1[3] = AF_PKW(P0, 14); AF_PIN(pw1); AF_SBAR(); } \
    AF_VRD(1); AF_VRD(5); AF_VRD(2); AF_VRD(6); \
    { C1 = AF_MX6(kn1, qn, zero16); AF_A4(P1, 0); AF_A4(P1, 4); AF_A4(P1, 8); AF_A4(P1, 12); AF_PIN(sacc); \
      pw2[0] = AF_PKW(P1, 0); pw2[1] = AF_PKW(P1, 2); pw2[2] = AF_PKW(P1, 4); pw2[3] = AF_PKW(P1, 6); AF_PIN(pw2); pw3[0] = AF_PKW(P1, 8); pw3[1] = AF_PKW(P1, 10); pw3[2] = AF_PKW(P1, 12); pw3[3] = AF_PKW(P1, 14); AF_PIN(pw3); AF_SBAR(); } \
    AF_VRD(3); AF_VRD(7); \
    l_reg += sacc; \
    if (GK) { AF_DMA_KA((t) + 3, s_cur * KSLOT); } if (GV) { AF_DMA_V((t) + 1, s_next * VSLOT); } } while (0)
#define AF_STEP(C0, C1, P0, P1, t, GK, GV, GL) do { AF_SBAR(); \
    const lds_cptr vp_ = vp0 + s_prev * VSLOT; \
    if constexpr (F6) AF_PHASE_A6(C0, C1, P0, P1, t, GK, GV); else if constexpr (DKC == 12) AF_PHASE_A12(C0, C1, P0, P1, t, GK, GV); else AF_PHASE_A8(C0, C1, P0, P1, t, GK, GV); \
    if constexpr (U::HAS_MASK) u.mask(C0, C1, (t), wid, r32, hi); \
    AF_SBAR(); \
    AF_GB(o[0] = AF_MF(AF_PAF(0), AF_VFR(0), o[0]), C0, 0);  AF_KRD(GL, 0); \
    AF_GB(o[1] = AF_MF(AF_PAF(0), AF_VFR(4), o[1]), C0, 4);  AF_KRD(GL, 1); \
    AF_GB(o[0] = AF_MF(AF_PAF(1), AF_VFR(1), o[0]), C0, 8);  AF_KRD(GL, 2); \
    AF_GB(o[1] = AF_MF(AF_PAF(1), AF_VFR(5), o[1]), C0, 12); AF_KRD(GL, 3); \
    AF_GB(o[0] = AF_MF(AF_PAF(2), AF_VFR(2), o[0]), C1, 0);  AF_KRD(GL, 4); \
    AF_GB(o[1] = AF_MF(AF_PAF(2), AF_VFR(6), o[1]), C1, 4);  AF_KRD(GL, 5); \
    AF_GB(o[0] = AF_MF(AF_PAF(3), AF_VFR(3), o[0]), C1, 8); \
    AF_GB(o[1] = AF_MF(AF_PAF(3), AF_VFR(7), o[1]), C1, 12); \
  } while (0)
  int t = 1;
  for (; t + 3 < NT; t += 2) {
    AF_STEP(pB0, pB1, pA0, pA1, t, true, true, true);     AF_WAITN(1, 1); AF_ROT();
    AF_STEP(pA0, pA1, pB0, pB1, t + 1, true, true, true); AF_WAITN(1, 1); AF_ROT();
  }
  AF_STEP(pB0, pB1, pA0, pA1, NT - 3, false, true, true);  AF_WAITN(0, 1); AF_ROT();
  AF_STEP(pA0, pA1, pB0, pB1, NT - 2, false, true, true);  AF_WAIT_BAR(0); AF_ROT();
  AF_STEP(pB0, pB1, pA0, pA1, NT - 1, false, false, false);
  { float sacc = pB0[0] + pB0[1];
#pragma unroll
    for (int r = 2; r < 16; ++r) sacc += pB0[r];
#pragma unroll
    for (int r = 0; r < 16; ++r) sacc += pB1[r];
    l_reg += sacc;
    pw0 = (u32x4){AF_PKW(pB0, 0), AF_PKW(pB0, 2), AF_PKW(pB0, 4), AF_PKW(pB0, 6)}; pw1 = (u32x4){AF_PKW(pB0, 8), AF_PKW(pB0, 10), AF_PKW(pB0, 12), AF_PKW(pB0, 14)};
    pw2 = (u32x4){AF_PKW(pB1, 0), AF_PKW(pB1, 2), AF_PKW(pB1, 4), AF_PKW(pB1, 6)}; pw3 = (u32x4){AF_PKW(pB1, 8), AF_PKW(pB1, 10), AF_PKW(pB1, 12), AF_PKW(pB1, 14)};
    AF_SBAR();
    const lds_cptr vp_ = vp0 + s_cur * VSLOT;
#pragma unroll
    for (int i = 0; i < 8; ++i) { vlo[i] = vtr(vp_ + ((i >> 2) * 4096 + (i & 3) * 1024)); vhi[i] = vtr(vp_ + ((i >> 2) * 4096 + (i & 3) * 1024 + 512)); }
    o[0] = AF_MF(AF_PAF(0), AF_VFR(0), o[0]); o[1] = AF_MF(AF_PAF(0), AF_VFR(4), o[1]);
    o[0] = AF_MF(AF_PAF(1), AF_VFR(1), o[0]); o[1] = AF_MF(AF_PAF(1), AF_VFR(5), o[1]);
    o[0] = AF_MF(AF_PAF(2), AF_VFR(2), o[0]); o[1] = AF_MF(AF_PAF(2), AF_VFR(6), o[1]);
    o[0] = AF_MF(AF_PAF(3), AF_VFR(3), o[0]); o[1] = AF_MF(AF_PAF(3), AF_VFR(7), o[1]); }
  { auto rr = __builtin_amdgcn_permlane32_swap(__float_as_uint(l_reg), __float_as_uint(l_reg), false, false); l_reg = __uint_as_float(rr[0]) + __uint_as_float(rr[1]); }
  l_reg += __builtin_amdgcn_exp2f(u.sink(wid));
  if (hi == 0) wsf[32 + r32] = l_reg; asm volatile("s_waitcnt lgkmcnt(0)" ::: "memory");
  float rli[16];
#pragma unroll
  for (int r = 0; r < 16; ++r) rli[r] = __builtin_amdgcn_rcpf(wsf[32 + crow(r, hi)]);
  bf16* Ow = u.orow0(wid);
  { bf16* stg = (bf16*)(shm + LDS_OST) + wid * 2048;
#pragma unroll
    for (int r = 0; r < 16; ++r) { const int orow = crow(r, hi);
#pragma unroll
      for (int d0 = 0; d0 < 2; ++d0) stg[orow * 64 + d0 * 32 + r32] = (bf16)(cvtpk_s(o[d0][r] * rli[r], 0.f) & 0xffffu); }
    asm volatile("s_waitcnt lgkmcnt(0)" ::: "memory");
#pragma unroll
    for (int i = 0; i < 4; ++i) { const int row = i * 8 + (lane >> 3), ch = lane & 7; const u32x4 v = *(const u32x4*)(stg + row * 64 + ch * 8); *(u32x4*)(Ow + (long)row * 1024 + ch * 8) = v; } }
  asm volatile("s_waitcnt lgkmcnt(0)\n\ts_barrier" ::: "memory");
#undef AF_DMA_KA
#undef AF_DMA_KB
#undef AF_DMA_K
#undef AF_DMA_V
#undef AF_WAITN
#undef AF_ROT
#undef AF_PKW
#undef AF_PAF
#undef AF_VFR
#undef AF_PIN
#undef AF_MF
#undef AF_EX
#undef AF_VRD
#undef AF_GA4
#undef AF_GA3
#undef AF_GA2
#undef AF_GB
#undef AF_KRD
#undef AF_PHASE_A12
#undef AF_PHASE_A8
#undef AF_PHASE_A6
#undef AF_A4
#undef AF_MX6
#undef AF_STEP
}

constexpr int ROWS_LAT = 16384;
constexpr float LOG2E_ = 1.4426950408889634f;
__device__ __forceinline__ int clampi(int v, int lo, int hi_) { return v < lo ? lo : (v > hi_ ? hi_ : v); }
struct FDense {
  static constexpr bool HAS_MASK = false;
  const bf16* Q; const bf16* kbase; const bf16* vbase; const bf16* krbase; bf16* O; int b, h, qb; static constexpr int kpitch = 2048, vpitch = 2048; const char* k6base = nullptr;
  __device__ __forceinline__ void init(const bf16* Q_, const bf16* KV, const bf16* KR, bf16* O_, int b_, int h_, int qb_) { Q = Q_; kbase = KV + 64 * h_; vbase = KV + 1024 + 64 * h_; krbase = KR; O = O_; b = b_; h = h_; qb = qb_; }
  __device__ __forceinline__ int nt() const { return 132; }
  __device__ __forceinline__ long trow(int t) const { return t < 4 ? (long)(ROWS_LAT + 256 * b + 64 * t) : (long)(8192 * b + 64 * (t - 4)); }
  __device__ __forceinline__ const bf16* qptr(int wid, int r32, int d0, int hi) const { const bf16* qp = Q + (long)(8192 * b + 256 * qb + 32 * wid + r32) * 1536;
    return d0 < 4 ? qp + 64 * h + 16 * d0 + 8 * hi : qp + 1024 + 32 * h + 16 * (d0 - 4) + 8 * hi; }
  __device__ __forceinline__ void mask(f32x16&, f32x16&, int, int, int, int) const {}
  __device__ __forceinline__ float sink(int) const { return -INFINITY; }
  __device__ __forceinline__ bf16* orow0(int wid) const { return O + (long)(8192 * b + 256 * qb + 32 * wid) * 1024 + 64 * h; }
};
struct FWin {
  static constexpr bool HAS_MASK = true; static constexpr int kpitch = 2304, vpitch = 2304;
  const bf16* QKV; const bf16* kbase; const bf16* vbase; const bf16* krbase; bf16* O; const float* sinkp; int b, n, g, hh, i0, cnt; const char* k6base;
  __device__ __forceinline__ void init(const bf16* QKV_, bf16* O_, const float* sk, int b_, int n_, int g_, int hh_, const char* K6E = nullptr) { QKV = QKV_; O = O_; sinkp = sk; b = b_; n = n_; g = g_; hh = hh_; krbase = nullptr; k6base = K6E + g_ * 3072;
    kbase = QKV_ + 512 + 64 * g_; vbase = QKV_ + 640 + 64 * g_; i0 = (n_ == 0) ? 2 : 0; cnt = (n_ == 0 || n_ == 63) ? 4 : 6; }
  __device__ __forceinline__ int nt() const { return 4 + cnt; }
  __device__ __forceinline__ int kpos0(int t) const { return 128 * (n - 1) + 64 * (i0 + t - 4); }
  __device__ __forceinline__ long trow(int t) const { return t < 4 ? (long)(ROWS_LAT + 256 * b + 64 * t) : (long)(8192 * b + kpos0(t)); }
  __device__ __forceinline__ int head(int wid) const { return 4 * g + 2 * hh + (wid >> 2); }
  __device__ __forceinline__ int qpos0(int wid) const { return 128 * n + 32 * (wid & 3); }
  __device__ __forceinline__ const bf16* qptr(int wid, int r32, int d0, int hi) const { return QKV + (long)(8192 * b + qpos0(wid) + r32) * 2304 + 64 * head(wid) + 16 * d0 + 8 * hi; }
  __device__ __forceinline__ void mask(f32x16& p0, f32x16& p1, int t, int wid, int r32, int hi) const {
    if (t < 4) return;
    const int k0 = kpos0(t), q0 = qpos0(wid);
    if (k0 - (q0 + 31) >= -128 && k0 + 63 - q0 <= 128) return;
    asm volatile("" : "+v"(r32), "+v"(hi));
    const int dq = k0 - (q0 + r32);
#pragma unroll
    for (int r = 0; r < 16; ++r) { const int d = dq + crow(r, hi); if (d > 128 || d < -128) p0[r] = -INFINITY; if (d + 32 > 128 || d + 32 < -128) p1[r] = -INFINITY; }
  }
  __device__ __forceinline__ float sink(int wid) const { return sinkp[head(wid)] * LOG2E_; }
  __device__ __forceinline__ bf16* orow0(int wid) const { return O + (long)(8192 * b + qpos0(wid)) * 1024 + 64 * head(wid); }
};
struct FNa {
  static constexpr bool HAS_MASK = true; static constexpr int kpitch = 2304, vpitch = 2304;
  const bf16* QKV; const bf16* kbase; const bf16* vbase; const bf16* krbase; bf16* O; const float* rpbl; int b, h, R4, krlo, nloc; const char* k6base;
  __device__ __forceinline__ void init(const bf16* QKV_, bf16* O_, const float* rpbl_, int b_, int h_, int R4_, const char* K6E = nullptr) { QKV = QKV_; O = O_; rpbl = rpbl_; b = b_; h = h_; R4 = R4_; krbase = nullptr; k6base = K6E + (2 + h_) * 3072;
    kbase = QKV_ + 1280 + 64 * h_; vbase = QKV_ + 1792 + 64 * h_; krlo = clampi(4 * R4_ - 4, 0, 120); nloc = clampi(4 * R4_ - 1, 0, 120) + 7 - krlo + 1; }
  __device__ __forceinline__ int nt() const { return (4 + nloc + 1) & ~1; }
  __device__ __forceinline__ long trow(int t) const { return (t < 4 || t >= 4 + nloc) ? (long)(ROWS_LAT + 256 * b + 64 * (t & 3)) : (long)(8192 * b + 64 * (krlo + t - 4)); }
  __device__ __forceinline__ int qrow(int wid) const { return 4 * R4 + (wid >> 1); }
  __device__ __forceinline__ const bf16* qptr(int wid, int r32, int d0, int hi) const { return QKV + (long)(8192 * b + 64 * qrow(wid) + 32 * (wid & 1) + r32) * 2304 + 768 + 64 * h + 16 * d0 + 8 * hi; }
  __device__ __forceinline__ void mask(f32x16& p0, f32x16& p1, int t, int wid, int r32, int hi) const {
    if (t < 4) return;
    const int kr = krlo + t - 4, w0 = clampi(qrow(wid) - 4, 0, 120);
    if (t >= 4 + nloc || kr < w0 || kr > w0 + 7) {
#pragma unroll
      for (int r = 0; r < 16; ++r) { p0[r] = -INFINITY; p1[r] = -INFINITY; }
      return; }
    asm volatile("" : "+v"(r32), "+v"(hi));
    const int qc = 32 * (wid & 1) + r32, c0 = clampi(qc - 8, 0, 48);
    const float* pb = rpbl + (kr - qrow(wid) + 7) * 31 + 15 - qc + 4 * hi;
    const unsigned t0 = (unsigned)(4 * hi - c0);
#define AF_PIN16(a) asm volatile("" : "+v"(a[0]), "+v"(a[1]), "+v"(a[2]), "+v"(a[3]), "+v"(a[4]), "+v"(a[5]), "+v"(a[6]), "+v"(a[7]), "+v"(a[8]), "+v"(a[9]), "+v"(a[10]), "+v"(a[11]), "+v"(a[12]), "+v"(a[13]), "+v"(a[14]), "+v"(a[15]))
    float bv[16];
#pragma unroll
    for (int r = 0; r < 16; ++r) bv[r] = pb[(r & 3) + 8 * (r >> 2)];
    AF_PIN16(bv);
#pragma unroll
    for (int r = 0; r < 16; ++r) { const bool ok = (t0 + (unsigned)((r & 3) + 8 * (r >> 2))) < 16u; p0[r] = ok ? p0[r] + bv[r] : -INFINITY; }
#pragma unroll
    for (int r = 0; r < 16; ++r) bv[r] = pb[32 + (r & 3) + 8 * (r >> 2)];
    AF_PIN16(bv);
#pragma unroll
    for (int r = 0; r < 16; ++r) { const bool ok = (t0 + (unsigned)(32 + (r & 3) + 8 * (r >> 2))) < 16u; p1[r] = ok ? p1[r] + bv[r] : -INFINITY; }
#undef AF_PIN16
  }
  __device__ __forceinline__ float sink(int) const { return -INFINITY; }
  __device__ __forceinline__ bf16* orow0(int wid) const { return O + (long)(8192 * b + 64 * qrow(wid) + 32 * (wid & 1)) * 1024 + 512 + 64 * h; }
};
struct FCtx {
  static constexpr bool HAS_MASK = false; static constexpr int kpitch = 2304, vpitch = 2304;
  const bf16* QKV; const bf16* kbase; const bf16* vbase; const bf16* krbase; bf16* O; const float* sinkp; int b, hx, qcol, ocol; const char* k6base;
  __device__ __forceinline__ void init(const bf16* QKV_, bf16* O_, const float* sk, int b_, int hx_, const char* K6E = nullptr) { QKV = QKV_; O = O_; sinkp = sk; b = b_; hx = hx_; krbase = nullptr; k6base = K6E + (hx_ < 8 ? (hx_ >> 2) : 2 + (hx_ - 8)) * 3072;
    if (hx_ < 8) { qcol = 64 * hx_; kbase = QKV_ + 512 + 64 * (hx_ >> 2); vbase = QKV_ + 640 + 64 * (hx_ >> 2); ocol = 64 * hx_; }
    else { const int h = hx_ - 8; qcol = 768 + 64 * h; kbase = QKV_ + 1280 + 64 * h; vbase = QKV_ + 1792 + 64 * h; ocol = 512 + 64 * h; } }
  __device__ __forceinline__ int nt() const { return 4; }
  __device__ __forceinline__ long trow(int t) const { return (long)(ROWS_LAT + 256 * b + 64 * (t & 3)); }
  __device__ __forceinline__ const bf16* qptr(int wid, int r32, int d0, int hi) const { return QKV + (long)(ROWS_LAT + 256 * b + 32 * wid + r32) * 2304 + qcol + 16 * d0 + 8 * hi; }
  __device__ __forceinline__ void mask(f32x16&, f32x16&, int, int, int, int) const {}
  __device__ __forceinline__ float sink(int) const { return hx < 8 ? sinkp[hx] * LOG2E_ : -INFINITY; }
  __device__ __forceinline__ bf16* orow0(int wid) const { return O + (long)(ROWS_LAT + 256 * b + 32 * wid) * 1024 + ocol; }
};
#undef AF_SBAR
#undef AF_WAIT_BAR
}
constexpr int NWAVES = 8;
#ifndef MK_PER_PHASE
#define MK_PER_PHASE 0
#endif
constexpr int BATCH = 2, SEQ = 8192, DM = 1024, CTXL = 256, FF = 4096;
constexpr int ML = BATCH * SEQ, MC = BATCH * CTXL, MR = ML + MC;
constexpr int NQKV = 2304, NCIN = 768, NUQ = 1536, NUKV = 2048;
constexpr float NORM_EPS = 1e-6f;
constexpr int ADA_KS = 16;
constexpr size_t MiB = 1u << 20;
constexpr size_t WS_CTL = 0, CTL_ZERO_BYTES = 64 * 1024;
constexpr size_t WS_MODP = 1 * MiB;
constexpr size_t WS_MOD = 3 * MiB + 512 * 1024;
constexpr size_t WS_ROPE = 3 * MiB + 768 * 1024;
constexpr size_t WS_ROPEP = WS_ROPE + 64 * 1024;
constexpr size_t WS_HPAR = WS_ROPE + 32 * 1024;
constexpr size_t WS_CTXRES = 4 * MiB;
constexpr size_t WS_WQKV = 6 * MiB, WS_WO0 = WS_WQKV + 4608 * 1024, WS_W1_0 = WS_WO0 + 2 * MiB, WS_W2_0 = WS_W1_0 + 8 * MiB, WS_W1_1 = WS_W2_0 + 8 * MiB, WS_W2_1 = WS_W1_1 + 8 * MiB;
constexpr size_t WS_WIN = WS_W2_1 + 8 * MiB, WS_WUQ = WS_WIN + 1536 * 1024, WS_WUKV = WS_WUQ + 1152 * 1024, WS_WO1 = WS_WUKV + 1 * MiB, WS_WEND = WS_WO1 + 2 * MiB;
constexpr size_t WS_AR = 51 * MiB;
static_assert(WS_WEND <= WS_AR, "weights overlap the arena");
constexpr size_t WS_XN = WS_AR, WS_H = WS_AR + 33 * MiB;
constexpr size_t WS_QKV = WS_AR + 33 * MiB, WS_O0 = WS_AR + 108 * MiB;
constexpr size_t WS_CQKV = WS_AR + 33 * MiB, WS_CQN = WS_AR + 58 * MiB, WS_CKVN = WS_AR + 71 * MiB, WS_KR = WS_AR + 80 * MiB, WS_Q1 = WS_AR + 82 * MiB, WS_KV1 = WS_AR + 130 * MiB, WS_O1 = WS_AR;
constexpr size_t WS_K6E = WS_AR + 150 * MiB;
constexpr size_t WS_K6N = WS_AR + 34 * MiB, WS_K6R = WS_AR + 48 * MiB;
constexpr size_t WS_PART5 = WS_AR + 33 * MiB;
constexpr size_t WS_XR = WS_AR + 166 * MiB;
constexpr size_t WS_PART8 = WS_AR + 166 * MiB;
constexpr size_t WS_END = 256 * MiB;
static_assert(WS_PART8 + (size_t)16 * 512 * 1024 * 4 <= WS_END && WS_KV1 + (size_t)MR * NUKV * 2 <= WS_END && WS_H + (size_t)MR * FF * 2 <= WS_END, "d_ws map");
constexpr int CW_BAR = 4096;
constexpr int RING_OFF = 0, RING_BYTES = 131072;
constexpr int LDSCTL_OFF = RING_BYTES, MISC_OFF = LDSCTL_OFF + 320;
constexpr int LDS_BYTES = 147456;
static_assert(att::L_END <= RING_BYTES && attf::LDS_BYTES <= RING_BYTES, "attention LDS");

#define GAS __attribute__((address_space(1)))
#define LAS __attribute__((address_space(3)))
typedef unsigned short bf16;
typedef unsigned v4u __attribute__((ext_vector_type(4)));
typedef unsigned v2u __attribute__((ext_vector_type(2)));
typedef float f32x4 __attribute__((ext_vector_type(4)));
typedef GAS unsigned gu32;
#define RLX_AGENT __ATOMIC_RELAXED, __HIP_MEMORY_SCOPE_AGENT
#define LDS_WAIT() asm volatile("s_waitcnt lgkmcnt(0)" ::: "memory")
#define VM_WAIT() asm volatile("s_waitcnt vmcnt(0)" ::: "memory")
__device__ __forceinline__ unsigned f2bf(float f) { unsigned u = __builtin_bit_cast(unsigned, f); return (u + 0x7fffu + ((u >> 16) & 1u)) >> 16; }
__device__ __forceinline__ unsigned pk2(float lo, float hi) { return f2bf(lo) | (f2bf(hi) << 16); }
__device__ __forceinline__ float bf2f(unsigned short h) { return __builtin_bit_cast(float, (unsigned)h << 16); }
__device__ __forceinline__ float bflo(unsigned w) { return __builtin_bit_cast(float, w << 16); }
__device__ __forceinline__ float bfhi(unsigned w) { return __builtin_bit_cast(float, w & 0xffff0000u); }

#define XB_TMO      128
#define XB_XCNT(j)  (256  + 64 * (j))
#define XB_XSUB(j)  (1280 + 64 * (j))
#define XB_XGEN(j)  (2304 + 64 * (j))
#define XB_TOP      3328
#define XB_TOPGEN   3392
#define XCD_BAR_WORDS 3456
#define XB_SPIN_CAP (1u << 18)

__device__ __forceinline__ unsigned xb_ld(unsigned* p)              { return __hip_atomic_load(p, __ATOMIC_RELAXED, __HIP_MEMORY_SCOPE_AGENT); }
__device__ __forceinline__ unsigned xb_add(unsigned* p, unsigned v) { return __hip_atomic_fetch_add(p, v, __ATOMIC_RELAXED, __HIP_MEMORY_SCOPE_AGENT); }
__device__ __forceinline__ unsigned xb_xcc_id() { return (unsigned)__builtin_amdgcn_s_getreg((3 << 11) | 20) & 0xFu; }
#define XB_SPIN(cond, bar) do { unsigned _sp = 0; while (cond) { __builtin_amdgcn_s_sleep(1); \
    if ((++_sp & 255u) == 0u) { if (xb_ld(&(bar)[XB_TMO])) break; if (_sp > XB_SPIN_CAP) { atomicAdd(&(bar)[XB_TMO], 1u); break; } } } } while (0)

struct XcdBarrier {
    unsigned* bar; unsigned x;
    volatile LAS unsigned* st;
};

__device__ __forceinline__ XcdBarrier xcd_barrier_post(unsigned* bar, volatile LAS unsigned* st) {
    XcdBarrier b; b.bar = bar; b.x = xb_xcc_id(); b.st = st;
    if (threadIdx.x == 0) (void)xb_add(&bar[XB_XCNT(b.x)], 1u);
    return b;
}
__device__ __forceinline__ void xcd_barrier_complete(unsigned* bar, unsigned x, unsigned& nloc, unsigned& nx) {
    const unsigned G = gridDim.x * gridDim.y * gridDim.z;
    unsigned sum, cnt, mine, sp = 0u;
    for (;;) {
        sum = 0u; cnt = 0u; mine = 0u;
#pragma unroll
        for (unsigned j = 0; j < 16; ++j) { const unsigned c = xb_ld(&bar[XB_XCNT(j)]); sum += c; cnt += (c > 0u) ? 1u : 0u; mine = (j == x) ? c : mine; }
        if (sum == G) break;
        __builtin_amdgcn_s_sleep(1);
        if ((++sp & 255u) == 0u) { if (xb_ld(&bar[XB_TMO])) break; if (sp > XB_SPIN_CAP) { atomicAdd(&bar[XB_TMO], 1u); break; } }
    }
    nloc = mine > 0u ? mine : 1u; nx = cnt > 0u ? cnt : 1u;
}

__device__ __forceinline__ void xcd_barrier(const XcdBarrier& b) {
    asm volatile("s_waitcnt vmcnt(0)" ::: "memory");
    __syncthreads();
    if (threadIdx.x == 0) {
        unsigned* bar = b.bar;
        __builtin_amdgcn_s_waitcnt(0);
        unsigned nloc = b.st[0], nx = b.st[1];
        if (nloc == 0u) { xcd_barrier_complete(bar, b.x, nloc, nx); b.st[0] = nloc; b.st[1] = nx; }
        const unsigned old = xb_add(&bar[XB_XSUB(b.x)], 1u);
        const unsigned gen = old / nloc;
        if (old + 1u == (gen + 1u) * nloc) {
            __builtin_amdgcn_fence(__ATOMIC_RELEASE, "agent");
            asm volatile("s_waitcnt vmcnt(0)" ::: "memory");
            const unsigned og = xb_add(&bar[XB_TOP], 1u);
            const unsigned tg = og / nx;
            if (og + 1u == (tg + 1u) * nx) xb_add(&bar[XB_TOPGEN], 1u);
            else XB_SPIN(xb_ld(&bar[XB_TOPGEN]) == tg, bar);
            __builtin_amdgcn_fence(__ATOMIC_ACQUIRE, "agent");
            xb_add(&bar[XB_XGEN(b.x)], 1u);
            asm volatile("s_waitcnt vmcnt(0)" ::: "memory");
        } else {
            XB_SPIN(xb_ld(&bar[XB_XGEN(b.x)]) == gen, bar);
            __builtin_amdgcn_fence(__ATOMIC_ACQUIRE, "agent");
            asm volatile("s_waitcnt vmcnt(0)" ::: "memory");
        }
    }
    __syncthreads();
}


template <int K> __device__ __forceinline__ const float* ldarg() {
    auto ka = __builtin_amdgcn_kernarg_segment_ptr();
    const __attribute__((address_space(1))) float* p; asm volatile("s_load_dwordx2 %0, %1, %2\n\ts_waitcnt lgkmcnt(0)" : "=s"(p) : "s"(ka), "i"(K * 8) : "memory"); return (const float*)p;
}
#define ARG(k) (ldarg<k>())
#define ARG_OUT ((float*)ldarg<28>())
#define ARG_WS ((unsigned char*)ldarg<29>())
struct Frame {
    LAS unsigned char* lds;
    volatile LAS unsigned* MISC;
    gu32* ctl;
    int tid, lane, wave;
    int vcu, G, bx;
    float* out; unsigned char* ws;
};
__device__ __forceinline__ float shx(float v, int mask, int lane) { return __builtin_bit_cast(float, __builtin_amdgcn_ds_bpermute((lane ^ mask) << 2, __builtin_bit_cast(int, v))); }
__device__ __forceinline__ float wave_sum(float v, int lane) {
    (void)lane;
#define WS_ROR(x, n) __builtin_bit_cast(float, __builtin_amdgcn_update_dpp(0, __builtin_bit_cast(int, x), 0x120 | (n), 0xf, 0xf, false))
    v += WS_ROR(v, 8); v += WS_ROR(v, 4); v += WS_ROR(v, 2); v += WS_ROR(v, 1);
#undef WS_ROR
    const int b = __builtin_bit_cast(int, v);
    return (__builtin_bit_cast(float, __builtin_amdgcn_readlane(b, 0)) + __builtin_bit_cast(float, __builtin_amdgcn_readlane(b, 16))) + (__builtin_bit_cast(float, __builtin_amdgcn_readlane(b, 32)) + __builtin_bit_cast(float, __builtin_amdgcn_readlane(b, 48)));
}
__device__ __forceinline__ unsigned pk4f8(float a, float b, float c, float d) { int w = 0; w = __builtin_amdgcn_cvt_pk_fp8_f32(a, b, w, false); w = __builtin_amdgcn_cvt_pk_fp8_f32(c, d, w, true); return (unsigned)w; }
__device__ __forceinline__ void p0_transpose_item(const float* W, int K, int N, bf16* WT, int pmode, LAS float* scr, int item, int lane, bool f8 = false) {
    const int nblk = N / 32, kb = item / nblk, nb = item % nblk, k0 = 64 * kb, n0 = 32 * nb;
    int r0 = n0;
    if (pmode == 1) { const int h = n0 / 96, d = n0 % 96; r0 = d < 64 ? h * 64 + d : 1024 + h * 32 + (d - 64); }
    else if (pmode == 2) { const int h = n0 / 128, d = n0 % 128; r0 = d < 64 ? h * 64 + d : 1024 + h * 64 + (d - 64); }
#pragma unroll 8
    for (int i = 0; i < 32; ++i) { const int kk = 2 * i + (lane >> 5); scr[kk * 33 + (lane & 31)] = W[(size_t)(k0 + kk) * N + n0 + (lane & 31)]; }
    LDS_WAIT(); asm volatile("" ::: "memory");
    const int c = lane & 7;
#pragma unroll
    for (int j = 0; j < 4; ++j) { const int n = (lane >> 3) + 8 * j; const LAS float* s = scr + (8 * c) * 33 + n;
        if (f8) {
            v2u o; o.x = pk4f8(s[0 * 33] * 32.f, s[1 * 33] * 32.f, s[2 * 33] * 32.f, s[3 * 33] * 32.f); o.y = pk4f8(s[4 * 33] * 32.f, s[5 * 33] * 32.f, s[6 * 33] * 32.f, s[7 * 33] * 32.f);
            *(GAS v2u*)((unsigned char*)WT + (size_t)(r0 + n) * K + k0 + 8 * c) = o; continue; }
        v4u o; o.x = pk2(s[0 * 33], s[1 * 33]); o.y = pk2(s[2 * 33], s[3 * 33]); o.z = pk2(s[4 * 33], s[5 * 33]); o.w = pk2(s[6 * 33], s[7 * 33]);
        *(GAS v4u*)(WT + (size_t)(r0 + n) * K + k0 + 8 * c) = o; }
    LDS_WAIT(); asm volatile("" ::: "memory");
}
__device__ __forceinline__ float silu_f(float v) { return v / (1.f + __expf(-v)); }

__device__ __forceinline__ void p0_prologue(Frame& F) {
    LAS float* scr = (LAS float*)(F.lds + RING_OFF + F.wave * 16384);
    const float* c = ARG(1); const float* cctx = ARG(3);
    if (F.wave >= 5) {
        for (int it = F.vcu * 3 + (F.wave - 5); it < 2 * 24 * ADA_KS; it += F.G * 3) {
            const int l = it / (24 * ADA_KS), rem = it % (24 * ADA_KS), cg = rem / ADA_KS, ks = rem % ADA_KS;
            const float* W = ARG(4) + (size_t)l * DM * 6144 + cg * 256 + 4 * F.lane;
            f32x4 a0 = {0.f, 0.f, 0.f, 0.f}, a1 = a0, a2 = a0;
            const int kbeg = ks * (DM / ADA_KS);
#pragma unroll 8
            for (int k = kbeg; k < kbeg + DM / ADA_KS; ++k) {
                const f32x4 w = *(const GAS f32x4*)(W + (size_t)k * 6144);
                const float s0 = silu_f(c[k]), s1 = silu_f(c[DM + k]), s2 = silu_f(cctx[k]);
                a0 += w * s0; a1 += w * s1; a2 += w * s2;
            }
            float* P = (float*)(F.ws + WS_MODP) + ((size_t)(ks * 2 + l) * 3) * 6144 + cg * 256 + 4 * F.lane;
            *(GAS f32x4*)(P) = a0; *(GAS f32x4*)(P + 6144) = a1; *(GAS f32x4*)(P + 2 * 6144) = a2;
        }
    } else {
        const int gw = F.vcu * 5 + F.wave, NGW = F.G * 5;
        constexpr int I_QKV = 16 * 72, I_O = 16 * 32, I_1 = 16 * 128, I_2 = 64 * 32, I_IN = 16 * 21, I_UQ = 6 * 48, I_UKV = 4 * 64;
        constexpr int NITEMS = I_QKV + I_O + 2 * I_1 + 2 * I_2 + I_IN + I_UQ + I_UKV + I_O;
        for (int it = gw; it < NITEMS; it += NGW) {
            int r = it;
            if (r < I_QKV) { p0_transpose_item(ARG(10), DM, NQKV, (bf16*)(F.ws + WS_WQKV), 0, scr, r, F.lane, true); continue; } r -= I_QKV;
            if (r < I_O) { p0_transpose_item(ARG(11), DM, DM, (bf16*)(F.ws + WS_WO0), 0, scr, r, F.lane); continue; } r -= I_O;
            if (r < I_1) { p0_transpose_item(ARG(8), DM, FF, (bf16*)(F.ws + WS_W1_0), 0, scr, r, F.lane); continue; } r -= I_1;
            if (r < I_1) { p0_transpose_item(ARG(8) + (size_t)DM * FF, DM, FF, (bf16*)(F.ws + WS_W1_1), 0, scr, r, F.lane); continue; } r -= I_1;
            if (r < I_2) { p0_transpose_item(ARG(9), FF, DM, (bf16*)(F.ws + WS_W2_0), 0, scr, r, F.lane); continue; } r -= I_2;
            if (r < I_2) { p0_transpose_item(ARG(9) + (size_t)DM * FF, FF, DM, (bf16*)(F.ws + WS_W2_1), 0, scr, r, F.lane); continue; } r -= I_2;
            if (r < I_IN) { p0_transpose_item(ARG(18), DM, 672, (bf16*)(F.ws + WS_WIN), 0, scr, r, F.lane); continue; } r -= I_IN;
            if (r < I_UQ) { p0_transpose_item(ARG(21), 384, NUQ, (bf16*)(F.ws + WS_WUQ), 1, scr, r, F.lane); continue; } r -= I_UQ;
            if (r < I_UKV) { p0_transpose_item(ARG(22), 256, NUKV, (bf16*)(F.ws + WS_WUKV), 2, scr, r, F.lane); continue; } r -= I_UKV;
            p0_transpose_item(ARG(27), DM, DM, (bf16*)(F.ws + WS_WO1), 0, scr, r, F.lane);
        }
    }
    if (F.bx == 1 % F.G) {
        float* rt = (float*)(F.ws + WS_ROPE);
        for (int e = F.tid; e < 128 * 16; e += NWAVES * 64) { const int pos = e >> 4, i = e & 15; const float inv = exp2f(-(float)i * (13.287712379549449f / 16.f));
            float x = (float)pos * inv * 0.15915494309189535f; x -= rintf(x); const float c_ = __builtin_amdgcn_cosf(x), s_ = __builtin_amdgcn_sinf(x); rt[e] = c_; rt[2048 + e] = s_; ((unsigned*)(F.ws + WS_ROPEP))[e] = pk2(c_, s_); }
        for (int e = F.tid; e < 128 * 8; e += NWAVES * 64) { const int pos = e >> 3, i = e & 7; const float inv = exp2f(-(float)i * (13.287712379549449f / 8.f));
            float x = (float)pos * inv * 0.15915494309189535f; x -= rintf(x); const float c_ = __builtin_amdgcn_cosf(x), s_ = __builtin_amdgcn_sinf(x); rt[4096 + e] = c_; rt[5120 + e] = s_; ((unsigned*)(F.ws + WS_ROPEP))[2048 + e] = pk2(c_, s_); }
    }
    if (F.bx == 3 % F.G && F.wave == NWAVES - 1) {
        float* hp = (float*)(F.ws + WS_HPAR); const int i = F.lane;
        hp[i] = ARG(12)[i]; hp[64 + i] = ARG(13)[i]; hp[128 + i] = ARG(15)[i]; hp[192 + i] = ARG(16)[i]; hp[256 + i] = ARG(23)[i]; hp[320 + i] = ARG(24)[i & 31]; hp[384 + i] = ARG(25)[i];
        float a = fabsf(ARG(23)[i]), b_ = fabsf(ARG(25)[i]), c_ = fabsf(ARG(24)[i & 31]), d_ = fabsf(ARG(26)[i & 31]);
#pragma unroll
        for (int o_ = 1; o_ < 64; o_ <<= 1) { a = fmaxf(a, shx(a, o_, i)); b_ = fmaxf(b_, shx(b_, o_, i)); c_ = fmaxf(c_, shx(c_, o_, i)); d_ = fmaxf(d_, shx(d_, o_, i)); }
        const float bound = (64.f * a * b_ + 32.f * c_ * d_) * (0.10206207261596575f * 1.4426950408889634f);
        if (i == 0) hp[448] = (bound < 64.f && fmaxf(fmaxf(a, b_), fmaxf(c_, d_)) < 3.f) ? 1.f : 0.f;
        { float a2 = fabsf(ARG(12)[i]), b2 = fabsf(ARG(13)[i]), c2 = fabsf(ARG(15)[i]), d2 = fabsf(ARG(16)[i]), e2 = 0.f, f2 = fabsf(ARG(14)[i & 7]);
          const float* rpbp = ARG(17);
          float e3 = 0.f, e4 = 0.f, e5 = 0.f;
          for (int j = i; j < 8 * 465; j += 256) { e2 = fmaxf(e2, fabsf(rpbp[j])); if (j + 64 < 8 * 465) e3 = fmaxf(e3, fabsf(rpbp[j + 64])); if (j + 128 < 8 * 465) e4 = fmaxf(e4, fabsf(rpbp[j + 128])); if (j + 192 < 8 * 465) e5 = fmaxf(e5, fabsf(rpbp[j + 192])); }
          e2 = fmaxf(fmaxf(e2, e3), fmaxf(e4, e5));
#pragma unroll
          for (int o_ = 1; o_ < 64; o_ <<= 1) { a2 = fmaxf(a2, shx(a2, o_, i)); b2 = fmaxf(b2, shx(b2, o_, i)); c2 = fmaxf(c2, shx(c2, o_, i)); d2 = fmaxf(d2, shx(d2, o_, i)); e2 = fmaxf(e2, shx(e2, o_, i)); f2 = fmaxf(f2, shx(f2, o_, i)); }
          const float bound0 = fmaxf(fmaxf(8.f * a2 * b2, 8.f * c2 * d2 + e2), f2) * 1.4426950408889634f;
          if (i == 0) hp[449] = (bound0 < 64.f && fmaxf(fmaxf(a2, b2), fmaxf(c2, d2)) < 3.f) ? 1.f : 0.f; }
    }
    if (F.bx == 2 % F.G) {
        GAS v4u* z = (GAS v4u*)((bf16*)(F.ws + WS_WIN) + (size_t)672 * DM);
        unsigned zz = 0u; asm volatile("" : "+v"(zz));
        for (int e = F.tid; e < 96 * DM / 8; e += NWAVES * 64) z[e] = (v4u){zz, zz, zz, zz};
    }
}

__device__ __forceinline__ void norm_phase(Frame& F, const float* src_lat, const float* src_ctx, int nrows, const float* gw_, int layer, int which  , bool from_partials, const float* parts = nullptr, int nparts = 0, bool lat_bf16 = false, bool xn_fp8 = false) {
    LAS float* gl = (LAS float*)(F.lds + RING_OFF); LAS float* scl = gl + 1024; LAS float* shl = scl + 3 * 1024;
    const float* modp = (const float*)(F.ws + WS_MODP); const float* mod = (const float*)(F.ws + WS_MOD); const float* ada_b = ARG(5);
    const int offsh = which * 3072, offsc = which * 3072 + 1024;
    for (int i = F.tid; i < 1024; i += NWAVES * 64) {
        gl[i] = gw_[i];
#pragma unroll
        for (int cnd = 0; cnd < 3; ++cnd) {
            float sh, sc;
            if (from_partials) { sh = ada_b[layer * 6144 + offsh + i]; sc = ada_b[layer * 6144 + offsc + i];
                float ph[ADA_KS], pc[ADA_KS];
#pragma unroll
                for (int ks = 0; ks < ADA_KS; ++ks) { const float* p = modp + ((size_t)(ks * 2 + layer) * 3 + cnd) * 6144; ph[ks] = p[offsh + i]; pc[ks] = p[offsc + i]; }
#pragma unroll
                for (int ks = 0; ks < ADA_KS; ++ks) { sh += ph[ks]; sc += pc[ks]; } }
            else { sh = mod[(layer * 3 + cnd) * 6144 + offsh + i]; sc = mod[(layer * 3 + cnd) * 6144 + offsc + i]; }
            scl[cnd * 1024 + i] = 1.f + sc; shl[cnd * 1024 + i] = sh;
        }
    }
    if (from_partials) {
        float* modw = (float*)(F.ws + WS_MOD);
        for (int e = F.vcu * (NWAVES * 64) + F.tid; e < 2 * 3 * 6144; e += F.G * NWAVES * 64) {
            const int l = e / (3 * 6144), rem = e % (3 * 6144), cnd = rem / 6144, col = rem % 6144;
            float v = ada_b[l * 6144 + col];
            float pv[ADA_KS];
#pragma unroll
            for (int ks = 0; ks < ADA_KS; ++ks) pv[ks] = modp[((size_t)(ks * 2 + l) * 3 + cnd) * 6144 + col];
#pragma unroll
            for (int ks = 0; ks < ADA_KS; ++ks) v += pv[ks];
            modw[e] = v;
        }
    }
    __syncthreads();
    bf16* XN = (bf16*)(F.ws + WS_XN);
    const int gw = F.vcu * NWAVES + F.wave, NGW = F.G * NWAVES;
    for (int m = gw; m < nrows; m += NGW) {
        const float* xrow = m < ML ? src_lat + (size_t)m * DM : src_ctx + (size_t)(m - ML) * DM;
        const int cnd = m < SEQ ? 0 : (m < ML ? 1 : 2);
        const GAS f32x4* xr = (const GAS f32x4*)xrow + F.lane;
        f32x4 v[4]; float s = 0.f;
        if (lat_bf16 && m < ML) {
            const GAS v2u* xb = (const GAS v2u*)((const bf16*)src_lat + (size_t)m * DM) + F.lane;
            v2u w[4];
#pragma unroll
            for (int j = 0; j < 4; ++j) w[j] = xb[64 * j];
#pragma unroll
            for (int j = 0; j < 4; ++j) v[j] = f32x4{bflo(w[j].x), bfhi(w[j].x), bflo(w[j].y), bfhi(w[j].y)};
        } else {
#pragma unroll
            for (int j = 0; j < 4; ++j) v[j] = xr[64 * j];
        }
        if (nparts > 0 && m >= ML) {
            for (int p = 0; p < nparts; p += 4) {
                const GAS f32x4* pr = (const GAS f32x4*)(parts + (size_t)p * (512 * 1024) + (size_t)(m - ML) * DM) + F.lane;
                f32x4 w[4][4];
#pragma unroll
                for (int q = 0; q < 4; ++q)
#pragma unroll
                    for (int j = 0; j < 4; ++j) w[q][j] = pr[(size_t)q * (512 * 1024 / 4) + 64 * j];
#pragma unroll
                for (int j = 0; j < 4; ++j) v[j] += (w[0][j] + w[1][j]) + (w[2][j] + w[3][j]); }
            GAS f32x4* cr = (GAS f32x4*)((float*)(F.ws + WS_CTXRES) + (size_t)(m - ML) * DM) + F.lane;
#pragma unroll
            for (int j = 0; j < 4; ++j) cr[64 * j] = v[j];
        }
#pragma unroll
        for (int j = 0; j < 4; ++j) s += (v[j].x * v[j].x + v[j].y * v[j].y) + (v[j].z * v[j].z + v[j].w * v[j].w);
        const float rstd = 1.f / sqrtf(wave_sum(s, F.lane) * (1.f / DM) + NORM_EPS);
        if (from_partials && m >= ML) { GAS f32x4* cr = (GAS f32x4*)((float*)(F.ws + WS_CTXRES) + (size_t)(m - ML) * DM) + F.lane;
#pragma unroll
            for (int j = 0; j < 4; ++j) cr[64 * j] = v[j]; }
        GAS v2u* o8 = (GAS v2u*)(XN + (size_t)m * DM) + F.lane;
        GAS unsigned* o4 = (GAS unsigned*)((unsigned char*)XN + (size_t)m * DM) + F.lane;
#pragma unroll
        for (int j = 0; j < 4; ++j) { const int col = 4 * F.lane + 256 * j;
            const f32x4 g = *(const LAS f32x4*)(gl + col), sc = *(const LAS f32x4*)(scl + cnd * 1024 + col), sh = *(const LAS f32x4*)(shl + cnd * 1024 + col);
            const f32x4 y = (v[j] * rstd) * g * sc + sh;
            if (xn_fp8) o4[64 * j] = pk4f8(y.x, y.y, y.z, y.w);
            else { v2u w; w.x = pk2(y.x, y.y); w.y = pk2(y.z, y.w); o8[64 * j] = w; } }
    }
    __syncthreads();
}

__device__ __forceinline__ void unpack8(const v4u w, float (&x)[8]) { x[0] = bflo(w.x); x[1] = bfhi(w.x); x[2] = bflo(w.y); x[3] = bfhi(w.y); x[4] = bflo(w.z); x[5] = bfhi(w.z); x[6] = bflo(w.w); x[7] = bfhi(w.w); }
__device__ __forceinline__ v4u pack8(const float (&x)[8]) { v4u w; w.x = pk2(x[0], x[1]); w.y = pk2(x[2], x[3]); w.z = pk2(x[4], x[5]); w.w = pk2(x[6], x[7]); return w; }

__device__ __forceinline__ void qknorm_phase(Frame& F) {
    bf16* QKV = (bf16*)(F.ws + WS_QKV);
    const float* rt = (const float*)(F.ws + WS_ROPE);
    const float* nw[4] = {ARG(12), ARG(13), ARG(15), ARG(16)};
    const float qscale = 0.125f * att::LOG2E;
    const int gw = F.vcu * NWAVES + F.wave, NGW = F.G * NWAVES;
    const int lane = F.lane, grp = lane >> 3, l8 = lane & 7;
    for (int m = gw; m < MR; m += NGW) {
        const bool lat = m < ML; const int t = m & (SEQ - 1); const int prow = t >> 6, pcol = t & 63;
        GAS v4u* rowp = (GAS v4u*)(QKV + (size_t)m * NQKV);
#pragma unroll
        for (int pass = 0; pass < 4; ++pass) {
            int type;
            if (pass == 0) type = 1; else if (pass == 1) type = grp < 2 ? 2 : (grp < 4 ? 0 : 3); else if (pass == 2) type = grp < 4 ? 3 : 4; else type = grp < 4 ? 4 : 0;
            const v4u w = rowp[pass * 64 + lane];
            float x[8]; unpack8(w, x);
            float ss = 0.f;
#pragma unroll
            for (int j = 0; j < 8; ++j) ss += x[j] * x[j];
            ss += shx(ss, 1, F.lane); ss += shx(ss, 2, F.lane); ss += shx(ss, 4, F.lane);
            const float rstd = 1.f / sqrtf(ss * (1.f / 64.f) + NORM_EPS);
            const float* g = type == 1 ? nw[0] : (type == 2 ? nw[1] : (type == 3 ? nw[2] : nw[3]));
            const f32x4 g0 = *(const GAS f32x4*)(g + l8 * 8), g1 = *(const GAS f32x4*)(g + l8 * 8 + 4);
            x[0] *= rstd * g0.x; x[1] *= rstd * g0.y; x[2] *= rstd * g0.z; x[3] *= rstd * g0.w; x[4] *= rstd * g1.x; x[5] *= rstd * g1.y; x[6] *= rstd * g1.z; x[7] *= rstd * g1.w;
            float px[8];
#pragma unroll
            for (int j = 0; j < 8; ++j) px[j] = shx(x[j], 2, F.lane);
            if (lat && (type == 1 || type == 2)) {
                const int pos = (l8 & 4) ? pcol : prow; const float* cs = rt + pos * 16 + (l8 & 1) * 8;
                const f32x4 c0 = *(const GAS f32x4*)(cs), c1 = *(const GAS f32x4*)(cs + 4), s0 = *(const GAS f32x4*)(cs + 2048), s1 = *(const GAS f32x4*)(cs + 2052);
                const float cc[8] = {c0.x, c0.y, c0.z, c0.w, c1.x, c1.y, c1.z, c1.w}, sn[8] = {s0.x, s0.y, s0.z, s0.w, s1.x, s1.y, s1.z, s1.w};
                const float sgn = (l8 & 2) ? 1.f : -1.f;
#pragma unroll
                for (int j = 0; j < 8; ++j) x[j] = x[j] * cc[j] + sgn * px[j] * sn[j];
            }
            if (type == 1 || type == 3) {
#pragma unroll
                for (int j = 0; j < 8; ++j) x[j] *= qscale;
            }
            if (type != 0) rowp[pass * 64 + lane] = pack8(x);
        }
    }
}

__device__ __forceinline__ void cnorm_phase(Frame& F) {
    const bf16* CQKV = (const bf16*)(F.ws + WS_CQKV); bf16* CQN = (bf16*)(F.ws + WS_CQN); bf16* CKVN = (bf16*)(F.ws + WS_CKVN); bf16* KR = (bf16*)(F.ws + WS_KR);
    const float* rt = (const float*)(F.ws + WS_ROPE) + 4096;
    const float* gq = ARG(19); const float* gkv = ARG(20); const float* gkr = ARG(26);
    const int gw = F.vcu * NWAVES + F.wave, NGW = F.G * NWAVES; const int lane = F.lane;
    const float* gA = lane < 48 ? gq + lane * 8 : gkv + (lane - 48) * 8;
    const int li = lane < 16 ? lane : (lane < 20 ? lane - 16 : 0);
    const float* gB = lane < 16 ? gkv + 128 + li * 8 : gkr + li * 8;
    const f32x4 gA0 = *(const GAS f32x4*)(gA), gA1 = *(const GAS f32x4*)(gA + 4), gB0 = *(const GAS f32x4*)(gB), gB1 = *(const GAS f32x4*)(gB + 4);
    v4u w0 = {0u, 0u, 0u, 0u}, w1 = {0u, 0u, 0u, 0u};
    if (gw < MR) { const GAS v4u* rowp = (const GAS v4u*)(CQKV + (size_t)gw * NCIN); w0 = rowp[lane]; if (lane < 32) w1 = rowp[64 + lane]; }
    for (int m = gw; m < MR; m += NGW) {
        const bool lat = m < ML; const int t = m & (SEQ - 1); const int prow = t >> 6, pcol = t & 63;
        const int pos = (lane & 2) ? pcol : prow; const float* cs = rt + pos * 8;
        const f32x4 c0 = *(const GAS f32x4*)(cs), c1 = *(const GAS f32x4*)(cs + 4), sa = *(const GAS f32x4*)(cs + 1024), sb = *(const GAS f32x4*)(cs + 1028);
        v4u n0 = {0u, 0u, 0u, 0u}, n1 = {0u, 0u, 0u, 0u};
        if (m + NGW < MR) { const GAS v4u* rowp = (const GAS v4u*)(CQKV + (size_t)(m + NGW) * NCIN); n0 = rowp[lane]; if (lane < 32) n1 = rowp[64 + lane]; }
        float x0[8], x1[8]; unpack8(w0, x0); unpack8(w1, x1);
        float s0 = 0.f, s1 = 0.f;
#pragma unroll
        for (int j = 0; j < 8; ++j) { s0 += x0[j] * x0[j]; s1 += x1[j] * x1[j]; }
        const float ssq = wave_sum(lane < 48 ? s0 : 0.f, F.lane);
        const float sskv = wave_sum((lane >= 48 ? s0 : 0.f) + (lane < 16 ? s1 : 0.f), F.lane);
        const float sskr = wave_sum((lane >= 16 && lane < 20) ? s1 : 0.f, F.lane);
        const float rq = 1.f / sqrtf(ssq * (1.f / 384.f) + NORM_EPS), rkv = 1.f / sqrtf(sskv * (1.f / 256.f) + NORM_EPS), rkr = 1.f / sqrtf(sskr * (1.f / 32.f) + NORM_EPS);
        { const float r = lane < 48 ? rq : rkv;
          float y[8] = {x0[0] * r * gA0.x, x0[1] * r * gA0.y, x0[2] * r * gA0.z, x0[3] * r * gA0.w, x0[4] * r * gA1.x, x0[5] * r * gA1.y, x0[6] * r * gA1.z, x0[7] * r * gA1.w};
          if (lane < 48) *(GAS v4u*)(CQN + (size_t)m * 384 + lane * 8) = pack8(y); else *(GAS v4u*)(CKVN + (size_t)m * 256 + (lane - 48) * 8) = pack8(y); }
        { const float r = lane < 16 ? rkv : rkr;
          float y[8] = {x1[0] * r * gB0.x, x1[1] * r * gB0.y, x1[2] * r * gB0.z, x1[3] * r * gB0.w, x1[4] * r * gB1.x, x1[5] * r * gB1.y, x1[6] * r * gB1.z, x1[7] * r * gB1.w};
          float py[8];
#pragma unroll
          for (int j = 0; j < 8; ++j) py[j] = shx(y[j], 1, F.lane);
          if (lat && lane >= 16 && lane < 20) {
              const float cc[8] = {c0.x, c0.y, c0.z, c0.w, c1.x, c1.y, c1.z, c1.w}, sn[8] = {sa.x, sa.y, sa.z, sa.w, sb.x, sb.y, sb.z, sb.w};
              const float sgn = (lane & 1) ? 1.f : -1.f;
#pragma unroll
              for (int j = 0; j < 8; ++j) y[j] = y[j] * cc[j] + sgn * py[j] * sn[j];
          }
          if (lane < 16) *(GAS v4u*)(CKVN + (size_t)m * 256 + 128 + lane * 8) = pack8(y);
          else if (lane < 20) *(GAS v4u*)(KR + (size_t)m * 32 + (lane - 16) * 8) = pack8(y); }
        w0 = n0; w1 = n1;
    }
}

__device__ __forceinline__ void hnorm_phase(Frame& F) {
    bf16* Q = (bf16*)(F.ws + WS_Q1); bf16* KV = (bf16*)(F.ws + WS_KV1);
    const float* rt = (const float*)(F.ws + WS_ROPE) + 4096;
    const float* gqn = ARG(23); const float* gqr = ARG(24); const float* gkn = ARG(25);
    const float qscale = 0.10206207261596575f * att::LOG2E;
    const int gw = F.vcu * NWAVES + F.wave, NGW = F.G * NWAVES; const int lane = F.lane, l8 = lane & 7, l4 = lane & 3;
    for (int m = gw; m < MR; m += NGW) {
        const bool lat = m < ML; const int t = m & (SEQ - 1); const int prow = t >> 6, pcol = t & 63;
        { GAS v4u* rowp = (GAS v4u*)(KV + (size_t)m * NUKV);
          const f32x4 g0 = *(const GAS f32x4*)(gkn + l8 * 8), g1 = *(const GAS f32x4*)(gkn + l8 * 8 + 4);
#pragma unroll
          for (int pass = 0; pass < 2; ++pass) {
              float x[8]; unpack8(rowp[pass * 64 + lane], x); float ss = 0.f;
#pragma unroll
              for (int j = 0; j < 8; ++j) ss += x[j] * x[j];
              ss += shx(ss, 1, F.lane); ss += shx(ss, 2, F.lane); ss += shx(ss, 4, F.lane);
              const float r = 1.f / sqrtf(ss * (1.f / 64.f) + NORM_EPS);
              x[0] *= r * g0.x; x[1] *= r * g0.y; x[2] *= r * g0.z; x[3] *= r * g0.w; x[4] *= r * g1.x; x[5] *= r * g1.y; x[6] *= r * g1.z; x[7] *= r * g1.w;
              rowp[pass * 64 + lane] = pack8(x); } }
        if (lat) {
            GAS v4u* rowp = (GAS v4u*)(Q + (size_t)m * NUQ);
            { const f32x4 g0 = *(const GAS f32x4*)(gqn + l8 * 8), g1 = *(const GAS f32x4*)(gqn + l8 * 8 + 4);
#pragma unroll
              for (int pass = 0; pass < 2; ++pass) {
                  float x[8]; unpack8(rowp[pass * 64 + lane], x); float ss = 0.f;
#pragma unroll
                  for (int j = 0; j < 8; ++j) ss += x[j] * x[j];
                  ss += shx(ss, 1, F.lane); ss += shx(ss, 2, F.lane); ss += shx(ss, 4, F.lane);
                  const float r = qscale / sqrtf(ss * (1.f / 64.f) + NORM_EPS);
                  x[0] *= r * g0.x; x[1] *= r * g0.y; x[2] *= r * g0.z; x[3] *= r * g0.w; x[4] *= r * g1.x; x[5] *= r * g1.y; x[6] *= r * g1.z; x[7] *= r * g1.w;
                  rowp[pass * 64 + lane] = pack8(x); } }
            {
              const f32x4 g0 = *(const GAS f32x4*)(gqr + l4 * 8), g1 = *(const GAS f32x4*)(gqr + l4 * 8 + 4);
              float x[8]; unpack8(rowp[128 + lane], x); float ss = 0.f;
#pragma unroll
              for (int j = 0; j < 8; ++j) ss += x[j] * x[j];
              ss += shx(ss, 1, F.lane); ss += shx(ss, 2, F.lane);
              const float r = 1.f / sqrtf(ss * (1.f / 32.f) + NORM_EPS);
              x[0] *= r * g0.x; x[1] *= r * g0.y; x[2] *= r * g0.z; x[3] *= r * g0.w; x[4] *= r * g1.x; x[5] *= r * g1.y; x[6] *= r * g1.z; x[7] *= r * g1.w;
              float px[8];
#pragma unroll
              for (int j = 0; j < 8; ++j) px[j] = shx(x[j], 1, F.lane);
              const int pos = (l4 & 2) ? pcol : prow; const float* cs = rt + pos * 8;
              const f32x4 c0 = *(const GAS f32x4*)(cs), c1 = *(const GAS f32x4*)(cs + 4), sa = *(const GAS f32x4*)(cs + 1024), sb = *(const GAS f32x4*)(cs + 1028);
              const float cc[8] = {c0.x, c0.y, c0.z, c0.w, c1.x, c1.y, c1.z, c1.w}, sn[8] = {sa.x, sa.y, sa.z, sa.w, sb.x, sb.y, sb.z, sb.w};
              const float sgn = (l4 & 1) ? 1.f : -1.f;
#pragma unroll
              for (int j = 0; j < 8; ++j) x[j] = (x[j] * cc[j] + sgn * px[j] * sn[j]) * qscale;
              rowp[128 + lane] = pack8(x); }
        }
    }
}

__device__ __forceinline__ void kr6_pass(Frame& F) {
    if (((const float*)(F.ws + WS_HPAR))[448] == 0.f) return;
    const bf16* KR = (const bf16*)(F.ws + WS_KR); unsigned char* K6R = (unsigned char*)(F.ws + WS_K6R);
    for (int r = F.vcu * (NWAVES * 64) + F.tid; r < MR; r += F.G * (NWAVES * 64)) {
        const GAS v4u* rp = (const GAS v4u*)(KR + (size_t)r * 32);
        v4u w[4] = {rp[0], rp[1], rp[2], rp[3]};
#pragma unroll
        for (int q = 0; q < 4; ++q) { float x[8]; unpack8(w[q], x);
#pragma unroll
            for (int j = 0; j < 8; ++j) x[j] *= 1.5349124f;
            w[q] = pack8(x); }
        const attd::u32x6 c = attd::to_fp6(w[0], w[1], w[2], w[3]);
        unsigned char* img = K6R + (size_t)(r >> 6) * 2048; const int key = r & 63;
        *(GAS v4u*)(img + key * 16) = (v4u){c[0], c[1], c[2], c[3]}; *(GAS v2u*)(img + 1024 + key * 8) = (v2u){c[4], c[5]};
    }
}
__device__ __forceinline__ void attn0_phase(Frame& F) {
    att::lchar* lds = (att::lchar*)(F.lds + RING_OFF);
    const att::bf16* QKV = (const att::bf16*)(F.ws + WS_QKV); att::bf16* O = (att::bf16*)(F.ws + WS_O0);
    const bool fast = __builtin_amdgcn_readfirstlane(__builtin_bit_cast(int, ((const float*)(F.ws + WS_HPAR))[449])) != 0;
    const char* K6E = (const char*)(F.ws + WS_K6E);
    char* shm = (char*)(F.lds + RING_OFF);
    for (int ui = F.vcu; ui < 1056; ui += F.G) {
        if (ui < 512) {
            const int b = ui >> 8, h = (ui >> 5) & 7, R4 = ui & 31;
            const float* rpb = ARG(17) + h * 465;
            if (fast) {
                float* rl = (float*)(shm + attf::LDS_RPB);
                for (int i = F.tid; i < 465; i += NWAVES * 64) rl[i] = rpb[i] * att::LOG2E;
                __syncthreads();
                attf::FNa fu; fu.init((const attf::bf16*)QKV, (attf::bf16*)O, rl, b, h, R4, K6E);
                attf::fast_unit<8, attf::FNa, true>(fu, shm, F.tid);
            } else {
                att::UNa u; u.QKV = QKV; u.O = O; u.rpbl = (const LAS float*)(lds + att::L_RPB); u.b = b; u.h = h; u.R4 = R4; u.init();
                for (int i = F.tid; i < 465; i += NWAVES * 64) ((LAS float*)(lds + att::L_RPB))[i] = rpb[i] * att::LOG2E;
                att::unit<8, att::UNa>(u, lds, F.tid);
            }
        } else if (ui < 1024) {
            const int v = ui - 512;
            if (fast) { attf::FWin fu; fu.init((const attf::bf16*)QKV, (attf::bf16*)O, ARG(14), v >> 8, (v >> 2) & 63, (v >> 1) & 1, v & 1, K6E); attf::fast_unit<8, attf::FWin, true>(fu, shm, F.tid); }
            else { att::UWin u; u.QKV = QKV; u.O = O; u.sinkp = ARG(14); u.b = v >> 8; u.n = (v >> 2) & 63; u.g = (v >> 1) & 1; u.hh = v & 1; u.init(); att::unit<8, att::UWin>(u, lds, F.tid); }
        } else {
            const int v = ui - 1024;
            if (fast) { attf::FCtx fu; fu.init((const attf::bf16*)QKV, (attf::bf16*)O, ARG(14), v >> 4, v & 15, K6E); attf::fast_unit<8, attf::FCtx, true>(fu, shm, F.tid); }
            else { att::UCtx u; u.QKV = QKV; u.O = O; u.sinkp = ARG(14); u.b = v >> 4; u.hx = v & 15; u.init(); att::unit<8, att::UCtx>(u, lds, F.tid); }
        }
    }
}
__device__ __forceinline__ void attn1_phase(Frame& F) {
    att::lchar* lds = (att::lchar*)(F.lds + RING_OFF);
    const bool fast = __builtin_amdgcn_readfirstlane(__builtin_bit_cast(int, ((const float*)(F.ws + WS_HPAR))[448])) != 0;
    const bool g256 = F.G == 256; const int x = F.vcu >> 5, j = F.vcu & 31;
    const int nit = g256 ? 4 : (F.vcu < 1024 ? (1024 - F.vcu + F.G - 1) / F.G : 0);
    for (int i = 0; i < nit; ++i) {
        const int ui = g256 ? ((x * 4 + i) * 32 + j) : F.vcu + i * F.G;
        if (fast) attd::dense_unit(ui >> 9, (ui >> 5) & 15, ui & 31, (const attd::bf16*)(F.ws + WS_Q1), (const attd::bf16*)(F.ws + WS_KV1), (const char*)(F.ws + WS_K6N), (const char*)(F.ws + WS_K6R), (attd::bf16*)(F.ws + WS_O1), (char*)(F.lds + RING_OFF), F.tid);
        else {
        att::UDense u; u.Q = (const att::bf16*)(F.ws + WS_Q1); u.KV = (const att::bf16*)(F.ws + WS_KV1); u.KR = (const att::bf16*)(F.ws + WS_KR); u.O = (att::bf16*)(F.ws + WS_O1);
        u.b = ui >> 9; u.h = (ui >> 5) & 15; u.qb = ui & 31;
        att::unit<12, att::UDense>(u, lds, F.tid); }
    }
}

#ifndef PHASE_MASK
#define PHASE_MASK 0xFFFFFu
#endif
#ifndef PHASE_REP
#define PHASE_REP 0u
#endif
struct Args { const float* in[28]; float* out; unsigned char* ws; int ph_lo, ph_hi; };
constexpr int N_PHASES = 19;
__global__ void __launch_bounds__(NWAVES * 64, 2) fwd_kernel(Args args) {
    extern __shared__ __attribute__((aligned(16))) unsigned char lds[];
    for (int u = threadIdx.x; u < (LDS_BYTES - LDSCTL_OFF) / 4; u += NWAVES * 64) ((LAS unsigned*)((LAS unsigned char*)lds + LDSCTL_OFF))[u] = 0u;
    __syncthreads();
    if (!MK_PER_PHASE) (void)xcd_barrier_post((unsigned*)((gu32*)(ARG_WS + WS_CTL) + CW_BAR), (volatile LAS unsigned*)((LAS unsigned char*)lds + MISC_OFF) + 8);
    const int wv0_ = __builtin_amdgcn_readfirstlane((int)threadIdx.x >> 6);
    for (int ph2 = 2 * args.ph_lo; ph2 < 2 * args.ph_hi; ++ph2) {
        const int ph = ph2 >> 1; if ((ph2 & 1) && !((PHASE_REP >> ph) & 1)) continue;
        if (ph == 3 || ph == 14) continue;
        Frame F;
        { int t_ = wv0_ * 64 + (int)__builtin_amdgcn_mbcnt_hi(~0u, __builtin_amdgcn_mbcnt_lo(~0u, 0u)); asm volatile("" : "+v"(t_)); int b_ = blockIdx.x; asm volatile("" : "+s"(b_)); int g_ = gridDim.x; asm volatile("" : "+s"(g_)); F.tid = t_; F.bx = b_; F.G = g_; }
        F.lds = (LAS unsigned char*)lds; F.MISC = (volatile LAS unsigned*)(F.lds + MISC_OFF);
        F.lane = F.tid & 63; F.wave = __builtin_amdgcn_readfirstlane(F.tid >> 6);
        F.vcu = (F.G % 8 == 0) ? (F.bx % 8) * (F.G / 8) + F.bx / 8 : F.bx;
        F.ws = ARG_WS; F.out = ARG_OUT; F.ctl = (gu32*)(F.ws + WS_CTL);
        XcdBarrier bar; bar.bar = (unsigned*)(F.ctl + CW_BAR); bar.x = xb_xcc_id(); bar.st = F.MISC + 8;
        float* ctxres = (float*)(F.ws + WS_CTXRES);
        const float* mod = (const float*)(F.ws + WS_MOD);
        int gk = 0, xrows = 0, xS = 0;
        pg8::Gemm g{nullptr, nullptr, 0, 0, 0, 0}; pg8::EpiAny ea{0, nullptr, nullptr, nullptr, nullptr, 0, 0};
        switch (ph) {
        case 0: if (!((PHASE_MASK >> 0) & 1)) break; p0_prologue(F); break;
        case 1: if (!((PHASE_MASK >> 1) & 1)) break; norm_phase(F, ARG(0), ARG(2), MR, ARG(6), 0, 0, true, nullptr, 0, false, true); break;
        case 2: if (!((PHASE_MASK >> 2) & 1)) break; gk = 1; g = pg8::Gemm{(const bf16*)(F.ws + WS_XN), (const bf16*)(F.ws + WS_WQKV), MR, NQKV, DM / 2, 1}; ea = pg8::EpiAny{3, (const float*)(F.ws + WS_HPAR), (void*)(F.ws + WS_QKV), (float*)(F.ws + WS_K6E), (const float*)(F.ws + WS_ROPEP), NQKV, 0}; break;
        case 4: if (!((PHASE_MASK >> 4) & 1)) break; attn0_phase(F); break;
        case 5: if (!((PHASE_MASK >> 5) & 1)) break; gk = 2; g = pg8::Gemm{(const bf16*)(F.ws + WS_O0), (const bf16*)(F.ws + WS_WO0), ML, DM, DM}; xrows = MC; xS = 2; ea = pg8::EpiAny{2, ARG(0), (void*)F.out, (float*)(F.ws + WS_PART5), mod + 2048, 0, 2}; break;
        case 6: if (!((PHASE_MASK >> 6) & 1)) break; norm_phase(F, F.out, ctxres, MR, ARG(7), 0, 1, false, (const float*)(F.ws + WS_PART5), 4, true); break;
        case 7: if (!((PHASE_MASK >> 7) & 1)) break; gk = 1; g = pg8::Gemm{(const bf16*)(F.ws + WS_XN), (const bf16*)(F.ws + WS_W1_0), MR, FF, DM}; ea = pg8::EpiAny{1, nullptr, (void*)(F.ws + WS_H), nullptr, nullptr, FF, 1}; break;
        case 8: if (!((PHASE_MASK >> 8) & 1)) break; gk = 2; g = pg8::Gemm{(const bf16*)(F.ws + WS_H), (const bf16*)(F.ws + WS_W2_0), ML, DM, FF}; xrows = MC; xS = 4; ea = pg8::EpiAny{2, F.out, (void*)F.out, (float*)(F.ws + WS_PART8), mod + 5120, 0, 3}; break;
        case 9: if (!((PHASE_MASK >> 9) & 1)) break; norm_phase(F, F.out, ctxres, MR, ARG(6) + DM, 1, 0, false, (const float*)(F.ws + WS_PART8), 16, true); break;
        case 10: if (!((PHASE_MASK >> 10) & 1)) break; gk = 1; g = pg8::Gemm{(const bf16*)(F.ws + WS_XN), (const bf16*)(F.ws + WS_WIN), MR, NCIN, DM}; ea = pg8::EpiAny{1, nullptr, (void*)(F.ws + WS_CQKV), nullptr, nullptr, NCIN, 0}; break;
        case 11: if (!((PHASE_MASK >> 11) & 1)) break; cnorm_phase(F); break;
        case 12: if (!((PHASE_MASK >> 12) & 1)) break; kr6_pass(F); gk = 1; g = pg8::Gemm{(const bf16*)(F.ws + WS_CQN), (const bf16*)(F.ws + WS_WUQ), ML, NUQ, 384}; ea = pg8::EpiAny{3, (const float*)(F.ws + WS_HPAR), (void*)(F.ws + WS_Q1), nullptr, (const float*)(F.ws + WS_ROPEP), NUQ, 1}; break;
        case 13: if (!((PHASE_MASK >> 13) & 1)) break; gk = 1; g = pg8::Gemm{(const bf16*)(F.ws + WS_CKVN), (const bf16*)(F.ws + WS_WUKV), MR, NUKV, 256}; ea = pg8::EpiAny{3, (const float*)(F.ws + WS_HPAR), (void*)(F.ws + WS_KV1), (float*)(F.ws + WS_K6N), (const float*)(F.ws + WS_ROPEP), NUKV, 2}; break;
        case 15: if (!((PHASE_MASK >> 15) & 1)) break; attn1_phase(F); break;
        case 16: if (!((PHASE_MASK >> 16) & 1)) break; gk = 2; g = pg8::Gemm{(const bf16*)(F.ws + WS_O1), (const bf16*)(F.ws + WS_WO1), ML, DM, DM}; ea = pg8::EpiAny{2, F.out, (void*)(F.ws + WS_XR), ctxres, mod + 3 * 6144 + 2048, 0, 3}; break;
        case 17: if (!((PHASE_MASK >> 17) & 1)) break; norm_phase(F, (const float*)(F.ws + WS_XR), ctxres, ML, ARG(7) + DM, 1, 1, false, nullptr, 0, true); break;
        case 18: if (!((PHASE_MASK >> 18) & 1)) break; gk = 1; g = pg8::Gemm{(const bf16*)(F.ws + WS_XN), (const bf16*)(F.ws + WS_W1_1), ML, FF, DM}; ea = pg8::EpiAny{1, nullptr, (void*)(F.ws + WS_H), nullptr, nullptr, FF, 1}; break;
        case 19: if (!((PHASE_MASK >> 19) & 1)) break; gk = 2; g = pg8::Gemm{(const bf16*)(F.ws + WS_H), (const bf16*)(F.ws + WS_W2_1), ML, DM, FF}; ea = pg8::EpiAny{2, (const float*)(F.ws + WS_XR), (void*)F.out, ctxres, mod + 3 * 6144 + 5120, 0, 1}; break;
        default: break;
        }
        ea.scr = F.lds + LDSCTL_OFF + 4096;
        if (gk != 0) { pg8::StaticOrder S; S.init(g.M, g.N, g.K, F.G, ph == 13 ? (F.bx + F.G / 2) % F.G : F.bx, xrows, xS);
            if (g.mx) pg8::gemm_phase<pg8::EpiAny, pg8::StaticOrder, true, true, true>(F.lds + RING_OFF, g, S, ea, F.tid);
            else pg8::gemm_phase<pg8::EpiAny, pg8::StaticOrder, true, true, false>(F.lds + RING_OFF, g, S, ea, F.tid); }
        const bool last_ = (ph == args.ph_hi - 1) && ((ph2 & 1) || !((PHASE_REP >> ph) & 1));
        if (!MK_PER_PHASE && !last_ && ph != 12) xcd_barrier(bar);
        else __syncthreads();
    }
}

extern "C" void kernel_launch(void* const* d_in, const int* in_sizes, int n_in, void* d_out, int out_size, void* d_ws, size_t ws_size, hipStream_t stream) {
    static int grid = 0;
    if (grid == 0) {
        if (n_in != 28 || in_sizes[0] != ML * DM || out_size != ML * DM || ws_size < WS_END) { fprintf(stderr, "kernel_launch: unexpected shapes: n_in %d in0 %d out %d ws %zu\n", n_in, n_in > 0 ? in_sizes[0] : -1, out_size, ws_size); grid = -1; return; }
        int dev = 0, cus = 0, per_cu = 0;
        if (hipGetDevice(&dev) != hipSuccess || hipDeviceGetAttribute(&cus, hipDeviceAttributeMultiprocessorCount, dev) != hipSuccess) { fprintf(stderr, "kernel_launch: device query failed\n"); grid = -1; return; }
        if (hipFuncSetAttribute((const void*)fwd_kernel, hipFuncAttributeMaxDynamicSharedMemorySize, LDS_BYTES) != hipSuccess) { fprintf(stderr, "kernel_launch: hipFuncSetAttribute failed\n"); grid = -1; return; }
        if (hipOccupancyMaxActiveBlocksPerMultiprocessor(&per_cu, (const void*)fwd_kernel, NWAVES * 64, LDS_BYTES) != hipSuccess || per_cu < 1)
            fprintf(stderr, "kernel_launch: note: occupancy query reports %d workgroups per CU\n", per_cu);
        (void)hipGetLastError();
        grid = cus;
    }
    if (grid < 0) return;
    if (hipMemsetAsync((char*)d_ws + WS_CTL, 0, CTL_ZERO_BYTES, stream) != hipSuccess) { fprintf(stderr, "kernel_launch: hipMemsetAsync failed\n"); return; }
    Args a{};
    for (int i = 0; i < 28; ++i) a.in[i] = (const float*)d_in[i];
    a.out = (float*)d_out; a.ws = (unsigned char*)d_ws;
#if MK_PER_PHASE
    for (int ph = 0; ph <= N_PHASES; ++ph) { a.ph_lo = ph; a.ph_hi = ph + 1; hipLaunchKernelGGL(fwd_kernel, dim3(grid), dim3(NWAVES * 64), LDS_BYTES, stream, a); }
#else
    a.ph_lo = 0; a.ph_hi = N_PHASES + 1;
    hipLaunchKernelGGL(fwd_kernel, dim3(grid), dim3(NWAVES * 64), LDS_BYTES, stream, a);
#endif
    const hipError_t le = hipPeekAtLastError();
    if (le != hipSuccess) fprintf(stderr, "kernel_launch: launch failed: %s\n", hipGetErrorName(le));
}
```
